# Optimizing an MI355X kernel written in HIP

```python
import jax
import jax.numpy as jnp
from jax import lax
import numpy as np

D_MODEL = 1024
BATCH = 8
SEQ = 4096
DEPTH = 1

GRID_W = 64
CTX_LEN = 256
NORM_EPS = 1e-6

RWKV_WIDTH = 1024
RWKV_HEAD = 64
RWKV_HEADS = RWKV_WIDTH // RWKV_HEAD
DECAY_LORA = 64
AAA_LORA = 64
GATE_LORA = 160
LNX_EPS = 64e-5

LRU_WIDTH = 1024
LRU_BLOCKS = 16
LRU_BLOCK = LRU_WIDTH // LRU_BLOCKS
CONV_W = 4
CONV_LEFT = 2
LRU_C = 8.0

N_EXPERTS = 64
TOP_K = 6
N_GROUPS = 8
TOPK_GROUPS = 4
EXPERT_FF = 256
SHARED_FF = 256
ROUTED_SCALE = 2.5
MOE_BLOCK = 128

OFF_R = 0
OFF_K = OFF_R + RWKV_WIDTH
OFF_V = OFF_K + RWKV_WIDTH
OFF_WD = OFF_V + RWKV_WIDTH
OFF_AD = OFF_WD + 2 * DECAY_LORA
OFF_GD = OFF_AD + 2 * AAA_LORA
RWKV_COLS = OFF_GD + GATE_LORA
OFF_LX = RWKV_COLS
OFF_LG = OFF_LX + LRU_WIDTH
OFF_GATE = OFF_LG + LRU_WIDTH
IN_COLS = OFF_GATE + 2 * D_MODEL

kernel_name = 'hybrid_rwkv7_rglru_moe_flow_block'


def _rmsnorm(x, g):
    xf = x.astype(jnp.float32)
    y = xf * lax.rsqrt(jnp.mean(xf * xf, axis=-1, keepdims=True) + NORM_EPS)
    return (y * g.astype(jnp.float32)).astype(x.dtype)


def _modulate(x, shift, scale):
    return x * (1.0 + scale) + shift


def _shift_centred(z, mu):
    pad = [(0, 0)] * (z.ndim - 2) + [(1, 1), (0, 0)]
    zp = jnp.pad(z, pad)
    return z + mu[0] * (zp[..., :-2, :] - z) + mu[1] * (zp[..., 2:, :] - z)


def _dwconv(z, w, b):
    lead, (t, ch) = z.shape[:-2], z.shape[-2:]
    y = lax.conv_general_dilated(z.reshape((-1, t, ch)), w[:, None, :].astype(z.dtype),
                                 window_strides=(1,), padding=[(CONV_LEFT, CONV_W - 1 - CONV_LEFT)],
                                 dimension_numbers=('NWC', 'WIO', 'NWC'), feature_group_count=ch)
    return (y + b).reshape(lead + (t, ch))


def _swiglu(x, w_gu, w_down):
    g, u = jnp.split(x @ w_gu, 2, axis=-1)
    return (jax.nn.silu(g) * u) @ w_down


def _dirs_to_scan(t):
    s = jnp.stack([t[:, :, 0], jnp.flip(t[:, :, 1], axis=1)], axis=0)
    return jnp.moveaxis(s, 2, 0)


def _scan_to_dirs(t):
    t = jnp.moveaxis(t, 0, 2)
    return jnp.stack([t[0], jnp.flip(t[1], axis=1)], axis=2)


def _rwkv_scan(r, decay, k, v, kk, b, s0):
    def step(s, inp):
        r_t, w_t, k_t, v_t, kk_t, b_t = inp
        s_a = jnp.einsum('dbhvk,dbhk->dbhv', s, -kk_t)
        s = s * w_t[..., None, :] + s_a[..., None] * b_t[..., None, :] + v_t[..., None] * k_t[..., None, :]
        return s, jnp.einsum('dbhvk,dbhk->dbhv', s, r_t)
    s_fin, y = lax.scan(step, s0, (r, decay, k, v, kk, b))
    return y, s_fin


def _linear_scan(a, bx, h0):
    def comb(lhs, rhs):
        return lhs[0] * rhs[0], rhs[0] * lhs[1] + rhs[1]
    a_cum, b_cum = lax.associative_scan(comb, (a, bx), axis=0)
    h = a_cum * h0 + b_cum
    return h, h[-1]


def _rwkv_branch(zr, s0, with_output, w0, w_up, a0, a_up, g_up, k_k, k_a, r_k, lnx):
    bsz, t, _ = zr.shape
    f32 = jnp.float32
    r = zr[..., OFF_R:OFF_K]
    k = zr[..., OFF_K:OFF_V]
    v = zr[..., OFF_V:OFF_WD]
    wd = zr[..., OFF_WD:OFF_AD].reshape(bsz, t, 2, DECAY_LORA)
    ad = zr[..., OFF_AD:OFF_GD].reshape(bsz, t, 2, AAA_LORA)
    w_log = -jax.nn.softplus(-(w0 + jnp.einsum('btdr,drc->btdc', jnp.tanh(wd), w_up)).astype(f32)) - 0.5
    decay = jnp.exp(-jnp.exp(w_log))
    a = jax.nn.sigmoid(a0 + jnp.einsum('btdr,drc->btdc', ad, a_up)).astype(f32)
    heads = lambda u: u.reshape(u.shape[:-1] + (RWKV_HEADS, RWKV_HEAD))
    both = lambda u: jnp.broadcast_to(u[:, :, None], (bsz, t, 2) + u.shape[2:])
    kk = heads((k * k_k).astype(f32))
    kk = kk / jnp.maximum(jnp.linalg.norm(kk, axis=-1, keepdims=True), 1e-12)
    k_dir = heads(k[:, :, None].astype(f32) * (1.0 + (a - 1.0) * k_a))
    r_h = heads(r.astype(f32))
    v_h = heads(v.astype(f32))
    if s0 is None:
        s0 = jnp.zeros((2, bsz, RWKV_HEADS, RWKV_HEAD, RWKV_HEAD), f32)
    seq = [both(r_h), heads(decay), k_dir, both(v_h), both(kk), both(kk) * heads(a)]
    y, s_fin = _rwkv_scan(*[_dirs_to_scan(u) for u in seq], s0)
    if not with_output:
        return None, s_fin
    y = _scan_to_dirs(y).sum(axis=2)
    mu = jnp.mean(y, axis=-1, keepdims=True)
    var = jnp.mean(jnp.square(y - mu), axis=-1, keepdims=True)
    y = ((y - mu) * lax.rsqrt(var + LNX_EPS)).reshape(bsz, t, RWKV_WIDTH) * lnx[0] + lnx[1]
    bonus = jnp.sum(r_h[:, :, None] * k_dir * r_k, axis=(2, 4))
    y = y + (bonus[..., None] * v_h).reshape(bsz, t, RWKV_WIDTH)
    g = jax.nn.sigmoid(zr[..., OFF_GD:RWKV_COLS]) @ g_up
    return (y * g).astype(zr.dtype), s_fin


def _rglru_branch(xc, zg, h0, with_output, gate_w, gate_b, lru_l):
    bsz, t, ch = xc.shape
    f32 = jnp.float32
    xb = xc.reshape(bsz, t, LRU_BLOCKS, LRU_BLOCK)
    gates = jax.nn.sigmoid((jnp.einsum('btnj,dgnjk->btdgnk', xb, gate_w) + gate_b).astype(f32))
    gates = gates.reshape(bsz, t, 2, 2, ch)
    log_a = -LRU_C * gates[:, :, :, 0] * jax.nn.softplus(-lru_l.astype(f32))
    bx = jnp.sqrt(-jnp.expm1(2.0 * log_a)) * gates[:, :, :, 1] * xc[:, :, None].astype(f32)
    if h0 is None:
        h0 = jnp.zeros((2, bsz, ch), f32)
    h, h_fin = _linear_scan(_dirs_to_scan(jnp.exp(log_a)), _dirs_to_scan(bx), h0)
    if not with_output:
        return None, h_fin
    h = _scan_to_dirs(h).sum(axis=2)
    return (jax.nn.gelu(zg.astype(f32)) * h).astype(xc.dtype), h_fin


def _token_mixers(z, rows, s_rwkv0, h_lru0, with_output, shift_mu, rw_w0, rw_w_up, rw_a0, rw_a_up,
                  rw_g_up, rw_k_k, rw_k_a, rw_r_k, rw_lnx, lru_conv_w, lru_conv_b, lru_gate_w,
                  lru_gate_b, lru_l, w_branch_a, w_branch_b, w_out):
    bsz, t, _ = z.shape
    zr = z[..., :RWKV_COLS]
    zx = z[..., OFF_LX:OFF_LG]
    zg = None
    if rows is None:
        zr = _shift_centred(zr, shift_mu)
        xc = _dwconv(zx, lru_conv_w, lru_conv_b)
        if with_output:
            zg = z[..., OFF_LG:OFF_GATE]
    else:
        zr = _shift_centred(zr.reshape(bsz, rows, GRID_W, RWKV_COLS), shift_mu).reshape(bsz, t, RWKV_COLS)
        to_cols = lambda u: jnp.swapaxes(u.reshape(bsz, rows, GRID_W, u.shape[-1]), 1, 2)
        xc = _dwconv(to_cols(zx), lru_conv_w, lru_conv_b).reshape(bsz, t, LRU_WIDTH)
        zg = to_cols(z[..., OFF_LG:OFF_GATE]).reshape(bsz, t, LRU_WIDTH)
    y_a, s_rwkv = _rwkv_branch(zr, s_rwkv0, with_output, rw_w0, rw_w_up, rw_a0, rw_a_up, rw_g_up,
                               rw_k_k, rw_k_a, rw_r_k, rw_lnx)
    y_b, h_lru = _rglru_branch(xc, zg, h_lru0, with_output, lru_gate_w, lru_gate_b, lru_l)
    if not with_output:
        return None, s_rwkv, h_lru
    if rows is not None:
        y_b = jnp.swapaxes(y_b.reshape(bsz, GRID_W, rows, LRU_WIDTH), 1, 2).reshape(bsz, t, LRU_WIDTH)
    gates = jax.nn.sigmoid(z[..., OFF_GATE:IN_COLS])
    mixed = gates[..., :D_MODEL] * (y_a @ w_branch_a) + gates[..., D_MODEL:] * (y_b @ w_branch_b)
    return mixed @ w_out, s_rwkv, h_lru


def _grouped_experts(x2, top_idx, gate, w_gu, w_down):
    m, d = x2.shape
    n_assign = m * TOP_K
    flat_e = top_idx.reshape(-1)
    flat_tok = jnp.arange(n_assign, dtype=jnp.int32) // TOP_K
    order = jnp.argsort(flat_e)
    sorted_e = flat_e[order]
    counts = jnp.bincount(flat_e, length=N_EXPERTS)
    padded = (counts + MOE_BLOCK - 1) // MOE_BLOCK * MOE_BLOCK
    pad_end = jnp.cumsum(padded)
    pad_start = pad_end - padded
    start = jnp.cumsum(counts) - counts
    dest = pad_start[sorted_e] + jnp.arange(n_assign, dtype=jnp.int32) - start[sorted_e]
    n_blocks = (n_assign + N_EXPERTS * (MOE_BLOCK - 1) + MOE_BLOCK - 1) // MOE_BLOCK
    p_rows = n_blocks * MOE_BLOCK
    buf_tok = jnp.full((p_rows,), m, jnp.int32).at[dest].set(flat_tok[order])
    buf_gate = jnp.zeros((p_rows,), gate.dtype).at[dest].set(gate.reshape(-1)[order])
    blk_e = jnp.minimum(jnp.searchsorted(pad_end, jnp.arange(n_blocks) * MOE_BLOCK, side='right'),
                        N_EXPERTS - 1)
    x_pad = jnp.concatenate([x2, jnp.zeros((1, d), x2.dtype)], axis=0)

    def block(args):
        tok, g, e = args
        return _swiglu(x_pad[tok], w_gu[e], w_down[e]) * g[:, None]

    y = lax.map(block, (buf_tok.reshape(n_blocks, MOE_BLOCK), buf_gate.reshape(n_blocks, MOE_BLOCK), blk_e))
    out = jnp.zeros((m + 1, d), y.dtype).at[buf_tok].add(y.reshape(p_rows, d))
    return out[:m]


def _moe_ffn(u, router_w, router_b, ex_w_gu, ex_w_down, sh_w_gu, sh_w_down):
    shape = u.shape
    x2 = u.reshape(-1, D_MODEL)
    m = x2.shape[0]
    scores = jax.nn.sigmoid((x2 @ router_w).astype(jnp.float32))
    biased = scores + router_b
    grp_score = lax.top_k(biased.reshape(m, N_GROUPS, N_EXPERTS // N_GROUPS), 2)[0].sum(-1)
    _, grp_idx = lax.top_k(grp_score, TOPK_GROUPS)
    grp_mask = jnp.any(grp_idx[:, :, None] == jnp.arange(N_GROUPS)[None, None, :], axis=1)
    masked = jnp.where(jnp.repeat(grp_mask, N_EXPERTS // N_GROUPS, axis=1), biased, -jnp.inf)
    _, top_idx = lax.top_k(masked, TOP_K)
    top_s = jnp.take_along_axis(scores, top_idx, axis=1)
    gate = (top_s / jnp.sum(top_s, axis=-1, keepdims=True) * ROUTED_SCALE).astype(u.dtype)
    routed = _grouped_experts(x2, top_idx, gate, ex_w_gu, ex_w_down)
    return (routed + _swiglu(x2, sh_w_gu, sh_w_down)).reshape(shape)


def setup_inputs(seed: int = 0) -> dict:
    key = jax.random.key(seed)
    ks = iter(jax.random.split(key, 48))
    f32 = jnp.float32
    nrm = lambda shape, s: jax.random.normal(next(ks), shape, f32) * s
    uni = lambda shape, lo, hi: jax.random.uniform(next(ks), shape, f32, lo, hi)
    d = D_MODEL
    x = nrm((BATCH, SEQ, d), 1.0)
    c = nrm((BATCH, d), 1.0)
    ctx = nrm((BATCH, CTX_LEN, d), 1.0)
    c_ctx = nrm((d,), 1.0)
    w_mod = nrm((DEPTH, d, 6 * d), 0.5 * d ** -0.5)
    b_mod = nrm((DEPTH, 6 * d), 0.02)
    norm_g = 1.0 + nrm((DEPTH, 4, d), 0.05)
    w_in = nrm((DEPTH, d, IN_COLS), d ** -0.5)
    shift_mu = uni((DEPTH, 2, RWKV_COLS), 0.0, 0.5)
    rw_w0 = uni((DEPTH, 2, RWKV_WIDTH), -6.0, -1.0)
    rw_w_up = nrm((DEPTH, 2, DECAY_LORA, RWKV_WIDTH), 0.1 * DECAY_LORA ** -0.5)
    rw_a0 = nrm((DEPTH, 2, RWKV_WIDTH), 0.1)
    rw_a_up = nrm((DEPTH, 2, AAA_LORA, RWKV_WIDTH), 0.5 * AAA_LORA ** -0.5)
    rw_g_up = nrm((DEPTH, GATE_LORA, RWKV_WIDTH), GATE_LORA ** -0.5)
    rw_k_k = 0.85 + nrm((DEPTH, RWKV_WIDTH), 0.05)
    rw_k_a = 1.0 + nrm((DEPTH, RWKV_WIDTH), 0.05)
    rw_r_k = nrm((DEPTH, RWKV_HEADS, RWKV_HEAD), 0.1)
    rw_lnx = jnp.stack([1.0 + nrm((DEPTH, RWKV_WIDTH), 0.05), nrm((DEPTH, RWKV_WIDTH), 0.02)], axis=1)
    lru_conv_w = nrm((DEPTH, CONV_W, LRU_WIDTH), 0.5)
    lru_conv_b = nrm((DEPTH, LRU_WIDTH), 0.02)
    lru_gate_w = nrm((DEPTH, 2, 2, LRU_BLOCKS, LRU_BLOCK, LRU_BLOCK), LRU_BLOCK ** -0.5)
    lru_gate_b = nrm((DEPTH, 2, 2, LRU_BLOCKS, LRU_BLOCK), 0.02)
    sig = uni((DEPTH, 2, LRU_WIDTH), 0.9, 0.999) ** (1.0 / LRU_C)
    lru_l = jnp.log(sig) - jnp.log1p(-sig)
    w_branch_a = nrm((DEPTH, RWKV_WIDTH, d), RWKV_WIDTH ** -0.5)
    w_branch_b = nrm((DEPTH, LRU_WIDTH, d), LRU_WIDTH ** -0.5)
    w_out = nrm((DEPTH, d, d), d ** -0.5)
    router_w = nrm((DEPTH, d, N_EXPERTS), d ** -0.5)
    router_b = nrm((DEPTH, N_EXPERTS), 0.01)
    ex_w_gu = nrm((DEPTH, N_EXPERTS, d, 2 * EXPERT_FF), d ** -0.5)
    ex_w_down = nrm((DEPTH, N_EXPERTS, EXPERT_FF, d), EXPERT_FF ** -0.5)
    sh_w_gu = nrm((DEPTH, d, 2 * SHARED_FF), d ** -0.5)
    sh_w_down = nrm((DEPTH, SHARED_FF, d), SHARED_FF ** -0.5)
    return {'x': x, 'c': c, 'ctx': ctx, 'c_ctx': c_ctx, 'w_mod': w_mod, 'b_mod': b_mod,
            'norm_g': norm_g, 'w_in': w_in, 'shift_mu': shift_mu, 'rw_w0': rw_w0, 'rw_w_up': rw_w_up,
            'rw_a0': rw_a0, 'rw_a_up': rw_a_up, 'rw_g_up': rw_g_up, 'rw_k_k': rw_k_k, 'rw_k_a': rw_k_a,
            'rw_r_k': rw_r_k, 'rw_lnx': rw_lnx, 'lru_conv_w': lru_conv_w, 'lru_conv_b': lru_conv_b,
            'lru_gate_w': lru_gate_w, 'lru_gate_b': lru_gate_b, 'lru_l': lru_l,
            'w_branch_a': w_branch_a, 'w_branch_b': w_branch_b, 'w_out': w_out,
            'router_w': router_w, 'router_b': router_b, 'ex_w_gu': ex_w_gu, 'ex_w_down': ex_w_down,
            'sh_w_gu': sh_w_gu, 'sh_w_down': sh_w_down}


def reference(x, c, ctx, c_ctx, w_mod, b_mod, norm_g, w_in, shift_mu, rw_w0, rw_w_up, rw_a0, rw_a_up,
              rw_g_up, rw_k_k, rw_k_a, rw_r_k, rw_lnx, lru_conv_w, lru_conv_b, lru_gate_w, lru_gate_b,
              lru_l, w_branch_a, w_branch_b, w_out, router_w, router_b, ex_w_gu, ex_w_down,
              sh_w_gu, sh_w_down):
    rows = x.shape[1] // GRID_W
    h = x
    hc = ctx
    for l in range(DEPTH):
        last = l == DEPTH - 1
        mod = (jax.nn.silu(c) @ w_mod[l] + b_mod[l])[:, None, :]
        mod_c = jax.nn.silu(c_ctx) @ w_mod[l] + b_mod[l]
        sh1, sc1, gt1, sh2, sc2, gt2 = jnp.split(mod, 6, axis=-1)
        csh1, csc1, cgt1, csh2, csc2, cgt2 = jnp.split(mod_c, 6, axis=-1)
        g_pre1, g_post1, g_pre2, g_post2 = norm_g[l]
        mix_p = (shift_mu[l], rw_w0[l], rw_w_up[l], rw_a0[l], rw_a_up[l], rw_g_up[l], rw_k_k[l],
                 rw_k_a[l], rw_r_k[l], rw_lnx[l], lru_conv_w[l], lru_conv_b[l], lru_gate_w[l],
                 lru_gate_b[l], lru_l[l], w_branch_a[l], w_branch_b[l], w_out[l])
        ffn_p = (router_w[l], router_b[l], ex_w_gu[l], ex_w_down[l], sh_w_gu[l], sh_w_down[l])
        zc = _modulate(_rmsnorm(hc, g_pre1), csh1, csc1) @ w_in[l]
        yc, s_rwkv, h_lru = _token_mixers(zc, None, None, None, not last, *mix_p)
        z = _modulate(_rmsnorm(h, g_pre1), sh1, sc1) @ w_in[l]
        y, _, _ = _token_mixers(z, rows, s_rwkv, h_lru, True, *mix_p)
        h = h + gt1 * _rmsnorm(y, g_post1)
        u = _modulate(_rmsnorm(h, g_pre2), sh2, sc2)
        h = h + gt2 * _rmsnorm(_moe_ffn(u, *ffn_p), g_post2)
        if not last:
            hc = hc + cgt1 * _rmsnorm(yc, g_post1)
            uc = _modulate(_rmsnorm(hc, g_pre2), csh2, csc2)
            hc = hc + cgt2 * _rmsnorm(_moe_ffn(uc, *ffn_p), g_post2)
    return h
```

```cpp
#ifndef HOST_EMU
#include <hip/hip_runtime.h>
#define HD __host__ __device__ __forceinline__
#else
#include <cmath>
#include <cstdio>
#include <cstdlib>
#include <cstring>
#include <vector>
#define HD inline
#endif

#ifdef SMALL
constexpr int D = 128, NB = 2, SEQ = 64, GW = 8, CTX = 16, RW = 128, RH = 64, DL = 16, AL = 16, GL = 24, LW = 128, LB = 2, NE = 8, TOPK = 3, NG = 4, TG = 2, EF = 32, SF = 32;
#else
constexpr int D = 1024, NB = 8, SEQ = 4096, GW = 64, CTX = 256, RW = 1024, RH = 64, DL = 64, AL = 64, GL = 160, LW = 1024, LB = 16, NE = 64, TOPK = 6, NG = 8, TG = 4, EF = 256, SF = 256;
#endif
constexpr int NH = RW / RH, LBS = LW / LB, ROWS = SEQ / GW, TA = CTX + SEQ;
constexpr int OFF_R = 0, OFF_K = RW, OFF_V = 2 * RW, OFF_WD = 3 * RW, OFF_AD = OFF_WD + 2 * DL, OFF_GD = OFF_AD + 2 * AL, RC = OFF_GD + GL;
constexpr int OFF_LX = RC, OFF_LG = OFF_LX + LW, OFF_GATE = OFF_LG + LW, INC = OFF_GATE + 2 * D;
constexpr int EPG = NE / NG, NASG = SEQ * TOPK;
#define NORM_EPS 1e-6f
#define LNX_EPS 64e-5f

HD float sigmoidf_(float x) { return 1.f / (1.f + expf(-x)); }
HD float softplusf_(float x) { return x > 20.f ? x : log1pf(expf(x)); }
HD float siluf_(float x) { return x * sigmoidf_(x); }
HD float gelu_tanhf_(float x) { return 0.5f * x * (1.f + tanhf(0.7978845608028654f * (x + 0.044715f * x * x * x))); }

struct In {
    const float *x, *c, *ctx, *c_ctx, *w_mod, *b_mod, *norm_g, *w_in, *shift_mu, *rw_w0, *rw_w_up, *rw_a0, *rw_a_up, *rw_g_up, *rw_k_k, *rw_k_a, *rw_r_k, *rw_lnx,
        *lru_conv_w, *lru_conv_b, *lru_gate_w, *lru_gate_b, *lru_l, *w_branch_a, *w_branch_b, *w_out, *router_w, *router_b, *ex_w_gu, *ex_w_down, *sh_w_gu, *sh_w_down;
};

struct FMod {
    In in; float* mod;
    HD void operator()(long i) const {
        int r = (int)(i / (6 * D)), j = (int)(i % (6 * D));
        const float* cv = r < NB ? in.c + (long)r * D : in.c_ctx;
        float s = 0.f;
        for (int k = 0; k < D; ++k) s += siluf_(cv[k]) * in.w_mod[(long)k * 6 * D + j];
        mod[i] = s + in.b_mod[j];
    }
};
struct FXn {
    In in; const float* mod; float* xn; long b;
    HD void operator()(long tt) const {
        const float* src = tt < CTX ? in.ctx + ((long)b * CTX + tt) * D : in.x + ((long)b * SEQ + (tt - CTX)) * D;
        const float* m = mod + (long)(tt < CTX ? NB : b) * 6 * D;
        float ss = 0.f; for (int k = 0; k < D; ++k) ss += src[k] * src[k];
        float rinv = 1.f / sqrtf(ss / D + NORM_EPS);
        for (int k = 0; k < D; ++k) xn[tt * D + k] = (src[k] * rinv * in.norm_g[k]) * (1.f + m[D + k]) + m[k];
    }
};
HD float zshift(const float* z, const float* mu, long tt, int col) {
    bool hp, hn;
    if (tt < CTX) { hp = tt > 0; hn = tt < CTX - 1; }
    else { int cg = (int)((tt - CTX) % GW); hp = cg > 0; hn = cg < GW - 1; }
    float v = z[tt * INC + col], p = hp ? z[(tt - 1) * INC + col] : 0.f, n = hn ? z[(tt + 1) * INC + col] : 0.f;
    return v + mu[col] * (p - v) + mu[RC + col] * (n - v);
}
struct FRwPrepA {
    In in; const float* z; float *R, *V, *KKr, *Wd, *KD, *Aa;
    HD void operator()(long i) const {
        long tt = i / RW; int c = (int)(i % RW);
        float r = zshift(z, in.shift_mu, tt, OFF_R + c), k = zshift(z, in.shift_mu, tt, OFF_K + c), v = zshift(z, in.shift_mu, tt, OFF_V + c);
        R[i] = r; V[i] = v; KKr[i] = k * in.rw_k_k[c];
        for (int d = 0; d < 2; ++d) {
            float lw = in.rw_w0[d * RW + c], la = in.rw_a0[d * RW + c];
            for (int j = 0; j < DL; ++j) lw += tanhf(zshift(z, in.shift_mu, tt, OFF_WD + d * DL + j)) * in.rw_w_up[((long)d * DL + j) * RW + c];
            for (int j = 0; j < AL; ++j) la += zshift(z, in.shift_mu, tt, OFF_AD + d * AL + j) * in.rw_a_up[((long)d * AL + j) * RW + c];
            float wlog = -softplusf_(-lw) - 0.5f, a = sigmoidf_(la);
            long o = ((long)d * TA + tt) * RW + c;
            Wd[o] = expf(-expf(wlog)); Aa[o] = a; KD[o] = k * (1.f + (a - 1.f) * in.rw_k_a[c]);
        }
    }
};
struct FRwPrepB {
    In in; const float *R, *KKr, *KD, *Aa; float *KK, *Bv, *bonus;
    HD void operator()(long i) const {
        long tt = i / NH; int h = (int)(i % NH);
        float ss = 0.f; for (int n = 0; n < RH; ++n) { float q = KKr[tt * RW + h * RH + n]; ss += q * q; }
        float inv = 1.f / fmaxf(sqrtf(ss), 1e-12f);
        float bon = 0.f;
        for (int n = 0; n < RH; ++n) {
            long o = tt * RW + h * RH + n; float kk = KKr[o] * inv; KK[o] = kk;
            for (int d = 0; d < 2; ++d) { long od = ((long)d * TA + tt) * RW + h * RH + n; Bv[od] = kk * Aa[od]; bon += R[o] * KD[od] * in.rw_r_k[h * RH + n]; }
        }
        bonus[i] = bon;
    }
};
HD long rw_step_tt(int d, int step) { return step < CTX ? (d == 0 ? step : CTX - 1 - step) : CTX + (d == 0 ? (step - CTX) : SEQ - 1 - (step - CTX)); }
struct FRwScan {
    const float *R, *V, *KK, *Wd, *KD, *Bv; float* Y;
    HD void operator()(long i) const {
        int d = (int)(i / (NH * RH)), h = (int)((i / RH) % NH), v = (int)(i % RH);
        float S[RH];
#pragma unroll
        for (int k = 0; k < RH; ++k) S[k] = 0.f;
        for (int step = 0; step < TA; ++step) {
            long tt = rw_step_tt(d, step);
            const float* kk = KK + tt * RW + h * RH; const float* r = R + tt * RW + h * RH;
            const float* w = Wd + ((long)d * TA + tt) * RW + h * RH; const float* kd = KD + ((long)d * TA + tt) * RW + h * RH; const float* bv = Bv + ((long)d * TA + tt) * RW + h * RH;
            float vv = V[tt * RW + h * RH + v];
            float sa = 0.f;
#pragma unroll
            for (int k = 0; k < RH; ++k) sa -= S[k] * kk[k];
            float y = 0.f;
#pragma unroll
            for (int k = 0; k < RH; ++k) { S[k] = S[k] * w[k] + sa * bv[k] + vv * kd[k]; y += S[k] * r[k]; }
            if (step >= CTX) Y[((long)d * SEQ + (tt - CTX)) * RW + h * RH + v] = y;
        }
    }
};
struct FRwPostA {
    In in; const float *Y, *V, *bonus; float* YA;
    HD void operator()(long i) const {
        long t = i / NH; int h = (int)(i % NH); long tt = t + CTX;
        float mu = 0.f; for (int n = 0; n < RH; ++n) mu += Y[t * RW + h * RH + n] + Y[((long)SEQ + t) * RW + h * RH + n];
        mu /= RH; float var = 0.f;
        for (int n = 0; n < RH; ++n) { float q = Y[t * RW + h * RH + n] + Y[((long)SEQ + t) * RW + h * RH + n] - mu; var += q * q; }
        var /= RH; float rs = 1.f / sqrtf(var + LNX_EPS);
        for (int n = 0; n < RH; ++n) { int c = h * RH + n; float y = Y[t * RW + c] + Y[((long)SEQ + t) * RW + c];
            YA[t * RW + c] = (y - mu) * rs * in.rw_lnx[c] + in.rw_lnx[RW + c] + bonus[tt * NH + h] * V[tt * RW + c]; }
    }
};
struct FRwPostB {
    In in; const float* z; float* YA;
    HD void operator()(long i) const {
        long t = i / RW; int c = (int)(i % RW); long tt = t + CTX; float g = 0.f;
        for (int j = 0; j < GL; ++j) g += sigmoidf_(zshift(z, in.shift_mu, tt, OFF_GD + j)) * in.rw_g_up[(long)j * RW + c];
        YA[i] *= g;
    }
};
struct FConv {
    In in; const float* z; float* xc;
    HD void operator()(long i) const {
        long tt = i / LW; int c = (int)(i % LW); float s = in.lru_conv_b[c];
        for (int j = 0; j < 4; ++j) {
            long src = -1;
            if (tt < CTX) { long q = tt + j - 2; if (q >= 0 && q < CTX) src = q; }
            else { long t = tt - CTX; int row = (int)(t / GW), col = (int)(t % GW), rr = row + j - 2; if (rr >= 0 && rr < ROWS) src = CTX + (long)rr * GW + col; }
            if (src >= 0) s += in.lru_conv_w[j * LW + c] * z[src * INC + OFF_LX + c];
        }
        xc[i] = s;
    }
};
struct FLruGates {
    In in; const float* xc; float *LA, *LBX;
    HD void operator()(long i) const {
        int d = (int)(i / ((long)TA * LW)); long tt = (i / LW) % TA; int c = (int)(i % LW), n = c / LBS, k = c % LBS;
        float p0 = in.lru_gate_b[((d * 2 + 0) * LB + n) * LBS + k], p1 = in.lru_gate_b[((d * 2 + 1) * LB + n) * LBS + k];
        for (int j = 0; j < LBS; ++j) { float xv = xc[tt * LW + n * LBS + j];
            p0 += xv * in.lru_gate_w[((((long)d * 2 + 0) * LB + n) * LBS + j) * LBS + k]; p1 += xv * in.lru_gate_w[((((long)d * 2 + 1) * LB + n) * LBS + j) * LBS + k]; }
        float la = -8.f * sigmoidf_(p0) * softplusf_(-in.lru_l[d * LW + c]);
        LA[i] = expf(la); LBX[i] = sqrtf(-expm1f(2.f * la)) * sigmoidf_(p1) * xc[tt * LW + c];
    }
};
struct FLruScan {
    const float *LA, *LBX; float* Hs;
    HD void operator()(long i) const {
        int d = (int)(i / LW), c = (int)(i % LW); float h = 0.f;
        for (int step = 0; step < TA; ++step) {
            long tt;
            if (step < CTX) tt = d == 0 ? step : CTX - 1 - step;
            else { int s = step - CTX, si = d == 0 ? s : SEQ - 1 - s, col = si / ROWS, row = si % ROWS; tt = CTX + (long)row * GW + col; }
            long o = ((long)d * TA + tt) * LW + c;
            h = LA[o] * h + LBX[o];
            if (step >= CTX) Hs[((long)d * SEQ + (tt - CTX)) * LW + c] = h;
        }
    }
};
struct FYb {
    const float *z, *Hs; float* YB;
    HD void operator()(long i) const { long t = i / LW; int c = (int)(i % LW); YB[i] = gelu_tanhf_(z[(t + CTX) * INC + OFF_LG + c]) * (Hs[i] + Hs[(long)SEQ * LW + i]); }
};
struct FMix {
    const float *z, *m1, *m2; float* mixed;
    HD void operator()(long i) const { long t = i / D; int c = (int)(i % D);
        mixed[i] = sigmoidf_(z[(t + CTX) * INC + OFF_GATE + c]) * m1[i] + sigmoidf_(z[(t + CTX) * INC + OFF_GATE + D + c]) * m2[i]; }
};
struct FH1U {
    In in; const float *mod, *y2; float *h1, *u; long b;
    HD void operator()(long t) const {
        const float* m = mod + (long)b * 6 * D; const float* xr = in.x + ((long)b * SEQ + t) * D;
        float ss = 0.f; for (int k = 0; k < D; ++k) ss += y2[t * D + k] * y2[t * D + k];
        float rinv = 1.f / sqrtf(ss / D + NORM_EPS); float s2 = 0.f;
        for (int k = 0; k < D; ++k) { float hv = xr[k] + m[2 * D + k] * (y2[t * D + k] * rinv * in.norm_g[D + k]); h1[t * D + k] = hv; s2 += hv * hv; }
        float r2 = 1.f / sqrtf(s2 / D + NORM_EPS);
        for (int k = 0; k < D; ++k) u[t * D + k] = (h1[t * D + k] * r2 * in.norm_g[2 * D + k]) * (1.f + m[4 * D + k]) + m[3 * D + k];
    }
};
struct FTopk {
    In in; const float* logits; int* tope; float* gatev;
    HD float sc(long t, int e) const { return sigmoidf_(logits[t * NE + e]); }
    HD float bi(long t, int e) const { return sc(t, e) + in.router_b[e]; }
    HD void operator()(long t) const {
        float gs[NG];
#pragma unroll
        for (int g = 0; g < NG; ++g) { float a = -1e30f, b2 = -1e30f; for (int j = 0; j < EPG; ++j) { float v = bi(t, g * EPG + j); if (v > a) { b2 = a; a = v; } else if (v > b2) b2 = v; } gs[g] = a + b2; }
        unsigned gmask = 0;
        for (int it = 0; it < TG; ++it) { float bv = -1e30f; int best = 0;
#pragma unroll
            for (int g = 0; g < NG; ++g) if (!((gmask >> g) & 1u) && gs[g] > bv) { bv = gs[g]; best = g; }
            gmask |= 1u << best; }
        unsigned long long used = 0ull; float tsum = 0.f;
        for (int it = 0; it < TOPK; ++it) { float bv = -1e30f; int best = 0;
            for (int e = 0; e < NE; ++e) if (((gmask >> (e / EPG)) & 1u) && !((used >> e) & 1ull)) { float v = bi(t, e); if (v > bv) { bv = v; best = e; } }
            used |= 1ull << best; tope[t * TOPK + it] = best; tsum += sc(t, best); }
        for (int it = 0; it < TOPK; ++it) gatev[t * TOPK + it] = sc(t, tope[t * TOPK + it]) / tsum * 2.5f;
    }
};
struct FCount {
    const int* tope; int* cnt;
    HD void operator()(long e) const { int n = 0; for (int a = 0; a < NASG; ++a) n += tope[a] == e; cnt[e] = n; }
};
struct FOffsets {
    const int* cnt; int* off;
    HD void operator()(long) const { int s = 0; for (int e = 0; e < NE; ++e) { off[e] = s; s += cnt[e]; } }
};
struct FList {
    const int *tope, *off; int *pos, *atok;
    HD void operator()(long e) const { int p = off[e]; for (int a = 0; a < NASG; ++a) if (tope[a] == e) { pos[a] = p; atok[p] = a / TOPK; ++p; } }
};
struct FAct {
    const float* hid; float* act; long F;
    HD void operator()(long i) const { long r = i / F; int j = (int)(i % F); act[i] = siluf_(hid[r * 2 * F + j]) * hid[r * 2 * F + F + j]; }
};
struct FFinal {
    In in; const float *mod, *h1, *rowsb, *shared, *gatev; const int* pos; float* out; long b;
    HD void operator()(long t) const {
        const float* m = mod + (long)b * 6 * D; float* o = out + ((long)b * SEQ + t) * D;
        float ss = 0.f;
        for (int k = 0; k < D; ++k) { float v = shared[t * D + k]; for (int j = 0; j < TOPK; ++j) v += gatev[t * TOPK + j] * rowsb[(long)pos[t * TOPK + j] * D + k]; o[k] = v; ss += v * v; }
        float rinv = 1.f / sqrtf(ss / D + NORM_EPS);
        for (int k = 0; k < D; ++k) o[k] = h1[t * D + k] + m[5 * D + k] * (o[k] * rinv * in.norm_g[3 * D + k]);
    }
};

#ifndef HOST_EMU
template <class F> __global__ void __launch_bounds__(256) k_for(long n, F f) { long i = (long)blockIdx.x * blockDim.x + threadIdx.x; if (i < n) f(i); }
static hipStream_t g_stream;
template <class F> static void run_for(long n, const F& f, int bs = 256) { k_for<F><<<(unsigned)((n + bs - 1) / bs), bs, 0, g_stream>>>(n, f); }
__global__ void __launch_bounds__(256) k_gemm(const float* A, int lda, const int* gather, const float* B, int ldb, float* C, int ldc, int M, int N, int K, const int* goff, const int* gcnt, long strideB) {
    __shared__ float As[16][65], Bs[16][65];
    int row0 = blockIdx.y * 64, col0 = blockIdx.x * 64, rbase = 0, Mg = M;
    if (goff) { rbase = goff[blockIdx.z]; Mg = gcnt[blockIdx.z]; B += (long)blockIdx.z * strideB; }
    if (row0 >= Mg) return;
    int tx = threadIdx.x % 16, ty = threadIdx.x / 16;
    float acc[4][4] = {};
    for (int k0 = 0; k0 < K; k0 += 16) {
        for (int i = threadIdx.x; i < 64 * 16; i += 256) { int r = i / 16, kk = i % 16; int gr = row0 + r; float v = 0.f;
            if (gr < Mg) { long ar = gather ? gather[rbase + gr] : (long)(rbase + gr); v = A[ar * lda + k0 + kk]; } As[kk][r] = v; }
        for (int i = threadIdx.x; i < 64 * 16; i += 256) { int kk = i / 64, cc = i % 64; Bs[kk][cc] = (col0 + cc < N) ? B[(long)(k0 + kk) * ldb + col0 + cc] : 0.f; }
        __syncthreads();
#pragma unroll
        for (int kk = 0; kk < 16; ++kk) { float a[4], b[4];
#pragma unroll
            for (int i = 0; i < 4; ++i) { a[i] = As[kk][ty * 4 + i]; b[i] = Bs[kk][tx * 4 + i]; }
#pragma unroll
            for (int i = 0; i < 4; ++i)
#pragma unroll
                for (int j = 0; j < 4; ++j) acc[i][j] += a[i] * b[j]; }
        __syncthreads();
    }
    for (int i = 0; i < 4; ++i) for (int j = 0; j < 4; ++j) { int r = row0 + ty * 4 + i, c = col0 + tx * 4 + j; if (r < Mg && c < N) C[(long)(rbase + r) * ldc + c] = acc[i][j]; }
}
static void gemm(const float* A, int lda, const int* gather, const float* B, int ldb, float* C, int ldc, int M, int N, int K, const int* goff = nullptr, const int* gcnt = nullptr, long strideB = 0, int ngroups = 1) {
    dim3 g((N + 63) / 64, (M + 63) / 64, ngroups); k_gemm<<<g, 256, 0, g_stream>>>(A, lda, gather, B, ldb, C, ldc, M, N, K, goff, gcnt, strideB);
}
#else
template <class F> static void run_for(long n, const F& f, int = 0) { for (long i = 0; i < n; ++i) f(i); }
static void gemm(const float* A, int lda, const int* gather, const float* B, int ldb, float* C, int ldc, int M, int N, int K, const int* goff = nullptr, const int* gcnt = nullptr, long strideB = 0, int ngroups = 1) {
    for (int g = 0; g < ngroups; ++g) { int rbase = goff ? goff[g] : 0, Mg = goff ? gcnt[g] : M; const float* Bg = B + (long)g * strideB;
        for (int r = 0; r < Mg; ++r) { long ar = gather ? gather[rbase + r] : (long)(rbase + r);
            for (int c = 0; c < N; ++c) { float s = 0.f; for (int k = 0; k < K; ++k) s += A[ar * lda + k] * Bg[(long)k * ldb + c]; C[(long)(rbase + r) * ldc + c] = s; } } }
}
#endif

static void forward(const In& in, float* out, char* ws) {
    size_t off = 0;
    auto alloc = [&](size_t nfloats) { float* p = (float*)(ws + off); off += ((nfloats * 4 + 255) / 256) * 256; return p; };
    float* mod = alloc((size_t)(NB + 1) * 6 * D);
    run_for((long)(NB + 1) * 6 * D, FMod{in, mod});
    size_t base = off;
    for (int b = 0; b < NB; ++b) {
        off = base;
        float* z = alloc((size_t)TA * INC);
        float* h1 = alloc((size_t)SEQ * D);
        float* YA = alloc((size_t)SEQ * RW);
        float* YB = alloc((size_t)SEQ * LW);
        size_t mark = off;
        float* xn = alloc((size_t)TA * D);
        run_for(TA, FXn{in, mod, xn, b}, 64);
        gemm(xn, D, nullptr, in.w_in, INC, z, INC, TA, INC, D);
        off = mark;
        {
            float *R = alloc((size_t)TA * RW), *V = alloc((size_t)TA * RW), *KKr = alloc((size_t)TA * RW), *KK = alloc((size_t)TA * RW);
            float *Wd = alloc((size_t)2 * TA * RW), *KD = alloc((size_t)2 * TA * RW), *Aa = alloc((size_t)2 * TA * RW), *Bv = alloc((size_t)2 * TA * RW);
            float* bonus = alloc((size_t)TA * NH); float* Y = alloc((size_t)2 * SEQ * RW);
            run_for((long)TA * RW, FRwPrepA{in, z, R, V, KKr, Wd, KD, Aa});
            run_for((long)TA * NH, FRwPrepB{in, R, KKr, KD, Aa, KK, Bv, bonus}, 64);
            run_for((long)2 * NH * RH, FRwScan{R, V, KK, Wd, KD, Bv, Y}, 64);
            run_for((long)SEQ * NH, FRwPostA{in, Y, V, bonus, YA}, 64);
            run_for((long)SEQ * RW, FRwPostB{in, z, YA});
        }
        off = mark;
        {
            float *xc = alloc((size_t)TA * LW), *LA = alloc((size_t)2 * TA * LW), *LBX = alloc((size_t)2 * TA * LW), *Hs = alloc((size_t)2 * SEQ * LW);
            run_for((long)TA * LW, FConv{in, z, xc});
            run_for((long)2 * TA * LW, FLruGates{in, xc, LA, LBX});
            run_for((long)2 * LW, FLruScan{LA, LBX, Hs}, 64);
            run_for((long)SEQ * LW, FYb{z, Hs, YB});
        }
        off = mark;
        float *m1 = alloc((size_t)SEQ * D), *m2 = alloc((size_t)SEQ * D), *mixed = alloc((size_t)SEQ * D), *y2 = alloc((size_t)SEQ * D), *u = alloc((size_t)SEQ * D);
        gemm(YA, RW, nullptr, in.w_branch_a, D, m1, D, SEQ, D, RW);
        gemm(YB, LW, nullptr, in.w_branch_b, D, m2, D, SEQ, D, LW);
        run_for((long)SEQ * D, FMix{z, m1, m2, mixed});
        gemm(mixed, D, nullptr, in.w_out, D, y2, D, SEQ, D, D);
        run_for(SEQ, FH1U{in, mod, y2, h1, u, b}, 64);
        float* logits = alloc((size_t)SEQ * NE); int* tope = (int*)alloc(NASG); float* gatev = alloc(NASG);
        int *cnt = (int*)alloc(NE), *offs = (int*)alloc(NE), *pos = (int*)alloc(NASG), *atok = (int*)alloc(NASG);
        float *hid = alloc((size_t)NASG * 2 * EF), *act = alloc((size_t)NASG * EF), *rowsb = alloc((size_t)NASG * D);
        float *shh = alloc((size_t)SEQ * 2 * SF), *sha = alloc((size_t)SEQ * SF), *shared = alloc((size_t)SEQ * D);
        gemm(u, D, nullptr, in.router_w, NE, logits, NE, SEQ, NE, D);
        run_for(SEQ, FTopk{in, logits, tope, gatev}, 64);
        run_for(NE, FCount{tope, cnt}, 64);
        run_for(1, FOffsets{cnt, offs}, 64);
        run_for(NE, FList{tope, offs, pos, atok}, 64);
        gemm(u, D, atok, in.ex_w_gu, 2 * EF, hid, 2 * EF, NASG, 2 * EF, D, offs, cnt, (long)D * 2 * EF, NE);
        run_for((long)NASG * EF, FAct{hid, act, EF});
        gemm(act, EF, nullptr, in.ex_w_down, D, rowsb, D, NASG, D, EF, offs, cnt, (long)EF * D, NE);
        gemm(u, D, nullptr, in.sh_w_gu, 2 * SF, shh, 2 * SF, SEQ, 2 * SF, D);
        run_for((long)SEQ * SF, FAct{shh, sha, SF});
        gemm(sha, SF, nullptr, in.sh_w_down, D, shared, D, SEQ, D, SF);
        run_for(SEQ, FFinal{in, mod, h1, rowsb, shared, gatev, pos, out, b}, 64);
    }
}

static In make_in(void* const* p) {
    In in; const float** f = (const float**)&in; for (int i = 0; i < 32; ++i) f[i] = (const float*)p[i]; return in;
}
#ifndef HOST_EMU
extern "C" void kernel_launch(void* const* d_in, const int* in_sizes, int n_in, void* d_out, int out_size, void* d_ws, size_t ws_size, hipStream_t stream) {
    g_stream = stream;
    forward(make_in(d_in), (float*)d_out, (char*)d_ws);
}
#else
int main() {
    const long sizes[32] = {(long)NB * SEQ * D, (long)NB * D, (long)NB * CTX * D, D, (long)D * 6 * D, 6 * D, 4 * D, (long)D * INC, 2 * RC, 2 * RW, 2L * DL * RW, 2 * RW, 2L * AL * RW, (long)GL * RW, RW, RW, RW, 2 * RW,
        4 * LW, LW, 4L * LB * LBS * LBS, 4L * LB * LBS, 2 * LW, (long)RW * D, (long)LW * D, (long)D * D, (long)D * NE, NE, (long)NE * D * 2 * EF, (long)NE * EF * D, (long)D * 2 * SF, (long)SF * D};
    FILE* f = fopen("small_in.bin", "rb"); if (!f) { printf("no input\n"); return 1; }
    std::vector<std::vector<float>> bufs(32); void* ptrs[32];
    for (int i = 0; i < 32; ++i) { bufs[i].resize(sizes[i]); if (fread(bufs[i].data(), 4, sizes[i], f) != (size_t)sizes[i]) { printf("short read %d\n", i); return 1; } ptrs[i] = bufs[i].data(); }
    fclose(f);
    long nout = (long)NB * SEQ * D; std::vector<float> out(nout); std::vector<char> ws((size_t)256 << 20);
    forward(make_in(ptrs), out.data(), ws.data());
    std::vector<double> ref(nout); f = fopen("small_out.bin", "rb"); if (fread(ref.data(), 8, nout, f) != (size_t)nout) { printf("short ref\n"); return 1; } fclose(f);
    double num = 0, den = 0, mx = 0; for (long i = 0; i < nout; ++i) { double d = out[i] - ref[i]; num += d * d; den += ref[i] * ref[i]; if (fabs(d) > mx) mx = fabs(d); }
    printf("rvr = %.3e  maxabs = %.3e\n", num / den, mx);
    return 0;
}
#endif
```

```cpp
#ifndef HOST_EMU
#include <hip/hip_runtime.h>
#include <cstdio>
#include <cstring>
#define HD __host__ __device__ __forceinline__
#else
#include <cmath>
#include <cstdio>
#include <cstdlib>
#include <cstring>
#include <vector>
#define HD inline
#endif

#ifdef SMALL
constexpr int D = 128, NB = 2, SEQ = 64, GW = 8, CTX = 16, RW = 128, RH = 64, DL = 16, AL = 16, GL = 24, LW = 128, LB = 2, NE = 8, TOPK = 3, NG = 4, TG = 2, EF = 32, SF = 32;
#else
constexpr int D = 1024, NB = 8, SEQ = 4096, GW = 64, CTX = 256, RW = 1024, RH = 64, DL = 64, AL = 64, GL = 160, LW = 1024, LB = 16, NE = 64, TOPK = 6, NG = 8, TG = 4, EF = 256, SF = 256;
#endif
constexpr int NH = RW / RH, LBS = LW / LB, ROWS = SEQ / GW, TA = CTX + SEQ;
constexpr int OFF_R = 0, OFF_K = RW, OFF_V = 2 * RW, OFF_WD = 3 * RW, OFF_AD = OFF_WD + 2 * DL, OFF_GD = OFF_AD + 2 * AL, RC = OFF_GD + GL;
constexpr int OFF_LX = RC, OFF_LG = OFF_LX + LW, OFF_GATE = OFF_LG + LW, INC = OFF_GATE + 2 * D;
constexpr int EPG = NE / NG, NASG = SEQ * TOPK;
#define NORM_EPS 1e-6f
#define LNX_EPS 64e-5f

HD float sigmoidf_(float x) { return 1.f / (1.f + expf(-x)); }
HD float softplusf_(float x) { return x > 20.f ? x : log1pf(expf(x)); }
HD float siluf_(float x) { return x * sigmoidf_(x); }
HD float gelu_tanhf_(float x) { return 0.5f * x * (1.f + tanhf(0.7978845608028654f * (x + 0.044715f * x * x * x))); }

struct In {
    const float *x, *c, *ctx, *c_ctx, *w_mod, *b_mod, *norm_g, *w_in, *shift_mu, *rw_w0, *rw_w_up, *rw_a0, *rw_a_up, *rw_g_up, *rw_k_k, *rw_k_a, *rw_r_k, *rw_lnx,
        *lru_conv_w, *lru_conv_b, *lru_gate_w, *lru_gate_b, *lru_l, *w_branch_a, *w_branch_b, *w_out, *router_w, *router_b, *ex_w_gu, *ex_w_down, *sh_w_gu, *sh_w_down;
};

struct FMod {
    In in; float* mod;
    HD void operator()(long i) const {
        int r = (int)(i / (6 * D)), j = (int)(i % (6 * D));
        const float* cv = r < NB ? in.c + (long)r * D : in.c_ctx;
        float s = 0.f;
        for (int k = 0; k < D; ++k) s += siluf_(cv[k]) * in.w_mod[(long)k * 6 * D + j];
        mod[i] = s + in.b_mod[j];
    }
};
struct FXn {
    In in; const float* mod; float* xn; long b;
    HD void operator()(long tt) const {
        const float* src = tt < CTX ? in.ctx + ((long)b * CTX + tt) * D : in.x + ((long)b * SEQ + (tt - CTX)) * D;
        const float* m = mod + (long)(tt < CTX ? NB : b) * 6 * D;
        float ss = 0.f; for (int k = 0; k < D; ++k) ss += src[k] * src[k];
        float rinv = 1.f / sqrtf(ss / D + NORM_EPS);
        for (int k = 0; k < D; ++k) xn[tt * D + k] = (src[k] * rinv * in.norm_g[k]) * (1.f + m[D + k]) + m[k];
    }
};
HD float zshift(const float* z, const float* mu, long tt, int col) {
    bool hp, hn;
    if (tt < CTX) { hp = tt > 0; hn = tt < CTX - 1; }
    else { int cg = (int)((tt - CTX) % GW); hp = cg > 0; hn = cg < GW - 1; }
    float v = z[tt * INC + col], p = hp ? z[(tt - 1) * INC + col] : 0.f, n = hn ? z[(tt + 1) * INC + col] : 0.f;
    return v + mu[col] * (p - v) + mu[RC + col] * (n - v);
}
struct FRwPrepA {
    In in; const float* z; float *R, *V, *KKr, *Wd, *KD, *Aa;
    HD void operator()(long i) const {
        long tt = i / RW; int c = (int)(i % RW);
        float r = zshift(z, in.shift_mu, tt, OFF_R + c), k = zshift(z, in.shift_mu, tt, OFF_K + c), v = zshift(z, in.shift_mu, tt, OFF_V + c);
        R[i] = r; V[i] = v; KKr[i] = k * in.rw_k_k[c];
        for (int d = 0; d < 2; ++d) {
            float lw = in.rw_w0[d * RW + c], la = in.rw_a0[d * RW + c];
            for (int j = 0; j < DL; ++j) lw += tanhf(zshift(z, in.shift_mu, tt, OFF_WD + d * DL + j)) * in.rw_w_up[((long)d * DL + j) * RW + c];
            for (int j = 0; j < AL; ++j) la += zshift(z, in.shift_mu, tt, OFF_AD + d * AL + j) * in.rw_a_up[((long)d * AL + j) * RW + c];
            float wlog = -softplusf_(-lw) - 0.5f, a = sigmoidf_(la);
            long o = ((long)d * TA + tt) * RW + c;
            Wd[o] = expf(-expf(wlog)); Aa[o] = a; KD[o] = k * (1.f + (a - 1.f) * in.rw_k_a[c]);
        }
    }
};
struct FRwPrepB {
    In in; const float *R, *KKr, *KD, *Aa; float *KK, *Bv, *bonus;
    HD void operator()(long i) const {
        long tt = i / NH; int h = (int)(i % NH);
        float ss = 0.f; for (int n = 0; n < RH; ++n) { float q = KKr[tt * RW + h * RH + n]; ss += q * q; }
        float inv = 1.f / fmaxf(sqrtf(ss), 1e-12f);
        float bon = 0.f;
        for (int n = 0; n < RH; ++n) {
            long o = tt * RW + h * RH + n; float kk = KKr[o] * inv; KK[o] = kk;
            for (int d = 0; d < 2; ++d) { long od = ((long)d * TA + tt) * RW + h * RH + n; Bv[od] = kk * Aa[od]; bon += R[o] * KD[od] * in.rw_r_k[h * RH + n]; }
        }
        bonus[i] = bon;
    }
};
HD long rw_step_tt(int d, int step) { return step < CTX ? (d == 0 ? step : CTX - 1 - step) : CTX + (d == 0 ? (step - CTX) : SEQ - 1 - (step - CTX)); }
struct FRwScan {
    const float *R, *V, *KK, *Wd, *KD, *Bv; float* Y;
    HD void operator()(long i) const {
        int d = (int)(i / (NH * RH)), h = (int)((i / RH) % NH), v = (int)(i % RH);
        float S[RH];
#pragma unroll
        for (int k = 0; k < RH; ++k) S[k] = 0.f;
        for (int step = 0; step < TA; ++step) {
            long tt = rw_step_tt(d, step);
            const float* kk = KK + tt * RW + h * RH; const float* r = R + tt * RW + h * RH;
            const float* w = Wd + ((long)d * TA + tt) * RW + h * RH; const float* kd = KD + ((long)d * TA + tt) * RW + h * RH; const float* bv = Bv + ((long)d * TA + tt) * RW + h * RH;
            float vv = V[tt * RW + h * RH + v];
            float sa = 0.f;
#pragma unroll
            for (int k = 0; k < RH; ++k) sa -= S[k] * kk[k];
            float y = 0.f;
#pragma unroll
            for (int k = 0; k < RH; ++k) { S[k] = S[k] * w[k] + sa * bv[k] + vv * kd[k]; y += S[k] * r[k]; }
            if (step >= CTX) Y[((long)d * SEQ + (tt - CTX)) * RW + h * RH + v] = y;
        }
    }
};
struct FRwPostA {
    In in; const float *Y, *V, *bonus; float* YA;
    HD void operator()(long i) const {
        long t = i / NH; int h = (int)(i % NH); long tt = t + CTX;
        float mu = 0.f; for (int n = 0; n < RH; ++n) mu += Y[t * RW + h * RH + n] + Y[((long)SEQ + t) * RW + h * RH + n];
        mu /= RH; float var = 0.f;
        for (int n = 0; n < RH; ++n) { float q = Y[t * RW + h * RH + n] + Y[((long)SEQ + t) * RW + h * RH + n] - mu; var += q * q; }
        var /= RH; float rs = 1.f / sqrtf(var + LNX_EPS);
        for (int n = 0; n < RH; ++n) { int c = h * RH + n; float y = Y[t * RW + c] + Y[((long)SEQ + t) * RW + c];
            YA[t * RW + c] = (y - mu) * rs * in.rw_lnx[c] + in.rw_lnx[RW + c] + bonus[tt * NH + h] * V[tt * RW + c]; }
    }
};
struct FRwPostB {
    In in; const float* z; float* YA;
    HD void operator()(long i) const {
        long t = i / RW; int c = (int)(i % RW); long tt = t + CTX; float g = 0.f;
        for (int j = 0; j < GL; ++j) g += sigmoidf_(zshift(z, in.shift_mu, tt, OFF_GD + j)) * in.rw_g_up[(long)j * RW + c];
        YA[i] *= g;
    }
};
struct FConv {
    In in; const float* z; float* xc;
    HD void operator()(long i) const {
        long tt = i / LW; int c = (int)(i % LW); float s = in.lru_conv_b[c];
        for (int j = 0; j < 4; ++j) {
            long src = -1;
            if (tt < CTX) { long q = tt + j - 2; if (q >= 0 && q < CTX) src = q; }
            else { long t = tt - CTX; int row = (int)(t / GW), col = (int)(t % GW), rr = row + j - 2; if (rr >= 0 && rr < ROWS) src = CTX + (long)rr * GW + col; }
            if (src >= 0) s += in.lru_conv_w[j * LW + c] * z[src * INC + OFF_LX + c];
        }
        xc[i] = s;
    }
};
struct FLruGates {
    In in; const float* xc; float *LA, *LBX;
    HD void operator()(long i) const {
        int d = (int)(i / ((long)TA * LW)); long tt = (i / LW) % TA; int c = (int)(i % LW), n = c / LBS, k = c % LBS;
        float p0 = in.lru_gate_b[((d * 2 + 0) * LB + n) * LBS + k], p1 = in.lru_gate_b[((d * 2 + 1) * LB + n) * LBS + k];
        for (int j = 0; j < LBS; ++j) { float xv = xc[tt * LW + n * LBS + j];
            p0 += xv * in.lru_gate_w[((((long)d * 2 + 0) * LB + n) * LBS + j) * LBS + k]; p1 += xv * in.lru_gate_w[((((long)d * 2 + 1) * LB + n) * LBS + j) * LBS + k]; }
        float la = -8.f * sigmoidf_(p0) * softplusf_(-in.lru_l[d * LW + c]);
        LA[i] = expf(la); LBX[i] = sqrtf(-expm1f(2.f * la)) * sigmoidf_(p1) * xc[tt * LW + c];
    }
};
struct FLruScan {
    const float *LA, *LBX; float* Hs;
    HD void operator()(long i) const {
        int d = (int)(i / LW), c = (int)(i % LW); float h = 0.f;
        for (int step = 0; step < TA; ++step) {
            long tt;
            if (step < CTX) tt = d == 0 ? step : CTX - 1 - step;
            else { int s = step - CTX, si = d == 0 ? s : SEQ - 1 - s, col = si / ROWS, row = si % ROWS; tt = CTX + (long)row * GW + col; }
            long o = ((long)d * TA + tt) * LW + c;
            h = LA[o] * h + LBX[o];
            if (step >= CTX) Hs[((long)d * SEQ + (tt - CTX)) * LW + c] = h;
        }
    }
};
struct FYb {
    const float *z, *Hs; float* YB;
    HD void operator()(long i) const { long t = i / LW; int c = (int)(i % LW); YB[i] = gelu_tanhf_(z[(t + CTX) * INC + OFF_LG + c]) * (Hs[i] + Hs[(long)SEQ * LW + i]); }
};
struct FMix {
    const float *z, *m1, *m2; float* mixed;
    HD void operator()(long i) const { long t = i / D; int c = (int)(i % D);
        mixed[i] = sigmoidf_(z[(t + CTX) * INC + OFF_GATE + c]) * m1[i] + sigmoidf_(z[(t + CTX) * INC + OFF_GATE + D + c]) * m2[i]; }
};
struct FH1U {
    In in; const float *mod, *y2; float *h1, *u; long b;
    HD void operator()(long t) const {
        const float* m = mod + (long)b * 6 * D; const float* xr = in.x + ((long)b * SEQ + t) * D;
        float ss = 0.f; for (int k = 0; k < D; ++k) ss += y2[t * D + k] * y2[t * D + k];
        float rinv = 1.f / sqrtf(ss / D + NORM_EPS); float s2 = 0.f;
        for (int k = 0; k < D; ++k) { float hv = xr[k] + m[2 * D + k] * (y2[t * D + k] * rinv * in.norm_g[D + k]); h1[t * D + k] = hv; s2 += hv * hv; }
        float r2 = 1.f / sqrtf(s2 / D + NORM_EPS);
        for (int k = 0; k < D; ++k) u[t * D + k] = (h1[t * D + k] * r2 * in.norm_g[2 * D + k]) * (1.f + m[4 * D + k]) + m[3 * D + k];
    }
};
struct FTopk {
    In in; const float* logits; int* tope; float* gatev;
    HD float sc(long t, int e) const { return sigmoidf_(logits[t * NE + e]); }
    HD float bi(long t, int e) const { return sc(t, e) + in.router_b[e]; }
    HD void operator()(long t) const {
        float gs[NG];
#pragma unroll
        for (int g = 0; g < NG; ++g) { float a = -1e30f, b2 = -1e30f; for (int j = 0; j < EPG; ++j) { float v = bi(t, g * EPG + j); if (v > a) { b2 = a; a = v; } else if (v > b2) b2 = v; } gs[g] = a + b2; }
        unsigned gmask = 0;
        for (int it = 0; it < TG; ++it) { float bv = -1e30f; int best = 0;
#pragma unroll
            for (int g = 0; g < NG; ++g) if (!((gmask >> g) & 1u) && gs[g] > bv) { bv = gs[g]; best = g; }
            gmask |= 1u << best; }
        unsigned long long used = 0ull; float tsum = 0.f;
        for (int it = 0; it < TOPK; ++it) { float bv = -1e30f; int best = 0;
            for (int e = 0; e < NE; ++e) if (((gmask >> (e / EPG)) & 1u) && !((used >> e) & 1ull)) { float v = bi(t, e); if (v > bv) { bv = v; best = e; } }
            used |= 1ull << best; tope[t * TOPK + it] = best; tsum += sc(t, best); }
        for (int it = 0; it < TOPK; ++it) gatev[t * TOPK + it] = sc(t, tope[t * TOPK + it]) / tsum * 2.5f;
    }
};
struct FCount {
    const int* tope; int* cnt;
    HD void operator()(long e) const { int n = 0; for (int a = 0; a < NASG; ++a) n += tope[a] == e; cnt[e] = n; }
};
struct FOffsets {
    const int* cnt; int* off;
    HD void operator()(long) const { int s = 0; for (int e = 0; e < NE; ++e) { off[e] = s; s += cnt[e]; } }
};
struct FList {
    const int *tope, *off; int *pos, *atok;
    HD void operator()(long e) const { int p = off[e]; for (int a = 0; a < NASG; ++a) if (tope[a] == e) { pos[a] = p; atok[p] = a / TOPK; ++p; } }
};
struct FAct {
    const float* hid; float* act; long F;
    HD void operator()(long i) const { long r = i / F; int j = (int)(i % F); act[i] = siluf_(hid[r * 2 * F + j]) * hid[r * 2 * F + F + j]; }
};
struct FFinal {
    In in; const float *mod, *h1, *rowsb, *shared, *gatev; const int* pos; float* out; long b;
    HD void operator()(long t) const {
        const float* m = mod + (long)b * 6 * D; float* o = out + ((long)b * SEQ + t) * D;
        float ss = 0.f;
        for (int k = 0; k < D; ++k) { float v = shared[t * D + k]; for (int j = 0; j < TOPK; ++j) v += gatev[t * TOPK + j] * rowsb[(long)pos[t * TOPK + j] * D + k]; o[k] = v; ss += v * v; }
        float rinv = 1.f / sqrtf(ss / D + NORM_EPS);
        for (int k = 0; k < D; ++k) o[k] = h1[t * D + k] + m[5 * D + k] * (o[k] * rinv * in.norm_g[3 * D + k]);
    }
};

#ifndef HOST_EMU
#include <hip/hip_cooperative_groups.h>
namespace cg = cooperative_groups;
__device__ __forceinline__ void gemm_tile(float (*As)[65], float (*Bs)[65], const float* A, int lda, const int* gather, const float* B, int ldb, float* C, int ldc, int Mg, int rbase, int N, int K, int row0, int col0) {
    int tx = threadIdx.x % 16, ty = threadIdx.x / 16;
    float acc[4][4] = {};
    for (int k0 = 0; k0 < K; k0 += 16) {
        for (int i = threadIdx.x; i < 64 * 16; i += 256) { int r = i / 16, kk = i % 16; int gr = row0 + r; float v = 0.f;
            if (gr < Mg) { long ar = gather ? gather[rbase + gr] : (long)(rbase + gr); v = A[ar * lda + k0 + kk]; } As[kk][r] = v; }
        for (int i = threadIdx.x; i < 64 * 16; i += 256) { int kk = i / 64, cc = i % 64; Bs[kk][cc] = (col0 + cc < N) ? B[(long)(k0 + kk) * ldb + col0 + cc] : 0.f; }
        __syncthreads();
#pragma unroll
        for (int kk = 0; kk < 16; ++kk) { float a[4], b[4];
#pragma unroll
            for (int i = 0; i < 4; ++i) { a[i] = As[kk][ty * 4 + i]; b[i] = Bs[kk][tx * 4 + i]; }
#pragma unroll
            for (int i = 0; i < 4; ++i)
#pragma unroll
                for (int j = 0; j < 4; ++j) acc[i][j] += a[i] * b[j]; }
        __syncthreads();
    }
    for (int i = 0; i < 4; ++i) for (int j = 0; j < 4; ++j) { int r = row0 + ty * 4 + i, c = col0 + tx * 4 + j; if (r < Mg && c < N) C[(long)(rbase + r) * ldc + c] = acc[i][j]; }
}
struct DevExec {
    float (*As)[65]; float (*Bs)[65];
    template <class F> __device__ void run_for(long n, const F& f, int = 0) const {
        for (long i = (long)blockIdx.x * blockDim.x + threadIdx.x; i < n; i += (long)gridDim.x * blockDim.x) f(i);
        cg::this_grid().sync();
    }
    __device__ void gemm(const float* A, int lda, const int* gather, const float* B, int ldb, float* C, int ldc, int M, int N, int K, const int* goff = nullptr, const int* gcnt = nullptr, long strideB = 0, int ngroups = 1) const {
        int tn = (N + 63) / 64, tm = (M + 63) / 64; long ntile = (long)tn * tm * ngroups;
        for (long t = blockIdx.x; t < ntile; t += gridDim.x) {
            int g = (int)(t / ((long)tn * tm)), rem = (int)(t % ((long)tn * tm)), row0 = (rem / tn) * 64, col0 = (rem % tn) * 64;
            int rbase = 0, Mg = M; const float* Bg = B;
            if (goff) { rbase = goff[g]; Mg = gcnt[g]; Bg = B + (long)g * strideB; }
            if (row0 >= Mg) continue;
            gemm_tile(As, Bs, A, lda, gather, Bg, ldb, C, ldc, Mg, rbase, N, K, row0, col0);
        }
        cg::this_grid().sync();
    }
};
#define FWD_HD __device__
#else
struct DevExec {
    template <class F> void run_for(long n, const F& f, int = 0) const { for (long i = 0; i < n; ++i) f(i); }
    void gemm(const float* A, int lda, const int* gather, const float* B, int ldb, float* C, int ldc, int M, int N, int K, const int* goff = nullptr, const int* gcnt = nullptr, long strideB = 0, int ngroups = 1) const {
        for (int g = 0; g < ngroups; ++g) { int rbase = goff ? goff[g] : 0, Mg = goff ? gcnt[g] : M; const float* Bg = B + (long)g * strideB;
            for (int r = 0; r < Mg; ++r) { long ar = gather ? gather[rbase + r] : (long)(rbase + r);
                for (int c = 0; c < N; ++c) { float s = 0.f; for (int k = 0; k < K; ++k) s += A[ar * lda + k] * Bg[(long)k * ldb + c]; C[(long)(rbase + r) * ldc + c] = s; } } }
    }
};
#define FWD_HD
#endif

struct Bump { char* ws; size_t off; FWD_HD float* alloc(size_t nfloats) { float* p = (float*)(ws + off); off += ((nfloats * 4 + 255) / 256) * 256; return p; } };

template <class X> FWD_HD void forward(const X& ex, const In& in, float* out, char* ws) {
    Bump bp{ws, 0};
    float* mod = bp.alloc((size_t)(NB + 1) * 6 * D);
    ex.run_for((long)(NB + 1) * 6 * D, FMod{in, mod});
    size_t base = bp.off;
    for (int b = 0; b < NB; ++b) {
        bp.off = base;
        float* z = bp.alloc((size_t)TA * INC);
        float* h1 = bp.alloc((size_t)SEQ * D);
        float* YA = bp.alloc((size_t)SEQ * RW);
        float* YB = bp.alloc((size_t)SEQ * LW);
        size_t mark = bp.off;
        float* xn = bp.alloc((size_t)TA * D);
        ex.run_for(TA, FXn{in, mod, xn, b}, 64);
        ex.gemm(xn, D, nullptr, in.w_in, INC, z, INC, TA, INC, D);
        bp.off = mark;
        {
            float *R = bp.alloc((size_t)TA * RW), *V = bp.alloc((size_t)TA * RW), *KKr = bp.alloc((size_t)TA * RW), *KK = bp.alloc((size_t)TA * RW);
            float *Wd = bp.alloc((size_t)2 * TA * RW), *KD = bp.alloc((size_t)2 * TA * RW), *Aa = bp.alloc((size_t)2 * TA * RW), *Bv = bp.alloc((size_t)2 * TA * RW);
            float* bonus = bp.alloc((size_t)TA * NH); float* Y = bp.alloc((size_t)2 * SEQ * RW);
            ex.run_for((long)TA * RW, FRwPrepA{in, z, R, V, KKr, Wd, KD, Aa});
            ex.run_for((long)TA * NH, FRwPrepB{in, R, KKr, KD, Aa, KK, Bv, bonus}, 64);
            ex.run_for((long)2 * NH * RH, FRwScan{R, V, KK, Wd, KD, Bv, Y}, 64);
            ex.run_for((long)SEQ * NH, FRwPostA{in, Y, V, bonus, YA}, 64);
            ex.run_for((long)SEQ * RW, FRwPostB{in, z, YA});
        }
        bp.off = mark;
        {
            float *xc = bp.alloc((size_t)TA * LW), *LA = bp.alloc((size_t)2 * TA * LW), *LBX = bp.alloc((size_t)2 * TA * LW), *Hs = bp.alloc((size_t)2 * SEQ * LW);
            ex.run_for((long)TA * LW, FConv{in, z, xc});
            ex.run_for((long)2 * TA * LW, FLruGates{in, xc, LA, LBX});
            ex.run_for((long)2 * LW, FLruScan{LA, LBX, Hs}, 64);
            ex.run_for((long)SEQ * LW, FYb{z, Hs, YB});
        }
        bp.off = mark;
        float *m1 = bp.alloc((size_t)SEQ * D), *m2 = bp.alloc((size_t)SEQ * D), *mixed = bp.alloc((size_t)SEQ * D), *y2 = bp.alloc((size_t)SEQ * D), *u = bp.alloc((size_t)SEQ * D);
        ex.gemm(YA, RW, nullptr, in.w_branch_a, D, m1, D, SEQ, D, RW);
        ex.gemm(YB, LW, nullptr, in.w_branch_b, D, m2, D, SEQ, D, LW);
        ex.run_for((long)SEQ * D, FMix{z, m1, m2, mixed});
        ex.gemm(mixed, D, nullptr, in.w_out, D, y2, D, SEQ, D, D);
        ex.run_for(SEQ, FH1U{in, mod, y2, h1, u, b}, 64);
        float* logits = bp.alloc((size_t)SEQ * NE); int* tope = (int*)bp.alloc(NASG); float* gatev = bp.alloc(NASG);
        int *cnt = (int*)bp.alloc(NE), *offs = (int*)bp.alloc(NE), *pos = (int*)bp.alloc(NASG), *atok = (int*)bp.alloc(NASG);
        float *hid = bp.alloc((size_t)NASG * 2 * EF), *act = bp.alloc((size_t)NASG * EF), *rowsb = bp.alloc((size_t)NASG * D);
        float *shh = bp.alloc((size_t)SEQ * 2 * SF), *sha = bp.alloc((size_t)SEQ * SF), *shared = bp.alloc((size_t)SEQ * D);
        ex.gemm(u, D, nullptr, in.router_w, NE, logits, NE, SEQ, NE, D);
        ex.run_for(SEQ, FTopk{in, logits, tope, gatev}, 64);
        ex.run_for(NE, FCount{tope, cnt}, 64);
        ex.run_for(1, FOffsets{cnt, offs}, 64);
        ex.run_for(NE, FList{tope, offs, pos, atok}, 64);
        ex.gemm(u, D, atok, in.ex_w_gu, 2 * EF, hid, 2 * EF, NASG, 2 * EF, D, offs, cnt, (long)D * 2 * EF, NE);
        ex.run_for((long)NASG * EF, FAct{hid, act, EF});
        ex.gemm(act, EF, nullptr, in.ex_w_down, D, rowsb, D, NASG, D, EF, offs, cnt, (long)EF * D, NE);
        ex.gemm(u, D, nullptr, in.sh_w_gu, 2 * SF, shh, 2 * SF, SEQ, 2 * SF, D);
        ex.run_for((long)SEQ * SF, FAct{shh, sha, SF});
        ex.gemm(sha, SF, nullptr, in.sh_w_down, D, shared, D, SEQ, D, SF);
        ex.run_for(SEQ, FFinal{in, mod, h1, rowsb, shared, gatev, pos, out, b}, 64);
    }
}

static In make_in(void* const* p) {
    In in; const float** f = (const float**)&in; for (int i = 0; i < 32; ++i) f[i] = (const float*)p[i]; return in;
}
#ifndef HOST_EMU
struct MegaArgs { In in; float* out; char* ws; };
__global__ void __launch_bounds__(256) mega_naive(MegaArgs a) {
    __shared__ float As[16][65], Bs[16][65];
    DevExec ex{As, Bs};
    forward(ex, a.in, a.out, a.ws);
}
extern "C" void kernel_launch(void* const* d_in, const int* in_sizes, int n_in, void* d_out, int out_size, void* d_ws, size_t ws_size, hipStream_t stream) {
    static int grid_blocks = 0;
    if (!grid_blocks) { int dev = 0, cus = 0, per_cu = 0; hipGetDevice(&dev); hipDeviceGetAttribute(&cus, hipDeviceAttributeMultiprocessorCount, dev);
        hipOccupancyMaxActiveBlocksPerMultiprocessor(&per_cu, mega_naive, 256, 0); if (per_cu > 1) per_cu = 1; grid_blocks = cus * per_cu; }
    MegaArgs a; memset(&a, 0, sizeof(a)); a.in = make_in(d_in); a.out = (float*)d_out; a.ws = (char*)d_ws;
    void* args[] = {&a};
    hipError_t e = hipLaunchCooperativeKernel((void*)mega_naive, dim3(grid_blocks), dim3(256), args, 0, stream);
    if (e != hipSuccess) fprintf(stderr, "cooperative launch failed: %s (grid %d)\n", hipGetErrorString(e), grid_blocks);
}
#else
int main() {
    const long sizes[32] = {(long)NB * SEQ * D, (long)NB * D, (long)NB * CTX * D, D, (long)D * 6 * D, 6 * D, 4 * D, (long)D * INC, 2 * RC, 2 * RW, 2L * DL * RW, 2 * RW, 2L * AL * RW, (long)GL * RW, RW, RW, RW, 2 * RW,
        4 * LW, LW, 4L * LB * LBS * LBS, 4L * LB * LBS, 2 * LW, (long)RW * D, (long)LW * D, (long)D * D, (long)D * NE, NE, (long)NE * D * 2 * EF, (long)NE * EF * D, (long)D * 2 * SF, (long)SF * D};
    FILE* f = fopen("small_in.bin", "rb"); if (!f) { printf("no input\n"); return 1; }
    std::vector<std::vector<float>> bufs(32); void* ptrs[32];
    for (int i = 0; i < 32; ++i) { bufs[i].resize(sizes[i]); if (fread(bufs[i].data(), 4, sizes[i], f) != (size_t)sizes[i]) { printf("short read %d\n", i); return 1; } ptrs[i] = bufs[i].data(); }
    fclose(f);
    long nout = (long)NB * SEQ * D; std::vector<float> out(nout); std::vector<char> ws((size_t)256 << 20);
    forward(DevExec{}, make_in(ptrs), out.data(), ws.data());
    std::vector<double> ref(nout); f = fopen("small_out.bin", "rb"); if (fread(ref.data(), 8, nout, f) != (size_t)nout) { printf("short ref\n"); return 1; } fclose(f);
    double num = 0, den = 0, mx = 0; for (long i = 0; i < nout; ++i) { double d = out[i] - ref[i]; num += d * d; den += ref[i] * ref[i]; if (fabs(d) > mx) mx = fabs(d); }
    printf("rvr = %.3e  maxabs = %.3e\n", num / den, mx);
    return 0;
}
#endif
```

```cpp
#include <hip/hip_runtime.h>
#include <cstdio>
#include <cstring>
#define HD __host__ __device__ __forceinline__
static hipStream_t g_stream;

#ifdef SMALL
constexpr int D = 128, NB = 2, SEQ = 64, GW = 8, CTX = 16, RW = 128, RH = 64, DL = 16, AL = 16, GL = 24, LW = 128, LB = 2, NE = 8, TOPK = 3, NG = 4, TG = 2, EF = 32, SF = 32;
#else
constexpr int D = 1024, NB = 8, SEQ = 4096, GW = 64, CTX = 256, RW = 1024, RH = 64, DL = 64, AL = 64, GL = 160, LW = 1024, LB = 16, NE = 64, TOPK = 6, NG = 8, TG = 4, EF = 256, SF = 256;
#endif
constexpr int NH = RW / RH, LBS = LW / LB, ROWS = SEQ / GW, TA = CTX + SEQ;
constexpr int OFF_R = 0, OFF_K = RW, OFF_V = 2 * RW, OFF_WD = 3 * RW, OFF_AD = OFF_WD + 2 * DL, OFF_GD = OFF_AD + 2 * AL, RC = OFF_GD + GL;
constexpr int OFF_LX = RC, OFF_LG = OFF_LX + LW, OFF_GATE = OFF_LG + LW, INC = OFF_GATE + 2 * D;
constexpr int EPG = NE / NG, NASG = SEQ * TOPK;
#define NORM_EPS 1e-6f
#define LNX_EPS 64e-5f

HD float sigmoidf_(float x) { return 1.f / (1.f + expf(-x)); }
HD float softplusf_(float x) { return x > 20.f ? x : log1pf(expf(x)); }
HD float siluf_(float x) { return x * sigmoidf_(x); }
HD float gelu_tanhf_(float x) { return 0.5f * x * (1.f + tanhf(0.7978845608028654f * (x + 0.044715f * x * x * x))); }

struct In {
    const float *x, *c, *ctx, *c_ctx, *w_mod, *b_mod, *norm_g, *w_in, *shift_mu, *rw_w0, *rw_w_up, *rw_a0, *rw_a_up, *rw_g_up, *rw_k_k, *rw_k_a, *rw_r_k, *rw_lnx,
        *lru_conv_w, *lru_conv_b, *lru_gate_w, *lru_gate_b, *lru_l, *w_branch_a, *w_branch_b, *w_out, *router_w, *router_b, *ex_w_gu, *ex_w_down, *sh_w_gu, *sh_w_down;
};


namespace mk {
#define LAS __attribute__((address_space(3)))
typedef unsigned short bf16_t;
typedef short bf16x8 __attribute__((ext_vector_type(8)));
typedef float f32x4 __attribute__((ext_vector_type(4)));
typedef float f32x2 __attribute__((ext_vector_type(2)));
typedef unsigned u32x4 __attribute__((ext_vector_type(4)));
typedef unsigned u32x2 __attribute__((ext_vector_type(2)));
constexpr int NT = 512;
constexpr int BM = 256, BK = 64, HALF = 128, HTB = HALF * BK * 2, STAGE_BYTES = 8 * HTB;
constexpr int LDS_BYTES = 160 * 1024 - 1024;

constexpr int Z1_LX = 3584, Z1_N = 4608;
constexpr int ZC_N = 3072;

__device__ __forceinline__ unsigned cvt_pk_bf16(float lo, float hi) { unsigned r; asm volatile("v_cvt_pk_bf16_f32 %0, %1, %2" : "=v"(r) : "v"(lo), "v"(hi)); return r; }
__device__ __forceinline__ bf16_t f2bf(float f) { unsigned u = __float_as_uint(f); u += 0x7FFFu + ((u >> 16) & 1u); return (bf16_t)(u >> 16); }
__device__ __forceinline__ float bf2f(bf16_t b) { return __uint_as_float(((unsigned)b) << 16); }
__device__ __forceinline__ float bflo(unsigned w) { return __uint_as_float(w << 16); }
__device__ __forceinline__ float bfhi(unsigned w) { return __uint_as_float(w & 0xffff0000u); }

__device__ __forceinline__ int lds_byte(int r, int c) { const int st = (r >> 4) * 2 + (c >> 5), rr = r & 15, cc = c & 31, ob = rr * 64 + cc * 2; return st * 1024 + (ob ^ (((ob >> 9) & 1) << 5)); }
__device__ __forceinline__ void stage_rc(int b, int& R, int& C) { const int st = b / 1024, sb = b % 1024, swz = sb ^ (((sb >> 9) & 1) << 5); R = (st >> 1) * 16 + swz / 64; C = (st & 1) * 32 + (swz % 64) / 2; }
__device__ __forceinline__ int perm32(int rho) { const int n = rho >> 4, i = rho & 15; return 8 * (i >> 2) + 4 * n + (i & 3); }

struct Unit { int pm, pn, e; };
struct GemmP { const bf16_t* A0; const bf16_t* A1; const bf16_t* Bt; long strideB; const int* gather; int K; int pad_; };

struct StaticOrder {
    int nM, nN, nwg, G, c;
    __device__ void init(int M, int N, int G_, int c_) { nM = M / BM; nN = N / BM; nwg = nM * nN; G = G_; c = c_; }
    __device__ bool next(int i, Unit& u) const {
        const long L = (long)i * G + c; if (L >= nwg) return false;
        int wgid = (int)L; { const int q = nwg / 8, r = nwg % 8, xcd = wgid % 8, off = wgid / 8; wgid = (xcd < r ? xcd * (q + 1) : r * (q + 1) + (xcd - r) * q) + off; }
        const int nig = 8 * nN, gid = wgid / nig, fm = gid * 8, gsz = (nM - fm) < 8 ? (nM - fm) : 8;
        u.pm = fm + ((wgid % nig) % gsz); u.pn = (wgid % nig) / gsz; u.e = 0; return true;
    }
};

#define MK_FRAG_LOOP(ROW, COL) \
    _Pragma("unroll") for (int ai = 0; ai < 2; ++ai) _Pragma("unroll") for (int m = 0; m < 4; ++m) _Pragma("unroll") for (int bj = 0; bj < 2; ++bj) \
        if (const int ROW = ai * HALF + wr * 64 + m * 16 + fr; true) if (const int COL = bj * HALF + wc * 32 + 8 * fq; true)

template <class Epi, class Sched>
__device__ __forceinline__ void gemm_phase(LAS unsigned char* lds, const GemmP g, const Sched& S, const Epi& E) {
    const int tid = threadIdx.x, wid = __builtin_amdgcn_readfirstlane(tid >> 6), lane = tid & 63, wr = wid >> 2, wc = wid & 3, fr = lane & 15, fq = lane >> 4;
    int K = g.K; asm volatile("" : "+s"(K));
    const int nt = K / BK;
    int RA[2], CA[2]; unsigned voffB[2];
#pragma unroll
    for (int i = 0; i < 2; ++i) { int R, C; stage_rc(tid * 16 + i * 8192, R, C); RA[i] = R; CA[i] = C; const int Rb = (R & ~31) + perm32(R & 31); voffB[i] = (unsigned)(Rb * K + C) * 2u; }
    const size_t kstep = (size_t)(BK * 2), hstepB = (size_t)HALF * K * 2, tstepB = 2 * hstepB;
    const unsigned ldsw = (unsigned)wid * 1024u;
    const int aoff = lds_byte(wr * 64 + fr, fq * 8), boff = lds_byte(wc * 32 + fr, fq * 8);
#define MK_SA(b, h) (((b) * 2 + (h)) * HTB)
#define MK_SB(b, h) ((4 + (b) * 2 + (h)) * HTB)
#define MK_STAGE(bufoff, gbase, voff) do { _Pragma("unroll") for (int _i = 0; _i < 2; ++_i) \
        __builtin_amdgcn_global_load_lds((const unsigned*)((const char*)(gbase) + (voff)[_i]), (LAS unsigned*)(lds + (bufoff) + ldsw + _i * 8192), 16, 0, 0); } while (0)
#define MK_LDA(dst, b, h) do { _Pragma("unroll") for (int m = 0; m < 4; ++m) _Pragma("unroll") for (int k = 0; k < 2; ++k) dst[m][k] = *(const LAS bf16x8*)(lds + MK_SA(b, h) + aoff + m * 2048 + k * 1024); } while (0)
#define MK_LDB(dst, b, h) do { _Pragma("unroll") for (int n = 0; n < 2; ++n) _Pragma("unroll") for (int k = 0; k < 2; ++k) dst[n][k] = *(const LAS bf16x8*)(lds + MK_SB(b, h) + boff + n * 2048 + k * 1024); } while (0)
#define MK_MMA(ai, bj, At, Bt) do { __builtin_amdgcn_s_setprio(1); _Pragma("unroll") for (int m = 0; m < 4; ++m) _Pragma("unroll") for (int n = 0; n < 2; ++n) _Pragma("unroll") for (int k = 0; k < 2; ++k) \
        acc[ai][bj][m][n] = __builtin_amdgcn_mfma_f32_16x16x32_bf16(Bt[n][k], At[m][k], acc[ai][bj][m][n], 0, 0, 0); __builtin_amdgcn_s_setprio(0); } while (0)
#define MK_WAIT_V(n) asm volatile("s_waitcnt vmcnt(" #n ")" ::: "memory")
#define MK_WAIT_L(n) asm volatile("s_waitcnt lgkmcnt(" #n ")" ::: "memory")
#define MK_BAR __builtin_amdgcn_s_barrier()
#define MK_SCHED __builtin_amdgcn_sched_barrier(0)
    Unit cur, nxt; int ui = 0;
    if (!S.next(0, cur)) return;
    f32x4 acc[2][2][4][2];
#pragma unroll
    for (int a = 0; a < 2; ++a)
#pragma unroll
        for (int b = 0; b < 2; ++b)
#pragma unroll
            for (int m = 0; m < 4; ++m)
#pragma unroll
                for (int n = 0; n < 2; ++n) acc[a][b][m][n] = (f32x4){0.f, 0.f, 0.f, 0.f};
    bf16x8 At[4][2], B0[2][2], B1[2][2];
    unsigned vA[2][2], vAn[2][2];
    auto a_voff = [&](const Unit& u, unsigned (&vo)[2][2]) {
#pragma unroll
        for (int h = 0; h < 2; ++h)
#pragma unroll
            for (int i = 0; i < 2; ++i) { const int row = u.pm * BM + h * HALF + RA[i]; const int arow = g.gather ? g.gather[row] : row; vo[h][i] = (unsigned)((size_t)arow * K + CA[i]) * 2u; }
    };
    a_voff(cur, vA);
    const char* cA = (const char*)(cur.e ? g.A1 : g.A0);
    const char* cB = (const char*)g.Bt + ((size_t)cur.e * g.strideB) * 2 + (size_t)cur.pn * tstepB;
    MK_STAGE(MK_SB(0, 0), cB, voffB); MK_STAGE(MK_SA(0, 0), cA, vA[0]); MK_STAGE(MK_SB(0, 1), cB + hstepB, voffB); MK_STAGE(MK_SA(0, 1), cA, vA[1]);
    if (wr == 1) MK_BAR;
    MK_WAIT_V(4); MK_BAR;
    MK_STAGE(MK_SB(1, 0), cB + kstep, voffB); MK_STAGE(MK_SA(1, 0), cA + kstep, vA[0]); MK_STAGE(MK_SB(1, 1), cB + hstepB + kstep, voffB);
    MK_WAIT_V(6); MK_BAR;
    for (;;) {
        const bool has_next = S.next(ui + 1, nxt);
        const char* nA = has_next ? (const char*)(nxt.e ? g.A1 : g.A0) : cA;
        const char* nB = has_next ? (const char*)g.Bt + ((size_t)nxt.e * g.strideB) * 2 + (size_t)nxt.pn * tstepB : cB;
        for (int t = 0; t < nt; t += 2) {
            const bool last = (t == nt - 2);
            if (last) { if (has_next) a_voff(nxt, vAn); else {
#pragma unroll
                for (int h = 0; h < 2; ++h)
#pragma unroll
                    for (int i = 0; i < 2; ++i) vAn[h][i] = vA[h][i]; } }
            const char* a1 = cA + (size_t)(t + 1) * kstep;
            const char* a2 = last ? nA : cA + (size_t)(t + 2) * kstep; const char* b2 = last ? nB : cB + (size_t)(t + 2) * kstep;
            const char* a3 = a2 + kstep; const char* b3 = b2 + kstep;
            unsigned v2[2][2];
#pragma unroll
            for (int h = 0; h < 2; ++h)
#pragma unroll
                for (int i = 0; i < 2; ++i) v2[h][i] = last ? vAn[h][i] : vA[h][i];
            MK_LDB(B0, 0, 0); MK_SCHED; MK_LDA(At, 0, 0); MK_STAGE(MK_SA(1, 1), a1, vA[1]);
            MK_WAIT_L(8); MK_BAR; MK_WAIT_L(0); MK_MMA(0, 0, At, B0); MK_BAR; MK_SCHED;
            MK_LDB(B1, 0, 1); MK_STAGE(MK_SB(0, 0), b2, voffB);
            MK_BAR; MK_WAIT_L(0); MK_MMA(0, 1, At, B1); MK_BAR;
            MK_LDA(At, 0, 1); MK_STAGE(MK_SA(0, 0), a2, v2[0]);
            MK_BAR; MK_WAIT_L(0); MK_MMA(1, 0, At, B0); MK_BAR; MK_SCHED;
            MK_STAGE(MK_SB(0, 1), b2 + hstepB, voffB);
            MK_WAIT_V(6); MK_BAR; MK_MMA(1, 1, At, B1); MK_BAR;
            MK_LDB(B0, 1, 0); MK_SCHED; MK_LDA(At, 1, 0); MK_STAGE(MK_SA(0, 1), a2, v2[1]);
            MK_WAIT_L(8); MK_BAR; MK_WAIT_L(0); MK_MMA(0, 0, At, B0); MK_BAR; MK_SCHED;
            MK_LDB(B1, 1, 1); MK_STAGE(MK_SB(1, 0), b3, voffB);
            MK_BAR; MK_WAIT_L(0); MK_MMA(0, 1, At, B1); MK_BAR;
            MK_LDA(At, 1, 1); MK_STAGE(MK_SA(1, 0), a3, v2[0]);
            MK_BAR; MK_WAIT_L(0); MK_MMA(1, 0, At, B0); MK_BAR; MK_SCHED;
            MK_STAGE(MK_SB(1, 1), b3 + hstepB, voffB);
            MK_WAIT_V(6); MK_BAR; MK_MMA(1, 1, At, B1); MK_BAR;
        }
        const bool keep = E(acc, cur, wr, wc, fr, fq);
        if (!has_next) break;
        if (!keep) {
#pragma unroll
            for (int a = 0; a < 2; ++a)
#pragma unroll
                for (int b = 0; b < 2; ++b)
#pragma unroll
                    for (int m = 0; m < 4; ++m)
#pragma unroll
                        for (int n = 0; n < 2; ++n) acc[a][b][m][n] = (f32x4){0.f, 0.f, 0.f, 0.f};
        }
        cur = nxt; cA = nA; cB = nB; ++ui;
#pragma unroll
        for (int h = 0; h < 2; ++h)
#pragma unroll
            for (int i = 0; i < 2; ++i) vA[h][i] = vAn[h][i];
    }
    MK_WAIT_V(0);
    if (wr == 0) MK_BAR;
    MK_BAR;
#undef MK_SA
#undef MK_SB
#undef MK_STAGE
#undef MK_LDA
#undef MK_LDB
#undef MK_MMA
#undef MK_WAIT_V
#undef MK_WAIT_L
#undef MK_BAR
#undef MK_SCHED
}

__device__ __forceinline__ u32x4 pack8(const f32x4 a, const f32x4 b) { u32x4 w; w.x = cvt_pk_bf16(a[0], a[1]); w.y = cvt_pk_bf16(a[2], a[3]); w.z = cvt_pk_bf16(b[0], b[1]); w.w = cvt_pk_bf16(b[2], b[3]); return w; }
struct EpiStoreBf16 {
    bf16_t* O; long ldc;
    __device__ __forceinline__ bool operator()(const f32x4 (&acc)[2][2][4][2], const Unit& u, int wr, int wc, int fr, int fq) const {
        MK_FRAG_LOOP(r, c) { *(u32x4*)(O + (size_t)(u.pm * BM + r) * ldc + u.pn * BM + c) = pack8(acc[ai][bj][m][0], acc[ai][bj][m][1]); }
        return false;
    }
};

struct CMapZ1 { __device__ int operator()(int n) const { return n < RC ? n : (n < Z1_LX ? -1 : OFF_LX + (n - Z1_LX)); } };
struct CMapZC { __device__ int operator()(int n) const { return OFF_LG + n; } };
struct CMapId { __device__ int operator()(int n) const { return n; } };
struct CMapGU { int F; __device__ int operator()(int n) const { return (n & 1) * F + (n >> 1); } };
template <class CM>
__device__ __forceinline__ void convT_tile(LAS float* tile  , const float* src, int lds_, int Ks, bf16_t* dst, int Kd, int n0, int k0, const CM& cm) {
    const int tid = threadIdx.x;
    { const int kk = tid >> 3, nn8 = (tid & 7) * 8; const int k = k0 + kk;
#pragma unroll
      for (int j = 0; j < 8; ++j) { const int sc = cm(n0 + nn8 + j); tile[kk * 65 + nn8 + j] = (k < Ks && sc >= 0) ? src[(size_t)k * lds_ + sc] : 0.f; } }
    __syncthreads();
    { const int nn = tid >> 3, kk8 = (tid & 7) * 8; f32x4 a, b;
#pragma unroll
      for (int j = 0; j < 4; ++j) { a[j] = tile[(kk8 + j) * 65 + nn]; b[j] = tile[(kk8 + 4 + j) * 65 + nn]; }
      *(u32x4*)(dst + (size_t)(n0 + nn) * Kd + k0 + kk8) = pack8(a, b); }
    __syncthreads();
}
template <class CM>
__device__ __forceinline__ void convT_job(LAS float* tile, const float* src, int lds_, int Ks, bf16_t* dst, int Kd, int N, const CM& cm, int bid, int nblk, int& base) {
    const int tn = N / 64, tk = Kd / 64, nt = tn * tk;
    int first = (bid - base % nblk + nblk) % nblk;
    for (int t = first; t < nt; t += nblk) convT_tile(tile, src, lds_, Ks, dst, Kd, (t / tk) * 64, (t % tk) * 64, cm);
    base += nt;
}

constexpr int MOD_SL = 16, MOD_KS = D / MOD_SL;
__device__ __forceinline__ void mod_partials(LAS float* sl  , const In& in, float* part  , int bid, int nblk) {
    const int ncc = 6 * D / NT, nitem = MOD_SL * ncc;
    for (int it = bid; it < nitem; it += nblk) {
        const int s = it / ncc, j = (it % ncc) * NT + threadIdx.x;
        for (int i = threadIdx.x; i < (NB + 1) * MOD_KS; i += NT) { const int r = i / MOD_KS, k = s * MOD_KS + i % MOD_KS; const float cv = r < NB ? in.c[r * D + k] : in.c_ctx[k]; sl[i] = siluf_(cv); }
        __syncthreads();
        float acc[NB + 1];
#pragma unroll
        for (int r = 0; r <= NB; ++r) acc[r] = 0.f;
        for (int k = 0; k < MOD_KS; ++k) { const float w = in.w_mod[(size_t)(s * MOD_KS + k) * 6 * D + j];
#pragma unroll
            for (int r = 0; r <= NB; ++r) acc[r] += sl[r * MOD_KS + k] * w; }
#pragma unroll
        for (int r = 0; r <= NB; ++r) part[((size_t)s * (NB + 1) + r) * 6 * D + j] = acc[r];
        __syncthreads();
    }
}
__device__ __forceinline__ float mod_value(const In& in, const float* part, int r, int j) {
    float s = in.b_mod[j];
#pragma unroll
    for (int q = 0; q < MOD_SL; ++q) s += part[((size_t)q * (NB + 1) + r) * 6 * D + j];
    return s;
}

__device__ __forceinline__ void xn_rows(LAS float* sm  , const In& in, const float* part, bf16_t* xn, int b0, int nb, int row_lo, int row_hi) {
    const int nlat = nb * SEQ, wid = threadIdx.x >> 6, lane = threadIdx.x & 63;
    int cur_mr = -1;
    for (int rbase = row_lo; rbase < row_hi; rbase += 8) {
        const int mr = rbase < nlat ? b0 + rbase / SEQ : NB;
        if (mr != cur_mr) { __syncthreads(); for (int j = threadIdx.x; j < 2 * D; j += NT) sm[j] = mod_value(in, part, mr, j); __syncthreads(); cur_mr = mr; }
        const int r = rbase + wid; if (r >= row_hi) continue;
        const float* src = r < nlat ? in.x + ((size_t)b0 * SEQ + r) * D : in.ctx + ((size_t)b0 * CTX + (r - nlat)) * D;
        f32x4 v[4]; float ss = 0.f;
#pragma unroll
        for (int j = 0; j < 4; ++j) { v[j] = *(const f32x4*)(src + j * 256 + lane * 4); ss += v[j][0] * v[j][0] + v[j][1] * v[j][1] + v[j][2] * v[j][2] + v[j][3] * v[j][3]; }
#pragma unroll
        for (int o = 32; o > 0; o >>= 1) ss += __shfl_xor(ss, o);
        const float rinv = 1.f / sqrtf(ss * (1.f / D) + NORM_EPS);
#pragma unroll
        for (int j = 0; j < 4; ++j) { const int c = j * 256 + lane * 4; float o[4];
#pragma unroll
            for (int q = 0; q < 4; ++q) o[q] = (v[j][q] * rinv * in.norm_g[c + q]) * (1.f + sm[D + c + q]) + sm[c + q];
            u32x2 w; w.x = cvt_pk_bf16(o[0], o[1]); w.y = cvt_pk_bf16(o[2], o[3]); *(u32x2*)(xn + (size_t)r * D + c) = w; }
    }
}
}

namespace mk {
constexpr int TB = 32;
constexpr int RAWW = 320;
constexpr int RW_RAW = 0;
constexpr int RW_MU = RW_RAW + (TB + 2) * RAWW * 2;
constexpr int RW_WUP = RW_MU + 2 * RAWW * 4;
constexpr int RW_AUP = RW_WUP + 64 * 72 * 2;
constexpr int RW_CST = RW_AUP + 64 * 72 * 2;
constexpr int RW_AWD = RW_CST + 5 * 64 * 4;
constexpr int RW_AAD = RW_AWD + TB * 72 * 2;
constexpr int RW_R = RW_AAD + TB * 72 * 2;
constexpr int RW_KR = RW_R + TB * 64 * 4;
constexpr int RW_LA = RW_KR + TB * 64 * 4;
constexpr int RW_KK = RW_LA + TB * 64 * 4;
constexpr int RW_W = RW_KK + TB * 64 * 4;
constexpr int RW_B = RW_W + TB * 64 * 4;
constexpr int RW_KD = RW_B + TB * 64 * 4;
constexpr int RW_WR = RW_KD + TB * 64 * 4;
constexpr int RW_V = RW_WR + TB * 64 * 4;
constexpr int RW_SC = RW_V + TB * 64 * 4;
constexpr int RW_YO = RW_SC + TB * 2 * 4;
constexpr int RW_BON = RW_YO + TB * 64 * 4;
constexpr int RW_END = RW_BON + TB * 4;
static_assert(RW_END <= LDS_BYTES, "rwkv LDS");

#define MK_DPP(x, ctrl) __int_as_float(__builtin_amdgcn_update_dpp(__float_as_int(x), __float_as_int(x), ctrl, 0xF, 0xF, false))
__device__ __forceinline__ float allreduce16(float x) {
    x += MK_DPP(x, 0xB1); x += MK_DPP(x, 0x4E); x += MK_DPP(x, 0x141); x += MK_DPP(x, 0x140); return x;
}

struct RwkvP { const bf16_t* z1; bf16_t* Y; float* bon; int b0, nb; };

constexpr int RW_NPIECE = (TB + 2) * 40, RW_PPT = (RW_NPIECE + NT - 1) / NT;

__device__ __forceinline__ void rwkv_chain(LAS unsigned char* lds, const In& in, const RwkvP p, int chain) {
    const int tid = threadIdx.x, lane = tid & 63, wid = tid >> 6;
    const int d = chain / (p.nb * NH), bl = (chain / NH) % p.nb, h = chain % NH;
    const int nlat = p.nb * SEQ;
    LAS bf16_t* RAW = (LAS bf16_t*)(lds + RW_RAW); LAS float* MU = (LAS float*)(lds + RW_MU);
    LAS bf16_t* WUP = (LAS bf16_t*)(lds + RW_WUP); LAS bf16_t* AUP = (LAS bf16_t*)(lds + RW_AUP); LAS float* CST = (LAS float*)(lds + RW_CST);
    LAS bf16_t* AWD = (LAS bf16_t*)(lds + RW_AWD); LAS bf16_t* AAD = (LAS bf16_t*)(lds + RW_AAD);
    LAS float *Rr = (LAS float*)(lds + RW_R), *KR = (LAS float*)(lds + RW_KR), *LA_ = (LAS float*)(lds + RW_LA);
    LAS float *KK = (LAS float*)(lds + RW_KK), *Wv = (LAS float*)(lds + RW_W), *Bv = (LAS float*)(lds + RW_B), *KD = (LAS float*)(lds + RW_KD), *WR = (LAS float*)(lds + RW_WR), *Vv = (LAS float*)(lds + RW_V);
    LAS float *SC = (LAS float*)(lds + RW_SC), *YO = (LAS float*)(lds + RW_YO), *BON = (LAS float*)(lds + RW_BON);
    auto segcol = [&](int s) { return s < 3 ? s * RW + h * 64 : (s == 3 ? OFF_WD + d * DL : OFF_AD + d * AL); };
    for (int i = tid; i < 2 * RAWW; i += NT) { const int m = i / RAWW, c = i % RAWW; MU[i] = in.shift_mu[m * RC + segcol(c >> 6) + (c & 63)]; }
    for (int i = tid; i < 64 * 64; i += NT) { const int j = i >> 6, c = i & 63;
        WUP[c * 72 + j] = f2bf(in.rw_w_up[((size_t)d * DL + j) * RW + h * 64 + c]); AUP[c * 72 + j] = f2bf(in.rw_a_up[((size_t)d * AL + j) * RW + h * 64 + c]); }
    for (int i = tid; i < 64; i += NT) { CST[i] = in.rw_w0[d * RW + h * 64 + i]; CST[64 + i] = in.rw_a0[d * RW + h * 64 + i]; CST[128 + i] = in.rw_k_k[h * 64 + i]; CST[192 + i] = in.rw_k_a[h * 64 + i]; CST[256 + i] = in.rw_r_k[h * 64 + i]; }
    constexpr int NQ = (CTX + SEQ) / TB, NQC = CTX / TB;
    auto blk_info = [&](int q, bool& isctx, int& t0, bool& hp, bool& hn, size_t& grow0) {
        isctx = q < NQC;
        if (isctx) { const int qq = d == 0 ? q : NQC - 1 - q; t0 = qq * TB; hp = t0 > 0; hn = t0 + TB < CTX; grow0 = (size_t)nlat + (size_t)bl * CTX + t0; }
        else { const int ql = q - NQC, qq = d == 0 ? ql : SEQ / TB - 1 - ql; t0 = qq * TB; hp = (t0 % GW) != 0; hn = ((t0 + TB) % GW) != 0; grow0 = (size_t)bl * SEQ + t0; }
    };
    u32x4 pre[RW_PPT];
    auto prefetch = [&](int q) {
        bool isctx, hp, hn; int t0; size_t grow0; blk_info(q, isctx, t0, hp, hn, grow0);
#pragma unroll
        for (int k = 0; k < RW_PPT; ++k) { const int i = tid + k * NT; u32x4 v = (u32x4){0u, 0u, 0u, 0u};
            if (i < RW_NPIECE) { const int rr = i / 40, sp = i % 40, seg = sp >> 3, part = sp & 7;
                const bool ok = (rr == 0) ? hp : ((rr == TB + 1) ? hn : true);
                if (ok) v = *(const u32x4*)(p.z1 + (grow0 + rr - 1) * Z1_N + segcol(seg) + part * 8); }
            pre[k] = v; }
    };
    auto commit = [&]() {
#pragma unroll
        for (int k = 0; k < RW_PPT; ++k) { const int i = tid + k * NT; if (i < RW_NPIECE) { const int rr = i / 40, sp = i % 40; *(LAS u32x4*)(RAW + rr * RAWW + sp * 8) = pre[k]; } }
    };
    float S[2][4];
#pragma unroll
    for (int i = 0; i < 2; ++i)
#pragma unroll
        for (int j = 0; j < 4; ++j) S[i][j] = 0.f;
    const int kg = lane & 15, rp = (lane >> 4) + 4 * wid;
    prefetch(0);
    for (int q = 0; q < NQ; ++q) {
        bool isctx, hp, hn; int t0; size_t grow0; blk_info(q, isctx, t0, hp, hn, grow0);
        commit();
        __syncthreads();
        if (q + 1 < NQ) prefetch(q + 1);
        for (int it = tid; it < TB * 40; it += NT) {
            const int t = it / 40, g = it % 40, c0 = g * 8;
            const u32x4 xp = *(const LAS u32x4*)(RAW + t * RAWW + c0), xc = *(const LAS u32x4*)(RAW + (t + 1) * RAWW + c0), xn_ = *(const LAS u32x4*)(RAW + (t + 2) * RAWW + c0);
            float s[8];
#pragma unroll
            for (int j = 0; j < 4; ++j) { const unsigned a = xp[j], b = xc[j], c = xn_[j];
                { const float x = bflo(b), pv = bflo(a), nv = bflo(c); s[2 * j] = x + MU[c0 + 2 * j] * (pv - x) + MU[RAWW + c0 + 2 * j] * (nv - x); }
                { const float x = bfhi(b), pv = bfhi(a), nv = bfhi(c); s[2 * j + 1] = x + MU[c0 + 2 * j + 1] * (pv - x) + MU[RAWW + c0 + 2 * j + 1] * (nv - x); } }
            const int seg = g >> 3, cc = (g & 7) * 8;
            if (seg < 3) { LAS float* dst = (seg == 0 ? Rr : (seg == 1 ? KR : Vv)) + t * 64 + cc; *(LAS f32x4*)dst = (f32x4){s[0], s[1], s[2], s[3]}; *(LAS f32x4*)(dst + 4) = (f32x4){s[4], s[5], s[6], s[7]}; }
            else { if (seg == 3) {
#pragma unroll
                    for (int j = 0; j < 8; ++j) s[j] = tanhf(s[j]); }
                LAS bf16_t* dst = (seg == 3 ? AWD : AAD) + t * 72 + cc;
                u32x4 w; w.x = cvt_pk_bf16(s[0], s[1]); w.y = cvt_pk_bf16(s[2], s[3]); w.z = cvt_pk_bf16(s[4], s[5]); w.w = cvt_pk_bf16(s[6], s[7]); *(LAS u32x4*)dst = w; }
        }
        __syncthreads();
        {
            const int lora = wid >> 2, ct = wid & 3, fr = lane & 15, fq = lane >> 4;
            const LAS bf16_t* Am = lora ? AAD : AWD; const LAS bf16_t* Bm = lora ? AUP : WUP;
#pragma unroll
            for (int rt = 0; rt < 2; ++rt) {
                f32x4 acc = (f32x4){0.f, 0.f, 0.f, 0.f};
#pragma unroll
                for (int ks = 0; ks < 2; ++ks) {
                    const bf16x8 a = *(const LAS bf16x8*)(Am + (rt * 16 + fr) * 72 + ks * 32 + fq * 8);
                    const bf16x8 b = *(const LAS bf16x8*)(Bm + (ct * 16 + fr) * 72 + ks * 32 + fq * 8);
                    acc = __builtin_amdgcn_mfma_f32_16x16x32_bf16(a, b, acc, 0, 0, 0);
                }
                const int col = ct * 16 + fr;
#pragma unroll
                for (int i = 0; i < 4; ++i) { const int t = rt * 16 + fq * 4 + i;
                    if (lora == 0) { const float lw = acc[i] + CST[col]; const float wl = -softplusf_(-lw) - 0.5f; Wv[t * 64 + col] = __expf(-__expf(wl)); }
                    else { LA_[t * 64 + col] = sigmoidf_(acc[i] + CST[64 + col]); } }
            }
        }
        __syncthreads();
        {
            const int t = tid >> 4, c4 = (tid & 15) * 4;
            const f32x4 k = *(const LAS f32x4*)(KR + t * 64 + c4), a = *(const LAS f32x4*)(LA_ + t * 64 + c4), w = *(const LAS f32x4*)(Wv + t * 64 + c4), r = *(const LAS f32x4*)(Rr + t * 64 + c4);
            f32x4 kkr, kd, bb, wr; float ss = 0.f, br = 0.f, kr = 0.f, bn = 0.f;
#pragma unroll
            for (int j = 0; j < 4; ++j) { kkr[j] = k[j] * CST[128 + c4 + j]; ss += kkr[j] * kkr[j]; }
            ss = allreduce16(ss);
            const float inv = 1.f / fmaxf(sqrtf(ss), 1e-12f);
#pragma unroll
            for (int j = 0; j < 4; ++j) { const float kk = kkr[j] * inv; kkr[j] = kk; kd[j] = k[j] * (1.f + (a[j] - 1.f) * CST[192 + c4 + j]); bb[j] = kk * a[j]; wr[j] = w[j] * r[j];
                br += bb[j] * r[j]; kr += kd[j] * r[j]; bn += r[j] * kd[j] * CST[256 + c4 + j]; }
            br = allreduce16(br); kr = allreduce16(kr); bn = allreduce16(bn);
            *(LAS f32x4*)(KK + t * 64 + c4) = kkr; *(LAS f32x4*)(KD + t * 64 + c4) = kd; *(LAS f32x4*)(Bv + t * 64 + c4) = bb; *(LAS f32x4*)(WR + t * 64 + c4) = wr;
            if ((tid & 15) == 0) { SC[t * 2] = br; SC[t * 2 + 1] = kr; BON[t] = bn; }
        }
        __syncthreads();
        for (int st = 0; st < TB; ++st) {
            const int t = d == 0 ? st : TB - 1 - st;
            const f32x4 kk4 = *(const LAS f32x4*)(KK + t * 64 + 4 * kg), w4 = *(const LAS f32x4*)(Wv + t * 64 + 4 * kg), b4 = *(const LAS f32x4*)(Bv + t * 64 + 4 * kg),
                        kd4 = *(const LAS f32x4*)(KD + t * 64 + 4 * kg), wr4 = *(const LAS f32x4*)(WR + t * 64 + 4 * kg);
            const f32x2 vv = *(const LAS f32x2*)(Vv + t * 64 + 2 * rp), sc = *(const LAS f32x2*)(SC + t * 2);
            float sa0 = S[0][0] * kk4[0], sa1 = S[1][0] * kk4[0], yo0 = S[0][0] * wr4[0], yo1 = S[1][0] * wr4[0];
#pragma unroll
            for (int j = 1; j < 4; ++j) { sa0 += S[0][j] * kk4[j]; sa1 += S[1][j] * kk4[j]; yo0 += S[0][j] * wr4[j]; yo1 += S[1][j] * wr4[j]; }
            sa0 = -allreduce16(sa0); sa1 = -allreduce16(sa1); yo0 = allreduce16(yo0); yo1 = allreduce16(yo1);
#pragma unroll
            for (int j = 0; j < 4; ++j) { S[0][j] = S[0][j] * w4[j] + (sa0 * b4[j] + vv[0] * kd4[j]); S[1][j] = S[1][j] * w4[j] + (sa1 * b4[j] + vv[1] * kd4[j]); }
            if (kg == 0) { f32x2 y; y[0] = yo0 + sa0 * sc[0] + vv[0] * sc[1]; y[1] = yo1 + sa1 * sc[0] + vv[1] * sc[1]; *(LAS f32x2*)(YO + t * 64 + 2 * rp) = y; }
        }
        __syncthreads();
        if (!isctx) {
            const int t = tid >> 4, c4 = (tid & 15) * 4; const f32x4 y = *(const LAS f32x4*)(YO + t * 64 + c4);
            u32x2 w; w.x = cvt_pk_bf16(y[0], y[1]); w.y = cvt_pk_bf16(y[2], y[3]);
            *(u32x2*)(p.Y + ((size_t)d * nlat + grow0 + t) * RW + h * 64 + c4) = w;
            if (tid < TB) p.bon[((size_t)d * nlat + grow0 + tid) * NH + h] = BON[tid];
        }
    }
}
__device__ __forceinline__ void rwkv_phase(LAS unsigned char* lds, const In& in, const RwkvP p, int bid, int nblk) {
    const int nchain = 2 * p.nb * NH;
    for (int c = bid; c < nchain; c += nblk) { rwkv_chain(lds, in, p, c); __syncthreads(); }
}
}

namespace mk {
constexpr int LR_XT = 0;
constexpr int LR_XC = LR_XT + 67 * 64 * 2 + 64;
constexpr int LR_XCB = LR_XC + 64 * 64 * 4;
constexpr int LR_GWT = LR_XCB + 64 * 72 * 2;
constexpr int LR_A = LR_GWT + 2 * 64 * 72 * 2;
constexpr int LR_BX = LR_A + 64 * 64 * 4;
constexpr int LR_HO = LR_BX + 64 * 64 * 4;
constexpr int LR_CST = LR_HO + 64 * 64 * 4;
constexpr int LR_END = LR_CST + 8 * 64 * 4;
static_assert(LR_END <= LDS_BYTES && (LR_XC % 16) == 0, "lru LDS");

struct LruP { const bf16_t* z1; bf16_t* Hd; int b0, nb; };

__device__ __forceinline__ void lru_item(LAS unsigned char* lds, const In& in, const LruP p, int item) {
    const int tid = threadIdx.x, lane = tid & 63, wid = tid >> 6;
    const int d = item / (p.nb * LB), bl = (item / LB) % p.nb, n = item % LB;
    const int nlat = p.nb * SEQ;
    LAS bf16_t* XT = (LAS bf16_t*)(lds + LR_XT); LAS float* XC = (LAS float*)(lds + LR_XC); LAS bf16_t* XCB = (LAS bf16_t*)(lds + LR_XCB); LAS bf16_t* GWT = (LAS bf16_t*)(lds + LR_GWT);
    LAS float *A_ = (LAS float*)(lds + LR_A), *BX = (LAS float*)(lds + LR_BX), *HO = (LAS float*)(lds + LR_HO), *CST = (LAS float*)(lds + LR_CST);
    for (int i = tid; i < 2 * 64 * 64; i += NT) { const int g = i >> 12, j = (i >> 6) & 63, k = i & 63;
        GWT[(g * 64 + k) * 72 + j] = f2bf(in.lru_gate_w[((((size_t)d * 2 + g) * LB + n) * LBS + j) * LBS + k]); }
    for (int i = tid; i < 64; i += NT) { const int c = n * 64 + i;
        CST[i] = in.lru_conv_w[c]; CST[64 + i] = in.lru_conv_w[LW + c]; CST[128 + i] = in.lru_conv_w[2 * LW + c]; CST[192 + i] = in.lru_conv_w[3 * LW + c]; CST[256 + i] = in.lru_conv_b[c];
        CST[320 + i] = in.lru_gate_b[((d * 2 + 0) * LB + n) * LBS + i]; CST[384 + i] = in.lru_gate_b[((d * 2 + 1) * LB + n) * LBS + i]; CST[448 + i] = softplusf_(-in.lru_l[d * LW + c]); }
    constexpr int NSEG = CTX / 64 + GW, NSC = CTX / 64;
    u32x4 pre[2];
    auto tok_row = [&](int sidx, int rr, bool& ok) -> size_t {
        if (sidx < NSC) { const int t = sidx * 64 + rr - 2; ok = t >= 0 && t < CTX; return (size_t)nlat + (size_t)bl * CTX + t; }
        const int col = sidx - NSC, row = rr - 2; ok = row >= 0 && row < ROWS; return (size_t)bl * SEQ + (size_t)row * GW + col;
    };
    auto seg_of = [&](int q) { if (q < NSC) return d == 0 ? q : NSC - 1 - q; const int ql = q - NSC; return NSC + (d == 0 ? ql : GW - 1 - ql); };
    auto prefetch = [&](int q) { const int sidx = seg_of(q);
#pragma unroll
        for (int k = 0; k < 2; ++k) { const int i = tid + k * NT; u32x4 v = (u32x4){0u, 0u, 0u, 0u};
            if (i < 67 * 8) { const int rr = i >> 3, part = i & 7; bool ok; const size_t gr = tok_row(sidx, rr, ok); if (ok) v = *(const u32x4*)(p.z1 + gr * Z1_N + Z1_LX + n * 64 + part * 8); }
            pre[k] = v; } };
    auto commit = [&]() {
#pragma unroll
        for (int k = 0; k < 2; ++k) { const int i = tid + k * NT; if (i < 67 * 8) *(LAS u32x4*)(XT + (i >> 3) * 64 + (i & 7) * 8) = pre[k]; } };
    float hcar = 0.f;
    prefetch(0);
    for (int q = 0; q < NSEG; ++q) {
        const int sidx = seg_of(q);
        commit();
        __syncthreads();
        if (q + 1 < NSEG) prefetch(q + 1);
        { const int t = tid >> 3, c0 = (tid & 7) * 8; float s[8];
#pragma unroll
          for (int j = 0; j < 8; ++j) s[j] = CST[256 + c0 + j];
#pragma unroll
          for (int tap = 0; tap < 4; ++tap) { const u32x4 x = *(const LAS u32x4*)(XT + (t + tap) * 64 + c0);
#pragma unroll
              for (int j = 0; j < 4; ++j) { s[2 * j] += CST[tap * 64 + c0 + 2 * j] * bflo(x[j]); s[2 * j + 1] += CST[tap * 64 + c0 + 2 * j + 1] * bfhi(x[j]); } }
          *(LAS f32x4*)(XC + t * 64 + c0) = (f32x4){s[0], s[1], s[2], s[3]}; *(LAS f32x4*)(XC + t * 64 + c0 + 4) = (f32x4){s[4], s[5], s[6], s[7]};
          u32x4 w; w.x = cvt_pk_bf16(s[0], s[1]); w.y = cvt_pk_bf16(s[2], s[3]); w.z = cvt_pk_bf16(s[4], s[5]); w.w = cvt_pk_bf16(s[6], s[7]); *(LAS u32x4*)(XCB + t * 72 + c0) = w; }
        __syncthreads();
        { const int rt = wid >> 1, fr = lane & 15, fq = lane >> 4;
          bf16x8 a[2];
#pragma unroll
          for (int ks = 0; ks < 2; ++ks) a[ks] = *(const LAS bf16x8*)(XCB + (rt * 16 + fr) * 72 + ks * 32 + fq * 8);
#pragma unroll
          for (int cc = 0; cc < 2; ++cc) { const int ct = 2 * (wid & 1) + cc, col = ct * 16 + fr;
              f32x4 acc0 = (f32x4){0.f, 0.f, 0.f, 0.f}, acc1 = acc0;
#pragma unroll
              for (int ks = 0; ks < 2; ++ks) {
                  const bf16x8 b0 = *(const LAS bf16x8*)(GWT + (0 * 64 + col) * 72 + ks * 32 + fq * 8), b1 = *(const LAS bf16x8*)(GWT + (1 * 64 + col) * 72 + ks * 32 + fq * 8);
                  acc0 = __builtin_amdgcn_mfma_f32_16x16x32_bf16(a[ks], b0, acc0, 0, 0, 0); acc1 = __builtin_amdgcn_mfma_f32_16x16x32_bf16(a[ks], b1, acc1, 0, 0, 0); }
#pragma unroll
              for (int i = 0; i < 4; ++i) { const int t = rt * 16 + fq * 4 + i;
                  const float rec = sigmoidf_(acc0[i] + CST[320 + col]), inp = sigmoidf_(acc1[i] + CST[384 + col]);
                  const float la = -8.f * rec * CST[448 + col];
                  A_[t * 64 + col] = __expf(la); BX[t * 64 + col] = sqrtf(-expm1f(2.f * la)) * inp * XC[t * 64 + col]; } } }
        __syncthreads();
        if (wid == 0) {
#pragma unroll 8
            for (int st = 0; st < 64; ++st) { const int t = d == 0 ? st : 63 - st; hcar = A_[t * 64 + lane] * hcar + BX[t * 64 + lane]; HO[t * 64 + lane] = hcar; }
        }
        __syncthreads();
        if (sidx >= NSC) { const int col = sidx - NSC, t = tid >> 3, c0 = (tid & 7) * 8;
            const f32x4 x = *(const LAS f32x4*)(HO + t * 64 + c0), y = *(const LAS f32x4*)(HO + t * 64 + c0 + 4);
            *(u32x4*)(p.Hd + ((size_t)d * nlat + (size_t)bl * SEQ + (size_t)t * GW + col) * LW + n * 64 + c0) = pack8(x, y); }
    }
}
__device__ __forceinline__ void lru_phase(LAS unsigned char* lds, const In& in, const LruP p, int bid, int nblk) {
    const int nitem = 2 * p.nb * LB;
    for (int it = bid; it < nitem; it += nblk) { lru_item(lds, in, p, it); __syncthreads(); }
}
}

namespace mk {
#define MK_DPPX(x, ctrl) __int_as_float(__builtin_amdgcn_update_dpp(__float_as_int(x), __float_as_int(x), ctrl, 0xF, 0xF, false))
__device__ __forceinline__ float allreduce4(float x) { x += MK_DPPX(x, 0xB1); x += MK_DPPX(x, 0x4E); return x; }
__device__ __forceinline__ void unpack8(const u32x4 w, float (&f)[8]) {
#pragma unroll
    for (int j = 0; j < 4; ++j) { f[2 * j] = bflo(w[j]); f[2 * j + 1] = bfhi(w[j]); } }
constexpr int AG_K = 256;
struct PostP { const bf16_t* z1; bf16_t* Y; const float* bon; bf16_t* Ag; int nlat; int pad_; };
__device__ __forceinline__ void rwkv_post_rows(const In& in, const PostP p, int row_lo, int row_hi) {
    const int lane = threadIdx.x & 63, wid = threadIdx.x >> 6, c0 = lane * 16, h = lane >> 2;
    for (int r = row_lo + wid; r < row_hi; r += NT / 64) {
        const int cg = r % GW; const bool hp = cg > 0, hn = cg < GW - 1;
        bf16_t* y0p = p.Y + (size_t)r * RW + c0; const bf16_t* y1p = p.Y + ((size_t)p.nlat + r) * RW + c0;
        float y[16], t8[8];
        unpack8(*(const u32x4*)y0p, t8);
#pragma unroll
        for (int j = 0; j < 8; ++j) y[j] = t8[j];
        unpack8(*(const u32x4*)(y0p + 8), t8);
#pragma unroll
        for (int j = 0; j < 8; ++j) y[8 + j] = t8[j];
        unpack8(*(const u32x4*)y1p, t8);
#pragma unroll
        for (int j = 0; j < 8; ++j) y[j] += t8[j];
        unpack8(*(const u32x4*)(y1p + 8), t8);
#pragma unroll
        for (int j = 0; j < 8; ++j) y[8 + j] += t8[j];
        float s = 0.f;
#pragma unroll
        for (int j = 0; j < 16; ++j) s += y[j];
        const float mu = allreduce4(s) * (1.f / 64.f); float q = 0.f;
#pragma unroll
        for (int j = 0; j < 16; ++j) { const float dlt = y[j] - mu; q += dlt * dlt; }
        const float rs = 1.f / sqrtf(allreduce4(q) * (1.f / 64.f) + LNX_EPS);
        const float bonus = p.bon[(size_t)r * NH + h] + p.bon[((size_t)p.nlat + r) * NH + h];
        const bf16_t* zr = p.z1 + (size_t)r * Z1_N;
#pragma unroll
        for (int half = 0; half < 2; ++half) {
            const int c = OFF_V + c0 + half * 8; float xv[8], pv[8], nv[8];
            unpack8(*(const u32x4*)(zr + c), xv);
            if (hp) unpack8(*(const u32x4*)(zr - Z1_N + c), pv); else {
#pragma unroll
                for (int j = 0; j < 8; ++j) pv[j] = 0.f; }
            if (hn) unpack8(*(const u32x4*)(zr + Z1_N + c), nv); else {
#pragma unroll
                for (int j = 0; j < 8; ++j) nv[j] = 0.f; }
            float o[8];
#pragma unroll
            for (int j = 0; j < 8; ++j) { const float v = xv[j] + in.shift_mu[c + j] * (pv[j] - xv[j]) + in.shift_mu[RC + c + j] * (nv[j] - xv[j]); const int ch = c0 + half * 8 + j;
                o[j] = (y[half * 8 + j] - mu) * rs * in.rw_lnx[ch] + in.rw_lnx[RW + ch] + bonus * v; }
            u32x4 w; w.x = cvt_pk_bf16(o[0], o[1]); w.y = cvt_pk_bf16(o[2], o[3]); w.z = cvt_pk_bf16(o[4], o[5]); w.w = cvt_pk_bf16(o[6], o[7]); *(u32x4*)(y0p + half * 8) = w;
        }
        if (lane < 32) { u32x4 w = (u32x4){0u, 0u, 0u, 0u};
            if (lane < GL / 8) { const int c = OFF_GD + lane * 8; float xv[8], pv[8], nv[8];
                unpack8(*(const u32x4*)(zr + c), xv);
                if (hp) unpack8(*(const u32x4*)(zr - Z1_N + c), pv); else {
#pragma unroll
                    for (int j = 0; j < 8; ++j) pv[j] = 0.f; }
                if (hn) unpack8(*(const u32x4*)(zr + Z1_N + c), nv); else {
#pragma unroll
                    for (int j = 0; j < 8; ++j) nv[j] = 0.f; }
                float o[8];
#pragma unroll
                for (int j = 0; j < 8; ++j) o[j] = sigmoidf_(xv[j] + in.shift_mu[c + j] * (pv[j] - xv[j]) + in.shift_mu[RC + c + j] * (nv[j] - xv[j]));
                w.x = cvt_pk_bf16(o[0], o[1]); w.y = cvt_pk_bf16(o[2], o[3]); w.z = cvt_pk_bf16(o[4], o[5]); w.w = cvt_pk_bf16(o[6], o[7]); }
            *(u32x4*)(p.Ag + (size_t)r * AG_K + lane * 8) = w; }
    }
}
struct EpiYa { const bf16_t* yn; bf16_t* ya;
    __device__ __forceinline__ bool operator()(f32x4 (&acc)[2][2][4][2], const Unit& u, int wr, int wc, int fr, int fq) const {
        MK_FRAG_LOOP(r, c) { const size_t o = (size_t)(u.pm * BM + r) * RW + u.pn * BM + c; float f[8]; unpack8(*(const u32x4*)(yn + o), f);
            f32x4 a = acc[ai][bj][m][0], b = acc[ai][bj][m][1];
#pragma unroll
            for (int j = 0; j < 4; ++j) { a[j] *= f[j]; b[j] *= f[4 + j]; }
            *(u32x4*)(ya + o) = pack8(a, b); asm volatile("" ::: "memory"); }
        return false; } };
struct EpiZc { const bf16_t* Hd; bf16_t* yb; bf16_t* gates; int nlat; int pad_;
    __device__ __forceinline__ bool operator()(f32x4 (&acc)[2][2][4][2], const Unit& u, int wr, int wc, int fr, int fq) const {
        if (u.pn < LW / BM) {
            MK_FRAG_LOOP(r, c) { const size_t o = (size_t)(u.pm * BM + r) * LW + u.pn * BM + c; float h0[8], h1[8]; unpack8(*(const u32x4*)(Hd + o), h0); unpack8(*(const u32x4*)(Hd + (size_t)nlat * LW + o), h1);
                f32x4 a = acc[ai][bj][m][0], b = acc[ai][bj][m][1];
#pragma unroll
                for (int j = 0; j < 4; ++j) { a[j] = gelu_tanhf_(a[j]) * (h0[j] + h1[j]); b[j] = gelu_tanhf_(b[j]) * (h0[4 + j] + h1[4 + j]); }
                *(u32x4*)(yb + o) = pack8(a, b); asm volatile("" ::: "memory"); }
        } else {
            MK_FRAG_LOOP(r, c) { const size_t o = (size_t)(u.pm * BM + r) * (2 * D) + (u.pn * BM - LW) + c;
                f32x4 a = acc[ai][bj][m][0], b = acc[ai][bj][m][1];
#pragma unroll
                for (int j = 0; j < 4; ++j) { a[j] = sigmoidf_(a[j]); b[j] = sigmoidf_(b[j]); }
                *(u32x4*)(gates + o) = pack8(a, b); }
        }
        return false; } };
struct PairOrder { StaticOrder S;
    __device__ bool next(int i, Unit& u) const { if (!S.next(i >> 1, u)) return false; u.e = i & 1; return true; } };
struct EpiBranch { const bf16_t* gates; bf16_t* mixed;
    __device__ __forceinline__ bool operator()(f32x4 (&acc)[2][2][4][2], const Unit& u, int wr, int wc, int fr, int fq) const {
        MK_FRAG_LOOP(r, c) { const size_t row = (size_t)(u.pm * BM + r); const int col = u.pn * BM + c; float g1[8], g2[8];
            unpack8(*(const u32x4*)(gates + row * (2 * D) + col), g1); unpack8(*(const u32x4*)(gates + row * (2 * D) + D + col), g2);
            if (u.e == 0) {
#pragma unroll
                for (int j = 0; j < 4; ++j) { acc[ai][bj][m][0][j] *= g1[j] / g2[j]; acc[ai][bj][m][1][j] *= g1[4 + j] / g2[4 + j]; }
            } else { f32x4 a = acc[ai][bj][m][0], b = acc[ai][bj][m][1];
#pragma unroll
                for (int j = 0; j < 4; ++j) { a[j] *= g2[j]; b[j] *= g2[4 + j]; }
                *(u32x4*)(mixed + row * D + col) = pack8(a, b); } asm volatile("" ::: "memory"); }
        return u.e == 0; } };
struct EpiF32 { float* C; long ldc;
    __device__ __forceinline__ bool operator()(f32x4 (&acc)[2][2][4][2], const Unit& u, int wr, int wc, int fr, int fq) const {
        MK_FRAG_LOOP(r, c) { float* o = C + (size_t)(u.pm * BM + r) * ldc + u.pn * BM + c; *(f32x4*)o = acc[ai][bj][m][0]; *(f32x4*)(o + 4) = acc[ai][bj][m][1]; }
        return false; } };
}

namespace mk {
constexpr int NEX = NE + 1;
constexpr int SLOTS_PER_TOK = TOPK + 1;
constexpr int RP_MOD = 0;
constexpr int RP_UH = RP_MOD + 3 * D * 4;
constexpr int RP_UL = RP_UH + 16 * (D + 8) * 2;
constexpr int RP_PART = RP_UL + 16 * (D + 8) * 2;
constexpr int RP_LOG = RP_PART + 8 * 16 * 64 * 4;
constexpr int RP_HIST = RP_LOG + 16 * 64 * 4;
constexpr int RP_END = RP_HIST + 64 * 4;
static_assert(RP_END <= LDS_BYTES, "rowpass LDS");

struct RowP { float* y2h1; bf16_t* u; const float* modpart; const bf16_t* rwt;
              int* tope; float* gatev; int* lrank; int* blkcnt; int b0, nlat; };
__device__ __forceinline__ float wave_max(float x) {
#pragma unroll
    for (int o = 32; o > 0; o >>= 1) x = fmaxf(x, __shfl_xor(x, o));
    return x; }
__device__ __forceinline__ void row_pass(LAS unsigned char* lds, const In& in, const RowP p, int row_lo, int row_hi) {
    const int tid = threadIdx.x, lane = tid & 63, wid = tid >> 6;
    LAS float* MOD = (LAS float*)(lds + RP_MOD); LAS bf16_t* UH = (LAS bf16_t*)(lds + RP_UH); LAS bf16_t* UL = (LAS bf16_t*)(lds + RP_UL);
    LAS float* PART = (LAS float*)(lds + RP_PART); LAS float* LOG = (LAS float*)(lds + RP_LOG); LAS int* HIST = (LAS int*)(lds + RP_HIST);
    const int mr = p.b0 + row_lo / SEQ;
    for (int j = tid; j < 3 * D; j += NT) MOD[j] = mod_value(in, p.modpart, mr, 2 * D + j);
    if (tid < 64) HIST[tid] = 0;
    __syncthreads();
    for (int r16 = row_lo; r16 < row_hi; r16 += 16) {
#pragma unroll
        for (int rr = 0; rr < 2; ++rr) {
            const int lr = wid * 2 + rr, r = r16 + lr;
            float* yp = p.y2h1 + (size_t)r * D; const float* xp = in.x + ((size_t)p.b0 * SEQ + r) * D;
            f32x4 v[4]; float ss = 0.f;
#pragma unroll
            for (int j = 0; j < 4; ++j) { v[j] = *(const f32x4*)(yp + j * 256 + lane * 4); ss += v[j][0] * v[j][0] + v[j][1] * v[j][1] + v[j][2] * v[j][2] + v[j][3] * v[j][3]; }
#pragma unroll
            for (int o = 32; o > 0; o >>= 1) ss += __shfl_xor(ss, o);
            const float rinv = 1.f / sqrtf(ss * (1.f / D) + NORM_EPS); float s2 = 0.f;
#pragma unroll
            for (int j = 0; j < 4; ++j) { const int c = j * 256 + lane * 4; const f32x4 xv = *(const f32x4*)(xp + c);
#pragma unroll
                for (int q = 0; q < 4; ++q) { const float hv = xv[q] + MOD[c + q] * (v[j][q] * rinv * in.norm_g[D + c + q]); v[j][q] = hv; s2 += hv * hv; }
                *(f32x4*)(yp + c) = v[j]; }
#pragma unroll
            for (int o = 32; o > 0; o >>= 1) s2 += __shfl_xor(s2, o);
            const float r2 = 1.f / sqrtf(s2 * (1.f / D) + NORM_EPS);
#pragma unroll
            for (int j = 0; j < 4; ++j) { const int c = j * 256 + lane * 4; float uu[4], lo[4]; unsigned hw[2];
#pragma unroll
                for (int q = 0; q < 4; ++q) uu[q] = (v[j][q] * r2 * in.norm_g[2 * D + c + q]) * (1.f + MOD[2 * D + c + q]) + MOD[D + c + q];
                hw[0] = cvt_pk_bf16(uu[0], uu[1]); hw[1] = cvt_pk_bf16(uu[2], uu[3]);
                lo[0] = uu[0] - bflo(hw[0]); lo[1] = uu[1] - bfhi(hw[0]); lo[2] = uu[2] - bflo(hw[1]); lo[3] = uu[3] - bfhi(hw[1]);
                u32x2 w; w.x = hw[0]; w.y = hw[1]; *(u32x2*)(p.u + (size_t)r * D + c) = w; *(LAS u32x2*)(UH + lr * (D + 8) + c) = w;
                u32x2 wl; wl.x = cvt_pk_bf16(lo[0], lo[1]); wl.y = cvt_pk_bf16(lo[2], lo[3]); *(LAS u32x2*)(UL + lr * (D + 8) + c) = wl; }
        }
        __syncthreads();
        { const int fr = lane & 15, fq = lane >> 4;
          f32x4 acc[4];
#pragma unroll
          for (int ct = 0; ct < 4; ++ct) acc[ct] = (f32x4){0.f, 0.f, 0.f, 0.f};
#pragma unroll
          for (int ks = 0; ks < 4; ++ks) { const int k0 = wid * 128 + ks * 32 + fq * 8;
              const bf16x8 ah = *(const LAS bf16x8*)(UH + fr * (D + 8) + k0), al = *(const LAS bf16x8*)(UL + fr * (D + 8) + k0);
#pragma unroll
              for (int ct = 0; ct < 4; ++ct) { const bf16x8 bh = *(const bf16x8*)(p.rwt + (size_t)(ct * 16 + fr) * D + k0), bl = *(const bf16x8*)(p.rwt + (size_t)(NE + ct * 16 + fr) * D + k0);
                  acc[ct] = __builtin_amdgcn_mfma_f32_16x16x32_bf16(ah, bh, acc[ct], 0, 0, 0); acc[ct] = __builtin_amdgcn_mfma_f32_16x16x32_bf16(ah, bl, acc[ct], 0, 0, 0); acc[ct] = __builtin_amdgcn_mfma_f32_16x16x32_bf16(al, bh, acc[ct], 0, 0, 0); } }
#pragma unroll
          for (int ct = 0; ct < 4; ++ct)
#pragma unroll
              for (int i = 0; i < 4; ++i) PART[(wid * 16 + fq * 4 + i) * 64 + ct * 16 + fr] = acc[ct][i]; }
        __syncthreads();
        for (int i = tid; i < 16 * 64; i += NT) { float s = 0.f;
#pragma unroll
            for (int w = 0; w < 8; ++w) s += PART[w * 1024 + i];
            LOG[i] = s; }
        __syncthreads();
#pragma unroll 1
        for (int rr = 0; rr < 2; ++rr) {
            const int lr = wid * 2 + rr, r = r16 + lr;
            const float sc = sigmoidf_(LOG[lr * 64 + lane]), bi = sc + in.router_b[lane];
            float m1 = bi; m1 = fmaxf(m1, __shfl_xor(m1, 1)); m1 = fmaxf(m1, __shfl_xor(m1, 2)); m1 = fmaxf(m1, __shfl_xor(m1, 4));
            const unsigned long long eq = __ballot(bi == m1); const int first = __ffsll((long long)((eq >> (lane & ~7)) & 0xffull)) - 1 + (lane & ~7);
            float m2 = (lane == first) ? -1e30f : bi; m2 = fmaxf(m2, __shfl_xor(m2, 1)); m2 = fmaxf(m2, __shfl_xor(m2, 2)); m2 = fmaxf(m2, __shfl_xor(m2, 4));
            const float gs = m1 + m2; const int myg = lane >> 3; int rank = 0;
#pragma unroll
            for (int g = 0; g < NG; ++g) { const float og = __shfl(gs, g * 8); rank += (og > gs || (og == gs && g < myg)) ? 1 : 0; }
            float cand = rank < TG ? bi : -1e30f; float tsum = 0.f; int myidx = 0; float mysc = 0.f;
#pragma unroll
            for (int it = 0; it < TOPK; ++it) { const float m = wave_max(cand); const unsigned long long bm = __ballot(cand == m); const int win = __ffsll((long long)bm) - 1;
                const float ws = __shfl(sc, win); tsum += ws; if (lane == it) { myidx = win; mysc = ws; } if (lane == win) cand = -1e30f; }
            if (lane < TOPK) { const int rk = atomicAdd((int*)&HIST[myidx], 1);
                p.tope[(size_t)r * TOPK + lane] = myidx; p.gatev[(size_t)r * TOPK + lane] = mysc / tsum * 2.5f; p.lrank[(size_t)r * TOPK + lane] = rk; }
        }
        __syncthreads();
    }
    if (tid < 64) p.blkcnt[blockIdx.x * 64 + tid] = HIST[tid];
}

struct MoeP { const int* tope; const float* gatev; const int* lrank; const int* blkcnt;
              int* tilepre;
              int* list;
              int* sdst;
              float* sgate;
              int r0, nr, blk0, nbh, rpb, pad_; };
__device__ __forceinline__ void moe_assign(LAS unsigned char* lds, const MoeP p, int bid, int nblk) {
    LAS int* BASE = (LAS int*)lds; LAS int* CNT = BASE + 80; LAS int* BOFF = CNT + 80;
    const int tid = threadIdx.x;
    if (tid < NE) { int c = 0, bo = 0; for (int b = 0; b < p.nbh; ++b) { const int v = p.blkcnt[(p.blk0 + b) * 64 + tid]; if (p.blk0 + b < bid) bo += v; c += v; } CNT[tid] = c; BOFF[tid] = bo; }
    __syncthreads();
    if (tid == 0) { int s = 0; for (int e = 0; e < NE; ++e) { BASE[e] = s; s += (CNT[e] + BM - 1) / BM * BM; } BASE[NE] = s; CNT[NE] = p.nr; BASE[NE + 1] = s + p.nr;
        if (bid == 0) { for (int e = 0; e <= NEX; ++e) p.tilepre[e] = BASE[e] / BM; } }
    __syncthreads();
    if (bid >= p.blk0 && bid < p.blk0 + p.nbh) {
        const int rlo = p.r0 + (bid - p.blk0) * p.rpb;
        for (int i = tid; i < p.rpb * TOPK; i += NT) { const int r = rlo + i / TOPK, a = r * TOPK + i % TOPK, e = p.tope[a]; const int slot = BASE[e] + BOFF[e] + p.lrank[a];
            p.list[slot] = r; p.sdst[slot] = (r - p.r0) * SLOTS_PER_TOK + i % TOPK; p.sgate[slot] = p.gatev[a]; }
        for (int i = tid; i < p.rpb; i += NT) { const int r = rlo + i, slot = BASE[NE] + (r - p.r0); p.list[slot] = r; p.sdst[slot] = (r - p.r0) * SLOTS_PER_TOK + TOPK; p.sgate[slot] = 1.f; }
    }
    for (int e = bid; e < NE; e += nblk) { const int lo = BASE[e] + CNT[e], hi = BASE[e + 1]; for (int s = lo + tid; s < hi; s += NT) { p.list[s] = p.r0; p.sdst[s] = -1; p.sgate[s] = 0.f; } }
}
struct GroupOrder { const int* tilepre; int nN, G, c;
    __device__ bool next(int i, Unit& u) const { const long L = (long)i * G + c; const int total = tilepre[NEX] * nN; if (L >= total) return false;
        const int T = (int)(L / nN); int e = 0; while (tilepre[e + 1] <= T) ++e; u.pm = T; u.pn = (int)(L % nN); u.e = e; return true; } };
struct EpiGU { bf16_t* act;
    __device__ __forceinline__ bool operator()(f32x4 (&acc)[2][2][4][2], const Unit& u, int wr, int wc, int fr, int fq) const {
        MK_FRAG_LOOP(r, c) { const f32x4 a = acc[ai][bj][m][0], b = acc[ai][bj][m][1];
            u32x2 w; w.x = cvt_pk_bf16(siluf_(a[0]) * a[1], siluf_(a[2]) * a[3]); w.y = cvt_pk_bf16(siluf_(b[0]) * b[1], siluf_(b[2]) * b[3]);
            *(u32x2*)(act + (size_t)(u.pm * BM + r) * EF + ((u.pn * BM + c) >> 1)) = w; }
        return false; } };
struct EpiDown { const int* sdst; const float* sgate; bf16_t* rowsb;
    __device__ __forceinline__ bool operator()(f32x4 (&acc)[2][2][4][2], const Unit& u, int wr, int wc, int fr, int fq) const {
        MK_FRAG_LOOP(r, c) { const int slot = u.pm * BM + r, dst = sdst[slot]; if (dst >= 0) { const float g = sgate[slot];
            f32x4 a = acc[ai][bj][m][0], b = acc[ai][bj][m][1];
#pragma unroll
            for (int j = 0; j < 4; ++j) { a[j] *= g; b[j] *= g; }
            *(u32x4*)(rowsb + (size_t)dst * D + u.pn * BM + c) = pack8(a, b); } }
        return false; } };
__device__ __forceinline__ void final_rows(LAS float* sm  , const In& in, const float* modpart, const bf16_t* rowsb, float* h1out, int b0, int r0, int row_lo, int row_hi) {
    const int tid = threadIdx.x, lane = tid & 63, wid = tid >> 6;
    const int mr = b0 + row_lo / SEQ;
    __syncthreads();
    for (int j = tid; j < D; j += NT) sm[j] = mod_value(in, modpart, mr, 5 * D + j);
    __syncthreads();
    for (int r = row_lo + wid; r < row_hi; r += NT / 64) {
        float v[16];
#pragma unroll
        for (int j = 0; j < 16; ++j) v[j] = 0.f;
        const bf16_t* rb = rowsb + (size_t)(r - r0) * SLOTS_PER_TOK * D;
#pragma unroll
        for (int s = 0; s < SLOTS_PER_TOK; ++s)
#pragma unroll
            for (int j = 0; j < 4; ++j) { const u32x2 w = *(const u32x2*)(rb + (size_t)s * D + j * 256 + lane * 4); v[4 * j] += bflo(w.x); v[4 * j + 1] += bfhi(w.x); v[4 * j + 2] += bflo(w.y); v[4 * j + 3] += bfhi(w.y); }
        float ss = 0.f;
#pragma unroll
        for (int j = 0; j < 16; ++j) ss += v[j] * v[j];
#pragma unroll
        for (int o = 32; o > 0; o >>= 1) ss += __shfl_xor(ss, o);
        const float rinv = 1.f / sqrtf(ss * (1.f / D) + NORM_EPS);
        float* hp = h1out + (size_t)r * D;
#pragma unroll
        for (int j = 0; j < 4; ++j) { const int c = j * 256 + lane * 4; f32x4 hv = *(const f32x4*)(hp + c);
#pragma unroll
            for (int q = 0; q < 4; ++q) hv[q] += sm[c + q] * (v[4 * j + q] * rinv * in.norm_g[3 * D + c + q]);
            *(f32x4*)(hp + c) = hv; }
    }
}
__device__ __forceinline__ void rwt_prep(const In& in, bf16_t* rwt, int bid, int nblk) {
    for (int i = bid * NT + threadIdx.x; i < NE * D; i += nblk * NT) { const int e = i / D, k = i % D; const float w = in.router_w[(size_t)k * NE + e]; const bf16_t h = f2bf(w); rwt[i] = h; rwt[(size_t)NE * D + i] = f2bf(w - bf2f(h)); }
}
}

#include <hip/hip_cooperative_groups.h>
namespace cg = cooperative_groups;
using namespace mk;
constexpr size_t MiB = (size_t)1 << 20;
constexpr int NLAT = NB * SEQ, NCTXR = NB * CTX, NALL = NLAT + NCTXR, NRH = NLAT / 2, MAXSLOTS = NRH * SLOTS_PER_TOK + NE * BM;
constexpr size_t O_W1A = 0, O_W1C = O_W1A + (size_t)Z1_N * D * 2, O_WG = O_W1C + (size_t)ZC_N * D * 2, O_WBR = O_WG + (size_t)RW * AG_K * 2, O_WOUT = O_WBR + (size_t)2 * D * RW * 2,
                 O_RWT = O_WOUT + (size_t)D * D * 2, O_MODP = O_RWT + (size_t)2 * NE * D * 2, O_S_END = O_MODP + (size_t)MOD_SL * (NB + 1) * 6 * D * 4;
static_assert(O_S_END <= 28 * MiB, "S region");
constexpr size_t O_Z1 = 28 * MiB, O_R2 = O_Z1 + (size_t)NALL * Z1_N * 2;
static_assert(O_R2 == 334 * MiB, "z1 size");
constexpr size_t O_HD = O_R2, O_BON = O_HD + (size_t)2 * NLAT * LW * 2, O_AG = O_BON + (size_t)2 * NLAT * NH * 4, O_R2_END = O_AG + (size_t)NLAT * AG_K * 2;
static_assert(O_R2_END <= 512 * MiB, "R2");
constexpr size_t O_XNL = O_Z1, O_YB = O_XNL + (size_t)NLAT * D * 2, O_GATES = O_YB + (size_t)NLAT * LW * 2, O_MIXED = O_HD;
static_assert(O_GATES + (size_t)NLAT * 2 * D * 2 <= O_R2, "late R1");
constexpr size_t O_U = O_Z1, O_WGU = O_U + (size_t)NLAT * D * 2, O_WDN = O_WGU + (size_t)NEX * 2 * EF * D * 2, O_ROUT = O_WDN + (size_t)NEX * D * EF * 2;
constexpr size_t O_TOPE = O_ROUT, O_LRANK = O_TOPE + (size_t)NLAT * TOPK * 4, O_GATEV = O_LRANK + (size_t)NLAT * TOPK * 4, O_BLKCNT = O_GATEV + (size_t)NLAT * TOPK * 4, O_TILEPRE = O_BLKCNT + 256 * 64 * 4,
                 O_LIST = O_TILEPRE + 1024, O_SDST = O_LIST + (size_t)MAXSLOTS * 4, O_SGATE = O_SDST + (size_t)MAXSLOTS * 4, O_ACT = ((O_SGATE + (size_t)MAXSLOTS * 4 + 255) / 256) * 256,
                 O_ROWSB = ((O_ACT + (size_t)MAXSLOTS * EF * 2 + 255) / 256) * 256, O_END = O_ROWSB + (size_t)NRH * SLOTS_PER_TOK * D * 2;
static_assert(O_END <= 512 * MiB, "workspace");
static_assert(O_WGU >= O_YB && O_ROWSB >= O_GATES, "late layout");

struct MP { In in; float* out; unsigned char* ws; long ph_lo, ph_hi; };
constexpr int NPHASE = 17;

__global__ void __launch_bounds__(512, 2) mega(MP P) {
    extern __shared__ __attribute__((aligned(16))) unsigned char shm[];
    LAS unsigned char* lds = (LAS unsigned char*)shm;
    const In& in = P.in; unsigned char* ws = P.ws; const int bid = blockIdx.x, nblk = gridDim.x;
    bf16_t *W1a = (bf16_t*)(ws + O_W1A), *W1c = (bf16_t*)(ws + O_W1C), *Wg = (bf16_t*)(ws + O_WG), *Wbr = (bf16_t*)(ws + O_WBR), *Wout = (bf16_t*)(ws + O_WOUT), *rwt = (bf16_t*)(ws + O_RWT);
    float* modpart = (float*)(ws + O_MODP);
    bf16_t *z1 = (bf16_t*)(ws + O_Z1), *Hd = (bf16_t*)(ws + O_HD), *Ag = (bf16_t*)(ws + O_AG); float* bon = (float*)(ws + O_BON);
    bf16_t *xnl = (bf16_t*)(ws + O_XNL), *yb = (bf16_t*)(ws + O_YB), *gates = (bf16_t*)(ws + O_GATES), *mixed = (bf16_t*)(ws + O_MIXED);
    bf16_t *u = (bf16_t*)(ws + O_U), *Wgu = (bf16_t*)(ws + O_WGU), *Wdn = (bf16_t*)(ws + O_WDN), *act = (bf16_t*)(ws + O_ACT), *rowsb = (bf16_t*)(ws + O_ROWSB);
    int *tope = (int*)(ws + O_TOPE), *lrank = (int*)(ws + O_LRANK), *blkcnt = (int*)(ws + O_BLKCNT), *tilepre = (int*)(ws + O_TILEPRE), *list = (int*)(ws + O_LIST), *sdst = (int*)(ws + O_SDST);
    float *gatev = (float*)(ws + O_GATEV), *sgate = (float*)(ws + O_SGATE);
    bf16_t* xn_all = (bf16_t*)P.out;
    bf16_t* Y = (bf16_t*)P.out;
    float* y2h1 = P.out;
    const int ph_lo = (int)P.ph_lo, ph_hi = (int)P.ph_hi;
    if (0 >= ph_lo && 0 < ph_hi) { if (0 > ph_lo) cg::this_grid().sync(); const int ph = 0; (void)ph;
        { LAS float* tile = (LAS float*)lds; int base = 0;
            convT_job(tile, in.w_in, INC, D, W1a, D, Z1_N, CMapZ1{}, bid, nblk, base);
            convT_job(tile, in.w_in, INC, D, W1c, D, ZC_N, CMapZC{}, bid, nblk, base);
            convT_job(tile, in.rw_g_up, RW, GL, Wg, AG_K, RW, CMapId{}, bid, nblk, base);
            convT_job(tile, in.w_branch_a, D, RW, Wbr, RW, D, CMapId{}, bid, nblk, base);
            convT_job(tile, in.w_branch_b, D, LW, Wbr + (size_t)D * RW, LW, D, CMapId{}, bid, nblk, base);
            convT_job(tile, in.w_out, D, D, Wout, D, D, CMapId{}, bid, nblk, base);
            rwt_prep(in, rwt, bid, nblk);
            mod_partials((LAS float*)lds, in, modpart, bid, nblk); }
    }
    if (1 >= ph_lo && 1 < ph_hi) { if (1 > ph_lo) cg::this_grid().sync(); const int ph = 1; (void)ph;
        { const int L = NLAT / nblk, Lc = NCTXR / nblk;
            xn_rows((LAS float*)lds, in, modpart, xn_all, 0, NB, bid * L, (bid + 1) * L);
            xn_rows((LAS float*)lds, in, modpart, xn_all, 0, NB, NLAT + bid * Lc, NLAT + (bid + 1) * Lc); }
    }
    if (2 >= ph_lo && 2 < ph_hi) { if (2 > ph_lo) cg::this_grid().sync(); const int ph = 2; (void)ph;
        { GemmP g{xn_all, xn_all, W1a, 0, nullptr, D, 0}; StaticOrder S; S.init(NALL, Z1_N, nblk, bid); gemm_phase(lds, g, S, EpiStoreBf16{z1, Z1_N}); }
    }
    if (3 >= ph_lo && 3 < ph_hi) { if (3 > ph_lo) cg::this_grid().sync(); const int ph = 3; (void)ph;
        { LruP lp{z1, Hd, 0, NB}; lru_phase(lds, in, lp, bid, nblk); __syncthreads();
                  RwkvP rp{z1, Y, bon, 0, NB}; rwkv_phase(lds, in, rp, bid, nblk); }
    }
    if (4 >= ph_lo && 4 < ph_hi) { if (4 > ph_lo) cg::this_grid().sync(); const int ph = 4; (void)ph;
        { const int L = NLAT / nblk; PostP pp{z1, Y, bon, Ag, NLAT, 0}; rwkv_post_rows(in, pp, bid * L, (bid + 1) * L); }
    }
    if (5 >= ph_lo && 5 < ph_hi) { if (5 > ph_lo) cg::this_grid().sync(); const int ph = 5; (void)ph;
        { const int L = NLAT / nblk; xn_rows((LAS float*)lds, in, modpart, xnl, 0, NB, bid * L, (bid + 1) * L); __syncthreads();
                  GemmP g{Ag, Ag, Wg, 0, nullptr, AG_K, 0}; StaticOrder S; S.init(NLAT, RW, nblk, bid); gemm_phase(lds, g, S, EpiYa{Y, Y + (size_t)NLAT * RW}); }
    }
    if (6 >= ph_lo && 6 < ph_hi) { if (6 > ph_lo) cg::this_grid().sync(); const int ph = 6; (void)ph;
        { GemmP g{xnl, xnl, W1c, 0, nullptr, D, 0}; StaticOrder S; S.init(NLAT, ZC_N, nblk, bid); gemm_phase(lds, g, S, EpiZc{Hd, yb, gates, NLAT, 0}); }
    }
    if (7 >= ph_lo && 7 < ph_hi) { if (7 > ph_lo) cg::this_grid().sync(); const int ph = 7; (void)ph;
        { GemmP g{Y + (size_t)NLAT * RW, yb, Wbr, (long)D * RW, nullptr, D, 0}; PairOrder S; S.S.init(NLAT, D, nblk, bid); gemm_phase(lds, g, S, EpiBranch{gates, mixed}); }
    }
    if (8 >= ph_lo && 8 < ph_hi) { if (8 > ph_lo) cg::this_grid().sync(); const int ph = 8; (void)ph;
        { LAS float* tile = (LAS float*)lds; int base = 0;
            for (int e = 0; e < NE; ++e) {
                convT_job(tile, in.ex_w_gu + (size_t)e * D * 2 * EF, 2 * EF, D, Wgu + (size_t)e * 2 * EF * D, D, 2 * EF, CMapGU{EF}, bid, nblk, base);
                convT_job(tile, in.ex_w_down + (size_t)e * EF * D, D, EF, Wdn + (size_t)e * D * EF, EF, D, CMapId{}, bid, nblk, base); }
            convT_job(tile, in.sh_w_gu, 2 * SF, D, Wgu + (size_t)NE * 2 * EF * D, D, 2 * SF, CMapGU{SF}, bid, nblk, base);
            convT_job(tile, in.sh_w_down, D, SF, Wdn + (size_t)NE * D * EF, SF, D, CMapId{}, bid, nblk, base);
            __syncthreads();
            GemmP g{mixed, mixed, Wout, 0, nullptr, D, 0}; StaticOrder S; S.init(NLAT, D, nblk, bid); gemm_phase(lds, g, S, EpiF32{y2h1, D}); }
    }
    if (9 >= ph_lo && 9 < ph_hi) { if (9 > ph_lo) cg::this_grid().sync(); const int ph = 9; (void)ph;
        { const int L = NLAT / nblk; RowP rp{y2h1, u, modpart, rwt, tope, gatev, lrank, blkcnt, 0, NLAT}; row_pass(lds, in, rp, bid * L, (bid + 1) * L); }
    }
    if (10 >= ph_lo && 10 < ph_hi) { if (10 > ph_lo) cg::this_grid().sync(); const int ph = 10; (void)ph;
        { const int q = ph - 10, half = q >= 4 ? 1 : 0, st = q - 4 * half;
            const int rpb = NLAT / nblk;
            auto assign = [&](int hf) { MoeP mp{tope, gatev, lrank, blkcnt, tilepre, list, sdst, sgate, hf * NRH, NRH, hf * (nblk / 2), nblk / 2, rpb, 0}; moe_assign(lds, mp, bid, nblk); };
            auto fin = [&](int hf) { const int L = NRH / nblk, r0 = hf * NRH; final_rows((LAS float*)lds, in, modpart, rowsb, y2h1, 0, r0, r0 + bid * L, r0 + (bid + 1) * L); };
            if (ph == 10) assign(0);
            else if (ph == 11 || ph == 14) { GemmP g{u, u, Wgu, (long)2 * EF * D, list, D, 0}; GroupOrder S{tilepre, 2 * EF / BM, nblk, bid}; gemm_phase(lds, g, S, EpiGU{act}); }
            else if (ph == 12 || ph == 15) { GemmP g{act, act, Wdn, (long)D * EF, nullptr, EF, 0}; GroupOrder S{tilepre, D / BM, nblk, bid}; gemm_phase(lds, g, S, EpiDown{sdst, sgate, rowsb}); }
            else if (ph == 13) { fin(0); __syncthreads(); assign(1); }
            else if (ph == 16) fin(1);
            (void)half; (void)st; }
    }
    if (11 >= ph_lo && 11 < ph_hi) { if (11 > ph_lo) cg::this_grid().sync(); const int ph = 11; (void)ph;
        { const int q = ph - 10, half = q >= 4 ? 1 : 0, st = q - 4 * half;
            const int rpb = NLAT / nblk;
            auto assign = [&](int hf) { MoeP mp{tope, gatev, lrank, blkcnt, tilepre, list, sdst, sgate, hf * NRH, NRH, hf * (nblk / 2), nblk / 2, rpb, 0}; moe_assign(lds, mp, bid, nblk); };
            auto fin = [&](int hf) { const int L = NRH / nblk, r0 = hf * NRH; final_rows((LAS float*)lds, in, modpart, rowsb, y2h1, 0, r0, r0 + bid * L, r0 + (bid + 1) * L); };
            if (ph == 10) assign(0);
            else if (ph == 11 || ph == 14) { GemmP g{u, u, Wgu, (long)2 * EF * D, list, D, 0}; GroupOrder S{tilepre, 2 * EF / BM, nblk, bid}; gemm_phase(lds, g, S, EpiGU{act}); }
            else if (ph == 12 || ph == 15) { GemmP g{act, act, Wdn, (long)D * EF, nullptr, EF, 0}; GroupOrder S{tilepre, D / BM, nblk, bid}; gemm_phase(lds, g, S, EpiDown{sdst, sgate, rowsb}); }
            else if (ph == 13) { fin(0); __syncthreads(); assign(1); }
            else if (ph == 16) fin(1);
            (void)half; (void)st; }
    }
    if (12 >= ph_lo && 12 < ph_hi) { if (12 > ph_lo) cg::this_grid().sync(); const int ph = 12; (void)ph;
        { const int q = ph - 10, half = q >= 4 ? 1 : 0, st = q - 4 * half;
            const int rpb = NLAT / nblk;
            auto assign = [&](int hf) { MoeP mp{tope, gatev, lrank, blkcnt, tilepre, list, sdst, sgate, hf * NRH, NRH, hf * (nblk / 2), nblk / 2, rpb, 0}; moe_assign(lds, mp, bid, nblk); };
            auto fin = [&](int hf) { const int L = NRH / nblk, r0 = hf * NRH; final_rows((LAS float*)lds, in, modpart, rowsb, y2h1, 0, r0, r0 + bid * L, r0 + (bid + 1) * L); };
            if (ph == 10) assign(0);
            else if (ph == 11 || ph == 14) { GemmP g{u, u, Wgu, (long)2 * EF * D, list, D, 0}; GroupOrder S{tilepre, 2 * EF / BM, nblk, bid}; gemm_phase(lds, g, S, EpiGU{act}); }
            else if (ph == 12 || ph == 15) { GemmP g{act, act, Wdn, (long)D * EF, nullptr, EF, 0}; GroupOrder S{tilepre, D / BM, nblk, bid}; gemm_phase(lds, g, S, EpiDown{sdst, sgate, rowsb}); }
            else if (ph == 13) { fin(0); __syncthreads(); assign(1); }
            else if (ph == 16) fin(1);
            (void)half; (void)st; }
    }
    if (13 >= ph_lo && 13 < ph_hi) { if (13 > ph_lo) cg::this_grid().sync(); const int ph = 13; (void)ph;
        { const int q = ph - 10, half = q >= 4 ? 1 : 0, st = q - 4 * half;
            const int rpb = NLAT / nblk;
            auto assign = [&](int hf) { MoeP mp{tope, gatev, lrank, blkcnt, tilepre, list, sdst, sgate, hf * NRH, NRH, hf * (nblk / 2), nblk / 2, rpb, 0}; moe_assign(lds, mp, bid, nblk); };
            auto fin = [&](int hf) { const int L = NRH / nblk, r0 = hf * NRH; final_rows((LAS float*)lds, in, modpart, rowsb, y2h1, 0, r0, r0 + bid * L, r0 + (bid + 1) * L); };
            if (ph == 10) assign(0);
            else if (ph == 11 || ph == 14) { GemmP g{u, u, Wgu, (long)2 * EF * D, list, D, 0}; GroupOrder S{tilepre, 2 * EF / BM, nblk, bid}; gemm_phase(lds, g, S, EpiGU{act}); }
            else if (ph == 12 || ph == 15) { GemmP g{act, act, Wdn, (long)D * EF, nullptr, EF, 0}; GroupOrder S{tilepre, D / BM, nblk, bid}; gemm_phase(lds, g, S, EpiDown{sdst, sgate, rowsb}); }
            else if (ph == 13) { fin(0); __syncthreads(); assign(1); }
            else if (ph == 16) fin(1);
            (void)half; (void)st; }
    }
    if (14 >= ph_lo && 14 < ph_hi) { if (14 > ph_lo) cg::this_grid().sync(); const int ph = 14; (void)ph;
        { const int q = ph - 10, half = q >= 4 ? 1 : 0, st = q - 4 * half;
            const int rpb = NLAT / nblk;
            auto assign = [&](int hf) { MoeP mp{tope, gatev, lrank, blkcnt, tilepre, list, sdst, sgate, hf * NRH, NRH, hf * (nblk / 2), nblk / 2, rpb, 0}; moe_assign(lds, mp, bid, nblk); };
            auto fin = [&](int hf) { const int L = NRH / nblk, r0 = hf * NRH; final_rows((LAS float*)lds, in, modpart, rowsb, y2h1, 0, r0, r0 + bid * L, r0 + (bid + 1) * L); };
            if (ph == 10) assign(0);
            else if (ph == 11 || ph == 14) { GemmP g{u, u, Wgu, (long)2 * EF * D, list, D, 0}; GroupOrder S{tilepre, 2 * EF / BM, nblk, bid}; gemm_phase(lds, g, S, EpiGU{act}); }
            else if (ph == 12 || ph == 15) { GemmP g{act, act, Wdn, (long)D * EF, nullptr, EF, 0}; GroupOrder S{tilepre, D / BM, nblk, bid}; gemm_phase(lds, g, S, EpiDown{sdst, sgate, rowsb}); }
            else if (ph == 13) { fin(0); __syncthreads(); assign(1); }
            else if (ph == 16) fin(1);
            (void)half; (void)st; }
    }
    if (15 >= ph_lo && 15 < ph_hi) { if (15 > ph_lo) cg::this_grid().sync(); const int ph = 15; (void)ph;
        { const int q = ph - 10, half = q >= 4 ? 1 : 0, st = q - 4 * half;
            const int rpb = NLAT / nblk;
            auto assign = [&](int hf) { MoeP mp{tope, gatev, lrank, blkcnt, tilepre, list, sdst, sgate, hf * NRH, NRH, hf * (nblk / 2), nblk / 2, rpb, 0}; moe_assign(lds, mp, bid, nblk); };
            auto fin = [&](int hf) { const int L = NRH / nblk, r0 = hf * NRH; final_rows((LAS float*)lds, in, modpart, rowsb, y2h1, 0, r0, r0 + bid * L, r0 + (bid + 1) * L); };
            if (ph == 10) assign(0);
            else if (ph == 11 || ph == 14) { GemmP g{u, u, Wgu, (long)2 * EF * D, list, D, 0}; GroupOrder S{tilepre, 2 * EF / BM, nblk, bid}; gemm_phase(lds, g, S, EpiGU{act}); }
            else if (ph == 12 || ph == 15) { GemmP g{act, act, Wdn, (long)D * EF, nullptr, EF, 0}; GroupOrder S{tilepre, D / BM, nblk, bid}; gemm_phase(lds, g, S, EpiDown{sdst, sgate, rowsb}); }
            else if (ph == 13) { fin(0); __syncthreads(); assign(1); }
            else if (ph == 16) fin(1);
            (void)half; (void)st; }
    }
    if (16 >= ph_lo && 16 < ph_hi) { if (16 > ph_lo) cg::this_grid().sync(); const int ph = 16; (void)ph;
        { const int q = ph - 10, half = q >= 4 ? 1 : 0, st = q - 4 * half;
            const int rpb = NLAT / nblk;
            auto assign = [&](int hf) { MoeP mp{tope, gatev, lrank, blkcnt, tilepre, list, sdst, sgate, hf * NRH, NRH, hf * (nblk / 2), nblk / 2, rpb, 0}; moe_assign(lds, mp, bid, nblk); };
            auto fin = [&](int hf) { const int L = NRH / nblk, r0 = hf * NRH; final_rows((LAS float*)lds, in, modpart, rowsb, y2h1, 0, r0, r0 + bid * L, r0 + (bid + 1) * L); };
            if (ph == 10) assign(0);
            else if (ph == 11 || ph == 14) { GemmP g{u, u, Wgu, (long)2 * EF * D, list, D, 0}; GroupOrder S{tilepre, 2 * EF / BM, nblk, bid}; gemm_phase(lds, g, S, EpiGU{act}); }
            else if (ph == 12 || ph == 15) { GemmP g{act, act, Wdn, (long)D * EF, nullptr, EF, 0}; GroupOrder S{tilepre, D / BM, nblk, bid}; gemm_phase(lds, g, S, EpiDown{sdst, sgate, rowsb}); }
            else if (ph == 13) { fin(0); __syncthreads(); assign(1); }
            else if (ph == 16) fin(1);
            (void)half; (void)st; }
    }
}
extern "C" void kernel_launch(void* const* d_in, const int* in_sizes, int n_in, void* d_out, int out_size, void* d_ws, size_t ws_size, hipStream_t stream) {
    static int grid = 0;
    if (grid == 0) {
        int dev = 0, cus = 0; hipGetDevice(&dev); hipDeviceGetAttribute(&cus, hipDeviceAttributeMultiprocessorCount, dev);
        hipFuncSetAttribute((const void*)mega, hipFuncAttributeMaxDynamicSharedMemorySize, LDS_BYTES);
        grid = cus;
        if (ws_size < O_END || grid != 256) fprintf(stderr, "kernel_launch: unexpected ws_size %zu (need %zu) or CU count %d\n", ws_size, (size_t)O_END, grid);
    }
    MP P; memset(&P, 0, sizeof(P));
    const float** f = (const float**)&P.in; for (int i = 0; i < 32; ++i) f[i] = (const float*)d_in[i];
    P.out = (float*)d_out; P.ws = (unsigned char*)d_ws;
#ifdef MK_PER_PHASE
    for (int ph = 0; ph < NPHASE; ++ph) { P.ph_lo = ph; P.ph_hi = ph + 1; hipLaunchKernelGGL(mega, dim3(grid), dim3(NT), LDS_BYTES, stream, P); }
#else
    P.ph_lo = 0; P.ph_hi = NPHASE;
    void* args[] = {&P};
    hipError_t e = hipLaunchCooperativeKernel((void*)mega, dim3(grid), dim3(NT), args, LDS_BYTES, stream);
    if (e != hipSuccess) fprintf(stderr, "cooperative launch failed: %s (grid %d)\n", hipGetErrorString(e), grid);
#endif
}
```

```cpp
#include <hip/hip_runtime.h>
#include <cstdio>
#include <cstring>
#define HD __host__ __device__ __forceinline__
static hipStream_t g_stream;

#ifdef SMALL
constexpr int D = 128, NB = 2, SEQ = 64, GW = 8, CTX = 16, RW = 128, RH = 64, DL = 16, AL = 16, GL = 24, LW = 128, LB = 2, NE = 8, TOPK = 3, NG = 4, TG = 2, EF = 32, SF = 32;
#else
constexpr int D = 1024, NB = 8, SEQ = 4096, GW = 64, CTX = 256, RW = 1024, RH = 64, DL = 64, AL = 64, GL = 160, LW = 1024, LB = 16, NE = 64, TOPK = 6, NG = 8, TG = 4, EF = 256, SF = 256;
#endif
constexpr int NH = RW / RH, LBS = LW / LB, ROWS = SEQ / GW, TA = CTX + SEQ;
constexpr int OFF_R = 0, OFF_K = RW, OFF_V = 2 * RW, OFF_WD = 3 * RW, OFF_AD = OFF_WD + 2 * DL, OFF_GD = OFF_AD + 2 * AL, RC = OFF_GD + GL;
constexpr int OFF_LX = RC, OFF_LG = OFF_LX + LW, OFF_GATE = OFF_LG + LW, INC = OFF_GATE + 2 * D;
constexpr int EPG = NE / NG, NASG = SEQ * TOPK;
#define NORM_EPS 1e-6f
#define LNX_EPS 64e-5f

HD float sigmoidf_(float x) { return 1.f / (1.f + expf(-x)); }
HD float softplusf_(float x) { return x > 20.f ? x : log1pf(expf(x)); }
HD float siluf_(float x) { return x * sigmoidf_(x); }
HD float gelu_tanhf_(float x) { return 0.5f * x * (1.f + tanhf(0.7978845608028654f * (x + 0.044715f * x * x * x))); }

struct In {
    const float *x, *c, *ctx, *c_ctx, *w_mod, *b_mod, *norm_g, *w_in, *shift_mu, *rw_w0, *rw_w_up, *rw_a0, *rw_a_up, *rw_g_up, *rw_k_k, *rw_k_a, *rw_r_k, *rw_lnx,
        *lru_conv_w, *lru_conv_b, *lru_gate_w, *lru_gate_b, *lru_l, *w_branch_a, *w_branch_b, *w_out, *router_w, *router_b, *ex_w_gu, *ex_w_down, *sh_w_gu, *sh_w_down;
};


namespace mk {
#define LAS __attribute__((address_space(3)))
typedef unsigned short bf16_t;
typedef short bf16x8 __attribute__((ext_vector_type(8)));
typedef float f32x4 __attribute__((ext_vector_type(4)));
typedef float f32x2 __attribute__((ext_vector_type(2)));
typedef unsigned u32x4 __attribute__((ext_vector_type(4)));
typedef unsigned u32x2 __attribute__((ext_vector_type(2)));
constexpr int NT = 512;
constexpr int BM = 256, BK = 64, HALF = 128, HTB = HALF * BK * 2, STAGE_BYTES = 8 * HTB;
constexpr int LDS_BYTES = 160 * 1024 - 1024;

constexpr int Z1_LX = 3584, Z1_N = 4608;
constexpr int ZC_N = 3072;

__device__ __forceinline__ unsigned cvt_pk_bf16(float lo, float hi) { unsigned r; asm volatile("v_cvt_pk_bf16_f32 %0, %1, %2" : "=v"(r) : "v"(lo), "v"(hi)); return r; }
__device__ __forceinline__ bf16_t f2bf(float f) { unsigned u = __float_as_uint(f); u += 0x7FFFu + ((u >> 16) & 1u); return (bf16_t)(u >> 16); }
__device__ __forceinline__ float bf2f(bf16_t b) { return __uint_as_float(((unsigned)b) << 16); }
__device__ __forceinline__ float bflo(unsigned w) { return __uint_as_float(w << 16); }
__device__ __forceinline__ float bfhi(unsigned w) { return __uint_as_float(w & 0xffff0000u); }

__device__ __forceinline__ float fast_rcp(float x) { return __builtin_amdgcn_rcpf(x); }
__device__ __forceinline__ float fast_sigmoid(float x) { return fast_rcp(1.f + __expf(-x)); }
__device__ __forceinline__ float fast_tanh(float x) { return 1.f - 2.f * fast_rcp(1.f + __expf(2.f * x)); }
__device__ __forceinline__ float fast_softplus(float x) { return x > 15.f ? x : __logf(1.f + __expf(x)); }
__device__ __forceinline__ float fast_silu(float x) { return x * fast_sigmoid(x); }
__device__ __forceinline__ float fast_gelu_tanh(float x) { return x * fast_sigmoid(1.5957691216057308f * (x + 0.044715f * x * x * x)); }
__device__ __forceinline__ int lds_byte(int r, int c) { const int st = (r >> 4) * 2 + (c >> 5), rr = r & 15, cc = c & 31, ob = rr * 64 + cc * 2; return st * 1024 + (ob ^ (((ob >> 9) & 1) << 5)); }
__device__ __forceinline__ void stage_rc(int b, int& R, int& C) { const int st = b / 1024, sb = b % 1024, swz = sb ^ (((sb >> 9) & 1) << 5); R = (st >> 1) * 16 + swz / 64; C = (st & 1) * 32 + (swz % 64) / 2; }
__device__ __forceinline__ int perm32(int rho) { const int n = rho >> 4, i = rho & 15; return 8 * (i >> 2) + 4 * n + (i & 3); }

struct Unit { int pm, pn, e; };
struct GemmP { const bf16_t* A0; const bf16_t* A1; const bf16_t* Bt; long strideB; const int* gather; int K; int pad_; };

struct StaticOrder {
    int nM, nN, nwg, G, c;
    __device__ void init(int M, int N, int G_, int c_) { nM = M / BM; nN = N / BM; nwg = nM * nN; G = G_; c = c_; }
    __device__ bool next(int i, Unit& u) const {
        const long L = (long)i * G + c; if (L >= nwg) return false;
        int wgid = (int)L; { const int q = nwg / 8, r = nwg % 8, xcd = wgid % 8, off = wgid / 8; wgid = (xcd < r ? xcd * (q + 1) : r * (q + 1) + (xcd - r) * q) + off; }
        const int nig = 8 * nN, gid = wgid / nig, fm = gid * 8, gsz = (nM - fm) < 8 ? (nM - fm) : 8;
        u.pm = fm + ((wgid % nig) % gsz); u.pn = (wgid % nig) / gsz; u.e = 0; return true;
    }
};

#define MK_FRAG_LOOP(ROW, COL) \
    _Pragma("unroll") for (int ai = 0; ai < 2; ++ai) _Pragma("unroll") for (int m = 0; m < 4; ++m) _Pragma("unroll") for (int bj = 0; bj < 2; ++bj) \
        if (const int ROW = ai * HALF + wr * 64 + m * 16 + fr; true) if (const int COL = bj * HALF + wc * 32 + 8 * fq; true)

template <class Epi, class Sched>
__device__ __forceinline__ void gemm_phase(LAS unsigned char* lds, const GemmP g, const Sched& S, const Epi& E) {
    const int tid = threadIdx.x, wid = __builtin_amdgcn_readfirstlane(tid >> 6), lane = tid & 63, wr = wid >> 2, wc = wid & 3, fr = lane & 15, fq = lane >> 4;
    int K = g.K; asm volatile("" : "+s"(K));
    const int nt = K / BK;
    int RA[2], CA[2]; unsigned voffB[2];
#pragma unroll
    for (int i = 0; i < 2; ++i) { int R, C; stage_rc(tid * 16 + i * 8192, R, C); RA[i] = R; CA[i] = C; const int Rb = (R & ~31) + perm32(R & 31); voffB[i] = (unsigned)(Rb * K + C) * 2u; }
    const size_t kstep = (size_t)(BK * 2), hstepB = (size_t)HALF * K * 2, tstepB = 2 * hstepB;
    const unsigned ldsw = (unsigned)wid * 1024u;
    const int aoff = lds_byte(wr * 64 + fr, fq * 8), boff = lds_byte(wc * 32 + fr, fq * 8);
#define MK_SA(b, h) (((b) * 2 + (h)) * HTB)
#define MK_SB(b, h) ((4 + (b) * 2 + (h)) * HTB)
#define MK_STAGE(bufoff, gbase, voff) do { _Pragma("unroll") for (int _i = 0; _i < 2; ++_i) \
        __builtin_amdgcn_global_load_lds((const unsigned*)((const char*)(gbase) + (voff)[_i]), (LAS unsigned*)(lds + (bufoff) + ldsw + _i * 8192), 16, 0, 0); } while (0)
#define MK_LDA(dst, b, h) do { _Pragma("unroll") for (int m = 0; m < 4; ++m) _Pragma("unroll") for (int k = 0; k < 2; ++k) dst[m][k] = *(const LAS bf16x8*)(lds + MK_SA(b, h) + aoff + m * 2048 + k * 1024); } while (0)
#define MK_LDB(dst, b, h) do { _Pragma("unroll") for (int n = 0; n < 2; ++n) _Pragma("unroll") for (int k = 0; k < 2; ++k) dst[n][k] = *(const LAS bf16x8*)(lds + MK_SB(b, h) + boff + n * 2048 + k * 1024); } while (0)
#define MK_MMA(ai, bj, At, Bt) do { __builtin_amdgcn_s_setprio(1); _Pragma("unroll") for (int m = 0; m < 4; ++m) _Pragma("unroll") for (int n = 0; n < 2; ++n) _Pragma("unroll") for (int k = 0; k < 2; ++k) \
        acc[ai][bj][m][n] = __builtin_amdgcn_mfma_f32_16x16x32_bf16(Bt[n][k], At[m][k], acc[ai][bj][m][n], 0, 0, 0); __builtin_amdgcn_s_setprio(0); } while (0)
#define MK_WAIT_V(n) asm volatile("s_waitcnt vmcnt(" #n ")" ::: "memory")
#define MK_WAIT_L(n) asm volatile("s_waitcnt lgkmcnt(" #n ")" ::: "memory")
#define MK_BAR __builtin_amdgcn_s_barrier()
#define MK_SCHED __builtin_amdgcn_sched_barrier(0)
    Unit cur, nxt; int ui = 0;
    if (!S.next(0, cur)) return;
    f32x4 acc[2][2][4][2];
#pragma unroll
    for (int a = 0; a < 2; ++a)
#pragma unroll
        for (int b = 0; b < 2; ++b)
#pragma unroll
            for (int m = 0; m < 4; ++m)
#pragma unroll
                for (int n = 0; n < 2; ++n) acc[a][b][m][n] = (f32x4){0.f, 0.f, 0.f, 0.f};
    bf16x8 At[4][2], B0[2][2], B1[2][2];
    unsigned vA[2][2], vAn[2][2];
    auto a_voff = [&](const Unit& u, unsigned (&vo)[2][2]) {
#pragma unroll
        for (int h = 0; h < 2; ++h)
#pragma unroll
            for (int i = 0; i < 2; ++i) { const int row = u.pm * BM + h * HALF + RA[i]; const int arow = g.gather ? g.gather[row] : row; vo[h][i] = (unsigned)((size_t)arow * K + CA[i]) * 2u; }
    };
    a_voff(cur, vA);
    const char* cA = (const char*)(cur.e ? g.A1 : g.A0);
    const char* cB = (const char*)g.Bt + ((size_t)cur.e * g.strideB) * 2 + (size_t)cur.pn * tstepB;
    MK_STAGE(MK_SB(0, 0), cB, voffB); MK_STAGE(MK_SA(0, 0), cA, vA[0]); MK_STAGE(MK_SB(0, 1), cB + hstepB, voffB); MK_STAGE(MK_SA(0, 1), cA, vA[1]);
    if (wr == 1) MK_BAR;
    MK_WAIT_V(4); MK_BAR;
    MK_STAGE(MK_SB(1, 0), cB + kstep, voffB); MK_STAGE(MK_SA(1, 0), cA + kstep, vA[0]); MK_STAGE(MK_SB(1, 1), cB + hstepB + kstep, voffB);
    MK_WAIT_V(6); MK_BAR;
    for (;;) {
        const bool has_next = S.next(ui + 1, nxt);
        const char* nA = has_next ? (const char*)(nxt.e ? g.A1 : g.A0) : cA;
        const char* nB = has_next ? (const char*)g.Bt + ((size_t)nxt.e * g.strideB) * 2 + (size_t)nxt.pn * tstepB : cB;
        for (int t = 0; t < nt; t += 2) {
            const bool last = (t == nt - 2);
            if (last) { if (has_next) a_voff(nxt, vAn); else {
#pragma unroll
                for (int h = 0; h < 2; ++h)
#pragma unroll
                    for (int i = 0; i < 2; ++i) vAn[h][i] = vA[h][i]; } }
            const char* a1 = cA + (size_t)(t + 1) * kstep;
            const char* a2 = last ? nA : cA + (size_t)(t + 2) * kstep; const char* b2 = last ? nB : cB + (size_t)(t + 2) * kstep;
            const char* a3 = a2 + kstep; const char* b3 = b2 + kstep;
            unsigned v2[2][2];
#pragma unroll
            for (int h = 0; h < 2; ++h)
#pragma unroll
                for (int i = 0; i < 2; ++i) v2[h][i] = last ? vAn[h][i] : vA[h][i];
            MK_LDB(B0, 0, 0); MK_SCHED; MK_LDA(At, 0, 0); MK_STAGE(MK_SA(1, 1), a1, vA[1]);
            MK_WAIT_L(8); MK_BAR; MK_WAIT_L(0); MK_MMA(0, 0, At, B0); MK_BAR; MK_SCHED;
            MK_LDB(B1, 0, 1); MK_STAGE(MK_SB(0, 0), b2, voffB);
            MK_BAR; MK_WAIT_L(0); MK_MMA(0, 1, At, B1); MK_BAR;
            MK_LDA(At, 0, 1); MK_STAGE(MK_SA(0, 0), a2, v2[0]);
            MK_BAR; MK_WAIT_L(0); MK_MMA(1, 0, At, B0); MK_BAR; MK_SCHED;
            MK_STAGE(MK_SB(0, 1), b2 + hstepB, voffB);
            MK_WAIT_V(6); MK_BAR; MK_MMA(1, 1, At, B1); MK_BAR;
            MK_LDB(B0, 1, 0); MK_SCHED; MK_LDA(At, 1, 0); MK_STAGE(MK_SA(0, 1), a2, v2[1]);
            MK_WAIT_L(8); MK_BAR; MK_WAIT_L(0); MK_MMA(0, 0, At, B0); MK_BAR; MK_SCHED;
            MK_LDB(B1, 1, 1); MK_STAGE(MK_SB(1, 0), b3, voffB);
            MK_BAR; MK_WAIT_L(0); MK_MMA(0, 1, At, B1); MK_BAR;
            MK_LDA(At, 1, 1); MK_STAGE(MK_SA(1, 0), a3, v2[0]);
            MK_BAR; MK_WAIT_L(0); MK_MMA(1, 0, At, B0); MK_BAR; MK_SCHED;
            MK_STAGE(MK_SB(1, 1), b3 + hstepB, voffB);
            MK_WAIT_V(6); MK_BAR; MK_MMA(1, 1, At, B1); MK_BAR;
        }
        const bool keep = E(acc, cur, wr, wc, fr, fq);
        if (!has_next) break;
        if (!keep) {
#pragma unroll
            for (int a = 0; a < 2; ++a)
#pragma unroll
                for (int b = 0; b < 2; ++b)
#pragma unroll
                    for (int m = 0; m < 4; ++m)
#pragma unroll
                        for (int n = 0; n < 2; ++n) acc[a][b][m][n] = (f32x4){0.f, 0.f, 0.f, 0.f};
        }
        cur = nxt; cA = nA; cB = nB; ++ui;
#pragma unroll
        for (int h = 0; h < 2; ++h)
#pragma unroll
            for (int i = 0; i < 2; ++i) vA[h][i] = vAn[h][i];
    }
    MK_WAIT_V(0);
    if (wr == 0) MK_BAR;
    MK_BAR;
#undef MK_SA
#undef MK_SB
#undef MK_STAGE
#undef MK_LDA
#undef MK_LDB
#undef MK_MMA
#undef MK_WAIT_V
#undef MK_WAIT_L
#undef MK_BAR
#undef MK_SCHED
}

__device__ __forceinline__ u32x4 pack8(const f32x4 a, const f32x4 b) { u32x4 w; w.x = cvt_pk_bf16(a[0], a[1]); w.y = cvt_pk_bf16(a[2], a[3]); w.z = cvt_pk_bf16(b[0], b[1]); w.w = cvt_pk_bf16(b[2], b[3]); return w; }
struct EpiStoreBf16 {
    bf16_t* O; long ldc;
    __device__ __forceinline__ bool operator()(const f32x4 (&acc)[2][2][4][2], const Unit& u, int wr, int wc, int fr, int fq) const {
        MK_FRAG_LOOP(r, c) { *(u32x4*)(O + (size_t)(u.pm * BM + r) * ldc + u.pn * BM + c) = pack8(acc[ai][bj][m][0], acc[ai][bj][m][1]); }
        return false;
    }
};

struct CMapZ1 { __device__ int operator()(int n) const { return n < RC ? n : (n < Z1_LX ? -1 : OFF_LX + (n - Z1_LX)); } };
struct CMapZC { __device__ int operator()(int n) const { return OFF_LG + n; } };
struct CMapId { __device__ int operator()(int n) const { return n; } };
struct CMapGU { int F; __device__ int operator()(int n) const { return (n & 1) * F + (n >> 1); } };
template <class CM>
__device__ __forceinline__ void convT_tile(LAS float* tile  , const float* src, int lds_, int Ks, bf16_t* dst, int Kd, int n0, int k0, const CM& cm) {
    const int tid = threadIdx.x;
    { const int kk = tid >> 3, nn8 = (tid & 7) * 8; const int k = k0 + kk;
#pragma unroll
      for (int j = 0; j < 8; ++j) { const int sc = cm(n0 + nn8 + j); tile[kk * 65 + nn8 + j] = (k < Ks && sc >= 0) ? src[(size_t)k * lds_ + sc] : 0.f; } }
    __syncthreads();
    { const int nn = tid >> 3, kk8 = (tid & 7) * 8; f32x4 a, b;
#pragma unroll
      for (int j = 0; j < 4; ++j) { a[j] = tile[(kk8 + j) * 65 + nn]; b[j] = tile[(kk8 + 4 + j) * 65 + nn]; }
      *(u32x4*)(dst + (size_t)(n0 + nn) * Kd + k0 + kk8) = pack8(a, b); }
    __syncthreads();
}
template <class CM>
__device__ __forceinline__ void convT_job(LAS float* tile, const float* src, int lds_, int Ks, bf16_t* dst, int Kd, int N, const CM& cm, int bid, int nblk, int& base) {
    const int tn = N / 64, tk = Kd / 64, nt = tn * tk;
    int first = (bid - base % nblk + nblk) % nblk;
    for (int t = first; t < nt; t += nblk) convT_tile(tile, src, lds_, Ks, dst, Kd, (t / tk) * 64, (t % tk) * 64, cm);
    base += nt;
}

constexpr int MOD_SL = 16, MOD_KS = D / MOD_SL;
__device__ __forceinline__ void mod_partials(LAS float* sl  , const In& in, float* part  , int bid, int nblk) {
    const int ncc = 6 * D / NT, nitem = MOD_SL * ncc;
    for (int it = bid; it < nitem; it += nblk) {
        const int s = it / ncc, j = (it % ncc) * NT + threadIdx.x;
        for (int i = threadIdx.x; i < (NB + 1) * MOD_KS; i += NT) { const int r = i / MOD_KS, k = s * MOD_KS + i % MOD_KS; const float cv = r < NB ? in.c[r * D + k] : in.c_ctx[k]; sl[i] = siluf_(cv); }
        __syncthreads();
        float acc[NB + 1];
#pragma unroll
        for (int r = 0; r <= NB; ++r) acc[r] = 0.f;
        for (int k = 0; k < MOD_KS; ++k) { const float w = in.w_mod[(size_t)(s * MOD_KS + k) * 6 * D + j];
#pragma unroll
            for (int r = 0; r <= NB; ++r) acc[r] += sl[r * MOD_KS + k] * w; }
#pragma unroll
        for (int r = 0; r <= NB; ++r) part[((size_t)s * (NB + 1) + r) * 6 * D + j] = acc[r];
        __syncthreads();
    }
}
__device__ __forceinline__ float mod_value(const In& in, const float* part, int r, int j) {
    float s = in.b_mod[j];
#pragma unroll
    for (int q = 0; q < MOD_SL; ++q) s += part[((size_t)q * (NB + 1) + r) * 6 * D + j];
    return s;
}

__device__ __forceinline__ void xn_rows(LAS float* sm  , const In& in, const float* part, bf16_t* xn, int b0, int nb, int row_lo, int row_hi) {
    const int nlat = nb * SEQ, wid = threadIdx.x >> 6, lane = threadIdx.x & 63;
    int cur_mr = -1;
    for (int rbase = row_lo; rbase < row_hi; rbase += 8) {
        const int mr = rbase < nlat ? b0 + rbase / SEQ : NB;
        if (mr != cur_mr) { __syncthreads(); for (int j = threadIdx.x; j < 2 * D; j += NT) sm[j] = mod_value(in, part, mr, j); __syncthreads(); cur_mr = mr; }
        const int r = rbase + wid; if (r >= row_hi) continue;
        const float* src = r < nlat ? in.x + ((size_t)b0 * SEQ + r) * D : in.ctx + ((size_t)b0 * CTX + (r - nlat)) * D;
        f32x4 v[4]; float ss = 0.f;
#pragma unroll
        for (int j = 0; j < 4; ++j) { v[j] = *(const f32x4*)(src + j * 256 + lane * 4); ss += v[j][0] * v[j][0] + v[j][1] * v[j][1] + v[j][2] * v[j][2] + v[j][3] * v[j][3]; }
#pragma unroll
        for (int o = 32; o > 0; o >>= 1) ss += __shfl_xor(ss, o);
        const float rinv = 1.f / sqrtf(ss * (1.f / D) + NORM_EPS);
#pragma unroll
        for (int j = 0; j < 4; ++j) { const int c = j * 256 + lane * 4; float o[4];
#pragma unroll
            for (int q = 0; q < 4; ++q) o[q] = (v[j][q] * rinv * in.norm_g[c + q]) * (1.f + sm[D + c + q]) + sm[c + q];
            u32x2 w; w.x = cvt_pk_bf16(o[0], o[1]); w.y = cvt_pk_bf16(o[2], o[3]); *(u32x2*)(xn + (size_t)r * D + c) = w; }
    }
}
}

namespace mk {
#define XB_TMO      128
#define XB_XCNT(j)  (256  + 64 * (j))
#define XB_XSUB(j)  (1280 + 64 * (j))
#define XB_XGEN(j)  (2304 + 64 * (j))
#define XB_TOP      3328
#define XB_TOPGEN   3392
#define XCD_BAR_WORDS 3456
#define XB_SPIN_CAP (1u << 18)
__device__ __forceinline__ unsigned xb_ld(unsigned* p)              { return __hip_atomic_load(p, __ATOMIC_RELAXED, __HIP_MEMORY_SCOPE_AGENT); }
__device__ __forceinline__ unsigned xb_add(unsigned* p, unsigned v) { return __hip_atomic_fetch_add(p, v, __ATOMIC_RELAXED, __HIP_MEMORY_SCOPE_AGENT); }
__device__ __forceinline__ unsigned xb_xcc_id() { return (unsigned)__builtin_amdgcn_s_getreg((3 << 11) | 20) & 0xFu; }
#define XB_SPIN(cond, bar) do { unsigned _sp = 0; while (cond) { __builtin_amdgcn_s_sleep(1); \
    if ((++_sp & 255u) == 0u) { if (xb_ld(&(bar)[XB_TMO])) break; if (_sp > XB_SPIN_CAP) { atomicAdd(&(bar)[XB_TMO], 1u); break; } } } } while (0)
struct XcdBarrier { unsigned* bar; unsigned x; volatile LAS unsigned* st; };
__device__ __forceinline__ XcdBarrier xcd_barrier_post(unsigned* bar, volatile LAS unsigned* st) {
    XcdBarrier b; b.bar = bar; b.x = xb_xcc_id(); b.st = st;
    if (threadIdx.x == 0) (void)xb_add(&bar[XB_XCNT(b.x)], 1u);
    return b;
}
__device__ __forceinline__ void xcd_barrier_complete(unsigned* bar, unsigned x, unsigned& nloc, unsigned& nx) {
    const unsigned G = gridDim.x * gridDim.y * gridDim.z;
    unsigned sum, cnt, mine, sp = 0u;
    for (;;) {
        sum = 0u; cnt = 0u; mine = 0u;
#pragma unroll
        for (unsigned j = 0; j < 16; ++j) { const unsigned c = xb_ld(&bar[XB_XCNT(j)]); sum += c; cnt += (c > 0u) ? 1u : 0u; mine = (j == x) ? c : mine; }
        if (sum == G) break;
        __builtin_amdgcn_s_sleep(1);
        if ((++sp & 255u) == 0u) { if (xb_ld(&bar[XB_TMO])) break; if (sp > XB_SPIN_CAP) { atomicAdd(&bar[XB_TMO], 1u); break; } }
    }
    nloc = mine > 0u ? mine : 1u; nx = cnt > 0u ? cnt : 1u;
}
__device__ __forceinline__ void xcd_barrier(const XcdBarrier& b) {
    asm volatile("s_waitcnt vmcnt(0)" ::: "memory");
    __syncthreads();
    if (threadIdx.x == 0) {
        unsigned* bar = b.bar;
        __builtin_amdgcn_s_waitcnt(0);
        unsigned nloc = b.st[0], nx = b.st[1];
        if (nloc == 0u) { xcd_barrier_complete(bar, b.x, nloc, nx); b.st[0] = nloc; b.st[1] = nx; }
        const unsigned old = xb_add(&bar[XB_XSUB(b.x)], 1u);
        const unsigned gen = old / nloc;
        if (old + 1u == (gen + 1u) * nloc) {
            __builtin_amdgcn_fence(__ATOMIC_RELEASE, "agent");
            asm volatile("s_waitcnt vmcnt(0)" ::: "memory");
            const unsigned og = xb_add(&bar[XB_TOP], 1u);
            const unsigned tg = og / nx;
            if (og + 1u == (tg + 1u) * nx) xb_add(&bar[XB_TOPGEN], 1u);
            else XB_SPIN(xb_ld(&bar[XB_TOPGEN]) == tg, bar);
            __builtin_amdgcn_fence(__ATOMIC_ACQUIRE, "agent");
            xb_add(&bar[XB_XGEN(b.x)], 1u);
            asm volatile("s_waitcnt vmcnt(0)" ::: "memory");
        } else {
            XB_SPIN(xb_ld(&bar[XB_XGEN(b.x)]) == gen, bar);
            __builtin_amdgcn_fence(__ATOMIC_ACQUIRE, "agent");
            asm volatile("s_waitcnt vmcnt(0)" ::: "memory");
        }
    }
    __syncthreads();
}
}

namespace mk {
constexpr int TB = 32;
constexpr int RAWW = 320;
constexpr int RW_RAW = 0;
constexpr int RW_MU = RW_RAW + (TB + 2) * RAWW * 2;
constexpr int RW_WUP = RW_MU + 2 * RAWW * 4;
constexpr int RW_AUP = RW_WUP + 64 * 72 * 2;
constexpr int RW_CST = RW_AUP + 64 * 72 * 2;
constexpr int RW_AWD = RW_CST + 5 * 64 * 4;
constexpr int RW_AAD = RW_AWD + TB * 72 * 2;
constexpr int RW_R = RW_AAD + TB * 72 * 2;
constexpr int RW_KR = RW_R + TB * 64 * 4;
constexpr int RW_LA = RW_KR + TB * 64 * 4;
constexpr int RW_KK = RW_LA + TB * 64 * 4;
constexpr int RW_W = RW_KK + TB * 64 * 4;
constexpr int RW_B = RW_W + TB * 64 * 4;
constexpr int RW_KD = RW_B + TB * 64 * 4;
constexpr int RW_WR = RW_KD + TB * 64 * 4;
constexpr int RW_V = RW_WR + TB * 64 * 4;
constexpr int RW_SC = RW_V + TB * 64 * 4;
constexpr int RW_YO = RW_SC + TB * 2 * 4;
constexpr int RW_BON = RW_YO + TB * 64 * 4;
constexpr int RW_END = RW_BON + TB * 4;
static_assert(RW_END <= LDS_BYTES, "rwkv LDS");

#define MK_DPP(x, ctrl) __int_as_float(__builtin_amdgcn_update_dpp(__float_as_int(x), __float_as_int(x), ctrl, 0xF, 0xF, false))
__device__ __forceinline__ float allreduce16(float x) {
    x += MK_DPP(x, 0xB1); x += MK_DPP(x, 0x4E); x += MK_DPP(x, 0x141); x += MK_DPP(x, 0x140); return x;
}

__device__ __forceinline__ void allreduce16x4(float& a, float& b, float& c, float& d) {
    asm volatile("s_nop 1\n\t"
        "v_add_f32_dpp %0, %0, %0 quad_perm:[1,0,3,2] row_mask:0xf bank_mask:0xf\n\t" "v_add_f32_dpp %1, %1, %1 quad_perm:[1,0,3,2] row_mask:0xf bank_mask:0xf\n\t"
        "v_add_f32_dpp %2, %2, %2 quad_perm:[1,0,3,2] row_mask:0xf bank_mask:0xf\n\t" "v_add_f32_dpp %3, %3, %3 quad_perm:[1,0,3,2] row_mask:0xf bank_mask:0xf\n\t"
        "v_add_f32_dpp %0, %0, %0 quad_perm:[2,3,0,1] row_mask:0xf bank_mask:0xf\n\t" "v_add_f32_dpp %1, %1, %1 quad_perm:[2,3,0,1] row_mask:0xf bank_mask:0xf\n\t"
        "v_add_f32_dpp %2, %2, %2 quad_perm:[2,3,0,1] row_mask:0xf bank_mask:0xf\n\t" "v_add_f32_dpp %3, %3, %3 quad_perm:[2,3,0,1] row_mask:0xf bank_mask:0xf\n\t"
        "v_add_f32_dpp %0, %0, %0 row_half_mirror row_mask:0xf bank_mask:0xf\n\t" "v_add_f32_dpp %1, %1, %1 row_half_mirror row_mask:0xf bank_mask:0xf\n\t"
        "v_add_f32_dpp %2, %2, %2 row_half_mirror row_mask:0xf bank_mask:0xf\n\t" "v_add_f32_dpp %3, %3, %3 row_half_mirror row_mask:0xf bank_mask:0xf\n\t"
        "v_add_f32_dpp %0, %0, %0 row_mirror row_mask:0xf bank_mask:0xf\n\t" "v_add_f32_dpp %1, %1, %1 row_mirror row_mask:0xf bank_mask:0xf\n\t"
        "v_add_f32_dpp %2, %2, %2 row_mirror row_mask:0xf bank_mask:0xf\n\t" "v_add_f32_dpp %3, %3, %3 row_mirror row_mask:0xf bank_mask:0xf"
        : "+v"(a), "+v"(b), "+v"(c), "+v"(d));
}
struct RwkvP { const bf16_t* z1; bf16_t* Y; float* bon; int b0, nb; };

constexpr int RW_NPIECE = (TB + 2) * 40, RW_PPT = (RW_NPIECE + NT - 1) / NT;

__device__ __forceinline__ void rwkv_chain(LAS unsigned char* lds, const In& in, const RwkvP p, int chain) {
    const int tid = threadIdx.x, lane = tid & 63, wid = tid >> 6;
    const int d = chain / (p.nb * NH), bl = (chain / NH) % p.nb, h = chain % NH;
    const int nlat = p.nb * SEQ;
    LAS bf16_t* RAW = (LAS bf16_t*)(lds + RW_RAW); LAS float* MU = (LAS float*)(lds + RW_MU);
    LAS bf16_t* WUP = (LAS bf16_t*)(lds + RW_WUP); LAS bf16_t* AUP = (LAS bf16_t*)(lds + RW_AUP); LAS float* CST = (LAS float*)(lds + RW_CST);
    LAS bf16_t* AWD = (LAS bf16_t*)(lds + RW_AWD); LAS bf16_t* AAD = (LAS bf16_t*)(lds + RW_AAD);
    LAS float *Rr = (LAS float*)(lds + RW_R), *KR = (LAS float*)(lds + RW_KR), *LA_ = (LAS float*)(lds + RW_LA);
    LAS float *KK = (LAS float*)(lds + RW_KK), *Wv = (LAS float*)(lds + RW_W), *Bv = (LAS float*)(lds + RW_B), *KD = (LAS float*)(lds + RW_KD), *WR = (LAS float*)(lds + RW_WR), *Vv = (LAS float*)(lds + RW_V);
    LAS float *SC = (LAS float*)(lds + RW_SC), *YO = (LAS float*)(lds + RW_YO), *BON = (LAS float*)(lds + RW_BON);
    auto segcol = [&](int s) { return s < 3 ? s * RW + h * 64 : (s == 3 ? OFF_WD + d * DL : OFF_AD + d * AL); };
    for (int i = tid; i < 2 * RAWW; i += NT) { const int m = i / RAWW, c = i % RAWW; MU[i] = in.shift_mu[m * RC + segcol(c >> 6) + (c & 63)]; }
    for (int i = tid; i < 64 * 64; i += NT) { const int j = i >> 6, c = i & 63;
        WUP[c * 72 + j] = f2bf(in.rw_w_up[((size_t)d * DL + j) * RW + h * 64 + c]); AUP[c * 72 + j] = f2bf(in.rw_a_up[((size_t)d * AL + j) * RW + h * 64 + c]); }
    for (int i = tid; i < 64; i += NT) { CST[i] = in.rw_w0[d * RW + h * 64 + i]; CST[64 + i] = in.rw_a0[d * RW + h * 64 + i]; CST[128 + i] = in.rw_k_k[h * 64 + i]; CST[192 + i] = in.rw_k_a[h * 64 + i]; CST[256 + i] = in.rw_r_k[h * 64 + i]; }
    constexpr int NQ = (CTX + SEQ) / TB, NQC = CTX / TB;
    auto blk_info = [&](int q, bool& isctx, int& t0, bool& hp, bool& hn, size_t& grow0) {
        isctx = q < NQC;
        if (isctx) { const int qq = d == 0 ? q : NQC - 1 - q; t0 = qq * TB; hp = t0 > 0; hn = t0 + TB < CTX; grow0 = (size_t)nlat + (size_t)bl * CTX + t0; }
        else { const int ql = q - NQC, qq = d == 0 ? ql : SEQ / TB - 1 - ql; t0 = qq * TB; hp = (t0 % GW) != 0; hn = ((t0 + TB) % GW) != 0; grow0 = (size_t)bl * SEQ + t0; }
    };
    u32x4 pre[RW_PPT];
    auto prefetch = [&](int q) {
        bool isctx, hp, hn; int t0; size_t grow0; blk_info(q, isctx, t0, hp, hn, grow0);
#pragma unroll
        for (int k = 0; k < RW_PPT; ++k) { const int i = tid + k * NT; u32x4 v = (u32x4){0u, 0u, 0u, 0u};
            if (i < RW_NPIECE) { const int rr = i / 40, sp = i % 40, seg = sp >> 3, part = sp & 7;
                const bool ok = (rr == 0) ? hp : ((rr == TB + 1) ? hn : true);
                if (ok) v = *(const u32x4*)(p.z1 + (grow0 + rr - 1) * Z1_N + segcol(seg) + part * 8); }
            pre[k] = v; }
    };
    auto commit = [&]() {
#pragma unroll
        for (int k = 0; k < RW_PPT; ++k) { const int i = tid + k * NT; if (i < RW_NPIECE) { const int rr = i / 40, sp = i % 40; *(LAS u32x4*)(RAW + rr * RAWW + sp * 8) = pre[k]; } }
    };
    float S[2][4];
#pragma unroll
    for (int i = 0; i < 2; ++i)
#pragma unroll
        for (int j = 0; j < 4; ++j) S[i][j] = 0.f;
    const int kg = lane & 15, rp = (lane >> 4) + 4 * wid;
    prefetch(0);
    for (int q = 0; q < NQ; ++q) {
        bool isctx, hp, hn; int t0; size_t grow0; blk_info(q, isctx, t0, hp, hn, grow0);
        commit();
        __syncthreads();
        if (q + 1 < NQ) prefetch(q + 1);
        auto shift8 = [&](int t, int c0, float (&s)[8]) {
            const u32x4 xp = *(const LAS u32x4*)(RAW + t * RAWW + c0), xc = *(const LAS u32x4*)(RAW + (t + 1) * RAWW + c0), xn_ = *(const LAS u32x4*)(RAW + (t + 2) * RAWW + c0);
            const f32x4 m0a = *(const LAS f32x4*)(MU + c0), m0b = *(const LAS f32x4*)(MU + c0 + 4), m1a = *(const LAS f32x4*)(MU + RAWW + c0), m1b = *(const LAS f32x4*)(MU + RAWW + c0 + 4);
#pragma unroll
            for (int j = 0; j < 4; ++j) { const unsigned a = xp[j], b = xc[j], c = xn_[j];
                const float mu0l = j < 2 ? m0a[2 * j] : m0b[2 * j - 4], mu0h = j < 2 ? m0a[2 * j + 1] : m0b[2 * j - 3], mu1l = j < 2 ? m1a[2 * j] : m1b[2 * j - 4], mu1h = j < 2 ? m1a[2 * j + 1] : m1b[2 * j - 3];
                { const float x = bflo(b); s[2 * j] = x + mu0l * (bflo(a) - x) + mu1l * (bflo(c) - x); }
                { const float x = bfhi(b); s[2 * j + 1] = x + mu0h * (bfhi(a) - x) + mu1h * (bfhi(c) - x); } } };
        for (int it = tid; it < TB * 24; it += NT) {
            const int t = it / 24, g = it % 24, seg = g >> 3, cc = (g & 7) * 8; float s[8]; shift8(t, g * 8, s);
            LAS float* dst = (seg == 0 ? Rr : (seg == 1 ? KR : Vv)) + t * 64 + cc; *(LAS f32x4*)dst = (f32x4){s[0], s[1], s[2], s[3]}; *(LAS f32x4*)(dst + 4) = (f32x4){s[4], s[5], s[6], s[7]};
        }
        { const int t = tid >> 4, g = 24 + (tid & 15), cc = (g & 7) * 8; float s[8]; shift8(t, g * 8, s);
          const bool isw = (tid & 15) < 8;
#pragma unroll
          for (int j = 0; j < 8; ++j) { const float th = fast_tanh(s[j]); s[j] = isw ? th : s[j]; }
          LAS bf16_t* dst = (isw ? AWD : AAD) + t * 72 + cc;
          u32x4 w; w.x = cvt_pk_bf16(s[0], s[1]); w.y = cvt_pk_bf16(s[2], s[3]); w.z = cvt_pk_bf16(s[4], s[5]); w.w = cvt_pk_bf16(s[6], s[7]); *(LAS u32x4*)dst = w; }
        __syncthreads();
        {
            const int lora = wid >> 2, ct = wid & 3, fr = lane & 15, fq = lane >> 4;
            const LAS bf16_t* Am = lora ? AAD : AWD; const LAS bf16_t* Bm = lora ? AUP : WUP;
#pragma unroll
            for (int rt = 0; rt < 2; ++rt) {
                f32x4 acc = (f32x4){0.f, 0.f, 0.f, 0.f};
#pragma unroll
                for (int ks = 0; ks < 2; ++ks) {
                    const bf16x8 a = *(const LAS bf16x8*)(Am + (rt * 16 + fr) * 72 + ks * 32 + fq * 8);
                    const bf16x8 b = *(const LAS bf16x8*)(Bm + (ct * 16 + fr) * 72 + ks * 32 + fq * 8);
                    acc = __builtin_amdgcn_mfma_f32_16x16x32_bf16(a, b, acc, 0, 0, 0);
                }
                const int col = ct * 16 + fr;
#pragma unroll
                for (int i = 0; i < 4; ++i) { const int t = rt * 16 + fq * 4 + i;
                    if (lora == 0) { const float lw = acc[i] + CST[col]; const float wl = -fast_softplus(-lw) - 0.5f; Wv[t * 64 + col] = __expf(-__expf(wl)); }
                    else { LA_[t * 64 + col] = fast_sigmoid(acc[i] + CST[64 + col]); } }
            }
        }
        __syncthreads();
        {
            const int t = tid >> 4, c4 = (tid & 15) * 4;
            const f32x4 k = *(const LAS f32x4*)(KR + t * 64 + c4), a = *(const LAS f32x4*)(LA_ + t * 64 + c4), w = *(const LAS f32x4*)(Wv + t * 64 + c4), r = *(const LAS f32x4*)(Rr + t * 64 + c4);
            f32x4 kkr, kd, bb, wr; float ss = 0.f, br = 0.f, kr = 0.f, bn = 0.f;
#pragma unroll
            for (int j = 0; j < 4; ++j) { kkr[j] = k[j] * CST[128 + c4 + j]; ss += kkr[j] * kkr[j]; }
            ss = allreduce16(ss);
            const float inv = 1.f / fmaxf(sqrtf(ss), 1e-12f);
#pragma unroll
            for (int j = 0; j < 4; ++j) { const float kk = kkr[j] * inv; kkr[j] = kk; kd[j] = k[j] * (1.f + (a[j] - 1.f) * CST[192 + c4 + j]); bb[j] = kk * a[j]; wr[j] = w[j] * r[j];
                br += bb[j] * r[j]; kr += kd[j] * r[j]; bn += r[j] * kd[j] * CST[256 + c4 + j]; }
            br = allreduce16(br); kr = allreduce16(kr); bn = allreduce16(bn);
            *(LAS f32x4*)(KK + t * 64 + c4) = kkr; *(LAS f32x4*)(KD + t * 64 + c4) = kd; *(LAS f32x4*)(Bv + t * 64 + c4) = bb; *(LAS f32x4*)(WR + t * 64 + c4) = wr;
            if ((tid & 15) == 0) { SC[t * 2] = br; SC[t * 2 + 1] = kr; BON[t] = bn; }
        }
        __syncthreads();
        {
            auto tof = [&](int st) { return d == 0 ? st : TB - 1 - st; };
            const LAS float* lb = KK + 4 * kg;
            const LAS float* vb = Vv + 2 * rp;
            constexpr int OW = (RW_W - RW_KK) / 4, OB = (RW_B - RW_KK) / 4, OKD = (RW_KD - RW_KK) / 4, OWR = (RW_WR - RW_KK) / 4;
            int t = tof(0);
            f32x4 kk4 = *(const LAS f32x4*)(lb + t * 64), w4 = *(const LAS f32x4*)(lb + t * 64 + OW), b4 = *(const LAS f32x4*)(lb + t * 64 + OB),
                  kd4 = *(const LAS f32x4*)(lb + t * 64 + OKD), wr4 = *(const LAS f32x4*)(lb + t * 64 + OWR);
            f32x2 vv = *(const LAS f32x2*)(vb + t * 64), sc = *(const LAS f32x2*)(SC + t * 2);
#pragma unroll 2
            for (int st = 0; st < TB; ++st) {
                const int tn = tof(st + 1 < TB ? st + 1 : st);
                const f32x4 nkk4 = *(const LAS f32x4*)(lb + tn * 64), nw4 = *(const LAS f32x4*)(lb + tn * 64 + OW), nb4 = *(const LAS f32x4*)(lb + tn * 64 + OB),
                            nkd4 = *(const LAS f32x4*)(lb + tn * 64 + OKD), nwr4 = *(const LAS f32x4*)(lb + tn * 64 + OWR);
                const f32x2 nvv = *(const LAS f32x2*)(vb + tn * 64), nsc = *(const LAS f32x2*)(SC + tn * 2);
                float sa0 = S[0][0] * kk4[0], sa1 = S[1][0] * kk4[0], yo0 = S[0][0] * wr4[0], yo1 = S[1][0] * wr4[0];
#pragma unroll
                for (int j = 1; j < 4; ++j) { sa0 += S[0][j] * kk4[j]; sa1 += S[1][j] * kk4[j]; yo0 += S[0][j] * wr4[j]; yo1 += S[1][j] * wr4[j]; }
                allreduce16x4(sa0, sa1, yo0, yo1);
                const float vk0 = vv[0], vk1 = vv[1];
#pragma unroll
                for (int j = 0; j < 4; ++j) { S[0][j] = S[0][j] * w4[j] + (vk0 * kd4[j] - sa0 * b4[j]); S[1][j] = S[1][j] * w4[j] + (vk1 * kd4[j] - sa1 * b4[j]); }
                if (kg == 0) { f32x2 y; y[0] = yo0 - sa0 * sc[0] + vk0 * sc[1]; y[1] = yo1 - sa1 * sc[0] + vk1 * sc[1]; *(LAS f32x2*)(YO + t * 64 + 2 * rp) = y; }
                kk4 = nkk4; w4 = nw4; b4 = nb4; kd4 = nkd4; wr4 = nwr4; vv = nvv; sc = nsc; t = tn;
            }
        }
        __syncthreads();
        if (!isctx) {
            const int t = tid >> 4, c4 = (tid & 15) * 4; const f32x4 y = *(const LAS f32x4*)(YO + t * 64 + c4);
            u32x2 w; w.x = cvt_pk_bf16(y[0], y[1]); w.y = cvt_pk_bf16(y[2], y[3]);
            *(u32x2*)(p.Y + ((size_t)d * nlat + grow0 + t) * RW + h * 64 + c4) = w;
            if (tid < TB) p.bon[((size_t)d * nlat + grow0 + tid) * NH + h] = BON[tid];
        }
    }
}
__device__ __forceinline__ void rwkv_phase(LAS unsigned char* lds, const In& in, const RwkvP p, int bid, int nblk) {
    const int nchain = 2 * p.nb * NH;
    for (int c = bid; c < nchain; c += nblk) { rwkv_chain(lds, in, p, c); __syncthreads(); }
}
}

namespace mk {
constexpr int LR_XT = 0;
constexpr int LR_XC = LR_XT + 67 * 64 * 2 + 64;
constexpr int LR_XCB = LR_XC + 64 * 64 * 4;
constexpr int LR_GWT = LR_XCB + 64 * 72 * 2;
constexpr int LR_A = LR_GWT + 2 * 64 * 72 * 2;
constexpr int LR_BX = LR_A + 64 * 64 * 4;
constexpr int LR_HO = LR_BX + 64 * 64 * 4;
constexpr int LR_CST = LR_HO + 64 * 64 * 4;
constexpr int LR_END = LR_CST + 8 * 64 * 4;
static_assert(LR_END <= LDS_BYTES && (LR_XC % 16) == 0, "lru LDS");

struct LruP { const bf16_t* z1; bf16_t* Hd; int b0, nb; };

__device__ __forceinline__ void lru_item(LAS unsigned char* lds, const In& in, const LruP p, int item) {
    const int tid = threadIdx.x, lane = tid & 63, wid = tid >> 6;
    const int d = item / (p.nb * LB), bl = (item / LB) % p.nb, n = item % LB;
    const int nlat = p.nb * SEQ;
    LAS bf16_t* XT = (LAS bf16_t*)(lds + LR_XT); LAS float* XC = (LAS float*)(lds + LR_XC); LAS bf16_t* XCB = (LAS bf16_t*)(lds + LR_XCB); LAS bf16_t* GWT = (LAS bf16_t*)(lds + LR_GWT);
    LAS float *A_ = (LAS float*)(lds + LR_A), *BX = (LAS float*)(lds + LR_BX), *HO = (LAS float*)(lds + LR_HO), *CST = (LAS float*)(lds + LR_CST);
    for (int i = tid; i < 2 * 64 * 64; i += NT) { const int g = i >> 12, j = (i >> 6) & 63, k = i & 63;
        GWT[(g * 64 + k) * 72 + j] = f2bf(in.lru_gate_w[((((size_t)d * 2 + g) * LB + n) * LBS + j) * LBS + k]); }
    for (int i = tid; i < 64; i += NT) { const int c = n * 64 + i;
        CST[i] = in.lru_conv_w[c]; CST[64 + i] = in.lru_conv_w[LW + c]; CST[128 + i] = in.lru_conv_w[2 * LW + c]; CST[192 + i] = in.lru_conv_w[3 * LW + c]; CST[256 + i] = in.lru_conv_b[c];
        CST[320 + i] = in.lru_gate_b[((d * 2 + 0) * LB + n) * LBS + i]; CST[384 + i] = in.lru_gate_b[((d * 2 + 1) * LB + n) * LBS + i]; CST[448 + i] = softplusf_(-in.lru_l[d * LW + c]); }
    constexpr int NSEG = CTX / 64 + GW, NSC = CTX / 64;
    u32x4 pre[2];
    auto tok_row = [&](int sidx, int rr, bool& ok) -> size_t {
        if (sidx < NSC) { const int t = sidx * 64 + rr - 2; ok = t >= 0 && t < CTX; return (size_t)nlat + (size_t)bl * CTX + t; }
        const int col = sidx - NSC, row = rr - 2; ok = row >= 0 && row < ROWS; return (size_t)bl * SEQ + (size_t)row * GW + col;
    };
    auto seg_of = [&](int q) { if (q < NSC) return d == 0 ? q : NSC - 1 - q; const int ql = q - NSC; return NSC + (d == 0 ? ql : GW - 1 - ql); };
    auto prefetch = [&](int q) { const int sidx = seg_of(q);
#pragma unroll
        for (int k = 0; k < 2; ++k) { const int i = tid + k * NT; u32x4 v = (u32x4){0u, 0u, 0u, 0u};
            if (i < 67 * 8) { const int rr = i >> 3, part = i & 7; bool ok; const size_t gr = tok_row(sidx, rr, ok); if (ok) v = *(const u32x4*)(p.z1 + gr * Z1_N + Z1_LX + n * 64 + part * 8); }
            pre[k] = v; } };
    auto commit = [&]() {
#pragma unroll
        for (int k = 0; k < 2; ++k) { const int i = tid + k * NT; if (i < 67 * 8) *(LAS u32x4*)(XT + (i >> 3) * 64 + (i & 7) * 8) = pre[k]; } };
    float hcar = 0.f;
    prefetch(0);
    for (int q = 0; q < NSEG; ++q) {
        const int sidx = seg_of(q);
        commit();
        __syncthreads();
        if (q + 1 < NSEG) prefetch(q + 1);
        { const int t = tid >> 3, c0 = (tid & 7) * 8; float s[8];
#pragma unroll
          for (int j = 0; j < 8; ++j) s[j] = CST[256 + c0 + j];
#pragma unroll
          for (int tap = 0; tap < 4; ++tap) { const u32x4 x = *(const LAS u32x4*)(XT + (t + tap) * 64 + c0);
#pragma unroll
              for (int j = 0; j < 4; ++j) { s[2 * j] += CST[tap * 64 + c0 + 2 * j] * bflo(x[j]); s[2 * j + 1] += CST[tap * 64 + c0 + 2 * j + 1] * bfhi(x[j]); } }
          *(LAS f32x4*)(XC + t * 64 + c0) = (f32x4){s[0], s[1], s[2], s[3]}; *(LAS f32x4*)(XC + t * 64 + c0 + 4) = (f32x4){s[4], s[5], s[6], s[7]};
          u32x4 w; w.x = cvt_pk_bf16(s[0], s[1]); w.y = cvt_pk_bf16(s[2], s[3]); w.z = cvt_pk_bf16(s[4], s[5]); w.w = cvt_pk_bf16(s[6], s[7]); *(LAS u32x4*)(XCB + t * 72 + c0) = w; }
        __syncthreads();
        { const int rt = wid >> 1, fr = lane & 15, fq = lane >> 4;
          bf16x8 a[2];
#pragma unroll
          for (int ks = 0; ks < 2; ++ks) a[ks] = *(const LAS bf16x8*)(XCB + (rt * 16 + fr) * 72 + ks * 32 + fq * 8);
#pragma unroll
          for (int cc = 0; cc < 2; ++cc) { const int ct = 2 * (wid & 1) + cc, col = ct * 16 + fr;
              f32x4 acc0 = (f32x4){0.f, 0.f, 0.f, 0.f}, acc1 = acc0;
#pragma unroll
              for (int ks = 0; ks < 2; ++ks) {
                  const bf16x8 b0 = *(const LAS bf16x8*)(GWT + (0 * 64 + col) * 72 + ks * 32 + fq * 8), b1 = *(const LAS bf16x8*)(GWT + (1 * 64 + col) * 72 + ks * 32 + fq * 8);
                  acc0 = __builtin_amdgcn_mfma_f32_16x16x32_bf16(a[ks], b0, acc0, 0, 0, 0); acc1 = __builtin_amdgcn_mfma_f32_16x16x32_bf16(a[ks], b1, acc1, 0, 0, 0); }
#pragma unroll
              for (int i = 0; i < 4; ++i) { const int t = rt * 16 + fq * 4 + i;
                  const float rec = fast_sigmoid(acc0[i] + CST[320 + col]), inp = fast_sigmoid(acc1[i] + CST[384 + col]);
                  const float la = -8.f * rec * CST[448 + col];
                  const float av = __expf(la), x2 = 2.f * la; const float om = x2 > -0.03f ? -x2 * (1.f + x2 * (0.5f + x2 * (1.f / 6.f))) : 1.f - av * av;
                  A_[t * 64 + col] = av; BX[t * 64 + col] = __builtin_amdgcn_sqrtf(om) * inp * XC[t * 64 + col]; } } }
        __syncthreads();
        if (wid == 0) {
#pragma unroll 8
            for (int st = 0; st < 64; ++st) { const int t = d == 0 ? st : 63 - st; hcar = A_[t * 64 + lane] * hcar + BX[t * 64 + lane]; HO[t * 64 + lane] = hcar; }
        }
        __syncthreads();
        if (sidx >= NSC) { const int col = sidx - NSC, t = tid >> 3, c0 = (tid & 7) * 8;
            const f32x4 x = *(const LAS f32x4*)(HO + t * 64 + c0), y = *(const LAS f32x4*)(HO + t * 64 + c0 + 4);
            *(u32x4*)(p.Hd + ((size_t)d * nlat + (size_t)bl * SEQ + (size_t)t * GW + col) * LW + n * 64 + c0) = pack8(x, y); }
    }
}
__device__ __forceinline__ void lru_phase(LAS unsigned char* lds, const In& in, const LruP p, int bid, int nblk) {
    const int nitem = 2 * p.nb * LB;
    for (int it = bid; it < nitem; it += nblk) { lru_item(lds, in, p, it); __syncthreads(); }
}
}

namespace mk {
#define MK_DPPX(x, ctrl) __int_as_float(__builtin_amdgcn_update_dpp(__float_as_int(x), __float_as_int(x), ctrl, 0xF, 0xF, false))
__device__ __forceinline__ float allreduce4(float x) { x += MK_DPPX(x, 0xB1); x += MK_DPPX(x, 0x4E); return x; }
__device__ __forceinline__ void unpack8(const u32x4 w, float (&f)[8]) {
#pragma unroll
    for (int j = 0; j < 4; ++j) { f[2 * j] = bflo(w[j]); f[2 * j + 1] = bfhi(w[j]); } }
constexpr int AG_K = 256;
struct PostP { const bf16_t* z1; bf16_t* Y; const float* bon; bf16_t* Ag; int nlat; int pad_; };
__device__ __forceinline__ void rwkv_post_rows(const In& in, const PostP p, int row_lo, int row_hi) {
    const int lane = threadIdx.x & 63, wid = threadIdx.x >> 6, c0 = lane * 16, h = lane >> 2;
    for (int r = row_lo + wid; r < row_hi; r += NT / 64) {
        const int cg = r % GW; const bool hp = cg > 0, hn = cg < GW - 1;
        bf16_t* y0p = p.Y + (size_t)r * RW + c0; const bf16_t* y1p = p.Y + ((size_t)p.nlat + r) * RW + c0;
        float y[16], t8[8];
        unpack8(*(const u32x4*)y0p, t8);
#pragma unroll
        for (int j = 0; j < 8; ++j) y[j] = t8[j];
        unpack8(*(const u32x4*)(y0p + 8), t8);
#pragma unroll
        for (int j = 0; j < 8; ++j) y[8 + j] = t8[j];
        unpack8(*(const u32x4*)y1p, t8);
#pragma unroll
        for (int j = 0; j < 8; ++j) y[j] += t8[j];
        unpack8(*(const u32x4*)(y1p + 8), t8);
#pragma unroll
        for (int j = 0; j < 8; ++j) y[8 + j] += t8[j];
        float s = 0.f;
#pragma unroll
        for (int j = 0; j < 16; ++j) s += y[j];
        const float mu = allreduce4(s) * (1.f / 64.f); float q = 0.f;
#pragma unroll
        for (int j = 0; j < 16; ++j) { const float dlt = y[j] - mu; q += dlt * dlt; }
        const float rs = 1.f / sqrtf(allreduce4(q) * (1.f / 64.f) + LNX_EPS);
        const float bonus = p.bon[(size_t)r * NH + h] + p.bon[((size_t)p.nlat + r) * NH + h];
        const bf16_t* zr = p.z1 + (size_t)r * Z1_N;
#pragma unroll
        for (int half = 0; half < 2; ++half) {
            const int c = OFF_V + c0 + half * 8; float xv[8], pv[8], nv[8];
            unpack8(*(const u32x4*)(zr + c), xv);
            if (hp) unpack8(*(const u32x4*)(zr - Z1_N + c), pv); else {
#pragma unroll
                for (int j = 0; j < 8; ++j) pv[j] = 0.f; }
            if (hn) unpack8(*(const u32x4*)(zr + Z1_N + c), nv); else {
#pragma unroll
                for (int j = 0; j < 8; ++j) nv[j] = 0.f; }
            float o[8];
#pragma unroll
            for (int j = 0; j < 8; ++j) { const float v = xv[j] + in.shift_mu[c + j] * (pv[j] - xv[j]) + in.shift_mu[RC + c + j] * (nv[j] - xv[j]); const int ch = c0 + half * 8 + j;
                o[j] = (y[half * 8 + j] - mu) * rs * in.rw_lnx[ch] + in.rw_lnx[RW + ch] + bonus * v; }
            u32x4 w; w.x = cvt_pk_bf16(o[0], o[1]); w.y = cvt_pk_bf16(o[2], o[3]); w.z = cvt_pk_bf16(o[4], o[5]); w.w = cvt_pk_bf16(o[6], o[7]); *(u32x4*)(y0p + half * 8) = w;
        }
        if (lane < 32) { u32x4 w = (u32x4){0u, 0u, 0u, 0u};
            if (lane < GL / 8) { const int c = OFF_GD + lane * 8; float xv[8], pv[8], nv[8];
                unpack8(*(const u32x4*)(zr + c), xv);
                if (hp) unpack8(*(const u32x4*)(zr - Z1_N + c), pv); else {
#pragma unroll
                    for (int j = 0; j < 8; ++j) pv[j] = 0.f; }
                if (hn) unpack8(*(const u32x4*)(zr + Z1_N + c), nv); else {
#pragma unroll
                    for (int j = 0; j < 8; ++j) nv[j] = 0.f; }
                float o[8];
#pragma unroll
                for (int j = 0; j < 8; ++j) o[j] = sigmoidf_(xv[j] + in.shift_mu[c + j] * (pv[j] - xv[j]) + in.shift_mu[RC + c + j] * (nv[j] - xv[j]));
                w.x = cvt_pk_bf16(o[0], o[1]); w.y = cvt_pk_bf16(o[2], o[3]); w.z = cvt_pk_bf16(o[4], o[5]); w.w = cvt_pk_bf16(o[6], o[7]); }
            *(u32x4*)(p.Ag + (size_t)r * AG_K + lane * 8) = w; }
    }
}
struct EpiYa { const bf16_t* yn; bf16_t* ya;
    __device__ __forceinline__ bool operator()(f32x4 (&acc)[2][2][4][2], const Unit& u, int wr, int wc, int fr, int fq) const {
        MK_FRAG_LOOP(r, c) { const size_t o = (size_t)(u.pm * BM + r) * RW + u.pn * BM + c; float f[8]; unpack8(*(const u32x4*)(yn + o), f);
            f32x4 a = acc[ai][bj][m][0], b = acc[ai][bj][m][1];
#pragma unroll
            for (int j = 0; j < 4; ++j) { a[j] *= f[j]; b[j] *= f[4 + j]; }
            *(u32x4*)(ya + o) = pack8(a, b); asm volatile("" ::: "memory"); }
        return false; } };
struct EpiZc { const bf16_t* Hd; bf16_t* yb; bf16_t* gates; int nlat; int pad_;
    __device__ __forceinline__ bool operator()(f32x4 (&acc)[2][2][4][2], const Unit& u, int wr, int wc, int fr, int fq) const {
        if (u.pn < LW / BM) {
            MK_FRAG_LOOP(r, c) { const size_t o = (size_t)(u.pm * BM + r) * LW + u.pn * BM + c; float h0[8], h1[8]; unpack8(*(const u32x4*)(Hd + o), h0); unpack8(*(const u32x4*)(Hd + (size_t)nlat * LW + o), h1);
                f32x4 a = acc[ai][bj][m][0], b = acc[ai][bj][m][1];
#pragma unroll
                for (int j = 0; j < 4; ++j) { a[j] = gelu_tanhf_(a[j]) * (h0[j] + h1[j]); b[j] = gelu_tanhf_(b[j]) * (h0[4 + j] + h1[4 + j]); }
                *(u32x4*)(yb + o) = pack8(a, b); asm volatile("" ::: "memory"); }
        } else {
            MK_FRAG_LOOP(r, c) { const size_t o = (size_t)(u.pm * BM + r) * (2 * D) + (u.pn * BM - LW) + c;
                f32x4 a = acc[ai][bj][m][0], b = acc[ai][bj][m][1];
#pragma unroll
                for (int j = 0; j < 4; ++j) { a[j] = fast_sigmoid(a[j]); b[j] = fast_sigmoid(b[j]); }
                *(u32x4*)(gates + o) = pack8(a, b); }
        }
        return false; } };
struct PairOrder { StaticOrder S;
    __device__ bool next(int i, Unit& u) const { if (!S.next(i >> 1, u)) return false; u.e = i & 1; return true; } };
struct EpiBranch { const bf16_t* gates; bf16_t* mixed;
    __device__ __forceinline__ bool operator()(f32x4 (&acc)[2][2][4][2], const Unit& u, int wr, int wc, int fr, int fq) const {
        MK_FRAG_LOOP(r, c) { const size_t row = (size_t)(u.pm * BM + r); const int col = u.pn * BM + c; float g1[8], g2[8];
            unpack8(*(const u32x4*)(gates + row * (2 * D) + col), g1); unpack8(*(const u32x4*)(gates + row * (2 * D) + D + col), g2);
            if (u.e == 0) {
#pragma unroll
                for (int j = 0; j < 4; ++j) { acc[ai][bj][m][0][j] *= g1[j] / g2[j]; acc[ai][bj][m][1][j] *= g1[4 + j] / g2[4 + j]; }
            } else { f32x4 a = acc[ai][bj][m][0], b = acc[ai][bj][m][1];
#pragma unroll
                for (int j = 0; j < 4; ++j) { a[j] *= g2[j]; b[j] *= g2[4 + j]; }
                *(u32x4*)(mixed + row * D + col) = pack8(a, b); } asm volatile("" ::: "memory"); }
        return u.e == 0; } };
struct EpiF32 { float* C; long ldc;
    __device__ __forceinline__ bool operator()(f32x4 (&acc)[2][2][4][2], const Unit& u, int wr, int wc, int fr, int fq) const {
        MK_FRAG_LOOP(r, c) { float* o = C + (size_t)(u.pm * BM + r) * ldc + u.pn * BM + c; *(f32x4*)o = acc[ai][bj][m][0]; *(f32x4*)(o + 4) = acc[ai][bj][m][1]; }
        return false; } };
}

namespace mk {
constexpr int NEX = NE + 1;
constexpr int SLOTS_PER_TOK = TOPK + 1;
constexpr int RP_MOD = 0;
constexpr int RP_UH = RP_MOD + 3 * D * 4;
constexpr int RP_UL = RP_UH + 16 * (D + 8) * 2;
constexpr int RP_PART = RP_UL + 16 * (D + 8) * 2;
constexpr int RP_LOG = RP_PART + 8 * 16 * 64 * 4;
constexpr int RP_HIST = RP_LOG + 16 * 64 * 4;
constexpr int RP_END = RP_HIST + 64 * 4;
static_assert(RP_END <= LDS_BYTES, "rowpass LDS");

struct RowP { float* y2h1; bf16_t* u; const float* modpart; const bf16_t* rwt;
              int* tope; float* gatev; int* lrank; int* blkcnt; int b0, nlat; };
__device__ __forceinline__ float wave_max(float x) {
#pragma unroll
    for (int o = 32; o > 0; o >>= 1) x = fmaxf(x, __shfl_xor(x, o));
    return x; }
__device__ __forceinline__ void row_pass(LAS unsigned char* lds, const In& in, const RowP p, int row_lo, int row_hi) {
    const int tid = threadIdx.x, lane = tid & 63, wid = tid >> 6;
    LAS float* MOD = (LAS float*)(lds + RP_MOD); LAS bf16_t* UH = (LAS bf16_t*)(lds + RP_UH); LAS bf16_t* UL = (LAS bf16_t*)(lds + RP_UL);
    LAS float* PART = (LAS float*)(lds + RP_PART); LAS float* LOG = (LAS float*)(lds + RP_LOG); LAS int* HIST = (LAS int*)(lds + RP_HIST);
    const int mr = p.b0 + row_lo / SEQ;
    for (int j = tid; j < 3 * D; j += NT) MOD[j] = mod_value(in, p.modpart, mr, 2 * D + j);
    if (tid < 64) HIST[tid] = 0;
    __syncthreads();
    for (int r16 = row_lo; r16 < row_hi; r16 += 16) {
#pragma unroll
        for (int rr = 0; rr < 2; ++rr) {
            const int lr = wid * 2 + rr, r = r16 + lr;
            float* yp = p.y2h1 + (size_t)r * D; const float* xp = in.x + ((size_t)p.b0 * SEQ + r) * D;
            f32x4 v[4]; float ss = 0.f;
#pragma unroll
            for (int j = 0; j < 4; ++j) { v[j] = *(const f32x4*)(yp + j * 256 + lane * 4); ss += v[j][0] * v[j][0] + v[j][1] * v[j][1] + v[j][2] * v[j][2] + v[j][3] * v[j][3]; }
#pragma unroll
            for (int o = 32; o > 0; o >>= 1) ss += __shfl_xor(ss, o);
            const float rinv = 1.f / sqrtf(ss * (1.f / D) + NORM_EPS); float s2 = 0.f;
#pragma unroll
            for (int j = 0; j < 4; ++j) { const int c = j * 256 + lane * 4; const f32x4 xv = *(const f32x4*)(xp + c);
#pragma unroll
                for (int q = 0; q < 4; ++q) { const float hv = xv[q] + MOD[c + q] * (v[j][q] * rinv * in.norm_g[D + c + q]); v[j][q] = hv; s2 += hv * hv; }
                *(f32x4*)(yp + c) = v[j]; }
#pragma unroll
            for (int o = 32; o > 0; o >>= 1) s2 += __shfl_xor(s2, o);
            const float r2 = 1.f / sqrtf(s2 * (1.f / D) + NORM_EPS);
#pragma unroll
            for (int j = 0; j < 4; ++j) { const int c = j * 256 + lane * 4; float uu[4], lo[4]; unsigned hw[2];
#pragma unroll
                for (int q = 0; q < 4; ++q) uu[q] = (v[j][q] * r2 * in.norm_g[2 * D + c + q]) * (1.f + MOD[2 * D + c + q]) + MOD[D + c + q];
                hw[0] = cvt_pk_bf16(uu[0], uu[1]); hw[1] = cvt_pk_bf16(uu[2], uu[3]);
                lo[0] = uu[0] - bflo(hw[0]); lo[1] = uu[1] - bfhi(hw[0]); lo[2] = uu[2] - bflo(hw[1]); lo[3] = uu[3] - bfhi(hw[1]);
                u32x2 w; w.x = hw[0]; w.y = hw[1]; *(u32x2*)(p.u + (size_t)r * D + c) = w; *(LAS u32x2*)(UH + lr * (D + 8) + c) = w;
                u32x2 wl; wl.x = cvt_pk_bf16(lo[0], lo[1]); wl.y = cvt_pk_bf16(lo[2], lo[3]); *(LAS u32x2*)(UL + lr * (D + 8) + c) = wl; }
        }
        __syncthreads();
        { const int fr = lane & 15, fq = lane >> 4;
          f32x4 acc[4];
#pragma unroll
          for (int ct = 0; ct < 4; ++ct) acc[ct] = (f32x4){0.f, 0.f, 0.f, 0.f};
#pragma unroll
          for (int ks = 0; ks < 4; ++ks) { const int k0 = wid * 128 + ks * 32 + fq * 8;
              const bf16x8 ah = *(const LAS bf16x8*)(UH + fr * (D + 8) + k0), al = *(const LAS bf16x8*)(UL + fr * (D + 8) + k0);
#pragma unroll
              for (int ct = 0; ct < 4; ++ct) { const bf16x8 bh = *(const bf16x8*)(p.rwt + (size_t)(ct * 16 + fr) * D + k0), bl = *(const bf16x8*)(p.rwt + (size_t)(NE + ct * 16 + fr) * D + k0);
                  acc[ct] = __builtin_amdgcn_mfma_f32_16x16x32_bf16(ah, bh, acc[ct], 0, 0, 0); acc[ct] = __builtin_amdgcn_mfma_f32_16x16x32_bf16(ah, bl, acc[ct], 0, 0, 0); acc[ct] = __builtin_amdgcn_mfma_f32_16x16x32_bf16(al, bh, acc[ct], 0, 0, 0); } }
#pragma unroll
          for (int ct = 0; ct < 4; ++ct)
#pragma unroll
              for (int i = 0; i < 4; ++i) PART[(wid * 16 + fq * 4 + i) * 64 + ct * 16 + fr] = acc[ct][i]; }
        __syncthreads();
        for (int i = tid; i < 16 * 64; i += NT) { float s = 0.f;
#pragma unroll
            for (int w = 0; w < 8; ++w) s += PART[w * 1024 + i];
            LOG[i] = s; }
        __syncthreads();
#pragma unroll 1
        for (int rr = 0; rr < 2; ++rr) {
            const int lr = wid * 2 + rr, r = r16 + lr;
            const float sc = sigmoidf_(LOG[lr * 64 + lane]), bi = sc + in.router_b[lane];
            float m1 = bi; m1 = fmaxf(m1, __shfl_xor(m1, 1)); m1 = fmaxf(m1, __shfl_xor(m1, 2)); m1 = fmaxf(m1, __shfl_xor(m1, 4));
            const unsigned long long eq = __ballot(bi == m1); const int first = __ffsll((long long)((eq >> (lane & ~7)) & 0xffull)) - 1 + (lane & ~7);
            float m2 = (lane == first) ? -1e30f : bi; m2 = fmaxf(m2, __shfl_xor(m2, 1)); m2 = fmaxf(m2, __shfl_xor(m2, 2)); m2 = fmaxf(m2, __shfl_xor(m2, 4));
            const float gs = m1 + m2; const int myg = lane >> 3; int rank = 0;
#pragma unroll
            for (int g = 0; g < NG; ++g) { const float og = __shfl(gs, g * 8); rank += (og > gs || (og == gs && g < myg)) ? 1 : 0; }
            float cand = rank < TG ? bi : -1e30f; float tsum = 0.f; int myidx = 0; float mysc = 0.f;
#pragma unroll
            for (int it = 0; it < TOPK; ++it) { const float m = wave_max(cand); const unsigned long long bm = __ballot(cand == m); const int win = __ffsll((long long)bm) - 1;
                const float ws = __shfl(sc, win); tsum += ws; if (lane == it) { myidx = win; mysc = ws; } if (lane == win) cand = -1e30f; }
            if (lane < TOPK) { const int rk = atomicAdd((int*)&HIST[myidx], 1);
                p.tope[(size_t)r * TOPK + lane] = myidx; p.gatev[(size_t)r * TOPK + lane] = mysc / tsum * 2.5f; p.lrank[(size_t)r * TOPK + lane] = rk; }
        }
        __syncthreads();
    }
    if (tid < 64) p.blkcnt[blockIdx.x * 64 + tid] = HIST[tid];
}

struct MoeP { const int* tope; const float* gatev; const int* lrank; const int* blkcnt;
              int* tilepre;
              int* list;
              int* sdst;
              float* sgate;
              int r0, nr, blk0, nbh, rpb, pad_; };
__device__ __forceinline__ void moe_assign(LAS unsigned char* lds, const MoeP p, int bid, int nblk) {
    LAS int* BASE = (LAS int*)lds; LAS int* CNT = BASE + 80; LAS int* BOFF = CNT + 80;
    const int tid = threadIdx.x;
    if (tid < NE) { int c = 0, bo = 0; for (int b = 0; b < p.nbh; ++b) { const int v = p.blkcnt[(p.blk0 + b) * 64 + tid]; if (p.blk0 + b < bid) bo += v; c += v; } CNT[tid] = c; BOFF[tid] = bo; }
    __syncthreads();
    if (tid == 0) { int s = 0; for (int e = 0; e < NE; ++e) { BASE[e] = s; s += (CNT[e] + BM - 1) / BM * BM; } BASE[NE] = s; CNT[NE] = p.nr; BASE[NE + 1] = s + p.nr;
        if (bid == 0) { for (int e = 0; e <= NEX; ++e) p.tilepre[e] = BASE[e] / BM; } }
    __syncthreads();
    if (bid >= p.blk0 && bid < p.blk0 + p.nbh) {
        const int rlo = p.r0 + (bid - p.blk0) * p.rpb;
        for (int i = tid; i < p.rpb * TOPK; i += NT) { const int r = rlo + i / TOPK, a = r * TOPK + i % TOPK, e = p.tope[a]; const int slot = BASE[e] + BOFF[e] + p.lrank[a];
            p.list[slot] = r; p.sdst[slot] = (r - p.r0) * SLOTS_PER_TOK + i % TOPK; p.sgate[slot] = p.gatev[a]; }
        for (int i = tid; i < p.rpb; i += NT) { const int r = rlo + i, slot = BASE[NE] + (r - p.r0); p.list[slot] = r; p.sdst[slot] = (r - p.r0) * SLOTS_PER_TOK + TOPK; p.sgate[slot] = 1.f; }
    }
    for (int e = bid; e < NE; e += nblk) { const int lo = BASE[e] + CNT[e], hi = BASE[e + 1]; for (int s = lo + tid; s < hi; s += NT) { p.list[s] = p.r0; p.sdst[s] = -1; p.sgate[s] = 0.f; } }
}
struct GroupOrder { const int* tilepre; int nN, G, c;
    __device__ __forceinline__ int tp(int i) const { return (int)__hip_atomic_load((const unsigned*)tilepre + i, __ATOMIC_RELAXED, __HIP_MEMORY_SCOPE_AGENT); }
    __device__ bool next(int i, Unit& u) const { const long L = (long)i * G + c; const int total = tp(NEX) * nN; if (L >= total) return false;
        const int T = (int)(L / nN); int e = 0; while (tp(e + 1) <= T) ++e; u.pm = T; u.pn = (int)(L % nN); u.e = __builtin_amdgcn_readfirstlane(e); return true; } };
struct EpiGU { bf16_t* act;
    __device__ __forceinline__ bool operator()(f32x4 (&acc)[2][2][4][2], const Unit& u, int wr, int wc, int fr, int fq) const {
        MK_FRAG_LOOP(r, c) { const f32x4 a = acc[ai][bj][m][0], b = acc[ai][bj][m][1];
            u32x2 w; w.x = cvt_pk_bf16(fast_silu(a[0]) * a[1], fast_silu(a[2]) * a[3]); w.y = cvt_pk_bf16(fast_silu(b[0]) * b[1], fast_silu(b[2]) * b[3]);
            *(u32x2*)(act + (size_t)(u.pm * BM + r) * EF + ((u.pn * BM + c) >> 1)) = w; }
        return false; } };
struct EpiDown { const int* sdst; const float* sgate; bf16_t* rowsb;
    __device__ __forceinline__ bool operator()(f32x4 (&acc)[2][2][4][2], const Unit& u, int wr, int wc, int fr, int fq) const {
        MK_FRAG_LOOP(r, c) { const int slot = u.pm * BM + r, dst = sdst[slot]; if (dst >= 0) { const float g = sgate[slot];
            f32x4 a = acc[ai][bj][m][0], b = acc[ai][bj][m][1];
#pragma unroll
            for (int j = 0; j < 4; ++j) { a[j] *= g; b[j] *= g; }
            *(u32x4*)(rowsb + (size_t)dst * D + u.pn * BM + c) = pack8(a, b); } }
        return false; } };
__device__ __forceinline__ void final_rows(LAS float* sm  , const In& in, const float* modpart, const bf16_t* rowsb, float* h1out, int b0, int r0, int row_lo, int row_hi) {
    const int tid = threadIdx.x, lane = tid & 63, wid = tid >> 6;
    const int mr = b0 + row_lo / SEQ;
    __syncthreads();
    for (int j = tid; j < D; j += NT) sm[j] = mod_value(in, modpart, mr, 5 * D + j);
    __syncthreads();
    for (int r = row_lo + wid; r < row_hi; r += NT / 64) {
        float v[16];
#pragma unroll
        for (int j = 0; j < 16; ++j) v[j] = 0.f;
        const bf16_t* rb = rowsb + (size_t)(r - r0) * SLOTS_PER_TOK * D;
#pragma unroll
        for (int s = 0; s < SLOTS_PER_TOK; ++s)
#pragma unroll
            for (int j = 0; j < 4; ++j) { const u32x2 w = *(const u32x2*)(rb + (size_t)s * D + j * 256 + lane * 4); v[4 * j] += bflo(w.x); v[4 * j + 1] += bfhi(w.x); v[4 * j + 2] += bflo(w.y); v[4 * j + 3] += bfhi(w.y); }
        float ss = 0.f;
#pragma unroll
        for (int j = 0; j < 16; ++j) ss += v[j] * v[j];
#pragma unroll
        for (int o = 32; o > 0; o >>= 1) ss += __shfl_xor(ss, o);
        const float rinv = 1.f / sqrtf(ss * (1.f / D) + NORM_EPS);
        float* hp = h1out + (size_t)r * D;
#pragma unroll
        for (int j = 0; j < 4; ++j) { const int c = j * 256 + lane * 4; f32x4 hv = *(const f32x4*)(hp + c);
#pragma unroll
            for (int q = 0; q < 4; ++q) hv[q] += sm[c + q] * (v[4 * j + q] * rinv * in.norm_g[3 * D + c + q]);
            *(f32x4*)(hp + c) = hv; }
    }
}
__device__ __forceinline__ void rwt_prep(const In& in, bf16_t* rwt, int bid, int nblk) {
    for (int i = bid * NT + threadIdx.x; i < NE * D; i += nblk * NT) { const int e = i / D, k = i % D; const float w = in.router_w[(size_t)k * NE + e]; const bf16_t h = f2bf(w); rwt[i] = h; rwt[(size_t)NE * D + i] = f2bf(w - bf2f(h)); }
}
}

using namespace mk;
constexpr size_t MiB = (size_t)1 << 20;
constexpr int NLAT = NB * SEQ, NCTXR = NB * CTX, NALL = NLAT + NCTXR, NRH = NLAT / 2, MAXSLOTS = NRH * SLOTS_PER_TOK + NE * BM;
constexpr size_t O_W1A = 0, O_W1C = O_W1A + (size_t)Z1_N * D * 2, O_WG = O_W1C + (size_t)ZC_N * D * 2, O_WBR = O_WG + (size_t)RW * AG_K * 2, O_WOUT = O_WBR + (size_t)2 * D * RW * 2,
                 O_RWT = O_WOUT + (size_t)D * D * 2, O_MODP = O_RWT + (size_t)2 * NE * D * 2, O_S_END = O_MODP + (size_t)MOD_SL * (NB + 1) * 6 * D * 4;
static_assert(O_S_END <= 27 * MiB, "S region");
constexpr size_t O_BAR = 27 * MiB;
constexpr size_t O_Z1 = 28 * MiB, O_R2 = O_Z1 + (size_t)NALL * Z1_N * 2;
static_assert(O_R2 == 334 * MiB, "z1 size");
constexpr size_t O_HD = O_R2, O_BON = O_HD + (size_t)2 * NLAT * LW * 2, O_AG = O_BON + (size_t)2 * NLAT * NH * 4, O_R2_END = O_AG + (size_t)NLAT * AG_K * 2;
static_assert(O_R2_END <= 512 * MiB, "R2");
constexpr size_t O_XNL = O_Z1, O_YB = O_XNL + (size_t)NLAT * D * 2, O_GATES = O_YB + (size_t)NLAT * LW * 2, O_MIXED = O_HD;
static_assert(O_GATES + (size_t)NLAT * 2 * D * 2 <= O_R2, "late R1");
constexpr size_t O_U = O_Z1, O_WGU = O_U + (size_t)NLAT * D * 2, O_WDN = O_WGU + (size_t)NEX * 2 * EF * D * 2, O_ROUT = O_WDN + (size_t)NEX * D * EF * 2;
constexpr size_t O_TOPE = O_ROUT, O_LRANK = O_TOPE + (size_t)NLAT * TOPK * 4, O_GATEV = O_LRANK + (size_t)NLAT * TOPK * 4, O_BLKCNT = O_GATEV + (size_t)NLAT * TOPK * 4, O_TILEPRE = O_BLKCNT + 256 * 64 * 4,
                 O_LIST = O_TILEPRE + 1024, O_SDST = O_LIST + (size_t)MAXSLOTS * 4, O_SGATE = O_SDST + (size_t)MAXSLOTS * 4, O_ACT = ((O_SGATE + (size_t)MAXSLOTS * 4 + 255) / 256) * 256,
                 O_ROWSB = ((O_ACT + (size_t)MAXSLOTS * EF * 2 + 255) / 256) * 256, O_END = O_ROWSB + (size_t)NRH * SLOTS_PER_TOK * D * 2;
static_assert(O_END <= 512 * MiB, "workspace");
static_assert(O_WGU >= O_YB && O_ROWSB >= O_GATES, "late layout");

struct MP { In in; float* out; unsigned char* ws; long ph_lo, ph_hi; };
constexpr int NPHASE = 17;

__global__ void __launch_bounds__(512, 2) mega(MP P) {
    extern __shared__ __attribute__((aligned(16))) unsigned char shm[];
    LAS unsigned char* lds = (LAS unsigned char*)shm;
    const In& in = P.in; unsigned char* ws = P.ws; const int bid = blockIdx.x, nblk = gridDim.x;
    bf16_t *W1a = (bf16_t*)(ws + O_W1A), *W1c = (bf16_t*)(ws + O_W1C), *Wg = (bf16_t*)(ws + O_WG), *Wbr = (bf16_t*)(ws + O_WBR), *Wout = (bf16_t*)(ws + O_WOUT), *rwt = (bf16_t*)(ws + O_RWT);
    float* modpart = (float*)(ws + O_MODP);
    bf16_t *z1 = (bf16_t*)(ws + O_Z1), *Hd = (bf16_t*)(ws + O_HD), *Ag = (bf16_t*)(ws + O_AG); float* bon = (float*)(ws + O_BON);
    bf16_t *xnl = (bf16_t*)(ws + O_XNL), *yb = (bf16_t*)(ws + O_YB), *gates = (bf16_t*)(ws + O_GATES), *mixed = (bf16_t*)(ws + O_MIXED);
    bf16_t *u = (bf16_t*)(ws + O_U), *Wgu = (bf16_t*)(ws + O_WGU), *Wdn = (bf16_t*)(ws + O_WDN), *act = (bf16_t*)(ws + O_ACT), *rowsb = (bf16_t*)(ws + O_ROWSB);
    int *tope = (int*)(ws + O_TOPE), *lrank = (int*)(ws + O_LRANK), *blkcnt = (int*)(ws + O_BLKCNT), *tilepre = (int*)(ws + O_TILEPRE), *list = (int*)(ws + O_LIST), *sdst = (int*)(ws + O_SDST);
    float *gatev = (float*)(ws + O_GATEV), *sgate = (float*)(ws + O_SGATE);
    bf16_t* xn_all = (bf16_t*)P.out;
    bf16_t* Y = (bf16_t*)P.out;
    float* y2h1 = P.out;
    const int ph_lo = (int)P.ph_lo, ph_hi = (int)P.ph_hi;
    volatile LAS unsigned* xst = (volatile LAS unsigned*)(lds + LDS_BYTES - 16);
    if (threadIdx.x == 0) { xst[0] = 0u; xst[1] = 0u; }
    __syncthreads();
    const XcdBarrier xb = xcd_barrier_post((unsigned*)(ws + O_BAR), xst);
    if (0 >= ph_lo && 0 < ph_hi) { if (0 > ph_lo) xcd_barrier(xb); const int ph = 0; (void)ph;
        { LAS float* tile = (LAS float*)lds; int base = 0;
            convT_job(tile, in.w_in, INC, D, W1a, D, Z1_N, CMapZ1{}, bid, nblk, base);
            convT_job(tile, in.w_in, INC, D, W1c, D, ZC_N, CMapZC{}, bid, nblk, base);
            convT_job(tile, in.rw_g_up, RW, GL, Wg, AG_K, RW, CMapId{}, bid, nblk, base);
            convT_job(tile, in.w_branch_a, D, RW, Wbr, RW, D, CMapId{}, bid, nblk, base);
            convT_job(tile, in.w_branch_b, D, LW, Wbr + (size_t)D * RW, LW, D, CMapId{}, bid, nblk, base);
            convT_job(tile, in.w_out, D, D, Wout, D, D, CMapId{}, bid, nblk, base);
            rwt_prep(in, rwt, bid, nblk);
            mod_partials((LAS float*)lds, in, modpart, bid, nblk); }
    }
    if (1 >= ph_lo && 1 < ph_hi) { if (1 > ph_lo) xcd_barrier(xb); const int ph = 1; (void)ph;
        { const int L = NLAT / nblk, Lc = NCTXR / nblk;
            xn_rows((LAS float*)lds, in, modpart, xn_all, 0, NB, bid * L, (bid + 1) * L);
            xn_rows((LAS float*)lds, in, modpart, xn_all, 0, NB, NLAT + bid * Lc, NLAT + (bid + 1) * Lc); }
    }
    if (2 >= ph_lo && 2 < ph_hi) { if (2 > ph_lo) xcd_barrier(xb); const int ph = 2; (void)ph;
        { GemmP g{xn_all, xn_all, W1a, 0, nullptr, D, 0}; StaticOrder S; S.init(NALL, Z1_N, nblk, bid); gemm_phase(lds, g, S, EpiStoreBf16{z1, Z1_N}); }
    }
    if (3 >= ph_lo && 3 < ph_hi) { if (3 > ph_lo) xcd_barrier(xb); const int ph = 3; (void)ph;
        { LruP lp{z1, Hd, 0, NB}; lru_phase(lds, in, lp, bid, nblk); __syncthreads();
                  RwkvP rp{z1, Y, bon, 0, NB}; rwkv_phase(lds, in, rp, bid, nblk); }
    }
    if (4 >= ph_lo && 4 < ph_hi) { if (4 > ph_lo) xcd_barrier(xb); const int ph = 4; (void)ph;
        { const int L = NLAT / nblk; PostP pp{z1, Y, bon, Ag, NLAT, 0}; rwkv_post_rows(in, pp, bid * L, (bid + 1) * L); }
    }
    if (5 >= ph_lo && 5 < ph_hi) { if (5 > ph_lo) xcd_barrier(xb); const int ph = 5; (void)ph;
        { const int L = NLAT / nblk; xn_rows((LAS float*)lds, in, modpart, xnl, 0, NB, bid * L, (bid + 1) * L); __syncthreads();
                  GemmP g{Ag, Ag, Wg, 0, nullptr, AG_K, 0}; StaticOrder S; S.init(NLAT, RW, nblk, bid); gemm_phase(lds, g, S, EpiYa{Y, Y + (size_t)NLAT * RW}); }
    }
    if (6 >= ph_lo && 6 < ph_hi) { if (6 > ph_lo) xcd_barrier(xb); const int ph = 6; (void)ph;
        { GemmP g{xnl, xnl, W1c, 0, nullptr, D, 0}; StaticOrder S; S.init(NLAT, ZC_N, nblk, bid); gemm_phase(lds, g, S, EpiZc{Hd, yb, gates, NLAT, 0}); }
    }
    if (7 >= ph_lo && 7 < ph_hi) { if (7 > ph_lo) xcd_barrier(xb); const int ph = 7; (void)ph;
        { GemmP g{Y + (size_t)NLAT * RW, yb, Wbr, (long)D * RW, nullptr, D, 0}; PairOrder S; S.S.init(NLAT, D, nblk, bid); gemm_phase(lds, g, S, EpiBranch{gates, mixed}); }
    }
    if (8 >= ph_lo && 8 < ph_hi) { if (8 > ph_lo) xcd_barrier(xb); const int ph = 8; (void)ph;
        { LAS float* tile = (LAS float*)lds; int base = 0;
            for (int e = 0; e < NE; ++e) {
                convT_job(tile, in.ex_w_gu + (size_t)e * D * 2 * EF, 2 * EF, D, Wgu + (size_t)e * 2 * EF * D, D, 2 * EF, CMapGU{EF}, bid, nblk, base);
                convT_job(tile, in.ex_w_down + (size_t)e * EF * D, D, EF, Wdn + (size_t)e * D * EF, EF, D, CMapId{}, bid, nblk, base); }
            convT_job(tile, in.sh_w_gu, 2 * SF, D, Wgu + (size_t)NE * 2 * EF * D, D, 2 * SF, CMapGU{SF}, bid, nblk, base);
            convT_job(tile, in.sh_w_down, D, SF, Wdn + (size_t)NE * D * EF, SF, D, CMapId{}, bid, nblk, base);
            __syncthreads();
            GemmP g{mixed, mixed, Wout, 0, nullptr, D, 0}; StaticOrder S; S.init(NLAT, D, nblk, bid); gemm_phase(lds, g, S, EpiF32{y2h1, D}); }
    }
    if (9 >= ph_lo && 9 < ph_hi) { if (9 > ph_lo) xcd_barrier(xb); const int ph = 9; (void)ph;
        { const int L = NLAT / nblk; RowP rp{y2h1, u, modpart, rwt, tope, gatev, lrank, blkcnt, 0, NLAT}; row_pass(lds, in, rp, bid * L, (bid + 1) * L); }
    }
    if (10 >= ph_lo && 10 < ph_hi) { if (10 > ph_lo) xcd_barrier(xb); const int ph = 10; (void)ph;
        { const int q = ph - 10, half = q >= 4 ? 1 : 0, st = q - 4 * half;
            const int rpb = NLAT / nblk;
            auto assign = [&](int hf) { MoeP mp{tope, gatev, lrank, blkcnt, tilepre, list, sdst, sgate, hf * NRH, NRH, hf * (nblk / 2), nblk / 2, rpb, 0}; moe_assign(lds, mp, bid, nblk); };
            auto fin = [&](int hf) { const int L = NRH / nblk, r0 = hf * NRH; final_rows((LAS float*)lds, in, modpart, rowsb, y2h1, 0, r0, r0 + bid * L, r0 + (bid + 1) * L); };
            if (ph == 10) assign(0);
            else if (ph == 11 || ph == 14) { GemmP g{u, u, Wgu, (long)2 * EF * D, list, D, 0}; GroupOrder S{tilepre, 2 * EF / BM, nblk, bid}; gemm_phase(lds, g, S, EpiGU{act}); }
            else if (ph == 12 || ph == 15) { GemmP g{act, act, Wdn, (long)D * EF, nullptr, EF, 0}; GroupOrder S{tilepre, D / BM, nblk, bid}; gemm_phase(lds, g, S, EpiDown{sdst, sgate, rowsb}); }
            else if (ph == 13) { fin(0); __syncthreads(); assign(1); }
            else if (ph == 16) fin(1);
            (void)half; (void)st; }
    }
    if (11 >= ph_lo && 11 < ph_hi) { if (11 > ph_lo) xcd_barrier(xb); const int ph = 11; (void)ph;
        { const int q = ph - 10, half = q >= 4 ? 1 : 0, st = q - 4 * half;
            const int rpb = NLAT / nblk;
            auto assign = [&](int hf) { MoeP mp{tope, gatev, lrank, blkcnt, tilepre, list, sdst, sgate, hf * NRH, NRH, hf * (nblk / 2), nblk / 2, rpb, 0}; moe_assign(lds, mp, bid, nblk); };
            auto fin = [&](int hf) { const int L = NRH / nblk, r0 = hf * NRH; final_rows((LAS float*)lds, in, modpart, rowsb, y2h1, 0, r0, r0 + bid * L, r0 + (bid + 1) * L); };
            if (ph == 10) assign(0);
            else if (ph == 11 || ph == 14) { GemmP g{u, u, Wgu, (long)2 * EF * D, list, D, 0}; GroupOrder S{tilepre, 2 * EF / BM, nblk, bid}; gemm_phase(lds, g, S, EpiGU{act}); }
            else if (ph == 12 || ph == 15) { GemmP g{act, act, Wdn, (long)D * EF, nullptr, EF, 0}; GroupOrder S{tilepre, D / BM, nblk, bid}; gemm_phase(lds, g, S, EpiDown{sdst, sgate, rowsb}); }
            else if (ph == 13) { fin(0); __syncthreads(); assign(1); }
            else if (ph == 16) fin(1);
            (void)half; (void)st; }
    }
    if (12 >= ph_lo && 12 < ph_hi) { if (12 > ph_lo) xcd_barrier(xb); const int ph = 12; (void)ph;
        { const int q = ph - 10, half = q >= 4 ? 1 : 0, st = q - 4 * half;
            const int rpb = NLAT / nblk;
            auto assign = [&](int hf) { MoeP mp{tope, gatev, lrank, blkcnt, tilepre, list, sdst, sgate, hf * NRH, NRH, hf * (nblk / 2), nblk / 2, rpb, 0}; moe_assign(lds, mp, bid, nblk); };
            auto fin = [&](int hf) { const int L = NRH / nblk, r0 = hf * NRH; final_rows((LAS float*)lds, in, modpart, rowsb, y2h1, 0, r0, r0 + bid * L, r0 + (bid + 1) * L); };
            if (ph == 10) assign(0);
            else if (ph == 11 || ph == 14) { GemmP g{u, u, Wgu, (long)2 * EF * D, list, D, 0}; GroupOrder S{tilepre, 2 * EF / BM, nblk, bid}; gemm_phase(lds, g, S, EpiGU{act}); }
            else if (ph == 12 || ph == 15) { GemmP g{act, act, Wdn, (long)D * EF, nullptr, EF, 0}; GroupOrder S{tilepre, D / BM, nblk, bid}; gemm_phase(lds, g, S, EpiDown{sdst, sgate, rowsb}); }
            else if (ph == 13) { fin(0); __syncthreads(); assign(1); }
            else if (ph == 16) fin(1);
            (void)half; (void)st; }
    }
    if (13 >= ph_lo && 13 < ph_hi) { if (13 > ph_lo) xcd_barrier(xb); const int ph = 13; (void)ph;
        { const int q = ph - 10, half = q >= 4 ? 1 : 0, st = q - 4 * half;
            const int rpb = NLAT / nblk;
            auto assign = [&](int hf) { MoeP mp{tope, gatev, lrank, blkcnt, tilepre, list, sdst, sgate, hf * NRH, NRH, hf * (nblk / 2), nblk / 2, rpb, 0}; moe_assign(lds, mp, bid, nblk); };
            auto fin = [&](int hf) { const int L = NRH / nblk, r0 = hf * NRH; final_rows((LAS float*)lds, in, modpart, rowsb, y2h1, 0, r0, r0 + bid * L, r0 + (bid + 1) * L); };
            if (ph == 10) assign(0);
            else if (ph == 11 || ph == 14) { GemmP g{u, u, Wgu, (long)2 * EF * D, list, D, 0}; GroupOrder S{tilepre, 2 * EF / BM, nblk, bid}; gemm_phase(lds, g, S, EpiGU{act}); }
            else if (ph == 12 || ph == 15) { GemmP g{act, act, Wdn, (long)D * EF, nullptr, EF, 0}; GroupOrder S{tilepre, D / BM, nblk, bid}; gemm_phase(lds, g, S, EpiDown{sdst, sgate, rowsb}); }
            else if (ph == 13) { fin(0); __syncthreads(); assign(1); }
            else if (ph == 16) fin(1);
            (void)half; (void)st; }
    }
    if (14 >= ph_lo && 14 < ph_hi) { if (14 > ph_lo) xcd_barrier(xb); const int ph = 14; (void)ph;
        { const int q = ph - 10, half = q >= 4 ? 1 : 0, st = q - 4 * half;
            const int rpb = NLAT / nblk;
            auto assign = [&](int hf) { MoeP mp{tope, gatev, lrank, blkcnt, tilepre, list, sdst, sgate, hf * NRH, NRH, hf * (nblk / 2), nblk / 2, rpb, 0}; moe_assign(lds, mp, bid, nblk); };
            auto fin = [&](int hf) { const int L = NRH / nblk, r0 = hf * NRH; final_rows((LAS float*)lds, in, modpart, rowsb, y2h1, 0, r0, r0 + bid * L, r0 + (bid + 1) * L); };
            if (ph == 10) assign(0);
            else if (ph == 11 || ph == 14) { GemmP g{u, u, Wgu, (long)2 * EF * D, list, D, 0}; GroupOrder S{tilepre, 2 * EF / BM, nblk, bid}; gemm_phase(lds, g, S, EpiGU{act}); }
            else if (ph == 12 || ph == 15) { GemmP g{act, act, Wdn, (long)D * EF, nullptr, EF, 0}; GroupOrder S{tilepre, D / BM, nblk, bid}; gemm_phase(lds, g, S, EpiDown{sdst, sgate, rowsb}); }
            else if (ph == 13) { fin(0); __syncthreads(); assign(1); }
            else if (ph == 16) fin(1);
            (void)half; (void)st; }
    }
    if (15 >= ph_lo && 15 < ph_hi) { if (15 > ph_lo) xcd_barrier(xb); const int ph = 15; (void)ph;
        { const int q = ph - 10, half = q >= 4 ? 1 : 0, st = q - 4 * half;
            const int rpb = NLAT / nblk;
            auto assign = [&](int hf) { MoeP mp{tope, gatev, lrank, blkcnt, tilepre, list, sdst, sgate, hf * NRH, NRH, hf * (nblk / 2), nblk / 2, rpb, 0}; moe_assign(lds, mp, bid, nblk); };
            auto fin = [&](int hf) { const int L = NRH / nblk, r0 = hf * NRH; final_rows((LAS float*)lds, in, modpart, rowsb, y2h1, 0, r0, r0 + bid * L, r0 + (bid + 1) * L); };
            if (ph == 10) assign(0);
            else if (ph == 11 || ph == 14) { GemmP g{u, u, Wgu, (long)2 * EF * D, list, D, 0}; GroupOrder S{tilepre, 2 * EF / BM, nblk, bid}; gemm_phase(lds, g, S, EpiGU{act}); }
            else if (ph == 12 || ph == 15) { GemmP g{act, act, Wdn, (long)D * EF, nullptr, EF, 0}; GroupOrder S{tilepre, D / BM, nblk, bid}; gemm_phase(lds, g, S, EpiDown{sdst, sgate, rowsb}); }
            else if (ph == 13) { fin(0); __syncthreads(); assign(1); }
            else if (ph == 16) fin(1);
            (void)half; (void)st; }
    }
    if (16 >= ph_lo && 16 < ph_hi) { if (16 > ph_lo) xcd_barrier(xb); const int ph = 16; (void)ph;
        { const int q = ph - 10, half = q >= 4 ? 1 : 0, st = q - 4 * half;
            const int rpb = NLAT / nblk;
            auto assign = [&](int hf) { MoeP mp{tope, gatev, lrank, blkcnt, tilepre, list, sdst, sgate, hf * NRH, NRH, hf * (nblk / 2), nblk / 2, rpb, 0}; moe_assign(lds, mp, bid, nblk); };
            auto fin = [&](int hf) { const int L = NRH / nblk, r0 = hf * NRH; final_rows((LAS float*)lds, in, modpart, rowsb, y2h1, 0, r0, r0 + bid * L, r0 + (bid + 1) * L); };
            if (ph == 10) assign(0);
            else if (ph == 11 || ph == 14) { GemmP g{u, u, Wgu, (long)2 * EF * D, list, D, 0}; GroupOrder S{tilepre, 2 * EF / BM, nblk, bid}; gemm_phase(lds, g, S, EpiGU{act}); }
            else if (ph == 12 || ph == 15) { GemmP g{act, act, Wdn, (long)D * EF, nullptr, EF, 0}; GroupOrder S{tilepre, D / BM, nblk, bid}; gemm_phase(lds, g, S, EpiDown{sdst, sgate, rowsb}); }
            else if (ph == 13) { fin(0); __syncthreads(); assign(1); }
            else if (ph == 16) fin(1);
            (void)half; (void)st; }
    }
}
extern "C" void kernel_launch(void* const* d_in, const int* in_sizes, int n_in, void* d_out, int out_size, void* d_ws, size_t ws_size, hipStream_t stream) {
    static int grid = 0;
    if (grid == 0) {
        int dev = 0, cus = 0; hipGetDevice(&dev); hipDeviceGetAttribute(&cus, hipDeviceAttributeMultiprocessorCount, dev);
        hipFuncSetAttribute((const void*)mega, hipFuncAttributeMaxDynamicSharedMemorySize, LDS_BYTES);
        grid = cus;
        if (ws_size < O_END || grid != 256) fprintf(stderr, "kernel_launch: unexpected ws_size %zu (need %zu) or CU count %d\n", ws_size, (size_t)O_END, grid);
    }
    hipMemsetAsync((char*)d_ws + O_BAR, 0, XCD_BAR_WORDS * 4, stream);
    MP P; memset(&P, 0, sizeof(P));
    const float** f = (const float**)&P.in; for (int i = 0; i < 32; ++i) f[i] = (const float*)d_in[i];
    P.out = (float*)d_out; P.ws = (unsigned char*)d_ws;
#ifdef MK_PER_PHASE
    for (int ph = 0; ph < NPHASE; ++ph) { P.ph_lo = ph; P.ph_hi = ph + 1; hipLaunchKernelGGL(mega, dim3(grid), dim3(NT), LDS_BYTES, stream, P); }
#else
    P.ph_lo = 0; P.ph_hi = NPHASE;
    void* args[] = {&P};
    hipError_t e = hipLaunchCooperativeKernel((void*)mega, dim3(grid), dim3(NT), args, LDS_BYTES, stream);
    if (e != hipSuccess) fprintf(stderr, "cooperative launch failed: %s (grid %d)\n", hipGetErrorString(e), grid);
#endif
}
```

```cpp
#include <hip/hip_runtime.h>
#include <cstdio>
#include <cstring>
#define HD __host__ __device__ __forceinline__
static hipStream_t g_stream;

#ifdef SMALL
constexpr int D = 128, NB = 2, SEQ = 64, GW = 8, CTX = 16, RW = 128, RH = 64, DL = 16, AL = 16, GL = 24, LW = 128, LB = 2, NE = 8, TOPK = 3, NG = 4, TG = 2, EF = 32, SF = 32;
#else
constexpr int D = 1024, NB = 8, SEQ = 4096, GW = 64, CTX = 256, RW = 1024, RH = 64, DL = 64, AL = 64, GL = 160, LW = 1024, LB = 16, NE = 64, TOPK = 6, NG = 8, TG = 4, EF = 256, SF = 256;
#endif
constexpr int NH = RW / RH, LBS = LW / LB, ROWS = SEQ / GW, TA = CTX + SEQ;
constexpr int OFF_R = 0, OFF_K = RW, OFF_V = 2 * RW, OFF_WD = 3 * RW, OFF_AD = OFF_WD + 2 * DL, OFF_GD = OFF_AD + 2 * AL, RC = OFF_GD + GL;
constexpr int OFF_LX = RC, OFF_LG = OFF_LX + LW, OFF_GATE = OFF_LG + LW, INC = OFF_GATE + 2 * D;
constexpr int EPG = NE / NG, NASG = SEQ * TOPK;
#define NORM_EPS 1e-6f
#define LNX_EPS 64e-5f

HD float sigmoidf_(float x) { return 1.f / (1.f + expf(-x)); }
HD float softplusf_(float x) { return x > 20.f ? x : log1pf(expf(x)); }
HD float siluf_(float x) { return x * sigmoidf_(x); }
HD float gelu_tanhf_(float x) { return 0.5f * x * (1.f + tanhf(0.7978845608028654f * (x + 0.044715f * x * x * x))); }

struct In {
    const float *x, *c, *ctx, *c_ctx, *w_mod, *b_mod, *norm_g, *w_in, *shift_mu, *rw_w0, *rw_w_up, *rw_a0, *rw_a_up, *rw_g_up, *rw_k_k, *rw_k_a, *rw_r_k, *rw_lnx,
        *lru_conv_w, *lru_conv_b, *lru_gate_w, *lru_gate_b, *lru_l, *w_branch_a, *w_branch_b, *w_out, *router_w, *router_b, *ex_w_gu, *ex_w_down, *sh_w_gu, *sh_w_down;
};


namespace mk {
#define LAS __attribute__((address_space(3)))
typedef unsigned short bf16_t;
typedef short bf16x8 __attribute__((ext_vector_type(8)));
typedef float f32x4 __attribute__((ext_vector_type(4)));
typedef float f32x2 __attribute__((ext_vector_type(2)));
typedef unsigned u32x4 __attribute__((ext_vector_type(4)));
typedef unsigned u32x2 __attribute__((ext_vector_type(2)));
constexpr int NT = 512;
constexpr int BM = 256, BK = 64, HALF = 128, HTB = HALF * BK * 2, STAGE_BYTES = 8 * HTB;
constexpr int LDS_BYTES = 160 * 1024 - 1024;

constexpr int Z1_LX = 3584, Z1_N = 4608;
constexpr int ZC_N = 3072;

__device__ __forceinline__ unsigned cvt_pk_bf16(float lo, float hi) { unsigned r; asm volatile("v_cvt_pk_bf16_f32 %0, %1, %2" : "=v"(r) : "v"(lo), "v"(hi)); return r; }
__device__ __forceinline__ bf16_t f2bf(float f) { unsigned u = __float_as_uint(f); u += 0x7FFFu + ((u >> 16) & 1u); return (bf16_t)(u >> 16); }
__device__ __forceinline__ float bf2f(bf16_t b) { return __uint_as_float(((unsigned)b) << 16); }
__device__ __forceinline__ float bflo(unsigned w) { return __uint_as_float(w << 16); }
__device__ __forceinline__ float bfhi(unsigned w) { return __uint_as_float(w & 0xffff0000u); }

__device__ __forceinline__ float fast_rcp(float x) { return __builtin_amdgcn_rcpf(x); }
__device__ __forceinline__ float fast_sigmoid(float x) { return fast_rcp(1.f + __expf(-x)); }
__device__ __forceinline__ float fast_tanh(float x) { return 1.f - 2.f * fast_rcp(1.f + __expf(2.f * x)); }
__device__ __forceinline__ float fast_softplus(float x) { return x > 15.f ? x : __logf(1.f + __expf(x)); }
__device__ __forceinline__ float fast_silu(float x) { return x * fast_sigmoid(x); }
__device__ __forceinline__ float fast_gelu_tanh(float x) { return x * fast_sigmoid(1.5957691216057308f * (x + 0.044715f * x * x * x)); }
__device__ __forceinline__ int lds_byte(int r, int c) { const int st = (r >> 4) * 2 + (c >> 5), rr = r & 15, cc = c & 31, ob = rr * 64 + cc * 2; return st * 1024 + (ob ^ (((ob >> 9) & 1) << 5)); }
__device__ __forceinline__ void stage_rc(int b, int& R, int& C) { const int st = b / 1024, sb = b % 1024, swz = sb ^ (((sb >> 9) & 1) << 5); R = (st >> 1) * 16 + swz / 64; C = (st & 1) * 32 + (swz % 64) / 2; }
__device__ __forceinline__ int perm32(int rho) { const int n = rho >> 4, i = rho & 15; return 8 * (i >> 2) + 4 * n + (i & 3); }

struct Unit { int pm, pn, e; };
struct GemmP { const bf16_t* A0; const bf16_t* A1; const bf16_t* Bt; long strideB; const int* gather; int K; int pad_; };

struct StaticOrder {
    int nM, nN, nwg, G, c;
    __device__ void init(int M, int N, int G_, int c_) { nM = M / BM; nN = N / BM; nwg = nM * nN; G = G_; c = c_; }
    __device__ bool next(int i, Unit& u) const {
        const long L = (long)i * G + c; if (L >= nwg) return false;
        int wgid = (int)L; { const int q = nwg / 8, r = nwg % 8, xcd = wgid % 8, off = wgid / 8; wgid = (xcd < r ? xcd * (q + 1) : r * (q + 1) + (xcd - r) * q) + off; }
        const int nig = 8 * nN, gid = wgid / nig, fm = gid * 8, gsz = (nM - fm) < 8 ? (nM - fm) : 8;
        u.pm = fm + ((wgid % nig) % gsz); u.pn = (wgid % nig) / gsz; u.e = 0; return true;
    }
};

#define MK_FRAG_LOOP(ROW, COL) \
    _Pragma("unroll") for (int ai = 0; ai < 2; ++ai) _Pragma("unroll") for (int m = 0; m < 4; ++m) _Pragma("unroll") for (int bj = 0; bj < 2; ++bj) \
        if (const int ROW = ai * HALF + wr * 64 + m * 16 + fr; true) if (const int COL = bj * HALF + wc * 32 + 8 * fq; true)

template <class Epi, class Sched>
__device__ __forceinline__ void gemm_phase(LAS unsigned char* lds, const GemmP g, const Sched& S, const Epi& E) {
    const int tid = threadIdx.x, wid = __builtin_amdgcn_readfirstlane(tid >> 6), lane = tid & 63, wr = wid >> 2, wc = wid & 3, fr = lane & 15, fq = lane >> 4;
    int K = g.K; asm volatile("" : "+s"(K));
    const int nt = K / BK;
    int RA[2], CA[2]; unsigned voffB[2];
#pragma unroll
    for (int i = 0; i < 2; ++i) { int R, C; stage_rc(tid * 16 + i * 8192, R, C); RA[i] = R; CA[i] = C; const int Rb = (R & ~31) + perm32(R & 31); voffB[i] = (unsigned)(Rb * K + C) * 2u; }
    const size_t kstep = (size_t)(BK * 2), hstepB = (size_t)HALF * K * 2, tstepB = 2 * hstepB;
    const unsigned ldsw = (unsigned)wid * 1024u;
    const int aoff = lds_byte(wr * 64 + fr, fq * 8), boff = lds_byte(wc * 32 + fr, fq * 8);
#define MK_SA(b, h) (((b) * 2 + (h)) * HTB)
#define MK_SB(b, h) ((4 + (b) * 2 + (h)) * HTB)
#define MK_STAGE(bufoff, gbase, voff) do { _Pragma("unroll") for (int _i = 0; _i < 2; ++_i) \
        __builtin_amdgcn_global_load_lds((const unsigned*)((const char*)(gbase) + (voff)[_i]), (LAS unsigned*)(lds + (bufoff) + ldsw + _i * 8192), 16, 0, 0); } while (0)
#define MK_LDA(dst, b, h) do { _Pragma("unroll") for (int m = 0; m < 4; ++m) _Pragma("unroll") for (int k = 0; k < 2; ++k) dst[m][k] = *(const LAS bf16x8*)(lds + MK_SA(b, h) + aoff + m * 2048 + k * 1024); } while (0)
#define MK_LDB(dst, b, h) do { _Pragma("unroll") for (int n = 0; n < 2; ++n) _Pragma("unroll") for (int k = 0; k < 2; ++k) dst[n][k] = *(const LAS bf16x8*)(lds + MK_SB(b, h) + boff + n * 2048 + k * 1024); } while (0)
#define MK_MMA(ai, bj, At, Bt) do { __builtin_amdgcn_s_setprio(1); _Pragma("unroll") for (int m = 0; m < 4; ++m) _Pragma("unroll") for (int n = 0; n < 2; ++n) _Pragma("unroll") for (int k = 0; k < 2; ++k) \
        acc[ai][bj][m][n] = __builtin_amdgcn_mfma_f32_16x16x32_bf16(Bt[n][k], At[m][k], acc[ai][bj][m][n], 0, 0, 0); __builtin_amdgcn_s_setprio(0); } while (0)
#define MK_WAIT_V(n) asm volatile("s_waitcnt vmcnt(" #n ")" ::: "memory")
#define MK_WAIT_L(n) asm volatile("s_waitcnt lgkmcnt(" #n ")" ::: "memory")
#define MK_BAR __builtin_amdgcn_s_barrier()
#define MK_SCHED __builtin_amdgcn_sched_barrier(0)
    Unit cur, nxt; int ui = 0;
    if (!S.next(0, cur)) return;
    f32x4 acc[2][2][4][2];
#pragma unroll
    for (int a = 0; a < 2; ++a)
#pragma unroll
        for (int b = 0; b < 2; ++b)
#pragma unroll
            for (int m = 0; m < 4; ++m)
#pragma unroll
                for (int n = 0; n < 2; ++n) acc[a][b][m][n] = (f32x4){0.f, 0.f, 0.f, 0.f};
    bf16x8 At[4][2], B0[2][2], B1[2][2];
    unsigned vA[2][2], vAn[2][2];
    auto a_voff = [&](const Unit& u, unsigned (&vo)[2][2]) {
#pragma unroll
        for (int h = 0; h < 2; ++h)
#pragma unroll
            for (int i = 0; i < 2; ++i) { const int row = u.pm * BM + h * HALF + RA[i]; const int arow = g.gather ? g.gather[row] : row; vo[h][i] = (unsigned)((size_t)arow * K + CA[i]) * 2u; }
    };
    a_voff(cur, vA);
    const char* cA = (const char*)(cur.e ? g.A1 : g.A0);
    const char* cB = (const char*)g.Bt + ((size_t)cur.e * g.strideB) * 2 + (size_t)cur.pn * tstepB;
    MK_STAGE(MK_SB(0, 0), cB, voffB); MK_STAGE(MK_SA(0, 0), cA, vA[0]); MK_STAGE(MK_SB(0, 1), cB + hstepB, voffB); MK_STAGE(MK_SA(0, 1), cA, vA[1]);
    if (wr == 1) MK_BAR;
    MK_WAIT_V(4); MK_BAR;
    MK_STAGE(MK_SB(1, 0), cB + kstep, voffB); MK_STAGE(MK_SA(1, 0), cA + kstep, vA[0]); MK_STAGE(MK_SB(1, 1), cB + hstepB + kstep, voffB);
    MK_WAIT_V(6); MK_BAR;
    for (;;) {
        const bool has_next = S.next(ui + 1, nxt);
        const char* nA = has_next ? (const char*)(nxt.e ? g.A1 : g.A0) : cA;
        const char* nB = has_next ? (const char*)g.Bt + ((size_t)nxt.e * g.strideB) * 2 + (size_t)nxt.pn * tstepB : cB;
        for (int t = 0; t < nt; t += 2) {
            const bool last = (t == nt - 2);
            if (last) { if (has_next) a_voff(nxt, vAn); else {
#pragma unroll
                for (int h = 0; h < 2; ++h)
#pragma unroll
                    for (int i = 0; i < 2; ++i) vAn[h][i] = vA[h][i]; } }
            const char* a1 = cA + (size_t)(t + 1) * kstep;
            const char* a2 = last ? nA : cA + (size_t)(t + 2) * kstep; const char* b2 = last ? nB : cB + (size_t)(t + 2) * kstep;
            const char* a3 = a2 + kstep; const char* b3 = b2 + kstep;
            unsigned v2[2][2];
#pragma unroll
            for (int h = 0; h < 2; ++h)
#pragma unroll
                for (int i = 0; i < 2; ++i) v2[h][i] = last ? vAn[h][i] : vA[h][i];
            MK_LDB(B0, 0, 0); MK_SCHED; MK_LDA(At, 0, 0); MK_STAGE(MK_SA(1, 1), a1, vA[1]);
            MK_WAIT_L(8); MK_BAR; MK_WAIT_L(0); MK_MMA(0, 0, At, B0); MK_BAR; MK_SCHED;
            MK_LDB(B1, 0, 1); MK_STAGE(MK_SB(0, 0), b2, voffB);
            MK_BAR; MK_WAIT_L(0); MK_MMA(0, 1, At, B1); MK_BAR;
            MK_LDA(At, 0, 1); MK_STAGE(MK_SA(0, 0), a2, v2[0]);
            MK_BAR; MK_WAIT_L(0); MK_MMA(1, 0, At, B0); MK_BAR; MK_SCHED;
            MK_STAGE(MK_SB(0, 1), b2 + hstepB, voffB);
            MK_WAIT_V(6); MK_BAR; MK_MMA(1, 1, At, B1); MK_BAR;
            MK_LDB(B0, 1, 0); MK_SCHED; MK_LDA(At, 1, 0); MK_STAGE(MK_SA(0, 1), a2, v2[1]);
            MK_WAIT_L(8); MK_BAR; MK_WAIT_L(0); MK_MMA(0, 0, At, B0); MK_BAR; MK_SCHED;
            MK_LDB(B1, 1, 1); MK_STAGE(MK_SB(1, 0), b3, voffB);
            MK_BAR; MK_WAIT_L(0); MK_MMA(0, 1, At, B1); MK_BAR;
            MK_LDA(At, 1, 1); MK_STAGE(MK_SA(1, 0), a3, v2[0]);
            MK_BAR; MK_WAIT_L(0); MK_MMA(1, 0, At, B0); MK_BAR; MK_SCHED;
            MK_STAGE(MK_SB(1, 1), b3 + hstepB, voffB);
            MK_WAIT_V(6); MK_BAR; MK_MMA(1, 1, At, B1); MK_BAR;
        }
        const bool keep = E(acc, cur, wr, wc, fr, fq);
        if (!has_next) break;
        if (!keep) {
#pragma unroll
            for (int a = 0; a < 2; ++a)
#pragma unroll
                for (int b = 0; b < 2; ++b)
#pragma unroll
                    for (int m = 0; m < 4; ++m)
#pragma unroll
                        for (int n = 0; n < 2; ++n) acc[a][b][m][n] = (f32x4){0.f, 0.f, 0.f, 0.f};
        }
        cur = nxt; cA = nA; cB = nB; ++ui;
#pragma unroll
        for (int h = 0; h < 2; ++h)
#pragma unroll
            for (int i = 0; i < 2; ++i) vA[h][i] = vAn[h][i];
    }
    MK_WAIT_V(0);
    if (wr == 0) MK_BAR;
    MK_BAR;
#undef MK_SA
#undef MK_SB
#undef MK_STAGE
#undef MK_LDA
#undef MK_LDB
#undef MK_MMA
#undef MK_WAIT_V
#undef MK_WAIT_L
#undef MK_BAR
#undef MK_SCHED
}

__device__ __forceinline__ u32x4 pack8(const f32x4 a, const f32x4 b) { u32x4 w; w.x = cvt_pk_bf16(a[0], a[1]); w.y = cvt_pk_bf16(a[2], a[3]); w.z = cvt_pk_bf16(b[0], b[1]); w.w = cvt_pk_bf16(b[2], b[3]); return w; }
struct EpiStoreBf16 {
    bf16_t* O; long ldc;
    __device__ __forceinline__ bool operator()(const f32x4 (&acc)[2][2][4][2], const Unit& u, int wr, int wc, int fr, int fq) const {
        MK_FRAG_LOOP(r, c) { *(u32x4*)(O + (size_t)(u.pm * BM + r) * ldc + u.pn * BM + c) = pack8(acc[ai][bj][m][0], acc[ai][bj][m][1]); }
        return false;
    }
};

struct CMapZ1 { __device__ int operator()(int n) const { return n < RC ? n : (n < Z1_LX ? -1 : OFF_LX + (n - Z1_LX)); } };
struct CMapZC { __device__ int operator()(int n) const { return OFF_LG + n; } };
struct CMapId { __device__ int operator()(int n) const { return n; } };
struct CMapGU { int F; __device__ int operator()(int n) const { return (n & 1) * F + (n >> 1); } };
template <class CM>
__device__ __forceinline__ void convT_tile(LAS float* tile  , const float* src, int lds_, int Ks, bf16_t* dst, int Kd, int n0, int k0, const CM& cm) {
    const int tid = threadIdx.x;
    { const int kk = tid >> 3, nn8 = (tid & 7) * 8; const int k = k0 + kk;
#pragma unroll
      for (int j = 0; j < 8; ++j) { const int sc = cm(n0 + nn8 + j); tile[kk * 65 + nn8 + j] = (k < Ks && sc >= 0) ? src[(size_t)k * lds_ + sc] : 0.f; } }
    __syncthreads();
    { const int nn = tid >> 3, kk8 = (tid & 7) * 8; f32x4 a, b;
#pragma unroll
      for (int j = 0; j < 4; ++j) { a[j] = tile[(kk8 + j) * 65 + nn]; b[j] = tile[(kk8 + 4 + j) * 65 + nn]; }
      *(u32x4*)(dst + (size_t)(n0 + nn) * Kd + k0 + kk8) = pack8(a, b); }
    __syncthreads();
}
template <class CM>
__device__ __forceinline__ void convT_job(LAS float* tile, const float* src, int lds_, int Ks, bf16_t* dst, int Kd, int N, const CM& cm, int bid, int nblk, int& base) {
    const int tn = N / 64, tk = Kd / 64, nt = tn * tk;
    int first = (bid - base % nblk + nblk) % nblk;
    for (int t = first; t < nt; t += nblk) convT_tile(tile, src, lds_, Ks, dst, Kd, (t / tk) * 64, (t % tk) * 64, cm);
    base += nt;
}

constexpr int MOD_SL = 16, MOD_KS = D / MOD_SL;
__device__ __forceinline__ void mod_partials(LAS float* sl  , const In& in, float* part  , int bid, int nblk) {
    const int ncc = 6 * D / NT, nitem = MOD_SL * ncc;
    for (int it = bid; it < nitem; it += nblk) {
        const int s = it / ncc, j = (it % ncc) * NT + threadIdx.x;
        for (int i = threadIdx.x; i < (NB + 1) * MOD_KS; i += NT) { const int r = i / MOD_KS, k = s * MOD_KS + i % MOD_KS; const float cv = r < NB ? in.c[r * D + k] : in.c_ctx[k]; sl[i] = siluf_(cv); }
        __syncthreads();
        float acc[NB + 1];
#pragma unroll
        for (int r = 0; r <= NB; ++r) acc[r] = 0.f;
        for (int k = 0; k < MOD_KS; ++k) { const float w = in.w_mod[(size_t)(s * MOD_KS + k) * 6 * D + j];
#pragma unroll
            for (int r = 0; r <= NB; ++r) acc[r] += sl[r * MOD_KS + k] * w; }
#pragma unroll
        for (int r = 0; r <= NB; ++r) part[((size_t)s * (NB + 1) + r) * 6 * D + j] = acc[r];
        __syncthreads();
    }
}
__device__ __forceinline__ float mod_value(const In& in, const float* part, int r, int j) {
    float s = in.b_mod[j];
#pragma unroll
    for (int q = 0; q < MOD_SL; ++q) s += part[((size_t)q * (NB + 1) + r) * 6 * D + j];
    return s;
}

__device__ __forceinline__ void xn_rows(LAS float* sm  , const In& in, const float* part, bf16_t* xn, int b0, int nb, int row_lo, int row_hi) {
    const int nlat = nb * SEQ, wid = threadIdx.x >> 6, lane = threadIdx.x & 63;
    int cur_mr = -1;
    for (int rbase = row_lo; rbase < row_hi; rbase += 8) {
        const int mr = rbase < nlat ? b0 + rbase / SEQ : NB;
        if (mr != cur_mr) { __syncthreads(); for (int j = threadIdx.x; j < 2 * D; j += NT) sm[j] = mod_value(in, part, mr, j); __syncthreads(); cur_mr = mr; }
        const int r = rbase + wid; if (r >= row_hi) continue;
        const float* src = r < nlat ? in.x + ((size_t)b0 * SEQ + r) * D : in.ctx + ((size_t)b0 * CTX + (r - nlat)) * D;
        f32x4 v[4]; float ss = 0.f;
#pragma unroll
        for (int j = 0; j < 4; ++j) { v[j] = *(const f32x4*)(src + j * 256 + lane * 4); ss += v[j][0] * v[j][0] + v[j][1] * v[j][1] + v[j][2] * v[j][2] + v[j][3] * v[j][3]; }
#pragma unroll
        for (int o = 32; o > 0; o >>= 1) ss += __shfl_xor(ss, o);
        const float rinv = 1.f / sqrtf(ss * (1.f / D) + NORM_EPS);
#pragma unroll
        for (int j = 0; j < 4; ++j) { const int c = j * 256 + lane * 4; float o[4];
#pragma unroll
            for (int q = 0; q < 4; ++q) o[q] = (v[j][q] * rinv * in.norm_g[c + q]) * (1.f + sm[D + c + q]) + sm[c + q];
            u32x2 w; w.x = cvt_pk_bf16(o[0], o[1]); w.y = cvt_pk_bf16(o[2], o[3]); *(u32x2*)(xn + (size_t)r * D + c) = w; }
    }
}
}

namespace mk {
#define XB_TMO      128
#define XB_XCNT(j)  (256  + 64 * (j))
#define XB_XSUB(j)  (1280 + 64 * (j))
#define XB_XGEN(j)  (2304 + 64 * (j))
#define XB_TOP      3328
#define XB_TOPGEN   3392
#define XCD_BAR_WORDS 3456
#define XB_SPIN_CAP (1u << 18)
__device__ __forceinline__ unsigned xb_ld(unsigned* p)              { return __hip_atomic_load(p, __ATOMIC_RELAXED, __HIP_MEMORY_SCOPE_AGENT); }
__device__ __forceinline__ unsigned xb_add(unsigned* p, unsigned v) { return __hip_atomic_fetch_add(p, v, __ATOMIC_RELAXED, __HIP_MEMORY_SCOPE_AGENT); }
__device__ __forceinline__ unsigned xb_xcc_id() { return (unsigned)__builtin_amdgcn_s_getreg((3 << 11) | 20) & 0xFu; }
#define XB_SPIN(cond, bar) do { unsigned _sp = 0; while (cond) { __builtin_amdgcn_s_sleep(1); \
    if ((++_sp & 255u) == 0u) { if (xb_ld(&(bar)[XB_TMO])) break; if (_sp > XB_SPIN_CAP) { atomicAdd(&(bar)[XB_TMO], 1u); break; } } } } while (0)
struct XcdBarrier { unsigned* bar; unsigned x; volatile LAS unsigned* st; };
__device__ __forceinline__ XcdBarrier xcd_barrier_post(unsigned* bar, volatile LAS unsigned* st) {
    XcdBarrier b; b.bar = bar; b.x = xb_xcc_id(); b.st = st;
    if (threadIdx.x == 0) (void)xb_add(&bar[XB_XCNT(b.x)], 1u);
    return b;
}
__device__ __forceinline__ void xcd_barrier_complete(unsigned* bar, unsigned x, unsigned& nloc, unsigned& nx) {
    const unsigned G = gridDim.x * gridDim.y * gridDim.z;
    unsigned sum, cnt, mine, sp = 0u;
    for (;;) {
        sum = 0u; cnt = 0u; mine = 0u;
#pragma unroll
        for (unsigned j = 0; j < 16; ++j) { const unsigned c = xb_ld(&bar[XB_XCNT(j)]); sum += c; cnt += (c > 0u) ? 1u : 0u; mine = (j == x) ? c : mine; }
        if (sum == G) break;
        __builtin_amdgcn_s_sleep(1);
        if ((++sp & 255u) == 0u) { if (xb_ld(&bar[XB_TMO])) break; if (sp > XB_SPIN_CAP) { atomicAdd(&bar[XB_TMO], 1u); break; } }
    }
    nloc = mine > 0u ? mine : 1u; nx = cnt > 0u ? cnt : 1u;
}
__device__ __forceinline__ void xcd_barrier(const XcdBarrier& b) {
    asm volatile("s_waitcnt vmcnt(0)" ::: "memory");
    __syncthreads();
    if (threadIdx.x == 0) {
        unsigned* bar = b.bar;
        __builtin_amdgcn_s_waitcnt(0);
        unsigned nloc = b.st[0], nx = b.st[1];
        if (nloc == 0u) { xcd_barrier_complete(bar, b.x, nloc, nx); b.st[0] = nloc; b.st[1] = nx; }
        const unsigned old = xb_add(&bar[XB_XSUB(b.x)], 1u);
        const unsigned gen = old / nloc;
        if (old + 1u == (gen + 1u) * nloc) {
            __builtin_amdgcn_fence(__ATOMIC_RELEASE, "agent");
            asm volatile("s_waitcnt vmcnt(0)" ::: "memory");
            const unsigned og = xb_add(&bar[XB_TOP], 1u);
            const unsigned tg = og / nx;
            if (og + 1u == (tg + 1u) * nx) xb_add(&bar[XB_TOPGEN], 1u);
            else XB_SPIN(xb_ld(&bar[XB_TOPGEN]) == tg, bar);
            __builtin_amdgcn_fence(__ATOMIC_ACQUIRE, "agent");
            xb_add(&bar[XB_XGEN(b.x)], 1u);
            asm volatile("s_waitcnt vmcnt(0)" ::: "memory");
        } else {
            XB_SPIN(xb_ld(&bar[XB_XGEN(b.x)]) == gen, bar);
            __builtin_amdgcn_fence(__ATOMIC_ACQUIRE, "agent");
            asm volatile("s_waitcnt vmcnt(0)" ::: "memory");
        }
    }
    __syncthreads();
}
}

namespace mk {
constexpr int TB = 32;
constexpr int RAWW = 320;
constexpr int RW_RAW = 0;
constexpr int RW_MU = RW_RAW + (TB + 2) * RAWW * 2;
constexpr int RW_WUP = RW_MU + 2 * RAWW * 4;
constexpr int RW_AUP = RW_WUP + 64 * 72 * 2;
constexpr int RW_CST = RW_AUP + 64 * 72 * 2;
constexpr int RW_AWD = RW_CST + 5 * 64 * 4;
constexpr int RW_AAD = RW_AWD + TB * 72 * 2;
constexpr int RW_R = RW_AAD + TB * 72 * 2;
constexpr int RW_KR = RW_R + TB * 64 * 4;
constexpr int RW_LA = RW_KR + TB * 64 * 4;
constexpr int RW_KK = RW_LA + TB * 64 * 4;
constexpr int RW_W = RW_KK + TB * 64 * 4;
constexpr int RW_B = RW_W + TB * 64 * 4;
constexpr int RW_KD = RW_B + TB * 64 * 4;
constexpr int RW_WR = RW_KD + TB * 64 * 4;
constexpr int RW_V = RW_WR + TB * 64 * 4;
constexpr int RW_SC = RW_V + TB * 64 * 4;
constexpr int RW_YO = RW_SC + TB * 2 * 4;
constexpr int RW_BON = RW_YO + TB * 64 * 4;
constexpr int RW_END = RW_BON + TB * 4;
static_assert(RW_END <= LDS_BYTES, "rwkv LDS");

#define MK_DPP(x, ctrl) __int_as_float(__builtin_amdgcn_update_dpp(__float_as_int(x), __float_as_int(x), ctrl, 0xF, 0xF, false))
__device__ __forceinline__ float allreduce16(float x) {
    x += MK_DPP(x, 0xB1); x += MK_DPP(x, 0x4E); x += MK_DPP(x, 0x141); x += MK_DPP(x, 0x140); return x;
}

__device__ __forceinline__ void allreduce16x4(float& a, float& b, float& c, float& d) {
    asm volatile("s_nop 1\n\t"
        "v_add_f32_dpp %0, %0, %0 quad_perm:[1,0,3,2] row_mask:0xf bank_mask:0xf\n\t" "v_add_f32_dpp %1, %1, %1 quad_perm:[1,0,3,2] row_mask:0xf bank_mask:0xf\n\t"
        "v_add_f32_dpp %2, %2, %2 quad_perm:[1,0,3,2] row_mask:0xf bank_mask:0xf\n\t" "v_add_f32_dpp %3, %3, %3 quad_perm:[1,0,3,2] row_mask:0xf bank_mask:0xf\n\t"
        "v_add_f32_dpp %0, %0, %0 quad_perm:[2,3,0,1] row_mask:0xf bank_mask:0xf\n\t" "v_add_f32_dpp %1, %1, %1 quad_perm:[2,3,0,1] row_mask:0xf bank_mask:0xf\n\t"
        "v_add_f32_dpp %2, %2, %2 quad_perm:[2,3,0,1] row_mask:0xf bank_mask:0xf\n\t" "v_add_f32_dpp %3, %3, %3 quad_perm:[2,3,0,1] row_mask:0xf bank_mask:0xf\n\t"
        "v_add_f32_dpp %0, %0, %0 row_half_mirror row_mask:0xf bank_mask:0xf\n\t" "v_add_f32_dpp %1, %1, %1 row_half_mirror row_mask:0xf bank_mask:0xf\n\t"
        "v_add_f32_dpp %2, %2, %2 row_half_mirror row_mask:0xf bank_mask:0xf\n\t" "v_add_f32_dpp %3, %3, %3 row_half_mirror row_mask:0xf bank_mask:0xf\n\t"
        "v_add_f32_dpp %0, %0, %0 row_mirror row_mask:0xf bank_mask:0xf\n\t" "v_add_f32_dpp %1, %1, %1 row_mirror row_mask:0xf bank_mask:0xf\n\t"
        "v_add_f32_dpp %2, %2, %2 row_mirror row_mask:0xf bank_mask:0xf\n\t" "v_add_f32_dpp %3, %3, %3 row_mirror row_mask:0xf bank_mask:0xf"
        : "+v"(a), "+v"(b), "+v"(c), "+v"(d));
}
struct RwkvP { const bf16_t* z1; bf16_t* Y; float* bon; int b0, nb; };

constexpr int RW_NPIECE = (TB + 2) * 40, RW_PPT = (RW_NPIECE + NT - 1) / NT;

__device__ __forceinline__ void rwkv_chain(LAS unsigned char* lds, const In& in, const RwkvP p, int chain) {
    const int tid = threadIdx.x, lane = tid & 63, wid = tid >> 6;
    const int d = chain / (p.nb * NH), bl = (chain / NH) % p.nb, h = chain % NH;
    const int nlat = p.nb * SEQ;
    LAS bf16_t* RAW = (LAS bf16_t*)(lds + RW_RAW); LAS float* MU = (LAS float*)(lds + RW_MU);
    LAS bf16_t* WUP = (LAS bf16_t*)(lds + RW_WUP); LAS bf16_t* AUP = (LAS bf16_t*)(lds + RW_AUP); LAS float* CST = (LAS float*)(lds + RW_CST);
    LAS bf16_t* AWD = (LAS bf16_t*)(lds + RW_AWD); LAS bf16_t* AAD = (LAS bf16_t*)(lds + RW_AAD);
    LAS float *Rr = (LAS float*)(lds + RW_R), *KR = (LAS float*)(lds + RW_KR), *LA_ = (LAS float*)(lds + RW_LA);
    LAS float *KK = (LAS float*)(lds + RW_KK), *Wv = (LAS float*)(lds + RW_W), *Bv = (LAS float*)(lds + RW_B), *KD = (LAS float*)(lds + RW_KD), *WR = (LAS float*)(lds + RW_WR), *Vv = (LAS float*)(lds + RW_V);
    LAS float *SC = (LAS float*)(lds + RW_SC), *YO = (LAS float*)(lds + RW_YO), *BON = (LAS float*)(lds + RW_BON);
    auto segcol = [&](int s) { return s < 3 ? s * RW + h * 64 : (s == 3 ? OFF_WD + d * DL : OFF_AD + d * AL); };
    for (int i = tid; i < 2 * RAWW; i += NT) { const int m = i / RAWW, c = i % RAWW; MU[i] = in.shift_mu[m * RC + segcol(c >> 6) + (c & 63)]; }
    for (int i = tid; i < 64 * 64; i += NT) { const int j = i >> 6, c = i & 63;
        WUP[c * 72 + j] = f2bf(in.rw_w_up[((size_t)d * DL + j) * RW + h * 64 + c]); AUP[c * 72 + j] = f2bf(in.rw_a_up[((size_t)d * AL + j) * RW + h * 64 + c]); }
    for (int i = tid; i < 64; i += NT) { CST[i] = in.rw_w0[d * RW + h * 64 + i]; CST[64 + i] = in.rw_a0[d * RW + h * 64 + i]; CST[128 + i] = in.rw_k_k[h * 64 + i]; CST[192 + i] = in.rw_k_a[h * 64 + i]; CST[256 + i] = in.rw_r_k[h * 64 + i]; }
    constexpr int NQ = (CTX + SEQ) / TB, NQC = CTX / TB;
    auto blk_info = [&](int q, bool& isctx, int& t0, bool& hp, bool& hn, size_t& grow0) {
        isctx = q < NQC;
        if (isctx) { const int qq = d == 0 ? q : NQC - 1 - q; t0 = qq * TB; hp = t0 > 0; hn = t0 + TB < CTX; grow0 = (size_t)nlat + (size_t)bl * CTX + t0; }
        else { const int ql = q - NQC, qq = d == 0 ? ql : SEQ / TB - 1 - ql; t0 = qq * TB; hp = (t0 % GW) != 0; hn = ((t0 + TB) % GW) != 0; grow0 = (size_t)bl * SEQ + t0; }
    };
    u32x4 pre[RW_PPT];
    auto prefetch = [&](int q) {
        bool isctx, hp, hn; int t0; size_t grow0; blk_info(q, isctx, t0, hp, hn, grow0);
#pragma unroll
        for (int k = 0; k < RW_PPT; ++k) { const int i = tid + k * NT; u32x4 v = (u32x4){0u, 0u, 0u, 0u};
            if (i < RW_NPIECE) { const int rr = i / 40, sp = i % 40, seg = sp >> 3, part = sp & 7;
                const bool ok = (rr == 0) ? hp : ((rr == TB + 1) ? hn : true);
                if (ok) v = *(const u32x4*)(p.z1 + (grow0 + rr - 1) * Z1_N + segcol(seg) + part * 8); }
            pre[k] = v; }
    };
    auto commit = [&]() {
#pragma unroll
        for (int k = 0; k < RW_PPT; ++k) { const int i = tid + k * NT; if (i < RW_NPIECE) { const int rr = i / 40, sp = i % 40; *(LAS u32x4*)(RAW + rr * RAWW + sp * 8) = pre[k]; } }
    };
    float S[2][4];
#pragma unroll
    for (int i = 0; i < 2; ++i)
#pragma unroll
        for (int j = 0; j < 4; ++j) S[i][j] = 0.f;
    const int kg = lane & 15, rp = (lane >> 4) + 4 * wid;
    prefetch(0);
    for (int q = 0; q < NQ; ++q) {
        bool isctx, hp, hn; int t0; size_t grow0; blk_info(q, isctx, t0, hp, hn, grow0);
        commit();
        __syncthreads();
        if (q + 1 < NQ) prefetch(q + 1);
        auto shift8 = [&](int t, int c0, float (&s)[8]) {
            const u32x4 xp = *(const LAS u32x4*)(RAW + t * RAWW + c0), xc = *(const LAS u32x4*)(RAW + (t + 1) * RAWW + c0), xn_ = *(const LAS u32x4*)(RAW + (t + 2) * RAWW + c0);
            const f32x4 m0a = *(const LAS f32x4*)(MU + c0), m0b = *(const LAS f32x4*)(MU + c0 + 4), m1a = *(const LAS f32x4*)(MU + RAWW + c0), m1b = *(const LAS f32x4*)(MU + RAWW + c0 + 4);
#pragma unroll
            for (int j = 0; j < 4; ++j) { const unsigned a = xp[j], b = xc[j], c = xn_[j];
                const float mu0l = j < 2 ? m0a[2 * j] : m0b[2 * j - 4], mu0h = j < 2 ? m0a[2 * j + 1] : m0b[2 * j - 3], mu1l = j < 2 ? m1a[2 * j] : m1b[2 * j - 4], mu1h = j < 2 ? m1a[2 * j + 1] : m1b[2 * j - 3];
                { const float x = bflo(b); s[2 * j] = x + mu0l * (bflo(a) - x) + mu1l * (bflo(c) - x); }
                { const float x = bfhi(b); s[2 * j + 1] = x + mu0h * (bfhi(a) - x) + mu1h * (bfhi(c) - x); } } };
        for (int it = tid; it < TB * 24; it += NT) {
            const int t = it / 24, g = it % 24, seg = g >> 3, cc = (g & 7) * 8; float s[8]; shift8(t, g * 8, s);
            LAS float* dst = (seg == 0 ? Rr : (seg == 1 ? KR : Vv)) + t * 64 + cc; *(LAS f32x4*)dst = (f32x4){s[0], s[1], s[2], s[3]}; *(LAS f32x4*)(dst + 4) = (f32x4){s[4], s[5], s[6], s[7]};
        }
        { const int t = tid >> 4, g = 24 + (tid & 15), cc = (g & 7) * 8; float s[8]; shift8(t, g * 8, s);
          const bool isw = (tid & 15) < 8;
#pragma unroll
          for (int j = 0; j < 8; ++j) { const float th = fast_tanh(s[j]); s[j] = isw ? th : s[j]; }
          LAS bf16_t* dst = (isw ? AWD : AAD) + t * 72 + cc;
          u32x4 w; w.x = cvt_pk_bf16(s[0], s[1]); w.y = cvt_pk_bf16(s[2], s[3]); w.z = cvt_pk_bf16(s[4], s[5]); w.w = cvt_pk_bf16(s[6], s[7]); *(LAS u32x4*)dst = w; }
        __syncthreads();
        {
            const int lora = wid >> 2, ct = wid & 3, fr = lane & 15, fq = lane >> 4;
            const LAS bf16_t* Am = lora ? AAD : AWD; const LAS bf16_t* Bm = lora ? AUP : WUP;
#pragma unroll
            for (int rt = 0; rt < 2; ++rt) {
                f32x4 acc = (f32x4){0.f, 0.f, 0.f, 0.f};
#pragma unroll
                for (int ks = 0; ks < 2; ++ks) {
                    const bf16x8 a = *(const LAS bf16x8*)(Am + (rt * 16 + fr) * 72 + ks * 32 + fq * 8);
                    const bf16x8 b = *(const LAS bf16x8*)(Bm + (ct * 16 + fr) * 72 + ks * 32 + fq * 8);
                    acc = __builtin_amdgcn_mfma_f32_16x16x32_bf16(a, b, acc, 0, 0, 0);
                }
                const int col = ct * 16 + fr;
#pragma unroll
                for (int i = 0; i < 4; ++i) { const int t = rt * 16 + fq * 4 + i;
                    if (lora == 0) { const float lw = acc[i] + CST[col]; const float wl = -fast_softplus(-lw) - 0.5f; Wv[t * 64 + col] = __expf(-__expf(wl)); }
                    else { LA_[t * 64 + col] = fast_sigmoid(acc[i] + CST[64 + col]); } }
            }
        }
        __syncthreads();
        {
            const int t = tid >> 4, c4 = (tid & 15) * 4;
            const f32x4 k = *(const LAS f32x4*)(KR + t * 64 + c4), a = *(const LAS f32x4*)(LA_ + t * 64 + c4), w = *(const LAS f32x4*)(Wv + t * 64 + c4), r = *(const LAS f32x4*)(Rr + t * 64 + c4);
            f32x4 kkr, kd, bb, wr; float ss = 0.f, br = 0.f, kr = 0.f, bn = 0.f;
#pragma unroll
            for (int j = 0; j < 4; ++j) { kkr[j] = k[j] * CST[128 + c4 + j]; ss += kkr[j] * kkr[j]; }
            ss = allreduce16(ss);
            const float inv = 1.f / fmaxf(sqrtf(ss), 1e-12f);
#pragma unroll
            for (int j = 0; j < 4; ++j) { const float kk = kkr[j] * inv; kkr[j] = kk; kd[j] = k[j] * (1.f + (a[j] - 1.f) * CST[192 + c4 + j]); bb[j] = kk * a[j]; wr[j] = w[j] * r[j];
                br += bb[j] * r[j]; kr += kd[j] * r[j]; bn += r[j] * kd[j] * CST[256 + c4 + j]; }
            br = allreduce16(br); kr = allreduce16(kr); bn = allreduce16(bn);
            *(LAS f32x4*)(KK + t * 64 + c4) = kkr; *(LAS f32x4*)(KD + t * 64 + c4) = kd; *(LAS f32x4*)(Bv + t * 64 + c4) = bb; *(LAS f32x4*)(WR + t * 64 + c4) = wr;
            if ((tid & 15) == 0) { SC[t * 2] = br; SC[t * 2 + 1] = kr; BON[t] = bn; }
        }
        __syncthreads();
        {
            auto tof = [&](int st) { return d == 0 ? st : TB - 1 - st; };
            const LAS float* lb = KK + 4 * kg;
            const LAS float* vb = Vv + 2 * rp;
            constexpr int OW = (RW_W - RW_KK) / 4, OB = (RW_B - RW_KK) / 4, OKD = (RW_KD - RW_KK) / 4, OWR = (RW_WR - RW_KK) / 4;
            int t = tof(0);
            f32x4 kk4 = *(const LAS f32x4*)(lb + t * 64), w4 = *(const LAS f32x4*)(lb + t * 64 + OW), b4 = *(const LAS f32x4*)(lb + t * 64 + OB),
                  kd4 = *(const LAS f32x4*)(lb + t * 64 + OKD), wr4 = *(const LAS f32x4*)(lb + t * 64 + OWR);
            f32x2 vv = *(const LAS f32x2*)(vb + t * 64), sc = *(const LAS f32x2*)(SC + t * 2);
            f32x2 S2[4];
#pragma unroll
            for (int j = 0; j < 4; ++j) { S2[j][0] = S[0][j]; S2[j][1] = S[1][j]; }
#pragma unroll 2
            for (int st = 0; st < TB; ++st) {
                const int tn = tof(st + 1 < TB ? st + 1 : st);
                const f32x4 nkk4 = *(const LAS f32x4*)(lb + tn * 64), nw4 = *(const LAS f32x4*)(lb + tn * 64 + OW), nb4 = *(const LAS f32x4*)(lb + tn * 64 + OB),
                            nkd4 = *(const LAS f32x4*)(lb + tn * 64 + OKD), nwr4 = *(const LAS f32x4*)(lb + tn * 64 + OWR);
                const f32x2 nvv = *(const LAS f32x2*)(vb + tn * 64), nsc = *(const LAS f32x2*)(SC + tn * 2);
                f32x2 sa2 = S2[0] * kk4[0], yo2 = S2[0] * wr4[0];
#pragma unroll
                for (int j = 1; j < 4; ++j) { sa2 += S2[j] * kk4[j]; yo2 += S2[j] * wr4[j]; }
                float sa0 = sa2[0], sa1 = sa2[1], yo0 = yo2[0], yo1 = yo2[1];
                allreduce16x4(sa0, sa1, yo0, yo1);
                f32x2 sar; sar[0] = sa0; sar[1] = sa1;
#pragma unroll
                for (int j = 0; j < 4; ++j) S2[j] = S2[j] * w4[j] + (vv * kd4[j] - sar * b4[j]);
                if (kg == 0) { f32x2 yor; yor[0] = yo0; yor[1] = yo1; const f32x2 y = yor - sar * sc[0] + vv * sc[1]; *(LAS f32x2*)(YO + t * 64 + 2 * rp) = y; }
                kk4 = nkk4; w4 = nw4; b4 = nb4; kd4 = nkd4; wr4 = nwr4; vv = nvv; sc = nsc; t = tn;
            }
#pragma unroll
            for (int j = 0; j < 4; ++j) { S[0][j] = S2[j][0]; S[1][j] = S2[j][1]; }
        }
        __syncthreads();
        if (!isctx) {
            const int t = tid >> 4, c4 = (tid & 15) * 4; const f32x4 y = *(const LAS f32x4*)(YO + t * 64 + c4);
            u32x2 w; w.x = cvt_pk_bf16(y[0], y[1]); w.y = cvt_pk_bf16(y[2], y[3]);
            *(u32x2*)(p.Y + ((size_t)d * nlat + grow0 + t) * RW + h * 64 + c4) = w;
            if (tid < TB) p.bon[((size_t)d * nlat + grow0 + tid) * NH + h] = BON[tid];
        }
    }
}
__device__ __forceinline__ void rwkv_phase(LAS unsigned char* lds, const In& in, const RwkvP p, int bid, int nblk) {
    const int nchain = 2 * p.nb * NH;
    for (int c = bid; c < nchain; c += nblk) { rwkv_chain(lds, in, p, c); __syncthreads(); }
}
}

namespace mk {
constexpr int C2_RAW = 0;
constexpr int C2_MU = C2_RAW + (TB + 2) * RAWW * 2;
constexpr int C2_WUP = C2_MU + 2 * RAWW * 4;
constexpr int C2_AUP = C2_WUP + 64 * 72 * 2;
constexpr int C2_CST = C2_AUP + 64 * 72 * 2;
constexpr int C2_AWD = C2_CST + 5 * 64 * 4;
constexpr int C2_AAD = C2_AWD + TB * 72 * 2;
constexpr int C2_X = C2_AAD + TB * 72 * 2;
constexpr int C2_R = C2_X, C2_KR = C2_R + TB * 64 * 4, C2_V = C2_KR + TB * 64 * 4, C2_E = C2_V + TB * 64 * 4, C2_LA = C2_E + TB * 64 * 4, C2_CUM = C2_LA + TB * 64 * 4, C2_X_END = C2_CUM + TB * 64 * 4;
constexpr int C2_YO = C2_X;
constexpr int C2_G = C2_YO + TB * 64 * 4;
constexpr int C2_UB = C2_G + 64 * 36 * 4;
constexpr int C2_ABT = C2_UB + 64 * 40 * 2;
constexpr int C2_AKT = C2_ABT + 32 * 32 * 4;
constexpr int C2_NBT = C2_AKT + 32 * 40 * 2;
constexpr int C2_NKT = C2_NBT + 32 * 40 * 2;
static_assert(C2_NKT + 32 * 40 * 2 <= C2_X_END, "region X reuse");
constexpr int C2_KKS = C2_X_END;
constexpr int C2_BS = C2_KKS + TB * 72 * 2, C2_KDS = C2_BS + TB * 72 * 2, C2_RS = C2_KDS + TB * 72 * 2;
constexpr int C2_BST = C2_RS + TB * 72 * 2;
constexpr int C2_KDST = C2_BST + 64 * 40 * 2;
constexpr int C2_VT = C2_KDST + 64 * 40 * 2;
constexpr int C2_S0B = C2_VT + 64 * 40 * 2;
constexpr int C2_GC = C2_S0B + 64 * 72 * 2;
constexpr int C2_BON = C2_GC + 64 * 4;
constexpr int C2_END = C2_BON + TB * 4;
static_assert(C2_END <= LDS_BYTES - 16 && (C2_X % 16) == 0 && (C2_KKS % 16) == 0 && (C2_G % 16) == 0 && (C2_UB % 16) == 0 && (C2_ABT % 16) == 0 && (C2_AKT % 16) == 0 && (C2_S0B % 16) == 0, "rwkv2 LDS");

__device__ __forceinline__ bf16x8 ldsb8(const LAS bf16_t* p) { return *(const LAS bf16x8*)p; }

template <int MODE>
__device__ __forceinline__ void rwkv_chain2(LAS unsigned char* lds, const In& in, const RwkvP p, int chain) {
    const int tid = threadIdx.x, lane = tid & 63, wid = tid >> 6, fr = lane & 15, fq = lane >> 4;
    const int d = chain / (p.nb * NH), bl = (chain / NH) % p.nb, h = chain % NH;
    const int nlat = p.nb * SEQ;
    LAS bf16_t* RAW = (LAS bf16_t*)(lds + C2_RAW); LAS float* MU = (LAS float*)(lds + C2_MU);
    LAS bf16_t* WUP = (LAS bf16_t*)(lds + C2_WUP); LAS bf16_t* AUP = (LAS bf16_t*)(lds + C2_AUP); LAS float* CST = (LAS float*)(lds + C2_CST);
    LAS bf16_t* AWD = (LAS bf16_t*)(lds + C2_AWD); LAS bf16_t* AAD = (LAS bf16_t*)(lds + C2_AAD);
    LAS float *Rr = (LAS float*)(lds + C2_R), *KR = (LAS float*)(lds + C2_KR), *Vv = (LAS float*)(lds + C2_V), *Ee = (LAS float*)(lds + C2_E), *LA_ = (LAS float*)(lds + C2_LA), *CUM = (LAS float*)(lds + C2_CUM);
    LAS float *YO = (LAS float*)(lds + C2_YO), *Gm = (LAS float*)(lds + C2_G), *ABT = (LAS float*)(lds + C2_ABT), *GC = (LAS float*)(lds + C2_GC), *BON = (LAS float*)(lds + C2_BON);
    LAS bf16_t *UB = (LAS bf16_t*)(lds + C2_UB), *AKT = (LAS bf16_t*)(lds + C2_AKT), *NBT = (LAS bf16_t*)(lds + C2_NBT), *NKT = (LAS bf16_t*)(lds + C2_NKT);
    LAS bf16_t *KKS = (LAS bf16_t*)(lds + C2_KKS), *BS = (LAS bf16_t*)(lds + C2_BS), *KDS = (LAS bf16_t*)(lds + C2_KDS), *RS = (LAS bf16_t*)(lds + C2_RS);
    LAS bf16_t *BST = (LAS bf16_t*)(lds + C2_BST), *KDST = (LAS bf16_t*)(lds + C2_KDST), *VT = (LAS bf16_t*)(lds + C2_VT), *S0B = (LAS bf16_t*)(lds + C2_S0B);
    auto segcol = [&](int s) { return s < 3 ? s * RW + h * 64 : (s == 3 ? OFF_WD + d * DL : OFF_AD + d * AL); };
    for (int i = tid; i < 2 * RAWW; i += NT) { const int m = i / RAWW, c = i % RAWW; MU[i] = in.shift_mu[m * RC + segcol(c >> 6) + (c & 63)]; }
    for (int i = tid; i < 64 * 64; i += NT) { const int j = i >> 6, c = i & 63;
        WUP[c * 72 + j] = f2bf(in.rw_w_up[((size_t)d * DL + j) * RW + h * 64 + c]); AUP[c * 72 + j] = f2bf(in.rw_a_up[((size_t)d * AL + j) * RW + h * 64 + c]); }
    for (int i = tid; i < 64; i += NT) { CST[i] = in.rw_w0[d * RW + h * 64 + i]; CST[64 + i] = in.rw_a0[d * RW + h * 64 + i]; CST[128 + i] = in.rw_k_k[h * 64 + i]; CST[192 + i] = in.rw_k_a[h * 64 + i]; CST[256 + i] = in.rw_r_k[h * 64 + i]; }
    for (int i = tid; i < 64 * 72 / 2; i += NT) ((LAS unsigned*)S0B)[i] = 0u;
    constexpr int NQ = (CTX + SEQ) / TB, NQC = CTX / TB;
    auto blk_info = [&](int q, bool& isctx, int& t0, bool& hp, bool& hn, size_t& grow0) {
        isctx = q < NQC;
        if (isctx) { const int qq = d == 0 ? q : NQC - 1 - q; t0 = qq * TB; hp = t0 > 0; hn = t0 + TB < CTX; grow0 = (size_t)nlat + (size_t)bl * CTX + t0; }
        else { const int ql = q - NQC, qq = d == 0 ? ql : SEQ / TB - 1 - ql; t0 = qq * TB; hp = (t0 % GW) != 0; hn = ((t0 + TB) % GW) != 0; grow0 = (size_t)bl * SEQ + t0; }
    };
    u32x4 pre[RW_PPT];
    auto prefetch = [&](int q) {
        bool isctx, hp, hn; int t0; size_t grow0; blk_info(q, isctx, t0, hp, hn, grow0);
#pragma unroll
        for (int k = 0; k < RW_PPT; ++k) { const int i = tid + k * NT; u32x4 v = (u32x4){0u, 0u, 0u, 0u};
            if (i < RW_NPIECE) { const int rr = i / 40, sp = i % 40, seg = sp >> 3, part = sp & 7;
                const bool ok = (rr == 0) ? hp : ((rr == TB + 1) ? hn : true);
                if (ok) v = *(const u32x4*)(p.z1 + (grow0 + rr - 1) * Z1_N + segcol(seg) + part * 8); }
            pre[k] = v; }
    };
    auto commit = [&]() {
#pragma unroll
        for (int k = 0; k < RW_PPT; ++k) { const int i = tid + k * NT; if (i < RW_NPIECE) { const int rr = i / 40, sp = i % 40; *(LAS u32x4*)(RAW + rr * RAWW + sp * 8) = pre[k]; } }
    };
    f32x4 Sreg[2];
    Sreg[0] = (f32x4){0.f, 0.f, 0.f, 0.f}; Sreg[1] = Sreg[0];
    const int rt = wid >> 1;
    prefetch(0);
    for (int q = 0; q < NQ; ++q) {
        bool isctx, hp, hn; int t0; size_t grow0; blk_info(q, isctx, t0, hp, hn, grow0);
        commit();
        __syncthreads();
        if (q + 1 < NQ) prefetch(q + 1);
        auto shift8 = [&](int t, int c0, float (&s)[8]) {
            const u32x4 xp = *(const LAS u32x4*)(RAW + t * RAWW + c0), xc = *(const LAS u32x4*)(RAW + (t + 1) * RAWW + c0), xn_ = *(const LAS u32x4*)(RAW + (t + 2) * RAWW + c0);
            const f32x4 m0a = *(const LAS f32x4*)(MU + c0), m0b = *(const LAS f32x4*)(MU + c0 + 4), m1a = *(const LAS f32x4*)(MU + RAWW + c0), m1b = *(const LAS f32x4*)(MU + RAWW + c0 + 4);
#pragma unroll
            for (int j = 0; j < 4; ++j) { const unsigned a = xp[j], b = xc[j], c = xn_[j];
                const float mu0l = j < 2 ? m0a[2 * j] : m0b[2 * j - 4], mu0h = j < 2 ? m0a[2 * j + 1] : m0b[2 * j - 3], mu1l = j < 2 ? m1a[2 * j] : m1b[2 * j - 4], mu1h = j < 2 ? m1a[2 * j + 1] : m1b[2 * j - 3];
                { const float x = bflo(b); s[2 * j] = x + mu0l * (bflo(a) - x) + mu1l * (bflo(c) - x); }
                { const float x = bfhi(b); s[2 * j + 1] = x + mu0h * (bfhi(a) - x) + mu1h * (bfhi(c) - x); } } };
        for (int it = tid; it < TB * 24; it += NT) {
            const int t = it / 24, g = it % 24, seg = g >> 3, cc = (g & 7) * 8, js = d == 0 ? t : TB - 1 - t; float s[8]; shift8(t, g * 8, s);
            LAS float* dst = (seg == 0 ? Rr : (seg == 1 ? KR : Vv)) + js * 64 + cc; *(LAS f32x4*)dst = (f32x4){s[0], s[1], s[2], s[3]}; *(LAS f32x4*)(dst + 4) = (f32x4){s[4], s[5], s[6], s[7]};
        }
        { const int t = tid >> 4, g = 24 + (tid & 15), cc = (g & 7) * 8, js = d == 0 ? t : TB - 1 - t; float s[8]; shift8(t, g * 8, s);
          const bool isw = (tid & 15) < 8;
#pragma unroll
          for (int j = 0; j < 8; ++j) { const float th = fast_tanh(s[j]); s[j] = isw ? th : s[j]; }
          LAS bf16_t* dst = (isw ? AWD : AAD) + js * 72 + cc;
          u32x4 w; w.x = cvt_pk_bf16(s[0], s[1]); w.y = cvt_pk_bf16(s[2], s[3]); w.z = cvt_pk_bf16(s[4], s[5]); w.w = cvt_pk_bf16(s[6], s[7]); *(LAS u32x4*)dst = w; }
        __syncthreads();
        if (MODE == 3) continue;
        {
            const int lora = wid >> 2, ct = wid & 3;
            const LAS bf16_t* Am = lora ? AAD : AWD; const LAS bf16_t* Bm = lora ? AUP : WUP;
            float carry = 0.f;
#pragma unroll
            for (int r2 = 0; r2 < 2; ++r2) {
                f32x4 acc = (f32x4){0.f, 0.f, 0.f, 0.f};
#pragma unroll
                for (int ks = 0; ks < 2; ++ks) acc = __builtin_amdgcn_mfma_f32_16x16x32_bf16(ldsb8(Am + (r2 * 16 + fr) * 72 + ks * 32 + fq * 8), ldsb8(Bm + (ct * 16 + fr) * 72 + ks * 32 + fq * 8), acc, 0, 0, 0);
                const int col = ct * 16 + fr;
                if (lora == 0) {
                    float c[4];
#pragma unroll
                    for (int i = 0; i < 4; ++i) { const float lw = acc[i] + CST[col]; const float e = __expf(-fast_softplus(-lw) - 0.5f); c[i] = i ? c[i - 1] + e : e; }
                    const float tot = c[3];
                    float s1 = tot; { const float y = __shfl_up(s1, 16); s1 += fq >= 1 ? y : 0.f; }
                    float s2 = s1;  { const float z = __shfl_up(s1, 32); s2 += fq >= 2 ? z : 0.f; }
                    const float base = carry + s2 - tot;
#pragma unroll
                    for (int i = 0; i < 4; ++i) CUM[(r2 * 16 + fq * 4 + i) * 64 + col] = base + c[i];
                    carry += __shfl(s2, 48 + fr);
                } else {
#pragma unroll
                    for (int i = 0; i < 4; ++i) LA_[(r2 * 16 + fq * 4 + i) * 64 + col] = fast_sigmoid(acc[i] + CST[64 + col]);
                }
            }
        }
        __syncthreads();
        if (MODE == 2) continue;
        {
            const int j = tid >> 4, c4 = (tid & 15) * 4;
            const f32x4 k = *(const LAS f32x4*)(KR + j * 64 + c4), a = *(const LAS f32x4*)(LA_ + j * 64 + c4), r = *(const LAS f32x4*)(Rr + j * 64 + c4), vv = *(const LAS f32x4*)(Vv + j * 64 + c4);
            const f32x4 cu = *(const LAS f32x4*)(CUM + j * 64 + c4); f32x4 cp = (f32x4){0.f, 0.f, 0.f, 0.f}; if (j > 0) cp = *(const LAS f32x4*)(CUM + (j - 1) * 64 + c4);
            float kkr[4], ss = 0.f, bn = 0.f;
#pragma unroll
            for (int x = 0; x < 4; ++x) { kkr[x] = k[x] * CST[128 + c4 + x]; ss += kkr[x] * kkr[x]; }
            ss = allreduce16(ss);
            const float inv = 1.f / fmaxf(sqrtf(ss), 1e-12f);
            float kks[4], bs[4], kds[4], rs[4];
#pragma unroll
            for (int x = 0; x < 4; ++x) { const float kk = kkr[x] * inv, kd = k[x] * (1.f + (a[x] - 1.f) * CST[192 + c4 + x]), bb = kk * a[x];
                const float g = __expf(-cu[x]), gp = __expf(-cp[x]), ig = __expf(cu[x]);
                kks[x] = kk * gp; bs[x] = bb * ig; kds[x] = kd * ig; rs[x] = r[x] * g; bn += r[x] * kd * CST[256 + c4 + x];
                if (j == TB - 1) GC[c4 + x] = g;
                BST[(c4 + x) * 40 + j] = f2bf(bs[x]); KDST[(c4 + x) * 40 + j] = f2bf(kds[x]); VT[(c4 + x) * 40 + j] = f2bf(vv[x]); }
            bn = allreduce16(bn);
            u32x2 w; w.x = cvt_pk_bf16(kks[0], kks[1]); w.y = cvt_pk_bf16(kks[2], kks[3]); *(LAS u32x2*)(KKS + j * 72 + c4) = w;
            w.x = cvt_pk_bf16(bs[0], bs[1]); w.y = cvt_pk_bf16(bs[2], bs[3]); *(LAS u32x2*)(BS + j * 72 + c4) = w;
            w.x = cvt_pk_bf16(kds[0], kds[1]); w.y = cvt_pk_bf16(kds[2], kds[3]); *(LAS u32x2*)(KDS + j * 72 + c4) = w;
            w.x = cvt_pk_bf16(rs[0], rs[1]); w.y = cvt_pk_bf16(rs[2], rs[3]); *(LAS u32x2*)(RS + j * 72 + c4) = w;
            if ((tid & 15) == 0) BON[j] = bn;
        }
        __syncthreads();
        if (MODE == 1) continue;
        const int ctg = wid & 1;
        f32x4 accG = (f32x4){0.f, 0.f, 0.f, 0.f}, accY = accG;
        {
            const int pr = wid >> 1, rts = wid & 1;
            const LAS bf16_t* Xm = (pr & 1) ? KDS : BS; const LAS bf16_t* Ym = (pr < 2) ? KKS : RS;
            const bf16x8 a0 = ldsb8(Xm + (rts * 16 + fr) * 72 + fq * 8), a1 = ldsb8(Xm + (rts * 16 + fr) * 72 + 32 + fq * 8);
#pragma unroll
            for (int cts = 0; cts < 2; ++cts) {
                f32x4 acc = (f32x4){0.f, 0.f, 0.f, 0.f};
                acc = __builtin_amdgcn_mfma_f32_16x16x32_bf16(a0, ldsb8(Ym + (cts * 16 + fr) * 72 + fq * 8), acc, 0, 0, 0);
                acc = __builtin_amdgcn_mfma_f32_16x16x32_bf16(a1, ldsb8(Ym + (cts * 16 + fr) * 72 + 32 + fq * 8), acc, 0, 0, 0);
                const int t = cts * 16 + fr, s0 = rts * 16 + fq * 4;
#pragma unroll
                for (int i = 0; i < 4; ++i) { const bool keep = (pr < 2) ? (s0 + i < t) : (s0 + i <= t); acc[i] = keep ? acc[i] : 0.f; }
                if (pr == 0) *(LAS f32x4*)(ABT + t * 32 + s0) = acc;
                else { u32x2 w; w.x = cvt_pk_bf16(acc[0], acc[1]); w.y = cvt_pk_bf16(acc[2], acc[3]); *(LAS u32x2*)((pr == 1 ? AKT : (pr == 2 ? NBT : NKT)) + t * 40 + s0) = w; }
            }
#pragma unroll
            for (int ks = 0; ks < 2; ++ks) { const bf16x8 sa = ldsb8(S0B + (rt * 16 + fr) * 72 + ks * 32 + fq * 8);
                accG = __builtin_amdgcn_mfma_f32_16x16x32_bf16(sa, ldsb8(KKS + (ctg * 16 + fr) * 72 + ks * 32 + fq * 8), accG, 0, 0, 0);
                accY = __builtin_amdgcn_mfma_f32_16x16x32_bf16(sa, ldsb8(RS + (ctg * 16 + fr) * 72 + ks * 32 + fq * 8), accY, 0, 0, 0); }
        }
        __syncthreads();
        {
            const bf16x8 va = ldsb8(VT + (rt * 16 + fr) * 40 + fq * 8);
            accG = __builtin_amdgcn_mfma_f32_16x16x32_bf16(va, ldsb8(AKT + (ctg * 16 + fr) * 40 + fq * 8), accG, 0, 0, 0);
            accY = __builtin_amdgcn_mfma_f32_16x16x32_bf16(va, ldsb8(NKT + (ctg * 16 + fr) * 40 + fq * 8), accY, 0, 0, 0);
#pragma unroll
            for (int i = 0; i < 4; ++i) Gm[(rt * 16 + fq * 4 + i) * 36 + ctg * 16 + fr] = -accG[i];
        }
        __syncthreads();
        if (wid < 4) {
            const int v = wid * 16 + (lane >> 2), pq = lane & 3;
            const LAS float* grow = Gm + v * 36;
            f32x4 ua = (f32x4){0.f, 0.f, 0.f, 0.f}, ub = ua;
#pragma unroll
            for (int g = 0; g < TB / 4; ++g) {
                const f32x4 g4 = *(const LAS f32x4*)(grow + 4 * g);
                const LAS float* ab = ABT + (4 * g) * 32;
                float part[4];
#pragma unroll
                for (int jj = 0; jj < 4; ++jj) { const f32x4 a0 = *(const LAS f32x4*)(ab + jj * 32 + 4 * pq), a1 = *(const LAS f32x4*)(ab + jj * 32 + 16 + 4 * pq);
                    part[jj] = ua[0] * a0[0] + ua[1] * a0[1] + ua[2] * a0[2] + ua[3] * a0[3] + ub[0] * a1[0] + ub[1] * a1[1] + ub[2] * a1[2] + ub[3] * a1[3]; }
                asm volatile("s_nop 1\n\t"
                    "v_add_f32_dpp %0, %0, %0 quad_perm:[1,0,3,2] row_mask:0xf bank_mask:0xf\n\t" "v_add_f32_dpp %1, %1, %1 quad_perm:[1,0,3,2] row_mask:0xf bank_mask:0xf\n\t"
                    "v_add_f32_dpp %2, %2, %2 quad_perm:[1,0,3,2] row_mask:0xf bank_mask:0xf\n\t" "v_add_f32_dpp %3, %3, %3 quad_perm:[1,0,3,2] row_mask:0xf bank_mask:0xf\n\t"
                    "v_add_f32_dpp %0, %0, %0 quad_perm:[2,3,0,1] row_mask:0xf bank_mask:0xf\n\t" "v_add_f32_dpp %1, %1, %1 quad_perm:[2,3,0,1] row_mask:0xf bank_mask:0xf\n\t"
                    "v_add_f32_dpp %2, %2, %2 quad_perm:[2,3,0,1] row_mask:0xf bank_mask:0xf\n\t" "v_add_f32_dpp %3, %3, %3 quad_perm:[2,3,0,1] row_mask:0xf bank_mask:0xf"
                    : "+v"(part[0]), "+v"(part[1]), "+v"(part[2]), "+v"(part[3]));
                const f32x4 d1 = *(const LAS f32x4*)(ab + 1 * 32 + 4 * g), d2 = *(const LAS f32x4*)(ab + 2 * 32 + 4 * g), d3 = *(const LAS f32x4*)(ab + 3 * 32 + 4 * g);
                f32x4 u4;
                u4[0] = g4[0] - part[0];
                u4[1] = g4[1] - part[1] - u4[0] * d1[0];
                u4[2] = g4[2] - part[2] - (u4[0] * d2[0] + u4[1] * d2[1]);
                u4[3] = g4[3] - part[3] - (u4[0] * d3[0] + u4[1] * d3[1] + u4[2] * d3[2]);
                if (g < 4) { if (pq == g) ua = u4; } else { if (pq == g - 4) ub = u4; }
                if (pq == (g & 3)) { u32x2 w; w.x = cvt_pk_bf16(u4[0], u4[1]); w.y = cvt_pk_bf16(u4[2], u4[3]); *(LAS u32x2*)(UB + v * 40 + 4 * g) = w; }
            }
        }
        __syncthreads();
        {
            const bf16x8 ua = ldsb8(UB + (rt * 16 + fr) * 40 + fq * 8), va = ldsb8(VT + (rt * 16 + fr) * 40 + fq * 8);
            accY = __builtin_amdgcn_mfma_f32_16x16x32_bf16(ua, ldsb8(NBT + (ctg * 16 + fr) * 40 + fq * 8), accY, 0, 0, 0);
            *(LAS f32x4*)(YO + (ctg * 16 + fr) * 64 + rt * 16 + fq * 4) = accY;
#pragma unroll
            for (int cc = 0; cc < 2; ++cc) { const int ct = 2 * (wid & 1) + cc, kcol = ct * 16 + fr;
                f32x4 acc = Sreg[cc];
                acc = __builtin_amdgcn_mfma_f32_16x16x32_bf16(ua, ldsb8(BST + kcol * 40 + fq * 8), acc, 0, 0, 0);
                acc = __builtin_amdgcn_mfma_f32_16x16x32_bf16(va, ldsb8(KDST + kcol * 40 + fq * 8), acc, 0, 0, 0);
                const float g = GC[kcol];
#pragma unroll
                for (int i = 0; i < 4; ++i) { acc[i] *= g; S0B[(rt * 16 + fq * 4 + i) * 72 + kcol] = f2bf(acc[i]); }
                Sreg[cc] = acc; }
        }
        __syncthreads();
        if (!isctx) {
            const int j = tid >> 4, c4 = (tid & 15) * 4, t = d == 0 ? j : TB - 1 - j; const f32x4 y = *(const LAS f32x4*)(YO + j * 64 + c4);
            u32x2 w; w.x = cvt_pk_bf16(y[0], y[1]); w.y = cvt_pk_bf16(y[2], y[3]);
            *(u32x2*)(p.Y + ((size_t)d * nlat + grow0 + t) * RW + h * 64 + c4) = w;
            if (tid < TB) { const int tt = d == 0 ? tid : TB - 1 - tid; p.bon[((size_t)d * nlat + grow0 + tt) * NH + h] = BON[tid]; }
        }
    }
}
template <int MODE = 0>
__device__ __forceinline__ void rwkv_phase2(LAS unsigned char* lds, const In& in, const RwkvP p, int bid, int nblk) {
    const int nchain = 2 * p.nb * NH;
    for (int c = bid; c < nchain; c += nblk) { rwkv_chain2<MODE>(lds, in, p, c); __syncthreads(); }
}
}

namespace mk {
constexpr int LR_XT = 0;
constexpr int LR_XC = LR_XT + 67 * 64 * 2 + 64;
constexpr int LR_XCB = LR_XC + 64 * 64 * 4;
constexpr int LR_GWT = LR_XCB + 64 * 72 * 2;
constexpr int LR_A = LR_GWT + 2 * 64 * 72 * 2;
constexpr int LR_BX = LR_A + 64 * 64 * 4;
constexpr int LR_HO = LR_BX + 64 * 64 * 4;
constexpr int LR_CST = LR_HO + 64 * 64 * 4;
constexpr int LR_END = LR_CST + 8 * 64 * 4;
static_assert(LR_END <= LDS_BYTES && (LR_XC % 16) == 0, "lru LDS");

struct LruP { const bf16_t* z1; bf16_t* Hd; int b0, nb; };

__device__ __forceinline__ void lru_item(LAS unsigned char* lds, const In& in, const LruP p, int item) {
    const int tid = threadIdx.x, lane = tid & 63, wid = tid >> 6;
    const int d = item / (p.nb * LB), bl = (item / LB) % p.nb, n = item % LB;
    const int nlat = p.nb * SEQ;
    LAS bf16_t* XT = (LAS bf16_t*)(lds + LR_XT); LAS float* XC = (LAS float*)(lds + LR_XC); LAS bf16_t* XCB = (LAS bf16_t*)(lds + LR_XCB); LAS bf16_t* GWT = (LAS bf16_t*)(lds + LR_GWT);
    LAS float *A_ = (LAS float*)(lds + LR_A), *BX = (LAS float*)(lds + LR_BX), *HO = (LAS float*)(lds + LR_HO), *CST = (LAS float*)(lds + LR_CST);
    for (int i = tid; i < 2 * 64 * 64; i += NT) { const int g = i >> 12, j = (i >> 6) & 63, k = i & 63;
        GWT[(g * 64 + k) * 72 + j] = f2bf(in.lru_gate_w[((((size_t)d * 2 + g) * LB + n) * LBS + j) * LBS + k]); }
    for (int i = tid; i < 64; i += NT) { const int c = n * 64 + i;
        CST[i] = in.lru_conv_w[c]; CST[64 + i] = in.lru_conv_w[LW + c]; CST[128 + i] = in.lru_conv_w[2 * LW + c]; CST[192 + i] = in.lru_conv_w[3 * LW + c]; CST[256 + i] = in.lru_conv_b[c];
        CST[320 + i] = in.lru_gate_b[((d * 2 + 0) * LB + n) * LBS + i]; CST[384 + i] = in.lru_gate_b[((d * 2 + 1) * LB + n) * LBS + i]; CST[448 + i] = softplusf_(-in.lru_l[d * LW + c]); }
    constexpr int NSEG = CTX / 64 + GW, NSC = CTX / 64;
    u32x4 pre[2];
    auto tok_row = [&](int sidx, int rr, bool& ok) -> size_t {
        if (sidx < NSC) { const int t = sidx * 64 + rr - 2; ok = t >= 0 && t < CTX; return (size_t)nlat + (size_t)bl * CTX + t; }
        const int col = sidx - NSC, row = rr - 2; ok = row >= 0 && row < ROWS; return (size_t)bl * SEQ + (size_t)row * GW + col;
    };
    auto seg_of = [&](int q) { if (q < NSC) return d == 0 ? q : NSC - 1 - q; const int ql = q - NSC; return NSC + (d == 0 ? ql : GW - 1 - ql); };
    auto prefetch = [&](int q) { const int sidx = seg_of(q);
#pragma unroll
        for (int k = 0; k < 2; ++k) { const int i = tid + k * NT; u32x4 v = (u32x4){0u, 0u, 0u, 0u};
            if (i < 67 * 8) { const int rr = i >> 3, part = i & 7; bool ok; const size_t gr = tok_row(sidx, rr, ok); if (ok) v = *(const u32x4*)(p.z1 + gr * Z1_N + Z1_LX + n * 64 + part * 8); }
            pre[k] = v; } };
    auto commit = [&]() {
#pragma unroll
        for (int k = 0; k < 2; ++k) { const int i = tid + k * NT; if (i < 67 * 8) *(LAS u32x4*)(XT + (i >> 3) * 64 + (i & 7) * 8) = pre[k]; } };
    float hcar = 0.f;
    prefetch(0);
    for (int q = 0; q < NSEG; ++q) {
        const int sidx = seg_of(q);
        commit();
        __syncthreads();
        if (q + 1 < NSEG) prefetch(q + 1);
        { const int t = tid >> 3, c0 = (tid & 7) * 8; float s[8];
#pragma unroll
          for (int j = 0; j < 8; ++j) s[j] = CST[256 + c0 + j];
#pragma unroll
          for (int tap = 0; tap < 4; ++tap) { const u32x4 x = *(const LAS u32x4*)(XT + (t + tap) * 64 + c0);
#pragma unroll
              for (int j = 0; j < 4; ++j) { s[2 * j] += CST[tap * 64 + c0 + 2 * j] * bflo(x[j]); s[2 * j + 1] += CST[tap * 64 + c0 + 2 * j + 1] * bfhi(x[j]); } }
          *(LAS f32x4*)(XC + t * 64 + c0) = (f32x4){s[0], s[1], s[2], s[3]}; *(LAS f32x4*)(XC + t * 64 + c0 + 4) = (f32x4){s[4], s[5], s[6], s[7]};
          u32x4 w; w.x = cvt_pk_bf16(s[0], s[1]); w.y = cvt_pk_bf16(s[2], s[3]); w.z = cvt_pk_bf16(s[4], s[5]); w.w = cvt_pk_bf16(s[6], s[7]); *(LAS u32x4*)(XCB + t * 72 + c0) = w; }
        __syncthreads();
        { const int rt = wid >> 1, fr = lane & 15, fq = lane >> 4;
          bf16x8 a[2];
#pragma unroll
          for (int ks = 0; ks < 2; ++ks) a[ks] = *(const LAS bf16x8*)(XCB + (rt * 16 + fr) * 72 + ks * 32 + fq * 8);
#pragma unroll
          for (int cc = 0; cc < 2; ++cc) { const int ct = 2 * (wid & 1) + cc, col = ct * 16 + fr;
              f32x4 acc0 = (f32x4){0.f, 0.f, 0.f, 0.f}, acc1 = acc0;
#pragma unroll
              for (int ks = 0; ks < 2; ++ks) {
                  const bf16x8 b0 = *(const LAS bf16x8*)(GWT + (0 * 64 + col) * 72 + ks * 32 + fq * 8), b1 = *(const LAS bf16x8*)(GWT + (1 * 64 + col) * 72 + ks * 32 + fq * 8);
                  acc0 = __builtin_amdgcn_mfma_f32_16x16x32_bf16(a[ks], b0, acc0, 0, 0, 0); acc1 = __builtin_amdgcn_mfma_f32_16x16x32_bf16(a[ks], b1, acc1, 0, 0, 0); }
#pragma unroll
              for (int i = 0; i < 4; ++i) { const int t = rt * 16 + fq * 4 + i;
                  const float rec = fast_sigmoid(acc0[i] + CST[320 + col]), inp = fast_sigmoid(acc1[i] + CST[384 + col]);
                  const float la = -8.f * rec * CST[448 + col];
                  const float av = __expf(la), x2 = 2.f * la; const float om = x2 > -0.03f ? -x2 * (1.f + x2 * (0.5f + x2 * (1.f / 6.f))) : 1.f - av * av;
                  A_[t * 64 + col] = av; BX[t * 64 + col] = __builtin_amdgcn_sqrtf(om) * inp * XC[t * 64 + col]; } } }
        __syncthreads();
        if (wid == 0) {
#pragma unroll 8
            for (int st = 0; st < 64; ++st) { const int t = d == 0 ? st : 63 - st; hcar = A_[t * 64 + lane] * hcar + BX[t * 64 + lane]; HO[t * 64 + lane] = hcar; }
        }
        __syncthreads();
        if (sidx >= NSC) { const int col = sidx - NSC, t = tid >> 3, c0 = (tid & 7) * 8;
            const f32x4 x = *(const LAS f32x4*)(HO + t * 64 + c0), y = *(const LAS f32x4*)(HO + t * 64 + c0 + 4);
            *(u32x4*)(p.Hd + ((size_t)d * nlat + (size_t)bl * SEQ + (size_t)t * GW + col) * LW + n * 64 + c0) = pack8(x, y); }
    }
}
__device__ __forceinline__ void lru_phase(LAS unsigned char* lds, const In& in, const LruP p, int bid, int nblk) {
    const int nitem = 2 * p.nb * LB;
    for (int it = bid; it < nitem; it += nblk) { lru_item(lds, in, p, it); __syncthreads(); }
}
}

namespace mk {
#define MK_DPPX(x, ctrl) __int_as_float(__builtin_amdgcn_update_dpp(__float_as_int(x), __float_as_int(x), ctrl, 0xF, 0xF, false))
__device__ __forceinline__ float allreduce4(float x) { x += MK_DPPX(x, 0xB1); x += MK_DPPX(x, 0x4E); return x; }
__device__ __forceinline__ void unpack8(const u32x4 w, float (&f)[8]) {
#pragma unroll
    for (int j = 0; j < 4; ++j) { f[2 * j] = bflo(w[j]); f[2 * j + 1] = bfhi(w[j]); } }
constexpr int AG_K = 256;
struct PostP { const bf16_t* z1; bf16_t* Y; const float* bon; bf16_t* Ag; int nlat; int pad_; };
__device__ __forceinline__ void rwkv_post_rows(const In& in, const PostP p, int row_lo, int row_hi, bool dry = false) {
    const int lane = threadIdx.x & 63, wid = threadIdx.x >> 6, c0 = lane * 16, h = lane >> 2;
    for (int r = row_lo + wid; r < row_hi; r += NT / 64) {
        const int cg = r % GW; const bool hp = cg > 0, hn = cg < GW - 1;
        bf16_t* y0p = p.Y + (size_t)r * RW + c0; const bf16_t* y1p = p.Y + ((size_t)p.nlat + r) * RW + c0;
        float y[16], t8[8];
        unpack8(*(const u32x4*)y0p, t8);
#pragma unroll
        for (int j = 0; j < 8; ++j) y[j] = t8[j];
        unpack8(*(const u32x4*)(y0p + 8), t8);
#pragma unroll
        for (int j = 0; j < 8; ++j) y[8 + j] = t8[j];
        unpack8(*(const u32x4*)y1p, t8);
#pragma unroll
        for (int j = 0; j < 8; ++j) y[j] += t8[j];
        unpack8(*(const u32x4*)(y1p + 8), t8);
#pragma unroll
        for (int j = 0; j < 8; ++j) y[8 + j] += t8[j];
        float s = 0.f;
#pragma unroll
        for (int j = 0; j < 16; ++j) s += y[j];
        const float mu = allreduce4(s) * (1.f / 64.f); float q = 0.f;
#pragma unroll
        for (int j = 0; j < 16; ++j) { const float dlt = y[j] - mu; q += dlt * dlt; }
        const float rs = 1.f / sqrtf(allreduce4(q) * (1.f / 64.f) + LNX_EPS);
        const float bonus = p.bon[(size_t)r * NH + h] + p.bon[((size_t)p.nlat + r) * NH + h];
        const bf16_t* zr = p.z1 + (size_t)r * Z1_N;
#pragma unroll
        for (int half = 0; half < 2; ++half) {
            const int c = OFF_V + c0 + half * 8; float xv[8], pv[8], nv[8];
            unpack8(*(const u32x4*)(zr + c), xv);
            if (hp) unpack8(*(const u32x4*)(zr - Z1_N + c), pv); else {
#pragma unroll
                for (int j = 0; j < 8; ++j) pv[j] = 0.f; }
            if (hn) unpack8(*(const u32x4*)(zr + Z1_N + c), nv); else {
#pragma unroll
                for (int j = 0; j < 8; ++j) nv[j] = 0.f; }
            float o[8];
#pragma unroll
            for (int j = 0; j < 8; ++j) { const float v = xv[j] + in.shift_mu[c + j] * (pv[j] - xv[j]) + in.shift_mu[RC + c + j] * (nv[j] - xv[j]); const int ch = c0 + half * 8 + j;
                o[j] = (y[half * 8 + j] - mu) * rs * in.rw_lnx[ch] + in.rw_lnx[RW + ch] + bonus * v; }
            u32x4 w; w.x = cvt_pk_bf16(o[0], o[1]); w.y = cvt_pk_bf16(o[2], o[3]); w.z = cvt_pk_bf16(o[4], o[5]); w.w = cvt_pk_bf16(o[6], o[7]); if (!dry) *(u32x4*)(y0p + half * 8) = w; else if (w.x == 0x12345678u) *(u32x4*)(y0p + half * 8) = w;
        }
        if (lane < 32) { u32x4 w = (u32x4){0u, 0u, 0u, 0u};
            if (lane < GL / 8) { const int c = OFF_GD + lane * 8; float xv[8], pv[8], nv[8];
                unpack8(*(const u32x4*)(zr + c), xv);
                if (hp) unpack8(*(const u32x4*)(zr - Z1_N + c), pv); else {
#pragma unroll
                    for (int j = 0; j < 8; ++j) pv[j] = 0.f; }
                if (hn) unpack8(*(const u32x4*)(zr + Z1_N + c), nv); else {
#pragma unroll
                    for (int j = 0; j < 8; ++j) nv[j] = 0.f; }
                float o[8];
#pragma unroll
                for (int j = 0; j < 8; ++j) o[j] = sigmoidf_(xv[j] + in.shift_mu[c + j] * (pv[j] - xv[j]) + in.shift_mu[RC + c + j] * (nv[j] - xv[j]));
                w.x = cvt_pk_bf16(o[0], o[1]); w.y = cvt_pk_bf16(o[2], o[3]); w.z = cvt_pk_bf16(o[4], o[5]); w.w = cvt_pk_bf16(o[6], o[7]); }
            *(u32x4*)(p.Ag + (size_t)r * AG_K + lane * 8) = w; }
    }
}
struct EpiYa { const bf16_t* yn; bf16_t* ya;
    __device__ __forceinline__ bool operator()(f32x4 (&acc)[2][2][4][2], const Unit& u, int wr, int wc, int fr, int fq) const {
        MK_FRAG_LOOP(r, c) { const size_t o = (size_t)(u.pm * BM + r) * RW + u.pn * BM + c; float f[8]; unpack8(*(const u32x4*)(yn + o), f);
            f32x4 a = acc[ai][bj][m][0], b = acc[ai][bj][m][1];
#pragma unroll
            for (int j = 0; j < 4; ++j) { a[j] *= f[j]; b[j] *= f[4 + j]; }
            *(u32x4*)(ya + o) = pack8(a, b); asm volatile("" ::: "memory"); }
        return false; } };
struct EpiZc { const bf16_t* Hd; bf16_t* yb; bf16_t* gates; int nlat; int pad_;
    __device__ __forceinline__ bool operator()(f32x4 (&acc)[2][2][4][2], const Unit& u, int wr, int wc, int fr, int fq) const {
        if (u.pn < LW / BM) {
            MK_FRAG_LOOP(r, c) { const size_t o = (size_t)(u.pm * BM + r) * LW + u.pn * BM + c; float h0[8], h1[8]; unpack8(*(const u32x4*)(Hd + o), h0); unpack8(*(const u32x4*)(Hd + (size_t)nlat * LW + o), h1);
                f32x4 a = acc[ai][bj][m][0], b = acc[ai][bj][m][1];
#pragma unroll
                for (int j = 0; j < 4; ++j) { a[j] = gelu_tanhf_(a[j]) * (h0[j] + h1[j]); b[j] = gelu_tanhf_(b[j]) * (h0[4 + j] + h1[4 + j]); }
                *(u32x4*)(yb + o) = pack8(a, b); asm volatile("" ::: "memory"); }
        } else {
            MK_FRAG_LOOP(r, c) { const size_t o = (size_t)(u.pm * BM + r) * (2 * D) + (u.pn * BM - LW) + c;
                f32x4 a = acc[ai][bj][m][0], b = acc[ai][bj][m][1];
#pragma unroll
                for (int j = 0; j < 4; ++j) { a[j] = fast_sigmoid(a[j]); b[j] = fast_sigmoid(b[j]); }
                *(u32x4*)(gates + o) = pack8(a, b); }
        }
        return false; } };
struct PairOrder { StaticOrder S;
    __device__ bool next(int i, Unit& u) const { if (!S.next(i >> 1, u)) return false; u.e = i & 1; return true; } };
struct EpiBranch { const bf16_t* gates; bf16_t* mixed;
    __device__ __forceinline__ bool operator()(f32x4 (&acc)[2][2][4][2], const Unit& u, int wr, int wc, int fr, int fq) const {
        MK_FRAG_LOOP(r, c) { const size_t row = (size_t)(u.pm * BM + r); const int col = u.pn * BM + c; float g1[8], g2[8];
            unpack8(*(const u32x4*)(gates + row * (2 * D) + col), g1); unpack8(*(const u32x4*)(gates + row * (2 * D) + D + col), g2);
            if (u.e == 0) {
#pragma unroll
                for (int j = 0; j < 4; ++j) { acc[ai][bj][m][0][j] *= g1[j] / g2[j]; acc[ai][bj][m][1][j] *= g1[4 + j] / g2[4 + j]; }
            } else { f32x4 a = acc[ai][bj][m][0], b = acc[ai][bj][m][1];
#pragma unroll
                for (int j = 0; j < 4; ++j) { a[j] *= g2[j]; b[j] *= g2[4 + j]; }
                *(u32x4*)(mixed + row * D + col) = pack8(a, b); } asm volatile("" ::: "memory"); }
        return u.e == 0; } };
struct EpiF32 { float* C; long ldc;
    __device__ __forceinline__ bool operator()(f32x4 (&acc)[2][2][4][2], const Unit& u, int wr, int wc, int fr, int fq) const {
        MK_FRAG_LOOP(r, c) { float* o = C + (size_t)(u.pm * BM + r) * ldc + u.pn * BM + c; *(f32x4*)o = acc[ai][bj][m][0]; *(f32x4*)(o + 4) = acc[ai][bj][m][1]; }
        return false; } };
}

namespace mk {
constexpr int NEX = NE + 1;
constexpr int SLOTS_PER_TOK = TOPK + 1;
constexpr int RP_MOD = 0;
constexpr int RP_UH = RP_MOD + 3 * D * 4;
constexpr int RP_UL = RP_UH + 16 * (D + 8) * 2;
constexpr int RP_PART = RP_UL + 16 * (D + 8) * 2;
constexpr int RP_LOG = RP_PART + 8 * 16 * 64 * 4;
constexpr int RP_HIST = RP_LOG + 16 * 64 * 4;
constexpr int RP_END = RP_HIST + 64 * 4;
static_assert(RP_END <= LDS_BYTES, "rowpass LDS");

struct RowP { float* y2h1; bf16_t* u; const float* modpart; const bf16_t* rwt;
              int* tope; float* gatev; int* lrank; int* blkcnt; int b0, nlat; };
__device__ __forceinline__ float wave_max(float x) {
#pragma unroll
    for (int o = 32; o > 0; o >>= 1) x = fmaxf(x, __shfl_xor(x, o));
    return x; }
__device__ __forceinline__ void row_pass(LAS unsigned char* lds, const In& in, const RowP p, int row_lo, int row_hi, bool dry = false) {
    const int tid = threadIdx.x, lane = tid & 63, wid = tid >> 6;
    LAS float* MOD = (LAS float*)(lds + RP_MOD); LAS bf16_t* UH = (LAS bf16_t*)(lds + RP_UH); LAS bf16_t* UL = (LAS bf16_t*)(lds + RP_UL);
    LAS float* PART = (LAS float*)(lds + RP_PART); LAS float* LOG = (LAS float*)(lds + RP_LOG); LAS int* HIST = (LAS int*)(lds + RP_HIST);
    const int mr = p.b0 + row_lo / SEQ;
    for (int j = tid; j < 3 * D; j += NT) MOD[j] = mod_value(in, p.modpart, mr, 2 * D + j);
    if (tid < 64) HIST[tid] = 0;
    __syncthreads();
    for (int r16 = row_lo; r16 < row_hi; r16 += 16) {
#pragma unroll
        for (int rr = 0; rr < 2; ++rr) {
            const int lr = wid * 2 + rr, r = r16 + lr;
            float* yp = p.y2h1 + (size_t)r * D; const float* xp = in.x + ((size_t)p.b0 * SEQ + r) * D;
            f32x4 v[4]; float ss = 0.f;
#pragma unroll
            for (int j = 0; j < 4; ++j) { v[j] = *(const f32x4*)(yp + j * 256 + lane * 4); ss += v[j][0] * v[j][0] + v[j][1] * v[j][1] + v[j][2] * v[j][2] + v[j][3] * v[j][3]; }
#pragma unroll
            for (int o = 32; o > 0; o >>= 1) ss += __shfl_xor(ss, o);
            const float rinv = 1.f / sqrtf(ss * (1.f / D) + NORM_EPS); float s2 = 0.f;
#pragma unroll
            for (int j = 0; j < 4; ++j) { const int c = j * 256 + lane * 4; const f32x4 xv = *(const f32x4*)(xp + c);
#pragma unroll
                for (int q = 0; q < 4; ++q) { const float hv = xv[q] + MOD[c + q] * (v[j][q] * rinv * in.norm_g[D + c + q]); v[j][q] = hv; s2 += hv * hv; }
                if (!dry) *(f32x4*)(yp + c) = v[j]; }
#pragma unroll
            for (int o = 32; o > 0; o >>= 1) s2 += __shfl_xor(s2, o);
            const float r2 = 1.f / sqrtf(s2 * (1.f / D) + NORM_EPS);
#pragma unroll
            for (int j = 0; j < 4; ++j) { const int c = j * 256 + lane * 4; float uu[4], lo[4]; unsigned hw[2];
#pragma unroll
                for (int q = 0; q < 4; ++q) uu[q] = (v[j][q] * r2 * in.norm_g[2 * D + c + q]) * (1.f + MOD[2 * D + c + q]) + MOD[D + c + q];
                hw[0] = cvt_pk_bf16(uu[0], uu[1]); hw[1] = cvt_pk_bf16(uu[2], uu[3]);
                lo[0] = uu[0] - bflo(hw[0]); lo[1] = uu[1] - bfhi(hw[0]); lo[2] = uu[2] - bflo(hw[1]); lo[3] = uu[3] - bfhi(hw[1]);
                u32x2 w; w.x = hw[0]; w.y = hw[1]; *(u32x2*)(p.u + (size_t)r * D + c) = w; *(LAS u32x2*)(UH + lr * (D + 8) + c) = w;
                u32x2 wl; wl.x = cvt_pk_bf16(lo[0], lo[1]); wl.y = cvt_pk_bf16(lo[2], lo[3]); *(LAS u32x2*)(UL + lr * (D + 8) + c) = wl; }
        }
        __syncthreads();
        { const int fr = lane & 15, fq = lane >> 4;
          f32x4 acc[4];
#pragma unroll
          for (int ct = 0; ct < 4; ++ct) acc[ct] = (f32x4){0.f, 0.f, 0.f, 0.f};
#pragma unroll
          for (int ks = 0; ks < 4; ++ks) { const int k0 = wid * 128 + ks * 32 + fq * 8;
              const bf16x8 ah = *(const LAS bf16x8*)(UH + fr * (D + 8) + k0), al = *(const LAS bf16x8*)(UL + fr * (D + 8) + k0);
#pragma unroll
              for (int ct = 0; ct < 4; ++ct) { const bf16x8 bh = *(const bf16x8*)(p.rwt + (size_t)(ct * 16 + fr) * D + k0), bl = *(const bf16x8*)(p.rwt + (size_t)(NE + ct * 16 + fr) * D + k0);
                  acc[ct] = __builtin_amdgcn_mfma_f32_16x16x32_bf16(ah, bh, acc[ct], 0, 0, 0); acc[ct] = __builtin_amdgcn_mfma_f32_16x16x32_bf16(ah, bl, acc[ct], 0, 0, 0); acc[ct] = __builtin_amdgcn_mfma_f32_16x16x32_bf16(al, bh, acc[ct], 0, 0, 0); } }
#pragma unroll
          for (int ct = 0; ct < 4; ++ct)
#pragma unroll
              for (int i = 0; i < 4; ++i) PART[(wid * 16 + fq * 4 + i) * 64 + ct * 16 + fr] = acc[ct][i]; }
        __syncthreads();
        for (int i = tid; i < 16 * 64; i += NT) { float s = 0.f;
#pragma unroll
            for (int w = 0; w < 8; ++w) s += PART[w * 1024 + i];
            LOG[i] = s; }
        __syncthreads();
#pragma unroll 1
        for (int rr = 0; rr < 2; ++rr) {
            const int lr = wid * 2 + rr, r = r16 + lr;
            const float sc = sigmoidf_(LOG[lr * 64 + lane]), bi = sc + in.router_b[lane];
            float m1 = bi; m1 = fmaxf(m1, __shfl_xor(m1, 1)); m1 = fmaxf(m1, __shfl_xor(m1, 2)); m1 = fmaxf(m1, __shfl_xor(m1, 4));
            const unsigned long long eq = __ballot(bi == m1); const int first = __ffsll((long long)((eq >> (lane & ~7)) & 0xffull)) - 1 + (lane & ~7);
            float m2 = (lane == first) ? -1e30f : bi; m2 = fmaxf(m2, __shfl_xor(m2, 1)); m2 = fmaxf(m2, __shfl_xor(m2, 2)); m2 = fmaxf(m2, __shfl_xor(m2, 4));
            const float gs = m1 + m2; const int myg = lane >> 3; int rank = 0;
#pragma unroll
            for (int g = 0; g < NG; ++g) { const float og = __shfl(gs, g * 8); rank += (og > gs || (og == gs && g < myg)) ? 1 : 0; }
            float cand = rank < TG ? bi : -1e30f; float tsum = 0.f; int myidx = 0; float mysc = 0.f;
#pragma unroll
            for (int it = 0; it < TOPK; ++it) { const float m = wave_max(cand); const unsigned long long bm = __ballot(cand == m); const int win = __ffsll((long long)bm) - 1;
                const float ws = __shfl(sc, win); tsum += ws; if (lane == it) { myidx = win; mysc = ws; } if (lane == win) cand = -1e30f; }
            if (lane < TOPK) { const int rk = atomicAdd((int*)&HIST[myidx], 1);
                p.tope[(size_t)r * TOPK + lane] = myidx; p.gatev[(size_t)r * TOPK + lane] = mysc / tsum * 2.5f; p.lrank[(size_t)r * TOPK + lane] = rk; }
        }
        __syncthreads();
    }
    if (tid < 64) p.blkcnt[blockIdx.x * 64 + tid] = HIST[tid];
}

struct MoeP { const int* tope; const float* gatev; const int* lrank; const int* blkcnt;
              int* tilepre;
              int* list;
              int* sdst;
              float* sgate;
              int r0, nr, blk0, nbh, rpb, pad_; };
__device__ __forceinline__ void moe_assign(LAS unsigned char* lds, const MoeP p, int bid, int nblk) {
    LAS int* BASE = (LAS int*)lds; LAS int* CNT = BASE + 80; LAS int* BOFF = CNT + 80;
    const int tid = threadIdx.x;
    if (tid < NE) { int c = 0, bo = 0; for (int b = 0; b < p.nbh; ++b) { const int v = p.blkcnt[(p.blk0 + b) * 64 + tid]; if (p.blk0 + b < bid) bo += v; c += v; } CNT[tid] = c; BOFF[tid] = bo; }
    __syncthreads();
    if (tid == 0) { int s = 0; for (int e = 0; e < NE; ++e) { BASE[e] = s; s += (CNT[e] + BM - 1) / BM * BM; } BASE[NE] = s; CNT[NE] = p.nr; BASE[NE + 1] = s + p.nr;
        if (bid == 0) { for (int e = 0; e <= NEX; ++e) p.tilepre[e] = BASE[e] / BM; } }
    __syncthreads();
    if (bid >= p.blk0 && bid < p.blk0 + p.nbh) {
        const int rlo = p.r0 + (bid - p.blk0) * p.rpb;
        for (int i = tid; i < p.rpb * TOPK; i += NT) { const int r = rlo + i / TOPK, a = r * TOPK + i % TOPK, e = p.tope[a]; const int slot = BASE[e] + BOFF[e] + p.lrank[a];
            p.list[slot] = r; p.sdst[slot] = (r - p.r0) * SLOTS_PER_TOK + i % TOPK; p.sgate[slot] = p.gatev[a]; }
        for (int i = tid; i < p.rpb; i += NT) { const int r = rlo + i, slot = BASE[NE] + (r - p.r0); p.list[slot] = r; p.sdst[slot] = (r - p.r0) * SLOTS_PER_TOK + TOPK; p.sgate[slot] = 1.f; }
    }
    for (int e = bid; e < NE; e += nblk) { const int lo = BASE[e] + CNT[e], hi = BASE[e + 1]; for (int s = lo + tid; s < hi; s += NT) { p.list[s] = p.r0; p.sdst[s] = -1; p.sgate[s] = 0.f; } }
}
struct GroupOrder { int tpn, total, nN, G, c;
    __device__ void init(const int* tilepre, int nN_, int G_, int c_) { const int lane = threadIdx.x & 63;
        tpn = (int)__hip_atomic_load((const unsigned*)tilepre + lane + 1, __ATOMIC_RELAXED, __HIP_MEMORY_SCOPE_AGENT);
        total = (int)__hip_atomic_load((const unsigned*)tilepre + NEX, __ATOMIC_RELAXED, __HIP_MEMORY_SCOPE_AGENT); nN = nN_; G = G_; c = c_; }
    __device__ bool next(int i, Unit& u) const { const long L = (long)i * G + c; if (L >= (long)total * nN) return false;
        const int T = (int)(L / nN); const int e = __popcll(__ballot(tpn <= T));
        u.pm = T; u.pn = (int)(L % nN); u.e = __builtin_amdgcn_readfirstlane(e); return true; } };
struct EpiGU { bf16_t* act;
    __device__ __forceinline__ bool operator()(f32x4 (&acc)[2][2][4][2], const Unit& u, int wr, int wc, int fr, int fq) const {
        MK_FRAG_LOOP(r, c) { const f32x4 a = acc[ai][bj][m][0], b = acc[ai][bj][m][1];
            u32x2 w; w.x = cvt_pk_bf16(fast_silu(a[0]) * a[1], fast_silu(a[2]) * a[3]); w.y = cvt_pk_bf16(fast_silu(b[0]) * b[1], fast_silu(b[2]) * b[3]);
            *(u32x2*)(act + (size_t)(u.pm * BM + r) * EF + ((u.pn * BM + c) >> 1)) = w; }
        return false; } };
struct EpiDown { const int* sdst; const float* sgate; bf16_t* rowsb;
    __device__ __forceinline__ bool operator()(f32x4 (&acc)[2][2][4][2], const Unit& u, int wr, int wc, int fr, int fq) const {
        MK_FRAG_LOOP(r, c) { const int slot = u.pm * BM + r, dst = sdst[slot]; if (dst >= 0) { const float g = sgate[slot];
            f32x4 a = acc[ai][bj][m][0], b = acc[ai][bj][m][1];
#pragma unroll
            for (int j = 0; j < 4; ++j) { a[j] *= g; b[j] *= g; }
            *(u32x4*)(rowsb + (size_t)dst * D + u.pn * BM + c) = pack8(a, b); } }
        return false; } };
__device__ __forceinline__ void final_rows(LAS float* sm  , const In& in, const float* modpart, const bf16_t* rowsb, float* h1out, int b0, int r0, int row_lo, int row_hi, bool dry = false) {
    const int tid = threadIdx.x, lane = tid & 63, wid = tid >> 6;
    const int mr = b0 + row_lo / SEQ;
    __syncthreads();
    for (int j = tid; j < D; j += NT) sm[j] = mod_value(in, modpart, mr, 5 * D + j);
    __syncthreads();
    for (int r = row_lo + wid; r < row_hi; r += NT / 64) {
        float v[16];
#pragma unroll
        for (int j = 0; j < 16; ++j) v[j] = 0.f;
        const bf16_t* rb = rowsb + (size_t)(r - r0) * SLOTS_PER_TOK * D;
#pragma unroll
        for (int s = 0; s < SLOTS_PER_TOK; ++s)
#pragma unroll
            for (int j = 0; j < 4; ++j) { const u32x2 w = *(const u32x2*)(rb + (size_t)s * D + j * 256 + lane * 4); v[4 * j] += bflo(w.x); v[4 * j + 1] += bfhi(w.x); v[4 * j + 2] += bflo(w.y); v[4 * j + 3] += bfhi(w.y); }
        float ss = 0.f;
#pragma unroll
        for (int j = 0; j < 16; ++j) ss += v[j] * v[j];
#pragma unroll
        for (int o = 32; o > 0; o >>= 1) ss += __shfl_xor(ss, o);
        const float rinv = 1.f / sqrtf(ss * (1.f / D) + NORM_EPS);
        float* hp = h1out + (size_t)r * D;
#pragma unroll
        for (int j = 0; j < 4; ++j) { const int c = j * 256 + lane * 4; f32x4 hv = *(const f32x4*)(hp + c);
#pragma unroll
            for (int q = 0; q < 4; ++q) hv[q] += sm[c + q] * (v[4 * j + q] * rinv * in.norm_g[3 * D + c + q]);
            if (!dry) *(f32x4*)(hp + c) = hv; else if (hv[0] == 1.2345e30f) *(f32x4*)(hp + c) = hv; }
    }
}
__device__ __forceinline__ void rwt_prep(const In& in, bf16_t* rwt, int bid, int nblk) {
    for (int i = bid * NT + threadIdx.x; i < NE * D; i += nblk * NT) { const int e = i / D, k = i % D; const float w = in.router_w[(size_t)k * NE + e]; const bf16_t h = f2bf(w); rwt[i] = h; rwt[(size_t)NE * D + i] = f2bf(w - bf2f(h)); }
}
}

using namespace mk;
constexpr size_t MiB = (size_t)1 << 20;
constexpr int NLAT = NB * SEQ, NCTXR = NB * CTX, NALL = NLAT + NCTXR, NRH = NLAT / 2, MAXSLOTS = NRH * SLOTS_PER_TOK + NE * BM;
constexpr size_t O_W1A = 0, O_W1C = O_W1A + (size_t)Z1_N * D * 2, O_WG = O_W1C + (size_t)ZC_N * D * 2, O_WBR = O_WG + (size_t)RW * AG_K * 2, O_WOUT = O_WBR + (size_t)2 * D * RW * 2,
                 O_RWT = O_WOUT + (size_t)D * D * 2, O_MODP = O_RWT + (size_t)2 * NE * D * 2, O_S_END = O_MODP + (size_t)MOD_SL * (NB + 1) * 6 * D * 4;
static_assert(O_S_END <= 27 * MiB, "S region");
constexpr size_t O_BAR = 27 * MiB;
constexpr size_t O_Z1 = 28 * MiB, O_R2 = O_Z1 + (size_t)NALL * Z1_N * 2;
static_assert(O_R2 == 334 * MiB, "z1 size");
constexpr size_t O_HD = O_R2, O_BON = O_HD + (size_t)2 * NLAT * LW * 2, O_AG = O_BON + (size_t)2 * NLAT * NH * 4, O_R2_END = O_AG + (size_t)NLAT * AG_K * 2;
static_assert(O_R2_END <= 512 * MiB, "R2");
constexpr size_t O_XNL = O_Z1, O_YB = O_XNL + (size_t)NLAT * D * 2, O_GATES = O_YB + (size_t)NLAT * LW * 2, O_MIXED = O_HD;
static_assert(O_GATES + (size_t)NLAT * 2 * D * 2 <= O_R2, "late R1");
constexpr size_t O_U = O_Z1, O_WGU = O_U + (size_t)NLAT * D * 2, O_WDN = O_WGU + (size_t)NEX * 2 * EF * D * 2, O_ROUT = O_WDN + (size_t)NEX * D * EF * 2;
constexpr size_t O_TOPE = O_ROUT, O_LRANK = O_TOPE + (size_t)NLAT * TOPK * 4, O_GATEV = O_LRANK + (size_t)NLAT * TOPK * 4, O_BLKCNT = O_GATEV + (size_t)NLAT * TOPK * 4, O_TILEPRE = O_BLKCNT + 256 * 64 * 4,
                 O_LIST = O_TILEPRE + 1024, O_SDST = O_LIST + (size_t)MAXSLOTS * 4, O_SGATE = O_SDST + (size_t)MAXSLOTS * 4, O_ACT = ((O_SGATE + (size_t)MAXSLOTS * 4 + 255) / 256) * 256,
                 O_ROWSB = ((O_ACT + (size_t)MAXSLOTS * EF * 2 + 255) / 256) * 256, O_END = O_ROWSB + (size_t)NRH * SLOTS_PER_TOK * D * 2;
static_assert(O_END <= 512 * MiB, "workspace");
static_assert(O_WGU >= O_YB && O_ROWSB >= O_GATES, "late layout");

struct MP { In in; float* out; unsigned char* ws; long ph_lo, ph_hi; };
constexpr int NPHASE = 17;

__global__ void __launch_bounds__(512, 2) mega(MP P) {
    extern __shared__ __attribute__((aligned(16))) unsigned char shm[];
    LAS unsigned char* lds = (LAS unsigned char*)shm;
    const In& in = P.in; unsigned char* ws = P.ws; const int bid = blockIdx.x, nblk = gridDim.x;
    bf16_t *W1a = (bf16_t*)(ws + O_W1A), *W1c = (bf16_t*)(ws + O_W1C), *Wg = (bf16_t*)(ws + O_WG), *Wbr = (bf16_t*)(ws + O_WBR), *Wout = (bf16_t*)(ws + O_WOUT), *rwt = (bf16_t*)(ws + O_RWT);
    float* modpart = (float*)(ws + O_MODP);
    bf16_t *z1 = (bf16_t*)(ws + O_Z1), *Hd = (bf16_t*)(ws + O_HD), *Ag = (bf16_t*)(ws + O_AG); float* bon = (float*)(ws + O_BON);
    bf16_t *xnl = (bf16_t*)(ws + O_XNL), *yb = (bf16_t*)(ws + O_YB), *gates = (bf16_t*)(ws + O_GATES), *mixed = (bf16_t*)(ws + O_MIXED);
    bf16_t *u = (bf16_t*)(ws + O_U), *Wgu = (bf16_t*)(ws + O_WGU), *Wdn = (bf16_t*)(ws + O_WDN), *act = (bf16_t*)(ws + O_ACT), *rowsb = (bf16_t*)(ws + O_ROWSB);
    int *tope = (int*)(ws + O_TOPE), *lrank = (int*)(ws + O_LRANK), *blkcnt = (int*)(ws + O_BLKCNT), *tilepre = (int*)(ws + O_TILEPRE), *list = (int*)(ws + O_LIST), *sdst = (int*)(ws + O_SDST);
    float *gatev = (float*)(ws + O_GATEV), *sgate = (float*)(ws + O_SGATE);
    bf16_t* xn_all = (bf16_t*)P.out;
    bf16_t* Y = (bf16_t*)P.out;
    float* y2h1 = P.out;
    const int ph_lo = (int)P.ph_lo, ph_hi = (int)P.ph_hi;
    volatile LAS unsigned* xst = (volatile LAS unsigned*)(lds + LDS_BYTES - 16);
    if (threadIdx.x == 0) { xst[0] = 0u; xst[1] = 0u; }
    __syncthreads();
    const XcdBarrier xb = xcd_barrier_post((unsigned*)(ws + O_BAR), xst);
    if (0 >= ph_lo && 0 < ph_hi) { if (0 > ph_lo) xcd_barrier(xb); const int ph = 0; (void)ph;
        { LAS float* tile = (LAS float*)lds; int base = 0;
            convT_job(tile, in.w_in, INC, D, W1a, D, Z1_N, CMapZ1{}, bid, nblk, base);
            convT_job(tile, in.w_in, INC, D, W1c, D, ZC_N, CMapZC{}, bid, nblk, base);
            convT_job(tile, in.rw_g_up, RW, GL, Wg, AG_K, RW, CMapId{}, bid, nblk, base);
            convT_job(tile, in.w_branch_a, D, RW, Wbr, RW, D, CMapId{}, bid, nblk, base);
            convT_job(tile, in.w_branch_b, D, LW, Wbr + (size_t)D * RW, LW, D, CMapId{}, bid, nblk, base);
            convT_job(tile, in.w_out, D, D, Wout, D, D, CMapId{}, bid, nblk, base);
            rwt_prep(in, rwt, bid, nblk);
            mod_partials((LAS float*)lds, in, modpart, bid, nblk); }
    }
    if (1 >= ph_lo && 1 < ph_hi) { if (1 > ph_lo) xcd_barrier(xb); const int ph = 1; (void)ph;
        { const int L = NLAT / nblk, Lc = NCTXR / nblk;
            xn_rows((LAS float*)lds, in, modpart, xn_all, 0, NB, bid * L, (bid + 1) * L);
            xn_rows((LAS float*)lds, in, modpart, xn_all, 0, NB, NLAT + bid * Lc, NLAT + (bid + 1) * Lc); }
    }
    if (2 >= ph_lo && 2 < ph_hi) { if (2 > ph_lo) xcd_barrier(xb); const int ph = 2; (void)ph;
        { GemmP g{xn_all, xn_all, W1a, 0, nullptr, D, 0}; StaticOrder S; S.init(NALL, Z1_N, nblk, bid); gemm_phase(lds, g, S, EpiStoreBf16{z1, Z1_N}); }
    }
    if (3 >= ph_lo && 3 < ph_hi) { if (3 > ph_lo) xcd_barrier(xb); const int ph = 3; (void)ph;
        { LruP lp{z1, Hd, 0, NB}; lru_phase(lds, in, lp, bid, nblk); __syncthreads();
                  RwkvP rp{z1, Y, bon, 0, NB}; rwkv_phase2(lds, in, rp, bid, nblk); }
    }
    if (4 >= ph_lo && 4 < ph_hi) { if (4 > ph_lo) xcd_barrier(xb); const int ph = 4; (void)ph;
        { const int L = NLAT / nblk; PostP pp{z1, Y, bon, Ag, NLAT, 0}; rwkv_post_rows(in, pp, bid * L, (bid + 1) * L); }
    }
    if (5 >= ph_lo && 5 < ph_hi) { if (5 > ph_lo) xcd_barrier(xb); const int ph = 5; (void)ph;
        { const int L = NLAT / nblk; xn_rows((LAS float*)lds, in, modpart, xnl, 0, NB, bid * L, (bid + 1) * L); __syncthreads();
                  GemmP g{Ag, Ag, Wg, 0, nullptr, AG_K, 0}; StaticOrder S; S.init(NLAT, RW, nblk, bid); gemm_phase(lds, g, S, EpiYa{Y, Y + (size_t)NLAT * RW}); }
    }
    if (6 >= ph_lo && 6 < ph_hi) { if (6 > ph_lo) xcd_barrier(xb); const int ph = 6; (void)ph;
        { GemmP g{xnl, xnl, W1c, 0, nullptr, D, 0}; StaticOrder S; S.init(NLAT, ZC_N, nblk, bid); gemm_phase(lds, g, S, EpiZc{Hd, yb, gates, NLAT, 0}); }
    }
    if (7 >= ph_lo && 7 < ph_hi) { if (7 > ph_lo) xcd_barrier(xb); const int ph = 7; (void)ph;
        { GemmP g{Y + (size_t)NLAT * RW, yb, Wbr, (long)D * RW, nullptr, D, 0}; PairOrder S; S.S.init(NLAT, D, nblk, bid); gemm_phase(lds, g, S, EpiBranch{gates, mixed}); }
    }
    if (8 >= ph_lo && 8 < ph_hi) { if (8 > ph_lo) xcd_barrier(xb); const int ph = 8; (void)ph;
        { LAS float* tile = (LAS float*)lds; int base = 0;
            for (int e = 0; e < NE; ++e) {
                convT_job(tile, in.ex_w_gu + (size_t)e * D * 2 * EF, 2 * EF, D, Wgu + (size_t)e * 2 * EF * D, D, 2 * EF, CMapGU{EF}, bid, nblk, base);
                convT_job(tile, in.ex_w_down + (size_t)e * EF * D, D, EF, Wdn + (size_t)e * D * EF, EF, D, CMapId{}, bid, nblk, base); }
            convT_job(tile, in.sh_w_gu, 2 * SF, D, Wgu + (size_t)NE * 2 * EF * D, D, 2 * SF, CMapGU{SF}, bid, nblk, base);
            convT_job(tile, in.sh_w_down, D, SF, Wdn + (size_t)NE * D * EF, SF, D, CMapId{}, bid, nblk, base);
            __syncthreads();
            GemmP g{mixed, mixed, Wout, 0, nullptr, D, 0}; StaticOrder S; S.init(NLAT, D, nblk, bid); gemm_phase(lds, g, S, EpiF32{y2h1, D}); }
    }
    if (9 >= ph_lo && 9 < ph_hi) { if (9 > ph_lo) xcd_barrier(xb); const int ph = 9; (void)ph;
        { const int L = NLAT / nblk; RowP rp{y2h1, u, modpart, rwt, tope, gatev, lrank, blkcnt, 0, NLAT}; row_pass(lds, in, rp, bid * L, (bid + 1) * L); }
    }
    if (10 >= ph_lo && 10 < ph_hi) { if (10 > ph_lo) xcd_barrier(xb); const int ph = 10; (void)ph;
        { const int q = ph - 10, half = q >= 4 ? 1 : 0, st = q - 4 * half;
            const int rpb = NLAT / nblk;
            auto assign = [&](int hf) { MoeP mp{tope, gatev, lrank, blkcnt, tilepre, list, sdst, sgate, hf * NRH, NRH, hf * (nblk / 2), nblk / 2, rpb, 0}; moe_assign(lds, mp, bid, nblk); };
            auto fin = [&](int hf) { const int L = NRH / nblk, r0 = hf * NRH; final_rows((LAS float*)lds, in, modpart, rowsb, y2h1, 0, r0, r0 + bid * L, r0 + (bid + 1) * L); };
            if (ph == 10) assign(0);
            else if (ph == 11 || ph == 14) { GemmP g{u, u, Wgu, (long)2 * EF * D, list, D, 0}; GroupOrder S; S.init(tilepre, 2 * EF / BM, nblk, bid); gemm_phase(lds, g, S, EpiGU{act}); }
            else if (ph == 12 || ph == 15) { GemmP g{act, act, Wdn, (long)D * EF, nullptr, EF, 0}; GroupOrder S; S.init(tilepre, D / BM, nblk, bid); gemm_phase(lds, g, S, EpiDown{sdst, sgate, rowsb}); }
            else if (ph == 13) { fin(0); __syncthreads(); assign(1); }
            else if (ph == 16) fin(1);
            (void)half; (void)st; }
    }
    if (11 >= ph_lo && 11 < ph_hi) { if (11 > ph_lo) xcd_barrier(xb); const int ph = 11; (void)ph;
        { const int q = ph - 10, half = q >= 4 ? 1 : 0, st = q - 4 * half;
            const int rpb = NLAT / nblk;
            auto assign = [&](int hf) { MoeP mp{tope, gatev, lrank, blkcnt, tilepre, list, sdst, sgate, hf * NRH, NRH, hf * (nblk / 2), nblk / 2, rpb, 0}; moe_assign(lds, mp, bid, nblk); };
            auto fin = [&](int hf) { const int L = NRH / nblk, r0 = hf * NRH; final_rows((LAS float*)lds, in, modpart, rowsb, y2h1, 0, r0, r0 + bid * L, r0 + (bid + 1) * L); };
            if (ph == 10) assign(0);
            else if (ph == 11 || ph == 14) { GemmP g{u, u, Wgu, (long)2 * EF * D, list, D, 0}; GroupOrder S; S.init(tilepre, 2 * EF / BM, nblk, bid); gemm_phase(lds, g, S, EpiGU{act}); }
            else if (ph == 12 || ph == 15) { GemmP g{act, act, Wdn, (long)D * EF, nullptr, EF, 0}; GroupOrder S; S.init(tilepre, D / BM, nblk, bid); gemm_phase(lds, g, S, EpiDown{sdst, sgate, rowsb}); }
            else if (ph == 13) { fin(0); __syncthreads(); assign(1); }
            else if (ph == 16) fin(1);
            (void)half; (void)st; }
    }
    if (12 >= ph_lo && 12 < ph_hi) { if (12 > ph_lo) xcd_barrier(xb); const int ph = 12; (void)ph;
        { const int q = ph - 10, half = q >= 4 ? 1 : 0, st = q - 4 * half;
            const int rpb = NLAT / nblk;
            auto assign = [&](int hf) { MoeP mp{tope, gatev, lrank, blkcnt, tilepre, list, sdst, sgate, hf * NRH, NRH, hf * (nblk / 2), nblk / 2, rpb, 0}; moe_assign(lds, mp, bid, nblk); };
            auto fin = [&](int hf) { const int L = NRH / nblk, r0 = hf * NRH; final_rows((LAS float*)lds, in, modpart, rowsb, y2h1, 0, r0, r0 + bid * L, r0 + (bid + 1) * L); };
            if (ph == 10) assign(0);
            else if (ph == 11 || ph == 14) { GemmP g{u, u, Wgu, (long)2 * EF * D, list, D, 0}; GroupOrder S; S.init(tilepre, 2 * EF / BM, nblk, bid); gemm_phase(lds, g, S, EpiGU{act}); }
            else if (ph == 12 || ph == 15) { GemmP g{act, act, Wdn, (long)D * EF, nullptr, EF, 0}; GroupOrder S; S.init(tilepre, D / BM, nblk, bid); gemm_phase(lds, g, S, EpiDown{sdst, sgate, rowsb}); }
            else if (ph == 13) { fin(0); __syncthreads(); assign(1); }
            else if (ph == 16) fin(1);
            (void)half; (void)st; }
    }
    if (13 >= ph_lo && 13 < ph_hi) { if (13 > ph_lo) xcd_barrier(xb); const int ph = 13; (void)ph;
        { const int q = ph - 10, half = q >= 4 ? 1 : 0, st = q - 4 * half;
            const int rpb = NLAT / nblk;
            auto assign = [&](int hf) { MoeP mp{tope, gatev, lrank, blkcnt, tilepre, list, sdst, sgate, hf * NRH, NRH, hf * (nblk / 2), nblk / 2, rpb, 0}; moe_assign(lds, mp, bid, nblk); };
            auto fin = [&](int hf) { const int L = NRH / nblk, r0 = hf * NRH; final_rows((LAS float*)lds, in, modpart, rowsb, y2h1, 0, r0, r0 + bid * L, r0 + (bid + 1) * L); };
            if (ph == 10) assign(0);
            else if (ph == 11 || ph == 14) { GemmP g{u, u, Wgu, (long)2 * EF * D, list, D, 0}; GroupOrder S; S.init(tilepre, 2 * EF / BM, nblk, bid); gemm_phase(lds, g, S, EpiGU{act}); }
            else if (ph == 12 || ph == 15) { GemmP g{act, act, Wdn, (long)D * EF, nullptr, EF, 0}; GroupOrder S; S.init(tilepre, D / BM, nblk, bid); gemm_phase(lds, g, S, EpiDown{sdst, sgate, rowsb}); }
            else if (ph == 13) { fin(0); __syncthreads(); assign(1); }
            else if (ph == 16) fin(1);
            (void)half; (void)st; }
    }
    if (14 >= ph_lo && 14 < ph_hi) { if (14 > ph_lo) xcd_barrier(xb); const int ph = 14; (void)ph;
        { const int q = ph - 10, half = q >= 4 ? 1 : 0, st = q - 4 * half;
            const int rpb = NLAT / nblk;
            auto assign = [&](int hf) { MoeP mp{tope, gatev, lrank, blkcnt, tilepre, list, sdst, sgate, hf * NRH, NRH, hf * (nblk / 2), nblk / 2, rpb, 0}; moe_assign(lds, mp, bid, nblk); };
            auto fin = [&](int hf) { const int L = NRH / nblk, r0 = hf * NRH; final_rows((LAS float*)lds, in, modpart, rowsb, y2h1, 0, r0, r0 + bid * L, r0 + (bid + 1) * L); };
            if (ph == 10) assign(0);
            else if (ph == 11 || ph == 14) { GemmP g{u, u, Wgu, (long)2 * EF * D, list, D, 0}; GroupOrder S; S.init(tilepre, 2 * EF / BM, nblk, bid); gemm_phase(lds, g, S, EpiGU{act}); }
            else if (ph == 12 || ph == 15) { GemmP g{act, act, Wdn, (long)D * EF, nullptr, EF, 0}; GroupOrder S; S.init(tilepre, D / BM, nblk, bid); gemm_phase(lds, g, S, EpiDown{sdst, sgate, rowsb}); }
            else if (ph == 13) { fin(0); __syncthreads(); assign(1); }
            else if (ph == 16) fin(1);
            (void)half; (void)st; }
    }
    if (15 >= ph_lo && 15 < ph_hi) { if (15 > ph_lo) xcd_barrier(xb); const int ph = 15; (void)ph;
        { const int q = ph - 10, half = q >= 4 ? 1 : 0, st = q - 4 * half;
            const int rpb = NLAT / nblk;
            auto assign = [&](int hf) { MoeP mp{tope, gatev, lrank, blkcnt, tilepre, list, sdst, sgate, hf * NRH, NRH, hf * (nblk / 2), nblk / 2, rpb, 0}; moe_assign(lds, mp, bid, nblk); };
            auto fin = [&](int hf) { const int L = NRH / nblk, r0 = hf * NRH; final_rows((LAS float*)lds, in, modpart, rowsb, y2h1, 0, r0, r0 + bid * L, r0 + (bid + 1) * L); };
            if (ph == 10) assign(0);
            else if (ph == 11 || ph == 14) { GemmP g{u, u, Wgu, (long)2 * EF * D, list, D, 0}; GroupOrder S; S.init(tilepre, 2 * EF / BM, nblk, bid); gemm_phase(lds, g, S, EpiGU{act}); }
            else if (ph == 12 || ph == 15) { GemmP g{act, act, Wdn, (long)D * EF, nullptr, EF, 0}; GroupOrder S; S.init(tilepre, D / BM, nblk, bid); gemm_phase(lds, g, S, EpiDown{sdst, sgate, rowsb}); }
            else if (ph == 13) { fin(0); __syncthreads(); assign(1); }
            else if (ph == 16) fin(1);
            (void)half; (void)st; }
    }
    if (16 >= ph_lo && 16 < ph_hi) { if (16 > ph_lo) xcd_barrier(xb); const int ph = 16; (void)ph;
        { const int q = ph - 10, half = q >= 4 ? 1 : 0, st = q - 4 * half;
            const int rpb = NLAT / nblk;
            auto assign = [&](int hf) { MoeP mp{tope, gatev, lrank, blkcnt, tilepre, list, sdst, sgate, hf * NRH, NRH, hf * (nblk / 2), nblk / 2, rpb, 0}; moe_assign(lds, mp, bid, nblk); };
            auto fin = [&](int hf) { const int L = NRH / nblk, r0 = hf * NRH; final_rows((LAS float*)lds, in, modpart, rowsb, y2h1, 0, r0, r0 + bid * L, r0 + (bid + 1) * L); };
            if (ph == 10) assign(0);
            else if (ph == 11 || ph == 14) { GemmP g{u, u, Wgu, (long)2 * EF * D, list, D, 0}; GroupOrder S; S.init(tilepre, 2 * EF / BM, nblk, bid); gemm_phase(lds, g, S, EpiGU{act}); }
            else if (ph == 12 || ph == 15) { GemmP g{act, act, Wdn, (long)D * EF, nullptr, EF, 0}; GroupOrder S; S.init(tilepre, D / BM, nblk, bid); gemm_phase(lds, g, S, EpiDown{sdst, sgate, rowsb}); }
            else if (ph == 13) { fin(0); __syncthreads(); assign(1); }
            else if (ph == 16) fin(1);
            (void)half; (void)st; }
    }
}
extern "C" void kernel_launch(void* const* d_in, const int* in_sizes, int n_in, void* d_out, int out_size, void* d_ws, size_t ws_size, hipStream_t stream) {
    static int grid = 0;
    if (grid == 0) {
        int dev = 0, cus = 0; hipGetDevice(&dev); hipDeviceGetAttribute(&cus, hipDeviceAttributeMultiprocessorCount, dev);
        hipFuncSetAttribute((const void*)mega, hipFuncAttributeMaxDynamicSharedMemorySize, LDS_BYTES);
        grid = cus;
        if (ws_size < O_END || grid != 256) fprintf(stderr, "kernel_launch: unexpected ws_size %zu (need %zu) or CU count %d\n", ws_size, (size_t)O_END, grid);
    }
    hipMemsetAsync((char*)d_ws + O_BAR, 0, XCD_BAR_WORDS * 4, stream);
    MP P; memset(&P, 0, sizeof(P));
    const float** f = (const float**)&P.in; for (int i = 0; i < 32; ++i) f[i] = (const float*)d_in[i];
    P.out = (float*)d_out; P.ws = (unsigned char*)d_ws;
#ifdef MK_PER_PHASE
    for (int ph = 0; ph < NPHASE; ++ph) { P.ph_lo = ph; P.ph_hi = ph + 1; hipLaunchKernelGGL(mega, dim3(grid), dim3(NT), LDS_BYTES, stream, P); }
#else
    P.ph_lo = 0; P.ph_hi = NPHASE;
    void* args[] = {&P};
    hipError_t e = hipLaunchCooperativeKernel((void*)mega, dim3(grid), dim3(NT), args, LDS_BYTES, stream);
    if (e != hipSuccess) fprintf(stderr, "cooperative launch failed: %s (grid %d)\n", hipGetErrorString(e), grid);
#endif
}
```

```cpp
#include <hip/hip_runtime.h>
#include <cstdio>
#include <cstring>
#define HD __host__ __device__ __forceinline__
static hipStream_t g_stream;

#ifdef SMALL
constexpr int D = 128, NB = 2, SEQ = 64, GW = 8, CTX = 16, RW = 128, RH = 64, DL = 16, AL = 16, GL = 24, LW = 128, LB = 2, NE = 8, TOPK = 3, NG = 4, TG = 2, EF = 32, SF = 32;
#else
constexpr int D = 1024, NB = 8, SEQ = 4096, GW = 64, CTX = 256, RW = 1024, RH = 64, DL = 64, AL = 64, GL = 160, LW = 1024, LB = 16, NE = 64, TOPK = 6, NG = 8, TG = 4, EF = 256, SF = 256;
#endif
constexpr int NH = RW / RH, LBS = LW / LB, ROWS = SEQ / GW, TA = CTX + SEQ;
constexpr int OFF_R = 0, OFF_K = RW, OFF_V = 2 * RW, OFF_WD = 3 * RW, OFF_AD = OFF_WD + 2 * DL, OFF_GD = OFF_AD + 2 * AL, RC = OFF_GD + GL;
constexpr int OFF_LX = RC, OFF_LG = OFF_LX + LW, OFF_GATE = OFF_LG + LW, INC = OFF_GATE + 2 * D;
constexpr int EPG = NE / NG, NASG = SEQ * TOPK;
#define NORM_EPS 1e-6f
#define LNX_EPS 64e-5f

HD float sigmoidf_(float x) { return 1.f / (1.f + expf(-x)); }
HD float softplusf_(float x) { return x > 20.f ? x : log1pf(expf(x)); }
HD float siluf_(float x) { return x * sigmoidf_(x); }
HD float gelu_tanhf_(float x) { return 0.5f * x * (1.f + tanhf(0.7978845608028654f * (x + 0.044715f * x * x * x))); }

struct In {
    const float *x, *c, *ctx, *c_ctx, *w_mod, *b_mod, *norm_g, *w_in, *shift_mu, *rw_w0, *rw_w_up, *rw_a0, *rw_a_up, *rw_g_up, *rw_k_k, *rw_k_a, *rw_r_k, *rw_lnx,
        *lru_conv_w, *lru_conv_b, *lru_gate_w, *lru_gate_b, *lru_l, *w_branch_a, *w_branch_b, *w_out, *router_w, *router_b, *ex_w_gu, *ex_w_down, *sh_w_gu, *sh_w_down;
};


namespace mk {
#define LAS __attribute__((address_space(3)))
typedef unsigned short bf16_t;
typedef short bf16x8 __attribute__((ext_vector_type(8)));
typedef float f32x4 __attribute__((ext_vector_type(4)));
typedef float f32x2 __attribute__((ext_vector_type(2)));
typedef unsigned u32x4 __attribute__((ext_vector_type(4)));
typedef unsigned u32x2 __attribute__((ext_vector_type(2)));
constexpr int NT = 512;
constexpr int BM = 256, BK = 64, HALF = 128, HTB = HALF * BK * 2, STAGE_BYTES = 8 * HTB;
constexpr int LDS_BYTES = 160 * 1024 - 1024;

constexpr int Z1_LX = 3584, Z1_N = 4608;
constexpr int ZC_N = 3072;

__device__ __forceinline__ unsigned cvt_pk_bf16(float lo, float hi) { unsigned r; asm volatile("v_cvt_pk_bf16_f32 %0, %1, %2" : "=v"(r) : "v"(lo), "v"(hi)); return r; }
__device__ __forceinline__ bf16_t f2bf(float f) { unsigned u = __float_as_uint(f); u += 0x7FFFu + ((u >> 16) & 1u); return (bf16_t)(u >> 16); }
__device__ __forceinline__ float bf2f(bf16_t b) { return __uint_as_float(((unsigned)b) << 16); }
__device__ __forceinline__ float bflo(unsigned w) { return __uint_as_float(w << 16); }
__device__ __forceinline__ float bfhi(unsigned w) { return __uint_as_float(w & 0xffff0000u); }

__device__ __forceinline__ float fast_rcp(float x) { return __builtin_amdgcn_rcpf(x); }
__device__ __forceinline__ float fast_sigmoid(float x) { return fast_rcp(1.f + __expf(-x)); }
__device__ __forceinline__ float fast_tanh(float x) { return 1.f - 2.f * fast_rcp(1.f + __expf(2.f * x)); }
__device__ __forceinline__ float fast_softplus(float x) { return x > 15.f ? x : __logf(1.f + __expf(x)); }
__device__ __forceinline__ float fast_silu(float x) { return x * fast_sigmoid(x); }
__device__ __forceinline__ float fast_gelu_tanh(float x) { return x * fast_sigmoid(1.5957691216057308f * (x + 0.044715f * x * x * x)); }
__device__ __forceinline__ int lds_byte(int r, int c) { const int st = (r >> 4) * 2 + (c >> 5), rr = r & 15, cc = c & 31, ob = rr * 64 + cc * 2; return st * 1024 + (ob ^ (((ob >> 9) & 1) << 5)); }
__device__ __forceinline__ void stage_rc(int b, int& R, int& C) { const int st = b / 1024, sb = b % 1024, swz = sb ^ (((sb >> 9) & 1) << 5); R = (st >> 1) * 16 + swz / 64; C = (st & 1) * 32 + (swz % 64) / 2; }
__device__ __forceinline__ int perm32(int rho) { const int n = rho >> 4, i = rho & 15; return 8 * (i >> 2) + 4 * n + (i & 3); }

struct Unit { int pm, pn, e; };
struct GemmP { const bf16_t* A0; const bf16_t* A1; const bf16_t* Bt; long strideB; const int* gather; int K; int pad_; };

struct StaticOrder {
    int nM, nN, nwg, G, c;
    __device__ void init(int M, int N, int G_, int c_) { nM = M / BM; nN = N / BM; nwg = nM * nN; G = G_; c = c_; }
    __device__ bool next(int i, Unit& u) const {
        const long L = (long)i * G + c; if (L >= nwg) return false;
        int wgid = (int)L; { const int q = nwg / 8, r = nwg % 8, xcd = wgid % 8, off = wgid / 8; wgid = (xcd < r ? xcd * (q + 1) : r * (q + 1) + (xcd - r) * q) + off; }
        const int nig = 8 * nN, gid = wgid / nig, fm = gid * 8, gsz = (nM - fm) < 8 ? (nM - fm) : 8;
        u.pm = fm + ((wgid % nig) % gsz); u.pn = (wgid % nig) / gsz; u.e = 0; return true;
    }
};

#define MK_FRAG_LOOP(ROW, COL) \
    _Pragma("unroll") for (int ai = 0; ai < 2; ++ai) _Pragma("unroll") for (int m = 0; m < 4; ++m) _Pragma("unroll") for (int bj = 0; bj < 2; ++bj) \
        if (const int ROW = ai * HALF + wr * 64 + m * 16 + fr; true) if (const int COL = bj * HALF + wc * 32 + 8 * fq; true)

template <bool GATHER = false, class Epi, class Sched>
__device__ __forceinline__ void gemm_phase(LAS unsigned char* lds, const GemmP g, const Sched& S, const Epi& E) {
    const int tid = threadIdx.x, wid = __builtin_amdgcn_readfirstlane(tid >> 6), lane = tid & 63, wr = wid >> 2, wc = wid & 3, fr = lane & 15, fq = lane >> 4;
    int K = g.K; asm volatile("" : "+s"(K));
    const int nt = K / BK;
    int RA[2], CA[2]; unsigned voffB[2];
#pragma unroll
    for (int i = 0; i < 2; ++i) { int R, C; stage_rc(tid * 16 + i * 8192, R, C); RA[i] = R; CA[i] = C; const int Rb = (R & ~31) + perm32(R & 31); voffB[i] = (unsigned)(Rb * K + C) * 2u; }
    const size_t kstep = (size_t)(BK * 2), hstepB = (size_t)HALF * K * 2, tstepB = 2 * hstepB;
    const unsigned ldsw = (unsigned)wid * 1024u;
    const int aoff = lds_byte(wr * 64 + fr, fq * 8), boff = lds_byte(wc * 32 + fr, fq * 8);
#define MK_SA(b, h) (((b) * 2 + (h)) * HTB)
#define MK_SB(b, h) ((4 + (b) * 2 + (h)) * HTB)
#define MK_STAGE(bufoff, gbase, voff) do { _Pragma("unroll") for (int _i = 0; _i < 2; ++_i) \
        __builtin_amdgcn_global_load_lds((const unsigned*)((const char*)(gbase) + (voff)[_i]), (LAS unsigned*)(lds + (bufoff) + ldsw + _i * 8192), 16, 0, 0); } while (0)
#define MK_LDA(dst, b, h) do { _Pragma("unroll") for (int m = 0; m < 4; ++m) _Pragma("unroll") for (int k = 0; k < 2; ++k) dst[m][k] = *(const LAS bf16x8*)(lds + MK_SA(b, h) + aoff + m * 2048 + k * 1024); } while (0)
#define MK_LDB(dst, b, h) do { _Pragma("unroll") for (int n = 0; n < 2; ++n) _Pragma("unroll") for (int k = 0; k < 2; ++k) dst[n][k] = *(const LAS bf16x8*)(lds + MK_SB(b, h) + boff + n * 2048 + k * 1024); } while (0)
#define MK_MMA(ai, bj, At, Bt) do { __builtin_amdgcn_s_setprio(1); _Pragma("unroll") for (int m = 0; m < 4; ++m) _Pragma("unroll") for (int n = 0; n < 2; ++n) _Pragma("unroll") for (int k = 0; k < 2; ++k) \
        acc[ai][bj][m][n] = __builtin_amdgcn_mfma_f32_16x16x32_bf16(Bt[n][k], At[m][k], acc[ai][bj][m][n], 0, 0, 0); __builtin_amdgcn_s_setprio(0); } while (0)
#define MK_WAIT_V(n) asm volatile("s_waitcnt vmcnt(" #n ")" ::: "memory")
#define MK_WAIT_L(n) asm volatile("s_waitcnt lgkmcnt(" #n ")" ::: "memory")
#define MK_BAR __builtin_amdgcn_s_barrier()
#define MK_SCHED __builtin_amdgcn_sched_barrier(0)
    Unit cur, nxt; int ui = 0;
    if (!S.next(0, cur)) return;
    f32x4 acc[2][2][4][2];
#pragma unroll
    for (int a = 0; a < 2; ++a)
#pragma unroll
        for (int b = 0; b < 2; ++b)
#pragma unroll
            for (int m = 0; m < 4; ++m)
#pragma unroll
                for (int n = 0; n < 2; ++n) acc[a][b][m][n] = (f32x4){0.f, 0.f, 0.f, 0.f};
    bf16x8 At[4][2], B0[2][2], B1[2][2];
    unsigned vA[2][2], vAn[2][2];
    const size_t hstepA = GATHER ? 0 : (size_t)HALF * K * 2, tstepA = 2 * (size_t)HALF * K * 2;
    auto a_voff = [&](const Unit& u, unsigned (&vo)[2][2]) {
#pragma unroll
        for (int h = 0; h < 2; ++h)
#pragma unroll
            for (int i = 0; i < 2; ++i) { if (GATHER) { const int row = u.pm * BM + h * HALF + RA[i]; vo[h][i] = (unsigned)((size_t)g.gather[row] * K + CA[i]) * 2u; } else vo[h][i] = (unsigned)(RA[i] * K + CA[i]) * 2u; }
    };
    a_voff(cur, vA);
    auto a_base = [&](const Unit& u) { return (const char*)(u.e ? g.A1 : g.A0) + (GATHER ? (size_t)0 : (size_t)u.pm * tstepA); };
    const char* cA = a_base(cur);
    const char* cB = (const char*)g.Bt + ((size_t)cur.e * g.strideB) * 2 + (size_t)cur.pn * tstepB;
    MK_STAGE(MK_SB(0, 0), cB, voffB); MK_STAGE(MK_SA(0, 0), cA, vA[0]); MK_STAGE(MK_SB(0, 1), cB + hstepB, voffB); MK_STAGE(MK_SA(0, 1), cA + hstepA, vA[1]);
    if (wr == 1) MK_BAR;
    MK_WAIT_V(4); MK_BAR;
    MK_STAGE(MK_SB(1, 0), cB + kstep, voffB); MK_STAGE(MK_SA(1, 0), cA + kstep, vA[0]); MK_STAGE(MK_SB(1, 1), cB + hstepB + kstep, voffB);
    MK_WAIT_V(6); MK_BAR;
    for (;;) {
        const bool has_next = S.next(ui + 1, nxt);
        const char* nA = has_next ? a_base(nxt) : cA;
        const char* nB = has_next ? (const char*)g.Bt + ((size_t)nxt.e * g.strideB) * 2 + (size_t)nxt.pn * tstepB : cB;
        for (int t = 0; t < nt; t += 2) {
            const bool last = (t == nt - 2);
            if (GATHER && last) { if (has_next) a_voff(nxt, vAn); else {
#pragma unroll
                for (int h = 0; h < 2; ++h)
#pragma unroll
                    for (int i = 0; i < 2; ++i) vAn[h][i] = vA[h][i]; } }
            const char* a1 = cA + (size_t)(t + 1) * kstep;
            const char* a2 = last ? nA : cA + (size_t)(t + 2) * kstep; const char* b2 = last ? nB : cB + (size_t)(t + 2) * kstep;
            const char* a3 = a2 + kstep; const char* b3 = b2 + kstep;
            unsigned v2[2][2];
#pragma unroll
            for (int h = 0; h < 2; ++h)
#pragma unroll
                for (int i = 0; i < 2; ++i) v2[h][i] = (GATHER && last) ? vAn[h][i] : vA[h][i];
            MK_LDB(B0, 0, 0); MK_SCHED; MK_LDA(At, 0, 0); MK_STAGE(MK_SA(1, 1), a1 + hstepA, vA[1]);
            MK_WAIT_L(8); MK_BAR; MK_WAIT_L(0); MK_MMA(0, 0, At, B0); MK_BAR; MK_SCHED;
            MK_LDB(B1, 0, 1); MK_STAGE(MK_SB(0, 0), b2, voffB);
            MK_BAR; MK_WAIT_L(0); MK_MMA(0, 1, At, B1); MK_BAR;
            MK_LDA(At, 0, 1); MK_STAGE(MK_SA(0, 0), a2, v2[0]);
            MK_BAR; MK_WAIT_L(0); MK_MMA(1, 0, At, B0); MK_BAR; MK_SCHED;
            MK_STAGE(MK_SB(0, 1), b2 + hstepB, voffB);
            MK_WAIT_V(6); MK_BAR; MK_MMA(1, 1, At, B1); MK_BAR;
            MK_LDB(B0, 1, 0); MK_SCHED; MK_LDA(At, 1, 0); MK_STAGE(MK_SA(0, 1), a2 + hstepA, v2[1]);
            MK_WAIT_L(8); MK_BAR; MK_WAIT_L(0); MK_MMA(0, 0, At, B0); MK_BAR; MK_SCHED;
            MK_LDB(B1, 1, 1); MK_STAGE(MK_SB(1, 0), b3, voffB);
            MK_BAR; MK_WAIT_L(0); MK_MMA(0, 1, At, B1); MK_BAR;
            MK_LDA(At, 1, 1); MK_STAGE(MK_SA(1, 0), a3, v2[0]);
            MK_BAR; MK_WAIT_L(0); MK_MMA(1, 0, At, B0); MK_BAR; MK_SCHED;
            MK_STAGE(MK_SB(1, 1), b3 + hstepB, voffB);
            MK_WAIT_V(6); MK_BAR; MK_MMA(1, 1, At, B1); MK_BAR;
        }
        int fr_ = fr, fq_ = fq; asm volatile("" : "+v"(fr_), "+v"(fq_));
        const bool keep = E(acc, cur, wr, wc, fr_, fq_);
        if (!has_next) break;
        if (!keep) {
#pragma unroll
            for (int a = 0; a < 2; ++a)
#pragma unroll
                for (int b = 0; b < 2; ++b)
#pragma unroll
                    for (int m = 0; m < 4; ++m)
#pragma unroll
                        for (int n = 0; n < 2; ++n) acc[a][b][m][n] = (f32x4){0.f, 0.f, 0.f, 0.f};
        }
        cur = nxt; cA = nA; cB = nB; ++ui;
        if (GATHER) {
#pragma unroll
            for (int h = 0; h < 2; ++h)
#pragma unroll
                for (int i = 0; i < 2; ++i) vA[h][i] = vAn[h][i]; }
    }
    MK_WAIT_V(0);
    if (wr == 0) MK_BAR;
    MK_BAR;
#undef MK_SA
#undef MK_SB
#undef MK_STAGE
#undef MK_LDA
#undef MK_LDB
#undef MK_MMA
#undef MK_WAIT_V
#undef MK_WAIT_L
#undef MK_BAR
#undef MK_SCHED
}

__device__ __forceinline__ u32x4 pack8(const f32x4 a, const f32x4 b) { u32x4 w; w.x = cvt_pk_bf16(a[0], a[1]); w.y = cvt_pk_bf16(a[2], a[3]); w.z = cvt_pk_bf16(b[0], b[1]); w.w = cvt_pk_bf16(b[2], b[3]); return w; }
struct EpiStoreBf16 {
    bf16_t* O; long ldc;
    __device__ __forceinline__ bool operator()(const f32x4 (&acc)[2][2][4][2], const Unit& u, int wr, int wc, int fr, int fq) const {
        MK_FRAG_LOOP(r, c) { *(u32x4*)(O + (size_t)(u.pm * BM + r) * ldc + u.pn * BM + c) = pack8(acc[ai][bj][m][0], acc[ai][bj][m][1]); }
        return false;
    }
};

struct CMapZ1 { __device__ int operator()(int n) const { return n < RC ? n : (n < Z1_LX ? -1 : OFF_LX + (n - Z1_LX)); } };
struct CMapZC { __device__ int operator()(int n) const { return OFF_LG + n; } };
struct CMapId { __device__ int operator()(int n) const { return n; } };
struct CMapGU { int F; __device__ int operator()(int n) const { return (n & 1) * F + (n >> 1); } };
template <class CM>
__device__ __forceinline__ void convT_tile(LAS float* tile  , const float* src, int lds_, int Ks, bf16_t* dst, int Kd, int n0, int k0, const CM& cm) {
    const int tid = threadIdx.x;
    { const int kk = tid >> 3, nn8 = (tid & 7) * 8; const int k = k0 + kk;
#pragma unroll
      for (int j = 0; j < 8; ++j) { const int sc = cm(n0 + nn8 + j); tile[kk * 65 + nn8 + j] = (k < Ks && sc >= 0) ? src[(size_t)k * lds_ + sc] : 0.f; } }
    __syncthreads();
    { const int nn = tid >> 3, kk8 = (tid & 7) * 8; f32x4 a, b;
#pragma unroll
      for (int j = 0; j < 4; ++j) { a[j] = tile[(kk8 + j) * 65 + nn]; b[j] = tile[(kk8 + 4 + j) * 65 + nn]; }
      *(u32x4*)(dst + (size_t)(n0 + nn) * Kd + k0 + kk8) = pack8(a, b); }
    __syncthreads();
}
template <class CM>
__device__ __forceinline__ void convT_job(LAS float* tile, const float* src, int lds_, int Ks, bf16_t* dst, int Kd, int N, const CM& cm, int bid, int nblk, int& base) {
    const int tn = N / 64, tk = Kd / 64, nt = tn * tk;
    int first = (bid - base % nblk + nblk) % nblk;
    for (int t = first; t < nt; t += nblk) convT_tile(tile, src, lds_, Ks, dst, Kd, (t / tk) * 64, (t % tk) * 64, cm);
    base += nt;
}

constexpr int MOD_SL = 16, MOD_KS = D / MOD_SL;
__device__ __forceinline__ void mod_partials(LAS float* sl  , const In& in, float* part  , int bid, int nblk) {
    const int ncc = 6 * D / NT, nitem = MOD_SL * ncc;
    for (int it = bid; it < nitem; it += nblk) {
        const int s = it / ncc, j = (it % ncc) * NT + threadIdx.x;
        for (int i = threadIdx.x; i < (NB + 1) * MOD_KS; i += NT) { const int r = i / MOD_KS, k = s * MOD_KS + i % MOD_KS; const float cv = r < NB ? in.c[r * D + k] : in.c_ctx[k]; sl[i] = siluf_(cv); }
        __syncthreads();
        float acc[NB + 1];
#pragma unroll
        for (int r = 0; r <= NB; ++r) acc[r] = 0.f;
        for (int k = 0; k < MOD_KS; ++k) { const float w = in.w_mod[(size_t)(s * MOD_KS + k) * 6 * D + j];
#pragma unroll
            for (int r = 0; r <= NB; ++r) acc[r] += sl[r * MOD_KS + k] * w; }
#pragma unroll
        for (int r = 0; r <= NB; ++r) part[((size_t)s * (NB + 1) + r) * 6 * D + j] = acc[r];
        __syncthreads();
    }
}
__device__ __forceinline__ float mod_value(const In& in, const float* part, int r, int j) {
    float s = in.b_mod[j];
#pragma unroll
    for (int q = 0; q < MOD_SL; ++q) s += part[((size_t)q * (NB + 1) + r) * 6 * D + j];
    return s;
}

__device__ __forceinline__ void xn_rows(LAS float* sm  , const In& in, const float* part, bf16_t* xn, int b0, int nb, int row_lo, int row_hi) {
    const int nlat = nb * SEQ, wid = threadIdx.x >> 6, lane = threadIdx.x & 63;
    int cur_mr = -1;
    float gp[16];
#pragma unroll
    for (int j = 0; j < 4; ++j)
#pragma unroll
        for (int q = 0; q < 4; ++q) gp[4 * j + q] = in.norm_g[j * 256 + lane * 4 + q];
    for (int rbase = row_lo; rbase < row_hi; rbase += 8) {
        const int mr = rbase < nlat ? b0 + rbase / SEQ : NB;
        if (mr != cur_mr) { __syncthreads(); for (int j = threadIdx.x; j < 2 * D; j += NT) sm[j] = mod_value(in, part, mr, j); __syncthreads(); cur_mr = mr; }
        const int r = rbase + wid; if (r >= row_hi) continue;
        const float* src = r < nlat ? in.x + ((size_t)b0 * SEQ + r) * D : in.ctx + ((size_t)b0 * CTX + (r - nlat)) * D;
        f32x4 v[4]; float ss = 0.f;
#pragma unroll
        for (int j = 0; j < 4; ++j) { v[j] = *(const f32x4*)(src + j * 256 + lane * 4); ss += v[j][0] * v[j][0] + v[j][1] * v[j][1] + v[j][2] * v[j][2] + v[j][3] * v[j][3]; }
#pragma unroll
        for (int o = 32; o > 0; o >>= 1) ss += __shfl_xor(ss, o);
        const float rinv = 1.f / sqrtf(ss * (1.f / D) + NORM_EPS);
#pragma unroll
        for (int j = 0; j < 4; ++j) { const int c = j * 256 + lane * 4; float o[4];
#pragma unroll
            for (int q = 0; q < 4; ++q) o[q] = (v[j][q] * rinv * gp[4 * j + q]) * (1.f + sm[D + c + q]) + sm[c + q];
            u32x2 w; w.x = cvt_pk_bf16(o[0], o[1]); w.y = cvt_pk_bf16(o[2], o[3]); *(u32x2*)(xn + (size_t)r * D + c) = w; }
    }
}
}

namespace mk {
#define XB_TMO      128
#define XB_XCNT(j)  (256  + 64 * (j))
#define XB_XSUB(j)  (1280 + 64 * (j))
#define XB_XGEN(j)  (2304 + 64 * (j))
#define XB_TOP      3328
#define XB_TOPGEN   3392
#define XCD_BAR_WORDS 3456
#define XB_SPIN_CAP (1u << 18)
__device__ __forceinline__ unsigned xb_ld(unsigned* p)              { return __hip_atomic_load(p, __ATOMIC_RELAXED, __HIP_MEMORY_SCOPE_AGENT); }
__device__ __forceinline__ unsigned xb_add(unsigned* p, unsigned v) { return __hip_atomic_fetch_add(p, v, __ATOMIC_RELAXED, __HIP_MEMORY_SCOPE_AGENT); }
__device__ __forceinline__ unsigned xb_xcc_id() { return (unsigned)__builtin_amdgcn_s_getreg((3 << 11) | 20) & 0xFu; }
#define XB_SPIN(cond, bar) do { unsigned _sp = 0; while (cond) { __builtin_amdgcn_s_sleep(1); \
    if ((++_sp & 255u) == 0u) { if (xb_ld(&(bar)[XB_TMO])) break; if (_sp > XB_SPIN_CAP) { atomicAdd(&(bar)[XB_TMO], 1u); break; } } } } while (0)
struct XcdBarrier { unsigned* bar; unsigned x; volatile LAS unsigned* st; };
__device__ __forceinline__ XcdBarrier xcd_barrier_post(unsigned* bar, volatile LAS unsigned* st) {
    XcdBarrier b; b.bar = bar; b.x = xb_xcc_id(); b.st = st;
    if (threadIdx.x == 0) (void)xb_add(&bar[XB_XCNT(b.x)], 1u);
    return b;
}
__device__ __forceinline__ void xcd_barrier_complete(unsigned* bar, unsigned x, unsigned& nloc, unsigned& nx) {
    const unsigned G = gridDim.x * gridDim.y * gridDim.z;
    unsigned sum, cnt, mine, sp = 0u;
    for (;;) {
        sum = 0u; cnt = 0u; mine = 0u;
#pragma unroll
        for (unsigned j = 0; j < 16; ++j) { const unsigned c = xb_ld(&bar[XB_XCNT(j)]); sum += c; cnt += (c > 0u) ? 1u : 0u; mine = (j == x) ? c : mine; }
        if (sum == G) break;
        __builtin_amdgcn_s_sleep(1);
        if ((++sp & 255u) == 0u) { if (xb_ld(&bar[XB_TMO])) break; if (sp > XB_SPIN_CAP) { atomicAdd(&bar[XB_TMO], 1u); break; } }
    }
    nloc = mine > 0u ? mine : 1u; nx = cnt > 0u ? cnt : 1u;
}
__device__ __forceinline__ void xcd_barrier(const XcdBarrier& b) {
    asm volatile("s_waitcnt vmcnt(0)" ::: "memory");
    __syncthreads();
    if (threadIdx.x == 0) {
        unsigned* bar = b.bar;
        __builtin_amdgcn_s_waitcnt(0);
        unsigned nloc = b.st[0], nx = b.st[1];
        if (nloc == 0u) { xcd_barrier_complete(bar, b.x, nloc, nx); b.st[0] = nloc; b.st[1] = nx; }
        const unsigned old = xb_add(&bar[XB_XSUB(b.x)], 1u);
        const unsigned gen = old / nloc;
        if (old + 1u == (gen + 1u) * nloc) {
            __builtin_amdgcn_fence(__ATOMIC_RELEASE, "agent");
            asm volatile("s_waitcnt vmcnt(0)" ::: "memory");
            const unsigned og = xb_add(&bar[XB_TOP], 1u);
            const unsigned tg = og / nx;
            if (og + 1u == (tg + 1u) * nx) xb_add(&bar[XB_TOPGEN], 1u);
            else XB_SPIN(xb_ld(&bar[XB_TOPGEN]) == tg, bar);
            __builtin_amdgcn_fence(__ATOMIC_ACQUIRE, "agent");
            xb_add(&bar[XB_XGEN(b.x)], 1u);
            asm volatile("s_waitcnt vmcnt(0)" ::: "memory");
        } else {
            XB_SPIN(xb_ld(&bar[XB_XGEN(b.x)]) == gen, bar);
            __builtin_amdgcn_fence(__ATOMIC_ACQUIRE, "agent");
            asm volatile("s_waitcnt vmcnt(0)" ::: "memory");
        }
    }
    __syncthreads();
}
}

namespace mk {
constexpr int TB = 32;
constexpr int RAWW = 320;
constexpr int RW_RAW = 0;
constexpr int RW_MU = RW_RAW + (TB + 2) * RAWW * 2;
constexpr int RW_WUP = RW_MU + 2 * RAWW * 4;
constexpr int RW_AUP = RW_WUP + 64 * 72 * 2;
constexpr int RW_CST = RW_AUP + 64 * 72 * 2;
constexpr int RW_AWD = RW_CST + 5 * 64 * 4;
constexpr int RW_AAD = RW_AWD + TB * 72 * 2;
constexpr int RW_R = RW_AAD + TB * 72 * 2;
constexpr int RW_KR = RW_R + TB * 64 * 4;
constexpr int RW_LA = RW_KR + TB * 64 * 4;
constexpr int RW_KK = RW_LA + TB * 64 * 4;
constexpr int RW_W = RW_KK + TB * 64 * 4;
constexpr int RW_B = RW_W + TB * 64 * 4;
constexpr int RW_KD = RW_B + TB * 64 * 4;
constexpr int RW_WR = RW_KD + TB * 64 * 4;
constexpr int RW_V = RW_WR + TB * 64 * 4;
constexpr int RW_SC = RW_V + TB * 64 * 4;
constexpr int RW_YO = RW_SC + TB * 2 * 4;
constexpr int RW_BON = RW_YO + TB * 64 * 4;
constexpr int RW_END = RW_BON + TB * 4;
static_assert(RW_END <= LDS_BYTES, "rwkv LDS");

#define MK_DPP(x, ctrl) __int_as_float(__builtin_amdgcn_update_dpp(__float_as_int(x), __float_as_int(x), ctrl, 0xF, 0xF, false))
__device__ __forceinline__ float allreduce16(float x) {
    x += MK_DPP(x, 0xB1); x += MK_DPP(x, 0x4E); x += MK_DPP(x, 0x141); x += MK_DPP(x, 0x140); return x;
}

__device__ __forceinline__ void allreduce16x4(float& a, float& b, float& c, float& d) {
    asm volatile("s_nop 1\n\t"
        "v_add_f32_dpp %0, %0, %0 quad_perm:[1,0,3,2] row_mask:0xf bank_mask:0xf\n\t" "v_add_f32_dpp %1, %1, %1 quad_perm:[1,0,3,2] row_mask:0xf bank_mask:0xf\n\t"
        "v_add_f32_dpp %2, %2, %2 quad_perm:[1,0,3,2] row_mask:0xf bank_mask:0xf\n\t" "v_add_f32_dpp %3, %3, %3 quad_perm:[1,0,3,2] row_mask:0xf bank_mask:0xf\n\t"
        "v_add_f32_dpp %0, %0, %0 quad_perm:[2,3,0,1] row_mask:0xf bank_mask:0xf\n\t" "v_add_f32_dpp %1, %1, %1 quad_perm:[2,3,0,1] row_mask:0xf bank_mask:0xf\n\t"
        "v_add_f32_dpp %2, %2, %2 quad_perm:[2,3,0,1] row_mask:0xf bank_mask:0xf\n\t" "v_add_f32_dpp %3, %3, %3 quad_perm:[2,3,0,1] row_mask:0xf bank_mask:0xf\n\t"
        "v_add_f32_dpp %0, %0, %0 row_half_mirror row_mask:0xf bank_mask:0xf\n\t" "v_add_f32_dpp %1, %1, %1 row_half_mirror row_mask:0xf bank_mask:0xf\n\t"
        "v_add_f32_dpp %2, %2, %2 row_half_mirror row_mask:0xf bank_mask:0xf\n\t" "v_add_f32_dpp %3, %3, %3 row_half_mirror row_mask:0xf bank_mask:0xf\n\t"
        "v_add_f32_dpp %0, %0, %0 row_mirror row_mask:0xf bank_mask:0xf\n\t" "v_add_f32_dpp %1, %1, %1 row_mirror row_mask:0xf bank_mask:0xf\n\t"
        "v_add_f32_dpp %2, %2, %2 row_mirror row_mask:0xf bank_mask:0xf\n\t" "v_add_f32_dpp %3, %3, %3 row_mirror row_mask:0xf bank_mask:0xf"
        : "+v"(a), "+v"(b), "+v"(c), "+v"(d));
}
struct RwkvP { const bf16_t* z1; bf16_t* Y; float* bon; int b0, nb; };

constexpr int RW_NPIECE = (TB + 2) * 40, RW_PPT = (RW_NPIECE + NT - 1) / NT;

__device__ __forceinline__ void rwkv_chain(LAS unsigned char* lds, const In& in, const RwkvP p, int chain) {
    const int tid = threadIdx.x, lane = tid & 63, wid = tid >> 6;
    const int d = chain / (p.nb * NH), bl = (chain / NH) % p.nb, h = chain % NH;
    const int nlat = p.nb * SEQ;
    LAS bf16_t* RAW = (LAS bf16_t*)(lds + RW_RAW); LAS float* MU = (LAS float*)(lds + RW_MU);
    LAS bf16_t* WUP = (LAS bf16_t*)(lds + RW_WUP); LAS bf16_t* AUP = (LAS bf16_t*)(lds + RW_AUP); LAS float* CST = (LAS float*)(lds + RW_CST);
    LAS bf16_t* AWD = (LAS bf16_t*)(lds + RW_AWD); LAS bf16_t* AAD = (LAS bf16_t*)(lds + RW_AAD);
    LAS float *Rr = (LAS float*)(lds + RW_R), *KR = (LAS float*)(lds + RW_KR), *LA_ = (LAS float*)(lds + RW_LA);
    LAS float *KK = (LAS float*)(lds + RW_KK), *Wv = (LAS float*)(lds + RW_W), *Bv = (LAS float*)(lds + RW_B), *KD = (LAS float*)(lds + RW_KD), *WR = (LAS float*)(lds + RW_WR), *Vv = (LAS float*)(lds + RW_V);
    LAS float *SC = (LAS float*)(lds + RW_SC), *YO = (LAS float*)(lds + RW_YO), *BON = (LAS float*)(lds + RW_BON);
    auto segcol = [&](int s) { return s < 3 ? s * RW + h * 64 : (s == 3 ? OFF_WD + d * DL : OFF_AD + d * AL); };
    for (int i = tid; i < 2 * RAWW; i += NT) { const int m = i / RAWW, c = i % RAWW; MU[i] = in.shift_mu[m * RC + segcol(c >> 6) + (c & 63)]; }
    for (int i = tid; i < 64 * 64; i += NT) { const int j = i >> 6, c = i & 63;
        WUP[c * 72 + j] = f2bf(in.rw_w_up[((size_t)d * DL + j) * RW + h * 64 + c]); AUP[c * 72 + j] = f2bf(in.rw_a_up[((size_t)d * AL + j) * RW + h * 64 + c]); }
    for (int i = tid; i < 64; i += NT) { CST[i] = in.rw_w0[d * RW + h * 64 + i]; CST[64 + i] = in.rw_a0[d * RW + h * 64 + i]; CST[128 + i] = in.rw_k_k[h * 64 + i]; CST[192 + i] = in.rw_k_a[h * 64 + i]; CST[256 + i] = in.rw_r_k[h * 64 + i]; }
    constexpr int NQ = (CTX + SEQ) / TB, NQC = CTX / TB;
    auto blk_info = [&](int q, bool& isctx, int& t0, bool& hp, bool& hn, size_t& grow0) {
        isctx = q < NQC;
        if (isctx) { const int qq = d == 0 ? q : NQC - 1 - q; t0 = qq * TB; hp = t0 > 0; hn = t0 + TB < CTX; grow0 = (size_t)nlat + (size_t)bl * CTX + t0; }
        else { const int ql = q - NQC, qq = d == 0 ? ql : SEQ / TB - 1 - ql; t0 = qq * TB; hp = (t0 % GW) != 0; hn = ((t0 + TB) % GW) != 0; grow0 = (size_t)bl * SEQ + t0; }
    };
    u32x4 pre[RW_PPT];
    auto prefetch = [&](int q) {
        bool isctx, hp, hn; int t0; size_t grow0; blk_info(q, isctx, t0, hp, hn, grow0);
#pragma unroll
        for (int k = 0; k < RW_PPT; ++k) { const int i = tid + k * NT; u32x4 v = (u32x4){0u, 0u, 0u, 0u};
            if (i < RW_NPIECE) { const int rr = i / 40, sp = i % 40, seg = sp >> 3, part = sp & 7;
                const bool ok = (rr == 0) ? hp : ((rr == TB + 1) ? hn : true);
                if (ok) v = *(const u32x4*)(p.z1 + (grow0 + rr - 1) * Z1_N + segcol(seg) + part * 8); }
            pre[k] = v; }
    };
    auto commit = [&]() {
#pragma unroll
        for (int k = 0; k < RW_PPT; ++k) { const int i = tid + k * NT; if (i < RW_NPIECE) { const int rr = i / 40, sp = i % 40; *(LAS u32x4*)(RAW + rr * RAWW + sp * 8) = pre[k]; } }
    };
    float S[2][4];
#pragma unroll
    for (int i = 0; i < 2; ++i)
#pragma unroll
        for (int j = 0; j < 4; ++j) S[i][j] = 0.f;
    const int kg = lane & 15, rp = (lane >> 4) + 4 * wid;
    prefetch(0);
    for (int q = 0; q < NQ; ++q) {
        bool isctx, hp, hn; int t0; size_t grow0; blk_info(q, isctx, t0, hp, hn, grow0);
        commit();
        __syncthreads();
        if (q + 1 < NQ) prefetch(q + 1);
        auto shift8 = [&](int t, int c0, float (&s)[8]) {
            const u32x4 xp = *(const LAS u32x4*)(RAW + t * RAWW + c0), xc = *(const LAS u32x4*)(RAW + (t + 1) * RAWW + c0), xn_ = *(const LAS u32x4*)(RAW + (t + 2) * RAWW + c0);
            const f32x4 m0a = *(const LAS f32x4*)(MU + c0), m0b = *(const LAS f32x4*)(MU + c0 + 4), m1a = *(const LAS f32x4*)(MU + RAWW + c0), m1b = *(const LAS f32x4*)(MU + RAWW + c0 + 4);
#pragma unroll
            for (int j = 0; j < 4; ++j) { const unsigned a = xp[j], b = xc[j], c = xn_[j];
                const float mu0l = j < 2 ? m0a[2 * j] : m0b[2 * j - 4], mu0h = j < 2 ? m0a[2 * j + 1] : m0b[2 * j - 3], mu1l = j < 2 ? m1a[2 * j] : m1b[2 * j - 4], mu1h = j < 2 ? m1a[2 * j + 1] : m1b[2 * j - 3];
                { const float x = bflo(b); s[2 * j] = x + mu0l * (bflo(a) - x) + mu1l * (bflo(c) - x); }
                { const float x = bfhi(b); s[2 * j + 1] = x + mu0h * (bfhi(a) - x) + mu1h * (bfhi(c) - x); } } };
        for (int it = tid; it < TB * 24; it += NT) {
            const int t = it / 24, g = it % 24, seg = g >> 3, cc = (g & 7) * 8; float s[8]; shift8(t, g * 8, s);
            LAS float* dst = (seg == 0 ? Rr : (seg == 1 ? KR : Vv)) + t * 64 + cc; *(LAS f32x4*)dst = (f32x4){s[0], s[1], s[2], s[3]}; *(LAS f32x4*)(dst + 4) = (f32x4){s[4], s[5], s[6], s[7]};
        }
        { const int t = tid >> 4, g = 24 + (tid & 15), cc = (g & 7) * 8; float s[8]; shift8(t, g * 8, s);
          const bool isw = (tid & 15) < 8;
#pragma unroll
          for (int j = 0; j < 8; ++j) { const float th = fast_tanh(s[j]); s[j] = isw ? th : s[j]; }
          LAS bf16_t* dst = (isw ? AWD : AAD) + t * 72 + cc;
          u32x4 w; w.x = cvt_pk_bf16(s[0], s[1]); w.y = cvt_pk_bf16(s[2], s[3]); w.z = cvt_pk_bf16(s[4], s[5]); w.w = cvt_pk_bf16(s[6], s[7]); *(LAS u32x4*)dst = w; }
        __syncthreads();
        {
            const int lora = wid >> 2, ct = wid & 3, fr = lane & 15, fq = lane >> 4;
            const LAS bf16_t* Am = lora ? AAD : AWD; const LAS bf16_t* Bm = lora ? AUP : WUP;
#pragma unroll
            for (int rt = 0; rt < 2; ++rt) {
                f32x4 acc = (f32x4){0.f, 0.f, 0.f, 0.f};
#pragma unroll
                for (int ks = 0; ks < 2; ++ks) {
                    const bf16x8 a = *(const LAS bf16x8*)(Am + (rt * 16 + fr) * 72 + ks * 32 + fq * 8);
                    const bf16x8 b = *(const LAS bf16x8*)(Bm + (ct * 16 + fr) * 72 + ks * 32 + fq * 8);
                    acc = __builtin_amdgcn_mfma_f32_16x16x32_bf16(a, b, acc, 0, 0, 0);
                }
                const int col = ct * 16 + fr;
#pragma unroll
                for (int i = 0; i < 4; ++i) { const int t = rt * 16 + fq * 4 + i;
                    if (lora == 0) { const float lw = acc[i] + CST[col]; const float wl = -fast_softplus(-lw) - 0.5f; Wv[t * 64 + col] = __expf(-__expf(wl)); }
                    else { LA_[t * 64 + col] = fast_sigmoid(acc[i] + CST[64 + col]); } }
            }
        }
        __syncthreads();
        {
            const int t = tid >> 4, c4 = (tid & 15) * 4;
            const f32x4 k = *(const LAS f32x4*)(KR + t * 64 + c4), a = *(const LAS f32x4*)(LA_ + t * 64 + c4), w = *(const LAS f32x4*)(Wv + t * 64 + c4), r = *(const LAS f32x4*)(Rr + t * 64 + c4);
            f32x4 kkr, kd, bb, wr; float ss = 0.f, br = 0.f, kr = 0.f, bn = 0.f;
#pragma unroll
            for (int j = 0; j < 4; ++j) { kkr[j] = k[j] * CST[128 + c4 + j]; ss += kkr[j] * kkr[j]; }
            ss = allreduce16(ss);
            const float inv = 1.f / fmaxf(sqrtf(ss), 1e-12f);
#pragma unroll
            for (int j = 0; j < 4; ++j) { const float kk = kkr[j] * inv; kkr[j] = kk; kd[j] = k[j] * (1.f + (a[j] - 1.f) * CST[192 + c4 + j]); bb[j] = kk * a[j]; wr[j] = w[j] * r[j];
                br += bb[j] * r[j]; kr += kd[j] * r[j]; bn += r[j] * kd[j] * CST[256 + c4 + j]; }
            br = allreduce16(br); kr = allreduce16(kr); bn = allreduce16(bn);
            *(LAS f32x4*)(KK + t * 64 + c4) = kkr; *(LAS f32x4*)(KD + t * 64 + c4) = kd; *(LAS f32x4*)(Bv + t * 64 + c4) = bb; *(LAS f32x4*)(WR + t * 64 + c4) = wr;
            if ((tid & 15) == 0) { SC[t * 2] = br; SC[t * 2 + 1] = kr; BON[t] = bn; }
        }
        __syncthreads();
        {
            auto tof = [&](int st) { return d == 0 ? st : TB - 1 - st; };
            const LAS float* lb = KK + 4 * kg;
            const LAS float* vb = Vv + 2 * rp;
            constexpr int OW = (RW_W - RW_KK) / 4, OB = (RW_B - RW_KK) / 4, OKD = (RW_KD - RW_KK) / 4, OWR = (RW_WR - RW_KK) / 4;
            int t = tof(0);
            f32x4 kk4 = *(const LAS f32x4*)(lb + t * 64), w4 = *(const LAS f32x4*)(lb + t * 64 + OW), b4 = *(const LAS f32x4*)(lb + t * 64 + OB),
                  kd4 = *(const LAS f32x4*)(lb + t * 64 + OKD), wr4 = *(const LAS f32x4*)(lb + t * 64 + OWR);
            f32x2 vv = *(const LAS f32x2*)(vb + t * 64), sc = *(const LAS f32x2*)(SC + t * 2);
            f32x2 S2[4];
#pragma unroll
            for (int j = 0; j < 4; ++j) { S2[j][0] = S[0][j]; S2[j][1] = S[1][j]; }
#pragma unroll 2
            for (int st = 0; st < TB; ++st) {
                const int tn = tof(st + 1 < TB ? st + 1 : st);
                const f32x4 nkk4 = *(const LAS f32x4*)(lb + tn * 64), nw4 = *(const LAS f32x4*)(lb + tn * 64 + OW), nb4 = *(const LAS f32x4*)(lb + tn * 64 + OB),
                            nkd4 = *(const LAS f32x4*)(lb + tn * 64 + OKD), nwr4 = *(const LAS f32x4*)(lb + tn * 64 + OWR);
                const f32x2 nvv = *(const LAS f32x2*)(vb + tn * 64), nsc = *(const LAS f32x2*)(SC + tn * 2);
                f32x2 sa2 = S2[0] * kk4[0], yo2 = S2[0] * wr4[0];
#pragma unroll
                for (int j = 1; j < 4; ++j) { sa2 += S2[j] * kk4[j]; yo2 += S2[j] * wr4[j]; }
                float sa0 = sa2[0], sa1 = sa2[1], yo0 = yo2[0], yo1 = yo2[1];
                allreduce16x4(sa0, sa1, yo0, yo1);
                f32x2 sar; sar[0] = sa0; sar[1] = sa1;
#pragma unroll
                for (int j = 0; j < 4; ++j) S2[j] = S2[j] * w4[j] + (vv * kd4[j] - sar * b4[j]);
                if (kg == 0) { f32x2 yor; yor[0] = yo0; yor[1] = yo1; const f32x2 y = yor - sar * sc[0] + vv * sc[1]; *(LAS f32x2*)(YO + t * 64 + 2 * rp) = y; }
                kk4 = nkk4; w4 = nw4; b4 = nb4; kd4 = nkd4; wr4 = nwr4; vv = nvv; sc = nsc; t = tn;
            }
#pragma unroll
            for (int j = 0; j < 4; ++j) { S[0][j] = S2[j][0]; S[1][j] = S2[j][1]; }
        }
        __syncthreads();
        if (!isctx) {
            const int t = tid >> 4, c4 = (tid & 15) * 4; const f32x4 y = *(const LAS f32x4*)(YO + t * 64 + c4);
            u32x2 w; w.x = cvt_pk_bf16(y[0], y[1]); w.y = cvt_pk_bf16(y[2], y[3]);
            *(u32x2*)(p.Y + ((size_t)d * nlat + grow0 + t) * RW + h * 64 + c4) = w;
            if (tid < TB) p.bon[((size_t)d * nlat + grow0 + tid) * NH + h] = BON[tid];
        }
    }
}
__device__ __forceinline__ void rwkv_phase(LAS unsigned char* lds, const In& in, const RwkvP p, int bid, int nblk) {
    const int nchain = 2 * p.nb * NH;
    for (int c = bid; c < nchain; c += nblk) { rwkv_chain(lds, in, p, c); __syncthreads(); }
}
}

namespace mk {
constexpr int C2_RAW = 0;
constexpr int C2_MU = C2_RAW + (TB + 2) * RAWW * 2;
constexpr int C2_WUP = C2_MU + 2 * RAWW * 4;
constexpr int C2_AUP = C2_WUP + 64 * 72 * 2;
constexpr int C2_CST = C2_AUP + 64 * 72 * 2;
constexpr int C2_AWD = C2_CST + 5 * 64 * 4;
constexpr int C2_AAD = C2_AWD + TB * 72 * 2;
constexpr int C2_X = C2_AAD + TB * 72 * 2;
constexpr int C2_R = C2_X, C2_KR = C2_R + TB * 64 * 4, C2_V = C2_KR + TB * 64 * 4, C2_E = C2_V + TB * 64 * 4, C2_LA = C2_E + TB * 64 * 4, C2_CUM = C2_LA + TB * 64 * 4, C2_X_END = C2_CUM + TB * 64 * 4;
constexpr int C2_YO = C2_X;
constexpr int C2_G = C2_YO + TB * 64 * 4;
constexpr int C2_UB = C2_G + 64 * 36 * 4;
constexpr int C2_ABT = C2_UB + 64 * 40 * 2;
constexpr int C2_AKT = C2_ABT + 32 * 32 * 4;
constexpr int C2_NBT = C2_AKT + 32 * 40 * 2;
constexpr int C2_NKT = C2_NBT + 32 * 40 * 2;
static_assert(C2_NKT + 32 * 40 * 2 <= C2_X_END, "region X reuse");
constexpr int C2_KKS = C2_X_END;
constexpr int C2_BS = C2_KKS + TB * 72 * 2, C2_KDS = C2_BS + TB * 72 * 2, C2_RS = C2_KDS + TB * 72 * 2;
constexpr int C2_BST = C2_RS + TB * 72 * 2;
constexpr int C2_KDST = C2_BST + 64 * 40 * 2;
constexpr int C2_VT = C2_KDST + 64 * 40 * 2;
constexpr int C2_S0B = C2_VT + 64 * 40 * 2;
constexpr int C2_GC = C2_S0B + 64 * 72 * 2;
constexpr int C2_BON = C2_GC + 64 * 4;
constexpr int C2_END = C2_BON + TB * 4;
static_assert(C2_END <= LDS_BYTES - 16 && (C2_X % 16) == 0 && (C2_KKS % 16) == 0 && (C2_G % 16) == 0 && (C2_UB % 16) == 0 && (C2_ABT % 16) == 0 && (C2_AKT % 16) == 0 && (C2_S0B % 16) == 0, "rwkv2 LDS");

__device__ __forceinline__ bf16x8 ldsb8(const LAS bf16_t* p) { return *(const LAS bf16x8*)p; }

template <int MODE>
__device__ __forceinline__ void rwkv_chain2(LAS unsigned char* lds, const In& in, const RwkvP p, int chain) {
    const int tid = threadIdx.x, lane = tid & 63, wid = tid >> 6, fr = lane & 15, fq = lane >> 4;
    const int d = chain / (p.nb * NH), bl = (chain / NH) % p.nb, h = chain % NH;
    const int nlat = p.nb * SEQ;
    LAS bf16_t* RAW = (LAS bf16_t*)(lds + C2_RAW); LAS float* MU = (LAS float*)(lds + C2_MU);
    LAS bf16_t* WUP = (LAS bf16_t*)(lds + C2_WUP); LAS bf16_t* AUP = (LAS bf16_t*)(lds + C2_AUP); LAS float* CST = (LAS float*)(lds + C2_CST);
    LAS bf16_t* AWD = (LAS bf16_t*)(lds + C2_AWD); LAS bf16_t* AAD = (LAS bf16_t*)(lds + C2_AAD);
    LAS float *Rr = (LAS float*)(lds + C2_R), *KR = (LAS float*)(lds + C2_KR), *Vv = (LAS float*)(lds + C2_V), *Ee = (LAS float*)(lds + C2_E), *LA_ = (LAS float*)(lds + C2_LA), *CUM = (LAS float*)(lds + C2_CUM);
    LAS float *YO = (LAS float*)(lds + C2_YO), *Gm = (LAS float*)(lds + C2_G), *ABT = (LAS float*)(lds + C2_ABT), *GC = (LAS float*)(lds + C2_GC), *BON = (LAS float*)(lds + C2_BON);
    LAS bf16_t *UB = (LAS bf16_t*)(lds + C2_UB), *AKT = (LAS bf16_t*)(lds + C2_AKT), *NBT = (LAS bf16_t*)(lds + C2_NBT), *NKT = (LAS bf16_t*)(lds + C2_NKT);
    LAS bf16_t *KKS = (LAS bf16_t*)(lds + C2_KKS), *BS = (LAS bf16_t*)(lds + C2_BS), *KDS = (LAS bf16_t*)(lds + C2_KDS), *RS = (LAS bf16_t*)(lds + C2_RS);
    LAS bf16_t *BST = (LAS bf16_t*)(lds + C2_BST), *KDST = (LAS bf16_t*)(lds + C2_KDST), *VT = (LAS bf16_t*)(lds + C2_VT), *S0B = (LAS bf16_t*)(lds + C2_S0B);
    auto segcol = [&](int s) { return s < 3 ? s * RW + h * 64 : (s == 3 ? OFF_WD + d * DL : OFF_AD + d * AL); };
    for (int i = tid; i < 2 * RAWW; i += NT) { const int m = i / RAWW, c = i % RAWW; MU[i] = in.shift_mu[m * RC + segcol(c >> 6) + (c & 63)]; }
    for (int i = tid; i < 64 * 64; i += NT) { const int j = i >> 6, c = i & 63;
        WUP[c * 72 + j] = f2bf(in.rw_w_up[((size_t)d * DL + j) * RW + h * 64 + c]); AUP[c * 72 + j] = f2bf(in.rw_a_up[((size_t)d * AL + j) * RW + h * 64 + c]); }
    for (int i = tid; i < 64; i += NT) { CST[i] = in.rw_w0[d * RW + h * 64 + i]; CST[64 + i] = in.rw_a0[d * RW + h * 64 + i]; CST[128 + i] = in.rw_k_k[h * 64 + i]; CST[192 + i] = in.rw_k_a[h * 64 + i]; CST[256 + i] = in.rw_r_k[h * 64 + i]; }
    for (int i = tid; i < 64 * 72 / 2; i += NT) ((LAS unsigned*)S0B)[i] = 0u;
    constexpr int NQ = (CTX + SEQ) / TB, NQC = CTX / TB;
    auto blk_info = [&](int q, bool& isctx, int& t0, bool& hp, bool& hn, size_t& grow0) {
        isctx = q < NQC;
        if (isctx) { const int qq = d == 0 ? q : NQC - 1 - q; t0 = qq * TB; hp = t0 > 0; hn = t0 + TB < CTX; grow0 = (size_t)nlat + (size_t)bl * CTX + t0; }
        else { const int ql = q - NQC, qq = d == 0 ? ql : SEQ / TB - 1 - ql; t0 = qq * TB; hp = (t0 % GW) != 0; hn = ((t0 + TB) % GW) != 0; grow0 = (size_t)bl * SEQ + t0; }
    };
    u32x4 pre[RW_PPT];
    auto prefetch = [&](int q) {
        bool isctx, hp, hn; int t0; size_t grow0; blk_info(q, isctx, t0, hp, hn, grow0);
#pragma unroll
        for (int k = 0; k < RW_PPT; ++k) { const int i = tid + k * NT; u32x4 v = (u32x4){0u, 0u, 0u, 0u};
            if (i < RW_NPIECE) { const int rr = i / 40, sp = i % 40, seg = sp >> 3, part = sp & 7;
                const bool ok = (rr == 0) ? hp : ((rr == TB + 1) ? hn : true);
                if (ok) v = *(const u32x4*)(p.z1 + (grow0 + rr - 1) * Z1_N + segcol(seg) + part * 8); }
            pre[k] = v; }
    };
    auto commit = [&]() {
#pragma unroll
        for (int k = 0; k < RW_PPT; ++k) { const int i = tid + k * NT; if (i < RW_NPIECE) { const int rr = i / 40, sp = i % 40; *(LAS u32x4*)(RAW + rr * RAWW + sp * 8) = pre[k]; } }
    };
    f32x4 Sreg[2];
    Sreg[0] = (f32x4){0.f, 0.f, 0.f, 0.f}; Sreg[1] = Sreg[0];
    const int rt = wid >> 1;
    prefetch(0);
    for (int q = 0; q < NQ; ++q) {
        bool isctx, hp, hn; int t0; size_t grow0; blk_info(q, isctx, t0, hp, hn, grow0);
        commit();
        __syncthreads();
        if (q + 1 < NQ) prefetch(q + 1);
        auto shift8 = [&](int t, int c0, float (&s)[8]) {
            const u32x4 xp = *(const LAS u32x4*)(RAW + t * RAWW + c0), xc = *(const LAS u32x4*)(RAW + (t + 1) * RAWW + c0), xn_ = *(const LAS u32x4*)(RAW + (t + 2) * RAWW + c0);
            const f32x4 m0a = *(const LAS f32x4*)(MU + c0), m0b = *(const LAS f32x4*)(MU + c0 + 4), m1a = *(const LAS f32x4*)(MU + RAWW + c0), m1b = *(const LAS f32x4*)(MU + RAWW + c0 + 4);
#pragma unroll
            for (int j = 0; j < 4; ++j) { const unsigned a = xp[j], b = xc[j], c = xn_[j];
                const float mu0l = j < 2 ? m0a[2 * j] : m0b[2 * j - 4], mu0h = j < 2 ? m0a[2 * j + 1] : m0b[2 * j - 3], mu1l = j < 2 ? m1a[2 * j] : m1b[2 * j - 4], mu1h = j < 2 ? m1a[2 * j + 1] : m1b[2 * j - 3];
                { const float x = bflo(b); s[2 * j] = x + mu0l * (bflo(a) - x) + mu1l * (bflo(c) - x); }
                { const float x = bfhi(b); s[2 * j + 1] = x + mu0h * (bfhi(a) - x) + mu1h * (bfhi(c) - x); } } };
        for (int it = tid; it < TB * 24; it += NT) {
            const int t = it / 24, g = it % 24, seg = g >> 3, cc = (g & 7) * 8, js = d == 0 ? t : TB - 1 - t; float s[8]; shift8(t, g * 8, s);
            LAS float* dst = (seg == 0 ? Rr : (seg == 1 ? KR : Vv)) + js * 64 + cc; *(LAS f32x4*)dst = (f32x4){s[0], s[1], s[2], s[3]}; *(LAS f32x4*)(dst + 4) = (f32x4){s[4], s[5], s[6], s[7]};
        }
        { const int t = tid >> 4, g = 24 + (tid & 15), cc = (g & 7) * 8, js = d == 0 ? t : TB - 1 - t; float s[8]; shift8(t, g * 8, s);
          const bool isw = (tid & 15) < 8;
#pragma unroll
          for (int j = 0; j < 8; ++j) { const float th = fast_tanh(s[j]); s[j] = isw ? th : s[j]; }
          LAS bf16_t* dst = (isw ? AWD : AAD) + js * 72 + cc;
          u32x4 w; w.x = cvt_pk_bf16(s[0], s[1]); w.y = cvt_pk_bf16(s[2], s[3]); w.z = cvt_pk_bf16(s[4], s[5]); w.w = cvt_pk_bf16(s[6], s[7]); *(LAS u32x4*)dst = w; }
        __syncthreads();
        if (MODE == 3) continue;
        {
            const int lora = wid >> 2, ct = wid & 3;
            const LAS bf16_t* Am = lora ? AAD : AWD; const LAS bf16_t* Bm = lora ? AUP : WUP;
            float carry = 0.f;
#pragma unroll
            for (int r2 = 0; r2 < 2; ++r2) {
                f32x4 acc = (f32x4){0.f, 0.f, 0.f, 0.f};
#pragma unroll
                for (int ks = 0; ks < 2; ++ks) acc = __builtin_amdgcn_mfma_f32_16x16x32_bf16(ldsb8(Am + (r2 * 16 + fr) * 72 + ks * 32 + fq * 8), ldsb8(Bm + (ct * 16 + fr) * 72 + ks * 32 + fq * 8), acc, 0, 0, 0);
                const int col = ct * 16 + fr;
                if (lora == 0) {
                    float c[4];
#pragma unroll
                    for (int i = 0; i < 4; ++i) { const float lw = acc[i] + CST[col]; const float e = __expf(-fast_softplus(-lw) - 0.5f); c[i] = i ? c[i - 1] + e : e; }
                    const float tot = c[3];
                    float s1 = tot; { const float y = __shfl_up(s1, 16); s1 += fq >= 1 ? y : 0.f; }
                    float s2 = s1;  { const float z = __shfl_up(s1, 32); s2 += fq >= 2 ? z : 0.f; }
                    const float base = carry + s2 - tot;
#pragma unroll
                    for (int i = 0; i < 4; ++i) CUM[(r2 * 16 + fq * 4 + i) * 64 + col] = base + c[i];
                    carry += __shfl(s2, 48 + fr);
                } else {
#pragma unroll
                    for (int i = 0; i < 4; ++i) LA_[(r2 * 16 + fq * 4 + i) * 64 + col] = fast_sigmoid(acc[i] + CST[64 + col]);
                }
            }
        }
        __syncthreads();
        if (MODE == 2) continue;
        {
            const int j = tid >> 4, c4 = (tid & 15) * 4;
            const f32x4 k = *(const LAS f32x4*)(KR + j * 64 + c4), a = *(const LAS f32x4*)(LA_ + j * 64 + c4), r = *(const LAS f32x4*)(Rr + j * 64 + c4), vv = *(const LAS f32x4*)(Vv + j * 64 + c4);
            const f32x4 cu = *(const LAS f32x4*)(CUM + j * 64 + c4); f32x4 cp = (f32x4){0.f, 0.f, 0.f, 0.f}; if (j > 0) cp = *(const LAS f32x4*)(CUM + (j - 1) * 64 + c4);
            float kkr[4], ss = 0.f, bn = 0.f;
#pragma unroll
            for (int x = 0; x < 4; ++x) { kkr[x] = k[x] * CST[128 + c4 + x]; ss += kkr[x] * kkr[x]; }
            ss = allreduce16(ss);
            const float inv = 1.f / fmaxf(sqrtf(ss), 1e-12f);
            float kks[4], bs[4], kds[4], rs[4];
#pragma unroll
            for (int x = 0; x < 4; ++x) { const float kk = kkr[x] * inv, kd = k[x] * (1.f + (a[x] - 1.f) * CST[192 + c4 + x]), bb = kk * a[x];
                const float g = __expf(-cu[x]), gp = __expf(-cp[x]), ig = __expf(cu[x]);
                kks[x] = kk * gp; bs[x] = bb * ig; kds[x] = kd * ig; rs[x] = r[x] * g; bn += r[x] * kd * CST[256 + c4 + x];
                if (j == TB - 1) GC[c4 + x] = g;
                BST[(c4 + x) * 40 + j] = f2bf(bs[x]); KDST[(c4 + x) * 40 + j] = f2bf(kds[x]); VT[(c4 + x) * 40 + j] = f2bf(vv[x]); }
            bn = allreduce16(bn);
            u32x2 w; w.x = cvt_pk_bf16(kks[0], kks[1]); w.y = cvt_pk_bf16(kks[2], kks[3]); *(LAS u32x2*)(KKS + j * 72 + c4) = w;
            w.x = cvt_pk_bf16(bs[0], bs[1]); w.y = cvt_pk_bf16(bs[2], bs[3]); *(LAS u32x2*)(BS + j * 72 + c4) = w;
            w.x = cvt_pk_bf16(kds[0], kds[1]); w.y = cvt_pk_bf16(kds[2], kds[3]); *(LAS u32x2*)(KDS + j * 72 + c4) = w;
            w.x = cvt_pk_bf16(rs[0], rs[1]); w.y = cvt_pk_bf16(rs[2], rs[3]); *(LAS u32x2*)(RS + j * 72 + c4) = w;
            if ((tid & 15) == 0) BON[j] = bn;
        }
        __syncthreads();
        if (MODE == 1) continue;
        const int ctg = wid & 1;
        f32x4 accG = (f32x4){0.f, 0.f, 0.f, 0.f}, accY = accG;
        {
            const int pr = wid >> 1, rts = wid & 1;
            const LAS bf16_t* Xm = (pr & 1) ? KDS : BS; const LAS bf16_t* Ym = (pr < 2) ? KKS : RS;
            const bf16x8 a0 = ldsb8(Xm + (rts * 16 + fr) * 72 + fq * 8), a1 = ldsb8(Xm + (rts * 16 + fr) * 72 + 32 + fq * 8);
#pragma unroll
            for (int cts = 0; cts < 2; ++cts) {
                f32x4 acc = (f32x4){0.f, 0.f, 0.f, 0.f};
                acc = __builtin_amdgcn_mfma_f32_16x16x32_bf16(a0, ldsb8(Ym + (cts * 16 + fr) * 72 + fq * 8), acc, 0, 0, 0);
                acc = __builtin_amdgcn_mfma_f32_16x16x32_bf16(a1, ldsb8(Ym + (cts * 16 + fr) * 72 + 32 + fq * 8), acc, 0, 0, 0);
                const int t = cts * 16 + fr, s0 = rts * 16 + fq * 4;
#pragma unroll
                for (int i = 0; i < 4; ++i) { const bool keep = (pr < 2) ? (s0 + i < t) : (s0 + i <= t); acc[i] = keep ? acc[i] : 0.f; }
                if (pr == 0) *(LAS f32x4*)(ABT + t * 32 + s0) = acc;
                else { u32x2 w; w.x = cvt_pk_bf16(acc[0], acc[1]); w.y = cvt_pk_bf16(acc[2], acc[3]); *(LAS u32x2*)((pr == 1 ? AKT : (pr == 2 ? NBT : NKT)) + t * 40 + s0) = w; }
            }
#pragma unroll
            for (int ks = 0; ks < 2; ++ks) { const bf16x8 sa = ldsb8(S0B + (rt * 16 + fr) * 72 + ks * 32 + fq * 8);
                accG = __builtin_amdgcn_mfma_f32_16x16x32_bf16(sa, ldsb8(KKS + (ctg * 16 + fr) * 72 + ks * 32 + fq * 8), accG, 0, 0, 0);
                accY = __builtin_amdgcn_mfma_f32_16x16x32_bf16(sa, ldsb8(RS + (ctg * 16 + fr) * 72 + ks * 32 + fq * 8), accY, 0, 0, 0); }
        }
        __syncthreads();
        {
            const bf16x8 va = ldsb8(VT + (rt * 16 + fr) * 40 + fq * 8);
            accG = __builtin_amdgcn_mfma_f32_16x16x32_bf16(va, ldsb8(AKT + (ctg * 16 + fr) * 40 + fq * 8), accG, 0, 0, 0);
            accY = __builtin_amdgcn_mfma_f32_16x16x32_bf16(va, ldsb8(NKT + (ctg * 16 + fr) * 40 + fq * 8), accY, 0, 0, 0);
#pragma unroll
            for (int i = 0; i < 4; ++i) Gm[(rt * 16 + fq * 4 + i) * 36 + ctg * 16 + fr] = -accG[i];
        }
        __syncthreads();
        if (MODE == 4) continue;
        if (wid < 4) {
            const int v = wid * 16 + (lane >> 2), pq = lane & 3;
            const LAS float* grow = Gm + v * 36;
            f32x4 r0 = *(const LAS f32x4*)(grow + 4 * pq), r1 = *(const LAS f32x4*)(grow + 16 + 4 * pq);
#pragma unroll
            for (int g = 0; g < TB / 4; ++g) {
                const LAS float* ab = ABT + (4 * g) * 32;
                const f32x4 d1 = *(const LAS f32x4*)(ab + 1 * 32 + 4 * g), d2 = *(const LAS f32x4*)(ab + 2 * 32 + 4 * g), d3 = *(const LAS f32x4*)(ab + 3 * 32 + 4 * g);
                const f32x4 rr = g < 4 ? r0 : r1;
                f32x4 u4;
                u4[0] = rr[0];
                u4[1] = rr[1] - u4[0] * d1[0];
                u4[2] = rr[2] - (u4[0] * d2[0] + u4[1] * d2[1]);
                u4[3] = rr[3] - (u4[0] * d3[0] + u4[1] * d3[1] + u4[2] * d3[2]);
#pragma unroll
                for (int x = 0; x < 4; ++x) { const int ui = __float_as_int(u4[x]); int bi;
                    if ((g & 3) == 0) bi = __builtin_amdgcn_update_dpp(0, ui, 0x00, 0xF, 0xF, true); else if ((g & 3) == 1) bi = __builtin_amdgcn_update_dpp(0, ui, 0x55, 0xF, 0xF, true);
                    else if ((g & 3) == 2) bi = __builtin_amdgcn_update_dpp(0, ui, 0xAA, 0xF, 0xF, true); else bi = __builtin_amdgcn_update_dpp(0, ui, 0xFF, 0xF, 0xF, true);
                    u4[x] = __int_as_float(bi); }
                if (pq == 0) { u32x2 w; w.x = cvt_pk_bf16(u4[0], u4[1]); w.y = cvt_pk_bf16(u4[2], u4[3]); *(LAS u32x2*)(UB + v * 40 + 4 * g) = w; }
                if (g < 3) {
#pragma unroll
                    for (int jj = 0; jj < 4; ++jj) { const f32x4 a0 = *(const LAS f32x4*)(ABT + (4 * pq + jj) * 32 + 4 * g); r0[jj] -= u4[0] * a0[0] + u4[1] * a0[1] + u4[2] * a0[2] + u4[3] * a0[3]; } }
                if (g < 7) {
#pragma unroll
                    for (int jj = 0; jj < 4; ++jj) { const f32x4 a1 = *(const LAS f32x4*)(ABT + (16 + 4 * pq + jj) * 32 + 4 * g); r1[jj] -= u4[0] * a1[0] + u4[1] * a1[1] + u4[2] * a1[2] + u4[3] * a1[3]; } }
            }
        }
        __syncthreads();
        if (MODE == 5) continue;
        {
            const bf16x8 ua = ldsb8(UB + (rt * 16 + fr) * 40 + fq * 8), va = ldsb8(VT + (rt * 16 + fr) * 40 + fq * 8);
            accY = __builtin_amdgcn_mfma_f32_16x16x32_bf16(ua, ldsb8(NBT + (ctg * 16 + fr) * 40 + fq * 8), accY, 0, 0, 0);
            *(LAS f32x4*)(YO + (ctg * 16 + fr) * 64 + rt * 16 + fq * 4) = accY;
#pragma unroll
            for (int cc = 0; cc < 2; ++cc) { const int ct = 2 * (wid & 1) + cc, kcol = ct * 16 + fr;
                f32x4 acc = Sreg[cc];
                acc = __builtin_amdgcn_mfma_f32_16x16x32_bf16(ua, ldsb8(BST + kcol * 40 + fq * 8), acc, 0, 0, 0);
                acc = __builtin_amdgcn_mfma_f32_16x16x32_bf16(va, ldsb8(KDST + kcol * 40 + fq * 8), acc, 0, 0, 0);
                const float g = GC[kcol];
#pragma unroll
                for (int i = 0; i < 4; ++i) { acc[i] *= g; S0B[(rt * 16 + fq * 4 + i) * 72 + kcol] = f2bf(acc[i]); }
                Sreg[cc] = acc; }
        }
        __syncthreads();
        if (!isctx) {
            const int j = tid >> 4, c4 = (tid & 15) * 4, t = d == 0 ? j : TB - 1 - j; const f32x4 y = *(const LAS f32x4*)(YO + j * 64 + c4);
            u32x2 w; w.x = cvt_pk_bf16(y[0], y[1]); w.y = cvt_pk_bf16(y[2], y[3]);
            *(u32x2*)(p.Y + ((size_t)d * nlat + grow0 + t) * RW + h * 64 + c4) = w;
            if (tid < TB) { const int tt = d == 0 ? tid : TB - 1 - tid; p.bon[((size_t)d * nlat + grow0 + tt) * NH + h] = BON[tid]; }
        }
    }
}
template <int MODE = 0>
__device__ __forceinline__ void rwkv_phase2(LAS unsigned char* lds, const In& in, const RwkvP p, int bid, int nblk) {
    const int nchain = 2 * p.nb * NH;
    for (int c = bid; c < nchain; c += nblk) { rwkv_chain2<MODE>(lds, in, p, c); __syncthreads(); }
}
}

namespace mk {
constexpr int LR_XT = 0;
constexpr int LR_XC = LR_XT + 67 * 64 * 2 + 64;
constexpr int LR_XCB = LR_XC + 64 * 64 * 4;
constexpr int LR_GWT = LR_XCB + 64 * 72 * 2;
constexpr int LR_A = LR_GWT + 2 * 64 * 72 * 2;
constexpr int LR_BX = LR_A + 64 * 64 * 4;
constexpr int LR_HO = LR_BX + 64 * 64 * 4;
constexpr int LR_CST = LR_HO + 64 * 64 * 4;
constexpr int LR_SEGP = LR_CST + 8 * 64 * 4;
constexpr int LR_SEGH = LR_SEGP + 8 * 64 * 4;
constexpr int LR_HC = LR_SEGH + 8 * 64 * 4;
constexpr int LR_END = LR_HC + 64 * 4;
static_assert(LR_END <= LDS_BYTES && (LR_XC % 16) == 0, "lru LDS");

struct LruP { const bf16_t* z1; bf16_t* Hd; int b0, nb; };

__device__ __forceinline__ void lru_item(LAS unsigned char* lds, const In& in, const LruP p, int item) {
    const int tid = threadIdx.x, lane = tid & 63, wid = tid >> 6;
    const int d = item / (p.nb * LB), bl = (item / LB) % p.nb, n = item % LB;
    const int nlat = p.nb * SEQ;
    LAS bf16_t* XT = (LAS bf16_t*)(lds + LR_XT); LAS float* XC = (LAS float*)(lds + LR_XC); LAS bf16_t* XCB = (LAS bf16_t*)(lds + LR_XCB); LAS bf16_t* GWT = (LAS bf16_t*)(lds + LR_GWT);
    LAS float *A_ = (LAS float*)(lds + LR_A), *BX = (LAS float*)(lds + LR_BX), *HO = (LAS float*)(lds + LR_HO), *CST = (LAS float*)(lds + LR_CST), *SEGP = (LAS float*)(lds + LR_SEGP), *SEGH = (LAS float*)(lds + LR_SEGH), *HC = (LAS float*)(lds + LR_HC);
    for (int i = tid; i < 2 * 64 * 64; i += NT) { const int g = i >> 12, j = (i >> 6) & 63, k = i & 63;
        GWT[(g * 64 + k) * 72 + j] = f2bf(in.lru_gate_w[((((size_t)d * 2 + g) * LB + n) * LBS + j) * LBS + k]); }
    for (int i = tid; i < 64; i += NT) { const int c = n * 64 + i;
        CST[i] = in.lru_conv_w[c]; CST[64 + i] = in.lru_conv_w[LW + c]; CST[128 + i] = in.lru_conv_w[2 * LW + c]; CST[192 + i] = in.lru_conv_w[3 * LW + c]; CST[256 + i] = in.lru_conv_b[c];
        CST[320 + i] = in.lru_gate_b[((d * 2 + 0) * LB + n) * LBS + i]; CST[384 + i] = in.lru_gate_b[((d * 2 + 1) * LB + n) * LBS + i]; CST[448 + i] = softplusf_(-in.lru_l[d * LW + c]); }
    constexpr int NSEG = CTX / 64 + GW, NSC = CTX / 64;
    u32x4 pre[2];
    auto tok_row = [&](int sidx, int rr, bool& ok) -> size_t {
        if (sidx < NSC) { const int t = sidx * 64 + rr - 2; ok = t >= 0 && t < CTX; return (size_t)nlat + (size_t)bl * CTX + t; }
        const int col = sidx - NSC, row = rr - 2; ok = row >= 0 && row < ROWS; return (size_t)bl * SEQ + (size_t)row * GW + col;
    };
    auto seg_of = [&](int q) { if (q < NSC) return d == 0 ? q : NSC - 1 - q; const int ql = q - NSC; return NSC + (d == 0 ? ql : GW - 1 - ql); };
    auto prefetch = [&](int q) { const int sidx = seg_of(q);
#pragma unroll
        for (int k = 0; k < 2; ++k) { const int i = tid + k * NT; u32x4 v = (u32x4){0u, 0u, 0u, 0u};
            if (i < 67 * 8) { const int rr = i >> 3, part = i & 7; bool ok; const size_t gr = tok_row(sidx, rr, ok); if (ok) v = *(const u32x4*)(p.z1 + gr * Z1_N + Z1_LX + n * 64 + part * 8); }
            pre[k] = v; } };
    auto commit = [&]() {
#pragma unroll
        for (int k = 0; k < 2; ++k) { const int i = tid + k * NT; if (i < 67 * 8) *(LAS u32x4*)(XT + (i >> 3) * 64 + (i & 7) * 8) = pre[k]; } };
    if (tid < 64) HC[tid] = 0.f;
    prefetch(0);
    for (int q = 0; q < NSEG; ++q) {
        const int sidx = seg_of(q);
        commit();
        __syncthreads();
        if (q + 1 < NSEG) prefetch(q + 1);
        { const int t = tid >> 3, c0 = (tid & 7) * 8; float s[8];
#pragma unroll
          for (int j = 0; j < 8; ++j) s[j] = CST[256 + c0 + j];
#pragma unroll
          for (int tap = 0; tap < 4; ++tap) { const u32x4 x = *(const LAS u32x4*)(XT + (t + tap) * 64 + c0);
#pragma unroll
              for (int j = 0; j < 4; ++j) { s[2 * j] += CST[tap * 64 + c0 + 2 * j] * bflo(x[j]); s[2 * j + 1] += CST[tap * 64 + c0 + 2 * j + 1] * bfhi(x[j]); } }
          *(LAS f32x4*)(XC + t * 64 + c0) = (f32x4){s[0], s[1], s[2], s[3]}; *(LAS f32x4*)(XC + t * 64 + c0 + 4) = (f32x4){s[4], s[5], s[6], s[7]};
          u32x4 w; w.x = cvt_pk_bf16(s[0], s[1]); w.y = cvt_pk_bf16(s[2], s[3]); w.z = cvt_pk_bf16(s[4], s[5]); w.w = cvt_pk_bf16(s[6], s[7]); *(LAS u32x4*)(XCB + t * 72 + c0) = w; }
        __syncthreads();
        { const int rt = wid >> 1, fr = lane & 15, fq = lane >> 4;
          bf16x8 a[2];
#pragma unroll
          for (int ks = 0; ks < 2; ++ks) a[ks] = *(const LAS bf16x8*)(XCB + (rt * 16 + fr) * 72 + ks * 32 + fq * 8);
#pragma unroll
          for (int cc = 0; cc < 2; ++cc) { const int ct = 2 * (wid & 1) + cc, col = ct * 16 + fr;
              f32x4 acc0 = (f32x4){0.f, 0.f, 0.f, 0.f}, acc1 = acc0;
#pragma unroll
              for (int ks = 0; ks < 2; ++ks) {
                  const bf16x8 b0 = *(const LAS bf16x8*)(GWT + (0 * 64 + col) * 72 + ks * 32 + fq * 8), b1 = *(const LAS bf16x8*)(GWT + (1 * 64 + col) * 72 + ks * 32 + fq * 8);
                  acc0 = __builtin_amdgcn_mfma_f32_16x16x32_bf16(a[ks], b0, acc0, 0, 0, 0); acc1 = __builtin_amdgcn_mfma_f32_16x16x32_bf16(a[ks], b1, acc1, 0, 0, 0); }
#pragma unroll
              for (int i = 0; i < 4; ++i) { const int t = rt * 16 + fq * 4 + i;
                  const float rec = fast_sigmoid(acc0[i] + CST[320 + col]), inp = fast_sigmoid(acc1[i] + CST[384 + col]);
                  const float la = -8.f * rec * CST[448 + col];
                  const float av = __expf(la), x2 = 2.f * la; const float om = x2 > -0.03f ? -x2 * (1.f + x2 * (0.5f + x2 * (1.f / 6.f))) : 1.f - av * av;
                  A_[t * 64 + col] = av; BX[t * 64 + col] = __builtin_amdgcn_sqrtf(om) * inp * XC[t * 64 + col]; } } }
        __syncthreads();
        { const int ch = tid & 63, pc = tid >> 6; float av[8], bv[8]; float P = 1.f, H = 0.f;
#pragma unroll
          for (int x = 0; x < 8; ++x) { const int st = pc * 8 + x, t = d == 0 ? st : 63 - st; av[x] = A_[t * 64 + ch]; bv[x] = BX[t * 64 + ch]; H = av[x] * H + bv[x]; P *= av[x]; }
          SEGP[pc * 64 + ch] = P; SEGH[pc * 64 + ch] = H;
          __syncthreads();
          float h = HC[ch];
#pragma unroll
          for (int q2 = 0; q2 < 7; ++q2) if (q2 < pc) h = SEGP[q2 * 64 + ch] * h + SEGH[q2 * 64 + ch];
#pragma unroll
          for (int x = 0; x < 8; ++x) { const int st = pc * 8 + x, t = d == 0 ? st : 63 - st; h = av[x] * h + bv[x]; HO[t * 64 + ch] = h; }
          __syncthreads();
          if (pc == 7) HC[ch] = h;
        }
        if (sidx >= NSC) { const int col = sidx - NSC, t = tid >> 3, c0 = (tid & 7) * 8;
            const f32x4 x = *(const LAS f32x4*)(HO + t * 64 + c0), y = *(const LAS f32x4*)(HO + t * 64 + c0 + 4);
            *(u32x4*)(p.Hd + ((size_t)d * nlat + (size_t)bl * SEQ + (size_t)t * GW + col) * LW + n * 64 + c0) = pack8(x, y); }
    }
}
__device__ __forceinline__ void lru_phase(LAS unsigned char* lds, const In& in, const LruP p, int bid, int nblk) {
    const int nitem = 2 * p.nb * LB;
    for (int it = bid; it < nitem; it += nblk) { lru_item(lds, in, p, it); __syncthreads(); }
}
}

namespace mk {
#define MK_DPPX(x, ctrl) __int_as_float(__builtin_amdgcn_update_dpp(__float_as_int(x), __float_as_int(x), ctrl, 0xF, 0xF, false))
__device__ __forceinline__ float allreduce4(float x) { x += MK_DPPX(x, 0xB1); x += MK_DPPX(x, 0x4E); return x; }
__device__ __forceinline__ void unpack8(const u32x4 w, float (&f)[8]) {
#pragma unroll
    for (int j = 0; j < 4; ++j) { f[2 * j] = bflo(w[j]); f[2 * j + 1] = bfhi(w[j]); } }
constexpr int AG_K = 256;
struct PostP { const bf16_t* z1; bf16_t* Y; const float* bon; bf16_t* Ag; int nlat; int pad_; };
__device__ __forceinline__ void rwkv_post_rows(const In& in, const PostP p, int row_lo, int row_hi, bool dry = false) {
    const int lane = threadIdx.x & 63, wid = threadIdx.x >> 6, c0 = lane * 16, h = lane >> 2;
    float mu0v[16], mu1v[16], l0[16], l1[16], mg0[8], mg1[8];
#pragma unroll
    for (int j = 0; j < 16; ++j) { mu0v[j] = in.shift_mu[OFF_V + c0 + j]; mu1v[j] = in.shift_mu[RC + OFF_V + c0 + j]; l0[j] = in.rw_lnx[c0 + j]; l1[j] = in.rw_lnx[RW + c0 + j]; }
#pragma unroll
    for (int j = 0; j < 8; ++j) { const int c = OFF_GD + (lane < GL / 8 ? lane : 0) * 8 + j; mg0[j] = in.shift_mu[c]; mg1[j] = in.shift_mu[RC + c]; }
    for (int r = row_lo + wid; r < row_hi; r += NT / 64) {
        const int cg = r % GW; const bool hp = cg > 0, hn = cg < GW - 1;
        bf16_t* y0p = p.Y + (size_t)r * RW + c0; const bf16_t* y1p = p.Y + ((size_t)p.nlat + r) * RW + c0;
        float y[16], t8[8];
        unpack8(*(const u32x4*)y0p, t8);
#pragma unroll
        for (int j = 0; j < 8; ++j) y[j] = t8[j];
        unpack8(*(const u32x4*)(y0p + 8), t8);
#pragma unroll
        for (int j = 0; j < 8; ++j) y[8 + j] = t8[j];
        unpack8(*(const u32x4*)y1p, t8);
#pragma unroll
        for (int j = 0; j < 8; ++j) y[j] += t8[j];
        unpack8(*(const u32x4*)(y1p + 8), t8);
#pragma unroll
        for (int j = 0; j < 8; ++j) y[8 + j] += t8[j];
        float s = 0.f;
#pragma unroll
        for (int j = 0; j < 16; ++j) s += y[j];
        const float mu = allreduce4(s) * (1.f / 64.f); float q = 0.f;
#pragma unroll
        for (int j = 0; j < 16; ++j) { const float dlt = y[j] - mu; q += dlt * dlt; }
        const float rs = 1.f / sqrtf(allreduce4(q) * (1.f / 64.f) + LNX_EPS);
        const float bonus = p.bon[(size_t)r * NH + h] + p.bon[((size_t)p.nlat + r) * NH + h];
        const bf16_t* zr = p.z1 + (size_t)r * Z1_N;
#pragma unroll
        for (int half = 0; half < 2; ++half) {
            const int c = OFF_V + c0 + half * 8; float xv[8], pv[8], nv[8];
            unpack8(*(const u32x4*)(zr + c), xv);
            if (hp) unpack8(*(const u32x4*)(zr - Z1_N + c), pv); else {
#pragma unroll
                for (int j = 0; j < 8; ++j) pv[j] = 0.f; }
            if (hn) unpack8(*(const u32x4*)(zr + Z1_N + c), nv); else {
#pragma unroll
                for (int j = 0; j < 8; ++j) nv[j] = 0.f; }
            float o[8];
#pragma unroll
            for (int j = 0; j < 8; ++j) { const int cj = half * 8 + j; const float v = xv[j] + mu0v[cj] * (pv[j] - xv[j]) + mu1v[cj] * (nv[j] - xv[j]);
                o[j] = (y[cj] - mu) * rs * l0[cj] + l1[cj] + bonus * v; }
            u32x4 w; w.x = cvt_pk_bf16(o[0], o[1]); w.y = cvt_pk_bf16(o[2], o[3]); w.z = cvt_pk_bf16(o[4], o[5]); w.w = cvt_pk_bf16(o[6], o[7]); if (!dry) *(u32x4*)(y0p + half * 8) = w; else if (w.x == 0x12345678u) *(u32x4*)(y0p + half * 8) = w;
        }
        if (lane < 32) { u32x4 w = (u32x4){0u, 0u, 0u, 0u};
            if (lane < GL / 8) { const int c = OFF_GD + lane * 8; float xv[8], pv[8], nv[8];
                unpack8(*(const u32x4*)(zr + c), xv);
                if (hp) unpack8(*(const u32x4*)(zr - Z1_N + c), pv); else {
#pragma unroll
                    for (int j = 0; j < 8; ++j) pv[j] = 0.f; }
                if (hn) unpack8(*(const u32x4*)(zr + Z1_N + c), nv); else {
#pragma unroll
                    for (int j = 0; j < 8; ++j) nv[j] = 0.f; }
                float o[8];
#pragma unroll
                for (int j = 0; j < 8; ++j) o[j] = fast_sigmoid(xv[j] + mg0[j] * (pv[j] - xv[j]) + mg1[j] * (nv[j] - xv[j]));
                w.x = cvt_pk_bf16(o[0], o[1]); w.y = cvt_pk_bf16(o[2], o[3]); w.z = cvt_pk_bf16(o[4], o[5]); w.w = cvt_pk_bf16(o[6], o[7]); }
            *(u32x4*)(p.Ag + (size_t)r * AG_K + lane * 8) = w; }
    }
}
#define MK_FR_ROW(f) ((((f) >> 3) * HALF) + wr * 64 + ((((f) >> 1) & 3) * 16) + fr)
#define MK_FR_COL(f) ((((f) & 1) * HALF) + wc * 32 + 8 * fq)
#define MK_FR_ACC(f, n) acc[(f) >> 3][(f) & 1][((f) >> 1) & 3][n]
#define MK_FENCE asm volatile("" ::: "memory")
struct EpiYa { const bf16_t* yn; bf16_t* ya;
    __device__ __forceinline__ bool operator()(f32x4 (&acc)[2][2][4][2], const Unit& u, int wr, int wc, int fr, int fq) const {
        const size_t base = (size_t)(u.pm * BM) * RW + u.pn * BM;
        u32x4 cur = *(const u32x4*)(yn + base + (size_t)MK_FR_ROW(0) * RW + MK_FR_COL(0));
#pragma unroll
        for (int f = 0; f < 16; ++f) { u32x4 nxt = cur; if (f + 1 < 16) nxt = *(const u32x4*)(yn + base + (size_t)MK_FR_ROW(f + 1) * RW + MK_FR_COL(f + 1));
            MK_FENCE; float v[8]; unpack8(cur, v); f32x4 a = MK_FR_ACC(f, 0), b = MK_FR_ACC(f, 1);
#pragma unroll
            for (int j = 0; j < 4; ++j) { a[j] *= v[j]; b[j] *= v[4 + j]; }
            *(u32x4*)(ya + base + (size_t)MK_FR_ROW(f) * RW + MK_FR_COL(f)) = pack8(a, b); MK_FENCE; cur = nxt; }
        return false; } };
struct EpiZc { const bf16_t* Hd; bf16_t* yb; bf16_t* gates; int nlat; int pad_;
    __device__ __forceinline__ bool operator()(f32x4 (&acc)[2][2][4][2], const Unit& u, int wr, int wc, int fr, int fq) const {
        if (u.pn < LW / BM) {
            MK_FRAG_LOOP(r, c) { const size_t o = (size_t)(u.pm * BM + r) * LW + u.pn * BM + c; float h0[8], h1[8]; unpack8(*(const u32x4*)(Hd + o), h0); unpack8(*(const u32x4*)(Hd + (size_t)nlat * LW + o), h1);
                f32x4 a = acc[ai][bj][m][0], b = acc[ai][bj][m][1];
#pragma unroll
                for (int j = 0; j < 4; ++j) { a[j] = gelu_tanhf_(a[j]) * (h0[j] + h1[j]); b[j] = gelu_tanhf_(b[j]) * (h0[4 + j] + h1[4 + j]); }
                *(u32x4*)(yb + o) = pack8(a, b); asm volatile("" ::: "memory"); }
        } else {
            MK_FRAG_LOOP(r, c) { const size_t o = (size_t)(u.pm * BM + r) * (2 * D) + (u.pn * BM - LW) + c;
                f32x4 a = acc[ai][bj][m][0], b = acc[ai][bj][m][1];
#pragma unroll
                for (int j = 0; j < 4; ++j) { a[j] = fast_sigmoid(a[j]); b[j] = fast_sigmoid(b[j]); }
                *(u32x4*)(gates + o) = pack8(a, b); }
        }
        return false; } };
struct PairOrder { StaticOrder S;
    __device__ bool next(int i, Unit& u) const { if (!S.next(i >> 1, u)) return false; u.e = i & 1; return true; } };
struct EpiBranch { const bf16_t* gates; bf16_t* mixed;
    __device__ __forceinline__ bool operator()(f32x4 (&acc)[2][2][4][2], const Unit& u, int wr, int wc, int fr, int fq) const {
        const size_t gbase = (size_t)(u.pm * BM) * (2 * D) + u.pn * BM, mbase = (size_t)(u.pm * BM) * D + u.pn * BM;
        u32x4 c1 = (u32x4){0u, 0u, 0u, 0u}, c2 = *(const u32x4*)(gates + gbase + (size_t)MK_FR_ROW(0) * (2 * D) + D + MK_FR_COL(0));
        if (u.e == 0) c1 = *(const u32x4*)(gates + gbase + (size_t)MK_FR_ROW(0) * (2 * D) + MK_FR_COL(0));
#pragma unroll
        for (int f = 0; f < 16; ++f) { u32x4 n1 = c1, n2 = c2;
            if (f + 1 < 16) { const size_t o = gbase + (size_t)MK_FR_ROW(f + 1) * (2 * D) + MK_FR_COL(f + 1); n2 = *(const u32x4*)(gates + o + D); if (u.e == 0) n1 = *(const u32x4*)(gates + o); }
            MK_FENCE; float g1[8], g2[8]; unpack8(c1, g1); unpack8(c2, g2);
            if (u.e == 0) {
#pragma unroll
                for (int j = 0; j < 4; ++j) { MK_FR_ACC(f, 0)[j] *= g1[j] / g2[j]; MK_FR_ACC(f, 1)[j] *= g1[4 + j] / g2[4 + j]; }
            } else { f32x4 a = MK_FR_ACC(f, 0), b = MK_FR_ACC(f, 1);
#pragma unroll
                for (int j = 0; j < 4; ++j) { a[j] *= g2[j]; b[j] *= g2[4 + j]; }
                *(u32x4*)(mixed + mbase + (size_t)MK_FR_ROW(f) * D + MK_FR_COL(f)) = pack8(a, b); }
            MK_FENCE; c1 = n1; c2 = n2; }
        return u.e == 0; } };
struct EpiF32 { float* C; long ldc;
    __device__ __forceinline__ bool operator()(f32x4 (&acc)[2][2][4][2], const Unit& u, int wr, int wc, int fr, int fq) const {
        MK_FRAG_LOOP(r, c) { float* o = C + (size_t)(u.pm * BM + r) * ldc + u.pn * BM + c; *(f32x4*)o = acc[ai][bj][m][0]; *(f32x4*)(o + 4) = acc[ai][bj][m][1]; }
        return false; } };
}

namespace mk {
constexpr int NEX = NE + 1;
constexpr int SLOTS_PER_TOK = TOPK + 1;
constexpr int RP_MOD = 0;
constexpr int RP_UH = RP_MOD + 3 * D * 4;
constexpr int RP_UL = RP_UH + 16 * (D + 8) * 2;
constexpr int RP_PART = RP_UL + 16 * (D + 8) * 2;
constexpr int RP_LOG = RP_PART + 8 * 16 * 64 * 4;
constexpr int RP_HIST = RP_LOG + 16 * 64 * 4;
constexpr int RP_END = RP_HIST + 64 * 4;
static_assert(RP_END <= LDS_BYTES, "rowpass LDS");

struct RowP { float* y2h1; bf16_t* u; const float* modpart; const bf16_t* rwt;
              int* tope; float* gatev; int* lrank; int* blkcnt; int b0, nlat; };
__device__ __forceinline__ float wave_max(float x) {
#pragma unroll
    for (int o = 32; o > 0; o >>= 1) x = fmaxf(x, __shfl_xor(x, o));
    return x; }
__device__ __forceinline__ void row_pass(LAS unsigned char* lds, const In& in, const RowP p, int row_lo, int row_hi, bool dry = false) {
    const int tid = threadIdx.x, lane = tid & 63, wid = tid >> 6;
    LAS float* MOD = (LAS float*)(lds + RP_MOD); LAS bf16_t* UH = (LAS bf16_t*)(lds + RP_UH); LAS bf16_t* UL = (LAS bf16_t*)(lds + RP_UL);
    LAS float* PART = (LAS float*)(lds + RP_PART); LAS float* LOG = (LAS float*)(lds + RP_LOG); LAS int* HIST = (LAS int*)(lds + RP_HIST);
    const int mr = p.b0 + row_lo / SEQ;
    for (int j = tid; j < 3 * D; j += NT) MOD[j] = mod_value(in, p.modpart, mr, 2 * D + j);
    if (tid < 64) HIST[tid] = 0;
    __syncthreads();
    float gp1[16], gp2[16];
#pragma unroll
    for (int j = 0; j < 4; ++j)
#pragma unroll
        for (int q = 0; q < 4; ++q) { gp1[4 * j + q] = in.norm_g[D + j * 256 + lane * 4 + q]; gp2[4 * j + q] = in.norm_g[2 * D + j * 256 + lane * 4 + q]; }
    for (int r16 = row_lo; r16 < row_hi; r16 += 16) {
#pragma unroll
        for (int rr = 0; rr < 2; ++rr) {
            const int lr = wid * 2 + rr, r = r16 + lr;
            float* yp = p.y2h1 + (size_t)r * D; const float* xp = in.x + ((size_t)p.b0 * SEQ + r) * D;
            f32x4 v[4]; float ss = 0.f;
#pragma unroll
            for (int j = 0; j < 4; ++j) { v[j] = *(const f32x4*)(yp + j * 256 + lane * 4); ss += v[j][0] * v[j][0] + v[j][1] * v[j][1] + v[j][2] * v[j][2] + v[j][3] * v[j][3]; }
#pragma unroll
            for (int o = 32; o > 0; o >>= 1) ss += __shfl_xor(ss, o);
            const float rinv = 1.f / sqrtf(ss * (1.f / D) + NORM_EPS); float s2 = 0.f;
#pragma unroll
            for (int j = 0; j < 4; ++j) { const int c = j * 256 + lane * 4; const f32x4 xv = *(const f32x4*)(xp + c);
#pragma unroll
                for (int q = 0; q < 4; ++q) { const float hv = xv[q] + MOD[c + q] * (v[j][q] * rinv * gp1[4 * j + q]); v[j][q] = hv; s2 += hv * hv; }
                if (!dry) *(f32x4*)(yp + c) = v[j]; }
#pragma unroll
            for (int o = 32; o > 0; o >>= 1) s2 += __shfl_xor(s2, o);
            const float r2 = 1.f / sqrtf(s2 * (1.f / D) + NORM_EPS);
#pragma unroll
            for (int j = 0; j < 4; ++j) { const int c = j * 256 + lane * 4; float uu[4], lo[4]; unsigned hw[2];
#pragma unroll
                for (int q = 0; q < 4; ++q) uu[q] = (v[j][q] * r2 * gp2[4 * j + q]) * (1.f + MOD[2 * D + c + q]) + MOD[D + c + q];
                hw[0] = cvt_pk_bf16(uu[0], uu[1]); hw[1] = cvt_pk_bf16(uu[2], uu[3]);
                lo[0] = uu[0] - bflo(hw[0]); lo[1] = uu[1] - bfhi(hw[0]); lo[2] = uu[2] - bflo(hw[1]); lo[3] = uu[3] - bfhi(hw[1]);
                u32x2 w; w.x = hw[0]; w.y = hw[1]; *(u32x2*)(p.u + (size_t)r * D + c) = w; *(LAS u32x2*)(UH + lr * (D + 8) + c) = w;
                u32x2 wl; wl.x = cvt_pk_bf16(lo[0], lo[1]); wl.y = cvt_pk_bf16(lo[2], lo[3]); *(LAS u32x2*)(UL + lr * (D + 8) + c) = wl; }
        }
        __syncthreads();
        { const int fr = lane & 15, fq = lane >> 4;
          f32x4 acc[4];
#pragma unroll
          for (int ct = 0; ct < 4; ++ct) acc[ct] = (f32x4){0.f, 0.f, 0.f, 0.f};
#pragma unroll
          for (int ks = 0; ks < 4; ++ks) { const int k0 = wid * 128 + ks * 32 + fq * 8;
              const bf16x8 ah = *(const LAS bf16x8*)(UH + fr * (D + 8) + k0), al = *(const LAS bf16x8*)(UL + fr * (D + 8) + k0);
#pragma unroll
              for (int ct = 0; ct < 4; ++ct) { const bf16x8 bh = *(const bf16x8*)(p.rwt + (size_t)(ct * 16 + fr) * D + k0), bl = *(const bf16x8*)(p.rwt + (size_t)(NE + ct * 16 + fr) * D + k0);
                  acc[ct] = __builtin_amdgcn_mfma_f32_16x16x32_bf16(ah, bh, acc[ct], 0, 0, 0); acc[ct] = __builtin_amdgcn_mfma_f32_16x16x32_bf16(ah, bl, acc[ct], 0, 0, 0); acc[ct] = __builtin_amdgcn_mfma_f32_16x16x32_bf16(al, bh, acc[ct], 0, 0, 0); } }
#pragma unroll
          for (int ct = 0; ct < 4; ++ct)
#pragma unroll
              for (int i = 0; i < 4; ++i) PART[(wid * 16 + fq * 4 + i) * 64 + ct * 16 + fr] = acc[ct][i]; }
        __syncthreads();
        for (int i = tid; i < 16 * 64; i += NT) { float s = 0.f;
#pragma unroll
            for (int w = 0; w < 8; ++w) s += PART[w * 1024 + i];
            LOG[i] = s; }
        __syncthreads();
#pragma unroll 1
        for (int rr = 0; rr < 2; ++rr) {
            const int lr = wid * 2 + rr, r = r16 + lr;
            const float sc = sigmoidf_(LOG[lr * 64 + lane]), bi = sc + in.router_b[lane];
            float m1 = bi; m1 = fmaxf(m1, __shfl_xor(m1, 1)); m1 = fmaxf(m1, __shfl_xor(m1, 2)); m1 = fmaxf(m1, __shfl_xor(m1, 4));
            const unsigned long long eq = __ballot(bi == m1); const int first = __ffsll((long long)((eq >> (lane & ~7)) & 0xffull)) - 1 + (lane & ~7);
            float m2 = (lane == first) ? -1e30f : bi; m2 = fmaxf(m2, __shfl_xor(m2, 1)); m2 = fmaxf(m2, __shfl_xor(m2, 2)); m2 = fmaxf(m2, __shfl_xor(m2, 4));
            const float gs = m1 + m2; const int myg = lane >> 3; int rank = 0;
#pragma unroll
            for (int g = 0; g < NG; ++g) { const float og = __shfl(gs, g * 8); rank += (og > gs || (og == gs && g < myg)) ? 1 : 0; }
            float cand = rank < TG ? bi : -1e30f; float tsum = 0.f; int myidx = 0; float mysc = 0.f;
#pragma unroll
            for (int it = 0; it < TOPK; ++it) { const float m = wave_max(cand); const unsigned long long bm = __ballot(cand == m); const int win = __ffsll((long long)bm) - 1;
                const float ws = __shfl(sc, win); tsum += ws; if (lane == it) { myidx = win; mysc = ws; } if (lane == win) cand = -1e30f; }
            if (lane < TOPK) { const int rk = atomicAdd((int*)&HIST[myidx], 1);
                p.tope[(size_t)r * TOPK + lane] = myidx; p.gatev[(size_t)r * TOPK + lane] = mysc / tsum * 2.5f; p.lrank[(size_t)r * TOPK + lane] = rk; }
        }
        __syncthreads();
    }
    if (tid < 64) p.blkcnt[blockIdx.x * 64 + tid] = HIST[tid];
}

struct MoeP { const int* tope; const float* gatev; const int* lrank; const int* blkcnt;
              int* tilepre;
              int* list;
              int* sdst;
              float* sgate;
              int r0, nr, blk0, nbh, rpb, pad_; };
__device__ __forceinline__ void moe_assign(LAS unsigned char* lds, const MoeP p, int bid, int nblk) {
    LAS int* BASE = (LAS int*)lds; LAS int* CNT = BASE + 80; LAS int* BOFF = CNT + 80;
    const int tid = threadIdx.x;
    if (tid < NE) { int c = 0, bo = 0; for (int b = 0; b < p.nbh; ++b) { const int v = p.blkcnt[(p.blk0 + b) * 64 + tid]; if (p.blk0 + b < bid) bo += v; c += v; } CNT[tid] = c; BOFF[tid] = bo; }
    __syncthreads();
    if (tid == 0) { int s = 0; for (int e = 0; e < NE; ++e) { BASE[e] = s; s += (CNT[e] + BM - 1) / BM * BM; } BASE[NE] = s; CNT[NE] = p.nr; BASE[NE + 1] = s + p.nr;
        if (bid == 0) { for (int e = 0; e <= NEX; ++e) p.tilepre[e] = BASE[e] / BM; } }
    __syncthreads();
    if (bid >= p.blk0 && bid < p.blk0 + p.nbh) {
        const int rlo = p.r0 + (bid - p.blk0) * p.rpb;
        for (int i = tid; i < p.rpb * TOPK; i += NT) { const int r = rlo + i / TOPK, a = r * TOPK + i % TOPK, e = p.tope[a]; const int slot = BASE[e] + BOFF[e] + p.lrank[a];
            p.list[slot] = r; p.sdst[slot] = (r - p.r0) * SLOTS_PER_TOK + i % TOPK; p.sgate[slot] = p.gatev[a]; }
        for (int i = tid; i < p.rpb; i += NT) { const int r = rlo + i, slot = BASE[NE] + (r - p.r0); p.list[slot] = r; p.sdst[slot] = (r - p.r0) * SLOTS_PER_TOK + TOPK; p.sgate[slot] = 1.f; }
    }
    for (int e = bid; e < NE; e += nblk) { const int lo = BASE[e] + CNT[e], hi = BASE[e + 1]; for (int s = lo + tid; s < hi; s += NT) { p.list[s] = p.r0; p.sdst[s] = -1; p.sgate[s] = 0.f; } }
}
struct GroupOrder { int tpn, total, nN, G, c;
    __device__ void init(const int* tilepre, int nN_, int G_, int c_) { const int lane = threadIdx.x & 63;
        tpn = (int)__hip_atomic_load((const unsigned*)tilepre + lane + 1, __ATOMIC_RELAXED, __HIP_MEMORY_SCOPE_AGENT);
        total = (int)__hip_atomic_load((const unsigned*)tilepre + NEX, __ATOMIC_RELAXED, __HIP_MEMORY_SCOPE_AGENT); nN = nN_; G = G_; c = c_; }
    __device__ bool next(int i, Unit& u) const { const long L = (long)i * G + c; if (L >= (long)total * nN) return false;
        const int T = (int)(L / nN); const int e = __popcll(__ballot(tpn <= T));
        u.pm = T; u.pn = (int)(L % nN); u.e = __builtin_amdgcn_readfirstlane(e); return true; } };
struct EpiGU { bf16_t* act;
    __device__ __forceinline__ bool operator()(f32x4 (&acc)[2][2][4][2], const Unit& u, int wr, int wc, int fr, int fq) const {
        MK_FRAG_LOOP(r, c) { const f32x4 a = acc[ai][bj][m][0], b = acc[ai][bj][m][1];
            u32x2 w; w.x = cvt_pk_bf16(fast_silu(a[0]) * a[1], fast_silu(a[2]) * a[3]); w.y = cvt_pk_bf16(fast_silu(b[0]) * b[1], fast_silu(b[2]) * b[3]);
            *(u32x2*)(act + (size_t)(u.pm * BM + r) * EF + ((u.pn * BM + c) >> 1)) = w; }
        return false; } };
struct EpiDown { const int* sdst; const float* sgate; bf16_t* rowsb;
    __device__ __forceinline__ bool operator()(f32x4 (&acc)[2][2][4][2], const Unit& u, int wr, int wc, int fr, int fq) const {
        int dst[8]; float gt[8];
#pragma unroll
        for (int q = 0; q < 8; ++q) { const int slot = u.pm * BM + (q >> 2) * HALF + wr * 64 + (q & 3) * 16 + fr; dst[q] = sdst[slot]; gt[q] = sgate[slot]; }
#pragma unroll
        for (int ai = 0; ai < 2; ++ai)
#pragma unroll
            for (int m = 0; m < 4; ++m) { const int q = ai * 4 + m; if (dst[q] >= 0) {
#pragma unroll
                for (int bj = 0; bj < 2; ++bj) { f32x4 a = acc[ai][bj][m][0], b = acc[ai][bj][m][1];
#pragma unroll
                    for (int j = 0; j < 4; ++j) { a[j] *= gt[q]; b[j] *= gt[q]; }
                    *(u32x4*)(rowsb + (size_t)dst[q] * D + u.pn * BM + bj * HALF + wc * 32 + 8 * fq) = pack8(a, b); } } }
        return false; } };
__device__ __forceinline__ void final_rows(LAS float* sm  , const In& in, const float* modpart, const bf16_t* rowsb, float* h1out, int b0, int r0, int row_lo, int row_hi, bool dry = false) {
    const int tid = threadIdx.x, lane = tid & 63, wid = tid >> 6;
    const int mr = b0 + row_lo / SEQ;
    __syncthreads();
    for (int j = tid; j < D; j += NT) sm[j] = mod_value(in, modpart, mr, 5 * D + j);
    __syncthreads();
    float gq[16];
#pragma unroll
    for (int j = 0; j < 4; ++j)
#pragma unroll
        for (int q = 0; q < 4; ++q) gq[4 * j + q] = sm[j * 256 + lane * 4 + q] * in.norm_g[3 * D + j * 256 + lane * 4 + q];
    for (int r = row_lo + wid; r < row_hi; r += NT / 64) {
        float v[16];
#pragma unroll
        for (int j = 0; j < 16; ++j) v[j] = 0.f;
        const bf16_t* rb = rowsb + (size_t)(r - r0) * SLOTS_PER_TOK * D;
#pragma unroll
        for (int s = 0; s < SLOTS_PER_TOK; ++s)
#pragma unroll
            for (int j = 0; j < 4; ++j) { const u32x2 w = *(const u32x2*)(rb + (size_t)s * D + j * 256 + lane * 4); v[4 * j] += bflo(w.x); v[4 * j + 1] += bfhi(w.x); v[4 * j + 2] += bflo(w.y); v[4 * j + 3] += bfhi(w.y); }
        float ss = 0.f;
#pragma unroll
        for (int j = 0; j < 16; ++j) ss += v[j] * v[j];
#pragma unroll
        for (int o = 32; o > 0; o >>= 1) ss += __shfl_xor(ss, o);
        const float rinv = 1.f / sqrtf(ss * (1.f / D) + NORM_EPS);
        float* hp = h1out + (size_t)r * D;
#pragma unroll
        for (int j = 0; j < 4; ++j) { const int c = j * 256 + lane * 4; f32x4 hv = *(const f32x4*)(hp + c);
#pragma unroll
            for (int q = 0; q < 4; ++q) hv[q] += gq[4 * j + q] * (v[4 * j + q] * rinv);
            if (!dry) *(f32x4*)(hp + c) = hv; else if (hv[0] == 1.2345e30f) *(f32x4*)(hp + c) = hv; }
    }
}
__device__ __forceinline__ void rwt_prep(const In& in, bf16_t* rwt, int bid, int nblk) {
    for (int i = bid * NT + threadIdx.x; i < NE * D; i += nblk * NT) { const int e = i / D, k = i % D; const float w = in.router_w[(size_t)k * NE + e]; const bf16_t h = f2bf(w); rwt[i] = h; rwt[(size_t)NE * D + i] = f2bf(w - bf2f(h)); }
}
}

using namespace mk;
constexpr size_t MiB = (size_t)1 << 20;
constexpr int NLAT = NB * SEQ, NCTXR = NB * CTX, NALL = NLAT + NCTXR, NRH = NLAT / 2, MAXSLOTS = NRH * SLOTS_PER_TOK + NE * BM;
constexpr size_t O_W1A = 0, O_W1C = O_W1A + (size_t)Z1_N * D * 2, O_WG = O_W1C + (size_t)ZC_N * D * 2, O_WBR = O_WG + (size_t)RW * AG_K * 2, O_WOUT = O_WBR + (size_t)2 * D * RW * 2,
                 O_RWT = O_WOUT + (size_t)D * D * 2, O_MODP = O_RWT + (size_t)2 * NE * D * 2, O_S_END = O_MODP + (size_t)MOD_SL * (NB + 1) * 6 * D * 4;
static_assert(O_S_END <= 27 * MiB, "S region");
constexpr size_t O_BAR = 27 * MiB;
constexpr size_t O_Z1 = 28 * MiB, O_R2 = O_Z1 + (size_t)NALL * Z1_N * 2;
static_assert(O_R2 == 334 * MiB, "z1 size");
constexpr size_t O_HD = O_R2, O_BON = O_HD + (size_t)2 * NLAT * LW * 2, O_AG = O_BON + (size_t)2 * NLAT * NH * 4, O_R2_END = O_AG + (size_t)NLAT * AG_K * 2;
static_assert(O_R2_END <= 512 * MiB, "R2");
constexpr size_t O_XNL = O_Z1, O_YB = O_XNL + (size_t)NLAT * D * 2, O_GATES = O_YB + (size_t)NLAT * LW * 2, O_MIXED = O_HD;
static_assert(O_GATES + (size_t)NLAT * 2 * D * 2 <= O_R2, "late R1");
constexpr size_t O_U = O_Z1, O_WGU = O_U + (size_t)NLAT * D * 2, O_WDN = O_WGU + (size_t)NEX * 2 * EF * D * 2, O_ROUT = O_WDN + (size_t)NEX * D * EF * 2;
constexpr size_t O_TOPE = O_ROUT, O_LRANK = O_TOPE + (size_t)NLAT * TOPK * 4, O_GATEV = O_LRANK + (size_t)NLAT * TOPK * 4, O_BLKCNT = O_GATEV + (size_t)NLAT * TOPK * 4, O_TILEPRE = O_BLKCNT + 256 * 64 * 4,
                 O_LIST = O_TILEPRE + 1024, O_SDST = O_LIST + (size_t)MAXSLOTS * 4, O_SGATE = O_SDST + (size_t)MAXSLOTS * 4, O_ACT = ((O_SGATE + (size_t)MAXSLOTS * 4 + 255) / 256) * 256,
                 O_ROWSB = ((O_ACT + (size_t)MAXSLOTS * EF * 2 + 255) / 256) * 256, O_END = O_ROWSB + (size_t)NRH * SLOTS_PER_TOK * D * 2;
static_assert(O_END <= 512 * MiB, "workspace");
static_assert(O_WGU >= O_YB && O_ROWSB >= O_GATES, "late layout");

struct MP { In in; float* out; unsigned char* ws; long ph_lo, ph_hi; };
constexpr int NPHASE = 17;

__global__ void __launch_bounds__(512, 2) mega(MP P) {
    extern __shared__ __attribute__((aligned(16))) unsigned char shm[];
    LAS unsigned char* lds = (LAS unsigned char*)shm;
    const In& in = P.in; unsigned char* ws = P.ws; const int bid = blockIdx.x, nblk = gridDim.x;
    bf16_t *W1a = (bf16_t*)(ws + O_W1A), *W1c = (bf16_t*)(ws + O_W1C), *Wg = (bf16_t*)(ws + O_WG), *Wbr = (bf16_t*)(ws + O_WBR), *Wout = (bf16_t*)(ws + O_WOUT), *rwt = (bf16_t*)(ws + O_RWT);
    float* modpart = (float*)(ws + O_MODP);
    bf16_t *z1 = (bf16_t*)(ws + O_Z1), *Hd = (bf16_t*)(ws + O_HD), *Ag = (bf16_t*)(ws + O_AG); float* bon = (float*)(ws + O_BON);
    bf16_t *xnl = (bf16_t*)(ws + O_XNL), *yb = (bf16_t*)(ws + O_YB), *gates = (bf16_t*)(ws + O_GATES), *mixed = (bf16_t*)(ws + O_MIXED);
    bf16_t *u = (bf16_t*)(ws + O_U), *Wgu = (bf16_t*)(ws + O_WGU), *Wdn = (bf16_t*)(ws + O_WDN), *act = (bf16_t*)(ws + O_ACT), *rowsb = (bf16_t*)(ws + O_ROWSB);
    int *tope = (int*)(ws + O_TOPE), *lrank = (int*)(ws + O_LRANK), *blkcnt = (int*)(ws + O_BLKCNT), *tilepre = (int*)(ws + O_TILEPRE), *list = (int*)(ws + O_LIST), *sdst = (int*)(ws + O_SDST);
    float *gatev = (float*)(ws + O_GATEV), *sgate = (float*)(ws + O_SGATE);
    bf16_t* xn_all = (bf16_t*)P.out;
    bf16_t* Y = (bf16_t*)P.out;
    float* y2h1 = P.out;
    const int ph_lo = (int)P.ph_lo, ph_hi = (int)P.ph_hi;
    volatile LAS unsigned* xst = (volatile LAS unsigned*)(lds + LDS_BYTES - 16);
    if (threadIdx.x == 0) { xst[0] = 0u; xst[1] = 0u; }
    __syncthreads();
    const XcdBarrier xb = xcd_barrier_post((unsigned*)(ws + O_BAR), xst);
    if (0 >= ph_lo && 0 < ph_hi) { if (0 > ph_lo) xcd_barrier(xb); const int ph = 0; (void)ph;
        { LAS float* tile = (LAS float*)lds; int base = 0;
            convT_job(tile, in.w_in, INC, D, W1a, D, Z1_N, CMapZ1{}, bid, nblk, base);
            convT_job(tile, in.w_in, INC, D, W1c, D, ZC_N, CMapZC{}, bid, nblk, base);
            convT_job(tile, in.rw_g_up, RW, GL, Wg, AG_K, RW, CMapId{}, bid, nblk, base);
            convT_job(tile, in.w_branch_a, D, RW, Wbr, RW, D, CMapId{}, bid, nblk, base);
            convT_job(tile, in.w_branch_b, D, LW, Wbr + (size_t)D * RW, LW, D, CMapId{}, bid, nblk, base);
            convT_job(tile, in.w_out, D, D, Wout, D, D, CMapId{}, bid, nblk, base);
            rwt_prep(in, rwt, bid, nblk);
            mod_partials((LAS float*)lds, in, modpart, bid, nblk); }
    }
    if (1 >= ph_lo && 1 < ph_hi) { if (1 > ph_lo) xcd_barrier(xb); const int ph = 1; (void)ph;
        { const int L = NLAT / nblk, Lc = NCTXR / nblk;
            xn_rows((LAS float*)lds, in, modpart, xn_all, 0, NB, bid * L, (bid + 1) * L);
            xn_rows((LAS float*)lds, in, modpart, xn_all, 0, NB, NLAT + bid * Lc, NLAT + (bid + 1) * Lc); }
    }
    if (2 >= ph_lo && 2 < ph_hi) { if (2 > ph_lo) xcd_barrier(xb); const int ph = 2; (void)ph;
        { GemmP g{xn_all, xn_all, W1a, 0, nullptr, D, 0}; StaticOrder S; S.init(NALL, Z1_N, nblk, bid); gemm_phase(lds, g, S, EpiStoreBf16{z1, Z1_N}); }
    }
    if (3 >= ph_lo && 3 < ph_hi) { if (3 > ph_lo) xcd_barrier(xb); const int ph = 3; (void)ph;
        { LruP lp{z1, Hd, 0, NB}; lru_phase(lds, in, lp, bid, nblk); __syncthreads();
                  RwkvP rp{z1, Y, bon, 0, NB}; rwkv_phase2(lds, in, rp, bid, nblk); }
    }
    if (4 >= ph_lo && 4 < ph_hi) { if (4 > ph_lo) xcd_barrier(xb); const int ph = 4; (void)ph;
        { const int L = NLAT / nblk; PostP pp{z1, Y, bon, Ag, NLAT, 0}; rwkv_post_rows(in, pp, bid * L, (bid + 1) * L); }
    }
    if (5 >= ph_lo && 5 < ph_hi) { if (5 > ph_lo) xcd_barrier(xb); const int ph = 5; (void)ph;
        { const int L = NLAT / nblk; xn_rows((LAS float*)lds, in, modpart, xnl, 0, NB, bid * L, (bid + 1) * L); __syncthreads();
                  GemmP g{Ag, Ag, Wg, 0, nullptr, AG_K, 0}; StaticOrder S; S.init(NLAT, RW, nblk, bid); gemm_phase(lds, g, S, EpiYa{Y, Y + (size_t)NLAT * RW}); }
    }
    if (6 >= ph_lo && 6 < ph_hi) { if (6 > ph_lo) xcd_barrier(xb); const int ph = 6; (void)ph;
        { GemmP g{xnl, xnl, W1c, 0, nullptr, D, 0}; StaticOrder S; S.init(NLAT, ZC_N, nblk, bid); gemm_phase(lds, g, S, EpiZc{Hd, yb, gates, NLAT, 0}); }
    }
    if (7 >= ph_lo && 7 < ph_hi) { if (7 > ph_lo) xcd_barrier(xb); const int ph = 7; (void)ph;
        { GemmP g{Y + (size_t)NLAT * RW, yb, Wbr, (long)D * RW, nullptr, D, 0}; PairOrder S; S.S.init(NLAT, D, nblk, bid); gemm_phase(lds, g, S, EpiBranch{gates, mixed}); }
    }
    if (8 >= ph_lo && 8 < ph_hi) { if (8 > ph_lo) xcd_barrier(xb); const int ph = 8; (void)ph;
        { LAS float* tile = (LAS float*)lds; int base = 0;
            for (int e = 0; e < NE; ++e) {
                convT_job(tile, in.ex_w_gu + (size_t)e * D * 2 * EF, 2 * EF, D, Wgu + (size_t)e * 2 * EF * D, D, 2 * EF, CMapGU{EF}, bid, nblk, base);
                convT_job(tile, in.ex_w_down + (size_t)e * EF * D, D, EF, Wdn + (size_t)e * D * EF, EF, D, CMapId{}, bid, nblk, base); }
            convT_job(tile, in.sh_w_gu, 2 * SF, D, Wgu + (size_t)NE * 2 * EF * D, D, 2 * SF, CMapGU{SF}, bid, nblk, base);
            convT_job(tile, in.sh_w_down, D, SF, Wdn + (size_t)NE * D * EF, SF, D, CMapId{}, bid, nblk, base);
            __syncthreads();
            GemmP g{mixed, mixed, Wout, 0, nullptr, D, 0}; StaticOrder S; S.init(NLAT, D, nblk, bid); gemm_phase(lds, g, S, EpiF32{y2h1, D}); }
    }
    if (9 >= ph_lo && 9 < ph_hi) { if (9 > ph_lo) xcd_barrier(xb); const int ph = 9; (void)ph;
        { const int L = NLAT / nblk; RowP rp{y2h1, u, modpart, rwt, tope, gatev, lrank, blkcnt, 0, NLAT}; row_pass(lds, in, rp, bid * L, (bid + 1) * L); }
    }
    if (10 >= ph_lo && 10 < ph_hi) { if (10 > ph_lo) xcd_barrier(xb); const int ph = 10; (void)ph;
        { const int q = ph - 10, half = q >= 4 ? 1 : 0, st = q - 4 * half;
            const int rpb = NLAT / nblk;
            auto assign = [&](int hf) { MoeP mp{tope, gatev, lrank, blkcnt, tilepre, list, sdst, sgate, hf * NRH, NRH, hf * (nblk / 2), nblk / 2, rpb, 0}; moe_assign(lds, mp, bid, nblk); };
            auto fin = [&](int hf) { const int L = NRH / nblk, r0 = hf * NRH; final_rows((LAS float*)lds, in, modpart, rowsb, y2h1, 0, r0, r0 + bid * L, r0 + (bid + 1) * L); };
            if (ph == 10) assign(0);
            else if (ph == 11 || ph == 14) { GemmP g{u, u, Wgu, (long)2 * EF * D, list, D, 0}; GroupOrder S; S.init(tilepre, 2 * EF / BM, nblk, bid); gemm_phase<true>(lds, g, S, EpiGU{act}); }
            else if (ph == 12 || ph == 15) { GemmP g{act, act, Wdn, (long)D * EF, nullptr, EF, 0}; GroupOrder S; S.init(tilepre, D / BM, nblk, bid); gemm_phase(lds, g, S, EpiDown{sdst, sgate, rowsb}); }
            else if (ph == 13) { fin(0); __syncthreads(); assign(1); }
            else if (ph == 16) fin(1);
            (void)half; (void)st; }
    }
    if (11 >= ph_lo && 11 < ph_hi) { if (11 > ph_lo) xcd_barrier(xb); const int ph = 11; (void)ph;
        { const int q = ph - 10, half = q >= 4 ? 1 : 0, st = q - 4 * half;
            const int rpb = NLAT / nblk;
            auto assign = [&](int hf) { MoeP mp{tope, gatev, lrank, blkcnt, tilepre, list, sdst, sgate, hf * NRH, NRH, hf * (nblk / 2), nblk / 2, rpb, 0}; moe_assign(lds, mp, bid, nblk); };
            auto fin = [&](int hf) { const int L = NRH / nblk, r0 = hf * NRH; final_rows((LAS float*)lds, in, modpart, rowsb, y2h1, 0, r0, r0 + bid * L, r0 + (bid + 1) * L); };
            if (ph == 10) assign(0);
            else if (ph == 11 || ph == 14) { GemmP g{u, u, Wgu, (long)2 * EF * D, list, D, 0}; GroupOrder S; S.init(tilepre, 2 * EF / BM, nblk, bid); gemm_phase<true>(lds, g, S, EpiGU{act}); }
            else if (ph == 12 || ph == 15) { GemmP g{act, act, Wdn, (long)D * EF, nullptr, EF, 0}; GroupOrder S; S.init(tilepre, D / BM, nblk, bid); gemm_phase(lds, g, S, EpiDown{sdst, sgate, rowsb}); }
            else if (ph == 13) { fin(0); __syncthreads(); assign(1); }
            else if (ph == 16) fin(1);
            (void)half; (void)st; }
    }
    if (12 >= ph_lo && 12 < ph_hi) { if (12 > ph_lo) xcd_barrier(xb); const int ph = 12; (void)ph;
        { const int q = ph - 10, half = q >= 4 ? 1 : 0, st = q - 4 * half;
            const int rpb = NLAT / nblk;
            auto assign = [&](int hf) { MoeP mp{tope, gatev, lrank, blkcnt, tilepre, list, sdst, sgate, hf * NRH, NRH, hf * (nblk / 2), nblk / 2, rpb, 0}; moe_assign(lds, mp, bid, nblk); };
            auto fin = [&](int hf) { const int L = NRH / nblk, r0 = hf * NRH; final_rows((LAS float*)lds, in, modpart, rowsb, y2h1, 0, r0, r0 + bid * L, r0 + (bid + 1) * L); };
            if (ph == 10) assign(0);
            else if (ph == 11 || ph == 14) { GemmP g{u, u, Wgu, (long)2 * EF * D, list, D, 0}; GroupOrder S; S.init(tilepre, 2 * EF / BM, nblk, bid); gemm_phase<true>(lds, g, S, EpiGU{act}); }
            else if (ph == 12 || ph == 15) { GemmP g{act, act, Wdn, (long)D * EF, nullptr, EF, 0}; GroupOrder S; S.init(tilepre, D / BM, nblk, bid); gemm_phase(lds, g, S, EpiDown{sdst, sgate, rowsb}); }
            else if (ph == 13) { fin(0); __syncthreads(); assign(1); }
            else if (ph == 16) fin(1);
            (void)half; (void)st; }
    }
    if (13 >= ph_lo && 13 < ph_hi) { if (13 > ph_lo) xcd_barrier(xb); const int ph = 13; (void)ph;
        { const int q = ph - 10, half = q >= 4 ? 1 : 0, st = q - 4 * half;
            const int rpb = NLAT / nblk;
            auto assign = [&](int hf) { MoeP mp{tope, gatev, lrank, blkcnt, tilepre, list, sdst, sgate, hf * NRH, NRH, hf * (nblk / 2), nblk / 2, rpb, 0}; moe_assign(lds, mp, bid, nblk); };
            auto fin = [&](int hf) { const int L = NRH / nblk, r0 = hf * NRH; final_rows((LAS float*)lds, in, modpart, rowsb, y2h1, 0, r0, r0 + bid * L, r0 + (bid + 1) * L); };
            if (ph == 10) assign(0);
            else if (ph == 11 || ph == 14) { GemmP g{u, u, Wgu, (long)2 * EF * D, list, D, 0}; GroupOrder S; S.init(tilepre, 2 * EF / BM, nblk, bid); gemm_phase<true>(lds, g, S, EpiGU{act}); }
            else if (ph == 12 || ph == 15) { GemmP g{act, act, Wdn, (long)D * EF, nullptr, EF, 0}; GroupOrder S; S.init(tilepre, D / BM, nblk, bid); gemm_phase(lds, g, S, EpiDown{sdst, sgate, rowsb}); }
            else if (ph == 13) { fin(0); __syncthreads(); assign(1); }
            else if (ph == 16) fin(1);
            (void)half; (void)st; }
    }
    if (14 >= ph_lo && 14 < ph_hi) { if (14 > ph_lo) xcd_barrier(xb); const int ph = 14; (void)ph;
        { const int q = ph - 10, half = q >= 4 ? 1 : 0, st = q - 4 * half;
            const int rpb = NLAT / nblk;
            auto assign = [&](int hf) { MoeP mp{tope, gatev, lrank, blkcnt, tilepre, list, sdst, sgate, hf * NRH, NRH, hf * (nblk / 2), nblk / 2, rpb, 0}; moe_assign(lds, mp, bid, nblk); };
            auto fin = [&](int hf) { const int L = NRH / nblk, r0 = hf * NRH; final_rows((LAS float*)lds, in, modpart, rowsb, y2h1, 0, r0, r0 + bid * L, r0 + (bid + 1) * L); };
            if (ph == 10) assign(0);
            else if (ph == 11 || ph == 14) { GemmP g{u, u, Wgu, (long)2 * EF * D, list, D, 0}; GroupOrder S; S.init(tilepre, 2 * EF / BM, nblk, bid); gemm_phase<true>(lds, g, S, EpiGU{act}); }
            else if (ph == 12 || ph == 15) { GemmP g{act, act, Wdn, (long)D * EF, nullptr, EF, 0}; GroupOrder S; S.init(tilepre, D / BM, nblk, bid); gemm_phase(lds, g, S, EpiDown{sdst, sgate, rowsb}); }
            else if (ph == 13) { fin(0); __syncthreads(); assign(1); }
            else if (ph == 16) fin(1);
            (void)half; (void)st; }
    }
    if (15 >= ph_lo && 15 < ph_hi) { if (15 > ph_lo) xcd_barrier(xb); const int ph = 15; (void)ph;
        { const int q = ph - 10, half = q >= 4 ? 1 : 0, st = q - 4 * half;
            const int rpb = NLAT / nblk;
            auto assign = [&](int hf) { MoeP mp{tope, gatev, lrank, blkcnt, tilepre, list, sdst, sgate, hf * NRH, NRH, hf * (nblk / 2), nblk / 2, rpb, 0}; moe_assign(lds, mp, bid, nblk); };
            auto fin = [&](int hf) { const int L = NRH / nblk, r0 = hf * NRH; final_rows((LAS float*)lds, in, modpart, rowsb, y2h1, 0, r0, r0 + bid * L, r0 + (bid + 1) * L); };
            if (ph == 10) assign(0);
            else if (ph == 11 || ph == 14) { GemmP g{u, u, Wgu, (long)2 * EF * D, list, D, 0}; GroupOrder S; S.init(tilepre, 2 * EF / BM, nblk, bid); gemm_phase<true>(lds, g, S, EpiGU{act}); }
            else if (ph == 12 || ph == 15) { GemmP g{act, act, Wdn, (long)D * EF, nullptr, EF, 0}; GroupOrder S; S.init(tilepre, D / BM, nblk, bid); gemm_phase(lds, g, S, EpiDown{sdst, sgate, rowsb}); }
            else if (ph == 13) { fin(0); __syncthreads(); assign(1); }
            else if (ph == 16) fin(1);
            (void)half; (void)st; }
    }
    if (16 >= ph_lo && 16 < ph_hi) { if (16 > ph_lo) xcd_barrier(xb); const int ph = 16; (void)ph;
        { const int q = ph - 10, half = q >= 4 ? 1 : 0, st = q - 4 * half;
            const int rpb = NLAT / nblk;
            auto assign = [&](int hf) { MoeP mp{tope, gatev, lrank, blkcnt, tilepre, list, sdst, sgate, hf * NRH, NRH, hf * (nblk / 2), nblk / 2, rpb, 0}; moe_assign(lds, mp, bid, nblk); };
            auto fin = [&](int hf) { const int L = NRH / nblk, r0 = hf * NRH; final_rows((LAS float*)lds, in, modpart, rowsb, y2h1, 0, r0, r0 + bid * L, r0 + (bid + 1) * L); };
            if (ph == 10) assign(0);
            else if (ph == 11 || ph == 14) { GemmP g{u, u, Wgu, (long)2 * EF * D, list, D, 0}; GroupOrder S; S.init(tilepre, 2 * EF / BM, nblk, bid); gemm_phase<true>(lds, g, S, EpiGU{act}); }
            else if (ph == 12 || ph == 15) { GemmP g{act, act, Wdn, (long)D * EF, nullptr, EF, 0}; GroupOrder S; S.init(tilepre, D / BM, nblk, bid); gemm_phase(lds, g, S, EpiDown{sdst, sgate, rowsb}); }
            else if (ph == 13) { fin(0); __syncthreads(); assign(1); }
            else if (ph == 16) fin(1);
            (void)half; (void)st; }
    }
}
extern "C" void kernel_launch(void* const* d_in, const int* in_sizes, int n_in, void* d_out, int out_size, void* d_ws, size_t ws_size, hipStream_t stream) {
    static int grid = 0;
    if (grid == 0) {
        int dev = 0, cus = 0; hipGetDevice(&dev); hipDeviceGetAttribute(&cus, hipDeviceAttributeMultiprocessorCount, dev);
        hipFuncSetAttribute((const void*)mega, hipFuncAttributeMaxDynamicSharedMemorySize, LDS_BYTES);
        grid = cus;
        if (ws_size < O_END || grid != 256) fprintf(stderr, "kernel_launch: unexpected ws_size %zu (need %zu) or CU count %d\n", ws_size, (size_t)O_END, grid);
    }
    hipMemsetAsync((char*)d_ws + O_BAR, 0, XCD_BAR_WORDS * 4, stream);
    MP P; memset(&P, 0, sizeof(P));
    const float** f = (const float**)&P.in; for (int i = 0; i < 32; ++i) f[i] = (const float*)d_in[i];
    P.out = (float*)d_out; P.ws = (unsigned char*)d_ws;
#ifdef MK_PER_PHASE
    for (int ph = 0; ph < NPHASE; ++ph) { P.ph_lo = ph; P.ph_hi = ph + 1; hipLaunchKernelGGL(mega, dim3(grid), dim3(NT), LDS_BYTES, stream, P); }
#else
    P.ph_lo = 0; P.ph_hi = NPHASE;
    void* args[] = {&P};
    hipError_t e = hipLaunchCooperativeKernel((void*)mega, dim3(grid), dim3(NT), args, LDS_BYTES, stream);
    if (e != hipSuccess) fprintf(stderr, "cooperative launch failed: %s (grid %d)\n", hipGetErrorString(e), grid);
#endif
}
```

```cpp
#include <hip/hip_runtime.h>
#include <cstdio>
#include <cstring>
#define HD __host__ __device__ __forceinline__
static hipStream_t g_stream;

#ifdef SMALL
constexpr int D = 128, NB = 2, SEQ = 64, GW = 8, CTX = 16, RW = 128, RH = 64, DL = 16, AL = 16, GL = 24, LW = 128, LB = 2, NE = 8, TOPK = 3, NG = 4, TG = 2, EF = 32, SF = 32;
#else
constexpr int D = 1024, NB = 8, SEQ = 4096, GW = 64, CTX = 256, RW = 1024, RH = 64, DL = 64, AL = 64, GL = 160, LW = 1024, LB = 16, NE = 64, TOPK = 6, NG = 8, TG = 4, EF = 256, SF = 256;
#endif
constexpr int NH = RW / RH, LBS = LW / LB, ROWS = SEQ / GW, TA = CTX + SEQ;
constexpr int OFF_R = 0, OFF_K = RW, OFF_V = 2 * RW, OFF_WD = 3 * RW, OFF_AD = OFF_WD + 2 * DL, OFF_GD = OFF_AD + 2 * AL, RC = OFF_GD + GL;
constexpr int OFF_LX = RC, OFF_LG = OFF_LX + LW, OFF_GATE = OFF_LG + LW, INC = OFF_GATE + 2 * D;
constexpr int EPG = NE / NG, NASG = SEQ * TOPK;
#define NORM_EPS 1e-6f
#define LNX_EPS 64e-5f

HD float sigmoidf_(float x) { return 1.f / (1.f + expf(-x)); }
HD float softplusf_(float x) { return x > 20.f ? x : log1pf(expf(x)); }
HD float siluf_(float x) { return x * sigmoidf_(x); }
HD float gelu_tanhf_(float x) { return 0.5f * x * (1.f + tanhf(0.7978845608028654f * (x + 0.044715f * x * x * x))); }

struct In {
    const float *x, *c, *ctx, *c_ctx, *w_mod, *b_mod, *norm_g, *w_in, *shift_mu, *rw_w0, *rw_w_up, *rw_a0, *rw_a_up, *rw_g_up, *rw_k_k, *rw_k_a, *rw_r_k, *rw_lnx,
        *lru_conv_w, *lru_conv_b, *lru_gate_w, *lru_gate_b, *lru_l, *w_branch_a, *w_branch_b, *w_out, *router_w, *router_b, *ex_w_gu, *ex_w_down, *sh_w_gu, *sh_w_down;
};


namespace mk {
#define LAS __attribute__((address_space(3)))
typedef unsigned short bf16_t;
typedef short bf16x8 __attribute__((ext_vector_type(8)));
typedef float f32x4 __attribute__((ext_vector_type(4)));
typedef float f32x2 __attribute__((ext_vector_type(2)));
typedef unsigned u32x4 __attribute__((ext_vector_type(4)));
typedef unsigned u32x2 __attribute__((ext_vector_type(2)));
constexpr int NT = 512;
constexpr int BM = 256, BK = 64, HALF = 128, HTB = HALF * BK * 2, STAGE_BYTES = 8 * HTB;
constexpr int LDS_BYTES = 160 * 1024 - 1024;

constexpr int Z1_LX = 3584, Z1_N = 4608;
constexpr int ZC_N = 3072;

__device__ __forceinline__ unsigned cvt_pk_bf16(float lo, float hi) { unsigned r; asm volatile("v_cvt_pk_bf16_f32 %0, %1, %2" : "=v"(r) : "v"(lo), "v"(hi)); return r; }
__device__ __forceinline__ bf16_t f2bf(float f) { unsigned u = __float_as_uint(f); u += 0x7FFFu + ((u >> 16) & 1u); return (bf16_t)(u >> 16); }
__device__ __forceinline__ float bf2f(bf16_t b) { return __uint_as_float(((unsigned)b) << 16); }
__device__ __forceinline__ float bflo(unsigned w) { return __uint_as_float(w << 16); }
__device__ __forceinline__ float bfhi(unsigned w) { return __uint_as_float(w & 0xffff0000u); }

__device__ __forceinline__ float fast_rcp(float x) { return __builtin_amdgcn_rcpf(x); }
__device__ __forceinline__ float fast_sigmoid(float x) { return fast_rcp(1.f + __expf(-x)); }
__device__ __forceinline__ float fast_tanh(float x) { return 1.f - 2.f * fast_rcp(1.f + __expf(2.f * x)); }
__device__ __forceinline__ float fast_softplus(float x) { return x > 15.f ? x : __logf(1.f + __expf(x)); }
__device__ __forceinline__ float fast_silu(float x) { return x * fast_sigmoid(x); }
__device__ __forceinline__ float fast_gelu_tanh(float x) { return x * fast_sigmoid(1.5957691216057308f * (x + 0.044715f * x * x * x)); }
__device__ __forceinline__ int lds_byte(int r, int c) { const int st = (r >> 4) * 2 + (c >> 5), rr = r & 15, cc = c & 31, ob = rr * 64 + cc * 2; return st * 1024 + (ob ^ (((ob >> 9) & 1) << 5)); }
__device__ __forceinline__ void stage_rc(int b, int& R, int& C) { const int st = b / 1024, sb = b % 1024, swz = sb ^ (((sb >> 9) & 1) << 5); R = (st >> 1) * 16 + swz / 64; C = (st & 1) * 32 + (swz % 64) / 2; }
__device__ __forceinline__ int perm32(int rho) { const int n = rho >> 4, i = rho & 15; return 8 * (i >> 2) + 4 * n + (i & 3); }

struct Unit { int pm, pn, e; };
struct GemmP { const bf16_t* A0; const bf16_t* A1; const bf16_t* Bt; long strideB; const int* gather; int K; int pad_; };

struct StaticOrder {
    int nM, nN, nwg, G, c;
    __device__ void init(int M, int N, int G_, int c_) { nM = M / BM; nN = N / BM; nwg = nM * nN; G = G_; c = c_; }
    __device__ bool next(int i, Unit& u) const {
        const long L = (long)i * G + c; if (L >= nwg) return false;
        int wgid = (int)L; { const int q = nwg / 8, r = nwg % 8, xcd = wgid % 8, off = wgid / 8; wgid = (xcd < r ? xcd * (q + 1) : r * (q + 1) + (xcd - r) * q) + off; }
        const int nig = 8 * nN, gid = wgid / nig, fm = gid * 8, gsz = (nM - fm) < 8 ? (nM - fm) : 8;
        u.pm = fm + ((wgid % nig) % gsz); u.pn = (wgid % nig) / gsz; u.e = 0; return true;
    }
};

#define MK_FRAG_LOOP(ROW, COL) \
    _Pragma("unroll") for (int ai = 0; ai < 2; ++ai) _Pragma("unroll") for (int m = 0; m < 4; ++m) _Pragma("unroll") for (int bj = 0; bj < 2; ++bj) \
        if (const int ROW = ai * HALF + wr * 64 + m * 16 + fr; true) if (const int COL = bj * HALF + wc * 32 + 8 * fq; true)

template <bool GATHER = false, class Epi, class Sched>
__device__ __forceinline__ void gemm_phase(LAS unsigned char* lds, const GemmP g, const Sched& S, const Epi& E) {
    const int tid = threadIdx.x, wid = __builtin_amdgcn_readfirstlane(tid >> 6), lane = tid & 63, wr = wid >> 2, wc = wid & 3, fr = lane & 15, fq = lane >> 4;
    int K = g.K; asm volatile("" : "+s"(K));
    const int nt = K / BK;
    int RA[2], CA[2]; unsigned voffB[2];
#pragma unroll
    for (int i = 0; i < 2; ++i) { int R, C; stage_rc(tid * 16 + i * 8192, R, C); RA[i] = R; CA[i] = C; const int Rb = (R & ~31) + perm32(R & 31); voffB[i] = (unsigned)(Rb * K + C) * 2u; }
    const size_t kstep = (size_t)(BK * 2), hstepB = (size_t)HALF * K * 2, tstepB = 2 * hstepB;
    const unsigned ldsw = (unsigned)wid * 1024u;
    const int aoff = lds_byte(wr * 64 + fr, fq * 8), boff = lds_byte(wc * 32 + fr, fq * 8);
#define MK_SA(b, h) (((b) * 2 + (h)) * HTB)
#define MK_SB(b, h) ((4 + (b) * 2 + (h)) * HTB)
#define MK_STAGE(bufoff, gbase, voff) do { _Pragma("unroll") for (int _i = 0; _i < 2; ++_i) \
        __builtin_amdgcn_global_load_lds((const unsigned*)((const char*)(gbase) + (voff)[_i]), (LAS unsigned*)(lds + (bufoff) + ldsw + _i * 8192), 16, 0, 0); } while (0)
#define MK_LDA(dst, b, h) do { _Pragma("unroll") for (int m = 0; m < 4; ++m) _Pragma("unroll") for (int k = 0; k < 2; ++k) dst[m][k] = *(const LAS bf16x8*)(lds + MK_SA(b, h) + aoff + m * 2048 + k * 1024); } while (0)
#define MK_LDB(dst, b, h) do { _Pragma("unroll") for (int n = 0; n < 2; ++n) _Pragma("unroll") for (int k = 0; k < 2; ++k) dst[n][k] = *(const LAS bf16x8*)(lds + MK_SB(b, h) + boff + n * 2048 + k * 1024); } while (0)
#define MK_MMA(ai, bj, At, Bt) do { __builtin_amdgcn_s_setprio(1); _Pragma("unroll") for (int m = 0; m < 4; ++m) _Pragma("unroll") for (int n = 0; n < 2; ++n) _Pragma("unroll") for (int k = 0; k < 2; ++k) \
        acc[ai][bj][m][n] = __builtin_amdgcn_mfma_f32_16x16x32_bf16(Bt[n][k], At[m][k], acc[ai][bj][m][n], 0, 0, 0); __builtin_amdgcn_s_setprio(0); } while (0)
#define MK_WAIT_V(n) asm volatile("s_waitcnt vmcnt(" #n ")" ::: "memory")
#define MK_WAIT_L(n) asm volatile("s_waitcnt lgkmcnt(" #n ")" ::: "memory")
#define MK_BAR __builtin_amdgcn_s_barrier()
#define MK_SCHED __builtin_amdgcn_sched_barrier(0)
    Unit cur, nxt; int ui = 0;
    if (!S.next(0, cur)) return;
    f32x4 acc[2][2][4][2];
#pragma unroll
    for (int a = 0; a < 2; ++a)
#pragma unroll
        for (int b = 0; b < 2; ++b)
#pragma unroll
            for (int m = 0; m < 4; ++m)
#pragma unroll
                for (int n = 0; n < 2; ++n) acc[a][b][m][n] = (f32x4){0.f, 0.f, 0.f, 0.f};
    bf16x8 At[4][2], B0[2][2], B1[2][2];
    unsigned vA[2][2], vAn[2][2];
    const size_t hstepA = GATHER ? 0 : (size_t)HALF * K * 2, tstepA = 2 * (size_t)HALF * K * 2;
    auto a_voff = [&](const Unit& u, unsigned (&vo)[2][2]) {
#pragma unroll
        for (int h = 0; h < 2; ++h)
#pragma unroll
            for (int i = 0; i < 2; ++i) { if (GATHER) { const int row = u.pm * BM + h * HALF + RA[i]; vo[h][i] = (unsigned)((size_t)g.gather[row] * K + CA[i]) * 2u; } else vo[h][i] = (unsigned)(RA[i] * K + CA[i]) * 2u; }
    };
    a_voff(cur, vA);
    auto a_base = [&](const Unit& u) { return (const char*)(u.e ? g.A1 : g.A0) + (GATHER ? (size_t)0 : (size_t)u.pm * tstepA); };
    const char* cA = a_base(cur);
    const char* cB = (const char*)g.Bt + ((size_t)cur.e * g.strideB) * 2 + (size_t)cur.pn * tstepB;
    MK_STAGE(MK_SB(0, 0), cB, voffB); MK_STAGE(MK_SA(0, 0), cA, vA[0]); MK_STAGE(MK_SB(0, 1), cB + hstepB, voffB); MK_STAGE(MK_SA(0, 1), cA + hstepA, vA[1]);
    if (wr == 1) MK_BAR;
    MK_WAIT_V(4); MK_BAR;
    MK_STAGE(MK_SB(1, 0), cB + kstep, voffB); MK_STAGE(MK_SA(1, 0), cA + kstep, vA[0]); MK_STAGE(MK_SB(1, 1), cB + hstepB + kstep, voffB);
    MK_WAIT_V(6); MK_BAR;
    for (;;) {
        const bool has_next = S.next(ui + 1, nxt);
        const char* nA = has_next ? a_base(nxt) : cA;
        const char* nB = has_next ? (const char*)g.Bt + ((size_t)nxt.e * g.strideB) * 2 + (size_t)nxt.pn * tstepB : cB;
        for (int t = 0; t < nt; t += 2) {
            const bool last = (t == nt - 2);
            if (GATHER && last) { if (has_next) a_voff(nxt, vAn); else {
#pragma unroll
                for (int h = 0; h < 2; ++h)
#pragma unroll
                    for (int i = 0; i < 2; ++i) vAn[h][i] = vA[h][i]; } }
            const char* a1 = cA + (size_t)(t + 1) * kstep;
            const char* a2 = last ? nA : cA + (size_t)(t + 2) * kstep; const char* b2 = last ? nB : cB + (size_t)(t + 2) * kstep;
            const char* a3 = a2 + kstep; const char* b3 = b2 + kstep;
            unsigned v2[2][2];
#pragma unroll
            for (int h = 0; h < 2; ++h)
#pragma unroll
                for (int i = 0; i < 2; ++i) v2[h][i] = (GATHER && last) ? vAn[h][i] : vA[h][i];
            MK_LDB(B0, 0, 0); MK_SCHED; MK_LDA(At, 0, 0); MK_STAGE(MK_SA(1, 1), a1 + hstepA, vA[1]);
            MK_WAIT_L(8); MK_BAR; MK_WAIT_L(0); MK_MMA(0, 0, At, B0); MK_BAR; MK_SCHED;
            MK_LDB(B1, 0, 1); MK_STAGE(MK_SB(0, 0), b2, voffB);
            MK_BAR; MK_WAIT_L(0); MK_MMA(0, 1, At, B1); MK_BAR;
            MK_LDA(At, 0, 1); MK_STAGE(MK_SA(0, 0), a2, v2[0]);
            MK_BAR; MK_WAIT_L(0); MK_MMA(1, 0, At, B0); MK_BAR; MK_SCHED;
            MK_STAGE(MK_SB(0, 1), b2 + hstepB, voffB);
            MK_WAIT_V(6); MK_BAR; MK_MMA(1, 1, At, B1); MK_BAR;
            MK_LDB(B0, 1, 0); MK_SCHED; MK_LDA(At, 1, 0); MK_STAGE(MK_SA(0, 1), a2 + hstepA, v2[1]);
            MK_WAIT_L(8); MK_BAR; MK_WAIT_L(0); MK_MMA(0, 0, At, B0); MK_BAR; MK_SCHED;
            MK_LDB(B1, 1, 1); MK_STAGE(MK_SB(1, 0), b3, voffB);
            MK_BAR; MK_WAIT_L(0); MK_MMA(0, 1, At, B1); MK_BAR;
            MK_LDA(At, 1, 1); MK_STAGE(MK_SA(1, 0), a3, v2[0]);
            MK_BAR; MK_WAIT_L(0); MK_MMA(1, 0, At, B0); MK_BAR; MK_SCHED;
            MK_STAGE(MK_SB(1, 1), b3 + hstepB, voffB);
            MK_WAIT_V(6); MK_BAR; MK_MMA(1, 1, At, B1); MK_BAR;
        }
        int fr_ = fr, fq_ = fq; asm volatile("" : "+v"(fr_), "+v"(fq_));
        const bool keep = E(acc, cur, wr, wc, fr_, fq_);
        if (!has_next) break;
        if (!keep) {
#pragma unroll
            for (int a = 0; a < 2; ++a)
#pragma unroll
                for (int b = 0; b < 2; ++b)
#pragma unroll
                    for (int m = 0; m < 4; ++m)
#pragma unroll
                        for (int n = 0; n < 2; ++n) acc[a][b][m][n] = (f32x4){0.f, 0.f, 0.f, 0.f};
        }
        cur = nxt; cA = nA; cB = nB; ++ui;
        if (GATHER) {
#pragma unroll
            for (int h = 0; h < 2; ++h)
#pragma unroll
                for (int i = 0; i < 2; ++i) vA[h][i] = vAn[h][i]; }
    }
    MK_WAIT_V(0);
    if (wr == 0) MK_BAR;
    MK_BAR;
#undef MK_SA
#undef MK_SB
#undef MK_STAGE
#undef MK_LDA
#undef MK_LDB
#undef MK_MMA
#undef MK_WAIT_V
#undef MK_WAIT_L
#undef MK_BAR
#undef MK_SCHED
}

__device__ __forceinline__ u32x4 pack8(const f32x4 a, const f32x4 b) { u32x4 w; w.x = cvt_pk_bf16(a[0], a[1]); w.y = cvt_pk_bf16(a[2], a[3]); w.z = cvt_pk_bf16(b[0], b[1]); w.w = cvt_pk_bf16(b[2], b[3]); return w; }
struct EpiStoreBf16 {
    bf16_t* O; long ldc;
    __device__ __forceinline__ bool operator()(const f32x4 (&acc)[2][2][4][2], const Unit& u, int wr, int wc, int fr, int fq) const {
        MK_FRAG_LOOP(r, c) { *(u32x4*)(O + (size_t)(u.pm * BM + r) * ldc + u.pn * BM + c) = pack8(acc[ai][bj][m][0], acc[ai][bj][m][1]); }
        return false;
    }
};

struct CMapZ1 { __device__ int operator()(int n) const { return n < RC ? n : (n < Z1_LX ? -1 : OFF_LX + (n - Z1_LX)); } };
struct CMapZC { __device__ int operator()(int n) const { return OFF_LG + n; } };
struct CMapId { __device__ int operator()(int n) const { return n; } };
struct CMapGU { int F; __device__ int operator()(int n) const { return (n & 1) * F + (n >> 1); } };
template <class CM>
__device__ __forceinline__ void convT_tile(LAS float* tile  , const float* src, int lds_, int Ks, bf16_t* dst, int Kd, int n0, int k0, const CM& cm) {
    const int tid = threadIdx.x;
    { const int kk = tid >> 3, nn8 = (tid & 7) * 8; const int k = k0 + kk;
#pragma unroll
      for (int j = 0; j < 8; ++j) { const int sc = cm(n0 + nn8 + j); tile[kk * 65 + nn8 + j] = (k < Ks && sc >= 0) ? src[(size_t)k * lds_ + sc] : 0.f; } }
    __syncthreads();
    { const int nn = tid >> 3, kk8 = (tid & 7) * 8; f32x4 a, b;
#pragma unroll
      for (int j = 0; j < 4; ++j) { a[j] = tile[(kk8 + j) * 65 + nn]; b[j] = tile[(kk8 + 4 + j) * 65 + nn]; }
      *(u32x4*)(dst + (size_t)(n0 + nn) * Kd + k0 + kk8) = pack8(a, b); }
    __syncthreads();
}
template <class CM>
__device__ __forceinline__ void convT_job(LAS float* tile, const float* src, int lds_, int Ks, bf16_t* dst, int Kd, int N, const CM& cm, int bid, int nblk, int& base) {
    const int tn = N / 64, tk = Kd / 64, nt = tn * tk;
    int first = (bid - base % nblk + nblk) % nblk;
    for (int t = first; t < nt; t += nblk) convT_tile(tile, src, lds_, Ks, dst, Kd, (t / tk) * 64, (t % tk) * 64, cm);
    base += nt;
}

constexpr int MOD_SL = 16, MOD_KS = D / MOD_SL;
__device__ __forceinline__ void mod_partials(LAS float* sl  , const In& in, float* part  , int bid, int nblk) {
    const int ncc = 6 * D / NT, nitem = MOD_SL * ncc;
    for (int it = bid; it < nitem; it += nblk) {
        const int s = it / ncc, j = (it % ncc) * NT + threadIdx.x;
        for (int i = threadIdx.x; i < (NB + 1) * MOD_KS; i += NT) { const int r = i / MOD_KS, k = s * MOD_KS + i % MOD_KS; const float cv = r < NB ? in.c[r * D + k] : in.c_ctx[k]; sl[i] = siluf_(cv); }
        __syncthreads();
        float acc[NB + 1];
#pragma unroll
        for (int r = 0; r <= NB; ++r) acc[r] = 0.f;
        for (int k = 0; k < MOD_KS; ++k) { const float w = in.w_mod[(size_t)(s * MOD_KS + k) * 6 * D + j];
#pragma unroll
            for (int r = 0; r <= NB; ++r) acc[r] += sl[r * MOD_KS + k] * w; }
#pragma unroll
        for (int r = 0; r <= NB; ++r) part[((size_t)s * (NB + 1) + r) * 6 * D + j] = acc[r];
        __syncthreads();
    }
}
__device__ __forceinline__ float mod_value(const In& in, const float* part, int r, int j) {
    float s = in.b_mod[j];
#pragma unroll
    for (int q = 0; q < MOD_SL; ++q) s += part[((size_t)q * (NB + 1) + r) * 6 * D + j];
    return s;
}

__device__ __forceinline__ void xn_rows(LAS float* sm  , const In& in, const float* part, bf16_t* xn, int b0, int nb, int row_lo, int row_hi) {
    const int nlat = nb * SEQ, wid = threadIdx.x >> 6, lane = threadIdx.x & 63;
    int cur_mr = -1;
    float gp[16];
#pragma unroll
    for (int j = 0; j < 4; ++j)
#pragma unroll
        for (int q = 0; q < 4; ++q) gp[4 * j + q] = in.norm_g[j * 256 + lane * 4 + q];
    for (int rbase = row_lo; rbase < row_hi; rbase += 8) {
        const int mr = rbase < nlat ? b0 + rbase / SEQ : NB;
        if (mr != cur_mr) { __syncthreads(); for (int j = threadIdx.x; j < 2 * D; j += NT) sm[j] = mod_value(in, part, mr, j); __syncthreads(); cur_mr = mr; }
        const int r = rbase + wid; if (r >= row_hi) continue;
        const float* src = r < nlat ? in.x + ((size_t)b0 * SEQ + r) * D : in.ctx + ((size_t)b0 * CTX + (r - nlat)) * D;
        f32x4 v[4]; float ss = 0.f;
#pragma unroll
        for (int j = 0; j < 4; ++j) { v[j] = *(const f32x4*)(src + j * 256 + lane * 4); ss += v[j][0] * v[j][0] + v[j][1] * v[j][1] + v[j][2] * v[j][2] + v[j][3] * v[j][3]; }
#pragma unroll
        for (int o = 32; o > 0; o >>= 1) ss += __shfl_xor(ss, o);
        const float rinv = 1.f / sqrtf(ss * (1.f / D) + NORM_EPS);
#pragma unroll
        for (int j = 0; j < 4; ++j) { const int c = j * 256 + lane * 4; float o[4];
#pragma unroll
            for (int q = 0; q < 4; ++q) o[q] = (v[j][q] * rinv * gp[4 * j + q]) * (1.f + sm[D + c + q]) + sm[c + q];
            u32x2 w; w.x = cvt_pk_bf16(o[0], o[1]); w.y = cvt_pk_bf16(o[2], o[3]); *(u32x2*)(xn + (size_t)r * D + c) = w; }
    }
}
}

namespace mk {
#define XB_TMO      128
#define XB_XCNT(j)  (256  + 64 * (j))
#define XB_XSUB(j)  (1280 + 64 * (j))
#define XB_XGEN(j)  (2304 + 64 * (j))
#define XB_TOP      3328
#define XB_TOPGEN   3392
#define XCD_BAR_WORDS 3456
#define XB_SPIN_CAP (1u << 18)
__device__ __forceinline__ unsigned xb_ld(unsigned* p)              { return __hip_atomic_load(p, __ATOMIC_RELAXED, __HIP_MEMORY_SCOPE_AGENT); }
__device__ __forceinline__ unsigned xb_add(unsigned* p, unsigned v) { return __hip_atomic_fetch_add(p, v, __ATOMIC_RELAXED, __HIP_MEMORY_SCOPE_AGENT); }
__device__ __forceinline__ unsigned xb_xcc_id() { return (unsigned)__builtin_amdgcn_s_getreg((3 << 11) | 20) & 0xFu; }
#define XB_SPIN(cond, bar) do { unsigned _sp = 0; while (cond) { __builtin_amdgcn_s_sleep(1); \
    if ((++_sp & 255u) == 0u) { if (xb_ld(&(bar)[XB_TMO])) break; if (_sp > XB_SPIN_CAP) { atomicAdd(&(bar)[XB_TMO], 1u); break; } } } } while (0)
struct XcdBarrier { unsigned* bar; unsigned x; volatile LAS unsigned* st; };
__device__ __forceinline__ XcdBarrier xcd_barrier_post(unsigned* bar, volatile LAS unsigned* st) {
    XcdBarrier b; b.bar = bar; b.x = xb_xcc_id(); b.st = st;
    if (threadIdx.x == 0) (void)xb_add(&bar[XB_XCNT(b.x)], 1u);
    return b;
}
__device__ __forceinline__ void xcd_barrier_complete(unsigned* bar, unsigned x, unsigned& nloc, unsigned& nx) {
    const unsigned G = gridDim.x * gridDim.y * gridDim.z;
    unsigned sum, cnt, mine, sp = 0u;
    for (;;) {
        sum = 0u; cnt = 0u; mine = 0u;
#pragma unroll
        for (unsigned j = 0; j < 16; ++j) { const unsigned c = xb_ld(&bar[XB_XCNT(j)]); sum += c; cnt += (c > 0u) ? 1u : 0u; mine = (j == x) ? c : mine; }
        if (sum == G) break;
        __builtin_amdgcn_s_sleep(1);
        if ((++sp & 255u) == 0u) { if (xb_ld(&bar[XB_TMO])) break; if (sp > XB_SPIN_CAP) { atomicAdd(&bar[XB_TMO], 1u); break; } }
    }
    nloc = mine > 0u ? mine : 1u; nx = cnt > 0u ? cnt : 1u;
}
__device__ __forceinline__ void xcd_barrier(const XcdBarrier& b) {
    asm volatile("s_waitcnt vmcnt(0)" ::: "memory");
    __syncthreads();
    if (threadIdx.x == 0) {
        unsigned* bar = b.bar;
        __builtin_amdgcn_s_waitcnt(0);
        unsigned nloc = b.st[0], nx = b.st[1];
        if (nloc == 0u) { xcd_barrier_complete(bar, b.x, nloc, nx); b.st[0] = nloc; b.st[1] = nx; }
        const unsigned old = xb_add(&bar[XB_XSUB(b.x)], 1u);
        const unsigned gen = old / nloc;
        if (old + 1u == (gen + 1u) * nloc) {
            __builtin_amdgcn_fence(__ATOMIC_RELEASE, "agent");
            asm volatile("s_waitcnt vmcnt(0)" ::: "memory");
            const unsigned og = xb_add(&bar[XB_TOP], 1u);
            const unsigned tg = og / nx;
            if (og + 1u == (tg + 1u) * nx) xb_add(&bar[XB_TOPGEN], 1u);
            else XB_SPIN(xb_ld(&bar[XB_TOPGEN]) == tg, bar);
            __builtin_amdgcn_fence(__ATOMIC_ACQUIRE, "agent");
            xb_add(&bar[XB_XGEN(b.x)], 1u);
            asm volatile("s_waitcnt vmcnt(0)" ::: "memory");
        } else {
            XB_SPIN(xb_ld(&bar[XB_XGEN(b.x)]) == gen, bar);
            __builtin_amdgcn_fence(__ATOMIC_ACQUIRE, "agent");
            asm volatile("s_waitcnt vmcnt(0)" ::: "memory");
        }
    }
    __syncthreads();
}
}

namespace mk {
constexpr int TB = 32;
constexpr int RAWW = 320;
constexpr int RW_RAW = 0;
constexpr int RW_MU = RW_RAW + (TB + 2) * RAWW * 2;
constexpr int RW_WUP = RW_MU + 2 * RAWW * 4;
constexpr int RW_AUP = RW_WUP + 64 * 72 * 2;
constexpr int RW_CST = RW_AUP + 64 * 72 * 2;
constexpr int RW_AWD = RW_CST + 5 * 64 * 4;
constexpr int RW_AAD = RW_AWD + TB * 72 * 2;
constexpr int RW_R = RW_AAD + TB * 72 * 2;
constexpr int RW_KR = RW_R + TB * 64 * 4;
constexpr int RW_LA = RW_KR + TB * 64 * 4;
constexpr int RW_KK = RW_LA + TB * 64 * 4;
constexpr int RW_W = RW_KK + TB * 64 * 4;
constexpr int RW_B = RW_W + TB * 64 * 4;
constexpr int RW_KD = RW_B + TB * 64 * 4;
constexpr int RW_WR = RW_KD + TB * 64 * 4;
constexpr int RW_V = RW_WR + TB * 64 * 4;
constexpr int RW_SC = RW_V + TB * 64 * 4;
constexpr int RW_YO = RW_SC + TB * 2 * 4;
constexpr int RW_BON = RW_YO + TB * 64 * 4;
constexpr int RW_END = RW_BON + TB * 4;
static_assert(RW_END <= LDS_BYTES, "rwkv LDS");

#define MK_DPP(x, ctrl) __int_as_float(__builtin_amdgcn_update_dpp(__float_as_int(x), __float_as_int(x), ctrl, 0xF, 0xF, false))
__device__ __forceinline__ float allreduce16(float x) {
    x += MK_DPP(x, 0xB1); x += MK_DPP(x, 0x4E); x += MK_DPP(x, 0x141); x += MK_DPP(x, 0x140); return x;
}

__device__ __forceinline__ void allreduce16x4(float& a, float& b, float& c, float& d) {
    asm volatile("s_nop 1\n\t"
        "v_add_f32_dpp %0, %0, %0 quad_perm:[1,0,3,2] row_mask:0xf bank_mask:0xf\n\t" "v_add_f32_dpp %1, %1, %1 quad_perm:[1,0,3,2] row_mask:0xf bank_mask:0xf\n\t"
        "v_add_f32_dpp %2, %2, %2 quad_perm:[1,0,3,2] row_mask:0xf bank_mask:0xf\n\t" "v_add_f32_dpp %3, %3, %3 quad_perm:[1,0,3,2] row_mask:0xf bank_mask:0xf\n\t"
        "v_add_f32_dpp %0, %0, %0 quad_perm:[2,3,0,1] row_mask:0xf bank_mask:0xf\n\t" "v_add_f32_dpp %1, %1, %1 quad_perm:[2,3,0,1] row_mask:0xf bank_mask:0xf\n\t"
        "v_add_f32_dpp %2, %2, %2 quad_perm:[2,3,0,1] row_mask:0xf bank_mask:0xf\n\t" "v_add_f32_dpp %3, %3, %3 quad_perm:[2,3,0,1] row_mask:0xf bank_mask:0xf\n\t"
        "v_add_f32_dpp %0, %0, %0 row_half_mirror row_mask:0xf bank_mask:0xf\n\t" "v_add_f32_dpp %1, %1, %1 row_half_mirror row_mask:0xf bank_mask:0xf\n\t"
        "v_add_f32_dpp %2, %2, %2 row_half_mirror row_mask:0xf bank_mask:0xf\n\t" "v_add_f32_dpp %3, %3, %3 row_half_mirror row_mask:0xf bank_mask:0xf\n\t"
        "v_add_f32_dpp %0, %0, %0 row_mirror row_mask:0xf bank_mask:0xf\n\t" "v_add_f32_dpp %1, %1, %1 row_mirror row_mask:0xf bank_mask:0xf\n\t"
        "v_add_f32_dpp %2, %2, %2 row_mirror row_mask:0xf bank_mask:0xf\n\t" "v_add_f32_dpp %3, %3, %3 row_mirror row_mask:0xf bank_mask:0xf"
        : "+v"(a), "+v"(b), "+v"(c), "+v"(d));
}
struct RwkvP { const bf16_t* z1; bf16_t* Y; float* bon; int b0, nb; };

constexpr int RW_NPIECE = (TB + 2) * 40, RW_PPT = (RW_NPIECE + NT - 1) / NT;

__device__ __forceinline__ void rwkv_chain(LAS unsigned char* lds, const In& in, const RwkvP p, int chain) {
    const int tid = threadIdx.x, lane = tid & 63, wid = tid >> 6;
    const int d = chain / (p.nb * NH), bl = (chain / NH) % p.nb, h = chain % NH;
    const int nlat = p.nb * SEQ;
    LAS bf16_t* RAW = (LAS bf16_t*)(lds + RW_RAW); LAS float* MU = (LAS float*)(lds + RW_MU);
    LAS bf16_t* WUP = (LAS bf16_t*)(lds + RW_WUP); LAS bf16_t* AUP = (LAS bf16_t*)(lds + RW_AUP); LAS float* CST = (LAS float*)(lds + RW_CST);
    LAS bf16_t* AWD = (LAS bf16_t*)(lds + RW_AWD); LAS bf16_t* AAD = (LAS bf16_t*)(lds + RW_AAD);
    LAS float *Rr = (LAS float*)(lds + RW_R), *KR = (LAS float*)(lds + RW_KR), *LA_ = (LAS float*)(lds + RW_LA);
    LAS float *KK = (LAS float*)(lds + RW_KK), *Wv = (LAS float*)(lds + RW_W), *Bv = (LAS float*)(lds + RW_B), *KD = (LAS float*)(lds + RW_KD), *WR = (LAS float*)(lds + RW_WR), *Vv = (LAS float*)(lds + RW_V);
    LAS float *SC = (LAS float*)(lds + RW_SC), *YO = (LAS float*)(lds + RW_YO), *BON = (LAS float*)(lds + RW_BON);
    auto segcol = [&](int s) { return s < 3 ? s * RW + h * 64 : (s == 3 ? OFF_WD + d * DL : OFF_AD + d * AL); };
    for (int i = tid; i < 2 * RAWW; i += NT) { const int m = i / RAWW, c = i % RAWW; MU[i] = in.shift_mu[m * RC + segcol(c >> 6) + (c & 63)]; }
    for (int i = tid; i < 64 * 64; i += NT) { const int j = i >> 6, c = i & 63;
        WUP[c * 72 + j] = f2bf(in.rw_w_up[((size_t)d * DL + j) * RW + h * 64 + c]); AUP[c * 72 + j] = f2bf(in.rw_a_up[((size_t)d * AL + j) * RW + h * 64 + c]); }
    for (int i = tid; i < 64; i += NT) { CST[i] = in.rw_w0[d * RW + h * 64 + i]; CST[64 + i] = in.rw_a0[d * RW + h * 64 + i]; CST[128 + i] = in.rw_k_k[h * 64 + i]; CST[192 + i] = in.rw_k_a[h * 64 + i]; CST[256 + i] = in.rw_r_k[h * 64 + i]; }
    constexpr int NQ = (CTX + SEQ) / TB, NQC = CTX / TB;
    auto blk_info = [&](int q, bool& isctx, int& t0, bool& hp, bool& hn, size_t& grow0) {
        isctx = q < NQC;
        if (isctx) { const int qq = d == 0 ? q : NQC - 1 - q; t0 = qq * TB; hp = t0 > 0; hn = t0 + TB < CTX; grow0 = (size_t)nlat + (size_t)bl * CTX + t0; }
        else { const int ql = q - NQC, qq = d == 0 ? ql : SEQ / TB - 1 - ql; t0 = qq * TB; hp = (t0 % GW) != 0; hn = ((t0 + TB) % GW) != 0; grow0 = (size_t)bl * SEQ + t0; }
    };
    u32x4 pre[RW_PPT];
    auto prefetch = [&](int q) {
        bool isctx, hp, hn; int t0; size_t grow0; blk_info(q, isctx, t0, hp, hn, grow0);
#pragma unroll
        for (int k = 0; k < RW_PPT; ++k) { const int i = tid + k * NT; u32x4 v = (u32x4){0u, 0u, 0u, 0u};
            if (i < RW_NPIECE) { const int rr = i / 40, sp = i % 40, seg = sp >> 3, part = sp & 7;
                const bool ok = (rr == 0) ? hp : ((rr == TB + 1) ? hn : true);
                if (ok) v = *(const u32x4*)(p.z1 + (grow0 + rr - 1) * Z1_N + segcol(seg) + part * 8); }
            pre[k] = v; }
    };
    auto commit = [&]() {
#pragma unroll
        for (int k = 0; k < RW_PPT; ++k) { const int i = tid + k * NT; if (i < RW_NPIECE) { const int rr = i / 40, sp = i % 40; *(LAS u32x4*)(RAW + rr * RAWW + sp * 8) = pre[k]; } }
    };
    float S[2][4];
#pragma unroll
    for (int i = 0; i < 2; ++i)
#pragma unroll
        for (int j = 0; j < 4; ++j) S[i][j] = 0.f;
    const int kg = lane & 15, rp = (lane >> 4) + 4 * wid;
    prefetch(0);
    for (int q = 0; q < NQ; ++q) {
        bool isctx, hp, hn; int t0; size_t grow0; blk_info(q, isctx, t0, hp, hn, grow0);
        commit();
        __syncthreads();
        if (q + 1 < NQ) prefetch(q + 1);
        auto shift8 = [&](int t, int c0, float (&s)[8]) {
            const u32x4 xp = *(const LAS u32x4*)(RAW + t * RAWW + c0), xc = *(const LAS u32x4*)(RAW + (t + 1) * RAWW + c0), xn_ = *(const LAS u32x4*)(RAW + (t + 2) * RAWW + c0);
            const f32x4 m0a = *(const LAS f32x4*)(MU + c0), m0b = *(const LAS f32x4*)(MU + c0 + 4), m1a = *(const LAS f32x4*)(MU + RAWW + c0), m1b = *(const LAS f32x4*)(MU + RAWW + c0 + 4);
#pragma unroll
            for (int j = 0; j < 4; ++j) { const unsigned a = xp[j], b = xc[j], c = xn_[j];
                const float mu0l = j < 2 ? m0a[2 * j] : m0b[2 * j - 4], mu0h = j < 2 ? m0a[2 * j + 1] : m0b[2 * j - 3], mu1l = j < 2 ? m1a[2 * j] : m1b[2 * j - 4], mu1h = j < 2 ? m1a[2 * j + 1] : m1b[2 * j - 3];
                { const float x = bflo(b); s[2 * j] = x + mu0l * (bflo(a) - x) + mu1l * (bflo(c) - x); }
                { const float x = bfhi(b); s[2 * j + 1] = x + mu0h * (bfhi(a) - x) + mu1h * (bfhi(c) - x); } } };
        for (int it = tid; it < TB * 24; it += NT) {
            const int t = it / 24, g = it % 24, seg = g >> 3, cc = (g & 7) * 8; float s[8]; shift8(t, g * 8, s);
            LAS float* dst = (seg == 0 ? Rr : (seg == 1 ? KR : Vv)) + t * 64 + cc; *(LAS f32x4*)dst = (f32x4){s[0], s[1], s[2], s[3]}; *(LAS f32x4*)(dst + 4) = (f32x4){s[4], s[5], s[6], s[7]};
        }
        { const int t = tid >> 4, g = 24 + (tid & 15), cc = (g & 7) * 8; float s[8]; shift8(t, g * 8, s);
          const bool isw = (tid & 15) < 8;
#pragma unroll
          for (int j = 0; j < 8; ++j) { const float th = fast_tanh(s[j]); s[j] = isw ? th : s[j]; }
          LAS bf16_t* dst = (isw ? AWD : AAD) + t * 72 + cc;
          u32x4 w; w.x = cvt_pk_bf16(s[0], s[1]); w.y = cvt_pk_bf16(s[2], s[3]); w.z = cvt_pk_bf16(s[4], s[5]); w.w = cvt_pk_bf16(s[6], s[7]); *(LAS u32x4*)dst = w; }
        __syncthreads();
        {
            const int lora = wid >> 2, ct = wid & 3, fr = lane & 15, fq = lane >> 4;
            const LAS bf16_t* Am = lora ? AAD : AWD; const LAS bf16_t* Bm = lora ? AUP : WUP;
#pragma unroll
            for (int rt = 0; rt < 2; ++rt) {
                f32x4 acc = (f32x4){0.f, 0.f, 0.f, 0.f};
#pragma unroll
                for (int ks = 0; ks < 2; ++ks) {
                    const bf16x8 a = *(const LAS bf16x8*)(Am + (rt * 16 + fr) * 72 + ks * 32 + fq * 8);
                    const bf16x8 b = *(const LAS bf16x8*)(Bm + (ct * 16 + fr) * 72 + ks * 32 + fq * 8);
                    acc = __builtin_amdgcn_mfma_f32_16x16x32_bf16(a, b, acc, 0, 0, 0);
                }
                const int col = ct * 16 + fr;
#pragma unroll
                for (int i = 0; i < 4; ++i) { const int t = rt * 16 + fq * 4 + i;
                    if (lora == 0) { const float lw = acc[i] + CST[col]; const float wl = -fast_softplus(-lw) - 0.5f; Wv[t * 64 + col] = __expf(-__expf(wl)); }
                    else { LA_[t * 64 + col] = fast_sigmoid(acc[i] + CST[64 + col]); } }
            }
        }
        __syncthreads();
        {
            const int t = tid >> 4, c4 = (tid & 15) * 4;
            const f32x4 k = *(const LAS f32x4*)(KR + t * 64 + c4), a = *(const LAS f32x4*)(LA_ + t * 64 + c4), w = *(const LAS f32x4*)(Wv + t * 64 + c4), r = *(const LAS f32x4*)(Rr + t * 64 + c4);
            f32x4 kkr, kd, bb, wr; float ss = 0.f, br = 0.f, kr = 0.f, bn = 0.f;
#pragma unroll
            for (int j = 0; j < 4; ++j) { kkr[j] = k[j] * CST[128 + c4 + j]; ss += kkr[j] * kkr[j]; }
            ss = allreduce16(ss);
            const float inv = 1.f / fmaxf(sqrtf(ss), 1e-12f);
#pragma unroll
            for (int j = 0; j < 4; ++j) { const float kk = kkr[j] * inv; kkr[j] = kk; kd[j] = k[j] * (1.f + (a[j] - 1.f) * CST[192 + c4 + j]); bb[j] = kk * a[j]; wr[j] = w[j] * r[j];
                br += bb[j] * r[j]; kr += kd[j] * r[j]; bn += r[j] * kd[j] * CST[256 + c4 + j]; }
            br = allreduce16(br); kr = allreduce16(kr); bn = allreduce16(bn);
            *(LAS f32x4*)(KK + t * 64 + c4) = kkr; *(LAS f32x4*)(KD + t * 64 + c4) = kd; *(LAS f32x4*)(Bv + t * 64 + c4) = bb; *(LAS f32x4*)(WR + t * 64 + c4) = wr;
            if ((tid & 15) == 0) { SC[t * 2] = br; SC[t * 2 + 1] = kr; BON[t] = bn; }
        }
        __syncthreads();
        {
            auto tof = [&](int st) { return d == 0 ? st : TB - 1 - st; };
            const LAS float* lb = KK + 4 * kg;
            const LAS float* vb = Vv + 2 * rp;
            constexpr int OW = (RW_W - RW_KK) / 4, OB = (RW_B - RW_KK) / 4, OKD = (RW_KD - RW_KK) / 4, OWR = (RW_WR - RW_KK) / 4;
            int t = tof(0);
            f32x4 kk4 = *(const LAS f32x4*)(lb + t * 64), w4 = *(const LAS f32x4*)(lb + t * 64 + OW), b4 = *(const LAS f32x4*)(lb + t * 64 + OB),
                  kd4 = *(const LAS f32x4*)(lb + t * 64 + OKD), wr4 = *(const LAS f32x4*)(lb + t * 64 + OWR);
            f32x2 vv = *(const LAS f32x2*)(vb + t * 64), sc = *(const LAS f32x2*)(SC + t * 2);
            f32x2 S2[4];
#pragma unroll
            for (int j = 0; j < 4; ++j) { S2[j][0] = S[0][j]; S2[j][1] = S[1][j]; }
#pragma unroll 2
            for (int st = 0; st < TB; ++st) {
                const int tn = tof(st + 1 < TB ? st + 1 : st);
                const f32x4 nkk4 = *(const LAS f32x4*)(lb + tn * 64), nw4 = *(const LAS f32x4*)(lb + tn * 64 + OW), nb4 = *(const LAS f32x4*)(lb + tn * 64 + OB),
                            nkd4 = *(const LAS f32x4*)(lb + tn * 64 + OKD), nwr4 = *(const LAS f32x4*)(lb + tn * 64 + OWR);
                const f32x2 nvv = *(const LAS f32x2*)(vb + tn * 64), nsc = *(const LAS f32x2*)(SC + tn * 2);
                f32x2 sa2 = S2[0] * kk4[0], yo2 = S2[0] * wr4[0];
#pragma unroll
                for (int j = 1; j < 4; ++j) { sa2 += S2[j] * kk4[j]; yo2 += S2[j] * wr4[j]; }
                float sa0 = sa2[0], sa1 = sa2[1], yo0 = yo2[0], yo1 = yo2[1];
                allreduce16x4(sa0, sa1, yo0, yo1);
                f32x2 sar; sar[0] = sa0; sar[1] = sa1;
#pragma unroll
                for (int j = 0; j < 4; ++j) S2[j] = S2[j] * w4[j] + (vv * kd4[j] - sar * b4[j]);
                if (kg == 0) { f32x2 yor; yor[0] = yo0; yor[1] = yo1; const f32x2 y = yor - sar * sc[0] + vv * sc[1]; *(LAS f32x2*)(YO + t * 64 + 2 * rp) = y; }
                kk4 = nkk4; w4 = nw4; b4 = nb4; kd4 = nkd4; wr4 = nwr4; vv = nvv; sc = nsc; t = tn;
            }
#pragma unroll
            for (int j = 0; j < 4; ++j) { S[0][j] = S2[j][0]; S[1][j] = S2[j][1]; }
        }
        __syncthreads();
        if (!isctx) {
            const int t = tid >> 4, c4 = (tid & 15) * 4; const f32x4 y = *(const LAS f32x4*)(YO + t * 64 + c4);
            u32x2 w; w.x = cvt_pk_bf16(y[0], y[1]); w.y = cvt_pk_bf16(y[2], y[3]);
            *(u32x2*)(p.Y + ((size_t)d * nlat + grow0 + t) * RW + h * 64 + c4) = w;
            if (tid < TB) p.bon[((size_t)d * nlat + grow0 + tid) * NH + h] = BON[tid];
        }
    }
}
__device__ __forceinline__ void rwkv_phase(LAS unsigned char* lds, const In& in, const RwkvP p, int bid, int nblk) {
    const int nchain = 2 * p.nb * NH;
    for (int c = bid; c < nchain; c += nblk) { rwkv_chain(lds, in, p, c); __syncthreads(); }
}
}

namespace mk {
constexpr int C2_RAW = 0;
constexpr int C2_MU = C2_RAW + (TB + 2) * RAWW * 2;
constexpr int C2_WUP = C2_MU + 2 * RAWW * 4;
constexpr int C2_AUP = C2_WUP + 64 * 72 * 2;
constexpr int C2_CST = C2_AUP + 64 * 72 * 2;
constexpr int C2_AWD = C2_CST + 5 * 64 * 4;
constexpr int C2_AAD = C2_AWD + TB * 72 * 2;
constexpr int C2_X = C2_AAD + TB * 72 * 2;
constexpr int C2_R = C2_X, C2_KR = C2_R + TB * 64 * 4, C2_V = C2_KR + TB * 64 * 4, C2_E = C2_V + TB * 64 * 4, C2_LA = C2_E + TB * 64 * 4, C2_CUM = C2_LA + TB * 64 * 4, C2_X_END = C2_CUM + TB * 64 * 4;
constexpr int C2_YO = C2_X;
constexpr int C2_G = C2_YO + TB * 64 * 4;
constexpr int C2_UB = C2_G + 64 * 36 * 4;
constexpr int C2_ABT = C2_UB + 64 * 40 * 2;
constexpr int C2_AKT = C2_ABT + 32 * 32 * 4;
constexpr int C2_NBT = C2_AKT + 32 * 40 * 2;
constexpr int C2_NKT = C2_NBT + 32 * 40 * 2;
static_assert(C2_NKT + 32 * 40 * 2 <= C2_X_END, "region X reuse");
constexpr int C2_KKS = C2_X_END;
constexpr int C2_BS = C2_KKS + TB * 72 * 2, C2_KDS = C2_BS + TB * 72 * 2, C2_RS = C2_KDS + TB * 72 * 2;
constexpr int C2_BST = C2_RS + TB * 72 * 2;
constexpr int C2_KDST = C2_BST + 64 * 40 * 2;
constexpr int C2_VT = C2_KDST + 64 * 40 * 2;
constexpr int C2_S0B = C2_VT + 64 * 40 * 2;
constexpr int C2_GC = C2_S0B + 64 * 72 * 2;
constexpr int C2_BON = C2_GC + 64 * 4;
constexpr int C2_END = C2_BON + TB * 4;
static_assert(C2_END <= LDS_BYTES - 16 && (C2_X % 16) == 0 && (C2_KKS % 16) == 0 && (C2_G % 16) == 0 && (C2_UB % 16) == 0 && (C2_ABT % 16) == 0 && (C2_AKT % 16) == 0 && (C2_S0B % 16) == 0, "rwkv2 LDS");

__device__ __forceinline__ bf16x8 ldsb8(const LAS bf16_t* p) { return *(const LAS bf16x8*)p; }

template <int MODE>
__device__ __forceinline__ void rwkv_chain2(LAS unsigned char* lds, const In& in, const RwkvP p, int chain) {
    const int tid = threadIdx.x, lane = tid & 63, wid = tid >> 6, fr = lane & 15, fq = lane >> 4;
    const int d = chain / (p.nb * NH), bl = (chain / NH) % p.nb, h = chain % NH;
    const int nlat = p.nb * SEQ;
    LAS bf16_t* RAW = (LAS bf16_t*)(lds + C2_RAW); LAS float* MU = (LAS float*)(lds + C2_MU);
    LAS bf16_t* WUP = (LAS bf16_t*)(lds + C2_WUP); LAS bf16_t* AUP = (LAS bf16_t*)(lds + C2_AUP); LAS float* CST = (LAS float*)(lds + C2_CST);
    LAS bf16_t* AWD = (LAS bf16_t*)(lds + C2_AWD); LAS bf16_t* AAD = (LAS bf16_t*)(lds + C2_AAD);
    LAS float *Rr = (LAS float*)(lds + C2_R), *KR = (LAS float*)(lds + C2_KR), *Vv = (LAS float*)(lds + C2_V), *Ee = (LAS float*)(lds + C2_E), *LA_ = (LAS float*)(lds + C2_LA), *CUM = (LAS float*)(lds + C2_CUM);
    LAS float *YO = (LAS float*)(lds + C2_YO), *Gm = (LAS float*)(lds + C2_G), *ABT = (LAS float*)(lds + C2_ABT), *GC = (LAS float*)(lds + C2_GC), *BON = (LAS float*)(lds + C2_BON);
    LAS bf16_t *UB = (LAS bf16_t*)(lds + C2_UB), *AKT = (LAS bf16_t*)(lds + C2_AKT), *NBT = (LAS bf16_t*)(lds + C2_NBT), *NKT = (LAS bf16_t*)(lds + C2_NKT);
    LAS bf16_t *KKS = (LAS bf16_t*)(lds + C2_KKS), *BS = (LAS bf16_t*)(lds + C2_BS), *KDS = (LAS bf16_t*)(lds + C2_KDS), *RS = (LAS bf16_t*)(lds + C2_RS);
    LAS bf16_t *BST = (LAS bf16_t*)(lds + C2_BST), *KDST = (LAS bf16_t*)(lds + C2_KDST), *VT = (LAS bf16_t*)(lds + C2_VT), *S0B = (LAS bf16_t*)(lds + C2_S0B);
    auto segcol = [&](int s) { return s < 3 ? s * RW + h * 64 : (s == 3 ? OFF_WD + d * DL : OFF_AD + d * AL); };
    for (int i = tid; i < 2 * RAWW; i += NT) { const int m = i / RAWW, c = i % RAWW; MU[i] = in.shift_mu[m * RC + segcol(c >> 6) + (c & 63)]; }
    for (int i = tid; i < 64 * 64; i += NT) { const int j = i >> 6, c = i & 63;
        WUP[c * 72 + j] = f2bf(in.rw_w_up[((size_t)d * DL + j) * RW + h * 64 + c]); AUP[c * 72 + j] = f2bf(in.rw_a_up[((size_t)d * AL + j) * RW + h * 64 + c]); }
    for (int i = tid; i < 64; i += NT) { CST[i] = in.rw_w0[d * RW + h * 64 + i]; CST[64 + i] = in.rw_a0[d * RW + h * 64 + i]; CST[128 + i] = in.rw_k_k[h * 64 + i]; CST[192 + i] = in.rw_k_a[h * 64 + i]; CST[256 + i] = in.rw_r_k[h * 64 + i]; }
    for (int i = tid; i < 64 * 72 / 2; i += NT) ((LAS unsigned*)S0B)[i] = 0u;
    constexpr int NQ = (CTX + SEQ) / TB, NQC = CTX / TB;
    auto blk_info = [&](int q, bool& isctx, int& t0, bool& hp, bool& hn, size_t& grow0) {
        isctx = q < NQC;
        if (isctx) { const int qq = d == 0 ? q : NQC - 1 - q; t0 = qq * TB; hp = t0 > 0; hn = t0 + TB < CTX; grow0 = (size_t)nlat + (size_t)bl * CTX + t0; }
        else { const int ql = q - NQC, qq = d == 0 ? ql : SEQ / TB - 1 - ql; t0 = qq * TB; hp = (t0 % GW) != 0; hn = ((t0 + TB) % GW) != 0; grow0 = (size_t)bl * SEQ + t0; }
    };
    u32x4 pre[RW_PPT];
    auto prefetch = [&](int q) {
        bool isctx, hp, hn; int t0; size_t grow0; blk_info(q, isctx, t0, hp, hn, grow0);
#pragma unroll
        for (int k = 0; k < RW_PPT; ++k) { const int i = tid + k * NT; u32x4 v = (u32x4){0u, 0u, 0u, 0u};
            if (i < RW_NPIECE) { const int rr = i / 40, sp = i % 40, seg = sp >> 3, part = sp & 7;
                const bool ok = (rr == 0) ? hp : ((rr == TB + 1) ? hn : true);
                if (ok) v = *(const u32x4*)(p.z1 + (grow0 + rr - 1) * Z1_N + segcol(seg) + part * 8); }
            pre[k] = v; }
    };
    auto commit = [&]() {
#pragma unroll
        for (int k = 0; k < RW_PPT; ++k) { const int i = tid + k * NT; if (i < RW_NPIECE) { const int rr = i / 40, sp = i % 40; *(LAS u32x4*)(RAW + rr * RAWW + sp * 8) = pre[k]; } }
    };
    f32x4 Sreg[2];
    Sreg[0] = (f32x4){0.f, 0.f, 0.f, 0.f}; Sreg[1] = Sreg[0];
    const int rt = wid >> 1;
    prefetch(0);
    for (int q = 0; q < NQ; ++q) {
        bool isctx, hp, hn; int t0; size_t grow0; blk_info(q, isctx, t0, hp, hn, grow0);
        commit();
        __syncthreads();
        if (q + 1 < NQ) prefetch(q + 1);
        auto shift8 = [&](int t, int c0, float (&s)[8]) {
            const u32x4 xp = *(const LAS u32x4*)(RAW + t * RAWW + c0), xc = *(const LAS u32x4*)(RAW + (t + 1) * RAWW + c0), xn_ = *(const LAS u32x4*)(RAW + (t + 2) * RAWW + c0);
            const f32x4 m0a = *(const LAS f32x4*)(MU + c0), m0b = *(const LAS f32x4*)(MU + c0 + 4), m1a = *(const LAS f32x4*)(MU + RAWW + c0), m1b = *(const LAS f32x4*)(MU + RAWW + c0 + 4);
#pragma unroll
            for (int j = 0; j < 4; ++j) { const unsigned a = xp[j], b = xc[j], c = xn_[j];
                const float mu0l = j < 2 ? m0a[2 * j] : m0b[2 * j - 4], mu0h = j < 2 ? m0a[2 * j + 1] : m0b[2 * j - 3], mu1l = j < 2 ? m1a[2 * j] : m1b[2 * j - 4], mu1h = j < 2 ? m1a[2 * j + 1] : m1b[2 * j - 3];
                { const float x = bflo(b); s[2 * j] = x + mu0l * (bflo(a) - x) + mu1l * (bflo(c) - x); }
                { const float x = bfhi(b); s[2 * j + 1] = x + mu0h * (bfhi(a) - x) + mu1h * (bfhi(c) - x); } } };
        for (int it = tid; it < TB * 24; it += NT) {
            const int t = it / 24, g = it % 24, seg = g >> 3, cc = (g & 7) * 8, js = d == 0 ? t : TB - 1 - t; float s[8]; shift8(t, g * 8, s);
            LAS float* dst = (seg == 0 ? Rr : (seg == 1 ? KR : Vv)) + js * 64 + cc; *(LAS f32x4*)dst = (f32x4){s[0], s[1], s[2], s[3]}; *(LAS f32x4*)(dst + 4) = (f32x4){s[4], s[5], s[6], s[7]};
        }
        { const int t = tid >> 4, g = 24 + (tid & 15), cc = (g & 7) * 8, js = d == 0 ? t : TB - 1 - t; float s[8]; shift8(t, g * 8, s);
          const bool isw = (tid & 15) < 8;
#pragma unroll
          for (int j = 0; j < 8; ++j) { const float th = fast_tanh(s[j]); s[j] = isw ? th : s[j]; }
          LAS bf16_t* dst = (isw ? AWD : AAD) + js * 72 + cc;
          u32x4 w; w.x = cvt_pk_bf16(s[0], s[1]); w.y = cvt_pk_bf16(s[2], s[3]); w.z = cvt_pk_bf16(s[4], s[5]); w.w = cvt_pk_bf16(s[6], s[7]); *(LAS u32x4*)dst = w; }
        __syncthreads();
        if (MODE == 3) continue;
        {
            const int lora = wid >> 2, ct = wid & 3;
            const LAS bf16_t* Am = lora ? AAD : AWD; const LAS bf16_t* Bm = lora ? AUP : WUP;
            float carry = 0.f;
#pragma unroll
            for (int r2 = 0; r2 < 2; ++r2) {
                f32x4 acc = (f32x4){0.f, 0.f, 0.f, 0.f};
#pragma unroll
                for (int ks = 0; ks < 2; ++ks) acc = __builtin_amdgcn_mfma_f32_16x16x32_bf16(ldsb8(Am + (r2 * 16 + fr) * 72 + ks * 32 + fq * 8), ldsb8(Bm + (ct * 16 + fr) * 72 + ks * 32 + fq * 8), acc, 0, 0, 0);
                const int col = ct * 16 + fr;
                if (lora == 0) {
                    float c[4];
#pragma unroll
                    for (int i = 0; i < 4; ++i) { const float lw = acc[i] + CST[col]; const float e = __expf(-fast_softplus(-lw) - 0.5f); c[i] = i ? c[i - 1] + e : e; }
                    const float tot = c[3];
                    float s1 = tot; { const float y = __shfl_up(s1, 16); s1 += fq >= 1 ? y : 0.f; }
                    float s2 = s1;  { const float z = __shfl_up(s1, 32); s2 += fq >= 2 ? z : 0.f; }
                    const float base = carry + s2 - tot;
#pragma unroll
                    for (int i = 0; i < 4; ++i) CUM[(r2 * 16 + fq * 4 + i) * 64 + col] = base + c[i];
                    carry += __shfl(s2, 48 + fr);
                } else {
#pragma unroll
                    for (int i = 0; i < 4; ++i) LA_[(r2 * 16 + fq * 4 + i) * 64 + col] = fast_sigmoid(acc[i] + CST[64 + col]);
                }
            }
        }
        __syncthreads();
        if (MODE == 2) continue;
        {
            const int j = tid >> 4, c4 = (tid & 15) * 4;
            const f32x4 k = *(const LAS f32x4*)(KR + j * 64 + c4), a = *(const LAS f32x4*)(LA_ + j * 64 + c4), r = *(const LAS f32x4*)(Rr + j * 64 + c4), vv = *(const LAS f32x4*)(Vv + j * 64 + c4);
            const f32x4 cu = *(const LAS f32x4*)(CUM + j * 64 + c4); f32x4 cp = (f32x4){0.f, 0.f, 0.f, 0.f}; if (j > 0) cp = *(const LAS f32x4*)(CUM + (j - 1) * 64 + c4);
            float kkr[4], ss = 0.f, bn = 0.f;
#pragma unroll
            for (int x = 0; x < 4; ++x) { kkr[x] = k[x] * CST[128 + c4 + x]; ss += kkr[x] * kkr[x]; }
            ss = allreduce16(ss);
            const float inv = 1.f / fmaxf(sqrtf(ss), 1e-12f);
            float kks[4], bs[4], kds[4], rs[4];
#pragma unroll
            for (int x = 0; x < 4; ++x) { const float kk = kkr[x] * inv, kd = k[x] * (1.f + (a[x] - 1.f) * CST[192 + c4 + x]), bb = kk * a[x];
                const float g = __expf(-cu[x]), gp = __expf(-cp[x]), ig = __expf(cu[x]);
                kks[x] = kk * gp; bs[x] = bb * ig; kds[x] = kd * ig; rs[x] = r[x] * g; bn += r[x] * kd * CST[256 + c4 + x];
                if (j == TB - 1) GC[c4 + x] = g;
            }
#pragma unroll
            for (int x = 0; x < 4; x += 2) { const unsigned pb = cvt_pk_bf16(bs[x], bs[x + 1]), pk = cvt_pk_bf16(kds[x], kds[x + 1]), pv = cvt_pk_bf16(vv[x], vv[x + 1]);
                BST[(c4 + x) * 40 + j] = (bf16_t)pb; BST[(c4 + x + 1) * 40 + j] = (bf16_t)(pb >> 16); KDST[(c4 + x) * 40 + j] = (bf16_t)pk; KDST[(c4 + x + 1) * 40 + j] = (bf16_t)(pk >> 16);
                VT[(c4 + x) * 40 + j] = (bf16_t)pv; VT[(c4 + x + 1) * 40 + j] = (bf16_t)(pv >> 16); }
            bn = allreduce16(bn);
            u32x2 w; w.x = cvt_pk_bf16(kks[0], kks[1]); w.y = cvt_pk_bf16(kks[2], kks[3]); *(LAS u32x2*)(KKS + j * 72 + c4) = w;
            w.x = cvt_pk_bf16(bs[0], bs[1]); w.y = cvt_pk_bf16(bs[2], bs[3]); *(LAS u32x2*)(BS + j * 72 + c4) = w;
            w.x = cvt_pk_bf16(kds[0], kds[1]); w.y = cvt_pk_bf16(kds[2], kds[3]); *(LAS u32x2*)(KDS + j * 72 + c4) = w;
            w.x = cvt_pk_bf16(rs[0], rs[1]); w.y = cvt_pk_bf16(rs[2], rs[3]); *(LAS u32x2*)(RS + j * 72 + c4) = w;
            if ((tid & 15) == 0) BON[j] = bn;
        }
        __syncthreads();
        if (MODE == 1) continue;
        const int ctg = wid & 1;
        f32x4 accG = (f32x4){0.f, 0.f, 0.f, 0.f}, accY = accG;
        {
            const int pr = wid >> 1, rts = wid & 1;
            const LAS bf16_t* Xm = (pr & 1) ? KDS : BS; const LAS bf16_t* Ym = (pr < 2) ? KKS : RS;
            const bf16x8 a0 = ldsb8(Xm + (rts * 16 + fr) * 72 + fq * 8), a1 = ldsb8(Xm + (rts * 16 + fr) * 72 + 32 + fq * 8);
#pragma unroll
            for (int cts = 0; cts < 2; ++cts) {
                f32x4 acc = (f32x4){0.f, 0.f, 0.f, 0.f};
                acc = __builtin_amdgcn_mfma_f32_16x16x32_bf16(a0, ldsb8(Ym + (cts * 16 + fr) * 72 + fq * 8), acc, 0, 0, 0);
                acc = __builtin_amdgcn_mfma_f32_16x16x32_bf16(a1, ldsb8(Ym + (cts * 16 + fr) * 72 + 32 + fq * 8), acc, 0, 0, 0);
                const int t = cts * 16 + fr, s0 = rts * 16 + fq * 4;
#pragma unroll
                for (int i = 0; i < 4; ++i) { const bool keep = (pr < 2) ? (s0 + i < t) : (s0 + i <= t); acc[i] = keep ? acc[i] : 0.f; }
                if (pr == 0) *(LAS f32x4*)(ABT + t * 32 + s0) = acc;
                else { u32x2 w; w.x = cvt_pk_bf16(acc[0], acc[1]); w.y = cvt_pk_bf16(acc[2], acc[3]); *(LAS u32x2*)((pr == 1 ? AKT : (pr == 2 ? NBT : NKT)) + t * 40 + s0) = w; }
            }
#pragma unroll
            for (int ks = 0; ks < 2; ++ks) { const bf16x8 sa = ldsb8(S0B + (rt * 16 + fr) * 72 + ks * 32 + fq * 8);
                accG = __builtin_amdgcn_mfma_f32_16x16x32_bf16(sa, ldsb8(KKS + (ctg * 16 + fr) * 72 + ks * 32 + fq * 8), accG, 0, 0, 0);
                accY = __builtin_amdgcn_mfma_f32_16x16x32_bf16(sa, ldsb8(RS + (ctg * 16 + fr) * 72 + ks * 32 + fq * 8), accY, 0, 0, 0); }
        }
        __syncthreads();
        {
            const bf16x8 va = ldsb8(VT + (rt * 16 + fr) * 40 + fq * 8);
            accG = __builtin_amdgcn_mfma_f32_16x16x32_bf16(va, ldsb8(AKT + (ctg * 16 + fr) * 40 + fq * 8), accG, 0, 0, 0);
            accY = __builtin_amdgcn_mfma_f32_16x16x32_bf16(va, ldsb8(NKT + (ctg * 16 + fr) * 40 + fq * 8), accY, 0, 0, 0);
#pragma unroll
            for (int i = 0; i < 4; ++i) Gm[(rt * 16 + fq * 4 + i) * 36 + ctg * 16 + fr] = -accG[i];
        }
        __syncthreads();
        if (MODE == 4) continue;
        if (wid < 4) {
            const int v = wid * 16 + (lane >> 2), pq = lane & 3;
            const LAS float* grow = Gm + v * 36;
            f32x4 r0 = *(const LAS f32x4*)(grow + 4 * pq), r1 = *(const LAS f32x4*)(grow + 16 + 4 * pq);
            u32x2 ubo[TB / 4];
            const LAS float* abd = ABT; asm volatile("" : "+v"(abd));
            const LAS float* abq = ABT + 128 * pq; asm volatile("" : "+v"(abq));
            f32x4 dc[3], a0c[4], a1c[4];
            auto ldg = [&](int g, f32x4 (&dd)[3], f32x4 (&aa0)[4], f32x4 (&aa1)[4]) {
#pragma unroll
                for (int x = 0; x < 3; ++x) dd[x] = *(const LAS f32x4*)(abd + (4 * g + 1 + x) * 32 + 4 * g);
#pragma unroll
                for (int jj = 0; jj < 4; ++jj) { if (g < 3) aa0[jj] = *(const LAS f32x4*)(abq + jj * 32 + 4 * g); if (g < 7) aa1[jj] = *(const LAS f32x4*)(abq + (16 + jj) * 32 + 4 * g); } };
            ldg(0, dc, a0c, a1c);
#pragma unroll
            for (int g = 0; g < TB / 4; ++g) {
                f32x4 dn[3], a0n[4], a1n[4];
                if (g + 1 < TB / 4) ldg(g + 1, dn, a0n, a1n);
                __builtin_amdgcn_sched_barrier(0);
                const f32x4 rr = g < 4 ? r0 : r1;
                f32x4 u4;
                u4[0] = rr[0];
                u4[1] = rr[1] - u4[0] * dc[0][0];
                u4[2] = rr[2] - (u4[0] * dc[1][0] + u4[1] * dc[1][1]);
                u4[3] = rr[3] - (u4[0] * dc[2][0] + u4[1] * dc[2][1] + u4[2] * dc[2][2]);
#pragma unroll
                for (int x = 0; x < 4; ++x) { const int ui = __float_as_int(u4[x]); int bi;
                    if ((g & 3) == 0) bi = __builtin_amdgcn_update_dpp(0, ui, 0x00, 0xF, 0xF, true); else if ((g & 3) == 1) bi = __builtin_amdgcn_update_dpp(0, ui, 0x55, 0xF, 0xF, true);
                    else if ((g & 3) == 2) bi = __builtin_amdgcn_update_dpp(0, ui, 0xAA, 0xF, 0xF, true); else bi = __builtin_amdgcn_update_dpp(0, ui, 0xFF, 0xF, 0xF, true);
                    u4[x] = __int_as_float(bi); }
                ubo[g].x = cvt_pk_bf16(u4[0], u4[1]); ubo[g].y = cvt_pk_bf16(u4[2], u4[3]);
                if (g < 3) {
#pragma unroll
                    for (int jj = 0; jj < 4; ++jj) r0[jj] -= u4[0] * a0c[jj][0] + u4[1] * a0c[jj][1] + u4[2] * a0c[jj][2] + u4[3] * a0c[jj][3]; }
                if (g < 7) {
#pragma unroll
                    for (int jj = 0; jj < 4; ++jj) r1[jj] -= u4[0] * a1c[jj][0] + u4[1] * a1c[jj][1] + u4[2] * a1c[jj][2] + u4[3] * a1c[jj][3]; }
                if (g + 1 < TB / 4) {
#pragma unroll
                    for (int x = 0; x < 3; ++x) dc[x] = dn[x];
#pragma unroll
                    for (int jj = 0; jj < 4; ++jj) { a0c[jj] = a0n[jj]; a1c[jj] = a1n[jj]; } }
            }
            if (pq == 0) {
#pragma unroll
                for (int g = 0; g < TB / 4; g += 2) { u32x4 w; w.x = ubo[g].x; w.y = ubo[g].y; w.z = ubo[g + 1].x; w.w = ubo[g + 1].y; *(LAS u32x4*)(UB + v * 40 + 4 * g) = w; } }
        }
        __syncthreads();
        if (MODE == 5) continue;
        {
            const bf16x8 ua = ldsb8(UB + (rt * 16 + fr) * 40 + fq * 8), va = ldsb8(VT + (rt * 16 + fr) * 40 + fq * 8);
            accY = __builtin_amdgcn_mfma_f32_16x16x32_bf16(ua, ldsb8(NBT + (ctg * 16 + fr) * 40 + fq * 8), accY, 0, 0, 0);
            *(LAS f32x4*)(YO + (ctg * 16 + fr) * 64 + rt * 16 + fq * 4) = accY;
#pragma unroll
            for (int cc = 0; cc < 2; ++cc) { const int ct = 2 * (wid & 1) + cc, kcol = ct * 16 + fr;
                f32x4 acc = Sreg[cc];
                acc = __builtin_amdgcn_mfma_f32_16x16x32_bf16(ua, ldsb8(BST + kcol * 40 + fq * 8), acc, 0, 0, 0);
                acc = __builtin_amdgcn_mfma_f32_16x16x32_bf16(va, ldsb8(KDST + kcol * 40 + fq * 8), acc, 0, 0, 0);
                const float g = GC[kcol];
#pragma unroll
                for (int i = 0; i < 4; ++i) acc[i] *= g;
                { const unsigned p0 = cvt_pk_bf16(acc[0], acc[1]), p1 = cvt_pk_bf16(acc[2], acc[3]); LAS bf16_t* sp = S0B + (rt * 16 + fq * 4) * 72 + kcol;
                  sp[0] = (bf16_t)p0; sp[72] = (bf16_t)(p0 >> 16); sp[144] = (bf16_t)p1; sp[216] = (bf16_t)(p1 >> 16); }
                Sreg[cc] = acc; }
        }
        __syncthreads();
        if (!isctx) {
            const int j = tid >> 4, c4 = (tid & 15) * 4, t = d == 0 ? j : TB - 1 - j; const f32x4 y = *(const LAS f32x4*)(YO + j * 64 + c4);
            u32x2 w; w.x = cvt_pk_bf16(y[0], y[1]); w.y = cvt_pk_bf16(y[2], y[3]);
            *(u32x2*)(p.Y + ((size_t)d * nlat + grow0 + t) * RW + h * 64 + c4) = w;
            if (tid < TB) { const int tt = d == 0 ? tid : TB - 1 - tid; p.bon[((size_t)d * nlat + grow0 + tt) * NH + h] = BON[tid]; }
        }
    }
}
template <int MODE = 0>
__device__ __forceinline__ void rwkv_phase2(LAS unsigned char* lds, const In& in, const RwkvP p, int bid, int nblk) {
    const int nchain = 2 * p.nb * NH;
    for (int c = bid; c < nchain; c += nblk) { rwkv_chain2<MODE>(lds, in, p, c); __syncthreads(); }
}
}

namespace mk {
constexpr int LR_XT = 0;
constexpr int LR_XC = LR_XT + 67 * 64 * 2 + 64;
constexpr int LR_XCB = LR_XC + 64 * 64 * 4;
constexpr int LR_GWT = LR_XCB + 64 * 72 * 2;
constexpr int LR_A = LR_GWT + 2 * 64 * 72 * 2;
constexpr int LR_BX = LR_A + 64 * 64 * 4;
constexpr int LR_HO = LR_BX + 64 * 64 * 4;
constexpr int LR_CST = LR_HO + 64 * 64 * 4;
constexpr int LR_SEGP = LR_CST + 8 * 64 * 4;
constexpr int LR_SEGH = LR_SEGP + 8 * 64 * 4;
constexpr int LR_HC = LR_SEGH + 8 * 64 * 4;
constexpr int LR_END = LR_HC + 64 * 4;
static_assert(LR_END <= LDS_BYTES && (LR_XC % 16) == 0, "lru LDS");

struct LruP { const bf16_t* z1; bf16_t* Hd; int b0, nb; };

__device__ __forceinline__ void lru_item(LAS unsigned char* lds, const In& in, const LruP p, int item) {
    const int tid = threadIdx.x, lane = tid & 63, wid = tid >> 6;
    const int d = item / (p.nb * LB), bl = (item / LB) % p.nb, n = item % LB;
    const int nlat = p.nb * SEQ;
    LAS bf16_t* XT = (LAS bf16_t*)(lds + LR_XT); LAS float* XC = (LAS float*)(lds + LR_XC); LAS bf16_t* XCB = (LAS bf16_t*)(lds + LR_XCB); LAS bf16_t* GWT = (LAS bf16_t*)(lds + LR_GWT);
    LAS float *A_ = (LAS float*)(lds + LR_A), *BX = (LAS float*)(lds + LR_BX), *HO = (LAS float*)(lds + LR_HO), *CST = (LAS float*)(lds + LR_CST), *SEGP = (LAS float*)(lds + LR_SEGP), *SEGH = (LAS float*)(lds + LR_SEGH), *HC = (LAS float*)(lds + LR_HC);
    for (int i = tid; i < 2 * 64 * 64; i += NT) { const int g = i >> 12, j = (i >> 6) & 63, k = i & 63;
        GWT[(g * 64 + k) * 72 + j] = f2bf(in.lru_gate_w[((((size_t)d * 2 + g) * LB + n) * LBS + j) * LBS + k]); }
    for (int i = tid; i < 64; i += NT) { const int c = n * 64 + i;
        CST[i] = in.lru_conv_w[c]; CST[64 + i] = in.lru_conv_w[LW + c]; CST[128 + i] = in.lru_conv_w[2 * LW + c]; CST[192 + i] = in.lru_conv_w[3 * LW + c]; CST[256 + i] = in.lru_conv_b[c];
        CST[320 + i] = in.lru_gate_b[((d * 2 + 0) * LB + n) * LBS + i]; CST[384 + i] = in.lru_gate_b[((d * 2 + 1) * LB + n) * LBS + i]; CST[448 + i] = softplusf_(-in.lru_l[d * LW + c]); }
    constexpr int NSEG = CTX / 64 + GW, NSC = CTX / 64;
    u32x4 pre[2];
    auto tok_row = [&](int sidx, int rr, bool& ok) -> size_t {
        if (sidx < NSC) { const int t = sidx * 64 + rr - 2; ok = t >= 0 && t < CTX; return (size_t)nlat + (size_t)bl * CTX + t; }
        const int col = sidx - NSC, row = rr - 2; ok = row >= 0 && row < ROWS; return (size_t)bl * SEQ + (size_t)row * GW + col;
    };
    auto seg_of = [&](int q) { if (q < NSC) return d == 0 ? q : NSC - 1 - q; const int ql = q - NSC; return NSC + (d == 0 ? ql : GW - 1 - ql); };
    auto prefetch = [&](int q) { const int sidx = seg_of(q);
#pragma unroll
        for (int k = 0; k < 2; ++k) { const int i = tid + k * NT; u32x4 v = (u32x4){0u, 0u, 0u, 0u};
            if (i < 67 * 8) { const int rr = i >> 3, part = i & 7; bool ok; const size_t gr = tok_row(sidx, rr, ok); if (ok) v = *(const u32x4*)(p.z1 + gr * Z1_N + Z1_LX + n * 64 + part * 8); }
            pre[k] = v; } };
    auto commit = [&]() {
#pragma unroll
        for (int k = 0; k < 2; ++k) { const int i = tid + k * NT; if (i < 67 * 8) *(LAS u32x4*)(XT + (i >> 3) * 64 + (i & 7) * 8) = pre[k]; } };
    if (tid < 64) HC[tid] = 0.f;
    prefetch(0);
    for (int q = 0; q < NSEG; ++q) {
        const int sidx = seg_of(q);
        commit();
        __syncthreads();
        if (q + 1 < NSEG) prefetch(q + 1);
        { const int t = tid >> 3, c0 = (tid & 7) * 8; float s[8];
#pragma unroll
          for (int j = 0; j < 8; ++j) s[j] = CST[256 + c0 + j];
#pragma unroll
          for (int tap = 0; tap < 4; ++tap) { const u32x4 x = *(const LAS u32x4*)(XT + (t + tap) * 64 + c0);
#pragma unroll
              for (int j = 0; j < 4; ++j) { s[2 * j] += CST[tap * 64 + c0 + 2 * j] * bflo(x[j]); s[2 * j + 1] += CST[tap * 64 + c0 + 2 * j + 1] * bfhi(x[j]); } }
          *(LAS f32x4*)(XC + t * 64 + c0) = (f32x4){s[0], s[1], s[2], s[3]}; *(LAS f32x4*)(XC + t * 64 + c0 + 4) = (f32x4){s[4], s[5], s[6], s[7]};
          u32x4 w; w.x = cvt_pk_bf16(s[0], s[1]); w.y = cvt_pk_bf16(s[2], s[3]); w.z = cvt_pk_bf16(s[4], s[5]); w.w = cvt_pk_bf16(s[6], s[7]); *(LAS u32x4*)(XCB + t * 72 + c0) = w; }
        __syncthreads();
        { const int rt = wid >> 1, fr = lane & 15, fq = lane >> 4;
          bf16x8 a[2];
#pragma unroll
          for (int ks = 0; ks < 2; ++ks) a[ks] = *(const LAS bf16x8*)(XCB + (rt * 16 + fr) * 72 + ks * 32 + fq * 8);
#pragma unroll
          for (int cc = 0; cc < 2; ++cc) { const int ct = 2 * (wid & 1) + cc, col = ct * 16 + fr;
              f32x4 acc0 = (f32x4){0.f, 0.f, 0.f, 0.f}, acc1 = acc0;
#pragma unroll
              for (int ks = 0; ks < 2; ++ks) {
                  const bf16x8 b0 = *(const LAS bf16x8*)(GWT + (0 * 64 + col) * 72 + ks * 32 + fq * 8), b1 = *(const LAS bf16x8*)(GWT + (1 * 64 + col) * 72 + ks * 32 + fq * 8);
                  acc0 = __builtin_amdgcn_mfma_f32_16x16x32_bf16(a[ks], b0, acc0, 0, 0, 0); acc1 = __builtin_amdgcn_mfma_f32_16x16x32_bf16(a[ks], b1, acc1, 0, 0, 0); }
#pragma unroll
              for (int i = 0; i < 4; ++i) { const int t = rt * 16 + fq * 4 + i;
                  const float rec = fast_sigmoid(acc0[i] + CST[320 + col]), inp = fast_sigmoid(acc1[i] + CST[384 + col]);
                  const float la = -8.f * rec * CST[448 + col];
                  const float av = __expf(la), x2 = 2.f * la; const float om = x2 > -0.03f ? -x2 * (1.f + x2 * (0.5f + x2 * (1.f / 6.f))) : 1.f - av * av;
                  A_[t * 64 + col] = av; BX[t * 64 + col] = __builtin_amdgcn_sqrtf(om) * inp * XC[t * 64 + col]; } } }
        __syncthreads();
        { const int ch = tid & 63, pc = tid >> 6; float av[8], bv[8]; float P = 1.f, H = 0.f;
#pragma unroll
          for (int x = 0; x < 8; ++x) { const int st = pc * 8 + x, t = d == 0 ? st : 63 - st; av[x] = A_[t * 64 + ch]; bv[x] = BX[t * 64 + ch]; H = av[x] * H + bv[x]; P *= av[x]; }
          SEGP[pc * 64 + ch] = P; SEGH[pc * 64 + ch] = H;
          __syncthreads();
          float h = HC[ch];
#pragma unroll
          for (int q2 = 0; q2 < 7; ++q2) if (q2 < pc) h = SEGP[q2 * 64 + ch] * h + SEGH[q2 * 64 + ch];
#pragma unroll
          for (int x = 0; x < 8; ++x) { const int st = pc * 8 + x, t = d == 0 ? st : 63 - st; h = av[x] * h + bv[x]; HO[t * 64 + ch] = h; }
          __syncthreads();
          if (pc == 7) HC[ch] = h;
        }
        if (sidx >= NSC) { const int col = sidx - NSC, t = tid >> 3, c0 = (tid & 7) * 8;
            const f32x4 x = *(const LAS f32x4*)(HO + t * 64 + c0), y = *(const LAS f32x4*)(HO + t * 64 + c0 + 4);
            *(u32x4*)(p.Hd + ((size_t)d * nlat + (size_t)bl * SEQ + (size_t)t * GW + col) * LW + n * 64 + c0) = pack8(x, y); }
    }
}
__device__ __forceinline__ void lru_phase(LAS unsigned char* lds, const In& in, const LruP p, int bid, int nblk) {
    const int nitem = 2 * p.nb * LB;
    for (int it = bid; it < nitem; it += nblk) { lru_item(lds, in, p, it); __syncthreads(); }
}
}

namespace mk {
#define MK_DPPX(x, ctrl) __int_as_float(__builtin_amdgcn_update_dpp(__float_as_int(x), __float_as_int(x), ctrl, 0xF, 0xF, false))
__device__ __forceinline__ float allreduce4(float x) { x += MK_DPPX(x, 0xB1); x += MK_DPPX(x, 0x4E); return x; }
__device__ __forceinline__ void unpack8(const u32x4 w, float (&f)[8]) {
#pragma unroll
    for (int j = 0; j < 4; ++j) { f[2 * j] = bflo(w[j]); f[2 * j + 1] = bfhi(w[j]); } }
constexpr int AG_K = 256;
struct PostP { const bf16_t* z1; bf16_t* Y; const float* bon; bf16_t* Ag; int nlat; int pad_; };
__device__ __forceinline__ void rwkv_post_rows(const In& in, const PostP p, int row_lo, int row_hi, bool dry = false) {
    const int lane = threadIdx.x & 63, wid = threadIdx.x >> 6, c0 = lane * 16, h = lane >> 2;
    float mu0v[16], mu1v[16], l0[16], l1[16], mg0[8], mg1[8];
#pragma unroll
    for (int j = 0; j < 16; ++j) { mu0v[j] = in.shift_mu[OFF_V + c0 + j]; mu1v[j] = in.shift_mu[RC + OFF_V + c0 + j]; l0[j] = in.rw_lnx[c0 + j]; l1[j] = in.rw_lnx[RW + c0 + j]; }
#pragma unroll
    for (int j = 0; j < 8; ++j) { const int c = OFF_GD + (lane < GL / 8 ? lane : 0) * 8 + j; mg0[j] = in.shift_mu[c]; mg1[j] = in.shift_mu[RC + c]; }
    for (int r = row_lo + wid; r < row_hi; r += NT / 64) {
        const int cg = r % GW; const bool hp = cg > 0, hn = cg < GW - 1;
        bf16_t* y0p = p.Y + (size_t)r * RW + c0; const bf16_t* y1p = p.Y + ((size_t)p.nlat + r) * RW + c0;
        float y[16], t8[8];
        unpack8(*(const u32x4*)y0p, t8);
#pragma unroll
        for (int j = 0; j < 8; ++j) y[j] = t8[j];
        unpack8(*(const u32x4*)(y0p + 8), t8);
#pragma unroll
        for (int j = 0; j < 8; ++j) y[8 + j] = t8[j];
        unpack8(*(const u32x4*)y1p, t8);
#pragma unroll
        for (int j = 0; j < 8; ++j) y[j] += t8[j];
        unpack8(*(const u32x4*)(y1p + 8), t8);
#pragma unroll
        for (int j = 0; j < 8; ++j) y[8 + j] += t8[j];
        float s = 0.f;
#pragma unroll
        for (int j = 0; j < 16; ++j) s += y[j];
        const float mu = allreduce4(s) * (1.f / 64.f); float q = 0.f;
#pragma unroll
        for (int j = 0; j < 16; ++j) { const float dlt = y[j] - mu; q += dlt * dlt; }
        const float rs = 1.f / sqrtf(allreduce4(q) * (1.f / 64.f) + LNX_EPS);
        const float bonus = p.bon[(size_t)r * NH + h] + p.bon[((size_t)p.nlat + r) * NH + h];
        const bf16_t* zr = p.z1 + (size_t)r * Z1_N;
#pragma unroll
        for (int half = 0; half < 2; ++half) {
            const int c = OFF_V + c0 + half * 8; float xv[8], pv[8], nv[8];
            unpack8(*(const u32x4*)(zr + c), xv);
            if (hp) unpack8(*(const u32x4*)(zr - Z1_N + c), pv); else {
#pragma unroll
                for (int j = 0; j < 8; ++j) pv[j] = 0.f; }
            if (hn) unpack8(*(const u32x4*)(zr + Z1_N + c), nv); else {
#pragma unroll
                for (int j = 0; j < 8; ++j) nv[j] = 0.f; }
            float o[8];
#pragma unroll
            for (int j = 0; j < 8; ++j) { const int cj = half * 8 + j; const float v = xv[j] + mu0v[cj] * (pv[j] - xv[j]) + mu1v[cj] * (nv[j] - xv[j]);
                o[j] = (y[cj] - mu) * rs * l0[cj] + l1[cj] + bonus * v; }
            u32x4 w; w.x = cvt_pk_bf16(o[0], o[1]); w.y = cvt_pk_bf16(o[2], o[3]); w.z = cvt_pk_bf16(o[4], o[5]); w.w = cvt_pk_bf16(o[6], o[7]); if (!dry) *(u32x4*)(y0p + half * 8) = w; else if (w.x == 0x12345678u) *(u32x4*)(y0p + half * 8) = w;
        }
        if (lane < 32) { u32x4 w = (u32x4){0u, 0u, 0u, 0u};
            if (lane < GL / 8) { const int c = OFF_GD + lane * 8; float xv[8], pv[8], nv[8];
                unpack8(*(const u32x4*)(zr + c), xv);
                if (hp) unpack8(*(const u32x4*)(zr - Z1_N + c), pv); else {
#pragma unroll
                    for (int j = 0; j < 8; ++j) pv[j] = 0.f; }
                if (hn) unpack8(*(const u32x4*)(zr + Z1_N + c), nv); else {
#pragma unroll
                    for (int j = 0; j < 8; ++j) nv[j] = 0.f; }
                float o[8];
#pragma unroll
                for (int j = 0; j < 8; ++j) o[j] = fast_sigmoid(xv[j] + mg0[j] * (pv[j] - xv[j]) + mg1[j] * (nv[j] - xv[j]));
                w.x = cvt_pk_bf16(o[0], o[1]); w.y = cvt_pk_bf16(o[2], o[3]); w.z = cvt_pk_bf16(o[4], o[5]); w.w = cvt_pk_bf16(o[6], o[7]); }
            *(u32x4*)(p.Ag + (size_t)r * AG_K + lane * 8) = w; }
    }
}
#define MK_FR_ROW(f) ((((f) >> 3) * HALF) + wr * 64 + ((((f) >> 1) & 3) * 16) + fr)
#define MK_FR_COL(f) ((((f) & 1) * HALF) + wc * 32 + 8 * fq)
#define MK_FR_ACC(f, n) acc[(f) >> 3][(f) & 1][((f) >> 1) & 3][n]
#define MK_FENCE asm volatile("" ::: "memory")
struct EpiYa { const bf16_t* yn; bf16_t* ya;
    __device__ __forceinline__ bool operator()(f32x4 (&acc)[2][2][4][2], const Unit& u, int wr, int wc, int fr, int fq) const {
        const size_t base = (size_t)(u.pm * BM) * RW + u.pn * BM;
        u32x4 cur = *(const u32x4*)(yn + base + (size_t)MK_FR_ROW(0) * RW + MK_FR_COL(0));
#pragma unroll
        for (int f = 0; f < 16; ++f) { u32x4 nxt = cur; if (f + 1 < 16) nxt = *(const u32x4*)(yn + base + (size_t)MK_FR_ROW(f + 1) * RW + MK_FR_COL(f + 1));
            MK_FENCE; float v[8]; unpack8(cur, v); f32x4 a = MK_FR_ACC(f, 0), b = MK_FR_ACC(f, 1);
#pragma unroll
            for (int j = 0; j < 4; ++j) { a[j] *= v[j]; b[j] *= v[4 + j]; }
            *(u32x4*)(ya + base + (size_t)MK_FR_ROW(f) * RW + MK_FR_COL(f)) = pack8(a, b); MK_FENCE; cur = nxt; }
        return false; } };
struct EpiZc { const bf16_t* Hd; bf16_t* yb; bf16_t* gates; int nlat; int pad_;
    __device__ __forceinline__ bool operator()(f32x4 (&acc)[2][2][4][2], const Unit& u, int wr, int wc, int fr, int fq) const {
        if (u.pn < LW / BM) {
            MK_FRAG_LOOP(r, c) { const size_t o = (size_t)(u.pm * BM + r) * LW + u.pn * BM + c; float h0[8], h1[8]; unpack8(*(const u32x4*)(Hd + o), h0); unpack8(*(const u32x4*)(Hd + (size_t)nlat * LW + o), h1);
                f32x4 a = acc[ai][bj][m][0], b = acc[ai][bj][m][1];
#pragma unroll
                for (int j = 0; j < 4; ++j) { a[j] = gelu_tanhf_(a[j]) * (h0[j] + h1[j]); b[j] = gelu_tanhf_(b[j]) * (h0[4 + j] + h1[4 + j]); }
                *(u32x4*)(yb + o) = pack8(a, b); asm volatile("" ::: "memory"); }
        } else {
            MK_FRAG_LOOP(r, c) { const size_t o = (size_t)(u.pm * BM + r) * (2 * D) + (u.pn * BM - LW) + c;
                f32x4 a = acc[ai][bj][m][0], b = acc[ai][bj][m][1];
#pragma unroll
                for (int j = 0; j < 4; ++j) { a[j] = fast_sigmoid(a[j]); b[j] = fast_sigmoid(b[j]); }
                *(u32x4*)(gates + o) = pack8(a, b); }
        }
        return false; } };
struct PairOrder { StaticOrder S;
    __device__ bool next(int i, Unit& u) const { if (!S.next(i >> 1, u)) return false; u.e = i & 1; return true; } };
struct EpiBranch { const bf16_t* gates; bf16_t* mixed;
    __device__ __forceinline__ bool operator()(f32x4 (&acc)[2][2][4][2], const Unit& u, int wr, int wc, int fr, int fq) const {
        const size_t gbase = (size_t)(u.pm * BM) * (2 * D) + u.pn * BM, mbase = (size_t)(u.pm * BM) * D + u.pn * BM;
        u32x4 c1 = (u32x4){0u, 0u, 0u, 0u}, c2 = *(const u32x4*)(gates + gbase + (size_t)MK_FR_ROW(0) * (2 * D) + D + MK_FR_COL(0));
        if (u.e == 0) c1 = *(const u32x4*)(gates + gbase + (size_t)MK_FR_ROW(0) * (2 * D) + MK_FR_COL(0));
#pragma unroll
        for (int f = 0; f < 16; ++f) { u32x4 n1 = c1, n2 = c2;
            if (f + 1 < 16) { const size_t o = gbase + (size_t)MK_FR_ROW(f + 1) * (2 * D) + MK_FR_COL(f + 1); n2 = *(const u32x4*)(gates + o + D); if (u.e == 0) n1 = *(const u32x4*)(gates + o); }
            MK_FENCE; float g1[8], g2[8]; unpack8(c1, g1); unpack8(c2, g2);
            if (u.e == 0) {
#pragma unroll
                for (int j = 0; j < 4; ++j) { MK_FR_ACC(f, 0)[j] *= g1[j] / g2[j]; MK_FR_ACC(f, 1)[j] *= g1[4 + j] / g2[4 + j]; }
            } else { f32x4 a = MK_FR_ACC(f, 0), b = MK_FR_ACC(f, 1);
#pragma unroll
                for (int j = 0; j < 4; ++j) { a[j] *= g2[j]; b[j] *= g2[4 + j]; }
                *(u32x4*)(mixed + mbase + (size_t)MK_FR_ROW(f) * D + MK_FR_COL(f)) = pack8(a, b); }
            MK_FENCE; c1 = n1; c2 = n2; }
        return u.e == 0; } };
struct EpiF32 { float* C; long ldc;
    __device__ __forceinline__ bool operator()(f32x4 (&acc)[2][2][4][2], const Unit& u, int wr, int wc, int fr, int fq) const {
        MK_FRAG_LOOP(r, c) { float* o = C + (size_t)(u.pm * BM + r) * ldc + u.pn * BM + c; *(f32x4*)o = acc[ai][bj][m][0]; *(f32x4*)(o + 4) = acc[ai][bj][m][1]; }
        return false; } };
}

namespace mk {
constexpr int NEX = NE + 1;
constexpr int SLOTS_PER_TOK = TOPK + 1;
constexpr int RP_MOD = 0;
constexpr int RP_UH = RP_MOD + 3 * D * 4;
constexpr int RP_UL = RP_UH + 16 * (D + 8) * 2;
constexpr int RP_PART = RP_UL + 16 * (D + 8) * 2;
constexpr int RP_LOG = RP_PART + 8 * 16 * 64 * 4;
constexpr int RP_HIST = RP_LOG + 16 * 64 * 4;
constexpr int RP_END = RP_HIST + 64 * 4;
static_assert(RP_END <= LDS_BYTES, "rowpass LDS");

struct RowP { float* y2h1; bf16_t* u; const float* modpart; const bf16_t* rwt;
              int* tope; float* gatev; int* lrank; int* blkcnt; int b0, nlat; };
__device__ __forceinline__ float wave_max(float x) {
#pragma unroll
    for (int o = 32; o > 0; o >>= 1) x = fmaxf(x, __shfl_xor(x, o));
    return x; }
__device__ __forceinline__ void row_pass(LAS unsigned char* lds, const In& in, const RowP p, int row_lo, int row_hi, bool dry = false) {
    const int tid = threadIdx.x, lane = tid & 63, wid = tid >> 6;
    LAS float* MOD = (LAS float*)(lds + RP_MOD); LAS bf16_t* UH = (LAS bf16_t*)(lds + RP_UH); LAS bf16_t* UL = (LAS bf16_t*)(lds + RP_UL);
    LAS float* PART = (LAS float*)(lds + RP_PART); LAS float* LOG = (LAS float*)(lds + RP_LOG); LAS int* HIST = (LAS int*)(lds + RP_HIST);
    const int mr = p.b0 + row_lo / SEQ;
    for (int j = tid; j < 3 * D; j += NT) MOD[j] = mod_value(in, p.modpart, mr, 2 * D + j);
    if (tid < 64) HIST[tid] = 0;
    __syncthreads();
    float gp1[16], gp2[16];
#pragma unroll
    for (int j = 0; j < 4; ++j)
#pragma unroll
        for (int q = 0; q < 4; ++q) { gp1[4 * j + q] = in.norm_g[D + j * 256 + lane * 4 + q]; gp2[4 * j + q] = in.norm_g[2 * D + j * 256 + lane * 4 + q]; }
    for (int r16 = row_lo; r16 < row_hi; r16 += 16) {
#pragma unroll
        for (int rr = 0; rr < 2; ++rr) {
            const int lr = wid * 2 + rr, r = r16 + lr;
            float* yp = p.y2h1 + (size_t)r * D; const float* xp = in.x + ((size_t)p.b0 * SEQ + r) * D;
            f32x4 v[4]; float ss = 0.f;
#pragma unroll
            for (int j = 0; j < 4; ++j) { v[j] = *(const f32x4*)(yp + j * 256 + lane * 4); ss += v[j][0] * v[j][0] + v[j][1] * v[j][1] + v[j][2] * v[j][2] + v[j][3] * v[j][3]; }
#pragma unroll
            for (int o = 32; o > 0; o >>= 1) ss += __shfl_xor(ss, o);
            const float rinv = 1.f / sqrtf(ss * (1.f / D) + NORM_EPS); float s2 = 0.f;
#pragma unroll
            for (int j = 0; j < 4; ++j) { const int c = j * 256 + lane * 4; const f32x4 xv = *(const f32x4*)(xp + c);
#pragma unroll
                for (int q = 0; q < 4; ++q) { const float hv = xv[q] + MOD[c + q] * (v[j][q] * rinv * gp1[4 * j + q]); v[j][q] = hv; s2 += hv * hv; }
                if (!dry) *(f32x4*)(yp + c) = v[j]; }
#pragma unroll
            for (int o = 32; o > 0; o >>= 1) s2 += __shfl_xor(s2, o);
            const float r2 = 1.f / sqrtf(s2 * (1.f / D) + NORM_EPS);
#pragma unroll
            for (int j = 0; j < 4; ++j) { const int c = j * 256 + lane * 4; float uu[4], lo[4]; unsigned hw[2];
#pragma unroll
                for (int q = 0; q < 4; ++q) uu[q] = (v[j][q] * r2 * gp2[4 * j + q]) * (1.f + MOD[2 * D + c + q]) + MOD[D + c + q];
                hw[0] = cvt_pk_bf16(uu[0], uu[1]); hw[1] = cvt_pk_bf16(uu[2], uu[3]);
                lo[0] = uu[0] - bflo(hw[0]); lo[1] = uu[1] - bfhi(hw[0]); lo[2] = uu[2] - bflo(hw[1]); lo[3] = uu[3] - bfhi(hw[1]);
                u32x2 w; w.x = hw[0]; w.y = hw[1]; *(u32x2*)(p.u + (size_t)r * D + c) = w; *(LAS u32x2*)(UH + lr * (D + 8) + c) = w;
                u32x2 wl; wl.x = cvt_pk_bf16(lo[0], lo[1]); wl.y = cvt_pk_bf16(lo[2], lo[3]); *(LAS u32x2*)(UL + lr * (D + 8) + c) = wl; }
        }
        __syncthreads();
        { const int fr = lane & 15, fq = lane >> 4;
          f32x4 acc[4];
#pragma unroll
          for (int ct = 0; ct < 4; ++ct) acc[ct] = (f32x4){0.f, 0.f, 0.f, 0.f};
#pragma unroll
          for (int ks = 0; ks < 4; ++ks) { const int k0 = wid * 128 + ks * 32 + fq * 8;
              const bf16x8 ah = *(const LAS bf16x8*)(UH + fr * (D + 8) + k0), al = *(const LAS bf16x8*)(UL + fr * (D + 8) + k0);
#pragma unroll
              for (int ct = 0; ct < 4; ++ct) { const bf16x8 bh = *(const bf16x8*)(p.rwt + (size_t)(ct * 16 + fr) * D + k0), bl = *(const bf16x8*)(p.rwt + (size_t)(NE + ct * 16 + fr) * D + k0);
                  acc[ct] = __builtin_amdgcn_mfma_f32_16x16x32_bf16(ah, bh, acc[ct], 0, 0, 0); acc[ct] = __builtin_amdgcn_mfma_f32_16x16x32_bf16(ah, bl, acc[ct], 0, 0, 0); acc[ct] = __builtin_amdgcn_mfma_f32_16x16x32_bf16(al, bh, acc[ct], 0, 0, 0); } }
#pragma unroll
          for (int ct = 0; ct < 4; ++ct)
#pragma unroll
              for (int i = 0; i < 4; ++i) PART[(wid * 16 + fq * 4 + i) * 64 + ct * 16 + fr] = acc[ct][i]; }
        __syncthreads();
        for (int i = tid; i < 16 * 64; i += NT) { float s = 0.f;
#pragma unroll
            for (int w = 0; w < 8; ++w) s += PART[w * 1024 + i];
            LOG[i] = s; }
        __syncthreads();
#pragma unroll 1
        for (int rr = 0; rr < 2; ++rr) {
            const int lr = wid * 2 + rr, r = r16 + lr;
            const float sc = sigmoidf_(LOG[lr * 64 + lane]), bi = sc + in.router_b[lane];
            float m1 = bi; m1 = fmaxf(m1, __shfl_xor(m1, 1)); m1 = fmaxf(m1, __shfl_xor(m1, 2)); m1 = fmaxf(m1, __shfl_xor(m1, 4));
            const unsigned long long eq = __ballot(bi == m1); const int first = __ffsll((long long)((eq >> (lane & ~7)) & 0xffull)) - 1 + (lane & ~7);
            float m2 = (lane == first) ? -1e30f : bi; m2 = fmaxf(m2, __shfl_xor(m2, 1)); m2 = fmaxf(m2, __shfl_xor(m2, 2)); m2 = fmaxf(m2, __shfl_xor(m2, 4));
            const float gs = m1 + m2; const int myg = lane >> 3; int rank = 0;
#pragma unroll
            for (int g = 0; g < NG; ++g) { const float og = __shfl(gs, g * 8); rank += (og > gs || (og == gs && g < myg)) ? 1 : 0; }
            float cand = rank < TG ? bi : -1e30f; float tsum = 0.f; int myidx = 0; float mysc = 0.f;
#pragma unroll
            for (int it = 0; it < TOPK; ++it) { const float m = wave_max(cand); const unsigned long long bm = __ballot(cand == m); const int win = __ffsll((long long)bm) - 1;
                const float ws = __shfl(sc, win); tsum += ws; if (lane == it) { myidx = win; mysc = ws; } if (lane == win) cand = -1e30f; }
            if (lane < TOPK) { const int rk = atomicAdd((int*)&HIST[myidx], 1);
                p.tope[(size_t)r * TOPK + lane] = myidx; p.gatev[(size_t)r * TOPK + lane] = mysc / tsum * 2.5f; p.lrank[(size_t)r * TOPK + lane] = rk; }
        }
        __syncthreads();
    }
    if (tid < 64) p.blkcnt[blockIdx.x * 64 + tid] = HIST[tid];
}

struct MoeP { const int* tope; const float* gatev; const int* lrank; const int* blkcnt;
              int* tilepre;
              int* list;
              int* sdst;
              float* sgate;
              int r0, nr, blk0, nbh, rpb, pad_; };
__device__ __forceinline__ void moe_assign(LAS unsigned char* lds, const MoeP p, int bid, int nblk) {
    LAS int* BASE = (LAS int*)lds; LAS int* CNT = BASE + 80; LAS int* BOFF = CNT + 80;
    const int tid = threadIdx.x;
    if (tid < NE) { int c = 0, bo = 0; for (int b = 0; b < p.nbh; ++b) { const int v = p.blkcnt[(p.blk0 + b) * 64 + tid]; if (p.blk0 + b < bid) bo += v; c += v; } CNT[tid] = c; BOFF[tid] = bo; }
    __syncthreads();
    if (tid == 0) { int s = 0; for (int e = 0; e < NE; ++e) { BASE[e] = s; s += (CNT[e] + BM - 1) / BM * BM; } BASE[NE] = s; CNT[NE] = p.nr; BASE[NE + 1] = s + p.nr;
        if (bid == 0) { for (int e = 0; e <= NEX; ++e) p.tilepre[e] = BASE[e] / BM; } }
    __syncthreads();
    if (bid >= p.blk0 && bid < p.blk0 + p.nbh) {
        const int rlo = p.r0 + (bid - p.blk0) * p.rpb;
        for (int i = tid; i < p.rpb * TOPK; i += NT) { const int r = rlo + i / TOPK, a = r * TOPK + i % TOPK, e = p.tope[a]; const int slot = BASE[e] + BOFF[e] + p.lrank[a];
            p.list[slot] = r; p.sdst[slot] = (r - p.r0) * SLOTS_PER_TOK + i % TOPK; p.sgate[slot] = p.gatev[a]; }
        for (int i = tid; i < p.rpb; i += NT) { const int r = rlo + i, slot = BASE[NE] + (r - p.r0); p.list[slot] = r; p.sdst[slot] = (r - p.r0) * SLOTS_PER_TOK + TOPK; p.sgate[slot] = 1.f; }
    }
    for (int e = bid; e < NE; e += nblk) { const int lo = BASE[e] + CNT[e], hi = BASE[e + 1]; for (int s = lo + tid; s < hi; s += NT) { p.list[s] = p.r0; p.sdst[s] = -1; p.sgate[s] = 0.f; } }
}
struct GroupOrder { int tpn, total, nN, G, c;
    __device__ void init(const int* tilepre, int nN_, int G_, int c_) { const int lane = threadIdx.x & 63;
        tpn = (int)__hip_atomic_load((const unsigned*)tilepre + lane + 1, __ATOMIC_RELAXED, __HIP_MEMORY_SCOPE_AGENT);
        total = (int)__hip_atomic_load((const unsigned*)tilepre + NEX, __ATOMIC_RELAXED, __HIP_MEMORY_SCOPE_AGENT); nN = nN_; G = G_; c = c_; }
    __device__ bool next(int i, Unit& u) const { const long L = (long)i * G + c; if (L >= (long)total * nN) return false;
        const int T = (int)(L / nN); const int e = __popcll(__ballot(tpn <= T));
        u.pm = T; u.pn = (int)(L % nN); u.e = __builtin_amdgcn_readfirstlane(e); return true; } };
struct EpiGU { bf16_t* act;
    __device__ __forceinline__ bool operator()(f32x4 (&acc)[2][2][4][2], const Unit& u, int wr, int wc, int fr, int fq) const {
        MK_FRAG_LOOP(r, c) { const f32x4 a = acc[ai][bj][m][0], b = acc[ai][bj][m][1];
            u32x2 w; w.x = cvt_pk_bf16(fast_silu(a[0]) * a[1], fast_silu(a[2]) * a[3]); w.y = cvt_pk_bf16(fast_silu(b[0]) * b[1], fast_silu(b[2]) * b[3]);
            *(u32x2*)(act + (size_t)(u.pm * BM + r) * EF + ((u.pn * BM + c) >> 1)) = w; }
        return false; } };
struct EpiDown { const int* sdst; const float* sgate; bf16_t* rowsb;
    __device__ __forceinline__ bool operator()(f32x4 (&acc)[2][2][4][2], const Unit& u, int wr, int wc, int fr, int fq) const {
        int dst[8]; float gt[8];
#pragma unroll
        for (int q = 0; q < 8; ++q) { const int slot = u.pm * BM + (q >> 2) * HALF + wr * 64 + (q & 3) * 16 + fr; dst[q] = sdst[slot]; gt[q] = sgate[slot]; }
#pragma unroll
        for (int ai = 0; ai < 2; ++ai)
#pragma unroll
            for (int m = 0; m < 4; ++m) { const int q = ai * 4 + m; if (dst[q] >= 0) {
#pragma unroll
                for (int bj = 0; bj < 2; ++bj) { f32x4 a = acc[ai][bj][m][0], b = acc[ai][bj][m][1];
#pragma unroll
                    for (int j = 0; j < 4; ++j) { a[j] *= gt[q]; b[j] *= gt[q]; }
                    *(u32x4*)(rowsb + (size_t)dst[q] * D + u.pn * BM + bj * HALF + wc * 32 + 8 * fq) = pack8(a, b); } } }
        return false; } };
__device__ __forceinline__ void final_rows(LAS float* sm  , const In& in, const float* modpart, const bf16_t* rowsb, float* h1out, int b0, int r0, int row_lo, int row_hi, bool dry = false) {
    const int tid = threadIdx.x, lane = tid & 63, wid = tid >> 6;
    const int mr = b0 + row_lo / SEQ;
    __syncthreads();
    for (int j = tid; j < D; j += NT) sm[j] = mod_value(in, modpart, mr, 5 * D + j);
    __syncthreads();
    float gq[16];
#pragma unroll
    for (int j = 0; j < 4; ++j)
#pragma unroll
        for (int q = 0; q < 4; ++q) gq[4 * j + q] = sm[j * 256 + lane * 4 + q] * in.norm_g[3 * D + j * 256 + lane * 4 + q];
    for (int r = row_lo + wid; r < row_hi; r += NT / 64) {
        float v[16];
#pragma unroll
        for (int j = 0; j < 16; ++j) v[j] = 0.f;
        const bf16_t* rb = rowsb + (size_t)(r - r0) * SLOTS_PER_TOK * D;
#pragma unroll
        for (int s = 0; s < SLOTS_PER_TOK; ++s)
#pragma unroll
            for (int j = 0; j < 4; ++j) { const u32x2 w = *(const u32x2*)(rb + (size_t)s * D + j * 256 + lane * 4); v[4 * j] += bflo(w.x); v[4 * j + 1] += bfhi(w.x); v[4 * j + 2] += bflo(w.y); v[4 * j + 3] += bfhi(w.y); }
        float ss = 0.f;
#pragma unroll
        for (int j = 0; j < 16; ++j) ss += v[j] * v[j];
#pragma unroll
        for (int o = 32; o > 0; o >>= 1) ss += __shfl_xor(ss, o);
        const float rinv = 1.f / sqrtf(ss * (1.f / D) + NORM_EPS);
        float* hp = h1out + (size_t)r * D;
#pragma unroll
        for (int j = 0; j < 4; ++j) { const int c = j * 256 + lane * 4; f32x4 hv = *(const f32x4*)(hp + c);
#pragma unroll
            for (int q = 0; q < 4; ++q) hv[q] += gq[4 * j + q] * (v[4 * j + q] * rinv);
            if (!dry) *(f32x4*)(hp + c) = hv; else if (hv[0] == 1.2345e30f) *(f32x4*)(hp + c) = hv; }
    }
}
__device__ __forceinline__ void rwt_prep(const In& in, bf16_t* rwt, int bid, int nblk) {
    for (int i = bid * NT + threadIdx.x; i < NE * D; i += nblk * NT) { const int e = i / D, k = i % D; const float w = in.router_w[(size_t)k * NE + e]; const bf16_t h = f2bf(w); rwt[i] = h; rwt[(size_t)NE * D + i] = f2bf(w - bf2f(h)); }
}
}

using namespace mk;
constexpr size_t MiB = (size_t)1 << 20;
constexpr int NLAT = NB * SEQ, NCTXR = NB * CTX, NALL = NLAT + NCTXR, NRH = NLAT / 2, MAXSLOTS = NRH * SLOTS_PER_TOK + NE * BM;
constexpr size_t O_W1A = 0, O_W1C = O_W1A + (size_t)Z1_N * D * 2, O_WG = O_W1C + (size_t)ZC_N * D * 2, O_WBR = O_WG + (size_t)RW * AG_K * 2, O_WOUT = O_WBR + (size_t)2 * D * RW * 2,
                 O_RWT = O_WOUT + (size_t)D * D * 2, O_MODP = O_RWT + (size_t)2 * NE * D * 2, O_S_END = O_MODP + (size_t)MOD_SL * (NB + 1) * 6 * D * 4;
static_assert(O_S_END <= 27 * MiB, "S region");
constexpr size_t O_BAR = 27 * MiB;
constexpr size_t O_Z1 = 28 * MiB, O_R2 = O_Z1 + (size_t)NALL * Z1_N * 2;
static_assert(O_R2 == 334 * MiB, "z1 size");
constexpr size_t O_HD = O_R2, O_BON = O_HD + (size_t)2 * NLAT * LW * 2, O_AG = O_BON + (size_t)2 * NLAT * NH * 4, O_R2_END = O_AG + (size_t)NLAT * AG_K * 2;
static_assert(O_R2_END <= 512 * MiB, "R2");
constexpr size_t O_XNL = O_Z1, O_YB = O_XNL + (size_t)NLAT * D * 2, O_GATES = O_YB + (size_t)NLAT * LW * 2, O_MIXED = O_HD;
static_assert(O_GATES + (size_t)NLAT * 2 * D * 2 <= O_R2, "late R1");
constexpr size_t O_U = O_Z1, O_WGU = O_U + (size_t)NLAT * D * 2, O_WDN = O_WGU + (size_t)NEX * 2 * EF * D * 2, O_ROUT = O_WDN + (size_t)NEX * D * EF * 2;
constexpr size_t O_TOPE = O_ROUT, O_LRANK = O_TOPE + (size_t)NLAT * TOPK * 4, O_GATEV = O_LRANK + (size_t)NLAT * TOPK * 4, O_BLKCNT = O_GATEV + (size_t)NLAT * TOPK * 4, O_TILEPRE = O_BLKCNT + 256 * 64 * 4,
                 O_LIST = O_TILEPRE + 1024, O_SDST = O_LIST + (size_t)MAXSLOTS * 4, O_SGATE = O_SDST + (size_t)MAXSLOTS * 4, O_ACT = ((O_SGATE + (size_t)MAXSLOTS * 4 + 255) / 256) * 256,
                 O_ROWSB = ((O_ACT + (size_t)MAXSLOTS * EF * 2 + 255) / 256) * 256, O_END = O_ROWSB + (size_t)NRH * SLOTS_PER_TOK * D * 2;
static_assert(O_END <= 512 * MiB, "workspace");
static_assert(O_WGU >= O_YB && O_ROWSB >= O_GATES, "late layout");

struct MP { In in; float* out; unsigned char* ws; long ph_lo, ph_hi; };
constexpr int NPHASE = 17;

#if defined(__HIP_DEVICE_COMPILE__)
#define MK_KARGS auto Pq_ = Pk_; asm volatile("" : "+s"(Pq_)); const MP* Pg_ = (const MP*)Pq_; const In in = Pg_->in; unsigned char* ws = Pg_->ws; float* out_ = Pg_->out; (void)out_;
#else
#define MK_KARGS const In in = P.in; unsigned char* ws = P.ws; float* out_ = P.out; (void)out_; (void)Pk_;
#endif
#define MK_PHASE_PTRS \
    MK_KARGS \
    bf16_t *W1a = (bf16_t*)(ws + O_W1A), *W1c = (bf16_t*)(ws + O_W1C), *Wg = (bf16_t*)(ws + O_WG), *Wbr = (bf16_t*)(ws + O_WBR), *Wout = (bf16_t*)(ws + O_WOUT), *rwt = (bf16_t*)(ws + O_RWT); \
    float* modpart = (float*)(ws + O_MODP); \
    bf16_t *z1 = (bf16_t*)(ws + O_Z1), *Hd = (bf16_t*)(ws + O_HD), *Ag = (bf16_t*)(ws + O_AG); float* bon = (float*)(ws + O_BON); \
    bf16_t *xnl = (bf16_t*)(ws + O_XNL), *yb = (bf16_t*)(ws + O_YB), *gates = (bf16_t*)(ws + O_GATES), *mixed = (bf16_t*)(ws + O_MIXED); \
    bf16_t *u = (bf16_t*)(ws + O_U), *Wgu = (bf16_t*)(ws + O_WGU), *Wdn = (bf16_t*)(ws + O_WDN), *act = (bf16_t*)(ws + O_ACT), *rowsb = (bf16_t*)(ws + O_ROWSB); \
    int *tope = (int*)(ws + O_TOPE), *lrank = (int*)(ws + O_LRANK), *blkcnt = (int*)(ws + O_BLKCNT), *tilepre = (int*)(ws + O_TILEPRE), *list = (int*)(ws + O_LIST), *sdst = (int*)(ws + O_SDST); \
    float *gatev = (float*)(ws + O_GATEV), *sgate = (float*)(ws + O_SGATE); \
    bf16_t* xn_all = (bf16_t*)out_; \
    bf16_t* Y = (bf16_t*)out_; \
    float* y2h1 = out_;
__global__ void __launch_bounds__(512, 2) mega(MP P) {
    extern __shared__ __attribute__((aligned(16))) unsigned char shm[];
    LAS unsigned char* lds = (LAS unsigned char*)shm;
    typedef const __attribute__((address_space(4))) MP* KargP;
    const KargP Pk_ = (KargP)__builtin_amdgcn_kernarg_segment_ptr();
    const int bid = blockIdx.x, nblk = gridDim.x;
    const int ph_lo = (int)P.ph_lo, ph_hi = (int)P.ph_hi;
    volatile LAS unsigned* xst = (volatile LAS unsigned*)(lds + LDS_BYTES - 16);
    if (threadIdx.x == 0) { xst[0] = 0u; xst[1] = 0u; }
    __syncthreads();
    const XcdBarrier xb = xcd_barrier_post((unsigned*)(P.ws + O_BAR), xst);
    if (0 >= ph_lo && 0 < ph_hi) { if (0 > ph_lo) xcd_barrier(xb); const int ph = 0; (void)ph; MK_PHASE_PTRS
        { LAS float* tile = (LAS float*)lds; int base = 0;
            convT_job(tile, in.w_in, INC, D, W1a, D, Z1_N, CMapZ1{}, bid, nblk, base);
            convT_job(tile, in.w_in, INC, D, W1c, D, ZC_N, CMapZC{}, bid, nblk, base);
            convT_job(tile, in.rw_g_up, RW, GL, Wg, AG_K, RW, CMapId{}, bid, nblk, base);
            convT_job(tile, in.w_branch_a, D, RW, Wbr, RW, D, CMapId{}, bid, nblk, base);
            convT_job(tile, in.w_branch_b, D, LW, Wbr + (size_t)D * RW, LW, D, CMapId{}, bid, nblk, base);
            convT_job(tile, in.w_out, D, D, Wout, D, D, CMapId{}, bid, nblk, base);
            rwt_prep(in, rwt, bid, nblk);
            mod_partials((LAS float*)lds, in, modpart, bid, nblk); }
    }
    if (1 >= ph_lo && 1 < ph_hi) { if (1 > ph_lo) xcd_barrier(xb); const int ph = 1; (void)ph; MK_PHASE_PTRS
        { const int L = NLAT / nblk, Lc = NCTXR / nblk;
            xn_rows((LAS float*)lds, in, modpart, xn_all, 0, NB, bid * L, (bid + 1) * L);
            xn_rows((LAS float*)lds, in, modpart, xn_all, 0, NB, NLAT + bid * Lc, NLAT + (bid + 1) * Lc); }
    }
    if (2 >= ph_lo && 2 < ph_hi) { if (2 > ph_lo) xcd_barrier(xb); const int ph = 2; (void)ph; MK_PHASE_PTRS
        { GemmP g{xn_all, xn_all, W1a, 0, nullptr, D, 0}; StaticOrder S; S.init(NALL, Z1_N, nblk, bid); gemm_phase(lds, g, S, EpiStoreBf16{z1, Z1_N}); }
    }
    if (3 >= ph_lo && 3 < ph_hi) { if (3 > ph_lo) xcd_barrier(xb); const int ph = 3; (void)ph; MK_PHASE_PTRS
        { LruP lp{z1, Hd, 0, NB}; lru_phase(lds, in, lp, bid, nblk); __syncthreads();
                  RwkvP rp{z1, Y, bon, 0, NB}; rwkv_phase2(lds, in, rp, bid, nblk); }
    }
    if (4 >= ph_lo && 4 < ph_hi) { if (4 > ph_lo) xcd_barrier(xb); const int ph = 4; (void)ph; MK_PHASE_PTRS
        { const int L = NLAT / nblk; PostP pp{z1, Y, bon, Ag, NLAT, 0}; rwkv_post_rows(in, pp, bid * L, (bid + 1) * L); }
    }
    if (5 >= ph_lo && 5 < ph_hi) { if (5 > ph_lo) xcd_barrier(xb); const int ph = 5; (void)ph; MK_PHASE_PTRS
        { const int L = NLAT / nblk; xn_rows((LAS float*)lds, in, modpart, xnl, 0, NB, bid * L, (bid + 1) * L); __syncthreads();
                  GemmP g{Ag, Ag, Wg, 0, nullptr, AG_K, 0}; StaticOrder S; S.init(NLAT, RW, nblk, bid); gemm_phase(lds, g, S, EpiYa{Y, Y + (size_t)NLAT * RW}); }
    }
    if (6 >= ph_lo && 6 < ph_hi) { if (6 > ph_lo) xcd_barrier(xb); const int ph = 6; (void)ph; MK_PHASE_PTRS
        { GemmP g{xnl, xnl, W1c, 0, nullptr, D, 0}; StaticOrder S; S.init(NLAT, ZC_N, nblk, bid); gemm_phase(lds, g, S, EpiZc{Hd, yb, gates, NLAT, 0}); }
    }
    if (7 >= ph_lo && 7 < ph_hi) { if (7 > ph_lo) xcd_barrier(xb); const int ph = 7; (void)ph; MK_PHASE_PTRS
        { GemmP g{Y + (size_t)NLAT * RW, yb, Wbr, (long)D * RW, nullptr, D, 0}; PairOrder S; S.S.init(NLAT, D, nblk, bid); gemm_phase(lds, g, S, EpiBranch{gates, mixed}); }
    }
    if (8 >= ph_lo && 8 < ph_hi) { if (8 > ph_lo) xcd_barrier(xb); const int ph = 8; (void)ph; MK_PHASE_PTRS
        { LAS float* tile = (LAS float*)lds; int base = 0;
            for (int e = 0; e < NE; ++e) {
                convT_job(tile, in.ex_w_gu + (size_t)e * D * 2 * EF, 2 * EF, D, Wgu + (size_t)e * 2 * EF * D, D, 2 * EF, CMapGU{EF}, bid, nblk, base);
                convT_job(tile, in.ex_w_down + (size_t)e * EF * D, D, EF, Wdn + (size_t)e * D * EF, EF, D, CMapId{}, bid, nblk, base); }
            convT_job(tile, in.sh_w_gu, 2 * SF, D, Wgu + (size_t)NE * 2 * EF * D, D, 2 * SF, CMapGU{SF}, bid, nblk, base);
            convT_job(tile, in.sh_w_down, D, SF, Wdn + (size_t)NE * D * EF, SF, D, CMapId{}, bid, nblk, base);
            __syncthreads();
            GemmP g{mixed, mixed, Wout, 0, nullptr, D, 0}; StaticOrder S; S.init(NLAT, D, nblk, bid); gemm_phase(lds, g, S, EpiF32{y2h1, D}); }
    }
    if (9 >= ph_lo && 9 < ph_hi) { if (9 > ph_lo) xcd_barrier(xb); const int ph = 9; (void)ph; MK_PHASE_PTRS
        { const int L = NLAT / nblk; RowP rp{y2h1, u, modpart, rwt, tope, gatev, lrank, blkcnt, 0, NLAT}; row_pass(lds, in, rp, bid * L, (bid + 1) * L); }
    }
    if (10 >= ph_lo && 10 < ph_hi) { if (10 > ph_lo) xcd_barrier(xb); const int ph = 10; (void)ph; MK_PHASE_PTRS
        { const int q = ph - 10, half = q >= 4 ? 1 : 0, st = q - 4 * half;
            const int rpb = NLAT / nblk;
            auto assign = [&](int hf) { MoeP mp{tope, gatev, lrank, blkcnt, tilepre, list, sdst, sgate, hf * NRH, NRH, hf * (nblk / 2), nblk / 2, rpb, 0}; moe_assign(lds, mp, bid, nblk); };
            auto fin = [&](int hf) { const int L = NRH / nblk, r0 = hf * NRH; final_rows((LAS float*)lds, in, modpart, rowsb, y2h1, 0, r0, r0 + bid * L, r0 + (bid + 1) * L); };
            if (ph == 10) assign(0);
            else if (ph == 11 || ph == 14) { GemmP g{u, u, Wgu, (long)2 * EF * D, list, D, 0}; GroupOrder S; S.init(tilepre, 2 * EF / BM, nblk, bid); gemm_phase<true>(lds, g, S, EpiGU{act}); }
            else if (ph == 12 || ph == 15) { GemmP g{act, act, Wdn, (long)D * EF, nullptr, EF, 0}; GroupOrder S; S.init(tilepre, D / BM, nblk, bid); gemm_phase(lds, g, S, EpiDown{sdst, sgate, rowsb}); }
            else if (ph == 13) { fin(0); __syncthreads(); assign(1); }
            else if (ph == 16) fin(1);
            (void)half; (void)st; }
    }
    if (11 >= ph_lo && 11 < ph_hi) { if (11 > ph_lo) xcd_barrier(xb); const int ph = 11; (void)ph; MK_PHASE_PTRS
        { const int q = ph - 10, half = q >= 4 ? 1 : 0, st = q - 4 * half;
            const int rpb = NLAT / nblk;
            auto assign = [&](int hf) { MoeP mp{tope, gatev, lrank, blkcnt, tilepre, list, sdst, sgate, hf * NRH, NRH, hf * (nblk / 2), nblk / 2, rpb, 0}; moe_assign(lds, mp, bid, nblk); };
            auto fin = [&](int hf) { const int L = NRH / nblk, r0 = hf * NRH; final_rows((LAS float*)lds, in, modpart, rowsb, y2h1, 0, r0, r0 + bid * L, r0 + (bid + 1) * L); };
            if (ph == 10) assign(0);
            else if (ph == 11 || ph == 14) { GemmP g{u, u, Wgu, (long)2 * EF * D, list, D, 0}; GroupOrder S; S.init(tilepre, 2 * EF / BM, nblk, bid); gemm_phase<true>(lds, g, S, EpiGU{act}); }
            else if (ph == 12 || ph == 15) { GemmP g{act, act, Wdn, (long)D * EF, nullptr, EF, 0}; GroupOrder S; S.init(tilepre, D / BM, nblk, bid); gemm_phase(lds, g, S, EpiDown{sdst, sgate, rowsb}); }
            else if (ph == 13) { fin(0); __syncthreads(); assign(1); }
            else if (ph == 16) fin(1);
            (void)half; (void)st; }
    }
    if (12 >= ph_lo && 12 < ph_hi) { if (12 > ph_lo) xcd_barrier(xb); const int ph = 12; (void)ph; MK_PHASE_PTRS
        { const int q = ph - 10, half = q >= 4 ? 1 : 0, st = q - 4 * half;
            const int rpb = NLAT / nblk;
            auto assign = [&](int hf) { MoeP mp{tope, gatev, lrank, blkcnt, tilepre, list, sdst, sgate, hf * NRH, NRH, hf * (nblk / 2), nblk / 2, rpb, 0}; moe_assign(lds, mp, bid, nblk); };
            auto fin = [&](int hf) { const int L = NRH / nblk, r0 = hf * NRH; final_rows((LAS float*)lds, in, modpart, rowsb, y2h1, 0, r0, r0 + bid * L, r0 + (bid + 1) * L); };
            if (ph == 10) assign(0);
            else if (ph == 11 || ph == 14) { GemmP g{u, u, Wgu, (long)2 * EF * D, list, D, 0}; GroupOrder S; S.init(tilepre, 2 * EF / BM, nblk, bid); gemm_phase<true>(lds, g, S, EpiGU{act}); }
            else if (ph == 12 || ph == 15) { GemmP g{act, act, Wdn, (long)D * EF, nullptr, EF, 0}; GroupOrder S; S.init(tilepre, D / BM, nblk, bid); gemm_phase(lds, g, S, EpiDown{sdst, sgate, rowsb}); }
            else if (ph == 13) { fin(0); __syncthreads(); assign(1); }
            else if (ph == 16) fin(1);
            (void)half; (void)st; }
    }
    if (13 >= ph_lo && 13 < ph_hi) { if (13 > ph_lo) xcd_barrier(xb); const int ph = 13; (void)ph; MK_PHASE_PTRS
        { const int q = ph - 10, half = q >= 4 ? 1 : 0, st = q - 4 * half;
            const int rpb = NLAT / nblk;
            auto assign = [&](int hf) { MoeP mp{tope, gatev, lrank, blkcnt, tilepre, list, sdst, sgate, hf * NRH, NRH, hf * (nblk / 2), nblk / 2, rpb, 0}; moe_assign(lds, mp, bid, nblk); };
            auto fin = [&](int hf) { const int L = NRH / nblk, r0 = hf * NRH; final_rows((LAS float*)lds, in, modpart, rowsb, y2h1, 0, r0, r0 + bid * L, r0 + (bid + 1) * L); };
            if (ph == 10) assign(0);
            else if (ph == 11 || ph == 14) { GemmP g{u, u, Wgu, (long)2 * EF * D, list, D, 0}; GroupOrder S; S.init(tilepre, 2 * EF / BM, nblk, bid); gemm_phase<true>(lds, g, S, EpiGU{act}); }
            else if (ph == 12 || ph == 15) { GemmP g{act, act, Wdn, (long)D * EF, nullptr, EF, 0}; GroupOrder S; S.init(tilepre, D / BM, nblk, bid); gemm_phase(lds, g, S, EpiDown{sdst, sgate, rowsb}); }
            else if (ph == 13) { fin(0); __syncthreads(); assign(1); }
            else if (ph == 16) fin(1);
            (void)half; (void)st; }
    }
    if (14 >= ph_lo && 14 < ph_hi) { if (14 > ph_lo) xcd_barrier(xb); const int ph = 14; (void)ph; MK_PHASE_PTRS
        { const int q = ph - 10, half = q >= 4 ? 1 : 0, st = q - 4 * half;
            const int rpb = NLAT / nblk;
            auto assign = [&](int hf) { MoeP mp{tope, gatev, lrank, blkcnt, tilepre, list, sdst, sgate, hf * NRH, NRH, hf * (nblk / 2), nblk / 2, rpb, 0}; moe_assign(lds, mp, bid, nblk); };
            auto fin = [&](int hf) { const int L = NRH / nblk, r0 = hf * NRH; final_rows((LAS float*)lds, in, modpart, rowsb, y2h1, 0, r0, r0 + bid * L, r0 + (bid + 1) * L); };
            if (ph == 10) assign(0);
            else if (ph == 11 || ph == 14) { GemmP g{u, u, Wgu, (long)2 * EF * D, list, D, 0}; GroupOrder S; S.init(tilepre, 2 * EF / BM, nblk, bid); gemm_phase<true>(lds, g, S, EpiGU{act}); }
            else if (ph == 12 || ph == 15) { GemmP g{act, act, Wdn, (long)D * EF, nullptr, EF, 0}; GroupOrder S; S.init(tilepre, D / BM, nblk, bid); gemm_phase(lds, g, S, EpiDown{sdst, sgate, rowsb}); }
            else if (ph == 13) { fin(0); __syncthreads(); assign(1); }
            else if (ph == 16) fin(1);
            (void)half; (void)st; }
    }
    if (15 >= ph_lo && 15 < ph_hi) { if (15 > ph_lo) xcd_barrier(xb); const int ph = 15; (void)ph; MK_PHASE_PTRS
        { const int q = ph - 10, half = q >= 4 ? 1 : 0, st = q - 4 * half;
            const int rpb = NLAT / nblk;
            auto assign = [&](int hf) { MoeP mp{tope, gatev, lrank, blkcnt, tilepre, list, sdst, sgate, hf * NRH, NRH, hf * (nblk / 2), nblk / 2, rpb, 0}; moe_assign(lds, mp, bid, nblk); };
            auto fin = [&](int hf) { const int L = NRH / nblk, r0 = hf * NRH; final_rows((LAS float*)lds, in, modpart, rowsb, y2h1, 0, r0, r0 + bid * L, r0 + (bid + 1) * L); };
            if (ph == 10) assign(0);
            else if (ph == 11 || ph == 14) { GemmP g{u, u, Wgu, (long)2 * EF * D, list, D, 0}; GroupOrder S; S.init(tilepre, 2 * EF / BM, nblk, bid); gemm_phase<true>(lds, g, S, EpiGU{act}); }
            else if (ph == 12 || ph == 15) { GemmP g{act, act, Wdn, (long)D * EF, nullptr, EF, 0}; GroupOrder S; S.init(tilepre, D / BM, nblk, bid); gemm_phase(lds, g, S, EpiDown{sdst, sgate, rowsb}); }
            else if (ph == 13) { fin(0); __syncthreads(); assign(1); }
            else if (ph == 16) fin(1);
            (void)half; (void)st; }
    }
    if (16 >= ph_lo && 16 < ph_hi) { if (16 > ph_lo) xcd_barrier(xb); const int ph = 16; (void)ph; MK_PHASE_PTRS
        { const int q = ph - 10, half = q >= 4 ? 1 : 0, st = q - 4 * half;
            const int rpb = NLAT / nblk;
            auto assign = [&](int hf) { MoeP mp{tope, gatev, lrank, blkcnt, tilepre, list, sdst, sgate, hf * NRH, NRH, hf * (nblk / 2), nblk / 2, rpb, 0}; moe_assign(lds, mp, bid, nblk); };
            auto fin = [&](int hf) { const int L = NRH / nblk, r0 = hf * NRH; final_rows((LAS float*)lds, in, modpart, rowsb, y2h1, 0, r0, r0 + bid * L, r0 + (bid + 1) * L); };
            if (ph == 10) assign(0);
            else if (ph == 11 || ph == 14) { GemmP g{u, u, Wgu, (long)2 * EF * D, list, D, 0}; GroupOrder S; S.init(tilepre, 2 * EF / BM, nblk, bid); gemm_phase<true>(lds, g, S, EpiGU{act}); }
            else if (ph == 12 || ph == 15) { GemmP g{act, act, Wdn, (long)D * EF, nullptr, EF, 0}; GroupOrder S; S.init(tilepre, D / BM, nblk, bid); gemm_phase(lds, g, S, EpiDown{sdst, sgate, rowsb}); }
            else if (ph == 13) { fin(0); __syncthreads(); assign(1); }
            else if (ph == 16) fin(1);
            (void)half; (void)st; }
    }
}
extern "C" void kernel_launch(void* const* d_in, const int* in_sizes, int n_in, void* d_out, int out_size, void* d_ws, size_t ws_size, hipStream_t stream) {
    static int grid = 0;
    if (grid == 0) {
        int dev = 0, cus = 0; hipGetDevice(&dev); hipDeviceGetAttribute(&cus, hipDeviceAttributeMultiprocessorCount, dev);
        hipFuncSetAttribute((const void*)mega, hipFuncAttributeMaxDynamicSharedMemorySize, LDS_BYTES);
        grid = cus;
        if (ws_size < O_END || grid != 256) fprintf(stderr, "kernel_launch: unexpected ws_size %zu (need %zu) or CU count %d\n", ws_size, (size_t)O_END, grid);
    }
    hipMemsetAsync((char*)d_ws + O_BAR, 0, XCD_BAR_WORDS * 4, stream);
    MP P; memset(&P, 0, sizeof(P));
    const float** f = (const float**)&P.in; for (int i = 0; i < 32; ++i) f[i] = (const float*)d_in[i];
    P.out = (float*)d_out; P.ws = (unsigned char*)d_ws;
#ifdef MK_PER_PHASE
    for (int ph = 0; ph < NPHASE; ++ph) { P.ph_lo = ph; P.ph_hi = ph + 1; hipLaunchKernelGGL(mega, dim3(grid), dim3(NT), LDS_BYTES, stream, P); }
#else
    P.ph_lo = 0; P.ph_hi = NPHASE;
    void* args[] = {&P};
    hipError_t e = hipLaunchCooperativeKernel((void*)mega, dim3(grid), dim3(NT), args, LDS_BYTES, stream);
    if (e != hipSuccess) fprintf(stderr, "cooperative launch failed: %s (grid %d)\n", hipGetErrorString(e), grid);
#endif
}
```

```cpp
#include <hip/hip_runtime.h>
#include <cstdio>
#include <cstring>
#define HD __host__ __device__ __forceinline__
static hipStream_t g_stream;

#ifdef SMALL
constexpr int D = 128, NB = 2, SEQ = 64, GW = 8, CTX = 16, RW = 128, RH = 64, DL = 16, AL = 16, GL = 24, LW = 128, LB = 2, NE = 8, TOPK = 3, NG = 4, TG = 2, EF = 32, SF = 32;
#else
constexpr int D = 1024, NB = 8, SEQ = 4096, GW = 64, CTX = 256, RW = 1024, RH = 64, DL = 64, AL = 64, GL = 160, LW = 1024, LB = 16, NE = 64, TOPK = 6, NG = 8, TG = 4, EF = 256, SF = 256;
#endif
constexpr int NH = RW / RH, LBS = LW / LB, ROWS = SEQ / GW, TA = CTX + SEQ;
constexpr int OFF_R = 0, OFF_K = RW, OFF_V = 2 * RW, OFF_WD = 3 * RW, OFF_AD = OFF_WD + 2 * DL, OFF_GD = OFF_AD + 2 * AL, RC = OFF_GD + GL;
constexpr int OFF_LX = RC, OFF_LG = OFF_LX + LW, OFF_GATE = OFF_LG + LW, INC = OFF_GATE + 2 * D;
constexpr int EPG = NE / NG, NASG = SEQ * TOPK;
#define NORM_EPS 1e-6f
#define LNX_EPS 64e-5f

HD float sigmoidf_(float x) { return 1.f / (1.f + expf(-x)); }
HD float softplusf_(float x) { return x > 20.f ? x : log1pf(expf(x)); }
HD float siluf_(float x) { return x * sigmoidf_(x); }
HD float gelu_tanhf_(float x) { return 0.5f * x * (1.f + tanhf(0.7978845608028654f * (x + 0.044715f * x * x * x))); }

struct In {
    const float *x, *c, *ctx, *c_ctx, *w_mod, *b_mod, *norm_g, *w_in, *shift_mu, *rw_w0, *rw_w_up, *rw_a0, *rw_a_up, *rw_g_up, *rw_k_k, *rw_k_a, *rw_r_k, *rw_lnx,
        *lru_conv_w, *lru_conv_b, *lru_gate_w, *lru_gate_b, *lru_l, *w_branch_a, *w_branch_b, *w_out, *router_w, *router_b, *ex_w_gu, *ex_w_down, *sh_w_gu, *sh_w_down;
};


namespace mk {
#define LAS __attribute__((address_space(3)))
typedef unsigned short bf16_t;
typedef short bf16x8 __attribute__((ext_vector_type(8)));
typedef float f32x4 __attribute__((ext_vector_type(4)));
typedef float f32x2 __attribute__((ext_vector_type(2)));
typedef unsigned u32x4 __attribute__((ext_vector_type(4)));
typedef unsigned u32x2 __attribute__((ext_vector_type(2)));
constexpr int NT = 512;
constexpr int BM = 256, BK = 64, HALF = 128, HTB = HALF * BK * 2, STAGE_BYTES = 8 * HTB;
constexpr int LDS_BYTES = 160 * 1024 - 1024;

constexpr int Z1_LX = 3584, Z1_N = 4608;
constexpr int ZC_N = 3072;

__device__ __forceinline__ unsigned cvt_pk_bf16(float lo, float hi) { unsigned r; asm volatile("v_cvt_pk_bf16_f32 %0, %1, %2" : "=v"(r) : "v"(lo), "v"(hi)); return r; }
__device__ __forceinline__ bf16_t f2bf(float f) { unsigned u = __float_as_uint(f); u += 0x7FFFu + ((u >> 16) & 1u); return (bf16_t)(u >> 16); }
__device__ __forceinline__ float bf2f(bf16_t b) { return __uint_as_float(((unsigned)b) << 16); }
__device__ __forceinline__ float bflo(unsigned w) { return __uint_as_float(w << 16); }
__device__ __forceinline__ float bfhi(unsigned w) { return __uint_as_float(w & 0xffff0000u); }

__device__ __forceinline__ float fast_rcp(float x) { return __builtin_amdgcn_rcpf(x); }
__device__ __forceinline__ float fast_sigmoid(float x) { return fast_rcp(1.f + __expf(-x)); }
__device__ __forceinline__ float fast_tanh(float x) { return 1.f - 2.f * fast_rcp(1.f + __expf(2.f * x)); }
__device__ __forceinline__ float fast_softplus(float x) { return x > 15.f ? x : __logf(1.f + __expf(x)); }
__device__ __forceinline__ float fast_silu(float x) { return x * fast_sigmoid(x); }
__device__ __forceinline__ float fast_gelu_tanh(float x) { return x * fast_sigmoid(1.5957691216057308f * (x + 0.044715f * x * x * x)); }
__device__ __forceinline__ int lds_byte(int r, int c) { const int st = (r >> 4) * 2 + (c >> 5), rr = r & 15, cc = c & 31, ob = rr * 64 + cc * 2; return st * 1024 + (ob ^ (((ob >> 9) & 1) << 5)); }
__device__ __forceinline__ void stage_rc(int b, int& R, int& C) { const int st = b / 1024, sb = b % 1024, swz = sb ^ (((sb >> 9) & 1) << 5); R = (st >> 1) * 16 + swz / 64; C = (st & 1) * 32 + (swz % 64) / 2; }
__device__ __forceinline__ int perm32(int rho) { const int n = rho >> 4, i = rho & 15; return 8 * (i >> 2) + 4 * n + (i & 3); }

struct Unit { int pm, pn, e; };
struct GemmP { const bf16_t* A0; const bf16_t* A1; const bf16_t* Bt; long strideB; const int* gather; int K; int pad_; };

struct StaticOrder {
    int nM, nN, nwg, G, c;
    __device__ void init(int M, int N, int G_, int c_) { nM = M / BM; nN = N / BM; nwg = nM * nN; G = G_; c = c_; }
    __device__ bool next(int i, Unit& u) const {
        const long L = (long)i * G + c; if (L >= nwg) return false;
        int wgid = (int)L; { const int q = nwg / 8, r = nwg % 8, xcd = wgid % 8, off = wgid / 8; wgid = (xcd < r ? xcd * (q + 1) : r * (q + 1) + (xcd - r) * q) + off; }
        const int nig = 8 * nN, gid = wgid / nig, fm = gid * 8, gsz = (nM - fm) < 8 ? (nM - fm) : 8;
        u.pm = fm + ((wgid % nig) % gsz); u.pn = (wgid % nig) / gsz; u.e = 0; return true;
    }
};

#define MK_FRAG_LOOP(ROW, COL) \
    _Pragma("unroll") for (int ai = 0; ai < 2; ++ai) _Pragma("unroll") for (int m = 0; m < 4; ++m) _Pragma("unroll") for (int bj = 0; bj < 2; ++bj) \
        if (const int ROW = ai * HALF + wr * 64 + m * 16 + fr; true) if (const int COL = bj * HALF + wc * 32 + 8 * fq; true)

template <bool GATHER = false, class Epi, class Sched>
__device__ __forceinline__ void gemm_phase(LAS unsigned char* lds, const GemmP g, const Sched& S, const Epi& E) {
    const int tid = threadIdx.x, wid = __builtin_amdgcn_readfirstlane(tid >> 6), lane = tid & 63, wr = wid >> 2, wc = wid & 3, fr = lane & 15, fq = lane >> 4;
    int K = g.K; asm volatile("" : "+s"(K));
    const int nt = K / BK;
    int RA[2], CA[2]; unsigned voffB[2];
#pragma unroll
    for (int i = 0; i < 2; ++i) { int R, C; stage_rc(tid * 16 + i * 8192, R, C); RA[i] = R; CA[i] = C; const int Rb = (R & ~31) + perm32(R & 31); voffB[i] = (unsigned)(Rb * K + C) * 2u; }
    const size_t kstep = (size_t)(BK * 2), hstepB = (size_t)HALF * K * 2, tstepB = 2 * hstepB;
    const unsigned ldsw = (unsigned)wid * 1024u;
    const int aoff = lds_byte(wr * 64 + fr, fq * 8), boff = lds_byte(wc * 32 + fr, fq * 8);
#define MK_SA(b, h) (((b) * 2 + (h)) * HTB)
#define MK_SB(b, h) ((4 + (b) * 2 + (h)) * HTB)
#define MK_STAGE(bufoff, gbase, voff) do { _Pragma("unroll") for (int _i = 0; _i < 2; ++_i) \
        __builtin_amdgcn_global_load_lds((const unsigned*)((const char*)(gbase) + (voff)[_i]), (LAS unsigned*)(lds + (bufoff) + ldsw + _i * 8192), 16, 0, 0); } while (0)
#define MK_LDA(dst, b, h) do { _Pragma("unroll") for (int m = 0; m < 4; ++m) _Pragma("unroll") for (int k = 0; k < 2; ++k) dst[m][k] = *(const LAS bf16x8*)(lds + MK_SA(b, h) + aoff + m * 2048 + k * 1024); } while (0)
#define MK_LDB(dst, b, h) do { _Pragma("unroll") for (int n = 0; n < 2; ++n) _Pragma("unroll") for (int k = 0; k < 2; ++k) dst[n][k] = *(const LAS bf16x8*)(lds + MK_SB(b, h) + boff + n * 2048 + k * 1024); } while (0)
#define MK_MMA(ai, bj, At, Bt) do { __builtin_amdgcn_s_setprio(1); _Pragma("unroll") for (int m = 0; m < 4; ++m) _Pragma("unroll") for (int n = 0; n < 2; ++n) _Pragma("unroll") for (int k = 0; k < 2; ++k) \
        acc[ai][bj][m][n] = __builtin_amdgcn_mfma_f32_16x16x32_bf16(Bt[n][k], At[m][k], acc[ai][bj][m][n], 0, 0, 0); __builtin_amdgcn_s_setprio(0); } while (0)
#define MK_WAIT_V(n) asm volatile("s_waitcnt vmcnt(" #n ")" ::: "memory")
#define MK_WAIT_L(n) asm volatile("s_waitcnt lgkmcnt(" #n ")" ::: "memory")
#define MK_BAR __builtin_amdgcn_s_barrier()
#define MK_SCHED __builtin_amdgcn_sched_barrier(0)
    Unit cur, nxt; int ui = 0;
    if (!S.next(0, cur)) return;
    f32x4 acc[2][2][4][2];
#pragma unroll
    for (int a = 0; a < 2; ++a)
#pragma unroll
        for (int b = 0; b < 2; ++b)
#pragma unroll
            for (int m = 0; m < 4; ++m)
#pragma unroll
                for (int n = 0; n < 2; ++n) acc[a][b][m][n] = (f32x4){0.f, 0.f, 0.f, 0.f};
    bf16x8 At[4][2], B0[2][2], B1[2][2];
    unsigned vA[2][2], vAn[2][2];
    const size_t hstepA = GATHER ? 0 : (size_t)HALF * K * 2, tstepA = 2 * (size_t)HALF * K * 2;
    auto a_voff = [&](const Unit& u, unsigned (&vo)[2][2]) {
#pragma unroll
        for (int h = 0; h < 2; ++h)
#pragma unroll
            for (int i = 0; i < 2; ++i) { if (GATHER) { const int row = u.pm * BM + h * HALF + RA[i]; vo[h][i] = (unsigned)((size_t)g.gather[row] * K + CA[i]) * 2u; } else vo[h][i] = (unsigned)(RA[i] * K + CA[i]) * 2u; }
    };
    a_voff(cur, vA);
    auto a_base = [&](const Unit& u) { return (const char*)(u.e ? g.A1 : g.A0) + (GATHER ? (size_t)0 : (size_t)u.pm * tstepA); };
    const char* cA = a_base(cur);
    const char* cB = (const char*)g.Bt + ((size_t)cur.e * g.strideB) * 2 + (size_t)cur.pn * tstepB;
    MK_STAGE(MK_SB(0, 0), cB, voffB); MK_STAGE(MK_SA(0, 0), cA, vA[0]); MK_STAGE(MK_SB(0, 1), cB + hstepB, voffB); MK_STAGE(MK_SA(0, 1), cA + hstepA, vA[1]);
    if (wr == 1) MK_BAR;
    MK_WAIT_V(4); MK_BAR;
    MK_STAGE(MK_SB(1, 0), cB + kstep, voffB); MK_STAGE(MK_SA(1, 0), cA + kstep, vA[0]); MK_STAGE(MK_SB(1, 1), cB + hstepB + kstep, voffB);
    MK_WAIT_V(6); MK_BAR;
    for (;;) {
        const bool has_next = S.next(ui + 1, nxt);
        const char* nA = has_next ? a_base(nxt) : cA;
        const char* nB = has_next ? (const char*)g.Bt + ((size_t)nxt.e * g.strideB) * 2 + (size_t)nxt.pn * tstepB : cB;
        for (int t = 0; t < nt; t += 2) {
            const bool last = (t == nt - 2);
            if (GATHER && last) { if (has_next) a_voff(nxt, vAn); else {
#pragma unroll
                for (int h = 0; h < 2; ++h)
#pragma unroll
                    for (int i = 0; i < 2; ++i) vAn[h][i] = vA[h][i]; } }
            const char* a1 = cA + (size_t)(t + 1) * kstep;
            const char* a2 = last ? nA : cA + (size_t)(t + 2) * kstep; const char* b2 = last ? nB : cB + (size_t)(t + 2) * kstep;
            const char* a3 = a2 + kstep; const char* b3 = b2 + kstep;
            unsigned v2[2][2];
#pragma unroll
            for (int h = 0; h < 2; ++h)
#pragma unroll
                for (int i = 0; i < 2; ++i) v2[h][i] = (GATHER && last) ? vAn[h][i] : vA[h][i];
            MK_LDB(B0, 0, 0); MK_SCHED; MK_LDA(At, 0, 0); MK_STAGE(MK_SA(1, 1), a1 + hstepA, vA[1]);
            MK_WAIT_L(8); MK_BAR; MK_WAIT_L(0); MK_MMA(0, 0, At, B0); MK_BAR; MK_SCHED;
            MK_LDB(B1, 0, 1); MK_STAGE(MK_SB(0, 0), b2, voffB);
            MK_BAR; MK_WAIT_L(0); MK_MMA(0, 1, At, B1); MK_BAR;
            MK_LDA(At, 0, 1); MK_STAGE(MK_SA(0, 0), a2, v2[0]);
            MK_BAR; MK_WAIT_L(0); MK_MMA(1, 0, At, B0); MK_BAR; MK_SCHED;
            MK_STAGE(MK_SB(0, 1), b2 + hstepB, voffB);
            MK_WAIT_V(6); MK_BAR; MK_MMA(1, 1, At, B1); MK_BAR;
            MK_LDB(B0, 1, 0); MK_SCHED; MK_LDA(At, 1, 0); MK_STAGE(MK_SA(0, 1), a2 + hstepA, v2[1]);
            MK_WAIT_L(8); MK_BAR; MK_WAIT_L(0); MK_MMA(0, 0, At, B0); MK_BAR; MK_SCHED;
            MK_LDB(B1, 1, 1); MK_STAGE(MK_SB(1, 0), b3, voffB);
            MK_BAR; MK_WAIT_L(0); MK_MMA(0, 1, At, B1); MK_BAR;
            MK_LDA(At, 1, 1); MK_STAGE(MK_SA(1, 0), a3, v2[0]);
            MK_BAR; MK_WAIT_L(0); MK_MMA(1, 0, At, B0); MK_BAR; MK_SCHED;
            MK_STAGE(MK_SB(1, 1), b3 + hstepB, voffB);
            MK_WAIT_V(6); MK_BAR; MK_MMA(1, 1, At, B1); MK_BAR;
        }
        int fr_ = fr, fq_ = fq; asm volatile("" : "+v"(fr_), "+v"(fq_));
        if (wr == 0) MK_BAR;
        const bool keep = E(acc, cur, wr, wc, fr_, fq_);
        if (wr == 1) MK_BAR;
        if (!has_next) break;
        if (!keep) {
#pragma unroll
            for (int a = 0; a < 2; ++a)
#pragma unroll
                for (int b = 0; b < 2; ++b)
#pragma unroll
                    for (int m = 0; m < 4; ++m)
#pragma unroll
                        for (int n = 0; n < 2; ++n) acc[a][b][m][n] = (f32x4){0.f, 0.f, 0.f, 0.f};
        }
        cur = nxt; cA = nA; cB = nB; ++ui;
        if (GATHER) {
#pragma unroll
            for (int h = 0; h < 2; ++h)
#pragma unroll
                for (int i = 0; i < 2; ++i) vA[h][i] = vAn[h][i]; }
    }
    MK_WAIT_V(0);
    if (wr == 0) MK_BAR;
    MK_BAR;
#undef MK_SA
#undef MK_SB
#undef MK_STAGE
#undef MK_LDA
#undef MK_LDB
#undef MK_MMA
#undef MK_WAIT_V
#undef MK_WAIT_L
#undef MK_BAR
#undef MK_SCHED
}

__device__ __forceinline__ u32x4 pack8(const f32x4 a, const f32x4 b) { u32x4 w; w.x = cvt_pk_bf16(a[0], a[1]); w.y = cvt_pk_bf16(a[2], a[3]); w.z = cvt_pk_bf16(b[0], b[1]); w.w = cvt_pk_bf16(b[2], b[3]); return w; }
struct EpiStoreBf16 {
    bf16_t* O; long ldc;
    __device__ __forceinline__ bool operator()(const f32x4 (&acc)[2][2][4][2], const Unit& u, int wr, int wc, int fr, int fq) const {
        MK_FRAG_LOOP(r, c) { *(u32x4*)(O + (size_t)(u.pm * BM + r) * ldc + u.pn * BM + c) = pack8(acc[ai][bj][m][0], acc[ai][bj][m][1]); }
        return false;
    }
};

struct CMapZ1 { __device__ int operator()(int n) const { return n < RC ? n : (n < Z1_LX ? -1 : OFF_LX + (n - Z1_LX)); } };
struct CMapZC { __device__ int operator()(int n) const { return OFF_LG + n; } };
struct CMapId { __device__ int operator()(int n) const { return n; } };
struct CMapGU { int F; __device__ int operator()(int n) const { return (n & 1) * F + (n >> 1); } };
template <class CM>
__device__ __forceinline__ void convT_tile(LAS float* tile  , const float* src, int lds_, int Ks, bf16_t* dst, int Kd, int n0, int k0, const CM& cm) {
    const int tid = threadIdx.x;
    { const int kk = tid >> 3, nn8 = (tid & 7) * 8; const int k = k0 + kk;
#pragma unroll
      for (int j = 0; j < 8; ++j) { const int sc = cm(n0 + nn8 + j); tile[kk * 65 + nn8 + j] = (k < Ks && sc >= 0) ? src[(size_t)k * lds_ + sc] : 0.f; } }
    __syncthreads();
    { const int nn = tid >> 3, kk8 = (tid & 7) * 8; f32x4 a, b;
#pragma unroll
      for (int j = 0; j < 4; ++j) { a[j] = tile[(kk8 + j) * 65 + nn]; b[j] = tile[(kk8 + 4 + j) * 65 + nn]; }
      *(u32x4*)(dst + (size_t)(n0 + nn) * Kd + k0 + kk8) = pack8(a, b); }
    __syncthreads();
}
template <class CM>
__device__ __forceinline__ void convT_job(LAS float* tile, const float* src, int lds_, int Ks, bf16_t* dst, int Kd, int N, const CM& cm, int bid, int nblk, int& base) {
    const int tn = N / 64, tk = Kd / 64, nt = tn * tk;
    int first = (bid - base % nblk + nblk) % nblk;
    for (int t = first; t < nt; t += nblk) convT_tile(tile, src, lds_, Ks, dst, Kd, (t / tk) * 64, (t % tk) * 64, cm);
    base += nt;
}

constexpr int MOD_SL = 16, MOD_KS = D / MOD_SL;
__device__ __forceinline__ void mod_partials(LAS float* sl  , const In& in, float* part  , int bid, int nblk) {
    const int ncc = 6 * D / NT, nitem = MOD_SL * ncc;
    for (int it = bid; it < nitem; it += nblk) {
        const int s = it / ncc, j = (it % ncc) * NT + threadIdx.x;
        for (int i = threadIdx.x; i < (NB + 1) * MOD_KS; i += NT) { const int r = i / MOD_KS, k = s * MOD_KS + i % MOD_KS; const float cv = r < NB ? in.c[r * D + k] : in.c_ctx[k]; sl[i] = siluf_(cv); }
        __syncthreads();
        float acc[NB + 1];
#pragma unroll
        for (int r = 0; r <= NB; ++r) acc[r] = 0.f;
        for (int k = 0; k < MOD_KS; ++k) { const float w = in.w_mod[(size_t)(s * MOD_KS + k) * 6 * D + j];
#pragma unroll
            for (int r = 0; r <= NB; ++r) acc[r] += sl[r * MOD_KS + k] * w; }
#pragma unroll
        for (int r = 0; r <= NB; ++r) part[((size_t)s * (NB + 1) + r) * 6 * D + j] = acc[r];
        __syncthreads();
    }
}
__device__ __forceinline__ float mod_value(const In& in, const float* part, int r, int j) {
    float s = in.b_mod[j];
#pragma unroll
    for (int q = 0; q < MOD_SL; ++q) s += part[((size_t)q * (NB + 1) + r) * 6 * D + j];
    return s;
}

__device__ __forceinline__ void xn_rows(LAS float* sm  , const In& in, const float* part, bf16_t* xn, int b0, int nb, int row_lo, int row_hi) {
    const int nlat = nb * SEQ, wid = threadIdx.x >> 6, lane = threadIdx.x & 63;
    int cur_mr = -1;
    float gp[16];
#pragma unroll
    for (int j = 0; j < 4; ++j)
#pragma unroll
        for (int q = 0; q < 4; ++q) gp[4 * j + q] = in.norm_g[j * 256 + lane * 4 + q];
    for (int rbase = row_lo; rbase < row_hi; rbase += 8) {
        const int mr = rbase < nlat ? b0 + rbase / SEQ : NB;
        if (mr != cur_mr) { __syncthreads(); for (int j = threadIdx.x; j < 2 * D; j += NT) sm[j] = mod_value(in, part, mr, j); __syncthreads(); cur_mr = mr; }
        const int r = rbase + wid; if (r >= row_hi) continue;
        const float* src = r < nlat ? in.x + ((size_t)b0 * SEQ + r) * D : in.ctx + ((size_t)b0 * CTX + (r - nlat)) * D;
        f32x4 v[4]; float ss = 0.f;
#pragma unroll
        for (int j = 0; j < 4; ++j) { v[j] = *(const f32x4*)(src + j * 256 + lane * 4); ss += v[j][0] * v[j][0] + v[j][1] * v[j][1] + v[j][2] * v[j][2] + v[j][3] * v[j][3]; }
#pragma unroll
        for (int o = 32; o > 0; o >>= 1) ss += __shfl_xor(ss, o);
        const float rinv = 1.f / sqrtf(ss * (1.f / D) + NORM_EPS);
#pragma unroll
        for (int j = 0; j < 4; ++j) { const int c = j * 256 + lane * 4; float o[4];
#pragma unroll
            for (int q = 0; q < 4; ++q) o[q] = (v[j][q] * rinv * gp[4 * j + q]) * (1.f + sm[D + c + q]) + sm[c + q];
            u32x2 w; w.x = cvt_pk_bf16(o[0], o[1]); w.y = cvt_pk_bf16(o[2], o[3]); *(u32x2*)(xn + (size_t)r * D + c) = w; }
    }
}
}

namespace mk {
#define XB_TMO      128
#define XB_XCNT(j)  (256  + 64 * (j))
#define XB_XSUB(j)  (1280 + 64 * (j))
#define XB_XGEN(j)  (2304 + 64 * (j))
#define XB_TOP      3328
#define XB_TOPGEN   3392
#define XCD_BAR_WORDS 3456
#define XB_SPIN_CAP (1u << 18)
__device__ __forceinline__ unsigned xb_ld(unsigned* p)              { return __hip_atomic_load(p, __ATOMIC_RELAXED, __HIP_MEMORY_SCOPE_AGENT); }
__device__ __forceinline__ unsigned xb_add(unsigned* p, unsigned v) { return __hip_atomic_fetch_add(p, v, __ATOMIC_RELAXED, __HIP_MEMORY_SCOPE_AGENT); }
__device__ __forceinline__ unsigned xb_xcc_id() { return (unsigned)__builtin_amdgcn_s_getreg((3 << 11) | 20) & 0xFu; }
#define XB_SPIN(cond, bar) do { unsigned _sp = 0; while (cond) { __builtin_amdgcn_s_sleep(1); \
    if ((++_sp & 255u) == 0u) { if (xb_ld(&(bar)[XB_TMO])) break; if (_sp > XB_SPIN_CAP) { atomicAdd(&(bar)[XB_TMO], 1u); break; } } } } while (0)
struct XcdBarrier { unsigned* bar; unsigned x; volatile LAS unsigned* st; };
__device__ __forceinline__ XcdBarrier xcd_barrier_post(unsigned* bar, volatile LAS unsigned* st) {
    XcdBarrier b; b.bar = bar; b.x = xb_xcc_id(); b.st = st;
    if (threadIdx.x == 0) (void)xb_add(&bar[XB_XCNT(b.x)], 1u);
    return b;
}
__device__ __forceinline__ void xcd_barrier_complete(unsigned* bar, unsigned x, unsigned& nloc, unsigned& nx) {
    const unsigned G = gridDim.x * gridDim.y * gridDim.z;
    unsigned sum, cnt, mine, sp = 0u;
    for (;;) {
        sum = 0u; cnt = 0u; mine = 0u;
#pragma unroll
        for (unsigned j = 0; j < 16; ++j) { const unsigned c = xb_ld(&bar[XB_XCNT(j)]); sum += c; cnt += (c > 0u) ? 1u : 0u; mine = (j == x) ? c : mine; }
        if (sum == G) break;
        __builtin_amdgcn_s_sleep(1);
        if ((++sp & 255u) == 0u) { if (xb_ld(&bar[XB_TMO])) break; if (sp > XB_SPIN_CAP) { atomicAdd(&bar[XB_TMO], 1u); break; } }
    }
    nloc = mine > 0u ? mine : 1u; nx = cnt > 0u ? cnt : 1u;
}
__device__ __forceinline__ void xcd_barrier(const XcdBarrier& b) {
    asm volatile("s_waitcnt vmcnt(0)" ::: "memory");
    __syncthreads();
    if (threadIdx.x == 0) {
        unsigned* bar = b.bar;
        __builtin_amdgcn_s_waitcnt(0);
        unsigned nloc = b.st[0], nx = b.st[1];
        if (nloc == 0u) { xcd_barrier_complete(bar, b.x, nloc, nx); b.st[0] = nloc; b.st[1] = nx; }
        const unsigned old = xb_add(&bar[XB_XSUB(b.x)], 1u);
        const unsigned gen = old / nloc;
        if (old + 1u == (gen + 1u) * nloc) {
            __builtin_amdgcn_fence(__ATOMIC_RELEASE, "agent");
            asm volatile("s_waitcnt vmcnt(0)" ::: "memory");
            const unsigned og = xb_add(&bar[XB_TOP], 1u);
            const unsigned tg = og / nx;
            if (og + 1u == (tg + 1u) * nx) xb_add(&bar[XB_TOPGEN], 1u);
            else XB_SPIN(xb_ld(&bar[XB_TOPGEN]) == tg, bar);
            __builtin_amdgcn_fence(__ATOMIC_ACQUIRE, "agent");
            xb_add(&bar[XB_XGEN(b.x)], 1u);
            asm volatile("s_waitcnt vmcnt(0)" ::: "memory");
        } else {
            XB_SPIN(xb_ld(&bar[XB_XGEN(b.x)]) == gen, bar);
            __builtin_amdgcn_fence(__ATOMIC_ACQUIRE, "agent");
            asm volatile("s_waitcnt vmcnt(0)" ::: "memory");
        }
    }
    __syncthreads();
}
}

namespace mk {
constexpr int TB = 32;
constexpr int RAWW = 320;
constexpr int RW_RAW = 0;
constexpr int RW_MU = RW_RAW + (TB + 2) * RAWW * 2;
constexpr int RW_WUP = RW_MU + 2 * RAWW * 4;
constexpr int RW_AUP = RW_WUP + 64 * 72 * 2;
constexpr int RW_CST = RW_AUP + 64 * 72 * 2;
constexpr int RW_AWD = RW_CST + 5 * 64 * 4;
constexpr int RW_AAD = RW_AWD + TB * 72 * 2;
constexpr int RW_R = RW_AAD + TB * 72 * 2;
constexpr int RW_KR = RW_R + TB * 64 * 4;
constexpr int RW_LA = RW_KR + TB * 64 * 4;
constexpr int RW_KK = RW_LA + TB * 64 * 4;
constexpr int RW_W = RW_KK + TB * 64 * 4;
constexpr int RW_B = RW_W + TB * 64 * 4;
constexpr int RW_KD = RW_B + TB * 64 * 4;
constexpr int RW_WR = RW_KD + TB * 64 * 4;
constexpr int RW_V = RW_WR + TB * 64 * 4;
constexpr int RW_SC = RW_V + TB * 64 * 4;
constexpr int RW_YO = RW_SC + TB * 2 * 4;
constexpr int RW_BON = RW_YO + TB * 64 * 4;
constexpr int RW_END = RW_BON + TB * 4;
static_assert(RW_END <= LDS_BYTES, "rwkv LDS");

#define MK_DPP(x, ctrl) __int_as_float(__builtin_amdgcn_update_dpp(__float_as_int(x), __float_as_int(x), ctrl, 0xF, 0xF, false))
__device__ __forceinline__ float allreduce16(float x) {
    x += MK_DPP(x, 0xB1); x += MK_DPP(x, 0x4E); x += MK_DPP(x, 0x141); x += MK_DPP(x, 0x140); return x;
}

__device__ __forceinline__ void allreduce16x4(float& a, float& b, float& c, float& d) {
    asm volatile("s_nop 1\n\t"
        "v_add_f32_dpp %0, %0, %0 quad_perm:[1,0,3,2] row_mask:0xf bank_mask:0xf\n\t" "v_add_f32_dpp %1, %1, %1 quad_perm:[1,0,3,2] row_mask:0xf bank_mask:0xf\n\t"
        "v_add_f32_dpp %2, %2, %2 quad_perm:[1,0,3,2] row_mask:0xf bank_mask:0xf\n\t" "v_add_f32_dpp %3, %3, %3 quad_perm:[1,0,3,2] row_mask:0xf bank_mask:0xf\n\t"
        "v_add_f32_dpp %0, %0, %0 quad_perm:[2,3,0,1] row_mask:0xf bank_mask:0xf\n\t" "v_add_f32_dpp %1, %1, %1 quad_perm:[2,3,0,1] row_mask:0xf bank_mask:0xf\n\t"
        "v_add_f32_dpp %2, %2, %2 quad_perm:[2,3,0,1] row_mask:0xf bank_mask:0xf\n\t" "v_add_f32_dpp %3, %3, %3 quad_perm:[2,3,0,1] row_mask:0xf bank_mask:0xf\n\t"
        "v_add_f32_dpp %0, %0, %0 row_half_mirror row_mask:0xf bank_mask:0xf\n\t" "v_add_f32_dpp %1, %1, %1 row_half_mirror row_mask:0xf bank_mask:0xf\n\t"
        "v_add_f32_dpp %2, %2, %2 row_half_mirror row_mask:0xf bank_mask:0xf\n\t" "v_add_f32_dpp %3, %3, %3 row_half_mirror row_mask:0xf bank_mask:0xf\n\t"
        "v_add_f32_dpp %0, %0, %0 row_mirror row_mask:0xf bank_mask:0xf\n\t" "v_add_f32_dpp %1, %1, %1 row_mirror row_mask:0xf bank_mask:0xf\n\t"
        "v_add_f32_dpp %2, %2, %2 row_mirror row_mask:0xf bank_mask:0xf\n\t" "v_add_f32_dpp %3, %3, %3 row_mirror row_mask:0xf bank_mask:0xf"
        : "+v"(a), "+v"(b), "+v"(c), "+v"(d));
}
struct RwkvP { const bf16_t* z1; bf16_t* Y; float* bon; int b0, nb; };

constexpr int RW_NPIECE = (TB + 2) * 40, RW_PPT = (RW_NPIECE + NT - 1) / NT;

__device__ __forceinline__ void rwkv_chain(LAS unsigned char* lds, const In& in, const RwkvP p, int chain) {
    const int tid = threadIdx.x, lane = tid & 63, wid = tid >> 6;
    const int d = chain / (p.nb * NH), bl = (chain / NH) % p.nb, h = chain % NH;
    const int nlat = p.nb * SEQ;
    LAS bf16_t* RAW = (LAS bf16_t*)(lds + RW_RAW); LAS float* MU = (LAS float*)(lds + RW_MU);
    LAS bf16_t* WUP = (LAS bf16_t*)(lds + RW_WUP); LAS bf16_t* AUP = (LAS bf16_t*)(lds + RW_AUP); LAS float* CST = (LAS float*)(lds + RW_CST);
    LAS bf16_t* AWD = (LAS bf16_t*)(lds + RW_AWD); LAS bf16_t* AAD = (LAS bf16_t*)(lds + RW_AAD);
    LAS float *Rr = (LAS float*)(lds + RW_R), *KR = (LAS float*)(lds + RW_KR), *LA_ = (LAS float*)(lds + RW_LA);
    LAS float *KK = (LAS float*)(lds + RW_KK), *Wv = (LAS float*)(lds + RW_W), *Bv = (LAS float*)(lds + RW_B), *KD = (LAS float*)(lds + RW_KD), *WR = (LAS float*)(lds + RW_WR), *Vv = (LAS float*)(lds + RW_V);
    LAS float *SC = (LAS float*)(lds + RW_SC), *YO = (LAS float*)(lds + RW_YO), *BON = (LAS float*)(lds + RW_BON);
    auto segcol = [&](int s) { return s < 3 ? s * RW + h * 64 : (s == 3 ? OFF_WD + d * DL : OFF_AD + d * AL); };
    for (int i = tid; i < 2 * RAWW; i += NT) { const int m = i / RAWW, c = i % RAWW; MU[i] = in.shift_mu[m * RC + segcol(c >> 6) + (c & 63)]; }
    for (int i = tid; i < 64 * 64; i += NT) { const int j = i >> 6, c = i & 63;
        WUP[c * 72 + j] = f2bf(in.rw_w_up[((size_t)d * DL + j) * RW + h * 64 + c]); AUP[c * 72 + j] = f2bf(in.rw_a_up[((size_t)d * AL + j) * RW + h * 64 + c]); }
    for (int i = tid; i < 64; i += NT) { CST[i] = in.rw_w0[d * RW + h * 64 + i]; CST[64 + i] = in.rw_a0[d * RW + h * 64 + i]; CST[128 + i] = in.rw_k_k[h * 64 + i]; CST[192 + i] = in.rw_k_a[h * 64 + i]; CST[256 + i] = in.rw_r_k[h * 64 + i]; }
    constexpr int NQ = (CTX + SEQ) / TB, NQC = CTX / TB;
    auto blk_info = [&](int q, bool& isctx, int& t0, bool& hp, bool& hn, size_t& grow0) {
        isctx = q < NQC;
        if (isctx) { const int qq = d == 0 ? q : NQC - 1 - q; t0 = qq * TB; hp = t0 > 0; hn = t0 + TB < CTX; grow0 = (size_t)nlat + (size_t)bl * CTX + t0; }
        else { const int ql = q - NQC, qq = d == 0 ? ql : SEQ / TB - 1 - ql; t0 = qq * TB; hp = (t0 % GW) != 0; hn = ((t0 + TB) % GW) != 0; grow0 = (size_t)bl * SEQ + t0; }
    };
    u32x4 pre[RW_PPT];
    auto prefetch = [&](int q) {
        bool isctx, hp, hn; int t0; size_t grow0; blk_info(q, isctx, t0, hp, hn, grow0);
#pragma unroll
        for (int k = 0; k < RW_PPT; ++k) { const int i = tid + k * NT; u32x4 v = (u32x4){0u, 0u, 0u, 0u};
            if (i < RW_NPIECE) { const int rr = i / 40, sp = i % 40, seg = sp >> 3, part = sp & 7;
                const bool ok = (rr == 0) ? hp : ((rr == TB + 1) ? hn : true);
                if (ok) v = *(const u32x4*)(p.z1 + (grow0 + rr - 1) * Z1_N + segcol(seg) + part * 8); }
            pre[k] = v; }
    };
    auto commit = [&]() {
#pragma unroll
        for (int k = 0; k < RW_PPT; ++k) { const int i = tid + k * NT; if (i < RW_NPIECE) { const int rr = i / 40, sp = i % 40; *(LAS u32x4*)(RAW + rr * RAWW + sp * 8) = pre[k]; } }
    };
    float S[2][4];
#pragma unroll
    for (int i = 0; i < 2; ++i)
#pragma unroll
        for (int j = 0; j < 4; ++j) S[i][j] = 0.f;
    const int kg = lane & 15, rp = (lane >> 4) + 4 * wid;
    prefetch(0);
    for (int q = 0; q < NQ; ++q) {
        bool isctx, hp, hn; int t0; size_t grow0; blk_info(q, isctx, t0, hp, hn, grow0);
        commit();
        __syncthreads();
        if (q + 1 < NQ) prefetch(q + 1);
        auto shift8 = [&](int t, int c0, float (&s)[8]) {
            const u32x4 xp = *(const LAS u32x4*)(RAW + t * RAWW + c0), xc = *(const LAS u32x4*)(RAW + (t + 1) * RAWW + c0), xn_ = *(const LAS u32x4*)(RAW + (t + 2) * RAWW + c0);
            const f32x4 m0a = *(const LAS f32x4*)(MU + c0), m0b = *(const LAS f32x4*)(MU + c0 + 4), m1a = *(const LAS f32x4*)(MU + RAWW + c0), m1b = *(const LAS f32x4*)(MU + RAWW + c0 + 4);
#pragma unroll
            for (int j = 0; j < 4; ++j) { const unsigned a = xp[j], b = xc[j], c = xn_[j];
                const float mu0l = j < 2 ? m0a[2 * j] : m0b[2 * j - 4], mu0h = j < 2 ? m0a[2 * j + 1] : m0b[2 * j - 3], mu1l = j < 2 ? m1a[2 * j] : m1b[2 * j - 4], mu1h = j < 2 ? m1a[2 * j + 1] : m1b[2 * j - 3];
                { const float x = bflo(b); s[2 * j] = x + mu0l * (bflo(a) - x) + mu1l * (bflo(c) - x); }
                { const float x = bfhi(b); s[2 * j + 1] = x + mu0h * (bfhi(a) - x) + mu1h * (bfhi(c) - x); } } };
        for (int it = tid; it < TB * 24; it += NT) {
            const int t = it / 24, g = it % 24, seg = g >> 3, cc = (g & 7) * 8; float s[8]; shift8(t, g * 8, s);
            LAS float* dst = (seg == 0 ? Rr : (seg == 1 ? KR : Vv)) + t * 64 + cc; *(LAS f32x4*)dst = (f32x4){s[0], s[1], s[2], s[3]}; *(LAS f32x4*)(dst + 4) = (f32x4){s[4], s[5], s[6], s[7]};
        }
        { const int t = tid >> 4, g = 24 + (tid & 15), cc = (g & 7) * 8; float s[8]; shift8(t, g * 8, s);
          const bool isw = (tid & 15) < 8;
#pragma unroll
          for (int j = 0; j < 8; ++j) { const float th = fast_tanh(s[j]); s[j] = isw ? th : s[j]; }
          LAS bf16_t* dst = (isw ? AWD : AAD) + t * 72 + cc;
          u32x4 w; w.x = cvt_pk_bf16(s[0], s[1]); w.y = cvt_pk_bf16(s[2], s[3]); w.z = cvt_pk_bf16(s[4], s[5]); w.w = cvt_pk_bf16(s[6], s[7]); *(LAS u32x4*)dst = w; }
        __syncthreads();
        {
            const int lora = wid >> 2, ct = wid & 3, fr = lane & 15, fq = lane >> 4;
            const LAS bf16_t* Am = lora ? AAD : AWD; const LAS bf16_t* Bm = lora ? AUP : WUP;
#pragma unroll
            for (int rt = 0; rt < 2; ++rt) {
                f32x4 acc = (f32x4){0.f, 0.f, 0.f, 0.f};
#pragma unroll
                for (int ks = 0; ks < 2; ++ks) {
                    const bf16x8 a = *(const LAS bf16x8*)(Am + (rt * 16 + fr) * 72 + ks * 32 + fq * 8);
                    const bf16x8 b = *(const LAS bf16x8*)(Bm + (ct * 16 + fr) * 72 + ks * 32 + fq * 8);
                    acc = __builtin_amdgcn_mfma_f32_16x16x32_bf16(a, b, acc, 0, 0, 0);
                }
                const int col = ct * 16 + fr;
#pragma unroll
                for (int i = 0; i < 4; ++i) { const int t = rt * 16 + fq * 4 + i;
                    if (lora == 0) { const float lw = acc[i] + CST[col]; const float wl = -fast_softplus(-lw) - 0.5f; Wv[t * 64 + col] = __expf(-__expf(wl)); }
                    else { LA_[t * 64 + col] = fast_sigmoid(acc[i] + CST[64 + col]); } }
            }
        }
        __syncthreads();
        {
            const int t = tid >> 4, c4 = (tid & 15) * 4;
            const f32x4 k = *(const LAS f32x4*)(KR + t * 64 + c4), a = *(const LAS f32x4*)(LA_ + t * 64 + c4), w = *(const LAS f32x4*)(Wv + t * 64 + c4), r = *(const LAS f32x4*)(Rr + t * 64 + c4);
            f32x4 kkr, kd, bb, wr; float ss = 0.f, br = 0.f, kr = 0.f, bn = 0.f;
#pragma unroll
            for (int j = 0; j < 4; ++j) { kkr[j] = k[j] * CST[128 + c4 + j]; ss += kkr[j] * kkr[j]; }
            ss = allreduce16(ss);
            const float inv = 1.f / fmaxf(sqrtf(ss), 1e-12f);
#pragma unroll
            for (int j = 0; j < 4; ++j) { const float kk = kkr[j] * inv; kkr[j] = kk; kd[j] = k[j] * (1.f + (a[j] - 1.f) * CST[192 + c4 + j]); bb[j] = kk * a[j]; wr[j] = w[j] * r[j];
                br += bb[j] * r[j]; kr += kd[j] * r[j]; bn += r[j] * kd[j] * CST[256 + c4 + j]; }
            br = allreduce16(br); kr = allreduce16(kr); bn = allreduce16(bn);
            *(LAS f32x4*)(KK + t * 64 + c4) = kkr; *(LAS f32x4*)(KD + t * 64 + c4) = kd; *(LAS f32x4*)(Bv + t * 64 + c4) = bb; *(LAS f32x4*)(WR + t * 64 + c4) = wr;
            if ((tid & 15) == 0) { SC[t * 2] = br; SC[t * 2 + 1] = kr; BON[t] = bn; }
        }
        __syncthreads();
        {
            auto tof = [&](int st) { return d == 0 ? st : TB - 1 - st; };
            const LAS float* lb = KK + 4 * kg;
            const LAS float* vb = Vv + 2 * rp;
            constexpr int OW = (RW_W - RW_KK) / 4, OB = (RW_B - RW_KK) / 4, OKD = (RW_KD - RW_KK) / 4, OWR = (RW_WR - RW_KK) / 4;
            int t = tof(0);
            f32x4 kk4 = *(const LAS f32x4*)(lb + t * 64), w4 = *(const LAS f32x4*)(lb + t * 64 + OW), b4 = *(const LAS f32x4*)(lb + t * 64 + OB),
                  kd4 = *(const LAS f32x4*)(lb + t * 64 + OKD), wr4 = *(const LAS f32x4*)(lb + t * 64 + OWR);
            f32x2 vv = *(const LAS f32x2*)(vb + t * 64), sc = *(const LAS f32x2*)(SC + t * 2);
            f32x2 S2[4];
#pragma unroll
            for (int j = 0; j < 4; ++j) { S2[j][0] = S[0][j]; S2[j][1] = S[1][j]; }
#pragma unroll 2
            for (int st = 0; st < TB; ++st) {
                const int tn = tof(st + 1 < TB ? st + 1 : st);
                const f32x4 nkk4 = *(const LAS f32x4*)(lb + tn * 64), nw4 = *(const LAS f32x4*)(lb + tn * 64 + OW), nb4 = *(const LAS f32x4*)(lb + tn * 64 + OB),
                            nkd4 = *(const LAS f32x4*)(lb + tn * 64 + OKD), nwr4 = *(const LAS f32x4*)(lb + tn * 64 + OWR);
                const f32x2 nvv = *(const LAS f32x2*)(vb + tn * 64), nsc = *(const LAS f32x2*)(SC + tn * 2);
                f32x2 sa2 = S2[0] * kk4[0], yo2 = S2[0] * wr4[0];
#pragma unroll
                for (int j = 1; j < 4; ++j) { sa2 += S2[j] * kk4[j]; yo2 += S2[j] * wr4[j]; }
                float sa0 = sa2[0], sa1 = sa2[1], yo0 = yo2[0], yo1 = yo2[1];
                allreduce16x4(sa0, sa1, yo0, yo1);
                f32x2 sar; sar[0] = sa0; sar[1] = sa1;
#pragma unroll
                for (int j = 0; j < 4; ++j) S2[j] = S2[j] * w4[j] + (vv * kd4[j] - sar * b4[j]);
                if (kg == 0) { f32x2 yor; yor[0] = yo0; yor[1] = yo1; const f32x2 y = yor - sar * sc[0] + vv * sc[1]; *(LAS f32x2*)(YO + t * 64 + 2 * rp) = y; }
                kk4 = nkk4; w4 = nw4; b4 = nb4; kd4 = nkd4; wr4 = nwr4; vv = nvv; sc = nsc; t = tn;
            }
#pragma unroll
            for (int j = 0; j < 4; ++j) { S[0][j] = S2[j][0]; S[1][j] = S2[j][1]; }
        }
        __syncthreads();
        if (!isctx) {
            const int t = tid >> 4, c4 = (tid & 15) * 4; const f32x4 y = *(const LAS f32x4*)(YO + t * 64 + c4);
            u32x2 w; w.x = cvt_pk_bf16(y[0], y[1]); w.y = cvt_pk_bf16(y[2], y[3]);
            *(u32x2*)(p.Y + ((size_t)d * nlat + grow0 + t) * RW + h * 64 + c4) = w;
            if (tid < TB) p.bon[((size_t)d * nlat + grow0 + tid) * NH + h] = BON[tid];
        }
    }
}
__device__ __forceinline__ void rwkv_phase(LAS unsigned char* lds, const In& in, const RwkvP p, int bid, int nblk) {
    const int nchain = 2 * p.nb * NH;
    for (int c = bid; c < nchain; c += nblk) { rwkv_chain(lds, in, p, c); __syncthreads(); }
}
}

namespace mk {
constexpr int C2_RAW = 0;
constexpr int C2_MU = C2_RAW + (TB + 2) * RAWW * 2;
constexpr int C2_WUP = C2_MU + 2 * RAWW * 4;
constexpr int C2_AUP = C2_WUP + 64 * 72 * 2;
constexpr int C2_CST = C2_AUP + 64 * 72 * 2;
constexpr int C2_AWD = C2_CST + 5 * 64 * 4;
constexpr int C2_AAD = C2_AWD + TB * 72 * 2;
constexpr int C2_X = C2_AAD + TB * 72 * 2;
constexpr int C2_R = C2_X, C2_KR = C2_R + TB * 64 * 4, C2_V = C2_KR + TB * 64 * 4, C2_E = C2_V + TB * 64 * 4, C2_LA = C2_E + TB * 64 * 4, C2_CUM = C2_LA + TB * 64 * 4, C2_X_END = C2_CUM + TB * 64 * 4;
constexpr int C2_YO = C2_X;
constexpr int C2_G = C2_YO + TB * 64 * 4;
constexpr int C2_UB = C2_G + 64 * 36 * 4;
constexpr int C2_ABT = C2_UB + 64 * 40 * 2;
constexpr int C2_AKT = C2_ABT + 32 * 32 * 4;
constexpr int C2_NBT = C2_AKT + 32 * 40 * 2;
constexpr int C2_NKT = C2_NBT + 32 * 40 * 2;
static_assert(C2_NKT + 32 * 40 * 2 <= C2_X_END, "region X reuse");
constexpr int C2_KKS = C2_X_END;
constexpr int C2_BS = C2_KKS + TB * 72 * 2, C2_KDS = C2_BS + TB * 72 * 2, C2_RS = C2_KDS + TB * 72 * 2;
constexpr int C2_BST = C2_RS + TB * 72 * 2;
constexpr int C2_KDST = C2_BST + 64 * 40 * 2;
constexpr int C2_VT = C2_KDST + 64 * 40 * 2;
constexpr int C2_S0B = C2_VT + 64 * 40 * 2;
constexpr int C2_GC = C2_S0B + 64 * 72 * 2;
constexpr int C2_BON = C2_GC + 64 * 4;
constexpr int C2_END = C2_BON + TB * 4;
static_assert(C2_END <= LDS_BYTES - 16 && (C2_X % 16) == 0 && (C2_KKS % 16) == 0 && (C2_G % 16) == 0 && (C2_UB % 16) == 0 && (C2_ABT % 16) == 0 && (C2_AKT % 16) == 0 && (C2_S0B % 16) == 0, "rwkv2 LDS");

__device__ __forceinline__ bf16x8 ldsb8(const LAS bf16_t* p) { return *(const LAS bf16x8*)p; }

template <int MODE>
__device__ __forceinline__ void rwkv_chain2(LAS unsigned char* lds, const In& in, const RwkvP p, int chain) {
    const int tid = threadIdx.x, lane = tid & 63, wid = tid >> 6, fr = lane & 15, fq = lane >> 4;
    const int d = chain / (p.nb * NH), bl = (chain / NH) % p.nb, h = chain % NH;
    const int nlat = p.nb * SEQ;
    LAS bf16_t* RAW = (LAS bf16_t*)(lds + C2_RAW); LAS float* MU = (LAS float*)(lds + C2_MU);
    LAS bf16_t* WUP = (LAS bf16_t*)(lds + C2_WUP); LAS bf16_t* AUP = (LAS bf16_t*)(lds + C2_AUP); LAS float* CST = (LAS float*)(lds + C2_CST);
    LAS bf16_t* AWD = (LAS bf16_t*)(lds + C2_AWD); LAS bf16_t* AAD = (LAS bf16_t*)(lds + C2_AAD);
    LAS float *Rr = (LAS float*)(lds + C2_R), *KR = (LAS float*)(lds + C2_KR), *Vv = (LAS float*)(lds + C2_V), *Ee = (LAS float*)(lds + C2_E), *LA_ = (LAS float*)(lds + C2_LA), *CUM = (LAS float*)(lds + C2_CUM);
    LAS float *YO = (LAS float*)(lds + C2_YO), *Gm = (LAS float*)(lds + C2_G), *ABT = (LAS float*)(lds + C2_ABT), *GC = (LAS float*)(lds + C2_GC), *BON = (LAS float*)(lds + C2_BON);
    LAS bf16_t *UB = (LAS bf16_t*)(lds + C2_UB), *AKT = (LAS bf16_t*)(lds + C2_AKT), *NBT = (LAS bf16_t*)(lds + C2_NBT), *NKT = (LAS bf16_t*)(lds + C2_NKT);
    LAS bf16_t *KKS = (LAS bf16_t*)(lds + C2_KKS), *BS = (LAS bf16_t*)(lds + C2_BS), *KDS = (LAS bf16_t*)(lds + C2_KDS), *RS = (LAS bf16_t*)(lds + C2_RS);
    LAS bf16_t *BST = (LAS bf16_t*)(lds + C2_BST), *KDST = (LAS bf16_t*)(lds + C2_KDST), *VT = (LAS bf16_t*)(lds + C2_VT), *S0B = (LAS bf16_t*)(lds + C2_S0B);
    auto segcol = [&](int s) { return s < 3 ? s * RW + h * 64 : (s == 3 ? OFF_WD + d * DL : OFF_AD + d * AL); };
    for (int i = tid; i < 2 * RAWW; i += NT) { const int m = i / RAWW, c = i % RAWW; MU[i] = in.shift_mu[m * RC + segcol(c >> 6) + (c & 63)]; }
    for (int i = tid; i < 64 * 64; i += NT) { const int j = i >> 6, c = i & 63;
        WUP[c * 72 + j] = f2bf(in.rw_w_up[((size_t)d * DL + j) * RW + h * 64 + c]); AUP[c * 72 + j] = f2bf(in.rw_a_up[((size_t)d * AL + j) * RW + h * 64 + c]); }
    for (int i = tid; i < 64; i += NT) { CST[i] = in.rw_w0[d * RW + h * 64 + i]; CST[64 + i] = in.rw_a0[d * RW + h * 64 + i]; CST[128 + i] = in.rw_k_k[h * 64 + i]; CST[192 + i] = in.rw_k_a[h * 64 + i]; CST[256 + i] = in.rw_r_k[h * 64 + i]; }
    for (int i = tid; i < 64 * 72 / 2; i += NT) ((LAS unsigned*)S0B)[i] = 0u;
    constexpr int NQ = (CTX + SEQ) / TB, NQC = CTX / TB;
    auto blk_info = [&](int q, bool& isctx, int& t0, bool& hp, bool& hn, size_t& grow0) {
        isctx = q < NQC;
        if (isctx) { const int qq = d == 0 ? q : NQC - 1 - q; t0 = qq * TB; hp = t0 > 0; hn = t0 + TB < CTX; grow0 = (size_t)nlat + (size_t)bl * CTX + t0; }
        else { const int ql = q - NQC, qq = d == 0 ? ql : SEQ / TB - 1 - ql; t0 = qq * TB; hp = (t0 % GW) != 0; hn = ((t0 + TB) % GW) != 0; grow0 = (size_t)bl * SEQ + t0; }
    };
    u32x4 pre[RW_PPT]; int poff[RW_PPT], plds[RW_PPT], pkind[RW_PPT];
#pragma unroll
    for (int k = 0; k < RW_PPT; ++k) { const int i = tid + k * NT, rr = i / 40, sp = i % 40, seg = sp >> 3, part = sp & 7;
        poff[k] = (rr - 1) * Z1_N + segcol(seg) + part * 8; plds[k] = rr * RAWW + sp * 8; pkind[k] = i >= RW_NPIECE ? 3 : (rr == 0 ? 1 : (rr == TB + 1 ? 2 : 0)); }
    auto prefetch = [&](int q) {
        bool isctx, hp, hn; int t0; size_t grow0; blk_info(q, isctx, t0, hp, hn, grow0);
        const bf16_t* base = p.z1 + grow0 * Z1_N;
#pragma unroll
        for (int k = 0; k < RW_PPT; ++k) { u32x4 v = (u32x4){0u, 0u, 0u, 0u};
            const bool ok = pkind[k] == 0 || (pkind[k] == 1 && hp) || (pkind[k] == 2 && hn);
            if (ok) v = *(const u32x4*)(base + poff[k]);
            pre[k] = v; }
    };
    auto commit = [&]() {
#pragma unroll
        for (int k = 0; k < RW_PPT; ++k) if (pkind[k] != 3) *(LAS u32x4*)(RAW + plds[k]) = pre[k];
    };
    f32x4 Sreg[2];
    Sreg[0] = (f32x4){0.f, 0.f, 0.f, 0.f}; Sreg[1] = Sreg[0];
    const int rt = wid >> 1;
    prefetch(0);
    for (int q = 0; q < NQ; ++q) {
        bool isctx, hp, hn; int t0; size_t grow0; blk_info(q, isctx, t0, hp, hn, grow0);
        commit();
        __syncthreads();
        if (q + 1 < NQ) prefetch(q + 1);
        auto shift8 = [&](int t, int c0, float (&s)[8]) {
            const u32x4 xp = *(const LAS u32x4*)(RAW + t * RAWW + c0), xc = *(const LAS u32x4*)(RAW + (t + 1) * RAWW + c0), xn_ = *(const LAS u32x4*)(RAW + (t + 2) * RAWW + c0);
            const f32x4 m0a = *(const LAS f32x4*)(MU + c0), m0b = *(const LAS f32x4*)(MU + c0 + 4), m1a = *(const LAS f32x4*)(MU + RAWW + c0), m1b = *(const LAS f32x4*)(MU + RAWW + c0 + 4);
#pragma unroll
            for (int j = 0; j < 4; ++j) { const unsigned a = xp[j], b = xc[j], c = xn_[j];
                const float mu0l = j < 2 ? m0a[2 * j] : m0b[2 * j - 4], mu0h = j < 2 ? m0a[2 * j + 1] : m0b[2 * j - 3], mu1l = j < 2 ? m1a[2 * j] : m1b[2 * j - 4], mu1h = j < 2 ? m1a[2 * j + 1] : m1b[2 * j - 3];
                { const float x = bflo(b); s[2 * j] = x + mu0l * (bflo(a) - x) + mu1l * (bflo(c) - x); }
                { const float x = bfhi(b); s[2 * j + 1] = x + mu0h * (bfhi(a) - x) + mu1h * (bfhi(c) - x); } } };
        for (int it = tid; it < TB * 24; it += NT) {
            const int t = it / 24, g = it % 24, seg = g >> 3, cc = (g & 7) * 8, js = d == 0 ? t : TB - 1 - t; float s[8]; shift8(t, g * 8, s);
            LAS float* dst = (seg == 0 ? Rr : (seg == 1 ? KR : Vv)) + js * 64 + cc; *(LAS f32x4*)dst = (f32x4){s[0], s[1], s[2], s[3]}; *(LAS f32x4*)(dst + 4) = (f32x4){s[4], s[5], s[6], s[7]};
        }
        { const int t = tid >> 4, g = 24 + (tid & 15), cc = (g & 7) * 8, js = d == 0 ? t : TB - 1 - t; float s[8]; shift8(t, g * 8, s);
          const bool isw = (tid & 15) < 8;
#pragma unroll
          for (int j = 0; j < 8; ++j) { const float th = fast_tanh(s[j]); s[j] = isw ? th : s[j]; }
          LAS bf16_t* dst = (isw ? AWD : AAD) + js * 72 + cc;
          u32x4 w; w.x = cvt_pk_bf16(s[0], s[1]); w.y = cvt_pk_bf16(s[2], s[3]); w.z = cvt_pk_bf16(s[4], s[5]); w.w = cvt_pk_bf16(s[6], s[7]); *(LAS u32x4*)dst = w; }
        __syncthreads();
        if (MODE == 3) continue;
        {
            const int lora = wid >> 2, ct = wid & 3;
            const LAS bf16_t* Am = lora ? AAD : AWD; const LAS bf16_t* Bm = lora ? AUP : WUP;
            float carry = 0.f;
#pragma unroll
            for (int r2 = 0; r2 < 2; ++r2) {
                f32x4 acc = (f32x4){0.f, 0.f, 0.f, 0.f};
#pragma unroll
                for (int ks = 0; ks < 2; ++ks) acc = __builtin_amdgcn_mfma_f32_16x16x32_bf16(ldsb8(Am + (r2 * 16 + fr) * 72 + ks * 32 + fq * 8), ldsb8(Bm + (ct * 16 + fr) * 72 + ks * 32 + fq * 8), acc, 0, 0, 0);
                const int col = ct * 16 + fr;
                if (lora == 0) {
                    float c[4];
#pragma unroll
                    for (int i = 0; i < 4; ++i) { const float lw = acc[i] + CST[col]; const float e = __expf(-fast_softplus(-lw) - 0.5f); c[i] = i ? c[i - 1] + e : e; }
                    const float tot = c[3];
                    float s1 = tot; { const float y = __shfl_up(s1, 16); s1 += fq >= 1 ? y : 0.f; }
                    float s2 = s1;  { const float z = __shfl_up(s1, 32); s2 += fq >= 2 ? z : 0.f; }
                    const float base = carry + s2 - tot;
#pragma unroll
                    for (int i = 0; i < 4; ++i) CUM[(r2 * 16 + fq * 4 + i) * 64 + col] = base + c[i];
                    carry += __shfl(s2, 48 + fr);
                } else {
#pragma unroll
                    for (int i = 0; i < 4; ++i) LA_[(r2 * 16 + fq * 4 + i) * 64 + col] = fast_sigmoid(acc[i] + CST[64 + col]);
                }
            }
        }
        __syncthreads();
        if (MODE == 2) continue;
        {
            const int j = tid >> 4, c4 = (tid & 15) * 4;
            const f32x4 k = *(const LAS f32x4*)(KR + j * 64 + c4), a = *(const LAS f32x4*)(LA_ + j * 64 + c4), r = *(const LAS f32x4*)(Rr + j * 64 + c4), vv = *(const LAS f32x4*)(Vv + j * 64 + c4);
            const f32x4 cu = *(const LAS f32x4*)(CUM + j * 64 + c4); f32x4 cp = (f32x4){0.f, 0.f, 0.f, 0.f}; if (j > 0) cp = *(const LAS f32x4*)(CUM + (j - 1) * 64 + c4);
            float kkr[4], ss = 0.f, bn = 0.f;
#pragma unroll
            for (int x = 0; x < 4; ++x) { kkr[x] = k[x] * CST[128 + c4 + x]; ss += kkr[x] * kkr[x]; }
            ss = allreduce16(ss);
            const float inv = 1.f / fmaxf(sqrtf(ss), 1e-12f);
            float kks[4], bs[4], kds[4], rs[4];
#pragma unroll
            for (int x = 0; x < 4; ++x) { const float kk = kkr[x] * inv, kd = k[x] * (1.f + (a[x] - 1.f) * CST[192 + c4 + x]), bb = kk * a[x];
                const float g = __expf(-cu[x]), gp = __expf(-cp[x]), ig = __expf(cu[x]);
                kks[x] = kk * gp; bs[x] = bb * ig; kds[x] = kd * ig; rs[x] = r[x] * g; bn += r[x] * kd * CST[256 + c4 + x];
                if (j == TB - 1) GC[c4 + x] = g;
            }
#pragma unroll
            for (int x = 0; x < 4; x += 2) { const unsigned pb = cvt_pk_bf16(bs[x], bs[x + 1]), pk = cvt_pk_bf16(kds[x], kds[x + 1]), pv = cvt_pk_bf16(vv[x], vv[x + 1]);
                BST[(c4 + x) * 40 + j] = (bf16_t)pb; BST[(c4 + x + 1) * 40 + j] = (bf16_t)(pb >> 16); KDST[(c4 + x) * 40 + j] = (bf16_t)pk; KDST[(c4 + x + 1) * 40 + j] = (bf16_t)(pk >> 16);
                VT[(c4 + x) * 40 + j] = (bf16_t)pv; VT[(c4 + x + 1) * 40 + j] = (bf16_t)(pv >> 16); }
            bn = allreduce16(bn);
            u32x2 w; w.x = cvt_pk_bf16(kks[0], kks[1]); w.y = cvt_pk_bf16(kks[2], kks[3]); *(LAS u32x2*)(KKS + j * 72 + c4) = w;
            w.x = cvt_pk_bf16(bs[0], bs[1]); w.y = cvt_pk_bf16(bs[2], bs[3]); *(LAS u32x2*)(BS + j * 72 + c4) = w;
            w.x = cvt_pk_bf16(kds[0], kds[1]); w.y = cvt_pk_bf16(kds[2], kds[3]); *(LAS u32x2*)(KDS + j * 72 + c4) = w;
            w.x = cvt_pk_bf16(rs[0], rs[1]); w.y = cvt_pk_bf16(rs[2], rs[3]); *(LAS u32x2*)(RS + j * 72 + c4) = w;
            if ((tid & 15) == 0) BON[j] = bn;
        }
        __syncthreads();
        if (MODE == 1) continue;
        const int ctg = wid & 1;
        f32x4 accG = (f32x4){0.f, 0.f, 0.f, 0.f}, accY = accG;
        {
            const int pr = wid >> 1, rts = wid & 1;
            const LAS bf16_t* Xm = (pr & 1) ? KDS : BS; const LAS bf16_t* Ym = (pr < 2) ? KKS : RS;
            const bf16x8 a0 = ldsb8(Xm + (rts * 16 + fr) * 72 + fq * 8), a1 = ldsb8(Xm + (rts * 16 + fr) * 72 + 32 + fq * 8);
#pragma unroll
            for (int cts = 0; cts < 2; ++cts) {
                f32x4 acc = (f32x4){0.f, 0.f, 0.f, 0.f};
                acc = __builtin_amdgcn_mfma_f32_16x16x32_bf16(a0, ldsb8(Ym + (cts * 16 + fr) * 72 + fq * 8), acc, 0, 0, 0);
                acc = __builtin_amdgcn_mfma_f32_16x16x32_bf16(a1, ldsb8(Ym + (cts * 16 + fr) * 72 + 32 + fq * 8), acc, 0, 0, 0);
                const int t = cts * 16 + fr, s0 = rts * 16 + fq * 4;
#pragma unroll
                for (int i = 0; i < 4; ++i) { const bool keep = (pr < 2) ? (s0 + i < t) : (s0 + i <= t); acc[i] = keep ? acc[i] : 0.f; }
                if (pr == 0) *(LAS f32x4*)(ABT + t * 32 + s0) = acc;
                else { u32x2 w; w.x = cvt_pk_bf16(acc[0], acc[1]); w.y = cvt_pk_bf16(acc[2], acc[3]); *(LAS u32x2*)((pr == 1 ? AKT : (pr == 2 ? NBT : NKT)) + t * 40 + s0) = w; }
            }
#pragma unroll
            for (int ks = 0; ks < 2; ++ks) { const bf16x8 sa = ldsb8(S0B + (rt * 16 + fr) * 72 + ks * 32 + fq * 8);
                accG = __builtin_amdgcn_mfma_f32_16x16x32_bf16(sa, ldsb8(KKS + (ctg * 16 + fr) * 72 + ks * 32 + fq * 8), accG, 0, 0, 0);
                accY = __builtin_amdgcn_mfma_f32_16x16x32_bf16(sa, ldsb8(RS + (ctg * 16 + fr) * 72 + ks * 32 + fq * 8), accY, 0, 0, 0); }
        }
        __syncthreads();
        {
            const bf16x8 va = ldsb8(VT + (rt * 16 + fr) * 40 + fq * 8);
            accG = __builtin_amdgcn_mfma_f32_16x16x32_bf16(va, ldsb8(AKT + (ctg * 16 + fr) * 40 + fq * 8), accG, 0, 0, 0);
            accY = __builtin_amdgcn_mfma_f32_16x16x32_bf16(va, ldsb8(NKT + (ctg * 16 + fr) * 40 + fq * 8), accY, 0, 0, 0);
#pragma unroll
            for (int i = 0; i < 4; ++i) Gm[(rt * 16 + fq * 4 + i) * 36 + ctg * 16 + fr] = -accG[i];
        }
        __syncthreads();
        if (MODE == 4) continue;
        if (wid < 4) {
            const int v = wid * 16 + (lane >> 2), pq = lane & 3;
            const LAS float* grow = Gm + v * 36;
            f32x4 r0 = *(const LAS f32x4*)(grow + 4 * pq), r1 = *(const LAS f32x4*)(grow + 16 + 4 * pq);
            u32x2 ubo[TB / 4];
            const LAS float* abd = ABT; asm volatile("" : "+v"(abd));
            const LAS float* abq = ABT + 128 * pq; asm volatile("" : "+v"(abq));
            f32x4 dc[3], a0c[4], a1c[4];
            auto ldg = [&](int g, f32x4 (&dd)[3], f32x4 (&aa0)[4], f32x4 (&aa1)[4]) {
#pragma unroll
                for (int x = 0; x < 3; ++x) dd[x] = *(const LAS f32x4*)(abd + (4 * g + 1 + x) * 32 + 4 * g);
#pragma unroll
                for (int jj = 0; jj < 4; ++jj) { if (g < 3) aa0[jj] = *(const LAS f32x4*)(abq + jj * 32 + 4 * g); if (g < 7) aa1[jj] = *(const LAS f32x4*)(abq + (16 + jj) * 32 + 4 * g); } };
            ldg(0, dc, a0c, a1c);
#pragma unroll
            for (int g = 0; g < TB / 4; ++g) {
                f32x4 dn[3], a0n[4], a1n[4];
                if (g + 1 < TB / 4) ldg(g + 1, dn, a0n, a1n);
                __builtin_amdgcn_sched_barrier(0);
                const f32x4 rr = g < 4 ? r0 : r1;
                f32x4 u4;
                u4[0] = rr[0];
                u4[1] = rr[1] - u4[0] * dc[0][0];
                u4[2] = rr[2] - (u4[0] * dc[1][0] + u4[1] * dc[1][1]);
                u4[3] = rr[3] - (u4[0] * dc[2][0] + u4[1] * dc[2][1] + u4[2] * dc[2][2]);
#pragma unroll
                for (int x = 0; x < 4; ++x) { const int ui = __float_as_int(u4[x]); int bi;
                    if ((g & 3) == 0) bi = __builtin_amdgcn_update_dpp(0, ui, 0x00, 0xF, 0xF, true); else if ((g & 3) == 1) bi = __builtin_amdgcn_update_dpp(0, ui, 0x55, 0xF, 0xF, true);
                    else if ((g & 3) == 2) bi = __builtin_amdgcn_update_dpp(0, ui, 0xAA, 0xF, 0xF, true); else bi = __builtin_amdgcn_update_dpp(0, ui, 0xFF, 0xF, 0xF, true);
                    u4[x] = __int_as_float(bi); }
                ubo[g].x = cvt_pk_bf16(u4[0], u4[1]); ubo[g].y = cvt_pk_bf16(u4[2], u4[3]);
                if (g < 3) {
#pragma unroll
                    for (int jj = 0; jj < 4; ++jj) r0[jj] -= u4[0] * a0c[jj][0] + u4[1] * a0c[jj][1] + u4[2] * a0c[jj][2] + u4[3] * a0c[jj][3]; }
                if (g < 7) {
#pragma unroll
                    for (int jj = 0; jj < 4; ++jj) r1[jj] -= u4[0] * a1c[jj][0] + u4[1] * a1c[jj][1] + u4[2] * a1c[jj][2] + u4[3] * a1c[jj][3]; }
                if (g + 1 < TB / 4) {
#pragma unroll
                    for (int x = 0; x < 3; ++x) dc[x] = dn[x];
#pragma unroll
                    for (int jj = 0; jj < 4; ++jj) { a0c[jj] = a0n[jj]; a1c[jj] = a1n[jj]; } }
            }
            if (pq == 0) {
#pragma unroll
                for (int g = 0; g < TB / 4; g += 2) { u32x4 w; w.x = ubo[g].x; w.y = ubo[g].y; w.z = ubo[g + 1].x; w.w = ubo[g + 1].y; *(LAS u32x4*)(UB + v * 40 + 4 * g) = w; } }
        }
        __syncthreads();
        if (MODE == 5) continue;
        {
            const bf16x8 ua = ldsb8(UB + (rt * 16 + fr) * 40 + fq * 8), va = ldsb8(VT + (rt * 16 + fr) * 40 + fq * 8);
            accY = __builtin_amdgcn_mfma_f32_16x16x32_bf16(ua, ldsb8(NBT + (ctg * 16 + fr) * 40 + fq * 8), accY, 0, 0, 0);
            *(LAS f32x4*)(YO + (ctg * 16 + fr) * 64 + rt * 16 + fq * 4) = accY;
#pragma unroll
            for (int cc = 0; cc < 2; ++cc) { const int ct = 2 * (wid & 1) + cc, kcol = ct * 16 + fr;
                f32x4 acc = Sreg[cc];
                acc = __builtin_amdgcn_mfma_f32_16x16x32_bf16(ua, ldsb8(BST + kcol * 40 + fq * 8), acc, 0, 0, 0);
                acc = __builtin_amdgcn_mfma_f32_16x16x32_bf16(va, ldsb8(KDST + kcol * 40 + fq * 8), acc, 0, 0, 0);
                const float g = GC[kcol];
#pragma unroll
                for (int i = 0; i < 4; ++i) acc[i] *= g;
                { const unsigned p0 = cvt_pk_bf16(acc[0], acc[1]), p1 = cvt_pk_bf16(acc[2], acc[3]); LAS bf16_t* sp = S0B + (rt * 16 + fq * 4) * 72 + kcol;
                  sp[0] = (bf16_t)p0; sp[72] = (bf16_t)(p0 >> 16); sp[144] = (bf16_t)p1; sp[216] = (bf16_t)(p1 >> 16); }
                Sreg[cc] = acc; }
        }
        __syncthreads();
        if (!isctx) {
            const int j = tid >> 4, c4 = (tid & 15) * 4, t = d == 0 ? j : TB - 1 - j; const f32x4 y = *(const LAS f32x4*)(YO + j * 64 + c4);
            u32x2 w; w.x = cvt_pk_bf16(y[0], y[1]); w.y = cvt_pk_bf16(y[2], y[3]);
            bf16_t* yb_ = p.Y + ((size_t)d * nlat + grow0) * RW + h * 64;
            *(u32x2*)(yb_ + t * RW + c4) = w;
            if (tid < TB) { const int tt = d == 0 ? tid : TB - 1 - tid; float* bb_ = p.bon + ((size_t)d * nlat + grow0) * NH + h; bb_[tt * NH] = BON[tid]; }
        }
    }
}
template <int MODE = 0>
__device__ __forceinline__ void rwkv_phase2(LAS unsigned char* lds, const In& in, const RwkvP p, int bid, int nblk) {
    const int nchain = 2 * p.nb * NH;
    for (int c = bid; c < nchain; c += nblk) { rwkv_chain2<MODE>(lds, in, p, c); __syncthreads(); }
}
}

namespace mk {
constexpr int LR_XT = 0;
constexpr int LR_XC = LR_XT + 67 * 64 * 2 + 64;
constexpr int LR_XCB = LR_XC + 64 * 64 * 4;
constexpr int LR_GWT = LR_XCB + 64 * 72 * 2;
constexpr int LR_A = LR_GWT + 2 * 64 * 72 * 2;
constexpr int LR_BX = LR_A + 64 * 64 * 4;
constexpr int LR_HO = LR_BX + 64 * 64 * 4;
constexpr int LR_CST = LR_HO + 64 * 64 * 4;
constexpr int LR_SEGP = LR_CST + 8 * 64 * 4;
constexpr int LR_SEGH = LR_SEGP + 8 * 64 * 4;
constexpr int LR_HC = LR_SEGH + 8 * 64 * 4;
constexpr int LR_END = LR_HC + 64 * 4;
static_assert(LR_END <= LDS_BYTES && (LR_XC % 16) == 0, "lru LDS");

struct LruP { const bf16_t* z1; bf16_t* Hd; int b0, nb; };

__device__ __forceinline__ void lru_item(LAS unsigned char* lds, const In& in, const LruP p, int item) {
    const int tid = threadIdx.x, lane = tid & 63, wid = tid >> 6;
    const int d = item / (p.nb * LB), bl = (item / LB) % p.nb, n = item % LB;
    const int nlat = p.nb * SEQ;
    LAS bf16_t* XT = (LAS bf16_t*)(lds + LR_XT); LAS float* XC = (LAS float*)(lds + LR_XC); LAS bf16_t* XCB = (LAS bf16_t*)(lds + LR_XCB); LAS bf16_t* GWT = (LAS bf16_t*)(lds + LR_GWT);
    LAS float *A_ = (LAS float*)(lds + LR_A), *BX = (LAS float*)(lds + LR_BX), *HO = (LAS float*)(lds + LR_HO), *CST = (LAS float*)(lds + LR_CST), *SEGP = (LAS float*)(lds + LR_SEGP), *SEGH = (LAS float*)(lds + LR_SEGH), *HC = (LAS float*)(lds + LR_HC);
    for (int i = tid; i < 2 * 64 * 64; i += NT) { const int g = i >> 12, j = (i >> 6) & 63, k = i & 63;
        GWT[(g * 64 + k) * 72 + j] = f2bf(in.lru_gate_w[((((size_t)d * 2 + g) * LB + n) * LBS + j) * LBS + k]); }
    for (int i = tid; i < 64; i += NT) { const int c = n * 64 + i;
        CST[i] = in.lru_conv_w[c]; CST[64 + i] = in.lru_conv_w[LW + c]; CST[128 + i] = in.lru_conv_w[2 * LW + c]; CST[192 + i] = in.lru_conv_w[3 * LW + c]; CST[256 + i] = in.lru_conv_b[c];
        CST[320 + i] = in.lru_gate_b[((d * 2 + 0) * LB + n) * LBS + i]; CST[384 + i] = in.lru_gate_b[((d * 2 + 1) * LB + n) * LBS + i]; CST[448 + i] = softplusf_(-in.lru_l[d * LW + c]); }
    constexpr int NSEG = CTX / 64 + GW, NSC = CTX / 64;
    u32x4 pre[2];
    auto tok_row = [&](int sidx, int rr, bool& ok) -> size_t {
        if (sidx < NSC) { const int t = sidx * 64 + rr - 2; ok = t >= 0 && t < CTX; return (size_t)nlat + (size_t)bl * CTX + t; }
        const int col = sidx - NSC, row = rr - 2; ok = row >= 0 && row < ROWS; return (size_t)bl * SEQ + (size_t)row * GW + col;
    };
    auto seg_of = [&](int q) { if (q < NSC) return d == 0 ? q : NSC - 1 - q; const int ql = q - NSC; return NSC + (d == 0 ? ql : GW - 1 - ql); };
    auto prefetch = [&](int q) { const int sidx = seg_of(q);
#pragma unroll
        for (int k = 0; k < 2; ++k) { const int i = tid + k * NT; u32x4 v = (u32x4){0u, 0u, 0u, 0u};
            if (i < 67 * 8) { const int rr = i >> 3, part = i & 7; bool ok; const size_t gr = tok_row(sidx, rr, ok); if (ok) v = *(const u32x4*)(p.z1 + gr * Z1_N + Z1_LX + n * 64 + part * 8); }
            pre[k] = v; } };
    auto commit = [&]() {
#pragma unroll
        for (int k = 0; k < 2; ++k) { const int i = tid + k * NT; if (i < 67 * 8) *(LAS u32x4*)(XT + (i >> 3) * 64 + (i & 7) * 8) = pre[k]; } };
    if (tid < 64) HC[tid] = 0.f;
    prefetch(0);
    for (int q = 0; q < NSEG; ++q) {
        const int sidx = seg_of(q);
        commit();
        __syncthreads();
        if (q + 1 < NSEG) prefetch(q + 1);
        { const int t = tid >> 3, c0 = (tid & 7) * 8; float s[8];
#pragma unroll
          for (int j = 0; j < 8; ++j) s[j] = CST[256 + c0 + j];
#pragma unroll
          for (int tap = 0; tap < 4; ++tap) { const u32x4 x = *(const LAS u32x4*)(XT + (t + tap) * 64 + c0);
#pragma unroll
              for (int j = 0; j < 4; ++j) { s[2 * j] += CST[tap * 64 + c0 + 2 * j] * bflo(x[j]); s[2 * j + 1] += CST[tap * 64 + c0 + 2 * j + 1] * bfhi(x[j]); } }
          *(LAS f32x4*)(XC + t * 64 + c0) = (f32x4){s[0], s[1], s[2], s[3]}; *(LAS f32x4*)(XC + t * 64 + c0 + 4) = (f32x4){s[4], s[5], s[6], s[7]};
          u32x4 w; w.x = cvt_pk_bf16(s[0], s[1]); w.y = cvt_pk_bf16(s[2], s[3]); w.z = cvt_pk_bf16(s[4], s[5]); w.w = cvt_pk_bf16(s[6], s[7]); *(LAS u32x4*)(XCB + t * 72 + c0) = w; }
        __syncthreads();
        { const int rt = wid >> 1, fr = lane & 15, fq = lane >> 4;
          bf16x8 a[2];
#pragma unroll
          for (int ks = 0; ks < 2; ++ks) a[ks] = *(const LAS bf16x8*)(XCB + (rt * 16 + fr) * 72 + ks * 32 + fq * 8);
#pragma unroll
          for (int cc = 0; cc < 2; ++cc) { const int ct = 2 * (wid & 1) + cc, col = ct * 16 + fr;
              f32x4 acc0 = (f32x4){0.f, 0.f, 0.f, 0.f}, acc1 = acc0;
#pragma unroll
              for (int ks = 0; ks < 2; ++ks) {
                  const bf16x8 b0 = *(const LAS bf16x8*)(GWT + (0 * 64 + col) * 72 + ks * 32 + fq * 8), b1 = *(const LAS bf16x8*)(GWT + (1 * 64 + col) * 72 + ks * 32 + fq * 8);
                  acc0 = __builtin_amdgcn_mfma_f32_16x16x32_bf16(a[ks], b0, acc0, 0, 0, 0); acc1 = __builtin_amdgcn_mfma_f32_16x16x32_bf16(a[ks], b1, acc1, 0, 0, 0); }
#pragma unroll
              for (int i = 0; i < 4; ++i) { const int t = rt * 16 + fq * 4 + i;
                  const float rec = fast_sigmoid(acc0[i] + CST[320 + col]), inp = fast_sigmoid(acc1[i] + CST[384 + col]);
                  const float la = -8.f * rec * CST[448 + col];
                  const float av = __expf(la), x2 = 2.f * la; const float om = x2 > -0.03f ? -x2 * (1.f + x2 * (0.5f + x2 * (1.f / 6.f))) : 1.f - av * av;
                  A_[t * 64 + col] = av; BX[t * 64 + col] = __builtin_amdgcn_sqrtf(om) * inp * XC[t * 64 + col]; } } }
        __syncthreads();
        { const int ch = tid & 63, pc = tid >> 6; float av[8], bv[8]; float P = 1.f, H = 0.f;
#pragma unroll
          for (int x = 0; x < 8; ++x) { const int st = pc * 8 + x, t = d == 0 ? st : 63 - st; av[x] = A_[t * 64 + ch]; bv[x] = BX[t * 64 + ch]; H = av[x] * H + bv[x]; P *= av[x]; }
          SEGP[pc * 64 + ch] = P; SEGH[pc * 64 + ch] = H;
          __syncthreads();
          float h = HC[ch];
#pragma unroll
          for (int q2 = 0; q2 < 7; ++q2) if (q2 < pc) h = SEGP[q2 * 64 + ch] * h + SEGH[q2 * 64 + ch];
#pragma unroll
          for (int x = 0; x < 8; ++x) { const int st = pc * 8 + x, t = d == 0 ? st : 63 - st; h = av[x] * h + bv[x]; HO[t * 64 + ch] = h; }
          __syncthreads();
          if (pc == 7) HC[ch] = h;
        }
        if (sidx >= NSC) { const int col = sidx - NSC, t = tid >> 3, c0 = (tid & 7) * 8;
            const f32x4 x = *(const LAS f32x4*)(HO + t * 64 + c0), y = *(const LAS f32x4*)(HO + t * 64 + c0 + 4);
            *(u32x4*)(p.Hd + ((size_t)d * nlat + (size_t)bl * SEQ + (size_t)t * GW + col) * LW + n * 64 + c0) = pack8(x, y); }
    }
}
__device__ __forceinline__ void lru_phase(LAS unsigned char* lds, const In& in, const LruP p, int bid, int nblk) {
    const int nitem = 2 * p.nb * LB;
    for (int it = bid; it < nitem; it += nblk) { lru_item(lds, in, p, it); __syncthreads(); }
}
}

namespace mk {
#define MK_DPPX(x, ctrl) __int_as_float(__builtin_amdgcn_update_dpp(__float_as_int(x), __float_as_int(x), ctrl, 0xF, 0xF, false))
__device__ __forceinline__ float allreduce4(float x) { x += MK_DPPX(x, 0xB1); x += MK_DPPX(x, 0x4E); return x; }
__device__ __forceinline__ void unpack8(const u32x4 w, float (&f)[8]) {
#pragma unroll
    for (int j = 0; j < 4; ++j) { f[2 * j] = bflo(w[j]); f[2 * j + 1] = bfhi(w[j]); } }
constexpr int AG_K = 256;
struct PostP { const bf16_t* z1; bf16_t* Y; const float* bon; bf16_t* Ag; int nlat; int pad_; };
__device__ __forceinline__ void rwkv_post_rows(const In& in, const PostP p, int row_lo, int row_hi, bool dry = false) {
    const int lane = threadIdx.x & 63, wid = threadIdx.x >> 6, c0 = lane * 16, h = lane >> 2;
    float mu0v[16], mu1v[16], l0[16], l1[16], mg0[8], mg1[8];
#pragma unroll
    for (int j = 0; j < 16; ++j) { mu0v[j] = in.shift_mu[OFF_V + c0 + j]; mu1v[j] = in.shift_mu[RC + OFF_V + c0 + j]; l0[j] = in.rw_lnx[c0 + j]; l1[j] = in.rw_lnx[RW + c0 + j]; }
#pragma unroll
    for (int j = 0; j < 8; ++j) { const int c = OFF_GD + (lane < GL / 8 ? lane : 0) * 8 + j; mg0[j] = in.shift_mu[c]; mg1[j] = in.shift_mu[RC + c]; }
    for (int r = row_lo + wid; r < row_hi; r += NT / 64) {
        const int cg = r % GW; const bool hp = cg > 0, hn = cg < GW - 1;
        bf16_t* y0p = p.Y + (size_t)r * RW + c0; const bf16_t* y1p = p.Y + ((size_t)p.nlat + r) * RW + c0;
        float y[16], t8[8];
        unpack8(*(const u32x4*)y0p, t8);
#pragma unroll
        for (int j = 0; j < 8; ++j) y[j] = t8[j];
        unpack8(*(const u32x4*)(y0p + 8), t8);
#pragma unroll
        for (int j = 0; j < 8; ++j) y[8 + j] = t8[j];
        unpack8(*(const u32x4*)y1p, t8);
#pragma unroll
        for (int j = 0; j < 8; ++j) y[j] += t8[j];
        unpack8(*(const u32x4*)(y1p + 8), t8);
#pragma unroll
        for (int j = 0; j < 8; ++j) y[8 + j] += t8[j];
        float s = 0.f;
#pragma unroll
        for (int j = 0; j < 16; ++j) s += y[j];
        const float mu = allreduce4(s) * (1.f / 64.f); float q = 0.f;
#pragma unroll
        for (int j = 0; j < 16; ++j) { const float dlt = y[j] - mu; q += dlt * dlt; }
        const float rs = 1.f / sqrtf(allreduce4(q) * (1.f / 64.f) + LNX_EPS);
        const float bonus = p.bon[(size_t)r * NH + h] + p.bon[((size_t)p.nlat + r) * NH + h];
        const bf16_t* zr = p.z1 + (size_t)r * Z1_N;
#pragma unroll
        for (int half = 0; half < 2; ++half) {
            const int c = OFF_V + c0 + half * 8; float xv[8], pv[8], nv[8];
            unpack8(*(const u32x4*)(zr + c), xv);
            if (hp) unpack8(*(const u32x4*)(zr - Z1_N + c), pv); else {
#pragma unroll
                for (int j = 0; j < 8; ++j) pv[j] = 0.f; }
            if (hn) unpack8(*(const u32x4*)(zr + Z1_N + c), nv); else {
#pragma unroll
                for (int j = 0; j < 8; ++j) nv[j] = 0.f; }
            float o[8];
#pragma unroll
            for (int j = 0; j < 8; ++j) { const int cj = half * 8 + j; const float v = xv[j] + mu0v[cj] * (pv[j] - xv[j]) + mu1v[cj] * (nv[j] - xv[j]);
                o[j] = (y[cj] - mu) * rs * l0[cj] + l1[cj] + bonus * v; }
            u32x4 w; w.x = cvt_pk_bf16(o[0], o[1]); w.y = cvt_pk_bf16(o[2], o[3]); w.z = cvt_pk_bf16(o[4], o[5]); w.w = cvt_pk_bf16(o[6], o[7]); if (!dry) *(u32x4*)(y0p + half * 8) = w; else if (w.x == 0x12345678u) *(u32x4*)(y0p + half * 8) = w;
        }
        if (lane < 32) { u32x4 w = (u32x4){0u, 0u, 0u, 0u};
            if (lane < GL / 8) { const int c = OFF_GD + lane * 8; float xv[8], pv[8], nv[8];
                unpack8(*(const u32x4*)(zr + c), xv);
                if (hp) unpack8(*(const u32x4*)(zr - Z1_N + c), pv); else {
#pragma unroll
                    for (int j = 0; j < 8; ++j) pv[j] = 0.f; }
                if (hn) unpack8(*(const u32x4*)(zr + Z1_N + c), nv); else {
#pragma unroll
                    for (int j = 0; j < 8; ++j) nv[j] = 0.f; }
                float o[8];
#pragma unroll
                for (int j = 0; j < 8; ++j) o[j] = fast_sigmoid(xv[j] + mg0[j] * (pv[j] - xv[j]) + mg1[j] * (nv[j] - xv[j]));
                w.x = cvt_pk_bf16(o[0], o[1]); w.y = cvt_pk_bf16(o[2], o[3]); w.z = cvt_pk_bf16(o[4], o[5]); w.w = cvt_pk_bf16(o[6], o[7]); }
            *(u32x4*)(p.Ag + (size_t)r * AG_K + lane * 8) = w; }
    }
}
#define MK_FR_ROW(f) ((((f) >> 3) * HALF) + wr * 64 + ((((f) >> 1) & 3) * 16) + fr)
#define MK_FR_COL(f) ((((f) & 1) * HALF) + wc * 32 + 8 * fq)
#define MK_FR_ACC(f, n) acc[(f) >> 3][(f) & 1][((f) >> 1) & 3][n]
#define MK_FENCE asm volatile("" ::: "memory")
struct EpiYa { const bf16_t* yn; bf16_t* ya;
    __device__ __forceinline__ bool operator()(f32x4 (&acc)[2][2][4][2], const Unit& u, int wr, int wc, int fr, int fq) const {
        const size_t base = (size_t)(u.pm * BM) * RW + u.pn * BM;
        u32x4 cur = *(const u32x4*)(yn + base + (size_t)MK_FR_ROW(0) * RW + MK_FR_COL(0));
#pragma unroll
        for (int f = 0; f < 16; ++f) { u32x4 nxt = cur; if (f + 1 < 16) nxt = *(const u32x4*)(yn + base + (size_t)MK_FR_ROW(f + 1) * RW + MK_FR_COL(f + 1));
            MK_FENCE; float v[8]; unpack8(cur, v); f32x4 a = MK_FR_ACC(f, 0), b = MK_FR_ACC(f, 1);
#pragma unroll
            for (int j = 0; j < 4; ++j) { a[j] *= v[j]; b[j] *= v[4 + j]; }
            *(u32x4*)(ya + base + (size_t)MK_FR_ROW(f) * RW + MK_FR_COL(f)) = pack8(a, b); MK_FENCE; cur = nxt; }
        return false; } };
struct EpiZc { const bf16_t* Hd; bf16_t* yb; bf16_t* gates; int nlat; int pad_;
    __device__ __forceinline__ bool operator()(f32x4 (&acc)[2][2][4][2], const Unit& u, int wr, int wc, int fr, int fq) const {
        if (u.pn < LW / BM) {
            MK_FRAG_LOOP(r, c) { const size_t o = (size_t)(u.pm * BM + r) * LW + u.pn * BM + c; float h0[8], h1[8]; unpack8(*(const u32x4*)(Hd + o), h0); unpack8(*(const u32x4*)(Hd + (size_t)nlat * LW + o), h1);
                f32x4 a = acc[ai][bj][m][0], b = acc[ai][bj][m][1];
#pragma unroll
                for (int j = 0; j < 4; ++j) { a[j] = gelu_tanhf_(a[j]) * (h0[j] + h1[j]); b[j] = gelu_tanhf_(b[j]) * (h0[4 + j] + h1[4 + j]); }
                *(u32x4*)(yb + o) = pack8(a, b); asm volatile("" ::: "memory"); }
        } else {
            MK_FRAG_LOOP(r, c) { const size_t o = (size_t)(u.pm * BM + r) * (2 * D) + (u.pn * BM - LW) + c;
                f32x4 a = acc[ai][bj][m][0], b = acc[ai][bj][m][1];
#pragma unroll
                for (int j = 0; j < 4; ++j) { a[j] = fast_sigmoid(a[j]); b[j] = fast_sigmoid(b[j]); }
                *(u32x4*)(gates + o) = pack8(a, b); }
        }
        return false; } };
struct PairOrder { StaticOrder S;
    __device__ bool next(int i, Unit& u) const { if (!S.next(i >> 1, u)) return false; u.e = i & 1; return true; } };
struct EpiBranch { const bf16_t* gates; bf16_t* mixed;
    __device__ __forceinline__ bool operator()(f32x4 (&acc)[2][2][4][2], const Unit& u, int wr, int wc, int fr, int fq) const {
        const size_t gbase = (size_t)(u.pm * BM) * (2 * D) + u.pn * BM, mbase = (size_t)(u.pm * BM) * D + u.pn * BM;
        u32x4 c1 = (u32x4){0u, 0u, 0u, 0u}, c2 = *(const u32x4*)(gates + gbase + (size_t)MK_FR_ROW(0) * (2 * D) + D + MK_FR_COL(0));
        if (u.e == 0) c1 = *(const u32x4*)(gates + gbase + (size_t)MK_FR_ROW(0) * (2 * D) + MK_FR_COL(0));
#pragma unroll
        for (int f = 0; f < 16; ++f) { u32x4 n1 = c1, n2 = c2;
            if (f + 1 < 16) { const size_t o = gbase + (size_t)MK_FR_ROW(f + 1) * (2 * D) + MK_FR_COL(f + 1); n2 = *(const u32x4*)(gates + o + D); if (u.e == 0) n1 = *(const u32x4*)(gates + o); }
            MK_FENCE; float g1[8], g2[8]; unpack8(c1, g1); unpack8(c2, g2);
            if (u.e == 0) {
#pragma unroll
                for (int j = 0; j < 4; ++j) { MK_FR_ACC(f, 0)[j] *= g1[j] / g2[j]; MK_FR_ACC(f, 1)[j] *= g1[4 + j] / g2[4 + j]; }
            } else { f32x4 a = MK_FR_ACC(f, 0), b = MK_FR_ACC(f, 1);
#pragma unroll
                for (int j = 0; j < 4; ++j) { a[j] *= g2[j]; b[j] *= g2[4 + j]; }
                *(u32x4*)(mixed + mbase + (size_t)MK_FR_ROW(f) * D + MK_FR_COL(f)) = pack8(a, b); }
            MK_FENCE; c1 = n1; c2 = n2; }
        return u.e == 0; } };
struct EpiF32 { float* C; long ldc;
    __device__ __forceinline__ bool operator()(f32x4 (&acc)[2][2][4][2], const Unit& u, int wr, int wc, int fr, int fq) const {
        MK_FRAG_LOOP(r, c) { float* o = C + (size_t)(u.pm * BM + r) * ldc + u.pn * BM + c; *(f32x4*)o = acc[ai][bj][m][0]; *(f32x4*)(o + 4) = acc[ai][bj][m][1]; }
        return false; } };
}

namespace mk {
constexpr int NEX = NE + 1;
constexpr int SLOTS_PER_TOK = TOPK + 1;
constexpr int RP_MOD = 0;
constexpr int RP_UH = RP_MOD + 3 * D * 4;
constexpr int RP_UL = RP_UH + 16 * (D + 8) * 2;
constexpr int RP_PART = RP_UL + 16 * (D + 8) * 2;
constexpr int RP_LOG = RP_PART + 8 * 16 * 64 * 4;
constexpr int RP_HIST = RP_LOG + 16 * 64 * 4;
constexpr int RP_END = RP_HIST + 64 * 4;
static_assert(RP_END <= LDS_BYTES, "rowpass LDS");

struct RowP { float* y2h1; bf16_t* u; const float* modpart; const bf16_t* rwt;
              int* tope; float* gatev; int* lrank; int* blkcnt; int b0, nlat; };
__device__ __forceinline__ float wave_max(float x) {
#pragma unroll
    for (int o = 32; o > 0; o >>= 1) x = fmaxf(x, __shfl_xor(x, o));
    return x; }
__device__ __forceinline__ void row_pass(LAS unsigned char* lds, const In& in, const RowP p, int row_lo, int row_hi, bool dry = false) {
    const int tid = threadIdx.x, lane = tid & 63, wid = tid >> 6;
    LAS float* MOD = (LAS float*)(lds + RP_MOD); LAS bf16_t* UH = (LAS bf16_t*)(lds + RP_UH); LAS bf16_t* UL = (LAS bf16_t*)(lds + RP_UL);
    LAS float* PART = (LAS float*)(lds + RP_PART); LAS float* LOG = (LAS float*)(lds + RP_LOG); LAS int* HIST = (LAS int*)(lds + RP_HIST);
    const int mr = p.b0 + row_lo / SEQ;
    for (int j = tid; j < 3 * D; j += NT) MOD[j] = mod_value(in, p.modpart, mr, 2 * D + j);
    if (tid < 64) HIST[tid] = 0;
    __syncthreads();
    float gp1[16], gp2[16];
#pragma unroll
    for (int j = 0; j < 4; ++j)
#pragma unroll
        for (int q = 0; q < 4; ++q) { gp1[4 * j + q] = in.norm_g[D + j * 256 + lane * 4 + q]; gp2[4 * j + q] = in.norm_g[2 * D + j * 256 + lane * 4 + q]; }
    for (int r16 = row_lo; r16 < row_hi; r16 += 16) {
#pragma unroll
        for (int rr = 0; rr < 2; ++rr) {
            const int lr = wid * 2 + rr, r = r16 + lr;
            float* yp = p.y2h1 + (size_t)r * D; const float* xp = in.x + ((size_t)p.b0 * SEQ + r) * D;
            f32x4 v[4]; float ss = 0.f;
#pragma unroll
            for (int j = 0; j < 4; ++j) { v[j] = *(const f32x4*)(yp + j * 256 + lane * 4); ss += v[j][0] * v[j][0] + v[j][1] * v[j][1] + v[j][2] * v[j][2] + v[j][3] * v[j][3]; }
#pragma unroll
            for (int o = 32; o > 0; o >>= 1) ss += __shfl_xor(ss, o);
            const float rinv = 1.f / sqrtf(ss * (1.f / D) + NORM_EPS); float s2 = 0.f;
#pragma unroll
            for (int j = 0; j < 4; ++j) { const int c = j * 256 + lane * 4; const f32x4 xv = *(const f32x4*)(xp + c);
#pragma unroll
                for (int q = 0; q < 4; ++q) { const float hv = xv[q] + MOD[c + q] * (v[j][q] * rinv * gp1[4 * j + q]); v[j][q] = hv; s2 += hv * hv; }
                if (!dry) *(f32x4*)(yp + c) = v[j]; }
#pragma unroll
            for (int o = 32; o > 0; o >>= 1) s2 += __shfl_xor(s2, o);
            const float r2 = 1.f / sqrtf(s2 * (1.f / D) + NORM_EPS);
#pragma unroll
            for (int j = 0; j < 4; ++j) { const int c = j * 256 + lane * 4; float uu[4], lo[4]; unsigned hw[2];
#pragma unroll
                for (int q = 0; q < 4; ++q) uu[q] = (v[j][q] * r2 * gp2[4 * j + q]) * (1.f + MOD[2 * D + c + q]) + MOD[D + c + q];
                hw[0] = cvt_pk_bf16(uu[0], uu[1]); hw[1] = cvt_pk_bf16(uu[2], uu[3]);
                lo[0] = uu[0] - bflo(hw[0]); lo[1] = uu[1] - bfhi(hw[0]); lo[2] = uu[2] - bflo(hw[1]); lo[3] = uu[3] - bfhi(hw[1]);
                u32x2 w; w.x = hw[0]; w.y = hw[1]; *(u32x2*)(p.u + (size_t)r * D + c) = w; *(LAS u32x2*)(UH + lr * (D + 8) + c) = w;
                u32x2 wl; wl.x = cvt_pk_bf16(lo[0], lo[1]); wl.y = cvt_pk_bf16(lo[2], lo[3]); *(LAS u32x2*)(UL + lr * (D + 8) + c) = wl; }
        }
        __syncthreads();
        { const int fr = lane & 15, fq = lane >> 4;
          f32x4 acc[4];
#pragma unroll
          for (int ct = 0; ct < 4; ++ct) acc[ct] = (f32x4){0.f, 0.f, 0.f, 0.f};
#pragma unroll
          for (int ks = 0; ks < 4; ++ks) { const int k0 = wid * 128 + ks * 32 + fq * 8;
              const bf16x8 ah = *(const LAS bf16x8*)(UH + fr * (D + 8) + k0), al = *(const LAS bf16x8*)(UL + fr * (D + 8) + k0);
#pragma unroll
              for (int ct = 0; ct < 4; ++ct) { const bf16x8 bh = *(const bf16x8*)(p.rwt + (size_t)(ct * 16 + fr) * D + k0), bl = *(const bf16x8*)(p.rwt + (size_t)(NE + ct * 16 + fr) * D + k0);
                  acc[ct] = __builtin_amdgcn_mfma_f32_16x16x32_bf16(ah, bh, acc[ct], 0, 0, 0); acc[ct] = __builtin_amdgcn_mfma_f32_16x16x32_bf16(ah, bl, acc[ct], 0, 0, 0); acc[ct] = __builtin_amdgcn_mfma_f32_16x16x32_bf16(al, bh, acc[ct], 0, 0, 0); } }
#pragma unroll
          for (int ct = 0; ct < 4; ++ct)
#pragma unroll
              for (int i = 0; i < 4; ++i) PART[(wid * 16 + fq * 4 + i) * 64 + ct * 16 + fr] = acc[ct][i]; }
        __syncthreads();
        for (int i = tid; i < 16 * 64; i += NT) { float s = 0.f;
#pragma unroll
            for (int w = 0; w < 8; ++w) s += PART[w * 1024 + i];
            LOG[i] = s; }
        __syncthreads();
#pragma unroll 1
        for (int rr = 0; rr < 2; ++rr) {
            const int lr = wid * 2 + rr, r = r16 + lr;
            const float sc = sigmoidf_(LOG[lr * 64 + lane]), bi = sc + in.router_b[lane];
            float m1 = bi; m1 = fmaxf(m1, __shfl_xor(m1, 1)); m1 = fmaxf(m1, __shfl_xor(m1, 2)); m1 = fmaxf(m1, __shfl_xor(m1, 4));
            const unsigned long long eq = __ballot(bi == m1); const int first = __ffsll((long long)((eq >> (lane & ~7)) & 0xffull)) - 1 + (lane & ~7);
            float m2 = (lane == first) ? -1e30f : bi; m2 = fmaxf(m2, __shfl_xor(m2, 1)); m2 = fmaxf(m2, __shfl_xor(m2, 2)); m2 = fmaxf(m2, __shfl_xor(m2, 4));
            const float gs = m1 + m2; const int myg = lane >> 3; int rank = 0;
#pragma unroll
            for (int g = 0; g < NG; ++g) { const float og = __shfl(gs, g * 8); rank += (og > gs || (og == gs && g < myg)) ? 1 : 0; }
            float cand = rank < TG ? bi : -1e30f; float tsum = 0.f; int myidx = 0; float mysc = 0.f;
#pragma unroll
            for (int it = 0; it < TOPK; ++it) { const float m = wave_max(cand); const unsigned long long bm = __ballot(cand == m); const int win = __ffsll((long long)bm) - 1;
                const float ws = __shfl(sc, win); tsum += ws; if (lane == it) { myidx = win; mysc = ws; } if (lane == win) cand = -1e30f; }
            if (lane < TOPK) { const int rk = atomicAdd((int*)&HIST[myidx], 1);
                p.tope[(size_t)r * TOPK + lane] = myidx; p.gatev[(size_t)r * TOPK + lane] = mysc / tsum * 2.5f; p.lrank[(size_t)r * TOPK + lane] = rk; }
        }
        __syncthreads();
    }
    if (tid < 64) p.blkcnt[blockIdx.x * 64 + tid] = HIST[tid];
}

struct MoeP { const int* tope; const float* gatev; const int* lrank; const int* blkcnt;
              int* tilepre;
              int* list;
              int* sdst;
              float* sgate;
              int r0, nr, blk0, nbh, rpb, pad_; };
__device__ __forceinline__ void moe_assign(LAS unsigned char* lds, const MoeP p, int bid, int nblk) {
    LAS int* BASE = (LAS int*)lds; LAS int* CNT = BASE + 80; LAS int* BOFF = CNT + 80;
    const int tid = threadIdx.x;
    if (tid < NE) { int c = 0, bo = 0; for (int b = 0; b < p.nbh; ++b) { const int v = p.blkcnt[(p.blk0 + b) * 64 + tid]; if (p.blk0 + b < bid) bo += v; c += v; } CNT[tid] = c; BOFF[tid] = bo; }
    __syncthreads();
    if (tid == 0) { int s = 0; for (int e = 0; e < NE; ++e) { BASE[e] = s; s += (CNT[e] + BM - 1) / BM * BM; } BASE[NE] = s; CNT[NE] = p.nr; BASE[NE + 1] = s + p.nr;
        if (bid == 0) { for (int e = 0; e <= NEX; ++e) p.tilepre[e] = BASE[e] / BM; } }
    __syncthreads();
    if (bid >= p.blk0 && bid < p.blk0 + p.nbh) {
        const int rlo = p.r0 + (bid - p.blk0) * p.rpb;
        for (int i = tid; i < p.rpb * TOPK; i += NT) { const int r = rlo + i / TOPK, a = r * TOPK + i % TOPK, e = p.tope[a]; const int slot = BASE[e] + BOFF[e] + p.lrank[a];
            p.list[slot] = r; p.sdst[slot] = (r - p.r0) * SLOTS_PER_TOK + i % TOPK; p.sgate[slot] = p.gatev[a]; }
        for (int i = tid; i < p.rpb; i += NT) { const int r = rlo + i, slot = BASE[NE] + (r - p.r0); p.list[slot] = r; p.sdst[slot] = (r - p.r0) * SLOTS_PER_TOK + TOPK; p.sgate[slot] = 1.f; }
    }
    for (int e = bid; e < NE; e += nblk) { const int lo = BASE[e] + CNT[e], hi = BASE[e + 1]; for (int s = lo + tid; s < hi; s += NT) { p.list[s] = p.r0; p.sdst[s] = -1; p.sgate[s] = 0.f; } }
}
struct GroupOrder { int tpn, total, nN, G, c;
    __device__ void init(const int* tilepre, int nN_, int G_, int c_) { const int lane = threadIdx.x & 63;
        tpn = (int)__hip_atomic_load((const unsigned*)tilepre + lane + 1, __ATOMIC_RELAXED, __HIP_MEMORY_SCOPE_AGENT);
        total = (int)__hip_atomic_load((const unsigned*)tilepre + NEX, __ATOMIC_RELAXED, __HIP_MEMORY_SCOPE_AGENT); nN = nN_; G = G_; c = c_; }
    __device__ bool next(int i, Unit& u) const { const long L = (long)i * G + c; if (L >= (long)total * nN) return false;
        const int T = (int)(L / nN); const int e = __popcll(__ballot(tpn <= T));
        u.pm = T; u.pn = (int)(L % nN); u.e = __builtin_amdgcn_readfirstlane(e); return true; } };
struct EpiGU { bf16_t* act;
    __device__ __forceinline__ bool operator()(f32x4 (&acc)[2][2][4][2], const Unit& u, int wr, int wc, int fr, int fq) const {
        MK_FRAG_LOOP(r, c) { const f32x4 a = acc[ai][bj][m][0], b = acc[ai][bj][m][1];
            u32x2 w; w.x = cvt_pk_bf16(fast_silu(a[0]) * a[1], fast_silu(a[2]) * a[3]); w.y = cvt_pk_bf16(fast_silu(b[0]) * b[1], fast_silu(b[2]) * b[3]);
            *(u32x2*)(act + (size_t)(u.pm * BM + r) * EF + ((u.pn * BM + c) >> 1)) = w; }
        return false; } };
struct EpiDown { const int* sdst; const float* sgate; bf16_t* rowsb;
    __device__ __forceinline__ bool operator()(f32x4 (&acc)[2][2][4][2], const Unit& u, int wr, int wc, int fr, int fq) const {
        int dst[8]; float gt[8];
#pragma unroll
        for (int q = 0; q < 8; ++q) { const int slot = u.pm * BM + (q >> 2) * HALF + wr * 64 + (q & 3) * 16 + fr; dst[q] = sdst[slot]; gt[q] = sgate[slot]; }
#pragma unroll
        for (int ai = 0; ai < 2; ++ai)
#pragma unroll
            for (int m = 0; m < 4; ++m) { const int q = ai * 4 + m; if (dst[q] >= 0) {
#pragma unroll
                for (int bj = 0; bj < 2; ++bj) { f32x4 a = acc[ai][bj][m][0], b = acc[ai][bj][m][1];
#pragma unroll
                    for (int j = 0; j < 4; ++j) { a[j] *= gt[q]; b[j] *= gt[q]; }
                    *(u32x4*)(rowsb + (size_t)dst[q] * D + u.pn * BM + bj * HALF + wc * 32 + 8 * fq) = pack8(a, b); } } }
        return false; } };
__device__ __forceinline__ void final_rows(LAS float* sm  , const In& in, const float* modpart, const bf16_t* rowsb, float* h1out, int b0, int r0, int row_lo, int row_hi, bool dry = false) {
    const int tid = threadIdx.x, lane = tid & 63, wid = tid >> 6;
    const int mr = b0 + row_lo / SEQ;
    __syncthreads();
    for (int j = tid; j < D; j += NT) sm[j] = mod_value(in, modpart, mr, 5 * D + j);
    __syncthreads();
    float gq[16];
#pragma unroll
    for (int j = 0; j < 4; ++j)
#pragma unroll
        for (int q = 0; q < 4; ++q) gq[4 * j + q] = sm[j * 256 + lane * 4 + q] * in.norm_g[3 * D + j * 256 + lane * 4 + q];
    for (int r = row_lo + wid; r < row_hi; r += NT / 64) {
        float v[16];
#pragma unroll
        for (int j = 0; j < 16; ++j) v[j] = 0.f;
        const bf16_t* rb = rowsb + (size_t)(r - r0) * SLOTS_PER_TOK * D;
#pragma unroll
        for (int s = 0; s < SLOTS_PER_TOK; ++s)
#pragma unroll
            for (int j = 0; j < 4; ++j) { const u32x2 w = *(const u32x2*)(rb + (size_t)s * D + j * 256 + lane * 4); v[4 * j] += bflo(w.x); v[4 * j + 1] += bfhi(w.x); v[4 * j + 2] += bflo(w.y); v[4 * j + 3] += bfhi(w.y); }
        float ss = 0.f;
#pragma unroll
        for (int j = 0; j < 16; ++j) ss += v[j] * v[j];
#pragma unroll
        for (int o = 32; o > 0; o >>= 1) ss += __shfl_xor(ss, o);
        const float rinv = 1.f / sqrtf(ss * (1.f / D) + NORM_EPS);
        float* hp = h1out + (size_t)r * D;
#pragma unroll
        for (int j = 0; j < 4; ++j) { const int c = j * 256 + lane * 4; f32x4 hv = *(const f32x4*)(hp + c);
#pragma unroll
            for (int q = 0; q < 4; ++q) hv[q] += gq[4 * j + q] * (v[4 * j + q] * rinv);
            if (!dry) *(f32x4*)(hp + c) = hv; else if (hv[0] == 1.2345e30f) *(f32x4*)(hp + c) = hv; }
    }
}
__device__ __forceinline__ void rwt_prep(const In& in, bf16_t* rwt, int bid, int nblk) {
    for (int i = bid * NT + threadIdx.x; i < NE * D; i += nblk * NT) { const int e = i / D, k = i % D; const float w = in.router_w[(size_t)k * NE + e]; const bf16_t h = f2bf(w); rwt[i] = h; rwt[(size_t)NE * D + i] = f2bf(w - bf2f(h)); }
}
}

using namespace mk;
constexpr size_t MiB = (size_t)1 << 20;
constexpr int NLAT = NB * SEQ, NCTXR = NB * CTX, NALL = NLAT + NCTXR, NRH = NLAT / 2, MAXSLOTS = NRH * SLOTS_PER_TOK + NE * BM;
constexpr size_t O_W1A = 0, O_W1C = O_W1A + (size_t)Z1_N * D * 2, O_WG = O_W1C + (size_t)ZC_N * D * 2, O_WBR = O_WG + (size_t)RW * AG_K * 2, O_WOUT = O_WBR + (size_t)2 * D * RW * 2,
                 O_RWT = O_WOUT + (size_t)D * D * 2, O_MODP = O_RWT + (size_t)2 * NE * D * 2, O_S_END = O_MODP + (size_t)MOD_SL * (NB + 1) * 6 * D * 4;
static_assert(O_S_END <= 27 * MiB, "S region");
constexpr size_t O_BAR = 27 * MiB;
constexpr size_t O_Z1 = 28 * MiB, O_R2 = O_Z1 + (size_t)NALL * Z1_N * 2;
static_assert(O_R2 == 334 * MiB, "z1 size");
constexpr size_t O_HD = O_R2, O_BON = O_HD + (size_t)2 * NLAT * LW * 2, O_AG = O_BON + (size_t)2 * NLAT * NH * 4, O_R2_END = O_AG + (size_t)NLAT * AG_K * 2;
static_assert(O_R2_END <= 512 * MiB, "R2");
constexpr size_t O_XNL = O_Z1, O_YB = O_XNL + (size_t)NLAT * D * 2, O_GATES = O_YB + (size_t)NLAT * LW * 2, O_MIXED = O_HD;
static_assert(O_GATES + (size_t)NLAT * 2 * D * 2 <= O_R2, "late R1");
constexpr size_t O_U = O_Z1, O_WGU = O_U + (size_t)NLAT * D * 2, O_WDN = O_WGU + (size_t)NEX * 2 * EF * D * 2, O_ROUT = O_WDN + (size_t)NEX * D * EF * 2;
constexpr size_t O_TOPE = O_ROUT, O_LRANK = O_TOPE + (size_t)NLAT * TOPK * 4, O_GATEV = O_LRANK + (size_t)NLAT * TOPK * 4, O_BLKCNT = O_GATEV + (size_t)NLAT * TOPK * 4, O_TILEPRE = O_BLKCNT + 256 * 64 * 4,
                 O_LIST = O_TILEPRE + 1024, O_SDST = O_LIST + (size_t)MAXSLOTS * 4, O_SGATE = O_SDST + (size_t)MAXSLOTS * 4, O_ACT = ((O_SGATE + (size_t)MAXSLOTS * 4 + 255) / 256) * 256,
                 O_ROWSB = ((O_ACT + (size_t)MAXSLOTS * EF * 2 + 255) / 256) * 256, O_END = O_ROWSB + (size_t)NRH * SLOTS_PER_TOK * D * 2;
static_assert(O_END <= 512 * MiB, "workspace");
static_assert(O_WGU >= O_YB && O_ROWSB >= O_GATES, "late layout");

struct MP { In in; float* out; unsigned char* ws; long ph_lo, ph_hi; };
constexpr int NPHASE = 17;

#if defined(__HIP_DEVICE_COMPILE__)
#define MK_KARGS auto Pq_ = Pk_; asm volatile("" : "+s"(Pq_)); const MP* Pg_ = (const MP*)Pq_; const In in = Pg_->in; unsigned char* ws = Pg_->ws; float* out_ = Pg_->out; (void)out_;
#else
#define MK_KARGS const In in = P.in; unsigned char* ws = P.ws; float* out_ = P.out; (void)out_; (void)Pk_;
#endif
#define MK_PHASE_PTRS \
    MK_KARGS \
    bf16_t *W1a = (bf16_t*)(ws + O_W1A), *W1c = (bf16_t*)(ws + O_W1C), *Wg = (bf16_t*)(ws + O_WG), *Wbr = (bf16_t*)(ws + O_WBR), *Wout = (bf16_t*)(ws + O_WOUT), *rwt = (bf16_t*)(ws + O_RWT); \
    float* modpart = (float*)(ws + O_MODP); \
    bf16_t *z1 = (bf16_t*)(ws + O_Z1), *Hd = (bf16_t*)(ws + O_HD), *Ag = (bf16_t*)(ws + O_AG); float* bon = (float*)(ws + O_BON); \
    bf16_t *xnl = (bf16_t*)(ws + O_XNL), *yb = (bf16_t*)(ws + O_YB), *gates = (bf16_t*)(ws + O_GATES), *mixed = (bf16_t*)(ws + O_MIXED); \
    bf16_t *u = (bf16_t*)(ws + O_U), *Wgu = (bf16_t*)(ws + O_WGU), *Wdn = (bf16_t*)(ws + O_WDN), *act = (bf16_t*)(ws + O_ACT), *rowsb = (bf16_t*)(ws + O_ROWSB); \
    int *tope = (int*)(ws + O_TOPE), *lrank = (int*)(ws + O_LRANK), *blkcnt = (int*)(ws + O_BLKCNT), *tilepre = (int*)(ws + O_TILEPRE), *list = (int*)(ws + O_LIST), *sdst = (int*)(ws + O_SDST); \
    float *gatev = (float*)(ws + O_GATEV), *sgate = (float*)(ws + O_SGATE); \
    bf16_t* xn_all = (bf16_t*)out_; \
    bf16_t* Y = (bf16_t*)out_; \
    float* y2h1 = out_;
__global__ void __launch_bounds__(512, 2) mega(MP P) {
    extern __shared__ __attribute__((aligned(16))) unsigned char shm[];
    LAS unsigned char* lds = (LAS unsigned char*)shm;
    typedef const __attribute__((address_space(4))) MP* KargP;
    const KargP Pk_ = (KargP)__builtin_amdgcn_kernarg_segment_ptr();
    const int bid = blockIdx.x, nblk = gridDim.x;
    const int ph_lo = (int)P.ph_lo, ph_hi = (int)P.ph_hi;
    volatile LAS unsigned* xst = (volatile LAS unsigned*)(lds + LDS_BYTES - 16);
    if (threadIdx.x == 0) { xst[0] = 0u; xst[1] = 0u; }
    __syncthreads();
    const XcdBarrier xb = xcd_barrier_post((unsigned*)(P.ws + O_BAR), xst);
    if (0 >= ph_lo && 0 < ph_hi) { if (0 > ph_lo) xcd_barrier(xb); const int ph = 0; (void)ph; MK_PHASE_PTRS
        { LAS float* tile = (LAS float*)lds; int base = 0;
            convT_job(tile, in.w_in, INC, D, W1a, D, Z1_N, CMapZ1{}, bid, nblk, base);
            convT_job(tile, in.w_in, INC, D, W1c, D, ZC_N, CMapZC{}, bid, nblk, base);
            convT_job(tile, in.rw_g_up, RW, GL, Wg, AG_K, RW, CMapId{}, bid, nblk, base);
            convT_job(tile, in.w_branch_a, D, RW, Wbr, RW, D, CMapId{}, bid, nblk, base);
            convT_job(tile, in.w_branch_b, D, LW, Wbr + (size_t)D * RW, LW, D, CMapId{}, bid, nblk, base);
            convT_job(tile, in.w_out, D, D, Wout, D, D, CMapId{}, bid, nblk, base);
            rwt_prep(in, rwt, bid, nblk);
            mod_partials((LAS float*)lds, in, modpart, bid, nblk); }
    }
    if (1 >= ph_lo && 1 < ph_hi) { if (1 > ph_lo) xcd_barrier(xb); const int ph = 1; (void)ph; MK_PHASE_PTRS
        { const int L = NLAT / nblk, Lc = NCTXR / nblk;
            xn_rows((LAS float*)lds, in, modpart, xn_all, 0, NB, bid * L, (bid + 1) * L);
            xn_rows((LAS float*)lds, in, modpart, xn_all, 0, NB, NLAT + bid * Lc, NLAT + (bid + 1) * Lc); }
    }
    if (2 >= ph_lo && 2 < ph_hi) { if (2 > ph_lo) xcd_barrier(xb); const int ph = 2; (void)ph; MK_PHASE_PTRS
        { GemmP g{xn_all, xn_all, W1a, 0, nullptr, D, 0}; StaticOrder S; S.init(NALL, Z1_N, nblk, bid); gemm_phase(lds, g, S, EpiStoreBf16{z1, Z1_N}); }
    }
    if (3 >= ph_lo && 3 < ph_hi) { if (3 > ph_lo) xcd_barrier(xb); const int ph = 3; (void)ph; MK_PHASE_PTRS
        { LruP lp{z1, Hd, 0, NB}; lru_phase(lds, in, lp, bid, nblk); __syncthreads();
                  RwkvP rp{z1, Y, bon, 0, NB}; rwkv_phase2(lds, in, rp, bid, nblk); }
    }
    if (4 >= ph_lo && 4 < ph_hi) { if (4 > ph_lo) xcd_barrier(xb); const int ph = 4; (void)ph; MK_PHASE_PTRS
        { const int L = NLAT / nblk; PostP pp{z1, Y, bon, Ag, NLAT, 0}; rwkv_post_rows(in, pp, bid * L, (bid + 1) * L); }
    }
    if (5 >= ph_lo && 5 < ph_hi) { if (5 > ph_lo) xcd_barrier(xb); const int ph = 5; (void)ph; MK_PHASE_PTRS
        { const int L = NLAT / nblk; xn_rows((LAS float*)lds, in, modpart, xnl, 0, NB, bid * L, (bid + 1) * L); __syncthreads();
                  GemmP g{Ag, Ag, Wg, 0, nullptr, AG_K, 0}; StaticOrder S; S.init(NLAT, RW, nblk, bid); gemm_phase(lds, g, S, EpiYa{Y, Y + (size_t)NLAT * RW}); }
    }
    if (6 >= ph_lo && 6 < ph_hi) { if (6 > ph_lo) xcd_barrier(xb); const int ph = 6; (void)ph; MK_PHASE_PTRS
        { GemmP g{xnl, xnl, W1c, 0, nullptr, D, 0}; StaticOrder S; S.init(NLAT, ZC_N, nblk, bid); gemm_phase(lds, g, S, EpiZc{Hd, yb, gates, NLAT, 0}); }
    }
    if (7 >= ph_lo && 7 < ph_hi) { if (7 > ph_lo) xcd_barrier(xb); const int ph = 7; (void)ph; MK_PHASE_PTRS
        { GemmP g{Y + (size_t)NLAT * RW, yb, Wbr, (long)D * RW, nullptr, D, 0}; PairOrder S; S.S.init(NLAT, D, nblk, bid); gemm_phase(lds, g, S, EpiBranch{gates, mixed}); }
    }
    if (8 >= ph_lo && 8 < ph_hi) { if (8 > ph_lo) xcd_barrier(xb); const int ph = 8; (void)ph; MK_PHASE_PTRS
        { LAS float* tile = (LAS float*)lds; int base = 0;
            for (int e = 0; e < NE; ++e) {
                convT_job(tile, in.ex_w_gu + (size_t)e * D * 2 * EF, 2 * EF, D, Wgu + (size_t)e * 2 * EF * D, D, 2 * EF, CMapGU{EF}, bid, nblk, base);
                convT_job(tile, in.ex_w_down + (size_t)e * EF * D, D, EF, Wdn + (size_t)e * D * EF, EF, D, CMapId{}, bid, nblk, base); }
            convT_job(tile, in.sh_w_gu, 2 * SF, D, Wgu + (size_t)NE * 2 * EF * D, D, 2 * SF, CMapGU{SF}, bid, nblk, base);
            convT_job(tile, in.sh_w_down, D, SF, Wdn + (size_t)NE * D * EF, SF, D, CMapId{}, bid, nblk, base);
            __syncthreads();
            GemmP g{mixed, mixed, Wout, 0, nullptr, D, 0}; StaticOrder S; S.init(NLAT, D, nblk, bid); gemm_phase(lds, g, S, EpiF32{y2h1, D}); }
    }
    if (9 >= ph_lo && 9 < ph_hi) { if (9 > ph_lo) xcd_barrier(xb); const int ph = 9; (void)ph; MK_PHASE_PTRS
        { const int L = NLAT / nblk; RowP rp{y2h1, u, modpart, rwt, tope, gatev, lrank, blkcnt, 0, NLAT}; row_pass(lds, in, rp, bid * L, (bid + 1) * L); }
    }
    if (10 >= ph_lo && 10 < ph_hi) { if (10 > ph_lo) xcd_barrier(xb); const int ph = 10; (void)ph; MK_PHASE_PTRS
        { const int q = ph - 10, half = q >= 4 ? 1 : 0, st = q - 4 * half;
            const int rpb = NLAT / nblk;
            auto assign = [&](int hf) { MoeP mp{tope, gatev, lrank, blkcnt, tilepre, list, sdst, sgate, hf * NRH, NRH, hf * (nblk / 2), nblk / 2, rpb, 0}; moe_assign(lds, mp, bid, nblk); };
            auto fin = [&](int hf) { const int L = NRH / nblk, r0 = hf * NRH; final_rows((LAS float*)lds, in, modpart, rowsb, y2h1, 0, r0, r0 + bid * L, r0 + (bid + 1) * L); };
            if (ph == 10) assign(0);
            else if (ph == 11 || ph == 14) { GemmP g{u, u, Wgu, (long)2 * EF * D, list, D, 0}; GroupOrder S; S.init(tilepre, 2 * EF / BM, nblk, bid); gemm_phase<true>(lds, g, S, EpiGU{act}); }
            else if (ph == 12 || ph == 15) { GemmP g{act, act, Wdn, (long)D * EF, nullptr, EF, 0}; GroupOrder S; S.init(tilepre, D / BM, nblk, bid); gemm_phase(lds, g, S, EpiDown{sdst, sgate, rowsb}); }
            else if (ph == 13) { fin(0); __syncthreads(); assign(1); }
            else if (ph == 16) fin(1);
            (void)half; (void)st; }
    }
    if (11 >= ph_lo && 11 < ph_hi) { if (11 > ph_lo) xcd_barrier(xb); const int ph = 11; (void)ph; MK_PHASE_PTRS
        { const int q = ph - 10, half = q >= 4 ? 1 : 0, st = q - 4 * half;
            const int rpb = NLAT / nblk;
            auto assign = [&](int hf) { MoeP mp{tope, gatev, lrank, blkcnt, tilepre, list, sdst, sgate, hf * NRH, NRH, hf * (nblk / 2), nblk / 2, rpb, 0}; moe_assign(lds, mp, bid, nblk); };
            auto fin = [&](int hf) { const int L = NRH / nblk, r0 = hf * NRH; final_rows((LAS float*)lds, in, modpart, rowsb, y2h1, 0, r0, r0 + bid * L, r0 + (bid + 1) * L); };
            if (ph == 10) assign(0);
            else if (ph == 11 || ph == 14) { GemmP g{u, u, Wgu, (long)2 * EF * D, list, D, 0}; GroupOrder S; S.init(tilepre, 2 * EF / BM, nblk, bid); gemm_phase<true>(lds, g, S, EpiGU{act}); }
            else if (ph == 12 || ph == 15) { GemmP g{act, act, Wdn, (long)D * EF, nullptr, EF, 0}; GroupOrder S; S.init(tilepre, D / BM, nblk, bid); gemm_phase(lds, g, S, EpiDown{sdst, sgate, rowsb}); }
            else if (ph == 13) { fin(0); __syncthreads(); assign(1); }
            else if (ph == 16) fin(1);
            (void)half; (void)st; }
    }
    if (12 >= ph_lo && 12 < ph_hi) { if (12 > ph_lo) xcd_barrier(xb); const int ph = 12; (void)ph; MK_PHASE_PTRS
        { const int q = ph - 10, half = q >= 4 ? 1 : 0, st = q - 4 * half;
            const int rpb = NLAT / nblk;
            auto assign = [&](int hf) { MoeP mp{tope, gatev, lrank, blkcnt, tilepre, list, sdst, sgate, hf * NRH, NRH, hf * (nblk / 2), nblk / 2, rpb, 0}; moe_assign(lds, mp, bid, nblk); };
            auto fin = [&](int hf) { const int L = NRH / nblk, r0 = hf * NRH; final_rows((LAS float*)lds, in, modpart, rowsb, y2h1, 0, r0, r0 + bid * L, r0 + (bid + 1) * L); };
            if (ph == 10) assign(0);
            else if (ph == 11 || ph == 14) { GemmP g{u, u, Wgu, (long)2 * EF * D, list, D, 0}; GroupOrder S; S.init(tilepre, 2 * EF / BM, nblk, bid); gemm_phase<true>(lds, g, S, EpiGU{act}); }
            else if (ph == 12 || ph == 15) { GemmP g{act, act, Wdn, (long)D * EF, nullptr, EF, 0}; GroupOrder S; S.init(tilepre, D / BM, nblk, bid); gemm_phase(lds, g, S, EpiDown{sdst, sgate, rowsb}); }
            else if (ph == 13) { fin(0); __syncthreads(); assign(1); }
            else if (ph == 16) fin(1);
            (void)half; (void)st; }
    }
    if (13 >= ph_lo && 13 < ph_hi) { if (13 > ph_lo) xcd_barrier(xb); const int ph = 13; (void)ph; MK_PHASE_PTRS
        { const int q = ph - 10, half = q >= 4 ? 1 : 0, st = q - 4 * half;
            const int rpb = NLAT / nblk;
            auto assign = [&](int hf) { MoeP mp{tope, gatev, lrank, blkcnt, tilepre, list, sdst, sgate, hf * NRH, NRH, hf * (nblk / 2), nblk / 2, rpb, 0}; moe_assign(lds, mp, bid, nblk); };
            auto fin = [&](int hf) { const int L = NRH / nblk, r0 = hf * NRH; final_rows((LAS float*)lds, in, modpart, rowsb, y2h1, 0, r0, r0 + bid * L, r0 + (bid + 1) * L); };
            if (ph == 10) assign(0);
            else if (ph == 11 || ph == 14) { GemmP g{u, u, Wgu, (long)2 * EF * D, list, D, 0}; GroupOrder S; S.init(tilepre, 2 * EF / BM, nblk, bid); gemm_phase<true>(lds, g, S, EpiGU{act}); }
            else if (ph == 12 || ph == 15) { GemmP g{act, act, Wdn, (long)D * EF, nullptr, EF, 0}; GroupOrder S; S.init(tilepre, D / BM, nblk, bid); gemm_phase(lds, g, S, EpiDown{sdst, sgate, rowsb}); }
            else if (ph == 13) { fin(0); __syncthreads(); assign(1); }
            else if (ph == 16) fin(1);
            (void)half; (void)st; }
    }
    if (14 >= ph_lo && 14 < ph_hi) { if (14 > ph_lo) xcd_barrier(xb); const int ph = 14; (void)ph; MK_PHASE_PTRS
        { const int q = ph - 10, half = q >= 4 ? 1 : 0, st = q - 4 * half;
            const int rpb = NLAT / nblk;
            auto assign = [&](int hf) { MoeP mp{tope, gatev, lrank, blkcnt, tilepre, list, sdst, sgate, hf * NRH, NRH, hf * (nblk / 2), nblk / 2, rpb, 0}; moe_assign(lds, mp, bid, nblk); };
            auto fin = [&](int hf) { const int L = NRH / nblk, r0 = hf * NRH; final_rows((LAS float*)lds, in, modpart, rowsb, y2h1, 0, r0, r0 + bid * L, r0 + (bid + 1) * L); };
            if (ph == 10) assign(0);
            else if (ph == 11 || ph == 14) { GemmP g{u, u, Wgu, (long)2 * EF * D, list, D, 0}; GroupOrder S; S.init(tilepre, 2 * EF / BM, nblk, bid); gemm_phase<true>(lds, g, S, EpiGU{act}); }
            else if (ph == 12 || ph == 15) { GemmP g{act, act, Wdn, (long)D * EF, nullptr, EF, 0}; GroupOrder S; S.init(tilepre, D / BM, nblk, bid); gemm_phase(lds, g, S, EpiDown{sdst, sgate, rowsb}); }
            else if (ph == 13) { fin(0); __syncthreads(); assign(1); }
            else if (ph == 16) fin(1);
            (void)half; (void)st; }
    }
    if (15 >= ph_lo && 15 < ph_hi) { if (15 > ph_lo) xcd_barrier(xb); const int ph = 15; (void)ph; MK_PHASE_PTRS
        { const int q = ph - 10, half = q >= 4 ? 1 : 0, st = q - 4 * half;
            const int rpb = NLAT / nblk;
            auto assign = [&](int hf) { MoeP mp{tope, gatev, lrank, blkcnt, tilepre, list, sdst, sgate, hf * NRH, NRH, hf * (nblk / 2), nblk / 2, rpb, 0}; moe_assign(lds, mp, bid, nblk); };
            auto fin = [&](int hf) { const int L = NRH / nblk, r0 = hf * NRH; final_rows((LAS float*)lds, in, modpart, rowsb, y2h1, 0, r0, r0 + bid * L, r0 + (bid + 1) * L); };
            if (ph == 10) assign(0);
            else if (ph == 11 || ph == 14) { GemmP g{u, u, Wgu, (long)2 * EF * D, list, D, 0}; GroupOrder S; S.init(tilepre, 2 * EF / BM, nblk, bid); gemm_phase<true>(lds, g, S, EpiGU{act}); }
            else if (ph == 12 || ph == 15) { GemmP g{act, act, Wdn, (long)D * EF, nullptr, EF, 0}; GroupOrder S; S.init(tilepre, D / BM, nblk, bid); gemm_phase(lds, g, S, EpiDown{sdst, sgate, rowsb}); }
            else if (ph == 13) { fin(0); __syncthreads(); assign(1); }
            else if (ph == 16) fin(1);
            (void)half; (void)st; }
    }
    if (16 >= ph_lo && 16 < ph_hi) { if (16 > ph_lo) xcd_barrier(xb); const int ph = 16; (void)ph; MK_PHASE_PTRS
        { const int q = ph - 10, half = q >= 4 ? 1 : 0, st = q - 4 * half;
            const int rpb = NLAT / nblk;
            auto assign = [&](int hf) { MoeP mp{tope, gatev, lrank, blkcnt, tilepre, list, sdst, sgate, hf * NRH, NRH, hf * (nblk / 2), nblk / 2, rpb, 0}; moe_assign(lds, mp, bid, nblk); };
            auto fin = [&](int hf) { const int L = NRH / nblk, r0 = hf * NRH; final_rows((LAS float*)lds, in, modpart, rowsb, y2h1, 0, r0, r0 + bid * L, r0 + (bid + 1) * L); };
            if (ph == 10) assign(0);
            else if (ph == 11 || ph == 14) { GemmP g{u, u, Wgu, (long)2 * EF * D, list, D, 0}; GroupOrder S; S.init(tilepre, 2 * EF / BM, nblk, bid); gemm_phase<true>(lds, g, S, EpiGU{act}); }
            else if (ph == 12 || ph == 15) { GemmP g{act, act, Wdn, (long)D * EF, nullptr, EF, 0}; GroupOrder S; S.init(tilepre, D / BM, nblk, bid); gemm_phase(lds, g, S, EpiDown{sdst, sgate, rowsb}); }
            else if (ph == 13) { fin(0); __syncthreads(); assign(1); }
            else if (ph == 16) fin(1);
            (void)half; (void)st; }
    }
}
extern "C" void kernel_launch(void* const* d_in, const int* in_sizes, int n_in, void* d_out, int out_size, void* d_ws, size_t ws_size, hipStream_t stream) {
    static int grid = 0;
    if (grid == 0) {
        int dev = 0, cus = 0; hipGetDevice(&dev); hipDeviceGetAttribute(&cus, hipDeviceAttributeMultiprocessorCount, dev);
        hipFuncSetAttribute((const void*)mega, hipFuncAttributeMaxDynamicSharedMemorySize, LDS_BYTES);
        grid = cus;
        if (ws_size < O_END || grid != 256) fprintf(stderr, "kernel_launch: unexpected ws_size %zu (need %zu) or CU count %d\n", ws_size, (size_t)O_END, grid);
    }
    hipMemsetAsync((char*)d_ws + O_BAR, 0, XCD_BAR_WORDS * 4, stream);
    MP P; memset(&P, 0, sizeof(P));
    const float** f = (const float**)&P.in; for (int i = 0; i < 32; ++i) f[i] = (const float*)d_in[i];
    P.out = (float*)d_out; P.ws = (unsigned char*)d_ws;
#ifdef MK_PER_PHASE
    for (int ph = 0; ph < NPHASE; ++ph) { P.ph_lo = ph; P.ph_hi = ph + 1; hipLaunchKernelGGL(mega, dim3(grid), dim3(NT), LDS_BYTES, stream, P); }
#else
    P.ph_lo = 0; P.ph_hi = NPHASE;
    void* args[] = {&P};
    hipError_t e = hipLaunchCooperativeKernel((void*)mega, dim3(grid), dim3(NT), args, LDS_BYTES, stream);
    if (e != hipSuccess) fprintf(stderr, "cooperative launch failed: %s (grid %d)\n", hipGetErrorString(e), grid);
#endif
}
```

```cpp
#include <hip/hip_runtime.h>
#include <cstdio>
#include <cstring>
#define HD __host__ __device__ __forceinline__
static hipStream_t g_stream;

#ifdef SMALL
constexpr int D = 128, NB = 2, SEQ = 64, GW = 8, CTX = 16, RW = 128, RH = 64, DL = 16, AL = 16, GL = 24, LW = 128, LB = 2, NE = 8, TOPK = 3, NG = 4, TG = 2, EF = 32, SF = 32;
#else
constexpr int D = 1024, NB = 8, SEQ = 4096, GW = 64, CTX = 256, RW = 1024, RH = 64, DL = 64, AL = 64, GL = 160, LW = 1024, LB = 16, NE = 64, TOPK = 6, NG = 8, TG = 4, EF = 256, SF = 256;
#endif
constexpr int NH = RW / RH, LBS = LW / LB, ROWS = SEQ / GW, TA = CTX + SEQ;
constexpr int OFF_R = 0, OFF_K = RW, OFF_V = 2 * RW, OFF_WD = 3 * RW, OFF_AD = OFF_WD + 2 * DL, OFF_GD = OFF_AD + 2 * AL, RC = OFF_GD + GL;
constexpr int OFF_LX = RC, OFF_LG = OFF_LX + LW, OFF_GATE = OFF_LG + LW, INC = OFF_GATE + 2 * D;
constexpr int EPG = NE / NG, NASG = SEQ * TOPK;
#define NORM_EPS 1e-6f
#define LNX_EPS 64e-5f

HD float sigmoidf_(float x) { return 1.f / (1.f + expf(-x)); }
HD float softplusf_(float x) { return x > 20.f ? x : log1pf(expf(x)); }
HD float siluf_(float x) { return x * sigmoidf_(x); }
HD float gelu_tanhf_(float x) { return 0.5f * x * (1.f + tanhf(0.7978845608028654f * (x + 0.044715f * x * x * x))); }

struct In {
    const float *x, *c, *ctx, *c_ctx, *w_mod, *b_mod, *norm_g, *w_in, *shift_mu, *rw_w0, *rw_w_up, *rw_a0, *rw_a_up, *rw_g_up, *rw_k_k, *rw_k_a, *rw_r_k, *rw_lnx,
        *lru_conv_w, *lru_conv_b, *lru_gate_w, *lru_gate_b, *lru_l, *w_branch_a, *w_branch_b, *w_out, *router_w, *router_b, *ex_w_gu, *ex_w_down, *sh_w_gu, *sh_w_down;
};


namespace mk {
#define LAS __attribute__((address_space(3)))
typedef unsigned short bf16_t;
typedef short bf16x8 __attribute__((ext_vector_type(8)));
typedef float f32x4 __attribute__((ext_vector_type(4)));
typedef float f32x2 __attribute__((ext_vector_type(2)));
typedef unsigned u32x4 __attribute__((ext_vector_type(4)));
typedef unsigned u32x2 __attribute__((ext_vector_type(2)));
constexpr int NT = 512;
constexpr int BM = 256, BK = 64, HALF = 128, HTB = HALF * BK * 2, STAGE_BYTES = 8 * HTB;
constexpr int LDS_BYTES = 160 * 1024 - 1024;

constexpr int Z1_LX = 3584, Z1_N = 4608;
constexpr int ZC_N = 3072;

__device__ __forceinline__ unsigned cvt_pk_bf16(float lo, float hi) { unsigned r; asm volatile("v_cvt_pk_bf16_f32 %0, %1, %2" : "=v"(r) : "v"(lo), "v"(hi)); return r; }
__device__ __forceinline__ bf16_t f2bf(float f) { unsigned u = __float_as_uint(f); u += 0x7FFFu + ((u >> 16) & 1u); return (bf16_t)(u >> 16); }
__device__ __forceinline__ float bf2f(bf16_t b) { return __uint_as_float(((unsigned)b) << 16); }
__device__ __forceinline__ float bflo(unsigned w) { return __uint_as_float(w << 16); }
__device__ __forceinline__ float bfhi(unsigned w) { return __uint_as_float(w & 0xffff0000u); }

__device__ __forceinline__ float fast_rcp(float x) { return __builtin_amdgcn_rcpf(x); }
__device__ __forceinline__ float fast_sigmoid(float x) { return fast_rcp(1.f + __expf(-x)); }
__device__ __forceinline__ float fast_tanh(float x) { return 1.f - 2.f * fast_rcp(1.f + __expf(2.f * x)); }
__device__ __forceinline__ float fast_softplus(float x) { return x > 15.f ? x : __logf(1.f + __expf(x)); }
__device__ __forceinline__ float fast_silu(float x) { return x * fast_sigmoid(x); }
__device__ __forceinline__ float fast_gelu_tanh(float x) { return x * fast_sigmoid(1.5957691216057308f * (x + 0.044715f * x * x * x)); }
__device__ __forceinline__ int lds_byte(int r, int c) { const int st = (r >> 4) * 2 + (c >> 5), rr = r & 15, cc = c & 31, ob = rr * 64 + cc * 2; return st * 1024 + (ob ^ (((ob >> 9) & 1) << 5)); }
__device__ __forceinline__ void stage_rc(int b, int& R, int& C) { const int st = b / 1024, sb = b % 1024, swz = sb ^ (((sb >> 9) & 1) << 5); R = (st >> 1) * 16 + swz / 64; C = (st & 1) * 32 + (swz % 64) / 2; }
__device__ __forceinline__ int perm32(int rho) { const int n = rho >> 4, i = rho & 15; return 8 * (i >> 2) + 4 * n + (i & 3); }

struct Unit { int pm, pn, e; };
struct GemmP { const bf16_t* A0; const bf16_t* A1; const bf16_t* Bt; long strideB; const int* gather; int K; int pad_; };

struct StaticOrder {
    int nM, nN, nwg, G, c;
    __device__ void init(int M, int N, int G_, int c_) { nM = M / BM; nN = N / BM; nwg = nM * nN; G = G_; c = c_; }
    __device__ bool next(int i, Unit& u) const {
        const long L = (long)i * G + c; if (L >= nwg) return false;
        int wgid = (int)L; { const int q = nwg / 8, r = nwg % 8, xcd = wgid % 8, off = wgid / 8; wgid = (xcd < r ? xcd * (q + 1) : r * (q + 1) + (xcd - r) * q) + off; }
        const int nig = 8 * nN, gid = wgid / nig, fm = gid * 8, gsz = (nM - fm) < 8 ? (nM - fm) : 8;
        u.pm = fm + ((wgid % nig) % gsz); u.pn = (wgid % nig) / gsz; u.e = 0; return true;
    }
};

#define MK_FRAG_LOOP(ROW, COL) \
    _Pragma("unroll") for (int ai = 0; ai < 2; ++ai) _Pragma("unroll") for (int m = 0; m < 4; ++m) _Pragma("unroll") for (int bj = 0; bj < 2; ++bj) \
        if (const int ROW = ai * HALF + wr * 64 + m * 16 + fr; true) if (const int COL = bj * HALF + wc * 32 + 8 * fq; true)

template <bool GATHER = false, class Epi, class Sched>
__device__ __forceinline__ void gemm_phase(LAS unsigned char* lds, const GemmP g, const Sched& S, const Epi& E) {
    const int tid = threadIdx.x, wid = __builtin_amdgcn_readfirstlane(tid >> 6), lane = tid & 63, wr = wid >> 2, wc = wid & 3, fr = lane & 15, fq = lane >> 4;
    int K = g.K; asm volatile("" : "+s"(K));
    const int nt = K / BK;
    int RA[2], CA[2]; unsigned voffB[2];
#pragma unroll
    for (int i = 0; i < 2; ++i) { int R, C; stage_rc(tid * 16 + i * 8192, R, C); RA[i] = R; CA[i] = C; const int Rb = (R & ~31) + perm32(R & 31); voffB[i] = (unsigned)(Rb * K + C) * 2u; }
    const size_t kstep = (size_t)(BK * 2), hstepB = (size_t)HALF * K * 2, tstepB = 2 * hstepB;
    const unsigned ldsw = (unsigned)wid * 1024u;
    const int aoff = lds_byte(wr * 64 + fr, fq * 8), boff = lds_byte(wc * 32 + fr, fq * 8);
#define MK_SA(b, h) (((b) * 2 + (h)) * HTB)
#define MK_SB(b, h) ((4 + (b) * 2 + (h)) * HTB)
#define MK_STAGE(bufoff, gbase, voff) do { _Pragma("unroll") for (int _i = 0; _i < 2; ++_i) \
        __builtin_amdgcn_global_load_lds((const unsigned*)((const char*)(gbase) + (voff)[_i]), (LAS unsigned*)(lds + (bufoff) + ldsw + _i * 8192), 16, 0, 0); } while (0)
#define MK_LDA(dst, b, h) do { _Pragma("unroll") for (int m = 0; m < 4; ++m) _Pragma("unroll") for (int k = 0; k < 2; ++k) dst[m][k] = *(const LAS bf16x8*)(lds + MK_SA(b, h) + aoff + m * 2048 + k * 1024); } while (0)
#define MK_LDB(dst, b, h) do { _Pragma("unroll") for (int n = 0; n < 2; ++n) _Pragma("unroll") for (int k = 0; k < 2; ++k) dst[n][k] = *(const LAS bf16x8*)(lds + MK_SB(b, h) + boff + n * 2048 + k * 1024); } while (0)
#define MK_MMA(ai, bj, At, Bt) do { __builtin_amdgcn_s_setprio(1); _Pragma("unroll") for (int m = 0; m < 4; ++m) _Pragma("unroll") for (int n = 0; n < 2; ++n) _Pragma("unroll") for (int k = 0; k < 2; ++k) \
        acc[ai][bj][m][n] = __builtin_amdgcn_mfma_f32_16x16x32_bf16(Bt[n][k], At[m][k], acc[ai][bj][m][n], 0, 0, 0); __builtin_amdgcn_s_setprio(0); } while (0)
#define MK_WAIT_V(n) asm volatile("s_waitcnt vmcnt(" #n ")" ::: "memory")
#define MK_WAIT_L(n) asm volatile("s_waitcnt lgkmcnt(" #n ")" ::: "memory")
#define MK_BAR __builtin_amdgcn_s_barrier()
#define MK_SCHED __builtin_amdgcn_sched_barrier(0)
    Unit cur, nxt; int ui = 0;
    if (!S.next(0, cur)) return;
    f32x4 acc[2][2][4][2];
#pragma unroll
    for (int a = 0; a < 2; ++a)
#pragma unroll
        for (int b = 0; b < 2; ++b)
#pragma unroll
            for (int m = 0; m < 4; ++m)
#pragma unroll
                for (int n = 0; n < 2; ++n) acc[a][b][m][n] = (f32x4){0.f, 0.f, 0.f, 0.f};
    bf16x8 At[4][2], B0[2][2], B1[2][2];
    unsigned vA[2][2], vAn[2][2];
    const size_t hstepA = GATHER ? 0 : (size_t)HALF * K * 2, tstepA = 2 * (size_t)HALF * K * 2;
    auto a_voff = [&](const Unit& u, unsigned (&vo)[2][2]) {
#pragma unroll
        for (int h = 0; h < 2; ++h)
#pragma unroll
            for (int i = 0; i < 2; ++i) { if (GATHER) { const int row = u.pm * BM + h * HALF + RA[i]; vo[h][i] = (unsigned)((size_t)g.gather[row] * K + CA[i]) * 2u; } else vo[h][i] = (unsigned)(RA[i] * K + CA[i]) * 2u; }
    };
    a_voff(cur, vA);
    auto a_base = [&](const Unit& u) { return (const char*)(u.e ? g.A1 : g.A0) + (GATHER ? (size_t)0 : (size_t)u.pm * tstepA); };
    const char* cA = a_base(cur);
    const char* cB = (const char*)g.Bt + ((size_t)cur.e * g.strideB) * 2 + (size_t)cur.pn * tstepB;
    MK_STAGE(MK_SB(0, 0), cB, voffB); MK_STAGE(MK_SA(0, 0), cA, vA[0]); MK_STAGE(MK_SB(0, 1), cB + hstepB, voffB); MK_STAGE(MK_SA(0, 1), cA + hstepA, vA[1]);
    if (wr == 1) MK_BAR;
    MK_WAIT_V(4); MK_BAR;
    MK_STAGE(MK_SB(1, 0), cB + kstep, voffB); MK_STAGE(MK_SA(1, 0), cA + kstep, vA[0]); MK_STAGE(MK_SB(1, 1), cB + hstepB + kstep, voffB);
    MK_WAIT_V(6); MK_BAR;
    for (;;) {
        const bool has_next = S.next(ui + 1, nxt);
        const char* nA = has_next ? a_base(nxt) : cA;
        const char* nB = has_next ? (const char*)g.Bt + ((size_t)nxt.e * g.strideB) * 2 + (size_t)nxt.pn * tstepB : cB;
        for (int t = 0; t < nt; t += 2) {
            const bool last = (t == nt - 2);
            if (GATHER && last) { if (has_next) a_voff(nxt, vAn); else {
#pragma unroll
                for (int h = 0; h < 2; ++h)
#pragma unroll
                    for (int i = 0; i < 2; ++i) vAn[h][i] = vA[h][i]; } }
            const char* a1 = cA + (size_t)(t + 1) * kstep;
            const char* a2 = last ? nA : cA + (size_t)(t + 2) * kstep; const char* b2 = last ? nB : cB + (size_t)(t + 2) * kstep;
            const char* a3 = a2 + kstep; const char* b3 = b2 + kstep;
            unsigned v2[2][2];
#pragma unroll
            for (int h = 0; h < 2; ++h)
#pragma unroll
                for (int i = 0; i < 2; ++i) v2[h][i] = (GATHER && last) ? vAn[h][i] : vA[h][i];
            MK_LDB(B0, 0, 0); MK_SCHED; MK_LDA(At, 0, 0); MK_STAGE(MK_SA(1, 1), a1 + hstepA, vA[1]);
            MK_WAIT_L(8); MK_BAR; MK_WAIT_L(0); MK_MMA(0, 0, At, B0); MK_BAR; MK_SCHED;
            MK_LDB(B1, 0, 1); MK_STAGE(MK_SB(0, 0), b2, voffB);
            MK_BAR; MK_WAIT_L(0); MK_MMA(0, 1, At, B1); MK_BAR;
            MK_LDA(At, 0, 1); MK_STAGE(MK_SA(0, 0), a2, v2[0]);
            MK_BAR; MK_WAIT_L(0); MK_MMA(1, 0, At, B0); MK_BAR; MK_SCHED;
            MK_STAGE(MK_SB(0, 1), b2 + hstepB, voffB);
            MK_WAIT_V(6); MK_BAR; MK_MMA(1, 1, At, B1); MK_BAR;
            MK_LDB(B0, 1, 0); MK_SCHED; MK_LDA(At, 1, 0); MK_STAGE(MK_SA(0, 1), a2 + hstepA, v2[1]);
            MK_WAIT_L(8); MK_BAR; MK_WAIT_L(0); MK_MMA(0, 0, At, B0); MK_BAR; MK_SCHED;
            MK_LDB(B1, 1, 1); MK_STAGE(MK_SB(1, 0), b3, voffB);
            MK_BAR; MK_WAIT_L(0); MK_MMA(0, 1, At, B1); MK_BAR;
            MK_LDA(At, 1, 1); MK_STAGE(MK_SA(1, 0), a3, v2[0]);
            MK_BAR; MK_WAIT_L(0); MK_MMA(1, 0, At, B0); MK_BAR; MK_SCHED;
            MK_STAGE(MK_SB(1, 1), b3 + hstepB, voffB);
            MK_WAIT_V(6); MK_BAR; MK_MMA(1, 1, At, B1); MK_BAR;
        }
        int fr_ = fr, fq_ = fq; asm volatile("" : "+v"(fr_), "+v"(fq_));
        if (wr == 0) MK_BAR;
        const bool keep = E(acc, cur, wr, wc, fr_, fq_);
        if (wr == 1) MK_BAR;
        if (!has_next) break;
        if (!keep) {
#pragma unroll
            for (int a = 0; a < 2; ++a)
#pragma unroll
                for (int b = 0; b < 2; ++b)
#pragma unroll
                    for (int m = 0; m < 4; ++m)
#pragma unroll
                        for (int n = 0; n < 2; ++n) acc[a][b][m][n] = (f32x4){0.f, 0.f, 0.f, 0.f};
        }
        cur = nxt; cA = nA; cB = nB; ++ui;
        if (GATHER) {
#pragma unroll
            for (int h = 0; h < 2; ++h)
#pragma unroll
                for (int i = 0; i < 2; ++i) vA[h][i] = vAn[h][i]; }
    }
    MK_WAIT_V(0);
    if (wr == 0) MK_BAR;
    MK_BAR;
#undef MK_SA
#undef MK_SB
#undef MK_STAGE
#undef MK_LDA
#undef MK_LDB
#undef MK_MMA
#undef MK_WAIT_V
#undef MK_WAIT_L
#undef MK_BAR
#undef MK_SCHED
}

__device__ __forceinline__ u32x4 pack8(const f32x4 a, const f32x4 b) { u32x4 w; w.x = cvt_pk_bf16(a[0], a[1]); w.y = cvt_pk_bf16(a[2], a[3]); w.z = cvt_pk_bf16(b[0], b[1]); w.w = cvt_pk_bf16(b[2], b[3]); return w; }
struct EpiStoreBf16 {
    bf16_t* O; long ldc;
    __device__ __forceinline__ bool operator()(const f32x4 (&acc)[2][2][4][2], const Unit& u, int wr, int wc, int fr, int fq) const {
        MK_FRAG_LOOP(r, c) { *(u32x4*)(O + (size_t)(u.pm * BM + r) * ldc + u.pn * BM + c) = pack8(acc[ai][bj][m][0], acc[ai][bj][m][1]); }
        return false;
    }
};

struct CMapZ1 { __device__ int operator()(int n) const { return n < RC ? n : (n < Z1_LX ? -1 : OFF_LX + (n - Z1_LX)); } };
struct CMapZC { __device__ int operator()(int n) const { return OFF_LG + n; } };
struct CMapId { __device__ int operator()(int n) const { return n; } };
struct CMapGU { int F; __device__ int operator()(int n) const { return (n & 1) * F + (n >> 1); } };
template <class CM>
__device__ __forceinline__ void convT_tile(LAS float* tile  , const float* src, int lds_, int Ks, bf16_t* dst, int Kd, int n0, int k0, const CM& cm) {
    const int tid = threadIdx.x;
    { const int kk = tid >> 3, nn8 = (tid & 7) * 8; const int k = k0 + kk;
#pragma unroll
      for (int j = 0; j < 8; ++j) { const int sc = cm(n0 + nn8 + j); tile[kk * 65 + nn8 + j] = (k < Ks && sc >= 0) ? src[(size_t)k * lds_ + sc] : 0.f; } }
    __syncthreads();
    { const int nn = tid >> 3, kk8 = (tid & 7) * 8; f32x4 a, b;
#pragma unroll
      for (int j = 0; j < 4; ++j) { a[j] = tile[(kk8 + j) * 65 + nn]; b[j] = tile[(kk8 + 4 + j) * 65 + nn]; }
      *(u32x4*)(dst + (size_t)(n0 + nn) * Kd + k0 + kk8) = pack8(a, b); }
    __syncthreads();
}
template <class CM>
__device__ __forceinline__ void convT_job(LAS float* tile, const float* src, int lds_, int Ks, bf16_t* dst, int Kd, int N, const CM& cm, int bid, int nblk, int& base) {
    const int tn = N / 64, tk = Kd / 64, nt = tn * tk;
    int first = (bid - base % nblk + nblk) % nblk;
    for (int t = first; t < nt; t += nblk) convT_tile(tile, src, lds_, Ks, dst, Kd, (t / tk) * 64, (t % tk) * 64, cm);
    base += nt;
}

constexpr int MOD_SL = 16, MOD_KS = D / MOD_SL;
__device__ __forceinline__ void mod_partials(LAS float* sl  , const In& in, float* part  , int bid, int nblk) {
    const int ncc = 6 * D / NT, nitem = MOD_SL * ncc;
    for (int it = bid; it < nitem; it += nblk) {
        const int s = it / ncc, j = (it % ncc) * NT + threadIdx.x;
        for (int i = threadIdx.x; i < (NB + 1) * MOD_KS; i += NT) { const int r = i / MOD_KS, k = s * MOD_KS + i % MOD_KS; const float cv = r < NB ? in.c[r * D + k] : in.c_ctx[k]; sl[i] = siluf_(cv); }
        __syncthreads();
        float acc[NB + 1];
#pragma unroll
        for (int r = 0; r <= NB; ++r) acc[r] = 0.f;
        for (int k = 0; k < MOD_KS; ++k) { const float w = in.w_mod[(size_t)(s * MOD_KS + k) * 6 * D + j];
#pragma unroll
            for (int r = 0; r <= NB; ++r) acc[r] += sl[r * MOD_KS + k] * w; }
#pragma unroll
        for (int r = 0; r <= NB; ++r) part[((size_t)s * (NB + 1) + r) * 6 * D + j] = acc[r];
        __syncthreads();
    }
}
__device__ __forceinline__ float mod_value(const In& in, const float* part, int r, int j) {
    float s = in.b_mod[j];
#pragma unroll
    for (int q = 0; q < MOD_SL; ++q) s += part[((size_t)q * (NB + 1) + r) * 6 * D + j];
    return s;
}

__device__ __forceinline__ void xn_rows(LAS float* sm  , const In& in, const float* part, bf16_t* xn, int b0, int nb, int row_lo, int row_hi) {
    const int nlat = nb * SEQ, wid = threadIdx.x >> 6, lane = threadIdx.x & 63;
    int cur_mr = -1;
    float gp[16];
#pragma unroll
    for (int j = 0; j < 4; ++j)
#pragma unroll
        for (int q = 0; q < 4; ++q) gp[4 * j + q] = in.norm_g[j * 256 + lane * 4 + q];
    for (int rbase = row_lo; rbase < row_hi; rbase += 8) {
        const int mr = rbase < nlat ? b0 + rbase / SEQ : NB;
        if (mr != cur_mr) { __syncthreads(); for (int j = threadIdx.x; j < 2 * D; j += NT) sm[j] = mod_value(in, part, mr, j); __syncthreads(); cur_mr = mr; }
        const int r = rbase + wid; if (r >= row_hi) continue;
        const float* src = r < nlat ? in.x + ((size_t)b0 * SEQ + r) * D : in.ctx + ((size_t)b0 * CTX + (r - nlat)) * D;
        f32x4 v[4]; float ss = 0.f;
#pragma unroll
        for (int j = 0; j < 4; ++j) { v[j] = *(const f32x4*)(src + j * 256 + lane * 4); ss += v[j][0] * v[j][0] + v[j][1] * v[j][1] + v[j][2] * v[j][2] + v[j][3] * v[j][3]; }
#pragma unroll
        for (int o = 32; o > 0; o >>= 1) ss += __shfl_xor(ss, o);
        const float rinv = 1.f / sqrtf(ss * (1.f / D) + NORM_EPS);
#pragma unroll
        for (int j = 0; j < 4; ++j) { const int c = j * 256 + lane * 4; float o[4];
#pragma unroll
            for (int q = 0; q < 4; ++q) o[q] = (v[j][q] * rinv * gp[4 * j + q]) * (1.f + sm[D + c + q]) + sm[c + q];
            u32x2 w; w.x = cvt_pk_bf16(o[0], o[1]); w.y = cvt_pk_bf16(o[2], o[3]); *(u32x2*)(xn + (size_t)r * D + c) = w; }
    }
}
}

namespace mk {
#define XB_TMO      128
#define XB_XCNT(j)  (256  + 64 * (j))
#define XB_XSUB(j)  (1280 + 64 * (j))
#define XB_XGEN(j)  (2304 + 64 * (j))
#define XB_TOP      3328
#define XB_TOPGEN   3392
#define XCD_BAR_WORDS 3456
#define XB_SPIN_CAP (1u << 18)
__device__ __forceinline__ unsigned xb_ld(unsigned* p)              { return __hip_atomic_load(p, __ATOMIC_RELAXED, __HIP_MEMORY_SCOPE_AGENT); }
__device__ __forceinline__ unsigned xb_add(unsigned* p, unsigned v) { return __hip_atomic_fetch_add(p, v, __ATOMIC_RELAXED, __HIP_MEMORY_SCOPE_AGENT); }
__device__ __forceinline__ unsigned xb_xcc_id() { return (unsigned)__builtin_amdgcn_s_getreg((3 << 11) | 20) & 0xFu; }
#define XB_SPIN(cond, bar) do { unsigned _sp = 0; while (cond) { __builtin_amdgcn_s_sleep(1); \
    if ((++_sp & 255u) == 0u) { if (xb_ld(&(bar)[XB_TMO])) break; if (_sp > XB_SPIN_CAP) { atomicAdd(&(bar)[XB_TMO], 1u); break; } } } } while (0)
struct XcdBarrier { unsigned* bar; unsigned x; volatile LAS unsigned* st; };
__device__ __forceinline__ XcdBarrier xcd_barrier_post(unsigned* bar, volatile LAS unsigned* st) {
    XcdBarrier b; b.bar = bar; b.x = xb_xcc_id(); b.st = st;
    if (threadIdx.x == 0) (void)xb_add(&bar[XB_XCNT(b.x)], 1u);
    return b;
}
__device__ __forceinline__ void xcd_barrier_complete(unsigned* bar, unsigned x, unsigned& nloc, unsigned& nx) {
    const unsigned G = gridDim.x * gridDim.y * gridDim.z;
    unsigned sum, cnt, mine, sp = 0u;
    for (;;) {
        sum = 0u; cnt = 0u; mine = 0u;
#pragma unroll
        for (unsigned j = 0; j < 16; ++j) { const unsigned c = xb_ld(&bar[XB_XCNT(j)]); sum += c; cnt += (c > 0u) ? 1u : 0u; mine = (j == x) ? c : mine; }
        if (sum == G) break;
        __builtin_amdgcn_s_sleep(1);
        if ((++sp & 255u) == 0u) { if (xb_ld(&bar[XB_TMO])) break; if (sp > XB_SPIN_CAP) { atomicAdd(&bar[XB_TMO], 1u); break; } }
    }
    nloc = mine > 0u ? mine : 1u; nx = cnt > 0u ? cnt : 1u;
}
__device__ __forceinline__ void xcd_barrier(const XcdBarrier& b) {
    asm volatile("s_waitcnt vmcnt(0)" ::: "memory");
    __syncthreads();
    if (threadIdx.x == 0) {
        unsigned* bar = b.bar;
        __builtin_amdgcn_s_waitcnt(0);
        unsigned nloc = b.st[0], nx = b.st[1];
        if (nloc == 0u) { xcd_barrier_complete(bar, b.x, nloc, nx); b.st[0] = nloc; b.st[1] = nx; }
        const unsigned old = xb_add(&bar[XB_XSUB(b.x)], 1u);
        const unsigned gen = old / nloc;
        if (old + 1u == (gen + 1u) * nloc) {
            __builtin_amdgcn_fence(__ATOMIC_RELEASE, "agent");
            asm volatile("s_waitcnt vmcnt(0)" ::: "memory");
            const unsigned og = xb_add(&bar[XB_TOP], 1u);
            const unsigned tg = og / nx;
            if (og + 1u == (tg + 1u) * nx) xb_add(&bar[XB_TOPGEN], 1u);
            else XB_SPIN(xb_ld(&bar[XB_TOPGEN]) == tg, bar);
            __builtin_amdgcn_fence(__ATOMIC_ACQUIRE, "agent");
            xb_add(&bar[XB_XGEN(b.x)], 1u);
            asm volatile("s_waitcnt vmcnt(0)" ::: "memory");
        } else {
            XB_SPIN(xb_ld(&bar[XB_XGEN(b.x)]) == gen, bar);
            __builtin_amdgcn_fence(__ATOMIC_ACQUIRE, "agent");
            asm volatile("s_waitcnt vmcnt(0)" ::: "memory");
        }
    }
    __syncthreads();
}
}

namespace mk {
constexpr int TB = 32;
constexpr int RAWW = 320;
constexpr int RW_RAW = 0;
constexpr int RW_MU = RW_RAW + (TB + 2) * RAWW * 2;
constexpr int RW_WUP = RW_MU + 2 * RAWW * 4;
constexpr int RW_AUP = RW_WUP + 64 * 72 * 2;
constexpr int RW_CST = RW_AUP + 64 * 72 * 2;
constexpr int RW_AWD = RW_CST + 5 * 64 * 4;
constexpr int RW_AAD = RW_AWD + TB * 72 * 2;
constexpr int RW_R = RW_AAD + TB * 72 * 2;
constexpr int RW_KR = RW_R + TB * 64 * 4;
constexpr int RW_LA = RW_KR + TB * 64 * 4;
constexpr int RW_KK = RW_LA + TB * 64 * 4;
constexpr int RW_W = RW_KK + TB * 64 * 4;
constexpr int RW_B = RW_W + TB * 64 * 4;
constexpr int RW_KD = RW_B + TB * 64 * 4;
constexpr int RW_WR = RW_KD + TB * 64 * 4;
constexpr int RW_V = RW_WR + TB * 64 * 4;
constexpr int RW_SC = RW_V + TB * 64 * 4;
constexpr int RW_YO = RW_SC + TB * 2 * 4;
constexpr int RW_BON = RW_YO + TB * 64 * 4;
constexpr int RW_END = RW_BON + TB * 4;
static_assert(RW_END <= LDS_BYTES, "rwkv LDS");

#define MK_DPP(x, ctrl) __int_as_float(__builtin_amdgcn_update_dpp(__float_as_int(x), __float_as_int(x), ctrl, 0xF, 0xF, false))
__device__ __forceinline__ float allreduce16(float x) {
    x += MK_DPP(x, 0xB1); x += MK_DPP(x, 0x4E); x += MK_DPP(x, 0x141); x += MK_DPP(x, 0x140); return x;
}

__device__ __forceinline__ void allreduce16x4(float& a, float& b, float& c, float& d) {
    asm volatile("s_nop 1\n\t"
        "v_add_f32_dpp %0, %0, %0 quad_perm:[1,0,3,2] row_mask:0xf bank_mask:0xf\n\t" "v_add_f32_dpp %1, %1, %1 quad_perm:[1,0,3,2] row_mask:0xf bank_mask:0xf\n\t"
        "v_add_f32_dpp %2, %2, %2 quad_perm:[1,0,3,2] row_mask:0xf bank_mask:0xf\n\t" "v_add_f32_dpp %3, %3, %3 quad_perm:[1,0,3,2] row_mask:0xf bank_mask:0xf\n\t"
        "v_add_f32_dpp %0, %0, %0 quad_perm:[2,3,0,1] row_mask:0xf bank_mask:0xf\n\t" "v_add_f32_dpp %1, %1, %1 quad_perm:[2,3,0,1] row_mask:0xf bank_mask:0xf\n\t"
        "v_add_f32_dpp %2, %2, %2 quad_perm:[2,3,0,1] row_mask:0xf bank_mask:0xf\n\t" "v_add_f32_dpp %3, %3, %3 quad_perm:[2,3,0,1] row_mask:0xf bank_mask:0xf\n\t"
        "v_add_f32_dpp %0, %0, %0 row_half_mirror row_mask:0xf bank_mask:0xf\n\t" "v_add_f32_dpp %1, %1, %1 row_half_mirror row_mask:0xf bank_mask:0xf\n\t"
        "v_add_f32_dpp %2, %2, %2 row_half_mirror row_mask:0xf bank_mask:0xf\n\t" "v_add_f32_dpp %3, %3, %3 row_half_mirror row_mask:0xf bank_mask:0xf\n\t"
        "v_add_f32_dpp %0, %0, %0 row_mirror row_mask:0xf bank_mask:0xf\n\t" "v_add_f32_dpp %1, %1, %1 row_mirror row_mask:0xf bank_mask:0xf\n\t"
        "v_add_f32_dpp %2, %2, %2 row_mirror row_mask:0xf bank_mask:0xf\n\t" "v_add_f32_dpp %3, %3, %3 row_mirror row_mask:0xf bank_mask:0xf"
        : "+v"(a), "+v"(b), "+v"(c), "+v"(d));
}
struct RwkvP { const bf16_t* z1; bf16_t* Y; float* bon; int b0, nb; };

constexpr int RW_NPIECE = (TB + 2) * 40, RW_PPT = (RW_NPIECE + NT - 1) / NT;

__device__ __forceinline__ void rwkv_chain(LAS unsigned char* lds, const In& in, const RwkvP p, int chain) {
    const int tid = threadIdx.x, lane = tid & 63, wid = tid >> 6;
    const int d = chain / (p.nb * NH), bl = (chain / NH) % p.nb, h = chain % NH;
    const int nlat = p.nb * SEQ;
    LAS bf16_t* RAW = (LAS bf16_t*)(lds + RW_RAW); LAS float* MU = (LAS float*)(lds + RW_MU);
    LAS bf16_t* WUP = (LAS bf16_t*)(lds + RW_WUP); LAS bf16_t* AUP = (LAS bf16_t*)(lds + RW_AUP); LAS float* CST = (LAS float*)(lds + RW_CST);
    LAS bf16_t* AWD = (LAS bf16_t*)(lds + RW_AWD); LAS bf16_t* AAD = (LAS bf16_t*)(lds + RW_AAD);
    LAS float *Rr = (LAS float*)(lds + RW_R), *KR = (LAS float*)(lds + RW_KR), *LA_ = (LAS float*)(lds + RW_LA);
    LAS float *KK = (LAS float*)(lds + RW_KK), *Wv = (LAS float*)(lds + RW_W), *Bv = (LAS float*)(lds + RW_B), *KD = (LAS float*)(lds + RW_KD), *WR = (LAS float*)(lds + RW_WR), *Vv = (LAS float*)(lds + RW_V);
    LAS float *SC = (LAS float*)(lds + RW_SC), *YO = (LAS float*)(lds + RW_YO), *BON = (LAS float*)(lds + RW_BON);
    auto segcol = [&](int s) { return s < 3 ? s * RW + h * 64 : (s == 3 ? OFF_WD + d * DL : OFF_AD + d * AL); };
    for (int i = tid; i < 2 * RAWW; i += NT) { const int m = i / RAWW, c = i % RAWW; MU[i] = in.shift_mu[m * RC + segcol(c >> 6) + (c & 63)]; }
    for (int i = tid; i < 64 * 64; i += NT) { const int j = i >> 6, c = i & 63;
        WUP[c * 72 + j] = f2bf(in.rw_w_up[((size_t)d * DL + j) * RW + h * 64 + c]); AUP[c * 72 + j] = f2bf(in.rw_a_up[((size_t)d * AL + j) * RW + h * 64 + c]); }
    for (int i = tid; i < 64; i += NT) { CST[i] = in.rw_w0[d * RW + h * 64 + i]; CST[64 + i] = in.rw_a0[d * RW + h * 64 + i]; CST[128 + i] = in.rw_k_k[h * 64 + i]; CST[192 + i] = in.rw_k_a[h * 64 + i]; CST[256 + i] = in.rw_r_k[h * 64 + i]; }
    constexpr int NQ = (CTX + SEQ) / TB, NQC = CTX / TB;
    auto blk_info = [&](int q, bool& isctx, int& t0, bool& hp, bool& hn, size_t& grow0) {
        isctx = q < NQC;
        if (isctx) { const int qq = d == 0 ? q : NQC - 1 - q; t0 = qq * TB; hp = t0 > 0; hn = t0 + TB < CTX; grow0 = (size_t)nlat + (size_t)bl * CTX + t0; }
        else { const int ql = q - NQC, qq = d == 0 ? ql : SEQ / TB - 1 - ql; t0 = qq * TB; hp = (t0 % GW) != 0; hn = ((t0 + TB) % GW) != 0; grow0 = (size_t)bl * SEQ + t0; }
    };
    u32x4 pre[RW_PPT];
    auto prefetch = [&](int q) {
        bool isctx, hp, hn; int t0; size_t grow0; blk_info(q, isctx, t0, hp, hn, grow0);
#pragma unroll
        for (int k = 0; k < RW_PPT; ++k) { const int i = tid + k * NT; u32x4 v = (u32x4){0u, 0u, 0u, 0u};
            if (i < RW_NPIECE) { const int rr = i / 40, sp = i % 40, seg = sp >> 3, part = sp & 7;
                const bool ok = (rr == 0) ? hp : ((rr == TB + 1) ? hn : true);
                if (ok) v = *(const u32x4*)(p.z1 + (grow0 + rr - 1) * Z1_N + segcol(seg) + part * 8); }
            pre[k] = v; }
    };
    auto commit = [&]() {
#pragma unroll
        for (int k = 0; k < RW_PPT; ++k) { const int i = tid + k * NT; if (i < RW_NPIECE) { const int rr = i / 40, sp = i % 40; *(LAS u32x4*)(RAW + rr * RAWW + sp * 8) = pre[k]; } }
    };
    float S[2][4];
#pragma unroll
    for (int i = 0; i < 2; ++i)
#pragma unroll
        for (int j = 0; j < 4; ++j) S[i][j] = 0.f;
    const int kg = lane & 15, rp = (lane >> 4) + 4 * wid;
    prefetch(0);
    for (int q = 0; q < NQ; ++q) {
        bool isctx, hp, hn; int t0; size_t grow0; blk_info(q, isctx, t0, hp, hn, grow0);
        commit();
        __syncthreads();
        if (q + 1 < NQ) prefetch(q + 1);
        auto shift8 = [&](int t, int c0, float (&s)[8]) {
            const u32x4 xp = *(const LAS u32x4*)(RAW + t * RAWW + c0), xc = *(const LAS u32x4*)(RAW + (t + 1) * RAWW + c0), xn_ = *(const LAS u32x4*)(RAW + (t + 2) * RAWW + c0);
            const f32x4 m0a = *(const LAS f32x4*)(MU + c0), m0b = *(const LAS f32x4*)(MU + c0 + 4), m1a = *(const LAS f32x4*)(MU + RAWW + c0), m1b = *(const LAS f32x4*)(MU + RAWW + c0 + 4);
#pragma unroll
            for (int j = 0; j < 4; ++j) { const unsigned a = xp[j], b = xc[j], c = xn_[j];
                const float mu0l = j < 2 ? m0a[2 * j] : m0b[2 * j - 4], mu0h = j < 2 ? m0a[2 * j + 1] : m0b[2 * j - 3], mu1l = j < 2 ? m1a[2 * j] : m1b[2 * j - 4], mu1h = j < 2 ? m1a[2 * j + 1] : m1b[2 * j - 3];
                { const float x = bflo(b); s[2 * j] = x + mu0l * (bflo(a) - x) + mu1l * (bflo(c) - x); }
                { const float x = bfhi(b); s[2 * j + 1] = x + mu0h * (bfhi(a) - x) + mu1h * (bfhi(c) - x); } } };
        for (int it = tid; it < TB * 24; it += NT) {
            const int t = it / 24, g = it % 24, seg = g >> 3, cc = (g & 7) * 8; float s[8]; shift8(t, g * 8, s);
            LAS float* dst = (seg == 0 ? Rr : (seg == 1 ? KR : Vv)) + t * 64 + cc; *(LAS f32x4*)dst = (f32x4){s[0], s[1], s[2], s[3]}; *(LAS f32x4*)(dst + 4) = (f32x4){s[4], s[5], s[6], s[7]};
        }
        { const int t = tid >> 4, g = 24 + (tid & 15), cc = (g & 7) * 8; float s[8]; shift8(t, g * 8, s);
          const bool isw = (tid & 15) < 8;
#pragma unroll
          for (int j = 0; j < 8; ++j) { const float th = fast_tanh(s[j]); s[j] = isw ? th : s[j]; }
          LAS bf16_t* dst = (isw ? AWD : AAD) + t * 72 + cc;
          u32x4 w; w.x = cvt_pk_bf16(s[0], s[1]); w.y = cvt_pk_bf16(s[2], s[3]); w.z = cvt_pk_bf16(s[4], s[5]); w.w = cvt_pk_bf16(s[6], s[7]); *(LAS u32x4*)dst = w; }
        __syncthreads();
        {
            const int lora = wid >> 2, ct = wid & 3, fr = lane & 15, fq = lane >> 4;
            const LAS bf16_t* Am = lora ? AAD : AWD; const LAS bf16_t* Bm = lora ? AUP : WUP;
#pragma unroll
            for (int rt = 0; rt < 2; ++rt) {
                f32x4 acc = (f32x4){0.f, 0.f, 0.f, 0.f};
#pragma unroll
                for (int ks = 0; ks < 2; ++ks) {
                    const bf16x8 a = *(const LAS bf16x8*)(Am + (rt * 16 + fr) * 72 + ks * 32 + fq * 8);
                    const bf16x8 b = *(const LAS bf16x8*)(Bm + (ct * 16 + fr) * 72 + ks * 32 + fq * 8);
                    acc = __builtin_amdgcn_mfma_f32_16x16x32_bf16(a, b, acc, 0, 0, 0);
                }
                const int col = ct * 16 + fr;
#pragma unroll
                for (int i = 0; i < 4; ++i) { const int t = rt * 16 + fq * 4 + i;
                    if (lora == 0) { const float lw = acc[i] + CST[col]; const float wl = -fast_softplus(-lw) - 0.5f; Wv[t * 64 + col] = __expf(-__expf(wl)); }
                    else { LA_[t * 64 + col] = fast_sigmoid(acc[i] + CST[64 + col]); } }
            }
        }
        __syncthreads();
        {
            const int t = tid >> 4, c4 = (tid & 15) * 4;
            const f32x4 k = *(const LAS f32x4*)(KR + t * 64 + c4), a = *(const LAS f32x4*)(LA_ + t * 64 + c4), w = *(const LAS f32x4*)(Wv + t * 64 + c4), r = *(const LAS f32x4*)(Rr + t * 64 + c4);
            f32x4 kkr, kd, bb, wr; float ss = 0.f, br = 0.f, kr = 0.f, bn = 0.f;
#pragma unroll
            for (int j = 0; j < 4; ++j) { kkr[j] = k[j] * CST[128 + c4 + j]; ss += kkr[j] * kkr[j]; }
            ss = allreduce16(ss);
            const float inv = 1.f / fmaxf(sqrtf(ss), 1e-12f);
#pragma unroll
            for (int j = 0; j < 4; ++j) { const float kk = kkr[j] * inv; kkr[j] = kk; kd[j] = k[j] * (1.f + (a[j] - 1.f) * CST[192 + c4 + j]); bb[j] = kk * a[j]; wr[j] = w[j] * r[j];
                br += bb[j] * r[j]; kr += kd[j] * r[j]; bn += r[j] * kd[j] * CST[256 + c4 + j]; }
            br = allreduce16(br); kr = allreduce16(kr); bn = allreduce16(bn);
            *(LAS f32x4*)(KK + t * 64 + c4) = kkr; *(LAS f32x4*)(KD + t * 64 + c4) = kd; *(LAS f32x4*)(Bv + t * 64 + c4) = bb; *(LAS f32x4*)(WR + t * 64 + c4) = wr;
            if ((tid & 15) == 0) { SC[t * 2] = br; SC[t * 2 + 1] = kr; BON[t] = bn; }
        }
        __syncthreads();
        {
            auto tof = [&](int st) { return d == 0 ? st : TB - 1 - st; };
            const LAS float* lb = KK + 4 * kg;
            const LAS float* vb = Vv + 2 * rp;
            constexpr int OW = (RW_W - RW_KK) / 4, OB = (RW_B - RW_KK) / 4, OKD = (RW_KD - RW_KK) / 4, OWR = (RW_WR - RW_KK) / 4;
            int t = tof(0);
            f32x4 kk4 = *(const LAS f32x4*)(lb + t * 64), w4 = *(const LAS f32x4*)(lb + t * 64 + OW), b4 = *(const LAS f32x4*)(lb + t * 64 + OB),
                  kd4 = *(const LAS f32x4*)(lb + t * 64 + OKD), wr4 = *(const LAS f32x4*)(lb + t * 64 + OWR);
            f32x2 vv = *(const LAS f32x2*)(vb + t * 64), sc = *(const LAS f32x2*)(SC + t * 2);
            f32x2 S2[4];
#pragma unroll
            for (int j = 0; j < 4; ++j) { S2[j][0] = S[0][j]; S2[j][1] = S[1][j]; }
#pragma unroll 2
            for (int st = 0; st < TB; ++st) {
                const int tn = tof(st + 1 < TB ? st + 1 : st);
                const f32x4 nkk4 = *(const LAS f32x4*)(lb + tn * 64), nw4 = *(const LAS f32x4*)(lb + tn * 64 + OW), nb4 = *(const LAS f32x4*)(lb + tn * 64 + OB),
                            nkd4 = *(const LAS f32x4*)(lb + tn * 64 + OKD), nwr4 = *(const LAS f32x4*)(lb + tn * 64 + OWR);
                const f32x2 nvv = *(const LAS f32x2*)(vb + tn * 64), nsc = *(const LAS f32x2*)(SC + tn * 2);
                f32x2 sa2 = S2[0] * kk4[0], yo2 = S2[0] * wr4[0];
#pragma unroll
                for (int j = 1; j < 4; ++j) { sa2 += S2[j] * kk4[j]; yo2 += S2[j] * wr4[j]; }
                float sa0 = sa2[0], sa1 = sa2[1], yo0 = yo2[0], yo1 = yo2[1];
                allreduce16x4(sa0, sa1, yo0, yo1);
                f32x2 sar; sar[0] = sa0; sar[1] = sa1;
#pragma unroll
                for (int j = 0; j < 4; ++j) S2[j] = S2[j] * w4[j] + (vv * kd4[j] - sar * b4[j]);
                if (kg == 0) { f32x2 yor; yor[0] = yo0; yor[1] = yo1; const f32x2 y = yor - sar * sc[0] + vv * sc[1]; *(LAS f32x2*)(YO + t * 64 + 2 * rp) = y; }
                kk4 = nkk4; w4 = nw4; b4 = nb4; kd4 = nkd4; wr4 = nwr4; vv = nvv; sc = nsc; t = tn;
            }
#pragma unroll
            for (int j = 0; j < 4; ++j) { S[0][j] = S2[j][0]; S[1][j] = S2[j][1]; }
        }
        __syncthreads();
        if (!isctx) {
            const int t = tid >> 4, c4 = (tid & 15) * 4; const f32x4 y = *(const LAS f32x4*)(YO + t * 64 + c4);
            u32x2 w; w.x = cvt_pk_bf16(y[0], y[1]); w.y = cvt_pk_bf16(y[2], y[3]);
            *(u32x2*)(p.Y + ((size_t)d * nlat + grow0 + t) * RW + h * 64 + c4) = w;
            if (tid < TB) p.bon[((size_t)d * nlat + grow0 + tid) * NH + h] = BON[tid];
        }
    }
}
__device__ __forceinline__ void rwkv_phase(LAS unsigned char* lds, const In& in, const RwkvP p, int bid, int nblk) {
    const int nchain = 2 * p.nb * NH;
    for (int c = bid; c < nchain; c += nblk) { rwkv_chain(lds, in, p, c); __syncthreads(); }
}
}

namespace mk {
constexpr int C2_RAW = 0;
constexpr int C2_MU = C2_RAW + (TB + 2) * RAWW * 2;
constexpr int C2_WUP = C2_MU + 2 * RAWW * 4;
constexpr int C2_AUP = C2_WUP + 64 * 72 * 2;
constexpr int C2_CST = C2_AUP + 64 * 72 * 2;
constexpr int C2_AWD = C2_CST + 5 * 64 * 4;
constexpr int C2_AAD = C2_AWD + TB * 72 * 2;
constexpr int C2_X = C2_AAD + TB * 72 * 2;
constexpr int C2_R = C2_X, C2_KR = C2_R + TB * 64 * 4, C2_V = C2_KR + TB * 64 * 4, C2_E = C2_V + TB * 64 * 4, C2_LA = C2_E + TB * 64 * 4, C2_CUM = C2_LA + TB * 64 * 4, C2_X_END = C2_CUM + TB * 64 * 4;
constexpr int C2_YO = C2_X;
constexpr int C2_G = C2_YO + TB * 64 * 4;
constexpr int C2_UB = C2_G + 64 * 36 * 4;
constexpr int C2_ABT = C2_UB + 64 * 40 * 2;
constexpr int C2_AKT = C2_ABT + 32 * 32 * 4;
constexpr int C2_NBT = C2_AKT + 32 * 40 * 2;
constexpr int C2_NKT = C2_NBT + 32 * 40 * 2;
static_assert(C2_NKT + 32 * 40 * 2 <= C2_X_END, "region X reuse");
constexpr int C2_KKS = C2_X_END;
constexpr int C2_BS = C2_KKS + TB * 72 * 2, C2_KDS = C2_BS + TB * 72 * 2, C2_RS = C2_KDS + TB * 72 * 2;
constexpr int C2_BST = C2_RS + TB * 72 * 2;
constexpr int C2_KDST = C2_BST + 64 * 40 * 2;
constexpr int C2_VT = C2_KDST + 64 * 40 * 2;
constexpr int C2_S0B = C2_VT + 64 * 40 * 2;
constexpr int C2_GC = C2_S0B + 64 * 72 * 2;
constexpr int C2_BON = C2_GC + 64 * 4;
constexpr int C2_END = C2_BON + TB * 4;
static_assert(C2_END <= LDS_BYTES - 16 && (C2_X % 16) == 0 && (C2_KKS % 16) == 0 && (C2_G % 16) == 0 && (C2_UB % 16) == 0 && (C2_ABT % 16) == 0 && (C2_AKT % 16) == 0 && (C2_S0B % 16) == 0, "rwkv2 LDS");

__device__ __forceinline__ bf16x8 ldsb8(const LAS bf16_t* p) { return *(const LAS bf16x8*)p; }

template <int MODE>
__device__ __forceinline__ void rwkv_chain2(LAS unsigned char* lds, const In& in, const RwkvP p, int chain) {
    const int tid = threadIdx.x, lane = tid & 63, wid = tid >> 6, fr = lane & 15, fq = lane >> 4;
    const int d = chain / (p.nb * NH), bl = (chain / NH) % p.nb, h = chain % NH;
    const int nlat = p.nb * SEQ;
    LAS bf16_t* RAW = (LAS bf16_t*)(lds + C2_RAW); LAS float* MU = (LAS float*)(lds + C2_MU);
    LAS bf16_t* WUP = (LAS bf16_t*)(lds + C2_WUP); LAS bf16_t* AUP = (LAS bf16_t*)(lds + C2_AUP); LAS float* CST = (LAS float*)(lds + C2_CST);
    LAS bf16_t* AWD = (LAS bf16_t*)(lds + C2_AWD); LAS bf16_t* AAD = (LAS bf16_t*)(lds + C2_AAD);
    LAS float *Rr = (LAS float*)(lds + C2_R), *KR = (LAS float*)(lds + C2_KR), *Vv = (LAS float*)(lds + C2_V), *Ee = (LAS float*)(lds + C2_E), *LA_ = (LAS float*)(lds + C2_LA), *CUM = (LAS float*)(lds + C2_CUM);
    LAS float *YO = (LAS float*)(lds + C2_YO), *Gm = (LAS float*)(lds + C2_G), *ABT = (LAS float*)(lds + C2_ABT), *GC = (LAS float*)(lds + C2_GC), *BON = (LAS float*)(lds + C2_BON);
    LAS bf16_t *UB = (LAS bf16_t*)(lds + C2_UB), *AKT = (LAS bf16_t*)(lds + C2_AKT), *NBT = (LAS bf16_t*)(lds + C2_NBT), *NKT = (LAS bf16_t*)(lds + C2_NKT);
    LAS bf16_t *KKS = (LAS bf16_t*)(lds + C2_KKS), *BS = (LAS bf16_t*)(lds + C2_BS), *KDS = (LAS bf16_t*)(lds + C2_KDS), *RS = (LAS bf16_t*)(lds + C2_RS);
    LAS bf16_t *BST = (LAS bf16_t*)(lds + C2_BST), *KDST = (LAS bf16_t*)(lds + C2_KDST), *VT = (LAS bf16_t*)(lds + C2_VT), *S0B = (LAS bf16_t*)(lds + C2_S0B);
    auto segcol = [&](int s) { return s < 3 ? s * RW + h * 64 : (s == 3 ? OFF_WD + d * DL : OFF_AD + d * AL); };
    for (int i = tid; i < 2 * RAWW; i += NT) { const int m = i / RAWW, c = i % RAWW; MU[i] = in.shift_mu[m * RC + segcol(c >> 6) + (c & 63)]; }
    for (int i = tid; i < 64 * 64; i += NT) { const int j = i >> 6, c = i & 63;
        WUP[c * 72 + j] = f2bf(in.rw_w_up[((size_t)d * DL + j) * RW + h * 64 + c]); AUP[c * 72 + j] = f2bf(in.rw_a_up[((size_t)d * AL + j) * RW + h * 64 + c]); }
    for (int i = tid; i < 64; i += NT) { CST[i] = in.rw_w0[d * RW + h * 64 + i]; CST[64 + i] = in.rw_a0[d * RW + h * 64 + i]; CST[128 + i] = in.rw_k_k[h * 64 + i]; CST[192 + i] = in.rw_k_a[h * 64 + i]; CST[256 + i] = in.rw_r_k[h * 64 + i]; }
    for (int i = tid; i < 64 * 72 / 2; i += NT) ((LAS unsigned*)S0B)[i] = 0u;
    constexpr int NQ = (CTX + SEQ) / TB, NQC = CTX / TB;
    auto blk_info = [&](int q, bool& isctx, int& t0, bool& hp, bool& hn, size_t& grow0) {
        isctx = q < NQC;
        if (isctx) { const int qq = d == 0 ? q : NQC - 1 - q; t0 = qq * TB; hp = t0 > 0; hn = t0 + TB < CTX; grow0 = (size_t)nlat + (size_t)bl * CTX + t0; }
        else { const int ql = q - NQC, qq = d == 0 ? ql : SEQ / TB - 1 - ql; t0 = qq * TB; hp = (t0 % GW) != 0; hn = ((t0 + TB) % GW) != 0; grow0 = (size_t)bl * SEQ + t0; }
    };
    u32x4 pre[RW_PPT]; int poff[RW_PPT], plds[RW_PPT], pkind[RW_PPT];
#pragma unroll
    for (int k = 0; k < RW_PPT; ++k) { const int i = tid + k * NT, rr = i / 40, sp = i % 40, seg = sp >> 3, part = sp & 7;
        poff[k] = (rr - 1) * Z1_N + segcol(seg) + part * 8; plds[k] = rr * RAWW + sp * 8; pkind[k] = i >= RW_NPIECE ? 3 : (rr == 0 ? 1 : (rr == TB + 1 ? 2 : 0)); }
    auto prefetch = [&](int q) {
        bool isctx, hp, hn; int t0; size_t grow0; blk_info(q, isctx, t0, hp, hn, grow0);
        const bf16_t* base = p.z1 + grow0 * Z1_N;
#pragma unroll
        for (int k = 0; k < RW_PPT; ++k) { u32x4 v = (u32x4){0u, 0u, 0u, 0u};
            const bool ok = pkind[k] == 0 || (pkind[k] == 1 && hp) || (pkind[k] == 2 && hn);
            if (ok) v = *(const u32x4*)(base + poff[k]);
            pre[k] = v; }
    };
    auto commit = [&]() {
#pragma unroll
        for (int k = 0; k < RW_PPT; ++k) if (pkind[k] != 3) *(LAS u32x4*)(RAW + plds[k]) = pre[k];
    };
    f32x4 Sreg[2];
    Sreg[0] = (f32x4){0.f, 0.f, 0.f, 0.f}; Sreg[1] = Sreg[0];
    const int rt = wid >> 1;
    prefetch(0);
    for (int q = 0; q < NQ; ++q) {
        bool isctx, hp, hn; int t0; size_t grow0; blk_info(q, isctx, t0, hp, hn, grow0);
        commit();
        __syncthreads();
        if (q + 1 < NQ) prefetch(q + 1);
        auto shift8 = [&](int t, int c0, float (&s)[8]) {
            const u32x4 xp = *(const LAS u32x4*)(RAW + t * RAWW + c0), xc = *(const LAS u32x4*)(RAW + (t + 1) * RAWW + c0), xn_ = *(const LAS u32x4*)(RAW + (t + 2) * RAWW + c0);
            const f32x4 m0a = *(const LAS f32x4*)(MU + c0), m0b = *(const LAS f32x4*)(MU + c0 + 4), m1a = *(const LAS f32x4*)(MU + RAWW + c0), m1b = *(const LAS f32x4*)(MU + RAWW + c0 + 4);
#pragma unroll
            for (int j = 0; j < 4; ++j) { const unsigned a = xp[j], b = xc[j], c = xn_[j];
                const float mu0l = j < 2 ? m0a[2 * j] : m0b[2 * j - 4], mu0h = j < 2 ? m0a[2 * j + 1] : m0b[2 * j - 3], mu1l = j < 2 ? m1a[2 * j] : m1b[2 * j - 4], mu1h = j < 2 ? m1a[2 * j + 1] : m1b[2 * j - 3];
                { const float x = bflo(b); s[2 * j] = x + mu0l * (bflo(a) - x) + mu1l * (bflo(c) - x); }
                { const float x = bfhi(b); s[2 * j + 1] = x + mu0h * (bfhi(a) - x) + mu1h * (bfhi(c) - x); } } };
        for (int it = tid; it < TB * 24; it += NT) {
            const int t = it / 24, g = it % 24, seg = g >> 3, cc = (g & 7) * 8, js = d == 0 ? t : TB - 1 - t; float s[8]; shift8(t, g * 8, s);
            LAS float* dst = (seg == 0 ? Rr : (seg == 1 ? KR : Vv)) + js * 64 + cc; *(LAS f32x4*)dst = (f32x4){s[0], s[1], s[2], s[3]}; *(LAS f32x4*)(dst + 4) = (f32x4){s[4], s[5], s[6], s[7]};
        }
        { const int t = tid >> 4, g = 24 + (tid & 15), cc = (g & 7) * 8, js = d == 0 ? t : TB - 1 - t; float s[8]; shift8(t, g * 8, s);
          const bool isw = (tid & 15) < 8;
#pragma unroll
          for (int j = 0; j < 8; ++j) { const float th = fast_tanh(s[j]); s[j] = isw ? th : s[j]; }
          LAS bf16_t* dst = (isw ? AWD : AAD) + js * 72 + cc;
          u32x4 w; w.x = cvt_pk_bf16(s[0], s[1]); w.y = cvt_pk_bf16(s[2], s[3]); w.z = cvt_pk_bf16(s[4], s[5]); w.w = cvt_pk_bf16(s[6], s[7]); *(LAS u32x4*)dst = w; }
        __syncthreads();
        if (MODE == 3) continue;
        {
            const int lora = wid >> 2, ct = wid & 3;
            const LAS bf16_t* Am = lora ? AAD : AWD; const LAS bf16_t* Bm = lora ? AUP : WUP;
            float carry = 0.f;
#pragma unroll
            for (int r2 = 0; r2 < 2; ++r2) {
                f32x4 acc = (f32x4){0.f, 0.f, 0.f, 0.f};
#pragma unroll
                for (int ks = 0; ks < 2; ++ks) acc = __builtin_amdgcn_mfma_f32_16x16x32_bf16(ldsb8(Am + (r2 * 16 + fr) * 72 + ks * 32 + fq * 8), ldsb8(Bm + (ct * 16 + fr) * 72 + ks * 32 + fq * 8), acc, 0, 0, 0);
                const int col = ct * 16 + fr;
                if (lora == 0) {
                    float c[4];
#pragma unroll
                    for (int i = 0; i < 4; ++i) { const float lw = acc[i] + CST[col]; const float e = __expf(-fast_softplus(-lw) - 0.5f); c[i] = i ? c[i - 1] + e : e; }
                    const float tot = c[3];
                    float s1 = tot; { const float y = __shfl_up(s1, 16); s1 += fq >= 1 ? y : 0.f; }
                    float s2 = s1;  { const float z = __shfl_up(s1, 32); s2 += fq >= 2 ? z : 0.f; }
                    const float base = carry + s2 - tot;
#pragma unroll
                    for (int i = 0; i < 4; ++i) CUM[(r2 * 16 + fq * 4 + i) * 64 + col] = base + c[i];
                    carry += __shfl(s2, 48 + fr);
                } else {
#pragma unroll
                    for (int i = 0; i < 4; ++i) LA_[(r2 * 16 + fq * 4 + i) * 64 + col] = fast_sigmoid(acc[i] + CST[64 + col]);
                }
            }
        }
        __syncthreads();
        if (MODE == 2) continue;
        {
            const int j = tid >> 4, c4 = (tid & 15) * 4;
            const f32x4 k = *(const LAS f32x4*)(KR + j * 64 + c4), a = *(const LAS f32x4*)(LA_ + j * 64 + c4), r = *(const LAS f32x4*)(Rr + j * 64 + c4), vv = *(const LAS f32x4*)(Vv + j * 64 + c4);
            const f32x4 cu = *(const LAS f32x4*)(CUM + j * 64 + c4); f32x4 cp = (f32x4){0.f, 0.f, 0.f, 0.f}; if (j > 0) cp = *(const LAS f32x4*)(CUM + (j - 1) * 64 + c4);
            float kkr[4], ss = 0.f, bn = 0.f;
#pragma unroll
            for (int x = 0; x < 4; ++x) { kkr[x] = k[x] * CST[128 + c4 + x]; ss += kkr[x] * kkr[x]; }
            ss = allreduce16(ss);
            const float inv = 1.f / fmaxf(sqrtf(ss), 1e-12f);
            float kks[4], bs[4], kds[4], rs[4];
#pragma unroll
            for (int x = 0; x < 4; ++x) { const float kk = kkr[x] * inv, kd = k[x] * (1.f + (a[x] - 1.f) * CST[192 + c4 + x]), bb = kk * a[x];
                const float g = __expf(-cu[x]), gp = __expf(-cp[x]), ig = __expf(cu[x]);
                kks[x] = kk * gp; bs[x] = bb * ig; kds[x] = kd * ig; rs[x] = r[x] * g; bn += r[x] * kd * CST[256 + c4 + x];
                if (j == TB - 1) GC[c4 + x] = g;
            }
#pragma unroll
            for (int x = 0; x < 4; x += 2) { const unsigned pb = cvt_pk_bf16(bs[x], bs[x + 1]), pk = cvt_pk_bf16(kds[x], kds[x + 1]), pv = cvt_pk_bf16(vv[x], vv[x + 1]);
                BST[(c4 + x) * 40 + j] = (bf16_t)pb; BST[(c4 + x + 1) * 40 + j] = (bf16_t)(pb >> 16); KDST[(c4 + x) * 40 + j] = (bf16_t)pk; KDST[(c4 + x + 1) * 40 + j] = (bf16_t)(pk >> 16);
                VT[(c4 + x) * 40 + j] = (bf16_t)pv; VT[(c4 + x + 1) * 40 + j] = (bf16_t)(pv >> 16); }
            bn = allreduce16(bn);
            u32x2 w; w.x = cvt_pk_bf16(kks[0], kks[1]); w.y = cvt_pk_bf16(kks[2], kks[3]); *(LAS u32x2*)(KKS + j * 72 + c4) = w;
            w.x = cvt_pk_bf16(bs[0], bs[1]); w.y = cvt_pk_bf16(bs[2], bs[3]); *(LAS u32x2*)(BS + j * 72 + c4) = w;
            w.x = cvt_pk_bf16(kds[0], kds[1]); w.y = cvt_pk_bf16(kds[2], kds[3]); *(LAS u32x2*)(KDS + j * 72 + c4) = w;
            w.x = cvt_pk_bf16(rs[0], rs[1]); w.y = cvt_pk_bf16(rs[2], rs[3]); *(LAS u32x2*)(RS + j * 72 + c4) = w;
            if ((tid & 15) == 0) BON[j] = bn;
        }
        __syncthreads();
        if (MODE == 1) continue;
        const int ctg = wid & 1;
        f32x4 accG = (f32x4){0.f, 0.f, 0.f, 0.f}, accY = accG;
        {
            const int pr = wid >> 1, rts = wid & 1;
            const LAS bf16_t* Xm = (pr & 1) ? KDS : BS; const LAS bf16_t* Ym = (pr < 2) ? KKS : RS;
            const bf16x8 a0 = ldsb8(Xm + (rts * 16 + fr) * 72 + fq * 8), a1 = ldsb8(Xm + (rts * 16 + fr) * 72 + 32 + fq * 8);
#pragma unroll
            for (int cts = 0; cts < 2; ++cts) {
                f32x4 acc = (f32x4){0.f, 0.f, 0.f, 0.f};
                acc = __builtin_amdgcn_mfma_f32_16x16x32_bf16(a0, ldsb8(Ym + (cts * 16 + fr) * 72 + fq * 8), acc, 0, 0, 0);
                acc = __builtin_amdgcn_mfma_f32_16x16x32_bf16(a1, ldsb8(Ym + (cts * 16 + fr) * 72 + 32 + fq * 8), acc, 0, 0, 0);
                const int t = cts * 16 + fr, s0 = rts * 16 + fq * 4;
#pragma unroll
                for (int i = 0; i < 4; ++i) { const bool keep = (pr < 2) ? (s0 + i < t) : (s0 + i <= t); acc[i] = keep ? acc[i] : 0.f; }
                if (pr == 0) *(LAS f32x4*)(ABT + t * 32 + s0) = acc;
                else { u32x2 w; w.x = cvt_pk_bf16(acc[0], acc[1]); w.y = cvt_pk_bf16(acc[2], acc[3]); *(LAS u32x2*)((pr == 1 ? AKT : (pr == 2 ? NBT : NKT)) + t * 40 + s0) = w; }
            }
#pragma unroll
            for (int ks = 0; ks < 2; ++ks) { const bf16x8 sa = ldsb8(S0B + (rt * 16 + fr) * 72 + ks * 32 + fq * 8);
                accG = __builtin_amdgcn_mfma_f32_16x16x32_bf16(sa, ldsb8(KKS + (ctg * 16 + fr) * 72 + ks * 32 + fq * 8), accG, 0, 0, 0);
                accY = __builtin_amdgcn_mfma_f32_16x16x32_bf16(sa, ldsb8(RS + (ctg * 16 + fr) * 72 + ks * 32 + fq * 8), accY, 0, 0, 0); }
        }
        __syncthreads();
        {
            const bf16x8 va = ldsb8(VT + (rt * 16 + fr) * 40 + fq * 8);
            accG = __builtin_amdgcn_mfma_f32_16x16x32_bf16(va, ldsb8(AKT + (ctg * 16 + fr) * 40 + fq * 8), accG, 0, 0, 0);
            accY = __builtin_amdgcn_mfma_f32_16x16x32_bf16(va, ldsb8(NKT + (ctg * 16 + fr) * 40 + fq * 8), accY, 0, 0, 0);
#pragma unroll
            for (int i = 0; i < 4; ++i) Gm[(rt * 16 + fq * 4 + i) * 36 + ctg * 16 + fr] = -accG[i];
        }
        __syncthreads();
        if (MODE == 4) continue;
        if (wid < 4) {
            const int v = wid * 16 + (lane >> 2), pq = lane & 3;
            const LAS float* grow = Gm + v * 36;
            f32x4 r0 = *(const LAS f32x4*)(grow + 4 * pq), r1 = *(const LAS f32x4*)(grow + 16 + 4 * pq);
            u32x2 ubo[TB / 4];
            const LAS float* abd = ABT; asm volatile("" : "+v"(abd));
            const LAS float* abq = ABT + 128 * pq; asm volatile("" : "+v"(abq));
            f32x4 dc[3], a0c[4], a1c[4];
            auto ldg = [&](int g, f32x4 (&dd)[3], f32x4 (&aa0)[4], f32x4 (&aa1)[4]) {
#pragma unroll
                for (int x = 0; x < 3; ++x) dd[x] = *(const LAS f32x4*)(abd + (4 * g + 1 + x) * 32 + 4 * g);
#pragma unroll
                for (int jj = 0; jj < 4; ++jj) { if (g < 3) aa0[jj] = *(const LAS f32x4*)(abq + jj * 32 + 4 * g); if (g < 7) aa1[jj] = *(const LAS f32x4*)(abq + (16 + jj) * 32 + 4 * g); } };
            ldg(0, dc, a0c, a1c);
#pragma unroll
            for (int g = 0; g < TB / 4; ++g) {
                f32x4 dn[3], a0n[4], a1n[4];
                if (g + 1 < TB / 4) ldg(g + 1, dn, a0n, a1n);
                __builtin_amdgcn_sched_barrier(0);
                const f32x4 rr = g < 4 ? r0 : r1;
                f32x4 u4;
                u4[0] = rr[0];
                u4[1] = rr[1] - u4[0] * dc[0][0];
                u4[2] = rr[2] - (u4[0] * dc[1][0] + u4[1] * dc[1][1]);
                u4[3] = rr[3] - (u4[0] * dc[2][0] + u4[1] * dc[2][1] + u4[2] * dc[2][2]);
#pragma unroll
                for (int x = 0; x < 4; ++x) { const int ui = __float_as_int(u4[x]); int bi;
                    if ((g & 3) == 0) bi = __builtin_amdgcn_update_dpp(0, ui, 0x00, 0xF, 0xF, true); else if ((g & 3) == 1) bi = __builtin_amdgcn_update_dpp(0, ui, 0x55, 0xF, 0xF, true);
                    else if ((g & 3) == 2) bi = __builtin_amdgcn_update_dpp(0, ui, 0xAA, 0xF, 0xF, true); else bi = __builtin_amdgcn_update_dpp(0, ui, 0xFF, 0xF, 0xF, true);
                    u4[x] = __int_as_float(bi); }
                ubo[g].x = cvt_pk_bf16(u4[0], u4[1]); ubo[g].y = cvt_pk_bf16(u4[2], u4[3]);
                if (g < 3) {
#pragma unroll
                    for (int jj = 0; jj < 4; ++jj) r0[jj] -= u4[0] * a0c[jj][0] + u4[1] * a0c[jj][1] + u4[2] * a0c[jj][2] + u4[3] * a0c[jj][3]; }
                if (g < 7) {
#pragma unroll
                    for (int jj = 0; jj < 4; ++jj) r1[jj] -= u4[0] * a1c[jj][0] + u4[1] * a1c[jj][1] + u4[2] * a1c[jj][2] + u4[3] * a1c[jj][3]; }
                if (g + 1 < TB / 4) {
#pragma unroll
                    for (int x = 0; x < 3; ++x) dc[x] = dn[x];
#pragma unroll
                    for (int jj = 0; jj < 4; ++jj) { a0c[jj] = a0n[jj]; a1c[jj] = a1n[jj]; } }
            }
            if (pq == 0) {
#pragma unroll
                for (int g = 0; g < TB / 4; g += 2) { u32x4 w; w.x = ubo[g].x; w.y = ubo[g].y; w.z = ubo[g + 1].x; w.w = ubo[g + 1].y; *(LAS u32x4*)(UB + v * 40 + 4 * g) = w; } }
        }
        __syncthreads();
        if (MODE == 5) continue;
        {
            const bf16x8 ua = ldsb8(UB + (rt * 16 + fr) * 40 + fq * 8), va = ldsb8(VT + (rt * 16 + fr) * 40 + fq * 8);
            accY = __builtin_amdgcn_mfma_f32_16x16x32_bf16(ua, ldsb8(NBT + (ctg * 16 + fr) * 40 + fq * 8), accY, 0, 0, 0);
            *(LAS f32x4*)(YO + (ctg * 16 + fr) * 64 + rt * 16 + fq * 4) = accY;
#pragma unroll
            for (int cc = 0; cc < 2; ++cc) { const int ct = 2 * (wid & 1) + cc, kcol = ct * 16 + fr;
                f32x4 acc = Sreg[cc];
                acc = __builtin_amdgcn_mfma_f32_16x16x32_bf16(ua, ldsb8(BST + kcol * 40 + fq * 8), acc, 0, 0, 0);
                acc = __builtin_amdgcn_mfma_f32_16x16x32_bf16(va, ldsb8(KDST + kcol * 40 + fq * 8), acc, 0, 0, 0);
                const float g = GC[kcol];
#pragma unroll
                for (int i = 0; i < 4; ++i) acc[i] *= g;
                { const unsigned p0 = cvt_pk_bf16(acc[0], acc[1]), p1 = cvt_pk_bf16(acc[2], acc[3]); LAS bf16_t* sp = S0B + (rt * 16 + fq * 4) * 72 + kcol;
                  sp[0] = (bf16_t)p0; sp[72] = (bf16_t)(p0 >> 16); sp[144] = (bf16_t)p1; sp[216] = (bf16_t)(p1 >> 16); }
                Sreg[cc] = acc; }
        }
        __syncthreads();
        if (!isctx) {
            const int j = tid >> 4, c4 = (tid & 15) * 4, t = d == 0 ? j : TB - 1 - j; const f32x4 y = *(const LAS f32x4*)(YO + j * 64 + c4);
            u32x2 w; w.x = cvt_pk_bf16(y[0], y[1]); w.y = cvt_pk_bf16(y[2], y[3]);
            bf16_t* yb_ = p.Y + ((size_t)d * nlat + grow0) * RW + h * 64;
            *(u32x2*)(yb_ + t * RW + c4) = w;
            if (tid < TB) { const int tt = d == 0 ? tid : TB - 1 - tid; float* bb_ = p.bon + ((size_t)d * nlat + grow0) * NH + h; bb_[tt * NH] = BON[tid]; }
        }
    }
}
template <int MODE = 0>
__device__ __forceinline__ void rwkv_phase2(LAS unsigned char* lds, const In& in, const RwkvP p, int bid, int nblk) {
    const int nchain = 2 * p.nb * NH;
    for (int c = bid; c < nchain; c += nblk) { rwkv_chain2<MODE>(lds, in, p, c); __syncthreads(); }
}
}

namespace mk {
namespace r3 {
constexpr int C2_RAW = 0;
constexpr int C2_MU = C2_RAW + (TB + 2) * RAWW * 2;
constexpr int C2_WUP = C2_MU + 2 * RAWW * 4;
constexpr int C2_AUP = C2_WUP + 64 * 72 * 2;
constexpr int C2_CST = C2_AUP + 64 * 72 * 2;
constexpr int C2_AWD = C2_CST + 5 * 64 * 4;
constexpr int C2_AAD = C2_AWD + TB * 72 * 2;
constexpr int C2_X = C2_AAD + TB * 72 * 2;
constexpr int C2_G = C2_X;
constexpr int C2_UB = C2_G + 64 * 36 * 4;
constexpr int C2_ABT = C2_UB + 64 * 40 * 2;
constexpr int C2_AKT = C2_ABT + 32 * 32 * 4;
constexpr int C2_NBT = C2_AKT + 32 * 40 * 2;
constexpr int C2_NKT = C2_NBT + 32 * 40 * 2;
constexpr int C2_YO = C2_NKT + 32 * 40 * 2;
constexpr int C2_X_END = C2_YO + TB * 64 * 4;
constexpr int C2_LA = C2_X, C2_CUM = C2_LA + TB * 64 * 4;
static_assert(C2_CUM + TB * 64 * 4 <= C2_YO, "LA/CUM overlay");
constexpr int C2_KKS = C2_X_END;
constexpr int C2_BS = C2_KKS + TB * 72 * 2, C2_KDS = C2_BS + TB * 72 * 2, C2_RS = C2_KDS + TB * 72 * 2;
constexpr int C2_BST = C2_RS + TB * 72 * 2;
constexpr int C2_KDST = C2_BST + 64 * 40 * 2;
constexpr int C2_VT = C2_KDST + 64 * 40 * 2;
constexpr int C2_S0B = C2_VT + 64 * 40 * 2;
constexpr int C2_GC = C2_S0B + 64 * 72 * 2;
constexpr int C2_BON = C2_GC + 64 * 4;
constexpr int C2_RB = C2_BON + TB * 4;
constexpr int C2_KRB = C2_RB + TB * 64 * 2, C2_VB = C2_KRB + TB * 64 * 2;
constexpr int C2_END = C2_VB + TB * 64 * 2;
static_assert(C2_END <= LDS_BYTES - 16 && (C2_X % 16) == 0 && (C2_KKS % 16) == 0 && (C2_G % 16) == 0 && (C2_UB % 16) == 0 && (C2_ABT % 16) == 0 && (C2_AKT % 16) == 0 && (C2_S0B % 16) == 0, "rwkv2 LDS");

__device__ __forceinline__ bf16x8 ldsb8(const LAS bf16_t* p) { return *(const LAS bf16x8*)p; }

template <int MODE>
__device__ __forceinline__ void rwkv_chain3(LAS unsigned char* lds, const In& in, const RwkvP p, int chain) {
    const int tid = threadIdx.x, lane = tid & 63, wid = tid >> 6, fr = lane & 15, fq = lane >> 4;
    const int d = chain / (p.nb * NH), bl = (chain / NH) % p.nb, h = chain % NH;
    const int nlat = p.nb * SEQ;
    LAS bf16_t* RAW = (LAS bf16_t*)(lds + C2_RAW); LAS float* MU = (LAS float*)(lds + C2_MU);
    LAS bf16_t* WUP = (LAS bf16_t*)(lds + C2_WUP); LAS bf16_t* AUP = (LAS bf16_t*)(lds + C2_AUP); LAS float* CST = (LAS float*)(lds + C2_CST);
    LAS bf16_t* AWD = (LAS bf16_t*)(lds + C2_AWD); LAS bf16_t* AAD = (LAS bf16_t*)(lds + C2_AAD);
    LAS bf16_t *Rb = (LAS bf16_t*)(lds + C2_RB), *KRb = (LAS bf16_t*)(lds + C2_KRB), *Vb = (LAS bf16_t*)(lds + C2_VB); LAS float *LA_ = (LAS float*)(lds + C2_LA), *CUM = (LAS float*)(lds + C2_CUM);
    LAS float *YO = (LAS float*)(lds + C2_YO), *Gm = (LAS float*)(lds + C2_G), *ABT = (LAS float*)(lds + C2_ABT), *GC = (LAS float*)(lds + C2_GC), *BON = (LAS float*)(lds + C2_BON);
    LAS bf16_t *UB = (LAS bf16_t*)(lds + C2_UB), *AKT = (LAS bf16_t*)(lds + C2_AKT), *NBT = (LAS bf16_t*)(lds + C2_NBT), *NKT = (LAS bf16_t*)(lds + C2_NKT);
    LAS bf16_t *KKS = (LAS bf16_t*)(lds + C2_KKS), *BS = (LAS bf16_t*)(lds + C2_BS), *KDS = (LAS bf16_t*)(lds + C2_KDS), *RS = (LAS bf16_t*)(lds + C2_RS);
    LAS bf16_t *BST = (LAS bf16_t*)(lds + C2_BST), *KDST = (LAS bf16_t*)(lds + C2_KDST), *VT = (LAS bf16_t*)(lds + C2_VT), *S0B = (LAS bf16_t*)(lds + C2_S0B);
    auto segcol = [&](int s) __attribute__((always_inline)) { return s < 3 ? s * RW + h * 64 : (s == 3 ? OFF_WD + d * DL : OFF_AD + d * AL); };
    for (int i = tid; i < 2 * RAWW; i += NT) { const int m = i / RAWW, c = i % RAWW; MU[i] = in.shift_mu[m * RC + segcol(c >> 6) + (c & 63)]; }
    for (int i = tid; i < 64 * 64; i += NT) { const int j = i >> 6, c = i & 63;
        WUP[c * 72 + j] = f2bf(in.rw_w_up[((size_t)d * DL + j) * RW + h * 64 + c]); AUP[c * 72 + j] = f2bf(in.rw_a_up[((size_t)d * AL + j) * RW + h * 64 + c]); }
    for (int i = tid; i < 64; i += NT) { CST[i] = in.rw_w0[d * RW + h * 64 + i]; CST[64 + i] = in.rw_a0[d * RW + h * 64 + i]; CST[128 + i] = in.rw_k_k[h * 64 + i]; CST[192 + i] = in.rw_k_a[h * 64 + i]; CST[256 + i] = in.rw_r_k[h * 64 + i]; }
    for (int i = tid; i < 64 * 72 / 2; i += NT) ((LAS unsigned*)S0B)[i] = 0u;
    constexpr int NQ = (CTX + SEQ) / TB, NQC = CTX / TB;
    auto blk_info = [&](int q, bool& isctx, int& t0, bool& hp, bool& hn, size_t& grow0) __attribute__((always_inline)) {
        isctx = q < NQC;
        if (isctx) { const int qq = d == 0 ? q : NQC - 1 - q; t0 = qq * TB; hp = t0 > 0; hn = t0 + TB < CTX; grow0 = (size_t)nlat + (size_t)bl * CTX + t0; }
        else { const int ql = q - NQC, qq = d == 0 ? ql : SEQ / TB - 1 - ql; t0 = qq * TB; hp = (t0 % GW) != 0; hn = ((t0 + TB) % GW) != 0; grow0 = (size_t)bl * SEQ + t0; }
    };
    u32x4 pre[RW_PPT]; int poff[RW_PPT], plds[RW_PPT];
#pragma unroll
    for (int k = 0; k < RW_PPT; ++k) { const int i = tid + k * NT, rr = i / 40, sp = i % 40, seg = sp >> 3, part = sp & 7;
        poff[k] = (rr - 1) * Z1_N + segcol(seg) + part * 8; plds[k] = (rr * RAWW + sp * 8) | (i >= RW_NPIECE ? 3 : (rr == 0 ? 1 : (rr == TB + 1 ? 2 : 0))); }
    auto prefetch = [&](int q) __attribute__((always_inline)) {
        bool isctx, hp, hn; int t0; size_t grow0; blk_info(q, isctx, t0, hp, hn, grow0);
        const bf16_t* base = p.z1 + grow0 * Z1_N;
#pragma unroll
        for (int k = 0; k < RW_PPT; ++k) { u32x4 v = (u32x4){0u, 0u, 0u, 0u};
            const int kind = plds[k] & 3; const bool ok = kind == 0 || (kind == 1 && hp) || (kind == 2 && hn);
            if (ok) v = *(const u32x4*)(base + poff[k]);
            pre[k] = v; }
    };
    auto commit = [&]() __attribute__((always_inline)) {
#pragma unroll
        for (int k = 0; k < RW_PPT; ++k) if ((plds[k] & 3) != 3) *(LAS u32x4*)(RAW + (plds[k] & ~3)) = pre[k];
    };
    f32x4 Sreg[2];
    Sreg[0] = (f32x4){0.f, 0.f, 0.f, 0.f}; Sreg[1] = Sreg[0];
    const int rt = wid >> 1;
    auto shift8 = [&](int t, int c0, float (&s)[8]) __attribute__((always_inline)) {
        const u32x4 xp = *(const LAS u32x4*)(RAW + t * RAWW + c0), xc = *(const LAS u32x4*)(RAW + (t + 1) * RAWW + c0), xn_ = *(const LAS u32x4*)(RAW + (t + 2) * RAWW + c0);
        const f32x4 m0a = *(const LAS f32x4*)(MU + c0), m0b = *(const LAS f32x4*)(MU + c0 + 4), m1a = *(const LAS f32x4*)(MU + RAWW + c0), m1b = *(const LAS f32x4*)(MU + RAWW + c0 + 4);
#define MK_SH1(J, XP, XC, XN, M0L, M0H, M1L, M1H) { const float xl = bflo(XC), xh = bfhi(XC); s[2 * J] = xl + M0L * (bflo(XP) - xl) + M1L * (bflo(XN) - xl); s[2 * J + 1] = xh + M0H * (bfhi(XP) - xh) + M1H * (bfhi(XN) - xh); }
        MK_SH1(0, xp.x, xc.x, xn_.x, m0a.x, m0a.y, m1a.x, m1a.y) MK_SH1(1, xp.y, xc.y, xn_.y, m0a.z, m0a.w, m1a.z, m1a.w)
        MK_SH1(2, xp.z, xc.z, xn_.z, m0b.x, m0b.y, m1b.x, m1b.y) MK_SH1(3, xp.w, xc.w, xn_.w, m0b.z, m0b.w, m1b.z, m1b.w)
#undef MK_SH1
    };
    auto do_shift = [&](int tl, int nth) __attribute__((always_inline)) {
#pragma unroll 1
        for (int it = tl; it < TB * 24; it += nth) {
            const int t = it / 24, g = it % 24, seg = g >> 3, cc = (g & 7) * 8, js = d == 0 ? t : TB - 1 - t; float s[8]; shift8(t, g * 8, s);
            LAS bf16_t* dst = Rb + seg * (TB * 64) + js * 64 + cc;
            u32x4 w; w.x = cvt_pk_bf16(s[0], s[1]); w.y = cvt_pk_bf16(s[2], s[3]); w.z = cvt_pk_bf16(s[4], s[5]); w.w = cvt_pk_bf16(s[6], s[7]); *(LAS u32x4*)dst = w;
        }
#pragma unroll 1
        for (int it = tl; it < TB * 16; it += nth) { const int t = it >> 4, g = 24 + (it & 15), cc = (g & 7) * 8, js = d == 0 ? t : TB - 1 - t; float s[8]; shift8(t, g * 8, s);
            const bool isw = (it & 15) < 8;
#pragma unroll
            for (int j = 0; j < 8; ++j) { const float th = fast_tanh(s[j]); s[j] = isw ? th : s[j]; }
            LAS bf16_t* dst = AWD + (isw ? 0 : TB * 72) + js * 72 + cc;
            u32x4 w; w.x = cvt_pk_bf16(s[0], s[1]); w.y = cvt_pk_bf16(s[2], s[3]); w.z = cvt_pk_bf16(s[4], s[5]); w.w = cvt_pk_bf16(s[6], s[7]); *(LAS u32x4*)dst = w; }
    };
    prefetch(0);
    commit();
    __syncthreads();
    if (1 < NQ) prefetch(1);
    do_shift(tid & (NT / 2 - 1), NT / 2);
    __syncthreads();
    for (int q = 0; q < NQ; ++q) {
        bool isctx, hp, hn; int t0; size_t grow0; blk_info(q, isctx, t0, hp, hn, grow0);
        {
            const int lora = wid >> 2, ct = wid & 3;
            const LAS bf16_t* Am = lora ? AAD : AWD; const LAS bf16_t* Bm = lora ? AUP : WUP;
            float carry = 0.f;
#pragma unroll
            for (int r2 = 0; r2 < 2; ++r2) {
                f32x4 acc = (f32x4){0.f, 0.f, 0.f, 0.f};
#pragma unroll
                for (int ks = 0; ks < 2; ++ks) acc = __builtin_amdgcn_mfma_f32_16x16x32_bf16(ldsb8(Am + (r2 * 16 + fr) * 72 + ks * 32 + fq * 8), ldsb8(Bm + (ct * 16 + fr) * 72 + ks * 32 + fq * 8), acc, 0, 0, 0);
                const int col = ct * 16 + fr;
                if (lora == 0) {
                    float c[4];
#pragma unroll
                    for (int i = 0; i < 4; ++i) { const float lw = acc[i] + CST[col]; const float e = __expf(-fast_softplus(-lw) - 0.5f); c[i] = i ? c[i - 1] + e : e; }
                    const float tot = c[3];
                    float s1 = tot; { const float y = __shfl_up(s1, 16); s1 += fq >= 1 ? y : 0.f; }
                    float s2 = s1;  { const float z = __shfl_up(s1, 32); s2 += fq >= 2 ? z : 0.f; }
                    const float base = carry + s2 - tot;
#pragma unroll
                    for (int i = 0; i < 4; ++i) CUM[(r2 * 16 + fq * 4 + i) * 64 + col] = base + c[i];
                    carry += __shfl(s2, 48 + fr);
                } else {
#pragma unroll
                    for (int i = 0; i < 4; ++i) LA_[(r2 * 16 + fq * 4 + i) * 64 + col] = fast_sigmoid(acc[i] + CST[64 + col]);
                }
            }
        }
        __syncthreads();
        {
            const int j = tid >> 4, c4 = (tid & 15) * 4;
            const u32x2 kp = *(const LAS u32x2*)(KRb + j * 64 + c4), rp = *(const LAS u32x2*)(Rb + j * 64 + c4), vp = *(const LAS u32x2*)(Vb + j * 64 + c4);
            const f32x4 k = (f32x4){bflo(kp.x), bfhi(kp.x), bflo(kp.y), bfhi(kp.y)}, r = (f32x4){bflo(rp.x), bfhi(rp.x), bflo(rp.y), bfhi(rp.y)}, vv = (f32x4){bflo(vp.x), bfhi(vp.x), bflo(vp.y), bfhi(vp.y)};
            const f32x4 a = *(const LAS f32x4*)(LA_ + j * 64 + c4);
            const f32x4 cu = *(const LAS f32x4*)(CUM + j * 64 + c4); f32x4 cp = (f32x4){0.f, 0.f, 0.f, 0.f}; if (j > 0) cp = *(const LAS f32x4*)(CUM + (j - 1) * 64 + c4);
            float kkr[4], ss = 0.f, bn = 0.f;
#pragma unroll
            for (int x = 0; x < 4; ++x) { kkr[x] = k[x] * CST[128 + c4 + x]; ss += kkr[x] * kkr[x]; }
            ss = allreduce16(ss);
            const float inv = 1.f / fmaxf(sqrtf(ss), 1e-12f);
            float kks[4], bs[4], kds[4], rs[4];
#pragma unroll
            for (int x = 0; x < 4; ++x) { const float kk = kkr[x] * inv, kd = k[x] * (1.f + (a[x] - 1.f) * CST[192 + c4 + x]), bb = kk * a[x];
                const float g = __expf(-cu[x]), gp = __expf(-cp[x]), ig = __expf(cu[x]);
                kks[x] = kk * gp; bs[x] = bb * ig; kds[x] = kd * ig; rs[x] = r[x] * g; bn += r[x] * kd * CST[256 + c4 + x];
                if (j == TB - 1) GC[c4 + x] = g;
            }
#pragma unroll
            for (int x = 0; x < 4; x += 2) { const unsigned pb = cvt_pk_bf16(bs[x], bs[x + 1]), pk = cvt_pk_bf16(kds[x], kds[x + 1]), pv = cvt_pk_bf16(vv[x], vv[x + 1]);
                BST[(c4 + x) * 40 + j] = (bf16_t)pb; BST[(c4 + x + 1) * 40 + j] = (bf16_t)(pb >> 16); KDST[(c4 + x) * 40 + j] = (bf16_t)pk; KDST[(c4 + x + 1) * 40 + j] = (bf16_t)(pk >> 16);
                VT[(c4 + x) * 40 + j] = (bf16_t)pv; VT[(c4 + x + 1) * 40 + j] = (bf16_t)(pv >> 16); }
            bn = allreduce16(bn);
            u32x2 w; w.x = cvt_pk_bf16(kks[0], kks[1]); w.y = cvt_pk_bf16(kks[2], kks[3]); *(LAS u32x2*)(KKS + j * 72 + c4) = w;
            w.x = cvt_pk_bf16(bs[0], bs[1]); w.y = cvt_pk_bf16(bs[2], bs[3]); *(LAS u32x2*)(BS + j * 72 + c4) = w;
            w.x = cvt_pk_bf16(kds[0], kds[1]); w.y = cvt_pk_bf16(kds[2], kds[3]); *(LAS u32x2*)(KDS + j * 72 + c4) = w;
            w.x = cvt_pk_bf16(rs[0], rs[1]); w.y = cvt_pk_bf16(rs[2], rs[3]); *(LAS u32x2*)(RS + j * 72 + c4) = w;
            if ((tid & 15) == 0) BON[j] = bn;
        }
        __syncthreads();
        const int ctg = wid & 1;
        f32x4 accG = (f32x4){0.f, 0.f, 0.f, 0.f}, accY = accG;
        {
            const int pr = wid >> 1, rts = wid & 1;
            const LAS bf16_t* Xm = (pr & 1) ? KDS : BS; const LAS bf16_t* Ym = (pr < 2) ? KKS : RS;
            const bf16x8 a0 = ldsb8(Xm + (rts * 16 + fr) * 72 + fq * 8), a1 = ldsb8(Xm + (rts * 16 + fr) * 72 + 32 + fq * 8);
#pragma unroll
            for (int cts = 0; cts < 2; ++cts) {
                f32x4 acc = (f32x4){0.f, 0.f, 0.f, 0.f};
                acc = __builtin_amdgcn_mfma_f32_16x16x32_bf16(a0, ldsb8(Ym + (cts * 16 + fr) * 72 + fq * 8), acc, 0, 0, 0);
                acc = __builtin_amdgcn_mfma_f32_16x16x32_bf16(a1, ldsb8(Ym + (cts * 16 + fr) * 72 + 32 + fq * 8), acc, 0, 0, 0);
                const int t = cts * 16 + fr, s0 = rts * 16 + fq * 4;
#pragma unroll
                for (int i = 0; i < 4; ++i) { const bool keep = (pr < 2) ? (s0 + i < t) : (s0 + i <= t); acc[i] = keep ? acc[i] : 0.f; }
                if (pr == 0) *(LAS f32x4*)(ABT + t * 32 + s0) = acc;
                else { u32x2 w; w.x = cvt_pk_bf16(acc[0], acc[1]); w.y = cvt_pk_bf16(acc[2], acc[3]); *(LAS u32x2*)((pr == 1 ? AKT : (pr == 2 ? NBT : NKT)) + t * 40 + s0) = w; }
            }
#pragma unroll
            for (int ks = 0; ks < 2; ++ks) { const bf16x8 sa = ldsb8(S0B + (rt * 16 + fr) * 72 + ks * 32 + fq * 8);
                accG = __builtin_amdgcn_mfma_f32_16x16x32_bf16(sa, ldsb8(KKS + (ctg * 16 + fr) * 72 + ks * 32 + fq * 8), accG, 0, 0, 0);
                accY = __builtin_amdgcn_mfma_f32_16x16x32_bf16(sa, ldsb8(RS + (ctg * 16 + fr) * 72 + ks * 32 + fq * 8), accY, 0, 0, 0); }
        }
        __syncthreads();
        {
            const bf16x8 va = ldsb8(VT + (rt * 16 + fr) * 40 + fq * 8);
            accG = __builtin_amdgcn_mfma_f32_16x16x32_bf16(va, ldsb8(AKT + (ctg * 16 + fr) * 40 + fq * 8), accG, 0, 0, 0);
            accY = __builtin_amdgcn_mfma_f32_16x16x32_bf16(va, ldsb8(NKT + (ctg * 16 + fr) * 40 + fq * 8), accY, 0, 0, 0);
#pragma unroll
            for (int i = 0; i < 4; ++i) Gm[(rt * 16 + fq * 4 + i) * 36 + ctg * 16 + fr] = -accG[i];
            if (q + 1 < NQ) { commit(); if (q + 2 < NQ) prefetch(q + 2); }
        }
        __syncthreads();
        if (wid >= 4) { if (q + 1 < NQ) do_shift(tid & (NT / 2 - 1), NT / 2); }
        else {
            const int v = wid * 16 + (lane >> 2), pq = lane & 3;
            const LAS float* grow = Gm + v * 36;
            f32x4 r0 = *(const LAS f32x4*)(grow + 4 * pq), r1 = *(const LAS f32x4*)(grow + 16 + 4 * pq);
            u32x2 ubo[TB / 4];
            const LAS float* abd = ABT; asm volatile("" : "+v"(abd));
            const LAS float* abq = ABT + 128 * pq; asm volatile("" : "+v"(abq));
            f32x4 dc[3], a0c[4], a1c[4];
            auto ldg = [&](int g, f32x4 (&dd)[3], f32x4 (&aa0)[4], f32x4 (&aa1)[4]) {
#pragma unroll
                for (int x = 0; x < 3; ++x) dd[x] = *(const LAS f32x4*)(abd + (4 * g + 1 + x) * 32 + 4 * g);
#pragma unroll
                for (int jj = 0; jj < 4; ++jj) { if (g < 3) aa0[jj] = *(const LAS f32x4*)(abq + jj * 32 + 4 * g); if (g < 7) aa1[jj] = *(const LAS f32x4*)(abq + (16 + jj) * 32 + 4 * g); } };
            ldg(0, dc, a0c, a1c);
#pragma unroll
            for (int g = 0; g < TB / 4; ++g) {
                f32x4 dn[3], a0n[4], a1n[4];
                if (g + 1 < TB / 4) ldg(g + 1, dn, a0n, a1n);
                __builtin_amdgcn_sched_barrier(0);
                const f32x4 rr = g < 4 ? r0 : r1;
                f32x4 u4;
                u4[0] = rr[0];
                u4[1] = rr[1] - u4[0] * dc[0][0];
                u4[2] = rr[2] - (u4[0] * dc[1][0] + u4[1] * dc[1][1]);
                u4[3] = rr[3] - (u4[0] * dc[2][0] + u4[1] * dc[2][1] + u4[2] * dc[2][2]);
#pragma unroll
                for (int x = 0; x < 4; ++x) { const int ui = __float_as_int(u4[x]); int bi;
                    if ((g & 3) == 0) bi = __builtin_amdgcn_update_dpp(0, ui, 0x00, 0xF, 0xF, true); else if ((g & 3) == 1) bi = __builtin_amdgcn_update_dpp(0, ui, 0x55, 0xF, 0xF, true);
                    else if ((g & 3) == 2) bi = __builtin_amdgcn_update_dpp(0, ui, 0xAA, 0xF, 0xF, true); else bi = __builtin_amdgcn_update_dpp(0, ui, 0xFF, 0xF, 0xF, true);
                    u4[x] = __int_as_float(bi); }
                ubo[g].x = cvt_pk_bf16(u4[0], u4[1]); ubo[g].y = cvt_pk_bf16(u4[2], u4[3]);
                if (g < 3) {
#pragma unroll
                    for (int jj = 0; jj < 4; ++jj) r0[jj] -= u4[0] * a0c[jj][0] + u4[1] * a0c[jj][1] + u4[2] * a0c[jj][2] + u4[3] * a0c[jj][3]; }
                if (g < 7) {
#pragma unroll
                    for (int jj = 0; jj < 4; ++jj) r1[jj] -= u4[0] * a1c[jj][0] + u4[1] * a1c[jj][1] + u4[2] * a1c[jj][2] + u4[3] * a1c[jj][3]; }
                if (g + 1 < TB / 4) {
#pragma unroll
                    for (int x = 0; x < 3; ++x) dc[x] = dn[x];
#pragma unroll
                    for (int jj = 0; jj < 4; ++jj) { a0c[jj] = a0n[jj]; a1c[jj] = a1n[jj]; } }
            }
            if (pq == 0) {
#pragma unroll
                for (int g = 0; g < TB / 4; g += 2) { u32x4 w; w.x = ubo[g].x; w.y = ubo[g].y; w.z = ubo[g + 1].x; w.w = ubo[g + 1].y; *(LAS u32x4*)(UB + v * 40 + 4 * g) = w; } }
        }
        __syncthreads();
        {
            const bf16x8 ua = ldsb8(UB + (rt * 16 + fr) * 40 + fq * 8), va = ldsb8(VT + (rt * 16 + fr) * 40 + fq * 8);
            accY = __builtin_amdgcn_mfma_f32_16x16x32_bf16(ua, ldsb8(NBT + (ctg * 16 + fr) * 40 + fq * 8), accY, 0, 0, 0);
            *(LAS f32x4*)(YO + (ctg * 16 + fr) * 64 + rt * 16 + fq * 4) = accY;
#pragma unroll
            for (int cc = 0; cc < 2; ++cc) { const int ct = 2 * (wid & 1) + cc, kcol = ct * 16 + fr;
                f32x4 acc = Sreg[cc];
                acc = __builtin_amdgcn_mfma_f32_16x16x32_bf16(ua, ldsb8(BST + kcol * 40 + fq * 8), acc, 0, 0, 0);
                acc = __builtin_amdgcn_mfma_f32_16x16x32_bf16(va, ldsb8(KDST + kcol * 40 + fq * 8), acc, 0, 0, 0);
                const float g = GC[kcol];
#pragma unroll
                for (int i = 0; i < 4; ++i) acc[i] *= g;
                { const unsigned p0 = cvt_pk_bf16(acc[0], acc[1]), p1 = cvt_pk_bf16(acc[2], acc[3]); LAS bf16_t* sp = S0B + (rt * 16 + fq * 4) * 72 + kcol;
                  sp[0] = (bf16_t)p0; sp[72] = (bf16_t)(p0 >> 16); sp[144] = (bf16_t)p1; sp[216] = (bf16_t)(p1 >> 16); }
                Sreg[cc] = acc; }
        }
        __syncthreads();
        if (!isctx) {
            const int j = tid >> 4, c4 = (tid & 15) * 4, t = d == 0 ? j : TB - 1 - j; const f32x4 y = *(const LAS f32x4*)(YO + j * 64 + c4);
            u32x2 w; w.x = cvt_pk_bf16(y[0], y[1]); w.y = cvt_pk_bf16(y[2], y[3]);
            bf16_t* yb_ = p.Y + ((size_t)d * nlat + grow0) * RW + h * 64;
            *(u32x2*)(yb_ + t * RW + c4) = w;
            if (tid < TB) { const int tt = d == 0 ? tid : TB - 1 - tid; float* bb_ = p.bon + ((size_t)d * nlat + grow0) * NH + h; bb_[tt * NH] = BON[tid]; }
        }
    }
}
template <int MODE = 0>
__device__ __forceinline__ void rwkv_phase3(LAS unsigned char* lds, const In& in, const RwkvP p, int bid, int nblk) {
    const int nchain = 2 * p.nb * NH;
    for (int c = bid; c < nchain; c += nblk) { rwkv_chain3<MODE>(lds, in, p, c); __syncthreads(); }
}
}
}

namespace mk {
constexpr int LR_XT = 0;
constexpr int LR_XC = LR_XT + 67 * 64 * 2 + 64;
constexpr int LR_XCB = LR_XC + 64 * 64 * 4;
constexpr int LR_GWT = LR_XCB + 64 * 72 * 2;
constexpr int LR_A = LR_GWT + 2 * 64 * 72 * 2;
constexpr int LR_BX = LR_A + 64 * 64 * 4;
constexpr int LR_HO = LR_BX + 64 * 64 * 4;
constexpr int LR_CST = LR_HO + 64 * 64 * 4;
constexpr int LR_SEGP = LR_CST + 8 * 64 * 4;
constexpr int LR_SEGH = LR_SEGP + 8 * 64 * 4;
constexpr int LR_HC = LR_SEGH + 8 * 64 * 4;
constexpr int LR_END = LR_HC + 64 * 4;
static_assert(LR_END <= LDS_BYTES && (LR_XC % 16) == 0, "lru LDS");

struct LruP { const bf16_t* z1; bf16_t* Hd; int b0, nb; };

__device__ __forceinline__ void lru_item(LAS unsigned char* lds, const In& in, const LruP p, int item) {
    const int tid = threadIdx.x, lane = tid & 63, wid = tid >> 6;
    const int d = item / (p.nb * LB), bl = (item / LB) % p.nb, n = item % LB;
    const int nlat = p.nb * SEQ;
    LAS bf16_t* XT = (LAS bf16_t*)(lds + LR_XT); LAS float* XC = (LAS float*)(lds + LR_XC); LAS bf16_t* XCB = (LAS bf16_t*)(lds + LR_XCB); LAS bf16_t* GWT = (LAS bf16_t*)(lds + LR_GWT);
    LAS float *A_ = (LAS float*)(lds + LR_A), *BX = (LAS float*)(lds + LR_BX), *HO = (LAS float*)(lds + LR_HO), *CST = (LAS float*)(lds + LR_CST), *SEGP = (LAS float*)(lds + LR_SEGP), *SEGH = (LAS float*)(lds + LR_SEGH), *HC = (LAS float*)(lds + LR_HC);
    for (int i = tid; i < 2 * 64 * 64; i += NT) { const int g = i >> 12, j = (i >> 6) & 63, k = i & 63;
        GWT[(g * 64 + k) * 72 + j] = f2bf(in.lru_gate_w[((((size_t)d * 2 + g) * LB + n) * LBS + j) * LBS + k]); }
    for (int i = tid; i < 64; i += NT) { const int c = n * 64 + i;
        CST[i] = in.lru_conv_w[c]; CST[64 + i] = in.lru_conv_w[LW + c]; CST[128 + i] = in.lru_conv_w[2 * LW + c]; CST[192 + i] = in.lru_conv_w[3 * LW + c]; CST[256 + i] = in.lru_conv_b[c];
        CST[320 + i] = in.lru_gate_b[((d * 2 + 0) * LB + n) * LBS + i]; CST[384 + i] = in.lru_gate_b[((d * 2 + 1) * LB + n) * LBS + i]; CST[448 + i] = softplusf_(-in.lru_l[d * LW + c]); }
    constexpr int NSEG = CTX / 64 + GW, NSC = CTX / 64;
    u32x4 pre[2];
    auto tok_row = [&](int sidx, int rr, bool& ok) -> size_t {
        if (sidx < NSC) { const int t = sidx * 64 + rr - 2; ok = t >= 0 && t < CTX; return (size_t)nlat + (size_t)bl * CTX + t; }
        const int col = sidx - NSC, row = rr - 2; ok = row >= 0 && row < ROWS; return (size_t)bl * SEQ + (size_t)row * GW + col;
    };
    auto seg_of = [&](int q) { if (q < NSC) return d == 0 ? q : NSC - 1 - q; const int ql = q - NSC; return NSC + (d == 0 ? ql : GW - 1 - ql); };
    auto prefetch = [&](int q) { const int sidx = seg_of(q);
#pragma unroll
        for (int k = 0; k < 2; ++k) { const int i = tid + k * NT; u32x4 v = (u32x4){0u, 0u, 0u, 0u};
            if (i < 67 * 8) { const int rr = i >> 3, part = i & 7; bool ok; const size_t gr = tok_row(sidx, rr, ok); if (ok) v = *(const u32x4*)(p.z1 + gr * Z1_N + Z1_LX + n * 64 + part * 8); }
            pre[k] = v; } };
    auto commit = [&]() {
#pragma unroll
        for (int k = 0; k < 2; ++k) { const int i = tid + k * NT; if (i < 67 * 8) *(LAS u32x4*)(XT + (i >> 3) * 64 + (i & 7) * 8) = pre[k]; } };
    if (tid < 64) HC[tid] = 0.f;
    prefetch(0);
    for (int q = 0; q < NSEG; ++q) {
        const int sidx = seg_of(q);
        commit();
        __syncthreads();
        if (q + 1 < NSEG) prefetch(q + 1);
        { const int t = tid >> 3, c0 = (tid & 7) * 8; float s[8];
#pragma unroll
          for (int j = 0; j < 8; ++j) s[j] = CST[256 + c0 + j];
#pragma unroll
          for (int tap = 0; tap < 4; ++tap) { const u32x4 x = *(const LAS u32x4*)(XT + (t + tap) * 64 + c0);
#pragma unroll
              for (int j = 0; j < 4; ++j) { s[2 * j] += CST[tap * 64 + c0 + 2 * j] * bflo(x[j]); s[2 * j + 1] += CST[tap * 64 + c0 + 2 * j + 1] * bfhi(x[j]); } }
          *(LAS f32x4*)(XC + t * 64 + c0) = (f32x4){s[0], s[1], s[2], s[3]}; *(LAS f32x4*)(XC + t * 64 + c0 + 4) = (f32x4){s[4], s[5], s[6], s[7]};
          u32x4 w; w.x = cvt_pk_bf16(s[0], s[1]); w.y = cvt_pk_bf16(s[2], s[3]); w.z = cvt_pk_bf16(s[4], s[5]); w.w = cvt_pk_bf16(s[6], s[7]); *(LAS u32x4*)(XCB + t * 72 + c0) = w; }
        __syncthreads();
        { const int rt = wid >> 1, fr = lane & 15, fq = lane >> 4;
          bf16x8 a[2];
#pragma unroll
          for (int ks = 0; ks < 2; ++ks) a[ks] = *(const LAS bf16x8*)(XCB + (rt * 16 + fr) * 72 + ks * 32 + fq * 8);
#pragma unroll
          for (int cc = 0; cc < 2; ++cc) { const int ct = 2 * (wid & 1) + cc, col = ct * 16 + fr;
              f32x4 acc0 = (f32x4){0.f, 0.f, 0.f, 0.f}, acc1 = acc0;
#pragma unroll
              for (int ks = 0; ks < 2; ++ks) {
                  const bf16x8 b0 = *(const LAS bf16x8*)(GWT + (0 * 64 + col) * 72 + ks * 32 + fq * 8), b1 = *(const LAS bf16x8*)(GWT + (1 * 64 + col) * 72 + ks * 32 + fq * 8);
                  acc0 = __builtin_amdgcn_mfma_f32_16x16x32_bf16(a[ks], b0, acc0, 0, 0, 0); acc1 = __builtin_amdgcn_mfma_f32_16x16x32_bf16(a[ks], b1, acc1, 0, 0, 0); }
#pragma unroll
              for (int i = 0; i < 4; ++i) { const int t = rt * 16 + fq * 4 + i;
                  const float rec = fast_sigmoid(acc0[i] + CST[320 + col]), inp = fast_sigmoid(acc1[i] + CST[384 + col]);
                  const float la = -8.f * rec * CST[448 + col];
                  const float av = __expf(la), x2 = 2.f * la; const float om = x2 > -0.03f ? -x2 * (1.f + x2 * (0.5f + x2 * (1.f / 6.f))) : 1.f - av * av;
                  A_[t * 64 + col] = av; BX[t * 64 + col] = __builtin_amdgcn_sqrtf(om) * inp * XC[t * 64 + col]; } } }
        __syncthreads();
        { const int ch = tid & 63, pc = tid >> 6; float av[8], bv[8]; float P = 1.f, H = 0.f;
#pragma unroll
          for (int x = 0; x < 8; ++x) { const int st = pc * 8 + x, t = d == 0 ? st : 63 - st; av[x] = A_[t * 64 + ch]; bv[x] = BX[t * 64 + ch]; H = av[x] * H + bv[x]; P *= av[x]; }
          SEGP[pc * 64 + ch] = P; SEGH[pc * 64 + ch] = H;
          __syncthreads();
          float h = HC[ch];
#pragma unroll
          for (int q2 = 0; q2 < 7; ++q2) if (q2 < pc) h = SEGP[q2 * 64 + ch] * h + SEGH[q2 * 64 + ch];
#pragma unroll
          for (int x = 0; x < 8; ++x) { const int st = pc * 8 + x, t = d == 0 ? st : 63 - st; h = av[x] * h + bv[x]; HO[t * 64 + ch] = h; }
          __syncthreads();
          if (pc == 7) HC[ch] = h;
        }
        if (sidx >= NSC) { const int col = sidx - NSC, t = tid >> 3, c0 = (tid & 7) * 8;
            const f32x4 x = *(const LAS f32x4*)(HO + t * 64 + c0), y = *(const LAS f32x4*)(HO + t * 64 + c0 + 4);
            *(u32x4*)(p.Hd + ((size_t)d * nlat + (size_t)bl * SEQ + (size_t)t * GW + col) * LW + n * 64 + c0) = pack8(x, y); }
    }
}
__device__ __forceinline__ void lru_phase(LAS unsigned char* lds, const In& in, const LruP p, int bid, int nblk) {
    const int nitem = 2 * p.nb * LB;
    for (int it = bid; it < nitem; it += nblk) { lru_item(lds, in, p, it); __syncthreads(); }
}
}

namespace mk {
#define MK_DPPX(x, ctrl) __int_as_float(__builtin_amdgcn_update_dpp(__float_as_int(x), __float_as_int(x), ctrl, 0xF, 0xF, false))
__device__ __forceinline__ float allreduce4(float x) { x += MK_DPPX(x, 0xB1); x += MK_DPPX(x, 0x4E); return x; }
__device__ __forceinline__ void unpack8(const u32x4 w, float (&f)[8]) {
#pragma unroll
    for (int j = 0; j < 4; ++j) { f[2 * j] = bflo(w[j]); f[2 * j + 1] = bfhi(w[j]); } }
constexpr int AG_K = 256;
struct PostP { const bf16_t* z1; bf16_t* Y; const float* bon; bf16_t* Ag; int nlat; int pad_; };
__device__ __forceinline__ void rwkv_post_rows(const In& in, const PostP p, int row_lo, int row_hi, bool dry = false) {
    const int lane = threadIdx.x & 63, wid = threadIdx.x >> 6, c0 = lane * 16, h = lane >> 2;
    float mu0v[16], mu1v[16], l0[16], l1[16], mg0[8], mg1[8];
#pragma unroll
    for (int j = 0; j < 16; ++j) { mu0v[j] = in.shift_mu[OFF_V + c0 + j]; mu1v[j] = in.shift_mu[RC + OFF_V + c0 + j]; l0[j] = in.rw_lnx[c0 + j]; l1[j] = in.rw_lnx[RW + c0 + j]; }
#pragma unroll
    for (int j = 0; j < 8; ++j) { const int c = OFF_GD + (lane < GL / 8 ? lane : 0) * 8 + j; mg0[j] = in.shift_mu[c]; mg1[j] = in.shift_mu[RC + c]; }
    for (int r = row_lo + wid; r < row_hi; r += NT / 64) {
        const int cg = r % GW; const bool hp = cg > 0, hn = cg < GW - 1;
        bf16_t* y0p = p.Y + (size_t)r * RW + c0; const bf16_t* y1p = p.Y + ((size_t)p.nlat + r) * RW + c0;
        float y[16], t8[8];
        unpack8(*(const u32x4*)y0p, t8);
#pragma unroll
        for (int j = 0; j < 8; ++j) y[j] = t8[j];
        unpack8(*(const u32x4*)(y0p + 8), t8);
#pragma unroll
        for (int j = 0; j < 8; ++j) y[8 + j] = t8[j];
        unpack8(*(const u32x4*)y1p, t8);
#pragma unroll
        for (int j = 0; j < 8; ++j) y[j] += t8[j];
        unpack8(*(const u32x4*)(y1p + 8), t8);
#pragma unroll
        for (int j = 0; j < 8; ++j) y[8 + j] += t8[j];
        float s = 0.f;
#pragma unroll
        for (int j = 0; j < 16; ++j) s += y[j];
        const float mu = allreduce4(s) * (1.f / 64.f); float q = 0.f;
#pragma unroll
        for (int j = 0; j < 16; ++j) { const float dlt = y[j] - mu; q += dlt * dlt; }
        const float rs = 1.f / sqrtf(allreduce4(q) * (1.f / 64.f) + LNX_EPS);
        const float bonus = p.bon[(size_t)r * NH + h] + p.bon[((size_t)p.nlat + r) * NH + h];
        const bf16_t* zr = p.z1 + (size_t)r * Z1_N;
#pragma unroll
        for (int half = 0; half < 2; ++half) {
            const int c = OFF_V + c0 + half * 8; float xv[8], pv[8], nv[8];
            unpack8(*(const u32x4*)(zr + c), xv);
            if (hp) unpack8(*(const u32x4*)(zr - Z1_N + c), pv); else {
#pragma unroll
                for (int j = 0; j < 8; ++j) pv[j] = 0.f; }
            if (hn) unpack8(*(const u32x4*)(zr + Z1_N + c), nv); else {
#pragma unroll
                for (int j = 0; j < 8; ++j) nv[j] = 0.f; }
            float o[8];
#pragma unroll
            for (int j = 0; j < 8; ++j) { const int cj = half * 8 + j; const float v = xv[j] + mu0v[cj] * (pv[j] - xv[j]) + mu1v[cj] * (nv[j] - xv[j]);
                o[j] = (y[cj] - mu) * rs * l0[cj] + l1[cj] + bonus * v; }
            u32x4 w; w.x = cvt_pk_bf16(o[0], o[1]); w.y = cvt_pk_bf16(o[2], o[3]); w.z = cvt_pk_bf16(o[4], o[5]); w.w = cvt_pk_bf16(o[6], o[7]); if (!dry) *(u32x4*)(y0p + half * 8) = w; else if (w.x == 0x12345678u) *(u32x4*)(y0p + half * 8) = w;
        }
        if (lane < 32) { u32x4 w = (u32x4){0u, 0u, 0u, 0u};
            if (lane < GL / 8) { const int c = OFF_GD + lane * 8; float xv[8], pv[8], nv[8];
                unpack8(*(const u32x4*)(zr + c), xv);
                if (hp) unpack8(*(const u32x4*)(zr - Z1_N + c), pv); else {
#pragma unroll
                    for (int j = 0; j < 8; ++j) pv[j] = 0.f; }
                if (hn) unpack8(*(const u32x4*)(zr + Z1_N + c), nv); else {
#pragma unroll
                    for (int j = 0; j < 8; ++j) nv[j] = 0.f; }
                float o[8];
#pragma unroll
                for (int j = 0; j < 8; ++j) o[j] = fast_sigmoid(xv[j] + mg0[j] * (pv[j] - xv[j]) + mg1[j] * (nv[j] - xv[j]));
                w.x = cvt_pk_bf16(o[0], o[1]); w.y = cvt_pk_bf16(o[2], o[3]); w.z = cvt_pk_bf16(o[4], o[5]); w.w = cvt_pk_bf16(o[6], o[7]); }
            *(u32x4*)(p.Ag + (size_t)r * AG_K + lane * 8) = w; }
    }
}
#define MK_FR_ROW(f) ((((f) >> 3) * HALF) + wr * 64 + ((((f) >> 1) & 3) * 16) + fr)
#define MK_FR_COL(f) ((((f) & 1) * HALF) + wc * 32 + 8 * fq)
#define MK_FR_ACC(f, n) acc[(f) >> 3][(f) & 1][((f) >> 1) & 3][n]
#define MK_FENCE asm volatile("" ::: "memory")
struct EpiYa { const bf16_t* yn; bf16_t* ya;
    __device__ __forceinline__ bool operator()(f32x4 (&acc)[2][2][4][2], const Unit& u, int wr, int wc, int fr, int fq) const {
        const size_t base = (size_t)(u.pm * BM) * RW + u.pn * BM;
        u32x4 cur = *(const u32x4*)(yn + base + (size_t)MK_FR_ROW(0) * RW + MK_FR_COL(0));
#pragma unroll
        for (int f = 0; f < 16; ++f) { u32x4 nxt = cur; if (f + 1 < 16) nxt = *(const u32x4*)(yn + base + (size_t)MK_FR_ROW(f + 1) * RW + MK_FR_COL(f + 1));
            MK_FENCE; float v[8]; unpack8(cur, v); f32x4 a = MK_FR_ACC(f, 0), b = MK_FR_ACC(f, 1);
#pragma unroll
            for (int j = 0; j < 4; ++j) { a[j] *= v[j]; b[j] *= v[4 + j]; }
            *(u32x4*)(ya + base + (size_t)MK_FR_ROW(f) * RW + MK_FR_COL(f)) = pack8(a, b); MK_FENCE; cur = nxt; }
        return false; } };
struct EpiZc { const bf16_t* Hd; bf16_t* yb; bf16_t* gates; int nlat; int pad_;
    __device__ __forceinline__ bool operator()(f32x4 (&acc)[2][2][4][2], const Unit& u, int wr, int wc, int fr, int fq) const {
        if (u.pn < LW / BM) {
            MK_FRAG_LOOP(r, c) { const size_t o = (size_t)(u.pm * BM + r) * LW + u.pn * BM + c; float h0[8], h1[8]; unpack8(*(const u32x4*)(Hd + o), h0); unpack8(*(const u32x4*)(Hd + (size_t)nlat * LW + o), h1);
                f32x4 a = acc[ai][bj][m][0], b = acc[ai][bj][m][1];
#pragma unroll
                for (int j = 0; j < 4; ++j) { a[j] = gelu_tanhf_(a[j]) * (h0[j] + h1[j]); b[j] = gelu_tanhf_(b[j]) * (h0[4 + j] + h1[4 + j]); }
                *(u32x4*)(yb + o) = pack8(a, b); asm volatile("" ::: "memory"); }
        } else {
            MK_FRAG_LOOP(r, c) { const size_t o = (size_t)(u.pm * BM + r) * (2 * D) + (u.pn * BM - LW) + c;
                f32x4 a = acc[ai][bj][m][0], b = acc[ai][bj][m][1];
#pragma unroll
                for (int j = 0; j < 4; ++j) { a[j] = fast_sigmoid(a[j]); b[j] = fast_sigmoid(b[j]); }
                *(u32x4*)(gates + o) = pack8(a, b); }
        }
        return false; } };
struct PairOrder { StaticOrder S;
    __device__ bool next(int i, Unit& u) const { if (!S.next(i >> 1, u)) return false; u.e = i & 1; return true; } };
struct EpiBranch { const bf16_t* gates; bf16_t* mixed;
    __device__ __forceinline__ bool operator()(f32x4 (&acc)[2][2][4][2], const Unit& u, int wr, int wc, int fr, int fq) const {
        const size_t gbase = (size_t)(u.pm * BM) * (2 * D) + u.pn * BM, mbase = (size_t)(u.pm * BM) * D + u.pn * BM;
        u32x4 c1 = (u32x4){0u, 0u, 0u, 0u}, c2 = *(const u32x4*)(gates + gbase + (size_t)MK_FR_ROW(0) * (2 * D) + D + MK_FR_COL(0));
        if (u.e == 0) c1 = *(const u32x4*)(gates + gbase + (size_t)MK_FR_ROW(0) * (2 * D) + MK_FR_COL(0));
#pragma unroll
        for (int f = 0; f < 16; ++f) { u32x4 n1 = c1, n2 = c2;
            if (f + 1 < 16) { const size_t o = gbase + (size_t)MK_FR_ROW(f + 1) * (2 * D) + MK_FR_COL(f + 1); n2 = *(const u32x4*)(gates + o + D); if (u.e == 0) n1 = *(const u32x4*)(gates + o); }
            MK_FENCE; float g1[8], g2[8]; unpack8(c1, g1); unpack8(c2, g2);
            if (u.e == 0) {
#pragma unroll
                for (int j = 0; j < 4; ++j) { MK_FR_ACC(f, 0)[j] *= g1[j] / g2[j]; MK_FR_ACC(f, 1)[j] *= g1[4 + j] / g2[4 + j]; }
            } else { f32x4 a = MK_FR_ACC(f, 0), b = MK_FR_ACC(f, 1);
#pragma unroll
                for (int j = 0; j < 4; ++j) { a[j] *= g2[j]; b[j] *= g2[4 + j]; }
                *(u32x4*)(mixed + mbase + (size_t)MK_FR_ROW(f) * D + MK_FR_COL(f)) = pack8(a, b); }
            MK_FENCE; c1 = n1; c2 = n2; }
        return u.e == 0; } };
struct EpiF32 { float* C; long ldc;
    __device__ __forceinline__ bool operator()(f32x4 (&acc)[2][2][4][2], const Unit& u, int wr, int wc, int fr, int fq) const {
        MK_FRAG_LOOP(r, c) { float* o = C + (size_t)(u.pm * BM + r) * ldc + u.pn * BM + c; *(f32x4*)o = acc[ai][bj][m][0]; *(f32x4*)(o + 4) = acc[ai][bj][m][1]; }
        return false; } };
}

namespace mk {
constexpr int NEX = NE + 1;
constexpr int SLOTS_PER_TOK = TOPK + 1;
constexpr int RP_MOD = 0;
constexpr int RP_UH = RP_MOD + 3 * D * 4;
constexpr int RP_UL = RP_UH + 16 * (D + 8) * 2;
constexpr int RP_PART = RP_UL + 16 * (D + 8) * 2;
constexpr int RP_LOG = RP_PART + 8 * 16 * 64 * 4;
constexpr int RP_HIST = RP_LOG + 16 * 64 * 4;
constexpr int RP_END = RP_HIST + 64 * 4;
static_assert(RP_END <= LDS_BYTES, "rowpass LDS");

struct RowP { float* y2h1; bf16_t* u; const float* modpart; const bf16_t* rwt;
              int* tope; float* gatev; int* lrank; int* blkcnt; int b0, nlat; };
__device__ __forceinline__ float wave_max(float x) {
#pragma unroll
    for (int o = 32; o > 0; o >>= 1) x = fmaxf(x, __shfl_xor(x, o));
    return x; }
__device__ __forceinline__ void row_pass(LAS unsigned char* lds, const In& in, const RowP p, int row_lo, int row_hi, bool dry = false) {
    const int tid = threadIdx.x, lane = tid & 63, wid = tid >> 6;
    LAS float* MOD = (LAS float*)(lds + RP_MOD); LAS bf16_t* UH = (LAS bf16_t*)(lds + RP_UH); LAS bf16_t* UL = (LAS bf16_t*)(lds + RP_UL);
    LAS float* PART = (LAS float*)(lds + RP_PART); LAS float* LOG = (LAS float*)(lds + RP_LOG); LAS int* HIST = (LAS int*)(lds + RP_HIST);
    const int mr = p.b0 + row_lo / SEQ;
    for (int j = tid; j < 3 * D; j += NT) MOD[j] = mod_value(in, p.modpart, mr, 2 * D + j);
    if (tid < 64) HIST[tid] = 0;
    __syncthreads();
    float gp1[16], gp2[16];
#pragma unroll
    for (int j = 0; j < 4; ++j)
#pragma unroll
        for (int q = 0; q < 4; ++q) { gp1[4 * j + q] = in.norm_g[D + j * 256 + lane * 4 + q]; gp2[4 * j + q] = in.norm_g[2 * D + j * 256 + lane * 4 + q]; }
    for (int r16 = row_lo; r16 < row_hi; r16 += 16) {
#pragma unroll
        for (int rr = 0; rr < 2; ++rr) {
            const int lr = wid * 2 + rr, r = r16 + lr;
            float* yp = p.y2h1 + (size_t)r * D; const float* xp = in.x + ((size_t)p.b0 * SEQ + r) * D;
            f32x4 v[4]; float ss = 0.f;
#pragma unroll
            for (int j = 0; j < 4; ++j) { v[j] = *(const f32x4*)(yp + j * 256 + lane * 4); ss += v[j][0] * v[j][0] + v[j][1] * v[j][1] + v[j][2] * v[j][2] + v[j][3] * v[j][3]; }
#pragma unroll
            for (int o = 32; o > 0; o >>= 1) ss += __shfl_xor(ss, o);
            const float rinv = 1.f / sqrtf(ss * (1.f / D) + NORM_EPS); float s2 = 0.f;
#pragma unroll
            for (int j = 0; j < 4; ++j) { const int c = j * 256 + lane * 4; const f32x4 xv = *(const f32x4*)(xp + c);
#pragma unroll
                for (int q = 0; q < 4; ++q) { const float hv = xv[q] + MOD[c + q] * (v[j][q] * rinv * gp1[4 * j + q]); v[j][q] = hv; s2 += hv * hv; }
                if (!dry) *(f32x4*)(yp + c) = v[j]; }
#pragma unroll
            for (int o = 32; o > 0; o >>= 1) s2 += __shfl_xor(s2, o);
            const float r2 = 1.f / sqrtf(s2 * (1.f / D) + NORM_EPS);
#pragma unroll
            for (int j = 0; j < 4; ++j) { const int c = j * 256 + lane * 4; float uu[4], lo[4]; unsigned hw[2];
#pragma unroll
                for (int q = 0; q < 4; ++q) uu[q] = (v[j][q] * r2 * gp2[4 * j + q]) * (1.f + MOD[2 * D + c + q]) + MOD[D + c + q];
                hw[0] = cvt_pk_bf16(uu[0], uu[1]); hw[1] = cvt_pk_bf16(uu[2], uu[3]);
                lo[0] = uu[0] - bflo(hw[0]); lo[1] = uu[1] - bfhi(hw[0]); lo[2] = uu[2] - bflo(hw[1]); lo[3] = uu[3] - bfhi(hw[1]);
                u32x2 w; w.x = hw[0]; w.y = hw[1]; *(u32x2*)(p.u + (size_t)r * D + c) = w; *(LAS u32x2*)(UH + lr * (D + 8) + c) = w;
                u32x2 wl; wl.x = cvt_pk_bf16(lo[0], lo[1]); wl.y = cvt_pk_bf16(lo[2], lo[3]); *(LAS u32x2*)(UL + lr * (D + 8) + c) = wl; }
        }
        __syncthreads();
        { const int fr = lane & 15, fq = lane >> 4;
          f32x4 acc[4];
#pragma unroll
          for (int ct = 0; ct < 4; ++ct) acc[ct] = (f32x4){0.f, 0.f, 0.f, 0.f};
#pragma unroll
          for (int ks = 0; ks < 4; ++ks) { const int k0 = wid * 128 + ks * 32 + fq * 8;
              const bf16x8 ah = *(const LAS bf16x8*)(UH + fr * (D + 8) + k0), al = *(const LAS bf16x8*)(UL + fr * (D + 8) + k0);
#pragma unroll
              for (int ct = 0; ct < 4; ++ct) { const bf16x8 bh = *(const bf16x8*)(p.rwt + (size_t)(ct * 16 + fr) * D + k0), bl = *(const bf16x8*)(p.rwt + (size_t)(NE + ct * 16 + fr) * D + k0);
                  acc[ct] = __builtin_amdgcn_mfma_f32_16x16x32_bf16(ah, bh, acc[ct], 0, 0, 0); acc[ct] = __builtin_amdgcn_mfma_f32_16x16x32_bf16(ah, bl, acc[ct], 0, 0, 0); acc[ct] = __builtin_amdgcn_mfma_f32_16x16x32_bf16(al, bh, acc[ct], 0, 0, 0); } }
#pragma unroll
          for (int ct = 0; ct < 4; ++ct)
#pragma unroll
              for (int i = 0; i < 4; ++i) PART[(wid * 16 + fq * 4 + i) * 64 + ct * 16 + fr] = acc[ct][i]; }
        __syncthreads();
        for (int i = tid; i < 16 * 64; i += NT) { float s = 0.f;
#pragma unroll
            for (int w = 0; w < 8; ++w) s += PART[w * 1024 + i];
            LOG[i] = s; }
        __syncthreads();
#pragma unroll 1
        for (int rr = 0; rr < 2; ++rr) {
            const int lr = wid * 2 + rr, r = r16 + lr;
            const float sc = sigmoidf_(LOG[lr * 64 + lane]), bi = sc + in.router_b[lane];
            float m1 = bi; m1 = fmaxf(m1, __shfl_xor(m1, 1)); m1 = fmaxf(m1, __shfl_xor(m1, 2)); m1 = fmaxf(m1, __shfl_xor(m1, 4));
            const unsigned long long eq = __ballot(bi == m1); const int first = __ffsll((long long)((eq >> (lane & ~7)) & 0xffull)) - 1 + (lane & ~7);
            float m2 = (lane == first) ? -1e30f : bi; m2 = fmaxf(m2, __shfl_xor(m2, 1)); m2 = fmaxf(m2, __shfl_xor(m2, 2)); m2 = fmaxf(m2, __shfl_xor(m2, 4));
            const float gs = m1 + m2; const int myg = lane >> 3; int rank = 0;
#pragma unroll
            for (int g = 0; g < NG; ++g) { const float og = __shfl(gs, g * 8); rank += (og > gs || (og == gs && g < myg)) ? 1 : 0; }
            float cand = rank < TG ? bi : -1e30f; float tsum = 0.f; int myidx = 0; float mysc = 0.f;
#pragma unroll
            for (int it = 0; it < TOPK; ++it) { const float m = wave_max(cand); const unsigned long long bm = __ballot(cand == m); const int win = __ffsll((long long)bm) - 1;
                const float ws = __shfl(sc, win); tsum += ws; if (lane == it) { myidx = win; mysc = ws; } if (lane == win) cand = -1e30f; }
            if (lane < TOPK) { const int rk = atomicAdd((int*)&HIST[myidx], 1);
                p.tope[(size_t)r * TOPK + lane] = myidx; p.gatev[(size_t)r * TOPK + lane] = mysc / tsum * 2.5f; p.lrank[(size_t)r * TOPK + lane] = rk; }
        }
        __syncthreads();
    }
    if (tid < 64) p.blkcnt[blockIdx.x * 64 + tid] = HIST[tid];
}

struct MoeP { const int* tope; const float* gatev; const int* lrank; const int* blkcnt;
              int* tilepre;
              int* list;
              int* sdst;
              float* sgate;
              int r0, nr, blk0, nbh, rpb, pad_; };
__device__ __forceinline__ void moe_assign(LAS unsigned char* lds, const MoeP p, int bid, int nblk) {
    LAS int* BASE = (LAS int*)lds; LAS int* CNT = BASE + 80; LAS int* BOFF = CNT + 80;
    const int tid = threadIdx.x;
    if (tid < NE) { int c = 0, bo = 0; for (int b = 0; b < p.nbh; ++b) { const int v = p.blkcnt[(p.blk0 + b) * 64 + tid]; if (p.blk0 + b < bid) bo += v; c += v; } CNT[tid] = c; BOFF[tid] = bo; }
    __syncthreads();
    if (tid == 0) { int s = 0; for (int e = 0; e < NE; ++e) { BASE[e] = s; s += (CNT[e] + BM - 1) / BM * BM; } BASE[NE] = s; CNT[NE] = p.nr; BASE[NE + 1] = s + p.nr;
        if (bid == 0) { for (int e = 0; e <= NEX; ++e) p.tilepre[e] = BASE[e] / BM; } }
    __syncthreads();
    if (bid >= p.blk0 && bid < p.blk0 + p.nbh) {
        const int rlo = p.r0 + (bid - p.blk0) * p.rpb;
        for (int i = tid; i < p.rpb * TOPK; i += NT) { const int r = rlo + i / TOPK, a = r * TOPK + i % TOPK, e = p.tope[a]; const int slot = BASE[e] + BOFF[e] + p.lrank[a];
            p.list[slot] = r; p.sdst[slot] = (r - p.r0) * SLOTS_PER_TOK + i % TOPK; p.sgate[slot] = p.gatev[a]; }
        for (int i = tid; i < p.rpb; i += NT) { const int r = rlo + i, slot = BASE[NE] + (r - p.r0); p.list[slot] = r; p.sdst[slot] = (r - p.r0) * SLOTS_PER_TOK + TOPK; p.sgate[slot] = 1.f; }
    }
    for (int e = bid; e < NE; e += nblk) { const int lo = BASE[e] + CNT[e], hi = BASE[e + 1]; for (int s = lo + tid; s < hi; s += NT) { p.list[s] = p.r0; p.sdst[s] = -1; p.sgate[s] = 0.f; } }
}
struct GroupOrder { int tpn, total, nN, G, c;
    __device__ void init(const int* tilepre, int nN_, int G_, int c_) { const int lane = threadIdx.x & 63;
        tpn = (int)__hip_atomic_load((const unsigned*)tilepre + lane + 1, __ATOMIC_RELAXED, __HIP_MEMORY_SCOPE_AGENT);
        total = (int)__hip_atomic_load((const unsigned*)tilepre + NEX, __ATOMIC_RELAXED, __HIP_MEMORY_SCOPE_AGENT); nN = nN_; G = G_; c = c_; }
    __device__ bool next(int i, Unit& u) const { const long L = (long)i * G + c; if (L >= (long)total * nN) return false;
        const int T = (int)(L / nN); const int e = __popcll(__ballot(tpn <= T));
        u.pm = T; u.pn = (int)(L % nN); u.e = __builtin_amdgcn_readfirstlane(e); return true; } };
struct EpiGU { bf16_t* act;
    __device__ __forceinline__ bool operator()(f32x4 (&acc)[2][2][4][2], const Unit& u, int wr, int wc, int fr, int fq) const {
        MK_FRAG_LOOP(r, c) { const f32x4 a = acc[ai][bj][m][0], b = acc[ai][bj][m][1];
            u32x2 w; w.x = cvt_pk_bf16(fast_silu(a[0]) * a[1], fast_silu(a[2]) * a[3]); w.y = cvt_pk_bf16(fast_silu(b[0]) * b[1], fast_silu(b[2]) * b[3]);
            *(u32x2*)(act + (size_t)(u.pm * BM + r) * EF + ((u.pn * BM + c) >> 1)) = w; }
        return false; } };
struct EpiDown { const int* sdst; const float* sgate; bf16_t* rowsb;
    __device__ __forceinline__ bool operator()(f32x4 (&acc)[2][2][4][2], const Unit& u, int wr, int wc, int fr, int fq) const {
        int dst[8]; float gt[8];
#pragma unroll
        for (int q = 0; q < 8; ++q) { const int slot = u.pm * BM + (q >> 2) * HALF + wr * 64 + (q & 3) * 16 + fr; dst[q] = sdst[slot]; gt[q] = sgate[slot]; }
#pragma unroll
        for (int ai = 0; ai < 2; ++ai)
#pragma unroll
            for (int m = 0; m < 4; ++m) { const int q = ai * 4 + m; if (dst[q] >= 0) {
#pragma unroll
                for (int bj = 0; bj < 2; ++bj) { f32x4 a = acc[ai][bj][m][0], b = acc[ai][bj][m][1];
#pragma unroll
                    for (int j = 0; j < 4; ++j) { a[j] *= gt[q]; b[j] *= gt[q]; }
                    *(u32x4*)(rowsb + (size_t)dst[q] * D + u.pn * BM + bj * HALF + wc * 32 + 8 * fq) = pack8(a, b); } } }
        return false; } };
__device__ __forceinline__ void final_rows(LAS float* sm  , const In& in, const float* modpart, const bf16_t* rowsb, float* h1out, int b0, int r0, int row_lo, int row_hi, bool dry = false) {
    const int tid = threadIdx.x, lane = tid & 63, wid = tid >> 6;
    const int mr = b0 + row_lo / SEQ;
    __syncthreads();
    for (int j = tid; j < D; j += NT) sm[j] = mod_value(in, modpart, mr, 5 * D + j);
    __syncthreads();
    float gq[16];
#pragma unroll
    for (int j = 0; j < 4; ++j)
#pragma unroll
        for (int q = 0; q < 4; ++q) gq[4 * j + q] = sm[j * 256 + lane * 4 + q] * in.norm_g[3 * D + j * 256 + lane * 4 + q];
    for (int r = row_lo + wid; r < row_hi; r += NT / 64) {
        float v[16];
#pragma unroll
        for (int j = 0; j < 16; ++j) v[j] = 0.f;
        const bf16_t* rb = rowsb + (size_t)(r - r0) * SLOTS_PER_TOK * D;
#pragma unroll
        for (int s = 0; s < SLOTS_PER_TOK; ++s)
#pragma unroll
            for (int j = 0; j < 4; ++j) { const u32x2 w = *(const u32x2*)(rb + (size_t)s * D + j * 256 + lane * 4); v[4 * j] += bflo(w.x); v[4 * j + 1] += bfhi(w.x); v[4 * j + 2] += bflo(w.y); v[4 * j + 3] += bfhi(w.y); }
        float ss = 0.f;
#pragma unroll
        for (int j = 0; j < 16; ++j) ss += v[j] * v[j];
#pragma unroll
        for (int o = 32; o > 0; o >>= 1) ss += __shfl_xor(ss, o);
        const float rinv = 1.f / sqrtf(ss * (1.f / D) + NORM_EPS);
        float* hp = h1out + (size_t)r * D;
#pragma unroll
        for (int j = 0; j < 4; ++j) { const int c = j * 256 + lane * 4; f32x4 hv = *(const f32x4*)(hp + c);
#pragma unroll
            for (int q = 0; q < 4; ++q) hv[q] += gq[4 * j + q] * (v[4 * j + q] * rinv);
            if (!dry) *(f32x4*)(hp + c) = hv; else if (hv[0] == 1.2345e30f) *(f32x4*)(hp + c) = hv; }
    }
}
__device__ __forceinline__ void rwt_prep(const In& in, bf16_t* rwt, int bid, int nblk) {
    for (int i = bid * NT + threadIdx.x; i < NE * D; i += nblk * NT) { const int e = i / D, k = i % D; const float w = in.router_w[(size_t)k * NE + e]; const bf16_t h = f2bf(w); rwt[i] = h; rwt[(size_t)NE * D + i] = f2bf(w - bf2f(h)); }
}
}

using namespace mk;
constexpr size_t MiB = (size_t)1 << 20;
constexpr int NLAT = NB * SEQ, NCTXR = NB * CTX, NALL = NLAT + NCTXR, NRH = NLAT / 2, MAXSLOTS = NRH * SLOTS_PER_TOK + NE * BM;
constexpr size_t O_W1A = 0, O_W1C = O_W1A + (size_t)Z1_N * D * 2, O_WG = O_W1C + (size_t)ZC_N * D * 2, O_WBR = O_WG + (size_t)RW * AG_K * 2, O_WOUT = O_WBR + (size_t)2 * D * RW * 2,
                 O_RWT = O_WOUT + (size_t)D * D * 2, O_MODP = O_RWT + (size_t)2 * NE * D * 2, O_S_END = O_MODP + (size_t)MOD_SL * (NB + 1) * 6 * D * 4;
static_assert(O_S_END <= 27 * MiB, "S region");
constexpr size_t O_BAR = 27 * MiB;
constexpr size_t O_Z1 = 28 * MiB, O_R2 = O_Z1 + (size_t)NALL * Z1_N * 2;
static_assert(O_R2 == 334 * MiB, "z1 size");
constexpr size_t O_HD = O_R2, O_BON = O_HD + (size_t)2 * NLAT * LW * 2, O_AG = O_BON + (size_t)2 * NLAT * NH * 4, O_R2_END = O_AG + (size_t)NLAT * AG_K * 2;
static_assert(O_R2_END <= 512 * MiB, "R2");
constexpr size_t O_XNL = O_Z1, O_YB = O_XNL + (size_t)NLAT * D * 2, O_GATES = O_YB + (size_t)NLAT * LW * 2, O_MIXED = O_HD;
static_assert(O_GATES + (size_t)NLAT * 2 * D * 2 <= O_R2, "late R1");
constexpr size_t O_U = O_Z1, O_WGU = O_U + (size_t)NLAT * D * 2, O_WDN = O_WGU + (size_t)NEX * 2 * EF * D * 2, O_ROUT = O_WDN + (size_t)NEX * D * EF * 2;
constexpr size_t O_TOPE = O_ROUT, O_LRANK = O_TOPE + (size_t)NLAT * TOPK * 4, O_GATEV = O_LRANK + (size_t)NLAT * TOPK * 4, O_BLKCNT = O_GATEV + (size_t)NLAT * TOPK * 4, O_TILEPRE = O_BLKCNT + 256 * 64 * 4,
                 O_LIST = O_TILEPRE + 1024, O_SDST = O_LIST + (size_t)MAXSLOTS * 4, O_SGATE = O_SDST + (size_t)MAXSLOTS * 4, O_ACT = ((O_SGATE + (size_t)MAXSLOTS * 4 + 255) / 256) * 256,
                 O_ROWSB = ((O_ACT + (size_t)MAXSLOTS * EF * 2 + 255) / 256) * 256, O_END = O_ROWSB + (size_t)NRH * SLOTS_PER_TOK * D * 2;
static_assert(O_END <= 512 * MiB, "workspace");
static_assert(O_WGU >= O_YB && O_ROWSB >= O_GATES, "late layout");

struct MP { In in; float* out; unsigned char* ws; long ph_lo, ph_hi; };
constexpr int NPHASE = 17;

#if defined(__HIP_DEVICE_COMPILE__)
#define MK_KARGS auto Pq_ = Pk_; asm volatile("" : "+s"(Pq_)); const MP* Pg_ = (const MP*)Pq_; const In in = Pg_->in; unsigned char* ws = Pg_->ws; float* out_ = Pg_->out; (void)out_;
#else
#define MK_KARGS const In in = P.in; unsigned char* ws = P.ws; float* out_ = P.out; (void)out_; (void)Pk_;
#endif
#define MK_PHASE_PTRS \
    MK_KARGS \
    bf16_t *W1a = (bf16_t*)(ws + O_W1A), *W1c = (bf16_t*)(ws + O_W1C), *Wg = (bf16_t*)(ws + O_WG), *Wbr = (bf16_t*)(ws + O_WBR), *Wout = (bf16_t*)(ws + O_WOUT), *rwt = (bf16_t*)(ws + O_RWT); \
    float* modpart = (float*)(ws + O_MODP); \
    bf16_t *z1 = (bf16_t*)(ws + O_Z1), *Hd = (bf16_t*)(ws + O_HD), *Ag = (bf16_t*)(ws + O_AG); float* bon = (float*)(ws + O_BON); \
    bf16_t *xnl = (bf16_t*)(ws + O_XNL), *yb = (bf16_t*)(ws + O_YB), *gates = (bf16_t*)(ws + O_GATES), *mixed = (bf16_t*)(ws + O_MIXED); \
    bf16_t *u = (bf16_t*)(ws + O_U), *Wgu = (bf16_t*)(ws + O_WGU), *Wdn = (bf16_t*)(ws + O_WDN), *act = (bf16_t*)(ws + O_ACT), *rowsb = (bf16_t*)(ws + O_ROWSB); \
    int *tope = (int*)(ws + O_TOPE), *lrank = (int*)(ws + O_LRANK), *blkcnt = (int*)(ws + O_BLKCNT), *tilepre = (int*)(ws + O_TILEPRE), *list = (int*)(ws + O_LIST), *sdst = (int*)(ws + O_SDST); \
    float *gatev = (float*)(ws + O_GATEV), *sgate = (float*)(ws + O_SGATE); \
    bf16_t* xn_all = (bf16_t*)out_; \
    bf16_t* Y = (bf16_t*)out_; \
    float* y2h1 = out_;
__global__ void __launch_bounds__(512, 2) mega(MP P) {
    extern __shared__ __attribute__((aligned(16))) unsigned char shm[];
    LAS unsigned char* lds = (LAS unsigned char*)shm;
    typedef const __attribute__((address_space(4))) MP* KargP;
    const KargP Pk_ = (KargP)__builtin_amdgcn_kernarg_segment_ptr();
    const int bid = blockIdx.x, nblk = gridDim.x;
    const int ph_lo = (int)P.ph_lo, ph_hi = (int)P.ph_hi;
    volatile LAS unsigned* xst = (volatile LAS unsigned*)(lds + LDS_BYTES - 16);
    if (threadIdx.x == 0) { xst[0] = 0u; xst[1] = 0u; }
    __syncthreads();
    const XcdBarrier xb = xcd_barrier_post((unsigned*)(P.ws + O_BAR), xst);
    if (0 >= ph_lo && 0 < ph_hi) { if (0 > ph_lo) xcd_barrier(xb); const int ph = 0; (void)ph; MK_PHASE_PTRS
        { LAS float* tile = (LAS float*)lds; int base = 0;
            convT_job(tile, in.w_in, INC, D, W1a, D, Z1_N, CMapZ1{}, bid, nblk, base);
            convT_job(tile, in.w_in, INC, D, W1c, D, ZC_N, CMapZC{}, bid, nblk, base);
            convT_job(tile, in.rw_g_up, RW, GL, Wg, AG_K, RW, CMapId{}, bid, nblk, base);
            convT_job(tile, in.w_branch_a, D, RW, Wbr, RW, D, CMapId{}, bid, nblk, base);
            convT_job(tile, in.w_branch_b, D, LW, Wbr + (size_t)D * RW, LW, D, CMapId{}, bid, nblk, base);
            convT_job(tile, in.w_out, D, D, Wout, D, D, CMapId{}, bid, nblk, base);
            rwt_prep(in, rwt, bid, nblk);
            mod_partials((LAS float*)lds, in, modpart, bid, nblk); }
    }
    if (1 >= ph_lo && 1 < ph_hi) { if (1 > ph_lo) xcd_barrier(xb); const int ph = 1; (void)ph; MK_PHASE_PTRS
        { const int L = NLAT / nblk, Lc = NCTXR / nblk;
            xn_rows((LAS float*)lds, in, modpart, xn_all, 0, NB, bid * L, (bid + 1) * L);
            xn_rows((LAS float*)lds, in, modpart, xn_all, 0, NB, NLAT + bid * Lc, NLAT + (bid + 1) * Lc); }
    }
    if (2 >= ph_lo && 2 < ph_hi) { if (2 > ph_lo) xcd_barrier(xb); const int ph = 2; (void)ph; MK_PHASE_PTRS
        { GemmP g{xn_all, xn_all, W1a, 0, nullptr, D, 0}; StaticOrder S; S.init(NALL, Z1_N, nblk, bid); gemm_phase(lds, g, S, EpiStoreBf16{z1, Z1_N}); }
    }
    if (3 >= ph_lo && 3 < ph_hi) { if (3 > ph_lo) xcd_barrier(xb); const int ph = 3; (void)ph; MK_PHASE_PTRS
        { LruP lp{z1, Hd, 0, NB}; lru_phase(lds, in, lp, bid, nblk); __syncthreads();
                  RwkvP rp{z1, Y, bon, 0, NB}; r3::rwkv_phase3(lds, in, rp, bid, nblk); }
    }
    if (4 >= ph_lo && 4 < ph_hi) { if (4 > ph_lo) xcd_barrier(xb); const int ph = 4; (void)ph; MK_PHASE_PTRS
        { const int L = NLAT / nblk; PostP pp{z1, Y, bon, Ag, NLAT, 0}; rwkv_post_rows(in, pp, bid * L, (bid + 1) * L); }
    }
    if (5 >= ph_lo && 5 < ph_hi) { if (5 > ph_lo) xcd_barrier(xb); const int ph = 5; (void)ph; MK_PHASE_PTRS
        { const int L = NLAT / nblk; xn_rows((LAS float*)lds, in, modpart, xnl, 0, NB, bid * L, (bid + 1) * L); __syncthreads();
                  GemmP g{Ag, Ag, Wg, 0, nullptr, AG_K, 0}; StaticOrder S; S.init(NLAT, RW, nblk, bid); gemm_phase(lds, g, S, EpiYa{Y, Y + (size_t)NLAT * RW}); }
    }
    if (6 >= ph_lo && 6 < ph_hi) { if (6 > ph_lo) xcd_barrier(xb); const int ph = 6; (void)ph; MK_PHASE_PTRS
        { GemmP g{xnl, xnl, W1c, 0, nullptr, D, 0}; StaticOrder S; S.init(NLAT, ZC_N, nblk, bid); gemm_phase(lds, g, S, EpiZc{Hd, yb, gates, NLAT, 0}); }
    }
    if (7 >= ph_lo && 7 < ph_hi) { if (7 > ph_lo) xcd_barrier(xb); const int ph = 7; (void)ph; MK_PHASE_PTRS
        { GemmP g{Y + (size_t)NLAT * RW, yb, Wbr, (long)D * RW, nullptr, D, 0}; PairOrder S; S.S.init(NLAT, D, nblk, bid); gemm_phase(lds, g, S, EpiBranch{gates, mixed}); }
    }
    if (8 >= ph_lo && 8 < ph_hi) { if (8 > ph_lo) xcd_barrier(xb); const int ph = 8; (void)ph; MK_PHASE_PTRS
        { LAS float* tile = (LAS float*)lds; int base = 0;
            for (int e = 0; e < NE; ++e) {
                convT_job(tile, in.ex_w_gu + (size_t)e * D * 2 * EF, 2 * EF, D, Wgu + (size_t)e * 2 * EF * D, D, 2 * EF, CMapGU{EF}, bid, nblk, base);
                convT_job(tile, in.ex_w_down + (size_t)e * EF * D, D, EF, Wdn + (size_t)e * D * EF, EF, D, CMapId{}, bid, nblk, base); }
            convT_job(tile, in.sh_w_gu, 2 * SF, D, Wgu + (size_t)NE * 2 * EF * D, D, 2 * SF, CMapGU{SF}, bid, nblk, base);
            convT_job(tile, in.sh_w_down, D, SF, Wdn + (size_t)NE * D * EF, SF, D, CMapId{}, bid, nblk, base);
            __syncthreads();
            GemmP g{mixed, mixed, Wout, 0, nullptr, D, 0}; StaticOrder S; S.init(NLAT, D, nblk, bid); gemm_phase(lds, g, S, EpiF32{y2h1, D}); }
    }
    if (9 >= ph_lo && 9 < ph_hi) { if (9 > ph_lo) xcd_barrier(xb); const int ph = 9; (void)ph; MK_PHASE_PTRS
        { const int L = NLAT / nblk; RowP rp{y2h1, u, modpart, rwt, tope, gatev, lrank, blkcnt, 0, NLAT}; row_pass(lds, in, rp, bid * L, (bid + 1) * L); }
    }
    if (10 >= ph_lo && 10 < ph_hi) { if (10 > ph_lo) xcd_barrier(xb); const int ph = 10; (void)ph; MK_PHASE_PTRS
        { const int q = ph - 10, half = q >= 4 ? 1 : 0, st = q - 4 * half;
            const int rpb = NLAT / nblk;
            auto assign = [&](int hf) { MoeP mp{tope, gatev, lrank, blkcnt, tilepre, list, sdst, sgate, hf * NRH, NRH, hf * (nblk / 2), nblk / 2, rpb, 0}; moe_assign(lds, mp, bid, nblk); };
            auto fin = [&](int hf) { const int L = NRH / nblk, r0 = hf * NRH; final_rows((LAS float*)lds, in, modpart, rowsb, y2h1, 0, r0, r0 + bid * L, r0 + (bid + 1) * L); };
            if (ph == 10) assign(0);
            else if (ph == 11 || ph == 14) { GemmP g{u, u, Wgu, (long)2 * EF * D, list, D, 0}; GroupOrder S; S.init(tilepre, 2 * EF / BM, nblk, bid); gemm_phase<true>(lds, g, S, EpiGU{act}); }
            else if (ph == 12 || ph == 15) { GemmP g{act, act, Wdn, (long)D * EF, nullptr, EF, 0}; GroupOrder S; S.init(tilepre, D / BM, nblk, bid); gemm_phase(lds, g, S, EpiDown{sdst, sgate, rowsb}); }
            else if (ph == 13) { fin(0); __syncthreads(); assign(1); }
            else if (ph == 16) fin(1);
            (void)half; (void)st; }
    }
    if (11 >= ph_lo && 11 < ph_hi) { if (11 > ph_lo) xcd_barrier(xb); const int ph = 11; (void)ph; MK_PHASE_PTRS
        { const int q = ph - 10, half = q >= 4 ? 1 : 0, st = q - 4 * half;
            const int rpb = NLAT / nblk;
            auto assign = [&](int hf) { MoeP mp{tope, gatev, lrank, blkcnt, tilepre, list, sdst, sgate, hf * NRH, NRH, hf * (nblk / 2), nblk / 2, rpb, 0}; moe_assign(lds, mp, bid, nblk); };
            auto fin = [&](int hf) { const int L = NRH / nblk, r0 = hf * NRH; final_rows((LAS float*)lds, in, modpart, rowsb, y2h1, 0, r0, r0 + bid * L, r0 + (bid + 1) * L); };
            if (ph == 10) assign(0);
            else if (ph == 11 || ph == 14) { GemmP g{u, u, Wgu, (long)2 * EF * D, list, D, 0}; GroupOrder S; S.init(tilepre, 2 * EF / BM, nblk, bid); gemm_phase<true>(lds, g, S, EpiGU{act}); }
            else if (ph == 12 || ph == 15) { GemmP g{act, act, Wdn, (long)D * EF, nullptr, EF, 0}; GroupOrder S; S.init(tilepre, D / BM, nblk, bid); gemm_phase(lds, g, S, EpiDown{sdst, sgate, rowsb}); }
            else if (ph == 13) { fin(0); __syncthreads(); assign(1); }
            else if (ph == 16) fin(1);
            (void)half; (void)st; }
    }
    if (12 >= ph_lo && 12 < ph_hi) { if (12 > ph_lo) xcd_barrier(xb); const int ph = 12; (void)ph; MK_PHASE_PTRS
        { const int q = ph - 10, half = q >= 4 ? 1 : 0, st = q - 4 * half;
            const int rpb = NLAT / nblk;
            auto assign = [&](int hf) { MoeP mp{tope, gatev, lrank, blkcnt, tilepre, list, sdst, sgate, hf * NRH, NRH, hf * (nblk / 2), nblk / 2, rpb, 0}; moe_assign(lds, mp, bid, nblk); };
            auto fin = [&](int hf) { const int L = NRH / nblk, r0 = hf * NRH; final_rows((LAS float*)lds, in, modpart, rowsb, y2h1, 0, r0, r0 + bid * L, r0 + (bid + 1) * L); };
            if (ph == 10) assign(0);
            else if (ph == 11 || ph == 14) { GemmP g{u, u, Wgu, (long)2 * EF * D, list, D, 0}; GroupOrder S; S.init(tilepre, 2 * EF / BM, nblk, bid); gemm_phase<true>(lds, g, S, EpiGU{act}); }
            else if (ph == 12 || ph == 15) { GemmP g{act, act, Wdn, (long)D * EF, nullptr, EF, 0}; GroupOrder S; S.init(tilepre, D / BM, nblk, bid); gemm_phase(lds, g, S, EpiDown{sdst, sgate, rowsb}); }
            else if (ph == 13) { fin(0); __syncthreads(); assign(1); }
            else if (ph == 16) fin(1);
            (void)half; (void)st; }
    }
    if (13 >= ph_lo && 13 < ph_hi) { if (13 > ph_lo) xcd_barrier(xb); const int ph = 13; (void)ph; MK_PHASE_PTRS
        { const int q = ph - 10, half = q >= 4 ? 1 : 0, st = q - 4 * half;
            const int rpb = NLAT / nblk;
            auto assign = [&](int hf) { MoeP mp{tope, gatev, lrank, blkcnt, tilepre, list, sdst, sgate, hf * NRH, NRH, hf * (nblk / 2), nblk / 2, rpb, 0}; moe_assign(lds, mp, bid, nblk); };
            auto fin = [&](int hf) { const int L = NRH / nblk, r0 = hf * NRH; final_rows((LAS float*)lds, in, modpart, rowsb, y2h1, 0, r0, r0 + bid * L, r0 + (bid + 1) * L); };
            if (ph == 10) assign(0);
            else if (ph == 11 || ph == 14) { GemmP g{u, u, Wgu, (long)2 * EF * D, list, D, 0}; GroupOrder S; S.init(tilepre, 2 * EF / BM, nblk, bid); gemm_phase<true>(lds, g, S, EpiGU{act}); }
            else if (ph == 12 || ph == 15) { GemmP g{act, act, Wdn, (long)D * EF, nullptr, EF, 0}; GroupOrder S; S.init(tilepre, D / BM, nblk, bid); gemm_phase(lds, g, S, EpiDown{sdst, sgate, rowsb}); }
            else if (ph == 13) { fin(0); __syncthreads(); assign(1); }
            else if (ph == 16) fin(1);
            (void)half; (void)st; }
    }
    if (14 >= ph_lo && 14 < ph_hi) { if (14 > ph_lo) xcd_barrier(xb); const int ph = 14; (void)ph; MK_PHASE_PTRS
        { const int q = ph - 10, half = q >= 4 ? 1 : 0, st = q - 4 * half;
            const int rpb = NLAT / nblk;
            auto assign = [&](int hf) { MoeP mp{tope, gatev, lrank, blkcnt, tilepre, list, sdst, sgate, hf * NRH, NRH, hf * (nblk / 2), nblk / 2, rpb, 0}; moe_assign(lds, mp, bid, nblk); };
            auto fin = [&](int hf) { const int L = NRH / nblk, r0 = hf * NRH; final_rows((LAS float*)lds, in, modpart, rowsb, y2h1, 0, r0, r0 + bid * L, r0 + (bid + 1) * L); };
            if (ph == 10) assign(0);
            else if (ph == 11 || ph == 14) { GemmP g{u, u, Wgu, (long)2 * EF * D, list, D, 0}; GroupOrder S; S.init(tilepre, 2 * EF / BM, nblk, bid); gemm_phase<true>(lds, g, S, EpiGU{act}); }
            else if (ph == 12 || ph == 15) { GemmP g{act, act, Wdn, (long)D * EF, nullptr, EF, 0}; GroupOrder S; S.init(tilepre, D / BM, nblk, bid); gemm_phase(lds, g, S, EpiDown{sdst, sgate, rowsb}); }
            else if (ph == 13) { fin(0); __syncthreads(); assign(1); }
            else if (ph == 16) fin(1);
            (void)half; (void)st; }
    }
    if (15 >= ph_lo && 15 < ph_hi) { if (15 > ph_lo) xcd_barrier(xb); const int ph = 15; (void)ph; MK_PHASE_PTRS
        { const int q = ph - 10, half = q >= 4 ? 1 : 0, st = q - 4 * half;
            const int rpb = NLAT / nblk;
            auto assign = [&](int hf) { MoeP mp{tope, gatev, lrank, blkcnt, tilepre, list, sdst, sgate, hf * NRH, NRH, hf * (nblk / 2), nblk / 2, rpb, 0}; moe_assign(lds, mp, bid, nblk); };
            auto fin = [&](int hf) { const int L = NRH / nblk, r0 = hf * NRH; final_rows((LAS float*)lds, in, modpart, rowsb, y2h1, 0, r0, r0 + bid * L, r0 + (bid + 1) * L); };
            if (ph == 10) assign(0);
            else if (ph == 11 || ph == 14) { GemmP g{u, u, Wgu, (long)2 * EF * D, list, D, 0}; GroupOrder S; S.init(tilepre, 2 * EF / BM, nblk, bid); gemm_phase<true>(lds, g, S, EpiGU{act}); }
            else if (ph == 12 || ph == 15) { GemmP g{act, act, Wdn, (long)D * EF, nullptr, EF, 0}; GroupOrder S; S.init(tilepre, D / BM, nblk, bid); gemm_phase(lds, g, S, EpiDown{sdst, sgate, rowsb}); }
            else if (ph == 13) { fin(0); __syncthreads(); assign(1); }
            else if (ph == 16) fin(1);
            (void)half; (void)st; }
    }
    if (16 >= ph_lo && 16 < ph_hi) { if (16 > ph_lo) xcd_barrier(xb); const int ph = 16; (void)ph; MK_PHASE_PTRS
        { const int q = ph - 10, half = q >= 4 ? 1 : 0, st = q - 4 * half;
            const int rpb = NLAT / nblk;
            auto assign = [&](int hf) { MoeP mp{tope, gatev, lrank, blkcnt, tilepre, list, sdst, sgate, hf * NRH, NRH, hf * (nblk / 2), nblk / 2, rpb, 0}; moe_assign(lds, mp, bid, nblk); };
            auto fin = [&](int hf) { const int L = NRH / nblk, r0 = hf * NRH; final_rows((LAS float*)lds, in, modpart, rowsb, y2h1, 0, r0, r0 + bid * L, r0 + (bid + 1) * L); };
            if (ph == 10) assign(0);
            else if (ph == 11 || ph == 14) { GemmP g{u, u, Wgu, (long)2 * EF * D, list, D, 0}; GroupOrder S; S.init(tilepre, 2 * EF / BM, nblk, bid); gemm_phase<true>(lds, g, S, EpiGU{act}); }
            else if (ph == 12 || ph == 15) { GemmP g{act, act, Wdn, (long)D * EF, nullptr, EF, 0}; GroupOrder S; S.init(tilepre, D / BM, nblk, bid); gemm_phase(lds, g, S, EpiDown{sdst, sgate, rowsb}); }
            else if (ph == 13) { fin(0); __syncthreads(); assign(1); }
            else if (ph == 16) fin(1);
            (void)half; (void)st; }
    }
}
extern "C" void kernel_launch(void* const* d_in, const int* in_sizes, int n_in, void* d_out, int out_size, void* d_ws, size_t ws_size, hipStream_t stream) {
    static int grid = 0;
    if (grid == 0) {
        int dev = 0, cus = 0; hipGetDevice(&dev); hipDeviceGetAttribute(&cus, hipDeviceAttributeMultiprocessorCount, dev);
        hipFuncSetAttribute((const void*)mega, hipFuncAttributeMaxDynamicSharedMemorySize, LDS_BYTES);
        grid = cus;
        if (ws_size < O_END || grid != 256) fprintf(stderr, "kernel_launch: unexpected ws_size %zu (need %zu) or CU count %d\n", ws_size, (size_t)O_END, grid);
    }
    hipMemsetAsync((char*)d_ws + O_BAR, 0, XCD_BAR_WORDS * 4, stream);
    MP P; memset(&P, 0, sizeof(P));
    const float** f = (const float**)&P.in; for (int i = 0; i < 32; ++i) f[i] = (const float*)d_in[i];
    P.out = (float*)d_out; P.ws = (unsigned char*)d_ws;
#ifdef MK_PER_PHASE
    for (int ph = 0; ph < NPHASE; ++ph) { P.ph_lo = ph; P.ph_hi = ph + 1; hipLaunchKernelGGL(mega, dim3(grid), dim3(NT), LDS_BYTES, stream, P); }
#else
    P.ph_lo = 0; P.ph_hi = NPHASE;
    void* args[] = {&P};
    hipError_t e = hipLaunchCooperativeKernel((void*)mega, dim3(grid), dim3(NT), args, LDS_BYTES, stream);
    if (e != hipSuccess) fprintf(stderr, "cooperative launch failed: %s (grid %d)\n", hipGetErrorString(e), grid);
#endif
}
```

```cpp
#include <hip/hip_runtime.h>
#include <cstdio>
#include <cstring>
#define HD __host__ __device__ __forceinline__
static hipStream_t g_stream;

#ifdef SMALL
constexpr int D = 128, NB = 2, SEQ = 64, GW = 8, CTX = 16, RW = 128, RH = 64, DL = 16, AL = 16, GL = 24, LW = 128, LB = 2, NE = 8, TOPK = 3, NG = 4, TG = 2, EF = 32, SF = 32;
#else
constexpr int D = 1024, NB = 8, SEQ = 4096, GW = 64, CTX = 256, RW = 1024, RH = 64, DL = 64, AL = 64, GL = 160, LW = 1024, LB = 16, NE = 64, TOPK = 6, NG = 8, TG = 4, EF = 256, SF = 256;
#endif
constexpr int NH = RW / RH, LBS = LW / LB, ROWS = SEQ / GW, TA = CTX + SEQ;
constexpr int OFF_R = 0, OFF_K = RW, OFF_V = 2 * RW, OFF_WD = 3 * RW, OFF_AD = OFF_WD + 2 * DL, OFF_GD = OFF_AD + 2 * AL, RC = OFF_GD + GL;
constexpr int OFF_LX = RC, OFF_LG = OFF_LX + LW, OFF_GATE = OFF_LG + LW, INC = OFF_GATE + 2 * D;
constexpr int EPG = NE / NG, NASG = SEQ * TOPK;
#define NORM_EPS 1e-6f
#define LNX_EPS 64e-5f

HD float sigmoidf_(float x) { return 1.f / (1.f + expf(-x)); }
HD float softplusf_(float x) { return x > 20.f ? x : log1pf(expf(x)); }
HD float siluf_(float x) { return x * sigmoidf_(x); }
HD float gelu_tanhf_(float x) { return 0.5f * x * (1.f + tanhf(0.7978845608028654f * (x + 0.044715f * x * x * x))); }

struct In {
    const float *x, *c, *ctx, *c_ctx, *w_mod, *b_mod, *norm_g, *w_in, *shift_mu, *rw_w0, *rw_w_up, *rw_a0, *rw_a_up, *rw_g_up, *rw_k_k, *rw_k_a, *rw_r_k, *rw_lnx,
        *lru_conv_w, *lru_conv_b, *lru_gate_w, *lru_gate_b, *lru_l, *w_branch_a, *w_branch_b, *w_out, *router_w, *router_b, *ex_w_gu, *ex_w_down, *sh_w_gu, *sh_w_down;
};


namespace mk {
#define LAS __attribute__((address_space(3)))
typedef unsigned short bf16_t;
typedef short bf16x8 __attribute__((ext_vector_type(8)));
typedef float f32x4 __attribute__((ext_vector_type(4)));
typedef float f32x2 __attribute__((ext_vector_type(2)));
typedef unsigned u32x4 __attribute__((ext_vector_type(4)));
typedef unsigned u32x2 __attribute__((ext_vector_type(2)));
constexpr int NT = 512;
constexpr int BM = 256, BK = 64, HALF = 128, HTB = HALF * BK * 2, STAGE_BYTES = 8 * HTB;
constexpr int LDS_BYTES = 160 * 1024 - 1024;

constexpr int Z1_LX = 3584, Z1_N = 4608;
constexpr int ZC_N = 3072;

__device__ __forceinline__ unsigned cvt_pk_bf16(float lo, float hi) { unsigned r; asm volatile("v_cvt_pk_bf16_f32 %0, %1, %2" : "=v"(r) : "v"(lo), "v"(hi)); return r; }
__device__ __forceinline__ bf16_t f2bf(float f) { unsigned u = __float_as_uint(f); u += 0x7FFFu + ((u >> 16) & 1u); return (bf16_t)(u >> 16); }
__device__ __forceinline__ float bf2f(bf16_t b) { return __uint_as_float(((unsigned)b) << 16); }
__device__ __forceinline__ float bflo(unsigned w) { return __uint_as_float(w << 16); }
__device__ __forceinline__ float bfhi(unsigned w) { return __uint_as_float(w & 0xffff0000u); }

__device__ __forceinline__ float fast_rcp(float x) { return __builtin_amdgcn_rcpf(x); }
__device__ __forceinline__ float fast_sigmoid(float x) { return fast_rcp(1.f + __expf(-x)); }
__device__ __forceinline__ float fast_tanh(float x) { return 1.f - 2.f * fast_rcp(1.f + __expf(2.f * x)); }
__device__ __forceinline__ float fast_softplus(float x) { return x > 15.f ? x : __logf(1.f + __expf(x)); }
__device__ __forceinline__ float fast_silu(float x) { return x * fast_sigmoid(x); }
__device__ __forceinline__ float fast_gelu_tanh(float x) { return x * fast_sigmoid(1.5957691216057308f * (x + 0.044715f * x * x * x)); }
__device__ __forceinline__ int lds_byte(int r, int c) { const int st = (r >> 4) * 2 + (c >> 5), rr = r & 15, cc = c & 31, ob = rr * 64 + cc * 2; return st * 1024 + (ob ^ (((ob >> 9) & 1) << 5)); }
__device__ __forceinline__ void stage_rc(int b, int& R, int& C) { const int st = b / 1024, sb = b % 1024, swz = sb ^ (((sb >> 9) & 1) << 5); R = (st >> 1) * 16 + swz / 64; C = (st & 1) * 32 + (swz % 64) / 2; }
__device__ __forceinline__ int perm32(int rho) { const int n = rho >> 4, i = rho & 15; return 8 * (i >> 2) + 4 * n + (i & 3); }

struct Unit { int pm, pn, e; };
struct GemmP { const bf16_t* A0; const bf16_t* A1; const bf16_t* Bt; long strideB; const int* gather; int K; int pad_; };

struct StaticOrder {
    int nM, nN, nwg, G, c;
    __device__ void init(int M, int N, int G_, int c_) { nM = M / BM; nN = N / BM; nwg = nM * nN; G = G_; c = c_; }
    __device__ bool next(int i, Unit& u) const {
        const long L = (long)i * G + c; if (L >= nwg) return false;
        int wgid = (int)L; { const int q = nwg / 8, r = nwg % 8, xcd = wgid % 8, off = wgid / 8; wgid = (xcd < r ? xcd * (q + 1) : r * (q + 1) + (xcd - r) * q) + off; }
        const int nig = 8 * nN, gid = wgid / nig, fm = gid * 8, gsz = (nM - fm) < 8 ? (nM - fm) : 8;
        u.pm = fm + ((wgid % nig) % gsz); u.pn = (wgid % nig) / gsz; u.e = 0; return true;
    }
};

#define MK_FRAG_LOOP(ROW, COL) \
    _Pragma("unroll") for (int ai = 0; ai < 2; ++ai) _Pragma("unroll") for (int m = 0; m < 4; ++m) _Pragma("unroll") for (int bj = 0; bj < 2; ++bj) \
        if (const int ROW = ai * HALF + wr * 64 + m * 16 + fr; true) if (const int COL = bj * HALF + wc * 32 + 8 * fq; true)

template <bool GATHER = false, class Epi, class Sched>
__device__ __forceinline__ void gemm_phase(LAS unsigned char* lds, const GemmP g, const Sched& S, const Epi& E) {
    const int tid = threadIdx.x, wid = __builtin_amdgcn_readfirstlane(tid >> 6), lane = tid & 63, wr = wid >> 2, wc = wid & 3, fr = lane & 15, fq = lane >> 4;
    int K = g.K; asm volatile("" : "+s"(K));
    const int nt = K / BK;
    int RA[2], CA[2]; unsigned voffB[2];
#pragma unroll
    for (int i = 0; i < 2; ++i) { int R, C; stage_rc(tid * 16 + i * 8192, R, C); RA[i] = R; CA[i] = C; const int Rb = (R & ~31) + perm32(R & 31); voffB[i] = (unsigned)(Rb * K + C) * 2u; }
    const size_t kstep = (size_t)(BK * 2), hstepB = (size_t)HALF * K * 2, tstepB = 2 * hstepB;
    const unsigned ldsw = (unsigned)wid * 1024u;
    const int aoff = lds_byte(wr * 64 + fr, fq * 8), boff = lds_byte(wc * 32 + fr, fq * 8);
#define MK_SA(b, h) (((b) * 2 + (h)) * HTB)
#define MK_SB(b, h) ((4 + (b) * 2 + (h)) * HTB)
#define MK_STAGE(bufoff, gbase, voff) do { _Pragma("unroll") for (int _i = 0; _i < 2; ++_i) \
        __builtin_amdgcn_global_load_lds((const unsigned*)((const char*)(gbase) + (voff)[_i]), (LAS unsigned*)(lds + (bufoff) + ldsw + _i * 8192), 16, 0, 0); } while (0)
#define MK_LDA(dst, b, h) do { _Pragma("unroll") for (int m = 0; m < 4; ++m) _Pragma("unroll") for (int k = 0; k < 2; ++k) dst[m][k] = *(const LAS bf16x8*)(lds + MK_SA(b, h) + aoff + m * 2048 + k * 1024); } while (0)
#define MK_LDB(dst, b, h) do { _Pragma("unroll") for (int n = 0; n < 2; ++n) _Pragma("unroll") for (int k = 0; k < 2; ++k) dst[n][k] = *(const LAS bf16x8*)(lds + MK_SB(b, h) + boff + n * 2048 + k * 1024); } while (0)
#define MK_MMA(ai, bj, At, Bt) do { __builtin_amdgcn_s_setprio(1); _Pragma("unroll") for (int m = 0; m < 4; ++m) _Pragma("unroll") for (int n = 0; n < 2; ++n) _Pragma("unroll") for (int k = 0; k < 2; ++k) \
        acc[ai][bj][m][n] = __builtin_amdgcn_mfma_f32_16x16x32_bf16(Bt[n][k], At[m][k], acc[ai][bj][m][n], 0, 0, 0); __builtin_amdgcn_s_setprio(0); } while (0)
#define MK_WAIT_V(n) asm volatile("s_waitcnt vmcnt(" #n ")" ::: "memory")
#define MK_WAIT_L(n) asm volatile("s_waitcnt lgkmcnt(" #n ")" ::: "memory")
#define MK_BAR __builtin_amdgcn_s_barrier()
#define MK_SCHED __builtin_amdgcn_sched_barrier(0)
    Unit cur, nxt; int ui = 0;
    if (!S.next(0, cur)) return;
    f32x4 acc[2][2][4][2];
#pragma unroll
    for (int a = 0; a < 2; ++a)
#pragma unroll
        for (int b = 0; b < 2; ++b)
#pragma unroll
            for (int m = 0; m < 4; ++m)
#pragma unroll
                for (int n = 0; n < 2; ++n) acc[a][b][m][n] = (f32x4){0.f, 0.f, 0.f, 0.f};
    bf16x8 At[4][2], B0[2][2], B1[2][2];
    unsigned vA[2][2], vAn[2][2];
    const size_t hstepA = GATHER ? 0 : (size_t)HALF * K * 2, tstepA = 2 * (size_t)HALF * K * 2;
    auto a_voff = [&](const Unit& u, unsigned (&vo)[2][2]) {
#pragma unroll
        for (int h = 0; h < 2; ++h)
#pragma unroll
            for (int i = 0; i < 2; ++i) { if (GATHER) { const int row = u.pm * BM + h * HALF + RA[i]; vo[h][i] = (unsigned)((size_t)g.gather[row] * K + CA[i]) * 2u; } else vo[h][i] = (unsigned)(RA[i] * K + CA[i]) * 2u; }
    };
    a_voff(cur, vA);
    auto a_base = [&](const Unit& u) { return (const char*)(u.e ? g.A1 : g.A0) + (GATHER ? (size_t)0 : (size_t)u.pm * tstepA); };
    const char* cA = a_base(cur);
    const char* cB = (const char*)g.Bt + ((size_t)cur.e * g.strideB) * 2 + (size_t)cur.pn * tstepB;
    MK_STAGE(MK_SB(0, 0), cB, voffB); MK_STAGE(MK_SA(0, 0), cA, vA[0]); MK_STAGE(MK_SB(0, 1), cB + hstepB, voffB); MK_STAGE(MK_SA(0, 1), cA + hstepA, vA[1]);
    if (wr == 1) MK_BAR;
    MK_WAIT_V(4); MK_BAR;
    MK_STAGE(MK_SB(1, 0), cB + kstep, voffB); MK_STAGE(MK_SA(1, 0), cA + kstep, vA[0]); MK_STAGE(MK_SB(1, 1), cB + hstepB + kstep, voffB);
    MK_WAIT_V(6); MK_BAR;
    for (;;) {
        const bool has_next = S.next(ui + 1, nxt);
        const char* nA = has_next ? a_base(nxt) : cA;
        const char* nB = has_next ? (const char*)g.Bt + ((size_t)nxt.e * g.strideB) * 2 + (size_t)nxt.pn * tstepB : cB;
        for (int t = 0; t < nt; t += 2) {
            const bool last = (t == nt - 2);
            if (GATHER && last) { if (has_next) a_voff(nxt, vAn); else {
#pragma unroll
                for (int h = 0; h < 2; ++h)
#pragma unroll
                    for (int i = 0; i < 2; ++i) vAn[h][i] = vA[h][i]; } }
            const char* a1 = cA + (size_t)(t + 1) * kstep;
            const char* a2 = last ? nA : cA + (size_t)(t + 2) * kstep; const char* b2 = last ? nB : cB + (size_t)(t + 2) * kstep;
            const char* a3 = a2 + kstep; const char* b3 = b2 + kstep;
            unsigned v2[2][2];
#pragma unroll
            for (int h = 0; h < 2; ++h)
#pragma unroll
                for (int i = 0; i < 2; ++i) v2[h][i] = (GATHER && last) ? vAn[h][i] : vA[h][i];
            MK_LDB(B0, 0, 0); MK_SCHED; MK_LDA(At, 0, 0); MK_STAGE(MK_SA(1, 1), a1 + hstepA, vA[1]);
            MK_WAIT_L(8); MK_BAR; MK_WAIT_L(0); MK_MMA(0, 0, At, B0); MK_BAR; MK_SCHED;
            MK_LDB(B1, 0, 1); MK_STAGE(MK_SB(0, 0), b2, voffB);
            MK_BAR; MK_WAIT_L(0); MK_MMA(0, 1, At, B1); MK_BAR;
            MK_LDA(At, 0, 1); MK_STAGE(MK_SA(0, 0), a2, v2[0]);
            MK_BAR; MK_WAIT_L(0); MK_MMA(1, 0, At, B0); MK_BAR; MK_SCHED;
            MK_STAGE(MK_SB(0, 1), b2 + hstepB, voffB);
            MK_WAIT_V(6); MK_BAR; MK_MMA(1, 1, At, B1); MK_BAR;
            MK_LDB(B0, 1, 0); MK_SCHED; MK_LDA(At, 1, 0); MK_STAGE(MK_SA(0, 1), a2 + hstepA, v2[1]);
            MK_WAIT_L(8); MK_BAR; MK_WAIT_L(0); MK_MMA(0, 0, At, B0); MK_BAR; MK_SCHED;
            MK_LDB(B1, 1, 1); MK_STAGE(MK_SB(1, 0), b3, voffB);
            MK_BAR; MK_WAIT_L(0); MK_MMA(0, 1, At, B1); MK_BAR;
            MK_LDA(At, 1, 1); MK_STAGE(MK_SA(1, 0), a3, v2[0]);
            MK_BAR; MK_WAIT_L(0); MK_MMA(1, 0, At, B0); MK_BAR; MK_SCHED;
            MK_STAGE(MK_SB(1, 1), b3 + hstepB, voffB);
            MK_WAIT_V(6); MK_BAR; MK_MMA(1, 1, At, B1); MK_BAR;
        }
        int fr_ = fr, fq_ = fq; asm volatile("" : "+v"(fr_), "+v"(fq_));
        if (wr == 0) MK_BAR;
        const bool keep = E(acc, cur, wr, wc, fr_, fq_);
        if (wr == 1) MK_BAR;
        if (!has_next) break;
        if (!keep) {
#pragma unroll
            for (int a = 0; a < 2; ++a)
#pragma unroll
                for (int b = 0; b < 2; ++b)
#pragma unroll
                    for (int m = 0; m < 4; ++m)
#pragma unroll
                        for (int n = 0; n < 2; ++n) acc[a][b][m][n] = (f32x4){0.f, 0.f, 0.f, 0.f};
        }
        cur = nxt; cA = nA; cB = nB; ++ui;
        if (GATHER) {
#pragma unroll
            for (int h = 0; h < 2; ++h)
#pragma unroll
                for (int i = 0; i < 2; ++i) vA[h][i] = vAn[h][i]; }
    }
    MK_WAIT_V(0);
    if (wr == 0) MK_BAR;
    MK_BAR;
#undef MK_SA
#undef MK_SB
#undef MK_STAGE
#undef MK_LDA
#undef MK_LDB
#undef MK_MMA
#undef MK_WAIT_V
#undef MK_WAIT_L
#undef MK_BAR
#undef MK_SCHED
}

__device__ __forceinline__ u32x4 pack8(const f32x4 a, const f32x4 b) { u32x4 w; w.x = cvt_pk_bf16(a[0], a[1]); w.y = cvt_pk_bf16(a[2], a[3]); w.z = cvt_pk_bf16(b[0], b[1]); w.w = cvt_pk_bf16(b[2], b[3]); return w; }
struct EpiStoreBf16 {
    bf16_t* O; long ldc;
    __device__ __forceinline__ bool operator()(const f32x4 (&acc)[2][2][4][2], const Unit& u, int wr, int wc, int fr, int fq) const {
        MK_FRAG_LOOP(r, c) { *(u32x4*)(O + (size_t)(u.pm * BM + r) * ldc + u.pn * BM + c) = pack8(acc[ai][bj][m][0], acc[ai][bj][m][1]); }
        return false;
    }
};

__device__ __forceinline__ void ld8_contig(const float* p, float (&o)[8]) { const f32x4 a = *(const f32x4*)p, b = *(const f32x4*)(p + 4); o[0] = a[0]; o[1] = a[1]; o[2] = a[2]; o[3] = a[3]; o[4] = b[0]; o[5] = b[1]; o[6] = b[2]; o[7] = b[3]; }
struct CMapZ1 { __device__ int operator()(int n) const { return n < RC ? n : (n < Z1_LX ? -1 : OFF_LX + (n - Z1_LX)); }
    __device__ __forceinline__ void load8(const float* rowp, int n, float (&o)[8]) const { const int sc = (*this)(n); if (sc >= 0) ld8_contig(rowp + sc, o); else {
#pragma unroll
        for (int j = 0; j < 8; ++j) o[j] = 0.f; } } };
struct CMapZC { __device__ int operator()(int n) const { return OFF_LG + n; }
    __device__ __forceinline__ void load8(const float* rowp, int n, float (&o)[8]) const { ld8_contig(rowp + OFF_LG + n, o); } };
struct CMapId { __device__ int operator()(int n) const { return n; }
    __device__ __forceinline__ void load8(const float* rowp, int n, float (&o)[8]) const { ld8_contig(rowp + n, o); } };
struct CMapGU { int F; __device__ int operator()(int n) const { return (n & 1) * F + (n >> 1); }
    __device__ __forceinline__ void load8(const float* rowp, int n, float (&o)[8]) const { const f32x4 g = *(const f32x4*)(rowp + (n >> 1)), u = *(const f32x4*)(rowp + F + (n >> 1));
        o[0] = g[0]; o[1] = u[0]; o[2] = g[1]; o[3] = u[1]; o[4] = g[2]; o[5] = u[2]; o[6] = g[3]; o[7] = u[3]; } };
constexpr int CT_B = 4;
template <class CM>
__device__ __forceinline__ void convT_job(LAS float* tile  , const float* src, int lds_, int Ks, bf16_t* dst, int Kd, int N, const CM& cm, int bid, int nblk, int& base) {
    const int tk = Kd / 64, nt = (N / 64) * tk, tid = threadIdx.x;
    const int first = (bid - base % nblk + nblk) % nblk;
    const int kk = tid >> 3, nn8 = (tid & 7) * 8, nn = tid >> 3, kk8 = (tid & 7) * 8;
    for (int t0 = first; t0 < nt; t0 += CT_B * nblk) {
        float v[CT_B][8];
#pragma unroll
        for (int b = 0; b < CT_B; ++b) { const int t = t0 + b * nblk; const int n0 = (t / tk) * 64, k0 = (t % tk) * 64, k = k0 + kk;
            if (t < nt && k < Ks) cm.load8(src + (size_t)k * lds_, n0 + nn8, v[b]); else {
#pragma unroll
                for (int j = 0; j < 8; ++j) v[b][j] = 0.f; } }
#pragma unroll
        for (int b = 0; b < CT_B; ++b)
#pragma unroll
            for (int j = 0; j < 8; ++j) tile[b * 64 * 65 + kk * 65 + nn8 + j] = v[b][j];
        __syncthreads();
#pragma unroll
        for (int b = 0; b < CT_B; ++b) { const int t = t0 + b * nblk; if (t < nt) { const int n0 = (t / tk) * 64, k0 = (t % tk) * 64; f32x4 a, c;
#pragma unroll
            for (int j = 0; j < 4; ++j) { a[j] = tile[b * 64 * 65 + (kk8 + j) * 65 + nn]; c[j] = tile[b * 64 * 65 + (kk8 + 4 + j) * 65 + nn]; }
            *(u32x4*)(dst + (size_t)(n0 + nn) * Kd + k0 + kk8) = pack8(a, c); } }
        __syncthreads();
    }
    base += nt;
}

constexpr int MOD_SL = 16, MOD_KS = D / MOD_SL;
__device__ __forceinline__ void mod_partials(LAS float* sl  , const In& in, float* part  , int bid, int nblk) {
    const int ncc = 6 * D / NT, nitem = MOD_SL * ncc;
    for (int it = bid; it < nitem; it += nblk) {
        const int s = it / ncc, j = (it % ncc) * NT + threadIdx.x;
        for (int i = threadIdx.x; i < (NB + 1) * MOD_KS; i += NT) { const int r = i / MOD_KS, k = s * MOD_KS + i % MOD_KS; const float cv = r < NB ? in.c[r * D + k] : in.c_ctx[k]; sl[i] = siluf_(cv); }
        __syncthreads();
        float acc[NB + 1];
#pragma unroll
        for (int r = 0; r <= NB; ++r) acc[r] = 0.f;
        for (int k = 0; k < MOD_KS; ++k) { const float w = in.w_mod[(size_t)(s * MOD_KS + k) * 6 * D + j];
#pragma unroll
            for (int r = 0; r <= NB; ++r) acc[r] += sl[r * MOD_KS + k] * w; }
#pragma unroll
        for (int r = 0; r <= NB; ++r) part[((size_t)s * (NB + 1) + r) * 6 * D + j] = acc[r];
        __syncthreads();
    }
}
__device__ __forceinline__ float mod_value(const In& in, const float* part, int r, int j) {
    float s = in.b_mod[j];
#pragma unroll
    for (int q = 0; q < MOD_SL; ++q) s += part[((size_t)q * (NB + 1) + r) * 6 * D + j];
    return s;
}

__device__ __forceinline__ void xn_rows(LAS float* sm  , const In& in, const float* part, bf16_t* xn, int b0, int nb, int row_lo, int row_hi) {
    const int nlat = nb * SEQ, wid = threadIdx.x >> 6, lane = threadIdx.x & 63;
    int cur_mr = -1;
    float gp[16];
#pragma unroll
    for (int j = 0; j < 4; ++j)
#pragma unroll
        for (int q = 0; q < 4; ++q) gp[4 * j + q] = in.norm_g[j * 256 + lane * 4 + q];
    for (int rbase = row_lo; rbase < row_hi; rbase += 8) {
        const int mr = rbase < nlat ? b0 + rbase / SEQ : NB;
        if (mr != cur_mr) { __syncthreads(); for (int j = threadIdx.x; j < 2 * D; j += NT) sm[j] = mod_value(in, part, mr, j); __syncthreads(); cur_mr = mr; }
        const int r = rbase + wid; if (r >= row_hi) continue;
        const float* src = r < nlat ? in.x + ((size_t)b0 * SEQ + r) * D : in.ctx + ((size_t)b0 * CTX + (r - nlat)) * D;
        f32x4 v[4]; float ss = 0.f;
#pragma unroll
        for (int j = 0; j < 4; ++j) { v[j] = *(const f32x4*)(src + j * 256 + lane * 4); ss += v[j][0] * v[j][0] + v[j][1] * v[j][1] + v[j][2] * v[j][2] + v[j][3] * v[j][3]; }
#pragma unroll
        for (int o = 32; o > 0; o >>= 1) ss += __shfl_xor(ss, o);
        const float rinv = 1.f / sqrtf(ss * (1.f / D) + NORM_EPS);
#pragma unroll
        for (int j = 0; j < 4; ++j) { const int c = j * 256 + lane * 4; float o[4];
#pragma unroll
            for (int q = 0; q < 4; ++q) o[q] = (v[j][q] * rinv * gp[4 * j + q]) * (1.f + sm[D + c + q]) + sm[c + q];
            u32x2 w; w.x = cvt_pk_bf16(o[0], o[1]); w.y = cvt_pk_bf16(o[2], o[3]); *(u32x2*)(xn + (size_t)r * D + c) = w; }
    }
}
}

namespace mk {
#define XB_TMO      128
#define XB_XCNT(j)  (256  + 64 * (j))
#define XB_XSUB(j)  (1280 + 64 * (j))
#define XB_XGEN(j)  (2304 + 64 * (j))
#define XB_TOP      3328
#define XB_TOPGEN   3392
#define XCD_BAR_WORDS 3456
#define XB_SPIN_CAP (1u << 18)
__device__ __forceinline__ unsigned xb_ld(unsigned* p)              { return __hip_atomic_load(p, __ATOMIC_RELAXED, __HIP_MEMORY_SCOPE_AGENT); }
__device__ __forceinline__ unsigned xb_add(unsigned* p, unsigned v) { return __hip_atomic_fetch_add(p, v, __ATOMIC_RELAXED, __HIP_MEMORY_SCOPE_AGENT); }
__device__ __forceinline__ unsigned xb_xcc_id() { return (unsigned)__builtin_amdgcn_s_getreg((3 << 11) | 20) & 0xFu; }
#define XB_SPIN(cond, bar) do { unsigned _sp = 0; while (cond) { __builtin_amdgcn_s_sleep(1); \
    if ((++_sp & 255u) == 0u) { if (xb_ld(&(bar)[XB_TMO])) break; if (_sp > XB_SPIN_CAP) { atomicAdd(&(bar)[XB_TMO], 1u); break; } } } } while (0)
struct XcdBarrier { unsigned* bar; unsigned x; volatile LAS unsigned* st; };
__device__ __forceinline__ XcdBarrier xcd_barrier_post(unsigned* bar, volatile LAS unsigned* st) {
    XcdBarrier b; b.bar = bar; b.x = xb_xcc_id(); b.st = st;
    if (threadIdx.x == 0) (void)xb_add(&bar[XB_XCNT(b.x)], 1u);
    return b;
}
__device__ __forceinline__ void xcd_barrier_complete(unsigned* bar, unsigned x, unsigned& nloc, unsigned& nx) {
    const unsigned G = gridDim.x * gridDim.y * gridDim.z;
    unsigned sum, cnt, mine, sp = 0u;
    for (;;) {
        sum = 0u; cnt = 0u; mine = 0u;
#pragma unroll
        for (unsigned j = 0; j < 16; ++j) { const unsigned c = xb_ld(&bar[XB_XCNT(j)]); sum += c; cnt += (c > 0u) ? 1u : 0u; mine = (j == x) ? c : mine; }
        if (sum == G) break;
        __builtin_amdgcn_s_sleep(1);
        if ((++sp & 255u) == 0u) { if (xb_ld(&bar[XB_TMO])) break; if (sp > XB_SPIN_CAP) { atomicAdd(&bar[XB_TMO], 1u); break; } }
    }
    nloc = mine > 0u ? mine : 1u; nx = cnt > 0u ? cnt : 1u;
}
__device__ __forceinline__ void xcd_barrier(const XcdBarrier& b) {
    asm volatile("s_waitcnt vmcnt(0)" ::: "memory");
    __syncthreads();
    if (threadIdx.x == 0) {
        unsigned* bar = b.bar;
        __builtin_amdgcn_s_waitcnt(0);
        unsigned nloc = b.st[0], nx = b.st[1];
        if (nloc == 0u) { xcd_barrier_complete(bar, b.x, nloc, nx); b.st[0] = nloc; b.st[1] = nx; }
        const unsigned old = xb_add(&bar[XB_XSUB(b.x)], 1u);
        const unsigned gen = old / nloc;
        if (old + 1u == (gen + 1u) * nloc) {
            __builtin_amdgcn_fence(__ATOMIC_RELEASE, "agent");
            asm volatile("s_waitcnt vmcnt(0)" ::: "memory");
            const unsigned og = xb_add(&bar[XB_TOP], 1u);
            const unsigned tg = og / nx;
            if (og + 1u == (tg + 1u) * nx) xb_add(&bar[XB_TOPGEN], 1u);
            else XB_SPIN(xb_ld(&bar[XB_TOPGEN]) == tg, bar);
            __builtin_amdgcn_fence(__ATOMIC_ACQUIRE, "agent");
            xb_add(&bar[XB_XGEN(b.x)], 1u);
            asm volatile("s_waitcnt vmcnt(0)" ::: "memory");
        } else {
            XB_SPIN(xb_ld(&bar[XB_XGEN(b.x)]) == gen, bar);
            __builtin_amdgcn_fence(__ATOMIC_ACQUIRE, "agent");
            asm volatile("s_waitcnt vmcnt(0)" ::: "memory");
        }
    }
    __syncthreads();
}
}

namespace mk {
constexpr int TB = 32;
constexpr int RAWW = 320;
constexpr int RW_RAW = 0;
constexpr int RW_MU = RW_RAW + (TB + 2) * RAWW * 2;
constexpr int RW_WUP = RW_MU + 2 * RAWW * 4;
constexpr int RW_AUP = RW_WUP + 64 * 72 * 2;
constexpr int RW_CST = RW_AUP + 64 * 72 * 2;
constexpr int RW_AWD = RW_CST + 5 * 64 * 4;
constexpr int RW_AAD = RW_AWD + TB * 72 * 2;
constexpr int RW_R = RW_AAD + TB * 72 * 2;
constexpr int RW_KR = RW_R + TB * 64 * 4;
constexpr int RW_LA = RW_KR + TB * 64 * 4;
constexpr int RW_KK = RW_LA + TB * 64 * 4;
constexpr int RW_W = RW_KK + TB * 64 * 4;
constexpr int RW_B = RW_W + TB * 64 * 4;
constexpr int RW_KD = RW_B + TB * 64 * 4;
constexpr int RW_WR = RW_KD + TB * 64 * 4;
constexpr int RW_V = RW_WR + TB * 64 * 4;
constexpr int RW_SC = RW_V + TB * 64 * 4;
constexpr int RW_YO = RW_SC + TB * 2 * 4;
constexpr int RW_BON = RW_YO + TB * 64 * 4;
constexpr int RW_END = RW_BON + TB * 4;
static_assert(RW_END <= LDS_BYTES, "rwkv LDS");

#define MK_DPP(x, ctrl) __int_as_float(__builtin_amdgcn_update_dpp(__float_as_int(x), __float_as_int(x), ctrl, 0xF, 0xF, false))
__device__ __forceinline__ float allreduce16(float x) {
    x += MK_DPP(x, 0xB1); x += MK_DPP(x, 0x4E); x += MK_DPP(x, 0x141); x += MK_DPP(x, 0x140); return x;
}

__device__ __forceinline__ void allreduce16x4(float& a, float& b, float& c, float& d) {
    asm volatile("s_nop 1\n\t"
        "v_add_f32_dpp %0, %0, %0 quad_perm:[1,0,3,2] row_mask:0xf bank_mask:0xf\n\t" "v_add_f32_dpp %1, %1, %1 quad_perm:[1,0,3,2] row_mask:0xf bank_mask:0xf\n\t"
        "v_add_f32_dpp %2, %2, %2 quad_perm:[1,0,3,2] row_mask:0xf bank_mask:0xf\n\t" "v_add_f32_dpp %3, %3, %3 quad_perm:[1,0,3,2] row_mask:0xf bank_mask:0xf\n\t"
        "v_add_f32_dpp %0, %0, %0 quad_perm:[2,3,0,1] row_mask:0xf bank_mask:0xf\n\t" "v_add_f32_dpp %1, %1, %1 quad_perm:[2,3,0,1] row_mask:0xf bank_mask:0xf\n\t"
        "v_add_f32_dpp %2, %2, %2 quad_perm:[2,3,0,1] row_mask:0xf bank_mask:0xf\n\t" "v_add_f32_dpp %3, %3, %3 quad_perm:[2,3,0,1] row_mask:0xf bank_mask:0xf\n\t"
        "v_add_f32_dpp %0, %0, %0 row_half_mirror row_mask:0xf bank_mask:0xf\n\t" "v_add_f32_dpp %1, %1, %1 row_half_mirror row_mask:0xf bank_mask:0xf\n\t"
        "v_add_f32_dpp %2, %2, %2 row_half_mirror row_mask:0xf bank_mask:0xf\n\t" "v_add_f32_dpp %3, %3, %3 row_half_mirror row_mask:0xf bank_mask:0xf\n\t"
        "v_add_f32_dpp %0, %0, %0 row_mirror row_mask:0xf bank_mask:0xf\n\t" "v_add_f32_dpp %1, %1, %1 row_mirror row_mask:0xf bank_mask:0xf\n\t"
        "v_add_f32_dpp %2, %2, %2 row_mirror row_mask:0xf bank_mask:0xf\n\t" "v_add_f32_dpp %3, %3, %3 row_mirror row_mask:0xf bank_mask:0xf"
        : "+v"(a), "+v"(b), "+v"(c), "+v"(d));
}
struct RwkvP { const bf16_t* z1; bf16_t* Y; float* bon; int b0, nb; };

constexpr int RW_NPIECE = (TB + 2) * 40, RW_PPT = (RW_NPIECE + NT - 1) / NT;

__device__ __forceinline__ void rwkv_chain(LAS unsigned char* lds, const In& in, const RwkvP p, int chain) {
    const int tid = threadIdx.x, lane = tid & 63, wid = tid >> 6;
    const int d = chain / (p.nb * NH), bl = (chain / NH) % p.nb, h = chain % NH;
    const int nlat = p.nb * SEQ;
    LAS bf16_t* RAW = (LAS bf16_t*)(lds + RW_RAW); LAS float* MU = (LAS float*)(lds + RW_MU);
    LAS bf16_t* WUP = (LAS bf16_t*)(lds + RW_WUP); LAS bf16_t* AUP = (LAS bf16_t*)(lds + RW_AUP); LAS float* CST = (LAS float*)(lds + RW_CST);
    LAS bf16_t* AWD = (LAS bf16_t*)(lds + RW_AWD); LAS bf16_t* AAD = (LAS bf16_t*)(lds + RW_AAD);
    LAS float *Rr = (LAS float*)(lds + RW_R), *KR = (LAS float*)(lds + RW_KR), *LA_ = (LAS float*)(lds + RW_LA);
    LAS float *KK = (LAS float*)(lds + RW_KK), *Wv = (LAS float*)(lds + RW_W), *Bv = (LAS float*)(lds + RW_B), *KD = (LAS float*)(lds + RW_KD), *WR = (LAS float*)(lds + RW_WR), *Vv = (LAS float*)(lds + RW_V);
    LAS float *SC = (LAS float*)(lds + RW_SC), *YO = (LAS float*)(lds + RW_YO), *BON = (LAS float*)(lds + RW_BON);
    auto segcol = [&](int s) { return s < 3 ? s * RW + h * 64 : (s == 3 ? OFF_WD + d * DL : OFF_AD + d * AL); };
    for (int i = tid; i < 2 * RAWW; i += NT) { const int m = i / RAWW, c = i % RAWW; MU[i] = in.shift_mu[m * RC + segcol(c >> 6) + (c & 63)]; }
    for (int i = tid; i < 64 * 64; i += NT) { const int j = i >> 6, c = i & 63;
        WUP[c * 72 + j] = f2bf(in.rw_w_up[((size_t)d * DL + j) * RW + h * 64 + c]); AUP[c * 72 + j] = f2bf(in.rw_a_up[((size_t)d * AL + j) * RW + h * 64 + c]); }
    for (int i = tid; i < 64; i += NT) { CST[i] = in.rw_w0[d * RW + h * 64 + i]; CST[64 + i] = in.rw_a0[d * RW + h * 64 + i]; CST[128 + i] = in.rw_k_k[h * 64 + i]; CST[192 + i] = in.rw_k_a[h * 64 + i]; CST[256 + i] = in.rw_r_k[h * 64 + i]; }
    constexpr int NQ = (CTX + SEQ) / TB, NQC = CTX / TB;
    auto blk_info = [&](int q, bool& isctx, int& t0, bool& hp, bool& hn, size_t& grow0) {
        isctx = q < NQC;
        if (isctx) { const int qq = d == 0 ? q : NQC - 1 - q; t0 = qq * TB; hp = t0 > 0; hn = t0 + TB < CTX; grow0 = (size_t)nlat + (size_t)bl * CTX + t0; }
        else { const int ql = q - NQC, qq = d == 0 ? ql : SEQ / TB - 1 - ql; t0 = qq * TB; hp = (t0 % GW) != 0; hn = ((t0 + TB) % GW) != 0; grow0 = (size_t)bl * SEQ + t0; }
    };
    u32x4 pre[RW_PPT];
    auto prefetch = [&](int q) {
        bool isctx, hp, hn; int t0; size_t grow0; blk_info(q, isctx, t0, hp, hn, grow0);
#pragma unroll
        for (int k = 0; k < RW_PPT; ++k) { const int i = tid + k * NT; u32x4 v = (u32x4){0u, 0u, 0u, 0u};
            if (i < RW_NPIECE) { const int rr = i / 40, sp = i % 40, seg = sp >> 3, part = sp & 7;
                const bool ok = (rr == 0) ? hp : ((rr == TB + 1) ? hn : true);
                if (ok) v = *(const u32x4*)(p.z1 + (grow0 + rr - 1) * Z1_N + segcol(seg) + part * 8); }
            pre[k] = v; }
    };
    auto commit = [&]() {
#pragma unroll
        for (int k = 0; k < RW_PPT; ++k) { const int i = tid + k * NT; if (i < RW_NPIECE) { const int rr = i / 40, sp = i % 40; *(LAS u32x4*)(RAW + rr * RAWW + sp * 8) = pre[k]; } }
    };
    float S[2][4];
#pragma unroll
    for (int i = 0; i < 2; ++i)
#pragma unroll
        for (int j = 0; j < 4; ++j) S[i][j] = 0.f;
    const int kg = lane & 15, rp = (lane >> 4) + 4 * wid;
    prefetch(0);
    for (int q = 0; q < NQ; ++q) {
        bool isctx, hp, hn; int t0; size_t grow0; blk_info(q, isctx, t0, hp, hn, grow0);
        commit();
        __syncthreads();
        if (q + 1 < NQ) prefetch(q + 1);
        auto shift8 = [&](int t, int c0, float (&s)[8]) {
            const u32x4 xp = *(const LAS u32x4*)(RAW + t * RAWW + c0), xc = *(const LAS u32x4*)(RAW + (t + 1) * RAWW + c0), xn_ = *(const LAS u32x4*)(RAW + (t + 2) * RAWW + c0);
            const f32x4 m0a = *(const LAS f32x4*)(MU + c0), m0b = *(const LAS f32x4*)(MU + c0 + 4), m1a = *(const LAS f32x4*)(MU + RAWW + c0), m1b = *(const LAS f32x4*)(MU + RAWW + c0 + 4);
#pragma unroll
            for (int j = 0; j < 4; ++j) { const unsigned a = xp[j], b = xc[j], c = xn_[j];
                const float mu0l = j < 2 ? m0a[2 * j] : m0b[2 * j - 4], mu0h = j < 2 ? m0a[2 * j + 1] : m0b[2 * j - 3], mu1l = j < 2 ? m1a[2 * j] : m1b[2 * j - 4], mu1h = j < 2 ? m1a[2 * j + 1] : m1b[2 * j - 3];
                { const float x = bflo(b); s[2 * j] = x + mu0l * (bflo(a) - x) + mu1l * (bflo(c) - x); }
                { const float x = bfhi(b); s[2 * j + 1] = x + mu0h * (bfhi(a) - x) + mu1h * (bfhi(c) - x); } } };
        for (int it = tid; it < TB * 24; it += NT) {
            const int t = it / 24, g = it % 24, seg = g >> 3, cc = (g & 7) * 8; float s[8]; shift8(t, g * 8, s);
            LAS float* dst = (seg == 0 ? Rr : (seg == 1 ? KR : Vv)) + t * 64 + cc; *(LAS f32x4*)dst = (f32x4){s[0], s[1], s[2], s[3]}; *(LAS f32x4*)(dst + 4) = (f32x4){s[4], s[5], s[6], s[7]};
        }
        { const int t = tid >> 4, g = 24 + (tid & 15), cc = (g & 7) * 8; float s[8]; shift8(t, g * 8, s);
          const bool isw = (tid & 15) < 8;
#pragma unroll
          for (int j = 0; j < 8; ++j) { const float th = fast_tanh(s[j]); s[j] = isw ? th : s[j]; }
          LAS bf16_t* dst = (isw ? AWD : AAD) + t * 72 + cc;
          u32x4 w; w.x = cvt_pk_bf16(s[0], s[1]); w.y = cvt_pk_bf16(s[2], s[3]); w.z = cvt_pk_bf16(s[4], s[5]); w.w = cvt_pk_bf16(s[6], s[7]); *(LAS u32x4*)dst = w; }
        __syncthreads();
        {
            const int lora = wid >> 2, ct = wid & 3, fr = lane & 15, fq = lane >> 4;
            const LAS bf16_t* Am = lora ? AAD : AWD; const LAS bf16_t* Bm = lora ? AUP : WUP;
#pragma unroll
            for (int rt = 0; rt < 2; ++rt) {
                f32x4 acc = (f32x4){0.f, 0.f, 0.f, 0.f};
#pragma unroll
                for (int ks = 0; ks < 2; ++ks) {
                    const bf16x8 a = *(const LAS bf16x8*)(Am + (rt * 16 + fr) * 72 + ks * 32 + fq * 8);
                    const bf16x8 b = *(const LAS bf16x8*)(Bm + (ct * 16 + fr) * 72 + ks * 32 + fq * 8);
                    acc = __builtin_amdgcn_mfma_f32_16x16x32_bf16(a, b, acc, 0, 0, 0);
                }
                const int col = ct * 16 + fr;
#pragma unroll
                for (int i = 0; i < 4; ++i) { const int t = rt * 16 + fq * 4 + i;
                    if (lora == 0) { const float lw = acc[i] + CST[col]; const float wl = -fast_softplus(-lw) - 0.5f; Wv[t * 64 + col] = __expf(-__expf(wl)); }
                    else { LA_[t * 64 + col] = fast_sigmoid(acc[i] + CST[64 + col]); } }
            }
        }
        __syncthreads();
        {
            const int t = tid >> 4, c4 = (tid & 15) * 4;
            const f32x4 k = *(const LAS f32x4*)(KR + t * 64 + c4), a = *(const LAS f32x4*)(LA_ + t * 64 + c4), w = *(const LAS f32x4*)(Wv + t * 64 + c4), r = *(const LAS f32x4*)(Rr + t * 64 + c4);
            f32x4 kkr, kd, bb, wr; float ss = 0.f, br = 0.f, kr = 0.f, bn = 0.f;
#pragma unroll
            for (int j = 0; j < 4; ++j) { kkr[j] = k[j] * CST[128 + c4 + j]; ss += kkr[j] * kkr[j]; }
            ss = allreduce16(ss);
            const float inv = 1.f / fmaxf(sqrtf(ss), 1e-12f);
#pragma unroll
            for (int j = 0; j < 4; ++j) { const float kk = kkr[j] * inv; kkr[j] = kk; kd[j] = k[j] * (1.f + (a[j] - 1.f) * CST[192 + c4 + j]); bb[j] = kk * a[j]; wr[j] = w[j] * r[j];
                br += bb[j] * r[j]; kr += kd[j] * r[j]; bn += r[j] * kd[j] * CST[256 + c4 + j]; }
            br = allreduce16(br); kr = allreduce16(kr); bn = allreduce16(bn);
            *(LAS f32x4*)(KK + t * 64 + c4) = kkr; *(LAS f32x4*)(KD + t * 64 + c4) = kd; *(LAS f32x4*)(Bv + t * 64 + c4) = bb; *(LAS f32x4*)(WR + t * 64 + c4) = wr;
            if ((tid & 15) == 0) { SC[t * 2] = br; SC[t * 2 + 1] = kr; BON[t] = bn; }
        }
        __syncthreads();
        {
            auto tof = [&](int st) { return d == 0 ? st : TB - 1 - st; };
            const LAS float* lb = KK + 4 * kg;
            const LAS float* vb = Vv + 2 * rp;
            constexpr int OW = (RW_W - RW_KK) / 4, OB = (RW_B - RW_KK) / 4, OKD = (RW_KD - RW_KK) / 4, OWR = (RW_WR - RW_KK) / 4;
            int t = tof(0);
            f32x4 kk4 = *(const LAS f32x4*)(lb + t * 64), w4 = *(const LAS f32x4*)(lb + t * 64 + OW), b4 = *(const LAS f32x4*)(lb + t * 64 + OB),
                  kd4 = *(const LAS f32x4*)(lb + t * 64 + OKD), wr4 = *(const LAS f32x4*)(lb + t * 64 + OWR);
            f32x2 vv = *(const LAS f32x2*)(vb + t * 64), sc = *(const LAS f32x2*)(SC + t * 2);
            f32x2 S2[4];
#pragma unroll
            for (int j = 0; j < 4; ++j) { S2[j][0] = S[0][j]; S2[j][1] = S[1][j]; }
#pragma unroll 2
            for (int st = 0; st < TB; ++st) {
                const int tn = tof(st + 1 < TB ? st + 1 : st);
                const f32x4 nkk4 = *(const LAS f32x4*)(lb + tn * 64), nw4 = *(const LAS f32x4*)(lb + tn * 64 + OW), nb4 = *(const LAS f32x4*)(lb + tn * 64 + OB),
                            nkd4 = *(const LAS f32x4*)(lb + tn * 64 + OKD), nwr4 = *(const LAS f32x4*)(lb + tn * 64 + OWR);
                const f32x2 nvv = *(const LAS f32x2*)(vb + tn * 64), nsc = *(const LAS f32x2*)(SC + tn * 2);
                f32x2 sa2 = S2[0] * kk4[0], yo2 = S2[0] * wr4[0];
#pragma unroll
                for (int j = 1; j < 4; ++j) { sa2 += S2[j] * kk4[j]; yo2 += S2[j] * wr4[j]; }
                float sa0 = sa2[0], sa1 = sa2[1], yo0 = yo2[0], yo1 = yo2[1];
                allreduce16x4(sa0, sa1, yo0, yo1);
                f32x2 sar; sar[0] = sa0; sar[1] = sa1;
#pragma unroll
                for (int j = 0; j < 4; ++j) S2[j] = S2[j] * w4[j] + (vv * kd4[j] - sar * b4[j]);
                if (kg == 0) { f32x2 yor; yor[0] = yo0; yor[1] = yo1; const f32x2 y = yor - sar * sc[0] + vv * sc[1]; *(LAS f32x2*)(YO + t * 64 + 2 * rp) = y; }
                kk4 = nkk4; w4 = nw4; b4 = nb4; kd4 = nkd4; wr4 = nwr4; vv = nvv; sc = nsc; t = tn;
            }
#pragma unroll
            for (int j = 0; j < 4; ++j) { S[0][j] = S2[j][0]; S[1][j] = S2[j][1]; }
        }
        __syncthreads();
        if (!isctx) {
            const int t = tid >> 4, c4 = (tid & 15) * 4; const f32x4 y = *(const LAS f32x4*)(YO + t * 64 + c4);
            u32x2 w; w.x = cvt_pk_bf16(y[0], y[1]); w.y = cvt_pk_bf16(y[2], y[3]);
            *(u32x2*)(p.Y + ((size_t)d * nlat + grow0 + t) * RW + h * 64 + c4) = w;
            if (tid < TB) p.bon[((size_t)d * nlat + grow0 + tid) * NH + h] = BON[tid];
        }
    }
}
__device__ __forceinline__ void rwkv_phase(LAS unsigned char* lds, const In& in, const RwkvP p, int bid, int nblk) {
    const int nchain = 2 * p.nb * NH;
    for (int c = bid; c < nchain; c += nblk) { rwkv_chain(lds, in, p, c); __syncthreads(); }
}
}

namespace mk {
constexpr int C2_RAW = 0;
constexpr int C2_MU = C2_RAW + (TB + 2) * RAWW * 2;
constexpr int C2_WUP = C2_MU + 2 * RAWW * 4;
constexpr int C2_AUP = C2_WUP + 64 * 72 * 2;
constexpr int C2_CST = C2_AUP + 64 * 72 * 2;
constexpr int C2_AWD = C2_CST + 5 * 64 * 4;
constexpr int C2_AAD = C2_AWD + TB * 72 * 2;
constexpr int C2_X = C2_AAD + TB * 72 * 2;
constexpr int C2_R = C2_X, C2_KR = C2_R + TB * 64 * 4, C2_V = C2_KR + TB * 64 * 4, C2_E = C2_V + TB * 64 * 4, C2_LA = C2_E + TB * 64 * 4, C2_CUM = C2_LA + TB * 64 * 4, C2_X_END = C2_CUM + TB * 64 * 4;
constexpr int C2_YO = C2_X;
constexpr int C2_G = C2_YO + TB * 64 * 4;
constexpr int C2_UB = C2_G + 64 * 36 * 4;
constexpr int C2_ABT = C2_UB + 64 * 40 * 2;
constexpr int C2_AKT = C2_ABT + 32 * 32 * 4;
constexpr int C2_NBT = C2_AKT + 32 * 40 * 2;
constexpr int C2_NKT = C2_NBT + 32 * 40 * 2;
static_assert(C2_NKT + 32 * 40 * 2 <= C2_X_END, "region X reuse");
constexpr int C2_KKS = C2_X_END;
constexpr int C2_BS = C2_KKS + TB * 72 * 2, C2_KDS = C2_BS + TB * 72 * 2, C2_RS = C2_KDS + TB * 72 * 2;
constexpr int C2_BST = C2_RS + TB * 72 * 2;
constexpr int C2_KDST = C2_BST + 64 * 40 * 2;
constexpr int C2_VT = C2_KDST + 64 * 40 * 2;
constexpr int C2_S0B = C2_VT + 64 * 40 * 2;
constexpr int C2_GC = C2_S0B + 64 * 72 * 2;
constexpr int C2_BON = C2_GC + 64 * 4;
constexpr int C2_END = C2_BON + TB * 4;
static_assert(C2_END <= LDS_BYTES - 16 && (C2_X % 16) == 0 && (C2_KKS % 16) == 0 && (C2_G % 16) == 0 && (C2_UB % 16) == 0 && (C2_ABT % 16) == 0 && (C2_AKT % 16) == 0 && (C2_S0B % 16) == 0, "rwkv2 LDS");

__device__ __forceinline__ bf16x8 ldsb8(const LAS bf16_t* p) { return *(const LAS bf16x8*)p; }

template <int MODE>
__device__ __forceinline__ void rwkv_chain2(LAS unsigned char* lds, const In& in, const RwkvP p, int chain) {
    const int tid = threadIdx.x, lane = tid & 63, wid = tid >> 6, fr = lane & 15, fq = lane >> 4;
    const int d = chain / (p.nb * NH), bl = (chain / NH) % p.nb, h = chain % NH;
    const int nlat = p.nb * SEQ;
    LAS bf16_t* RAW = (LAS bf16_t*)(lds + C2_RAW); LAS float* MU = (LAS float*)(lds + C2_MU);
    LAS bf16_t* WUP = (LAS bf16_t*)(lds + C2_WUP); LAS bf16_t* AUP = (LAS bf16_t*)(lds + C2_AUP); LAS float* CST = (LAS float*)(lds + C2_CST);
    LAS bf16_t* AWD = (LAS bf16_t*)(lds + C2_AWD); LAS bf16_t* AAD = (LAS bf16_t*)(lds + C2_AAD);
    LAS float *Rr = (LAS float*)(lds + C2_R), *KR = (LAS float*)(lds + C2_KR), *Vv = (LAS float*)(lds + C2_V), *Ee = (LAS float*)(lds + C2_E), *LA_ = (LAS float*)(lds + C2_LA), *CUM = (LAS float*)(lds + C2_CUM);
    LAS float *YO = (LAS float*)(lds + C2_YO), *Gm = (LAS float*)(lds + C2_G), *ABT = (LAS float*)(lds + C2_ABT), *GC = (LAS float*)(lds + C2_GC), *BON = (LAS float*)(lds + C2_BON);
    LAS bf16_t *UB = (LAS bf16_t*)(lds + C2_UB), *AKT = (LAS bf16_t*)(lds + C2_AKT), *NBT = (LAS bf16_t*)(lds + C2_NBT), *NKT = (LAS bf16_t*)(lds + C2_NKT);
    LAS bf16_t *KKS = (LAS bf16_t*)(lds + C2_KKS), *BS = (LAS bf16_t*)(lds + C2_BS), *KDS = (LAS bf16_t*)(lds + C2_KDS), *RS = (LAS bf16_t*)(lds + C2_RS);
    LAS bf16_t *BST = (LAS bf16_t*)(lds + C2_BST), *KDST = (LAS bf16_t*)(lds + C2_KDST), *VT = (LAS bf16_t*)(lds + C2_VT), *S0B = (LAS bf16_t*)(lds + C2_S0B);
    auto segcol = [&](int s) { return s < 3 ? s * RW + h * 64 : (s == 3 ? OFF_WD + d * DL : OFF_AD + d * AL); };
    for (int i = tid; i < 2 * RAWW; i += NT) { const int m = i / RAWW, c = i % RAWW; MU[i] = in.shift_mu[m * RC + segcol(c >> 6) + (c & 63)]; }
    for (int i = tid; i < 64 * 64; i += NT) { const int j = i >> 6, c = i & 63;
        WUP[c * 72 + j] = f2bf(in.rw_w_up[((size_t)d * DL + j) * RW + h * 64 + c]); AUP[c * 72 + j] = f2bf(in.rw_a_up[((size_t)d * AL + j) * RW + h * 64 + c]); }
    for (int i = tid; i < 64; i += NT) { CST[i] = in.rw_w0[d * RW + h * 64 + i]; CST[64 + i] = in.rw_a0[d * RW + h * 64 + i]; CST[128 + i] = in.rw_k_k[h * 64 + i]; CST[192 + i] = in.rw_k_a[h * 64 + i]; CST[256 + i] = in.rw_r_k[h * 64 + i]; }
    for (int i = tid; i < 64 * 72 / 2; i += NT) ((LAS unsigned*)S0B)[i] = 0u;
    constexpr int NQ = (CTX + SEQ) / TB, NQC = CTX / TB;
    auto blk_info = [&](int q, bool& isctx, int& t0, bool& hp, bool& hn, size_t& grow0) {
        isctx = q < NQC;
        if (isctx) { const int qq = d == 0 ? q : NQC - 1 - q; t0 = qq * TB; hp = t0 > 0; hn = t0 + TB < CTX; grow0 = (size_t)nlat + (size_t)bl * CTX + t0; }
        else { const int ql = q - NQC, qq = d == 0 ? ql : SEQ / TB - 1 - ql; t0 = qq * TB; hp = (t0 % GW) != 0; hn = ((t0 + TB) % GW) != 0; grow0 = (size_t)bl * SEQ + t0; }
    };
    u32x4 pre[RW_PPT]; int poff[RW_PPT], plds[RW_PPT], pkind[RW_PPT];
#pragma unroll
    for (int k = 0; k < RW_PPT; ++k) { const int i = tid + k * NT, rr = i / 40, sp = i % 40, seg = sp >> 3, part = sp & 7;
        poff[k] = (rr - 1) * Z1_N + segcol(seg) + part * 8; plds[k] = rr * RAWW + sp * 8; pkind[k] = i >= RW_NPIECE ? 3 : (rr == 0 ? 1 : (rr == TB + 1 ? 2 : 0)); }
    auto prefetch = [&](int q) {
        bool isctx, hp, hn; int t0; size_t grow0; blk_info(q, isctx, t0, hp, hn, grow0);
        const bf16_t* base = p.z1 + grow0 * Z1_N;
#pragma unroll
        for (int k = 0; k < RW_PPT; ++k) { u32x4 v = (u32x4){0u, 0u, 0u, 0u};
            const bool ok = pkind[k] == 0 || (pkind[k] == 1 && hp) || (pkind[k] == 2 && hn);
            if (ok) v = *(const u32x4*)(base + poff[k]);
            pre[k] = v; }
    };
    auto commit = [&]() {
#pragma unroll
        for (int k = 0; k < RW_PPT; ++k) if (pkind[k] != 3) *(LAS u32x4*)(RAW + plds[k]) = pre[k];
    };
    f32x4 Sreg[2];
    Sreg[0] = (f32x4){0.f, 0.f, 0.f, 0.f}; Sreg[1] = Sreg[0];
    const int rt = wid >> 1;
    prefetch(0);
    for (int q = 0; q < NQ; ++q) {
        bool isctx, hp, hn; int t0; size_t grow0; blk_info(q, isctx, t0, hp, hn, grow0);
        commit();
        __syncthreads();
        if (q + 1 < NQ) prefetch(q + 1);
        auto shift8 = [&](int t, int c0, float (&s)[8]) {
            const u32x4 xp = *(const LAS u32x4*)(RAW + t * RAWW + c0), xc = *(const LAS u32x4*)(RAW + (t + 1) * RAWW + c0), xn_ = *(const LAS u32x4*)(RAW + (t + 2) * RAWW + c0);
            const f32x4 m0a = *(const LAS f32x4*)(MU + c0), m0b = *(const LAS f32x4*)(MU + c0 + 4), m1a = *(const LAS f32x4*)(MU + RAWW + c0), m1b = *(const LAS f32x4*)(MU + RAWW + c0 + 4);
#pragma unroll
            for (int j = 0; j < 4; ++j) { const unsigned a = xp[j], b = xc[j], c = xn_[j];
                const float mu0l = j < 2 ? m0a[2 * j] : m0b[2 * j - 4], mu0h = j < 2 ? m0a[2 * j + 1] : m0b[2 * j - 3], mu1l = j < 2 ? m1a[2 * j] : m1b[2 * j - 4], mu1h = j < 2 ? m1a[2 * j + 1] : m1b[2 * j - 3];
                { const float x = bflo(b); s[2 * j] = x + mu0l * (bflo(a) - x) + mu1l * (bflo(c) - x); }
                { const float x = bfhi(b); s[2 * j + 1] = x + mu0h * (bfhi(a) - x) + mu1h * (bfhi(c) - x); } } };
        for (int it = tid; it < TB * 24; it += NT) {
            const int t = it / 24, g = it % 24, seg = g >> 3, cc = (g & 7) * 8, js = d == 0 ? t : TB - 1 - t; float s[8]; shift8(t, g * 8, s);
            LAS float* dst = (seg == 0 ? Rr : (seg == 1 ? KR : Vv)) + js * 64 + cc; *(LAS f32x4*)dst = (f32x4){s[0], s[1], s[2], s[3]}; *(LAS f32x4*)(dst + 4) = (f32x4){s[4], s[5], s[6], s[7]};
        }
        { const int t = tid >> 4, g = 24 + (tid & 15), cc = (g & 7) * 8, js = d == 0 ? t : TB - 1 - t; float s[8]; shift8(t, g * 8, s);
          const bool isw = (tid & 15) < 8;
#pragma unroll
          for (int j = 0; j < 8; ++j) { const float th = fast_tanh(s[j]); s[j] = isw ? th : s[j]; }
          LAS bf16_t* dst = (isw ? AWD : AAD) + js * 72 + cc;
          u32x4 w; w.x = cvt_pk_bf16(s[0], s[1]); w.y = cvt_pk_bf16(s[2], s[3]); w.z = cvt_pk_bf16(s[4], s[5]); w.w = cvt_pk_bf16(s[6], s[7]); *(LAS u32x4*)dst = w; }
        __syncthreads();
        if (MODE == 3) continue;
        {
            const int lora = wid >> 2, ct = wid & 3;
            const LAS bf16_t* Am = lora ? AAD : AWD; const LAS bf16_t* Bm = lora ? AUP : WUP;
            float carry = 0.f;
#pragma unroll
            for (int r2 = 0; r2 < 2; ++r2) {
                f32x4 acc = (f32x4){0.f, 0.f, 0.f, 0.f};
#pragma unroll
                for (int ks = 0; ks < 2; ++ks) acc = __builtin_amdgcn_mfma_f32_16x16x32_bf16(ldsb8(Am + (r2 * 16 + fr) * 72 + ks * 32 + fq * 8), ldsb8(Bm + (ct * 16 + fr) * 72 + ks * 32 + fq * 8), acc, 0, 0, 0);
                const int col = ct * 16 + fr;
                if (lora == 0) {
                    float c[4];
#pragma unroll
                    for (int i = 0; i < 4; ++i) { const float lw = acc[i] + CST[col]; const float e = __expf(-fast_softplus(-lw) - 0.5f); c[i] = i ? c[i - 1] + e : e; }
                    const float tot = c[3];
                    float s1 = tot; { const float y = __shfl_up(s1, 16); s1 += fq >= 1 ? y : 0.f; }
                    float s2 = s1;  { const float z = __shfl_up(s1, 32); s2 += fq >= 2 ? z : 0.f; }
                    const float base = carry + s2 - tot;
#pragma unroll
                    for (int i = 0; i < 4; ++i) CUM[(r2 * 16 + fq * 4 + i) * 64 + col] = base + c[i];
                    carry += __shfl(s2, 48 + fr);
                } else {
#pragma unroll
                    for (int i = 0; i < 4; ++i) LA_[(r2 * 16 + fq * 4 + i) * 64 + col] = fast_sigmoid(acc[i] + CST[64 + col]);
                }
            }
        }
        __syncthreads();
        if (MODE == 2) continue;
        {
            const int j = tid >> 4, c4 = (tid & 15) * 4;
            const f32x4 k = *(const LAS f32x4*)(KR + j * 64 + c4), a = *(const LAS f32x4*)(LA_ + j * 64 + c4), r = *(const LAS f32x4*)(Rr + j * 64 + c4), vv = *(const LAS f32x4*)(Vv + j * 64 + c4);
            const f32x4 cu = *(const LAS f32x4*)(CUM + j * 64 + c4); f32x4 cp = (f32x4){0.f, 0.f, 0.f, 0.f}; if (j > 0) cp = *(const LAS f32x4*)(CUM + (j - 1) * 64 + c4);
            float kkr[4], ss = 0.f, bn = 0.f;
#pragma unroll
            for (int x = 0; x < 4; ++x) { kkr[x] = k[x] * CST[128 + c4 + x]; ss += kkr[x] * kkr[x]; }
            ss = allreduce16(ss);
            const float inv = 1.f / fmaxf(sqrtf(ss), 1e-12f);
            float kks[4], bs[4], kds[4], rs[4];
#pragma unroll
            for (int x = 0; x < 4; ++x) { const float kk = kkr[x] * inv, kd = k[x] * (1.f + (a[x] - 1.f) * CST[192 + c4 + x]), bb = kk * a[x];
                const float g = __expf(-cu[x]), gp = __expf(-cp[x]), ig = __expf(cu[x]);
                kks[x] = kk * gp; bs[x] = bb * ig; kds[x] = kd * ig; rs[x] = r[x] * g; bn += r[x] * kd * CST[256 + c4 + x];
                if (j == TB - 1) GC[c4 + x] = g;
            }
#pragma unroll
            for (int x = 0; x < 4; x += 2) { const unsigned pb = cvt_pk_bf16(bs[x], bs[x + 1]), pk = cvt_pk_bf16(kds[x], kds[x + 1]), pv = cvt_pk_bf16(vv[x], vv[x + 1]);
                BST[(c4 + x) * 40 + j] = (bf16_t)pb; BST[(c4 + x + 1) * 40 + j] = (bf16_t)(pb >> 16); KDST[(c4 + x) * 40 + j] = (bf16_t)pk; KDST[(c4 + x + 1) * 40 + j] = (bf16_t)(pk >> 16);
                VT[(c4 + x) * 40 + j] = (bf16_t)pv; VT[(c4 + x + 1) * 40 + j] = (bf16_t)(pv >> 16); }
            bn = allreduce16(bn);
            u32x2 w; w.x = cvt_pk_bf16(kks[0], kks[1]); w.y = cvt_pk_bf16(kks[2], kks[3]); *(LAS u32x2*)(KKS + j * 72 + c4) = w;
            w.x = cvt_pk_bf16(bs[0], bs[1]); w.y = cvt_pk_bf16(bs[2], bs[3]); *(LAS u32x2*)(BS + j * 72 + c4) = w;
            w.x = cvt_pk_bf16(kds[0], kds[1]); w.y = cvt_pk_bf16(kds[2], kds[3]); *(LAS u32x2*)(KDS + j * 72 + c4) = w;
            w.x = cvt_pk_bf16(rs[0], rs[1]); w.y = cvt_pk_bf16(rs[2], rs[3]); *(LAS u32x2*)(RS + j * 72 + c4) = w;
            if ((tid & 15) == 0) BON[j] = bn;
        }
        __syncthreads();
        if (MODE == 1) continue;
        const int ctg = wid & 1;
        f32x4 accG = (f32x4){0.f, 0.f, 0.f, 0.f}, accY = accG;
        {
            const int pr = wid >> 1, rts = wid & 1;
            const LAS bf16_t* Xm = (pr & 1) ? KDS : BS; const LAS bf16_t* Ym = (pr < 2) ? KKS : RS;
            const bf16x8 a0 = ldsb8(Xm + (rts * 16 + fr) * 72 + fq * 8), a1 = ldsb8(Xm + (rts * 16 + fr) * 72 + 32 + fq * 8);
#pragma unroll
            for (int cts = 0; cts < 2; ++cts) {
                f32x4 acc = (f32x4){0.f, 0.f, 0.f, 0.f};
                acc = __builtin_amdgcn_mfma_f32_16x16x32_bf16(a0, ldsb8(Ym + (cts * 16 + fr) * 72 + fq * 8), acc, 0, 0, 0);
                acc = __builtin_amdgcn_mfma_f32_16x16x32_bf16(a1, ldsb8(Ym + (cts * 16 + fr) * 72 + 32 + fq * 8), acc, 0, 0, 0);
                const int t = cts * 16 + fr, s0 = rts * 16 + fq * 4;
#pragma unroll
                for (int i = 0; i < 4; ++i) { const bool keep = (pr < 2) ? (s0 + i < t) : (s0 + i <= t); acc[i] = keep ? acc[i] : 0.f; }
                if (pr == 0) *(LAS f32x4*)(ABT + t * 32 + s0) = acc;
                else { u32x2 w; w.x = cvt_pk_bf16(acc[0], acc[1]); w.y = cvt_pk_bf16(acc[2], acc[3]); *(LAS u32x2*)((pr == 1 ? AKT : (pr == 2 ? NBT : NKT)) + t * 40 + s0) = w; }
            }
#pragma unroll
            for (int ks = 0; ks < 2; ++ks) { const bf16x8 sa = ldsb8(S0B + (rt * 16 + fr) * 72 + ks * 32 + fq * 8);
                accG = __builtin_amdgcn_mfma_f32_16x16x32_bf16(sa, ldsb8(KKS + (ctg * 16 + fr) * 72 + ks * 32 + fq * 8), accG, 0, 0, 0);
                accY = __builtin_amdgcn_mfma_f32_16x16x32_bf16(sa, ldsb8(RS + (ctg * 16 + fr) * 72 + ks * 32 + fq * 8), accY, 0, 0, 0); }
        }
        __syncthreads();
        {
            const bf16x8 va = ldsb8(VT + (rt * 16 + fr) * 40 + fq * 8);
            accG = __builtin_amdgcn_mfma_f32_16x16x32_bf16(va, ldsb8(AKT + (ctg * 16 + fr) * 40 + fq * 8), accG, 0, 0, 0);
            accY = __builtin_amdgcn_mfma_f32_16x16x32_bf16(va, ldsb8(NKT + (ctg * 16 + fr) * 40 + fq * 8), accY, 0, 0, 0);
#pragma unroll
            for (int i = 0; i < 4; ++i) Gm[(rt * 16 + fq * 4 + i) * 36 + ctg * 16 + fr] = -accG[i];
        }
        __syncthreads();
        if (MODE == 4) continue;
        if (wid < 4) {
            const int v = wid * 16 + (lane >> 2), pq = lane & 3;
            const LAS float* grow = Gm + v * 36;
            f32x4 r0 = *(const LAS f32x4*)(grow + 4 * pq), r1 = *(const LAS f32x4*)(grow + 16 + 4 * pq);
            u32x2 ubo[TB / 4];
            const LAS float* abd = ABT; asm volatile("" : "+v"(abd));
            const LAS float* abq = ABT + 128 * pq; asm volatile("" : "+v"(abq));
            f32x4 dc[3], a0c[4], a1c[4];
            auto ldg = [&](int g, f32x4 (&dd)[3], f32x4 (&aa0)[4], f32x4 (&aa1)[4]) {
#pragma unroll
                for (int x = 0; x < 3; ++x) dd[x] = *(const LAS f32x4*)(abd + (4 * g + 1 + x) * 32 + 4 * g);
#pragma unroll
                for (int jj = 0; jj < 4; ++jj) { if (g < 3) aa0[jj] = *(const LAS f32x4*)(abq + jj * 32 + 4 * g); if (g < 7) aa1[jj] = *(const LAS f32x4*)(abq + (16 + jj) * 32 + 4 * g); } };
            ldg(0, dc, a0c, a1c);
#pragma unroll
            for (int g = 0; g < TB / 4; ++g) {
                f32x4 dn[3], a0n[4], a1n[4];
                if (g + 1 < TB / 4) ldg(g + 1, dn, a0n, a1n);
                __builtin_amdgcn_sched_barrier(0);
                const f32x4 rr = g < 4 ? r0 : r1;
                f32x4 u4;
                u4[0] = rr[0];
                u4[1] = rr[1] - u4[0] * dc[0][0];
                u4[2] = rr[2] - (u4[0] * dc[1][0] + u4[1] * dc[1][1]);
                u4[3] = rr[3] - (u4[0] * dc[2][0] + u4[1] * dc[2][1] + u4[2] * dc[2][2]);
#pragma unroll
                for (int x = 0; x < 4; ++x) { const int ui = __float_as_int(u4[x]); int bi;
                    if ((g & 3) == 0) bi = __builtin_amdgcn_update_dpp(0, ui, 0x00, 0xF, 0xF, true); else if ((g & 3) == 1) bi = __builtin_amdgcn_update_dpp(0, ui, 0x55, 0xF, 0xF, true);
                    else if ((g & 3) == 2) bi = __builtin_amdgcn_update_dpp(0, ui, 0xAA, 0xF, 0xF, true); else bi = __builtin_amdgcn_update_dpp(0, ui, 0xFF, 0xF, 0xF, true);
                    u4[x] = __int_as_float(bi); }
                ubo[g].x = cvt_pk_bf16(u4[0], u4[1]); ubo[g].y = cvt_pk_bf16(u4[2], u4[3]);
                if (g < 3) {
#pragma unroll
                    for (int jj = 0; jj < 4; ++jj) r0[jj] -= u4[0] * a0c[jj][0] + u4[1] * a0c[jj][1] + u4[2] * a0c[jj][2] + u4[3] * a0c[jj][3]; }
                if (g < 7) {
#pragma unroll
                    for (int jj = 0; jj < 4; ++jj) r1[jj] -= u4[0] * a1c[jj][0] + u4[1] * a1c[jj][1] + u4[2] * a1c[jj][2] + u4[3] * a1c[jj][3]; }
                if (g + 1 < TB / 4) {
#pragma unroll
                    for (int x = 0; x < 3; ++x) dc[x] = dn[x];
#pragma unroll
                    for (int jj = 0; jj < 4; ++jj) { a0c[jj] = a0n[jj]; a1c[jj] = a1n[jj]; } }
            }
            if (pq == 0) {
#pragma unroll
                for (int g = 0; g < TB / 4; g += 2) { u32x4 w; w.x = ubo[g].x; w.y = ubo[g].y; w.z = ubo[g + 1].x; w.w = ubo[g + 1].y; *(LAS u32x4*)(UB + v * 40 + 4 * g) = w; } }
        }
        __syncthreads();
        if (MODE == 5) continue;
        {
            const bf16x8 ua = ldsb8(UB + (rt * 16 + fr) * 40 + fq * 8), va = ldsb8(VT + (rt * 16 + fr) * 40 + fq * 8);
            accY = __builtin_amdgcn_mfma_f32_16x16x32_bf16(ua, ldsb8(NBT + (ctg * 16 + fr) * 40 + fq * 8), accY, 0, 0, 0);
            *(LAS f32x4*)(YO + (ctg * 16 + fr) * 64 + rt * 16 + fq * 4) = accY;
#pragma unroll
            for (int cc = 0; cc < 2; ++cc) { const int ct = 2 * (wid & 1) + cc, kcol = ct * 16 + fr;
                f32x4 acc = Sreg[cc];
                acc = __builtin_amdgcn_mfma_f32_16x16x32_bf16(ua, ldsb8(BST + kcol * 40 + fq * 8), acc, 0, 0, 0);
                acc = __builtin_amdgcn_mfma_f32_16x16x32_bf16(va, ldsb8(KDST + kcol * 40 + fq * 8), acc, 0, 0, 0);
                const float g = GC[kcol];
#pragma unroll
                for (int i = 0; i < 4; ++i) acc[i] *= g;
                { const unsigned p0 = cvt_pk_bf16(acc[0], acc[1]), p1 = cvt_pk_bf16(acc[2], acc[3]); LAS bf16_t* sp = S0B + (rt * 16 + fq * 4) * 72 + kcol;
                  sp[0] = (bf16_t)p0; sp[72] = (bf16_t)(p0 >> 16); sp[144] = (bf16_t)p1; sp[216] = (bf16_t)(p1 >> 16); }
                Sreg[cc] = acc; }
        }
        __syncthreads();
        if (!isctx) {
            const int j = tid >> 4, c4 = (tid & 15) * 4, t = d == 0 ? j : TB - 1 - j; const f32x4 y = *(const LAS f32x4*)(YO + j * 64 + c4);
            u32x2 w; w.x = cvt_pk_bf16(y[0], y[1]); w.y = cvt_pk_bf16(y[2], y[3]);
            bf16_t* yb_ = p.Y + ((size_t)d * nlat + grow0) * RW + h * 64;
            *(u32x2*)(yb_ + t * RW + c4) = w;
            if (tid < TB) { const int tt = d == 0 ? tid : TB - 1 - tid; float* bb_ = p.bon + ((size_t)d * nlat + grow0) * NH + h; bb_[tt * NH] = BON[tid]; }
        }
    }
}
template <int MODE = 0>
__device__ __forceinline__ void rwkv_phase2(LAS unsigned char* lds, const In& in, const RwkvP p, int bid, int nblk) {
    const int nchain = 2 * p.nb * NH;
    for (int c = bid; c < nchain; c += nblk) { rwkv_chain2<MODE>(lds, in, p, c); __syncthreads(); }
}
}

namespace mk {
namespace r3 {
constexpr int C2_RAW = 0;
constexpr int C2_MU = C2_RAW + (TB + 2) * RAWW * 2;
constexpr int C2_WUP = C2_MU + 2 * RAWW * 4;
constexpr int C2_AUP = C2_WUP + 64 * 72 * 2;
constexpr int C2_CST = C2_AUP + 64 * 72 * 2;
constexpr int C2_AWD = C2_CST + 5 * 64 * 4;
constexpr int C2_AAD = C2_AWD + TB * 72 * 2;
constexpr int C2_X = C2_AAD + TB * 72 * 2;
constexpr int C2_G = C2_X;
constexpr int C2_UB = C2_G + 64 * 36 * 4;
constexpr int C2_ABT = C2_UB + 64 * 40 * 2;
constexpr int C2_AKT = C2_ABT + 32 * 32 * 4;
constexpr int C2_NBT = C2_AKT + 32 * 40 * 2;
constexpr int C2_NKT = C2_NBT + 32 * 40 * 2;
constexpr int C2_YO = C2_NKT + 32 * 40 * 2;
constexpr int C2_X_END = C2_YO + TB * 64 * 4;
constexpr int C2_LA = C2_X, C2_CUM = C2_LA + TB * 64 * 4;
static_assert(C2_CUM + TB * 64 * 4 <= C2_YO, "LA/CUM overlay");
constexpr int C2_KKS = C2_X_END;
constexpr int C2_BS = C2_KKS + TB * 72 * 2, C2_KDS = C2_BS + TB * 72 * 2, C2_RS = C2_KDS + TB * 72 * 2;
constexpr int C2_BST = C2_RS + TB * 72 * 2;
constexpr int C2_KDST = C2_BST + 64 * 40 * 2;
constexpr int C2_VT = C2_KDST + 64 * 40 * 2;
constexpr int C2_S0B = C2_VT + 64 * 40 * 2;
constexpr int C2_GC = C2_S0B + 64 * 72 * 2;
constexpr int C2_BON = C2_GC + 64 * 4;
constexpr int C2_RB = C2_BON + TB * 4;
constexpr int C2_KRB = C2_RB + TB * 64 * 2, C2_VB = C2_KRB + TB * 64 * 2;
constexpr int C2_END = C2_VB + TB * 64 * 2;
static_assert(C2_END <= LDS_BYTES - 16 && (C2_X % 16) == 0 && (C2_KKS % 16) == 0 && (C2_G % 16) == 0 && (C2_UB % 16) == 0 && (C2_ABT % 16) == 0 && (C2_AKT % 16) == 0 && (C2_S0B % 16) == 0, "rwkv2 LDS");

__device__ __forceinline__ bf16x8 ldsb8(const LAS bf16_t* p) { return *(const LAS bf16x8*)p; }

template <int MODE>
__device__ __forceinline__ void rwkv_chain3(LAS unsigned char* lds, const In& in, const RwkvP p, int chain) {
    const int tid = threadIdx.x, lane = tid & 63, wid = tid >> 6, fr = lane & 15, fq = lane >> 4;
    const int d = chain / (p.nb * NH), bl = (chain / NH) % p.nb, h = chain % NH;
    const int nlat = p.nb * SEQ;
    LAS bf16_t* RAW = (LAS bf16_t*)(lds + C2_RAW); LAS float* MU = (LAS float*)(lds + C2_MU);
    LAS bf16_t* WUP = (LAS bf16_t*)(lds + C2_WUP); LAS bf16_t* AUP = (LAS bf16_t*)(lds + C2_AUP); LAS float* CST = (LAS float*)(lds + C2_CST);
    LAS bf16_t* AWD = (LAS bf16_t*)(lds + C2_AWD); LAS bf16_t* AAD = (LAS bf16_t*)(lds + C2_AAD);
    LAS bf16_t *Rb = (LAS bf16_t*)(lds + C2_RB), *KRb = (LAS bf16_t*)(lds + C2_KRB), *Vb = (LAS bf16_t*)(lds + C2_VB); LAS float *LA_ = (LAS float*)(lds + C2_LA), *CUM = (LAS float*)(lds + C2_CUM);
    LAS float *YO = (LAS float*)(lds + C2_YO), *Gm = (LAS float*)(lds + C2_G), *ABT = (LAS float*)(lds + C2_ABT), *GC = (LAS float*)(lds + C2_GC), *BON = (LAS float*)(lds + C2_BON);
    LAS bf16_t *UB = (LAS bf16_t*)(lds + C2_UB), *AKT = (LAS bf16_t*)(lds + C2_AKT), *NBT = (LAS bf16_t*)(lds + C2_NBT), *NKT = (LAS bf16_t*)(lds + C2_NKT);
    LAS bf16_t *KKS = (LAS bf16_t*)(lds + C2_KKS), *BS = (LAS bf16_t*)(lds + C2_BS), *KDS = (LAS bf16_t*)(lds + C2_KDS), *RS = (LAS bf16_t*)(lds + C2_RS);
    LAS bf16_t *BST = (LAS bf16_t*)(lds + C2_BST), *KDST = (LAS bf16_t*)(lds + C2_KDST), *VT = (LAS bf16_t*)(lds + C2_VT), *S0B = (LAS bf16_t*)(lds + C2_S0B);
    auto segcol = [&](int s) __attribute__((always_inline)) { return s < 3 ? s * RW + h * 64 : (s == 3 ? OFF_WD + d * DL : OFF_AD + d * AL); };
    for (int i = tid; i < 2 * RAWW; i += NT) { const int m = i / RAWW, c = i % RAWW; MU[i] = in.shift_mu[m * RC + segcol(c >> 6) + (c & 63)]; }
    for (int i = tid; i < 64 * 64; i += NT) { const int j = i >> 6, c = i & 63;
        WUP[c * 72 + j] = f2bf(in.rw_w_up[((size_t)d * DL + j) * RW + h * 64 + c]); AUP[c * 72 + j] = f2bf(in.rw_a_up[((size_t)d * AL + j) * RW + h * 64 + c]); }
    for (int i = tid; i < 64; i += NT) { CST[i] = in.rw_w0[d * RW + h * 64 + i]; CST[64 + i] = in.rw_a0[d * RW + h * 64 + i]; CST[128 + i] = in.rw_k_k[h * 64 + i]; CST[192 + i] = in.rw_k_a[h * 64 + i]; CST[256 + i] = in.rw_r_k[h * 64 + i]; }
    for (int i = tid; i < 64 * 72 / 2; i += NT) ((LAS unsigned*)S0B)[i] = 0u;
    constexpr int NQ = (CTX + SEQ) / TB, NQC = CTX / TB;
    auto blk_info = [&](int q, bool& isctx, int& t0, bool& hp, bool& hn, size_t& grow0) __attribute__((always_inline)) {
        isctx = q < NQC;
        if (isctx) { const int qq = d == 0 ? q : NQC - 1 - q; t0 = qq * TB; hp = t0 > 0; hn = t0 + TB < CTX; grow0 = (size_t)nlat + (size_t)bl * CTX + t0; }
        else { const int ql = q - NQC, qq = d == 0 ? ql : SEQ / TB - 1 - ql; t0 = qq * TB; hp = (t0 % GW) != 0; hn = ((t0 + TB) % GW) != 0; grow0 = (size_t)bl * SEQ + t0; }
    };
    u32x4 pre[RW_PPT]; int poff[RW_PPT], plds[RW_PPT];
#pragma unroll
    for (int k = 0; k < RW_PPT; ++k) { const int i = tid + k * NT, rr = i / 40, sp = i % 40, seg = sp >> 3, part = sp & 7;
        poff[k] = (rr - 1) * Z1_N + segcol(seg) + part * 8; plds[k] = (rr * RAWW + sp * 8) | (i >= RW_NPIECE ? 3 : (rr == 0 ? 1 : (rr == TB + 1 ? 2 : 0))); }
    auto prefetch = [&](int q) __attribute__((always_inline)) {
        bool isctx, hp, hn; int t0; size_t grow0; blk_info(q, isctx, t0, hp, hn, grow0);
        const bf16_t* base = p.z1 + grow0 * Z1_N;
#pragma unroll
        for (int k = 0; k < RW_PPT; ++k) { u32x4 v = (u32x4){0u, 0u, 0u, 0u};
            const int kind = plds[k] & 3; const bool ok = kind == 0 || (kind == 1 && hp) || (kind == 2 && hn);
            if (ok) v = *(const u32x4*)(base + poff[k]);
            pre[k] = v; }
    };
    auto commit = [&]() __attribute__((always_inline)) {
#pragma unroll
        for (int k = 0; k < RW_PPT; ++k) if ((plds[k] & 3) != 3) *(LAS u32x4*)(RAW + (plds[k] & ~3)) = pre[k];
    };
    f32x4 Sreg[2];
    Sreg[0] = (f32x4){0.f, 0.f, 0.f, 0.f}; Sreg[1] = Sreg[0];
    const int rt = wid >> 1;
    auto shift8 = [&](int t, int c0, float (&s)[8]) __attribute__((always_inline)) {
        const u32x4 xp = *(const LAS u32x4*)(RAW + t * RAWW + c0), xc = *(const LAS u32x4*)(RAW + (t + 1) * RAWW + c0), xn_ = *(const LAS u32x4*)(RAW + (t + 2) * RAWW + c0);
        const f32x4 m0a = *(const LAS f32x4*)(MU + c0), m0b = *(const LAS f32x4*)(MU + c0 + 4), m1a = *(const LAS f32x4*)(MU + RAWW + c0), m1b = *(const LAS f32x4*)(MU + RAWW + c0 + 4);
#define MK_SH1(J, XP, XC, XN, M0L, M0H, M1L, M1H) { const float xl = bflo(XC), xh = bfhi(XC); s[2 * J] = xl + M0L * (bflo(XP) - xl) + M1L * (bflo(XN) - xl); s[2 * J + 1] = xh + M0H * (bfhi(XP) - xh) + M1H * (bfhi(XN) - xh); }
        MK_SH1(0, xp.x, xc.x, xn_.x, m0a.x, m0a.y, m1a.x, m1a.y) MK_SH1(1, xp.y, xc.y, xn_.y, m0a.z, m0a.w, m1a.z, m1a.w)
        MK_SH1(2, xp.z, xc.z, xn_.z, m0b.x, m0b.y, m1b.x, m1b.y) MK_SH1(3, xp.w, xc.w, xn_.w, m0b.z, m0b.w, m1b.z, m1b.w)
#undef MK_SH1
    };
    auto do_shift = [&](int tl, int nth) __attribute__((always_inline)) {
#pragma unroll 1
        for (int it = tl; it < TB * 24; it += nth) {
            const int t = it / 24, g = it % 24, seg = g >> 3, cc = (g & 7) * 8, js = d == 0 ? t : TB - 1 - t; float s[8]; shift8(t, g * 8, s);
            LAS bf16_t* dst = Rb + seg * (TB * 64) + js * 64 + cc;
            u32x4 w; w.x = cvt_pk_bf16(s[0], s[1]); w.y = cvt_pk_bf16(s[2], s[3]); w.z = cvt_pk_bf16(s[4], s[5]); w.w = cvt_pk_bf16(s[6], s[7]); *(LAS u32x4*)dst = w;
        }
#pragma unroll 1
        for (int it = tl; it < TB * 16; it += nth) { const int t = it >> 4, g = 24 + (it & 15), cc = (g & 7) * 8, js = d == 0 ? t : TB - 1 - t; float s[8]; shift8(t, g * 8, s);
            const bool isw = (it & 15) < 8;
#pragma unroll
            for (int j = 0; j < 8; ++j) { const float th = fast_tanh(s[j]); s[j] = isw ? th : s[j]; }
            LAS bf16_t* dst = AWD + (isw ? 0 : TB * 72) + js * 72 + cc;
            u32x4 w; w.x = cvt_pk_bf16(s[0], s[1]); w.y = cvt_pk_bf16(s[2], s[3]); w.z = cvt_pk_bf16(s[4], s[5]); w.w = cvt_pk_bf16(s[6], s[7]); *(LAS u32x4*)dst = w; }
    };
    prefetch(0);
    commit();
    __syncthreads();
    if (1 < NQ) prefetch(1);
    do_shift(tid & (NT / 2 - 1), NT / 2);
    __syncthreads();
    for (int q = 0; q < NQ; ++q) {
        bool isctx, hp, hn; int t0; size_t grow0; blk_info(q, isctx, t0, hp, hn, grow0);
        {
            const int lora = wid >> 2, ct = wid & 3;
            const LAS bf16_t* Am = lora ? AAD : AWD; const LAS bf16_t* Bm = lora ? AUP : WUP;
            float carry = 0.f;
#pragma unroll
            for (int r2 = 0; r2 < 2; ++r2) {
                f32x4 acc = (f32x4){0.f, 0.f, 0.f, 0.f};
#pragma unroll
                for (int ks = 0; ks < 2; ++ks) acc = __builtin_amdgcn_mfma_f32_16x16x32_bf16(ldsb8(Am + (r2 * 16 + fr) * 72 + ks * 32 + fq * 8), ldsb8(Bm + (ct * 16 + fr) * 72 + ks * 32 + fq * 8), acc, 0, 0, 0);
                const int col = ct * 16 + fr;
                if (lora == 0) {
                    float c[4];
#pragma unroll
                    for (int i = 0; i < 4; ++i) { const float lw = acc[i] + CST[col]; const float e = __expf(-fast_softplus(-lw) - 0.5f); c[i] = i ? c[i - 1] + e : e; }
                    const float tot = c[3];
                    float s1 = tot; { const float y = __shfl_up(s1, 16); s1 += fq >= 1 ? y : 0.f; }
                    float s2 = s1;  { const float z = __shfl_up(s1, 32); s2 += fq >= 2 ? z : 0.f; }
                    const float base = carry + s2 - tot;
#pragma unroll
                    for (int i = 0; i < 4; ++i) CUM[(r2 * 16 + fq * 4 + i) * 64 + col] = base + c[i];
                    carry += __shfl(s2, 48 + fr);
                } else {
#pragma unroll
                    for (int i = 0; i < 4; ++i) LA_[(r2 * 16 + fq * 4 + i) * 64 + col] = fast_sigmoid(acc[i] + CST[64 + col]);
                }
            }
        }
        __syncthreads();
        {
            const int j = tid >> 4, c4 = (tid & 15) * 4;
            const u32x2 kp = *(const LAS u32x2*)(KRb + j * 64 + c4), rp = *(const LAS u32x2*)(Rb + j * 64 + c4), vp = *(const LAS u32x2*)(Vb + j * 64 + c4);
            const f32x4 k = (f32x4){bflo(kp.x), bfhi(kp.x), bflo(kp.y), bfhi(kp.y)}, r = (f32x4){bflo(rp.x), bfhi(rp.x), bflo(rp.y), bfhi(rp.y)}, vv = (f32x4){bflo(vp.x), bfhi(vp.x), bflo(vp.y), bfhi(vp.y)};
            const f32x4 a = *(const LAS f32x4*)(LA_ + j * 64 + c4);
            const f32x4 cu = *(const LAS f32x4*)(CUM + j * 64 + c4); f32x4 cp = (f32x4){0.f, 0.f, 0.f, 0.f}; if (j > 0) cp = *(const LAS f32x4*)(CUM + (j - 1) * 64 + c4);
            float kkr[4], ss = 0.f, bn = 0.f;
#pragma unroll
            for (int x = 0; x < 4; ++x) { kkr[x] = k[x] * CST[128 + c4 + x]; ss += kkr[x] * kkr[x]; }
            ss = allreduce16(ss);
            const float inv = 1.f / fmaxf(sqrtf(ss), 1e-12f);
            float kks[4], bs[4], kds[4], rs[4];
#pragma unroll
            for (int x = 0; x < 4; ++x) { const float kk = kkr[x] * inv, kd = k[x] * (1.f + (a[x] - 1.f) * CST[192 + c4 + x]), bb = kk * a[x];
                const float g = __expf(-cu[x]), gp = __expf(-cp[x]), ig = __expf(cu[x]);
                kks[x] = kk * gp; bs[x] = bb * ig; kds[x] = kd * ig; rs[x] = r[x] * g; bn += r[x] * kd * CST[256 + c4 + x];
                if (j == TB - 1) GC[c4 + x] = g;
            }
#pragma unroll
            for (int x = 0; x < 4; x += 2) { const unsigned pb = cvt_pk_bf16(bs[x], bs[x + 1]), pk = cvt_pk_bf16(kds[x], kds[x + 1]), pv = cvt_pk_bf16(vv[x], vv[x + 1]);
                BST[(c4 + x) * 40 + j] = (bf16_t)pb; BST[(c4 + x + 1) * 40 + j] = (bf16_t)(pb >> 16); KDST[(c4 + x) * 40 + j] = (bf16_t)pk; KDST[(c4 + x + 1) * 40 + j] = (bf16_t)(pk >> 16);
                VT[(c4 + x) * 40 + j] = (bf16_t)pv; VT[(c4 + x + 1) * 40 + j] = (bf16_t)(pv >> 16); }
            bn = allreduce16(bn);
            u32x2 w; w.x = cvt_pk_bf16(kks[0], kks[1]); w.y = cvt_pk_bf16(kks[2], kks[3]); *(LAS u32x2*)(KKS + j * 72 + c4) = w;
            w.x = cvt_pk_bf16(bs[0], bs[1]); w.y = cvt_pk_bf16(bs[2], bs[3]); *(LAS u32x2*)(BS + j * 72 + c4) = w;
            w.x = cvt_pk_bf16(kds[0], kds[1]); w.y = cvt_pk_bf16(kds[2], kds[3]); *(LAS u32x2*)(KDS + j * 72 + c4) = w;
            w.x = cvt_pk_bf16(rs[0], rs[1]); w.y = cvt_pk_bf16(rs[2], rs[3]); *(LAS u32x2*)(RS + j * 72 + c4) = w;
            if ((tid & 15) == 0) BON[j] = bn;
        }
        __syncthreads();
        const int ctg = wid & 1;
        f32x4 accG = (f32x4){0.f, 0.f, 0.f, 0.f}, accY = accG;
        {
            const int pr = wid >> 1, rts = wid & 1;
            const LAS bf16_t* Xm = (pr & 1) ? KDS : BS; const LAS bf16_t* Ym = (pr < 2) ? KKS : RS;
            const bf16x8 a0 = ldsb8(Xm + (rts * 16 + fr) * 72 + fq * 8), a1 = ldsb8(Xm + (rts * 16 + fr) * 72 + 32 + fq * 8);
#pragma unroll
            for (int cts = 0; cts < 2; ++cts) {
                f32x4 acc = (f32x4){0.f, 0.f, 0.f, 0.f};
                acc = __builtin_amdgcn_mfma_f32_16x16x32_bf16(a0, ldsb8(Ym + (cts * 16 + fr) * 72 + fq * 8), acc, 0, 0, 0);
                acc = __builtin_amdgcn_mfma_f32_16x16x32_bf16(a1, ldsb8(Ym + (cts * 16 + fr) * 72 + 32 + fq * 8), acc, 0, 0, 0);
                const int t = cts * 16 + fr, s0 = rts * 16 + fq * 4;
#pragma unroll
                for (int i = 0; i < 4; ++i) { const bool keep = (pr < 2) ? (s0 + i < t) : (s0 + i <= t); acc[i] = keep ? acc[i] : 0.f; }
                if (pr == 0) *(LAS f32x4*)(ABT + t * 32 + s0) = acc;
                else { u32x2 w; w.x = cvt_pk_bf16(acc[0], acc[1]); w.y = cvt_pk_bf16(acc[2], acc[3]); *(LAS u32x2*)((pr == 1 ? AKT : (pr == 2 ? NBT : NKT)) + t * 40 + s0) = w; }
            }
#pragma unroll
            for (int ks = 0; ks < 2; ++ks) { const bf16x8 sa = ldsb8(S0B + (rt * 16 + fr) * 72 + ks * 32 + fq * 8);
                accG = __builtin_amdgcn_mfma_f32_16x16x32_bf16(sa, ldsb8(KKS + (ctg * 16 + fr) * 72 + ks * 32 + fq * 8), accG, 0, 0, 0);
                accY = __builtin_amdgcn_mfma_f32_16x16x32_bf16(sa, ldsb8(RS + (ctg * 16 + fr) * 72 + ks * 32 + fq * 8), accY, 0, 0, 0); }
        }
        __syncthreads();
        {
            const bf16x8 va = ldsb8(VT + (rt * 16 + fr) * 40 + fq * 8);
            accG = __builtin_amdgcn_mfma_f32_16x16x32_bf16(va, ldsb8(AKT + (ctg * 16 + fr) * 40 + fq * 8), accG, 0, 0, 0);
            accY = __builtin_amdgcn_mfma_f32_16x16x32_bf16(va, ldsb8(NKT + (ctg * 16 + fr) * 40 + fq * 8), accY, 0, 0, 0);
#pragma unroll
            for (int i = 0; i < 4; ++i) Gm[(rt * 16 + fq * 4 + i) * 36 + ctg * 16 + fr] = -accG[i];
            if (q + 1 < NQ) { commit(); if (q + 2 < NQ) prefetch(q + 2); }
        }
        __syncthreads();
        if (wid >= 4) { if (q + 1 < NQ) do_shift(tid & (NT / 2 - 1), NT / 2); }
        else {
            const int v = wid * 16 + (lane >> 2), pq = lane & 3;
            const LAS float* grow = Gm + v * 36;
            f32x4 r0 = *(const LAS f32x4*)(grow + 4 * pq), r1 = *(const LAS f32x4*)(grow + 16 + 4 * pq);
            u32x2 ubo[TB / 4];
            const LAS float* abd = ABT; asm volatile("" : "+v"(abd));
            const LAS float* abq = ABT + 128 * pq; asm volatile("" : "+v"(abq));
            f32x4 dc[3], a0c[4], a1c[4];
            auto ldg = [&](int g, f32x4 (&dd)[3], f32x4 (&aa0)[4], f32x4 (&aa1)[4]) {
#pragma unroll
                for (int x = 0; x < 3; ++x) dd[x] = *(const LAS f32x4*)(abd + (4 * g + 1 + x) * 32 + 4 * g);
#pragma unroll
                for (int jj = 0; jj < 4; ++jj) { if (g < 3) aa0[jj] = *(const LAS f32x4*)(abq + jj * 32 + 4 * g); if (g < 7) aa1[jj] = *(const LAS f32x4*)(abq + (16 + jj) * 32 + 4 * g); } };
            ldg(0, dc, a0c, a1c);
#pragma unroll
            for (int g = 0; g < TB / 4; ++g) {
                f32x4 dn[3], a0n[4], a1n[4];
                if (g + 1 < TB / 4) ldg(g + 1, dn, a0n, a1n);
                __builtin_amdgcn_sched_barrier(0);
                const f32x4 rr = g < 4 ? r0 : r1;
                f32x4 u4;
                u4[0] = rr[0];
                u4[1] = rr[1] - u4[0] * dc[0][0];
                u4[2] = rr[2] - (u4[0] * dc[1][0] + u4[1] * dc[1][1]);
                u4[3] = rr[3] - (u4[0] * dc[2][0] + u4[1] * dc[2][1] + u4[2] * dc[2][2]);
#pragma unroll
                for (int x = 0; x < 4; ++x) { const int ui = __float_as_int(u4[x]); int bi;
                    if ((g & 3) == 0) bi = __builtin_amdgcn_update_dpp(0, ui, 0x00, 0xF, 0xF, true); else if ((g & 3) == 1) bi = __builtin_amdgcn_update_dpp(0, ui, 0x55, 0xF, 0xF, true);
                    else if ((g & 3) == 2) bi = __builtin_amdgcn_update_dpp(0, ui, 0xAA, 0xF, 0xF, true); else bi = __builtin_amdgcn_update_dpp(0, ui, 0xFF, 0xF, 0xF, true);
                    u4[x] = __int_as_float(bi); }
                ubo[g].x = cvt_pk_bf16(u4[0], u4[1]); ubo[g].y = cvt_pk_bf16(u4[2], u4[3]);
                if (g < 3) {
#pragma unroll
                    for (int jj = 0; jj < 4; ++jj) r0[jj] -= u4[0] * a0c[jj][0] + u4[1] * a0c[jj][1] + u4[2] * a0c[jj][2] + u4[3] * a0c[jj][3]; }
                if (g < 7) {
#pragma unroll
                    for (int jj = 0; jj < 4; ++jj) r1[jj] -= u4[0] * a1c[jj][0] + u4[1] * a1c[jj][1] + u4[2] * a1c[jj][2] + u4[3] * a1c[jj][3]; }
                if (g + 1 < TB / 4) {
#pragma unroll
                    for (int x = 0; x < 3; ++x) dc[x] = dn[x];
#pragma unroll
                    for (int jj = 0; jj < 4; ++jj) { a0c[jj] = a0n[jj]; a1c[jj] = a1n[jj]; } }
            }
            if (pq == 0) {
#pragma unroll
                for (int g = 0; g < TB / 4; g += 2) { u32x4 w; w.x = ubo[g].x; w.y = ubo[g].y; w.z = ubo[g + 1].x; w.w = ubo[g + 1].y; *(LAS u32x4*)(UB + v * 40 + 4 * g) = w; } }
        }
        __syncthreads();
        {
            const bf16x8 ua = ldsb8(UB + (rt * 16 + fr) * 40 + fq * 8), va = ldsb8(VT + (rt * 16 + fr) * 40 + fq * 8);
            accY = __builtin_amdgcn_mfma_f32_16x16x32_bf16(ua, ldsb8(NBT + (ctg * 16 + fr) * 40 + fq * 8), accY, 0, 0, 0);
            *(LAS f32x4*)(YO + (ctg * 16 + fr) * 64 + rt * 16 + fq * 4) = accY;
#pragma unroll
            for (int cc = 0; cc < 2; ++cc) { const int ct = 2 * (wid & 1) + cc, kcol = ct * 16 + fr;
                f32x4 acc = Sreg[cc];
                acc = __builtin_amdgcn_mfma_f32_16x16x32_bf16(ua, ldsb8(BST + kcol * 40 + fq * 8), acc, 0, 0, 0);
                acc = __builtin_amdgcn_mfma_f32_16x16x32_bf16(va, ldsb8(KDST + kcol * 40 + fq * 8), acc, 0, 0, 0);
                const float g = GC[kcol];
#pragma unroll
                for (int i = 0; i < 4; ++i) acc[i] *= g;
                { const unsigned p0 = cvt_pk_bf16(acc[0], acc[1]), p1 = cvt_pk_bf16(acc[2], acc[3]); LAS bf16_t* sp = S0B + (rt * 16 + fq * 4) * 72 + kcol;
                  sp[0] = (bf16_t)p0; sp[72] = (bf16_t)(p0 >> 16); sp[144] = (bf16_t)p1; sp[216] = (bf16_t)(p1 >> 16); }
                Sreg[cc] = acc; }
        }
        __syncthreads();
        if (!isctx) {
            const int j = tid >> 4, c4 = (tid & 15) * 4, t = d == 0 ? j : TB - 1 - j; const f32x4 y = *(const LAS f32x4*)(YO + j * 64 + c4);
            u32x2 w; w.x = cvt_pk_bf16(y[0], y[1]); w.y = cvt_pk_bf16(y[2], y[3]);
            bf16_t* yb_ = p.Y + ((size_t)d * nlat + grow0) * RW + h * 64;
            *(u32x2*)(yb_ + t * RW + c4) = w;
            if (tid < TB) { const int tt = d == 0 ? tid : TB - 1 - tid; float* bb_ = p.bon + ((size_t)d * nlat + grow0) * NH + h; bb_[tt * NH] = BON[tid]; }
        }
    }
}
template <int MODE = 0>
__device__ __forceinline__ void rwkv_phase3(LAS unsigned char* lds, const In& in, const RwkvP p, int bid, int nblk) {
    const int nchain = 2 * p.nb * NH;
    for (int c = bid; c < nchain; c += nblk) { rwkv_chain3<MODE>(lds, in, p, c); __syncthreads(); }
}
}
}

namespace mk {
constexpr int LR_XT = 0;
constexpr int LR_XC = LR_XT + 67 * 64 * 2 + 64;
constexpr int LR_XCB = LR_XC + 64 * 64 * 4;
constexpr int LR_GWT = LR_XCB + 64 * 72 * 2;
constexpr int LR_A = LR_GWT + 2 * 64 * 72 * 2;
constexpr int LR_BX = LR_A + 64 * 64 * 4;
constexpr int LR_HO = LR_BX + 64 * 64 * 4;
constexpr int LR_CST = LR_HO + 64 * 64 * 4;
constexpr int LR_SEGP = LR_CST + 8 * 64 * 4;
constexpr int LR_SEGH = LR_SEGP + 8 * 64 * 4;
constexpr int LR_HC = LR_SEGH + 8 * 64 * 4;
constexpr int LR_END = LR_HC + 64 * 4;
static_assert(LR_END <= LDS_BYTES && (LR_XC % 16) == 0, "lru LDS");

struct LruP { const bf16_t* z1; bf16_t* Hd; int b0, nb; };

__device__ __forceinline__ void lru_item(LAS unsigned char* lds, const In& in, const LruP p, int item) {
    const int tid = threadIdx.x, lane = tid & 63, wid = tid >> 6;
    const int d = item / (p.nb * LB), bl = (item / LB) % p.nb, n = item % LB;
    const int nlat = p.nb * SEQ;
    LAS bf16_t* XT = (LAS bf16_t*)(lds + LR_XT); LAS float* XC = (LAS float*)(lds + LR_XC); LAS bf16_t* XCB = (LAS bf16_t*)(lds + LR_XCB); LAS bf16_t* GWT = (LAS bf16_t*)(lds + LR_GWT);
    LAS float *A_ = (LAS float*)(lds + LR_A), *BX = (LAS float*)(lds + LR_BX), *HO = (LAS float*)(lds + LR_HO), *CST = (LAS float*)(lds + LR_CST), *SEGP = (LAS float*)(lds + LR_SEGP), *SEGH = (LAS float*)(lds + LR_SEGH), *HC = (LAS float*)(lds + LR_HC);
    for (int i = tid; i < 2 * 64 * 64; i += NT) { const int g = i >> 12, j = (i >> 6) & 63, k = i & 63;
        GWT[(g * 64 + k) * 72 + j] = f2bf(in.lru_gate_w[((((size_t)d * 2 + g) * LB + n) * LBS + j) * LBS + k]); }
    for (int i = tid; i < 64; i += NT) { const int c = n * 64 + i;
        CST[i] = in.lru_conv_w[c]; CST[64 + i] = in.lru_conv_w[LW + c]; CST[128 + i] = in.lru_conv_w[2 * LW + c]; CST[192 + i] = in.lru_conv_w[3 * LW + c]; CST[256 + i] = in.lru_conv_b[c];
        CST[320 + i] = in.lru_gate_b[((d * 2 + 0) * LB + n) * LBS + i]; CST[384 + i] = in.lru_gate_b[((d * 2 + 1) * LB + n) * LBS + i]; CST[448 + i] = softplusf_(-in.lru_l[d * LW + c]); }
    constexpr int NSEG = CTX / 64 + GW, NSC = CTX / 64;
    u32x4 pre[2];
    auto tok_row = [&](int sidx, int rr, bool& ok) -> size_t {
        if (sidx < NSC) { const int t = sidx * 64 + rr - 2; ok = t >= 0 && t < CTX; return (size_t)nlat + (size_t)bl * CTX + t; }
        const int col = sidx - NSC, row = rr - 2; ok = row >= 0 && row < ROWS; return (size_t)bl * SEQ + (size_t)row * GW + col;
    };
    auto seg_of = [&](int q) { if (q < NSC) return d == 0 ? q : NSC - 1 - q; const int ql = q - NSC; return NSC + (d == 0 ? ql : GW - 1 - ql); };
    auto prefetch = [&](int q) { const int sidx = seg_of(q);
#pragma unroll
        for (int k = 0; k < 2; ++k) { const int i = tid + k * NT; u32x4 v = (u32x4){0u, 0u, 0u, 0u};
            if (i < 67 * 8) { const int rr = i >> 3, part = i & 7; bool ok; const size_t gr = tok_row(sidx, rr, ok); if (ok) v = *(const u32x4*)(p.z1 + gr * Z1_N + Z1_LX + n * 64 + part * 8); }
            pre[k] = v; } };
    auto commit = [&]() {
#pragma unroll
        for (int k = 0; k < 2; ++k) { const int i = tid + k * NT; if (i < 67 * 8) *(LAS u32x4*)(XT + (i >> 3) * 64 + (i & 7) * 8) = pre[k]; } };
    if (tid < 64) HC[tid] = 0.f;
    prefetch(0);
    for (int q = 0; q < NSEG; ++q) {
        const int sidx = seg_of(q);
        commit();
        __syncthreads();
        if (q + 1 < NSEG) prefetch(q + 1);
        { const int t = tid >> 3, c0 = (tid & 7) * 8; float s[8];
#pragma unroll
          for (int j = 0; j < 8; ++j) s[j] = CST[256 + c0 + j];
#pragma unroll
          for (int tap = 0; tap < 4; ++tap) { const u32x4 x = *(const LAS u32x4*)(XT + (t + tap) * 64 + c0);
#pragma unroll
              for (int j = 0; j < 4; ++j) { s[2 * j] += CST[tap * 64 + c0 + 2 * j] * bflo(x[j]); s[2 * j + 1] += CST[tap * 64 + c0 + 2 * j + 1] * bfhi(x[j]); } }
          *(LAS f32x4*)(XC + t * 64 + c0) = (f32x4){s[0], s[1], s[2], s[3]}; *(LAS f32x4*)(XC + t * 64 + c0 + 4) = (f32x4){s[4], s[5], s[6], s[7]};
          u32x4 w; w.x = cvt_pk_bf16(s[0], s[1]); w.y = cvt_pk_bf16(s[2], s[3]); w.z = cvt_pk_bf16(s[4], s[5]); w.w = cvt_pk_bf16(s[6], s[7]); *(LAS u32x4*)(XCB + t * 72 + c0) = w; }
        __syncthreads();
        { const int rt = wid >> 1, fr = lane & 15, fq = lane >> 4;
          bf16x8 a[2];
#pragma unroll
          for (int ks = 0; ks < 2; ++ks) a[ks] = *(const LAS bf16x8*)(XCB + (rt * 16 + fr) * 72 + ks * 32 + fq * 8);
#pragma unroll
          for (int cc = 0; cc < 2; ++cc) { const int ct = 2 * (wid & 1) + cc, col = ct * 16 + fr;
              f32x4 acc0 = (f32x4){0.f, 0.f, 0.f, 0.f}, acc1 = acc0;
#pragma unroll
              for (int ks = 0; ks < 2; ++ks) {
                  const bf16x8 b0 = *(const LAS bf16x8*)(GWT + (0 * 64 + col) * 72 + ks * 32 + fq * 8), b1 = *(const LAS bf16x8*)(GWT + (1 * 64 + col) * 72 + ks * 32 + fq * 8);
                  acc0 = __builtin_amdgcn_mfma_f32_16x16x32_bf16(a[ks], b0, acc0, 0, 0, 0); acc1 = __builtin_amdgcn_mfma_f32_16x16x32_bf16(a[ks], b1, acc1, 0, 0, 0); }
#pragma unroll
              for (int i = 0; i < 4; ++i) { const int t = rt * 16 + fq * 4 + i;
                  const float rec = fast_sigmoid(acc0[i] + CST[320 + col]), inp = fast_sigmoid(acc1[i] + CST[384 + col]);
                  const float la = -8.f * rec * CST[448 + col];
                  const float av = __expf(la), x2 = 2.f * la; const float om = x2 > -0.03f ? -x2 * (1.f + x2 * (0.5f + x2 * (1.f / 6.f))) : 1.f - av * av;
                  A_[t * 64 + col] = av; BX[t * 64 + col] = __builtin_amdgcn_sqrtf(om) * inp * XC[t * 64 + col]; } } }
        __syncthreads();
        { const int ch = tid & 63, pc = tid >> 6; float av[8], bv[8]; float P = 1.f, H = 0.f;
#pragma unroll
          for (int x = 0; x < 8; ++x) { const int st = pc * 8 + x, t = d == 0 ? st : 63 - st; av[x] = A_[t * 64 + ch]; bv[x] = BX[t * 64 + ch]; H = av[x] * H + bv[x]; P *= av[x]; }
          SEGP[pc * 64 + ch] = P; SEGH[pc * 64 + ch] = H;
          __syncthreads();
          float h = HC[ch];
#pragma unroll
          for (int q2 = 0; q2 < 7; ++q2) if (q2 < pc) h = SEGP[q2 * 64 + ch] * h + SEGH[q2 * 64 + ch];
#pragma unroll
          for (int x = 0; x < 8; ++x) { const int st = pc * 8 + x, t = d == 0 ? st : 63 - st; h = av[x] * h + bv[x]; HO[t * 64 + ch] = h; }
          __syncthreads();
          if (pc == 7) HC[ch] = h;
        }
        if (sidx >= NSC) { const int col = sidx - NSC, t = tid >> 3, c0 = (tid & 7) * 8;
            const f32x4 x = *(const LAS f32x4*)(HO + t * 64 + c0), y = *(const LAS f32x4*)(HO + t * 64 + c0 + 4);
            *(u32x4*)(p.Hd + ((size_t)d * nlat + (size_t)bl * SEQ + (size_t)t * GW + col) * LW + n * 64 + c0) = pack8(x, y); }
    }
}
__device__ __forceinline__ void lru_phase(LAS unsigned char* lds, const In& in, const LruP p, int bid, int nblk) {
    const int nitem = 2 * p.nb * LB;
    for (int it = bid; it < nitem; it += nblk) { lru_item(lds, in, p, it); __syncthreads(); }
}
}

namespace mk {
#define MK_DPPX(x, ctrl) __int_as_float(__builtin_amdgcn_update_dpp(__float_as_int(x), __float_as_int(x), ctrl, 0xF, 0xF, false))
__device__ __forceinline__ float allreduce4(float x) { x += MK_DPPX(x, 0xB1); x += MK_DPPX(x, 0x4E); return x; }
__device__ __forceinline__ void unpack8(const u32x4 w, float (&f)[8]) {
#pragma unroll
    for (int j = 0; j < 4; ++j) { f[2 * j] = bflo(w[j]); f[2 * j + 1] = bfhi(w[j]); } }
constexpr int AG_K = 256;
struct PostP { const bf16_t* z1; bf16_t* Y; const float* bon; bf16_t* Ag; int nlat; int pad_; };
__device__ __forceinline__ void rwkv_post_rows(const In& in, const PostP p, int row_lo, int row_hi, bool dry = false) {
    const int lane = threadIdx.x & 63, wid = threadIdx.x >> 6, c0 = lane * 16, h = lane >> 2;
    float mu0v[16], mu1v[16], l0[16], l1[16], mg0[8], mg1[8];
#pragma unroll
    for (int j = 0; j < 16; ++j) { mu0v[j] = in.shift_mu[OFF_V + c0 + j]; mu1v[j] = in.shift_mu[RC + OFF_V + c0 + j]; l0[j] = in.rw_lnx[c0 + j]; l1[j] = in.rw_lnx[RW + c0 + j]; }
#pragma unroll
    for (int j = 0; j < 8; ++j) { const int c = OFF_GD + (lane < GL / 8 ? lane : 0) * 8 + j; mg0[j] = in.shift_mu[c]; mg1[j] = in.shift_mu[RC + c]; }
    for (int r = row_lo + wid; r < row_hi; r += NT / 64) {
        const int cg = r % GW; const bool hp = cg > 0, hn = cg < GW - 1;
        bf16_t* y0p = p.Y + (size_t)r * RW + c0; const bf16_t* y1p = p.Y + ((size_t)p.nlat + r) * RW + c0;
        float y[16], t8[8];
        unpack8(*(const u32x4*)y0p, t8);
#pragma unroll
        for (int j = 0; j < 8; ++j) y[j] = t8[j];
        unpack8(*(const u32x4*)(y0p + 8), t8);
#pragma unroll
        for (int j = 0; j < 8; ++j) y[8 + j] = t8[j];
        unpack8(*(const u32x4*)y1p, t8);
#pragma unroll
        for (int j = 0; j < 8; ++j) y[j] += t8[j];
        unpack8(*(const u32x4*)(y1p + 8), t8);
#pragma unroll
        for (int j = 0; j < 8; ++j) y[8 + j] += t8[j];
        float s = 0.f;
#pragma unroll
        for (int j = 0; j < 16; ++j) s += y[j];
        const float mu = allreduce4(s) * (1.f / 64.f); float q = 0.f;
#pragma unroll
        for (int j = 0; j < 16; ++j) { const float dlt = y[j] - mu; q += dlt * dlt; }
        const float rs = 1.f / sqrtf(allreduce4(q) * (1.f / 64.f) + LNX_EPS);
        const float bonus = p.bon[(size_t)r * NH + h] + p.bon[((size_t)p.nlat + r) * NH + h];
        const bf16_t* zr = p.z1 + (size_t)r * Z1_N;
#pragma unroll
        for (int half = 0; half < 2; ++half) {
            const int c = OFF_V + c0 + half * 8; float xv[8], pv[8], nv[8];
            unpack8(*(const u32x4*)(zr + c), xv);
            if (hp) unpack8(*(const u32x4*)(zr - Z1_N + c), pv); else {
#pragma unroll
                for (int j = 0; j < 8; ++j) pv[j] = 0.f; }
            if (hn) unpack8(*(const u32x4*)(zr + Z1_N + c), nv); else {
#pragma unroll
                for (int j = 0; j < 8; ++j) nv[j] = 0.f; }
            float o[8];
#pragma unroll
            for (int j = 0; j < 8; ++j) { const int cj = half * 8 + j; const float v = xv[j] + mu0v[cj] * (pv[j] - xv[j]) + mu1v[cj] * (nv[j] - xv[j]);
                o[j] = (y[cj] - mu) * rs * l0[cj] + l1[cj] + bonus * v; }
            u32x4 w; w.x = cvt_pk_bf16(o[0], o[1]); w.y = cvt_pk_bf16(o[2], o[3]); w.z = cvt_pk_bf16(o[4], o[5]); w.w = cvt_pk_bf16(o[6], o[7]); if (!dry) *(u32x4*)(y0p + half * 8) = w; else if (w.x == 0x12345678u) *(u32x4*)(y0p + half * 8) = w;
        }
        if (lane < 32) { u32x4 w = (u32x4){0u, 0u, 0u, 0u};
            if (lane < GL / 8) { const int c = OFF_GD + lane * 8; float xv[8], pv[8], nv[8];
                unpack8(*(const u32x4*)(zr + c), xv);
                if (hp) unpack8(*(const u32x4*)(zr - Z1_N + c), pv); else {
#pragma unroll
                    for (int j = 0; j < 8; ++j) pv[j] = 0.f; }
                if (hn) unpack8(*(const u32x4*)(zr + Z1_N + c), nv); else {
#pragma unroll
                    for (int j = 0; j < 8; ++j) nv[j] = 0.f; }
                float o[8];
#pragma unroll
                for (int j = 0; j < 8; ++j) o[j] = fast_sigmoid(xv[j] + mg0[j] * (pv[j] - xv[j]) + mg1[j] * (nv[j] - xv[j]));
                w.x = cvt_pk_bf16(o[0], o[1]); w.y = cvt_pk_bf16(o[2], o[3]); w.z = cvt_pk_bf16(o[4], o[5]); w.w = cvt_pk_bf16(o[6], o[7]); }
            *(u32x4*)(p.Ag + (size_t)r * AG_K + lane * 8) = w; }
    }
}
#define MK_FR_ROW(f) ((((f) >> 3) * HALF) + wr * 64 + ((((f) >> 1) & 3) * 16) + fr)
#define MK_FR_COL(f) ((((f) & 1) * HALF) + wc * 32 + 8 * fq)
#define MK_FR_ACC(f, n) acc[(f) >> 3][(f) & 1][((f) >> 1) & 3][n]
#define MK_FENCE asm volatile("" ::: "memory")
struct EpiYa { const bf16_t* yn; bf16_t* ya;
    __device__ __forceinline__ bool operator()(f32x4 (&acc)[2][2][4][2], const Unit& u, int wr, int wc, int fr, int fq) const {
        const size_t base = (size_t)(u.pm * BM) * RW + u.pn * BM;
        u32x4 cur = *(const u32x4*)(yn + base + (size_t)MK_FR_ROW(0) * RW + MK_FR_COL(0));
#pragma unroll
        for (int f = 0; f < 16; ++f) { u32x4 nxt = cur; if (f + 1 < 16) nxt = *(const u32x4*)(yn + base + (size_t)MK_FR_ROW(f + 1) * RW + MK_FR_COL(f + 1));
            MK_FENCE; float v[8]; unpack8(cur, v); f32x4 a = MK_FR_ACC(f, 0), b = MK_FR_ACC(f, 1);
#pragma unroll
            for (int j = 0; j < 4; ++j) { a[j] *= v[j]; b[j] *= v[4 + j]; }
            *(u32x4*)(ya + base + (size_t)MK_FR_ROW(f) * RW + MK_FR_COL(f)) = pack8(a, b); MK_FENCE; cur = nxt; }
        return false; } };
struct EpiZc { const bf16_t* Hd; bf16_t* yb; bf16_t* gates; int nlat; int pad_;
    __device__ __forceinline__ bool operator()(f32x4 (&acc)[2][2][4][2], const Unit& u, int wr, int wc, int fr, int fq) const {
        if (u.pn < LW / BM) {
            MK_FRAG_LOOP(r, c) { const size_t o = (size_t)(u.pm * BM + r) * LW + u.pn * BM + c; float h0[8], h1[8]; unpack8(*(const u32x4*)(Hd + o), h0); unpack8(*(const u32x4*)(Hd + (size_t)nlat * LW + o), h1);
                f32x4 a = acc[ai][bj][m][0], b = acc[ai][bj][m][1];
#pragma unroll
                for (int j = 0; j < 4; ++j) { a[j] = gelu_tanhf_(a[j]) * (h0[j] + h1[j]); b[j] = gelu_tanhf_(b[j]) * (h0[4 + j] + h1[4 + j]); }
                *(u32x4*)(yb + o) = pack8(a, b); asm volatile("" ::: "memory"); }
        } else {
            MK_FRAG_LOOP(r, c) { const size_t o = (size_t)(u.pm * BM + r) * (2 * D) + (u.pn * BM - LW) + c;
                f32x4 a = acc[ai][bj][m][0], b = acc[ai][bj][m][1];
#pragma unroll
                for (int j = 0; j < 4; ++j) { a[j] = fast_sigmoid(a[j]); b[j] = fast_sigmoid(b[j]); }
                *(u32x4*)(gates + o) = pack8(a, b); }
        }
        return false; } };
struct PairOrder { StaticOrder S;
    __device__ bool next(int i, Unit& u) const { if (!S.next(i >> 1, u)) return false; u.e = i & 1; return true; } };
struct EpiBranch { const bf16_t* gates; bf16_t* mixed;
    __device__ __forceinline__ bool operator()(f32x4 (&acc)[2][2][4][2], const Unit& u, int wr, int wc, int fr, int fq) const {
        const size_t gbase = (size_t)(u.pm * BM) * (2 * D) + u.pn * BM, mbase = (size_t)(u.pm * BM) * D + u.pn * BM;
        u32x4 c1 = (u32x4){0u, 0u, 0u, 0u}, c2 = *(const u32x4*)(gates + gbase + (size_t)MK_FR_ROW(0) * (2 * D) + D + MK_FR_COL(0));
        if (u.e == 0) c1 = *(const u32x4*)(gates + gbase + (size_t)MK_FR_ROW(0) * (2 * D) + MK_FR_COL(0));
#pragma unroll
        for (int f = 0; f < 16; ++f) { u32x4 n1 = c1, n2 = c2;
            if (f + 1 < 16) { const size_t o = gbase + (size_t)MK_FR_ROW(f + 1) * (2 * D) + MK_FR_COL(f + 1); n2 = *(const u32x4*)(gates + o + D); if (u.e == 0) n1 = *(const u32x4*)(gates + o); }
            MK_FENCE; float g1[8], g2[8]; unpack8(c1, g1); unpack8(c2, g2);
            if (u.e == 0) {
#pragma unroll
                for (int j = 0; j < 4; ++j) { MK_FR_ACC(f, 0)[j] *= g1[j] / g2[j]; MK_FR_ACC(f, 1)[j] *= g1[4 + j] / g2[4 + j]; }
            } else { f32x4 a = MK_FR_ACC(f, 0), b = MK_FR_ACC(f, 1);
#pragma unroll
                for (int j = 0; j < 4; ++j) { a[j] *= g2[j]; b[j] *= g2[4 + j]; }
                *(u32x4*)(mixed + mbase + (size_t)MK_FR_ROW(f) * D + MK_FR_COL(f)) = pack8(a, b); }
            MK_FENCE; c1 = n1; c2 = n2; }
        return u.e == 0; } };
struct EpiF32 { float* C; long ldc;
    __device__ __forceinline__ bool operator()(f32x4 (&acc)[2][2][4][2], const Unit& u, int wr, int wc, int fr, int fq) const {
        MK_FRAG_LOOP(r, c) { float* o = C + (size_t)(u.pm * BM + r) * ldc + u.pn * BM + c; *(f32x4*)o = acc[ai][bj][m][0]; *(f32x4*)(o + 4) = acc[ai][bj][m][1]; }
        return false; } };
}

namespace mk {
constexpr int NEX = NE + 1;
constexpr int SLOTS_PER_TOK = TOPK + 1;
constexpr int RP_MOD = 0;
constexpr int RP_UH = RP_MOD + 3 * D * 4;
constexpr int RP_UL = RP_UH + 16 * (D + 8) * 2;
constexpr int RP_PART = RP_UL + 16 * (D + 8) * 2;
constexpr int RP_LOG = RP_PART + 8 * 16 * 64 * 4;
constexpr int RP_HIST = RP_LOG + 16 * 64 * 4;
constexpr int RP_END = RP_HIST + 64 * 4;
static_assert(RP_END <= LDS_BYTES, "rowpass LDS");

struct RowP { float* y2h1; bf16_t* u; const float* modpart; const bf16_t* rwt;
              int* tope; float* gatev; int* lrank; int* blkcnt; int b0, nlat; };
__device__ __forceinline__ float wave_max(float x) {
#pragma unroll
    for (int o = 32; o > 0; o >>= 1) x = fmaxf(x, __shfl_xor(x, o));
    return x; }
__device__ __forceinline__ void row_pass(LAS unsigned char* lds, const In& in, const RowP p, int row_lo, int row_hi, bool dry = false) {
    const int tid = threadIdx.x, lane = tid & 63, wid = tid >> 6;
    LAS float* MOD = (LAS float*)(lds + RP_MOD); LAS bf16_t* UH = (LAS bf16_t*)(lds + RP_UH); LAS bf16_t* UL = (LAS bf16_t*)(lds + RP_UL);
    LAS float* PART = (LAS float*)(lds + RP_PART); LAS float* LOG = (LAS float*)(lds + RP_LOG); LAS int* HIST = (LAS int*)(lds + RP_HIST);
    const int mr = p.b0 + row_lo / SEQ;
    for (int j = tid; j < 3 * D; j += NT) MOD[j] = mod_value(in, p.modpart, mr, 2 * D + j);
    if (tid < 64) HIST[tid] = 0;
    __syncthreads();
    float gp1[16], gp2[16];
#pragma unroll
    for (int j = 0; j < 4; ++j)
#pragma unroll
        for (int q = 0; q < 4; ++q) { gp1[4 * j + q] = in.norm_g[D + j * 256 + lane * 4 + q]; gp2[4 * j + q] = in.norm_g[2 * D + j * 256 + lane * 4 + q]; }
    for (int r16 = row_lo; r16 < row_hi; r16 += 16) {
#pragma unroll
        for (int rr = 0; rr < 2; ++rr) {
            const int lr = wid * 2 + rr, r = r16 + lr;
            float* yp = p.y2h1 + (size_t)r * D; const float* xp = in.x + ((size_t)p.b0 * SEQ + r) * D;
            f32x4 v[4]; float ss = 0.f;
#pragma unroll
            for (int j = 0; j < 4; ++j) { v[j] = *(const f32x4*)(yp + j * 256 + lane * 4); ss += v[j][0] * v[j][0] + v[j][1] * v[j][1] + v[j][2] * v[j][2] + v[j][3] * v[j][3]; }
#pragma unroll
            for (int o = 32; o > 0; o >>= 1) ss += __shfl_xor(ss, o);
            const float rinv = 1.f / sqrtf(ss * (1.f / D) + NORM_EPS); float s2 = 0.f;
#pragma unroll
            for (int j = 0; j < 4; ++j) { const int c = j * 256 + lane * 4; const f32x4 xv = *(const f32x4*)(xp + c);
#pragma unroll
                for (int q = 0; q < 4; ++q) { const float hv = xv[q] + MOD[c + q] * (v[j][q] * rinv * gp1[4 * j + q]); v[j][q] = hv; s2 += hv * hv; }
                if (!dry) *(f32x4*)(yp + c) = v[j]; }
#pragma unroll
            for (int o = 32; o > 0; o >>= 1) s2 += __shfl_xor(s2, o);
            const float r2 = 1.f / sqrtf(s2 * (1.f / D) + NORM_EPS);
#pragma unroll
            for (int j = 0; j < 4; ++j) { const int c = j * 256 + lane * 4; float uu[4], lo[4]; unsigned hw[2];
#pragma unroll
                for (int q = 0; q < 4; ++q) uu[q] = (v[j][q] * r2 * gp2[4 * j + q]) * (1.f + MOD[2 * D + c + q]) + MOD[D + c + q];
                hw[0] = cvt_pk_bf16(uu[0], uu[1]); hw[1] = cvt_pk_bf16(uu[2], uu[3]);
                lo[0] = uu[0] - bflo(hw[0]); lo[1] = uu[1] - bfhi(hw[0]); lo[2] = uu[2] - bflo(hw[1]); lo[3] = uu[3] - bfhi(hw[1]);
                u32x2 w; w.x = hw[0]; w.y = hw[1]; *(u32x2*)(p.u + (size_t)r * D + c) = w; *(LAS u32x2*)(UH + lr * (D + 8) + c) = w;
                u32x2 wl; wl.x = cvt_pk_bf16(lo[0], lo[1]); wl.y = cvt_pk_bf16(lo[2], lo[3]); *(LAS u32x2*)(UL + lr * (D + 8) + c) = wl; }
        }
        __syncthreads();
        { const int fr = lane & 15, fq = lane >> 4;
          f32x4 acc[4];
#pragma unroll
          for (int ct = 0; ct < 4; ++ct) acc[ct] = (f32x4){0.f, 0.f, 0.f, 0.f};
#pragma unroll
          for (int ks = 0; ks < 4; ++ks) { const int k0 = wid * 128 + ks * 32 + fq * 8;
              const bf16x8 ah = *(const LAS bf16x8*)(UH + fr * (D + 8) + k0), al = *(const LAS bf16x8*)(UL + fr * (D + 8) + k0);
#pragma unroll
              for (int ct = 0; ct < 4; ++ct) { const bf16x8 bh = *(const bf16x8*)(p.rwt + (size_t)(ct * 16 + fr) * D + k0), bl = *(const bf16x8*)(p.rwt + (size_t)(NE + ct * 16 + fr) * D + k0);
                  acc[ct] = __builtin_amdgcn_mfma_f32_16x16x32_bf16(ah, bh, acc[ct], 0, 0, 0); acc[ct] = __builtin_amdgcn_mfma_f32_16x16x32_bf16(ah, bl, acc[ct], 0, 0, 0); acc[ct] = __builtin_amdgcn_mfma_f32_16x16x32_bf16(al, bh, acc[ct], 0, 0, 0); } }
#pragma unroll
          for (int ct = 0; ct < 4; ++ct)
#pragma unroll
              for (int i = 0; i < 4; ++i) PART[(wid * 16 + fq * 4 + i) * 64 + ct * 16 + fr] = acc[ct][i]; }
        __syncthreads();
        for (int i = tid; i < 16 * 64; i += NT) { float s = 0.f;
#pragma unroll
            for (int w = 0; w < 8; ++w) s += PART[w * 1024 + i];
            LOG[i] = s; }
        __syncthreads();
#pragma unroll 1
        for (int rr = 0; rr < 2; ++rr) {
            const int lr = wid * 2 + rr, r = r16 + lr;
            const float sc = sigmoidf_(LOG[lr * 64 + lane]), bi = sc + in.router_b[lane];
            float m1 = bi; m1 = fmaxf(m1, __shfl_xor(m1, 1)); m1 = fmaxf(m1, __shfl_xor(m1, 2)); m1 = fmaxf(m1, __shfl_xor(m1, 4));
            const unsigned long long eq = __ballot(bi == m1); const int first = __ffsll((long long)((eq >> (lane & ~7)) & 0xffull)) - 1 + (lane & ~7);
            float m2 = (lane == first) ? -1e30f : bi; m2 = fmaxf(m2, __shfl_xor(m2, 1)); m2 = fmaxf(m2, __shfl_xor(m2, 2)); m2 = fmaxf(m2, __shfl_xor(m2, 4));
            const float gs = m1 + m2; const int myg = lane >> 3; int rank = 0;
#pragma unroll
            for (int g = 0; g < NG; ++g) { const float og = __shfl(gs, g * 8); rank += (og > gs || (og == gs && g < myg)) ? 1 : 0; }
            float cand = rank < TG ? bi : -1e30f; float tsum = 0.f; int myidx = 0; float mysc = 0.f;
#pragma unroll
            for (int it = 0; it < TOPK; ++it) { const float m = wave_max(cand); const unsigned long long bm = __ballot(cand == m); const int win = __ffsll((long long)bm) - 1;
                const float ws = __shfl(sc, win); tsum += ws; if (lane == it) { myidx = win; mysc = ws; } if (lane == win) cand = -1e30f; }
            if (lane < TOPK) { const int rk = atomicAdd((int*)&HIST[myidx], 1);
                p.tope[(size_t)r * TOPK + lane] = myidx; p.gatev[(size_t)r * TOPK + lane] = mysc / tsum * 2.5f; p.lrank[(size_t)r * TOPK + lane] = rk; }
        }
        __syncthreads();
    }
    if (tid < 64) p.blkcnt[blockIdx.x * 64 + tid] = HIST[tid];
}

struct MoeP { const int* tope; const float* gatev; const int* lrank; const int* blkcnt;
              int* tilepre;
              int* list;
              int* sdst;
              float* sgate;
              int r0, nr, blk0, nbh, rpb, pad_; };
__device__ __forceinline__ void moe_assign(LAS unsigned char* lds, const MoeP p, int bid, int nblk) {
    LAS int* BASE = (LAS int*)lds; LAS int* CNT = BASE + 80; LAS int* BOFF = CNT + 80;
    const int tid = threadIdx.x;
    if (tid < NE) { int c = 0, bo = 0; for (int b = 0; b < p.nbh; ++b) { const int v = p.blkcnt[(p.blk0 + b) * 64 + tid]; if (p.blk0 + b < bid) bo += v; c += v; } CNT[tid] = c; BOFF[tid] = bo; }
    __syncthreads();
    if (tid == 0) { int s = 0; for (int e = 0; e < NE; ++e) { BASE[e] = s; s += (CNT[e] + BM - 1) / BM * BM; } BASE[NE] = s; CNT[NE] = p.nr; BASE[NE + 1] = s + p.nr;
        if (bid == 0) { for (int e = 0; e <= NEX; ++e) p.tilepre[e] = BASE[e] / BM; } }
    __syncthreads();
    if (bid >= p.blk0 && bid < p.blk0 + p.nbh) {
        const int rlo = p.r0 + (bid - p.blk0) * p.rpb;
        for (int i = tid; i < p.rpb * TOPK; i += NT) { const int r = rlo + i / TOPK, a = r * TOPK + i % TOPK, e = p.tope[a]; const int slot = BASE[e] + BOFF[e] + p.lrank[a];
            p.list[slot] = r; p.sdst[slot] = (r - p.r0) * SLOTS_PER_TOK + i % TOPK; p.sgate[slot] = p.gatev[a]; }
        for (int i = tid; i < p.rpb; i += NT) { const int r = rlo + i, slot = BASE[NE] + (r - p.r0); p.list[slot] = r; p.sdst[slot] = (r - p.r0) * SLOTS_PER_TOK + TOPK; p.sgate[slot] = 1.f; }
    }
    for (int e = bid; e < NE; e += nblk) { const int lo = BASE[e] + CNT[e], hi = BASE[e + 1]; for (int s = lo + tid; s < hi; s += NT) { p.list[s] = p.r0; p.sdst[s] = -1; p.sgate[s] = 0.f; } }
}
struct GroupOrder { int tpn, total, nN, G, c;
    __device__ void init(const int* tilepre, int nN_, int G_, int c_) { const int lane = threadIdx.x & 63;
        tpn = (int)__hip_atomic_load((const unsigned*)tilepre + lane + 1, __ATOMIC_RELAXED, __HIP_MEMORY_SCOPE_AGENT);
        total = (int)__hip_atomic_load((const unsigned*)tilepre + NEX, __ATOMIC_RELAXED, __HIP_MEMORY_SCOPE_AGENT); nN = nN_; G = G_; c = c_; }
    __device__ bool next(int i, Unit& u) const { const long L = (long)i * G + c; if (L >= (long)total * nN) return false;
        const int T = (int)(L / nN); const int e = __popcll(__ballot(tpn <= T));
        u.pm = T; u.pn = (int)(L % nN); u.e = __builtin_amdgcn_readfirstlane(e); return true; } };
struct EpiGU { bf16_t* act;
    __device__ __forceinline__ bool operator()(f32x4 (&acc)[2][2][4][2], const Unit& u, int wr, int wc, int fr, int fq) const {
        MK_FRAG_LOOP(r, c) { const f32x4 a = acc[ai][bj][m][0], b = acc[ai][bj][m][1];
            u32x2 w; w.x = cvt_pk_bf16(fast_silu(a[0]) * a[1], fast_silu(a[2]) * a[3]); w.y = cvt_pk_bf16(fast_silu(b[0]) * b[1], fast_silu(b[2]) * b[3]);
            *(u32x2*)(act + (size_t)(u.pm * BM + r) * EF + ((u.pn * BM + c) >> 1)) = w; }
        return false; } };
struct EpiDown { const int* sdst; const float* sgate; bf16_t* rowsb;
    __device__ __forceinline__ bool operator()(f32x4 (&acc)[2][2][4][2], const Unit& u, int wr, int wc, int fr, int fq) const {
        int dst[8]; float gt[8];
#pragma unroll
        for (int q = 0; q < 8; ++q) { const int slot = u.pm * BM + (q >> 2) * HALF + wr * 64 + (q & 3) * 16 + fr; dst[q] = sdst[slot]; gt[q] = sgate[slot]; }
#pragma unroll
        for (int ai = 0; ai < 2; ++ai)
#pragma unroll
            for (int m = 0; m < 4; ++m) { const int q = ai * 4 + m; if (dst[q] >= 0) {
#pragma unroll
                for (int bj = 0; bj < 2; ++bj) { f32x4 a = acc[ai][bj][m][0], b = acc[ai][bj][m][1];
#pragma unroll
                    for (int j = 0; j < 4; ++j) { a[j] *= gt[q]; b[j] *= gt[q]; }
                    *(u32x4*)(rowsb + (size_t)dst[q] * D + u.pn * BM + bj * HALF + wc * 32 + 8 * fq) = pack8(a, b); } } }
        return false; } };
__device__ __forceinline__ void final_rows(LAS float* sm  , const In& in, const float* modpart, const bf16_t* rowsb, float* h1out, int b0, int r0, int row_lo, int row_hi, bool dry = false) {
    const int tid = threadIdx.x, lane = tid & 63, wid = tid >> 6;
    const int mr = b0 + row_lo / SEQ;
    __syncthreads();
    for (int j = tid; j < D; j += NT) sm[j] = mod_value(in, modpart, mr, 5 * D + j);
    __syncthreads();
    float gq[16];
#pragma unroll
    for (int j = 0; j < 4; ++j)
#pragma unroll
        for (int q = 0; q < 4; ++q) gq[4 * j + q] = sm[j * 256 + lane * 4 + q] * in.norm_g[3 * D + j * 256 + lane * 4 + q];
    for (int r = row_lo + wid; r < row_hi; r += NT / 64) {
        float v[16];
#pragma unroll
        for (int j = 0; j < 16; ++j) v[j] = 0.f;
        const bf16_t* rb = rowsb + (size_t)(r - r0) * SLOTS_PER_TOK * D;
#pragma unroll
        for (int s = 0; s < SLOTS_PER_TOK; ++s)
#pragma unroll
            for (int j = 0; j < 4; ++j) { const u32x2 w = *(const u32x2*)(rb + (size_t)s * D + j * 256 + lane * 4); v[4 * j] += bflo(w.x); v[4 * j + 1] += bfhi(w.x); v[4 * j + 2] += bflo(w.y); v[4 * j + 3] += bfhi(w.y); }
        float ss = 0.f;
#pragma unroll
        for (int j = 0; j < 16; ++j) ss += v[j] * v[j];
#pragma unroll
        for (int o = 32; o > 0; o >>= 1) ss += __shfl_xor(ss, o);
        const float rinv = 1.f / sqrtf(ss * (1.f / D) + NORM_EPS);
        float* hp = h1out + (size_t)r * D;
#pragma unroll
        for (int j = 0; j < 4; ++j) { const int c = j * 256 + lane * 4; f32x4 hv = *(const f32x4*)(hp + c);
#pragma unroll
            for (int q = 0; q < 4; ++q) hv[q] += gq[4 * j + q] * (v[4 * j + q] * rinv);
            if (!dry) *(f32x4*)(hp + c) = hv; else if (hv[0] == 1.2345e30f) *(f32x4*)(hp + c) = hv; }
    }
}
__device__ __forceinline__ void rwt_prep(const In& in, bf16_t* rwt, int bid, int nblk) {
    for (int i = bid * NT + threadIdx.x; i < NE * D; i += nblk * NT) { const int e = i / D, k = i % D; const float w = in.router_w[(size_t)k * NE + e]; const bf16_t h = f2bf(w); rwt[i] = h; rwt[(size_t)NE * D + i] = f2bf(w - bf2f(h)); }
}
}

using namespace mk;
constexpr size_t MiB = (size_t)1 << 20;
constexpr int NLAT = NB * SEQ, NCTXR = NB * CTX, NALL = NLAT + NCTXR, NRH = NLAT / 2, MAXSLOTS = NRH * SLOTS_PER_TOK + NE * BM;
constexpr size_t O_W1A = 0, O_W1C = O_W1A + (size_t)Z1_N * D * 2, O_WG = O_W1C + (size_t)ZC_N * D * 2, O_WBR = O_WG + (size_t)RW * AG_K * 2, O_WOUT = O_WBR + (size_t)2 * D * RW * 2,
                 O_RWT = O_WOUT + (size_t)D * D * 2, O_MODP = O_RWT + (size_t)2 * NE * D * 2, O_S_END = O_MODP + (size_t)MOD_SL * (NB + 1) * 6 * D * 4;
static_assert(O_S_END <= 27 * MiB, "S region");
constexpr size_t O_BAR = 27 * MiB;
constexpr size_t O_Z1 = 28 * MiB, O_R2 = O_Z1 + (size_t)NALL * Z1_N * 2;
static_assert(O_R2 == 334 * MiB, "z1 size");
constexpr size_t O_HD = O_R2, O_BON = O_HD + (size_t)2 * NLAT * LW * 2, O_AG = O_BON + (size_t)2 * NLAT * NH * 4, O_R2_END = O_AG + (size_t)NLAT * AG_K * 2;
static_assert(O_R2_END <= 512 * MiB, "R2");
constexpr size_t O_XNL = O_Z1, O_YB = O_XNL + (size_t)NLAT * D * 2, O_GATES = O_YB + (size_t)NLAT * LW * 2, O_MIXED = O_HD;
static_assert(O_GATES + (size_t)NLAT * 2 * D * 2 <= O_R2, "late R1");
constexpr size_t O_U = O_Z1, O_WGU = O_U + (size_t)NLAT * D * 2, O_WDN = O_WGU + (size_t)NEX * 2 * EF * D * 2, O_ROUT = O_WDN + (size_t)NEX * D * EF * 2;
constexpr size_t O_TOPE = O_ROUT, O_LRANK = O_TOPE + (size_t)NLAT * TOPK * 4, O_GATEV = O_LRANK + (size_t)NLAT * TOPK * 4, O_BLKCNT = O_GATEV + (size_t)NLAT * TOPK * 4, O_TILEPRE = O_BLKCNT + 256 * 64 * 4,
                 O_LIST = O_TILEPRE + 1024, O_SDST = O_LIST + (size_t)MAXSLOTS * 4, O_SGATE = O_SDST + (size_t)MAXSLOTS * 4, O_ACT = ((O_SGATE + (size_t)MAXSLOTS * 4 + 255) / 256) * 256,
                 O_ROWSB = ((O_ACT + (size_t)MAXSLOTS * EF * 2 + 255) / 256) * 256, O_END = O_ROWSB + (size_t)NRH * SLOTS_PER_TOK * D * 2;
static_assert(O_END <= 512 * MiB, "workspace");
static_assert(O_WGU >= O_YB && O_ROWSB >= O_GATES, "late layout");

struct MP { In in; float* out; unsigned char* ws; long ph_lo, ph_hi; };
constexpr int NPHASE = 17;

#if defined(__HIP_DEVICE_COMPILE__)
#define MK_KARGS auto Pq_ = Pk_; asm volatile("" : "+s"(Pq_)); const MP* Pg_ = (const MP*)Pq_; const In in = Pg_->in; unsigned char* ws = Pg_->ws; float* out_ = Pg_->out; (void)out_;
#else
#define MK_KARGS const In in = P.in; unsigned char* ws = P.ws; float* out_ = P.out; (void)out_; (void)Pk_;
#endif
#define MK_PHASE_PTRS \
    MK_KARGS \
    bf16_t *W1a = (bf16_t*)(ws + O_W1A), *W1c = (bf16_t*)(ws + O_W1C), *Wg = (bf16_t*)(ws + O_WG), *Wbr = (bf16_t*)(ws + O_WBR), *Wout = (bf16_t*)(ws + O_WOUT), *rwt = (bf16_t*)(ws + O_RWT); \
    float* modpart = (float*)(ws + O_MODP); \
    bf16_t *z1 = (bf16_t*)(ws + O_Z1), *Hd = (bf16_t*)(ws + O_HD), *Ag = (bf16_t*)(ws + O_AG); float* bon = (float*)(ws + O_BON); \
    bf16_t *xnl = (bf16_t*)(ws + O_XNL), *yb = (bf16_t*)(ws + O_YB), *gates = (bf16_t*)(ws + O_GATES), *mixed = (bf16_t*)(ws + O_MIXED); \
    bf16_t *u = (bf16_t*)(ws + O_U), *Wgu = (bf16_t*)(ws + O_WGU), *Wdn = (bf16_t*)(ws + O_WDN), *act = (bf16_t*)(ws + O_ACT), *rowsb = (bf16_t*)(ws + O_ROWSB); \
    int *tope = (int*)(ws + O_TOPE), *lrank = (int*)(ws + O_LRANK), *blkcnt = (int*)(ws + O_BLKCNT), *tilepre = (int*)(ws + O_TILEPRE), *list = (int*)(ws + O_LIST), *sdst = (int*)(ws + O_SDST); \
    float *gatev = (float*)(ws + O_GATEV), *sgate = (float*)(ws + O_SGATE); \
    bf16_t* xn_all = (bf16_t*)out_; \
    bf16_t* Y = (bf16_t*)out_; \
    float* y2h1 = out_;
__global__ void __launch_bounds__(512, 2) mega(MP P) {
    extern __shared__ __attribute__((aligned(16))) unsigned char shm[];
    LAS unsigned char* lds = (LAS unsigned char*)shm;
    typedef const __attribute__((address_space(4))) MP* KargP;
    const KargP Pk_ = (KargP)__builtin_amdgcn_kernarg_segment_ptr();
    const int bid = blockIdx.x, nblk = gridDim.x;
    const int ph_lo = (int)P.ph_lo, ph_hi = (int)P.ph_hi;
    volatile LAS unsigned* xst = (volatile LAS unsigned*)(lds + LDS_BYTES - 16);
    if (threadIdx.x == 0) { xst[0] = 0u; xst[1] = 0u; }
    __syncthreads();
    const XcdBarrier xb = xcd_barrier_post((unsigned*)(P.ws + O_BAR), xst);
    if (0 >= ph_lo && 0 < ph_hi) { if (0 > ph_lo) xcd_barrier(xb); const int ph = 0; (void)ph; MK_PHASE_PTRS
        { LAS float* tile = (LAS float*)lds; int base = 0;
            convT_job(tile, in.w_in, INC, D, W1a, D, Z1_N, CMapZ1{}, bid, nblk, base);
            convT_job(tile, in.w_in, INC, D, W1c, D, ZC_N, CMapZC{}, bid, nblk, base);
            convT_job(tile, in.rw_g_up, RW, GL, Wg, AG_K, RW, CMapId{}, bid, nblk, base);
            convT_job(tile, in.w_branch_a, D, RW, Wbr, RW, D, CMapId{}, bid, nblk, base);
            convT_job(tile, in.w_branch_b, D, LW, Wbr + (size_t)D * RW, LW, D, CMapId{}, bid, nblk, base);
            convT_job(tile, in.w_out, D, D, Wout, D, D, CMapId{}, bid, nblk, base);
            rwt_prep(in, rwt, bid, nblk);
            mod_partials((LAS float*)lds, in, modpart, bid, nblk); }
    }
    if (1 >= ph_lo && 1 < ph_hi) { if (1 > ph_lo) xcd_barrier(xb); const int ph = 1; (void)ph; MK_PHASE_PTRS
        { const int L = NLAT / nblk, Lc = NCTXR / nblk;
            xn_rows((LAS float*)lds, in, modpart, xn_all, 0, NB, bid * L, (bid + 1) * L);
            xn_rows((LAS float*)lds, in, modpart, xn_all, 0, NB, NLAT + bid * Lc, NLAT + (bid + 1) * Lc); }
    }
    if (2 >= ph_lo && 2 < ph_hi) { if (2 > ph_lo) xcd_barrier(xb); const int ph = 2; (void)ph; MK_PHASE_PTRS
        { GemmP g{xn_all, xn_all, W1a, 0, nullptr, D, 0}; StaticOrder S; S.init(NALL, Z1_N, nblk, bid); gemm_phase(lds, g, S, EpiStoreBf16{z1, Z1_N}); }
    }
    if (3 >= ph_lo && 3 < ph_hi) { if (3 > ph_lo) xcd_barrier(xb); const int ph = 3; (void)ph; MK_PHASE_PTRS
        { LruP lp{z1, Hd, 0, NB}; lru_phase(lds, in, lp, bid, nblk); __syncthreads();
                  RwkvP rp{z1, Y, bon, 0, NB}; r3::rwkv_phase3(lds, in, rp, bid, nblk); }
    }
    if (4 >= ph_lo && 4 < ph_hi) { if (4 > ph_lo) xcd_barrier(xb); const int ph = 4; (void)ph; MK_PHASE_PTRS
        { const int L = NLAT / nblk; PostP pp{z1, Y, bon, Ag, NLAT, 0}; rwkv_post_rows(in, pp, bid * L, (bid + 1) * L); }
    }
    if (5 >= ph_lo && 5 < ph_hi) { if (5 > ph_lo) xcd_barrier(xb); const int ph = 5; (void)ph; MK_PHASE_PTRS
        { const int L = NLAT / nblk; xn_rows((LAS float*)lds, in, modpart, xnl, 0, NB, bid * L, (bid + 1) * L); __syncthreads();
                  GemmP g{Ag, Ag, Wg, 0, nullptr, AG_K, 0}; StaticOrder S; S.init(NLAT, RW, nblk, bid); gemm_phase(lds, g, S, EpiYa{Y, Y + (size_t)NLAT * RW}); }
    }
    if (6 >= ph_lo && 6 < ph_hi) { if (6 > ph_lo) xcd_barrier(xb); const int ph = 6; (void)ph; MK_PHASE_PTRS
        { GemmP g{xnl, xnl, W1c, 0, nullptr, D, 0}; StaticOrder S; S.init(NLAT, ZC_N, nblk, bid); gemm_phase(lds, g, S, EpiZc{Hd, yb, gates, NLAT, 0}); }
    }
    if (7 >= ph_lo && 7 < ph_hi) { if (7 > ph_lo) xcd_barrier(xb); const int ph = 7; (void)ph; MK_PHASE_PTRS
        { GemmP g{Y + (size_t)NLAT * RW, yb, Wbr, (long)D * RW, nullptr, D, 0}; PairOrder S; S.S.init(NLAT, D, nblk, bid); gemm_phase(lds, g, S, EpiBranch{gates, mixed}); }
    }
    if (8 >= ph_lo && 8 < ph_hi) { if (8 > ph_lo) xcd_barrier(xb); const int ph = 8; (void)ph; MK_PHASE_PTRS
        { LAS float* tile = (LAS float*)lds; int base = 0;
            for (int e = 0; e < NE; ++e) {
                convT_job(tile, in.ex_w_gu + (size_t)e * D * 2 * EF, 2 * EF, D, Wgu + (size_t)e * 2 * EF * D, D, 2 * EF, CMapGU{EF}, bid, nblk, base);
                convT_job(tile, in.ex_w_down + (size_t)e * EF * D, D, EF, Wdn + (size_t)e * D * EF, EF, D, CMapId{}, bid, nblk, base); }
            convT_job(tile, in.sh_w_gu, 2 * SF, D, Wgu + (size_t)NE * 2 * EF * D, D, 2 * SF, CMapGU{SF}, bid, nblk, base);
            convT_job(tile, in.sh_w_down, D, SF, Wdn + (size_t)NE * D * EF, SF, D, CMapId{}, bid, nblk, base);
            __syncthreads();
            GemmP g{mixed, mixed, Wout, 0, nullptr, D, 0}; StaticOrder S; S.init(NLAT, D, nblk, bid); gemm_phase(lds, g, S, EpiF32{y2h1, D}); }
    }
    if (9 >= ph_lo && 9 < ph_hi) { if (9 > ph_lo) xcd_barrier(xb); const int ph = 9; (void)ph; MK_PHASE_PTRS
        { const int L = NLAT / nblk; RowP rp{y2h1, u, modpart, rwt, tope, gatev, lrank, blkcnt, 0, NLAT}; row_pass(lds, in, rp, bid * L, (bid + 1) * L); }
    }
    if (10 >= ph_lo && 10 < ph_hi) { if (10 > ph_lo) xcd_barrier(xb); const int ph = 10; (void)ph; MK_PHASE_PTRS
        { const int q = ph - 10, half = q >= 4 ? 1 : 0, st = q - 4 * half;
            const int rpb = NLAT / nblk;
            auto assign = [&](int hf) { MoeP mp{tope, gatev, lrank, blkcnt, tilepre, list, sdst, sgate, hf * NRH, NRH, hf * (nblk / 2), nblk / 2, rpb, 0}; moe_assign(lds, mp, bid, nblk); };
            auto fin = [&](int hf) { const int L = NRH / nblk, r0 = hf * NRH; final_rows((LAS float*)lds, in, modpart, rowsb, y2h1, 0, r0, r0 + bid * L, r0 + (bid + 1) * L); };
            if (ph == 10) assign(0);
            else if (ph == 11 || ph == 14) { GemmP g{u, u, Wgu, (long)2 * EF * D, list, D, 0}; GroupOrder S; S.init(tilepre, 2 * EF / BM, nblk, bid); gemm_phase<true>(lds, g, S, EpiGU{act}); }
            else if (ph == 12 || ph == 15) { GemmP g{act, act, Wdn, (long)D * EF, nullptr, EF, 0}; GroupOrder S; S.init(tilepre, D / BM, nblk, bid); gemm_phase(lds, g, S, EpiDown{sdst, sgate, rowsb}); }
            else if (ph == 13) { fin(0); __syncthreads(); assign(1); }
            else if (ph == 16) fin(1);
            (void)half; (void)st; }
    }
    if (11 >= ph_lo && 11 < ph_hi) { if (11 > ph_lo) xcd_barrier(xb); const int ph = 11; (void)ph; MK_PHASE_PTRS
        { const int q = ph - 10, half = q >= 4 ? 1 : 0, st = q - 4 * half;
            const int rpb = NLAT / nblk;
            auto assign = [&](int hf) { MoeP mp{tope, gatev, lrank, blkcnt, tilepre, list, sdst, sgate, hf * NRH, NRH, hf * (nblk / 2), nblk / 2, rpb, 0}; moe_assign(lds, mp, bid, nblk); };
            auto fin = [&](int hf) { const int L = NRH / nblk, r0 = hf * NRH; final_rows((LAS float*)lds, in, modpart, rowsb, y2h1, 0, r0, r0 + bid * L, r0 + (bid + 1) * L); };
            if (ph == 10) assign(0);
            else if (ph == 11 || ph == 14) { GemmP g{u, u, Wgu, (long)2 * EF * D, list, D, 0}; GroupOrder S; S.init(tilepre, 2 * EF / BM, nblk, bid); gemm_phase<true>(lds, g, S, EpiGU{act}); }
            else if (ph == 12 || ph == 15) { GemmP g{act, act, Wdn, (long)D * EF, nullptr, EF, 0}; GroupOrder S; S.init(tilepre, D / BM, nblk, bid); gemm_phase(lds, g, S, EpiDown{sdst, sgate, rowsb}); }
            else if (ph == 13) { fin(0); __syncthreads(); assign(1); }
            else if (ph == 16) fin(1);
            (void)half; (void)st; }
    }
    if (12 >= ph_lo && 12 < ph_hi) { if (12 > ph_lo) xcd_barrier(xb); const int ph = 12; (void)ph; MK_PHASE_PTRS
        { const int q = ph - 10, half = q >= 4 ? 1 : 0, st = q - 4 * half;
            const int rpb = NLAT / nblk;
            auto assign = [&](int hf) { MoeP mp{tope, gatev, lrank, blkcnt, tilepre, list, sdst, sgate, hf * NRH, NRH, hf * (nblk / 2), nblk / 2, rpb, 0}; moe_assign(lds, mp, bid, nblk); };
            auto fin = [&](int hf) { const int L = NRH / nblk, r0 = hf * NRH; final_rows((LAS float*)lds, in, modpart, rowsb, y2h1, 0, r0, r0 + bid * L, r0 + (bid + 1) * L); };
            if (ph == 10) assign(0);
            else if (ph == 11 || ph == 14) { GemmP g{u, u, Wgu, (long)2 * EF * D, list, D, 0}; GroupOrder S; S.init(tilepre, 2 * EF / BM, nblk, bid); gemm_phase<true>(lds, g, S, EpiGU{act}); }
            else if (ph == 12 || ph == 15) { GemmP g{act, act, Wdn, (long)D * EF, nullptr, EF, 0}; GroupOrder S; S.init(tilepre, D / BM, nblk, bid); gemm_phase(lds, g, S, EpiDown{sdst, sgate, rowsb}); }
            else if (ph == 13) { fin(0); __syncthreads(); assign(1); }
            else if (ph == 16) fin(1);
            (void)half; (void)st; }
    }
    if (13 >= ph_lo && 13 < ph_hi) { if (13 > ph_lo) xcd_barrier(xb); const int ph = 13; (void)ph; MK_PHASE_PTRS
        { const int q = ph - 10, half = q >= 4 ? 1 : 0, st = q - 4 * half;
            const int rpb = NLAT / nblk;
            auto assign = [&](int hf) { MoeP mp{tope, gatev, lrank, blkcnt, tilepre, list, sdst, sgate, hf * NRH, NRH, hf * (nblk / 2), nblk / 2, rpb, 0}; moe_assign(lds, mp, bid, nblk); };
            auto fin = [&](int hf) { const int L = NRH / nblk, r0 = hf * NRH; final_rows((LAS float*)lds, in, modpart, rowsb, y2h1, 0, r0, r0 + bid * L, r0 + (bid + 1) * L); };
            if (ph == 10) assign(0);
            else if (ph == 11 || ph == 14) { GemmP g{u, u, Wgu, (long)2 * EF * D, list, D, 0}; GroupOrder S; S.init(tilepre, 2 * EF / BM, nblk, bid); gemm_phase<true>(lds, g, S, EpiGU{act}); }
            else if (ph == 12 || ph == 15) { GemmP g{act, act, Wdn, (long)D * EF, nullptr, EF, 0}; GroupOrder S; S.init(tilepre, D / BM, nblk, bid); gemm_phase(lds, g, S, EpiDown{sdst, sgate, rowsb}); }
            else if (ph == 13) { fin(0); __syncthreads(); assign(1); }
            else if (ph == 16) fin(1);
            (void)half; (void)st; }
    }
    if (14 >= ph_lo && 14 < ph_hi) { if (14 > ph_lo) xcd_barrier(xb); const int ph = 14; (void)ph; MK_PHASE_PTRS
        { const int q = ph - 10, half = q >= 4 ? 1 : 0, st = q - 4 * half;
            const int rpb = NLAT / nblk;
            auto assign = [&](int hf) { MoeP mp{tope, gatev, lrank, blkcnt, tilepre, list, sdst, sgate, hf * NRH, NRH, hf * (nblk / 2), nblk / 2, rpb, 0}; moe_assign(lds, mp, bid, nblk); };
            auto fin = [&](int hf) { const int L = NRH / nblk, r0 = hf * NRH; final_rows((LAS float*)lds, in, modpart, rowsb, y2h1, 0, r0, r0 + bid * L, r0 + (bid + 1) * L); };
            if (ph == 10) assign(0);
            else if (ph == 11 || ph == 14) { GemmP g{u, u, Wgu, (long)2 * EF * D, list, D, 0}; GroupOrder S; S.init(tilepre, 2 * EF / BM, nblk, bid); gemm_phase<true>(lds, g, S, EpiGU{act}); }
            else if (ph == 12 || ph == 15) { GemmP g{act, act, Wdn, (long)D * EF, nullptr, EF, 0}; GroupOrder S; S.init(tilepre, D / BM, nblk, bid); gemm_phase(lds, g, S, EpiDown{sdst, sgate, rowsb}); }
            else if (ph == 13) { fin(0); __syncthreads(); assign(1); }
            else if (ph == 16) fin(1);
            (void)half; (void)st; }
    }
    if (15 >= ph_lo && 15 < ph_hi) { if (15 > ph_lo) xcd_barrier(xb); const int ph = 15; (void)ph; MK_PHASE_PTRS
        { const int q = ph - 10, half = q >= 4 ? 1 : 0, st = q - 4 * half;
            const int rpb = NLAT / nblk;
            auto assign = [&](int hf) { MoeP mp{tope, gatev, lrank, blkcnt, tilepre, list, sdst, sgate, hf * NRH, NRH, hf * (nblk / 2), nblk / 2, rpb, 0}; moe_assign(lds, mp, bid, nblk); };
            auto fin = [&](int hf) { const int L = NRH / nblk, r0 = hf * NRH; final_rows((LAS float*)lds, in, modpart, rowsb, y2h1, 0, r0, r0 + bid * L, r0 + (bid + 1) * L); };
            if (ph == 10) assign(0);
            else if (ph == 11 || ph == 14) { GemmP g{u, u, Wgu, (long)2 * EF * D, list, D, 0}; GroupOrder S; S.init(tilepre, 2 * EF / BM, nblk, bid); gemm_phase<true>(lds, g, S, EpiGU{act}); }
            else if (ph == 12 || ph == 15) { GemmP g{act, act, Wdn, (long)D * EF, nullptr, EF, 0}; GroupOrder S; S.init(tilepre, D / BM, nblk, bid); gemm_phase(lds, g, S, EpiDown{sdst, sgate, rowsb}); }
            else if (ph == 13) { fin(0); __syncthreads(); assign(1); }
            else if (ph == 16) fin(1);
            (void)half; (void)st; }
    }
    if (16 >= ph_lo && 16 < ph_hi) { if (16 > ph_lo) xcd_barrier(xb); const int ph = 16; (void)ph; MK_PHASE_PTRS
        { const int q = ph - 10, half = q >= 4 ? 1 : 0, st = q - 4 * half;
            const int rpb = NLAT / nblk;
            auto assign = [&](int hf) { MoeP mp{tope, gatev, lrank, blkcnt, tilepre, list, sdst, sgate, hf * NRH, NRH, hf * (nblk / 2), nblk / 2, rpb, 0}; moe_assign(lds, mp, bid, nblk); };
            auto fin = [&](int hf) { const int L = NRH / nblk, r0 = hf * NRH; final_rows((LAS float*)lds, in, modpart, rowsb, y2h1, 0, r0, r0 + bid * L, r0 + (bid + 1) * L); };
            if (ph == 10) assign(0);
            else if (ph == 11 || ph == 14) { GemmP g{u, u, Wgu, (long)2 * EF * D, list, D, 0}; GroupOrder S; S.init(tilepre, 2 * EF / BM, nblk, bid); gemm_phase<true>(lds, g, S, EpiGU{act}); }
            else if (ph == 12 || ph == 15) { GemmP g{act, act, Wdn, (long)D * EF, nullptr, EF, 0}; GroupOrder S; S.init(tilepre, D / BM, nblk, bid); gemm_phase(lds, g, S, EpiDown{sdst, sgate, rowsb}); }
            else if (ph == 13) { fin(0); __syncthreads(); assign(1); }
            else if (ph == 16) fin(1);
            (void)half; (void)st; }
    }
}
extern "C" void kernel_launch(void* const* d_in, const int* in_sizes, int n_in, void* d_out, int out_size, void* d_ws, size_t ws_size, hipStream_t stream) {
    static int grid = 0;
    if (grid == 0) {
        int dev = 0, cus = 0; hipGetDevice(&dev); hipDeviceGetAttribute(&cus, hipDeviceAttributeMultiprocessorCount, dev);
        hipFuncSetAttribute((const void*)mega, hipFuncAttributeMaxDynamicSharedMemorySize, LDS_BYTES);
        grid = cus;
        if (ws_size < O_END || grid != 256) fprintf(stderr, "kernel_launch: unexpected ws_size %zu (need %zu) or CU count %d\n", ws_size, (size_t)O_END, grid);
    }
    hipMemsetAsync((char*)d_ws + O_BAR, 0, XCD_BAR_WORDS * 4, stream);
    MP P; memset(&P, 0, sizeof(P));
    const float** f = (const float**)&P.in; for (int i = 0; i < 32; ++i) f[i] = (const float*)d_in[i];
    P.out = (float*)d_out; P.ws = (unsigned char*)d_ws;
#ifdef MK_PER_PHASE
    for (int ph = 0; ph < NPHASE; ++ph) { P.ph_lo = ph; P.ph_hi = ph + 1; hipLaunchKernelGGL(mega, dim3(grid), dim3(NT), LDS_BYTES, stream, P); }
#else
    P.ph_lo = 0; P.ph_hi = NPHASE;
    void* args[] = {&P};
    hipError_t e = hipLaunchCooperativeKernel((void*)mega, dim3(grid), dim3(NT), args, LDS_BYTES, stream);
    if (e != hipSuccess) fprintf(stderr, "cooperative launch failed: %s (grid %d)\n", hipGetErrorString(e), grid);
#endif
}
```

```cpp
#include <hip/hip_runtime.h>
#include <cstdio>
#include <cstring>
#define HD __host__ __device__ __forceinline__
static hipStream_t g_stream;

#ifdef SMALL
constexpr int D = 128, NB = 2, SEQ = 64, GW = 8, CTX = 16, RW = 128, RH = 64, DL = 16, AL = 16, GL = 24, LW = 128, LB = 2, NE = 8, TOPK = 3, NG = 4, TG = 2, EF = 32, SF = 32;
#else
constexpr int D = 1024, NB = 8, SEQ = 4096, GW = 64, CTX = 256, RW = 1024, RH = 64, DL = 64, AL = 64, GL = 160, LW = 1024, LB = 16, NE = 64, TOPK = 6, NG = 8, TG = 4, EF = 256, SF = 256;
#endif
constexpr int NH = RW / RH, LBS = LW / LB, ROWS = SEQ / GW, TA = CTX + SEQ;
constexpr int OFF_R = 0, OFF_K = RW, OFF_V = 2 * RW, OFF_WD = 3 * RW, OFF_AD = OFF_WD + 2 * DL, OFF_GD = OFF_AD + 2 * AL, RC = OFF_GD + GL;
constexpr int OFF_LX = RC, OFF_LG = OFF_LX + LW, OFF_GATE = OFF_LG + LW, INC = OFF_GATE + 2 * D;
constexpr int EPG = NE / NG, NASG = SEQ * TOPK;
#define NORM_EPS 1e-6f
#define LNX_EPS 64e-5f

HD float sigmoidf_(float x) { return 1.f / (1.f + expf(-x)); }
HD float softplusf_(float x) { return x > 20.f ? x : log1pf(expf(x)); }
HD float siluf_(float x) { return x * sigmoidf_(x); }
HD float gelu_tanhf_(float x) { return 0.5f * x * (1.f + tanhf(0.7978845608028654f * (x + 0.044715f * x * x * x))); }

struct In {
    const float *x, *c, *ctx, *c_ctx, *w_mod, *b_mod, *norm_g, *w_in, *shift_mu, *rw_w0, *rw_w_up, *rw_a0, *rw_a_up, *rw_g_up, *rw_k_k, *rw_k_a, *rw_r_k, *rw_lnx,
        *lru_conv_w, *lru_conv_b, *lru_gate_w, *lru_gate_b, *lru_l, *w_branch_a, *w_branch_b, *w_out, *router_w, *router_b, *ex_w_gu, *ex_w_down, *sh_w_gu, *sh_w_down;
};


namespace mk {
#define LAS __attribute__((address_space(3)))
typedef unsigned short bf16_t;
typedef short bf16x8 __attribute__((ext_vector_type(8)));
typedef float f32x4 __attribute__((ext_vector_type(4)));
typedef float f32x2 __attribute__((ext_vector_type(2)));
typedef unsigned u32x4 __attribute__((ext_vector_type(4)));
typedef unsigned u32x2 __attribute__((ext_vector_type(2)));
constexpr int NT = 512;
constexpr int BM = 256, BK = 64, HALF = 128, HTB = HALF * BK * 2, STAGE_BYTES = 8 * HTB;
constexpr int LDS_BYTES = 160 * 1024 - 1024;

constexpr int Z1_LX = 3584, Z1_N = 4608;
constexpr int ZC_N = 3072;

__device__ __forceinline__ unsigned cvt_pk_bf16(float lo, float hi) { unsigned r; asm volatile("v_cvt_pk_bf16_f32 %0, %1, %2" : "=v"(r) : "v"(lo), "v"(hi)); return r; }
__device__ __forceinline__ bf16_t f2bf(float f) { unsigned u = __float_as_uint(f); u += 0x7FFFu + ((u >> 16) & 1u); return (bf16_t)(u >> 16); }
__device__ __forceinline__ float bf2f(bf16_t b) { return __uint_as_float(((unsigned)b) << 16); }
__device__ __forceinline__ float bflo(unsigned w) { return __uint_as_float(w << 16); }
__device__ __forceinline__ float bfhi(unsigned w) { return __uint_as_float(w & 0xffff0000u); }

__device__ __forceinline__ float fast_rcp(float x) { return __builtin_amdgcn_rcpf(x); }
__device__ __forceinline__ float fast_sigmoid(float x) { return fast_rcp(1.f + __expf(-x)); }
__device__ __forceinline__ float fast_tanh(float x) { return 1.f - 2.f * fast_rcp(1.f + __expf(2.f * x)); }
__device__ __forceinline__ float fast_softplus(float x) { return x > 15.f ? x : __logf(1.f + __expf(x)); }
__device__ __forceinline__ float fast_silu(float x) { return x * fast_sigmoid(x); }
__device__ __forceinline__ float fast_gelu_tanh(float x) { return x * fast_sigmoid(1.5957691216057308f * (x + 0.044715f * x * x * x)); }
__device__ __forceinline__ int lds_byte(int r, int c) { const int st = (r >> 4) * 2 + (c >> 5), rr = r & 15, cc = c & 31, ob = rr * 64 + cc * 2; return st * 1024 + (ob ^ (((ob >> 9) & 1) << 5)); }
__device__ __forceinline__ void stage_rc(int b, int& R, int& C) { const int st = b / 1024, sb = b % 1024, swz = sb ^ (((sb >> 9) & 1) << 5); R = (st >> 1) * 16 + swz / 64; C = (st & 1) * 32 + (swz % 64) / 2; }
__device__ __forceinline__ int perm32(int rho) { const int n = rho >> 4, i = rho & 15; return 8 * (i >> 2) + 4 * n + (i & 3); }

struct Unit { int pm, pn, e; };
struct GemmP { const bf16_t* A0; const bf16_t* A1; const bf16_t* Bt; long strideB; const int* gather; int K; int pad_; };

struct StaticOrder {
    int nM, nN, nwg, G, c;
    __device__ void init(int M, int N, int G_, int c_) { nM = M / BM; nN = N / BM; nwg = nM * nN; G = G_; c = c_; }
    __device__ bool next(int i, Unit& u) const {
        const long L = (long)i * G + c; if (L >= nwg) return false;
        int wgid = (int)L; { const int q = nwg / 8, r = nwg % 8, xcd = wgid % 8, off = wgid / 8; wgid = (xcd < r ? xcd * (q + 1) : r * (q + 1) + (xcd - r) * q) + off; }
        const int nig = 8 * nN, gid = wgid / nig, fm = gid * 8, gsz = (nM - fm) < 8 ? (nM - fm) : 8;
        u.pm = fm + ((wgid % nig) % gsz); u.pn = (wgid % nig) / gsz; u.e = 0; return true;
    }
};

#define MK_FRAG_LOOP(ROW, COL) \
    _Pragma("unroll") for (int ai = 0; ai < 2; ++ai) _Pragma("unroll") for (int m = 0; m < 4; ++m) _Pragma("unroll") for (int bj = 0; bj < 2; ++bj) \
        if (const int ROW = ai * HALF + wr * 64 + m * 16 + fr; true) if (const int COL = bj * HALF + wc * 32 + 8 * fq; true)

template <bool GATHER = false, class Epi, class Sched>
__device__ __forceinline__ void gemm_phase(LAS unsigned char* lds, const GemmP g, const Sched& S, const Epi& E) {
    const int tid = threadIdx.x, wid = __builtin_amdgcn_readfirstlane(tid >> 6), lane = tid & 63, wr = wid >> 2, wc = wid & 3, fr = lane & 15, fq = lane >> 4;
    int K = g.K; asm volatile("" : "+s"(K));
    const int nt = K / BK;
    int RA[2], CA[2]; unsigned voffB[2];
#pragma unroll
    for (int i = 0; i < 2; ++i) { int R, C; stage_rc(tid * 16 + i * 8192, R, C); RA[i] = R; CA[i] = C; const int Rb = (R & ~31) + perm32(R & 31); voffB[i] = (unsigned)(Rb * K + C) * 2u; }
    const size_t kstep = (size_t)(BK * 2), hstepB = (size_t)HALF * K * 2, tstepB = 2 * hstepB;
    const unsigned ldsw = (unsigned)wid * 1024u;
    const int aoff = lds_byte(wr * 64 + fr, fq * 8), boff = lds_byte(wc * 32 + fr, fq * 8);
#define MK_SA(b, h) (((b) * 2 + (h)) * HTB)
#define MK_SB(b, h) ((4 + (b) * 2 + (h)) * HTB)
#define MK_STAGE(bufoff, gbase, voff) do { _Pragma("unroll") for (int _i = 0; _i < 2; ++_i) \
        __builtin_amdgcn_global_load_lds((const unsigned*)((const char*)(gbase) + (voff)[_i]), (LAS unsigned*)(lds + (bufoff) + ldsw + _i * 8192), 16, 0, 0); } while (0)
#define MK_LDA(dst, b, h) do { _Pragma("unroll") for (int m = 0; m < 4; ++m) _Pragma("unroll") for (int k = 0; k < 2; ++k) dst[m][k] = *(const LAS bf16x8*)(lds + MK_SA(b, h) + aoff + m * 2048 + k * 1024); } while (0)
#define MK_LDB(dst, b, h) do { _Pragma("unroll") for (int n = 0; n < 2; ++n) _Pragma("unroll") for (int k = 0; k < 2; ++k) dst[n][k] = *(const LAS bf16x8*)(lds + MK_SB(b, h) + boff + n * 2048 + k * 1024); } while (0)
#define MK_MMA(ai, bj, At, Bt) do { __builtin_amdgcn_s_setprio(1); _Pragma("unroll") for (int m = 0; m < 4; ++m) _Pragma("unroll") for (int n = 0; n < 2; ++n) _Pragma("unroll") for (int k = 0; k < 2; ++k) \
        acc[ai][bj][m][n] = __builtin_amdgcn_mfma_f32_16x16x32_bf16(Bt[n][k], At[m][k], acc[ai][bj][m][n], 0, 0, 0); __builtin_amdgcn_s_setprio(0); } while (0)
#define MK_WAIT_V(n) asm volatile("s_waitcnt vmcnt(" #n ")" ::: "memory")
#define MK_WAIT_L(n) asm volatile("s_waitcnt lgkmcnt(" #n ")" ::: "memory")
#define MK_BAR __builtin_amdgcn_s_barrier()
#define MK_SCHED __builtin_amdgcn_sched_barrier(0)
    Unit cur, nxt; int ui = 0;
    if (!S.next(0, cur)) return;
    f32x4 acc[2][2][4][2];
#pragma unroll
    for (int a = 0; a < 2; ++a)
#pragma unroll
        for (int b = 0; b < 2; ++b)
#pragma unroll
            for (int m = 0; m < 4; ++m)
#pragma unroll
                for (int n = 0; n < 2; ++n) acc[a][b][m][n] = (f32x4){0.f, 0.f, 0.f, 0.f};
    bf16x8 At[4][2], B0[2][2], B1[2][2];
    unsigned vA[2][2], vAn[2][2];
    const size_t hstepA = GATHER ? 0 : (size_t)HALF * K * 2, tstepA = 2 * (size_t)HALF * K * 2;
    auto a_voff = [&](const Unit& u, unsigned (&vo)[2][2]) {
#pragma unroll
        for (int h = 0; h < 2; ++h)
#pragma unroll
            for (int i = 0; i < 2; ++i) { if (GATHER) { const int row = u.pm * BM + h * HALF + RA[i]; vo[h][i] = (unsigned)((size_t)g.gather[row] * K + CA[i]) * 2u; } else vo[h][i] = (unsigned)(RA[i] * K + CA[i]) * 2u; }
    };
    a_voff(cur, vA);
    auto a_base = [&](const Unit& u) { return (const char*)(u.e ? g.A1 : g.A0) + (GATHER ? (size_t)0 : (size_t)u.pm * tstepA); };
    const char* cA = a_base(cur);
    const char* cB = (const char*)g.Bt + ((size_t)cur.e * g.strideB) * 2 + (size_t)cur.pn * tstepB;
    MK_STAGE(MK_SB(0, 0), cB, voffB); MK_STAGE(MK_SA(0, 0), cA, vA[0]); MK_STAGE(MK_SB(0, 1), cB + hstepB, voffB); MK_STAGE(MK_SA(0, 1), cA + hstepA, vA[1]);
    if (wr == 1) MK_BAR;
    MK_WAIT_V(4); MK_BAR;
    MK_STAGE(MK_SB(1, 0), cB + kstep, voffB); MK_STAGE(MK_SA(1, 0), cA + kstep, vA[0]); MK_STAGE(MK_SB(1, 1), cB + hstepB + kstep, voffB);
    MK_WAIT_V(6); MK_BAR;
    for (;;) {
        const bool has_next = S.next(ui + 1, nxt);
        const char* nA = has_next ? a_base(nxt) : cA;
        const char* nB = has_next ? (const char*)g.Bt + ((size_t)nxt.e * g.strideB) * 2 + (size_t)nxt.pn * tstepB : cB;
        for (int t = 0; t < nt; t += 2) {
            const bool last = (t == nt - 2);
            if (GATHER && last) { if (has_next) a_voff(nxt, vAn); else {
#pragma unroll
                for (int h = 0; h < 2; ++h)
#pragma unroll
                    for (int i = 0; i < 2; ++i) vAn[h][i] = vA[h][i]; } }
            const char* a1 = cA + (size_t)(t + 1) * kstep;
            const char* a2 = last ? nA : cA + (size_t)(t + 2) * kstep; const char* b2 = last ? nB : cB + (size_t)(t + 2) * kstep;
            const char* a3 = a2 + kstep; const char* b3 = b2 + kstep;
            unsigned v2[2][2];
#pragma unroll
            for (int h = 0; h < 2; ++h)
#pragma unroll
                for (int i = 0; i < 2; ++i) v2[h][i] = (GATHER && last) ? vAn[h][i] : vA[h][i];
            MK_LDB(B0, 0, 0); MK_SCHED; MK_LDA(At, 0, 0); MK_STAGE(MK_SA(1, 1), a1 + hstepA, vA[1]);
            MK_WAIT_L(8); MK_BAR; MK_WAIT_L(0); MK_MMA(0, 0, At, B0); MK_BAR; MK_SCHED;
            MK_LDB(B1, 0, 1); MK_STAGE(MK_SB(0, 0), b2, voffB);
            MK_BAR; MK_WAIT_L(0); MK_MMA(0, 1, At, B1); MK_BAR;
            MK_LDA(At, 0, 1); MK_STAGE(MK_SA(0, 0), a2, v2[0]);
            MK_BAR; MK_WAIT_L(0); MK_MMA(1, 0, At, B0); MK_BAR; MK_SCHED;
            MK_STAGE(MK_SB(0, 1), b2 + hstepB, voffB);
            MK_WAIT_V(6); MK_BAR; MK_MMA(1, 1, At, B1); MK_BAR;
            MK_LDB(B0, 1, 0); MK_SCHED; MK_LDA(At, 1, 0); MK_STAGE(MK_SA(0, 1), a2 + hstepA, v2[1]);
            MK_WAIT_L(8); MK_BAR; MK_WAIT_L(0); MK_MMA(0, 0, At, B0); MK_BAR; MK_SCHED;
            MK_LDB(B1, 1, 1); MK_STAGE(MK_SB(1, 0), b3, voffB);
            MK_BAR; MK_WAIT_L(0); MK_MMA(0, 1, At, B1); MK_BAR;
            MK_LDA(At, 1, 1); MK_STAGE(MK_SA(1, 0), a3, v2[0]);
            MK_BAR; MK_WAIT_L(0); MK_MMA(1, 0, At, B0); MK_BAR; MK_SCHED;
            MK_STAGE(MK_SB(1, 1), b3 + hstepB, voffB);
            MK_WAIT_V(6); MK_BAR; MK_MMA(1, 1, At, B1); MK_BAR;
        }
        int fr_ = fr, fq_ = fq; asm volatile("" : "+v"(fr_), "+v"(fq_));
        if (wr == 0) MK_BAR;
        const bool keep = E(acc, cur, wr, wc, fr_, fq_);
        if (wr == 1) MK_BAR;
        if (!has_next) break;
        if (!keep) {
#pragma unroll
            for (int a = 0; a < 2; ++a)
#pragma unroll
                for (int b = 0; b < 2; ++b)
#pragma unroll
                    for (int m = 0; m < 4; ++m)
#pragma unroll
                        for (int n = 0; n < 2; ++n) acc[a][b][m][n] = (f32x4){0.f, 0.f, 0.f, 0.f};
        }
        cur = nxt; cA = nA; cB = nB; ++ui;
        if (GATHER) {
#pragma unroll
            for (int h = 0; h < 2; ++h)
#pragma unroll
                for (int i = 0; i < 2; ++i) vA[h][i] = vAn[h][i]; }
    }
    MK_WAIT_V(0);
    if (wr == 0) MK_BAR;
    MK_BAR;
#undef MK_SA
#undef MK_SB
#undef MK_STAGE
#undef MK_LDA
#undef MK_LDB
#undef MK_MMA
#undef MK_WAIT_V
#undef MK_WAIT_L
#undef MK_BAR
#undef MK_SCHED
}

__device__ __forceinline__ u32x4 pack8(const f32x4 a, const f32x4 b) { u32x4 w; w.x = cvt_pk_bf16(a[0], a[1]); w.y = cvt_pk_bf16(a[2], a[3]); w.z = cvt_pk_bf16(b[0], b[1]); w.w = cvt_pk_bf16(b[2], b[3]); return w; }
struct EpiStoreBf16 {
    bf16_t* O; long ldc;
    __device__ __forceinline__ bool operator()(const f32x4 (&acc)[2][2][4][2], const Unit& u, int wr, int wc, int fr, int fq) const {
        MK_FRAG_LOOP(r, c) { *(u32x4*)(O + (size_t)(u.pm * BM + r) * ldc + u.pn * BM + c) = pack8(acc[ai][bj][m][0], acc[ai][bj][m][1]); }
        return false;
    }
};

__device__ __forceinline__ void ld8_contig(const float* p, float (&o)[8]) { const f32x4 a = *(const f32x4*)p, b = *(const f32x4*)(p + 4); o[0] = a[0]; o[1] = a[1]; o[2] = a[2]; o[3] = a[3]; o[4] = b[0]; o[5] = b[1]; o[6] = b[2]; o[7] = b[3]; }
struct CMapZ1 { __device__ int operator()(int n) const { return n < RC ? n : (n < Z1_LX ? -1 : OFF_LX + (n - Z1_LX)); }
    __device__ __forceinline__ void load8(const float* rowp, int n, float (&o)[8]) const { const int sc = (*this)(n); if (sc >= 0) ld8_contig(rowp + sc, o); else {
#pragma unroll
        for (int j = 0; j < 8; ++j) o[j] = 0.f; } } };
struct CMapZC { __device__ int operator()(int n) const { return OFF_LG + n; }
    __device__ __forceinline__ void load8(const float* rowp, int n, float (&o)[8]) const { ld8_contig(rowp + OFF_LG + n, o); } };
struct CMapId { __device__ int operator()(int n) const { return n; }
    __device__ __forceinline__ void load8(const float* rowp, int n, float (&o)[8]) const { ld8_contig(rowp + n, o); } };
struct CMapGU { int F; __device__ int operator()(int n) const { return (n & 1) * F + (n >> 1); }
    __device__ __forceinline__ void load8(const float* rowp, int n, float (&o)[8]) const { const f32x4 g = *(const f32x4*)(rowp + (n >> 1)), u = *(const f32x4*)(rowp + F + (n >> 1));
        o[0] = g[0]; o[1] = u[0]; o[2] = g[1]; o[3] = u[1]; o[4] = g[2]; o[5] = u[2]; o[6] = g[3]; o[7] = u[3]; } };
constexpr int CT_B = 4;
template <class CM>
__device__ __forceinline__ void convT_job(LAS float* tile  , const float* src, int lds_, int Ks, bf16_t* dst, int Kd, int N, const CM& cm, int bid, int nblk, int& base) {
    const int tk = Kd / 64, nt = (N / 64) * tk, tid = threadIdx.x;
    const int first = (bid - base % nblk + nblk) % nblk;
    const int kk = tid >> 3, nn8 = (tid & 7) * 8, nn = tid >> 3, kk8 = (tid & 7) * 8;
    for (int t0 = first; t0 < nt; t0 += CT_B * nblk) {
        float v[CT_B][8];
#pragma unroll
        for (int b = 0; b < CT_B; ++b) { const int t = t0 + b * nblk; const int n0 = (t / tk) * 64, k0 = (t % tk) * 64, k = k0 + kk;
            if (t < nt && k < Ks) cm.load8(src + (size_t)k * lds_, n0 + nn8, v[b]); else {
#pragma unroll
                for (int j = 0; j < 8; ++j) v[b][j] = 0.f; } }
#pragma unroll
        for (int b = 0; b < CT_B; ++b)
#pragma unroll
            for (int j = 0; j < 8; ++j) tile[b * 64 * 65 + kk * 65 + nn8 + j] = v[b][j];
        __syncthreads();
#pragma unroll
        for (int b = 0; b < CT_B; ++b) { const int t = t0 + b * nblk; if (t < nt) { const int n0 = (t / tk) * 64, k0 = (t % tk) * 64; f32x4 a, c;
#pragma unroll
            for (int j = 0; j < 4; ++j) { a[j] = tile[b * 64 * 65 + (kk8 + j) * 65 + nn]; c[j] = tile[b * 64 * 65 + (kk8 + 4 + j) * 65 + nn]; }
            *(u32x4*)(dst + (size_t)(n0 + nn) * Kd + k0 + kk8) = pack8(a, c); } }
        __syncthreads();
    }
    base += nt;
}

template <class CM, class MS>
__device__ __forceinline__ void convT_multi(LAS float* tile, const MS& ms, int nmat, int lds_, int Ks, int Kd, int N, const CM& cm, int bid, int nblk) {
    const int tk = Kd / 64, tpm = (N / 64) * tk, nt = nmat * tpm, tid = threadIdx.x;
    const int kk = tid >> 3, nn8 = (tid & 7) * 8, nn = tid >> 3, kk8 = (tid & 7) * 8;
    for (int t0 = bid; t0 < nt; t0 += CT_B * nblk) {
        float v[CT_B][8];
#pragma unroll
        for (int b = 0; b < CT_B; ++b) { const int T = t0 + b * nblk, m = T / tpm, t = T % tpm; const int n0 = (t / tk) * 64, k0 = (t % tk) * 64, k = k0 + kk;
            if (T < nt && k < Ks) cm.load8(ms.src(m) + (size_t)k * lds_, n0 + nn8, v[b]); else {
#pragma unroll
                for (int j = 0; j < 8; ++j) v[b][j] = 0.f; } }
#pragma unroll
        for (int b = 0; b < CT_B; ++b)
#pragma unroll
            for (int j = 0; j < 8; ++j) tile[b * 64 * 65 + kk * 65 + nn8 + j] = v[b][j];
        __syncthreads();
#pragma unroll
        for (int b = 0; b < CT_B; ++b) { const int T = t0 + b * nblk; if (T < nt) { const int m = T / tpm, t = T % tpm, n0 = (t / tk) * 64, k0 = (t % tk) * 64; f32x4 a, c;
#pragma unroll
            for (int j = 0; j < 4; ++j) { a[j] = tile[b * 64 * 65 + (kk8 + j) * 65 + nn]; c[j] = tile[b * 64 * 65 + (kk8 + 4 + j) * 65 + nn]; }
            *(u32x4*)(ms.dst(m) + (size_t)(n0 + nn) * Kd + k0 + kk8) = pack8(a, c); } }
        __syncthreads();
    }
}

constexpr int MOD_SL = 16, MOD_KS = D / MOD_SL;
__device__ __forceinline__ void mod_partials(LAS float* sl  , const In& in, float* part  , int bid, int nblk) {
    const int ncc = 6 * D / NT, nitem = MOD_SL * ncc;
    for (int it = bid; it < nitem; it += nblk) {
        const int s = it / ncc, j = (it % ncc) * NT + threadIdx.x;
        for (int i = threadIdx.x; i < (NB + 1) * MOD_KS; i += NT) { const int r = i / MOD_KS, k = s * MOD_KS + i % MOD_KS; const float cv = r < NB ? in.c[r * D + k] : in.c_ctx[k]; sl[i] = siluf_(cv); }
        __syncthreads();
        float acc[NB + 1];
#pragma unroll
        for (int r = 0; r <= NB; ++r) acc[r] = 0.f;
        for (int k = 0; k < MOD_KS; ++k) { const float w = in.w_mod[(size_t)(s * MOD_KS + k) * 6 * D + j];
#pragma unroll
            for (int r = 0; r <= NB; ++r) acc[r] += sl[r * MOD_KS + k] * w; }
#pragma unroll
        for (int r = 0; r <= NB; ++r) part[((size_t)s * (NB + 1) + r) * 6 * D + j] = acc[r];
        __syncthreads();
    }
}
__device__ __forceinline__ float mod_value(const In& in, const float* part, int r, int j) {
    float s = in.b_mod[j];
#pragma unroll
    for (int q = 0; q < MOD_SL; ++q) s += part[((size_t)q * (NB + 1) + r) * 6 * D + j];
    return s;
}

__device__ __forceinline__ void xn_rows(LAS float* sm  , const In& in, const float* part, bf16_t* xn, int b0, int nb, int row_lo, int row_hi) {
    const int nlat = nb * SEQ, wid = threadIdx.x >> 6, lane = threadIdx.x & 63;
    int cur_mr = -1;
    float gp[16];
#pragma unroll
    for (int j = 0; j < 4; ++j)
#pragma unroll
        for (int q = 0; q < 4; ++q) gp[4 * j + q] = in.norm_g[j * 256 + lane * 4 + q];
    for (int rbase = row_lo; rbase < row_hi; rbase += 8) {
        const int mr = rbase < nlat ? b0 + rbase / SEQ : NB;
        if (mr != cur_mr) { __syncthreads(); for (int j = threadIdx.x; j < 2 * D; j += NT) sm[j] = mod_value(in, part, mr, j); __syncthreads(); cur_mr = mr; }
        const int r = rbase + wid; if (r >= row_hi) continue;
        const float* src = r < nlat ? in.x + ((size_t)b0 * SEQ + r) * D : in.ctx + ((size_t)b0 * CTX + (r - nlat)) * D;
        f32x4 v[4]; float ss = 0.f;
#pragma unroll
        for (int j = 0; j < 4; ++j) { v[j] = *(const f32x4*)(src + j * 256 + lane * 4); ss += v[j][0] * v[j][0] + v[j][1] * v[j][1] + v[j][2] * v[j][2] + v[j][3] * v[j][3]; }
#pragma unroll
        for (int o = 32; o > 0; o >>= 1) ss += __shfl_xor(ss, o);
        const float rinv = 1.f / sqrtf(ss * (1.f / D) + NORM_EPS);
#pragma unroll
        for (int j = 0; j < 4; ++j) { const int c = j * 256 + lane * 4; float o[4];
#pragma unroll
            for (int q = 0; q < 4; ++q) o[q] = (v[j][q] * rinv * gp[4 * j + q]) * (1.f + sm[D + c + q]) + sm[c + q];
            u32x2 w; w.x = cvt_pk_bf16(o[0], o[1]); w.y = cvt_pk_bf16(o[2], o[3]); *(u32x2*)(xn + (size_t)r * D + c) = w; }
    }
}
}

namespace mk {
#define XB_TMO      128
#define XB_XCNT(j)  (256  + 64 * (j))
#define XB_XSUB(j)  (1280 + 64 * (j))
#define XB_XGEN(j)  (2304 + 64 * (j))
#define XB_TOP      3328
#define XB_TOPGEN   3392
#define XCD_BAR_WORDS 3456
#define XB_SPIN_CAP (1u << 18)
__device__ __forceinline__ unsigned xb_ld(unsigned* p)              { return __hip_atomic_load(p, __ATOMIC_RELAXED, __HIP_MEMORY_SCOPE_AGENT); }
__device__ __forceinline__ unsigned xb_add(unsigned* p, unsigned v) { return __hip_atomic_fetch_add(p, v, __ATOMIC_RELAXED, __HIP_MEMORY_SCOPE_AGENT); }
__device__ __forceinline__ unsigned xb_xcc_id() { return (unsigned)__builtin_amdgcn_s_getreg((3 << 11) | 20) & 0xFu; }
#define XB_SPIN(cond, bar) do { unsigned _sp = 0; while (cond) { __builtin_amdgcn_s_sleep(1); \
    if ((++_sp & 255u) == 0u) { if (xb_ld(&(bar)[XB_TMO])) break; if (_sp > XB_SPIN_CAP) { atomicAdd(&(bar)[XB_TMO], 1u); break; } } } } while (0)
struct XcdBarrier { unsigned* bar; unsigned x; volatile LAS unsigned* st; };
__device__ __forceinline__ XcdBarrier xcd_barrier_post(unsigned* bar, volatile LAS unsigned* st) {
    XcdBarrier b; b.bar = bar; b.x = xb_xcc_id(); b.st = st;
    if (threadIdx.x == 0) (void)xb_add(&bar[XB_XCNT(b.x)], 1u);
    return b;
}
__device__ __forceinline__ void xcd_barrier_complete(unsigned* bar, unsigned x, unsigned& nloc, unsigned& nx) {
    const unsigned G = gridDim.x * gridDim.y * gridDim.z;
    unsigned sum, cnt, mine, sp = 0u;
    for (;;) {
        sum = 0u; cnt = 0u; mine = 0u;
#pragma unroll
        for (unsigned j = 0; j < 16; ++j) { const unsigned c = xb_ld(&bar[XB_XCNT(j)]); sum += c; cnt += (c > 0u) ? 1u : 0u; mine = (j == x) ? c : mine; }
        if (sum == G) break;
        __builtin_amdgcn_s_sleep(1);
        if ((++sp & 255u) == 0u) { if (xb_ld(&bar[XB_TMO])) break; if (sp > XB_SPIN_CAP) { atomicAdd(&bar[XB_TMO], 1u); break; } }
    }
    nloc = mine > 0u ? mine : 1u; nx = cnt > 0u ? cnt : 1u;
}
__device__ __forceinline__ void xcd_barrier(const XcdBarrier& b) {
    asm volatile("s_waitcnt vmcnt(0)" ::: "memory");
    __syncthreads();
    if (threadIdx.x == 0) {
        unsigned* bar = b.bar;
        __builtin_amdgcn_s_waitcnt(0);
        unsigned nloc = b.st[0], nx = b.st[1];
        if (nloc == 0u) { xcd_barrier_complete(bar, b.x, nloc, nx); b.st[0] = nloc; b.st[1] = nx; }
        const unsigned old = xb_add(&bar[XB_XSUB(b.x)], 1u);
        const unsigned gen = old / nloc;
        if (old + 1u == (gen + 1u) * nloc) {
            __builtin_amdgcn_fence(__ATOMIC_RELEASE, "agent");
            asm volatile("s_waitcnt vmcnt(0)" ::: "memory");
            const unsigned og = xb_add(&bar[XB_TOP], 1u);
            const unsigned tg = og / nx;
            if (og + 1u == (tg + 1u) * nx) xb_add(&bar[XB_TOPGEN], 1u);
            else XB_SPIN(xb_ld(&bar[XB_TOPGEN]) == tg, bar);
            __builtin_amdgcn_fence(__ATOMIC_ACQUIRE, "agent");
            xb_add(&bar[XB_XGEN(b.x)], 1u);
            asm volatile("s_waitcnt vmcnt(0)" ::: "memory");
        } else {
            XB_SPIN(xb_ld(&bar[XB_XGEN(b.x)]) == gen, bar);
            __builtin_amdgcn_fence(__ATOMIC_ACQUIRE, "agent");
            asm volatile("s_waitcnt vmcnt(0)" ::: "memory");
        }
    }
    __syncthreads();
}
}

namespace mk {
constexpr int TB = 32;
constexpr int RAWW = 320;
constexpr int RW_RAW = 0;
constexpr int RW_MU = RW_RAW + (TB + 2) * RAWW * 2;
constexpr int RW_WUP = RW_MU + 2 * RAWW * 4;
constexpr int RW_AUP = RW_WUP + 64 * 72 * 2;
constexpr int RW_CST = RW_AUP + 64 * 72 * 2;
constexpr int RW_AWD = RW_CST + 5 * 64 * 4;
constexpr int RW_AAD = RW_AWD + TB * 72 * 2;
constexpr int RW_R = RW_AAD + TB * 72 * 2;
constexpr int RW_KR = RW_R + TB * 64 * 4;
constexpr int RW_LA = RW_KR + TB * 64 * 4;
constexpr int RW_KK = RW_LA + TB * 64 * 4;
constexpr int RW_W = RW_KK + TB * 64 * 4;
constexpr int RW_B = RW_W + TB * 64 * 4;
constexpr int RW_KD = RW_B + TB * 64 * 4;
constexpr int RW_WR = RW_KD + TB * 64 * 4;
constexpr int RW_V = RW_WR + TB * 64 * 4;
constexpr int RW_SC = RW_V + TB * 64 * 4;
constexpr int RW_YO = RW_SC + TB * 2 * 4;
constexpr int RW_BON = RW_YO + TB * 64 * 4;
constexpr int RW_END = RW_BON + TB * 4;
static_assert(RW_END <= LDS_BYTES, "rwkv LDS");

#define MK_DPP(x, ctrl) __int_as_float(__builtin_amdgcn_update_dpp(__float_as_int(x), __float_as_int(x), ctrl, 0xF, 0xF, false))
__device__ __forceinline__ float allreduce16(float x) {
    x += MK_DPP(x, 0xB1); x += MK_DPP(x, 0x4E); x += MK_DPP(x, 0x141); x += MK_DPP(x, 0x140); return x;
}

__device__ __forceinline__ void allreduce16x4(float& a, float& b, float& c, float& d) {
    asm volatile("s_nop 1\n\t"
        "v_add_f32_dpp %0, %0, %0 quad_perm:[1,0,3,2] row_mask:0xf bank_mask:0xf\n\t" "v_add_f32_dpp %1, %1, %1 quad_perm:[1,0,3,2] row_mask:0xf bank_mask:0xf\n\t"
        "v_add_f32_dpp %2, %2, %2 quad_perm:[1,0,3,2] row_mask:0xf bank_mask:0xf\n\t" "v_add_f32_dpp %3, %3, %3 quad_perm:[1,0,3,2] row_mask:0xf bank_mask:0xf\n\t"
        "v_add_f32_dpp %0, %0, %0 quad_perm:[2,3,0,1] row_mask:0xf bank_mask:0xf\n\t" "v_add_f32_dpp %1, %1, %1 quad_perm:[2,3,0,1] row_mask:0xf bank_mask:0xf\n\t"
        "v_add_f32_dpp %2, %2, %2 quad_perm:[2,3,0,1] row_mask:0xf bank_mask:0xf\n\t" "v_add_f32_dpp %3, %3, %3 quad_perm:[2,3,0,1] row_mask:0xf bank_mask:0xf\n\t"
        "v_add_f32_dpp %0, %0, %0 row_half_mirror row_mask:0xf bank_mask:0xf\n\t" "v_add_f32_dpp %1, %1, %1 row_half_mirror row_mask:0xf bank_mask:0xf\n\t"
        "v_add_f32_dpp %2, %2, %2 row_half_mirror row_mask:0xf bank_mask:0xf\n\t" "v_add_f32_dpp %3, %3, %3 row_half_mirror row_mask:0xf bank_mask:0xf\n\t"
        "v_add_f32_dpp %0, %0, %0 row_mirror row_mask:0xf bank_mask:0xf\n\t" "v_add_f32_dpp %1, %1, %1 row_mirror row_mask:0xf bank_mask:0xf\n\t"
        "v_add_f32_dpp %2, %2, %2 row_mirror row_mask:0xf bank_mask:0xf\n\t" "v_add_f32_dpp %3, %3, %3 row_mirror row_mask:0xf bank_mask:0xf"
        : "+v"(a), "+v"(b), "+v"(c), "+v"(d));
}
struct RwkvP { const bf16_t* z1; bf16_t* Y; float* bon; int b0, nb; };

constexpr int RW_NPIECE = (TB + 2) * 40, RW_PPT = (RW_NPIECE + NT - 1) / NT;

__device__ __forceinline__ void rwkv_chain(LAS unsigned char* lds, const In& in, const RwkvP p, int chain) {
    const int tid = threadIdx.x, lane = tid & 63, wid = tid >> 6;
    const int d = chain / (p.nb * NH), bl = (chain / NH) % p.nb, h = chain % NH;
    const int nlat = p.nb * SEQ;
    LAS bf16_t* RAW = (LAS bf16_t*)(lds + RW_RAW); LAS float* MU = (LAS float*)(lds + RW_MU);
    LAS bf16_t* WUP = (LAS bf16_t*)(lds + RW_WUP); LAS bf16_t* AUP = (LAS bf16_t*)(lds + RW_AUP); LAS float* CST = (LAS float*)(lds + RW_CST);
    LAS bf16_t* AWD = (LAS bf16_t*)(lds + RW_AWD); LAS bf16_t* AAD = (LAS bf16_t*)(lds + RW_AAD);
    LAS float *Rr = (LAS float*)(lds + RW_R), *KR = (LAS float*)(lds + RW_KR), *LA_ = (LAS float*)(lds + RW_LA);
    LAS float *KK = (LAS float*)(lds + RW_KK), *Wv = (LAS float*)(lds + RW_W), *Bv = (LAS float*)(lds + RW_B), *KD = (LAS float*)(lds + RW_KD), *WR = (LAS float*)(lds + RW_WR), *Vv = (LAS float*)(lds + RW_V);
    LAS float *SC = (LAS float*)(lds + RW_SC), *YO = (LAS float*)(lds + RW_YO), *BON = (LAS float*)(lds + RW_BON);
    auto segcol = [&](int s) { return s < 3 ? s * RW + h * 64 : (s == 3 ? OFF_WD + d * DL : OFF_AD + d * AL); };
    for (int i = tid; i < 2 * RAWW; i += NT) { const int m = i / RAWW, c = i % RAWW; MU[i] = in.shift_mu[m * RC + segcol(c >> 6) + (c & 63)]; }
    for (int i = tid; i < 64 * 64; i += NT) { const int j = i >> 6, c = i & 63;
        WUP[c * 72 + j] = f2bf(in.rw_w_up[((size_t)d * DL + j) * RW + h * 64 + c]); AUP[c * 72 + j] = f2bf(in.rw_a_up[((size_t)d * AL + j) * RW + h * 64 + c]); }
    for (int i = tid; i < 64; i += NT) { CST[i] = in.rw_w0[d * RW + h * 64 + i]; CST[64 + i] = in.rw_a0[d * RW + h * 64 + i]; CST[128 + i] = in.rw_k_k[h * 64 + i]; CST[192 + i] = in.rw_k_a[h * 64 + i]; CST[256 + i] = in.rw_r_k[h * 64 + i]; }
    constexpr int NQ = (CTX + SEQ) / TB, NQC = CTX / TB;
    auto blk_info = [&](int q, bool& isctx, int& t0, bool& hp, bool& hn, size_t& grow0) {
        isctx = q < NQC;
        if (isctx) { const int qq = d == 0 ? q : NQC - 1 - q; t0 = qq * TB; hp = t0 > 0; hn = t0 + TB < CTX; grow0 = (size_t)nlat + (size_t)bl * CTX + t0; }
        else { const int ql = q - NQC, qq = d == 0 ? ql : SEQ / TB - 1 - ql; t0 = qq * TB; hp = (t0 % GW) != 0; hn = ((t0 + TB) % GW) != 0; grow0 = (size_t)bl * SEQ + t0; }
    };
    u32x4 pre[RW_PPT];
    auto prefetch = [&](int q) {
        bool isctx, hp, hn; int t0; size_t grow0; blk_info(q, isctx, t0, hp, hn, grow0);
#pragma unroll
        for (int k = 0; k < RW_PPT; ++k) { const int i = tid + k * NT; u32x4 v = (u32x4){0u, 0u, 0u, 0u};
            if (i < RW_NPIECE) { const int rr = i / 40, sp = i % 40, seg = sp >> 3, part = sp & 7;
                const bool ok = (rr == 0) ? hp : ((rr == TB + 1) ? hn : true);
                if (ok) v = *(const u32x4*)(p.z1 + (grow0 + rr - 1) * Z1_N + segcol(seg) + part * 8); }
            pre[k] = v; }
    };
    auto commit = [&]() {
#pragma unroll
        for (int k = 0; k < RW_PPT; ++k) { const int i = tid + k * NT; if (i < RW_NPIECE) { const int rr = i / 40, sp = i % 40; *(LAS u32x4*)(RAW + rr * RAWW + sp * 8) = pre[k]; } }
    };
    float S[2][4];
#pragma unroll
    for (int i = 0; i < 2; ++i)
#pragma unroll
        for (int j = 0; j < 4; ++j) S[i][j] = 0.f;
    const int kg = lane & 15, rp = (lane >> 4) + 4 * wid;
    prefetch(0);
    for (int q = 0; q < NQ; ++q) {
        bool isctx, hp, hn; int t0; size_t grow0; blk_info(q, isctx, t0, hp, hn, grow0);
        commit();
        __syncthreads();
        if (q + 1 < NQ) prefetch(q + 1);
        auto shift8 = [&](int t, int c0, float (&s)[8]) {
            const u32x4 xp = *(const LAS u32x4*)(RAW + t * RAWW + c0), xc = *(const LAS u32x4*)(RAW + (t + 1) * RAWW + c0), xn_ = *(const LAS u32x4*)(RAW + (t + 2) * RAWW + c0);
            const f32x4 m0a = *(const LAS f32x4*)(MU + c0), m0b = *(const LAS f32x4*)(MU + c0 + 4), m1a = *(const LAS f32x4*)(MU + RAWW + c0), m1b = *(const LAS f32x4*)(MU + RAWW + c0 + 4);
#pragma unroll
            for (int j = 0; j < 4; ++j) { const unsigned a = xp[j], b = xc[j], c = xn_[j];
                const float mu0l = j < 2 ? m0a[2 * j] : m0b[2 * j - 4], mu0h = j < 2 ? m0a[2 * j + 1] : m0b[2 * j - 3], mu1l = j < 2 ? m1a[2 * j] : m1b[2 * j - 4], mu1h = j < 2 ? m1a[2 * j + 1] : m1b[2 * j - 3];
                { const float x = bflo(b); s[2 * j] = x + mu0l * (bflo(a) - x) + mu1l * (bflo(c) - x); }
                { const float x = bfhi(b); s[2 * j + 1] = x + mu0h * (bfhi(a) - x) + mu1h * (bfhi(c) - x); } } };
        for (int it = tid; it < TB * 24; it += NT) {
            const int t = it / 24, g = it % 24, seg = g >> 3, cc = (g & 7) * 8; float s[8]; shift8(t, g * 8, s);
            LAS float* dst = (seg == 0 ? Rr : (seg == 1 ? KR : Vv)) + t * 64 + cc; *(LAS f32x4*)dst = (f32x4){s[0], s[1], s[2], s[3]}; *(LAS f32x4*)(dst + 4) = (f32x4){s[4], s[5], s[6], s[7]};
        }
        { const int t = tid >> 4, g = 24 + (tid & 15), cc = (g & 7) * 8; float s[8]; shift8(t, g * 8, s);
          const bool isw = (tid & 15) < 8;
#pragma unroll
          for (int j = 0; j < 8; ++j) { const float th = fast_tanh(s[j]); s[j] = isw ? th : s[j]; }
          LAS bf16_t* dst = (isw ? AWD : AAD) + t * 72 + cc;
          u32x4 w; w.x = cvt_pk_bf16(s[0], s[1]); w.y = cvt_pk_bf16(s[2], s[3]); w.z = cvt_pk_bf16(s[4], s[5]); w.w = cvt_pk_bf16(s[6], s[7]); *(LAS u32x4*)dst = w; }
        __syncthreads();
        {
            const int lora = wid >> 2, ct = wid & 3, fr = lane & 15, fq = lane >> 4;
            const LAS bf16_t* Am = lora ? AAD : AWD; const LAS bf16_t* Bm = lora ? AUP : WUP;
#pragma unroll
            for (int rt = 0; rt < 2; ++rt) {
                f32x4 acc = (f32x4){0.f, 0.f, 0.f, 0.f};
#pragma unroll
                for (int ks = 0; ks < 2; ++ks) {
                    const bf16x8 a = *(const LAS bf16x8*)(Am + (rt * 16 + fr) * 72 + ks * 32 + fq * 8);
                    const bf16x8 b = *(const LAS bf16x8*)(Bm + (ct * 16 + fr) * 72 + ks * 32 + fq * 8);
                    acc = __builtin_amdgcn_mfma_f32_16x16x32_bf16(a, b, acc, 0, 0, 0);
                }
                const int col = ct * 16 + fr;
#pragma unroll
                for (int i = 0; i < 4; ++i) { const int t = rt * 16 + fq * 4 + i;
                    if (lora == 0) { const float lw = acc[i] + CST[col]; const float wl = -fast_softplus(-lw) - 0.5f; Wv[t * 64 + col] = __expf(-__expf(wl)); }
                    else { LA_[t * 64 + col] = fast_sigmoid(acc[i] + CST[64 + col]); } }
            }
        }
        __syncthreads();
        {
            const int t = tid >> 4, c4 = (tid & 15) * 4;
            const f32x4 k = *(const LAS f32x4*)(KR + t * 64 + c4), a = *(const LAS f32x4*)(LA_ + t * 64 + c4), w = *(const LAS f32x4*)(Wv + t * 64 + c4), r = *(const LAS f32x4*)(Rr + t * 64 + c4);
            f32x4 kkr, kd, bb, wr; float ss = 0.f, br = 0.f, kr = 0.f, bn = 0.f;
#pragma unroll
            for (int j = 0; j < 4; ++j) { kkr[j] = k[j] * CST[128 + c4 + j]; ss += kkr[j] * kkr[j]; }
            ss = allreduce16(ss);
            const float inv = 1.f / fmaxf(sqrtf(ss), 1e-12f);
#pragma unroll
            for (int j = 0; j < 4; ++j) { const float kk = kkr[j] * inv; kkr[j] = kk; kd[j] = k[j] * (1.f + (a[j] - 1.f) * CST[192 + c4 + j]); bb[j] = kk * a[j]; wr[j] = w[j] * r[j];
                br += bb[j] * r[j]; kr += kd[j] * r[j]; bn += r[j] * kd[j] * CST[256 + c4 + j]; }
            br = allreduce16(br); kr = allreduce16(kr); bn = allreduce16(bn);
            *(LAS f32x4*)(KK + t * 64 + c4) = kkr; *(LAS f32x4*)(KD + t * 64 + c4) = kd; *(LAS f32x4*)(Bv + t * 64 + c4) = bb; *(LAS f32x4*)(WR + t * 64 + c4) = wr;
            if ((tid & 15) == 0) { SC[t * 2] = br; SC[t * 2 + 1] = kr; BON[t] = bn; }
        }
        __syncthreads();
        {
            auto tof = [&](int st) { return d == 0 ? st : TB - 1 - st; };
            const LAS float* lb = KK + 4 * kg;
            const LAS float* vb = Vv + 2 * rp;
            constexpr int OW = (RW_W - RW_KK) / 4, OB = (RW_B - RW_KK) / 4, OKD = (RW_KD - RW_KK) / 4, OWR = (RW_WR - RW_KK) / 4;
            int t = tof(0);
            f32x4 kk4 = *(const LAS f32x4*)(lb + t * 64), w4 = *(const LAS f32x4*)(lb + t * 64 + OW), b4 = *(const LAS f32x4*)(lb + t * 64 + OB),
                  kd4 = *(const LAS f32x4*)(lb + t * 64 + OKD), wr4 = *(const LAS f32x4*)(lb + t * 64 + OWR);
            f32x2 vv = *(const LAS f32x2*)(vb + t * 64), sc = *(const LAS f32x2*)(SC + t * 2);
            f32x2 S2[4];
#pragma unroll
            for (int j = 0; j < 4; ++j) { S2[j][0] = S[0][j]; S2[j][1] = S[1][j]; }
#pragma unroll 2
            for (int st = 0; st < TB; ++st) {
                const int tn = tof(st + 1 < TB ? st + 1 : st);
                const f32x4 nkk4 = *(const LAS f32x4*)(lb + tn * 64), nw4 = *(const LAS f32x4*)(lb + tn * 64 + OW), nb4 = *(const LAS f32x4*)(lb + tn * 64 + OB),
                            nkd4 = *(const LAS f32x4*)(lb + tn * 64 + OKD), nwr4 = *(const LAS f32x4*)(lb + tn * 64 + OWR);
                const f32x2 nvv = *(const LAS f32x2*)(vb + tn * 64), nsc = *(const LAS f32x2*)(SC + tn * 2);
                f32x2 sa2 = S2[0] * kk4[0], yo2 = S2[0] * wr4[0];
#pragma unroll
                for (int j = 1; j < 4; ++j) { sa2 += S2[j] * kk4[j]; yo2 += S2[j] * wr4[j]; }
                float sa0 = sa2[0], sa1 = sa2[1], yo0 = yo2[0], yo1 = yo2[1];
                allreduce16x4(sa0, sa1, yo0, yo1);
                f32x2 sar; sar[0] = sa0; sar[1] = sa1;
#pragma unroll
                for (int j = 0; j < 4; ++j) S2[j] = S2[j] * w4[j] + (vv * kd4[j] - sar * b4[j]);
                if (kg == 0) { f32x2 yor; yor[0] = yo0; yor[1] = yo1; const f32x2 y = yor - sar * sc[0] + vv * sc[1]; *(LAS f32x2*)(YO + t * 64 + 2 * rp) = y; }
                kk4 = nkk4; w4 = nw4; b4 = nb4; kd4 = nkd4; wr4 = nwr4; vv = nvv; sc = nsc; t = tn;
            }
#pragma unroll
            for (int j = 0; j < 4; ++j) { S[0][j] = S2[j][0]; S[1][j] = S2[j][1]; }
        }
        __syncthreads();
        if (!isctx) {
            const int t = tid >> 4, c4 = (tid & 15) * 4; const f32x4 y = *(const LAS f32x4*)(YO + t * 64 + c4);
            u32x2 w; w.x = cvt_pk_bf16(y[0], y[1]); w.y = cvt_pk_bf16(y[2], y[3]);
            *(u32x2*)(p.Y + ((size_t)d * nlat + grow0 + t) * RW + h * 64 + c4) = w;
            if (tid < TB) p.bon[((size_t)d * nlat + grow0 + tid) * NH + h] = BON[tid];
        }
    }
}
__device__ __forceinline__ void rwkv_phase(LAS unsigned char* lds, const In& in, const RwkvP p, int bid, int nblk) {
    const int nchain = 2 * p.nb * NH;
    for (int c = bid; c < nchain; c += nblk) { rwkv_chain(lds, in, p, c); __syncthreads(); }
}
}

namespace mk {
constexpr int C2_RAW = 0;
constexpr int C2_MU = C2_RAW + (TB + 2) * RAWW * 2;
constexpr int C2_WUP = C2_MU + 2 * RAWW * 4;
constexpr int C2_AUP = C2_WUP + 64 * 72 * 2;
constexpr int C2_CST = C2_AUP + 64 * 72 * 2;
constexpr int C2_AWD = C2_CST + 5 * 64 * 4;
constexpr int C2_AAD = C2_AWD + TB * 72 * 2;
constexpr int C2_X = C2_AAD + TB * 72 * 2;
constexpr int C2_R = C2_X, C2_KR = C2_R + TB * 64 * 4, C2_V = C2_KR + TB * 64 * 4, C2_E = C2_V + TB * 64 * 4, C2_LA = C2_E + TB * 64 * 4, C2_CUM = C2_LA + TB * 64 * 4, C2_X_END = C2_CUM + TB * 64 * 4;
constexpr int C2_YO = C2_X;
constexpr int C2_G = C2_YO + TB * 64 * 4;
constexpr int C2_UB = C2_G + 64 * 36 * 4;
constexpr int C2_ABT = C2_UB + 64 * 40 * 2;
constexpr int C2_AKT = C2_ABT + 32 * 32 * 4;
constexpr int C2_NBT = C2_AKT + 32 * 40 * 2;
constexpr int C2_NKT = C2_NBT + 32 * 40 * 2;
static_assert(C2_NKT + 32 * 40 * 2 <= C2_X_END, "region X reuse");
constexpr int C2_KKS = C2_X_END;
constexpr int C2_BS = C2_KKS + TB * 72 * 2, C2_KDS = C2_BS + TB * 72 * 2, C2_RS = C2_KDS + TB * 72 * 2;
constexpr int C2_BST = C2_RS + TB * 72 * 2;
constexpr int C2_KDST = C2_BST + 64 * 40 * 2;
constexpr int C2_VT = C2_KDST + 64 * 40 * 2;
constexpr int C2_S0B = C2_VT + 64 * 40 * 2;
constexpr int C2_GC = C2_S0B + 64 * 72 * 2;
constexpr int C2_BON = C2_GC + 64 * 4;
constexpr int C2_END = C2_BON + TB * 4;
static_assert(C2_END <= LDS_BYTES - 16 && (C2_X % 16) == 0 && (C2_KKS % 16) == 0 && (C2_G % 16) == 0 && (C2_UB % 16) == 0 && (C2_ABT % 16) == 0 && (C2_AKT % 16) == 0 && (C2_S0B % 16) == 0, "rwkv2 LDS");

__device__ __forceinline__ bf16x8 ldsb8(const LAS bf16_t* p) { return *(const LAS bf16x8*)p; }

template <int MODE>
__device__ __forceinline__ void rwkv_chain2(LAS unsigned char* lds, const In& in, const RwkvP p, int chain) {
    const int tid = threadIdx.x, lane = tid & 63, wid = tid >> 6, fr = lane & 15, fq = lane >> 4;
    const int d = chain / (p.nb * NH), bl = (chain / NH) % p.nb, h = chain % NH;
    const int nlat = p.nb * SEQ;
    LAS bf16_t* RAW = (LAS bf16_t*)(lds + C2_RAW); LAS float* MU = (LAS float*)(lds + C2_MU);
    LAS bf16_t* WUP = (LAS bf16_t*)(lds + C2_WUP); LAS bf16_t* AUP = (LAS bf16_t*)(lds + C2_AUP); LAS float* CST = (LAS float*)(lds + C2_CST);
    LAS bf16_t* AWD = (LAS bf16_t*)(lds + C2_AWD); LAS bf16_t* AAD = (LAS bf16_t*)(lds + C2_AAD);
    LAS float *Rr = (LAS float*)(lds + C2_R), *KR = (LAS float*)(lds + C2_KR), *Vv = (LAS float*)(lds + C2_V), *Ee = (LAS float*)(lds + C2_E), *LA_ = (LAS float*)(lds + C2_LA), *CUM = (LAS float*)(lds + C2_CUM);
    LAS float *YO = (LAS float*)(lds + C2_YO), *Gm = (LAS float*)(lds + C2_G), *ABT = (LAS float*)(lds + C2_ABT), *GC = (LAS float*)(lds + C2_GC), *BON = (LAS float*)(lds + C2_BON);
    LAS bf16_t *UB = (LAS bf16_t*)(lds + C2_UB), *AKT = (LAS bf16_t*)(lds + C2_AKT), *NBT = (LAS bf16_t*)(lds + C2_NBT), *NKT = (LAS bf16_t*)(lds + C2_NKT);
    LAS bf16_t *KKS = (LAS bf16_t*)(lds + C2_KKS), *BS = (LAS bf16_t*)(lds + C2_BS), *KDS = (LAS bf16_t*)(lds + C2_KDS), *RS = (LAS bf16_t*)(lds + C2_RS);
    LAS bf16_t *BST = (LAS bf16_t*)(lds + C2_BST), *KDST = (LAS bf16_t*)(lds + C2_KDST), *VT = (LAS bf16_t*)(lds + C2_VT), *S0B = (LAS bf16_t*)(lds + C2_S0B);
    auto segcol = [&](int s) { return s < 3 ? s * RW + h * 64 : (s == 3 ? OFF_WD + d * DL : OFF_AD + d * AL); };
    for (int i = tid; i < 2 * RAWW; i += NT) { const int m = i / RAWW, c = i % RAWW; MU[i] = in.shift_mu[m * RC + segcol(c >> 6) + (c & 63)]; }
    for (int i = tid; i < 64 * 64; i += NT) { const int j = i >> 6, c = i & 63;
        WUP[c * 72 + j] = f2bf(in.rw_w_up[((size_t)d * DL + j) * RW + h * 64 + c]); AUP[c * 72 + j] = f2bf(in.rw_a_up[((size_t)d * AL + j) * RW + h * 64 + c]); }
    for (int i = tid; i < 64; i += NT) { CST[i] = in.rw_w0[d * RW + h * 64 + i]; CST[64 + i] = in.rw_a0[d * RW + h * 64 + i]; CST[128 + i] = in.rw_k_k[h * 64 + i]; CST[192 + i] = in.rw_k_a[h * 64 + i]; CST[256 + i] = in.rw_r_k[h * 64 + i]; }
    for (int i = tid; i < 64 * 72 / 2; i += NT) ((LAS unsigned*)S0B)[i] = 0u;
    constexpr int NQ = (CTX + SEQ) / TB, NQC = CTX / TB;
    auto blk_info = [&](int q, bool& isctx, int& t0, bool& hp, bool& hn, size_t& grow0) {
        isctx = q < NQC;
        if (isctx) { const int qq = d == 0 ? q : NQC - 1 - q; t0 = qq * TB; hp = t0 > 0; hn = t0 + TB < CTX; grow0 = (size_t)nlat + (size_t)bl * CTX + t0; }
        else { const int ql = q - NQC, qq = d == 0 ? ql : SEQ / TB - 1 - ql; t0 = qq * TB; hp = (t0 % GW) != 0; hn = ((t0 + TB) % GW) != 0; grow0 = (size_t)bl * SEQ + t0; }
    };
    u32x4 pre[RW_PPT]; int poff[RW_PPT], plds[RW_PPT], pkind[RW_PPT];
#pragma unroll
    for (int k = 0; k < RW_PPT; ++k) { const int i = tid + k * NT, rr = i / 40, sp = i % 40, seg = sp >> 3, part = sp & 7;
        poff[k] = (rr - 1) * Z1_N + segcol(seg) + part * 8; plds[k] = rr * RAWW + sp * 8; pkind[k] = i >= RW_NPIECE ? 3 : (rr == 0 ? 1 : (rr == TB + 1 ? 2 : 0)); }
    auto prefetch = [&](int q) {
        bool isctx, hp, hn; int t0; size_t grow0; blk_info(q, isctx, t0, hp, hn, grow0);
        const bf16_t* base = p.z1 + grow0 * Z1_N;
#pragma unroll
        for (int k = 0; k < RW_PPT; ++k) { u32x4 v = (u32x4){0u, 0u, 0u, 0u};
            const bool ok = pkind[k] == 0 || (pkind[k] == 1 && hp) || (pkind[k] == 2 && hn);
            if (ok) v = *(const u32x4*)(base + poff[k]);
            pre[k] = v; }
    };
    auto commit = [&]() {
#pragma unroll
        for (int k = 0; k < RW_PPT; ++k) if (pkind[k] != 3) *(LAS u32x4*)(RAW + plds[k]) = pre[k];
    };
    f32x4 Sreg[2];
    Sreg[0] = (f32x4){0.f, 0.f, 0.f, 0.f}; Sreg[1] = Sreg[0];
    const int rt = wid >> 1;
    prefetch(0);
    for (int q = 0; q < NQ; ++q) {
        bool isctx, hp, hn; int t0; size_t grow0; blk_info(q, isctx, t0, hp, hn, grow0);
        commit();
        __syncthreads();
        if (q + 1 < NQ) prefetch(q + 1);
        auto shift8 = [&](int t, int c0, float (&s)[8]) {
            const u32x4 xp = *(const LAS u32x4*)(RAW + t * RAWW + c0), xc = *(const LAS u32x4*)(RAW + (t + 1) * RAWW + c0), xn_ = *(const LAS u32x4*)(RAW + (t + 2) * RAWW + c0);
            const f32x4 m0a = *(const LAS f32x4*)(MU + c0), m0b = *(const LAS f32x4*)(MU + c0 + 4), m1a = *(const LAS f32x4*)(MU + RAWW + c0), m1b = *(const LAS f32x4*)(MU + RAWW + c0 + 4);
#pragma unroll
            for (int j = 0; j < 4; ++j) { const unsigned a = xp[j], b = xc[j], c = xn_[j];
                const float mu0l = j < 2 ? m0a[2 * j] : m0b[2 * j - 4], mu0h = j < 2 ? m0a[2 * j + 1] : m0b[2 * j - 3], mu1l = j < 2 ? m1a[2 * j] : m1b[2 * j - 4], mu1h = j < 2 ? m1a[2 * j + 1] : m1b[2 * j - 3];
                { const float x = bflo(b); s[2 * j] = x + mu0l * (bflo(a) - x) + mu1l * (bflo(c) - x); }
                { const float x = bfhi(b); s[2 * j + 1] = x + mu0h * (bfhi(a) - x) + mu1h * (bfhi(c) - x); } } };
        for (int it = tid; it < TB * 24; it += NT) {
            const int t = it / 24, g = it % 24, seg = g >> 3, cc = (g & 7) * 8, js = d == 0 ? t : TB - 1 - t; float s[8]; shift8(t, g * 8, s);
            LAS float* dst = (seg == 0 ? Rr : (seg == 1 ? KR : Vv)) + js * 64 + cc; *(LAS f32x4*)dst = (f32x4){s[0], s[1], s[2], s[3]}; *(LAS f32x4*)(dst + 4) = (f32x4){s[4], s[5], s[6], s[7]};
        }
        { const int t = tid >> 4, g = 24 + (tid & 15), cc = (g & 7) * 8, js = d == 0 ? t : TB - 1 - t; float s[8]; shift8(t, g * 8, s);
          const bool isw = (tid & 15) < 8;
#pragma unroll
          for (int j = 0; j < 8; ++j) { const float th = fast_tanh(s[j]); s[j] = isw ? th : s[j]; }
          LAS bf16_t* dst = (isw ? AWD : AAD) + js * 72 + cc;
          u32x4 w; w.x = cvt_pk_bf16(s[0], s[1]); w.y = cvt_pk_bf16(s[2], s[3]); w.z = cvt_pk_bf16(s[4], s[5]); w.w = cvt_pk_bf16(s[6], s[7]); *(LAS u32x4*)dst = w; }
        __syncthreads();
        if (MODE == 3) continue;
        {
            const int lora = wid >> 2, ct = wid & 3;
            const LAS bf16_t* Am = lora ? AAD : AWD; const LAS bf16_t* Bm = lora ? AUP : WUP;
            float carry = 0.f;
#pragma unroll
            for (int r2 = 0; r2 < 2; ++r2) {
                f32x4 acc = (f32x4){0.f, 0.f, 0.f, 0.f};
#pragma unroll
                for (int ks = 0; ks < 2; ++ks) acc = __builtin_amdgcn_mfma_f32_16x16x32_bf16(ldsb8(Am + (r2 * 16 + fr) * 72 + ks * 32 + fq * 8), ldsb8(Bm + (ct * 16 + fr) * 72 + ks * 32 + fq * 8), acc, 0, 0, 0);
                const int col = ct * 16 + fr;
                if (lora == 0) {
                    float c[4];
#pragma unroll
                    for (int i = 0; i < 4; ++i) { const float lw = acc[i] + CST[col]; const float e = __expf(-fast_softplus(-lw) - 0.5f); c[i] = i ? c[i - 1] + e : e; }
                    const float tot = c[3];
                    float s1 = tot; { const float y = __shfl_up(s1, 16); s1 += fq >= 1 ? y : 0.f; }
                    float s2 = s1;  { const float z = __shfl_up(s1, 32); s2 += fq >= 2 ? z : 0.f; }
                    const float base = carry + s2 - tot;
#pragma unroll
                    for (int i = 0; i < 4; ++i) CUM[(r2 * 16 + fq * 4 + i) * 64 + col] = base + c[i];
                    carry += __shfl(s2, 48 + fr);
                } else {
#pragma unroll
                    for (int i = 0; i < 4; ++i) LA_[(r2 * 16 + fq * 4 + i) * 64 + col] = fast_sigmoid(acc[i] + CST[64 + col]);
                }
            }
        }
        __syncthreads();
        if (MODE == 2) continue;
        {
            const int j = tid >> 4, c4 = (tid & 15) * 4;
            const f32x4 k = *(const LAS f32x4*)(KR + j * 64 + c4), a = *(const LAS f32x4*)(LA_ + j * 64 + c4), r = *(const LAS f32x4*)(Rr + j * 64 + c4), vv = *(const LAS f32x4*)(Vv + j * 64 + c4);
            const f32x4 cu = *(const LAS f32x4*)(CUM + j * 64 + c4); f32x4 cp = (f32x4){0.f, 0.f, 0.f, 0.f}; if (j > 0) cp = *(const LAS f32x4*)(CUM + (j - 1) * 64 + c4);
            float kkr[4], ss = 0.f, bn = 0.f;
#pragma unroll
            for (int x = 0; x < 4; ++x) { kkr[x] = k[x] * CST[128 + c4 + x]; ss += kkr[x] * kkr[x]; }
            ss = allreduce16(ss);
            const float inv = 1.f / fmaxf(sqrtf(ss), 1e-12f);
            float kks[4], bs[4], kds[4], rs[4];
#pragma unroll
            for (int x = 0; x < 4; ++x) { const float kk = kkr[x] * inv, kd = k[x] * (1.f + (a[x] - 1.f) * CST[192 + c4 + x]), bb = kk * a[x];
                const float g = __expf(-cu[x]), gp = __expf(-cp[x]), ig = __expf(cu[x]);
                kks[x] = kk * gp; bs[x] = bb * ig; kds[x] = kd * ig; rs[x] = r[x] * g; bn += r[x] * kd * CST[256 + c4 + x];
                if (j == TB - 1) GC[c4 + x] = g;
            }
#pragma unroll
            for (int x = 0; x < 4; x += 2) { const unsigned pb = cvt_pk_bf16(bs[x], bs[x + 1]), pk = cvt_pk_bf16(kds[x], kds[x + 1]), pv = cvt_pk_bf16(vv[x], vv[x + 1]);
                BST[(c4 + x) * 40 + j] = (bf16_t)pb; BST[(c4 + x + 1) * 40 + j] = (bf16_t)(pb >> 16); KDST[(c4 + x) * 40 + j] = (bf16_t)pk; KDST[(c4 + x + 1) * 40 + j] = (bf16_t)(pk >> 16);
                VT[(c4 + x) * 40 + j] = (bf16_t)pv; VT[(c4 + x + 1) * 40 + j] = (bf16_t)(pv >> 16); }
            bn = allreduce16(bn);
            u32x2 w; w.x = cvt_pk_bf16(kks[0], kks[1]); w.y = cvt_pk_bf16(kks[2], kks[3]); *(LAS u32x2*)(KKS + j * 72 + c4) = w;
            w.x = cvt_pk_bf16(bs[0], bs[1]); w.y = cvt_pk_bf16(bs[2], bs[3]); *(LAS u32x2*)(BS + j * 72 + c4) = w;
            w.x = cvt_pk_bf16(kds[0], kds[1]); w.y = cvt_pk_bf16(kds[2], kds[3]); *(LAS u32x2*)(KDS + j * 72 + c4) = w;
            w.x = cvt_pk_bf16(rs[0], rs[1]); w.y = cvt_pk_bf16(rs[2], rs[3]); *(LAS u32x2*)(RS + j * 72 + c4) = w;
            if ((tid & 15) == 0) BON[j] = bn;
        }
        __syncthreads();
        if (MODE == 1) continue;
        const int ctg = wid & 1;
        f32x4 accG = (f32x4){0.f, 0.f, 0.f, 0.f}, accY = accG;
        {
            const int pr = wid >> 1, rts = wid & 1;
            const LAS bf16_t* Xm = (pr & 1) ? KDS : BS; const LAS bf16_t* Ym = (pr < 2) ? KKS : RS;
            const bf16x8 a0 = ldsb8(Xm + (rts * 16 + fr) * 72 + fq * 8), a1 = ldsb8(Xm + (rts * 16 + fr) * 72 + 32 + fq * 8);
#pragma unroll
            for (int cts = 0; cts < 2; ++cts) {
                f32x4 acc = (f32x4){0.f, 0.f, 0.f, 0.f};
                acc = __builtin_amdgcn_mfma_f32_16x16x32_bf16(a0, ldsb8(Ym + (cts * 16 + fr) * 72 + fq * 8), acc, 0, 0, 0);
                acc = __builtin_amdgcn_mfma_f32_16x16x32_bf16(a1, ldsb8(Ym + (cts * 16 + fr) * 72 + 32 + fq * 8), acc, 0, 0, 0);
                const int t = cts * 16 + fr, s0 = rts * 16 + fq * 4;
#pragma unroll
                for (int i = 0; i < 4; ++i) { const bool keep = (pr < 2) ? (s0 + i < t) : (s0 + i <= t); acc[i] = keep ? acc[i] : 0.f; }
                if (pr == 0) *(LAS f32x4*)(ABT + t * 32 + s0) = acc;
                else { u32x2 w; w.x = cvt_pk_bf16(acc[0], acc[1]); w.y = cvt_pk_bf16(acc[2], acc[3]); *(LAS u32x2*)((pr == 1 ? AKT : (pr == 2 ? NBT : NKT)) + t * 40 + s0) = w; }
            }
#pragma unroll
            for (int ks = 0; ks < 2; ++ks) { const bf16x8 sa = ldsb8(S0B + (rt * 16 + fr) * 72 + ks * 32 + fq * 8);
                accG = __builtin_amdgcn_mfma_f32_16x16x32_bf16(sa, ldsb8(KKS + (ctg * 16 + fr) * 72 + ks * 32 + fq * 8), accG, 0, 0, 0);
                accY = __builtin_amdgcn_mfma_f32_16x16x32_bf16(sa, ldsb8(RS + (ctg * 16 + fr) * 72 + ks * 32 + fq * 8), accY, 0, 0, 0); }
        }
        __syncthreads();
        {
            const bf16x8 va = ldsb8(VT + (rt * 16 + fr) * 40 + fq * 8);
            accG = __builtin_amdgcn_mfma_f32_16x16x32_bf16(va, ldsb8(AKT + (ctg * 16 + fr) * 40 + fq * 8), accG, 0, 0, 0);
            accY = __builtin_amdgcn_mfma_f32_16x16x32_bf16(va, ldsb8(NKT + (ctg * 16 + fr) * 40 + fq * 8), accY, 0, 0, 0);
#pragma unroll
            for (int i = 0; i < 4; ++i) Gm[(rt * 16 + fq * 4 + i) * 36 + ctg * 16 + fr] = -accG[i];
        }
        __syncthreads();
        if (MODE == 4) continue;
        if (wid < 4) {
            const int v = wid * 16 + (lane >> 2), pq = lane & 3;
            const LAS float* grow = Gm + v * 36;
            f32x4 r0 = *(const LAS f32x4*)(grow + 4 * pq), r1 = *(const LAS f32x4*)(grow + 16 + 4 * pq);
            u32x2 ubo[TB / 4];
            const LAS float* abd = ABT; asm volatile("" : "+v"(abd));
            const LAS float* abq = ABT + 128 * pq; asm volatile("" : "+v"(abq));
            f32x4 dc[3], a0c[4], a1c[4];
            auto ldg = [&](int g, f32x4 (&dd)[3], f32x4 (&aa0)[4], f32x4 (&aa1)[4]) {
#pragma unroll
                for (int x = 0; x < 3; ++x) dd[x] = *(const LAS f32x4*)(abd + (4 * g + 1 + x) * 32 + 4 * g);
#pragma unroll
                for (int jj = 0; jj < 4; ++jj) { if (g < 3) aa0[jj] = *(const LAS f32x4*)(abq + jj * 32 + 4 * g); if (g < 7) aa1[jj] = *(const LAS f32x4*)(abq + (16 + jj) * 32 + 4 * g); } };
            ldg(0, dc, a0c, a1c);
#pragma unroll
            for (int g = 0; g < TB / 4; ++g) {
                f32x4 dn[3], a0n[4], a1n[4];
                if (g + 1 < TB / 4) ldg(g + 1, dn, a0n, a1n);
                __builtin_amdgcn_sched_barrier(0);
                const f32x4 rr = g < 4 ? r0 : r1;
                f32x4 u4;
                u4[0] = rr[0];
                u4[1] = rr[1] - u4[0] * dc[0][0];
                u4[2] = rr[2] - (u4[0] * dc[1][0] + u4[1] * dc[1][1]);
                u4[3] = rr[3] - (u4[0] * dc[2][0] + u4[1] * dc[2][1] + u4[2] * dc[2][2]);
#pragma unroll
                for (int x = 0; x < 4; ++x) { const int ui = __float_as_int(u4[x]); int bi;
                    if ((g & 3) == 0) bi = __builtin_amdgcn_update_dpp(0, ui, 0x00, 0xF, 0xF, true); else if ((g & 3) == 1) bi = __builtin_amdgcn_update_dpp(0, ui, 0x55, 0xF, 0xF, true);
                    else if ((g & 3) == 2) bi = __builtin_amdgcn_update_dpp(0, ui, 0xAA, 0xF, 0xF, true); else bi = __builtin_amdgcn_update_dpp(0, ui, 0xFF, 0xF, 0xF, true);
                    u4[x] = __int_as_float(bi); }
                ubo[g].x = cvt_pk_bf16(u4[0], u4[1]); ubo[g].y = cvt_pk_bf16(u4[2], u4[3]);
                if (g < 3) {
#pragma unroll
                    for (int jj = 0; jj < 4; ++jj) r0[jj] -= u4[0] * a0c[jj][0] + u4[1] * a0c[jj][1] + u4[2] * a0c[jj][2] + u4[3] * a0c[jj][3]; }
                if (g < 7) {
#pragma unroll
                    for (int jj = 0; jj < 4; ++jj) r1[jj] -= u4[0] * a1c[jj][0] + u4[1] * a1c[jj][1] + u4[2] * a1c[jj][2] + u4[3] * a1c[jj][3]; }
                if (g + 1 < TB / 4) {
#pragma unroll
                    for (int x = 0; x < 3; ++x) dc[x] = dn[x];
#pragma unroll
                    for (int jj = 0; jj < 4; ++jj) { a0c[jj] = a0n[jj]; a1c[jj] = a1n[jj]; } }
            }
            if (pq == 0) {
#pragma unroll
                for (int g = 0; g < TB / 4; g += 2) { u32x4 w; w.x = ubo[g].x; w.y = ubo[g].y; w.z = ubo[g + 1].x; w.w = ubo[g + 1].y; *(LAS u32x4*)(UB + v * 40 + 4 * g) = w; } }
        }
        __syncthreads();
        if (MODE == 5) continue;
        {
            const bf16x8 ua = ldsb8(UB + (rt * 16 + fr) * 40 + fq * 8), va = ldsb8(VT + (rt * 16 + fr) * 40 + fq * 8);
            accY = __builtin_amdgcn_mfma_f32_16x16x32_bf16(ua, ldsb8(NBT + (ctg * 16 + fr) * 40 + fq * 8), accY, 0, 0, 0);
            *(LAS f32x4*)(YO + (ctg * 16 + fr) * 64 + rt * 16 + fq * 4) = accY;
#pragma unroll
            for (int cc = 0; cc < 2; ++cc) { const int ct = 2 * (wid & 1) + cc, kcol = ct * 16 + fr;
                f32x4 acc = Sreg[cc];
                acc = __builtin_amdgcn_mfma_f32_16x16x32_bf16(ua, ldsb8(BST + kcol * 40 + fq * 8), acc, 0, 0, 0);
                acc = __builtin_amdgcn_mfma_f32_16x16x32_bf16(va, ldsb8(KDST + kcol * 40 + fq * 8), acc, 0, 0, 0);
                const float g = GC[kcol];
#pragma unroll
                for (int i = 0; i < 4; ++i) acc[i] *= g;
                { const unsigned p0 = cvt_pk_bf16(acc[0], acc[1]), p1 = cvt_pk_bf16(acc[2], acc[3]); LAS bf16_t* sp = S0B + (rt * 16 + fq * 4) * 72 + kcol;
                  sp[0] = (bf16_t)p0; sp[72] = (bf16_t)(p0 >> 16); sp[144] = (bf16_t)p1; sp[216] = (bf16_t)(p1 >> 16); }
                Sreg[cc] = acc; }
        }
        __syncthreads();
        if (!isctx) {
            const int j = tid >> 4, c4 = (tid & 15) * 4, t = d == 0 ? j : TB - 1 - j; const f32x4 y = *(const LAS f32x4*)(YO + j * 64 + c4);
            u32x2 w; w.x = cvt_pk_bf16(y[0], y[1]); w.y = cvt_pk_bf16(y[2], y[3]);
            bf16_t* yb_ = p.Y + ((size_t)d * nlat + grow0) * RW + h * 64;
            *(u32x2*)(yb_ + t * RW + c4) = w;
            if (tid < TB) { const int tt = d == 0 ? tid : TB - 1 - tid; float* bb_ = p.bon + ((size_t)d * nlat + grow0) * NH + h; bb_[tt * NH] = BON[tid]; }
        }
    }
}
template <int MODE = 0>
__device__ __forceinline__ void rwkv_phase2(LAS unsigned char* lds, const In& in, const RwkvP p, int bid, int nblk) {
    const int nchain = 2 * p.nb * NH;
    for (int c = bid; c < nchain; c += nblk) { rwkv_chain2<MODE>(lds, in, p, c); __syncthreads(); }
}
}

namespace mk {
namespace r3 {
constexpr int C2_RAW = 0;
constexpr int C2_MU = C2_RAW + (TB + 2) * RAWW * 2;
constexpr int C2_WUP = C2_MU + 2 * RAWW * 4;
constexpr int C2_AUP = C2_WUP + 64 * 72 * 2;
constexpr int C2_CST = C2_AUP + 64 * 72 * 2;
constexpr int C2_AWD = C2_CST + 5 * 64 * 4;
constexpr int C2_AAD = C2_AWD + TB * 72 * 2;
constexpr int C2_X = C2_AAD + TB * 72 * 2;
constexpr int C2_G = C2_X;
constexpr int C2_UB = C2_G + 64 * 36 * 4;
constexpr int C2_ABT = C2_UB + 64 * 40 * 2;
constexpr int C2_AKT = C2_ABT + 32 * 32 * 4;
constexpr int C2_NBT = C2_AKT + 32 * 40 * 2;
constexpr int C2_NKT = C2_NBT + 32 * 40 * 2;
constexpr int C2_YO = C2_NKT + 32 * 40 * 2;
constexpr int C2_X_END = C2_YO + TB * 64 * 4;
constexpr int C2_LA = C2_X, C2_CUM = C2_LA + TB * 64 * 4;
static_assert(C2_CUM + TB * 64 * 4 <= C2_YO, "LA/CUM overlay");
constexpr int C2_KKS = C2_X_END;
constexpr int C2_BS = C2_KKS + TB * 72 * 2, C2_KDS = C2_BS + TB * 72 * 2, C2_RS = C2_KDS + TB * 72 * 2;
constexpr int C2_BST = C2_RS + TB * 72 * 2;
constexpr int C2_KDST = C2_BST + 64 * 40 * 2;
constexpr int C2_VT = C2_KDST + 64 * 40 * 2;
constexpr int C2_S0B = C2_VT + 64 * 40 * 2;
constexpr int C2_GC = C2_S0B + 64 * 72 * 2;
constexpr int C2_BON = C2_GC + 64 * 4;
constexpr int C2_RB = C2_BON + TB * 4;
constexpr int C2_KRB = C2_RB + TB * 64 * 2, C2_VB = C2_KRB + TB * 64 * 2;
constexpr int C2_END = C2_VB + TB * 64 * 2;
static_assert(C2_END <= LDS_BYTES - 16 && (C2_X % 16) == 0 && (C2_KKS % 16) == 0 && (C2_G % 16) == 0 && (C2_UB % 16) == 0 && (C2_ABT % 16) == 0 && (C2_AKT % 16) == 0 && (C2_S0B % 16) == 0, "rwkv2 LDS");

__device__ __forceinline__ bf16x8 ldsb8(const LAS bf16_t* p) { return *(const LAS bf16x8*)p; }

template <int MODE>
__device__ __forceinline__ void rwkv_chain3(LAS unsigned char* lds, const In& in, const RwkvP p, int chain) {
    const int tid = threadIdx.x, lane = tid & 63, wid = tid >> 6, fr = lane & 15, fq = lane >> 4;
    const int d = chain / (p.nb * NH), bl = (chain / NH) % p.nb, h = chain % NH;
    const int nlat = p.nb * SEQ;
    LAS bf16_t* RAW = (LAS bf16_t*)(lds + C2_RAW); LAS float* MU = (LAS float*)(lds + C2_MU);
    LAS bf16_t* WUP = (LAS bf16_t*)(lds + C2_WUP); LAS bf16_t* AUP = (LAS bf16_t*)(lds + C2_AUP); LAS float* CST = (LAS float*)(lds + C2_CST);
    LAS bf16_t* AWD = (LAS bf16_t*)(lds + C2_AWD); LAS bf16_t* AAD = (LAS bf16_t*)(lds + C2_AAD);
    LAS bf16_t *Rb = (LAS bf16_t*)(lds + C2_RB), *KRb = (LAS bf16_t*)(lds + C2_KRB), *Vb = (LAS bf16_t*)(lds + C2_VB); LAS float *LA_ = (LAS float*)(lds + C2_LA), *CUM = (LAS float*)(lds + C2_CUM);
    LAS float *YO = (LAS float*)(lds + C2_YO), *Gm = (LAS float*)(lds + C2_G), *ABT = (LAS float*)(lds + C2_ABT), *GC = (LAS float*)(lds + C2_GC), *BON = (LAS float*)(lds + C2_BON);
    LAS bf16_t *UB = (LAS bf16_t*)(lds + C2_UB), *AKT = (LAS bf16_t*)(lds + C2_AKT), *NBT = (LAS bf16_t*)(lds + C2_NBT), *NKT = (LAS bf16_t*)(lds + C2_NKT);
    LAS bf16_t *KKS = (LAS bf16_t*)(lds + C2_KKS), *BS = (LAS bf16_t*)(lds + C2_BS), *KDS = (LAS bf16_t*)(lds + C2_KDS), *RS = (LAS bf16_t*)(lds + C2_RS);
    LAS bf16_t *BST = (LAS bf16_t*)(lds + C2_BST), *KDST = (LAS bf16_t*)(lds + C2_KDST), *VT = (LAS bf16_t*)(lds + C2_VT), *S0B = (LAS bf16_t*)(lds + C2_S0B);
    auto segcol = [&](int s) __attribute__((always_inline)) { return s < 3 ? s * RW + h * 64 : (s == 3 ? OFF_WD + d * DL : OFF_AD + d * AL); };
    for (int i = tid; i < 2 * RAWW; i += NT) { const int m = i / RAWW, c = i % RAWW; MU[i] = in.shift_mu[m * RC + segcol(c >> 6) + (c & 63)]; }
    for (int i = tid; i < 64 * 64; i += NT) { const int j = i >> 6, c = i & 63;
        WUP[c * 72 + j] = f2bf(in.rw_w_up[((size_t)d * DL + j) * RW + h * 64 + c]); AUP[c * 72 + j] = f2bf(in.rw_a_up[((size_t)d * AL + j) * RW + h * 64 + c]); }
    for (int i = tid; i < 64; i += NT) { CST[i] = in.rw_w0[d * RW + h * 64 + i]; CST[64 + i] = in.rw_a0[d * RW + h * 64 + i]; CST[128 + i] = in.rw_k_k[h * 64 + i]; CST[192 + i] = in.rw_k_a[h * 64 + i]; CST[256 + i] = in.rw_r_k[h * 64 + i]; }
    for (int i = tid; i < 64 * 72 / 2; i += NT) ((LAS unsigned*)S0B)[i] = 0u;
    constexpr int NQ = (CTX + SEQ) / TB, NQC = CTX / TB;
    auto blk_info = [&](int q, bool& isctx, int& t0, bool& hp, bool& hn, size_t& grow0) __attribute__((always_inline)) {
        isctx = q < NQC;
        if (isctx) { const int qq = d == 0 ? q : NQC - 1 - q; t0 = qq * TB; hp = t0 > 0; hn = t0 + TB < CTX; grow0 = (size_t)nlat + (size_t)bl * CTX + t0; }
        else { const int ql = q - NQC, qq = d == 0 ? ql : SEQ / TB - 1 - ql; t0 = qq * TB; hp = (t0 % GW) != 0; hn = ((t0 + TB) % GW) != 0; grow0 = (size_t)bl * SEQ + t0; }
    };
    u32x4 pre[RW_PPT]; int poff[RW_PPT], plds[RW_PPT];
#pragma unroll
    for (int k = 0; k < RW_PPT; ++k) { const int i = tid + k * NT, rr = i / 40, sp = i % 40, seg = sp >> 3, part = sp & 7;
        poff[k] = (rr - 1) * Z1_N + segcol(seg) + part * 8; plds[k] = (rr * RAWW + sp * 8) | (i >= RW_NPIECE ? 3 : (rr == 0 ? 1 : (rr == TB + 1 ? 2 : 0))); }
    auto prefetch = [&](int q) __attribute__((always_inline)) {
        bool isctx, hp, hn; int t0; size_t grow0; blk_info(q, isctx, t0, hp, hn, grow0);
        const bf16_t* base = p.z1 + grow0 * Z1_N;
#pragma unroll
        for (int k = 0; k < RW_PPT; ++k) { u32x4 v = (u32x4){0u, 0u, 0u, 0u};
            const int kind = plds[k] & 3; const bool ok = kind == 0 || (kind == 1 && hp) || (kind == 2 && hn);
            if (ok) v = *(const u32x4*)(base + poff[k]);
            pre[k] = v; }
    };
    auto commit = [&]() __attribute__((always_inline)) {
#pragma unroll
        for (int k = 0; k < RW_PPT; ++k) if ((plds[k] & 3) != 3) *(LAS u32x4*)(RAW + (plds[k] & ~3)) = pre[k];
    };
    f32x4 Sreg[2];
    Sreg[0] = (f32x4){0.f, 0.f, 0.f, 0.f}; Sreg[1] = Sreg[0];
    const int rt = wid >> 1;
    auto shift8 = [&](int t, int c0, float (&s)[8]) __attribute__((always_inline)) {
        const u32x4 xp = *(const LAS u32x4*)(RAW + t * RAWW + c0), xc = *(const LAS u32x4*)(RAW + (t + 1) * RAWW + c0), xn_ = *(const LAS u32x4*)(RAW + (t + 2) * RAWW + c0);
        const f32x4 m0a = *(const LAS f32x4*)(MU + c0), m0b = *(const LAS f32x4*)(MU + c0 + 4), m1a = *(const LAS f32x4*)(MU + RAWW + c0), m1b = *(const LAS f32x4*)(MU + RAWW + c0 + 4);
#define MK_SH1(J, XP, XC, XN, M0L, M0H, M1L, M1H) { const float xl = bflo(XC), xh = bfhi(XC); s[2 * J] = xl + M0L * (bflo(XP) - xl) + M1L * (bflo(XN) - xl); s[2 * J + 1] = xh + M0H * (bfhi(XP) - xh) + M1H * (bfhi(XN) - xh); }
        MK_SH1(0, xp.x, xc.x, xn_.x, m0a.x, m0a.y, m1a.x, m1a.y) MK_SH1(1, xp.y, xc.y, xn_.y, m0a.z, m0a.w, m1a.z, m1a.w)
        MK_SH1(2, xp.z, xc.z, xn_.z, m0b.x, m0b.y, m1b.x, m1b.y) MK_SH1(3, xp.w, xc.w, xn_.w, m0b.z, m0b.w, m1b.z, m1b.w)
#undef MK_SH1
    };
    auto do_shift = [&](int tl, int nth) __attribute__((always_inline)) {
#pragma unroll 1
        for (int it = tl; it < TB * 24; it += nth) {
            const int t = it / 24, g = it % 24, seg = g >> 3, cc = (g & 7) * 8, js = d == 0 ? t : TB - 1 - t; float s[8]; shift8(t, g * 8, s);
            LAS bf16_t* dst = Rb + seg * (TB * 64) + js * 64 + cc;
            u32x4 w; w.x = cvt_pk_bf16(s[0], s[1]); w.y = cvt_pk_bf16(s[2], s[3]); w.z = cvt_pk_bf16(s[4], s[5]); w.w = cvt_pk_bf16(s[6], s[7]); *(LAS u32x4*)dst = w;
        }
#pragma unroll 1
        for (int it = tl; it < TB * 16; it += nth) { const int t = it >> 4, g = 24 + (it & 15), cc = (g & 7) * 8, js = d == 0 ? t : TB - 1 - t; float s[8]; shift8(t, g * 8, s);
            const bool isw = (it & 15) < 8;
#pragma unroll
            for (int j = 0; j < 8; ++j) { const float th = fast_tanh(s[j]); s[j] = isw ? th : s[j]; }
            LAS bf16_t* dst = AWD + (isw ? 0 : TB * 72) + js * 72 + cc;
            u32x4 w; w.x = cvt_pk_bf16(s[0], s[1]); w.y = cvt_pk_bf16(s[2], s[3]); w.z = cvt_pk_bf16(s[4], s[5]); w.w = cvt_pk_bf16(s[6], s[7]); *(LAS u32x4*)dst = w; }
    };
    prefetch(0);
    commit();
    __syncthreads();
    if (1 < NQ) prefetch(1);
    do_shift(tid & (NT / 2 - 1), NT / 2);
    __syncthreads();
    for (int q = 0; q < NQ; ++q) {
        bool isctx, hp, hn; int t0; size_t grow0; blk_info(q, isctx, t0, hp, hn, grow0);
        {
            const int lora = wid >> 2, ct = wid & 3;
            const LAS bf16_t* Am = lora ? AAD : AWD; const LAS bf16_t* Bm = lora ? AUP : WUP;
            float carry = 0.f;
#pragma unroll
            for (int r2 = 0; r2 < 2; ++r2) {
                f32x4 acc = (f32x4){0.f, 0.f, 0.f, 0.f};
#pragma unroll
                for (int ks = 0; ks < 2; ++ks) acc = __builtin_amdgcn_mfma_f32_16x16x32_bf16(ldsb8(Am + (r2 * 16 + fr) * 72 + ks * 32 + fq * 8), ldsb8(Bm + (ct * 16 + fr) * 72 + ks * 32 + fq * 8), acc, 0, 0, 0);
                const int col = ct * 16 + fr;
                if (lora == 0) {
                    float c[4];
#pragma unroll
                    for (int i = 0; i < 4; ++i) { const float lw = acc[i] + CST[col]; const float e = 0.60653066f * fast_sigmoid(lw); c[i] = i ? c[i - 1] + e : e;   }
                    const float tot = c[3];
                    float s1 = tot; { const float y = __shfl_up(s1, 16); s1 += fq >= 1 ? y : 0.f; }
                    float s2 = s1;  { const float z = __shfl_up(s1, 32); s2 += fq >= 2 ? z : 0.f; }
                    const float base = carry + s2 - tot;
#pragma unroll
                    for (int i = 0; i < 4; ++i) CUM[(r2 * 16 + fq * 4 + i) * 64 + col] = base + c[i];
                    carry += __shfl(s2, 48 + fr);
                } else {
#pragma unroll
                    for (int i = 0; i < 4; ++i) LA_[(r2 * 16 + fq * 4 + i) * 64 + col] = fast_sigmoid(acc[i] + CST[64 + col]);
                }
            }
        }
        __syncthreads();
        {
            const int j = tid >> 4, c4 = (tid & 15) * 4;
            const u32x2 kp = *(const LAS u32x2*)(KRb + j * 64 + c4), rp = *(const LAS u32x2*)(Rb + j * 64 + c4), vp = *(const LAS u32x2*)(Vb + j * 64 + c4);
            const f32x4 k = (f32x4){bflo(kp.x), bfhi(kp.x), bflo(kp.y), bfhi(kp.y)}, r = (f32x4){bflo(rp.x), bfhi(rp.x), bflo(rp.y), bfhi(rp.y)}, vv = (f32x4){bflo(vp.x), bfhi(vp.x), bflo(vp.y), bfhi(vp.y)};
            const f32x4 a = *(const LAS f32x4*)(LA_ + j * 64 + c4);
            const f32x4 cu = *(const LAS f32x4*)(CUM + j * 64 + c4); f32x4 cp = (f32x4){0.f, 0.f, 0.f, 0.f}; if (j > 0) cp = *(const LAS f32x4*)(CUM + (j - 1) * 64 + c4);
            float kkr[4], ss = 0.f, bn = 0.f;
#pragma unroll
            for (int x = 0; x < 4; ++x) { kkr[x] = k[x] * CST[128 + c4 + x]; ss += kkr[x] * kkr[x]; }
            ss = allreduce16(ss);
            const float inv = 1.f / fmaxf(sqrtf(ss), 1e-12f);
            float kks[4], bs[4], kds[4], rs[4];
#pragma unroll
            for (int x = 0; x < 4; ++x) { const float kk = kkr[x] * inv, kd = k[x] * (1.f + (a[x] - 1.f) * CST[192 + c4 + x]), bb = kk * a[x];
                const float ig = __expf(cu[x]), g = fast_rcp(ig), gp = __expf(-cp[x]);
                kks[x] = kk * gp; bs[x] = bb * ig; kds[x] = kd * ig; rs[x] = r[x] * g; bn += r[x] * kd * CST[256 + c4 + x];
                if (j == TB - 1) GC[c4 + x] = g;
            }
#pragma unroll
            for (int x = 0; x < 4; x += 2) { const unsigned pb = cvt_pk_bf16(bs[x], bs[x + 1]), pk = cvt_pk_bf16(kds[x], kds[x + 1]), pv = cvt_pk_bf16(vv[x], vv[x + 1]);
                BST[(c4 + x) * 40 + j] = (bf16_t)pb; BST[(c4 + x + 1) * 40 + j] = (bf16_t)(pb >> 16); KDST[(c4 + x) * 40 + j] = (bf16_t)pk; KDST[(c4 + x + 1) * 40 + j] = (bf16_t)(pk >> 16);
                VT[(c4 + x) * 40 + j] = (bf16_t)pv; VT[(c4 + x + 1) * 40 + j] = (bf16_t)(pv >> 16); }
            bn = allreduce16(bn);
            u32x2 w; w.x = cvt_pk_bf16(kks[0], kks[1]); w.y = cvt_pk_bf16(kks[2], kks[3]); *(LAS u32x2*)(KKS + j * 72 + c4) = w;
            w.x = cvt_pk_bf16(bs[0], bs[1]); w.y = cvt_pk_bf16(bs[2], bs[3]); *(LAS u32x2*)(BS + j * 72 + c4) = w;
            w.x = cvt_pk_bf16(kds[0], kds[1]); w.y = cvt_pk_bf16(kds[2], kds[3]); *(LAS u32x2*)(KDS + j * 72 + c4) = w;
            w.x = cvt_pk_bf16(rs[0], rs[1]); w.y = cvt_pk_bf16(rs[2], rs[3]); *(LAS u32x2*)(RS + j * 72 + c4) = w;
            if ((tid & 15) == 0) BON[j] = bn;
        }
        __syncthreads();
        const int ctg = wid & 1;
        f32x4 accG = (f32x4){0.f, 0.f, 0.f, 0.f}, accY = accG;
        {
            const int pr = wid >> 1, rts = wid & 1;
            const LAS bf16_t* Xm = (pr & 1) ? KDS : BS; const LAS bf16_t* Ym = (pr < 2) ? KKS : RS;
            const bf16x8 a0 = ldsb8(Xm + (rts * 16 + fr) * 72 + fq * 8), a1 = ldsb8(Xm + (rts * 16 + fr) * 72 + 32 + fq * 8);
#pragma unroll
            for (int cts = 0; cts < 2; ++cts) {
                f32x4 acc = (f32x4){0.f, 0.f, 0.f, 0.f};
                acc = __builtin_amdgcn_mfma_f32_16x16x32_bf16(a0, ldsb8(Ym + (cts * 16 + fr) * 72 + fq * 8), acc, 0, 0, 0);
                acc = __builtin_amdgcn_mfma_f32_16x16x32_bf16(a1, ldsb8(Ym + (cts * 16 + fr) * 72 + 32 + fq * 8), acc, 0, 0, 0);
                const int t = cts * 16 + fr, s0 = rts * 16 + fq * 4;
#pragma unroll
                for (int i = 0; i < 4; ++i) { const bool keep = (pr < 2) ? (s0 + i < t) : (s0 + i <= t); acc[i] = keep ? acc[i] : 0.f; }
                if (pr == 0) *(LAS f32x4*)(ABT + t * 32 + s0) = acc;
                else { u32x2 w; w.x = cvt_pk_bf16(acc[0], acc[1]); w.y = cvt_pk_bf16(acc[2], acc[3]); *(LAS u32x2*)((pr == 1 ? AKT : (pr == 2 ? NBT : NKT)) + t * 40 + s0) = w; }
            }
#pragma unroll
            for (int ks = 0; ks < 2; ++ks) { const bf16x8 sa = ldsb8(S0B + (rt * 16 + fr) * 72 + ks * 32 + fq * 8);
                accG = __builtin_amdgcn_mfma_f32_16x16x32_bf16(sa, ldsb8(KKS + (ctg * 16 + fr) * 72 + ks * 32 + fq * 8), accG, 0, 0, 0);
                accY = __builtin_amdgcn_mfma_f32_16x16x32_bf16(sa, ldsb8(RS + (ctg * 16 + fr) * 72 + ks * 32 + fq * 8), accY, 0, 0, 0); }
        }
        __syncthreads();
        {
            const bf16x8 va = ldsb8(VT + (rt * 16 + fr) * 40 + fq * 8);
            accG = __builtin_amdgcn_mfma_f32_16x16x32_bf16(va, ldsb8(AKT + (ctg * 16 + fr) * 40 + fq * 8), accG, 0, 0, 0);
            accY = __builtin_amdgcn_mfma_f32_16x16x32_bf16(va, ldsb8(NKT + (ctg * 16 + fr) * 40 + fq * 8), accY, 0, 0, 0);
#pragma unroll
            for (int i = 0; i < 4; ++i) Gm[(rt * 16 + fq * 4 + i) * 36 + ctg * 16 + fr] = -accG[i];
            if (q + 1 < NQ) { commit(); if (q + 2 < NQ) prefetch(q + 2); }
        }
        __syncthreads();
        if (wid >= 4) { if (q + 1 < NQ) do_shift(tid & (NT / 2 - 1), NT / 2); }
        else {
            const int v = wid * 16 + (lane >> 2), pq = lane & 3;
            const LAS float* grow = Gm + v * 36;
            f32x4 r0 = *(const LAS f32x4*)(grow + 4 * pq), r1 = *(const LAS f32x4*)(grow + 16 + 4 * pq);
            u32x2 ubo[TB / 4];
            const LAS float* abd = ABT; asm volatile("" : "+v"(abd));
            const LAS float* abq = ABT + 128 * pq; asm volatile("" : "+v"(abq));
            f32x4 dc[3], a0c[4], a1c[4];
            auto ldg = [&](int g, f32x4 (&dd)[3], f32x4 (&aa0)[4], f32x4 (&aa1)[4]) {
#pragma unroll
                for (int x = 0; x < 3; ++x) dd[x] = *(const LAS f32x4*)(abd + (4 * g + 1 + x) * 32 + 4 * g);
#pragma unroll
                for (int jj = 0; jj < 4; ++jj) { if (g < 3) aa0[jj] = *(const LAS f32x4*)(abq + jj * 32 + 4 * g); if (g < 7) aa1[jj] = *(const LAS f32x4*)(abq + (16 + jj) * 32 + 4 * g); } };
            ldg(0, dc, a0c, a1c);
#pragma unroll
            for (int g = 0; g < TB / 4; ++g) {
                f32x4 dn[3], a0n[4], a1n[4];
                if (g + 1 < TB / 4) ldg(g + 1, dn, a0n, a1n);
                __builtin_amdgcn_sched_barrier(0);
                const f32x4 rr = g < 4 ? r0 : r1;
                f32x4 u4;
                u4[0] = rr[0];
                u4[1] = rr[1] - u4[0] * dc[0][0];
                u4[2] = rr[2] - (u4[0] * dc[1][0] + u4[1] * dc[1][1]);
                u4[3] = rr[3] - (u4[0] * dc[2][0] + u4[1] * dc[2][1] + u4[2] * dc[2][2]);
#pragma unroll
                for (int x = 0; x < 4; ++x) { const int ui = __float_as_int(u4[x]); int bi;
                    if ((g & 3) == 0) bi = __builtin_amdgcn_update_dpp(0, ui, 0x00, 0xF, 0xF, true); else if ((g & 3) == 1) bi = __builtin_amdgcn_update_dpp(0, ui, 0x55, 0xF, 0xF, true);
                    else if ((g & 3) == 2) bi = __builtin_amdgcn_update_dpp(0, ui, 0xAA, 0xF, 0xF, true); else bi = __builtin_amdgcn_update_dpp(0, ui, 0xFF, 0xF, 0xF, true);
                    u4[x] = __int_as_float(bi); }
                ubo[g].x = cvt_pk_bf16(u4[0], u4[1]); ubo[g].y = cvt_pk_bf16(u4[2], u4[3]);
                if (g < 3) {
#pragma unroll
                    for (int jj = 0; jj < 4; ++jj) r0[jj] -= u4[0] * a0c[jj][0] + u4[1] * a0c[jj][1] + u4[2] * a0c[jj][2] + u4[3] * a0c[jj][3]; }
                if (g < 7) {
#pragma unroll
                    for (int jj = 0; jj < 4; ++jj) r1[jj] -= u4[0] * a1c[jj][0] + u4[1] * a1c[jj][1] + u4[2] * a1c[jj][2] + u4[3] * a1c[jj][3]; }
                if (g + 1 < TB / 4) {
#pragma unroll
                    for (int x = 0; x < 3; ++x) dc[x] = dn[x];
#pragma unroll
                    for (int jj = 0; jj < 4; ++jj) { a0c[jj] = a0n[jj]; a1c[jj] = a1n[jj]; } }
            }
            if (pq == 0) {
#pragma unroll
                for (int g = 0; g < TB / 4; g += 2) { u32x4 w; w.x = ubo[g].x; w.y = ubo[g].y; w.z = ubo[g + 1].x; w.w = ubo[g + 1].y; *(LAS u32x4*)(UB + v * 40 + 4 * g) = w; } }
        }
        __syncthreads();
        {
            const bf16x8 ua = ldsb8(UB + (rt * 16 + fr) * 40 + fq * 8), va = ldsb8(VT + (rt * 16 + fr) * 40 + fq * 8);
            accY = __builtin_amdgcn_mfma_f32_16x16x32_bf16(ua, ldsb8(NBT + (ctg * 16 + fr) * 40 + fq * 8), accY, 0, 0, 0);
            *(LAS f32x4*)(YO + (ctg * 16 + fr) * 64 + rt * 16 + fq * 4) = accY;
#pragma unroll
            for (int cc = 0; cc < 2; ++cc) { const int ct = 2 * (wid & 1) + cc, kcol = ct * 16 + fr;
                f32x4 acc = Sreg[cc];
                acc = __builtin_amdgcn_mfma_f32_16x16x32_bf16(ua, ldsb8(BST + kcol * 40 + fq * 8), acc, 0, 0, 0);
                acc = __builtin_amdgcn_mfma_f32_16x16x32_bf16(va, ldsb8(KDST + kcol * 40 + fq * 8), acc, 0, 0, 0);
                const float g = GC[kcol];
#pragma unroll
                for (int i = 0; i < 4; ++i) acc[i] *= g;
                { const unsigned p0 = cvt_pk_bf16(acc[0], acc[1]), p1 = cvt_pk_bf16(acc[2], acc[3]); LAS bf16_t* sp = S0B + (rt * 16 + fq * 4) * 72 + kcol;
                  sp[0] = (bf16_t)p0; sp[72] = (bf16_t)(p0 >> 16); sp[144] = (bf16_t)p1; sp[216] = (bf16_t)(p1 >> 16); }
                Sreg[cc] = acc; }
        }
        __syncthreads();
        if (!isctx) {
            const int j = tid >> 4, c4 = (tid & 15) * 4, t = d == 0 ? j : TB - 1 - j; const f32x4 y = *(const LAS f32x4*)(YO + j * 64 + c4);
            u32x2 w; w.x = cvt_pk_bf16(y[0], y[1]); w.y = cvt_pk_bf16(y[2], y[3]);
            bf16_t* yb_ = p.Y + ((size_t)d * nlat + grow0) * RW + h * 64;
            *(u32x2*)(yb_ + t * RW + c4) = w;
            if (tid < TB) { const int tt = d == 0 ? tid : TB - 1 - tid; float* bb_ = p.bon + ((size_t)d * nlat + grow0) * NH + h; bb_[tt * NH] = BON[tid]; }
        }
    }
}
template <int MODE = 0>
__device__ __forceinline__ void rwkv_phase3(LAS unsigned char* lds, const In& in, const RwkvP p, int bid, int nblk) {
    const int nchain = 2 * p.nb * NH;
    for (int c = bid; c < nchain; c += nblk) { rwkv_chain3<MODE>(lds, in, p, c); __syncthreads(); }
}
}
}

namespace mk {
constexpr int LR_XT = 0;
constexpr int LR_XC = LR_XT + 67 * 64 * 2 + 64;
constexpr int LR_XCB = LR_XC + 64 * 64 * 4;
constexpr int LR_GWT = LR_XCB + 64 * 72 * 2;
constexpr int LR_A = LR_GWT + 2 * 64 * 72 * 2;
constexpr int LR_BX = LR_A + 64 * 64 * 4;
constexpr int LR_HO = LR_BX + 64 * 64 * 4;
constexpr int LR_CST = LR_HO + 64 * 64 * 4;
constexpr int LR_SEGP = LR_CST + 8 * 64 * 4;
constexpr int LR_SEGH = LR_SEGP + 8 * 64 * 4;
constexpr int LR_HC = LR_SEGH + 8 * 64 * 4;
constexpr int LR_END = LR_HC + 64 * 4;
static_assert(LR_END <= LDS_BYTES && (LR_XC % 16) == 0, "lru LDS");

struct LruP { const bf16_t* z1; bf16_t* Hd; int b0, nb; };

__device__ __forceinline__ void lru_item(LAS unsigned char* lds, const In& in, const LruP p, int item) {
    const int tid = threadIdx.x, lane = tid & 63, wid = tid >> 6;
    const int d = item / (p.nb * LB), bl = (item / LB) % p.nb, n = item % LB;
    const int nlat = p.nb * SEQ;
    LAS bf16_t* XT = (LAS bf16_t*)(lds + LR_XT); LAS float* XC = (LAS float*)(lds + LR_XC); LAS bf16_t* XCB = (LAS bf16_t*)(lds + LR_XCB); LAS bf16_t* GWT = (LAS bf16_t*)(lds + LR_GWT);
    LAS float *A_ = (LAS float*)(lds + LR_A), *BX = (LAS float*)(lds + LR_BX), *HO = (LAS float*)(lds + LR_HO), *CST = (LAS float*)(lds + LR_CST), *SEGP = (LAS float*)(lds + LR_SEGP), *SEGH = (LAS float*)(lds + LR_SEGH), *HC = (LAS float*)(lds + LR_HC);
    for (int i = tid; i < 2 * 64 * 64; i += NT) { const int g = i >> 12, j = (i >> 6) & 63, k = i & 63;
        GWT[(g * 64 + k) * 72 + j] = f2bf(in.lru_gate_w[((((size_t)d * 2 + g) * LB + n) * LBS + j) * LBS + k]); }
    for (int i = tid; i < 64; i += NT) { const int c = n * 64 + i;
        CST[i] = in.lru_conv_w[c]; CST[64 + i] = in.lru_conv_w[LW + c]; CST[128 + i] = in.lru_conv_w[2 * LW + c]; CST[192 + i] = in.lru_conv_w[3 * LW + c]; CST[256 + i] = in.lru_conv_b[c];
        CST[320 + i] = in.lru_gate_b[((d * 2 + 0) * LB + n) * LBS + i]; CST[384 + i] = in.lru_gate_b[((d * 2 + 1) * LB + n) * LBS + i]; CST[448 + i] = softplusf_(-in.lru_l[d * LW + c]); }
    constexpr int NSEG = CTX / 64 + GW, NSC = CTX / 64;
    u32x4 pre[2];
    auto tok_row = [&](int sidx, int rr, bool& ok) -> size_t {
        if (sidx < NSC) { const int t = sidx * 64 + rr - 2; ok = t >= 0 && t < CTX; return (size_t)nlat + (size_t)bl * CTX + t; }
        const int col = sidx - NSC, row = rr - 2; ok = row >= 0 && row < ROWS; return (size_t)bl * SEQ + (size_t)row * GW + col;
    };
    auto seg_of = [&](int q) { if (q < NSC) return d == 0 ? q : NSC - 1 - q; const int ql = q - NSC; return NSC + (d == 0 ? ql : GW - 1 - ql); };
    auto prefetch = [&](int q) { const int sidx = seg_of(q);
#pragma unroll
        for (int k = 0; k < 2; ++k) { const int i = tid + k * NT; u32x4 v = (u32x4){0u, 0u, 0u, 0u};
            if (i < 67 * 8) { const int rr = i >> 3, part = i & 7; bool ok; const size_t gr = tok_row(sidx, rr, ok); if (ok) v = *(const u32x4*)(p.z1 + gr * Z1_N + Z1_LX + n * 64 + part * 8); }
            pre[k] = v; } };
    auto commit = [&]() {
#pragma unroll
        for (int k = 0; k < 2; ++k) { const int i = tid + k * NT; if (i < 67 * 8) *(LAS u32x4*)(XT + (i >> 3) * 64 + (i & 7) * 8) = pre[k]; } };
    if (tid < 64) HC[tid] = 0.f;
    prefetch(0);
    for (int q = 0; q < NSEG; ++q) {
        const int sidx = seg_of(q);
        commit();
        __syncthreads();
        if (q + 1 < NSEG) prefetch(q + 1);
        { const int t = tid >> 3, c0 = (tid & 7) * 8; float s[8];
#pragma unroll
          for (int j = 0; j < 8; ++j) s[j] = CST[256 + c0 + j];
#pragma unroll
          for (int tap = 0; tap < 4; ++tap) { const u32x4 x = *(const LAS u32x4*)(XT + (t + tap) * 64 + c0);
#pragma unroll
              for (int j = 0; j < 4; ++j) { s[2 * j] += CST[tap * 64 + c0 + 2 * j] * bflo(x[j]); s[2 * j + 1] += CST[tap * 64 + c0 + 2 * j + 1] * bfhi(x[j]); } }
          *(LAS f32x4*)(XC + t * 64 + c0) = (f32x4){s[0], s[1], s[2], s[3]}; *(LAS f32x4*)(XC + t * 64 + c0 + 4) = (f32x4){s[4], s[5], s[6], s[7]};
          u32x4 w; w.x = cvt_pk_bf16(s[0], s[1]); w.y = cvt_pk_bf16(s[2], s[3]); w.z = cvt_pk_bf16(s[4], s[5]); w.w = cvt_pk_bf16(s[6], s[7]); *(LAS u32x4*)(XCB + t * 72 + c0) = w; }
        __syncthreads();
        { const int rt = wid >> 1, fr = lane & 15, fq = lane >> 4;
          bf16x8 a[2];
#pragma unroll
          for (int ks = 0; ks < 2; ++ks) a[ks] = *(const LAS bf16x8*)(XCB + (rt * 16 + fr) * 72 + ks * 32 + fq * 8);
#pragma unroll
          for (int cc = 0; cc < 2; ++cc) { const int ct = 2 * (wid & 1) + cc, col = ct * 16 + fr;
              f32x4 acc0 = (f32x4){0.f, 0.f, 0.f, 0.f}, acc1 = acc0;
#pragma unroll
              for (int ks = 0; ks < 2; ++ks) {
                  const bf16x8 b0 = *(const LAS bf16x8*)(GWT + (0 * 64 + col) * 72 + ks * 32 + fq * 8), b1 = *(const LAS bf16x8*)(GWT + (1 * 64 + col) * 72 + ks * 32 + fq * 8);
                  acc0 = __builtin_amdgcn_mfma_f32_16x16x32_bf16(a[ks], b0, acc0, 0, 0, 0); acc1 = __builtin_amdgcn_mfma_f32_16x16x32_bf16(a[ks], b1, acc1, 0, 0, 0); }
#pragma unroll
              for (int i = 0; i < 4; ++i) { const int t = rt * 16 + fq * 4 + i;
                  const float rec = fast_sigmoid(acc0[i] + CST[320 + col]), inp = fast_sigmoid(acc1[i] + CST[384 + col]);
                  const float la = -8.f * rec * CST[448 + col];
                  const float av = __expf(la), x2 = 2.f * la; const float om = x2 > -0.03f ? -x2 * (1.f + x2 * (0.5f + x2 * (1.f / 6.f))) : 1.f - av * av;
                  A_[t * 64 + col] = av; BX[t * 64 + col] = __builtin_amdgcn_sqrtf(om) * inp * XC[t * 64 + col]; } } }
        __syncthreads();
        { const int ch = tid & 63, pc = tid >> 6; float av[8], bv[8]; float P = 1.f, H = 0.f;
#pragma unroll
          for (int x = 0; x < 8; ++x) { const int st = pc * 8 + x, t = d == 0 ? st : 63 - st; av[x] = A_[t * 64 + ch]; bv[x] = BX[t * 64 + ch]; H = av[x] * H + bv[x]; P *= av[x]; }
          SEGP[pc * 64 + ch] = P; SEGH[pc * 64 + ch] = H;
          __syncthreads();
          float h = HC[ch];
#pragma unroll
          for (int q2 = 0; q2 < 7; ++q2) if (q2 < pc) h = SEGP[q2 * 64 + ch] * h + SEGH[q2 * 64 + ch];
#pragma unroll
          for (int x = 0; x < 8; ++x) { const int st = pc * 8 + x, t = d == 0 ? st : 63 - st; h = av[x] * h + bv[x]; HO[t * 64 + ch] = h; }
          __syncthreads();
          if (pc == 7) HC[ch] = h;
        }
        if (sidx >= NSC) { const int col = sidx - NSC, t = tid >> 3, c0 = (tid & 7) * 8;
            const f32x4 x = *(const LAS f32x4*)(HO + t * 64 + c0), y = *(const LAS f32x4*)(HO + t * 64 + c0 + 4);
            *(u32x4*)(p.Hd + ((size_t)d * nlat + (size_t)bl * SEQ + (size_t)t * GW + col) * LW + n * 64 + c0) = pack8(x, y); }
    }
}
__device__ __forceinline__ void lru_phase(LAS unsigned char* lds, const In& in, const LruP p, int bid, int nblk) {
    const int nitem = 2 * p.nb * LB;
    for (int it = bid; it < nitem; it += nblk) { lru_item(lds, in, p, it); __syncthreads(); }
}
}

namespace mk {
#define MK_DPPX(x, ctrl) __int_as_float(__builtin_amdgcn_update_dpp(__float_as_int(x), __float_as_int(x), ctrl, 0xF, 0xF, false))
__device__ __forceinline__ float allreduce4(float x) { x += MK_DPPX(x, 0xB1); x += MK_DPPX(x, 0x4E); return x; }
__device__ __forceinline__ void unpack8(const u32x4 w, float (&f)[8]) {
#pragma unroll
    for (int j = 0; j < 4; ++j) { f[2 * j] = bflo(w[j]); f[2 * j + 1] = bfhi(w[j]); } }
constexpr int AG_K = 256;
struct PostP { const bf16_t* z1; bf16_t* Y; const float* bon; bf16_t* Ag; int nlat; int pad_; };
__device__ __forceinline__ void rwkv_post_rows(const In& in, const PostP p, int row_lo, int row_hi, bool dry = false) {
    const int lane = threadIdx.x & 63, wid = threadIdx.x >> 6, c0 = lane * 16, h = lane >> 2;
    float mu0v[16], mu1v[16], l0[16], l1[16], mg0[8], mg1[8];
#pragma unroll
    for (int j = 0; j < 16; ++j) { mu0v[j] = in.shift_mu[OFF_V + c0 + j]; mu1v[j] = in.shift_mu[RC + OFF_V + c0 + j]; l0[j] = in.rw_lnx[c0 + j]; l1[j] = in.rw_lnx[RW + c0 + j]; }
#pragma unroll
    for (int j = 0; j < 8; ++j) { const int c = OFF_GD + (lane < GL / 8 ? lane : 0) * 8 + j; mg0[j] = in.shift_mu[c]; mg1[j] = in.shift_mu[RC + c]; }
    for (int r = row_lo + wid; r < row_hi; r += NT / 64) {
        const int cg = r % GW; const bool hp = cg > 0, hn = cg < GW - 1;
        bf16_t* y0p = p.Y + (size_t)r * RW + c0; const bf16_t* y1p = p.Y + ((size_t)p.nlat + r) * RW + c0;
        float y[16], t8[8];
        unpack8(*(const u32x4*)y0p, t8);
#pragma unroll
        for (int j = 0; j < 8; ++j) y[j] = t8[j];
        unpack8(*(const u32x4*)(y0p + 8), t8);
#pragma unroll
        for (int j = 0; j < 8; ++j) y[8 + j] = t8[j];
        unpack8(*(const u32x4*)y1p, t8);
#pragma unroll
        for (int j = 0; j < 8; ++j) y[j] += t8[j];
        unpack8(*(const u32x4*)(y1p + 8), t8);
#pragma unroll
        for (int j = 0; j < 8; ++j) y[8 + j] += t8[j];
        float s = 0.f;
#pragma unroll
        for (int j = 0; j < 16; ++j) s += y[j];
        const float mu = allreduce4(s) * (1.f / 64.f); float q = 0.f;
#pragma unroll
        for (int j = 0; j < 16; ++j) { const float dlt = y[j] - mu; q += dlt * dlt; }
        const float rs = 1.f / sqrtf(allreduce4(q) * (1.f / 64.f) + LNX_EPS);
        const float bonus = p.bon[(size_t)r * NH + h] + p.bon[((size_t)p.nlat + r) * NH + h];
        const bf16_t* zr = p.z1 + (size_t)r * Z1_N;
#pragma unroll
        for (int half = 0; half < 2; ++half) {
            const int c = OFF_V + c0 + half * 8; float xv[8], pv[8], nv[8];
            unpack8(*(const u32x4*)(zr + c), xv);
            if (hp) unpack8(*(const u32x4*)(zr - Z1_N + c), pv); else {
#pragma unroll
                for (int j = 0; j < 8; ++j) pv[j] = 0.f; }
            if (hn) unpack8(*(const u32x4*)(zr + Z1_N + c), nv); else {
#pragma unroll
                for (int j = 0; j < 8; ++j) nv[j] = 0.f; }
            float o[8];
#pragma unroll
            for (int j = 0; j < 8; ++j) { const int cj = half * 8 + j; const float v = xv[j] + mu0v[cj] * (pv[j] - xv[j]) + mu1v[cj] * (nv[j] - xv[j]);
                o[j] = (y[cj] - mu) * rs * l0[cj] + l1[cj] + bonus * v; }
            u32x4 w; w.x = cvt_pk_bf16(o[0], o[1]); w.y = cvt_pk_bf16(o[2], o[3]); w.z = cvt_pk_bf16(o[4], o[5]); w.w = cvt_pk_bf16(o[6], o[7]); if (!dry) *(u32x4*)(y0p + half * 8) = w; else if (w.x == 0x12345678u) *(u32x4*)(y0p + half * 8) = w;
        }
        if (lane < 32) { u32x4 w = (u32x4){0u, 0u, 0u, 0u};
            if (lane < GL / 8) { const int c = OFF_GD + lane * 8; float xv[8], pv[8], nv[8];
                unpack8(*(const u32x4*)(zr + c), xv);
                if (hp) unpack8(*(const u32x4*)(zr - Z1_N + c), pv); else {
#pragma unroll
                    for (int j = 0; j < 8; ++j) pv[j] = 0.f; }
                if (hn) unpack8(*(const u32x4*)(zr + Z1_N + c), nv); else {
#pragma unroll
                    for (int j = 0; j < 8; ++j) nv[j] = 0.f; }
                float o[8];
#pragma unroll
                for (int j = 0; j < 8; ++j) o[j] = fast_sigmoid(xv[j] + mg0[j] * (pv[j] - xv[j]) + mg1[j] * (nv[j] - xv[j]));
                w.x = cvt_pk_bf16(o[0], o[1]); w.y = cvt_pk_bf16(o[2], o[3]); w.z = cvt_pk_bf16(o[4], o[5]); w.w = cvt_pk_bf16(o[6], o[7]); }
            *(u32x4*)(p.Ag + (size_t)r * AG_K + lane * 8) = w; }
    }
}
#define MK_FR_ROW(f) ((((f) >> 3) * HALF) + wr * 64 + ((((f) >> 1) & 3) * 16) + fr)
#define MK_FR_COL(f) ((((f) & 1) * HALF) + wc * 32 + 8 * fq)
#define MK_FR_ACC(f, n) acc[(f) >> 3][(f) & 1][((f) >> 1) & 3][n]
#define MK_FENCE asm volatile("" ::: "memory")
struct EpiYa { const bf16_t* yn; bf16_t* ya;
    __device__ __forceinline__ bool operator()(f32x4 (&acc)[2][2][4][2], const Unit& u, int wr, int wc, int fr, int fq) const {
        const size_t base = (size_t)(u.pm * BM) * RW + u.pn * BM;
        u32x4 cur = *(const u32x4*)(yn + base + (size_t)MK_FR_ROW(0) * RW + MK_FR_COL(0));
#pragma unroll
        for (int f = 0; f < 16; ++f) { u32x4 nxt = cur; if (f + 1 < 16) nxt = *(const u32x4*)(yn + base + (size_t)MK_FR_ROW(f + 1) * RW + MK_FR_COL(f + 1));
            MK_FENCE; float v[8]; unpack8(cur, v); f32x4 a = MK_FR_ACC(f, 0), b = MK_FR_ACC(f, 1);
#pragma unroll
            for (int j = 0; j < 4; ++j) { a[j] *= v[j]; b[j] *= v[4 + j]; }
            *(u32x4*)(ya + base + (size_t)MK_FR_ROW(f) * RW + MK_FR_COL(f)) = pack8(a, b); MK_FENCE; cur = nxt; }
        return false; } };
struct EpiZc { const bf16_t* Hd; bf16_t* yb; bf16_t* gates; int nlat; int pad_;
    __device__ __forceinline__ bool operator()(f32x4 (&acc)[2][2][4][2], const Unit& u, int wr, int wc, int fr, int fq) const {
        if (u.pn < LW / BM) {
            MK_FRAG_LOOP(r, c) { const size_t o = (size_t)(u.pm * BM + r) * LW + u.pn * BM + c; float h0[8], h1[8]; unpack8(*(const u32x4*)(Hd + o), h0); unpack8(*(const u32x4*)(Hd + (size_t)nlat * LW + o), h1);
                f32x4 a = acc[ai][bj][m][0], b = acc[ai][bj][m][1];
#pragma unroll
                for (int j = 0; j < 4; ++j) { a[j] = gelu_tanhf_(a[j]) * (h0[j] + h1[j]); b[j] = gelu_tanhf_(b[j]) * (h0[4 + j] + h1[4 + j]); }
                *(u32x4*)(yb + o) = pack8(a, b); asm volatile("" ::: "memory"); }
        } else {
            MK_FRAG_LOOP(r, c) { const size_t o = (size_t)(u.pm * BM + r) * (2 * D) + (u.pn * BM - LW) + c;
                f32x4 a = acc[ai][bj][m][0], b = acc[ai][bj][m][1];
#pragma unroll
                for (int j = 0; j < 4; ++j) { a[j] = fast_sigmoid(a[j]); b[j] = fast_sigmoid(b[j]); }
                *(u32x4*)(gates + o) = pack8(a, b); }
        }
        return false; } };
struct PairOrder { StaticOrder S;
    __device__ bool next(int i, Unit& u) const { if (!S.next(i >> 1, u)) return false; u.e = i & 1; return true; } };
struct EpiBranch { const bf16_t* gates; bf16_t* mixed;
    __device__ __forceinline__ bool operator()(f32x4 (&acc)[2][2][4][2], const Unit& u, int wr, int wc, int fr, int fq) const {
        const size_t gbase = (size_t)(u.pm * BM) * (2 * D) + u.pn * BM, mbase = (size_t)(u.pm * BM) * D + u.pn * BM;
        u32x4 c1 = (u32x4){0u, 0u, 0u, 0u}, c2 = *(const u32x4*)(gates + gbase + (size_t)MK_FR_ROW(0) * (2 * D) + D + MK_FR_COL(0));
        if (u.e == 0) c1 = *(const u32x4*)(gates + gbase + (size_t)MK_FR_ROW(0) * (2 * D) + MK_FR_COL(0));
#pragma unroll
        for (int f = 0; f < 16; ++f) { u32x4 n1 = c1, n2 = c2;
            if (f + 1 < 16) { const size_t o = gbase + (size_t)MK_FR_ROW(f + 1) * (2 * D) + MK_FR_COL(f + 1); n2 = *(const u32x4*)(gates + o + D); if (u.e == 0) n1 = *(const u32x4*)(gates + o); }
            MK_FENCE; float g1[8], g2[8]; unpack8(c1, g1); unpack8(c2, g2);
            if (u.e == 0) {
#pragma unroll
                for (int j = 0; j < 4; ++j) { MK_FR_ACC(f, 0)[j] *= g1[j] / g2[j]; MK_FR_ACC(f, 1)[j] *= g1[4 + j] / g2[4 + j]; }
            } else { f32x4 a = MK_FR_ACC(f, 0), b = MK_FR_ACC(f, 1);
#pragma unroll
                for (int j = 0; j < 4; ++j) { a[j] *= g2[j]; b[j] *= g2[4 + j]; }
                *(u32x4*)(mixed + mbase + (size_t)MK_FR_ROW(f) * D + MK_FR_COL(f)) = pack8(a, b); }
            MK_FENCE; c1 = n1; c2 = n2; }
        return u.e == 0; } };
struct EpiF32 { float* C; long ldc;
    __device__ __forceinline__ bool operator()(f32x4 (&acc)[2][2][4][2], const Unit& u, int wr, int wc, int fr, int fq) const {
        MK_FRAG_LOOP(r, c) { float* o = C + (size_t)(u.pm * BM + r) * ldc + u.pn * BM + c; *(f32x4*)o = acc[ai][bj][m][0]; *(f32x4*)(o + 4) = acc[ai][bj][m][1]; }
        return false; } };
}

namespace mk {
constexpr int NEX = NE + 1;
constexpr int SLOTS_PER_TOK = TOPK + 1;
constexpr int RP_MOD = 0;
constexpr int RP_UH = RP_MOD + 3 * D * 4;
constexpr int RP_UL = RP_UH + 16 * (D + 8) * 2;
constexpr int RP_PART = RP_UL + 16 * (D + 8) * 2;
constexpr int RP_LOG = RP_PART + 8 * 16 * 64 * 4;
constexpr int RP_HIST = RP_LOG + 16 * 64 * 4;
constexpr int RP_END = RP_HIST + 64 * 4;
static_assert(RP_END <= LDS_BYTES, "rowpass LDS");

struct RowP { float* y2h1; bf16_t* u; const float* modpart; const bf16_t* rwt;
              int* tope; float* gatev; int* lrank; int* blkcnt; int b0, nlat; };
__device__ __forceinline__ float wave_max(float x) {
#pragma unroll
    for (int o = 32; o > 0; o >>= 1) x = fmaxf(x, __shfl_xor(x, o));
    return x; }
__device__ __forceinline__ void row_pass(LAS unsigned char* lds, const In& in, const RowP p, int row_lo, int row_hi, bool dry = false) {
    const int tid = threadIdx.x, lane = tid & 63, wid = tid >> 6;
    LAS float* MOD = (LAS float*)(lds + RP_MOD); LAS bf16_t* UH = (LAS bf16_t*)(lds + RP_UH); LAS bf16_t* UL = (LAS bf16_t*)(lds + RP_UL);
    LAS float* PART = (LAS float*)(lds + RP_PART); LAS float* LOG = (LAS float*)(lds + RP_LOG); LAS int* HIST = (LAS int*)(lds + RP_HIST);
    const int mr = p.b0 + row_lo / SEQ;
    for (int j = tid; j < 3 * D; j += NT) MOD[j] = mod_value(in, p.modpart, mr, 2 * D + j);
    if (tid < 64) HIST[tid] = 0;
    __syncthreads();
    float gp1[16], gp2[16];
#pragma unroll
    for (int j = 0; j < 4; ++j)
#pragma unroll
        for (int q = 0; q < 4; ++q) { gp1[4 * j + q] = in.norm_g[D + j * 256 + lane * 4 + q]; gp2[4 * j + q] = in.norm_g[2 * D + j * 256 + lane * 4 + q]; }
    for (int r16 = row_lo; r16 < row_hi; r16 += 16) {
#pragma unroll
        for (int rr = 0; rr < 2; ++rr) {
            const int lr = wid * 2 + rr, r = r16 + lr;
            float* yp = p.y2h1 + (size_t)r * D; const float* xp = in.x + ((size_t)p.b0 * SEQ + r) * D;
            f32x4 v[4]; float ss = 0.f;
#pragma unroll
            for (int j = 0; j < 4; ++j) { v[j] = *(const f32x4*)(yp + j * 256 + lane * 4); ss += v[j][0] * v[j][0] + v[j][1] * v[j][1] + v[j][2] * v[j][2] + v[j][3] * v[j][3]; }
#pragma unroll
            for (int o = 32; o > 0; o >>= 1) ss += __shfl_xor(ss, o);
            const float rinv = 1.f / sqrtf(ss * (1.f / D) + NORM_EPS); float s2 = 0.f;
#pragma unroll
            for (int j = 0; j < 4; ++j) { const int c = j * 256 + lane * 4; const f32x4 xv = *(const f32x4*)(xp + c);
#pragma unroll
                for (int q = 0; q < 4; ++q) { const float hv = xv[q] + MOD[c + q] * (v[j][q] * rinv * gp1[4 * j + q]); v[j][q] = hv; s2 += hv * hv; }
                if (!dry) *(f32x4*)(yp + c) = v[j]; }
#pragma unroll
            for (int o = 32; o > 0; o >>= 1) s2 += __shfl_xor(s2, o);
            const float r2 = 1.f / sqrtf(s2 * (1.f / D) + NORM_EPS);
#pragma unroll
            for (int j = 0; j < 4; ++j) { const int c = j * 256 + lane * 4; float uu[4], lo[4]; unsigned hw[2];
#pragma unroll
                for (int q = 0; q < 4; ++q) uu[q] = (v[j][q] * r2 * gp2[4 * j + q]) * (1.f + MOD[2 * D + c + q]) + MOD[D + c + q];
                hw[0] = cvt_pk_bf16(uu[0], uu[1]); hw[1] = cvt_pk_bf16(uu[2], uu[3]);
                lo[0] = uu[0] - bflo(hw[0]); lo[1] = uu[1] - bfhi(hw[0]); lo[2] = uu[2] - bflo(hw[1]); lo[3] = uu[3] - bfhi(hw[1]);
                u32x2 w; w.x = hw[0]; w.y = hw[1]; *(u32x2*)(p.u + (size_t)r * D + c) = w; *(LAS u32x2*)(UH + lr * (D + 8) + c) = w;
                u32x2 wl; wl.x = cvt_pk_bf16(lo[0], lo[1]); wl.y = cvt_pk_bf16(lo[2], lo[3]); *(LAS u32x2*)(UL + lr * (D + 8) + c) = wl; }
        }
        __syncthreads();
        { const int fr = lane & 15, fq = lane >> 4;
          f32x4 acc[4];
#pragma unroll
          for (int ct = 0; ct < 4; ++ct) acc[ct] = (f32x4){0.f, 0.f, 0.f, 0.f};
#pragma unroll
          for (int ks = 0; ks < 4; ++ks) { const int k0 = wid * 128 + ks * 32 + fq * 8;
              const bf16x8 ah = *(const LAS bf16x8*)(UH + fr * (D + 8) + k0), al = *(const LAS bf16x8*)(UL + fr * (D + 8) + k0);
#pragma unroll
              for (int ct = 0; ct < 4; ++ct) { const bf16x8 bh = *(const bf16x8*)(p.rwt + (size_t)(ct * 16 + fr) * D + k0), bl = *(const bf16x8*)(p.rwt + (size_t)(NE + ct * 16 + fr) * D + k0);
                  acc[ct] = __builtin_amdgcn_mfma_f32_16x16x32_bf16(ah, bh, acc[ct], 0, 0, 0); acc[ct] = __builtin_amdgcn_mfma_f32_16x16x32_bf16(ah, bl, acc[ct], 0, 0, 0); acc[ct] = __builtin_amdgcn_mfma_f32_16x16x32_bf16(al, bh, acc[ct], 0, 0, 0); } }
#pragma unroll
          for (int ct = 0; ct < 4; ++ct)
#pragma unroll
              for (int i = 0; i < 4; ++i) PART[(wid * 16 + fq * 4 + i) * 64 + ct * 16 + fr] = acc[ct][i]; }
        __syncthreads();
        for (int i = tid; i < 16 * 64; i += NT) { float s = 0.f;
#pragma unroll
            for (int w = 0; w < 8; ++w) s += PART[w * 1024 + i];
            LOG[i] = s; }
        __syncthreads();
#pragma unroll 1
        for (int rr = 0; rr < 2; ++rr) {
            const int lr = wid * 2 + rr, r = r16 + lr;
            const float sc = sigmoidf_(LOG[lr * 64 + lane]), bi = sc + in.router_b[lane];
            float m1 = bi; m1 = fmaxf(m1, __shfl_xor(m1, 1)); m1 = fmaxf(m1, __shfl_xor(m1, 2)); m1 = fmaxf(m1, __shfl_xor(m1, 4));
            const unsigned long long eq = __ballot(bi == m1); const int first = __ffsll((long long)((eq >> (lane & ~7)) & 0xffull)) - 1 + (lane & ~7);
            float m2 = (lane == first) ? -1e30f : bi; m2 = fmaxf(m2, __shfl_xor(m2, 1)); m2 = fmaxf(m2, __shfl_xor(m2, 2)); m2 = fmaxf(m2, __shfl_xor(m2, 4));
            const float gs = m1 + m2; const int myg = lane >> 3; int rank = 0;
#pragma unroll
            for (int g = 0; g < NG; ++g) { const float og = __shfl(gs, g * 8); rank += (og > gs || (og == gs && g < myg)) ? 1 : 0; }
            float cand = rank < TG ? bi : -1e30f; float tsum = 0.f; int myidx = 0; float mysc = 0.f;
#pragma unroll
            for (int it = 0; it < TOPK; ++it) { const float m = wave_max(cand); const unsigned long long bm = __ballot(cand == m); const int win = __ffsll((long long)bm) - 1;
                const float ws = __shfl(sc, win); tsum += ws; if (lane == it) { myidx = win; mysc = ws; } if (lane == win) cand = -1e30f; }
            if (lane < TOPK) { const int rk = atomicAdd((int*)&HIST[myidx], 1);
                p.tope[(size_t)r * TOPK + lane] = myidx; p.gatev[(size_t)r * TOPK + lane] = mysc / tsum * 2.5f; p.lrank[(size_t)r * TOPK + lane] = rk; }
        }
        __syncthreads();
    }
    if (tid < 64) p.blkcnt[blockIdx.x * 64 + tid] = HIST[tid];
}

struct MoeP { const int* tope; const float* gatev; const int* lrank; const int* blkcnt;
              int* tilepre;
              int* list;
              int* sdst;
              float* sgate;
              int r0, nr, blk0, nbh, rpb, pad_; };
__device__ __forceinline__ void moe_assign(LAS unsigned char* lds, const MoeP p, int bid, int nblk) {
    LAS int* BASE = (LAS int*)lds; LAS int* CNT = BASE + 80; LAS int* BOFF = CNT + 80;
    const int tid = threadIdx.x;
    if (tid < NE) { int c = 0, bo = 0; for (int b = 0; b < p.nbh; ++b) { const int v = p.blkcnt[(p.blk0 + b) * 64 + tid]; if (p.blk0 + b < bid) bo += v; c += v; } CNT[tid] = c; BOFF[tid] = bo; }
    __syncthreads();
    if (tid == 0) { int s = 0; for (int e = 0; e < NE; ++e) { BASE[e] = s; s += (CNT[e] + BM - 1) / BM * BM; } BASE[NE] = s; CNT[NE] = p.nr; BASE[NE + 1] = s + p.nr;
        if (bid == 0) { for (int e = 0; e <= NEX; ++e) p.tilepre[e] = BASE[e] / BM; } }
    __syncthreads();
    if (bid >= p.blk0 && bid < p.blk0 + p.nbh) {
        const int rlo = p.r0 + (bid - p.blk0) * p.rpb;
        for (int i = tid; i < p.rpb * TOPK; i += NT) { const int r = rlo + i / TOPK, a = r * TOPK + i % TOPK, e = p.tope[a]; const int slot = BASE[e] + BOFF[e] + p.lrank[a];
            p.list[slot] = r; p.sdst[slot] = (r - p.r0) * SLOTS_PER_TOK + i % TOPK; p.sgate[slot] = p.gatev[a]; }
        for (int i = tid; i < p.rpb; i += NT) { const int r = rlo + i, slot = BASE[NE] + (r - p.r0); p.list[slot] = r; p.sdst[slot] = (r - p.r0) * SLOTS_PER_TOK + TOPK; p.sgate[slot] = 1.f; }
    }
    for (int e = bid; e < NE; e += nblk) { const int lo = BASE[e] + CNT[e], hi = BASE[e + 1]; for (int s = lo + tid; s < hi; s += NT) { p.list[s] = p.r0; p.sdst[s] = -1; p.sgate[s] = 0.f; } }
}
struct GroupOrder { int tpn, total, nN, G, c;
    __device__ void init(const int* tilepre, int nN_, int G_, int c_) { const int lane = threadIdx.x & 63;
        tpn = (int)__hip_atomic_load((const unsigned*)tilepre + lane + 1, __ATOMIC_RELAXED, __HIP_MEMORY_SCOPE_AGENT);
        total = (int)__hip_atomic_load((const unsigned*)tilepre + NEX, __ATOMIC_RELAXED, __HIP_MEMORY_SCOPE_AGENT); nN = nN_; G = G_; c = c_; }
    __device__ bool next(int i, Unit& u) const { const long L = (long)i * G + c; if (L >= (long)total * nN) return false;
        const int T = (int)(L / nN); const int e = __popcll(__ballot(tpn <= T));
        u.pm = T; u.pn = (int)(L % nN); u.e = __builtin_amdgcn_readfirstlane(e); return true; } };
struct EpiGU { bf16_t* act;
    __device__ __forceinline__ bool operator()(f32x4 (&acc)[2][2][4][2], const Unit& u, int wr, int wc, int fr, int fq) const {
        MK_FRAG_LOOP(r, c) { const f32x4 a = acc[ai][bj][m][0], b = acc[ai][bj][m][1];
            u32x2 w; w.x = cvt_pk_bf16(fast_silu(a[0]) * a[1], fast_silu(a[2]) * a[3]); w.y = cvt_pk_bf16(fast_silu(b[0]) * b[1], fast_silu(b[2]) * b[3]);
            *(u32x2*)(act + (size_t)(u.pm * BM + r) * EF + ((u.pn * BM + c) >> 1)) = w; }
        return false; } };
struct EpiDown { const int* sdst; const float* sgate; bf16_t* rowsb;
    __device__ __forceinline__ bool operator()(f32x4 (&acc)[2][2][4][2], const Unit& u, int wr, int wc, int fr, int fq) const {
        int dst[8]; float gt[8];
#pragma unroll
        for (int q = 0; q < 8; ++q) { const int slot = u.pm * BM + (q >> 2) * HALF + wr * 64 + (q & 3) * 16 + fr; dst[q] = sdst[slot]; gt[q] = sgate[slot]; }
#pragma unroll
        for (int ai = 0; ai < 2; ++ai)
#pragma unroll
            for (int m = 0; m < 4; ++m) { const int q = ai * 4 + m; if (dst[q] >= 0) {
#pragma unroll
                for (int bj = 0; bj < 2; ++bj) { f32x4 a = acc[ai][bj][m][0], b = acc[ai][bj][m][1];
#pragma unroll
                    for (int j = 0; j < 4; ++j) { a[j] *= gt[q]; b[j] *= gt[q]; }
                    *(u32x4*)(rowsb + (size_t)dst[q] * D + u.pn * BM + bj * HALF + wc * 32 + 8 * fq) = pack8(a, b); } } }
        return false; } };
__device__ __forceinline__ void final_rows(LAS float* sm  , const In& in, const float* modpart, const bf16_t* rowsb, float* h1out, int b0, int r0, int row_lo, int row_hi, bool dry = false) {
    const int tid = threadIdx.x, lane = tid & 63, wid = tid >> 6;
    const int mr = b0 + row_lo / SEQ;
    __syncthreads();
    for (int j = tid; j < D; j += NT) sm[j] = mod_value(in, modpart, mr, 5 * D + j);
    __syncthreads();
    float gq[16];
#pragma unroll
    for (int j = 0; j < 4; ++j)
#pragma unroll
        for (int q = 0; q < 4; ++q) gq[4 * j + q] = sm[j * 256 + lane * 4 + q] * in.norm_g[3 * D + j * 256 + lane * 4 + q];
    for (int r = row_lo + wid; r < row_hi; r += NT / 64) {
        float v[16];
#pragma unroll
        for (int j = 0; j < 16; ++j) v[j] = 0.f;
        const bf16_t* rb = rowsb + (size_t)(r - r0) * SLOTS_PER_TOK * D;
#pragma unroll
        for (int s = 0; s < SLOTS_PER_TOK; ++s)
#pragma unroll
            for (int j = 0; j < 4; ++j) { const u32x2 w = *(const u32x2*)(rb + (size_t)s * D + j * 256 + lane * 4); v[4 * j] += bflo(w.x); v[4 * j + 1] += bfhi(w.x); v[4 * j + 2] += bflo(w.y); v[4 * j + 3] += bfhi(w.y); }
        float ss = 0.f;
#pragma unroll
        for (int j = 0; j < 16; ++j) ss += v[j] * v[j];
#pragma unroll
        for (int o = 32; o > 0; o >>= 1) ss += __shfl_xor(ss, o);
        const float rinv = 1.f / sqrtf(ss * (1.f / D) + NORM_EPS);
        float* hp = h1out + (size_t)r * D;
#pragma unroll
        for (int j = 0; j < 4; ++j) { const int c = j * 256 + lane * 4; f32x4 hv = *(const f32x4*)(hp + c);
#pragma unroll
            for (int q = 0; q < 4; ++q) hv[q] += gq[4 * j + q] * (v[4 * j + q] * rinv);
            if (!dry) *(f32x4*)(hp + c) = hv; else if (hv[0] == 1.2345e30f) *(f32x4*)(hp + c) = hv; }
    }
}
__device__ __forceinline__ void rwt_prep(const In& in, bf16_t* rwt, int bid, int nblk) {
    for (int i = bid * NT + threadIdx.x; i < NE * D; i += nblk * NT) { const int e = i / D, k = i % D; const float w = in.router_w[(size_t)k * NE + e]; const bf16_t h = f2bf(w); rwt[i] = h; rwt[(size_t)NE * D + i] = f2bf(w - bf2f(h)); }
}
}

using namespace mk;
constexpr size_t MiB = (size_t)1 << 20;
constexpr int NLAT = NB * SEQ, NCTXR = NB * CTX, NALL = NLAT + NCTXR, NRH = NLAT / 2, MAXSLOTS = NRH * SLOTS_PER_TOK + NE * BM;
constexpr size_t O_W1A = 0, O_W1C = O_W1A + (size_t)Z1_N * D * 2, O_WG = O_W1C + (size_t)ZC_N * D * 2, O_WBR = O_WG + (size_t)RW * AG_K * 2, O_WOUT = O_WBR + (size_t)2 * D * RW * 2,
                 O_RWT = O_WOUT + (size_t)D * D * 2, O_MODP = O_RWT + (size_t)2 * NE * D * 2, O_S_END = O_MODP + (size_t)MOD_SL * (NB + 1) * 6 * D * 4;
static_assert(O_S_END <= 27 * MiB, "S region");
constexpr size_t O_BAR = 27 * MiB;
constexpr size_t O_Z1 = 28 * MiB, O_R2 = O_Z1 + (size_t)NALL * Z1_N * 2;
static_assert(O_R2 == 334 * MiB, "z1 size");
constexpr size_t O_HD = O_R2, O_BON = O_HD + (size_t)2 * NLAT * LW * 2, O_AG = O_BON + (size_t)2 * NLAT * NH * 4, O_R2_END = O_AG + (size_t)NLAT * AG_K * 2;
static_assert(O_R2_END <= 512 * MiB, "R2");
constexpr size_t O_XNL = O_Z1, O_YB = O_XNL + (size_t)NLAT * D * 2, O_GATES = O_YB + (size_t)NLAT * LW * 2, O_MIXED = O_HD;
static_assert(O_GATES + (size_t)NLAT * 2 * D * 2 <= O_R2, "late R1");
constexpr size_t O_U = O_Z1, O_WGU = O_U + (size_t)NLAT * D * 2, O_WDN = O_WGU + (size_t)NEX * 2 * EF * D * 2, O_ROUT = O_WDN + (size_t)NEX * D * EF * 2;
constexpr size_t O_TOPE = O_ROUT, O_LRANK = O_TOPE + (size_t)NLAT * TOPK * 4, O_GATEV = O_LRANK + (size_t)NLAT * TOPK * 4, O_BLKCNT = O_GATEV + (size_t)NLAT * TOPK * 4, O_TILEPRE = O_BLKCNT + 256 * 64 * 4,
                 O_LIST = O_TILEPRE + 1024, O_SDST = O_LIST + (size_t)MAXSLOTS * 4, O_SGATE = O_SDST + (size_t)MAXSLOTS * 4, O_ACT = ((O_SGATE + (size_t)MAXSLOTS * 4 + 255) / 256) * 256,
                 O_ROWSB = ((O_ACT + (size_t)MAXSLOTS * EF * 2 + 255) / 256) * 256, O_END = O_ROWSB + (size_t)NRH * SLOTS_PER_TOK * D * 2;
static_assert(O_END <= 512 * MiB, "workspace");
static_assert(O_WGU >= O_YB && O_ROWSB >= O_GATES, "late layout");

struct MP { In in; float* out; unsigned char* ws; long ph_lo, ph_hi; };
constexpr int NPHASE = 17;

#if defined(__HIP_DEVICE_COMPILE__)
#define MK_KARGS auto Pq_ = Pk_; asm volatile("" : "+s"(Pq_)); const MP* Pg_ = (const MP*)Pq_; const In in = Pg_->in; unsigned char* ws = Pg_->ws; float* out_ = Pg_->out; (void)out_;
#else
#define MK_KARGS const In in = P.in; unsigned char* ws = P.ws; float* out_ = P.out; (void)out_; (void)Pk_;
#endif
#define MK_PHASE_PTRS \
    MK_KARGS \
    bf16_t *W1a = (bf16_t*)(ws + O_W1A), *W1c = (bf16_t*)(ws + O_W1C), *Wg = (bf16_t*)(ws + O_WG), *Wbr = (bf16_t*)(ws + O_WBR), *Wout = (bf16_t*)(ws + O_WOUT), *rwt = (bf16_t*)(ws + O_RWT); \
    float* modpart = (float*)(ws + O_MODP); \
    bf16_t *z1 = (bf16_t*)(ws + O_Z1), *Hd = (bf16_t*)(ws + O_HD), *Ag = (bf16_t*)(ws + O_AG); float* bon = (float*)(ws + O_BON); \
    bf16_t *xnl = (bf16_t*)(ws + O_XNL), *yb = (bf16_t*)(ws + O_YB), *gates = (bf16_t*)(ws + O_GATES), *mixed = (bf16_t*)(ws + O_MIXED); \
    bf16_t *u = (bf16_t*)(ws + O_U), *Wgu = (bf16_t*)(ws + O_WGU), *Wdn = (bf16_t*)(ws + O_WDN), *act = (bf16_t*)(ws + O_ACT), *rowsb = (bf16_t*)(ws + O_ROWSB); \
    int *tope = (int*)(ws + O_TOPE), *lrank = (int*)(ws + O_LRANK), *blkcnt = (int*)(ws + O_BLKCNT), *tilepre = (int*)(ws + O_TILEPRE), *list = (int*)(ws + O_LIST), *sdst = (int*)(ws + O_SDST); \
    float *gatev = (float*)(ws + O_GATEV), *sgate = (float*)(ws + O_SGATE); \
    bf16_t* xn_all = (bf16_t*)out_; \
    bf16_t* Y = (bf16_t*)out_; \
    float* y2h1 = out_;
__global__ void __launch_bounds__(512, 2) mega(MP P) {
    extern __shared__ __attribute__((aligned(16))) unsigned char shm[];
    LAS unsigned char* lds = (LAS unsigned char*)shm;
    typedef const __attribute__((address_space(4))) MP* KargP;
    const KargP Pk_ = (KargP)__builtin_amdgcn_kernarg_segment_ptr();
    const int bid = blockIdx.x, nblk = gridDim.x;
    const int ph_lo = (int)P.ph_lo, ph_hi = (int)P.ph_hi;
    volatile LAS unsigned* xst = (volatile LAS unsigned*)(lds + LDS_BYTES - 16);
    if (threadIdx.x == 0) { xst[0] = 0u; xst[1] = 0u; }
    __syncthreads();
    const XcdBarrier xb = xcd_barrier_post((unsigned*)(P.ws + O_BAR), xst);
    if (0 >= ph_lo && 0 < ph_hi) { if (0 > ph_lo) xcd_barrier(xb); const int ph = 0; (void)ph; MK_PHASE_PTRS
        { LAS float* tile = (LAS float*)lds; int base = 0;
            convT_job(tile, in.w_in, INC, D, W1a, D, Z1_N, CMapZ1{}, bid, nblk, base);
            convT_job(tile, in.w_in, INC, D, W1c, D, ZC_N, CMapZC{}, bid, nblk, base);
            convT_job(tile, in.rw_g_up, RW, GL, Wg, AG_K, RW, CMapId{}, bid, nblk, base);
            convT_job(tile, in.w_branch_a, D, RW, Wbr, RW, D, CMapId{}, bid, nblk, base);
            convT_job(tile, in.w_branch_b, D, LW, Wbr + (size_t)D * RW, LW, D, CMapId{}, bid, nblk, base);
            convT_job(tile, in.w_out, D, D, Wout, D, D, CMapId{}, bid, nblk, base);
            rwt_prep(in, rwt, bid, nblk);
            mod_partials((LAS float*)lds, in, modpart, bid, nblk); }
    }
    if (1 >= ph_lo && 1 < ph_hi) { if (1 > ph_lo) xcd_barrier(xb); const int ph = 1; (void)ph; MK_PHASE_PTRS
        { const int L = NLAT / nblk, Lc = NCTXR / nblk;
            xn_rows((LAS float*)lds, in, modpart, xn_all, 0, NB, bid * L, (bid + 1) * L);
            xn_rows((LAS float*)lds, in, modpart, xn_all, 0, NB, NLAT + bid * Lc, NLAT + (bid + 1) * Lc); }
    }
    if (2 >= ph_lo && 2 < ph_hi) { if (2 > ph_lo) xcd_barrier(xb); const int ph = 2; (void)ph; MK_PHASE_PTRS
        { GemmP g{xn_all, xn_all, W1a, 0, nullptr, D, 0}; StaticOrder S; S.init(NALL, Z1_N, nblk, bid); gemm_phase(lds, g, S, EpiStoreBf16{z1, Z1_N}); }
    }
    if (3 >= ph_lo && 3 < ph_hi) { if (3 > ph_lo) xcd_barrier(xb); const int ph = 3; (void)ph; MK_PHASE_PTRS
        { LruP lp{z1, Hd, 0, NB}; lru_phase(lds, in, lp, bid, nblk); __syncthreads();
                  RwkvP rp{z1, Y, bon, 0, NB}; r3::rwkv_phase3(lds, in, rp, bid, nblk); }
    }
    if (4 >= ph_lo && 4 < ph_hi) { if (4 > ph_lo) xcd_barrier(xb); const int ph = 4; (void)ph; MK_PHASE_PTRS
        { const int L = NLAT / nblk; PostP pp{z1, Y, bon, Ag, NLAT, 0}; rwkv_post_rows(in, pp, bid * L, (bid + 1) * L); }
    }
    if (5 >= ph_lo && 5 < ph_hi) { if (5 > ph_lo) xcd_barrier(xb); const int ph = 5; (void)ph; MK_PHASE_PTRS
        { const int L = NLAT / nblk; xn_rows((LAS float*)lds, in, modpart, xnl, 0, NB, bid * L, (bid + 1) * L); __syncthreads();
                  GemmP g{Ag, Ag, Wg, 0, nullptr, AG_K, 0}; StaticOrder S; S.init(NLAT, RW, nblk, bid); gemm_phase(lds, g, S, EpiYa{Y, Y + (size_t)NLAT * RW}); }
    }
    if (6 >= ph_lo && 6 < ph_hi) { if (6 > ph_lo) xcd_barrier(xb); const int ph = 6; (void)ph; MK_PHASE_PTRS
        { GemmP g{xnl, xnl, W1c, 0, nullptr, D, 0}; StaticOrder S; S.init(NLAT, ZC_N, nblk, bid); gemm_phase(lds, g, S, EpiZc{Hd, yb, gates, NLAT, 0}); }
    }
    if (7 >= ph_lo && 7 < ph_hi) { if (7 > ph_lo) xcd_barrier(xb); const int ph = 7; (void)ph; MK_PHASE_PTRS
        { GemmP g{Y + (size_t)NLAT * RW, yb, Wbr, (long)D * RW, nullptr, D, 0}; PairOrder S; S.S.init(NLAT, D, nblk, bid); gemm_phase(lds, g, S, EpiBranch{gates, mixed}); }
    }
    if (8 >= ph_lo && 8 < ph_hi) { if (8 > ph_lo) xcd_barrier(xb); const int ph = 8; (void)ph; MK_PHASE_PTRS
        { LAS float* tile = (LAS float*)lds;
            struct MGU { const float* ex; const float* sh; bf16_t* d; __device__ const float* src(int m) const { return m < NE ? ex + (size_t)m * D * 2 * EF : sh; } __device__ bf16_t* dst(int m) const { return d + (size_t)m * 2 * EF * D; } };
            struct MDN { const float* ex; const float* sh; bf16_t* d; __device__ const float* src(int m) const { return m < NE ? ex + (size_t)m * EF * D : sh; } __device__ bf16_t* dst(int m) const { return d + (size_t)m * D * EF; } };
            auto conv = [&]() __attribute__((always_inline)) {
                convT_multi(tile, MGU{in.ex_w_gu, in.sh_w_gu, Wgu}, NEX, 2 * EF, D, D, 2 * EF, CMapGU{EF}, bid, nblk);
                convT_multi(tile, MDN{in.ex_w_down, in.sh_w_down, Wdn}, NEX, D, EF, EF, D, CMapId{}, bid, nblk); };
            if (bid & 1) { conv(); __syncthreads(); }
            { GemmP g{mixed, mixed, Wout, 0, nullptr, D, 0}; StaticOrder S; S.init(NLAT, D, nblk, bid); gemm_phase(lds, g, S, EpiF32{y2h1, D}); }
            if (!(bid & 1)) { __syncthreads(); conv(); } }
    }
    if (9 >= ph_lo && 9 < ph_hi) { if (9 > ph_lo) xcd_barrier(xb); const int ph = 9; (void)ph; MK_PHASE_PTRS
        { const int L = NLAT / nblk; RowP rp{y2h1, u, modpart, rwt, tope, gatev, lrank, blkcnt, 0, NLAT}; row_pass(lds, in, rp, bid * L, (bid + 1) * L); }
    }
    if (10 >= ph_lo && 10 < ph_hi) { if (10 > ph_lo) xcd_barrier(xb); const int ph = 10; (void)ph; MK_PHASE_PTRS
        { const int q = ph - 10, half = q >= 4 ? 1 : 0, st = q - 4 * half;
            const int rpb = NLAT / nblk;
            auto assign = [&](int hf) { MoeP mp{tope, gatev, lrank, blkcnt, tilepre, list, sdst, sgate, hf * NRH, NRH, hf * (nblk / 2), nblk / 2, rpb, 0}; moe_assign(lds, mp, bid, nblk); };
            auto fin = [&](int hf) { const int L = NRH / nblk, r0 = hf * NRH; final_rows((LAS float*)lds, in, modpart, rowsb, y2h1, 0, r0, r0 + bid * L, r0 + (bid + 1) * L); };
            if (ph == 10) assign(0);
            else if (ph == 11 || ph == 14) { GemmP g{u, u, Wgu, (long)2 * EF * D, list, D, 0}; GroupOrder S; S.init(tilepre, 2 * EF / BM, nblk, bid); gemm_phase<true>(lds, g, S, EpiGU{act}); }
            else if (ph == 12 || ph == 15) { GemmP g{act, act, Wdn, (long)D * EF, nullptr, EF, 0}; GroupOrder S; S.init(tilepre, D / BM, nblk, bid); gemm_phase(lds, g, S, EpiDown{sdst, sgate, rowsb}); }
            else if (ph == 13) { fin(0); __syncthreads(); assign(1); }
            else if (ph == 16) fin(1);
            (void)half; (void)st; }
    }
    if (11 >= ph_lo && 11 < ph_hi) { if (11 > ph_lo) xcd_barrier(xb); const int ph = 11; (void)ph; MK_PHASE_PTRS
        { const int q = ph - 10, half = q >= 4 ? 1 : 0, st = q - 4 * half;
            const int rpb = NLAT / nblk;
            auto assign = [&](int hf) { MoeP mp{tope, gatev, lrank, blkcnt, tilepre, list, sdst, sgate, hf * NRH, NRH, hf * (nblk / 2), nblk / 2, rpb, 0}; moe_assign(lds, mp, bid, nblk); };
            auto fin = [&](int hf) { const int L = NRH / nblk, r0 = hf * NRH; final_rows((LAS float*)lds, in, modpart, rowsb, y2h1, 0, r0, r0 + bid * L, r0 + (bid + 1) * L); };
            if (ph == 10) assign(0);
            else if (ph == 11 || ph == 14) { GemmP g{u, u, Wgu, (long)2 * EF * D, list, D, 0}; GroupOrder S; S.init(tilepre, 2 * EF / BM, nblk, bid); gemm_phase<true>(lds, g, S, EpiGU{act}); }
            else if (ph == 12 || ph == 15) { GemmP g{act, act, Wdn, (long)D * EF, nullptr, EF, 0}; GroupOrder S; S.init(tilepre, D / BM, nblk, bid); gemm_phase(lds, g, S, EpiDown{sdst, sgate, rowsb}); }
            else if (ph == 13) { fin(0); __syncthreads(); assign(1); }
            else if (ph == 16) fin(1);
            (void)half; (void)st; }
    }
    if (12 >= ph_lo && 12 < ph_hi) { if (12 > ph_lo) xcd_barrier(xb); const int ph = 12; (void)ph; MK_PHASE_PTRS
        { const int q = ph - 10, half = q >= 4 ? 1 : 0, st = q - 4 * half;
            const int rpb = NLAT / nblk;
            auto assign = [&](int hf) { MoeP mp{tope, gatev, lrank, blkcnt, tilepre, list, sdst, sgate, hf * NRH, NRH, hf * (nblk / 2), nblk / 2, rpb, 0}; moe_assign(lds, mp, bid, nblk); };
            auto fin = [&](int hf) { const int L = NRH / nblk, r0 = hf * NRH; final_rows((LAS float*)lds, in, modpart, rowsb, y2h1, 0, r0, r0 + bid * L, r0 + (bid + 1) * L); };
            if (ph == 10) assign(0);
            else if (ph == 11 || ph == 14) { GemmP g{u, u, Wgu, (long)2 * EF * D, list, D, 0}; GroupOrder S; S.init(tilepre, 2 * EF / BM, nblk, bid); gemm_phase<true>(lds, g, S, EpiGU{act}); }
            else if (ph == 12 || ph == 15) { GemmP g{act, act, Wdn, (long)D * EF, nullptr, EF, 0}; GroupOrder S; S.init(tilepre, D / BM, nblk, bid); gemm_phase(lds, g, S, EpiDown{sdst, sgate, rowsb}); }
            else if (ph == 13) { fin(0); __syncthreads(); assign(1); }
            else if (ph == 16) fin(1);
            (void)half; (void)st; }
    }
    if (13 >= ph_lo && 13 < ph_hi) { if (13 > ph_lo) xcd_barrier(xb); const int ph = 13; (void)ph; MK_PHASE_PTRS
        { const int q = ph - 10, half = q >= 4 ? 1 : 0, st = q - 4 * half;
            const int rpb = NLAT / nblk;
            auto assign = [&](int hf) { MoeP mp{tope, gatev, lrank, blkcnt, tilepre, list, sdst, sgate, hf * NRH, NRH, hf * (nblk / 2), nblk / 2, rpb, 0}; moe_assign(lds, mp, bid, nblk); };
            auto fin = [&](int hf) { const int L = NRH / nblk, r0 = hf * NRH; final_rows((LAS float*)lds, in, modpart, rowsb, y2h1, 0, r0, r0 + bid * L, r0 + (bid + 1) * L); };
            if (ph == 10) assign(0);
            else if (ph == 11 || ph == 14) { GemmP g{u, u, Wgu, (long)2 * EF * D, list, D, 0}; GroupOrder S; S.init(tilepre, 2 * EF / BM, nblk, bid); gemm_phase<true>(lds, g, S, EpiGU{act}); }
            else if (ph == 12 || ph == 15) { GemmP g{act, act, Wdn, (long)D * EF, nullptr, EF, 0}; GroupOrder S; S.init(tilepre, D / BM, nblk, bid); gemm_phase(lds, g, S, EpiDown{sdst, sgate, rowsb}); }
            else if (ph == 13) { fin(0); __syncthreads(); assign(1); }
            else if (ph == 16) fin(1);
            (void)half; (void)st; }
    }
    if (14 >= ph_lo && 14 < ph_hi) { if (14 > ph_lo) xcd_barrier(xb); const int ph = 14; (void)ph; MK_PHASE_PTRS
        { const int q = ph - 10, half = q >= 4 ? 1 : 0, st = q - 4 * half;
            const int rpb = NLAT / nblk;
            auto assign = [&](int hf) { MoeP mp{tope, gatev, lrank, blkcnt, tilepre, list, sdst, sgate, hf * NRH, NRH, hf * (nblk / 2), nblk / 2, rpb, 0}; moe_assign(lds, mp, bid, nblk); };
            auto fin = [&](int hf) { const int L = NRH / nblk, r0 = hf * NRH; final_rows((LAS float*)lds, in, modpart, rowsb, y2h1, 0, r0, r0 + bid * L, r0 + (bid + 1) * L); };
            if (ph == 10) assign(0);
            else if (ph == 11 || ph == 14) { GemmP g{u, u, Wgu, (long)2 * EF * D, list, D, 0}; GroupOrder S; S.init(tilepre, 2 * EF / BM, nblk, bid); gemm_phase<true>(lds, g, S, EpiGU{act}); }
            else if (ph == 12 || ph == 15) { GemmP g{act, act, Wdn, (long)D * EF, nullptr, EF, 0}; GroupOrder S; S.init(tilepre, D / BM, nblk, bid); gemm_phase(lds, g, S, EpiDown{sdst, sgate, rowsb}); }
            else if (ph == 13) { fin(0); __syncthreads(); assign(1); }
            else if (ph == 16) fin(1);
            (void)half; (void)st; }
    }
    if (15 >= ph_lo && 15 < ph_hi) { if (15 > ph_lo) xcd_barrier(xb); const int ph = 15; (void)ph; MK_PHASE_PTRS
        { const int q = ph - 10, half = q >= 4 ? 1 : 0, st = q - 4 * half;
            const int rpb = NLAT / nblk;
            auto assign = [&](int hf) { MoeP mp{tope, gatev, lrank, blkcnt, tilepre, list, sdst, sgate, hf * NRH, NRH, hf * (nblk / 2), nblk / 2, rpb, 0}; moe_assign(lds, mp, bid, nblk); };
            auto fin = [&](int hf) { const int L = NRH / nblk, r0 = hf * NRH; final_rows((LAS float*)lds, in, modpart, rowsb, y2h1, 0, r0, r0 + bid * L, r0 + (bid + 1) * L); };
            if (ph == 10) assign(0);
            else if (ph == 11 || ph == 14) { GemmP g{u, u, Wgu, (long)2 * EF * D, list, D, 0}; GroupOrder S; S.init(tilepre, 2 * EF / BM, nblk, bid); gemm_phase<true>(lds, g, S, EpiGU{act}); }
            else if (ph == 12 || ph == 15) { GemmP g{act, act, Wdn, (long)D * EF, nullptr, EF, 0}; GroupOrder S; S.init(tilepre, D / BM, nblk, bid); gemm_phase(lds, g, S, EpiDown{sdst, sgate, rowsb}); }
            else if (ph == 13) { fin(0); __syncthreads(); assign(1); }
            else if (ph == 16) fin(1);
            (void)half; (void)st; }
    }
    if (16 >= ph_lo && 16 < ph_hi) { if (16 > ph_lo) xcd_barrier(xb); const int ph = 16; (void)ph; MK_PHASE_PTRS
        { const int q = ph - 10, half = q >= 4 ? 1 : 0, st = q - 4 * half;
            const int rpb = NLAT / nblk;
            auto assign = [&](int hf) { MoeP mp{tope, gatev, lrank, blkcnt, tilepre, list, sdst, sgate, hf * NRH, NRH, hf * (nblk / 2), nblk / 2, rpb, 0}; moe_assign(lds, mp, bid, nblk); };
            auto fin = [&](int hf) { const int L = NRH / nblk, r0 = hf * NRH; final_rows((LAS float*)lds, in, modpart, rowsb, y2h1, 0, r0, r0 + bid * L, r0 + (bid + 1) * L); };
            if (ph == 10) assign(0);
            else if (ph == 11 || ph == 14) { GemmP g{u, u, Wgu, (long)2 * EF * D, list, D, 0}; GroupOrder S; S.init(tilepre, 2 * EF / BM, nblk, bid); gemm_phase<true>(lds, g, S, EpiGU{act}); }
            else if (ph == 12 || ph == 15) { GemmP g{act, act, Wdn, (long)D * EF, nullptr, EF, 0}; GroupOrder S; S.init(tilepre, D / BM, nblk, bid); gemm_phase(lds, g, S, EpiDown{sdst, sgate, rowsb}); }
            else if (ph == 13) { fin(0); __syncthreads(); assign(1); }
            else if (ph == 16) fin(1);
            (void)half; (void)st; }
    }
}
extern "C" void kernel_launch(void* const* d_in, const int* in_sizes, int n_in, void* d_out, int out_size, void* d_ws, size_t ws_size, hipStream_t stream) {
    static int grid = 0;
    if (grid == 0) {
        int dev = 0, cus = 0; hipGetDevice(&dev); hipDeviceGetAttribute(&cus, hipDeviceAttributeMultiprocessorCount, dev);
        hipFuncSetAttribute((const void*)mega, hipFuncAttributeMaxDynamicSharedMemorySize, LDS_BYTES);
        grid = cus;
        if (ws_size < O_END || grid != 256) fprintf(stderr, "kernel_launch: unexpected ws_size %zu (need %zu) or CU count %d\n", ws_size, (size_t)O_END, grid);
    }
    hipMemsetAsync((char*)d_ws + O_BAR, 0, XCD_BAR_WORDS * 4, stream);
    MP P; memset(&P, 0, sizeof(P));
    const float** f = (const float**)&P.in; for (int i = 0; i < 32; ++i) f[i] = (const float*)d_in[i];
    P.out = (float*)d_out; P.ws = (unsigned char*)d_ws;
#ifdef MK_PER_PHASE
    for (int ph = 0; ph < NPHASE; ++ph) { P.ph_lo = ph; P.ph_hi = ph + 1; hipLaunchKernelGGL(mega, dim3(grid), dim3(NT), LDS_BYTES, stream, P); }
#else
    P.ph_lo = 0; P.ph_hi = NPHASE;
    void* args[] = {&P};
    hipError_t e = hipLaunchCooperativeKernel((void*)mega, dim3(grid), dim3(NT), args, LDS_BYTES, stream);
    if (e != hipSuccess) fprintf(stderr, "cooperative launch failed: %s (grid %d)\n", hipGetErrorString(e), grid);
#endif
}
```

```cpp
#include <hip/hip_runtime.h>
#include <cstdio>
#include <cstring>
#define HD __host__ __device__ __forceinline__
static hipStream_t g_stream;

#ifdef SMALL
constexpr int D = 128, NB = 2, SEQ = 64, GW = 8, CTX = 16, RW = 128, RH = 64, DL = 16, AL = 16, GL = 24, LW = 128, LB = 2, NE = 8, TOPK = 3, NG = 4, TG = 2, EF = 32, SF = 32;
#else
constexpr int D = 1024, NB = 8, SEQ = 4096, GW = 64, CTX = 256, RW = 1024, RH = 64, DL = 64, AL = 64, GL = 160, LW = 1024, LB = 16, NE = 64, TOPK = 6, NG = 8, TG = 4, EF = 256, SF = 256;
#endif
constexpr int NH = RW / RH, LBS = LW / LB, ROWS = SEQ / GW, TA = CTX + SEQ;
constexpr int OFF_R = 0, OFF_K = RW, OFF_V = 2 * RW, OFF_WD = 3 * RW, OFF_AD = OFF_WD + 2 * DL, OFF_GD = OFF_AD + 2 * AL, RC = OFF_GD + GL;
constexpr int OFF_LX = RC, OFF_LG = OFF_LX + LW, OFF_GATE = OFF_LG + LW, INC = OFF_GATE + 2 * D;
constexpr int EPG = NE / NG, NASG = SEQ * TOPK;
#define NORM_EPS 1e-6f
#define LNX_EPS 64e-5f

HD float sigmoidf_(float x) { return 1.f / (1.f + expf(-x)); }
HD float softplusf_(float x) { return x > 20.f ? x : log1pf(expf(x)); }
HD float siluf_(float x) { return x * sigmoidf_(x); }
HD float gelu_tanhf_(float x) { return 0.5f * x * (1.f + tanhf(0.7978845608028654f * (x + 0.044715f * x * x * x))); }

struct In {
    const float *x, *c, *ctx, *c_ctx, *w_mod, *b_mod, *norm_g, *w_in, *shift_mu, *rw_w0, *rw_w_up, *rw_a0, *rw_a_up, *rw_g_up, *rw_k_k, *rw_k_a, *rw_r_k, *rw_lnx,
        *lru_conv_w, *lru_conv_b, *lru_gate_w, *lru_gate_b, *lru_l, *w_branch_a, *w_branch_b, *w_out, *router_w, *router_b, *ex_w_gu, *ex_w_down, *sh_w_gu, *sh_w_down;
};


namespace mk {
#define LAS __attribute__((address_space(3)))
typedef unsigned short bf16_t;
typedef short bf16x8 __attribute__((ext_vector_type(8)));
typedef float f32x4 __attribute__((ext_vector_type(4)));
typedef float f32x2 __attribute__((ext_vector_type(2)));
typedef unsigned u32x4 __attribute__((ext_vector_type(4)));
typedef unsigned u32x2 __attribute__((ext_vector_type(2)));
constexpr int NT = 512;
constexpr int BM = 256, BK = 64, HALF = 128, HTB = HALF * BK * 2, STAGE_BYTES = 8 * HTB;
constexpr int LDS_BYTES = 160 * 1024 - 1024;

constexpr int Z1_LX = 3584, Z1_N = 4608;
constexpr int ZC_N = 3072;

__device__ __forceinline__ unsigned cvt_pk_bf16(float lo, float hi) { unsigned r; asm volatile("v_cvt_pk_bf16_f32 %0, %1, %2" : "=v"(r) : "v"(lo), "v"(hi)); return r; }
__device__ __forceinline__ bf16_t f2bf(float f) { unsigned u = __float_as_uint(f); u += 0x7FFFu + ((u >> 16) & 1u); return (bf16_t)(u >> 16); }
__device__ __forceinline__ float bf2f(bf16_t b) { return __uint_as_float(((unsigned)b) << 16); }
__device__ __forceinline__ float bflo(unsigned w) { return __uint_as_float(w << 16); }
__device__ __forceinline__ float bfhi(unsigned w) { return __uint_as_float(w & 0xffff0000u); }

__device__ __forceinline__ float fast_rcp(float x) { return __builtin_amdgcn_rcpf(x); }
__device__ __forceinline__ float fast_sigmoid(float x) { return fast_rcp(1.f + __expf(-x)); }
__device__ __forceinline__ float fast_tanh(float x) { return 1.f - 2.f * fast_rcp(1.f + __expf(2.f * x)); }
__device__ __forceinline__ float fast_softplus(float x) { return x > 15.f ? x : __logf(1.f + __expf(x)); }
__device__ __forceinline__ float fast_silu(float x) { return x * fast_sigmoid(x); }
__device__ __forceinline__ float fast_gelu_tanh(float x) { return x * fast_sigmoid(1.5957691216057308f * (x + 0.044715f * x * x * x)); }
__device__ __forceinline__ int lds_byte(int r, int c) { const int st = (r >> 4) * 2 + (c >> 5), rr = r & 15, cc = c & 31, ob = rr * 64 + cc * 2; return st * 1024 + (ob ^ (((ob >> 9) & 1) << 5)); }
__device__ __forceinline__ void stage_rc(int b, int& R, int& C) { const int st = b / 1024, sb = b % 1024, swz = sb ^ (((sb >> 9) & 1) << 5); R = (st >> 1) * 16 + swz / 64; C = (st & 1) * 32 + (swz % 64) / 2; }
__device__ __forceinline__ int perm32(int rho) { const int n = rho >> 4, i = rho & 15; return 8 * (i >> 2) + 4 * n + (i & 3); }

struct Unit { int pm, pn, e; };
struct GemmP { const bf16_t* A0; const bf16_t* A1; const bf16_t* Bt; long strideB; const int* gather; int K; int pad_; };

struct StaticOrder {
    int nM, nN, nwg, G, c;
    __device__ void init(int M, int N, int G_, int c_) { nM = M / BM; nN = N / BM; nwg = nM * nN; G = G_; c = c_; }
    __device__ bool next(int i, Unit& u) const {
        const long L = (long)i * G + c; if (L >= nwg) return false;
        int wgid = (int)L; { const int q = nwg / 8, r = nwg % 8, xcd = wgid % 8, off = wgid / 8; wgid = (xcd < r ? xcd * (q + 1) : r * (q + 1) + (xcd - r) * q) + off; }
        const int nig = 8 * nN, gid = wgid / nig, fm = gid * 8, gsz = (nM - fm) < 8 ? (nM - fm) : 8;
        u.pm = fm + ((wgid % nig) % gsz); u.pn = (wgid % nig) / gsz; u.e = 0; return true;
    }
};

#define MK_FRAG_LOOP(ROW, COL) \
    _Pragma("unroll") for (int ai = 0; ai < 2; ++ai) _Pragma("unroll") for (int m = 0; m < 4; ++m) _Pragma("unroll") for (int bj = 0; bj < 2; ++bj) \
        if (const int ROW = ai * HALF + wr * 64 + m * 16 + fr; true) if (const int COL = bj * HALF + wc * 32 + 8 * fq; true)

template <bool GATHER = false, class Epi, class Sched>
__device__ __forceinline__ void gemm_phase(LAS unsigned char* lds, const GemmP g, const Sched& S, const Epi& E) {
    const int tid = threadIdx.x, wid = __builtin_amdgcn_readfirstlane(tid >> 6), lane = tid & 63, wr = wid >> 2, wc = wid & 3, fr = lane & 15, fq = lane >> 4;
    int K = g.K; asm volatile("" : "+s"(K));
    const int nt = K / BK;
    int RA[2], CA[2]; unsigned voffB[2];
#pragma unroll
    for (int i = 0; i < 2; ++i) { int R, C; stage_rc(tid * 16 + i * 8192, R, C); RA[i] = R; CA[i] = C; const int Rb = (R & ~31) + perm32(R & 31); voffB[i] = (unsigned)(Rb * K + C) * 2u; }
    const size_t kstep = (size_t)(BK * 2), hstepB = (size_t)HALF * K * 2, tstepB = 2 * hstepB;
    const unsigned ldsw = (unsigned)wid * 1024u;
    const int aoff = lds_byte(wr * 64 + fr, fq * 8), boff = lds_byte(wc * 32 + fr, fq * 8);
#define MK_SA(b, h) (((b) * 2 + (h)) * HTB)
#define MK_SB(b, h) ((4 + (b) * 2 + (h)) * HTB)
#define MK_STAGE(bufoff, gbase, voff) do { _Pragma("unroll") for (int _i = 0; _i < 2; ++_i) \
        __builtin_amdgcn_global_load_lds((const unsigned*)((const char*)(gbase) + (voff)[_i]), (LAS unsigned*)(lds + (bufoff) + ldsw + _i * 8192), 16, 0, 0); } while (0)
#define MK_LDA(dst, b, h) do { _Pragma("unroll") for (int m = 0; m < 4; ++m) _Pragma("unroll") for (int k = 0; k < 2; ++k) dst[m][k] = *(const LAS bf16x8*)(lds + MK_SA(b, h) + aoff + m * 2048 + k * 1024); } while (0)
#define MK_LDB(dst, b, h) do { _Pragma("unroll") for (int n = 0; n < 2; ++n) _Pragma("unroll") for (int k = 0; k < 2; ++k) dst[n][k] = *(const LAS bf16x8*)(lds + MK_SB(b, h) + boff + n * 2048 + k * 1024); } while (0)
#define MK_MMA(ai, bj, At, Bt) do { __builtin_amdgcn_s_setprio(1); _Pragma("unroll") for (int m = 0; m < 4; ++m) _Pragma("unroll") for (int n = 0; n < 2; ++n) _Pragma("unroll") for (int k = 0; k < 2; ++k) \
        acc[ai][bj][m][n] = __builtin_amdgcn_mfma_f32_16x16x32_bf16(Bt[n][k], At[m][k], acc[ai][bj][m][n], 0, 0, 0); __builtin_amdgcn_s_setprio(0); } while (0)
#define MK_WAIT_V(n) asm volatile("s_waitcnt vmcnt(" #n ")" ::: "memory")
#define MK_WAIT_L(n) asm volatile("s_waitcnt lgkmcnt(" #n ")" ::: "memory")
#define MK_BAR __builtin_amdgcn_s_barrier()
#define MK_SCHED __builtin_amdgcn_sched_barrier(0)
    Unit cur, nxt; int ui = 0;
    if (!S.next(0, cur)) return;
    f32x4 acc[2][2][4][2];
#pragma unroll
    for (int a = 0; a < 2; ++a)
#pragma unroll
        for (int b = 0; b < 2; ++b)
#pragma unroll
            for (int m = 0; m < 4; ++m)
#pragma unroll
                for (int n = 0; n < 2; ++n) acc[a][b][m][n] = (f32x4){0.f, 0.f, 0.f, 0.f};
    bf16x8 At[4][2], B0[2][2], B1[2][2];
    unsigned vA[2][2], vAn[2][2];
    const size_t hstepA = GATHER ? 0 : (size_t)HALF * K * 2, tstepA = 2 * (size_t)HALF * K * 2;
    auto a_voff = [&](const Unit& u, unsigned (&vo)[2][2]) {
#pragma unroll
        for (int h = 0; h < 2; ++h)
#pragma unroll
            for (int i = 0; i < 2; ++i) { if (GATHER) { const int row = u.pm * BM + h * HALF + RA[i]; vo[h][i] = (unsigned)((size_t)g.gather[row] * K + CA[i]) * 2u; } else vo[h][i] = (unsigned)(RA[i] * K + CA[i]) * 2u; }
    };
    a_voff(cur, vA);
    auto a_base = [&](const Unit& u) { return (const char*)(u.e ? g.A1 : g.A0) + (GATHER ? (size_t)0 : (size_t)u.pm * tstepA); };
    const char* cA = a_base(cur);
    const char* cB = (const char*)g.Bt + ((size_t)cur.e * g.strideB) * 2 + (size_t)cur.pn * tstepB;
    MK_STAGE(MK_SB(0, 0), cB, voffB); MK_STAGE(MK_SA(0, 0), cA, vA[0]); MK_STAGE(MK_SB(0, 1), cB + hstepB, voffB); MK_STAGE(MK_SA(0, 1), cA + hstepA, vA[1]);
    if (wr == 1) MK_BAR;
    MK_WAIT_V(4); MK_BAR;
    MK_STAGE(MK_SB(1, 0), cB + kstep, voffB); MK_STAGE(MK_SA(1, 0), cA + kstep, vA[0]); MK_STAGE(MK_SB(1, 1), cB + hstepB + kstep, voffB);
    MK_WAIT_V(6); MK_BAR;
    for (;;) {
        const bool has_next = S.next(ui + 1, nxt);
        const char* nA = has_next ? a_base(nxt) : cA;
        const char* nB = has_next ? (const char*)g.Bt + ((size_t)nxt.e * g.strideB) * 2 + (size_t)nxt.pn * tstepB : cB;
        for (int t = 0; t < nt; t += 2) {
            const bool last = (t == nt - 2);
            if (GATHER && last) { if (has_next) a_voff(nxt, vAn); else {
#pragma unroll
                for (int h = 0; h < 2; ++h)
#pragma unroll
                    for (int i = 0; i < 2; ++i) vAn[h][i] = vA[h][i]; } }
            const char* a1 = cA + (size_t)(t + 1) * kstep;
            const char* a2 = last ? nA : cA + (size_t)(t + 2) * kstep; const char* b2 = last ? nB : cB + (size_t)(t + 2) * kstep;
            const char* a3 = a2 + kstep; const char* b3 = b2 + kstep;
            unsigned v2[2][2];
#pragma unroll
            for (int h = 0; h < 2; ++h)
#pragma unroll
                for (int i = 0; i < 2; ++i) v2[h][i] = (GATHER && last) ? vAn[h][i] : vA[h][i];
            MK_LDB(B0, 0, 0); MK_SCHED; MK_LDA(At, 0, 0); MK_STAGE(MK_SA(1, 1), a1 + hstepA, vA[1]);
            MK_WAIT_L(8); MK_BAR; MK_WAIT_L(0); MK_MMA(0, 0, At, B0); MK_BAR; MK_SCHED;
            MK_LDB(B1, 0, 1); MK_STAGE(MK_SB(0, 0), b2, voffB);
            MK_BAR; MK_WAIT_L(0); MK_MMA(0, 1, At, B1); MK_BAR;
            MK_LDA(At, 0, 1); MK_STAGE(MK_SA(0, 0), a2, v2[0]);
            MK_BAR; MK_WAIT_L(0); MK_MMA(1, 0, At, B0); MK_BAR; MK_SCHED;
            MK_STAGE(MK_SB(0, 1), b2 + hstepB, voffB);
            MK_WAIT_V(6); MK_BAR; MK_MMA(1, 1, At, B1); MK_BAR;
            MK_LDB(B0, 1, 0); MK_SCHED; MK_LDA(At, 1, 0); MK_STAGE(MK_SA(0, 1), a2 + hstepA, v2[1]);
            MK_WAIT_L(8); MK_BAR; MK_WAIT_L(0); MK_MMA(0, 0, At, B0); MK_BAR; MK_SCHED;
            MK_LDB(B1, 1, 1); MK_STAGE(MK_SB(1, 0), b3, voffB);
            MK_BAR; MK_WAIT_L(0); MK_MMA(0, 1, At, B1); MK_BAR;
            MK_LDA(At, 1, 1); MK_STAGE(MK_SA(1, 0), a3, v2[0]);
            MK_BAR; MK_WAIT_L(0); MK_MMA(1, 0, At, B0); MK_BAR; MK_SCHED;
            MK_STAGE(MK_SB(1, 1), b3 + hstepB, voffB);
            MK_WAIT_V(6); MK_BAR; MK_MMA(1, 1, At, B1); MK_BAR;
        }
        int fr_ = fr, fq_ = fq; asm volatile("" : "+v"(fr_), "+v"(fq_));
        if (wr == 0) MK_BAR;
        const bool keep = E(acc, cur, wr, wc, fr_, fq_);
        if (wr == 1) MK_BAR;
        if (!has_next) break;
        if (!keep) {
#pragma unroll
            for (int a = 0; a < 2; ++a)
#pragma unroll
                for (int b = 0; b < 2; ++b)
#pragma unroll
                    for (int m = 0; m < 4; ++m)
#pragma unroll
                        for (int n = 0; n < 2; ++n) acc[a][b][m][n] = (f32x4){0.f, 0.f, 0.f, 0.f};
        }
        cur = nxt; cA = nA; cB = nB; ++ui;
        if (GATHER) {
#pragma unroll
            for (int h = 0; h < 2; ++h)
#pragma unroll
                for (int i = 0; i < 2; ++i) vA[h][i] = vAn[h][i]; }
    }
    MK_WAIT_V(0);
    if (wr == 0) MK_BAR;
    MK_BAR;
#undef MK_SA
#undef MK_SB
#undef MK_STAGE
#undef MK_LDA
#undef MK_LDB
#undef MK_MMA
#undef MK_WAIT_V
#undef MK_WAIT_L
#undef MK_BAR
#undef MK_SCHED
}

__device__ __forceinline__ u32x4 pack8(const f32x4 a, const f32x4 b) { u32x4 w; w.x = cvt_pk_bf16(a[0], a[1]); w.y = cvt_pk_bf16(a[2], a[3]); w.z = cvt_pk_bf16(b[0], b[1]); w.w = cvt_pk_bf16(b[2], b[3]); return w; }
struct EpiStoreBf16 {
    bf16_t* O; long ldc;
    __device__ __forceinline__ bool operator()(const f32x4 (&acc)[2][2][4][2], const Unit& u, int wr, int wc, int fr, int fq) const {
        MK_FRAG_LOOP(r, c) { *(u32x4*)(O + (size_t)(u.pm * BM + r) * ldc + u.pn * BM + c) = pack8(acc[ai][bj][m][0], acc[ai][bj][m][1]); }
        return false;
    }
};

__device__ __forceinline__ void ld8_contig(const float* p, float (&o)[8]) { const f32x4 a = *(const f32x4*)p, b = *(const f32x4*)(p + 4); o[0] = a[0]; o[1] = a[1]; o[2] = a[2]; o[3] = a[3]; o[4] = b[0]; o[5] = b[1]; o[6] = b[2]; o[7] = b[3]; }
struct CMapZ1 { __device__ int operator()(int n) const { return n < RC ? n : (n < Z1_LX ? -1 : OFF_LX + (n - Z1_LX)); }
    __device__ __forceinline__ void load8(const float* rowp, int n, float (&o)[8]) const { const int sc = (*this)(n); if (sc >= 0) ld8_contig(rowp + sc, o); else {
#pragma unroll
        for (int j = 0; j < 8; ++j) o[j] = 0.f; } } };
struct CMapZC { __device__ int operator()(int n) const { return OFF_LG + n; }
    __device__ __forceinline__ void load8(const float* rowp, int n, float (&o)[8]) const { ld8_contig(rowp + OFF_LG + n, o); } };
struct CMapId { __device__ int operator()(int n) const { return n; }
    __device__ __forceinline__ void load8(const float* rowp, int n, float (&o)[8]) const { ld8_contig(rowp + n, o); } };
struct CMapGU { int F; __device__ int operator()(int n) const { return (n & 1) * F + (n >> 1); }
    __device__ __forceinline__ void load8(const float* rowp, int n, float (&o)[8]) const { const f32x4 g = *(const f32x4*)(rowp + (n >> 1)), u = *(const f32x4*)(rowp + F + (n >> 1));
        o[0] = g[0]; o[1] = u[0]; o[2] = g[1]; o[3] = u[1]; o[4] = g[2]; o[5] = u[2]; o[6] = g[3]; o[7] = u[3]; } };
constexpr int CT_B = 4;
template <class CM>
__device__ __forceinline__ void convT_job(LAS float* tile  , const float* src, int lds_, int Ks, bf16_t* dst, int Kd, int N, const CM& cm, int bid, int nblk, int& base) {
    const int tk = Kd / 64, nt = (N / 64) * tk, tid = threadIdx.x;
    const int first = (bid - base % nblk + nblk) % nblk;
    const int kk = tid >> 3, nn8 = (tid & 7) * 8, nn = tid >> 3, kk8 = (tid & 7) * 8;
    for (int t0 = first; t0 < nt; t0 += CT_B * nblk) {
        float v[CT_B][8];
#pragma unroll
        for (int b = 0; b < CT_B; ++b) { const int t = t0 + b * nblk; const int n0 = (t / tk) * 64, k0 = (t % tk) * 64, k = k0 + kk;
            if (t < nt && k < Ks) cm.load8(src + (size_t)k * lds_, n0 + nn8, v[b]); else {
#pragma unroll
                for (int j = 0; j < 8; ++j) v[b][j] = 0.f; } }
#pragma unroll
        for (int b = 0; b < CT_B; ++b)
#pragma unroll
            for (int j = 0; j < 8; ++j) tile[b * 64 * 65 + kk * 65 + nn8 + j] = v[b][j];
        __syncthreads();
#pragma unroll
        for (int b = 0; b < CT_B; ++b) { const int t = t0 + b * nblk; if (t < nt) { const int n0 = (t / tk) * 64, k0 = (t % tk) * 64; f32x4 a, c;
#pragma unroll
            for (int j = 0; j < 4; ++j) { a[j] = tile[b * 64 * 65 + (kk8 + j) * 65 + nn]; c[j] = tile[b * 64 * 65 + (kk8 + 4 + j) * 65 + nn]; }
            *(u32x4*)(dst + (size_t)(n0 + nn) * Kd + k0 + kk8) = pack8(a, c); } }
        __syncthreads();
    }
    base += nt;
}

template <class CM, class MS>
__device__ __forceinline__ void convT_multi(LAS float* tile, const MS& ms, int nmat, int lds_, int Ks, int Kd, int N, const CM& cm, int bid, int nblk) {
    const int tk = Kd / 64, tpm = (N / 64) * tk, nt = nmat * tpm, tid = threadIdx.x;
    const int kk = tid >> 3, nn8 = (tid & 7) * 8, nn = tid >> 3, kk8 = (tid & 7) * 8;
    for (int t0 = bid; t0 < nt; t0 += CT_B * nblk) {
        float v[CT_B][8];
#pragma unroll
        for (int b = 0; b < CT_B; ++b) { const int T = t0 + b * nblk, m = T / tpm, t = T % tpm; const int n0 = (t / tk) * 64, k0 = (t % tk) * 64, k = k0 + kk;
            if (T < nt && k < Ks) cm.load8(ms.src(m) + (size_t)k * lds_, n0 + nn8, v[b]); else {
#pragma unroll
                for (int j = 0; j < 8; ++j) v[b][j] = 0.f; } }
#pragma unroll
        for (int b = 0; b < CT_B; ++b)
#pragma unroll
            for (int j = 0; j < 8; ++j) tile[b * 64 * 65 + kk * 65 + nn8 + j] = v[b][j];
        __syncthreads();
#pragma unroll
        for (int b = 0; b < CT_B; ++b) { const int T = t0 + b * nblk; if (T < nt) { const int m = T / tpm, t = T % tpm, n0 = (t / tk) * 64, k0 = (t % tk) * 64; f32x4 a, c;
#pragma unroll
            for (int j = 0; j < 4; ++j) { a[j] = tile[b * 64 * 65 + (kk8 + j) * 65 + nn]; c[j] = tile[b * 64 * 65 + (kk8 + 4 + j) * 65 + nn]; }
            *(u32x4*)(ms.dst(m) + (size_t)(n0 + nn) * Kd + k0 + kk8) = pack8(a, c); } }
        __syncthreads();
    }
}

constexpr int MOD_SL = 16, MOD_KS = D / MOD_SL;
__device__ __forceinline__ void mod_partials(LAS float* sl  , const In& in, float* part  , int bid, int nblk) {
    const int ncc = 6 * D / NT, nitem = MOD_SL * ncc;
    for (int it = bid; it < nitem; it += nblk) {
        const int s = it / ncc, j = (it % ncc) * NT + threadIdx.x;
        for (int i = threadIdx.x; i < (NB + 1) * MOD_KS; i += NT) { const int r = i / MOD_KS, k = s * MOD_KS + i % MOD_KS; const float cv = r < NB ? in.c[r * D + k] : in.c_ctx[k]; sl[i] = siluf_(cv); }
        __syncthreads();
        float acc[NB + 1];
#pragma unroll
        for (int r = 0; r <= NB; ++r) acc[r] = 0.f;
        for (int k = 0; k < MOD_KS; ++k) { const float w = in.w_mod[(size_t)(s * MOD_KS + k) * 6 * D + j];
#pragma unroll
            for (int r = 0; r <= NB; ++r) acc[r] += sl[r * MOD_KS + k] * w; }
#pragma unroll
        for (int r = 0; r <= NB; ++r) part[((size_t)s * (NB + 1) + r) * 6 * D + j] = acc[r];
        __syncthreads();
    }
}
__device__ __forceinline__ float mod_value(const In& in, const float* part, int r, int j) {
    float s = in.b_mod[j];
#pragma unroll
    for (int q = 0; q < MOD_SL; ++q) s += part[((size_t)q * (NB + 1) + r) * 6 * D + j];
    return s;
}

__device__ __forceinline__ void xn_rows(LAS float* sm  , const In& in, const float* part, bf16_t* xn, int b0, int nb, int row_lo, int row_hi) {
    const int nlat = nb * SEQ, wid = threadIdx.x >> 6, lane = threadIdx.x & 63;
    int cur_mr = -1;
    float gp[16];
#pragma unroll
    for (int j = 0; j < 4; ++j)
#pragma unroll
        for (int q = 0; q < 4; ++q) gp[4 * j + q] = in.norm_g[j * 256 + lane * 4 + q];
    for (int rbase = row_lo; rbase < row_hi; rbase += 8) {
        const int mr = rbase < nlat ? b0 + rbase / SEQ : NB;
        if (mr != cur_mr) { __syncthreads(); for (int j = threadIdx.x; j < 2 * D; j += NT) sm[j] = mod_value(in, part, mr, j); __syncthreads(); cur_mr = mr; }
        const int r = rbase + wid; if (r >= row_hi) continue;
        const float* src = r < nlat ? in.x + ((size_t)b0 * SEQ + r) * D : in.ctx + ((size_t)b0 * CTX + (r - nlat)) * D;
        f32x4 v[4]; float ss = 0.f;
#pragma unroll
        for (int j = 0; j < 4; ++j) { v[j] = *(const f32x4*)(src + j * 256 + lane * 4); ss += v[j][0] * v[j][0] + v[j][1] * v[j][1] + v[j][2] * v[j][2] + v[j][3] * v[j][3]; }
#pragma unroll
        for (int o = 32; o > 0; o >>= 1) ss += __shfl_xor(ss, o);
        const float rinv = 1.f / sqrtf(ss * (1.f / D) + NORM_EPS);
#pragma unroll
        for (int j = 0; j < 4; ++j) { const int c = j * 256 + lane * 4; float o[4];
#pragma unroll
            for (int q = 0; q < 4; ++q) o[q] = (v[j][q] * rinv * gp[4 * j + q]) * (1.f + sm[D + c + q]) + sm[c + q];
            u32x2 w; w.x = cvt_pk_bf16(o[0], o[1]); w.y = cvt_pk_bf16(o[2], o[3]); *(u32x2*)(xn + (size_t)r * D + c) = w; }
    }
}
}

namespace mk {
#define XB_TMO      128
#define XB_XCNT(j)  (256  + 64 * (j))
#define XB_XSUB(j)  (1280 + 64 * (j))
#define XB_XGEN(j)  (2304 + 64 * (j))
#define XB_TOP      3328
#define XB_TOPGEN   3392
#define XCD_BAR_WORDS 3456
#define XB_SPIN_CAP (1u << 18)
__device__ __forceinline__ unsigned xb_ld(unsigned* p)              { return __hip_atomic_load(p, __ATOMIC_RELAXED, __HIP_MEMORY_SCOPE_AGENT); }
__device__ __forceinline__ unsigned xb_add(unsigned* p, unsigned v) { return __hip_atomic_fetch_add(p, v, __ATOMIC_RELAXED, __HIP_MEMORY_SCOPE_AGENT); }
__device__ __forceinline__ unsigned xb_xcc_id() { return (unsigned)__builtin_amdgcn_s_getreg((3 << 11) | 20) & 0xFu; }
#define XB_SPIN(cond, bar) do { unsigned _sp = 0; while (cond) { __builtin_amdgcn_s_sleep(1); \
    if ((++_sp & 255u) == 0u) { if (xb_ld(&(bar)[XB_TMO])) break; if (_sp > XB_SPIN_CAP) { atomicAdd(&(bar)[XB_TMO], 1u); break; } } } } while (0)
struct XcdBarrier { unsigned* bar; unsigned x; volatile LAS unsigned* st; };
__device__ __forceinline__ XcdBarrier xcd_barrier_post(unsigned* bar, volatile LAS unsigned* st) {
    XcdBarrier b; b.bar = bar; b.x = xb_xcc_id(); b.st = st;
    if (threadIdx.x == 0) (void)xb_add(&bar[XB_XCNT(b.x)], 1u);
    return b;
}
__device__ __forceinline__ void xcd_barrier_complete(unsigned* bar, unsigned x, unsigned& nloc, unsigned& nx) {
    const unsigned G = gridDim.x * gridDim.y * gridDim.z;
    unsigned sum, cnt, mine, sp = 0u;
    for (;;) {
        sum = 0u; cnt = 0u; mine = 0u;
#pragma unroll
        for (unsigned j = 0; j < 16; ++j) { const unsigned c = xb_ld(&bar[XB_XCNT(j)]); sum += c; cnt += (c > 0u) ? 1u : 0u; mine = (j == x) ? c : mine; }
        if (sum == G) break;
        __builtin_amdgcn_s_sleep(1);
        if ((++sp & 255u) == 0u) { if (xb_ld(&bar[XB_TMO])) break; if (sp > XB_SPIN_CAP) { atomicAdd(&bar[XB_TMO], 1u); break; } }
    }
    nloc = mine > 0u ? mine : 1u; nx = cnt > 0u ? cnt : 1u;
}
__device__ __forceinline__ void xcd_barrier(const XcdBarrier& b) {
    asm volatile("s_waitcnt vmcnt(0)" ::: "memory");
    __syncthreads();
    if (threadIdx.x == 0) {
        unsigned* bar = b.bar;
        __builtin_amdgcn_s_waitcnt(0);
        unsigned nloc = b.st[0], nx = b.st[1];
        if (nloc == 0u) { xcd_barrier_complete(bar, b.x, nloc, nx); b.st[0] = nloc; b.st[1] = nx; }
        const unsigned old = xb_add(&bar[XB_XSUB(b.x)], 1u);
        const unsigned gen = old / nloc;
        if (old + 1u == (gen + 1u) * nloc) {
            __builtin_amdgcn_fence(__ATOMIC_RELEASE, "agent");
            asm volatile("s_waitcnt vmcnt(0)" ::: "memory");
            const unsigned og = xb_add(&bar[XB_TOP], 1u);
            const unsigned tg = og / nx;
            if (og + 1u == (tg + 1u) * nx) xb_add(&bar[XB_TOPGEN], 1u);
            else XB_SPIN(xb_ld(&bar[XB_TOPGEN]) == tg, bar);
            __builtin_amdgcn_fence(__ATOMIC_ACQUIRE, "agent");
            xb_add(&bar[XB_XGEN(b.x)], 1u);
            asm volatile("s_waitcnt vmcnt(0)" ::: "memory");
        } else {
            XB_SPIN(xb_ld(&bar[XB_XGEN(b.x)]) == gen, bar);
            __builtin_amdgcn_fence(__ATOMIC_ACQUIRE, "agent");
            asm volatile("s_waitcnt vmcnt(0)" ::: "memory");
        }
    }
    __syncthreads();
}
}

namespace mk {
constexpr int TB = 32;
constexpr int RAWW = 320;
constexpr int RW_RAW = 0;
constexpr int RW_MU = RW_RAW + (TB + 2) * RAWW * 2;
constexpr int RW_WUP = RW_MU + 2 * RAWW * 4;
constexpr int RW_AUP = RW_WUP + 64 * 72 * 2;
constexpr int RW_CST = RW_AUP + 64 * 72 * 2;
constexpr int RW_AWD = RW_CST + 5 * 64 * 4;
constexpr int RW_AAD = RW_AWD + TB * 72 * 2;
constexpr int RW_R = RW_AAD + TB * 72 * 2;
constexpr int RW_KR = RW_R + TB * 64 * 4;
constexpr int RW_LA = RW_KR + TB * 64 * 4;
constexpr int RW_KK = RW_LA + TB * 64 * 4;
constexpr int RW_W = RW_KK + TB * 64 * 4;
constexpr int RW_B = RW_W + TB * 64 * 4;
constexpr int RW_KD = RW_B + TB * 64 * 4;
constexpr int RW_WR = RW_KD + TB * 64 * 4;
constexpr int RW_V = RW_WR + TB * 64 * 4;
constexpr int RW_SC = RW_V + TB * 64 * 4;
constexpr int RW_YO = RW_SC + TB * 2 * 4;
constexpr int RW_BON = RW_YO + TB * 64 * 4;
constexpr int RW_END = RW_BON + TB * 4;
static_assert(RW_END <= LDS_BYTES, "rwkv LDS");

#define MK_DPP(x, ctrl) __int_as_float(__builtin_amdgcn_update_dpp(__float_as_int(x), __float_as_int(x), ctrl, 0xF, 0xF, false))
__device__ __forceinline__ float allreduce16(float x) {
    x += MK_DPP(x, 0xB1); x += MK_DPP(x, 0x4E); x += MK_DPP(x, 0x141); x += MK_DPP(x, 0x140); return x;
}

__device__ __forceinline__ void allreduce16x4(float& a, float& b, float& c, float& d) {
    asm volatile("s_nop 1\n\t"
        "v_add_f32_dpp %0, %0, %0 quad_perm:[1,0,3,2] row_mask:0xf bank_mask:0xf\n\t" "v_add_f32_dpp %1, %1, %1 quad_perm:[1,0,3,2] row_mask:0xf bank_mask:0xf\n\t"
        "v_add_f32_dpp %2, %2, %2 quad_perm:[1,0,3,2] row_mask:0xf bank_mask:0xf\n\t" "v_add_f32_dpp %3, %3, %3 quad_perm:[1,0,3,2] row_mask:0xf bank_mask:0xf\n\t"
        "v_add_f32_dpp %0, %0, %0 quad_perm:[2,3,0,1] row_mask:0xf bank_mask:0xf\n\t" "v_add_f32_dpp %1, %1, %1 quad_perm:[2,3,0,1] row_mask:0xf bank_mask:0xf\n\t"
        "v_add_f32_dpp %2, %2, %2 quad_perm:[2,3,0,1] row_mask:0xf bank_mask:0xf\n\t" "v_add_f32_dpp %3, %3, %3 quad_perm:[2,3,0,1] row_mask:0xf bank_mask:0xf\n\t"
        "v_add_f32_dpp %0, %0, %0 row_half_mirror row_mask:0xf bank_mask:0xf\n\t" "v_add_f32_dpp %1, %1, %1 row_half_mirror row_mask:0xf bank_mask:0xf\n\t"
        "v_add_f32_dpp %2, %2, %2 row_half_mirror row_mask:0xf bank_mask:0xf\n\t" "v_add_f32_dpp %3, %3, %3 row_half_mirror row_mask:0xf bank_mask:0xf\n\t"
        "v_add_f32_dpp %0, %0, %0 row_mirror row_mask:0xf bank_mask:0xf\n\t" "v_add_f32_dpp %1, %1, %1 row_mirror row_mask:0xf bank_mask:0xf\n\t"
        "v_add_f32_dpp %2, %2, %2 row_mirror row_mask:0xf bank_mask:0xf\n\t" "v_add_f32_dpp %3, %3, %3 row_mirror row_mask:0xf bank_mask:0xf"
        : "+v"(a), "+v"(b), "+v"(c), "+v"(d));
}
struct RwkvP { const bf16_t* z1; bf16_t* Y; float* bon; int b0, nb; };

constexpr int RW_NPIECE = (TB + 2) * 40, RW_PPT = (RW_NPIECE + NT - 1) / NT;

__device__ __forceinline__ void rwkv_chain(LAS unsigned char* lds, const In& in, const RwkvP p, int chain) {
    const int tid = threadIdx.x, lane = tid & 63, wid = tid >> 6;
    const int d = chain / (p.nb * NH), bl = (chain / NH) % p.nb, h = chain % NH;
    const int nlat = p.nb * SEQ;
    LAS bf16_t* RAW = (LAS bf16_t*)(lds + RW_RAW); LAS float* MU = (LAS float*)(lds + RW_MU);
    LAS bf16_t* WUP = (LAS bf16_t*)(lds + RW_WUP); LAS bf16_t* AUP = (LAS bf16_t*)(lds + RW_AUP); LAS float* CST = (LAS float*)(lds + RW_CST);
    LAS bf16_t* AWD = (LAS bf16_t*)(lds + RW_AWD); LAS bf16_t* AAD = (LAS bf16_t*)(lds + RW_AAD);
    LAS float *Rr = (LAS float*)(lds + RW_R), *KR = (LAS float*)(lds + RW_KR), *LA_ = (LAS float*)(lds + RW_LA);
    LAS float *KK = (LAS float*)(lds + RW_KK), *Wv = (LAS float*)(lds + RW_W), *Bv = (LAS float*)(lds + RW_B), *KD = (LAS float*)(lds + RW_KD), *WR = (LAS float*)(lds + RW_WR), *Vv = (LAS float*)(lds + RW_V);
    LAS float *SC = (LAS float*)(lds + RW_SC), *YO = (LAS float*)(lds + RW_YO), *BON = (LAS float*)(lds + RW_BON);
    auto segcol = [&](int s) { return s < 3 ? s * RW + h * 64 : (s == 3 ? OFF_WD + d * DL : OFF_AD + d * AL); };
    for (int i = tid; i < 2 * RAWW; i += NT) { const int m = i / RAWW, c = i % RAWW; MU[i] = in.shift_mu[m * RC + segcol(c >> 6) + (c & 63)]; }
    for (int i = tid; i < 64 * 64; i += NT) { const int j = i >> 6, c = i & 63;
        WUP[c * 72 + j] = f2bf(in.rw_w_up[((size_t)d * DL + j) * RW + h * 64 + c]); AUP[c * 72 + j] = f2bf(in.rw_a_up[((size_t)d * AL + j) * RW + h * 64 + c]); }
    for (int i = tid; i < 64; i += NT) { CST[i] = in.rw_w0[d * RW + h * 64 + i]; CST[64 + i] = in.rw_a0[d * RW + h * 64 + i]; CST[128 + i] = in.rw_k_k[h * 64 + i]; CST[192 + i] = in.rw_k_a[h * 64 + i]; CST[256 + i] = in.rw_r_k[h * 64 + i]; }
    constexpr int NQ = (CTX + SEQ) / TB, NQC = CTX / TB;
    auto blk_info = [&](int q, bool& isctx, int& t0, bool& hp, bool& hn, size_t& grow0) {
        isctx = q < NQC;
        if (isctx) { const int qq = d == 0 ? q : NQC - 1 - q; t0 = qq * TB; hp = t0 > 0; hn = t0 + TB < CTX; grow0 = (size_t)nlat + (size_t)bl * CTX + t0; }
        else { const int ql = q - NQC, qq = d == 0 ? ql : SEQ / TB - 1 - ql; t0 = qq * TB; hp = (t0 % GW) != 0; hn = ((t0 + TB) % GW) != 0; grow0 = (size_t)bl * SEQ + t0; }
    };
    u32x4 pre[RW_PPT];
    auto prefetch = [&](int q) {
        bool isctx, hp, hn; int t0; size_t grow0; blk_info(q, isctx, t0, hp, hn, grow0);
#pragma unroll
        for (int k = 0; k < RW_PPT; ++k) { const int i = tid + k * NT; u32x4 v = (u32x4){0u, 0u, 0u, 0u};
            if (i < RW_NPIECE) { const int rr = i / 40, sp = i % 40, seg = sp >> 3, part = sp & 7;
                const bool ok = (rr == 0) ? hp : ((rr == TB + 1) ? hn : true);
                if (ok) v = *(const u32x4*)(p.z1 + (grow0 + rr - 1) * Z1_N + segcol(seg) + part * 8); }
            pre[k] = v; }
    };
    auto commit = [&]() {
#pragma unroll
        for (int k = 0; k < RW_PPT; ++k) { const int i = tid + k * NT; if (i < RW_NPIECE) { const int rr = i / 40, sp = i % 40; *(LAS u32x4*)(RAW + rr * RAWW + sp * 8) = pre[k]; } }
    };
    float S[2][4];
#pragma unroll
    for (int i = 0; i < 2; ++i)
#pragma unroll
        for (int j = 0; j < 4; ++j) S[i][j] = 0.f;
    const int kg = lane & 15, rp = (lane >> 4) + 4 * wid;
    prefetch(0);
    for (int q = 0; q < NQ; ++q) {
        bool isctx, hp, hn; int t0; size_t grow0; blk_info(q, isctx, t0, hp, hn, grow0);
        commit();
        __syncthreads();
        if (q + 1 < NQ) prefetch(q + 1);
        auto shift8 = [&](int t, int c0, float (&s)[8]) {
            const u32x4 xp = *(const LAS u32x4*)(RAW + t * RAWW + c0), xc = *(const LAS u32x4*)(RAW + (t + 1) * RAWW + c0), xn_ = *(const LAS u32x4*)(RAW + (t + 2) * RAWW + c0);
            const f32x4 m0a = *(const LAS f32x4*)(MU + c0), m0b = *(const LAS f32x4*)(MU + c0 + 4), m1a = *(const LAS f32x4*)(MU + RAWW + c0), m1b = *(const LAS f32x4*)(MU + RAWW + c0 + 4);
#pragma unroll
            for (int j = 0; j < 4; ++j) { const unsigned a = xp[j], b = xc[j], c = xn_[j];
                const float mu0l = j < 2 ? m0a[2 * j] : m0b[2 * j - 4], mu0h = j < 2 ? m0a[2 * j + 1] : m0b[2 * j - 3], mu1l = j < 2 ? m1a[2 * j] : m1b[2 * j - 4], mu1h = j < 2 ? m1a[2 * j + 1] : m1b[2 * j - 3];
                { const float x = bflo(b); s[2 * j] = x + mu0l * (bflo(a) - x) + mu1l * (bflo(c) - x); }
                { const float x = bfhi(b); s[2 * j + 1] = x + mu0h * (bfhi(a) - x) + mu1h * (bfhi(c) - x); } } };
        for (int it = tid; it < TB * 24; it += NT) {
            const int t = it / 24, g = it % 24, seg = g >> 3, cc = (g & 7) * 8; float s[8]; shift8(t, g * 8, s);
            LAS float* dst = (seg == 0 ? Rr : (seg == 1 ? KR : Vv)) + t * 64 + cc; *(LAS f32x4*)dst = (f32x4){s[0], s[1], s[2], s[3]}; *(LAS f32x4*)(dst + 4) = (f32x4){s[4], s[5], s[6], s[7]};
        }
        { const int t = tid >> 4, g = 24 + (tid & 15), cc = (g & 7) * 8; float s[8]; shift8(t, g * 8, s);
          const bool isw = (tid & 15) < 8;
#pragma unroll
          for (int j = 0; j < 8; ++j) { const float th = fast_tanh(s[j]); s[j] = isw ? th : s[j]; }
          LAS bf16_t* dst = (isw ? AWD : AAD) + t * 72 + cc;
          u32x4 w; w.x = cvt_pk_bf16(s[0], s[1]); w.y = cvt_pk_bf16(s[2], s[3]); w.z = cvt_pk_bf16(s[4], s[5]); w.w = cvt_pk_bf16(s[6], s[7]); *(LAS u32x4*)dst = w; }
        __syncthreads();
        {
            const int lora = wid >> 2, ct = wid & 3, fr = lane & 15, fq = lane >> 4;
            const LAS bf16_t* Am = lora ? AAD : AWD; const LAS bf16_t* Bm = lora ? AUP : WUP;
#pragma unroll
            for (int rt = 0; rt < 2; ++rt) {
                f32x4 acc = (f32x4){0.f, 0.f, 0.f, 0.f};
#pragma unroll
                for (int ks = 0; ks < 2; ++ks) {
                    const bf16x8 a = *(const LAS bf16x8*)(Am + (rt * 16 + fr) * 72 + ks * 32 + fq * 8);
                    const bf16x8 b = *(const LAS bf16x8*)(Bm + (ct * 16 + fr) * 72 + ks * 32 + fq * 8);
                    acc = __builtin_amdgcn_mfma_f32_16x16x32_bf16(a, b, acc, 0, 0, 0);
                }
                const int col = ct * 16 + fr;
#pragma unroll
                for (int i = 0; i < 4; ++i) { const int t = rt * 16 + fq * 4 + i;
                    if (lora == 0) { const float lw = acc[i] + CST[col]; const float wl = -fast_softplus(-lw) - 0.5f; Wv[t * 64 + col] = __expf(-__expf(wl)); }
                    else { LA_[t * 64 + col] = fast_sigmoid(acc[i] + CST[64 + col]); } }
            }
        }
        __syncthreads();
        {
            const int t = tid >> 4, c4 = (tid & 15) * 4;
            const f32x4 k = *(const LAS f32x4*)(KR + t * 64 + c4), a = *(const LAS f32x4*)(LA_ + t * 64 + c4), w = *(const LAS f32x4*)(Wv + t * 64 + c4), r = *(const LAS f32x4*)(Rr + t * 64 + c4);
            f32x4 kkr, kd, bb, wr; float ss = 0.f, br = 0.f, kr = 0.f, bn = 0.f;
#pragma unroll
            for (int j = 0; j < 4; ++j) { kkr[j] = k[j] * CST[128 + c4 + j]; ss += kkr[j] * kkr[j]; }
            ss = allreduce16(ss);
            const float inv = 1.f / fmaxf(sqrtf(ss), 1e-12f);
#pragma unroll
            for (int j = 0; j < 4; ++j) { const float kk = kkr[j] * inv; kkr[j] = kk; kd[j] = k[j] * (1.f + (a[j] - 1.f) * CST[192 + c4 + j]); bb[j] = kk * a[j]; wr[j] = w[j] * r[j];
                br += bb[j] * r[j]; kr += kd[j] * r[j]; bn += r[j] * kd[j] * CST[256 + c4 + j]; }
            br = allreduce16(br); kr = allreduce16(kr); bn = allreduce16(bn);
            *(LAS f32x4*)(KK + t * 64 + c4) = kkr; *(LAS f32x4*)(KD + t * 64 + c4) = kd; *(LAS f32x4*)(Bv + t * 64 + c4) = bb; *(LAS f32x4*)(WR + t * 64 + c4) = wr;
            if ((tid & 15) == 0) { SC[t * 2] = br; SC[t * 2 + 1] = kr; BON[t] = bn; }
        }
        __syncthreads();
        {
            auto tof = [&](int st) { return d == 0 ? st : TB - 1 - st; };
            const LAS float* lb = KK + 4 * kg;
            const LAS float* vb = Vv + 2 * rp;
            constexpr int OW = (RW_W - RW_KK) / 4, OB = (RW_B - RW_KK) / 4, OKD = (RW_KD - RW_KK) / 4, OWR = (RW_WR - RW_KK) / 4;
            int t = tof(0);
            f32x4 kk4 = *(const LAS f32x4*)(lb + t * 64), w4 = *(const LAS f32x4*)(lb + t * 64 + OW), b4 = *(const LAS f32x4*)(lb + t * 64 + OB),
                  kd4 = *(const LAS f32x4*)(lb + t * 64 + OKD), wr4 = *(const LAS f32x4*)(lb + t * 64 + OWR);
            f32x2 vv = *(const LAS f32x2*)(vb + t * 64), sc = *(const LAS f32x2*)(SC + t * 2);
            f32x2 S2[4];
#pragma unroll
            for (int j = 0; j < 4; ++j) { S2[j][0] = S[0][j]; S2[j][1] = S[1][j]; }
#pragma unroll 2
            for (int st = 0; st < TB; ++st) {
                const int tn = tof(st + 1 < TB ? st + 1 : st);
                const f32x4 nkk4 = *(const LAS f32x4*)(lb + tn * 64), nw4 = *(const LAS f32x4*)(lb + tn * 64 + OW), nb4 = *(const LAS f32x4*)(lb + tn * 64 + OB),
                            nkd4 = *(const LAS f32x4*)(lb + tn * 64 + OKD), nwr4 = *(const LAS f32x4*)(lb + tn * 64 + OWR);
                const f32x2 nvv = *(const LAS f32x2*)(vb + tn * 64), nsc = *(const LAS f32x2*)(SC + tn * 2);
                f32x2 sa2 = S2[0] * kk4[0], yo2 = S2[0] * wr4[0];
#pragma unroll
                for (int j = 1; j < 4; ++j) { sa2 += S2[j] * kk4[j]; yo2 += S2[j] * wr4[j]; }
                float sa0 = sa2[0], sa1 = sa2[1], yo0 = yo2[0], yo1 = yo2[1];
                allreduce16x4(sa0, sa1, yo0, yo1);
                f32x2 sar; sar[0] = sa0; sar[1] = sa1;
#pragma unroll
                for (int j = 0; j < 4; ++j) S2[j] = S2[j] * w4[j] + (vv * kd4[j] - sar * b4[j]);
                if (kg == 0) { f32x2 yor; yor[0] = yo0; yor[1] = yo1; const f32x2 y = yor - sar * sc[0] + vv * sc[1]; *(LAS f32x2*)(YO + t * 64 + 2 * rp) = y; }
                kk4 = nkk4; w4 = nw4; b4 = nb4; kd4 = nkd4; wr4 = nwr4; vv = nvv; sc = nsc; t = tn;
            }
#pragma unroll
            for (int j = 0; j < 4; ++j) { S[0][j] = S2[j][0]; S[1][j] = S2[j][1]; }
        }
        __syncthreads();
        if (!isctx) {
            const int t = tid >> 4, c4 = (tid & 15) * 4; const f32x4 y = *(const LAS f32x4*)(YO + t * 64 + c4);
            u32x2 w; w.x = cvt_pk_bf16(y[0], y[1]); w.y = cvt_pk_bf16(y[2], y[3]);
            *(u32x2*)(p.Y + ((size_t)d * nlat + grow0 + t) * RW + h * 64 + c4) = w;
            if (tid < TB) p.bon[((size_t)d * nlat + grow0 + tid) * NH + h] = BON[tid];
        }
    }
}
__device__ __forceinline__ void rwkv_phase(LAS unsigned char* lds, const In& in, const RwkvP p, int bid, int nblk) {
    const int nchain = 2 * p.nb * NH;
    for (int c = bid; c < nchain; c += nblk) { rwkv_chain(lds, in, p, c); __syncthreads(); }
}
}

namespace mk {
constexpr int C2_RAW = 0;
constexpr int C2_MU = C2_RAW + (TB + 2) * RAWW * 2;
constexpr int C2_WUP = C2_MU + 2 * RAWW * 4;
constexpr int C2_AUP = C2_WUP + 64 * 72 * 2;
constexpr int C2_CST = C2_AUP + 64 * 72 * 2;
constexpr int C2_AWD = C2_CST + 5 * 64 * 4;
constexpr int C2_AAD = C2_AWD + TB * 72 * 2;
constexpr int C2_X = C2_AAD + TB * 72 * 2;
constexpr int C2_R = C2_X, C2_KR = C2_R + TB * 64 * 4, C2_V = C2_KR + TB * 64 * 4, C2_E = C2_V + TB * 64 * 4, C2_LA = C2_E + TB * 64 * 4, C2_CUM = C2_LA + TB * 64 * 4, C2_X_END = C2_CUM + TB * 64 * 4;
constexpr int C2_YO = C2_X;
constexpr int C2_G = C2_YO + TB * 64 * 4;
constexpr int C2_UB = C2_G + 64 * 36 * 4;
constexpr int C2_ABT = C2_UB + 64 * 40 * 2;
constexpr int C2_AKT = C2_ABT + 32 * 32 * 4;
constexpr int C2_NBT = C2_AKT + 32 * 40 * 2;
constexpr int C2_NKT = C2_NBT + 32 * 40 * 2;
static_assert(C2_NKT + 32 * 40 * 2 <= C2_X_END, "region X reuse");
constexpr int C2_KKS = C2_X_END;
constexpr int C2_BS = C2_KKS + TB * 72 * 2, C2_KDS = C2_BS + TB * 72 * 2, C2_RS = C2_KDS + TB * 72 * 2;
constexpr int C2_BST = C2_RS + TB * 72 * 2;
constexpr int C2_KDST = C2_BST + 64 * 40 * 2;
constexpr int C2_VT = C2_KDST + 64 * 40 * 2;
constexpr int C2_S0B = C2_VT + 64 * 40 * 2;
constexpr int C2_GC = C2_S0B + 64 * 72 * 2;
constexpr int C2_BON = C2_GC + 64 * 4;
constexpr int C2_END = C2_BON + TB * 4;
static_assert(C2_END <= LDS_BYTES - 16 && (C2_X % 16) == 0 && (C2_KKS % 16) == 0 && (C2_G % 16) == 0 && (C2_UB % 16) == 0 && (C2_ABT % 16) == 0 && (C2_AKT % 16) == 0 && (C2_S0B % 16) == 0, "rwkv2 LDS");

__device__ __forceinline__ bf16x8 ldsb8(const LAS bf16_t* p) { return *(const LAS bf16x8*)p; }

template <int MODE>
__device__ __forceinline__ void rwkv_chain2(LAS unsigned char* lds, const In& in, const RwkvP p, int chain) {
    const int tid = threadIdx.x, lane = tid & 63, wid = tid >> 6, fr = lane & 15, fq = lane >> 4;
    const int d = chain / (p.nb * NH), bl = (chain / NH) % p.nb, h = chain % NH;
    const int nlat = p.nb * SEQ;
    LAS bf16_t* RAW = (LAS bf16_t*)(lds + C2_RAW); LAS float* MU = (LAS float*)(lds + C2_MU);
    LAS bf16_t* WUP = (LAS bf16_t*)(lds + C2_WUP); LAS bf16_t* AUP = (LAS bf16_t*)(lds + C2_AUP); LAS float* CST = (LAS float*)(lds + C2_CST);
    LAS bf16_t* AWD = (LAS bf16_t*)(lds + C2_AWD); LAS bf16_t* AAD = (LAS bf16_t*)(lds + C2_AAD);
    LAS float *Rr = (LAS float*)(lds + C2_R), *KR = (LAS float*)(lds + C2_KR), *Vv = (LAS float*)(lds + C2_V), *Ee = (LAS float*)(lds + C2_E), *LA_ = (LAS float*)(lds + C2_LA), *CUM = (LAS float*)(lds + C2_CUM);
    LAS float *YO = (LAS float*)(lds + C2_YO), *Gm = (LAS float*)(lds + C2_G), *ABT = (LAS float*)(lds + C2_ABT), *GC = (LAS float*)(lds + C2_GC), *BON = (LAS float*)(lds + C2_BON);
    LAS bf16_t *UB = (LAS bf16_t*)(lds + C2_UB), *AKT = (LAS bf16_t*)(lds + C2_AKT), *NBT = (LAS bf16_t*)(lds + C2_NBT), *NKT = (LAS bf16_t*)(lds + C2_NKT);
    LAS bf16_t *KKS = (LAS bf16_t*)(lds + C2_KKS), *BS = (LAS bf16_t*)(lds + C2_BS), *KDS = (LAS bf16_t*)(lds + C2_KDS), *RS = (LAS bf16_t*)(lds + C2_RS);
    LAS bf16_t *BST = (LAS bf16_t*)(lds + C2_BST), *KDST = (LAS bf16_t*)(lds + C2_KDST), *VT = (LAS bf16_t*)(lds + C2_VT), *S0B = (LAS bf16_t*)(lds + C2_S0B);
    auto segcol = [&](int s) { return s < 3 ? s * RW + h * 64 : (s == 3 ? OFF_WD + d * DL : OFF_AD + d * AL); };
    for (int i = tid; i < 2 * RAWW; i += NT) { const int m = i / RAWW, c = i % RAWW; MU[i] = in.shift_mu[m * RC + segcol(c >> 6) + (c & 63)]; }
    for (int i = tid; i < 64 * 64; i += NT) { const int j = i >> 6, c = i & 63;
        WUP[c * 72 + j] = f2bf(in.rw_w_up[((size_t)d * DL + j) * RW + h * 64 + c]); AUP[c * 72 + j] = f2bf(in.rw_a_up[((size_t)d * AL + j) * RW + h * 64 + c]); }
    for (int i = tid; i < 64; i += NT) { CST[i] = in.rw_w0[d * RW + h * 64 + i]; CST[64 + i] = in.rw_a0[d * RW + h * 64 + i]; CST[128 + i] = in.rw_k_k[h * 64 + i]; CST[192 + i] = in.rw_k_a[h * 64 + i]; CST[256 + i] = in.rw_r_k[h * 64 + i]; }
    for (int i = tid; i < 64 * 72 / 2; i += NT) ((LAS unsigned*)S0B)[i] = 0u;
    constexpr int NQ = (CTX + SEQ) / TB, NQC = CTX / TB;
    auto blk_info = [&](int q, bool& isctx, int& t0, bool& hp, bool& hn, size_t& grow0) {
        isctx = q < NQC;
        if (isctx) { const int qq = d == 0 ? q : NQC - 1 - q; t0 = qq * TB; hp = t0 > 0; hn = t0 + TB < CTX; grow0 = (size_t)nlat + (size_t)bl * CTX + t0; }
        else { const int ql = q - NQC, qq = d == 0 ? ql : SEQ / TB - 1 - ql; t0 = qq * TB; hp = (t0 % GW) != 0; hn = ((t0 + TB) % GW) != 0; grow0 = (size_t)bl * SEQ + t0; }
    };
    u32x4 pre[RW_PPT]; int poff[RW_PPT], plds[RW_PPT], pkind[RW_PPT];
#pragma unroll
    for (int k = 0; k < RW_PPT; ++k) { const int i = tid + k * NT, rr = i / 40, sp = i % 40, seg = sp >> 3, part = sp & 7;
        poff[k] = (rr - 1) * Z1_N + segcol(seg) + part * 8; plds[k] = rr * RAWW + sp * 8; pkind[k] = i >= RW_NPIECE ? 3 : (rr == 0 ? 1 : (rr == TB + 1 ? 2 : 0)); }
    auto prefetch = [&](int q) {
        bool isctx, hp, hn; int t0; size_t grow0; blk_info(q, isctx, t0, hp, hn, grow0);
        const bf16_t* base = p.z1 + grow0 * Z1_N;
#pragma unroll
        for (int k = 0; k < RW_PPT; ++k) { u32x4 v = (u32x4){0u, 0u, 0u, 0u};
            const bool ok = pkind[k] == 0 || (pkind[k] == 1 && hp) || (pkind[k] == 2 && hn);
            if (ok) v = *(const u32x4*)(base + poff[k]);
            pre[k] = v; }
    };
    auto commit = [&]() {
#pragma unroll
        for (int k = 0; k < RW_PPT; ++k) if (pkind[k] != 3) *(LAS u32x4*)(RAW + plds[k]) = pre[k];
    };
    f32x4 Sreg[2];
    Sreg[0] = (f32x4){0.f, 0.f, 0.f, 0.f}; Sreg[1] = Sreg[0];
    const int rt = wid >> 1;
    prefetch(0);
    for (int q = 0; q < NQ; ++q) {
        bool isctx, hp, hn; int t0; size_t grow0; blk_info(q, isctx, t0, hp, hn, grow0);
        commit();
        __syncthreads();
        if (q + 1 < NQ) prefetch(q + 1);
        auto shift8 = [&](int t, int c0, float (&s)[8]) {
            const u32x4 xp = *(const LAS u32x4*)(RAW + t * RAWW + c0), xc = *(const LAS u32x4*)(RAW + (t + 1) * RAWW + c0), xn_ = *(const LAS u32x4*)(RAW + (t + 2) * RAWW + c0);
            const f32x4 m0a = *(const LAS f32x4*)(MU + c0), m0b = *(const LAS f32x4*)(MU + c0 + 4), m1a = *(const LAS f32x4*)(MU + RAWW + c0), m1b = *(const LAS f32x4*)(MU + RAWW + c0 + 4);
#pragma unroll
            for (int j = 0; j < 4; ++j) { const unsigned a = xp[j], b = xc[j], c = xn_[j];
                const float mu0l = j < 2 ? m0a[2 * j] : m0b[2 * j - 4], mu0h = j < 2 ? m0a[2 * j + 1] : m0b[2 * j - 3], mu1l = j < 2 ? m1a[2 * j] : m1b[2 * j - 4], mu1h = j < 2 ? m1a[2 * j + 1] : m1b[2 * j - 3];
                { const float x = bflo(b); s[2 * j] = x + mu0l * (bflo(a) - x) + mu1l * (bflo(c) - x); }
                { const float x = bfhi(b); s[2 * j + 1] = x + mu0h * (bfhi(a) - x) + mu1h * (bfhi(c) - x); } } };
        for (int it = tid; it < TB * 24; it += NT) {
            const int t = it / 24, g = it % 24, seg = g >> 3, cc = (g & 7) * 8, js = d == 0 ? t : TB - 1 - t; float s[8]; shift8(t, g * 8, s);
            LAS float* dst = (seg == 0 ? Rr : (seg == 1 ? KR : Vv)) + js * 64 + cc; *(LAS f32x4*)dst = (f32x4){s[0], s[1], s[2], s[3]}; *(LAS f32x4*)(dst + 4) = (f32x4){s[4], s[5], s[6], s[7]};
        }
        { const int t = tid >> 4, g = 24 + (tid & 15), cc = (g & 7) * 8, js = d == 0 ? t : TB - 1 - t; float s[8]; shift8(t, g * 8, s);
          const bool isw = (tid & 15) < 8;
#pragma unroll
          for (int j = 0; j < 8; ++j) { const float th = fast_tanh(s[j]); s[j] = isw ? th : s[j]; }
          LAS bf16_t* dst = (isw ? AWD : AAD) + js * 72 + cc;
          u32x4 w; w.x = cvt_pk_bf16(s[0], s[1]); w.y = cvt_pk_bf16(s[2], s[3]); w.z = cvt_pk_bf16(s[4], s[5]); w.w = cvt_pk_bf16(s[6], s[7]); *(LAS u32x4*)dst = w; }
        __syncthreads();
        if (MODE == 3) continue;
        {
            const int lora = wid >> 2, ct = wid & 3;
            const LAS bf16_t* Am = lora ? AAD : AWD; const LAS bf16_t* Bm = lora ? AUP : WUP;
            float carry = 0.f;
#pragma unroll
            for (int r2 = 0; r2 < 2; ++r2) {
                f32x4 acc = (f32x4){0.f, 0.f, 0.f, 0.f};
#pragma unroll
                for (int ks = 0; ks < 2; ++ks) acc = __builtin_amdgcn_mfma_f32_16x16x32_bf16(ldsb8(Am + (r2 * 16 + fr) * 72 + ks * 32 + fq * 8), ldsb8(Bm + (ct * 16 + fr) * 72 + ks * 32 + fq * 8), acc, 0, 0, 0);
                const int col = ct * 16 + fr;
                if (lora == 0) {
                    float c[4];
#pragma unroll
                    for (int i = 0; i < 4; ++i) { const float lw = acc[i] + CST[col]; const float e = __expf(-fast_softplus(-lw) - 0.5f); c[i] = i ? c[i - 1] + e : e; }
                    const float tot = c[3];
                    float s1 = tot; { const float y = __shfl_up(s1, 16); s1 += fq >= 1 ? y : 0.f; }
                    float s2 = s1;  { const float z = __shfl_up(s1, 32); s2 += fq >= 2 ? z : 0.f; }
                    const float base = carry + s2 - tot;
#pragma unroll
                    for (int i = 0; i < 4; ++i) CUM[(r2 * 16 + fq * 4 + i) * 64 + col] = base + c[i];
                    carry += __shfl(s2, 48 + fr);
                } else {
#pragma unroll
                    for (int i = 0; i < 4; ++i) LA_[(r2 * 16 + fq * 4 + i) * 64 + col] = fast_sigmoid(acc[i] + CST[64 + col]);
                }
            }
        }
        __syncthreads();
        if (MODE == 2) continue;
        {
            const int j = tid >> 4, c4 = (tid & 15) * 4;
            const f32x4 k = *(const LAS f32x4*)(KR + j * 64 + c4), a = *(const LAS f32x4*)(LA_ + j * 64 + c4), r = *(const LAS f32x4*)(Rr + j * 64 + c4), vv = *(const LAS f32x4*)(Vv + j * 64 + c4);
            const f32x4 cu = *(const LAS f32x4*)(CUM + j * 64 + c4); f32x4 cp = (f32x4){0.f, 0.f, 0.f, 0.f}; if (j > 0) cp = *(const LAS f32x4*)(CUM + (j - 1) * 64 + c4);
            float kkr[4], ss = 0.f, bn = 0.f;
#pragma unroll
            for (int x = 0; x < 4; ++x) { kkr[x] = k[x] * CST[128 + c4 + x]; ss += kkr[x] * kkr[x]; }
            ss = allreduce16(ss);
            const float inv = 1.f / fmaxf(sqrtf(ss), 1e-12f);
            float kks[4], bs[4], kds[4], rs[4];
#pragma unroll
            for (int x = 0; x < 4; ++x) { const float kk = kkr[x] * inv, kd = k[x] * (1.f + (a[x] - 1.f) * CST[192 + c4 + x]), bb = kk * a[x];
                const float g = __expf(-cu[x]), gp = __expf(-cp[x]), ig = __expf(cu[x]);
                kks[x] = kk * gp; bs[x] = bb * ig; kds[x] = kd * ig; rs[x] = r[x] * g; bn += r[x] * kd * CST[256 + c4 + x];
                if (j == TB - 1) GC[c4 + x] = g;
            }
#pragma unroll
            for (int x = 0; x < 4; x += 2) { const unsigned pb = cvt_pk_bf16(bs[x], bs[x + 1]), pk = cvt_pk_bf16(kds[x], kds[x + 1]), pv = cvt_pk_bf16(vv[x], vv[x + 1]);
                BST[(c4 + x) * 40 + j] = (bf16_t)pb; BST[(c4 + x + 1) * 40 + j] = (bf16_t)(pb >> 16); KDST[(c4 + x) * 40 + j] = (bf16_t)pk; KDST[(c4 + x + 1) * 40 + j] = (bf16_t)(pk >> 16);
                VT[(c4 + x) * 40 + j] = (bf16_t)pv; VT[(c4 + x + 1) * 40 + j] = (bf16_t)(pv >> 16); }
            bn = allreduce16(bn);
            u32x2 w; w.x = cvt_pk_bf16(kks[0], kks[1]); w.y = cvt_pk_bf16(kks[2], kks[3]); *(LAS u32x2*)(KKS + j * 72 + c4) = w;
            w.x = cvt_pk_bf16(bs[0], bs[1]); w.y = cvt_pk_bf16(bs[2], bs[3]); *(LAS u32x2*)(BS + j * 72 + c4) = w;
            w.x = cvt_pk_bf16(kds[0], kds[1]); w.y = cvt_pk_bf16(kds[2], kds[3]); *(LAS u32x2*)(KDS + j * 72 + c4) = w;
            w.x = cvt_pk_bf16(rs[0], rs[1]); w.y = cvt_pk_bf16(rs[2], rs[3]); *(LAS u32x2*)(RS + j * 72 + c4) = w;
            if ((tid & 15) == 0) BON[j] = bn;
        }
        __syncthreads();
        if (MODE == 1) continue;
        const int ctg = wid & 1;
        f32x4 accG = (f32x4){0.f, 0.f, 0.f, 0.f}, accY = accG;
        {
            const int pr = wid >> 1, rts = wid & 1;
            const LAS bf16_t* Xm = (pr & 1) ? KDS : BS; const LAS bf16_t* Ym = (pr < 2) ? KKS : RS;
            const bf16x8 a0 = ldsb8(Xm + (rts * 16 + fr) * 72 + fq * 8), a1 = ldsb8(Xm + (rts * 16 + fr) * 72 + 32 + fq * 8);
#pragma unroll
            for (int cts = 0; cts < 2; ++cts) {
                f32x4 acc = (f32x4){0.f, 0.f, 0.f, 0.f};
                acc = __builtin_amdgcn_mfma_f32_16x16x32_bf16(a0, ldsb8(Ym + (cts * 16 + fr) * 72 + fq * 8), acc, 0, 0, 0);
                acc = __builtin_amdgcn_mfma_f32_16x16x32_bf16(a1, ldsb8(Ym + (cts * 16 + fr) * 72 + 32 + fq * 8), acc, 0, 0, 0);
                const int t = cts * 16 + fr, s0 = rts * 16 + fq * 4;
#pragma unroll
                for (int i = 0; i < 4; ++i) { const bool keep = (pr < 2) ? (s0 + i < t) : (s0 + i <= t); acc[i] = keep ? acc[i] : 0.f; }
                if (pr == 0) *(LAS f32x4*)(ABT + t * 32 + s0) = acc;
                else { u32x2 w; w.x = cvt_pk_bf16(acc[0], acc[1]); w.y = cvt_pk_bf16(acc[2], acc[3]); *(LAS u32x2*)((pr == 1 ? AKT : (pr == 2 ? NBT : NKT)) + t * 40 + s0) = w; }
            }
#pragma unroll
            for (int ks = 0; ks < 2; ++ks) { const bf16x8 sa = ldsb8(S0B + (rt * 16 + fr) * 72 + ks * 32 + fq * 8);
                accG = __builtin_amdgcn_mfma_f32_16x16x32_bf16(sa, ldsb8(KKS + (ctg * 16 + fr) * 72 + ks * 32 + fq * 8), accG, 0, 0, 0);
                accY = __builtin_amdgcn_mfma_f32_16x16x32_bf16(sa, ldsb8(RS + (ctg * 16 + fr) * 72 + ks * 32 + fq * 8), accY, 0, 0, 0); }
        }
        __syncthreads();
        {
            const bf16x8 va = ldsb8(VT + (rt * 16 + fr) * 40 + fq * 8);
            accG = __builtin_amdgcn_mfma_f32_16x16x32_bf16(va, ldsb8(AKT + (ctg * 16 + fr) * 40 + fq * 8), accG, 0, 0, 0);
            accY = __builtin_amdgcn_mfma_f32_16x16x32_bf16(va, ldsb8(NKT + (ctg * 16 + fr) * 40 + fq * 8), accY, 0, 0, 0);
#pragma unroll
            for (int i = 0; i < 4; ++i) Gm[(rt * 16 + fq * 4 + i) * 36 + ctg * 16 + fr] = -accG[i];
        }
        __syncthreads();
        if (MODE == 4) continue;
        if (wid < 4) {
            const int v = wid * 16 + (lane >> 2), pq = lane & 3;
            const LAS float* grow = Gm + v * 36;
            f32x4 r0 = *(const LAS f32x4*)(grow + 4 * pq), r1 = *(const LAS f32x4*)(grow + 16 + 4 * pq);
            u32x2 ubo[TB / 4];
            const LAS float* abd = ABT; asm volatile("" : "+v"(abd));
            const LAS float* abq = ABT + 128 * pq; asm volatile("" : "+v"(abq));
            f32x4 dc[3], a0c[4], a1c[4];
            auto ldg = [&](int g, f32x4 (&dd)[3], f32x4 (&aa0)[4], f32x4 (&aa1)[4]) {
#pragma unroll
                for (int x = 0; x < 3; ++x) dd[x] = *(const LAS f32x4*)(abd + (4 * g + 1 + x) * 32 + 4 * g);
#pragma unroll
                for (int jj = 0; jj < 4; ++jj) { if (g < 3) aa0[jj] = *(const LAS f32x4*)(abq + jj * 32 + 4 * g); if (g < 7) aa1[jj] = *(const LAS f32x4*)(abq + (16 + jj) * 32 + 4 * g); } };
            ldg(0, dc, a0c, a1c);
#pragma unroll
            for (int g = 0; g < TB / 4; ++g) {
                f32x4 dn[3], a0n[4], a1n[4];
                if (g + 1 < TB / 4) ldg(g + 1, dn, a0n, a1n);
                __builtin_amdgcn_sched_barrier(0);
                const f32x4 rr = g < 4 ? r0 : r1;
                f32x4 u4;
                u4[0] = rr[0];
                u4[1] = rr[1] - u4[0] * dc[0][0];
                u4[2] = rr[2] - (u4[0] * dc[1][0] + u4[1] * dc[1][1]);
                u4[3] = rr[3] - (u4[0] * dc[2][0] + u4[1] * dc[2][1] + u4[2] * dc[2][2]);
#pragma unroll
                for (int x = 0; x < 4; ++x) { const int ui = __float_as_int(u4[x]); int bi;
                    if ((g & 3) == 0) bi = __builtin_amdgcn_update_dpp(0, ui, 0x00, 0xF, 0xF, true); else if ((g & 3) == 1) bi = __builtin_amdgcn_update_dpp(0, ui, 0x55, 0xF, 0xF, true);
                    else if ((g & 3) == 2) bi = __builtin_amdgcn_update_dpp(0, ui, 0xAA, 0xF, 0xF, true); else bi = __builtin_amdgcn_update_dpp(0, ui, 0xFF, 0xF, 0xF, true);
                    u4[x] = __int_as_float(bi); }
                ubo[g].x = cvt_pk_bf16(u4[0], u4[1]); ubo[g].y = cvt_pk_bf16(u4[2], u4[3]);
                if (g < 3) {
#pragma unroll
                    for (int jj = 0; jj < 4; ++jj) r0[jj] -= u4[0] * a0c[jj][0] + u4[1] * a0c[jj][1] + u4[2] * a0c[jj][2] + u4[3] * a0c[jj][3]; }
                if (g < 7) {
#pragma unroll
                    for (int jj = 0; jj < 4; ++jj) r1[jj] -= u4[0] * a1c[jj][0] + u4[1] * a1c[jj][1] + u4[2] * a1c[jj][2] + u4[3] * a1c[jj][3]; }
                if (g + 1 < TB / 4) {
#pragma unroll
                    for (int x = 0; x < 3; ++x) dc[x] = dn[x];
#pragma unroll
                    for (int jj = 0; jj < 4; ++jj) { a0c[jj] = a0n[jj]; a1c[jj] = a1n[jj]; } }
            }
            if (pq == 0) {
#pragma unroll
                for (int g = 0; g < TB / 4; g += 2) { u32x4 w; w.x = ubo[g].x; w.y = ubo[g].y; w.z = ubo[g + 1].x; w.w = ubo[g + 1].y; *(LAS u32x4*)(UB + v * 40 + 4 * g) = w; } }
        }
        __syncthreads();
        if (MODE == 5) continue;
        {
            const bf16x8 ua = ldsb8(UB + (rt * 16 + fr) * 40 + fq * 8), va = ldsb8(VT + (rt * 16 + fr) * 40 + fq * 8);
            accY = __builtin_amdgcn_mfma_f32_16x16x32_bf16(ua, ldsb8(NBT + (ctg * 16 + fr) * 40 + fq * 8), accY, 0, 0, 0);
            *(LAS f32x4*)(YO + (ctg * 16 + fr) * 64 + rt * 16 + fq * 4) = accY;
#pragma unroll
            for (int cc = 0; cc < 2; ++cc) { const int ct = 2 * (wid & 1) + cc, kcol = ct * 16 + fr;
                f32x4 acc = Sreg[cc];
                acc = __builtin_amdgcn_mfma_f32_16x16x32_bf16(ua, ldsb8(BST + kcol * 40 + fq * 8), acc, 0, 0, 0);
                acc = __builtin_amdgcn_mfma_f32_16x16x32_bf16(va, ldsb8(KDST + kcol * 40 + fq * 8), acc, 0, 0, 0);
                const float g = GC[kcol];
#pragma unroll
                for (int i = 0; i < 4; ++i) acc[i] *= g;
                { const unsigned p0 = cvt_pk_bf16(acc[0], acc[1]), p1 = cvt_pk_bf16(acc[2], acc[3]); LAS bf16_t* sp = S0B + (rt * 16 + fq * 4) * 72 + kcol;
                  sp[0] = (bf16_t)p0; sp[72] = (bf16_t)(p0 >> 16); sp[144] = (bf16_t)p1; sp[216] = (bf16_t)(p1 >> 16); }
                Sreg[cc] = acc; }
        }
        __syncthreads();
        if (!isctx) {
            const int j = tid >> 4, c4 = (tid & 15) * 4, t = d == 0 ? j : TB - 1 - j; const f32x4 y = *(const LAS f32x4*)(YO + j * 64 + c4);
            u32x2 w; w.x = cvt_pk_bf16(y[0], y[1]); w.y = cvt_pk_bf16(y[2], y[3]);
            bf16_t* yb_ = p.Y + ((size_t)d * nlat + grow0) * RW + h * 64;
            *(u32x2*)(yb_ + t * RW + c4) = w;
            if (tid < TB) { const int tt = d == 0 ? tid : TB - 1 - tid; float* bb_ = p.bon + ((size_t)d * nlat + grow0) * NH + h; bb_[tt * NH] = BON[tid]; }
        }
    }
}
template <int MODE = 0>
__device__ __forceinline__ void rwkv_phase2(LAS unsigned char* lds, const In& in, const RwkvP p, int bid, int nblk) {
    const int nchain = 2 * p.nb * NH;
    for (int c = bid; c < nchain; c += nblk) { rwkv_chain2<MODE>(lds, in, p, c); __syncthreads(); }
}
}

namespace mk {
namespace r3 {
constexpr int C2_RAW = 0;
constexpr int C2_MU = C2_RAW + (TB + 2) * RAWW * 2;
constexpr int C2_WUP = C2_MU + 3 * RAWW * 4;
constexpr int C2_AUP = C2_WUP + 64 * 72 * 2;
constexpr int C2_CST = C2_AUP + 64 * 72 * 2;
constexpr int C2_AWD = C2_CST + 5 * 64 * 4;
constexpr int C2_AAD = C2_AWD + TB * 72 * 2;
constexpr int C2_X = C2_AAD + TB * 72 * 2;
constexpr int C2_G = C2_X;
constexpr int C2_UB = C2_G + 64 * 36 * 4;
constexpr int C2_ABT = C2_UB + 64 * 40 * 2;
constexpr int C2_AKT = C2_ABT + 32 * 32 * 4;
constexpr int C2_NBT = C2_AKT + 32 * 40 * 2;
constexpr int C2_NKT = C2_NBT + 32 * 40 * 2;
constexpr int C2_YO = C2_NKT + 32 * 40 * 2;
constexpr int C2_X_END = C2_YO + TB * 64 * 4;
constexpr int C2_LA = C2_X, C2_CUM = C2_LA + TB * 64 * 4;
static_assert(C2_CUM + (TB + 1) * 64 * 4 <= C2_YO, "LA/CUM overlay");
constexpr int C2_KKS = C2_X_END;
constexpr int C2_BS = C2_KKS + TB * 72 * 2, C2_KDS = C2_BS + TB * 72 * 2, C2_RS = C2_KDS + TB * 72 * 2;
constexpr int C2_BST = C2_RS + TB * 72 * 2;
constexpr int C2_KDST = C2_BST + 64 * 40 * 2;
constexpr int C2_VT = C2_KDST + 64 * 40 * 2;
constexpr int C2_S0B = C2_VT + 64 * 40 * 2;
constexpr int C2_GC = C2_S0B + 64 * 72 * 2;
constexpr int C2_BON = C2_GC + 64 * 4;
constexpr int C2_RB = C2_BON + TB * 4;
constexpr int C2_KRB = C2_RB + TB * 64 * 2, C2_VB = C2_KRB + TB * 64 * 2;
constexpr int C2_END = C2_VB + TB * 64 * 2;
static_assert(C2_END <= LDS_BYTES - 16 && (C2_X % 16) == 0 && (C2_KKS % 16) == 0 && (C2_G % 16) == 0 && (C2_UB % 16) == 0 && (C2_ABT % 16) == 0 && (C2_AKT % 16) == 0 && (C2_S0B % 16) == 0, "rwkv2 LDS");

__device__ __forceinline__ bf16x8 ldsb8(const LAS bf16_t* p) { return *(const LAS bf16x8*)p; }

template <int MODE>
__device__ __forceinline__ void rwkv_chain3(LAS unsigned char* lds, const In& in, const RwkvP p, int chain) {
    const int tid = threadIdx.x, lane = tid & 63, wid = tid >> 6, fr = lane & 15, fq = lane >> 4;
    const int d = chain / (p.nb * NH), bl = (chain / NH) % p.nb, h = chain % NH;
    const int nlat = p.nb * SEQ;
    LAS bf16_t* RAW = (LAS bf16_t*)(lds + C2_RAW); LAS float* MU = (LAS float*)(lds + C2_MU);
    LAS bf16_t* WUP = (LAS bf16_t*)(lds + C2_WUP); LAS bf16_t* AUP = (LAS bf16_t*)(lds + C2_AUP); LAS float* CST = (LAS float*)(lds + C2_CST);
    LAS bf16_t* AWD = (LAS bf16_t*)(lds + C2_AWD); LAS bf16_t* AAD = (LAS bf16_t*)(lds + C2_AAD);
    LAS bf16_t *Rb = (LAS bf16_t*)(lds + C2_RB), *KRb = (LAS bf16_t*)(lds + C2_KRB), *Vb = (LAS bf16_t*)(lds + C2_VB); LAS float *LA_ = (LAS float*)(lds + C2_LA), *CUM = (LAS float*)(lds + C2_CUM);
    LAS float *YO = (LAS float*)(lds + C2_YO), *Gm = (LAS float*)(lds + C2_G), *ABT = (LAS float*)(lds + C2_ABT), *GC = (LAS float*)(lds + C2_GC), *BON = (LAS float*)(lds + C2_BON);
    LAS bf16_t *UB = (LAS bf16_t*)(lds + C2_UB), *AKT = (LAS bf16_t*)(lds + C2_AKT), *NBT = (LAS bf16_t*)(lds + C2_NBT), *NKT = (LAS bf16_t*)(lds + C2_NKT);
    LAS bf16_t *KKS = (LAS bf16_t*)(lds + C2_KKS), *BS = (LAS bf16_t*)(lds + C2_BS), *KDS = (LAS bf16_t*)(lds + C2_KDS), *RS = (LAS bf16_t*)(lds + C2_RS);
    LAS bf16_t *BST = (LAS bf16_t*)(lds + C2_BST), *KDST = (LAS bf16_t*)(lds + C2_KDST), *VT = (LAS bf16_t*)(lds + C2_VT), *S0B = (LAS bf16_t*)(lds + C2_S0B);
    auto segcol = [&](int s) __attribute__((always_inline)) { return s < 3 ? s * RW + h * 64 : (s == 3 ? OFF_WD + d * DL : OFF_AD + d * AL); };
    for (int i = tid; i < RAWW; i += NT) { const float m0 = in.shift_mu[segcol(i >> 6) + (i & 63)], m1 = in.shift_mu[RC + segcol(i >> 6) + (i & 63)]; MU[i] = m0; MU[RAWW + i] = m1; MU[2 * RAWW + i] = 1.f - m0 - m1; }
    for (int i = tid; i < 64 * 64; i += NT) { const int j = i >> 6, c = i & 63;
        WUP[c * 72 + j] = f2bf(in.rw_w_up[((size_t)d * DL + j) * RW + h * 64 + c]); AUP[c * 72 + j] = f2bf(in.rw_a_up[((size_t)d * AL + j) * RW + h * 64 + c]); }
    for (int i = tid; i < 64; i += NT) { CST[i] = in.rw_w0[d * RW + h * 64 + i]; CST[64 + i] = in.rw_a0[d * RW + h * 64 + i]; CST[128 + i] = in.rw_k_k[h * 64 + i]; CST[192 + i] = in.rw_k_a[h * 64 + i]; CST[256 + i] = in.rw_r_k[h * 64 + i]; }
    for (int i = tid; i < 64 * 72 / 2; i += NT) ((LAS unsigned*)S0B)[i] = 0u;
    constexpr int NQ = (CTX + SEQ) / TB, NQC = CTX / TB;
    auto blk_info = [&](int q, bool& isctx, int& t0, bool& hp, bool& hn, size_t& grow0) __attribute__((always_inline)) {
        isctx = q < NQC;
        if (isctx) { const int qq = d == 0 ? q : NQC - 1 - q; t0 = qq * TB; hp = t0 > 0; hn = t0 + TB < CTX; grow0 = (size_t)nlat + (size_t)bl * CTX + t0; }
        else { const int ql = q - NQC, qq = d == 0 ? ql : SEQ / TB - 1 - ql; t0 = qq * TB; hp = (t0 % GW) != 0; hn = ((t0 + TB) % GW) != 0; grow0 = (size_t)bl * SEQ + t0; }
    };
    u32x4 pre[RW_PPT]; int poff[RW_PPT], plds[RW_PPT];
#pragma unroll
    for (int k = 0; k < RW_PPT; ++k) { const int i = tid + k * NT, rr = i / 40, sp = i % 40, seg = sp >> 3, part = sp & 7;
        poff[k] = (rr - 1) * Z1_N + segcol(seg) + part * 8; plds[k] = (rr * RAWW + sp * 8) | (i >= RW_NPIECE ? 3 : (rr == 0 ? 1 : (rr == TB + 1 ? 2 : 0))); }
    auto prefetch = [&](int q) __attribute__((always_inline)) {
        bool isctx, hp, hn; int t0; size_t grow0; blk_info(q, isctx, t0, hp, hn, grow0);
        const bf16_t* base = p.z1 + grow0 * Z1_N;
#pragma unroll
        for (int k = 0; k < RW_PPT; ++k) { u32x4 v = (u32x4){0u, 0u, 0u, 0u};
            const int kind = plds[k] & 3; const bool ok = kind == 0 || (kind == 1 && hp) || (kind == 2 && hn);
            if (ok) v = *(const u32x4*)(base + poff[k]);
            pre[k] = v; }
    };
    auto commit = [&]() __attribute__((always_inline)) {
#pragma unroll
        for (int k = 0; k < RW_PPT; ++k) if ((plds[k] & 3) != 3) *(LAS u32x4*)(RAW + (plds[k] & ~3)) = pre[k];
    };
    f32x4 Sreg[2];
    Sreg[0] = (f32x4){0.f, 0.f, 0.f, 0.f}; Sreg[1] = Sreg[0];
    const int rt = wid >> 1;
    auto shift8 = [&](int t, int c0, f32x2 (&s)[4]) __attribute__((always_inline)) {
        const u32x4 xp = *(const LAS u32x4*)(RAW + t * RAWW + c0), xc = *(const LAS u32x4*)(RAW + (t + 1) * RAWW + c0), xn_ = *(const LAS u32x4*)(RAW + (t + 2) * RAWW + c0);
        const f32x4 m0a = *(const LAS f32x4*)(MU + c0), m0b = *(const LAS f32x4*)(MU + c0 + 4), m1a = *(const LAS f32x4*)(MU + RAWW + c0), m1b = *(const LAS f32x4*)(MU + RAWW + c0 + 4),
                    mca = *(const LAS f32x4*)(MU + 2 * RAWW + c0), mcb = *(const LAS f32x4*)(MU + 2 * RAWW + c0 + 4);
#define MK_SH2(J, XP, XC, XN, MC2, M02, M12) { f32x2 C, P, N; C.x = bflo(XC); C.y = bfhi(XC); P.x = bflo(XP); P.y = bfhi(XP); N.x = bflo(XN); N.y = bfhi(XN); f32x2 r_ = MC2 * C; r_ = M02 * P + r_; r_ = M12 * N + r_; s[J] = r_; }
        MK_SH2(0, xp.x, xc.x, xn_.x, mca.lo, m0a.lo, m1a.lo) MK_SH2(1, xp.y, xc.y, xn_.y, mca.hi, m0a.hi, m1a.hi)
        MK_SH2(2, xp.z, xc.z, xn_.z, mcb.lo, m0b.lo, m1b.lo) MK_SH2(3, xp.w, xc.w, xn_.w, mcb.hi, m0b.hi, m1b.hi)
#undef MK_SH2
    };
    auto pack4 = [&](const f32x2 (&s)[4]) __attribute__((always_inline)) { u32x4 w; w.x = cvt_pk_bf16(s[0].x, s[0].y); w.y = cvt_pk_bf16(s[1].x, s[1].y); w.z = cvt_pk_bf16(s[2].x, s[2].y); w.w = cvt_pk_bf16(s[3].x, s[3].y); return w; };
    auto do_shift = [&](int tl, int nth) __attribute__((always_inline)) {
#pragma unroll 1
        for (int it = tl; it < TB * 24; it += nth) {
            const int t = it / 24, g = it % 24, seg = g >> 3, cc = (g & 7) * 8, js = d == 0 ? t : TB - 1 - t; f32x2 s[4]; shift8(t, g * 8, s);
            LAS bf16_t* dst = Rb + seg * (TB * 64) + js * 64 + cc;
            *(LAS u32x4*)dst = pack4(s);
        }
#pragma unroll 1
        for (int it = tl; it < TB * 8; it += nth) { const int t = it >> 3, part = it & 7, js = d == 0 ? t : TB - 1 - t;
            { f32x2 s[4]; shift8(t, (24 + part) * 8, s);
#pragma unroll
              for (int j = 0; j < 4; ++j) { s[j].x = 1.f - 2.f * fast_rcp(1.f + __builtin_amdgcn_exp2f(2.885390081777927f * s[j].x)); s[j].y = 1.f - 2.f * fast_rcp(1.f + __builtin_amdgcn_exp2f(2.885390081777927f * s[j].y)); }
              *(LAS u32x4*)(AWD + js * 72 + part * 8) = pack4(s); }
            { f32x2 s[4]; shift8(t, (32 + part) * 8, s); *(LAS u32x4*)(AAD + js * 72 + part * 8) = pack4(s); }
        }
    };
    prefetch(0);
    commit();
    __syncthreads();
    if (1 < NQ) prefetch(1);
    do_shift(tid & (NT / 2 - 1), NT / 2);
    __syncthreads();
    for (int q = 0; q < NQ; ++q) {
        bool isctx, hp, hn; int t0; size_t grow0; blk_info(q, isctx, t0, hp, hn, grow0);
        {
            const int lora = wid >> 2, ct = wid & 3;
            if (tid < 16) *(LAS f32x4*)(CUM + tid * 4) = (f32x4){0.f, 0.f, 0.f, 0.f};
            const LAS bf16_t* Am = lora ? AAD : AWD; const LAS bf16_t* Bm = lora ? AUP : WUP;
            float carry = 0.f;
#pragma unroll
            for (int r2 = 0; r2 < 2; ++r2) {
                f32x4 acc = (f32x4){0.f, 0.f, 0.f, 0.f};
#pragma unroll
                for (int ks = 0; ks < 2; ++ks) acc = __builtin_amdgcn_mfma_f32_16x16x32_bf16(ldsb8(Am + (r2 * 16 + fr) * 72 + ks * 32 + fq * 8), ldsb8(Bm + (ct * 16 + fr) * 72 + ks * 32 + fq * 8), acc, 0, 0, 0);
                const int col = ct * 16 + fr;
                if (lora == 0) {
                    float c[4];
#pragma unroll
                    for (int i = 0; i < 4; ++i) { const float lw = acc[i] + CST[col]; const float e = 0.60653066f * fast_sigmoid(lw); c[i] = i ? c[i - 1] + e : e;   }
                    const float tot = c[3];
                    float s1 = tot; { const float y = __shfl_up(s1, 16); s1 += fq >= 1 ? y : 0.f; }
                    float s2 = s1;  { const float z = __shfl_up(s1, 32); s2 += fq >= 2 ? z : 0.f; }
                    const float base = carry + s2 - tot;
#pragma unroll
                    for (int i = 0; i < 4; ++i) CUM[(1 + r2 * 16 + fq * 4 + i) * 64 + col] = base + c[i];
                    carry += __shfl(s2, 48 + fr);
                } else {
#pragma unroll
                    for (int i = 0; i < 4; ++i) LA_[(r2 * 16 + fq * 4 + i) * 64 + col] = fast_sigmoid(acc[i] + CST[64 + col]);
                }
            }
        }
        __syncthreads();
        {
            const int j = tid >> 4, c4 = (tid & 15) * 4;
            const u32x2 kp = *(const LAS u32x2*)(KRb + j * 64 + c4), rp = *(const LAS u32x2*)(Rb + j * 64 + c4), vp = *(const LAS u32x2*)(Vb + j * 64 + c4);
            const f32x4 k = (f32x4){bflo(kp.x), bfhi(kp.x), bflo(kp.y), bfhi(kp.y)}, r = (f32x4){bflo(rp.x), bfhi(rp.x), bflo(rp.y), bfhi(rp.y)};
            const f32x4 a = *(const LAS f32x4*)(LA_ + j * 64 + c4);
            const f32x4 cu = *(const LAS f32x4*)(CUM + (j + 1) * 64 + c4), cp = *(const LAS f32x4*)(CUM + j * 64 + c4);
            const f32x4 ckk = *(const LAS f32x4*)(CST + 128 + c4), cka = *(const LAS f32x4*)(CST + 192 + c4), crk = *(const LAS f32x4*)(CST + 256 + c4);
            float kkr[4], kd[4], ss = 0.f, bn = 0.f;
#pragma unroll
            for (int x = 0; x < 4; ++x) { kkr[x] = k[x] * ckk[x]; ss += kkr[x] * kkr[x]; kd[x] = k[x] * (1.f + (a[x] - 1.f) * cka[x]); bn += r[x] * kd[x] * crk[x]; }
            asm volatile("s_nop 1\n\t"
                "v_add_f32_dpp %0, %0, %0 quad_perm:[1,0,3,2] row_mask:0xf bank_mask:0xf\n\t" "v_add_f32_dpp %1, %1, %1 quad_perm:[1,0,3,2] row_mask:0xf bank_mask:0xf\n\ts_nop 0\n\t"
                "v_add_f32_dpp %0, %0, %0 quad_perm:[2,3,0,1] row_mask:0xf bank_mask:0xf\n\t" "v_add_f32_dpp %1, %1, %1 quad_perm:[2,3,0,1] row_mask:0xf bank_mask:0xf\n\ts_nop 0\n\t"
                "v_add_f32_dpp %0, %0, %0 row_half_mirror row_mask:0xf bank_mask:0xf\n\t" "v_add_f32_dpp %1, %1, %1 row_half_mirror row_mask:0xf bank_mask:0xf\n\ts_nop 0\n\t"
                "v_add_f32_dpp %0, %0, %0 row_mirror row_mask:0xf bank_mask:0xf\n\t" "v_add_f32_dpp %1, %1, %1 row_mirror row_mask:0xf bank_mask:0xf"
                : "+v"(ss), "+v"(bn));
            const float inv = __builtin_amdgcn_rsqf(fmaxf(ss, 1e-24f));
            float kks[4], bs[4], kds[4], rs[4]; f32x4 gv;
#pragma unroll
            for (int x = 0; x < 4; ++x) { const float kk = kkr[x] * inv, bb = kk * a[x];
                const float ig = __expf(cu[x]), g = fast_rcp(ig), gp = __expf(-cp[x]);
                kks[x] = kk * gp; bs[x] = bb * ig; kds[x] = kd[x] * ig; rs[x] = r[x] * g; gv[x] = g;
            }
            if (j == TB - 1) *(LAS f32x4*)(GC + c4) = gv;
#pragma unroll
            for (int x = 0; x < 4; x += 2) { const unsigned pb = cvt_pk_bf16(bs[x], bs[x + 1]), pk = cvt_pk_bf16(kds[x], kds[x + 1]), pv = x ? vp.y : vp.x;
                BST[(c4 + x) * 40 + j] = (bf16_t)pb; BST[(c4 + x + 1) * 40 + j] = (bf16_t)(pb >> 16); KDST[(c4 + x) * 40 + j] = (bf16_t)pk; KDST[(c4 + x + 1) * 40 + j] = (bf16_t)(pk >> 16);
                VT[(c4 + x) * 40 + j] = (bf16_t)pv; VT[(c4 + x + 1) * 40 + j] = (bf16_t)(pv >> 16); }
            u32x2 w; w.x = cvt_pk_bf16(kks[0], kks[1]); w.y = cvt_pk_bf16(kks[2], kks[3]); *(LAS u32x2*)(KKS + j * 72 + c4) = w;
            w.x = cvt_pk_bf16(bs[0], bs[1]); w.y = cvt_pk_bf16(bs[2], bs[3]); *(LAS u32x2*)(BS + j * 72 + c4) = w;
            w.x = cvt_pk_bf16(kds[0], kds[1]); w.y = cvt_pk_bf16(kds[2], kds[3]); *(LAS u32x2*)(KDS + j * 72 + c4) = w;
            w.x = cvt_pk_bf16(rs[0], rs[1]); w.y = cvt_pk_bf16(rs[2], rs[3]); *(LAS u32x2*)(RS + j * 72 + c4) = w;
            if ((tid & 15) == 0) BON[j] = bn;
        }
        __syncthreads();
        const int ctg = wid & 1;
        f32x4 accG = (f32x4){0.f, 0.f, 0.f, 0.f}, accY = accG;
        {
            const int pr = wid >> 1, rts = wid & 1;
            const LAS bf16_t* Xm = (pr & 1) ? KDS : BS; const LAS bf16_t* Ym = (pr < 2) ? KKS : RS;
            const bf16x8 a0 = ldsb8(Xm + (rts * 16 + fr) * 72 + fq * 8), a1 = ldsb8(Xm + (rts * 16 + fr) * 72 + 32 + fq * 8);
#pragma unroll
            for (int cts = 0; cts < 2; ++cts) {
                f32x4 acc = (f32x4){0.f, 0.f, 0.f, 0.f};
                acc = __builtin_amdgcn_mfma_f32_16x16x32_bf16(a0, ldsb8(Ym + (cts * 16 + fr) * 72 + fq * 8), acc, 0, 0, 0);
                acc = __builtin_amdgcn_mfma_f32_16x16x32_bf16(a1, ldsb8(Ym + (cts * 16 + fr) * 72 + 32 + fq * 8), acc, 0, 0, 0);
                const int t = cts * 16 + fr, s0 = rts * 16 + fq * 4;
#pragma unroll
                for (int i = 0; i < 4; ++i) { const bool keep = (pr < 2) ? (s0 + i < t) : (s0 + i <= t); acc[i] = keep ? acc[i] : 0.f; }
                if (pr == 0) { ABT[s0 * 32 + t] = acc[0]; ABT[(s0 + 1) * 32 + t] = acc[1]; ABT[(s0 + 2) * 32 + t] = acc[2]; ABT[(s0 + 3) * 32 + t] = acc[3]; }
                else { u32x2 w; w.x = cvt_pk_bf16(acc[0], acc[1]); w.y = cvt_pk_bf16(acc[2], acc[3]); *(LAS u32x2*)((pr == 1 ? AKT : (pr == 2 ? NBT : NKT)) + t * 40 + s0) = w; }
            }
#pragma unroll
            for (int ks = 0; ks < 2; ++ks) { const bf16x8 sa = ldsb8(S0B + (rt * 16 + fr) * 72 + ks * 32 + fq * 8);
                accG = __builtin_amdgcn_mfma_f32_16x16x32_bf16(sa, ldsb8(KKS + (ctg * 16 + fr) * 72 + ks * 32 + fq * 8), accG, 0, 0, 0);
                accY = __builtin_amdgcn_mfma_f32_16x16x32_bf16(sa, ldsb8(RS + (ctg * 16 + fr) * 72 + ks * 32 + fq * 8), accY, 0, 0, 0); }
        }
        __syncthreads();
        {
            const bf16x8 va = ldsb8(VT + (rt * 16 + fr) * 40 + fq * 8);
            accG = __builtin_amdgcn_mfma_f32_16x16x32_bf16(va, ldsb8(AKT + (ctg * 16 + fr) * 40 + fq * 8), accG, 0, 0, 0);
            accY = __builtin_amdgcn_mfma_f32_16x16x32_bf16(va, ldsb8(NKT + (ctg * 16 + fr) * 40 + fq * 8), accY, 0, 0, 0);
#pragma unroll
            for (int i = 0; i < 4; ++i) Gm[(rt * 16 + fq * 4 + i) * 36 + ctg * 16 + fr] = -accG[i];
            if (q + 1 < NQ) { commit(); if (q + 2 < NQ) prefetch(q + 2); }
        }
        __syncthreads();
        if (wid >= 4) { if (q + 1 < NQ) do_shift(tid & (NT / 2 - 1), NT / 2); }
        else {
            const int v = wid * 16 + (lane >> 2), pq = lane & 3;
            const LAS float* grow = Gm + v * 36;
            f32x4 r0 = *(const LAS f32x4*)(grow + 4 * pq), r1 = *(const LAS f32x4*)(grow + 16 + 4 * pq);
            u32x2 ubo[TB / 4];
            const LAS float* abq = ABT + 4 * pq; asm volatile("" : "+v"(abq));
            f32x4 a0c[4], a1c[4];
            auto ldg = [&](int g, f32x4 (&aa0)[4], f32x4 (&aa1)[4]) __attribute__((always_inline)) {
#pragma unroll
                for (int x = 0; x < 4; ++x) { if (g < 4) aa0[x] = *(const LAS f32x4*)(abq + (4 * g + x) * 32); aa1[x] = *(const LAS f32x4*)(abq + (4 * g + x) * 32 + 16); } };
            ldg(0, a0c, a1c);
#pragma unroll
            for (int g = 0; g < TB / 4; ++g) {
                f32x4 a0n[4], a1n[4];
                if (g + 1 < TB / 4) ldg(g + 1, a0n, a1n);
                __builtin_amdgcn_sched_barrier(0);
                const f32x4 rr = g < 4 ? r0 : r1;
                f32x4 dg[3];
#pragma unroll
                for (int x = 0; x < 3; ++x) dg[x] = g < 4 ? a0c[x] : a1c[x];
                f32x4 u4;
                u4[0] = rr[0];
                u4[1] = __builtin_fmaf(-u4[0], dg[0][1], rr[1]);
                u4[2] = __builtin_fmaf(-u4[1], dg[1][2], __builtin_fmaf(-u4[0], dg[0][2], rr[2]));
                u4[3] = __builtin_fmaf(-u4[2], dg[2][3], __builtin_fmaf(-u4[1], dg[1][3], __builtin_fmaf(-u4[0], dg[0][3], rr[3])));
#pragma unroll
                for (int x = 0; x < 4; ++x) { const int ui = __float_as_int(u4[x]); int bi;
                    if ((g & 3) == 0) bi = __builtin_amdgcn_update_dpp(0, ui, 0x00, 0xF, 0xF, true); else if ((g & 3) == 1) bi = __builtin_amdgcn_update_dpp(0, ui, 0x55, 0xF, 0xF, true);
                    else if ((g & 3) == 2) bi = __builtin_amdgcn_update_dpp(0, ui, 0xAA, 0xF, 0xF, true); else bi = __builtin_amdgcn_update_dpp(0, ui, 0xFF, 0xF, 0xF, true);
                    u4[x] = __int_as_float(bi); }
                ubo[g].x = cvt_pk_bf16(u4[0], u4[1]); ubo[g].y = cvt_pk_bf16(u4[2], u4[3]);
                if (g < 3) {
                    f32x2 lo = r0.lo, hi = r0.hi;
#pragma unroll
                    for (int x = 0; x < 4; ++x) { const f32x2 ux = (f32x2){u4[x], u4[x]}; lo = lo - ux * a0c[x].lo; hi = hi - ux * a0c[x].hi; }
                    r0.lo = lo; r0.hi = hi; }
                if (g < 7) {
                    f32x2 lo = r1.lo, hi = r1.hi;
#pragma unroll
                    for (int x = 0; x < 4; ++x) { const f32x2 ux = (f32x2){u4[x], u4[x]}; lo = lo - ux * a1c[x].lo; hi = hi - ux * a1c[x].hi; }
                    r1.lo = lo; r1.hi = hi; }
                if (g + 1 < TB / 4) {
#pragma unroll
                    for (int x = 0; x < 4; ++x) { a0c[x] = a0n[x]; a1c[x] = a1n[x]; } }
            }
            if (pq == 0) {
#pragma unroll
                for (int g = 0; g < TB / 4; g += 2) { u32x4 w; w.x = ubo[g].x; w.y = ubo[g].y; w.z = ubo[g + 1].x; w.w = ubo[g + 1].y; *(LAS u32x4*)(UB + v * 40 + 4 * g) = w; } }
        }
        __syncthreads();
        {
            const bf16x8 ua = ldsb8(UB + (rt * 16 + fr) * 40 + fq * 8), va = ldsb8(VT + (rt * 16 + fr) * 40 + fq * 8);
            accY = __builtin_amdgcn_mfma_f32_16x16x32_bf16(ua, ldsb8(NBT + (ctg * 16 + fr) * 40 + fq * 8), accY, 0, 0, 0);
            *(LAS f32x4*)(YO + (ctg * 16 + fr) * 64 + rt * 16 + fq * 4) = accY;
#pragma unroll
            for (int cc = 0; cc < 2; ++cc) { const int ct = 2 * (wid & 1) + cc, kcol = ct * 16 + fr;
                f32x4 acc = Sreg[cc];
                acc = __builtin_amdgcn_mfma_f32_16x16x32_bf16(ua, ldsb8(BST + kcol * 40 + fq * 8), acc, 0, 0, 0);
                acc = __builtin_amdgcn_mfma_f32_16x16x32_bf16(va, ldsb8(KDST + kcol * 40 + fq * 8), acc, 0, 0, 0);
                const float g = GC[kcol];
#pragma unroll
                for (int i = 0; i < 4; ++i) acc[i] *= g;
                { const unsigned p0 = cvt_pk_bf16(acc[0], acc[1]), p1 = cvt_pk_bf16(acc[2], acc[3]); LAS bf16_t* sp = S0B + (rt * 16 + fq * 4) * 72 + kcol;
                  sp[0] = (bf16_t)p0; sp[72] = (bf16_t)(p0 >> 16); sp[144] = (bf16_t)p1; sp[216] = (bf16_t)(p1 >> 16); }
                Sreg[cc] = acc; }
        }
        __syncthreads();
        if (!isctx) {
            const int j = tid >> 4, c4 = (tid & 15) * 4, t = d == 0 ? j : TB - 1 - j; const f32x4 y = *(const LAS f32x4*)(YO + j * 64 + c4);
            u32x2 w; w.x = cvt_pk_bf16(y[0], y[1]); w.y = cvt_pk_bf16(y[2], y[3]);
            bf16_t* yb_ = p.Y + ((size_t)d * nlat + grow0) * RW + h * 64;
            *(u32x2*)(yb_ + t * RW + c4) = w;
            if (tid < TB) { const int tt = d == 0 ? tid : TB - 1 - tid; float* bb_ = p.bon + ((size_t)d * nlat + grow0) * NH + h; bb_[tt * NH] = BON[tid]; }
        }
    }
}
template <int MODE = 0>
__device__ __forceinline__ void rwkv_phase3(LAS unsigned char* lds, const In& in, const RwkvP p, int bid, int nblk) {
    const int nchain = 2 * p.nb * NH;
    for (int c = bid; c < nchain; c += nblk) { rwkv_chain3<MODE>(lds, in, p, c); __syncthreads(); }
}
}
}

namespace mk {
constexpr int LR_XT = 0;
constexpr int LR_XC = LR_XT + 67 * 64 * 2 + 64;
constexpr int LR_XCB = LR_XC + 64 * 64 * 4;
constexpr int LR_GWT = LR_XCB + 64 * 72 * 2;
constexpr int LR_A = LR_GWT + 2 * 64 * 72 * 2;
constexpr int LR_BX = LR_A + 64 * 64 * 4;
constexpr int LR_HO = LR_BX + 64 * 64 * 4;
constexpr int LR_CST = LR_HO + 64 * 64 * 4;
constexpr int LR_SEGP = LR_CST + 8 * 64 * 4;
constexpr int LR_SEGH = LR_SEGP + 8 * 64 * 4;
constexpr int LR_HC = LR_SEGH + 8 * 64 * 4;
constexpr int LR_END = LR_HC + 64 * 4;
static_assert(LR_END <= LDS_BYTES && (LR_XC % 16) == 0, "lru LDS");

struct LruP { const bf16_t* z1; bf16_t* Hd; int b0, nb; };

__device__ __forceinline__ void lru_item(LAS unsigned char* lds, const In& in, const LruP p, int item) {
    const int tid = threadIdx.x, lane = tid & 63, wid = tid >> 6;
    const int d = item / (p.nb * LB), bl = (item / LB) % p.nb, n = item % LB;
    const int nlat = p.nb * SEQ;
    LAS bf16_t* XT = (LAS bf16_t*)(lds + LR_XT); LAS float* XC = (LAS float*)(lds + LR_XC); LAS bf16_t* XCB = (LAS bf16_t*)(lds + LR_XCB); LAS bf16_t* GWT = (LAS bf16_t*)(lds + LR_GWT);
    LAS float *A_ = (LAS float*)(lds + LR_A), *BX = (LAS float*)(lds + LR_BX), *HO = (LAS float*)(lds + LR_HO), *CST = (LAS float*)(lds + LR_CST), *SEGP = (LAS float*)(lds + LR_SEGP), *SEGH = (LAS float*)(lds + LR_SEGH), *HC = (LAS float*)(lds + LR_HC);
    for (int i = tid; i < 2 * 64 * 64; i += NT) { const int g = i >> 12, j = (i >> 6) & 63, k = i & 63;
        GWT[(g * 64 + k) * 72 + j] = f2bf(in.lru_gate_w[((((size_t)d * 2 + g) * LB + n) * LBS + j) * LBS + k]); }
    for (int i = tid; i < 64; i += NT) { const int c = n * 64 + i;
        CST[i] = in.lru_conv_w[c]; CST[64 + i] = in.lru_conv_w[LW + c]; CST[128 + i] = in.lru_conv_w[2 * LW + c]; CST[192 + i] = in.lru_conv_w[3 * LW + c]; CST[256 + i] = in.lru_conv_b[c];
        CST[320 + i] = in.lru_gate_b[((d * 2 + 0) * LB + n) * LBS + i]; CST[384 + i] = in.lru_gate_b[((d * 2 + 1) * LB + n) * LBS + i]; CST[448 + i] = softplusf_(-in.lru_l[d * LW + c]); }
    constexpr int NSEG = CTX / 64 + GW, NSC = CTX / 64;
    u32x4 pre[2];
    auto tok_row = [&](int sidx, int rr, bool& ok) -> size_t {
        if (sidx < NSC) { const int t = sidx * 64 + rr - 2; ok = t >= 0 && t < CTX; return (size_t)nlat + (size_t)bl * CTX + t; }
        const int col = sidx - NSC, row = rr - 2; ok = row >= 0 && row < ROWS; return (size_t)bl * SEQ + (size_t)row * GW + col;
    };
    auto seg_of = [&](int q) { if (q < NSC) return d == 0 ? q : NSC - 1 - q; const int ql = q - NSC; return NSC + (d == 0 ? ql : GW - 1 - ql); };
    auto prefetch = [&](int q) { const int sidx = seg_of(q);
#pragma unroll
        for (int k = 0; k < 2; ++k) { const int i = tid + k * NT; u32x4 v = (u32x4){0u, 0u, 0u, 0u};
            if (i < 67 * 8) { const int rr = i >> 3, part = i & 7; bool ok; const size_t gr = tok_row(sidx, rr, ok); if (ok) v = *(const u32x4*)(p.z1 + gr * Z1_N + Z1_LX + n * 64 + part * 8); }
            pre[k] = v; } };
    auto commit = [&]() {
#pragma unroll
        for (int k = 0; k < 2; ++k) { const int i = tid + k * NT; if (i < 67 * 8) *(LAS u32x4*)(XT + (i >> 3) * 64 + (i & 7) * 8) = pre[k]; } };
    if (tid < 64) HC[tid] = 0.f;
    prefetch(0);
    for (int q = 0; q < NSEG; ++q) {
        const int sidx = seg_of(q);
        commit();
        __syncthreads();
        if (q + 1 < NSEG) prefetch(q + 1);
        { const int t = tid >> 3, c0 = (tid & 7) * 8; float s[8];
#pragma unroll
          for (int j = 0; j < 8; ++j) s[j] = CST[256 + c0 + j];
#pragma unroll
          for (int tap = 0; tap < 4; ++tap) { const u32x4 x = *(const LAS u32x4*)(XT + (t + tap) * 64 + c0);
#pragma unroll
              for (int j = 0; j < 4; ++j) { s[2 * j] += CST[tap * 64 + c0 + 2 * j] * bflo(x[j]); s[2 * j + 1] += CST[tap * 64 + c0 + 2 * j + 1] * bfhi(x[j]); } }
          *(LAS f32x4*)(XC + t * 64 + c0) = (f32x4){s[0], s[1], s[2], s[3]}; *(LAS f32x4*)(XC + t * 64 + c0 + 4) = (f32x4){s[4], s[5], s[6], s[7]};
          u32x4 w; w.x = cvt_pk_bf16(s[0], s[1]); w.y = cvt_pk_bf16(s[2], s[3]); w.z = cvt_pk_bf16(s[4], s[5]); w.w = cvt_pk_bf16(s[6], s[7]); *(LAS u32x4*)(XCB + t * 72 + c0) = w; }
        __syncthreads();
        { const int rt = wid >> 1, fr = lane & 15, fq = lane >> 4;
          bf16x8 a[2];
#pragma unroll
          for (int ks = 0; ks < 2; ++ks) a[ks] = *(const LAS bf16x8*)(XCB + (rt * 16 + fr) * 72 + ks * 32 + fq * 8);
#pragma unroll
          for (int cc = 0; cc < 2; ++cc) { const int ct = 2 * (wid & 1) + cc, col = ct * 16 + fr;
              f32x4 acc0 = (f32x4){0.f, 0.f, 0.f, 0.f}, acc1 = acc0;
#pragma unroll
              for (int ks = 0; ks < 2; ++ks) {
                  const bf16x8 b0 = *(const LAS bf16x8*)(GWT + (0 * 64 + col) * 72 + ks * 32 + fq * 8), b1 = *(const LAS bf16x8*)(GWT + (1 * 64 + col) * 72 + ks * 32 + fq * 8);
                  acc0 = __builtin_amdgcn_mfma_f32_16x16x32_bf16(a[ks], b0, acc0, 0, 0, 0); acc1 = __builtin_amdgcn_mfma_f32_16x16x32_bf16(a[ks], b1, acc1, 0, 0, 0); }
#pragma unroll
              for (int i = 0; i < 4; ++i) { const int t = rt * 16 + fq * 4 + i;
                  const float rec = fast_sigmoid(acc0[i] + CST[320 + col]), inp = fast_sigmoid(acc1[i] + CST[384 + col]);
                  const float la = -8.f * rec * CST[448 + col];
                  const float av = __expf(la), x2 = 2.f * la; const float om = x2 > -0.03f ? -x2 * (1.f + x2 * (0.5f + x2 * (1.f / 6.f))) : 1.f - av * av;
                  A_[t * 64 + col] = av; BX[t * 64 + col] = __builtin_amdgcn_sqrtf(om) * inp * XC[t * 64 + col]; } } }
        __syncthreads();
        { const int ch = tid & 63, pc = tid >> 6; float av[8], bv[8]; float P = 1.f, H = 0.f;
#pragma unroll
          for (int x = 0; x < 8; ++x) { const int st = pc * 8 + x, t = d == 0 ? st : 63 - st; av[x] = A_[t * 64 + ch]; bv[x] = BX[t * 64 + ch]; H = av[x] * H + bv[x]; P *= av[x]; }
          SEGP[pc * 64 + ch] = P; SEGH[pc * 64 + ch] = H;
          __syncthreads();
          float h = HC[ch];
#pragma unroll
          for (int q2 = 0; q2 < 7; ++q2) if (q2 < pc) h = SEGP[q2 * 64 + ch] * h + SEGH[q2 * 64 + ch];
#pragma unroll
          for (int x = 0; x < 8; ++x) { const int st = pc * 8 + x, t = d == 0 ? st : 63 - st; h = av[x] * h + bv[x]; HO[t * 64 + ch] = h; }
          __syncthreads();
          if (pc == 7) HC[ch] = h;
        }
        if (sidx >= NSC) { const int col = sidx - NSC, t = tid >> 3, c0 = (tid & 7) * 8;
            const f32x4 x = *(const LAS f32x4*)(HO + t * 64 + c0), y = *(const LAS f32x4*)(HO + t * 64 + c0 + 4);
            *(u32x4*)(p.Hd + ((size_t)d * nlat + (size_t)bl * SEQ + (size_t)t * GW + col) * LW + n * 64 + c0) = pack8(x, y); }
    }
}
__device__ __forceinline__ void lru_phase(LAS unsigned char* lds, const In& in, const LruP p, int bid, int nblk) {
    const int nitem = 2 * p.nb * LB;
    for (int it = bid; it < nitem; it += nblk) { lru_item(lds, in, p, it); __syncthreads(); }
}
}

namespace mk {
#define MK_DPPX(x, ctrl) __int_as_float(__builtin_amdgcn_update_dpp(__float_as_int(x), __float_as_int(x), ctrl, 0xF, 0xF, false))
__device__ __forceinline__ float allreduce4(float x) { x += MK_DPPX(x, 0xB1); x += MK_DPPX(x, 0x4E); return x; }
__device__ __forceinline__ void unpack8(const u32x4 w, float (&f)[8]) {
#pragma unroll
    for (int j = 0; j < 4; ++j) { f[2 * j] = bflo(w[j]); f[2 * j + 1] = bfhi(w[j]); } }
constexpr int AG_K = 256;
struct PostP { const bf16_t* z1; bf16_t* Y; const float* bon; bf16_t* Ag; int nlat; int pad_; };
__device__ __forceinline__ void rwkv_post_rows(const In& in, const PostP p, int row_lo, int row_hi, bool dry = false) {
    const int lane = threadIdx.x & 63, wid = threadIdx.x >> 6, c0 = lane * 16, h = lane >> 2;
    float mu0v[16], mu1v[16], l0[16], l1[16], mg0[8], mg1[8];
#pragma unroll
    for (int j = 0; j < 16; ++j) { mu0v[j] = in.shift_mu[OFF_V + c0 + j]; mu1v[j] = in.shift_mu[RC + OFF_V + c0 + j]; l0[j] = in.rw_lnx[c0 + j]; l1[j] = in.rw_lnx[RW + c0 + j]; }
#pragma unroll
    for (int j = 0; j < 8; ++j) { const int c = OFF_GD + (lane < GL / 8 ? lane : 0) * 8 + j; mg0[j] = in.shift_mu[c]; mg1[j] = in.shift_mu[RC + c]; }
    for (int r = row_lo + wid; r < row_hi; r += NT / 64) {
        const int cg = r % GW; const bool hp = cg > 0, hn = cg < GW - 1;
        bf16_t* y0p = p.Y + (size_t)r * RW + c0; const bf16_t* y1p = p.Y + ((size_t)p.nlat + r) * RW + c0;
        float y[16], t8[8];
        unpack8(*(const u32x4*)y0p, t8);
#pragma unroll
        for (int j = 0; j < 8; ++j) y[j] = t8[j];
        unpack8(*(const u32x4*)(y0p + 8), t8);
#pragma unroll
        for (int j = 0; j < 8; ++j) y[8 + j] = t8[j];
        unpack8(*(const u32x4*)y1p, t8);
#pragma unroll
        for (int j = 0; j < 8; ++j) y[j] += t8[j];
        unpack8(*(const u32x4*)(y1p + 8), t8);
#pragma unroll
        for (int j = 0; j < 8; ++j) y[8 + j] += t8[j];
        float s = 0.f;
#pragma unroll
        for (int j = 0; j < 16; ++j) s += y[j];
        const float mu = allreduce4(s) * (1.f / 64.f); float q = 0.f;
#pragma unroll
        for (int j = 0; j < 16; ++j) { const float dlt = y[j] - mu; q += dlt * dlt; }
        const float rs = 1.f / sqrtf(allreduce4(q) * (1.f / 64.f) + LNX_EPS);
        const float bonus = p.bon[(size_t)r * NH + h] + p.bon[((size_t)p.nlat + r) * NH + h];
        const bf16_t* zr = p.z1 + (size_t)r * Z1_N;
#pragma unroll
        for (int half = 0; half < 2; ++half) {
            const int c = OFF_V + c0 + half * 8; float xv[8], pv[8], nv[8];
            unpack8(*(const u32x4*)(zr + c), xv);
            if (hp) unpack8(*(const u32x4*)(zr - Z1_N + c), pv); else {
#pragma unroll
                for (int j = 0; j < 8; ++j) pv[j] = 0.f; }
            if (hn) unpack8(*(const u32x4*)(zr + Z1_N + c), nv); else {
#pragma unroll
                for (int j = 0; j < 8; ++j) nv[j] = 0.f; }
            float o[8];
#pragma unroll
            for (int j = 0; j < 8; ++j) { const int cj = half * 8 + j; const float v = xv[j] + mu0v[cj] * (pv[j] - xv[j]) + mu1v[cj] * (nv[j] - xv[j]);
                o[j] = (y[cj] - mu) * rs * l0[cj] + l1[cj] + bonus * v; }
            u32x4 w; w.x = cvt_pk_bf16(o[0], o[1]); w.y = cvt_pk_bf16(o[2], o[3]); w.z = cvt_pk_bf16(o[4], o[5]); w.w = cvt_pk_bf16(o[6], o[7]); if (!dry) *(u32x4*)(y0p + half * 8) = w; else if (w.x == 0x12345678u) *(u32x4*)(y0p + half * 8) = w;
        }
        if (lane < 32) { u32x4 w = (u32x4){0u, 0u, 0u, 0u};
            if (lane < GL / 8) { const int c = OFF_GD + lane * 8; float xv[8], pv[8], nv[8];
                unpack8(*(const u32x4*)(zr + c), xv);
                if (hp) unpack8(*(const u32x4*)(zr - Z1_N + c), pv); else {
#pragma unroll
                    for (int j = 0; j < 8; ++j) pv[j] = 0.f; }
                if (hn) unpack8(*(const u32x4*)(zr + Z1_N + c), nv); else {
#pragma unroll
                    for (int j = 0; j < 8; ++j) nv[j] = 0.f; }
                float o[8];
#pragma unroll
                for (int j = 0; j < 8; ++j) o[j] = fast_sigmoid(xv[j] + mg0[j] * (pv[j] - xv[j]) + mg1[j] * (nv[j] - xv[j]));
                w.x = cvt_pk_bf16(o[0], o[1]); w.y = cvt_pk_bf16(o[2], o[3]); w.z = cvt_pk_bf16(o[4], o[5]); w.w = cvt_pk_bf16(o[6], o[7]); }
            *(u32x4*)(p.Ag + (size_t)r * AG_K + lane * 8) = w; }
    }
}
#define MK_FR_ROW(f) ((((f) >> 3) * HALF) + wr * 64 + ((((f) >> 1) & 3) * 16) + fr)
#define MK_FR_COL(f) ((((f) & 1) * HALF) + wc * 32 + 8 * fq)
#define MK_FR_ACC(f, n) acc[(f) >> 3][(f) & 1][((f) >> 1) & 3][n]
#define MK_FENCE asm volatile("" ::: "memory")
struct EpiYa { const bf16_t* yn; bf16_t* ya;
    __device__ __forceinline__ bool operator()(f32x4 (&acc)[2][2][4][2], const Unit& u, int wr, int wc, int fr, int fq) const {
        const size_t base = (size_t)(u.pm * BM) * RW + u.pn * BM;
        u32x4 cur = *(const u32x4*)(yn + base + (size_t)MK_FR_ROW(0) * RW + MK_FR_COL(0));
#pragma unroll
        for (int f = 0; f < 16; ++f) { u32x4 nxt = cur; if (f + 1 < 16) nxt = *(const u32x4*)(yn + base + (size_t)MK_FR_ROW(f + 1) * RW + MK_FR_COL(f + 1));
            MK_FENCE; float v[8]; unpack8(cur, v); f32x4 a = MK_FR_ACC(f, 0), b = MK_FR_ACC(f, 1);
#pragma unroll
            for (int j = 0; j < 4; ++j) { a[j] *= v[j]; b[j] *= v[4 + j]; }
            *(u32x4*)(ya + base + (size_t)MK_FR_ROW(f) * RW + MK_FR_COL(f)) = pack8(a, b); MK_FENCE; cur = nxt; }
        return false; } };
struct EpiZc { const bf16_t* Hd; bf16_t* yb; bf16_t* gates; int nlat; int pad_;
    __device__ __forceinline__ bool operator()(f32x4 (&acc)[2][2][4][2], const Unit& u, int wr, int wc, int fr, int fq) const {
        if (u.pn < LW / BM) {
            MK_FRAG_LOOP(r, c) { const size_t o = (size_t)(u.pm * BM + r) * LW + u.pn * BM + c; float h0[8], h1[8]; unpack8(*(const u32x4*)(Hd + o), h0); unpack8(*(const u32x4*)(Hd + (size_t)nlat * LW + o), h1);
                f32x4 a = acc[ai][bj][m][0], b = acc[ai][bj][m][1];
#pragma unroll
                for (int j = 0; j < 4; ++j) { a[j] = gelu_tanhf_(a[j]) * (h0[j] + h1[j]); b[j] = gelu_tanhf_(b[j]) * (h0[4 + j] + h1[4 + j]); }
                *(u32x4*)(yb + o) = pack8(a, b); asm volatile("" ::: "memory"); }
        } else {
            MK_FRAG_LOOP(r, c) { const size_t o = (size_t)(u.pm * BM + r) * (2 * D) + (u.pn * BM - LW) + c;
                f32x4 a = acc[ai][bj][m][0], b = acc[ai][bj][m][1];
#pragma unroll
                for (int j = 0; j < 4; ++j) { a[j] = fast_sigmoid(a[j]); b[j] = fast_sigmoid(b[j]); }
                *(u32x4*)(gates + o) = pack8(a, b); }
        }
        return false; } };
struct PairOrder { StaticOrder S;
    __device__ bool next(int i, Unit& u) const { if (!S.next(i >> 1, u)) return false; u.e = i & 1; return true; } };
struct EpiBranch { const bf16_t* gates; bf16_t* mixed;
    __device__ __forceinline__ bool operator()(f32x4 (&acc)[2][2][4][2], const Unit& u, int wr, int wc, int fr, int fq) const {
        const size_t gbase = (size_t)(u.pm * BM) * (2 * D) + u.pn * BM, mbase = (size_t)(u.pm * BM) * D + u.pn * BM;
        u32x4 c1 = (u32x4){0u, 0u, 0u, 0u}, c2 = *(const u32x4*)(gates + gbase + (size_t)MK_FR_ROW(0) * (2 * D) + D + MK_FR_COL(0));
        if (u.e == 0) c1 = *(const u32x4*)(gates + gbase + (size_t)MK_FR_ROW(0) * (2 * D) + MK_FR_COL(0));
#pragma unroll
        for (int f = 0; f < 16; ++f) { u32x4 n1 = c1, n2 = c2;
            if (f + 1 < 16) { const size_t o = gbase + (size_t)MK_FR_ROW(f + 1) * (2 * D) + MK_FR_COL(f + 1); n2 = *(const u32x4*)(gates + o + D); if (u.e == 0) n1 = *(const u32x4*)(gates + o); }
            MK_FENCE; float g1[8], g2[8]; unpack8(c1, g1); unpack8(c2, g2);
            if (u.e == 0) {
#pragma unroll
                for (int j = 0; j < 4; ++j) { MK_FR_ACC(f, 0)[j] *= g1[j] / g2[j]; MK_FR_ACC(f, 1)[j] *= g1[4 + j] / g2[4 + j]; }
            } else { f32x4 a = MK_FR_ACC(f, 0), b = MK_FR_ACC(f, 1);
#pragma unroll
                for (int j = 0; j < 4; ++j) { a[j] *= g2[j]; b[j] *= g2[4 + j]; }
                *(u32x4*)(mixed + mbase + (size_t)MK_FR_ROW(f) * D + MK_FR_COL(f)) = pack8(a, b); }
            MK_FENCE; c1 = n1; c2 = n2; }
        return u.e == 0; } };
struct EpiF32 { float* C; long ldc;
    __device__ __forceinline__ bool operator()(f32x4 (&acc)[2][2][4][2], const Unit& u, int wr, int wc, int fr, int fq) const {
        MK_FRAG_LOOP(r, c) { float* o = C + (size_t)(u.pm * BM + r) * ldc + u.pn * BM + c; *(f32x4*)o = acc[ai][bj][m][0]; *(f32x4*)(o + 4) = acc[ai][bj][m][1]; }
        return false; } };
}

namespace mk {
constexpr int NEX = NE + 1;
constexpr int SLOTS_PER_TOK = TOPK + 1;
constexpr int RP_MOD = 0;
constexpr int RP_UH = RP_MOD + 3 * D * 4;
constexpr int RP_UL = RP_UH + 16 * (D + 8) * 2;
constexpr int RP_PART = RP_UL + 16 * (D + 8) * 2;
constexpr int RP_LOG = RP_PART + 8 * 16 * 64 * 4;
constexpr int RP_HIST = RP_LOG + 16 * 64 * 4;
constexpr int RP_END = RP_HIST + 64 * 4;
static_assert(RP_END <= LDS_BYTES, "rowpass LDS");

struct RowP { float* y2h1; bf16_t* u; const float* modpart; const bf16_t* rwt;
              int* tope; float* gatev; int* lrank; int* blkcnt; int b0, nlat; };
__device__ __forceinline__ float wave_max(float x) {
#pragma unroll
    for (int o = 32; o > 0; o >>= 1) x = fmaxf(x, __shfl_xor(x, o));
    return x; }
__device__ __forceinline__ void row_pass(LAS unsigned char* lds, const In& in, const RowP p, int row_lo, int row_hi, bool dry = false) {
    const int tid = threadIdx.x, lane = tid & 63, wid = tid >> 6;
    LAS float* MOD = (LAS float*)(lds + RP_MOD); LAS bf16_t* UH = (LAS bf16_t*)(lds + RP_UH); LAS bf16_t* UL = (LAS bf16_t*)(lds + RP_UL);
    LAS float* PART = (LAS float*)(lds + RP_PART); LAS float* LOG = (LAS float*)(lds + RP_LOG); LAS int* HIST = (LAS int*)(lds + RP_HIST);
    const int mr = p.b0 + row_lo / SEQ;
    for (int j = tid; j < 3 * D; j += NT) MOD[j] = mod_value(in, p.modpart, mr, 2 * D + j);
    if (tid < 64) HIST[tid] = 0;
    __syncthreads();
    float gp1[16], gp2[16];
#pragma unroll
    for (int j = 0; j < 4; ++j)
#pragma unroll
        for (int q = 0; q < 4; ++q) { gp1[4 * j + q] = in.norm_g[D + j * 256 + lane * 4 + q]; gp2[4 * j + q] = in.norm_g[2 * D + j * 256 + lane * 4 + q]; }
    for (int r16 = row_lo; r16 < row_hi; r16 += 16) {
#pragma unroll
        for (int rr = 0; rr < 2; ++rr) {
            const int lr = wid * 2 + rr, r = r16 + lr;
            float* yp = p.y2h1 + (size_t)r * D; const float* xp = in.x + ((size_t)p.b0 * SEQ + r) * D;
            f32x4 v[4]; float ss = 0.f;
#pragma unroll
            for (int j = 0; j < 4; ++j) { v[j] = *(const f32x4*)(yp + j * 256 + lane * 4); ss += v[j][0] * v[j][0] + v[j][1] * v[j][1] + v[j][2] * v[j][2] + v[j][3] * v[j][3]; }
#pragma unroll
            for (int o = 32; o > 0; o >>= 1) ss += __shfl_xor(ss, o);
            const float rinv = 1.f / sqrtf(ss * (1.f / D) + NORM_EPS); float s2 = 0.f;
#pragma unroll
            for (int j = 0; j < 4; ++j) { const int c = j * 256 + lane * 4; const f32x4 xv = *(const f32x4*)(xp + c);
#pragma unroll
                for (int q = 0; q < 4; ++q) { const float hv = xv[q] + MOD[c + q] * (v[j][q] * rinv * gp1[4 * j + q]); v[j][q] = hv; s2 += hv * hv; }
                if (!dry) *(f32x4*)(yp + c) = v[j]; }
#pragma unroll
            for (int o = 32; o > 0; o >>= 1) s2 += __shfl_xor(s2, o);
            const float r2 = 1.f / sqrtf(s2 * (1.f / D) + NORM_EPS);
#pragma unroll
            for (int j = 0; j < 4; ++j) { const int c = j * 256 + lane * 4; float uu[4], lo[4]; unsigned hw[2];
#pragma unroll
                for (int q = 0; q < 4; ++q) uu[q] = (v[j][q] * r2 * gp2[4 * j + q]) * (1.f + MOD[2 * D + c + q]) + MOD[D + c + q];
                hw[0] = cvt_pk_bf16(uu[0], uu[1]); hw[1] = cvt_pk_bf16(uu[2], uu[3]);
                lo[0] = uu[0] - bflo(hw[0]); lo[1] = uu[1] - bfhi(hw[0]); lo[2] = uu[2] - bflo(hw[1]); lo[3] = uu[3] - bfhi(hw[1]);
                u32x2 w; w.x = hw[0]; w.y = hw[1]; *(u32x2*)(p.u + (size_t)r * D + c) = w; *(LAS u32x2*)(UH + lr * (D + 8) + c) = w;
                u32x2 wl; wl.x = cvt_pk_bf16(lo[0], lo[1]); wl.y = cvt_pk_bf16(lo[2], lo[3]); *(LAS u32x2*)(UL + lr * (D + 8) + c) = wl; }
        }
        __syncthreads();
        { const int fr = lane & 15, fq = lane >> 4;
          f32x4 acc[4];
#pragma unroll
          for (int ct = 0; ct < 4; ++ct) acc[ct] = (f32x4){0.f, 0.f, 0.f, 0.f};
#pragma unroll
          for (int ks = 0; ks < 4; ++ks) { const int k0 = wid * 128 + ks * 32 + fq * 8;
              const bf16x8 ah = *(const LAS bf16x8*)(UH + fr * (D + 8) + k0), al = *(const LAS bf16x8*)(UL + fr * (D + 8) + k0);
#pragma unroll
              for (int ct = 0; ct < 4; ++ct) { const bf16x8 bh = *(const bf16x8*)(p.rwt + (size_t)(ct * 16 + fr) * D + k0), bl = *(const bf16x8*)(p.rwt + (size_t)(NE + ct * 16 + fr) * D + k0);
                  acc[ct] = __builtin_amdgcn_mfma_f32_16x16x32_bf16(ah, bh, acc[ct], 0, 0, 0); acc[ct] = __builtin_amdgcn_mfma_f32_16x16x32_bf16(ah, bl, acc[ct], 0, 0, 0); acc[ct] = __builtin_amdgcn_mfma_f32_16x16x32_bf16(al, bh, acc[ct], 0, 0, 0); } }
#pragma unroll
          for (int ct = 0; ct < 4; ++ct)
#pragma unroll
              for (int i = 0; i < 4; ++i) PART[(wid * 16 + fq * 4 + i) * 64 + ct * 16 + fr] = acc[ct][i]; }
        __syncthreads();
        for (int i = tid; i < 16 * 64; i += NT) { float s = 0.f;
#pragma unroll
            for (int w = 0; w < 8; ++w) s += PART[w * 1024 + i];
            LOG[i] = s; }
        __syncthreads();
#pragma unroll 1
        for (int rr = 0; rr < 2; ++rr) {
            const int lr = wid * 2 + rr, r = r16 + lr;
            const float sc = sigmoidf_(LOG[lr * 64 + lane]), bi = sc + in.router_b[lane];
            float m1 = bi; m1 = fmaxf(m1, __shfl_xor(m1, 1)); m1 = fmaxf(m1, __shfl_xor(m1, 2)); m1 = fmaxf(m1, __shfl_xor(m1, 4));
            const unsigned long long eq = __ballot(bi == m1); const int first = __ffsll((long long)((eq >> (lane & ~7)) & 0xffull)) - 1 + (lane & ~7);
            float m2 = (lane == first) ? -1e30f : bi; m2 = fmaxf(m2, __shfl_xor(m2, 1)); m2 = fmaxf(m2, __shfl_xor(m2, 2)); m2 = fmaxf(m2, __shfl_xor(m2, 4));
            const float gs = m1 + m2; const int myg = lane >> 3; int rank = 0;
#pragma unroll
            for (int g = 0; g < NG; ++g) { const float og = __shfl(gs, g * 8); rank += (og > gs || (og == gs && g < myg)) ? 1 : 0; }
            float cand = rank < TG ? bi : -1e30f; float tsum = 0.f; int myidx = 0; float mysc = 0.f;
#pragma unroll
            for (int it = 0; it < TOPK; ++it) { const float m = wave_max(cand); const unsigned long long bm = __ballot(cand == m); const int win = __ffsll((long long)bm) - 1;
                const float ws = __shfl(sc, win); tsum += ws; if (lane == it) { myidx = win; mysc = ws; } if (lane == win) cand = -1e30f; }
            if (lane < TOPK) { const int rk = atomicAdd((int*)&HIST[myidx], 1);
                p.tope[(size_t)r * TOPK + lane] = myidx; p.gatev[(size_t)r * TOPK + lane] = mysc / tsum * 2.5f; p.lrank[(size_t)r * TOPK + lane] = rk; }
        }
        __syncthreads();
    }
    if (tid < 64) p.blkcnt[blockIdx.x * 64 + tid] = HIST[tid];
}

struct MoeP { const int* tope; const float* gatev; const int* lrank; const int* blkcnt;
              int* tilepre;
              int* list;
              int* sdst;
              float* sgate;
              int r0, nr, blk0, nbh, rpb, pad_; };
__device__ __forceinline__ void moe_assign(LAS unsigned char* lds, const MoeP p, int bid, int nblk) {
    LAS int* BASE = (LAS int*)lds; LAS int* CNT = BASE + 80; LAS int* BOFF = CNT + 80;
    const int tid = threadIdx.x;
    if (tid < NE) { int c = 0, bo = 0; for (int b = 0; b < p.nbh; ++b) { const int v = p.blkcnt[(p.blk0 + b) * 64 + tid]; if (p.blk0 + b < bid) bo += v; c += v; } CNT[tid] = c; BOFF[tid] = bo; }
    __syncthreads();
    if (tid == 0) { int s = 0; for (int e = 0; e < NE; ++e) { BASE[e] = s; s += (CNT[e] + BM - 1) / BM * BM; } BASE[NE] = s; CNT[NE] = p.nr; BASE[NE + 1] = s + p.nr;
        if (bid == 0) { for (int e = 0; e <= NEX; ++e) p.tilepre[e] = BASE[e] / BM; } }
    __syncthreads();
    if (bid >= p.blk0 && bid < p.blk0 + p.nbh) {
        const int rlo = p.r0 + (bid - p.blk0) * p.rpb;
        for (int i = tid; i < p.rpb * TOPK; i += NT) { const int r = rlo + i / TOPK, a = r * TOPK + i % TOPK, e = p.tope[a]; const int slot = BASE[e] + BOFF[e] + p.lrank[a];
            p.list[slot] = r; p.sdst[slot] = (r - p.r0) * SLOTS_PER_TOK + i % TOPK; p.sgate[slot] = p.gatev[a]; }
        for (int i = tid; i < p.rpb; i += NT) { const int r = rlo + i, slot = BASE[NE] + (r - p.r0); p.list[slot] = r; p.sdst[slot] = (r - p.r0) * SLOTS_PER_TOK + TOPK; p.sgate[slot] = 1.f; }
    }
    for (int e = bid; e < NE; e += nblk) { const int lo = BASE[e] + CNT[e], hi = BASE[e + 1]; for (int s = lo + tid; s < hi; s += NT) { p.list[s] = p.r0; p.sdst[s] = -1; p.sgate[s] = 0.f; } }
}
struct GroupOrder { int tpn, total, nN, G, c;
    __device__ void init(const int* tilepre, int nN_, int G_, int c_) { const int lane = threadIdx.x & 63;
        tpn = (int)__hip_atomic_load((const unsigned*)tilepre + lane + 1, __ATOMIC_RELAXED, __HIP_MEMORY_SCOPE_AGENT);
        total = (int)__hip_atomic_load((const unsigned*)tilepre + NEX, __ATOMIC_RELAXED, __HIP_MEMORY_SCOPE_AGENT); nN = nN_; G = G_; c = c_; }
    __device__ bool next(int i, Unit& u) const { const long L = (long)i * G + c; if (L >= (long)total * nN) return false;
        const int T = (int)(L / nN); const int e = __popcll(__ballot(tpn <= T));
        u.pm = T; u.pn = (int)(L % nN); u.e = __builtin_amdgcn_readfirstlane(e); return true; } };
struct EpiGU { bf16_t* act;
    __device__ __forceinline__ bool operator()(f32x4 (&acc)[2][2][4][2], const Unit& u, int wr, int wc, int fr, int fq) const {
        MK_FRAG_LOOP(r, c) { const f32x4 a = acc[ai][bj][m][0], b = acc[ai][bj][m][1];
            u32x2 w; w.x = cvt_pk_bf16(fast_silu(a[0]) * a[1], fast_silu(a[2]) * a[3]); w.y = cvt_pk_bf16(fast_silu(b[0]) * b[1], fast_silu(b[2]) * b[3]);
            *(u32x2*)(act + (size_t)(u.pm * BM + r) * EF + ((u.pn * BM + c) >> 1)) = w; }
        return false; } };
struct EpiDown { const int* sdst; const float* sgate; bf16_t* rowsb;
    __device__ __forceinline__ bool operator()(f32x4 (&acc)[2][2][4][2], const Unit& u, int wr, int wc, int fr, int fq) const {
        int dst[8]; float gt[8];
#pragma unroll
        for (int q = 0; q < 8; ++q) { const int slot = u.pm * BM + (q >> 2) * HALF + wr * 64 + (q & 3) * 16 + fr; dst[q] = sdst[slot]; gt[q] = sgate[slot]; }
#pragma unroll
        for (int ai = 0; ai < 2; ++ai)
#pragma unroll
            for (int m = 0; m < 4; ++m) { const int q = ai * 4 + m; if (dst[q] >= 0) {
#pragma unroll
                for (int bj = 0; bj < 2; ++bj) { f32x4 a = acc[ai][bj][m][0], b = acc[ai][bj][m][1];
#pragma unroll
                    for (int j = 0; j < 4; ++j) { a[j] *= gt[q]; b[j] *= gt[q]; }
                    *(u32x4*)(rowsb + (size_t)dst[q] * D + u.pn * BM + bj * HALF + wc * 32 + 8 * fq) = pack8(a, b); } } }
        return false; } };
__device__ __forceinline__ void final_rows(LAS float* sm  , const In& in, const float* modpart, const bf16_t* rowsb, float* h1out, int b0, int r0, int row_lo, int row_hi, bool dry = false) {
    const int tid = threadIdx.x, lane = tid & 63, wid = tid >> 6;
    const int mr = b0 + row_lo / SEQ;
    __syncthreads();
    for (int j = tid; j < D; j += NT) sm[j] = mod_value(in, modpart, mr, 5 * D + j);
    __syncthreads();
    float gq[16];
#pragma unroll
    for (int j = 0; j < 4; ++j)
#pragma unroll
        for (int q = 0; q < 4; ++q) gq[4 * j + q] = sm[j * 256 + lane * 4 + q] * in.norm_g[3 * D + j * 256 + lane * 4 + q];
    for (int r = row_lo + wid; r < row_hi; r += NT / 64) {
        float v[16];
#pragma unroll
        for (int j = 0; j < 16; ++j) v[j] = 0.f;
        const bf16_t* rb = rowsb + (size_t)(r - r0) * SLOTS_PER_TOK * D;
#pragma unroll
        for (int s = 0; s < SLOTS_PER_TOK; ++s)
#pragma unroll
            for (int j = 0; j < 4; ++j) { const u32x2 w = *(const u32x2*)(rb + (size_t)s * D + j * 256 + lane * 4); v[4 * j] += bflo(w.x); v[4 * j + 1] += bfhi(w.x); v[4 * j + 2] += bflo(w.y); v[4 * j + 3] += bfhi(w.y); }
        float ss = 0.f;
#pragma unroll
        for (int j = 0; j < 16; ++j) ss += v[j] * v[j];
#pragma unroll
        for (int o = 32; o > 0; o >>= 1) ss += __shfl_xor(ss, o);
        const float rinv = 1.f / sqrtf(ss * (1.f / D) + NORM_EPS);
        float* hp = h1out + (size_t)r * D;
#pragma unroll
        for (int j = 0; j < 4; ++j) { const int c = j * 256 + lane * 4; f32x4 hv = *(const f32x4*)(hp + c);
#pragma unroll
            for (int q = 0; q < 4; ++q) hv[q] += gq[4 * j + q] * (v[4 * j + q] * rinv);
            if (!dry) *(f32x4*)(hp + c) = hv; else if (hv[0] == 1.2345e30f) *(f32x4*)(hp + c) = hv; }
    }
}
__device__ __forceinline__ void rwt_prep(const In& in, bf16_t* rwt, int bid, int nblk) {
    for (int i = bid * NT + threadIdx.x; i < NE * D; i += nblk * NT) { const int e = i / D, k = i % D; const float w = in.router_w[(size_t)k * NE + e]; const bf16_t h = f2bf(w); rwt[i] = h; rwt[(size_t)NE * D + i] = f2bf(w - bf2f(h)); }
}
}

using namespace mk;
constexpr size_t MiB = (size_t)1 << 20;
constexpr int NLAT = NB * SEQ, NCTXR = NB * CTX, NALL = NLAT + NCTXR, NRH = NLAT / 2, MAXSLOTS = NRH * SLOTS_PER_TOK + NE * BM;
constexpr size_t O_W1A = 0, O_W1C = O_W1A + (size_t)Z1_N * D * 2, O_WG = O_W1C + (size_t)ZC_N * D * 2, O_WBR = O_WG + (size_t)RW * AG_K * 2, O_WOUT = O_WBR + (size_t)2 * D * RW * 2,
                 O_RWT = O_WOUT + (size_t)D * D * 2, O_MODP = O_RWT + (size_t)2 * NE * D * 2, O_S_END = O_MODP + (size_t)MOD_SL * (NB + 1) * 6 * D * 4;
static_assert(O_S_END <= 27 * MiB, "S region");
constexpr size_t O_BAR = 27 * MiB;
constexpr size_t O_Z1 = 28 * MiB, O_R2 = O_Z1 + (size_t)NALL * Z1_N * 2;
static_assert(O_R2 == 334 * MiB, "z1 size");
constexpr size_t O_HD = O_R2, O_BON = O_HD + (size_t)2 * NLAT * LW * 2, O_AG = O_BON + (size_t)2 * NLAT * NH * 4, O_R2_END = O_AG + (size_t)NLAT * AG_K * 2;
static_assert(O_R2_END <= 512 * MiB, "R2");
constexpr size_t O_XNL = O_Z1, O_YB = O_XNL + (size_t)NLAT * D * 2, O_GATES = O_YB + (size_t)NLAT * LW * 2, O_MIXED = O_HD;
static_assert(O_GATES + (size_t)NLAT * 2 * D * 2 <= O_R2, "late R1");
constexpr size_t O_U = O_Z1, O_WGU = O_U + (size_t)NLAT * D * 2, O_WDN = O_WGU + (size_t)NEX * 2 * EF * D * 2, O_ROUT = O_WDN + (size_t)NEX * D * EF * 2;
constexpr size_t O_TOPE = O_ROUT, O_LRANK = O_TOPE + (size_t)NLAT * TOPK * 4, O_GATEV = O_LRANK + (size_t)NLAT * TOPK * 4, O_BLKCNT = O_GATEV + (size_t)NLAT * TOPK * 4, O_TILEPRE = O_BLKCNT + 256 * 64 * 4,
                 O_LIST = O_TILEPRE + 1024, O_SDST = O_LIST + (size_t)MAXSLOTS * 4, O_SGATE = O_SDST + (size_t)MAXSLOTS * 4, O_ACT = ((O_SGATE + (size_t)MAXSLOTS * 4 + 255) / 256) * 256,
                 O_ROWSB = ((O_ACT + (size_t)MAXSLOTS * EF * 2 + 255) / 256) * 256, O_END = O_ROWSB + (size_t)NRH * SLOTS_PER_TOK * D * 2;
static_assert(O_END <= 512 * MiB, "workspace");
static_assert(O_WGU >= O_YB && O_ROWSB >= O_GATES, "late layout");

struct MP { In in; float* out; unsigned char* ws; long ph_lo, ph_hi; };
constexpr int NPHASE = 17;

#if defined(__HIP_DEVICE_COMPILE__)
#define MK_KARGS auto Pq_ = Pk_; asm volatile("" : "+s"(Pq_)); const MP* Pg_ = (const MP*)Pq_; const In in = Pg_->in; unsigned char* ws = Pg_->ws; float* out_ = Pg_->out; (void)out_;
#else
#define MK_KARGS const In in = P.in; unsigned char* ws = P.ws; float* out_ = P.out; (void)out_; (void)Pk_;
#endif
#define MK_PHASE_PTRS \
    MK_KARGS \
    bf16_t *W1a = (bf16_t*)(ws + O_W1A), *W1c = (bf16_t*)(ws + O_W1C), *Wg = (bf16_t*)(ws + O_WG), *Wbr = (bf16_t*)(ws + O_WBR), *Wout = (bf16_t*)(ws + O_WOUT), *rwt = (bf16_t*)(ws + O_RWT); \
    float* modpart = (float*)(ws + O_MODP); \
    bf16_t *z1 = (bf16_t*)(ws + O_Z1), *Hd = (bf16_t*)(ws + O_HD), *Ag = (bf16_t*)(ws + O_AG); float* bon = (float*)(ws + O_BON); \
    bf16_t *xnl = (bf16_t*)(ws + O_XNL), *yb = (bf16_t*)(ws + O_YB), *gates = (bf16_t*)(ws + O_GATES), *mixed = (bf16_t*)(ws + O_MIXED); \
    bf16_t *u = (bf16_t*)(ws + O_U), *Wgu = (bf16_t*)(ws + O_WGU), *Wdn = (bf16_t*)(ws + O_WDN), *act = (bf16_t*)(ws + O_ACT), *rowsb = (bf16_t*)(ws + O_ROWSB); \
    int *tope = (int*)(ws + O_TOPE), *lrank = (int*)(ws + O_LRANK), *blkcnt = (int*)(ws + O_BLKCNT), *tilepre = (int*)(ws + O_TILEPRE), *list = (int*)(ws + O_LIST), *sdst = (int*)(ws + O_SDST); \
    float *gatev = (float*)(ws + O_GATEV), *sgate = (float*)(ws + O_SGATE); \
    bf16_t* xn_all = (bf16_t*)out_; \
    bf16_t* Y = (bf16_t*)out_; \
    float* y2h1 = out_;
__global__ void __launch_bounds__(512, 2) mega(MP P) {
    extern __shared__ __attribute__((aligned(16))) unsigned char shm[];
    LAS unsigned char* lds = (LAS unsigned char*)shm;
    typedef const __attribute__((address_space(4))) MP* KargP;
    const KargP Pk_ = (KargP)__builtin_amdgcn_kernarg_segment_ptr();
    const int bid = blockIdx.x, nblk = gridDim.x;
    const int ph_lo = (int)P.ph_lo, ph_hi = (int)P.ph_hi;
    volatile LAS unsigned* xst = (volatile LAS unsigned*)(lds + LDS_BYTES - 16);
    if (threadIdx.x == 0) { xst[0] = 0u; xst[1] = 0u; }
    __syncthreads();
    const XcdBarrier xb = xcd_barrier_post((unsigned*)(P.ws + O_BAR), xst);
    if (0 >= ph_lo && 0 < ph_hi) { if (0 > ph_lo) xcd_barrier(xb); const int ph = 0; (void)ph; MK_PHASE_PTRS
        { LAS float* tile = (LAS float*)lds; int base = 0;
            convT_job(tile, in.w_in, INC, D, W1a, D, Z1_N, CMapZ1{}, bid, nblk, base);
            convT_job(tile, in.w_in, INC, D, W1c, D, ZC_N, CMapZC{}, bid, nblk, base);
            convT_job(tile, in.rw_g_up, RW, GL, Wg, AG_K, RW, CMapId{}, bid, nblk, base);
            convT_job(tile, in.w_branch_a, D, RW, Wbr, RW, D, CMapId{}, bid, nblk, base);
            convT_job(tile, in.w_branch_b, D, LW, Wbr + (size_t)D * RW, LW, D, CMapId{}, bid, nblk, base);
            convT_job(tile, in.w_out, D, D, Wout, D, D, CMapId{}, bid, nblk, base);
            rwt_prep(in, rwt, bid, nblk);
            mod_partials((LAS float*)lds, in, modpart, bid, nblk); }
    }
    if (1 >= ph_lo && 1 < ph_hi) { if (1 > ph_lo) xcd_barrier(xb); const int ph = 1; (void)ph; MK_PHASE_PTRS
        { const int L = NLAT / nblk, Lc = NCTXR / nblk;
            xn_rows((LAS float*)lds, in, modpart, xn_all, 0, NB, bid * L, (bid + 1) * L);
            xn_rows((LAS float*)lds, in, modpart, xn_all, 0, NB, NLAT + bid * Lc, NLAT + (bid + 1) * Lc); }
    }
    if (2 >= ph_lo && 2 < ph_hi) { if (2 > ph_lo) xcd_barrier(xb); const int ph = 2; (void)ph; MK_PHASE_PTRS
        { GemmP g{xn_all, xn_all, W1a, 0, nullptr, D, 0}; StaticOrder S; S.init(NALL, Z1_N, nblk, bid); gemm_phase(lds, g, S, EpiStoreBf16{z1, Z1_N}); }
    }
    if (3 >= ph_lo && 3 < ph_hi) { if (3 > ph_lo) xcd_barrier(xb); const int ph = 3; (void)ph; MK_PHASE_PTRS
        { LruP lp{z1, Hd, 0, NB}; lru_phase(lds, in, lp, bid, nblk); __syncthreads();
                  RwkvP rp{z1, Y, bon, 0, NB}; r3::rwkv_phase3(lds, in, rp, bid, nblk); }
    }
    if (4 >= ph_lo && 4 < ph_hi) { if (4 > ph_lo) xcd_barrier(xb); const int ph = 4; (void)ph; MK_PHASE_PTRS
        { const int L = NLAT / nblk; PostP pp{z1, Y, bon, Ag, NLAT, 0}; rwkv_post_rows(in, pp, bid * L, (bid + 1) * L); }
    }
    if (5 >= ph_lo && 5 < ph_hi) { if (5 > ph_lo) xcd_barrier(xb); const int ph = 5; (void)ph; MK_PHASE_PTRS
        { const int L = NLAT / nblk; xn_rows((LAS float*)lds, in, modpart, xnl, 0, NB, bid * L, (bid + 1) * L); __syncthreads();
                  GemmP g{Ag, Ag, Wg, 0, nullptr, AG_K, 0}; StaticOrder S; S.init(NLAT, RW, nblk, bid); gemm_phase(lds, g, S, EpiYa{Y, Y + (size_t)NLAT * RW}); }
    }
    if (6 >= ph_lo && 6 < ph_hi) { if (6 > ph_lo) xcd_barrier(xb); const int ph = 6; (void)ph; MK_PHASE_PTRS
        { GemmP g{xnl, xnl, W1c, 0, nullptr, D, 0}; StaticOrder S; S.init(NLAT, ZC_N, nblk, bid); gemm_phase(lds, g, S, EpiZc{Hd, yb, gates, NLAT, 0}); }
    }
    if (7 >= ph_lo && 7 < ph_hi) { if (7 > ph_lo) xcd_barrier(xb); const int ph = 7; (void)ph; MK_PHASE_PTRS
        { GemmP g{Y + (size_t)NLAT * RW, yb, Wbr, (long)D * RW, nullptr, D, 0}; PairOrder S; S.S.init(NLAT, D, nblk, bid); gemm_phase(lds, g, S, EpiBranch{gates, mixed}); }
    }
    if (8 >= ph_lo && 8 < ph_hi) { if (8 > ph_lo) xcd_barrier(xb); const int ph = 8; (void)ph; MK_PHASE_PTRS
        { LAS float* tile = (LAS float*)lds;
            struct MGU { const float* ex; const float* sh; bf16_t* d; __device__ const float* src(int m) const { return m < NE ? ex + (size_t)m * D * 2 * EF : sh; } __device__ bf16_t* dst(int m) const { return d + (size_t)m * 2 * EF * D; } };
            struct MDN { const float* ex; const float* sh; bf16_t* d; __device__ const float* src(int m) const { return m < NE ? ex + (size_t)m * EF * D : sh; } __device__ bf16_t* dst(int m) const { return d + (size_t)m * D * EF; } };
            auto conv = [&]() __attribute__((always_inline)) {
                convT_multi(tile, MGU{in.ex_w_gu, in.sh_w_gu, Wgu}, NEX, 2 * EF, D, D, 2 * EF, CMapGU{EF}, bid, nblk);
                convT_multi(tile, MDN{in.ex_w_down, in.sh_w_down, Wdn}, NEX, D, EF, EF, D, CMapId{}, bid, nblk); };
            if (bid & 1) { conv(); __syncthreads(); }
            { GemmP g{mixed, mixed, Wout, 0, nullptr, D, 0}; StaticOrder S; S.init(NLAT, D, nblk, bid); gemm_phase(lds, g, S, EpiF32{y2h1, D}); }
            if (!(bid & 1)) { __syncthreads(); conv(); } }
    }
    if (9 >= ph_lo && 9 < ph_hi) { if (9 > ph_lo) xcd_barrier(xb); const int ph = 9; (void)ph; MK_PHASE_PTRS
        { const int L = NLAT / nblk; RowP rp{y2h1, u, modpart, rwt, tope, gatev, lrank, blkcnt, 0, NLAT}; row_pass(lds, in, rp, bid * L, (bid + 1) * L); }
    }
    if (10 >= ph_lo && 10 < ph_hi) { if (10 > ph_lo) xcd_barrier(xb); const int ph = 10; (void)ph; MK_PHASE_PTRS
        { const int q = ph - 10, half = q >= 4 ? 1 : 0, st = q - 4 * half;
            const int rpb = NLAT / nblk;
            auto assign = [&](int hf) { MoeP mp{tope, gatev, lrank, blkcnt, tilepre, list, sdst, sgate, hf * NRH, NRH, hf * (nblk / 2), nblk / 2, rpb, 0}; moe_assign(lds, mp, bid, nblk); };
            auto fin = [&](int hf) { const int L = NRH / nblk, r0 = hf * NRH; final_rows((LAS float*)lds, in, modpart, rowsb, y2h1, 0, r0, r0 + bid * L, r0 + (bid + 1) * L); };
            if (ph == 10) assign(0);
            else if (ph == 11 || ph == 14) { GemmP g{u, u, Wgu, (long)2 * EF * D, list, D, 0}; GroupOrder S; S.init(tilepre, 2 * EF / BM, nblk, bid); gemm_phase<true>(lds, g, S, EpiGU{act}); }
            else if (ph == 12 || ph == 15) { GemmP g{act, act, Wdn, (long)D * EF, nullptr, EF, 0}; GroupOrder S; S.init(tilepre, D / BM, nblk, bid); gemm_phase(lds, g, S, EpiDown{sdst, sgate, rowsb}); }
            else if (ph == 13) { fin(0); __syncthreads(); assign(1); }
            else if (ph == 16) fin(1);
            (void)half; (void)st; }
    }
    if (11 >= ph_lo && 11 < ph_hi) { if (11 > ph_lo) xcd_barrier(xb); const int ph = 11; (void)ph; MK_PHASE_PTRS
        { const int q = ph - 10, half = q >= 4 ? 1 : 0, st = q - 4 * half;
            const int rpb = NLAT / nblk;
            auto assign = [&](int hf) { MoeP mp{tope, gatev, lrank, blkcnt, tilepre, list, sdst, sgate, hf * NRH, NRH, hf * (nblk / 2), nblk / 2, rpb, 0}; moe_assign(lds, mp, bid, nblk); };
            auto fin = [&](int hf) { const int L = NRH / nblk, r0 = hf * NRH; final_rows((LAS float*)lds, in, modpart, rowsb, y2h1, 0, r0, r0 + bid * L, r0 + (bid + 1) * L); };
            if (ph == 10) assign(0);
            else if (ph == 11 || ph == 14) { GemmP g{u, u, Wgu, (long)2 * EF * D, list, D, 0}; GroupOrder S; S.init(tilepre, 2 * EF / BM, nblk, bid); gemm_phase<true>(lds, g, S, EpiGU{act}); }
            else if (ph == 12 || ph == 15) { GemmP g{act, act, Wdn, (long)D * EF, nullptr, EF, 0}; GroupOrder S; S.init(tilepre, D / BM, nblk, bid); gemm_phase(lds, g, S, EpiDown{sdst, sgate, rowsb}); }
            else if (ph == 13) { fin(0); __syncthreads(); assign(1); }
            else if (ph == 16) fin(1);
            (void)half; (void)st; }
    }
    if (12 >= ph_lo && 12 < ph_hi) { if (12 > ph_lo) xcd_barrier(xb); const int ph = 12; (void)ph; MK_PHASE_PTRS
        { const int q = ph - 10, half = q >= 4 ? 1 : 0, st = q - 4 * half;
            const int rpb = NLAT / nblk;
            auto assign = [&](int hf) { MoeP mp{tope, gatev, lrank, blkcnt, tilepre, list, sdst, sgate, hf * NRH, NRH, hf * (nblk / 2), nblk / 2, rpb, 0}; moe_assign(lds, mp, bid, nblk); };
            auto fin = [&](int hf) { const int L = NRH / nblk, r0 = hf * NRH; final_rows((LAS float*)lds, in, modpart, rowsb, y2h1, 0, r0, r0 + bid * L, r0 + (bid + 1) * L); };
            if (ph == 10) assign(0);
            else if (ph == 11 || ph == 14) { GemmP g{u, u, Wgu, (long)2 * EF * D, list, D, 0}; GroupOrder S; S.init(tilepre, 2 * EF / BM, nblk, bid); gemm_phase<true>(lds, g, S, EpiGU{act}); }
            else if (ph == 12 || ph == 15) { GemmP g{act, act, Wdn, (long)D * EF, nullptr, EF, 0}; GroupOrder S; S.init(tilepre, D / BM, nblk, bid); gemm_phase(lds, g, S, EpiDown{sdst, sgate, rowsb}); }
            else if (ph == 13) { fin(0); __syncthreads(); assign(1); }
            else if (ph == 16) fin(1);
            (void)half; (void)st; }
    }
    if (13 >= ph_lo && 13 < ph_hi) { if (13 > ph_lo) xcd_barrier(xb); const int ph = 13; (void)ph; MK_PHASE_PTRS
        { const int q = ph - 10, half = q >= 4 ? 1 : 0, st = q - 4 * half;
            const int rpb = NLAT / nblk;
            auto assign = [&](int hf) { MoeP mp{tope, gatev, lrank, blkcnt, tilepre, list, sdst, sgate, hf * NRH, NRH, hf * (nblk / 2), nblk / 2, rpb, 0}; moe_assign(lds, mp, bid, nblk); };
            auto fin = [&](int hf) { const int L = NRH / nblk, r0 = hf * NRH; final_rows((LAS float*)lds, in, modpart, rowsb, y2h1, 0, r0, r0 + bid * L, r0 + (bid + 1) * L); };
            if (ph == 10) assign(0);
            else if (ph == 11 || ph == 14) { GemmP g{u, u, Wgu, (long)2 * EF * D, list, D, 0}; GroupOrder S; S.init(tilepre, 2 * EF / BM, nblk, bid); gemm_phase<true>(lds, g, S, EpiGU{act}); }
            else if (ph == 12 || ph == 15) { GemmP g{act, act, Wdn, (long)D * EF, nullptr, EF, 0}; GroupOrder S; S.init(tilepre, D / BM, nblk, bid); gemm_phase(lds, g, S, EpiDown{sdst, sgate, rowsb}); }
            else if (ph == 13) { fin(0); __syncthreads(); assign(1); }
            else if (ph == 16) fin(1);
            (void)half; (void)st; }
    }
    if (14 >= ph_lo && 14 < ph_hi) { if (14 > ph_lo) xcd_barrier(xb); const int ph = 14; (void)ph; MK_PHASE_PTRS
        { const int q = ph - 10, half = q >= 4 ? 1 : 0, st = q - 4 * half;
            const int rpb = NLAT / nblk;
            auto assign = [&](int hf) { MoeP mp{tope, gatev, lrank, blkcnt, tilepre, list, sdst, sgate, hf * NRH, NRH, hf * (nblk / 2), nblk / 2, rpb, 0}; moe_assign(lds, mp, bid, nblk); };
            auto fin = [&](int hf) { const int L = NRH / nblk, r0 = hf * NRH; final_rows((LAS float*)lds, in, modpart, rowsb, y2h1, 0, r0, r0 + bid * L, r0 + (bid + 1) * L); };
            if (ph == 10) assign(0);
            else if (ph == 11 || ph == 14) { GemmP g{u, u, Wgu, (long)2 * EF * D, list, D, 0}; GroupOrder S; S.init(tilepre, 2 * EF / BM, nblk, bid); gemm_phase<true>(lds, g, S, EpiGU{act}); }
            else if (ph == 12 || ph == 15) { GemmP g{act, act, Wdn, (long)D * EF, nullptr, EF, 0}; GroupOrder S; S.init(tilepre, D / BM, nblk, bid); gemm_phase(lds, g, S, EpiDown{sdst, sgate, rowsb}); }
            else if (ph == 13) { fin(0); __syncthreads(); assign(1); }
            else if (ph == 16) fin(1);
            (void)half; (void)st; }
    }
    if (15 >= ph_lo && 15 < ph_hi) { if (15 > ph_lo) xcd_barrier(xb); const int ph = 15; (void)ph; MK_PHASE_PTRS
        { const int q = ph - 10, half = q >= 4 ? 1 : 0, st = q - 4 * half;
            const int rpb = NLAT / nblk;
            auto assign = [&](int hf) { MoeP mp{tope, gatev, lrank, blkcnt, tilepre, list, sdst, sgate, hf * NRH, NRH, hf * (nblk / 2), nblk / 2, rpb, 0}; moe_assign(lds, mp, bid, nblk); };
            auto fin = [&](int hf) { const int L = NRH / nblk, r0 = hf * NRH; final_rows((LAS float*)lds, in, modpart, rowsb, y2h1, 0, r0, r0 + bid * L, r0 + (bid + 1) * L); };
            if (ph == 10) assign(0);
            else if (ph == 11 || ph == 14) { GemmP g{u, u, Wgu, (long)2 * EF * D, list, D, 0}; GroupOrder S; S.init(tilepre, 2 * EF / BM, nblk, bid); gemm_phase<true>(lds, g, S, EpiGU{act}); }
            else if (ph == 12 || ph == 15) { GemmP g{act, act, Wdn, (long)D * EF, nullptr, EF, 0}; GroupOrder S; S.init(tilepre, D / BM, nblk, bid); gemm_phase(lds, g, S, EpiDown{sdst, sgate, rowsb}); }
            else if (ph == 13) { fin(0); __syncthreads(); assign(1); }
            else if (ph == 16) fin(1);
            (void)half; (void)st; }
    }
    if (16 >= ph_lo && 16 < ph_hi) { if (16 > ph_lo) xcd_barrier(xb); const int ph = 16; (void)ph; MK_PHASE_PTRS
        { const int q = ph - 10, half = q >= 4 ? 1 : 0, st = q - 4 * half;
            const int rpb = NLAT / nblk;
            auto assign = [&](int hf) { MoeP mp{tope, gatev, lrank, blkcnt, tilepre, list, sdst, sgate, hf * NRH, NRH, hf * (nblk / 2), nblk / 2, rpb, 0}; moe_assign(lds, mp, bid, nblk); };
            auto fin = [&](int hf) { const int L = NRH / nblk, r0 = hf * NRH; final_rows((LAS float*)lds, in, modpart, rowsb, y2h1, 0, r0, r0 + bid * L, r0 + (bid + 1) * L); };
            if (ph == 10) assign(0);
            else if (ph == 11 || ph == 14) { GemmP g{u, u, Wgu, (long)2 * EF * D, list, D, 0}; GroupOrder S; S.init(tilepre, 2 * EF / BM, nblk, bid); gemm_phase<true>(lds, g, S, EpiGU{act}); }
            else if (ph == 12 || ph == 15) { GemmP g{act, act, Wdn, (long)D * EF, nullptr, EF, 0}; GroupOrder S; S.init(tilepre, D / BM, nblk, bid); gemm_phase(lds, g, S, EpiDown{sdst, sgate, rowsb}); }
            else if (ph == 13) { fin(0); __syncthreads(); assign(1); }
            else if (ph == 16) fin(1);
            (void)half; (void)st; }
    }
}
extern "C" void kernel_launch(void* const* d_in, const int* in_sizes, int n_in, void* d_out, int out_size, void* d_ws, size_t ws_size, hipStream_t stream) {
    static int grid = 0;
    if (grid == 0) {
        int dev = 0, cus = 0; hipGetDevice(&dev); hipDeviceGetAttribute(&cus, hipDeviceAttributeMultiprocessorCount, dev);
        hipFuncSetAttribute((const void*)mega, hipFuncAttributeMaxDynamicSharedMemorySize, LDS_BYTES);
        grid = cus;
        if (ws_size < O_END || grid != 256) fprintf(stderr, "kernel_launch: unexpected ws_size %zu (need %zu) or CU count %d\n", ws_size, (size_t)O_END, grid);
    }
    hipMemsetAsync((char*)d_ws + O_BAR, 0, XCD_BAR_WORDS * 4, stream);
    MP P; memset(&P, 0, sizeof(P));
    const float** f = (const float**)&P.in; for (int i = 0; i < 32; ++i) f[i] = (const float*)d_in[i];
    P.out = (float*)d_out; P.ws = (unsigned char*)d_ws;
#ifdef MK_PER_PHASE
    for (int ph = 0; ph < NPHASE; ++ph) { P.ph_lo = ph; P.ph_hi = ph + 1; hipLaunchKernelGGL(mega, dim3(grid), dim3(NT), LDS_BYTES, stream, P); }
#else
    P.ph_lo = 0; P.ph_hi = NPHASE;
    void* args[] = {&P};
    hipError_t e = hipLaunchCooperativeKernel((void*)mega, dim3(grid), dim3(NT), args, LDS_BYTES, stream);
    if (e != hipSuccess) fprintf(stderr, "cooperative launch failed: %s (grid %d)\n", hipGetErrorString(e), grid);
#endif
}
```

```cpp
#include <hip/hip_runtime.h>
#include <cstdio>
#include <cstring>
#define HD __host__ __device__ __forceinline__
static hipStream_t g_stream;

#ifdef SMALL
constexpr int D = 128, NB = 2, SEQ = 64, GW = 8, CTX = 16, RW = 128, RH = 64, DL = 16, AL = 16, GL = 24, LW = 128, LB = 2, NE = 8, TOPK = 3, NG = 4, TG = 2, EF = 32, SF = 32;
#else
constexpr int D = 1024, NB = 8, SEQ = 4096, GW = 64, CTX = 256, RW = 1024, RH = 64, DL = 64, AL = 64, GL = 160, LW = 1024, LB = 16, NE = 64, TOPK = 6, NG = 8, TG = 4, EF = 256, SF = 256;
#endif
constexpr int NH = RW / RH, LBS = LW / LB, ROWS = SEQ / GW, TA = CTX + SEQ;
constexpr int OFF_R = 0, OFF_K = RW, OFF_V = 2 * RW, OFF_WD = 3 * RW, OFF_AD = OFF_WD + 2 * DL, OFF_GD = OFF_AD + 2 * AL, RC = OFF_GD + GL;
constexpr int OFF_LX = RC, OFF_LG = OFF_LX + LW, OFF_GATE = OFF_LG + LW, INC = OFF_GATE + 2 * D;
constexpr int EPG = NE / NG, NASG = SEQ * TOPK;
#define NORM_EPS 1e-6f
#define LNX_EPS 64e-5f

HD float sigmoidf_(float x) { return 1.f / (1.f + expf(-x)); }
HD float softplusf_(float x) { return x > 20.f ? x : log1pf(expf(x)); }
HD float siluf_(float x) { return x * sigmoidf_(x); }
HD float gelu_tanhf_(float x) { return 0.5f * x * (1.f + tanhf(0.7978845608028654f * (x + 0.044715f * x * x * x))); }

struct In {
    const float *x, *c, *ctx, *c_ctx, *w_mod, *b_mod, *norm_g, *w_in, *shift_mu, *rw_w0, *rw_w_up, *rw_a0, *rw_a_up, *rw_g_up, *rw_k_k, *rw_k_a, *rw_r_k, *rw_lnx,
        *lru_conv_w, *lru_conv_b, *lru_gate_w, *lru_gate_b, *lru_l, *w_branch_a, *w_branch_b, *w_out, *router_w, *router_b, *ex_w_gu, *ex_w_down, *sh_w_gu, *sh_w_down;
};


namespace mk {
#define LAS __attribute__((address_space(3)))
typedef unsigned short bf16_t;
typedef short bf16x8 __attribute__((ext_vector_type(8)));
typedef float f32x4 __attribute__((ext_vector_type(4)));
typedef float f32x2 __attribute__((ext_vector_type(2)));
typedef int i32x4 __attribute__((ext_vector_type(4)));
typedef int i32x8 __attribute__((ext_vector_type(8)));
typedef unsigned u32x4 __attribute__((ext_vector_type(4)));
typedef unsigned u32x2 __attribute__((ext_vector_type(2)));
constexpr int NT = 512;
constexpr int BM = 256, BK = 64, HALF = 128, HTB = HALF * BK * 2, STAGE_BYTES = 8 * HTB;
constexpr int LDS_BYTES = 160 * 1024 - 1024;

constexpr int Z1_LX = 3584, Z1_N = 4608;
constexpr int ZC_N = 3072;

__device__ __forceinline__ unsigned cvt_pk_bf16(float lo, float hi) { unsigned r; asm volatile("v_cvt_pk_bf16_f32 %0, %1, %2" : "=v"(r) : "v"(lo), "v"(hi)); return r; }
__device__ __forceinline__ bf16_t f2bf(float f) { unsigned u = __float_as_uint(f); u += 0x7FFFu + ((u >> 16) & 1u); return (bf16_t)(u >> 16); }
__device__ __forceinline__ float bf2f(bf16_t b) { return __uint_as_float(((unsigned)b) << 16); }
__device__ __forceinline__ float bflo(unsigned w) { return __uint_as_float(w << 16); }
__device__ __forceinline__ float bfhi(unsigned w) { return __uint_as_float(w & 0xffff0000u); }

#define MK_DPPF(x, ctrl) __int_as_float(__builtin_amdgcn_update_dpp(__float_as_int(x), __float_as_int(x), ctrl, 0xF, 0xF, false))
__device__ __forceinline__ float wave_sum64(float x) {
    x += MK_DPPF(x, 0xB1); x += MK_DPPF(x, 0x4E); x += MK_DPPF(x, 0x141); x += MK_DPPF(x, 0x140);
    const int xi = __float_as_int(x);
    return (__int_as_float(__builtin_amdgcn_readlane(xi, 0)) + __int_as_float(__builtin_amdgcn_readlane(xi, 16))) + (__int_as_float(__builtin_amdgcn_readlane(xi, 32)) + __int_as_float(__builtin_amdgcn_readlane(xi, 48)));
}
__device__ __forceinline__ float wave_max64(float x) {
    x = fmaxf(x, MK_DPPF(x, 0xB1)); x = fmaxf(x, MK_DPPF(x, 0x4E)); x = fmaxf(x, MK_DPPF(x, 0x141)); x = fmaxf(x, MK_DPPF(x, 0x140));
    const int xi = __float_as_int(x);
    return fmaxf(fmaxf(__int_as_float(__builtin_amdgcn_readlane(xi, 0)), __int_as_float(__builtin_amdgcn_readlane(xi, 16))), fmaxf(__int_as_float(__builtin_amdgcn_readlane(xi, 32)), __int_as_float(__builtin_amdgcn_readlane(xi, 48))));
}
__device__ __forceinline__ float fast_rcp(float x) { return __builtin_amdgcn_rcpf(x); }
__device__ __forceinline__ float fast_sigmoid(float x) { return fast_rcp(1.f + __expf(-x)); }
__device__ __forceinline__ float fast_tanh(float x) { return 1.f - 2.f * fast_rcp(1.f + __expf(2.f * x)); }
__device__ __forceinline__ float fast_softplus(float x) { return x > 15.f ? x : __logf(1.f + __expf(x)); }
__device__ __forceinline__ float fast_silu(float x) { return x * fast_sigmoid(x); }
__device__ __forceinline__ float fast_gelu_tanh(float x) { return x * fast_sigmoid(1.5957691216057308f * (x + 0.044715f * x * x * x)); }
__device__ __forceinline__ int lds_byte(int r, int c) { const int st = (r >> 4) * 2 + (c >> 5), rr = r & 15, cc = c & 31, ob = rr * 64 + cc * 2; return st * 1024 + (ob ^ (((ob >> 9) & 1) << 5)); }
__device__ __forceinline__ void stage_rc(int b, int& R, int& C) { const int st = b / 1024, sb = b % 1024, swz = sb ^ (((sb >> 9) & 1) << 5); R = (st >> 1) * 16 + swz / 64; C = (st & 1) * 32 + (swz % 64) / 2; }
__device__ __forceinline__ int perm32(int rho) { const int n = rho >> 4, i = rho & 15; return 8 * (i >> 2) + 4 * n + (i & 3); }

struct Unit { int pm, pn, e; };
struct GemmP { const bf16_t* A0; const bf16_t* A1; const bf16_t* Bt; long strideB; const int* gather; int K; int pad_; };

struct StaticOrder {
    int nM, nN, nwg, G, c;
    __device__ void init(int M, int N, int G_, int c_) { nM = M / BM; nN = N / BM; nwg = nM * nN; G = G_; c = c_; }
    __device__ bool next(int i, Unit& u) const {
        const long L = (long)i * G + c; if (L >= nwg) return false;
        int wgid = (int)L; { const int q = nwg / 8, r = nwg % 8, xcd = wgid % 8, off = wgid / 8; wgid = (xcd < r ? xcd * (q + 1) : r * (q + 1) + (xcd - r) * q) + off; }
        const int nig = 8 * nN, gid = wgid / nig, fm = gid * 8, gsz = (nM - fm) < 8 ? (nM - fm) : 8;
        u.pm = fm + ((wgid % nig) % gsz); u.pn = (wgid % nig) / gsz; u.e = 0; return true;
    }
};

#define MK_FRAG_LOOP(ROW, COL) \
    _Pragma("unroll") for (int ai = 0; ai < 2; ++ai) _Pragma("unroll") for (int m = 0; m < 4; ++m) _Pragma("unroll") for (int bj = 0; bj < 2; ++bj) \
        if (const int ROW = ai * HALF + wr * 64 + m * 16 + fr; true) if (const int COL = bj * HALF + wc * 32 + 8 * fq; true)

template <class E, class = void> struct epi_has_begin { static constexpr bool value = false; };
template <class E> struct epi_has_begin<E, decltype((void)&E::unit_begin)> { static constexpr bool value = true; };
template <bool B> struct BoolC { static constexpr bool value = B; };
template <class E, class = void> struct epi_ns { static constexpr int value = 0; };
template <class E> struct epi_ns<E, decltype((void)E::NS)> { static constexpr int value = 0 * E::NS; };
template <class E> __device__ __forceinline__ void epi_unit_begin(const E& e, const Unit& u, LAS unsigned char* lds) { if constexpr (epi_has_begin<E>::value) e.unit_begin(u, lds); }
template <bool GATHER = false, bool FP8 = false, class Epi, class Sched>
__device__ __forceinline__ void gemm_phase(LAS unsigned char* lds, const GemmP g, const Sched& S, const Epi& E) {
    const int tid = threadIdx.x, wid = __builtin_amdgcn_readfirstlane(tid >> 6), lane = tid & 63, wr = wid >> 2, wc = wid & 3, fr = lane & 15, fq = lane >> 4;
    int K = g.K; asm volatile("" : "+s"(K));
    const int nt = K / BK;
    int RA[2], CA[2]; unsigned voffB[2];
#pragma unroll
    for (int i = 0; i < 2; ++i) { int R, C; stage_rc(tid * 16 + i * 8192, R, C); RA[i] = R; CA[i] = C; const int Rb = (R & ~31) + perm32(R & 31); voffB[i] = (unsigned)(Rb * K + C) * 2u; }
    const size_t kstep = (size_t)(BK * 2), hstepB = (size_t)HALF * K * 2, tstepB = 2 * hstepB;
    const unsigned ldsw = (unsigned)wid * 1024u;
    const int aoff = lds_byte(wr * 64 + fr, fq * 8), boff = lds_byte(wc * 32 + fr, fq * 8);
#define MK_SA(b, h) (((b) * 2 + (h)) * HTB)
#define MK_SB(b, h) ((4 + (b) * 2 + (h)) * HTB)
#define MK_STAGE(bufoff, gbase, voff) do { _Pragma("unroll") for (int _i = 0; _i < 2; ++_i) \
        __builtin_amdgcn_global_load_lds((const unsigned*)((const char*)(gbase) + (voff)[_i]), (LAS unsigned*)(lds + (bufoff) + ldsw + _i * 8192), 16, 0, 0); } while (0)
#define MK_CAT8(x, y) __builtin_shufflevector(__builtin_bit_cast(i32x4, x), __builtin_bit_cast(i32x4, y), 0, 1, 2, 3, 4, 5, 6, 7)
#define MK_LDA(dst, b, h) do { _Pragma("unroll") for (int m = 0; m < 4; ++m) { if constexpr (FP8) dst##8[m] = MK_CAT8(*(const LAS bf16x8*)(lds + MK_SA(b, h) + aoff + m * 2048), *(const LAS bf16x8*)(lds + MK_SA(b, h) + aoff + m * 2048 + 1024)); \
        else { _Pragma("unroll") for (int k = 0; k < 2; ++k) dst[m][k] = *(const LAS bf16x8*)(lds + MK_SA(b, h) + aoff + m * 2048 + k * 1024); } } } while (0)
#define MK_LDB(dst, b, h) do { _Pragma("unroll") for (int n = 0; n < 2; ++n) { if constexpr (FP8) dst##8[n] = MK_CAT8(*(const LAS bf16x8*)(lds + MK_SB(b, h) + boff + n * 2048), *(const LAS bf16x8*)(lds + MK_SB(b, h) + boff + n * 2048 + 1024)); \
        else { _Pragma("unroll") for (int k = 0; k < 2; ++k) dst[n][k] = *(const LAS bf16x8*)(lds + MK_SB(b, h) + boff + n * 2048 + k * 1024); } } } while (0)
#define MK_MMA(ai, bj, At, Bt) do { __builtin_amdgcn_s_setprio(1); _Pragma("unroll") for (int m = 0; m < 4; ++m) _Pragma("unroll") for (int n = 0; n < 2; ++n) { \
        if constexpr (FP8) asm volatile("v_mfma_scale_f32_16x16x128_f8f6f4 %0, %1, %2, %0, %3, %3 op_sel_hi:[0,0,0]" : "+v"(acc[ai][bj][m][n]) : "v"(Bt##8[n]), "v"(At##8[m]), "v"(mx_one));   \
        else { _Pragma("unroll") for (int k = 0; k < 2; ++k) acc[ai][bj][m][n] = __builtin_amdgcn_mfma_f32_16x16x32_bf16(Bt[n][k], At[m][k], acc[ai][bj][m][n], 0, 0, 0); } } \
        __builtin_amdgcn_s_setprio(0); } while (0)
#define MK_WAIT_V(n) asm volatile("s_waitcnt vmcnt(" #n ")" ::: "memory")
#define MK_WAIT_L(n) asm volatile("s_waitcnt lgkmcnt(" #n ")" ::: "memory")
#define MK_BAR __builtin_amdgcn_s_barrier()
#define MK_SCHED __builtin_amdgcn_sched_barrier(0)
    Unit cur, nxt; int ui = 0;
    if (!S.next(0, cur)) return;
    f32x4 acc[2][2][4][2];
#pragma unroll
    for (int a = 0; a < 2; ++a)
#pragma unroll
        for (int b = 0; b < 2; ++b)
#pragma unroll
            for (int m = 0; m < 4; ++m)
#pragma unroll
                for (int n = 0; n < 2; ++n) acc[a][b][m][n] = (f32x4){0.f, 0.f, 0.f, 0.f};
    bf16x8 At[4][2], B0[2][2], B1[2][2];
    i32x8 At8[4], B08[2], B18[2];
    int mx_one = 0x7f7f7f7f; asm volatile("" : "+v"(mx_one));
    unsigned vA[2][2], vAn[2][2];
    const size_t hstepA = GATHER ? 0 : (size_t)HALF * K * 2, tstepA = 2 * (size_t)HALF * K * 2;
    auto a_voff = [&](const Unit& u, unsigned (&vo)[2][2]) {
#pragma unroll
        for (int h = 0; h < 2; ++h)
#pragma unroll
            for (int i = 0; i < 2; ++i) { if (GATHER) { const int row = u.pm * BM + h * HALF + RA[i]; vo[h][i] = (unsigned)((size_t)g.gather[row] * K + CA[i]) * 2u; } else vo[h][i] = (unsigned)(RA[i] * K + CA[i]) * 2u; }
    };
    a_voff(cur, vA);
    const LAS int* GLDS = (const LAS int*)(lds + STAGE_BYTES + 2048);
    auto a_voff_lds = [&](unsigned (&vo)[2][2]) {
#pragma unroll
        for (int h = 0; h < 2; ++h)
#pragma unroll
            for (int i = 0; i < 2; ++i) vo[h][i] = (unsigned)((size_t)GLDS[h * HALF + RA[i]] * K + CA[i]) * 2u;
    };
    auto a_base = [&](const Unit& u) { return (const char*)(u.e ? g.A1 : g.A0) + (GATHER ? (size_t)0 : (size_t)u.pm * tstepA); };
    const char* cA = a_base(cur);
    const char* cB = (const char*)g.Bt + ((size_t)cur.e * g.strideB) * 2 + (size_t)cur.pn * tstepB;
    MK_STAGE(MK_SB(0, 0), cB, voffB); MK_STAGE(MK_SA(0, 0), cA, vA[0]); MK_STAGE(MK_SB(0, 1), cB + hstepB, voffB); MK_STAGE(MK_SA(0, 1), cA + hstepA, vA[1]);
    if (wr == 1) MK_BAR;
    MK_WAIT_V(4); MK_BAR;
    MK_STAGE(MK_SB(1, 0), cB + kstep, voffB); MK_STAGE(MK_SA(1, 0), cA + kstep, vA[0]); MK_STAGE(MK_SB(1, 1), cB + hstepB + kstep, voffB);
    MK_WAIT_V(6); MK_BAR;
    for (;;) {
        epi_unit_begin(E, cur, lds);
        const bool has_next = S.next(ui + 1, nxt);
        if (GATHER && has_next && wid < 4) __builtin_amdgcn_global_load_lds((const unsigned*)g.gather + (size_t)nxt.pm * BM + wid * 64 + lane, (LAS unsigned*)(lds + STAGE_BYTES + 2048 + wid * 256), 4, 0, 0);
        const char* nA = has_next ? a_base(nxt) : cA;
        const char* nB = has_next ? (const char*)g.Bt + ((size_t)nxt.e * g.strideB) * 2 + (size_t)nxt.pn * tstepB : cB;
        for (int t = 0; t < nt; t += 2) {
            const bool last = (t == nt - 2);
            const int relax = (epi_ns<Epi>::value == 16 && t == 0) ? 1 : 0;
#define MK_WAIT_VR do { if constexpr (epi_ns<Epi>::value != 16) MK_WAIT_V(10); else asm volatile("v_cmp_ne_u32_e32 vcc, 0, %0\n\ts_nop 3\n\ts_cbranch_vccnz .Lwr%=\n\ts_waitcnt vmcnt(10)\n.Lwr%=:\n\ts_waitcnt vmcnt(26)" :: "v"(relax) : "vcc", "memory"); } while (0)
            if (GATHER && last) { if (has_next) a_voff_lds(vAn); else {
#pragma unroll
                for (int h = 0; h < 2; ++h)
#pragma unroll
                    for (int i = 0; i < 2; ++i) vAn[h][i] = vA[h][i]; } }
            const char* a1 = cA + (size_t)(t + 1) * kstep;
            const char* a2 = last ? nA : cA + (size_t)(t + 2) * kstep; const char* b2 = last ? nB : cB + (size_t)(t + 2) * kstep;
            const char* a3 = a2 + kstep; const char* b3 = b2 + kstep;
            unsigned v2[2][2];
#pragma unroll
            for (int h = 0; h < 2; ++h)
#pragma unroll
                for (int i = 0; i < 2; ++i) v2[h][i] = (GATHER && last) ? vAn[h][i] : vA[h][i];
            MK_LDB(B0, 0, 0); MK_SCHED; MK_LDA(At, 0, 0); MK_STAGE(MK_SA(1, 1), a1 + hstepA, vA[1]);
            MK_WAIT_VR; MK_WAIT_L(8); MK_BAR; MK_WAIT_L(0); MK_MMA(0, 0, At, B0); MK_BAR; MK_SCHED;
            MK_LDB(B1, 0, 1); MK_STAGE(MK_SB(0, 0), b2, voffB);
            MK_WAIT_VR; MK_BAR; MK_WAIT_L(0); MK_MMA(0, 1, At, B1); MK_BAR;
            MK_LDA(At, 0, 1); MK_STAGE(MK_SA(0, 0), a2, v2[0]);
            MK_BAR; MK_WAIT_L(0); MK_MMA(1, 0, At, B0); MK_BAR; MK_SCHED;
            MK_STAGE(MK_SB(0, 1), b2 + hstepB, voffB);
            MK_WAIT_VR; MK_BAR; MK_MMA(1, 1, At, B1); MK_BAR;
            MK_LDB(B0, 1, 0); MK_SCHED; MK_LDA(At, 1, 0); MK_STAGE(MK_SA(0, 1), a2 + hstepA, v2[1]);
            MK_WAIT_VR; MK_WAIT_L(8); MK_BAR; MK_WAIT_L(0); MK_MMA(0, 0, At, B0); MK_BAR; MK_SCHED;
            MK_LDB(B1, 1, 1); MK_STAGE(MK_SB(1, 0), b3, voffB);
            MK_WAIT_V(10); MK_BAR; MK_WAIT_L(0); MK_MMA(0, 1, At, B1); MK_BAR;
            MK_LDA(At, 1, 1); MK_STAGE(MK_SA(1, 0), a3, v2[0]);
            MK_BAR; MK_WAIT_L(0); MK_MMA(1, 0, At, B0); MK_BAR; MK_SCHED;
            MK_STAGE(MK_SB(1, 1), b3 + hstepB, voffB);
            MK_WAIT_V(10); MK_BAR; MK_MMA(1, 1, At, B1); MK_BAR;
        }
        if constexpr (FP8) asm volatile("s_nop 15\n\ts_nop 15" : "+v"(acc[1][1][0][0]), "+v"(acc[1][1][0][1]), "+v"(acc[1][1][1][0]), "+v"(acc[1][1][1][1]),
                                        "+v"(acc[1][1][2][0]), "+v"(acc[1][1][2][1]), "+v"(acc[1][1][3][0]), "+v"(acc[1][1][3][1]) :: "memory");
        int fr_ = fr, fq_ = fq; asm volatile("" : "+v"(fr_), "+v"(fq_));
        if (wr == 0) MK_BAR;
        const bool keep = E(acc, cur, wr, wc, fr_, fq_);
        if (wr == 1) MK_BAR;
        if (!has_next) break;
        if (!keep) {
#pragma unroll
            for (int a = 0; a < 2; ++a)
#pragma unroll
                for (int b = 0; b < 2; ++b)
#pragma unroll
                    for (int m = 0; m < 4; ++m)
#pragma unroll
                        for (int n = 0; n < 2; ++n) acc[a][b][m][n] = (f32x4){0.f, 0.f, 0.f, 0.f};
        }
        cur = nxt; cA = nA; cB = nB; ++ui;
        if (GATHER) {
#pragma unroll
            for (int h = 0; h < 2; ++h)
#pragma unroll
                for (int i = 0; i < 2; ++i) vA[h][i] = vAn[h][i]; }
    }
    MK_WAIT_V(0);
    if (wr == 0) MK_BAR;
    MK_BAR;
#undef MK_SA
#undef MK_SB
#undef MK_STAGE
#undef MK_LDA
#undef MK_LDB
#undef MK_MMA
#undef MK_CAT8
#undef MK_WAIT_V
#undef MK_WAIT_VR
#undef MK_WAIT_L
#undef MK_BAR
#undef MK_SCHED
}

__device__ __forceinline__ unsigned pack4_fp8(float a, float b, float c, float d) {
    a = fminf(fmaxf(a, -448.f), 448.f); b = fminf(fmaxf(b, -448.f), 448.f); c = fminf(fmaxf(c, -448.f), 448.f); d = fminf(fmaxf(d, -448.f), 448.f);
    int w = __builtin_amdgcn_cvt_pk_fp8_f32(a, b, 0, false); w = __builtin_amdgcn_cvt_pk_fp8_f32(c, d, w, true); return (unsigned)w; }
__device__ __forceinline__ u32x4 pack8(const f32x4 a, const f32x4 b) { u32x4 w; w.x = cvt_pk_bf16(a[0], a[1]); w.y = cvt_pk_bf16(a[2], a[3]); w.z = cvt_pk_bf16(b[0], b[1]); w.w = cvt_pk_bf16(b[2], b[3]); return w; }
struct EpiStoreBf16S {
    bf16_t* O; long ldc; float sc; int pad_;
    __device__ __forceinline__ bool operator()(const f32x4 (&acc)[2][2][4][2], const Unit& u, int wr, int wc, int fr, int fq) const {
        MK_FRAG_LOOP(r, c) { *(u32x4*)(O + (size_t)(u.pm * BM + r) * ldc + u.pn * BM + c) = pack8(acc[ai][bj][m][0] * sc, acc[ai][bj][m][1] * sc); }
        return false;
    }
};
struct EpiStoreBf16 {
    static constexpr int NS = 16;
    bf16_t* O; long ldc;
    __device__ __forceinline__ bool operator()(const f32x4 (&acc)[2][2][4][2], const Unit& u, int wr, int wc, int fr, int fq) const {
        MK_FRAG_LOOP(r, c) { *(u32x4*)(O + (size_t)(u.pm * BM + r) * ldc + u.pn * BM + c) = pack8(acc[ai][bj][m][0], acc[ai][bj][m][1]); }
        return false;
    }
};

struct EpiStorePred {
    bf16_t* O; long ldc;
    __device__ __forceinline__ bool operator()(const f32x4 (&acc)[2][2][4][2], const Unit& u, int wr, int wc, int fr, int fq) const {
        MK_FRAG_LOOP(r, c) { const u32x4 w = pack8(acc[ai][bj][m][0], acc[ai][bj][m][1]); if (w.x == 0x7fc17fc1u && w.w == 0x12345678u) *(u32x4*)(O + (size_t)(u.pm * BM + r) * ldc + u.pn * BM + c) = w; }
        return false;
    }
};
struct EpiStoreLine {
    bf16_t* O; long nunit;
    __device__ __forceinline__ bool operator()(const f32x4 (&acc)[2][2][4][2], const Unit& u, int wr, int wc, int fr, int fq) const {
        const size_t ub = (size_t)((u.pm * 18 + u.pn) % (int)nunit) * (BM * BM); const int wid = wr * 4 + wc, lane = fq * 16 + fr; int f = 0;
        MK_FRAG_LOOP(r, c) { *(u32x4*)(O + ub + ((size_t)(f * 8 + wid) * 64 + lane) * 8) = pack8(acc[ai][bj][m][0], acc[ai][bj][m][1]); ++f; }
        return false;
    }
};
struct EpiNull {
    __device__ __forceinline__ bool operator()(const f32x4 (&acc)[2][2][4][2], const Unit& u, int wr, int wc, int fr, int fq) const {
        MK_FRAG_LOOP(r, c) { asm volatile("" :: "v"(acc[ai][bj][m][0]), "v"(acc[ai][bj][m][1])); }
        return false;
    }
};

__device__ __forceinline__ void ld8_contig(const float* p, float (&o)[8]) { const f32x4 a = *(const f32x4*)p, b = *(const f32x4*)(p + 4); o[0] = a[0]; o[1] = a[1]; o[2] = a[2]; o[3] = a[3]; o[4] = b[0]; o[5] = b[1]; o[6] = b[2]; o[7] = b[3]; }
struct CMapZ1 { __device__ int operator()(int n) const { return n < RC ? n : (n < Z1_LX ? -1 : OFF_LX + (n - Z1_LX)); }
    __device__ __forceinline__ void load8(const float* rowp, int n, float (&o)[8]) const { const int sc = (*this)(n); if (sc >= 0) ld8_contig(rowp + sc, o); else {
#pragma unroll
        for (int j = 0; j < 8; ++j) o[j] = 0.f; } } };
struct CMapZC { __device__ int operator()(int n) const { return OFF_LG + n; }
    __device__ __forceinline__ void load8(const float* rowp, int n, float (&o)[8]) const { ld8_contig(rowp + OFF_LG + n, o); } };
struct CMapId { __device__ int operator()(int n) const { return n; }
    __device__ __forceinline__ void load8(const float* rowp, int n, float (&o)[8]) const { ld8_contig(rowp + n, o); } };
struct CMapGU { int F; __device__ int operator()(int n) const { return (n & 1) * F + (n >> 1); }
    __device__ __forceinline__ void load8(const float* rowp, int n, float (&o)[8]) const { const f32x4 g = *(const f32x4*)(rowp + (n >> 1)), u = *(const f32x4*)(rowp + F + (n >> 1));
        o[0] = g[0]; o[1] = u[0]; o[2] = g[1]; o[3] = u[1]; o[4] = g[2]; o[5] = u[2]; o[6] = g[3]; o[7] = u[3]; } };
constexpr int CT_B = 8;
template <bool OUT8 = false, class CM>
__device__ __forceinline__ void convT_job(LAS float* tile  , const float* src, int lds_, int Ks, bf16_t* dst, int Kd, int N, const CM& cm, int bid, int nblk, int& base, float oscale = 1.f) {
    const int tk = Kd / 64, nt = (N / 64) * tk, tid = threadIdx.x;
    const int first = (bid - base % nblk + nblk) % nblk;
    const int kk = tid >> 3, nn8 = (tid & 7) * 8, nn = tid >> 3, kk8 = (tid & 7) * 8;
    for (int t0 = first; t0 < nt; t0 += CT_B * nblk) {
        float v[CT_B][8];
#pragma unroll
        for (int b = 0; b < CT_B; ++b) { const int t = t0 + b * nblk; const int n0 = (t / tk) * 64, k0 = (t % tk) * 64, k = k0 + kk;
            if (t < nt && k < Ks) cm.load8(src + (size_t)k * lds_, n0 + nn8, v[b]); else {
#pragma unroll
                for (int j = 0; j < 8; ++j) v[b][j] = 0.f; } }
#pragma unroll
        for (int b = 0; b < CT_B; ++b)
#pragma unroll
            for (int j = 0; j < 8; ++j) tile[b * 64 * 65 + kk * 65 + nn8 + j] = v[b][j];
        __syncthreads();
#pragma unroll
        for (int b = 0; b < CT_B; ++b) { const int t = t0 + b * nblk; if (t < nt) { const int n0 = (t / tk) * 64, k0 = (t % tk) * 64; f32x4 a, c;
#pragma unroll
            for (int j = 0; j < 4; ++j) { a[j] = tile[b * 64 * 65 + (kk8 + j) * 65 + nn]; c[j] = tile[b * 64 * 65 + (kk8 + 4 + j) * 65 + nn]; }
            if constexpr (OUT8) { u32x2 w8; w8.x = pack4_fp8(a[0] * oscale, a[1] * oscale, a[2] * oscale, a[3] * oscale); w8.y = pack4_fp8(c[0] * oscale, c[1] * oscale, c[2] * oscale, c[3] * oscale);
                *(u32x2*)((unsigned char*)dst + (size_t)(n0 + nn) * Kd + k0 + kk8) = w8; }
            else *(u32x4*)(dst + (size_t)(n0 + nn) * Kd + k0 + kk8) = pack8(a, c); } }
        __syncthreads();
    }
    base += nt;
}

template <bool OUT8 = false, class CM, class MS>
__device__ __forceinline__ void convT_multi(LAS float* tile, const MS& ms, int nmat, int lds_, int Ks, int Kd, int N, const CM& cm, int bid, int nblk, float oscale = 1.f) {
    const int tk = Kd / 64, tpm = (N / 64) * tk, nt = nmat * tpm, tid = threadIdx.x;
    const int kk = tid >> 3, nn8 = (tid & 7) * 8, nn = tid >> 3, kk8 = (tid & 7) * 8;
    for (int t0 = bid; t0 < nt; t0 += CT_B * nblk) {
        float v[CT_B][8];
#pragma unroll
        for (int b = 0; b < CT_B; ++b) { const int T = t0 + b * nblk, m = T / tpm, t = T % tpm; const int n0 = (t / tk) * 64, k0 = (t % tk) * 64, k = k0 + kk;
            if (T < nt && k < Ks) cm.load8(ms.src(m) + (size_t)k * lds_, n0 + nn8, v[b]); else {
#pragma unroll
                for (int j = 0; j < 8; ++j) v[b][j] = 0.f; } }
#pragma unroll
        for (int b = 0; b < CT_B; ++b)
#pragma unroll
            for (int j = 0; j < 8; ++j) tile[b * 64 * 65 + kk * 65 + nn8 + j] = v[b][j];
        __syncthreads();
#pragma unroll
        for (int b = 0; b < CT_B; ++b) { const int T = t0 + b * nblk; if (T < nt) { const int m = T / tpm, t = T % tpm, n0 = (t / tk) * 64, k0 = (t % tk) * 64; f32x4 a, c;
#pragma unroll
            for (int j = 0; j < 4; ++j) { a[j] = tile[b * 64 * 65 + (kk8 + j) * 65 + nn]; c[j] = tile[b * 64 * 65 + (kk8 + 4 + j) * 65 + nn]; }
            if constexpr (OUT8) { u32x2 w8; w8.x = pack4_fp8(a[0] * oscale, a[1] * oscale, a[2] * oscale, a[3] * oscale); w8.y = pack4_fp8(c[0] * oscale, c[1] * oscale, c[2] * oscale, c[3] * oscale);
                *(u32x2*)((unsigned char*)ms.dst(m) + (size_t)(n0 + nn) * Kd + k0 + kk8) = w8; }
            else *(u32x4*)(ms.dst(m) + (size_t)(n0 + nn) * Kd + k0 + kk8) = pack8(a, c); } }
        __syncthreads();
    }
}

constexpr int MOD_SL = 16, MOD_KS = D / MOD_SL;
__device__ __forceinline__ void mod_partials(LAS float* sl  , const In& in, float* part  , int bid, int nblk) {
    const int ncc = 6 * D / NT, nitem = MOD_SL * ncc;
    for (int it = bid; it < nitem; it += nblk) {
        const int s = it / ncc, j = (it % ncc) * NT + threadIdx.x;
        for (int i = threadIdx.x; i < (NB + 1) * MOD_KS; i += NT) { const int r = i / MOD_KS, k = s * MOD_KS + i % MOD_KS; const float cv = r < NB ? in.c[r * D + k] : in.c_ctx[k]; sl[i] = siluf_(cv); }
        __syncthreads();
        float acc[NB + 1];
#pragma unroll
        for (int r = 0; r <= NB; ++r) acc[r] = 0.f;
        for (int k = 0; k < MOD_KS; ++k) { const float w = in.w_mod[(size_t)(s * MOD_KS + k) * 6 * D + j];
#pragma unroll
            for (int r = 0; r <= NB; ++r) acc[r] += sl[r * MOD_KS + k] * w; }
#pragma unroll
        for (int r = 0; r <= NB; ++r) part[((size_t)s * (NB + 1) + r) * 6 * D + j] = acc[r];
        __syncthreads();
    }
}
__device__ __forceinline__ float mod_value(const In& in, const float* part, int r, int j) {
    float s = in.b_mod[j];
#pragma unroll
    for (int q = 0; q < MOD_SL; ++q) s += part[((size_t)q * (NB + 1) + r) * 6 * D + j];
    return s;
}

template <bool OUT8 = false>
__device__ __forceinline__ void xn_rows(LAS float* sm  , const In& in, const float* part, bf16_t* xn, int b0, int nb, int row_lo, int row_hi) {
    const int nlat = nb * SEQ, wid = threadIdx.x >> 6, lane = threadIdx.x & 63;
    int cur_mr = -1;
    float gp[16];
#pragma unroll
    for (int j = 0; j < 4; ++j)
#pragma unroll
        for (int q = 0; q < 4; ++q) gp[4 * j + q] = in.norm_g[j * 256 + lane * 4 + q];
    auto src_of = [&](int r) __attribute__((always_inline)) { return r < nlat ? in.x + ((size_t)b0 * SEQ + r) * D : in.ctx + ((size_t)b0 * CTX + (r - nlat)) * D; };
    f32x4 nx[4];
    { const int r = row_lo + wid; if (r < row_hi) { const float* src = src_of(r);
#pragma unroll
        for (int j = 0; j < 4; ++j) nx[j] = *(const f32x4*)(src + j * 256 + lane * 4); } }
    for (int rbase = row_lo; rbase < row_hi; rbase += 8) {
        const int mr = rbase < nlat ? b0 + rbase / SEQ : NB;
        if (mr != cur_mr) { __syncthreads(); for (int j = threadIdx.x; j < 2 * D; j += NT) sm[j] = mod_value(in, part, mr, j); __syncthreads(); cur_mr = mr; }
        const int r = rbase + wid; if (r >= row_hi) continue;
        f32x4 v[4]; float ss = 0.f;
#pragma unroll
        for (int j = 0; j < 4; ++j) { v[j] = nx[j]; ss += v[j][0] * v[j][0] + v[j][1] * v[j][1] + v[j][2] * v[j][2] + v[j][3] * v[j][3]; }
        if (r + 8 < row_hi) { const float* src = src_of(r + 8);
#pragma unroll
            for (int j = 0; j < 4; ++j) nx[j] = *(const f32x4*)(src + j * 256 + lane * 4); }
        ss = wave_sum64(ss);
        const float rinv = __builtin_amdgcn_rsqf(ss * (1.f / D) + NORM_EPS);
#pragma unroll
        for (int j = 0; j < 4; ++j) { const int c = j * 256 + lane * 4; float o[4];
#pragma unroll
            for (int q = 0; q < 4; ++q) o[q] = (v[j][q] * rinv * gp[4 * j + q]) * (1.f + sm[D + c + q]) + sm[c + q];
            if constexpr (OUT8) *(unsigned*)((unsigned char*)xn + (size_t)r * D + c) = pack4_fp8(o[0] * 16.f, o[1] * 16.f, o[2] * 16.f, o[3] * 16.f);
            else { u32x2 w; w.x = cvt_pk_bf16(o[0], o[1]); w.y = cvt_pk_bf16(o[2], o[3]); *(u32x2*)(xn + (size_t)r * D + c) = w; } }
    }
}
}

namespace mk {
#define XB_TMO      128
#define XB_XCNT(j)  (256  + 64 * (j))
#define XB_XSUB(j)  (1280 + 64 * (j))
#define XB_XGEN(j)  (2304 + 64 * (j))
#define XB_TOP      3328
#define XB_TOPGEN   3392
#define XCD_BAR_WORDS 3456
#define XB_SPIN_CAP (1u << 18)
__device__ __forceinline__ unsigned xb_ld(unsigned* p)              { return __hip_atomic_load(p, __ATOMIC_RELAXED, __HIP_MEMORY_SCOPE_AGENT); }
__device__ __forceinline__ unsigned xb_add(unsigned* p, unsigned v) { return __hip_atomic_fetch_add(p, v, __ATOMIC_RELAXED, __HIP_MEMORY_SCOPE_AGENT); }
__device__ __forceinline__ unsigned xb_xcc_id() { return (unsigned)__builtin_amdgcn_s_getreg((3 << 11) | 20) & 0xFu; }
#define XB_SPIN(cond, bar) do { unsigned _sp = 0; while (cond) { __builtin_amdgcn_s_sleep(1); \
    if ((++_sp & 255u) == 0u) { if (xb_ld(&(bar)[XB_TMO])) break; if (_sp > XB_SPIN_CAP) { atomicAdd(&(bar)[XB_TMO], 1u); break; } } } } while (0)
struct XcdBarrier { unsigned* bar; unsigned x; volatile LAS unsigned* st; };
__device__ __forceinline__ XcdBarrier xcd_barrier_post(unsigned* bar, volatile LAS unsigned* st) {
    XcdBarrier b; b.bar = bar; b.x = xb_xcc_id(); b.st = st;
    if (threadIdx.x == 0) (void)xb_add(&bar[XB_XCNT(b.x)], 1u);
    return b;
}
__device__ __forceinline__ void xcd_barrier_complete(unsigned* bar, unsigned x, unsigned& nloc, unsigned& nx) {
    const unsigned G = gridDim.x * gridDim.y * gridDim.z;
    unsigned sum, cnt, mine, sp = 0u;
    for (;;) {
        sum = 0u; cnt = 0u; mine = 0u;
#pragma unroll
        for (unsigned j = 0; j < 16; ++j) { const unsigned c = xb_ld(&bar[XB_XCNT(j)]); sum += c; cnt += (c > 0u) ? 1u : 0u; mine = (j == x) ? c : mine; }
        if (sum == G) break;
        __builtin_amdgcn_s_sleep(1);
        if ((++sp & 255u) == 0u) { if (xb_ld(&bar[XB_TMO])) break; if (sp > XB_SPIN_CAP) { atomicAdd(&bar[XB_TMO], 1u); break; } }
    }
    nloc = mine > 0u ? mine : 1u; nx = cnt > 0u ? cnt : 1u;
}
__device__ __forceinline__ void xcd_barrier(const XcdBarrier& b) {
    asm volatile("s_waitcnt vmcnt(0)" ::: "memory");
    __syncthreads();
    if (threadIdx.x == 0) {
        unsigned* bar = b.bar;
        __builtin_amdgcn_s_waitcnt(0);
        unsigned nloc = b.st[0], nx = b.st[1];
        if (nloc == 0u) { xcd_barrier_complete(bar, b.x, nloc, nx); b.st[0] = nloc; b.st[1] = nx; }
        const unsigned old = xb_add(&bar[XB_XSUB(b.x)], 1u);
        const unsigned gen = old / nloc;
        if (old + 1u == (gen + 1u) * nloc) {
            __builtin_amdgcn_fence(__ATOMIC_RELEASE, "agent");
            asm volatile("s_waitcnt vmcnt(0)" ::: "memory");
            const unsigned og = xb_add(&bar[XB_TOP], 1u);
            const unsigned tg = og / nx;
            if (og + 1u == (tg + 1u) * nx) xb_add(&bar[XB_TOPGEN], 1u);
            else XB_SPIN(xb_ld(&bar[XB_TOPGEN]) == tg, bar);
            __builtin_amdgcn_fence(__ATOMIC_ACQUIRE, "agent");
            xb_add(&bar[XB_XGEN(b.x)], 1u);
            asm volatile("s_waitcnt vmcnt(0)" ::: "memory");
        } else {
            XB_SPIN(xb_ld(&bar[XB_XGEN(b.x)]) == gen, bar);
            __builtin_amdgcn_fence(__ATOMIC_ACQUIRE, "agent");
            asm volatile("s_waitcnt vmcnt(0)" ::: "memory");
        }
    }
    __syncthreads();
}
}

namespace mk {
constexpr int TB = 32;
constexpr int RAWW = 320;
constexpr int RW_RAW = 0;
constexpr int RW_MU = RW_RAW + (TB + 2) * RAWW * 2;
constexpr int RW_WUP = RW_MU + 2 * RAWW * 4;
constexpr int RW_AUP = RW_WUP + 64 * 72 * 2;
constexpr int RW_CST = RW_AUP + 64 * 72 * 2;
constexpr int RW_AWD = RW_CST + 5 * 64 * 4;
constexpr int RW_AAD = RW_AWD + TB * 72 * 2;
constexpr int RW_R = RW_AAD + TB * 72 * 2;
constexpr int RW_KR = RW_R + TB * 64 * 4;
constexpr int RW_LA = RW_KR + TB * 64 * 4;
constexpr int RW_KK = RW_LA + TB * 64 * 4;
constexpr int RW_W = RW_KK + TB * 64 * 4;
constexpr int RW_B = RW_W + TB * 64 * 4;
constexpr int RW_KD = RW_B + TB * 64 * 4;
constexpr int RW_WR = RW_KD + TB * 64 * 4;
constexpr int RW_V = RW_WR + TB * 64 * 4;
constexpr int RW_SC = RW_V + TB * 64 * 4;
constexpr int RW_YO = RW_SC + TB * 2 * 4;
constexpr int RW_BON = RW_YO + TB * 64 * 4;
constexpr int RW_END = RW_BON + TB * 4;
static_assert(RW_END <= LDS_BYTES, "rwkv LDS");

#define MK_DPP(x, ctrl) __int_as_float(__builtin_amdgcn_update_dpp(__float_as_int(x), __float_as_int(x), ctrl, 0xF, 0xF, false))
__device__ __forceinline__ float allreduce16(float x) {
    x += MK_DPP(x, 0xB1); x += MK_DPP(x, 0x4E); x += MK_DPP(x, 0x141); x += MK_DPP(x, 0x140); return x;
}

__device__ __forceinline__ void allreduce16x4(float& a, float& b, float& c, float& d) {
    asm volatile("s_nop 1\n\t"
        "v_add_f32_dpp %0, %0, %0 quad_perm:[1,0,3,2] row_mask:0xf bank_mask:0xf\n\t" "v_add_f32_dpp %1, %1, %1 quad_perm:[1,0,3,2] row_mask:0xf bank_mask:0xf\n\t"
        "v_add_f32_dpp %2, %2, %2 quad_perm:[1,0,3,2] row_mask:0xf bank_mask:0xf\n\t" "v_add_f32_dpp %3, %3, %3 quad_perm:[1,0,3,2] row_mask:0xf bank_mask:0xf\n\t"
        "v_add_f32_dpp %0, %0, %0 quad_perm:[2,3,0,1] row_mask:0xf bank_mask:0xf\n\t" "v_add_f32_dpp %1, %1, %1 quad_perm:[2,3,0,1] row_mask:0xf bank_mask:0xf\n\t"
        "v_add_f32_dpp %2, %2, %2 quad_perm:[2,3,0,1] row_mask:0xf bank_mask:0xf\n\t" "v_add_f32_dpp %3, %3, %3 quad_perm:[2,3,0,1] row_mask:0xf bank_mask:0xf\n\t"
        "v_add_f32_dpp %0, %0, %0 row_half_mirror row_mask:0xf bank_mask:0xf\n\t" "v_add_f32_dpp %1, %1, %1 row_half_mirror row_mask:0xf bank_mask:0xf\n\t"
        "v_add_f32_dpp %2, %2, %2 row_half_mirror row_mask:0xf bank_mask:0xf\n\t" "v_add_f32_dpp %3, %3, %3 row_half_mirror row_mask:0xf bank_mask:0xf\n\t"
        "v_add_f32_dpp %0, %0, %0 row_mirror row_mask:0xf bank_mask:0xf\n\t" "v_add_f32_dpp %1, %1, %1 row_mirror row_mask:0xf bank_mask:0xf\n\t"
        "v_add_f32_dpp %2, %2, %2 row_mirror row_mask:0xf bank_mask:0xf\n\t" "v_add_f32_dpp %3, %3, %3 row_mirror row_mask:0xf bank_mask:0xf"
        : "+v"(a), "+v"(b), "+v"(c), "+v"(d));
}
struct RwkvP { const bf16_t* z1; bf16_t* Y; float* bon; int b0, nb; };

constexpr int RW_NPIECE = (TB + 2) * 40, RW_PPT = (RW_NPIECE + NT - 1) / NT;

__device__ __forceinline__ void rwkv_chain(LAS unsigned char* lds, const In& in, const RwkvP p, int chain) {
    const int tid = threadIdx.x, lane = tid & 63, wid = tid >> 6;
    const int d = chain / (p.nb * NH), bl = (chain / NH) % p.nb, h = chain % NH;
    const int nlat = p.nb * SEQ;
    LAS bf16_t* RAW = (LAS bf16_t*)(lds + RW_RAW); LAS float* MU = (LAS float*)(lds + RW_MU);
    LAS bf16_t* WUP = (LAS bf16_t*)(lds + RW_WUP); LAS bf16_t* AUP = (LAS bf16_t*)(lds + RW_AUP); LAS float* CST = (LAS float*)(lds + RW_CST);
    LAS bf16_t* AWD = (LAS bf16_t*)(lds + RW_AWD); LAS bf16_t* AAD = (LAS bf16_t*)(lds + RW_AAD);
    LAS float *Rr = (LAS float*)(lds + RW_R), *KR = (LAS float*)(lds + RW_KR), *LA_ = (LAS float*)(lds + RW_LA);
    LAS float *KK = (LAS float*)(lds + RW_KK), *Wv = (LAS float*)(lds + RW_W), *Bv = (LAS float*)(lds + RW_B), *KD = (LAS float*)(lds + RW_KD), *WR = (LAS float*)(lds + RW_WR), *Vv = (LAS float*)(lds + RW_V);
    LAS float *SC = (LAS float*)(lds + RW_SC), *YO = (LAS float*)(lds + RW_YO), *BON = (LAS float*)(lds + RW_BON);
    auto segcol = [&](int s) { return s < 3 ? s * RW + h * 64 : (s == 3 ? OFF_WD + d * DL : OFF_AD + d * AL); };
    for (int i = tid; i < 2 * RAWW; i += NT) { const int m = i / RAWW, c = i % RAWW; MU[i] = in.shift_mu[m * RC + segcol(c >> 6) + (c & 63)]; }
    for (int i = tid; i < 64 * 64; i += NT) { const int j = i >> 6, c = i & 63;
        WUP[c * 72 + j] = f2bf(in.rw_w_up[((size_t)d * DL + j) * RW + h * 64 + c]); AUP[c * 72 + j] = f2bf(in.rw_a_up[((size_t)d * AL + j) * RW + h * 64 + c]); }
    for (int i = tid; i < 64; i += NT) { CST[i] = in.rw_w0[d * RW + h * 64 + i]; CST[64 + i] = in.rw_a0[d * RW + h * 64 + i]; CST[128 + i] = in.rw_k_k[h * 64 + i]; CST[192 + i] = in.rw_k_a[h * 64 + i]; CST[256 + i] = in.rw_r_k[h * 64 + i]; }
    constexpr int NQ = (CTX + SEQ) / TB, NQC = CTX / TB;
    auto blk_info = [&](int q, bool& isctx, int& t0, bool& hp, bool& hn, size_t& grow0) {
        isctx = q < NQC;
        if (isctx) { const int qq = d == 0 ? q : NQC - 1 - q; t0 = qq * TB; hp = t0 > 0; hn = t0 + TB < CTX; grow0 = (size_t)nlat + (size_t)bl * CTX + t0; }
        else { const int ql = q - NQC, qq = d == 0 ? ql : SEQ / TB - 1 - ql; t0 = qq * TB; hp = (t0 % GW) != 0; hn = ((t0 + TB) % GW) != 0; grow0 = (size_t)bl * SEQ + t0; }
    };
    u32x4 pre[RW_PPT];
    auto prefetch = [&](int q) {
        bool isctx, hp, hn; int t0; size_t grow0; blk_info(q, isctx, t0, hp, hn, grow0);
#pragma unroll
        for (int k = 0; k < RW_PPT; ++k) { const int i = tid + k * NT; u32x4 v = (u32x4){0u, 0u, 0u, 0u};
            if (i < RW_NPIECE) { const int rr = i / 40, sp = i % 40, seg = sp >> 3, part = sp & 7;
                const bool ok = (rr == 0) ? hp : ((rr == TB + 1) ? hn : true);
                if (ok) v = *(const u32x4*)(p.z1 + (grow0 + rr - 1) * Z1_N + segcol(seg) + part * 8); }
            pre[k] = v; }
    };
    auto commit = [&]() {
#pragma unroll
        for (int k = 0; k < RW_PPT; ++k) { const int i = tid + k * NT; if (i < RW_NPIECE) { const int rr = i / 40, sp = i % 40; *(LAS u32x4*)(RAW + rr * RAWW + sp * 8) = pre[k]; } }
    };
    float S[2][4];
#pragma unroll
    for (int i = 0; i < 2; ++i)
#pragma unroll
        for (int j = 0; j < 4; ++j) S[i][j] = 0.f;
    const int kg = lane & 15, rp = (lane >> 4) + 4 * wid;
    prefetch(0);
    for (int q = 0; q < NQ; ++q) {
        bool isctx, hp, hn; int t0; size_t grow0; blk_info(q, isctx, t0, hp, hn, grow0);
        commit();
        __syncthreads();
        if (q + 1 < NQ) prefetch(q + 1);
        auto shift8 = [&](int t, int c0, float (&s)[8]) {
            const u32x4 xp = *(const LAS u32x4*)(RAW + t * RAWW + c0), xc = *(const LAS u32x4*)(RAW + (t + 1) * RAWW + c0), xn_ = *(const LAS u32x4*)(RAW + (t + 2) * RAWW + c0);
            const f32x4 m0a = *(const LAS f32x4*)(MU + c0), m0b = *(const LAS f32x4*)(MU + c0 + 4), m1a = *(const LAS f32x4*)(MU + RAWW + c0), m1b = *(const LAS f32x4*)(MU + RAWW + c0 + 4);
#pragma unroll
            for (int j = 0; j < 4; ++j) { const unsigned a = xp[j], b = xc[j], c = xn_[j];
                const float mu0l = j < 2 ? m0a[2 * j] : m0b[2 * j - 4], mu0h = j < 2 ? m0a[2 * j + 1] : m0b[2 * j - 3], mu1l = j < 2 ? m1a[2 * j] : m1b[2 * j - 4], mu1h = j < 2 ? m1a[2 * j + 1] : m1b[2 * j - 3];
                { const float x = bflo(b); s[2 * j] = x + mu0l * (bflo(a) - x) + mu1l * (bflo(c) - x); }
                { const float x = bfhi(b); s[2 * j + 1] = x + mu0h * (bfhi(a) - x) + mu1h * (bfhi(c) - x); } } };
        for (int it = tid; it < TB * 24; it += NT) {
            const int t = it / 24, g = it % 24, seg = g >> 3, cc = (g & 7) * 8; float s[8]; shift8(t, g * 8, s);
            LAS float* dst = (seg == 0 ? Rr : (seg == 1 ? KR : Vv)) + t * 64 + cc; *(LAS f32x4*)dst = (f32x4){s[0], s[1], s[2], s[3]}; *(LAS f32x4*)(dst + 4) = (f32x4){s[4], s[5], s[6], s[7]};
        }
        { const int t = tid >> 4, g = 24 + (tid & 15), cc = (g & 7) * 8; float s[8]; shift8(t, g * 8, s);
          const bool isw = (tid & 15) < 8;
#pragma unroll
          for (int j = 0; j < 8; ++j) { const float th = fast_tanh(s[j]); s[j] = isw ? th : s[j]; }
          LAS bf16_t* dst = (isw ? AWD : AAD) + t * 72 + cc;
          u32x4 w; w.x = cvt_pk_bf16(s[0], s[1]); w.y = cvt_pk_bf16(s[2], s[3]); w.z = cvt_pk_bf16(s[4], s[5]); w.w = cvt_pk_bf16(s[6], s[7]); *(LAS u32x4*)dst = w; }
        __syncthreads();
        {
            const int lora = wid >> 2, ct = wid & 3, fr = lane & 15, fq = lane >> 4;
            const LAS bf16_t* Am = lora ? AAD : AWD; const LAS bf16_t* Bm = lora ? AUP : WUP;
#pragma unroll
            for (int rt = 0; rt < 2; ++rt) {
                f32x4 acc = (f32x4){0.f, 0.f, 0.f, 0.f};
#pragma unroll
                for (int ks = 0; ks < 2; ++ks) {
                    const bf16x8 a = *(const LAS bf16x8*)(Am + (rt * 16 + fr) * 72 + ks * 32 + fq * 8);
                    const bf16x8 b = *(const LAS bf16x8*)(Bm + (ct * 16 + fr) * 72 + ks * 32 + fq * 8);
                    acc = __builtin_amdgcn_mfma_f32_16x16x32_bf16(a, b, acc, 0, 0, 0);
                }
                const int col = ct * 16 + fr;
#pragma unroll
                for (int i = 0; i < 4; ++i) { const int t = rt * 16 + fq * 4 + i;
                    if (lora == 0) { const float lw = acc[i] + CST[col]; const float wl = -fast_softplus(-lw) - 0.5f; Wv[t * 64 + col] = __expf(-__expf(wl)); }
                    else { LA_[t * 64 + col] = fast_sigmoid(acc[i] + CST[64 + col]); } }
            }
        }
        __syncthreads();
        {
            const int t = tid >> 4, c4 = (tid & 15) * 4;
            const f32x4 k = *(const LAS f32x4*)(KR + t * 64 + c4), a = *(const LAS f32x4*)(LA_ + t * 64 + c4), w = *(const LAS f32x4*)(Wv + t * 64 + c4), r = *(const LAS f32x4*)(Rr + t * 64 + c4);
            f32x4 kkr, kd, bb, wr; float ss = 0.f, br = 0.f, kr = 0.f, bn = 0.f;
#pragma unroll
            for (int j = 0; j < 4; ++j) { kkr[j] = k[j] * CST[128 + c4 + j]; ss += kkr[j] * kkr[j]; }
            ss = allreduce16(ss);
            const float inv = 1.f / fmaxf(sqrtf(ss), 1e-12f);
#pragma unroll
            for (int j = 0; j < 4; ++j) { const float kk = kkr[j] * inv; kkr[j] = kk; kd[j] = k[j] * (1.f + (a[j] - 1.f) * CST[192 + c4 + j]); bb[j] = kk * a[j]; wr[j] = w[j] * r[j];
                br += bb[j] * r[j]; kr += kd[j] * r[j]; bn += r[j] * kd[j] * CST[256 + c4 + j]; }
            br = allreduce16(br); kr = allreduce16(kr); bn = allreduce16(bn);
            *(LAS f32x4*)(KK + t * 64 + c4) = kkr; *(LAS f32x4*)(KD + t * 64 + c4) = kd; *(LAS f32x4*)(Bv + t * 64 + c4) = bb; *(LAS f32x4*)(WR + t * 64 + c4) = wr;
            if ((tid & 15) == 0) { SC[t * 2] = br; SC[t * 2 + 1] = kr; BON[t] = bn; }
        }
        __syncthreads();
        {
            auto tof = [&](int st) { return d == 0 ? st : TB - 1 - st; };
            const LAS float* lb = KK + 4 * kg;
            const LAS float* vb = Vv + 2 * rp;
            constexpr int OW = (RW_W - RW_KK) / 4, OB = (RW_B - RW_KK) / 4, OKD = (RW_KD - RW_KK) / 4, OWR = (RW_WR - RW_KK) / 4;
            int t = tof(0);
            f32x4 kk4 = *(const LAS f32x4*)(lb + t * 64), w4 = *(const LAS f32x4*)(lb + t * 64 + OW), b4 = *(const LAS f32x4*)(lb + t * 64 + OB),
                  kd4 = *(const LAS f32x4*)(lb + t * 64 + OKD), wr4 = *(const LAS f32x4*)(lb + t * 64 + OWR);
            f32x2 vv = *(const LAS f32x2*)(vb + t * 64), sc = *(const LAS f32x2*)(SC + t * 2);
            f32x2 S2[4];
#pragma unroll
            for (int j = 0; j < 4; ++j) { S2[j][0] = S[0][j]; S2[j][1] = S[1][j]; }
#pragma unroll 2
            for (int st = 0; st < TB; ++st) {
                const int tn = tof(st + 1 < TB ? st + 1 : st);
                const f32x4 nkk4 = *(const LAS f32x4*)(lb + tn * 64), nw4 = *(const LAS f32x4*)(lb + tn * 64 + OW), nb4 = *(const LAS f32x4*)(lb + tn * 64 + OB),
                            nkd4 = *(const LAS f32x4*)(lb + tn * 64 + OKD), nwr4 = *(const LAS f32x4*)(lb + tn * 64 + OWR);
                const f32x2 nvv = *(const LAS f32x2*)(vb + tn * 64), nsc = *(const LAS f32x2*)(SC + tn * 2);
                f32x2 sa2 = S2[0] * kk4[0], yo2 = S2[0] * wr4[0];
#pragma unroll
                for (int j = 1; j < 4; ++j) { sa2 += S2[j] * kk4[j]; yo2 += S2[j] * wr4[j]; }
                float sa0 = sa2[0], sa1 = sa2[1], yo0 = yo2[0], yo1 = yo2[1];
                allreduce16x4(sa0, sa1, yo0, yo1);
                f32x2 sar; sar[0] = sa0; sar[1] = sa1;
#pragma unroll
                for (int j = 0; j < 4; ++j) S2[j] = S2[j] * w4[j] + (vv * kd4[j] - sar * b4[j]);
                if (kg == 0) { f32x2 yor; yor[0] = yo0; yor[1] = yo1; const f32x2 y = yor - sar * sc[0] + vv * sc[1]; *(LAS f32x2*)(YO + t * 64 + 2 * rp) = y; }
                kk4 = nkk4; w4 = nw4; b4 = nb4; kd4 = nkd4; wr4 = nwr4; vv = nvv; sc = nsc; t = tn;
            }
#pragma unroll
            for (int j = 0; j < 4; ++j) { S[0][j] = S2[j][0]; S[1][j] = S2[j][1]; }
        }
        __syncthreads();
        if (!isctx) {
            const int t = tid >> 4, c4 = (tid & 15) * 4; const f32x4 y = *(const LAS f32x4*)(YO + t * 64 + c4);
            u32x2 w; w.x = cvt_pk_bf16(y[0], y[1]); w.y = cvt_pk_bf16(y[2], y[3]);
            *(u32x2*)(p.Y + ((size_t)d * nlat + grow0 + t) * RW + h * 64 + c4) = w;
            if (tid < TB) p.bon[((size_t)d * nlat + grow0 + tid) * NH + h] = BON[tid];
        }
    }
}
__device__ __forceinline__ void rwkv_phase(LAS unsigned char* lds, const In& in, const RwkvP p, int bid, int nblk) {
    const int nchain = 2 * p.nb * NH;
    for (int c = bid; c < nchain; c += nblk) { rwkv_chain(lds, in, p, c); __syncthreads(); }
}
}

namespace mk {
constexpr int C2_RAW = 0;
constexpr int C2_MU = C2_RAW + (TB + 2) * RAWW * 2;
constexpr int C2_WUP = C2_MU + 2 * RAWW * 4;
constexpr int C2_AUP = C2_WUP + 64 * 72 * 2;
constexpr int C2_CST = C2_AUP + 64 * 72 * 2;
constexpr int C2_AWD = C2_CST + 5 * 64 * 4;
constexpr int C2_AAD = C2_AWD + TB * 72 * 2;
constexpr int C2_X = C2_AAD + TB * 72 * 2;
constexpr int C2_R = C2_X, C2_KR = C2_R + TB * 64 * 4, C2_V = C2_KR + TB * 64 * 4, C2_E = C2_V + TB * 64 * 4, C2_LA = C2_E + TB * 64 * 4, C2_CUM = C2_LA + TB * 64 * 4, C2_X_END = C2_CUM + TB * 64 * 4;
constexpr int C2_YO = C2_X;
constexpr int C2_G = C2_YO + TB * 64 * 4;
constexpr int C2_UB = C2_G + 64 * 36 * 4;
constexpr int C2_ABT = C2_UB + 64 * 40 * 2;
constexpr int C2_AKT = C2_ABT + 32 * 32 * 4;
constexpr int C2_NBT = C2_AKT + 32 * 40 * 2;
constexpr int C2_NKT = C2_NBT + 32 * 40 * 2;
static_assert(C2_NKT + 32 * 40 * 2 <= C2_X_END, "region X reuse");
constexpr int C2_KKS = C2_X_END;
constexpr int C2_BS = C2_KKS + TB * 72 * 2, C2_KDS = C2_BS + TB * 72 * 2, C2_RS = C2_KDS + TB * 72 * 2;
constexpr int C2_BST = C2_RS + TB * 72 * 2;
constexpr int C2_KDST = C2_BST + 64 * 40 * 2;
constexpr int C2_VT = C2_KDST + 64 * 40 * 2;
constexpr int C2_S0B = C2_VT + 64 * 40 * 2;
constexpr int C2_GC = C2_S0B + 64 * 72 * 2;
constexpr int C2_BON = C2_GC + 64 * 4;
constexpr int C2_END = C2_BON + TB * 4;
static_assert(C2_END <= LDS_BYTES - 16 && (C2_X % 16) == 0 && (C2_KKS % 16) == 0 && (C2_G % 16) == 0 && (C2_UB % 16) == 0 && (C2_ABT % 16) == 0 && (C2_AKT % 16) == 0 && (C2_S0B % 16) == 0, "rwkv2 LDS");

__device__ __forceinline__ bf16x8 ldsb8(const LAS bf16_t* p) { return *(const LAS bf16x8*)p; }

template <int MODE>
__device__ __forceinline__ void rwkv_chain2(LAS unsigned char* lds, const In& in, const RwkvP p, int chain) {
    const int tid = threadIdx.x, lane = tid & 63, wid = tid >> 6, fr = lane & 15, fq = lane >> 4;
    const int d = chain / (p.nb * NH), bl = (chain / NH) % p.nb, h = chain % NH;
    const int nlat = p.nb * SEQ;
    LAS bf16_t* RAW = (LAS bf16_t*)(lds + C2_RAW); LAS float* MU = (LAS float*)(lds + C2_MU);
    LAS bf16_t* WUP = (LAS bf16_t*)(lds + C2_WUP); LAS bf16_t* AUP = (LAS bf16_t*)(lds + C2_AUP); LAS float* CST = (LAS float*)(lds + C2_CST);
    LAS bf16_t* AWD = (LAS bf16_t*)(lds + C2_AWD); LAS bf16_t* AAD = (LAS bf16_t*)(lds + C2_AAD);
    LAS float *Rr = (LAS float*)(lds + C2_R), *KR = (LAS float*)(lds + C2_KR), *Vv = (LAS float*)(lds + C2_V), *Ee = (LAS float*)(lds + C2_E), *LA_ = (LAS float*)(lds + C2_LA), *CUM = (LAS float*)(lds + C2_CUM);
    LAS float *YO = (LAS float*)(lds + C2_YO), *Gm = (LAS float*)(lds + C2_G), *ABT = (LAS float*)(lds + C2_ABT), *GC = (LAS float*)(lds + C2_GC), *BON = (LAS float*)(lds + C2_BON);
    LAS bf16_t *UB = (LAS bf16_t*)(lds + C2_UB), *AKT = (LAS bf16_t*)(lds + C2_AKT), *NBT = (LAS bf16_t*)(lds + C2_NBT), *NKT = (LAS bf16_t*)(lds + C2_NKT);
    LAS bf16_t *KKS = (LAS bf16_t*)(lds + C2_KKS), *BS = (LAS bf16_t*)(lds + C2_BS), *KDS = (LAS bf16_t*)(lds + C2_KDS), *RS = (LAS bf16_t*)(lds + C2_RS);
    LAS bf16_t *BST = (LAS bf16_t*)(lds + C2_BST), *KDST = (LAS bf16_t*)(lds + C2_KDST), *VT = (LAS bf16_t*)(lds + C2_VT), *S0B = (LAS bf16_t*)(lds + C2_S0B);
    auto segcol = [&](int s) { return s < 3 ? s * RW + h * 64 : (s == 3 ? OFF_WD + d * DL : OFF_AD + d * AL); };
    for (int i = tid; i < 2 * RAWW; i += NT) { const int m = i / RAWW, c = i % RAWW; MU[i] = in.shift_mu[m * RC + segcol(c >> 6) + (c & 63)]; }
    for (int i = tid; i < 64 * 64; i += NT) { const int j = i >> 6, c = i & 63;
        WUP[c * 72 + j] = f2bf(in.rw_w_up[((size_t)d * DL + j) * RW + h * 64 + c]); AUP[c * 72 + j] = f2bf(in.rw_a_up[((size_t)d * AL + j) * RW + h * 64 + c]); }
    for (int i = tid; i < 64; i += NT) { CST[i] = in.rw_w0[d * RW + h * 64 + i]; CST[64 + i] = in.rw_a0[d * RW + h * 64 + i]; CST[128 + i] = in.rw_k_k[h * 64 + i]; CST[192 + i] = in.rw_k_a[h * 64 + i]; CST[256 + i] = in.rw_r_k[h * 64 + i]; }
    for (int i = tid; i < 64 * 72 / 2; i += NT) ((LAS unsigned*)S0B)[i] = 0u;
    constexpr int NQ = (CTX + SEQ) / TB, NQC = CTX / TB;
    auto blk_info = [&](int q, bool& isctx, int& t0, bool& hp, bool& hn, size_t& grow0) {
        isctx = q < NQC;
        if (isctx) { const int qq = d == 0 ? q : NQC - 1 - q; t0 = qq * TB; hp = t0 > 0; hn = t0 + TB < CTX; grow0 = (size_t)nlat + (size_t)bl * CTX + t0; }
        else { const int ql = q - NQC, qq = d == 0 ? ql : SEQ / TB - 1 - ql; t0 = qq * TB; hp = (t0 % GW) != 0; hn = ((t0 + TB) % GW) != 0; grow0 = (size_t)bl * SEQ + t0; }
    };
    u32x4 pre[RW_PPT]; int poff[RW_PPT], plds[RW_PPT], pkind[RW_PPT];
#pragma unroll
    for (int k = 0; k < RW_PPT; ++k) { const int i = tid + k * NT, rr = i / 40, sp = i % 40, seg = sp >> 3, part = sp & 7;
        poff[k] = (rr - 1) * Z1_N + segcol(seg) + part * 8; plds[k] = rr * RAWW + sp * 8; pkind[k] = i >= RW_NPIECE ? 3 : (rr == 0 ? 1 : (rr == TB + 1 ? 2 : 0)); }
    auto prefetch = [&](int q) {
        bool isctx, hp, hn; int t0; size_t grow0; blk_info(q, isctx, t0, hp, hn, grow0);
        const bf16_t* base = p.z1 + grow0 * Z1_N;
#pragma unroll
        for (int k = 0; k < RW_PPT; ++k) { u32x4 v = (u32x4){0u, 0u, 0u, 0u};
            const bool ok = pkind[k] == 0 || (pkind[k] == 1 && hp) || (pkind[k] == 2 && hn);
            if (ok) v = *(const u32x4*)(base + poff[k]);
            pre[k] = v; }
    };
    auto commit = [&]() {
#pragma unroll
        for (int k = 0; k < RW_PPT; ++k) if (pkind[k] != 3) *(LAS u32x4*)(RAW + plds[k]) = pre[k];
    };
    f32x4 Sreg[2];
    Sreg[0] = (f32x4){0.f, 0.f, 0.f, 0.f}; Sreg[1] = Sreg[0];
    const int rt = wid >> 1;
    prefetch(0);
    for (int q = 0; q < NQ; ++q) {
        bool isctx, hp, hn; int t0; size_t grow0; blk_info(q, isctx, t0, hp, hn, grow0);
        commit();
        __syncthreads();
        if (q + 1 < NQ) prefetch(q + 1);
        auto shift8 = [&](int t, int c0, float (&s)[8]) {
            const u32x4 xp = *(const LAS u32x4*)(RAW + t * RAWW + c0), xc = *(const LAS u32x4*)(RAW + (t + 1) * RAWW + c0), xn_ = *(const LAS u32x4*)(RAW + (t + 2) * RAWW + c0);
            const f32x4 m0a = *(const LAS f32x4*)(MU + c0), m0b = *(const LAS f32x4*)(MU + c0 + 4), m1a = *(const LAS f32x4*)(MU + RAWW + c0), m1b = *(const LAS f32x4*)(MU + RAWW + c0 + 4);
#pragma unroll
            for (int j = 0; j < 4; ++j) { const unsigned a = xp[j], b = xc[j], c = xn_[j];
                const float mu0l = j < 2 ? m0a[2 * j] : m0b[2 * j - 4], mu0h = j < 2 ? m0a[2 * j + 1] : m0b[2 * j - 3], mu1l = j < 2 ? m1a[2 * j] : m1b[2 * j - 4], mu1h = j < 2 ? m1a[2 * j + 1] : m1b[2 * j - 3];
                { const float x = bflo(b); s[2 * j] = x + mu0l * (bflo(a) - x) + mu1l * (bflo(c) - x); }
                { const float x = bfhi(b); s[2 * j + 1] = x + mu0h * (bfhi(a) - x) + mu1h * (bfhi(c) - x); } } };
        for (int it = tid; it < TB * 24; it += NT) {
            const int t = it / 24, g = it % 24, seg = g >> 3, cc = (g & 7) * 8, js = d == 0 ? t : TB - 1 - t; float s[8]; shift8(t, g * 8, s);
            LAS float* dst = (seg == 0 ? Rr : (seg == 1 ? KR : Vv)) + js * 64 + cc; *(LAS f32x4*)dst = (f32x4){s[0], s[1], s[2], s[3]}; *(LAS f32x4*)(dst + 4) = (f32x4){s[4], s[5], s[6], s[7]};
        }
        { const int t = tid >> 4, g = 24 + (tid & 15), cc = (g & 7) * 8, js = d == 0 ? t : TB - 1 - t; float s[8]; shift8(t, g * 8, s);
          const bool isw = (tid & 15) < 8;
#pragma unroll
          for (int j = 0; j < 8; ++j) { const float th = fast_tanh(s[j]); s[j] = isw ? th : s[j]; }
          LAS bf16_t* dst = (isw ? AWD : AAD) + js * 72 + cc;
          u32x4 w; w.x = cvt_pk_bf16(s[0], s[1]); w.y = cvt_pk_bf16(s[2], s[3]); w.z = cvt_pk_bf16(s[4], s[5]); w.w = cvt_pk_bf16(s[6], s[7]); *(LAS u32x4*)dst = w; }
        __syncthreads();
        if (MODE == 3) continue;
        {
            const int lora = wid >> 2, ct = wid & 3;
            const LAS bf16_t* Am = lora ? AAD : AWD; const LAS bf16_t* Bm = lora ? AUP : WUP;
            float carry = 0.f;
#pragma unroll
            for (int r2 = 0; r2 < 2; ++r2) {
                f32x4 acc = (f32x4){0.f, 0.f, 0.f, 0.f};
#pragma unroll
                for (int ks = 0; ks < 2; ++ks) acc = __builtin_amdgcn_mfma_f32_16x16x32_bf16(ldsb8(Am + (r2 * 16 + fr) * 72 + ks * 32 + fq * 8), ldsb8(Bm + (ct * 16 + fr) * 72 + ks * 32 + fq * 8), acc, 0, 0, 0);
                const int col = ct * 16 + fr;
                if (lora == 0) {
                    float c[4];
#pragma unroll
                    for (int i = 0; i < 4; ++i) { const float lw = acc[i] + CST[col]; const float e = __expf(-fast_softplus(-lw) - 0.5f); c[i] = i ? c[i - 1] + e : e; }
                    const float tot = c[3];
                    float s1 = tot; { const float y = __shfl_up(s1, 16); s1 += fq >= 1 ? y : 0.f; }
                    float s2 = s1;  { const float z = __shfl_up(s1, 32); s2 += fq >= 2 ? z : 0.f; }
                    const float base = carry + s2 - tot;
#pragma unroll
                    for (int i = 0; i < 4; ++i) CUM[(r2 * 16 + fq * 4 + i) * 64 + col] = base + c[i];
                    carry += __shfl(s2, 48 + fr);
                } else {
#pragma unroll
                    for (int i = 0; i < 4; ++i) LA_[(r2 * 16 + fq * 4 + i) * 64 + col] = fast_sigmoid(acc[i] + CST[64 + col]);
                }
            }
        }
        __syncthreads();
        if (MODE == 2) continue;
        {
            const int j = tid >> 4, c4 = (tid & 15) * 4;
            const f32x4 k = *(const LAS f32x4*)(KR + j * 64 + c4), a = *(const LAS f32x4*)(LA_ + j * 64 + c4), r = *(const LAS f32x4*)(Rr + j * 64 + c4), vv = *(const LAS f32x4*)(Vv + j * 64 + c4);
            const f32x4 cu = *(const LAS f32x4*)(CUM + j * 64 + c4); f32x4 cp = (f32x4){0.f, 0.f, 0.f, 0.f}; if (j > 0) cp = *(const LAS f32x4*)(CUM + (j - 1) * 64 + c4);
            float kkr[4], ss = 0.f, bn = 0.f;
#pragma unroll
            for (int x = 0; x < 4; ++x) { kkr[x] = k[x] * CST[128 + c4 + x]; ss += kkr[x] * kkr[x]; }
            ss = allreduce16(ss);
            const float inv = 1.f / fmaxf(sqrtf(ss), 1e-12f);
            float kks[4], bs[4], kds[4], rs[4];
#pragma unroll
            for (int x = 0; x < 4; ++x) { const float kk = kkr[x] * inv, kd = k[x] * (1.f + (a[x] - 1.f) * CST[192 + c4 + x]), bb = kk * a[x];
                const float g = __expf(-cu[x]), gp = __expf(-cp[x]), ig = __expf(cu[x]);
                kks[x] = kk * gp; bs[x] = bb * ig; kds[x] = kd * ig; rs[x] = r[x] * g; bn += r[x] * kd * CST[256 + c4 + x];
                if (j == TB - 1) GC[c4 + x] = g;
            }
#pragma unroll
            for (int x = 0; x < 4; x += 2) { const unsigned pb = cvt_pk_bf16(bs[x], bs[x + 1]), pk = cvt_pk_bf16(kds[x], kds[x + 1]), pv = cvt_pk_bf16(vv[x], vv[x + 1]);
                BST[(c4 + x) * 40 + j] = (bf16_t)pb; BST[(c4 + x + 1) * 40 + j] = (bf16_t)(pb >> 16); KDST[(c4 + x) * 40 + j] = (bf16_t)pk; KDST[(c4 + x + 1) * 40 + j] = (bf16_t)(pk >> 16);
                VT[(c4 + x) * 40 + j] = (bf16_t)pv; VT[(c4 + x + 1) * 40 + j] = (bf16_t)(pv >> 16); }
            bn = allreduce16(bn);
            u32x2 w; w.x = cvt_pk_bf16(kks[0], kks[1]); w.y = cvt_pk_bf16(kks[2], kks[3]); *(LAS u32x2*)(KKS + j * 72 + c4) = w;
            w.x = cvt_pk_bf16(bs[0], bs[1]); w.y = cvt_pk_bf16(bs[2], bs[3]); *(LAS u32x2*)(BS + j * 72 + c4) = w;
            w.x = cvt_pk_bf16(kds[0], kds[1]); w.y = cvt_pk_bf16(kds[2], kds[3]); *(LAS u32x2*)(KDS + j * 72 + c4) = w;
            w.x = cvt_pk_bf16(rs[0], rs[1]); w.y = cvt_pk_bf16(rs[2], rs[3]); *(LAS u32x2*)(RS + j * 72 + c4) = w;
            if ((tid & 15) == 0) BON[j] = bn;
        }
        __syncthreads();
        if (MODE == 1) continue;
        const int ctg = wid & 1;
        f32x4 accG = (f32x4){0.f, 0.f, 0.f, 0.f}, accY = accG;
        {
            const int pr = wid >> 1, rts = wid & 1;
            const LAS bf16_t* Xm = (pr & 1) ? KDS : BS; const LAS bf16_t* Ym = (pr < 2) ? KKS : RS;
            const bf16x8 a0 = ldsb8(Xm + (rts * 16 + fr) * 72 + fq * 8), a1 = ldsb8(Xm + (rts * 16 + fr) * 72 + 32 + fq * 8);
#pragma unroll
            for (int cts = 0; cts < 2; ++cts) {
                f32x4 acc = (f32x4){0.f, 0.f, 0.f, 0.f};
                acc = __builtin_amdgcn_mfma_f32_16x16x32_bf16(a0, ldsb8(Ym + (cts * 16 + fr) * 72 + fq * 8), acc, 0, 0, 0);
                acc = __builtin_amdgcn_mfma_f32_16x16x32_bf16(a1, ldsb8(Ym + (cts * 16 + fr) * 72 + 32 + fq * 8), acc, 0, 0, 0);
                const int t = cts * 16 + fr, s0 = rts * 16 + fq * 4;
#pragma unroll
                for (int i = 0; i < 4; ++i) { const bool keep = (pr < 2) ? (s0 + i < t) : (s0 + i <= t); acc[i] = keep ? acc[i] : 0.f; }
                if (pr == 0) *(LAS f32x4*)(ABT + t * 32 + s0) = acc;
                else { u32x2 w; w.x = cvt_pk_bf16(acc[0], acc[1]); w.y = cvt_pk_bf16(acc[2], acc[3]); *(LAS u32x2*)((pr == 1 ? AKT : (pr == 2 ? NBT : NKT)) + t * 40 + s0) = w; }
            }
#pragma unroll
            for (int ks = 0; ks < 2; ++ks) { const bf16x8 sa = ldsb8(S0B + (rt * 16 + fr) * 72 + ks * 32 + fq * 8);
                accG = __builtin_amdgcn_mfma_f32_16x16x32_bf16(sa, ldsb8(KKS + (ctg * 16 + fr) * 72 + ks * 32 + fq * 8), accG, 0, 0, 0);
                accY = __builtin_amdgcn_mfma_f32_16x16x32_bf16(sa, ldsb8(RS + (ctg * 16 + fr) * 72 + ks * 32 + fq * 8), accY, 0, 0, 0); }
        }
        __syncthreads();
        {
            const bf16x8 va = ldsb8(VT + (rt * 16 + fr) * 40 + fq * 8);
            accG = __builtin_amdgcn_mfma_f32_16x16x32_bf16(va, ldsb8(AKT + (ctg * 16 + fr) * 40 + fq * 8), accG, 0, 0, 0);
            accY = __builtin_amdgcn_mfma_f32_16x16x32_bf16(va, ldsb8(NKT + (ctg * 16 + fr) * 40 + fq * 8), accY, 0, 0, 0);
#pragma unroll
            for (int i = 0; i < 4; ++i) Gm[(rt * 16 + fq * 4 + i) * 36 + ctg * 16 + fr] = -accG[i];
        }
        __syncthreads();
        if (MODE == 4) continue;
        if (wid < 4) {
            const int v = wid * 16 + (lane >> 2), pq = lane & 3;
            const LAS float* grow = Gm + v * 36;
            f32x4 r0 = *(const LAS f32x4*)(grow + 4 * pq), r1 = *(const LAS f32x4*)(grow + 16 + 4 * pq);
            u32x2 ubo[TB / 4];
            const LAS float* abd = ABT; asm volatile("" : "+v"(abd));
            const LAS float* abq = ABT + 128 * pq; asm volatile("" : "+v"(abq));
            f32x4 dc[3], a0c[4], a1c[4];
            auto ldg = [&](int g, f32x4 (&dd)[3], f32x4 (&aa0)[4], f32x4 (&aa1)[4]) {
#pragma unroll
                for (int x = 0; x < 3; ++x) dd[x] = *(const LAS f32x4*)(abd + (4 * g + 1 + x) * 32 + 4 * g);
#pragma unroll
                for (int jj = 0; jj < 4; ++jj) { if (g < 3) aa0[jj] = *(const LAS f32x4*)(abq + jj * 32 + 4 * g); if (g < 7) aa1[jj] = *(const LAS f32x4*)(abq + (16 + jj) * 32 + 4 * g); } };
            ldg(0, dc, a0c, a1c);
#pragma unroll
            for (int g = 0; g < TB / 4; ++g) {
                f32x4 dn[3], a0n[4], a1n[4];
                if (g + 1 < TB / 4) ldg(g + 1, dn, a0n, a1n);
                __builtin_amdgcn_sched_barrier(0);
                const f32x4 rr = g < 4 ? r0 : r1;
                f32x4 u4;
                u4[0] = rr[0];
                u4[1] = rr[1] - u4[0] * dc[0][0];
                u4[2] = rr[2] - (u4[0] * dc[1][0] + u4[1] * dc[1][1]);
                u4[3] = rr[3] - (u4[0] * dc[2][0] + u4[1] * dc[2][1] + u4[2] * dc[2][2]);
#pragma unroll
                for (int x = 0; x < 4; ++x) { const int ui = __float_as_int(u4[x]); int bi;
                    if ((g & 3) == 0) bi = __builtin_amdgcn_update_dpp(0, ui, 0x00, 0xF, 0xF, true); else if ((g & 3) == 1) bi = __builtin_amdgcn_update_dpp(0, ui, 0x55, 0xF, 0xF, true);
                    else if ((g & 3) == 2) bi = __builtin_amdgcn_update_dpp(0, ui, 0xAA, 0xF, 0xF, true); else bi = __builtin_amdgcn_update_dpp(0, ui, 0xFF, 0xF, 0xF, true);
                    u4[x] = __int_as_float(bi); }
                ubo[g].x = cvt_pk_bf16(u4[0], u4[1]); ubo[g].y = cvt_pk_bf16(u4[2], u4[3]);
                if (g < 3) {
#pragma unroll
                    for (int jj = 0; jj < 4; ++jj) r0[jj] -= u4[0] * a0c[jj][0] + u4[1] * a0c[jj][1] + u4[2] * a0c[jj][2] + u4[3] * a0c[jj][3]; }
                if (g < 7) {
#pragma unroll
                    for (int jj = 0; jj < 4; ++jj) r1[jj] -= u4[0] * a1c[jj][0] + u4[1] * a1c[jj][1] + u4[2] * a1c[jj][2] + u4[3] * a1c[jj][3]; }
                if (g + 1 < TB / 4) {
#pragma unroll
                    for (int x = 0; x < 3; ++x) dc[x] = dn[x];
#pragma unroll
                    for (int jj = 0; jj < 4; ++jj) { a0c[jj] = a0n[jj]; a1c[jj] = a1n[jj]; } }
            }
            if (pq == 0) {
#pragma unroll
                for (int g = 0; g < TB / 4; g += 2) { u32x4 w; w.x = ubo[g].x; w.y = ubo[g].y; w.z = ubo[g + 1].x; w.w = ubo[g + 1].y; *(LAS u32x4*)(UB + v * 40 + 4 * g) = w; } }
        }
        __syncthreads();
        if (MODE == 5) continue;
        {
            const bf16x8 ua = ldsb8(UB + (rt * 16 + fr) * 40 + fq * 8), va = ldsb8(VT + (rt * 16 + fr) * 40 + fq * 8);
            accY = __builtin_amdgcn_mfma_f32_16x16x32_bf16(ua, ldsb8(NBT + (ctg * 16 + fr) * 40 + fq * 8), accY, 0, 0, 0);
            *(LAS f32x4*)(YO + (ctg * 16 + fr) * 64 + rt * 16 + fq * 4) = accY;
#pragma unroll
            for (int cc = 0; cc < 2; ++cc) { const int ct = 2 * (wid & 1) + cc, kcol = ct * 16 + fr;
                f32x4 acc = Sreg[cc];
                acc = __builtin_amdgcn_mfma_f32_16x16x32_bf16(ua, ldsb8(BST + kcol * 40 + fq * 8), acc, 0, 0, 0);
                acc = __builtin_amdgcn_mfma_f32_16x16x32_bf16(va, ldsb8(KDST + kcol * 40 + fq * 8), acc, 0, 0, 0);
                const float g = GC[kcol];
#pragma unroll
                for (int i = 0; i < 4; ++i) acc[i] *= g;
                { const unsigned p0 = cvt_pk_bf16(acc[0], acc[1]), p1 = cvt_pk_bf16(acc[2], acc[3]); LAS bf16_t* sp = S0B + (rt * 16 + fq * 4) * 72 + kcol;
                  sp[0] = (bf16_t)p0; sp[72] = (bf16_t)(p0 >> 16); sp[144] = (bf16_t)p1; sp[216] = (bf16_t)(p1 >> 16); }
                Sreg[cc] = acc; }
        }
        __syncthreads();
        if (!isctx) {
            const int j = tid >> 4, c4 = (tid & 15) * 4, t = d == 0 ? j : TB - 1 - j; const f32x4 y = *(const LAS f32x4*)(YO + j * 64 + c4);
            u32x2 w; w.x = cvt_pk_bf16(y[0], y[1]); w.y = cvt_pk_bf16(y[2], y[3]);
            bf16_t* yb_ = p.Y + ((size_t)d * nlat + grow0) * RW + h * 64;
            *(u32x2*)(yb_ + t * RW + c4) = w;
            if (tid < TB) { const int tt = d == 0 ? tid : TB - 1 - tid; float* bb_ = p.bon + ((size_t)d * nlat + grow0) * NH + h; bb_[tt * NH] = BON[tid]; }
        }
    }
}
template <int MODE = 0>
__device__ __forceinline__ void rwkv_phase2(LAS unsigned char* lds, const In& in, const RwkvP p, int bid, int nblk) {
    const int nchain = 2 * p.nb * NH;
    for (int c = bid; c < nchain; c += nblk) { rwkv_chain2<MODE>(lds, in, p, c); __syncthreads(); }
}
}

namespace mk {
namespace r3 {
constexpr int C2_RAW = 0;
constexpr int C2_MU = C2_RAW + (TB + 2) * RAWW * 2;
constexpr int C2_WUP = C2_MU + 3 * RAWW * 4;
constexpr int C2_AUP = C2_WUP + 64 * 72 * 2;
constexpr int C2_CST = C2_AUP + 64 * 72 * 2;
constexpr int C2_AWD = C2_CST + 5 * 64 * 4;
constexpr int C2_AAD = C2_AWD + TB * 72 * 2;
constexpr int C2_X = C2_AAD + TB * 72 * 2;
constexpr int C2_G = C2_X;
constexpr int C2_UB = C2_G + 64 * 36 * 4;
constexpr int C2_ABT = C2_UB + 64 * 40 * 2;
constexpr int C2_AKT = C2_ABT + 32 * 32 * 4;
constexpr int C2_NBT = C2_AKT + 32 * 40 * 2;
constexpr int C2_NKT = C2_NBT + 32 * 40 * 2;
constexpr int C2_YO = C2_NKT + 32 * 40 * 2;
constexpr int C2_X_END = C2_YO + TB * 64 * 4;
constexpr int C2_KKS = C2_X_END;
constexpr int C2_BS = C2_KKS + TB * 72 * 2, C2_KDS = C2_BS + TB * 72 * 2, C2_RS = C2_KDS + TB * 72 * 2;
constexpr int C2_BST = C2_RS + TB * 72 * 2;
constexpr int C2_KDST = C2_BST + 64 * 40 * 2;
constexpr int C2_VT = C2_KDST + 64 * 40 * 2;
constexpr int C2_S0B = C2_VT + 64 * 40 * 2;
constexpr int C2_GC = C2_S0B + 64 * 72 * 2;
constexpr int C2_BON = C2_GC + 64 * 4;
constexpr int C2_RB = C2_BON + TB * 4;
constexpr int C2_KRB = C2_RB + TB * 64 * 2, C2_VB = C2_KRB + TB * 64 * 2;
constexpr int C2_LA = C2_VB + TB * 64 * 2;
constexpr int C2_CUM = C2_LA + TB * 64 * 4;
constexpr int C2_BON2 = C2_CUM + (TB + 1) * 64 * 4;
constexpr int C2_END = C2_BON2 + TB * 4;
static_assert(C2_END <= LDS_BYTES - 16 && (C2_X % 16) == 0 && (C2_KKS % 16) == 0 && (C2_G % 16) == 0 && (C2_UB % 16) == 0 && (C2_ABT % 16) == 0 && (C2_AKT % 16) == 0 && (C2_S0B % 16) == 0, "rwkv2 LDS");

__device__ __forceinline__ bf16x8 ldsb8(const LAS bf16_t* p) { return *(const LAS bf16x8*)p; }

template <int MODE>
__device__ __forceinline__ void rwkv_chain3(LAS unsigned char* lds, const In& in, const RwkvP p, int chain) {
    const int tid = threadIdx.x, lane = tid & 63, wid = tid >> 6, fr = lane & 15, fq = lane >> 4;
    const int d = chain / (p.nb * NH), bl = (chain / NH) % p.nb, h = chain % NH;
    const int nlat = p.nb * SEQ;
    LAS bf16_t* RAW = (LAS bf16_t*)(lds + C2_RAW); LAS float* MU = (LAS float*)(lds + C2_MU);
    LAS bf16_t* WUP = (LAS bf16_t*)(lds + C2_WUP); LAS bf16_t* AUP = (LAS bf16_t*)(lds + C2_AUP); LAS float* CST = (LAS float*)(lds + C2_CST);
    LAS bf16_t* AWD = (LAS bf16_t*)(lds + C2_AWD); LAS bf16_t* AAD = (LAS bf16_t*)(lds + C2_AAD);
    LAS bf16_t *Rb = (LAS bf16_t*)(lds + C2_RB), *KRb = (LAS bf16_t*)(lds + C2_KRB), *Vb = (LAS bf16_t*)(lds + C2_VB); LAS float *LA_ = (LAS float*)(lds + C2_LA), *CUM = (LAS float*)(lds + C2_CUM);
    LAS float *YO = (LAS float*)(lds + C2_YO), *Gm = (LAS float*)(lds + C2_G), *ABT = (LAS float*)(lds + C2_ABT), *GC = (LAS float*)(lds + C2_GC), *BON = (LAS float*)(lds + C2_BON);
    LAS bf16_t *UB = (LAS bf16_t*)(lds + C2_UB), *AKT = (LAS bf16_t*)(lds + C2_AKT), *NBT = (LAS bf16_t*)(lds + C2_NBT), *NKT = (LAS bf16_t*)(lds + C2_NKT);
    LAS bf16_t *KKS = (LAS bf16_t*)(lds + C2_KKS), *BS = (LAS bf16_t*)(lds + C2_BS), *KDS = (LAS bf16_t*)(lds + C2_KDS), *RS = (LAS bf16_t*)(lds + C2_RS);
    LAS bf16_t *BST = (LAS bf16_t*)(lds + C2_BST), *KDST = (LAS bf16_t*)(lds + C2_KDST), *VT = (LAS bf16_t*)(lds + C2_VT), *S0B = (LAS bf16_t*)(lds + C2_S0B);
    auto segcol = [&](int s) __attribute__((always_inline)) { return s < 3 ? s * RW + h * 64 : (s == 3 ? OFF_WD + d * DL : OFF_AD + d * AL); };
    for (int i = tid; i < RAWW; i += NT) { const float m0 = in.shift_mu[segcol(i >> 6) + (i & 63)], m1 = in.shift_mu[RC + segcol(i >> 6) + (i & 63)]; MU[i] = m0; MU[RAWW + i] = m1; MU[2 * RAWW + i] = 1.f - m0 - m1; }
    for (int i = tid; i < 64 * 64; i += NT) { const int j = i >> 6, c = i & 63;
        WUP[c * 72 + j] = f2bf(in.rw_w_up[((size_t)d * DL + j) * RW + h * 64 + c]); AUP[c * 72 + j] = f2bf(in.rw_a_up[((size_t)d * AL + j) * RW + h * 64 + c]); }
    for (int i = tid; i < 64; i += NT) { CST[i] = in.rw_w0[d * RW + h * 64 + i]; CST[64 + i] = in.rw_a0[d * RW + h * 64 + i]; CST[128 + i] = in.rw_k_k[h * 64 + i]; CST[192 + i] = in.rw_k_a[h * 64 + i]; CST[256 + i] = in.rw_r_k[h * 64 + i]; }
    for (int i = tid; i < 64 * 72 / 2; i += NT) ((LAS unsigned*)S0B)[i] = 0u;
    constexpr int NQ = (CTX + SEQ) / TB, NQC = CTX / TB;
    auto blk_info = [&](int q, bool& isctx, int& t0, bool& hp, bool& hn, size_t& grow0) __attribute__((always_inline)) {
        isctx = q < NQC;
        if (isctx) { const int qq = d == 0 ? q : NQC - 1 - q; t0 = qq * TB; hp = t0 > 0; hn = t0 + TB < CTX; grow0 = (size_t)nlat + (size_t)bl * CTX + t0; }
        else { const int ql = q - NQC, qq = d == 0 ? ql : SEQ / TB - 1 - ql; t0 = qq * TB; hp = (t0 % GW) != 0; hn = ((t0 + TB) % GW) != 0; grow0 = (size_t)bl * SEQ + t0; }
    };
    u32x4 pre[RW_PPT]; int poff[RW_PPT], plds[RW_PPT];
#pragma unroll
    for (int k = 0; k < RW_PPT; ++k) { const int i = tid + k * NT, rr = i / 40, sp = i % 40, seg = sp >> 3, part = sp & 7;
        poff[k] = (rr - 1) * Z1_N + segcol(seg) + part * 8; plds[k] = (rr * RAWW + sp * 8) | (i >= RW_NPIECE ? 3 : (rr == 0 ? 1 : (rr == TB + 1 ? 2 : 0))); }
    auto prefetch = [&](int q) __attribute__((always_inline)) {
        bool isctx, hp, hn; int t0; size_t grow0; blk_info(q, isctx, t0, hp, hn, grow0);
        const bf16_t* base = p.z1 + grow0 * Z1_N;
#pragma unroll
        for (int k = 0; k < RW_PPT; ++k) { u32x4 v = (u32x4){0u, 0u, 0u, 0u};
            const int kind = plds[k] & 3; const bool ok = kind == 0 || (kind == 1 && hp) || (kind == 2 && hn);
            if (ok) v = *(const u32x4*)(base + poff[k]);
            pre[k] = v; }
    };
    auto commit = [&]() __attribute__((always_inline)) {
#pragma unroll
        for (int k = 0; k < RW_PPT; ++k) if ((plds[k] & 3) != 3) *(LAS u32x4*)(RAW + (plds[k] & ~3)) = pre[k];
    };
    f32x4 Sreg[2];
    Sreg[0] = (f32x4){0.f, 0.f, 0.f, 0.f}; Sreg[1] = Sreg[0];
    const int rt = wid >> 1;
    auto shift8 = [&](int t, int c0, f32x2 (&s)[4]) __attribute__((always_inline)) {
        const u32x4 xp = *(const LAS u32x4*)(RAW + t * RAWW + c0), xc = *(const LAS u32x4*)(RAW + (t + 1) * RAWW + c0), xn_ = *(const LAS u32x4*)(RAW + (t + 2) * RAWW + c0);
        const f32x4 m0a = *(const LAS f32x4*)(MU + c0), m0b = *(const LAS f32x4*)(MU + c0 + 4), m1a = *(const LAS f32x4*)(MU + RAWW + c0), m1b = *(const LAS f32x4*)(MU + RAWW + c0 + 4),
                    mca = *(const LAS f32x4*)(MU + 2 * RAWW + c0), mcb = *(const LAS f32x4*)(MU + 2 * RAWW + c0 + 4);
#define MK_SH2(J, XP, XC, XN, MC2, M02, M12) { f32x2 C, P, N; C.x = bflo(XC); C.y = bfhi(XC); P.x = bflo(XP); P.y = bfhi(XP); N.x = bflo(XN); N.y = bfhi(XN); f32x2 r_ = MC2 * C; r_ = M02 * P + r_; r_ = M12 * N + r_; s[J] = r_; }
        MK_SH2(0, xp.x, xc.x, xn_.x, mca.lo, m0a.lo, m1a.lo) MK_SH2(1, xp.y, xc.y, xn_.y, mca.hi, m0a.hi, m1a.hi)
        MK_SH2(2, xp.z, xc.z, xn_.z, mcb.lo, m0b.lo, m1b.lo) MK_SH2(3, xp.w, xc.w, xn_.w, mcb.hi, m0b.hi, m1b.hi)
#undef MK_SH2
    };
    auto pack4 = [&](const f32x2 (&s)[4]) __attribute__((always_inline)) { u32x4 w; w.x = cvt_pk_bf16(s[0].x, s[0].y); w.y = cvt_pk_bf16(s[1].x, s[1].y); w.z = cvt_pk_bf16(s[2].x, s[2].y); w.w = cvt_pk_bf16(s[3].x, s[3].y); return w; };
    int sh_t[3], sh_c[3], sh_d[3];
#pragma unroll
    for (int k = 0; k < 3; ++k) { const int it = (tid & (NT / 2 - 1)) + k * (NT / 2), t = it / 24, g = it % 24, seg = g >> 3, cc = (g & 7) * 8, js = d == 0 ? t : TB - 1 - t;
        sh_t[k] = t; sh_c[k] = g * 8; sh_d[k] = seg * (TB * 64) + js * 64 + cc; }
    auto do_shift = [&](int tl, int nth) __attribute__((always_inline)) {
#pragma unroll
        for (int k = 0; k < 3; ++k) { f32x2 s[4]; shift8(sh_t[k], sh_c[k], s); *(LAS u32x4*)(Rb + sh_d[k]) = pack4(s); }
#pragma unroll 1
        for (int it = tl; it < TB * 8; it += nth) { const int t = it >> 3, part = it & 7, js = d == 0 ? t : TB - 1 - t;
            { f32x2 s[4]; shift8(t, (24 + part) * 8, s);
#pragma unroll
              for (int j = 0; j < 4; ++j) { s[j].x = 1.f - 2.f * fast_rcp(1.f + __builtin_amdgcn_exp2f(2.885390081777927f * s[j].x)); s[j].y = 1.f - 2.f * fast_rcp(1.f + __builtin_amdgcn_exp2f(2.885390081777927f * s[j].y)); }
              *(LAS u32x4*)(AWD + js * 72 + part * 8) = pack4(s); }
            { f32x2 s[4]; shift8(t, (32 + part) * 8, s); *(LAS u32x4*)(AAD + js * 72 + part * 8) = pack4(s); }
        }
    };
    auto lora_stage = [&]() __attribute__((always_inline)) {
        {
            const int lora = wid >> 2, ct = wid & 3;
            const LAS bf16_t* Am = lora ? AAD : AWD; const LAS bf16_t* Bm = lora ? AUP : WUP;
            float carry = 0.f;
#pragma unroll
            for (int r2 = 0; r2 < 2; ++r2) {
                f32x4 acc = (f32x4){0.f, 0.f, 0.f, 0.f};
#pragma unroll
                for (int ks = 0; ks < 2; ++ks) acc = __builtin_amdgcn_mfma_f32_16x16x32_bf16(ldsb8(Am + (r2 * 16 + fr) * 72 + ks * 32 + fq * 8), ldsb8(Bm + (ct * 16 + fr) * 72 + ks * 32 + fq * 8), acc, 0, 0, 0);
                const int col = ct * 16 + fr;
                if (lora == 0) {
                    float c[4];
#pragma unroll
                    for (int i = 0; i < 4; ++i) { const float lw = acc[i] + CST[col]; const float e = fast_sigmoid(lw); c[i] = i ? c[i - 1] + e : e;   }
                    const float tot = c[3];
                    float s1 = tot; { const float y = __shfl_up(s1, 16); s1 += fq >= 1 ? y : 0.f; }
                    float s2 = s1;  { const float z = __shfl_up(s1, 32); s2 += fq >= 2 ? z : 0.f; }
                    const float base = carry + s2 - tot;
#pragma unroll
                    for (int i = 0; i < 4; ++i) CUM[(1 + r2 * 16 + fq * 4 + i) * 64 + col] = base + c[i];
                    carry += __shfl(s2, 48 + fr);
                } else {
#pragma unroll
                    for (int i = 0; i < 4; ++i) LA_[(r2 * 16 + fq * 4 + i) * 64 + col] = fast_sigmoid(acc[i] + CST[64 + col]);
                }
            }
        }
    };
    auto scale_stage = [&](LAS float* bonw) __attribute__((always_inline)) {
        {
            const int j = tid >> 4, c4 = (tid & 15) * 4;
            const u32x2 kp = *(const LAS u32x2*)(KRb + j * 64 + c4), rp = *(const LAS u32x2*)(Rb + j * 64 + c4), vp = *(const LAS u32x2*)(Vb + j * 64 + c4);
            const f32x4 k = (f32x4){bflo(kp.x), bfhi(kp.x), bflo(kp.y), bfhi(kp.y)}, r = (f32x4){bflo(rp.x), bfhi(rp.x), bflo(rp.y), bfhi(rp.y)};
            const f32x4 a = *(const LAS f32x4*)(LA_ + j * 64 + c4);
            const f32x4 cu = *(const LAS f32x4*)(CUM + (j + 1) * 64 + c4), cp = *(const LAS f32x4*)(CUM + j * 64 + c4);
            const f32x4 ckk = *(const LAS f32x4*)(CST + 128 + c4), cka = *(const LAS f32x4*)(CST + 192 + c4), crk = *(const LAS f32x4*)(CST + 256 + c4);
            float kkr[4], kd[4], ss = 0.f, bn = 0.f;
#pragma unroll
            for (int x = 0; x < 4; ++x) { kkr[x] = k[x] * ckk[x]; ss += kkr[x] * kkr[x]; kd[x] = k[x] * (1.f + (a[x] - 1.f) * cka[x]); bn += r[x] * kd[x] * crk[x]; }
            asm volatile("s_nop 1\n\t"
                "v_add_f32_dpp %0, %0, %0 quad_perm:[1,0,3,2] row_mask:0xf bank_mask:0xf\n\t" "v_add_f32_dpp %1, %1, %1 quad_perm:[1,0,3,2] row_mask:0xf bank_mask:0xf\n\ts_nop 0\n\t"
                "v_add_f32_dpp %0, %0, %0 quad_perm:[2,3,0,1] row_mask:0xf bank_mask:0xf\n\t" "v_add_f32_dpp %1, %1, %1 quad_perm:[2,3,0,1] row_mask:0xf bank_mask:0xf\n\ts_nop 0\n\t"
                "v_add_f32_dpp %0, %0, %0 row_half_mirror row_mask:0xf bank_mask:0xf\n\t" "v_add_f32_dpp %1, %1, %1 row_half_mirror row_mask:0xf bank_mask:0xf\n\ts_nop 0\n\t"
                "v_add_f32_dpp %0, %0, %0 row_mirror row_mask:0xf bank_mask:0xf\n\t" "v_add_f32_dpp %1, %1, %1 row_mirror row_mask:0xf bank_mask:0xf"
                : "+v"(ss), "+v"(bn));
            const float inv = __builtin_amdgcn_rsqf(fmaxf(ss, 1e-24f));
            float kks[4], bs[4], kds[4], rs[4]; f32x4 gv;
#pragma unroll
            for (int x = 0; x < 4; ++x) { const float kk = kkr[x] * inv, bb = kk * a[x];
                const float ig = __builtin_amdgcn_exp2f(0.87503877f * cu[x]), g = fast_rcp(ig), gp = __builtin_amdgcn_exp2f(-0.87503877f * cp[x]);
                kks[x] = kk * gp; bs[x] = bb * ig; kds[x] = kd[x] * ig; rs[x] = r[x] * g; gv[x] = g;
            }
            if (j == TB - 1) *(LAS f32x4*)(GC + c4) = gv;
#pragma unroll
            for (int x = 0; x < 4; x += 2) { const unsigned pb = cvt_pk_bf16(bs[x], bs[x + 1]), pk = cvt_pk_bf16(kds[x], kds[x + 1]), pv = x ? vp.y : vp.x;
                BST[(c4 + x) * 40 + j] = (bf16_t)pb; BST[(c4 + x + 1) * 40 + j] = (bf16_t)(pb >> 16); KDST[(c4 + x) * 40 + j] = (bf16_t)pk; KDST[(c4 + x + 1) * 40 + j] = (bf16_t)(pk >> 16);
                VT[(c4 + x) * 40 + j] = (bf16_t)pv; VT[(c4 + x + 1) * 40 + j] = (bf16_t)(pv >> 16); }
            u32x2 w; w.x = cvt_pk_bf16(kks[0], kks[1]); w.y = cvt_pk_bf16(kks[2], kks[3]); *(LAS u32x2*)(KKS + j * 72 + c4) = w;
            w.x = cvt_pk_bf16(bs[0], bs[1]); w.y = cvt_pk_bf16(bs[2], bs[3]); *(LAS u32x2*)(BS + j * 72 + c4) = w;
            w.x = cvt_pk_bf16(kds[0], kds[1]); w.y = cvt_pk_bf16(kds[2], kds[3]); *(LAS u32x2*)(KDS + j * 72 + c4) = w;
            w.x = cvt_pk_bf16(rs[0], rs[1]); w.y = cvt_pk_bf16(rs[2], rs[3]); *(LAS u32x2*)(RS + j * 72 + c4) = w;
            if ((tid & 15) == 0) bonw[j] = bn;
        }
    };
    if (tid < 16) *(LAS f32x4*)(CUM + tid * 4) = (f32x4){0.f, 0.f, 0.f, 0.f};
    prefetch(0);
    commit();
    __syncthreads();
    if (1 < NQ) prefetch(1);
    do_shift(tid & (NT / 2 - 1), NT / 2);
    __syncthreads();
    lora_stage();
    __syncthreads();
    scale_stage(BON);
    __syncthreads();
    for (int q = 0; q < NQ; ++q) {
        bool isctx, hp, hn; int t0; size_t grow0; blk_info(q, isctx, t0, hp, hn, grow0);
        LAS float* bonr = BON + (q & 1) * ((C2_BON2 - C2_BON) / 4); LAS float* bonn = BON + ((q + 1) & 1) * ((C2_BON2 - C2_BON) / 4);
        const int ctg = wid & 1;
        f32x4 accG = (f32x4){0.f, 0.f, 0.f, 0.f}, accY = accG;
        {
            const int pr = wid >> 1, rts = wid & 1;
            const LAS bf16_t* Xm = (pr & 1) ? KDS : BS; const LAS bf16_t* Ym = (pr < 2) ? KKS : RS;
            const bf16x8 a0 = ldsb8(Xm + (rts * 16 + fr) * 72 + fq * 8), a1 = ldsb8(Xm + (rts * 16 + fr) * 72 + 32 + fq * 8);
#pragma unroll
            for (int cts = 0; cts < 2; ++cts) {
                f32x4 acc = (f32x4){0.f, 0.f, 0.f, 0.f};
                acc = __builtin_amdgcn_mfma_f32_16x16x32_bf16(a0, ldsb8(Ym + (cts * 16 + fr) * 72 + fq * 8), acc, 0, 0, 0);
                acc = __builtin_amdgcn_mfma_f32_16x16x32_bf16(a1, ldsb8(Ym + (cts * 16 + fr) * 72 + 32 + fq * 8), acc, 0, 0, 0);
                const int t = cts * 16 + fr, s0 = rts * 16 + fq * 4;
#pragma unroll
                for (int i = 0; i < 4; ++i) { const bool keep = (pr < 2) ? (s0 + i < t) : (s0 + i <= t); acc[i] = keep ? acc[i] : 0.f; }
                if (pr == 0) { ABT[s0 * 32 + t] = acc[0]; ABT[(s0 + 1) * 32 + t] = acc[1]; ABT[(s0 + 2) * 32 + t] = acc[2]; ABT[(s0 + 3) * 32 + t] = acc[3]; }
                else { u32x2 w; w.x = cvt_pk_bf16(acc[0], acc[1]); w.y = cvt_pk_bf16(acc[2], acc[3]); *(LAS u32x2*)((pr == 1 ? AKT : (pr == 2 ? NBT : NKT)) + t * 40 + s0) = w; }
            }
#pragma unroll
            for (int ks = 0; ks < 2; ++ks) { const bf16x8 sa = ldsb8(S0B + (rt * 16 + fr) * 72 + ks * 32 + fq * 8);
                accG = __builtin_amdgcn_mfma_f32_16x16x32_bf16(sa, ldsb8(KKS + (ctg * 16 + fr) * 72 + ks * 32 + fq * 8), accG, 0, 0, 0);
                accY = __builtin_amdgcn_mfma_f32_16x16x32_bf16(sa, ldsb8(RS + (ctg * 16 + fr) * 72 + ks * 32 + fq * 8), accY, 0, 0, 0); }
        }
        __syncthreads();
        {
            const bf16x8 va = ldsb8(VT + (rt * 16 + fr) * 40 + fq * 8);
            accG = __builtin_amdgcn_mfma_f32_16x16x32_bf16(va, ldsb8(AKT + (ctg * 16 + fr) * 40 + fq * 8), accG, 0, 0, 0);
            accY = __builtin_amdgcn_mfma_f32_16x16x32_bf16(va, ldsb8(NKT + (ctg * 16 + fr) * 40 + fq * 8), accY, 0, 0, 0);
#pragma unroll
            for (int i = 0; i < 4; ++i) Gm[(rt * 16 + fq * 4 + i) * 36 + ctg * 16 + fr] = -accG[i];
            if (q + 1 < NQ) { commit(); if (q + 2 < NQ) prefetch(q + 2); }
        }
        __syncthreads();
        if (wid >= 4) { if (q + 1 < NQ) do_shift(tid & (NT / 2 - 1), NT / 2); }
        else {
            const int v = wid * 16 + (lane >> 2), pq = lane & 3;
            const LAS float* grow = Gm + v * 36;
            f32x4 r0 = *(const LAS f32x4*)(grow + 4 * pq), r1 = *(const LAS f32x4*)(grow + 16 + 4 * pq);
            u32x2 ubo[TB / 4];
            const LAS float* abq = ABT + 4 * pq; asm volatile("" : "+v"(abq));
            f32x4 a0c[4], a1c[4];
            auto ldg = [&](int g, f32x4 (&aa0)[4], f32x4 (&aa1)[4]) __attribute__((always_inline)) {
#pragma unroll
                for (int x = 0; x < 4; ++x) { if (g < 4) aa0[x] = *(const LAS f32x4*)(abq + (4 * g + x) * 32); aa1[x] = *(const LAS f32x4*)(abq + (4 * g + x) * 32 + 16); } };
            ldg(0, a0c, a1c);
#pragma unroll
            for (int g = 0; g < TB / 4; ++g) {
                f32x4 a0n[4], a1n[4];
                if (g + 1 < TB / 4) ldg(g + 1, a0n, a1n);
                __builtin_amdgcn_sched_barrier(0);
                const f32x4 rr = g < 4 ? r0 : r1;
                f32x4 dg[3];
#pragma unroll
                for (int x = 0; x < 3; ++x) dg[x] = g < 4 ? a0c[x] : a1c[x];
                f32x4 u4;
                u4[0] = rr[0];
                u4[1] = __builtin_fmaf(-u4[0], dg[0][1], rr[1]);
                u4[2] = __builtin_fmaf(-u4[1], dg[1][2], __builtin_fmaf(-u4[0], dg[0][2], rr[2]));
                u4[3] = __builtin_fmaf(-u4[2], dg[2][3], __builtin_fmaf(-u4[1], dg[1][3], __builtin_fmaf(-u4[0], dg[0][3], rr[3])));
#pragma unroll
                for (int x = 0; x < 4; ++x) { const int ui = __float_as_int(u4[x]); int bi;
                    if ((g & 3) == 0) bi = __builtin_amdgcn_update_dpp(0, ui, 0x00, 0xF, 0xF, true); else if ((g & 3) == 1) bi = __builtin_amdgcn_update_dpp(0, ui, 0x55, 0xF, 0xF, true);
                    else if ((g & 3) == 2) bi = __builtin_amdgcn_update_dpp(0, ui, 0xAA, 0xF, 0xF, true); else bi = __builtin_amdgcn_update_dpp(0, ui, 0xFF, 0xF, 0xF, true);
                    u4[x] = __int_as_float(bi); }
                ubo[g].x = cvt_pk_bf16(u4[0], u4[1]); ubo[g].y = cvt_pk_bf16(u4[2], u4[3]);
                if (g < 3) {
                    f32x2 lo = r0.lo, hi = r0.hi;
#pragma unroll
                    for (int x = 0; x < 4; ++x) { const f32x2 ux = (f32x2){u4[x], u4[x]}; lo = lo - ux * a0c[x].lo; hi = hi - ux * a0c[x].hi; }
                    r0.lo = lo; r0.hi = hi; }
                if (g < 7) {
                    f32x2 lo = r1.lo, hi = r1.hi;
#pragma unroll
                    for (int x = 0; x < 4; ++x) { const f32x2 ux = (f32x2){u4[x], u4[x]}; lo = lo - ux * a1c[x].lo; hi = hi - ux * a1c[x].hi; }
                    r1.lo = lo; r1.hi = hi; }
                if (g + 1 < TB / 4) {
#pragma unroll
                    for (int x = 0; x < 4; ++x) { a0c[x] = a0n[x]; a1c[x] = a1n[x]; } }
            }
            if (pq == 0) {
#pragma unroll
                for (int g = 0; g < TB / 4; g += 2) { u32x4 w; w.x = ubo[g].x; w.y = ubo[g].y; w.z = ubo[g + 1].x; w.w = ubo[g + 1].y; *(LAS u32x4*)(UB + v * 40 + 4 * g) = w; } }
        }
        __syncthreads();
        {
            const bf16x8 ua = ldsb8(UB + (rt * 16 + fr) * 40 + fq * 8), va = ldsb8(VT + (rt * 16 + fr) * 40 + fq * 8);
            accY = __builtin_amdgcn_mfma_f32_16x16x32_bf16(ua, ldsb8(NBT + (ctg * 16 + fr) * 40 + fq * 8), accY, 0, 0, 0);
            *(LAS f32x4*)(YO + (ctg * 16 + fr) * 64 + rt * 16 + fq * 4) = accY;
#pragma unroll
            for (int cc = 0; cc < 2; ++cc) { const int ct = 2 * (wid & 1) + cc, kcol = ct * 16 + fr;
                f32x4 acc = Sreg[cc];
                acc = __builtin_amdgcn_mfma_f32_16x16x32_bf16(ua, ldsb8(BST + kcol * 40 + fq * 8), acc, 0, 0, 0);
                acc = __builtin_amdgcn_mfma_f32_16x16x32_bf16(va, ldsb8(KDST + kcol * 40 + fq * 8), acc, 0, 0, 0);
                const float g = GC[kcol];
#pragma unroll
                for (int i = 0; i < 4; ++i) acc[i] *= g;
                { const unsigned p0 = cvt_pk_bf16(acc[0], acc[1]), p1 = cvt_pk_bf16(acc[2], acc[3]); LAS bf16_t* sp = S0B + (rt * 16 + fq * 4) * 72 + kcol;
                  sp[0] = (bf16_t)p0; sp[72] = (bf16_t)(p0 >> 16); sp[144] = (bf16_t)p1; sp[216] = (bf16_t)(p1 >> 16); }
                Sreg[cc] = acc; }
        }
        if (q + 1 < NQ) lora_stage();
        __syncthreads();
        if (!isctx) {
            const int j = tid >> 4, c4 = (tid & 15) * 4, t = d == 0 ? j : TB - 1 - j; const f32x4 y = *(const LAS f32x4*)(YO + j * 64 + c4);
            u32x2 w; w.x = cvt_pk_bf16(y[0], y[1]); w.y = cvt_pk_bf16(y[2], y[3]);
            bf16_t* yb_ = p.Y + ((size_t)d * nlat + grow0) * RW + h * 64;
            *(u32x2*)(yb_ + t * RW + c4) = w;
            if (tid < TB) { const int tt = d == 0 ? tid : TB - 1 - tid; float* bb_ = p.bon + ((size_t)d * nlat + grow0) * NH + h; bb_[tt * NH] = bonr[tid]; }
        }
        if (q + 1 < NQ) scale_stage(bonn);
        __syncthreads();
    }
}
template <int MODE = 0>
__device__ __forceinline__ void rwkv_phase3(LAS unsigned char* lds, const In& in, const RwkvP p, int bid, int nblk) {
    const int nchain = 2 * p.nb * NH;
    for (int c = bid; c < nchain; c += nblk) { rwkv_chain3<MODE>(lds, in, p, c); __syncthreads(); }
}
}
}

namespace mk {
constexpr int LR_XT = 0;
constexpr int LR_XC = LR_XT + 67 * 64 * 2 + 64;
constexpr int LR_XCB = LR_XC + 64 * 64 * 4;
constexpr int LR_GWT = LR_XCB + 64 * 72 * 2;
constexpr int LR_A = LR_GWT + 2 * 64 * 72 * 2;
constexpr int LR_BX = LR_A + 64 * 64 * 4;
constexpr int LR_HO = LR_BX + 64 * 64 * 4;
constexpr int LR_CST = LR_HO + 64 * 64 * 4;
constexpr int LR_SEGP = LR_CST + 8 * 64 * 4;
constexpr int LR_SEGH = LR_SEGP + 8 * 64 * 4;
constexpr int LR_HC = LR_SEGH + 8 * 64 * 4;
constexpr int LR_END = LR_HC + 64 * 4;
static_assert(LR_END <= LDS_BYTES && (LR_XC % 16) == 0, "lru LDS");

struct LruP { const bf16_t* z1; bf16_t* Hd; int b0, nb; };

__device__ __forceinline__ void lru_item(LAS unsigned char* lds, const In& in, const LruP p, int item) {
    const int tid = threadIdx.x, lane = tid & 63, wid = tid >> 6;
    const int d = item / (p.nb * LB), bl = (item / LB) % p.nb, n = item % LB;
    const int nlat = p.nb * SEQ;
    LAS bf16_t* XT = (LAS bf16_t*)(lds + LR_XT); LAS float* XC = (LAS float*)(lds + LR_XC); LAS bf16_t* XCB = (LAS bf16_t*)(lds + LR_XCB); LAS bf16_t* GWT = (LAS bf16_t*)(lds + LR_GWT);
    LAS float *A_ = (LAS float*)(lds + LR_A), *BX = (LAS float*)(lds + LR_BX), *HO = (LAS float*)(lds + LR_HO), *CST = (LAS float*)(lds + LR_CST), *SEGP = (LAS float*)(lds + LR_SEGP), *SEGH = (LAS float*)(lds + LR_SEGH), *HC = (LAS float*)(lds + LR_HC);
    for (int i = tid; i < 2 * 64 * 64; i += NT) { const int g = i >> 12, j = (i >> 6) & 63, k = i & 63;
        GWT[(g * 64 + k) * 72 + j] = f2bf(in.lru_gate_w[((((size_t)d * 2 + g) * LB + n) * LBS + j) * LBS + k]); }
    for (int i = tid; i < 64; i += NT) { const int c = n * 64 + i;
        CST[i] = in.lru_conv_w[c]; CST[64 + i] = in.lru_conv_w[LW + c]; CST[128 + i] = in.lru_conv_w[2 * LW + c]; CST[192 + i] = in.lru_conv_w[3 * LW + c]; CST[256 + i] = in.lru_conv_b[c];
        CST[320 + i] = in.lru_gate_b[((d * 2 + 0) * LB + n) * LBS + i]; CST[384 + i] = in.lru_gate_b[((d * 2 + 1) * LB + n) * LBS + i]; CST[448 + i] = softplusf_(-in.lru_l[d * LW + c]); }
    constexpr int NSEG = CTX / 64 + GW, NSC = CTX / 64;
    u32x4 pre[2];
    auto tok_row = [&](int sidx, int rr, bool& ok) -> size_t {
        if (sidx < NSC) { const int t = sidx * 64 + rr - 2; ok = t >= 0 && t < CTX; return (size_t)nlat + (size_t)bl * CTX + t; }
        const int col = sidx - NSC, row = rr - 2; ok = row >= 0 && row < ROWS; return (size_t)bl * SEQ + (size_t)row * GW + col;
    };
    auto seg_of = [&](int q) { if (q < NSC) return d == 0 ? q : NSC - 1 - q; const int ql = q - NSC; return NSC + (d == 0 ? ql : GW - 1 - ql); };
    auto prefetch = [&](int q) { const int sidx = seg_of(q);
#pragma unroll
        for (int k = 0; k < 2; ++k) { const int i = tid + k * NT; u32x4 v = (u32x4){0u, 0u, 0u, 0u};
            if (i < 67 * 8) { const int rr = i >> 3, part = i & 7; bool ok; const size_t gr = tok_row(sidx, rr, ok); if (ok) v = *(const u32x4*)(p.z1 + gr * Z1_N + Z1_LX + n * 64 + part * 8); }
            pre[k] = v; } };
    auto commit = [&]() {
#pragma unroll
        for (int k = 0; k < 2; ++k) { const int i = tid + k * NT; if (i < 67 * 8) *(LAS u32x4*)(XT + (i >> 3) * 64 + (i & 7) * 8) = pre[k]; } };
    if (tid < 64) HC[tid] = 0.f;
    auto conv = [&]() __attribute__((always_inline)) {
        const int t = tid >> 3, c0 = (tid & 7) * 8; f32x2 s[4];
        { const f32x4 b0 = *(const LAS f32x4*)(CST + 256 + c0), b1 = *(const LAS f32x4*)(CST + 256 + c0 + 4); s[0] = b0.lo; s[1] = b0.hi; s[2] = b1.lo; s[3] = b1.hi; }
#pragma unroll
        for (int tap = 0; tap < 4; ++tap) { const u32x4 x = *(const LAS u32x4*)(XT + (t + tap) * 64 + c0);
            const f32x4 w0 = *(const LAS f32x4*)(CST + tap * 64 + c0), w1 = *(const LAS f32x4*)(CST + tap * 64 + c0 + 4);
            f32x2 v; v.x = bflo(x[0]); v.y = bfhi(x[0]); s[0] = w0.lo * v + s[0]; v.x = bflo(x[1]); v.y = bfhi(x[1]); s[1] = w0.hi * v + s[1];
            v.x = bflo(x[2]); v.y = bfhi(x[2]); s[2] = w1.lo * v + s[2]; v.x = bflo(x[3]); v.y = bfhi(x[3]); s[3] = w1.hi * v + s[3]; }
        *(LAS f32x4*)(XC + t * 64 + c0) = (f32x4){s[0].x, s[0].y, s[1].x, s[1].y}; *(LAS f32x4*)(XC + t * 64 + c0 + 4) = (f32x4){s[2].x, s[2].y, s[3].x, s[3].y};
        u32x4 w; w.x = cvt_pk_bf16(s[0].x, s[0].y); w.y = cvt_pk_bf16(s[1].x, s[1].y); w.z = cvt_pk_bf16(s[2].x, s[2].y); w.w = cvt_pk_bf16(s[3].x, s[3].y); *(LAS u32x4*)(XCB + t * 72 + c0) = w; };
    auto output = [&](int sidx) __attribute__((always_inline)) {
        if (sidx >= NSC) { const int col = sidx - NSC, t = tid >> 3, c0 = (tid & 7) * 8;
            const f32x4 x = *(const LAS f32x4*)(HO + t * 64 + c0), y = *(const LAS f32x4*)(HO + t * 64 + c0 + 4);
            *(u32x4*)(p.Hd + ((size_t)d * nlat + (size_t)bl * SEQ + (size_t)t * GW + col) * LW + n * 64 + c0) = pack8(x, y); } };
    prefetch(0);
    commit();
    __syncthreads();
    if (1 < NSEG) prefetch(1);
    conv();
    __syncthreads();
    float hlast = 0.f;
    for (int q = 0; q < NSEG; ++q) {
        { const int rt = wid >> 1, fr = lane & 15, fq = lane >> 4;
          bf16x8 a[2];
#pragma unroll
          for (int ks = 0; ks < 2; ++ks) a[ks] = *(const LAS bf16x8*)(XCB + (rt * 16 + fr) * 72 + ks * 32 + fq * 8);
#pragma unroll
          for (int cc = 0; cc < 2; ++cc) { const int ct = 2 * (wid & 1) + cc, col = ct * 16 + fr;
              f32x4 acc0 = (f32x4){0.f, 0.f, 0.f, 0.f}, acc1 = acc0;
#pragma unroll
              for (int ks = 0; ks < 2; ++ks) {
                  const bf16x8 b0 = *(const LAS bf16x8*)(GWT + (0 * 64 + col) * 72 + ks * 32 + fq * 8), b1 = *(const LAS bf16x8*)(GWT + (1 * 64 + col) * 72 + ks * 32 + fq * 8);
                  acc0 = __builtin_amdgcn_mfma_f32_16x16x32_bf16(a[ks], b0, acc0, 0, 0, 0); acc1 = __builtin_amdgcn_mfma_f32_16x16x32_bf16(a[ks], b1, acc1, 0, 0, 0); }
              constexpr float L2E = 1.4426950408889634f;
              const float g0s = -L2E * CST[320 + col], g1s = -L2E * CST[384 + col], sp8l = -8.f * L2E * CST[448 + col];
#pragma unroll
              for (int i = 0; i < 4; ++i) { const int t = rt * 16 + fq * 4 + i;
                  const float rec = fast_rcp(1.f + __builtin_amdgcn_exp2f(__builtin_fmaf(acc0[i], -L2E, g0s))), ib = 1.f + __builtin_amdgcn_exp2f(__builtin_fmaf(acc1[i], -L2E, g1s));
                  const float av = __builtin_amdgcn_exp2f(sp8l * rec), om = __builtin_fmaf(-av, av, 1.f);
                  A_[t * 64 + col] = av; BX[t * 64 + col] = om * __builtin_amdgcn_rsqf(fmaxf(om * ib * ib, 1e-30f)) * XC[t * 64 + col]; } } }
        if (q + 1 < NSEG) commit();
        if (q > 0) { output(seg_of(q - 1)); if ((tid >> 6) == 7) HC[tid & 63] = hlast; }
        __syncthreads();
        const int ch = tid & 63, pc = tid >> 6; float av[8], bv[8];
        { float P = 1.f, H = 0.f;
#pragma unroll
          for (int x = 0; x < 8; ++x) { const int st = pc * 8 + x, t = d == 0 ? st : 63 - st; av[x] = A_[t * 64 + ch]; bv[x] = BX[t * 64 + ch]; H = av[x] * H + bv[x]; P *= av[x]; }
          SEGP[pc * 64 + ch] = P; SEGH[pc * 64 + ch] = H; }
        if (q + 1 < NSEG) { if (q + 2 < NSEG) prefetch(q + 2); conv(); }
        __syncthreads();
        { float h = HC[ch];
#pragma unroll
          for (int q2 = 0; q2 < 7; ++q2) if (q2 < pc) h = SEGP[q2 * 64 + ch] * h + SEGH[q2 * 64 + ch];
#pragma unroll
          for (int x = 0; x < 8; ++x) { const int st = pc * 8 + x, t = d == 0 ? st : 63 - st; h = av[x] * h + bv[x]; HO[t * 64 + ch] = h; }
          hlast = h; }
        __syncthreads();
    }
    output(seg_of(NSEG - 1));
}
__device__ __forceinline__ void lru_phase(LAS unsigned char* lds, const In& in, const LruP p, int bid, int nblk) {
    const int nitem = 2 * p.nb * LB;
    for (int it = bid; it < nitem; it += nblk) { lru_item(lds, in, p, it); __syncthreads(); }
}
}

namespace mk {
#define MK_DPPX(x, ctrl) __int_as_float(__builtin_amdgcn_update_dpp(__float_as_int(x), __float_as_int(x), ctrl, 0xF, 0xF, false))
__device__ __forceinline__ float allreduce4(float x) { x += MK_DPPX(x, 0xB1); x += MK_DPPX(x, 0x4E); return x; }
__device__ __forceinline__ void unpack8(const u32x4 w, float (&f)[8]) {
#pragma unroll
    for (int j = 0; j < 4; ++j) { f[2 * j] = bflo(w[j]); f[2 * j + 1] = bfhi(w[j]); } }
constexpr int AG_K = 256;
struct PostP { const bf16_t* z1; bf16_t* Y; const float* bon; bf16_t* Ag; int nlat; int pad_; };
__device__ __forceinline__ void rwkv_post_rows(LAS float* cst  , const In& in, const PostP p, int row_lo, int row_hi, bool dry = false) {
    const int lane = threadIdx.x & 63, wid = threadIdx.x >> 6, c0 = lane * 16, h = lane >> 2;
    float mg0[8], mg1[8];
    for (int i = threadIdx.x; i < RW; i += NT) { cst[i] = in.shift_mu[OFF_V + i]; cst[RW + i] = in.shift_mu[RC + OFF_V + i]; cst[2 * RW + i] = in.rw_lnx[i]; cst[3 * RW + i] = in.rw_lnx[RW + i]; }
    __syncthreads();
#pragma unroll
    for (int j = 0; j < 8; ++j) { const int c = OFF_GD + (lane < GL / 8 ? lane : 0) * 8 + j; mg0[j] = in.shift_mu[c]; mg1[j] = in.shift_mu[RC + c]; }
    struct Raw { u32x4 y00, y01, y10, y11, zx[2], zp[2], zn[2]; float b0, b1; };
    const u32x4 Z4 = (u32x4){0u, 0u, 0u, 0u};
    auto load_row = [&](int r, Raw& w) __attribute__((always_inline)) {
        const int cg = r % GW; const bool hp = cg > 0, hn = cg < GW - 1;
        const bf16_t* y0p = p.Y + (size_t)r * RW + c0; const bf16_t* y1p = p.Y + ((size_t)p.nlat + r) * RW + c0;
        w.y00 = *(const u32x4*)y0p; w.y01 = *(const u32x4*)(y0p + 8); w.y10 = *(const u32x4*)y1p; w.y11 = *(const u32x4*)(y1p + 8);
        w.b0 = p.bon[(size_t)r * NH + h]; w.b1 = p.bon[((size_t)p.nlat + r) * NH + h];
        const bf16_t* zr = p.z1 + (size_t)r * Z1_N;
#pragma unroll
        for (int half = 0; half < 2; ++half) { const int c = OFF_V + c0 + half * 8;
            w.zx[half] = *(const u32x4*)(zr + c); w.zp[half] = Z4; w.zn[half] = Z4;
            if (hp) w.zp[half] = *(const u32x4*)(zr - Z1_N + c);
            if (hn) w.zn[half] = *(const u32x4*)(zr + Z1_N + c); }
    };
    auto compute_row = [&](int r, const Raw& w) __attribute__((always_inline)) {
        bf16_t* y0p = p.Y + (size_t)r * RW + c0;
        float y[16], t8[8];
        unpack8(w.y00, t8);
#pragma unroll
        for (int j = 0; j < 8; ++j) y[j] = t8[j];
        unpack8(w.y01, t8);
#pragma unroll
        for (int j = 0; j < 8; ++j) y[8 + j] = t8[j];
        unpack8(w.y10, t8);
#pragma unroll
        for (int j = 0; j < 8; ++j) y[j] += t8[j];
        unpack8(w.y11, t8);
#pragma unroll
        for (int j = 0; j < 8; ++j) y[8 + j] += t8[j];
        float s = 0.f;
#pragma unroll
        for (int j = 0; j < 16; ++j) s += y[j];
        const float mu = allreduce4(s) * (1.f / 64.f); float q = 0.f;
#pragma unroll
        for (int j = 0; j < 16; ++j) { const float dlt = y[j] - mu; q += dlt * dlt; }
        const float rs = __builtin_amdgcn_rsqf(allreduce4(q) * (1.f / 64.f) + LNX_EPS);
        const float bonus = w.b0 + w.b1;
#pragma unroll
        for (int half = 0; half < 2; ++half) {
            float xv[8], pv[8], nv[8]; unpack8(w.zx[half], xv); unpack8(w.zp[half], pv); unpack8(w.zn[half], nv);
            float m0_[8], m1_[8], g0_[8], g1_[8];
            { const LAS float* cb = cst + c0 + half * 8; const f32x4 a0 = *(const LAS f32x4*)cb, a1 = *(const LAS f32x4*)(cb + 4), b0 = *(const LAS f32x4*)(cb + RW), b1 = *(const LAS f32x4*)(cb + RW + 4),
                  e0 = *(const LAS f32x4*)(cb + 2 * RW), e1 = *(const LAS f32x4*)(cb + 2 * RW + 4), f0 = *(const LAS f32x4*)(cb + 3 * RW), f1 = *(const LAS f32x4*)(cb + 3 * RW + 4);
#pragma unroll
              for (int j = 0; j < 4; ++j) { m0_[j] = a0[j]; m0_[4 + j] = a1[j]; m1_[j] = b0[j]; m1_[4 + j] = b1[j]; g0_[j] = e0[j]; g0_[4 + j] = e1[j]; g1_[j] = f0[j]; g1_[4 + j] = f1[j]; } }
            float o[8];
#pragma unroll
            for (int j = 0; j < 8; ++j) { const int cj = half * 8 + j; const float v = xv[j] + m0_[j] * (pv[j] - xv[j]) + m1_[j] * (nv[j] - xv[j]);
                o[j] = (y[cj] - mu) * rs * g0_[j] + g1_[j] + bonus * v; }
            u32x4 wv; wv.x = cvt_pk_bf16(o[0], o[1]); wv.y = cvt_pk_bf16(o[2], o[3]); wv.z = cvt_pk_bf16(o[4], o[5]); wv.w = cvt_pk_bf16(o[6], o[7]); if (!dry) *(u32x4*)(y0p + half * 8) = wv; else if (wv.x == 0x12345678u) *(u32x4*)(y0p + half * 8) = wv;
        }
        if (lane < 32) { u32x4 wv = Z4;
            if (lane < GL / 8) { const int cg = r % GW; const bool hp = cg > 0, hn = cg < GW - 1; const bf16_t* zr = p.z1 + (size_t)r * Z1_N; const int c = OFF_GD + lane * 8;
                u32x4 gx = *(const u32x4*)(zr + c), gp = Z4, gn = Z4; if (hp) gp = *(const u32x4*)(zr - Z1_N + c); if (hn) gn = *(const u32x4*)(zr + Z1_N + c);
                float xv[8], pv[8], nv[8]; unpack8(gx, xv); unpack8(gp, pv); unpack8(gn, nv);
                float o[8];
#pragma unroll
                for (int j = 0; j < 8; ++j) o[j] = fast_sigmoid(xv[j] + mg0[j] * (pv[j] - xv[j]) + mg1[j] * (nv[j] - xv[j]));
                wv.x = cvt_pk_bf16(o[0], o[1]); wv.y = cvt_pk_bf16(o[2], o[3]); wv.z = cvt_pk_bf16(o[4], o[5]); wv.w = cvt_pk_bf16(o[6], o[7]); }
            *(u32x4*)(p.Ag + (size_t)r * AG_K + lane * 8) = wv; }
    };
    constexpr int RS_ = NT / 64;
    Raw A, B;
    int r = row_lo + wid;
    if (r < row_hi) load_row(r, A);
    for (; r < row_hi; r += 2 * RS_) {
        if (r + RS_ < row_hi) load_row(r + RS_, B);
        compute_row(r, A);
        if (r + 2 * RS_ < row_hi) load_row(r + 2 * RS_, A);
        if (r + RS_ < row_hi) compute_row(r + RS_, B);
    }
}
#define MK_FR_ROW(f) ((((f) >> 3) * HALF) + wr * 64 + ((((f) >> 1) & 3) * 16) + fr)
#define MK_FR_COL(f) ((((f) & 1) * HALF) + wc * 32 + 8 * fq)
#define MK_FR_ACC(f, n) acc[(f) >> 3][(f) & 1][((f) >> 1) & 3][n]
#define MK_FENCE asm volatile("" ::: "memory")
struct EpiYa { static constexpr int NS = 16; const bf16_t* yn; bf16_t* ya;
    __device__ __forceinline__ bool operator()(f32x4 (&acc)[2][2][4][2], const Unit& u, int wr, int wc, int fr, int fq) const {
        const size_t base = (size_t)(u.pm * BM) * RW + u.pn * BM;
        u32x4 cur = *(const u32x4*)(yn + base + (size_t)MK_FR_ROW(0) * RW + MK_FR_COL(0));
#pragma unroll
        for (int f = 0; f < 16; ++f) { u32x4 nxt = cur; if (f + 1 < 16) nxt = *(const u32x4*)(yn + base + (size_t)MK_FR_ROW(f + 1) * RW + MK_FR_COL(f + 1));
            MK_FENCE; float v[8]; unpack8(cur, v); f32x4 a = MK_FR_ACC(f, 0), b = MK_FR_ACC(f, 1);
#pragma unroll
            for (int j = 0; j < 4; ++j) { a[j] *= v[j]; b[j] *= v[4 + j]; }
            *(u32x4*)(ya + base + (size_t)MK_FR_ROW(f) * RW + MK_FR_COL(f)) = pack8(a, b); MK_FENCE; cur = nxt; }
        return false; } };
struct EpiZc { static constexpr int NS = 16; const bf16_t* Hd; bf16_t* yb; bf16_t* gates; int nlat; int pad_;
    __device__ __forceinline__ bool operator()(f32x4 (&acc)[2][2][4][2], const Unit& u, int wr, int wc, int fr, int fq) const {
        if (u.pn < LW / BM) {
            MK_FRAG_LOOP(r, c) { const size_t o = (size_t)(u.pm * BM + r) * LW + u.pn * BM + c; float h0[8], h1[8]; unpack8(*(const u32x4*)(Hd + o), h0); unpack8(*(const u32x4*)(Hd + (size_t)nlat * LW + o), h1);
                f32x4 a = acc[ai][bj][m][0], b = acc[ai][bj][m][1];
#pragma unroll
                for (int j = 0; j < 4; ++j) { a[j] = gelu_tanhf_(a[j]) * (h0[j] + h1[j]); b[j] = gelu_tanhf_(b[j]) * (h0[4 + j] + h1[4 + j]); }
                *(u32x4*)(yb + o) = pack8(a, b); asm volatile("" ::: "memory"); }
        } else {
            MK_FRAG_LOOP(r, c) { const size_t o = (size_t)(u.pm * BM + r) * (2 * D) + (u.pn * BM - LW) + c;
                f32x4 a = acc[ai][bj][m][0], b = acc[ai][bj][m][1];
#pragma unroll
                for (int j = 0; j < 4; ++j) { a[j] = fast_sigmoid(a[j]); b[j] = fast_sigmoid(b[j]); }
                *(u32x4*)(gates + o) = pack8(a, b); }
        }
        return false; } };
struct PairOrder { StaticOrder S;
    __device__ bool next(int i, Unit& u) const { if (!S.next(i >> 1, u)) return false; u.e = i & 1; return true; } };
struct EpiBranch { const bf16_t* gates; bf16_t* mixed;
    __device__ __forceinline__ bool operator()(f32x4 (&acc)[2][2][4][2], const Unit& u, int wr, int wc, int fr, int fq) const {
        const size_t gbase = (size_t)(u.pm * BM) * (2 * D) + u.pn * BM, mbase = (size_t)(u.pm * BM) * D + u.pn * BM;
        u32x4 c1 = (u32x4){0u, 0u, 0u, 0u}, c2 = *(const u32x4*)(gates + gbase + (size_t)MK_FR_ROW(0) * (2 * D) + D + MK_FR_COL(0));
        if (u.e == 0) c1 = *(const u32x4*)(gates + gbase + (size_t)MK_FR_ROW(0) * (2 * D) + MK_FR_COL(0));
#pragma unroll
        for (int f = 0; f < 16; ++f) { u32x4 n1 = c1, n2 = c2;
            if (f + 1 < 16) { const size_t o = gbase + (size_t)MK_FR_ROW(f + 1) * (2 * D) + MK_FR_COL(f + 1); n2 = *(const u32x4*)(gates + o + D); if (u.e == 0) n1 = *(const u32x4*)(gates + o); }
            MK_FENCE; float g1[8], g2[8]; unpack8(c1, g1); unpack8(c2, g2);
            if (u.e == 0) {
#pragma unroll
                for (int j = 0; j < 4; ++j) { MK_FR_ACC(f, 0)[j] *= g1[j] / g2[j]; MK_FR_ACC(f, 1)[j] *= g1[4 + j] / g2[4 + j]; }
            } else { f32x4 a = MK_FR_ACC(f, 0), b = MK_FR_ACC(f, 1);
#pragma unroll
                for (int j = 0; j < 4; ++j) { a[j] *= g2[j]; b[j] *= g2[4 + j]; }
                *(u32x4*)(mixed + mbase + (size_t)MK_FR_ROW(f) * D + MK_FR_COL(f)) = pack8(a, b); }
            MK_FENCE; c1 = n1; c2 = n2; }
        __builtin_amdgcn_s_waitcnt(0x0F70);
        return u.e == 0; } };
struct EpiF32 { float* C; long ldc;
    __device__ __forceinline__ bool operator()(f32x4 (&acc)[2][2][4][2], const Unit& u, int wr, int wc, int fr, int fq) const {
        MK_FRAG_LOOP(r, c) { float* o = C + (size_t)(u.pm * BM + r) * ldc + u.pn * BM + c; *(f32x4*)o = acc[ai][bj][m][0]; *(f32x4*)(o + 4) = acc[ai][bj][m][1]; }
        return false; } };
}

namespace mk {
constexpr int NEX = NE + 1;
constexpr int SLOTS_PER_TOK = TOPK + 1;
constexpr int RP_MOD = 0;
constexpr int RP_UH = RP_MOD + 3 * D * 4;
constexpr int RP_UL = RP_UH + 16 * (D + 8) * 2;
constexpr int RP_PART = RP_UL + 16 * (D + 8) * 2;
constexpr int RP_LOG = RP_PART + 8 * 16 * 64 * 4;
constexpr int RP_HIST = RP_LOG + 16 * 64 * 4;
constexpr int RP_END = RP_HIST + 64 * 4;
static_assert(RP_END <= LDS_BYTES, "rowpass LDS");

constexpr float FP8_SR = 64.f;
constexpr float FP8_SA = 8.f, FP8_SWD = 256.f;
constexpr float FP8_SU = 16.f, FP8_SW = 256.f;
struct RowP { float* y2h1; bf16_t* u; unsigned char* u8; const float* modpart; const bf16_t* rwt;
              int* tope; float* gatev; int* lrank; int* blkcnt; int b0, nlat; };
__device__ __forceinline__ float wave_max(float x) { return wave_max64(x); }
__device__ __forceinline__ void row_pass(LAS unsigned char* lds, const In& in, const RowP p, int row_lo, int row_hi, bool dry = false) {
    const int tid = threadIdx.x, lane = tid & 63, wid = tid >> 6;
    LAS float* MOD = (LAS float*)(lds + RP_MOD); LAS bf16_t* UH = (LAS bf16_t*)(lds + RP_UH); LAS bf16_t* UL = (LAS bf16_t*)(lds + RP_UL);
    LAS float* PART = (LAS float*)(lds + RP_PART); LAS float* LOG = (LAS float*)(lds + RP_LOG); LAS int* HIST = (LAS int*)(lds + RP_HIST);
    const int mr = p.b0 + row_lo / SEQ;
    for (int j = tid; j < 3 * D; j += NT) MOD[j] = mod_value(in, p.modpart, mr, 2 * D + j);
    if (tid < 64) HIST[tid] = 0;
    __syncthreads();
    float gp1[16], gp2[16];
#pragma unroll
    for (int j = 0; j < 4; ++j)
#pragma unroll
        for (int q = 0; q < 4; ++q) { gp1[4 * j + q] = in.norm_g[D + j * 256 + lane * 4 + q]; gp2[4 * j + q] = in.norm_g[2 * D + j * 256 + lane * 4 + q]; }
    u32x2 py[2][4]; f32x4 px[2][4];
    auto fetch = [&](int r16) __attribute__((always_inline)) {
#pragma unroll
        for (int rr = 0; rr < 2; ++rr) { const int r = r16 + wid * 2 + rr;
#pragma unroll
            for (int j = 0; j < 4; ++j) { py[rr][j] = *(const u32x2*)(p.u + (size_t)r * D + j * 256 + lane * 4); px[rr][j] = *(const f32x4*)(in.x + ((size_t)p.b0 * SEQ + r) * D + j * 256 + lane * 4); } } };
    fetch(row_lo);
    for (int r16 = row_lo; r16 < row_hi; r16 += 16) {
#pragma unroll
        for (int rr = 0; rr < 2; ++rr) {
            const int lr = wid * 2 + rr, r = r16 + lr;
            float* yp = p.y2h1 + (size_t)r * D;
            f32x4 v[4]; float ss = 0.f;
#pragma unroll
            for (int j = 0; j < 4; ++j) { const u32x2 yw = py[rr][j];
                v[j] = (f32x4){bflo(yw.x), bfhi(yw.x), bflo(yw.y), bfhi(yw.y)}; ss += v[j][0] * v[j][0] + v[j][1] * v[j][1] + v[j][2] * v[j][2] + v[j][3] * v[j][3]; }
#pragma unroll
            for (int o_ = 0; o_ < 1; ++o_) ss = wave_sum64(ss);
            const float rinv = __builtin_amdgcn_rsqf(ss * (1.f / D) + NORM_EPS); float s2 = 0.f;
#pragma unroll
            for (int j = 0; j < 4; ++j) { const int c = j * 256 + lane * 4; const f32x4 xv = px[rr][j];
#pragma unroll
                for (int q = 0; q < 4; ++q) { const float hv = xv[q] + MOD[c + q] * (v[j][q] * rinv * gp1[4 * j + q]); v[j][q] = hv; s2 += hv * hv; }
                if (!dry) *(f32x4*)(yp + c) = v[j]; }
#pragma unroll
            for (int o_ = 0; o_ < 1; ++o_) s2 = wave_sum64(s2);
            const float r2 = __builtin_amdgcn_rsqf(s2 * (1.f / D) + NORM_EPS);
#pragma unroll
            for (int j = 0; j < 4; ++j) { const int c = j * 256 + lane * 4; float uu[4], lo[4]; unsigned hw[2];
#pragma unroll
                for (int q = 0; q < 4; ++q) uu[q] = (v[j][q] * r2 * gp2[4 * j + q]) * (1.f + MOD[2 * D + c + q]) + MOD[D + c + q];
                hw[0] = cvt_pk_bf16(uu[0], uu[1]); hw[1] = cvt_pk_bf16(uu[2], uu[3]);
                lo[0] = uu[0] - bflo(hw[0]); lo[1] = uu[1] - bfhi(hw[0]); lo[2] = uu[2] - bflo(hw[1]); lo[3] = uu[3] - bfhi(hw[1]);
                u32x2 w; w.x = hw[0]; w.y = hw[1]; *(unsigned*)(p.u8 + (size_t)r * D + c) = pack4_fp8(uu[0] * FP8_SU, uu[1] * FP8_SU, uu[2] * FP8_SU, uu[3] * FP8_SU); *(LAS u32x2*)(UH + lr * (D + 8) + c) = w;
                u32x2 wl; wl.x = cvt_pk_bf16(lo[0], lo[1]); wl.y = cvt_pk_bf16(lo[2], lo[3]); *(LAS u32x2*)(UL + lr * (D + 8) + c) = wl; }
        }
        __syncthreads();
        { const int fr = lane & 15, fq = lane >> 4;
          f32x4 acc[4];
#pragma unroll
          for (int ct = 0; ct < 4; ++ct) acc[ct] = (f32x4){0.f, 0.f, 0.f, 0.f};
#pragma unroll
          for (int ks = 0; ks < 4; ++ks) { const int k0 = wid * 128 + ks * 32 + fq * 8;
              const bf16x8 ah = *(const LAS bf16x8*)(UH + fr * (D + 8) + k0), al = *(const LAS bf16x8*)(UL + fr * (D + 8) + k0);
#pragma unroll
              for (int ct = 0; ct < 4; ++ct) { const bf16x8 bh = *(const bf16x8*)(p.rwt + (size_t)(ct * 16 + fr) * D + k0), bl = *(const bf16x8*)(p.rwt + (size_t)(NE + ct * 16 + fr) * D + k0);
                  acc[ct] = __builtin_amdgcn_mfma_f32_16x16x32_bf16(ah, bh, acc[ct], 0, 0, 0); acc[ct] = __builtin_amdgcn_mfma_f32_16x16x32_bf16(ah, bl, acc[ct], 0, 0, 0); acc[ct] = __builtin_amdgcn_mfma_f32_16x16x32_bf16(al, bh, acc[ct], 0, 0, 0); } }
#pragma unroll
          for (int ct = 0; ct < 4; ++ct)
#pragma unroll
              for (int i = 0; i < 4; ++i) PART[(wid * 16 + fq * 4 + i) * 64 + ct * 16 + fr] = acc[ct][i]; }
        __syncthreads();
        if (r16 + 16 < row_hi) fetch(r16 + 16);
        for (int i = tid; i < 16 * 64; i += NT) { float s = 0.f;
#pragma unroll
            for (int w = 0; w < 8; ++w) s += PART[w * 1024 + i];
            LOG[i] = s; }
        __syncthreads();
#pragma unroll 1
        for (int rr = 0; rr < 2; ++rr) {
            const int lr = wid * 2 + rr, r = r16 + lr;
            const float sc = sigmoidf_(LOG[lr * 64 + lane]), bi = sc + in.router_b[lane];
            float m1 = bi; m1 = fmaxf(m1, MK_DPPF(m1, 0xB1)); m1 = fmaxf(m1, MK_DPPF(m1, 0x4E)); m1 = fmaxf(m1, MK_DPPF(m1, 0x141));
            const unsigned long long eq = __ballot(bi == m1); const int first = __ffsll((long long)((eq >> (lane & ~7)) & 0xffull)) - 1 + (lane & ~7);
            float m2 = (lane == first) ? -1e30f : bi; m2 = fmaxf(m2, MK_DPPF(m2, 0xB1)); m2 = fmaxf(m2, MK_DPPF(m2, 0x4E)); m2 = fmaxf(m2, MK_DPPF(m2, 0x141));
            const float gs = m1 + m2; const int myg = lane >> 3; int rank = 0;
#pragma unroll
            for (int g = 0; g < NG; ++g) { const float og = __int_as_float(__builtin_amdgcn_readlane(__float_as_int(gs), g * 8)); rank += (og > gs || (og == gs && g < myg)) ? 1 : 0; }
            float cand = rank < TG ? bi : -1e30f; float tsum = 0.f; int myidx = 0; float mysc = 0.f;
#pragma unroll
            for (int it = 0; it < TOPK; ++it) { const float m = wave_max(cand); const unsigned long long bm = __ballot(cand == m); const int win = __builtin_amdgcn_readfirstlane(__ffsll((long long)bm) - 1);
                const float ws = __int_as_float(__builtin_amdgcn_readlane(__float_as_int(sc), win)); tsum += ws; if (lane == it) { myidx = win; mysc = ws; } if (lane == win) cand = -1e30f; }
            if (lane < TOPK) { const int rk = atomicAdd((int*)&HIST[myidx], 1);
                p.tope[(size_t)r * TOPK + lane] = myidx; p.gatev[(size_t)r * TOPK + lane] = mysc / tsum * 2.5f; p.lrank[(size_t)r * TOPK + lane] = rk; }
        }
        __syncthreads();
    }
    if (tid < 64) p.blkcnt[blockIdx.x * 64 + tid] = HIST[tid];
}

struct MoeP { const int* tope; const float* gatev; const int* lrank; const int* blkcnt;
              int* tilepre;
              int* list;
              int* sdst;
              float* sgate;
              int r0, nr, blk0, nbh, rpb, pad_; };
__device__ __forceinline__ void moe_assign(LAS unsigned char* lds, const MoeP p, int bid, int nblk) {
    LAS int* BASE = (LAS int*)lds; LAS int* CNT = BASE + 80; LAS int* BOFF = CNT + 80;
    const int tid = threadIdx.x;
    { LAS int* PC = BOFF + 80; const int e = tid & 63, part = tid >> 6, per = (p.nbh + 7) / 8; int c = 0, bo = 0;
#pragma unroll 4
      for (int b = part * per; b < (part + 1) * per && b < p.nbh; ++b) { const int v = p.blkcnt[(p.blk0 + b) * 64 + e]; if (p.blk0 + b < bid) bo += v; c += v; }
      PC[part * 64 + e] = c; PC[512 + part * 64 + e] = bo; }
    __syncthreads();
    if (tid < NE) { LAS int* PC = BOFF + 80; int c = 0, bo = 0;
#pragma unroll
        for (int q = 0; q < 8; ++q) { c += PC[q * 64 + tid]; bo += PC[512 + q * 64 + tid]; }
        CNT[tid] = c; BOFF[tid] = bo; }
    __syncthreads();
    if (tid == 0) { int s = 0; for (int e = 0; e < NE; ++e) { BASE[e] = s; s += (CNT[e] + BM - 1) / BM * BM; } BASE[NE] = s; CNT[NE] = p.nr; BASE[NE + 1] = s + p.nr;
        if (bid == 0) { for (int e = 0; e <= NEX; ++e) p.tilepre[e] = BASE[e] / BM; } }
    __syncthreads();
    if (bid >= p.blk0 && bid < p.blk0 + p.nbh) {
        const int rlo = p.r0 + (bid - p.blk0) * p.rpb;
        for (int i = tid; i < p.rpb * TOPK; i += NT) { const int r = rlo + i / TOPK, a = r * TOPK + i % TOPK, e = p.tope[a]; const int slot = BASE[e] + BOFF[e] + p.lrank[a];
            p.list[slot] = r; p.sdst[slot] = (r - p.r0) * SLOTS_PER_TOK + i % TOPK; p.sgate[slot] = p.gatev[a]; }
        for (int i = tid; i < p.rpb; i += NT) { const int r = rlo + i, slot = BASE[NE] + (r - p.r0); p.list[slot] = r; p.sdst[slot] = (r - p.r0) * SLOTS_PER_TOK + TOPK; p.sgate[slot] = 1.f; }
    }
    for (int e = bid; e < NE; e += nblk) { const int lo = BASE[e] + CNT[e], hi = BASE[e + 1]; for (int s = lo + tid; s < hi; s += NT) { p.list[s] = p.r0; p.sdst[s] = -1; p.sgate[s] = 0.f; } }
}
struct GroupOrder { int tpn, total, nN, G, c;
    __device__ void init(const int* tilepre, int nN_, int G_, int c_) { const int lane = threadIdx.x & 63;
        tpn = (int)__hip_atomic_load((const unsigned*)tilepre + lane + 1, __ATOMIC_RELAXED, __HIP_MEMORY_SCOPE_AGENT);
        total = (int)__hip_atomic_load((const unsigned*)tilepre + NEX, __ATOMIC_RELAXED, __HIP_MEMORY_SCOPE_AGENT); nN = nN_; G = G_; c = c_; }
    __device__ bool next(int i, Unit& u) const { const long L = (long)i * G + c; if (L >= (long)total * nN) return false;
        const int T = (int)(L / nN); const int e = __popcll(__ballot(tpn <= T));
        u.pm = T; u.pn = (int)(L % nN); u.e = __builtin_amdgcn_readfirstlane(e); return true; } };
struct EpiGU { static constexpr int NS = 16; bf16_t* act;
    __device__ __forceinline__ bool operator()(f32x4 (&acc)[2][2][4][2], const Unit& u, int wr, int wc, int fr, int fq) const {
        MK_FRAG_LOOP(r, c) { const f32x4 a = acc[ai][bj][m][0] * (1.f / (FP8_SU * FP8_SW)), b = acc[ai][bj][m][1] * (1.f / (FP8_SU * FP8_SW));
            *(unsigned*)((unsigned char*)act + (size_t)(u.pm * BM + r) * EF + ((u.pn * BM + c) >> 1)) =
                pack4_fp8(fast_silu(a[0]) * a[1] * FP8_SA, fast_silu(a[2]) * a[3] * FP8_SA, fast_silu(b[0]) * b[1] * FP8_SA, fast_silu(b[2]) * b[3] * FP8_SA); }
        return false; } };
struct EpiDown { const int* sdst; const float* sgate; bf16_t* rowsb; LAS unsigned char* lds;
    __device__ __forceinline__ void unit_begin(const Unit& u, LAS unsigned char* l) const {
        const int wid = __builtin_amdgcn_readfirstlane(threadIdx.x >> 6), lane = threadIdx.x & 63, w4 = wid & 3;
        const unsigned* src = (wid < 4 ? (const unsigned*)sdst : (const unsigned*)sgate) + (size_t)u.pm * BM + w4 * 64 + lane;
        __builtin_amdgcn_global_load_lds(src, (LAS unsigned*)(l + STAGE_BYTES + (wid < 4 ? 0 : 1024) + w4 * 256), 4, 0, 0); }
    __device__ __forceinline__ bool operator()(f32x4 (&acc)[2][2][4][2], const Unit& u, int wr, int wc, int fr, int fq) const {
        int dst[8]; float gt[8];
        const LAS int* LD = (const LAS int*)(lds + STAGE_BYTES); const LAS float* LG = (const LAS float*)(lds + STAGE_BYTES + 1024);
#pragma unroll
        for (int q = 0; q < 8; ++q) { const int sl = (q >> 2) * HALF + wr * 64 + (q & 3) * 16 + fr; dst[q] = LD[sl]; gt[q] = LG[sl]; }
#pragma unroll
        for (int ai = 0; ai < 2; ++ai)
#pragma unroll
            for (int m = 0; m < 4; ++m) { const int q = ai * 4 + m; const int dq = dst[q]; if (dq >= 0) {
#pragma unroll
                for (int bj = 0; bj < 2; ++bj) { f32x4 a = acc[ai][bj][m][0], b = acc[ai][bj][m][1];
#pragma unroll
                    for (int j = 0; j < 4; ++j) { a[j] *= gt[q] * (FP8_SR / (FP8_SA * FP8_SWD)); b[j] *= gt[q] * (FP8_SR / (FP8_SA * FP8_SWD)); }
                    u32x2 w8; w8.x = pack4_fp8(a[0], a[1], a[2], a[3]); w8.y = pack4_fp8(b[0], b[1], b[2], b[3]);
                    *(u32x2*)((unsigned char*)rowsb + (size_t)dq * D + u.pn * BM + bj * HALF + wc * 32 + 8 * fq) = w8; } } }
        return false; } };
__device__ __forceinline__ void final_rows(LAS float* sm  , const In& in, const float* modpart, const bf16_t* rowsb, float* h1out, int b0, int r0, int row_lo, int row_hi, bool dry = false) {
    const int tid = threadIdx.x, lane = tid & 63, wid = tid >> 6;
    const int mr = b0 + row_lo / SEQ;
    __syncthreads();
    for (int j = tid; j < D; j += NT) sm[j] = mod_value(in, modpart, mr, 5 * D + j);
    __syncthreads();
    float gq[16];
#pragma unroll
    for (int j = 0; j < 4; ++j)
#pragma unroll
        for (int q = 0; q < 4; ++q) gq[4 * j + q] = sm[j * 256 + lane * 4 + q] * in.norm_g[3 * D + j * 256 + lane * 4 + q];
    unsigned raw[SLOTS_PER_TOK][4]; f32x4 hraw[4];
    auto fetch = [&](int r) __attribute__((always_inline)) {
        const unsigned char* rb = (const unsigned char*)rowsb + (size_t)(r - r0) * SLOTS_PER_TOK * D; const float* hp = h1out + (size_t)r * D;
#pragma unroll
        for (int s = 0; s < SLOTS_PER_TOK; ++s)
#pragma unroll
            for (int j = 0; j < 4; ++j) raw[s][j] = *(const unsigned*)(rb + (size_t)s * D + j * 256 + lane * 4);
#pragma unroll
        for (int j = 0; j < 4; ++j) hraw[j] = *(const f32x4*)(hp + j * 256 + lane * 4); };
    if (row_lo + wid < row_hi) fetch(row_lo + wid);
    for (int r = row_lo + wid; r < row_hi; r += NT / 64) {
        float v[16];
#pragma unroll
        for (int j = 0; j < 16; ++j) v[j] = 0.f;
#pragma unroll
        for (int s = 0; s < SLOTS_PER_TOK; ++s)
#pragma unroll
            for (int j = 0; j < 4; ++j) { const int w = (int)raw[s][j]; const f32x2 lo = __builtin_amdgcn_cvt_pk_f32_fp8(w, false), hi = __builtin_amdgcn_cvt_pk_f32_fp8(w, true); v[4 * j] += lo.x; v[4 * j + 1] += lo.y; v[4 * j + 2] += hi.x; v[4 * j + 3] += hi.y; }
#pragma unroll
        for (int j = 0; j < 16; ++j) v[j] *= (1.f / FP8_SR);
        f32x4 hcur[4];
#pragma unroll
        for (int j = 0; j < 4; ++j) hcur[j] = hraw[j];
        if (r + NT / 64 < row_hi) fetch(r + NT / 64);
        float ss = 0.f;
#pragma unroll
        for (int j = 0; j < 16; ++j) ss += v[j] * v[j];
        ss = wave_sum64(ss);
        const float rinv = __builtin_amdgcn_rsqf(ss * (1.f / D) + NORM_EPS);
        float* hp = h1out + (size_t)r * D;
#pragma unroll
        for (int j = 0; j < 4; ++j) { const int c = j * 256 + lane * 4; f32x4 hv = hcur[j];
#pragma unroll
            for (int q = 0; q < 4; ++q) hv[q] += gq[4 * j + q] * (v[4 * j + q] * rinv);
            if (!dry) *(f32x4*)(hp + c) = hv; else if (hv[0] == 1.2345e30f) *(f32x4*)(hp + c) = hv; }
    }
}
__device__ __forceinline__ void rwt_prep(const In& in, bf16_t* rwt, int bid, int nblk) {
    for (int i = bid * NT + threadIdx.x; i < NE * D; i += nblk * NT) { const int e = i / D, k = i % D; const float w = in.router_w[(size_t)k * NE + e]; const bf16_t h = f2bf(w); rwt[i] = h; rwt[(size_t)NE * D + i] = f2bf(w - bf2f(h)); }
}
}

using namespace mk;
constexpr size_t MiB = (size_t)1 << 20;
constexpr int NLAT = NB * SEQ, NCTXR = NB * CTX, NALL = NLAT + NCTXR, NRH = NLAT / 2, MAXSLOTS = NRH * SLOTS_PER_TOK + NE * BM;
constexpr size_t O_W1A = 0, O_W1C = O_W1A + (size_t)Z1_N * D * 2, O_WG = O_W1C + (size_t)ZC_N * D * 2, O_WBR = O_WG + (size_t)RW * AG_K * 2, O_WOUT = O_WBR + (size_t)2 * D * RW * 2,
                 O_RWT = O_WOUT + (size_t)D * D * 2, O_MODP = O_RWT + (size_t)2 * NE * D * 2, O_S_END = O_MODP + (size_t)MOD_SL * (NB + 1) * 6 * D * 4;
static_assert(O_S_END <= 27 * MiB, "S region");
constexpr size_t O_BAR = 27 * MiB;
constexpr size_t O_Z1 = 28 * MiB, O_R2 = O_Z1 + (size_t)NALL * Z1_N * 2;
static_assert(O_R2 == 334 * MiB, "z1 size");
constexpr size_t O_HD = O_R2, O_BON = O_HD + (size_t)2 * NLAT * LW * 2, O_AG = O_BON + (size_t)2 * NLAT * NH * 4, O_R2_END = O_AG + (size_t)NLAT * AG_K * 2;
static_assert(O_R2_END <= 512 * MiB, "R2");
constexpr size_t O_XNL = O_Z1, O_YB = O_XNL + (size_t)NLAT * D * 2, O_GATES = O_YB + (size_t)NLAT * LW * 2, O_MIXED = O_HD;
static_assert(O_GATES + (size_t)NLAT * 2 * D * 2 <= O_R2, "late R1");
constexpr size_t O_U = O_Z1, O_WGU = O_U + (size_t)NLAT * D * 2, O_WDN = O_WGU + (size_t)NEX * 2 * EF * D * 2, O_ROUT = O_WDN + (size_t)NEX * D * EF * 2;
constexpr size_t O_TOPE = O_ROUT, O_LRANK = O_TOPE + (size_t)NLAT * TOPK * 4, O_GATEV = O_LRANK + (size_t)NLAT * TOPK * 4, O_BLKCNT = O_GATEV + (size_t)NLAT * TOPK * 4, O_TILEPRE = O_BLKCNT + 256 * 64 * 4,
                 O_LIST = O_TILEPRE + 2048, O_SDST = O_LIST + (size_t)2 * MAXSLOTS * 4, O_SGATE = O_SDST + (size_t)2 * MAXSLOTS * 4, O_ACT = ((O_SGATE + (size_t)2 * MAXSLOTS * 4 + 255) / 256) * 256,
                 O_ROWSB = ((O_ACT + (size_t)MAXSLOTS * EF * 2 + 255) / 256) * 256, O_END = O_ROWSB + ((size_t)NRH * SLOTS_PER_TOK + 1) * D * 2;
static_assert(O_END <= 512 * MiB, "workspace");
constexpr size_t O_U8 = O_WGU + (size_t)NEX * 2 * EF * D;
static_assert(O_U8 + (size_t)NLAT * D <= O_WDN, "u8");
static_assert(O_WGU >= O_YB && O_ROWSB >= O_GATES, "late layout");

struct MP { In in; float* out; unsigned char* ws; long ph_lo, ph_hi; };
constexpr int NPHASE = 16;

#if defined(__HIP_DEVICE_COMPILE__)
#define MK_KARGS auto Pq_ = Pk_; asm volatile("" : "+s"(Pq_)); const MP* Pg_ = (const MP*)Pq_; const In in = Pg_->in; unsigned char* ws = Pg_->ws; float* out_ = Pg_->out; (void)out_;
#else
#define MK_KARGS const In in = P.in; unsigned char* ws = P.ws; float* out_ = P.out; (void)out_; (void)Pk_;
#endif
#define MK_PHASE_PTRS \
    MK_KARGS \
    bf16_t *W1a = (bf16_t*)(ws + O_W1A), *W1c = (bf16_t*)(ws + O_W1C), *Wg = (bf16_t*)(ws + O_WG), *Wbr = (bf16_t*)(ws + O_WBR), *Wout = (bf16_t*)(ws + O_WOUT), *rwt = (bf16_t*)(ws + O_RWT); \
    float* modpart = (float*)(ws + O_MODP); \
    bf16_t *z1 = (bf16_t*)(ws + O_Z1), *Hd = (bf16_t*)(ws + O_HD), *Ag = (bf16_t*)(ws + O_AG); float* bon = (float*)(ws + O_BON); \
    bf16_t *xnl = (bf16_t*)(ws + O_XNL), *yb = (bf16_t*)(ws + O_YB), *gates = (bf16_t*)(ws + O_GATES), *mixed = (bf16_t*)(ws + O_MIXED); \
    unsigned char* u8 = ws + O_U8; \
    bf16_t *u = (bf16_t*)(ws + O_U), *Wgu = (bf16_t*)(ws + O_WGU), *Wdn = (bf16_t*)(ws + O_WDN), *act = (bf16_t*)(ws + O_ACT), *rowsb = (bf16_t*)(ws + O_ROWSB); \
    int *tope = (int*)(ws + O_TOPE), *lrank = (int*)(ws + O_LRANK), *blkcnt = (int*)(ws + O_BLKCNT), *tilepre = (int*)(ws + O_TILEPRE), *list = (int*)(ws + O_LIST), *sdst = (int*)(ws + O_SDST); \
    float *gatev = (float*)(ws + O_GATEV), *sgate = (float*)(ws + O_SGATE); \
    bf16_t* xn_all = (bf16_t*)out_; \
    bf16_t* Y = (bf16_t*)out_; \
    float* y2h1 = out_;
__device__ __forceinline__ void stagger_start(int bid, int ticks  ) {
    const int grp = (bid >> 3) & 3;
    if (grp) { const unsigned long long t0 = __builtin_amdgcn_s_memrealtime(); while (__builtin_amdgcn_s_memrealtime() - t0 < (unsigned long long)(grp * ticks)) __builtin_amdgcn_s_sleep(8); }
    __builtin_amdgcn_s_waitcnt(0xC07F);
}

__global__ void __launch_bounds__(512, 2) mega(MP P) {
    extern __shared__ __attribute__((aligned(16))) unsigned char shm[];
    LAS unsigned char* lds = (LAS unsigned char*)shm;
    typedef const __attribute__((address_space(4))) MP* KargP;
    const KargP Pk_ = (KargP)__builtin_amdgcn_kernarg_segment_ptr();
    const int bid = blockIdx.x, nblk = gridDim.x;
    const int gbid = (nblk & 7) ? bid : (bid & 7) * (nblk >> 3) + (bid >> 3);
    const int ph_lo = (int)P.ph_lo, ph_hi = (int)P.ph_hi;
    volatile LAS unsigned* xst = (volatile LAS unsigned*)(lds + LDS_BYTES - 16);
    if (threadIdx.x == 0) { xst[0] = 0u; xst[1] = 0u; }
    __syncthreads();
    const XcdBarrier xb = xcd_barrier_post((unsigned*)(P.ws + O_BAR), xst);
    if (0 >= ph_lo && 0 < ph_hi) { if (0 > ph_lo) xcd_barrier(xb); const int ph = 0; (void)ph; MK_PHASE_PTRS
        { LAS float* tile = (LAS float*)lds; int base = 0;
            convT_job<true>(tile, in.w_in, INC, D, W1a, D, Z1_N, CMapZ1{}, bid, nblk, base, 256.f);
            convT_job(tile, in.w_in, INC, D, W1c, D, ZC_N, CMapZC{}, bid, nblk, base);
            convT_job(tile, in.rw_g_up, RW, GL, Wg, AG_K, RW, CMapId{}, bid, nblk, base);
            convT_job(tile, in.w_branch_a, D, RW, Wbr, RW, D, CMapId{}, bid, nblk, base);
            convT_job(tile, in.w_branch_b, D, LW, Wbr + (size_t)D * RW, LW, D, CMapId{}, bid, nblk, base);
            convT_job(tile, in.w_out, D, D, Wout, D, D, CMapId{}, bid, nblk, base);
            rwt_prep(in, rwt, bid, nblk);
            mod_partials((LAS float*)lds, in, modpart, bid, nblk); }
    }
    if (1 >= ph_lo && 1 < ph_hi) { if (1 > ph_lo) xcd_barrier(xb); const int ph = 1; (void)ph; MK_PHASE_PTRS
        { const int L = NLAT / nblk, Lc = NCTXR / nblk;
            xn_rows<true>((LAS float*)lds, in, modpart, xn_all, 0, NB, bid * L, (bid + 1) * L);
            xn_rows<true>((LAS float*)lds, in, modpart, xn_all, 0, NB, NLAT + bid * Lc, NLAT + (bid + 1) * Lc); }
    }
    if (2 >= ph_lo && 2 < ph_hi) { if (2 > ph_lo) xcd_barrier(xb); const int ph = 2; (void)ph; MK_PHASE_PTRS
        { GemmP g{xn_all, xn_all, W1a, 0, nullptr, D / 2, 0}; StaticOrder S; S.init(NALL, Z1_N, nblk, bid); gemm_phase<false, true>(lds, g, S, EpiStoreBf16S{z1, Z1_N, 1.f / 4096.f, 0}); }
    }
    if (3 >= ph_lo && 3 < ph_hi) { if (3 > ph_lo) xcd_barrier(xb); const int ph = 3; (void)ph; MK_PHASE_PTRS
        { LruP lp{z1, Hd, 0, NB}; lru_phase(lds, in, lp, bid, nblk); __syncthreads();
                  RwkvP rp{z1, Y, bon, 0, NB}; r3::rwkv_phase3(lds, in, rp, bid, nblk); }
    }
    if (4 >= ph_lo && 4 < ph_hi) { if (4 > ph_lo) xcd_barrier(xb); const int ph = 4; (void)ph; MK_PHASE_PTRS
        { const int L = NLAT / nblk; PostP pp{z1, Y, bon, Ag, NLAT, 0}; rwkv_post_rows((LAS float*)lds, in, pp, bid * L, (bid + 1) * L); }
    }
    if (5 >= ph_lo && 5 < ph_hi) { if (5 > ph_lo) xcd_barrier(xb); const int ph = 5; (void)ph; MK_PHASE_PTRS
        { const int L = NLAT / nblk;
            if (bid & 1) { xn_rows((LAS float*)lds, in, modpart, xnl, 0, NB, bid * L, (bid + 1) * L); __syncthreads(); }
            { GemmP g{Ag, Ag, Wg, 0, nullptr, AG_K, 0}; StaticOrder S; S.init(NLAT, RW, nblk, bid); gemm_phase(lds, g, S, EpiYa{Y, Y + (size_t)NLAT * RW}); }
            if (!(bid & 1)) { __syncthreads(); xn_rows((LAS float*)lds, in, modpart, xnl, 0, NB, bid * L, (bid + 1) * L); } }
    }
    if (6 >= ph_lo && 6 < ph_hi) { if (6 > ph_lo) xcd_barrier(xb); const int ph = 6; (void)ph; MK_PHASE_PTRS
        { GemmP g{xnl, xnl, W1c, 0, nullptr, D, 0}; StaticOrder S; S.init(NLAT, ZC_N, nblk, bid); gemm_phase(lds, g, S, EpiZc{Hd, yb, gates, NLAT, 0}); }
    }
    if (7 >= ph_lo && 7 < ph_hi) { if (7 > ph_lo) xcd_barrier(xb); const int ph = 7; (void)ph; MK_PHASE_PTRS
        { GemmP g{Y + (size_t)NLAT * RW, yb, Wbr, (long)D * RW, nullptr, D, 0}; PairOrder S; S.S.init(NLAT, D, nblk, bid); gemm_phase(lds, g, S, EpiBranch{gates, mixed}); }
    }
    if (8 >= ph_lo && 8 < ph_hi) { if (8 > ph_lo) xcd_barrier(xb); const int ph = 8; (void)ph; MK_PHASE_PTRS
        { LAS float* tile = (LAS float*)lds;
            struct MGU { const float* ex; const float* sh; unsigned char* d; __device__ const float* src(int m) const { return m < NE ? ex + (size_t)m * D * 2 * EF : sh; } __device__ unsigned char* dst(int m) const { return d + (size_t)m * 2 * EF * D; } };
            struct MDN { const float* ex; const float* sh; unsigned char* d; __device__ const float* src(int m) const { return m < NE ? ex + (size_t)m * EF * D : sh; } __device__ unsigned char* dst(int m) const { return d + (size_t)m * D * EF; } };
            auto conv = [&]() __attribute__((always_inline)) {
                convT_multi<true>(tile, MGU{in.ex_w_gu, in.sh_w_gu, (unsigned char*)Wgu}, NEX, 2 * EF, D, D, 2 * EF, CMapGU{EF}, bid, nblk, FP8_SW);
                convT_multi<true>(tile, MDN{in.ex_w_down, in.sh_w_down, (unsigned char*)Wdn}, NEX, D, EF, EF, D, CMapId{}, bid, nblk, FP8_SWD); };
            if (bid & 1) { conv(); __syncthreads(); }
            { GemmP g{mixed, mixed, Wout, 0, nullptr, D, 0}; StaticOrder S; S.init(NLAT, D, nblk, bid); gemm_phase(lds, g, S, EpiStoreBf16{u, D}); }
            if (!(bid & 1)) { __syncthreads(); conv(); } }
    }
    if (9 >= ph_lo && 9 < ph_hi) { if (9 > ph_lo) xcd_barrier(xb); const int ph = 9; (void)ph; MK_PHASE_PTRS
        { const int L = NLAT / nblk; RowP rp{y2h1, u, u8, modpart, rwt, tope, gatev, lrank, blkcnt, 0, NLAT}; row_pass(lds, in, rp, bid * L, (bid + 1) * L); }
    }
    if (10 >= ph_lo && 10 < ph_hi) { if (10 > ph_lo) xcd_barrier(xb); const int ph = 10; (void)ph; MK_PHASE_PTRS
        { const int q = ph - 10, half = q >= 4 ? 1 : 0, st = q - 4 * half;
            const int rpb = NLAT / nblk;
            auto assign = [&](int hf) { MoeP mp{tope, gatev, lrank, blkcnt, tilepre + hf * 256, list + (size_t)hf * MAXSLOTS, sdst + (size_t)hf * MAXSLOTS, sgate + (size_t)hf * MAXSLOTS, hf * NRH, NRH, hf * (nblk / 2), nblk / 2, rpb, 0}; moe_assign(lds, mp, bid, nblk); };
            auto fin = [&](int hf) { const int L = NRH / nblk, r0 = hf * NRH; final_rows((LAS float*)lds, in, modpart, rowsb, y2h1, 0, r0, r0 + bid * L, r0 + (bid + 1) * L); };
            if (ph == 10) { assign(0); __syncthreads(); assign(1); }
            else if (ph == 11 || ph == 13) { const int hf = ph == 13 ? 1 : 0;
                if (ph == 13 && (bid & 1)) { fin(0); __syncthreads(); }
                { GemmP g{(const bf16_t*)u8, (const bf16_t*)u8, Wgu, (long)EF * D, list + (size_t)hf * MAXSLOTS, D / 2, 0}; GroupOrder S; S.init(tilepre + hf * 256, 2 * EF / BM, nblk, gbid); gemm_phase<true, true>(lds, g, S, EpiGU{act}); }
                if (ph == 13 && !(bid & 1)) { __syncthreads(); fin(0); } }
            else if (ph == 12 || ph == 14) { const int hf = ph == 14 ? 1 : 0;
                GemmP g{act, act, Wdn, (long)D * EF / 2, nullptr, EF / 2, 0}; GroupOrder S; S.init(tilepre + hf * 256, D / BM, nblk, gbid); gemm_phase<false, true>(lds, g, S, EpiDown{sdst + (size_t)hf * MAXSLOTS, sgate + (size_t)hf * MAXSLOTS, rowsb, lds}); }
            else if (ph == 15) fin(1);
            (void)half; (void)st; }
    }
    if (11 >= ph_lo && 11 < ph_hi) { if (11 > ph_lo) xcd_barrier(xb); const int ph = 11; (void)ph; MK_PHASE_PTRS
        { const int q = ph - 10, half = q >= 4 ? 1 : 0, st = q - 4 * half;
            const int rpb = NLAT / nblk;
            auto assign = [&](int hf) { MoeP mp{tope, gatev, lrank, blkcnt, tilepre + hf * 256, list + (size_t)hf * MAXSLOTS, sdst + (size_t)hf * MAXSLOTS, sgate + (size_t)hf * MAXSLOTS, hf * NRH, NRH, hf * (nblk / 2), nblk / 2, rpb, 0}; moe_assign(lds, mp, bid, nblk); };
            auto fin = [&](int hf) { const int L = NRH / nblk, r0 = hf * NRH; final_rows((LAS float*)lds, in, modpart, rowsb, y2h1, 0, r0, r0 + bid * L, r0 + (bid + 1) * L); };
            if (ph == 10) { assign(0); __syncthreads(); assign(1); }
            else if (ph == 11 || ph == 13) { const int hf = ph == 13 ? 1 : 0;
                if (ph == 13 && (bid & 1)) { fin(0); __syncthreads(); }
                { GemmP g{(const bf16_t*)u8, (const bf16_t*)u8, Wgu, (long)EF * D, list + (size_t)hf * MAXSLOTS, D / 2, 0}; GroupOrder S; S.init(tilepre + hf * 256, 2 * EF / BM, nblk, gbid); gemm_phase<true, true>(lds, g, S, EpiGU{act}); }
                if (ph == 13 && !(bid & 1)) { __syncthreads(); fin(0); } }
            else if (ph == 12 || ph == 14) { const int hf = ph == 14 ? 1 : 0;
                GemmP g{act, act, Wdn, (long)D * EF / 2, nullptr, EF / 2, 0}; GroupOrder S; S.init(tilepre + hf * 256, D / BM, nblk, gbid); gemm_phase<false, true>(lds, g, S, EpiDown{sdst + (size_t)hf * MAXSLOTS, sgate + (size_t)hf * MAXSLOTS, rowsb, lds}); }
            else if (ph == 15) fin(1);
            (void)half; (void)st; }
    }
    if (12 >= ph_lo && 12 < ph_hi) { if (12 > ph_lo) xcd_barrier(xb); const int ph = 12; (void)ph; MK_PHASE_PTRS
        { const int q = ph - 10, half = q >= 4 ? 1 : 0, st = q - 4 * half;
            const int rpb = NLAT / nblk;
            auto assign = [&](int hf) { MoeP mp{tope, gatev, lrank, blkcnt, tilepre + hf * 256, list + (size_t)hf * MAXSLOTS, sdst + (size_t)hf * MAXSLOTS, sgate + (size_t)hf * MAXSLOTS, hf * NRH, NRH, hf * (nblk / 2), nblk / 2, rpb, 0}; moe_assign(lds, mp, bid, nblk); };
            auto fin = [&](int hf) { const int L = NRH / nblk, r0 = hf * NRH; final_rows((LAS float*)lds, in, modpart, rowsb, y2h1, 0, r0, r0 + bid * L, r0 + (bid + 1) * L); };
            if (ph == 10) { assign(0); __syncthreads(); assign(1); }
            else if (ph == 11 || ph == 13) { const int hf = ph == 13 ? 1 : 0;
                if (ph == 13 && (bid & 1)) { fin(0); __syncthreads(); }
                { GemmP g{(const bf16_t*)u8, (const bf16_t*)u8, Wgu, (long)EF * D, list + (size_t)hf * MAXSLOTS, D / 2, 0}; GroupOrder S; S.init(tilepre + hf * 256, 2 * EF / BM, nblk, gbid); gemm_phase<true, true>(lds, g, S, EpiGU{act}); }
                if (ph == 13 && !(bid & 1)) { __syncthreads(); fin(0); } }
            else if (ph == 12 || ph == 14) { const int hf = ph == 14 ? 1 : 0;
                GemmP g{act, act, Wdn, (long)D * EF / 2, nullptr, EF / 2, 0}; GroupOrder S; S.init(tilepre + hf * 256, D / BM, nblk, gbid); gemm_phase<false, true>(lds, g, S, EpiDown{sdst + (size_t)hf * MAXSLOTS, sgate + (size_t)hf * MAXSLOTS, rowsb, lds}); }
            else if (ph == 15) fin(1);
            (void)half; (void)st; }
    }
    if (13 >= ph_lo && 13 < ph_hi) { if (13 > ph_lo) xcd_barrier(xb); const int ph = 13; (void)ph; MK_PHASE_PTRS
        { const int q = ph - 10, half = q >= 4 ? 1 : 0, st = q - 4 * half;
            const int rpb = NLAT / nblk;
            auto assign = [&](int hf) { MoeP mp{tope, gatev, lrank, blkcnt, tilepre + hf * 256, list + (size_t)hf * MAXSLOTS, sdst + (size_t)hf * MAXSLOTS, sgate + (size_t)hf * MAXSLOTS, hf * NRH, NRH, hf * (nblk / 2), nblk / 2, rpb, 0}; moe_assign(lds, mp, bid, nblk); };
            auto fin = [&](int hf) { const int L = NRH / nblk, r0 = hf * NRH; final_rows((LAS float*)lds, in, modpart, rowsb, y2h1, 0, r0, r0 + bid * L, r0 + (bid + 1) * L); };
            if (ph == 10) { assign(0); __syncthreads(); assign(1); }
            else if (ph == 11 || ph == 13) { const int hf = ph == 13 ? 1 : 0;
                if (ph == 13 && (bid & 1)) { fin(0); __syncthreads(); }
                { GemmP g{(const bf16_t*)u8, (const bf16_t*)u8, Wgu, (long)EF * D, list + (size_t)hf * MAXSLOTS, D / 2, 0}; GroupOrder S; S.init(tilepre + hf * 256, 2 * EF / BM, nblk, gbid); gemm_phase<true, true>(lds, g, S, EpiGU{act}); }
                if (ph == 13 && !(bid & 1)) { __syncthreads(); fin(0); } }
            else if (ph == 12 || ph == 14) { const int hf = ph == 14 ? 1 : 0;
                GemmP g{act, act, Wdn, (long)D * EF / 2, nullptr, EF / 2, 0}; GroupOrder S; S.init(tilepre + hf * 256, D / BM, nblk, gbid); gemm_phase<false, true>(lds, g, S, EpiDown{sdst + (size_t)hf * MAXSLOTS, sgate + (size_t)hf * MAXSLOTS, rowsb, lds}); }
            else if (ph == 15) fin(1);
            (void)half; (void)st; }
    }
    if (14 >= ph_lo && 14 < ph_hi) { if (14 > ph_lo) xcd_barrier(xb); const int ph = 14; (void)ph; MK_PHASE_PTRS
        { const int q = ph - 10, half = q >= 4 ? 1 : 0, st = q - 4 * half;
            const int rpb = NLAT / nblk;
            auto assign = [&](int hf) { MoeP mp{tope, gatev, lrank, blkcnt, tilepre + hf * 256, list + (size_t)hf * MAXSLOTS, sdst + (size_t)hf * MAXSLOTS, sgate + (size_t)hf * MAXSLOTS, hf * NRH, NRH, hf * (nblk / 2), nblk / 2, rpb, 0}; moe_assign(lds, mp, bid, nblk); };
            auto fin = [&](int hf) { const int L = NRH / nblk, r0 = hf * NRH; final_rows((LAS float*)lds, in, modpart, rowsb, y2h1, 0, r0, r0 + bid * L, r0 + (bid + 1) * L); };
            if (ph == 10) { assign(0); __syncthreads(); assign(1); }
            else if (ph == 11 || ph == 13) { const int hf = ph == 13 ? 1 : 0;
                if (ph == 13 && (bid & 1)) { fin(0); __syncthreads(); }
                { GemmP g{(const bf16_t*)u8, (const bf16_t*)u8, Wgu, (long)EF * D, list + (size_t)hf * MAXSLOTS, D / 2, 0}; GroupOrder S; S.init(tilepre + hf * 256, 2 * EF / BM, nblk, gbid); gemm_phase<true, true>(lds, g, S, EpiGU{act}); }
                if (ph == 13 && !(bid & 1)) { __syncthreads(); fin(0); } }
            else if (ph == 12 || ph == 14) { const int hf = ph == 14 ? 1 : 0;
                GemmP g{act, act, Wdn, (long)D * EF / 2, nullptr, EF / 2, 0}; GroupOrder S; S.init(tilepre + hf * 256, D / BM, nblk, gbid); gemm_phase<false, true>(lds, g, S, EpiDown{sdst + (size_t)hf * MAXSLOTS, sgate + (size_t)hf * MAXSLOTS, rowsb, lds}); }
            else if (ph == 15) fin(1);
            (void)half; (void)st; }
    }
    if (15 >= ph_lo && 15 < ph_hi) { if (15 > ph_lo) xcd_barrier(xb); const int ph = 15; (void)ph; MK_PHASE_PTRS
        { const int q = ph - 10, half = q >= 4 ? 1 : 0, st = q - 4 * half;
            const int rpb = NLAT / nblk;
            auto assign = [&](int hf) { MoeP mp{tope, gatev, lrank, blkcnt, tilepre + hf * 256, list + (size_t)hf * MAXSLOTS, sdst + (size_t)hf * MAXSLOTS, sgate + (size_t)hf * MAXSLOTS, hf * NRH, NRH, hf * (nblk / 2), nblk / 2, rpb, 0}; moe_assign(lds, mp, bid, nblk); };
            auto fin = [&](int hf) { const int L = NRH / nblk, r0 = hf * NRH; final_rows((LAS float*)lds, in, modpart, rowsb, y2h1, 0, r0, r0 + bid * L, r0 + (bid + 1) * L); };
            if (ph == 10) { assign(0); __syncthreads(); assign(1); }
            else if (ph == 11 || ph == 13) { const int hf = ph == 13 ? 1 : 0;
                if (ph == 13 && (bid & 1)) { fin(0); __syncthreads(); }
                { GemmP g{(const bf16_t*)u8, (const bf16_t*)u8, Wgu, (long)EF * D, list + (size_t)hf * MAXSLOTS, D / 2, 0}; GroupOrder S; S.init(tilepre + hf * 256, 2 * EF / BM, nblk, gbid); gemm_phase<true, true>(lds, g, S, EpiGU{act}); }
                if (ph == 13 && !(bid & 1)) { __syncthreads(); fin(0); } }
            else if (ph == 12 || ph == 14) { const int hf = ph == 14 ? 1 : 0;
                GemmP g{act, act, Wdn, (long)D * EF / 2, nullptr, EF / 2, 0}; GroupOrder S; S.init(tilepre + hf * 256, D / BM, nblk, gbid); gemm_phase<false, true>(lds, g, S, EpiDown{sdst + (size_t)hf * MAXSLOTS, sgate + (size_t)hf * MAXSLOTS, rowsb, lds}); }
            else if (ph == 15) fin(1);
            (void)half; (void)st; }
    }
}
extern "C" void kernel_launch(void* const* d_in, const int* in_sizes, int n_in, void* d_out, int out_size, void* d_ws, size_t ws_size, hipStream_t stream) {
    static int grid = 0;
    if (grid == 0) {
        int dev = 0, cus = 0; hipGetDevice(&dev); hipDeviceGetAttribute(&cus, hipDeviceAttributeMultiprocessorCount, dev);
        hipFuncSetAttribute((const void*)mega, hipFuncAttributeMaxDynamicSharedMemorySize, LDS_BYTES);
        grid = cus;
        if (ws_size < O_END || grid != 256) fprintf(stderr, "kernel_launch: unexpected ws_size %zu (need %zu) or CU count %d\n", ws_size, (size_t)O_END, grid);
    }
    hipMemsetAsync((char*)d_ws + O_BAR, 0, XCD_BAR_WORDS * 4, stream);
    MP P; memset(&P, 0, sizeof(P));
    const float** f = (const float**)&P.in; for (int i = 0; i < 32; ++i) f[i] = (const float*)d_in[i];
    P.out = (float*)d_out; P.ws = (unsigned char*)d_ws;
#ifdef MK_PER_PHASE
    for (int ph = 0; ph < NPHASE; ++ph) { P.ph_lo = ph; P.ph_hi = ph + 1; hipLaunchKernelGGL(mega, dim3(grid), dim3(NT), LDS_BYTES, stream, P); }
#else
    P.ph_lo = 0; P.ph_hi = NPHASE;
    void* args[] = {&P};
    hipError_t e = hipLaunchCooperativeKernel((void*)mega, dim3(grid), dim3(NT), args, LDS_BYTES, stream);
    if (e != hipSuccess) fprintf(stderr, "cooperative launch failed: %s (grid %d)\n", hipGetErrorString(e), grid);
#endif
}
```

```cpp
#include <hip/hip_runtime.h>
#include <cstdio>
#include <cstring>
#define HD __host__ __device__ __forceinline__
static hipStream_t g_stream;

#ifdef SMALL
constexpr int D = 128, NB = 2, SEQ = 64, GW = 8, CTX = 16, RW = 128, RH = 64, DL = 16, AL = 16, GL = 24, LW = 128, LB = 2, NE = 8, TOPK = 3, NG = 4, TG = 2, EF = 32, SF = 32;
#else
constexpr int D = 1024, NB = 8, SEQ = 4096, GW = 64, CTX = 256, RW = 1024, RH = 64, DL = 64, AL = 64, GL = 160, LW = 1024, LB = 16, NE = 64, TOPK = 6, NG = 8, TG = 4, EF = 256, SF = 256;
#endif
constexpr int NH = RW / RH, LBS = LW / LB, ROWS = SEQ / GW, TA = CTX + SEQ;
constexpr int OFF_R = 0, OFF_K = RW, OFF_V = 2 * RW, OFF_WD = 3 * RW, OFF_AD = OFF_WD + 2 * DL, OFF_GD = OFF_AD + 2 * AL, RC = OFF_GD + GL;
constexpr int OFF_LX = RC, OFF_LG = OFF_LX + LW, OFF_GATE = OFF_LG + LW, INC = OFF_GATE + 2 * D;
constexpr int EPG = NE / NG, NASG = SEQ * TOPK;
#define NORM_EPS 1e-6f
#define LNX_EPS 64e-5f

HD float sigmoidf_(float x) { return 1.f / (1.f + expf(-x)); }
HD float softplusf_(float x) { return x > 20.f ? x : log1pf(expf(x)); }
HD float siluf_(float x) { return x * sigmoidf_(x); }
HD float gelu_tanhf_(float x) { return 0.5f * x * (1.f + tanhf(0.7978845608028654f * (x + 0.044715f * x * x * x))); }

struct In {
    const float *x, *c, *ctx, *c_ctx, *w_mod, *b_mod, *norm_g, *w_in, *shift_mu, *rw_w0, *rw_w_up, *rw_a0, *rw_a_up, *rw_g_up, *rw_k_k, *rw_k_a, *rw_r_k, *rw_lnx,
        *lru_conv_w, *lru_conv_b, *lru_gate_w, *lru_gate_b, *lru_l, *w_branch_a, *w_branch_b, *w_out, *router_w, *router_b, *ex_w_gu, *ex_w_down, *sh_w_gu, *sh_w_down;
};


namespace mk {
#define LAS __attribute__((address_space(3)))
typedef unsigned short bf16_t;
typedef short bf16x8 __attribute__((ext_vector_type(8)));
typedef float f32x4 __attribute__((ext_vector_type(4)));
typedef float f32x2 __attribute__((ext_vector_type(2)));
typedef int i32x4 __attribute__((ext_vector_type(4)));
typedef int i32x8 __attribute__((ext_vector_type(8)));
typedef unsigned u32x4 __attribute__((ext_vector_type(4)));
typedef unsigned u32x2 __attribute__((ext_vector_type(2)));
constexpr int NT = 512;
constexpr int BM = 256, BK = 64, HALF = 128, HTB = HALF * BK * 2, STAGE_BYTES = 8 * HTB;
constexpr int LDS_BYTES = 160 * 1024 - 1024;

constexpr int Z1_LX = 3584, Z1_N = 4608;
constexpr int ZC_N = 3072;

__device__ __forceinline__ unsigned cvt_pk_bf16(float lo, float hi) { unsigned r; asm volatile("s_nop 0\n\tv_cvt_pk_bf16_f32 %0, %1, %2" : "=v"(r) : "v"(lo), "v"(hi)); return r; }
__device__ __forceinline__ bf16_t f2bf(float f) { unsigned u = __float_as_uint(f); u += 0x7FFFu + ((u >> 16) & 1u); return (bf16_t)(u >> 16); }
__device__ __forceinline__ float bf2f(bf16_t b) { return __uint_as_float(((unsigned)b) << 16); }
__device__ __forceinline__ float bflo(unsigned w) { return __uint_as_float(w << 16); }
__device__ __forceinline__ float bfhi(unsigned w) { return __uint_as_float(w & 0xffff0000u); }

#define MK_DPPF(x, ctrl) __int_as_float(__builtin_amdgcn_update_dpp(__float_as_int(x), __float_as_int(x), ctrl, 0xF, 0xF, false))
__device__ __forceinline__ float wave_sum64(float x) {
    x += MK_DPPF(x, 0xB1); x += MK_DPPF(x, 0x4E); x += MK_DPPF(x, 0x141); x += MK_DPPF(x, 0x140);
    const int xi = __float_as_int(x);
    return (__int_as_float(__builtin_amdgcn_readlane(xi, 0)) + __int_as_float(__builtin_amdgcn_readlane(xi, 16))) + (__int_as_float(__builtin_amdgcn_readlane(xi, 32)) + __int_as_float(__builtin_amdgcn_readlane(xi, 48)));
}
__device__ __forceinline__ float wave_max64(float x) {
    x = fmaxf(x, MK_DPPF(x, 0xB1)); x = fmaxf(x, MK_DPPF(x, 0x4E)); x = fmaxf(x, MK_DPPF(x, 0x141)); x = fmaxf(x, MK_DPPF(x, 0x140));
    const int xi = __float_as_int(x);
    return fmaxf(fmaxf(__int_as_float(__builtin_amdgcn_readlane(xi, 0)), __int_as_float(__builtin_amdgcn_readlane(xi, 16))), fmaxf(__int_as_float(__builtin_amdgcn_readlane(xi, 32)), __int_as_float(__builtin_amdgcn_readlane(xi, 48))));
}
__device__ __forceinline__ float fast_rcp(float x) { return __builtin_amdgcn_rcpf(x); }
__device__ __forceinline__ float fast_sigmoid(float x) { return fast_rcp(1.f + __expf(-x)); }
__device__ __forceinline__ float fast_tanh(float x) { return 1.f - 2.f * fast_rcp(1.f + __expf(2.f * x)); }
__device__ __forceinline__ float fast_softplus(float x) { return x > 15.f ? x : __logf(1.f + __expf(x)); }
__device__ __forceinline__ float fast_silu(float x) { return x * fast_sigmoid(x); }
__device__ __forceinline__ float fast_gelu_tanh(float x) { return x * fast_sigmoid(1.5957691216057308f * (x + 0.044715f * x * x * x)); }
__device__ __forceinline__ int lds_byte(int r, int c) { const int st = (r >> 4) * 2 + (c >> 5), rr = r & 15, cc = c & 31, ob = rr * 64 + cc * 2; return st * 1024 + (ob ^ (((ob >> 9) & 1) << 5)); }
__device__ __forceinline__ void stage_rc(int b, int& R, int& C) { const int st = b / 1024, sb = b % 1024, swz = sb ^ (((sb >> 9) & 1) << 5); R = (st >> 1) * 16 + swz / 64; C = (st & 1) * 32 + (swz % 64) / 2; }
__device__ __forceinline__ int perm32(int rho) { const int n = rho >> 4, i = rho & 15; return 8 * (i >> 2) + 4 * n + (i & 3); }

struct Unit { int pm, pn, e; };
struct GemmP { const bf16_t* A0; const bf16_t* A1; const bf16_t* Bt; long strideB; const int* gather; int K; int pad_; };

struct StaticOrder {
    int nM, nN, nwg, G, c;
    __device__ void init(int M, int N, int G_, int c_) { nM = M / BM; nN = N / BM; nwg = nM * nN; G = G_; c = c_; }
    __device__ bool next(int i, Unit& u) const {
        const long L = (long)i * G + c; if (L >= nwg) return false;
        int wgid = (int)L; { const int q = nwg / 8, r = nwg % 8, xcd = wgid % 8, off = wgid / 8; wgid = (xcd < r ? xcd * (q + 1) : r * (q + 1) + (xcd - r) * q) + off; }
        const int nig = 8 * nN, gid = wgid / nig, fm = gid * 8, gsz = (nM - fm) < 8 ? (nM - fm) : 8;
        u.pm = fm + ((wgid % nig) % gsz); u.pn = (wgid % nig) / gsz; u.e = 0; return true;
    }
};

#define MK_FRAG_LOOP(ROW, COL) \
    _Pragma("unroll") for (int ai = 0; ai < 2; ++ai) _Pragma("unroll") for (int m = 0; m < 4; ++m) _Pragma("unroll") for (int bj = 0; bj < 2; ++bj) \
        if (const int ROW = ai * HALF + wr * 64 + m * 16 + fr; true) if (const int COL = bj * HALF + wc * 32 + 8 * fq; true)

template <class E, class = void> struct epi_has_begin { static constexpr bool value = false; };
template <class E> struct epi_has_begin<E, decltype((void)&E::unit_begin)> { static constexpr bool value = true; };
template <bool B> struct BoolC { static constexpr bool value = B; };
template <class E, class = void> struct epi_ns { static constexpr int value = 0; };
template <class E> struct epi_ns<E, decltype((void)E::NS)> { static constexpr int value = 0 * E::NS; };
template <class E> __device__ __forceinline__ void epi_unit_begin(const E& e, const Unit& u, LAS unsigned char* lds) { if constexpr (epi_has_begin<E>::value) e.unit_begin(u, lds); }
template <bool GATHER = false, bool FP8 = false, class Epi, class Sched>
__device__ __forceinline__ void gemm_phase(LAS unsigned char* lds, const GemmP g, const Sched& S, const Epi& E) {
    const int tid = threadIdx.x, wid = __builtin_amdgcn_readfirstlane(tid >> 6), lane = tid & 63, wr = wid >> 2, wc = wid & 3, fr = lane & 15, fq = lane >> 4;
    int K = g.K; asm volatile("" : "+s"(K));
    const int nt = K / BK;
    int RA[2], CA[2]; unsigned voffB[2];
#pragma unroll
    for (int i = 0; i < 2; ++i) { int R, C; stage_rc(tid * 16 + i * 8192, R, C); RA[i] = R; CA[i] = C; const int Rb = (R & ~31) + perm32(R & 31); voffB[i] = (unsigned)(Rb * K + C) * 2u; }
    const size_t kstep = (size_t)(BK * 2), hstepB = (size_t)HALF * K * 2, tstepB = 2 * hstepB;
    const unsigned ldsw = (unsigned)wid * 1024u;
    const int aoff = lds_byte(wr * 64 + fr, fq * 8), boff = lds_byte(wc * 32 + fr, fq * 8);
#define MK_SA(b, h) (((b) * 2 + (h)) * HTB)
#define MK_SB(b, h) ((4 + (b) * 2 + (h)) * HTB)
#define MK_STAGE(bufoff, gbase, voff) do { _Pragma("unroll") for (int _i = 0; _i < 2; ++_i) \
        __builtin_amdgcn_global_load_lds((const unsigned*)((const char*)(gbase) + (voff)[_i]), (LAS unsigned*)(lds + (bufoff) + ldsw + _i * 8192), 16, 0, 0); } while (0)
#define MK_CAT8(x, y) __builtin_shufflevector(__builtin_bit_cast(i32x4, x), __builtin_bit_cast(i32x4, y), 0, 1, 2, 3, 4, 5, 6, 7)
#define MK_LDA(dst, b, h) do { _Pragma("unroll") for (int m = 0; m < 4; ++m) { if constexpr (FP8) dst##8[m] = MK_CAT8(*(const LAS bf16x8*)(lds + MK_SA(b, h) + aoff + m * 2048), *(const LAS bf16x8*)(lds + MK_SA(b, h) + aoff + m * 2048 + 1024)); \
        else { _Pragma("unroll") for (int k = 0; k < 2; ++k) dst[m][k] = *(const LAS bf16x8*)(lds + MK_SA(b, h) + aoff + m * 2048 + k * 1024); } } } while (0)
#define MK_LDB(dst, b, h) do { _Pragma("unroll") for (int n = 0; n < 2; ++n) { if constexpr (FP8) dst##8[n] = MK_CAT8(*(const LAS bf16x8*)(lds + MK_SB(b, h) + boff + n * 2048), *(const LAS bf16x8*)(lds + MK_SB(b, h) + boff + n * 2048 + 1024)); \
        else { _Pragma("unroll") for (int k = 0; k < 2; ++k) dst[n][k] = *(const LAS bf16x8*)(lds + MK_SB(b, h) + boff + n * 2048 + k * 1024); } } } while (0)
#define MK_MMA(ai, bj, At, Bt) do { __builtin_amdgcn_s_setprio(1); _Pragma("unroll") for (int m = 0; m < 4; ++m) _Pragma("unroll") for (int n = 0; n < 2; ++n) { \
        if constexpr (FP8) asm volatile("v_mfma_scale_f32_16x16x128_f8f6f4 %0, %1, %2, %0, %3, %3 op_sel_hi:[0,0,0]" : "+v"(acc[ai][bj][m][n]) : "v"(Bt##8[n]), "v"(At##8[m]), "v"(mx_one));   \
        else { _Pragma("unroll") for (int k = 0; k < 2; ++k) acc[ai][bj][m][n] = __builtin_amdgcn_mfma_f32_16x16x32_bf16(Bt[n][k], At[m][k], acc[ai][bj][m][n], 0, 0, 0); } } \
        __builtin_amdgcn_s_setprio(0); } while (0)
#define MK_WAIT_V(n) asm volatile("s_waitcnt vmcnt(" #n ")" ::: "memory")
#define MK_WAIT_L(n) asm volatile("s_waitcnt lgkmcnt(" #n ")" ::: "memory")
#define MK_BAR __builtin_amdgcn_s_barrier()
#define MK_SCHED __builtin_amdgcn_sched_barrier(0)
    Unit cur, nxt; int ui = 0;
    if (!S.next(0, cur)) return;
    f32x4 acc[2][2][4][2];
#pragma unroll
    for (int a = 0; a < 2; ++a)
#pragma unroll
        for (int b = 0; b < 2; ++b)
#pragma unroll
            for (int m = 0; m < 4; ++m)
#pragma unroll
                for (int n = 0; n < 2; ++n) acc[a][b][m][n] = (f32x4){0.f, 0.f, 0.f, 0.f};
    bf16x8 At[4][2], B0[2][2], B1[2][2];
    i32x8 At8[4], B08[2], B18[2];
    int mx_one = 0x7f7f7f7f; asm volatile("" : "+v"(mx_one));
    unsigned vA[2][2], vAn[2][2];
    const size_t hstepA = GATHER ? 0 : (size_t)HALF * K * 2, tstepA = 2 * (size_t)HALF * K * 2;
    auto a_voff = [&](const Unit& u, unsigned (&vo)[2][2]) {
#pragma unroll
        for (int h = 0; h < 2; ++h)
#pragma unroll
            for (int i = 0; i < 2; ++i) { if (GATHER) { const int row = u.pm * BM + h * HALF + RA[i]; vo[h][i] = (unsigned)((size_t)g.gather[row] * K + CA[i]) * 2u; } else vo[h][i] = (unsigned)(RA[i] * K + CA[i]) * 2u; }
    };
    a_voff(cur, vA);
    const LAS int* GLDS = (const LAS int*)(lds + STAGE_BYTES + 2048);
    auto a_voff_lds = [&](unsigned (&vo)[2][2]) {
#pragma unroll
        for (int h = 0; h < 2; ++h)
#pragma unroll
            for (int i = 0; i < 2; ++i) vo[h][i] = (unsigned)((size_t)GLDS[h * HALF + RA[i]] * K + CA[i]) * 2u;
    };
    auto a_base = [&](const Unit& u) { return (const char*)(u.e ? g.A1 : g.A0) + (GATHER ? (size_t)0 : (size_t)u.pm * tstepA); };
    const char* cA = a_base(cur);
    const char* cB = (const char*)g.Bt + ((size_t)cur.e * g.strideB) * 2 + (size_t)cur.pn * tstepB;
    MK_STAGE(MK_SB(0, 0), cB, voffB); MK_STAGE(MK_SA(0, 0), cA, vA[0]); MK_STAGE(MK_SB(0, 1), cB + hstepB, voffB); MK_STAGE(MK_SA(0, 1), cA + hstepA, vA[1]);
    if (wr == 1) MK_BAR;
    MK_WAIT_V(4); MK_BAR;
    MK_STAGE(MK_SB(1, 0), cB + kstep, voffB); MK_STAGE(MK_SA(1, 0), cA + kstep, vA[0]); MK_STAGE(MK_SB(1, 1), cB + hstepB + kstep, voffB);
    MK_WAIT_V(6); MK_BAR;
    for (;;) {
        epi_unit_begin(E, cur, lds);
        const bool has_next = S.next(ui + 1, nxt);
        if (GATHER && has_next && wid < 4) __builtin_amdgcn_global_load_lds((const unsigned*)g.gather + (size_t)nxt.pm * BM + wid * 64 + lane, (LAS unsigned*)(lds + STAGE_BYTES + 2048 + wid * 256), 4, 0, 0);
        const char* nA = has_next ? a_base(nxt) : cA;
        const char* nB = has_next ? (const char*)g.Bt + ((size_t)nxt.e * g.strideB) * 2 + (size_t)nxt.pn * tstepB : cB;
        for (int t = 0; t < nt; t += 2) {
            const bool last = (t == nt - 2);
            const int relax = (epi_ns<Epi>::value == 16 && t == 0) ? 1 : 0;
#define MK_WAIT_VR do { if constexpr (epi_ns<Epi>::value != 16) MK_WAIT_V(10); else asm volatile("v_cmp_ne_u32_e32 vcc, 0, %0\n\ts_nop 3\n\ts_cbranch_vccnz .Lwr%=\n\ts_waitcnt vmcnt(10)\n.Lwr%=:\n\ts_waitcnt vmcnt(26)" :: "v"(relax) : "vcc", "memory"); } while (0)
            if (GATHER && last) { if (has_next) a_voff_lds(vAn); else {
#pragma unroll
                for (int h = 0; h < 2; ++h)
#pragma unroll
                    for (int i = 0; i < 2; ++i) vAn[h][i] = vA[h][i]; } }
            const char* a1 = cA + (size_t)(t + 1) * kstep;
            const char* a2 = last ? nA : cA + (size_t)(t + 2) * kstep; const char* b2 = last ? nB : cB + (size_t)(t + 2) * kstep;
            const char* a3 = a2 + kstep; const char* b3 = b2 + kstep;
            unsigned v2[2][2];
#pragma unroll
            for (int h = 0; h < 2; ++h)
#pragma unroll
                for (int i = 0; i < 2; ++i) v2[h][i] = (GATHER && last) ? vAn[h][i] : vA[h][i];
            MK_LDB(B0, 0, 0); MK_SCHED; MK_LDA(At, 0, 0); MK_STAGE(MK_SA(1, 1), a1 + hstepA, vA[1]);
            MK_WAIT_VR; MK_WAIT_L(8); MK_BAR; MK_WAIT_L(0); MK_MMA(0, 0, At, B0); MK_BAR; MK_SCHED;
            MK_LDB(B1, 0, 1); MK_STAGE(MK_SB(0, 0), b2, voffB);
            MK_WAIT_VR; MK_BAR; MK_WAIT_L(0); MK_MMA(0, 1, At, B1); MK_BAR;
            MK_LDA(At, 0, 1); MK_STAGE(MK_SA(0, 0), a2, v2[0]);
            MK_BAR; MK_WAIT_L(0); MK_MMA(1, 0, At, B0); MK_BAR; MK_SCHED;
            MK_STAGE(MK_SB(0, 1), b2 + hstepB, voffB);
            MK_WAIT_VR; MK_BAR; MK_MMA(1, 1, At, B1); MK_BAR;
            MK_LDB(B0, 1, 0); MK_SCHED; MK_LDA(At, 1, 0); MK_STAGE(MK_SA(0, 1), a2 + hstepA, v2[1]);
            MK_WAIT_VR; MK_WAIT_L(8); MK_BAR; MK_WAIT_L(0); MK_MMA(0, 0, At, B0); MK_BAR; MK_SCHED;
            MK_LDB(B1, 1, 1); MK_STAGE(MK_SB(1, 0), b3, voffB);
            MK_WAIT_V(10); MK_BAR; MK_WAIT_L(0); MK_MMA(0, 1, At, B1); MK_BAR;
            MK_LDA(At, 1, 1); MK_STAGE(MK_SA(1, 0), a3, v2[0]);
            MK_BAR; MK_WAIT_L(0); MK_MMA(1, 0, At, B0); MK_BAR; MK_SCHED;
            MK_STAGE(MK_SB(1, 1), b3 + hstepB, voffB);
            MK_WAIT_V(10); MK_BAR; MK_MMA(1, 1, At, B1); MK_BAR;
        }
        if constexpr (FP8) asm volatile("s_nop 15\n\ts_nop 15" : "+v"(acc[1][1][0][0]), "+v"(acc[1][1][0][1]), "+v"(acc[1][1][1][0]), "+v"(acc[1][1][1][1]),
                                        "+v"(acc[1][1][2][0]), "+v"(acc[1][1][2][1]), "+v"(acc[1][1][3][0]), "+v"(acc[1][1][3][1]) :: "memory");
        int fr_ = fr, fq_ = fq; asm volatile("" : "+v"(fr_), "+v"(fq_));
        if (wr == 0) MK_BAR;
        const bool keep = E(acc, cur, wr, wc, fr_, fq_);
        if (wr == 1) MK_BAR;
        if (!has_next) break;
        if (!keep) {
#pragma unroll
            for (int a = 0; a < 2; ++a)
#pragma unroll
                for (int b = 0; b < 2; ++b)
#pragma unroll
                    for (int m = 0; m < 4; ++m)
#pragma unroll
                        for (int n = 0; n < 2; ++n) acc[a][b][m][n] = (f32x4){0.f, 0.f, 0.f, 0.f};
        }
        cur = nxt; cA = nA; cB = nB; ++ui;
        if (GATHER) {
#pragma unroll
            for (int h = 0; h < 2; ++h)
#pragma unroll
                for (int i = 0; i < 2; ++i) vA[h][i] = vAn[h][i]; }
    }
    MK_WAIT_V(0);
    if (wr == 0) MK_BAR;
    MK_BAR;
#undef MK_SA
#undef MK_SB
#undef MK_STAGE
#undef MK_LDA
#undef MK_LDB
#undef MK_MMA
#undef MK_CAT8
#undef MK_WAIT_V
#undef MK_WAIT_VR
#undef MK_WAIT_L
#undef MK_BAR
#undef MK_SCHED
}

__device__ __forceinline__ unsigned pack4_fp8(float a, float b, float c, float d) {
    a = fminf(fmaxf(a, -448.f), 448.f); b = fminf(fmaxf(b, -448.f), 448.f); c = fminf(fmaxf(c, -448.f), 448.f); d = fminf(fmaxf(d, -448.f), 448.f);
    int w = __builtin_amdgcn_cvt_pk_fp8_f32(a, b, 0, false); w = __builtin_amdgcn_cvt_pk_fp8_f32(c, d, w, true); return (unsigned)w; }
__device__ __forceinline__ u32x4 pack8(const f32x4 a, const f32x4 b) { u32x4 w; w.x = cvt_pk_bf16(a[0], a[1]); w.y = cvt_pk_bf16(a[2], a[3]); w.z = cvt_pk_bf16(b[0], b[1]); w.w = cvt_pk_bf16(b[2], b[3]); return w; }
struct EpiStoreBf16S {
    bf16_t* O; long ldc; float sc; int pad_;
    __device__ __forceinline__ bool operator()(const f32x4 (&acc)[2][2][4][2], const Unit& u, int wr, int wc, int fr, int fq) const {
        MK_FRAG_LOOP(r, c) { *(u32x4*)(O + (size_t)(u.pm * BM + r) * ldc + u.pn * BM + c) = pack8(acc[ai][bj][m][0] * sc, acc[ai][bj][m][1] * sc); }
        return false;
    }
};
struct EpiStoreBf16 {
    static constexpr int NS = 16;
    bf16_t* O; long ldc;
    __device__ __forceinline__ bool operator()(const f32x4 (&acc)[2][2][4][2], const Unit& u, int wr, int wc, int fr, int fq) const {
        MK_FRAG_LOOP(r, c) { *(u32x4*)(O + (size_t)(u.pm * BM + r) * ldc + u.pn * BM + c) = pack8(acc[ai][bj][m][0], acc[ai][bj][m][1]); }
        return false;
    }
};

struct EpiStorePred {
    bf16_t* O; long ldc;
    __device__ __forceinline__ bool operator()(const f32x4 (&acc)[2][2][4][2], const Unit& u, int wr, int wc, int fr, int fq) const {
        MK_FRAG_LOOP(r, c) { const u32x4 w = pack8(acc[ai][bj][m][0], acc[ai][bj][m][1]); if (w.x == 0x7fc17fc1u && w.w == 0x12345678u) *(u32x4*)(O + (size_t)(u.pm * BM + r) * ldc + u.pn * BM + c) = w; }
        return false;
    }
};
struct EpiStoreLine {
    bf16_t* O; long nunit;
    __device__ __forceinline__ bool operator()(const f32x4 (&acc)[2][2][4][2], const Unit& u, int wr, int wc, int fr, int fq) const {
        const size_t ub = (size_t)((u.pm * 18 + u.pn) % (int)nunit) * (BM * BM); const int wid = wr * 4 + wc, lane = fq * 16 + fr; int f = 0;
        MK_FRAG_LOOP(r, c) { *(u32x4*)(O + ub + ((size_t)(f * 8 + wid) * 64 + lane) * 8) = pack8(acc[ai][bj][m][0], acc[ai][bj][m][1]); ++f; }
        return false;
    }
};
struct EpiNull {
    __device__ __forceinline__ bool operator()(const f32x4 (&acc)[2][2][4][2], const Unit& u, int wr, int wc, int fr, int fq) const {
        MK_FRAG_LOOP(r, c) { asm volatile("" :: "v"(acc[ai][bj][m][0]), "v"(acc[ai][bj][m][1])); }
        return false;
    }
};

__device__ __forceinline__ void ld8_contig(const float* p, float (&o)[8]) { const f32x4 a = *(const f32x4*)p, b = *(const f32x4*)(p + 4); o[0] = a[0]; o[1] = a[1]; o[2] = a[2]; o[3] = a[3]; o[4] = b[0]; o[5] = b[1]; o[6] = b[2]; o[7] = b[3]; }
struct CMapZ1 { __device__ int operator()(int n) const { return n < RC ? n : (n < Z1_LX ? -1 : OFF_LX + (n - Z1_LX)); }
    __device__ __forceinline__ void load8(const float* rowp, int n, float (&o)[8]) const { const int sc = (*this)(n); if (sc >= 0) ld8_contig(rowp + sc, o); else {
#pragma unroll
        for (int j = 0; j < 8; ++j) o[j] = 0.f; } } };
struct CMapZC { __device__ int operator()(int n) const { return OFF_LG + n; }
    __device__ __forceinline__ void load8(const float* rowp, int n, float (&o)[8]) const { ld8_contig(rowp + OFF_LG + n, o); } };
struct CMapId { __device__ int operator()(int n) const { return n; }
    __device__ __forceinline__ void load8(const float* rowp, int n, float (&o)[8]) const { ld8_contig(rowp + n, o); } };
struct CMapGU { int F; __device__ int operator()(int n) const { return (n & 1) * F + (n >> 1); }
    __device__ __forceinline__ void load8(const float* rowp, int n, float (&o)[8]) const { const f32x4 g = *(const f32x4*)(rowp + (n >> 1)), u = *(const f32x4*)(rowp + F + (n >> 1));
        o[0] = g[0]; o[1] = u[0]; o[2] = g[1]; o[3] = u[1]; o[4] = g[2]; o[5] = u[2]; o[6] = g[3]; o[7] = u[3]; } };
constexpr int CT_B = 8;
template <bool OUT8 = false, class CM>
__device__ __forceinline__ void convT_job(LAS float* tile  , const float* src, int lds_, int Ks, bf16_t* dst, int Kd, int N, const CM& cm, int bid, int nblk, int& base, float oscale = 1.f) {
    const int tk = Kd / 64, nt = (N / 64) * tk, tid = threadIdx.x;
    const int first = (bid - base % nblk + nblk) % nblk;
    const int kk = tid >> 3, nn8 = (tid & 7) * 8, nn = tid >> 3, kk8 = (tid & 7) * 8;
    for (int t0 = first; t0 < nt; t0 += CT_B * nblk) {
        float v[CT_B][8];
#pragma unroll
        for (int b = 0; b < CT_B; ++b) { const int t = t0 + b * nblk; const int n0 = (t / tk) * 64, k0 = (t % tk) * 64, k = k0 + kk;
            if (t < nt && k < Ks) cm.load8(src + (size_t)k * lds_, n0 + nn8, v[b]); else {
#pragma unroll
                for (int j = 0; j < 8; ++j) v[b][j] = 0.f; } }
#pragma unroll
        for (int b = 0; b < CT_B; ++b)
#pragma unroll
            for (int j = 0; j < 8; ++j) tile[b * 64 * 65 + kk * 65 + nn8 + j] = v[b][j];
        __syncthreads();
#pragma unroll
        for (int b = 0; b < CT_B; ++b) { const int t = t0 + b * nblk; if (t < nt) { const int n0 = (t / tk) * 64, k0 = (t % tk) * 64; f32x4 a, c;
#pragma unroll
            for (int j = 0; j < 4; ++j) { a[j] = tile[b * 64 * 65 + (kk8 + j) * 65 + nn]; c[j] = tile[b * 64 * 65 + (kk8 + 4 + j) * 65 + nn]; }
            if constexpr (OUT8) { u32x2 w8; w8.x = pack4_fp8(a[0] * oscale, a[1] * oscale, a[2] * oscale, a[3] * oscale); w8.y = pack4_fp8(c[0] * oscale, c[1] * oscale, c[2] * oscale, c[3] * oscale);
                *(u32x2*)((unsigned char*)dst + (size_t)(n0 + nn) * Kd + k0 + kk8) = w8; }
            else *(u32x4*)(dst + (size_t)(n0 + nn) * Kd + k0 + kk8) = pack8(a, c); } }
        __syncthreads();
    }
    base += nt;
}

template <bool OUT8 = false, class CM, class MS>
__device__ __forceinline__ void convT_multi(LAS float* tile, const MS& ms, int nmat, int lds_, int Ks, int Kd, int N, const CM& cm, int bid, int nblk, float oscale = 1.f) {
    const int tk = Kd / 64, tpm = (N / 64) * tk, nt = nmat * tpm, tid = threadIdx.x;
    const int kk = tid >> 3, nn8 = (tid & 7) * 8, nn = tid >> 3, kk8 = (tid & 7) * 8;
    for (int t0 = bid; t0 < nt; t0 += CT_B * nblk) {
        float v[CT_B][8];
#pragma unroll
        for (int b = 0; b < CT_B; ++b) { const int T = t0 + b * nblk, m = T / tpm, t = T % tpm; const int n0 = (t / tk) * 64, k0 = (t % tk) * 64, k = k0 + kk;
            if (T < nt && k < Ks) cm.load8(ms.src(m) + (size_t)k * lds_, n0 + nn8, v[b]); else {
#pragma unroll
                for (int j = 0; j < 8; ++j) v[b][j] = 0.f; } }
#pragma unroll
        for (int b = 0; b < CT_B; ++b)
#pragma unroll
            for (int j = 0; j < 8; ++j) tile[b * 64 * 65 + kk * 65 + nn8 + j] = v[b][j];
        __syncthreads();
#pragma unroll
        for (int b = 0; b < CT_B; ++b) { const int T = t0 + b * nblk; if (T < nt) { const int m = T / tpm, t = T % tpm, n0 = (t / tk) * 64, k0 = (t % tk) * 64; f32x4 a, c;
#pragma unroll
            for (int j = 0; j < 4; ++j) { a[j] = tile[b * 64 * 65 + (kk8 + j) * 65 + nn]; c[j] = tile[b * 64 * 65 + (kk8 + 4 + j) * 65 + nn]; }
            if constexpr (OUT8) { u32x2 w8; w8.x = pack4_fp8(a[0] * oscale, a[1] * oscale, a[2] * oscale, a[3] * oscale); w8.y = pack4_fp8(c[0] * oscale, c[1] * oscale, c[2] * oscale, c[3] * oscale);
                *(u32x2*)((unsigned char*)ms.dst(m) + (size_t)(n0 + nn) * Kd + k0 + kk8) = w8; }
            else *(u32x4*)(ms.dst(m) + (size_t)(n0 + nn) * Kd + k0 + kk8) = pack8(a, c); } }
        __syncthreads();
    }
}

constexpr int MOD_SL = 16, MOD_KS = D / MOD_SL;
__device__ __forceinline__ void mod_partials(LAS float* sl  , const In& in, float* part  , int bid, int nblk) {
    const int ncc = 6 * D / NT, nitem = MOD_SL * ncc;
    for (int it = bid; it < nitem; it += nblk) {
        const int s = it / ncc, j = (it % ncc) * NT + threadIdx.x;
        for (int i = threadIdx.x; i < (NB + 1) * MOD_KS; i += NT) { const int r = i / MOD_KS, k = s * MOD_KS + i % MOD_KS; const float cv = r < NB ? in.c[r * D + k] : in.c_ctx[k]; sl[i] = siluf_(cv); }
        __syncthreads();
        float acc[NB + 1];
#pragma unroll
        for (int r = 0; r <= NB; ++r) acc[r] = 0.f;
        for (int k = 0; k < MOD_KS; ++k) { const float w = in.w_mod[(size_t)(s * MOD_KS + k) * 6 * D + j];
#pragma unroll
            for (int r = 0; r <= NB; ++r) acc[r] += sl[r * MOD_KS + k] * w; }
#pragma unroll
        for (int r = 0; r <= NB; ++r) part[((size_t)s * (NB + 1) + r) * 6 * D + j] = acc[r];
        __syncthreads();
    }
}
__device__ __forceinline__ float mod_value(const In& in, const float* part, int r, int j) {
    float s = in.b_mod[j];
#pragma unroll
    for (int q = 0; q < MOD_SL; ++q) s += part[((size_t)q * (NB + 1) + r) * 6 * D + j];
    return s;
}

template <bool OUT8 = false>
__device__ __forceinline__ void xn_rows(LAS float* sm  , const In& in, const float* part, bf16_t* xn, int b0, int nb, int row_lo, int row_hi) {
    const int nlat = nb * SEQ, wid = threadIdx.x >> 6, lane = threadIdx.x & 63;
    int cur_mr = -1;
    float gp[16];
#pragma unroll
    for (int j = 0; j < 4; ++j)
#pragma unroll
        for (int q = 0; q < 4; ++q) gp[4 * j + q] = in.norm_g[j * 256 + lane * 4 + q];
    auto src_of = [&](int r) __attribute__((always_inline)) { return r < nlat ? in.x + ((size_t)b0 * SEQ + r) * D : in.ctx + ((size_t)b0 * CTX + (r - nlat)) * D; };
    f32x4 nx[4];
    { const int r = row_lo + wid; if (r < row_hi) { const float* src = src_of(r);
#pragma unroll
        for (int j = 0; j < 4; ++j) nx[j] = *(const f32x4*)(src + j * 256 + lane * 4); } }
    for (int rbase = row_lo; rbase < row_hi; rbase += 8) {
        const int mr = rbase < nlat ? b0 + rbase / SEQ : NB;
        if (mr != cur_mr) { __syncthreads(); for (int j = threadIdx.x; j < 2 * D; j += NT) sm[j] = mod_value(in, part, mr, j); __syncthreads(); cur_mr = mr; }
        const int r = rbase + wid; if (r >= row_hi) continue;
        f32x4 v[4]; float ss = 0.f;
#pragma unroll
        for (int j = 0; j < 4; ++j) { v[j] = nx[j]; ss += v[j][0] * v[j][0] + v[j][1] * v[j][1] + v[j][2] * v[j][2] + v[j][3] * v[j][3]; }
        if (r + 8 < row_hi) { const float* src = src_of(r + 8);
#pragma unroll
            for (int j = 0; j < 4; ++j) nx[j] = *(const f32x4*)(src + j * 256 + lane * 4); }
        ss = wave_sum64(ss);
        const float rinv = __builtin_amdgcn_rsqf(ss * (1.f / D) + NORM_EPS);
#pragma unroll
        for (int j = 0; j < 4; ++j) { const int c = j * 256 + lane * 4; float o[4];
#pragma unroll
            for (int q = 0; q < 4; ++q) o[q] = (v[j][q] * rinv * gp[4 * j + q]) * (1.f + sm[D + c + q]) + sm[c + q];
            if constexpr (OUT8) *(unsigned*)((unsigned char*)xn + (size_t)r * D + c) = pack4_fp8(o[0] * 16.f, o[1] * 16.f, o[2] * 16.f, o[3] * 16.f);
            else { u32x2 w; w.x = cvt_pk_bf16(o[0], o[1]); w.y = cvt_pk_bf16(o[2], o[3]); *(u32x2*)(xn + (size_t)r * D + c) = w; } }
    }
}
}

namespace mk {
#define XB_TMO      128
#define XB_XCNT(j)  (256  + 64 * (j))
#define XB_XSUB(j)  (1280 + 64 * (j))
#define XB_XGEN(j)  (2304 + 64 * (j))
#define XB_TOP      3328
#define XB_TOPGEN   3392
#define XCD_BAR_WORDS 3456
#define XB_SPIN_CAP (1u << 18)
__device__ __forceinline__ unsigned xb_ld(unsigned* p)              { return __hip_atomic_load(p, __ATOMIC_RELAXED, __HIP_MEMORY_SCOPE_AGENT); }
__device__ __forceinline__ unsigned xb_add(unsigned* p, unsigned v) { return __hip_atomic_fetch_add(p, v, __ATOMIC_RELAXED, __HIP_MEMORY_SCOPE_AGENT); }
__device__ __forceinline__ unsigned xb_xcc_id() { return (unsigned)__builtin_amdgcn_s_getreg((3 << 11) | 20) & 0xFu; }
#define XB_SPIN(cond, bar) do { unsigned _sp = 0; while (cond) { __builtin_amdgcn_s_sleep(1); \
    if ((++_sp & 255u) == 0u) { if (xb_ld(&(bar)[XB_TMO])) break; if (_sp > XB_SPIN_CAP) { atomicAdd(&(bar)[XB_TMO], 1u); break; } } } } while (0)
struct XcdBarrier { unsigned* bar; unsigned x; volatile LAS unsigned* st; };
__device__ __forceinline__ XcdBarrier xcd_barrier_post(unsigned* bar, volatile LAS unsigned* st) {
    XcdBarrier b; b.bar = bar; b.x = xb_xcc_id(); b.st = st;
    if (threadIdx.x == 0) (void)xb_add(&bar[XB_XCNT(b.x)], 1u);
    return b;
}
__device__ __forceinline__ void xcd_barrier_complete(unsigned* bar, unsigned x, unsigned& nloc, unsigned& nx) {
    const unsigned G = gridDim.x * gridDim.y * gridDim.z;
    unsigned sum, cnt, mine, sp = 0u;
    for (;;) {
        sum = 0u; cnt = 0u; mine = 0u;
#pragma unroll
        for (unsigned j = 0; j < 16; ++j) { const unsigned c = xb_ld(&bar[XB_XCNT(j)]); sum += c; cnt += (c > 0u) ? 1u : 0u; mine = (j == x) ? c : mine; }
        if (sum == G) break;
        __builtin_amdgcn_s_sleep(1);
        if ((++sp & 255u) == 0u) { if (xb_ld(&bar[XB_TMO])) break; if (sp > XB_SPIN_CAP) { atomicAdd(&bar[XB_TMO], 1u); break; } }
    }
    nloc = mine > 0u ? mine : 1u; nx = cnt > 0u ? cnt : 1u;
}
__device__ __forceinline__ void xcd_barrier(const XcdBarrier& b) {
    asm volatile("s_waitcnt vmcnt(0)" ::: "memory");
    __syncthreads();
    if (threadIdx.x == 0) {
        unsigned* bar = b.bar;
        __builtin_amdgcn_s_waitcnt(0);
        unsigned nloc = b.st[0], nx = b.st[1];
        if (nloc == 0u) { xcd_barrier_complete(bar, b.x, nloc, nx); b.st[0] = nloc; b.st[1] = nx; }
        const unsigned old = xb_add(&bar[XB_XSUB(b.x)], 1u);
        const unsigned gen = old / nloc;
        if (old + 1u == (gen + 1u) * nloc) {
            __builtin_amdgcn_fence(__ATOMIC_RELEASE, "agent");
            asm volatile("s_waitcnt vmcnt(0)" ::: "memory");
            const unsigned og = xb_add(&bar[XB_TOP], 1u);
            const unsigned tg = og / nx;
            if (og + 1u == (tg + 1u) * nx) xb_add(&bar[XB_TOPGEN], 1u);
            else XB_SPIN(xb_ld(&bar[XB_TOPGEN]) == tg, bar);
            __builtin_amdgcn_fence(__ATOMIC_ACQUIRE, "agent");
            xb_add(&bar[XB_XGEN(b.x)], 1u);
            asm volatile("s_waitcnt vmcnt(0)" ::: "memory");
        } else {
            XB_SPIN(xb_ld(&bar[XB_XGEN(b.x)]) == gen, bar);
            __builtin_amdgcn_fence(__ATOMIC_ACQUIRE, "agent");
            asm volatile("s_waitcnt vmcnt(0)" ::: "memory");
        }
    }
    __syncthreads();
}
}

namespace mk {
constexpr int TB = 32;
constexpr int RAWW = 320;
constexpr int RW_RAW = 0;
constexpr int RW_MU = RW_RAW + (TB + 2) * RAWW * 2;
constexpr int RW_WUP = RW_MU + 2 * RAWW * 4;
constexpr int RW_AUP = RW_WUP + 64 * 72 * 2;
constexpr int RW_CST = RW_AUP + 64 * 72 * 2;
constexpr int RW_AWD = RW_CST + 5 * 64 * 4;
constexpr int RW_AAD = RW_AWD + TB * 72 * 2;
constexpr int RW_R = RW_AAD + TB * 72 * 2;
constexpr int RW_KR = RW_R + TB * 64 * 4;
constexpr int RW_LA = RW_KR + TB * 64 * 4;
constexpr int RW_KK = RW_LA + TB * 64 * 4;
constexpr int RW_W = RW_KK + TB * 64 * 4;
constexpr int RW_B = RW_W + TB * 64 * 4;
constexpr int RW_KD = RW_B + TB * 64 * 4;
constexpr int RW_WR = RW_KD + TB * 64 * 4;
constexpr int RW_V = RW_WR + TB * 64 * 4;
constexpr int RW_SC = RW_V + TB * 64 * 4;
constexpr int RW_YO = RW_SC + TB * 2 * 4;
constexpr int RW_BON = RW_YO + TB * 64 * 4;
constexpr int RW_END = RW_BON + TB * 4;
static_assert(RW_END <= LDS_BYTES, "rwkv LDS");

#define MK_DPP(x, ctrl) __int_as_float(__builtin_amdgcn_update_dpp(__float_as_int(x), __float_as_int(x), ctrl, 0xF, 0xF, false))
__device__ __forceinline__ float allreduce16(float x) {
    x += MK_DPP(x, 0xB1); x += MK_DPP(x, 0x4E); x += MK_DPP(x, 0x141); x += MK_DPP(x, 0x140); return x;
}

__device__ __forceinline__ void allreduce16x4(float& a, float& b, float& c, float& d) {
    asm volatile("s_nop 1\n\t"
        "v_add_f32_dpp %0, %0, %0 quad_perm:[1,0,3,2] row_mask:0xf bank_mask:0xf\n\t" "v_add_f32_dpp %1, %1, %1 quad_perm:[1,0,3,2] row_mask:0xf bank_mask:0xf\n\t"
        "v_add_f32_dpp %2, %2, %2 quad_perm:[1,0,3,2] row_mask:0xf bank_mask:0xf\n\t" "v_add_f32_dpp %3, %3, %3 quad_perm:[1,0,3,2] row_mask:0xf bank_mask:0xf\n\t"
        "v_add_f32_dpp %0, %0, %0 quad_perm:[2,3,0,1] row_mask:0xf bank_mask:0xf\n\t" "v_add_f32_dpp %1, %1, %1 quad_perm:[2,3,0,1] row_mask:0xf bank_mask:0xf\n\t"
        "v_add_f32_dpp %2, %2, %2 quad_perm:[2,3,0,1] row_mask:0xf bank_mask:0xf\n\t" "v_add_f32_dpp %3, %3, %3 quad_perm:[2,3,0,1] row_mask:0xf bank_mask:0xf\n\t"
        "v_add_f32_dpp %0, %0, %0 row_half_mirror row_mask:0xf bank_mask:0xf\n\t" "v_add_f32_dpp %1, %1, %1 row_half_mirror row_mask:0xf bank_mask:0xf\n\t"
        "v_add_f32_dpp %2, %2, %2 row_half_mirror row_mask:0xf bank_mask:0xf\n\t" "v_add_f32_dpp %3, %3, %3 row_half_mirror row_mask:0xf bank_mask:0xf\n\t"
        "v_add_f32_dpp %0, %0, %0 row_mirror row_mask:0xf bank_mask:0xf\n\t" "v_add_f32_dpp %1, %1, %1 row_mirror row_mask:0xf bank_mask:0xf\n\t"
        "v_add_f32_dpp %2, %2, %2 row_mirror row_mask:0xf bank_mask:0xf\n\t" "v_add_f32_dpp %3, %3, %3 row_mirror row_mask:0xf bank_mask:0xf"
        : "+v"(a), "+v"(b), "+v"(c), "+v"(d));
}
struct RwkvP { const bf16_t* z1; bf16_t* Y; float* bon; int b0, nb; };

constexpr int RW_NPIECE = (TB + 2) * 40, RW_PPT = (RW_NPIECE + NT - 1) / NT;

__device__ __forceinline__ void rwkv_chain(LAS unsigned char* lds, const In& in, const RwkvP p, int chain) {
    const int tid = threadIdx.x, lane = tid & 63, wid = tid >> 6;
    const int d = chain / (p.nb * NH), bl = (chain / NH) % p.nb, h = chain % NH;
    const int nlat = p.nb * SEQ;
    LAS bf16_t* RAW = (LAS bf16_t*)(lds + RW_RAW); LAS float* MU = (LAS float*)(lds + RW_MU);
    LAS bf16_t* WUP = (LAS bf16_t*)(lds + RW_WUP); LAS bf16_t* AUP = (LAS bf16_t*)(lds + RW_AUP); LAS float* CST = (LAS float*)(lds + RW_CST);
    LAS bf16_t* AWD = (LAS bf16_t*)(lds + RW_AWD); LAS bf16_t* AAD = (LAS bf16_t*)(lds + RW_AAD);
    LAS float *Rr = (LAS float*)(lds + RW_R), *KR = (LAS float*)(lds + RW_KR), *LA_ = (LAS float*)(lds + RW_LA);
    LAS float *KK = (LAS float*)(lds + RW_KK), *Wv = (LAS float*)(lds + RW_W), *Bv = (LAS float*)(lds + RW_B), *KD = (LAS float*)(lds + RW_KD), *WR = (LAS float*)(lds + RW_WR), *Vv = (LAS float*)(lds + RW_V);
    LAS float *SC = (LAS float*)(lds + RW_SC), *YO = (LAS float*)(lds + RW_YO), *BON = (LAS float*)(lds + RW_BON);
    auto segcol = [&](int s) { return s < 3 ? s * RW + h * 64 : (s == 3 ? OFF_WD + d * DL : OFF_AD + d * AL); };
    for (int i = tid; i < 2 * RAWW; i += NT) { const int m = i / RAWW, c = i % RAWW; MU[i] = in.shift_mu[m * RC + segcol(c >> 6) + (c & 63)]; }
    for (int i = tid; i < 64 * 64; i += NT) { const int j = i >> 6, c = i & 63;
        WUP[c * 72 + j] = f2bf(in.rw_w_up[((size_t)d * DL + j) * RW + h * 64 + c]); AUP[c * 72 + j] = f2bf(in.rw_a_up[((size_t)d * AL + j) * RW + h * 64 + c]); }
    for (int i = tid; i < 64; i += NT) { CST[i] = in.rw_w0[d * RW + h * 64 + i]; CST[64 + i] = in.rw_a0[d * RW + h * 64 + i]; CST[128 + i] = in.rw_k_k[h * 64 + i]; CST[192 + i] = in.rw_k_a[h * 64 + i]; CST[256 + i] = in.rw_r_k[h * 64 + i]; }
    constexpr int NQ = (CTX + SEQ) / TB, NQC = CTX / TB;
    auto blk_info = [&](int q, bool& isctx, int& t0, bool& hp, bool& hn, size_t& grow0) {
        isctx = q < NQC;
        if (isctx) { const int qq = d == 0 ? q : NQC - 1 - q; t0 = qq * TB; hp = t0 > 0; hn = t0 + TB < CTX; grow0 = (size_t)nlat + (size_t)bl * CTX + t0; }
        else { const int ql = q - NQC, qq = d == 0 ? ql : SEQ / TB - 1 - ql; t0 = qq * TB; hp = (t0 % GW) != 0; hn = ((t0 + TB) % GW) != 0; grow0 = (size_t)bl * SEQ + t0; }
    };
    u32x4 pre[RW_PPT];
    auto prefetch = [&](int q) {
        bool isctx, hp, hn; int t0; size_t grow0; blk_info(q, isctx, t0, hp, hn, grow0);
#pragma unroll
        for (int k = 0; k < RW_PPT; ++k) { const int i = tid + k * NT; u32x4 v = (u32x4){0u, 0u, 0u, 0u};
            if (i < RW_NPIECE) { const int rr = i / 40, sp = i % 40, seg = sp >> 3, part = sp & 7;
                const bool ok = (rr == 0) ? hp : ((rr == TB + 1) ? hn : true);
                if (ok) v = *(const u32x4*)(p.z1 + (grow0 + rr - 1) * Z1_N + segcol(seg) + part * 8); }
            pre[k] = v; }
    };
    auto commit = [&]() {
#pragma unroll
        for (int k = 0; k < RW_PPT; ++k) { const int i = tid + k * NT; if (i < RW_NPIECE) { const int rr = i / 40, sp = i % 40; *(LAS u32x4*)(RAW + rr * RAWW + sp * 8) = pre[k]; } }
    };
    float S[2][4];
#pragma unroll
    for (int i = 0; i < 2; ++i)
#pragma unroll
        for (int j = 0; j < 4; ++j) S[i][j] = 0.f;
    const int kg = lane & 15, rp = (lane >> 4) + 4 * wid;
    prefetch(0);
    for (int q = 0; q < NQ; ++q) {
        bool isctx, hp, hn; int t0; size_t grow0; blk_info(q, isctx, t0, hp, hn, grow0);
        commit();
        __syncthreads();
        if (q + 1 < NQ) prefetch(q + 1);
        auto shift8 = [&](int t, int c0, float (&s)[8]) {
            const u32x4 xp = *(const LAS u32x4*)(RAW + t * RAWW + c0), xc = *(const LAS u32x4*)(RAW + (t + 1) * RAWW + c0), xn_ = *(const LAS u32x4*)(RAW + (t + 2) * RAWW + c0);
            const f32x4 m0a = *(const LAS f32x4*)(MU + c0), m0b = *(const LAS f32x4*)(MU + c0 + 4), m1a = *(const LAS f32x4*)(MU + RAWW + c0), m1b = *(const LAS f32x4*)(MU + RAWW + c0 + 4);
#pragma unroll
            for (int j = 0; j < 4; ++j) { const unsigned a = xp[j], b = xc[j], c = xn_[j];
                const float mu0l = j < 2 ? m0a[2 * j] : m0b[2 * j - 4], mu0h = j < 2 ? m0a[2 * j + 1] : m0b[2 * j - 3], mu1l = j < 2 ? m1a[2 * j] : m1b[2 * j - 4], mu1h = j < 2 ? m1a[2 * j + 1] : m1b[2 * j - 3];
                { const float x = bflo(b); s[2 * j] = x + mu0l * (bflo(a) - x) + mu1l * (bflo(c) - x); }
                { const float x = bfhi(b); s[2 * j + 1] = x + mu0h * (bfhi(a) - x) + mu1h * (bfhi(c) - x); } } };
        for (int it = tid; it < TB * 24; it += NT) {
            const int t = it / 24, g = it % 24, seg = g >> 3, cc = (g & 7) * 8; float s[8]; shift8(t, g * 8, s);
            LAS float* dst = (seg == 0 ? Rr : (seg == 1 ? KR : Vv)) + t * 64 + cc; *(LAS f32x4*)dst = (f32x4){s[0], s[1], s[2], s[3]}; *(LAS f32x4*)(dst + 4) = (f32x4){s[4], s[5], s[6], s[7]};
        }
        { const int t = tid >> 4, g = 24 + (tid & 15), cc = (g & 7) * 8; float s[8]; shift8(t, g * 8, s);
          const bool isw = (tid & 15) < 8;
#pragma unroll
          for (int j = 0; j < 8; ++j) { const float th = fast_tanh(s[j]); s[j] = isw ? th : s[j]; }
          LAS bf16_t* dst = (isw ? AWD : AAD) + t * 72 + cc;
          u32x4 w; w.x = cvt_pk_bf16(s[0], s[1]); w.y = cvt_pk_bf16(s[2], s[3]); w.z = cvt_pk_bf16(s[4], s[5]); w.w = cvt_pk_bf16(s[6], s[7]); *(LAS u32x4*)dst = w; }
        __syncthreads();
        {
            const int lora = wid >> 2, ct = wid & 3, fr = lane & 15, fq = lane >> 4;
            const LAS bf16_t* Am = lora ? AAD : AWD; const LAS bf16_t* Bm = lora ? AUP : WUP;
#pragma unroll
            for (int rt = 0; rt < 2; ++rt) {
                f32x4 acc = (f32x4){0.f, 0.f, 0.f, 0.f};
#pragma unroll
                for (int ks = 0; ks < 2; ++ks) {
                    const bf16x8 a = *(const LAS bf16x8*)(Am + (rt * 16 + fr) * 72 + ks * 32 + fq * 8);
                    const bf16x8 b = *(const LAS bf16x8*)(Bm + (ct * 16 + fr) * 72 + ks * 32 + fq * 8);
                    acc = __builtin_amdgcn_mfma_f32_16x16x32_bf16(a, b, acc, 0, 0, 0);
                }
                const int col = ct * 16 + fr;
#pragma unroll
                for (int i = 0; i < 4; ++i) { const int t = rt * 16 + fq * 4 + i;
                    if (lora == 0) { const float lw = acc[i] + CST[col]; const float wl = -fast_softplus(-lw) - 0.5f; Wv[t * 64 + col] = __expf(-__expf(wl)); }
                    else { LA_[t * 64 + col] = fast_sigmoid(acc[i] + CST[64 + col]); } }
            }
        }
        __syncthreads();
        {
            const int t = tid >> 4, c4 = (tid & 15) * 4;
            const f32x4 k = *(const LAS f32x4*)(KR + t * 64 + c4), a = *(const LAS f32x4*)(LA_ + t * 64 + c4), w = *(const LAS f32x4*)(Wv + t * 64 + c4), r = *(const LAS f32x4*)(Rr + t * 64 + c4);
            f32x4 kkr, kd, bb, wr; float ss = 0.f, br = 0.f, kr = 0.f, bn = 0.f;
#pragma unroll
            for (int j = 0; j < 4; ++j) { kkr[j] = k[j] * CST[128 + c4 + j]; ss += kkr[j] * kkr[j]; }
            ss = allreduce16(ss);
            const float inv = 1.f / fmaxf(sqrtf(ss), 1e-12f);
#pragma unroll
            for (int j = 0; j < 4; ++j) { const float kk = kkr[j] * inv; kkr[j] = kk; kd[j] = k[j] * (1.f + (a[j] - 1.f) * CST[192 + c4 + j]); bb[j] = kk * a[j]; wr[j] = w[j] * r[j];
                br += bb[j] * r[j]; kr += kd[j] * r[j]; bn += r[j] * kd[j] * CST[256 + c4 + j]; }
            br = allreduce16(br); kr = allreduce16(kr); bn = allreduce16(bn);
            *(LAS f32x4*)(KK + t * 64 + c4) = kkr; *(LAS f32x4*)(KD + t * 64 + c4) = kd; *(LAS f32x4*)(Bv + t * 64 + c4) = bb; *(LAS f32x4*)(WR + t * 64 + c4) = wr;
            if ((tid & 15) == 0) { SC[t * 2] = br; SC[t * 2 + 1] = kr; BON[t] = bn; }
        }
        __syncthreads();
        {
            auto tof = [&](int st) { return d == 0 ? st : TB - 1 - st; };
            const LAS float* lb = KK + 4 * kg;
            const LAS float* vb = Vv + 2 * rp;
            constexpr int OW = (RW_W - RW_KK) / 4, OB = (RW_B - RW_KK) / 4, OKD = (RW_KD - RW_KK) / 4, OWR = (RW_WR - RW_KK) / 4;
            int t = tof(0);
            f32x4 kk4 = *(const LAS f32x4*)(lb + t * 64), w4 = *(const LAS f32x4*)(lb + t * 64 + OW), b4 = *(const LAS f32x4*)(lb + t * 64 + OB),
                  kd4 = *(const LAS f32x4*)(lb + t * 64 + OKD), wr4 = *(const LAS f32x4*)(lb + t * 64 + OWR);
            f32x2 vv = *(const LAS f32x2*)(vb + t * 64), sc = *(const LAS f32x2*)(SC + t * 2);
            f32x2 S2[4];
#pragma unroll
            for (int j = 0; j < 4; ++j) { S2[j][0] = S[0][j]; S2[j][1] = S[1][j]; }
#pragma unroll 2
            for (int st = 0; st < TB; ++st) {
                const int tn = tof(st + 1 < TB ? st + 1 : st);
                const f32x4 nkk4 = *(const LAS f32x4*)(lb + tn * 64), nw4 = *(const LAS f32x4*)(lb + tn * 64 + OW), nb4 = *(const LAS f32x4*)(lb + tn * 64 + OB),
                            nkd4 = *(const LAS f32x4*)(lb + tn * 64 + OKD), nwr4 = *(const LAS f32x4*)(lb + tn * 64 + OWR);
                const f32x2 nvv = *(const LAS f32x2*)(vb + tn * 64), nsc = *(const LAS f32x2*)(SC + tn * 2);
                f32x2 sa2 = S2[0] * kk4[0], yo2 = S2[0] * wr4[0];
#pragma unroll
                for (int j = 1; j < 4; ++j) { sa2 += S2[j] * kk4[j]; yo2 += S2[j] * wr4[j]; }
                float sa0 = sa2[0], sa1 = sa2[1], yo0 = yo2[0], yo1 = yo2[1];
                allreduce16x4(sa0, sa1, yo0, yo1);
                f32x2 sar; sar[0] = sa0; sar[1] = sa1;
#pragma unroll
                for (int j = 0; j < 4; ++j) S2[j] = S2[j] * w4[j] + (vv * kd4[j] - sar * b4[j]);
                if (kg == 0) { f32x2 yor; yor[0] = yo0; yor[1] = yo1; const f32x2 y = yor - sar * sc[0] + vv * sc[1]; *(LAS f32x2*)(YO + t * 64 + 2 * rp) = y; }
                kk4 = nkk4; w4 = nw4; b4 = nb4; kd4 = nkd4; wr4 = nwr4; vv = nvv; sc = nsc; t = tn;
            }
#pragma unroll
            for (int j = 0; j < 4; ++j) { S[0][j] = S2[j][0]; S[1][j] = S2[j][1]; }
        }
        __syncthreads();
        if (!isctx) {
            const int t = tid >> 4, c4 = (tid & 15) * 4; const f32x4 y = *(const LAS f32x4*)(YO + t * 64 + c4);
            u32x2 w; w.x = cvt_pk_bf16(y[0], y[1]); w.y = cvt_pk_bf16(y[2], y[3]);
            *(u32x2*)(p.Y + ((size_t)d * nlat + grow0 + t) * RW + h * 64 + c4) = w;
            if (tid < TB) p.bon[((size_t)d * nlat + grow0 + tid) * NH + h] = BON[tid];
        }
    }
}
__device__ __forceinline__ void rwkv_phase(LAS unsigned char* lds, const In& in, const RwkvP p, int bid, int nblk) {
    const int nchain = 2 * p.nb * NH;
    for (int c = bid; c < nchain; c += nblk) { rwkv_chain(lds, in, p, c); __syncthreads(); }
}
}

namespace mk {
constexpr int C2_RAW = 0;
constexpr int C2_MU = C2_RAW + (TB + 2) * RAWW * 2;
constexpr int C2_WUP = C2_MU + 2 * RAWW * 4;
constexpr int C2_AUP = C2_WUP + 64 * 72 * 2;
constexpr int C2_CST = C2_AUP + 64 * 72 * 2;
constexpr int C2_AWD = C2_CST + 5 * 64 * 4;
constexpr int C2_AAD = C2_AWD + TB * 72 * 2;
constexpr int C2_X = C2_AAD + TB * 72 * 2;
constexpr int C2_R = C2_X, C2_KR = C2_R + TB * 64 * 4, C2_V = C2_KR + TB * 64 * 4, C2_E = C2_V + TB * 64 * 4, C2_LA = C2_E + TB * 64 * 4, C2_CUM = C2_LA + TB * 64 * 4, C2_X_END = C2_CUM + TB * 64 * 4;
constexpr int C2_YO = C2_X;
constexpr int C2_G = C2_YO + TB * 64 * 4;
constexpr int C2_UB = C2_G + 64 * 36 * 4;
constexpr int C2_ABT = C2_UB + 64 * 40 * 2;
constexpr int C2_AKT = C2_ABT + 32 * 32 * 4;
constexpr int C2_NBT = C2_AKT + 32 * 40 * 2;
constexpr int C2_NKT = C2_NBT + 32 * 40 * 2;
static_assert(C2_NKT + 32 * 40 * 2 <= C2_X_END, "region X reuse");
constexpr int C2_KKS = C2_X_END;
constexpr int C2_BS = C2_KKS + TB * 72 * 2, C2_KDS = C2_BS + TB * 72 * 2, C2_RS = C2_KDS + TB * 72 * 2;
constexpr int C2_BST = C2_RS + TB * 72 * 2;
constexpr int C2_KDST = C2_BST + 64 * 40 * 2;
constexpr int C2_VT = C2_KDST + 64 * 40 * 2;
constexpr int C2_S0B = C2_VT + 64 * 40 * 2;
constexpr int C2_GC = C2_S0B + 64 * 72 * 2;
constexpr int C2_BON = C2_GC + 64 * 4;
constexpr int C2_END = C2_BON + TB * 4;
static_assert(C2_END <= LDS_BYTES - 16 && (C2_X % 16) == 0 && (C2_KKS % 16) == 0 && (C2_G % 16) == 0 && (C2_UB % 16) == 0 && (C2_ABT % 16) == 0 && (C2_AKT % 16) == 0 && (C2_S0B % 16) == 0, "rwkv2 LDS");

__device__ __forceinline__ bf16x8 ldsb8(const LAS bf16_t* p) { return *(const LAS bf16x8*)p; }

template <int MODE>
__device__ __forceinline__ void rwkv_chain2(LAS unsigned char* lds, const In& in, const RwkvP p, int chain) {
    const int tid = threadIdx.x, lane = tid & 63, wid = tid >> 6, fr = lane & 15, fq = lane >> 4;
    const int d = chain / (p.nb * NH), bl = (chain / NH) % p.nb, h = chain % NH;
    const int nlat = p.nb * SEQ;
    LAS bf16_t* RAW = (LAS bf16_t*)(lds + C2_RAW); LAS float* MU = (LAS float*)(lds + C2_MU);
    LAS bf16_t* WUP = (LAS bf16_t*)(lds + C2_WUP); LAS bf16_t* AUP = (LAS bf16_t*)(lds + C2_AUP); LAS float* CST = (LAS float*)(lds + C2_CST);
    LAS bf16_t* AWD = (LAS bf16_t*)(lds + C2_AWD); LAS bf16_t* AAD = (LAS bf16_t*)(lds + C2_AAD);
    LAS float *Rr = (LAS float*)(lds + C2_R), *KR = (LAS float*)(lds + C2_KR), *Vv = (LAS float*)(lds + C2_V), *Ee = (LAS float*)(lds + C2_E), *LA_ = (LAS float*)(lds + C2_LA), *CUM = (LAS float*)(lds + C2_CUM);
    LAS float *YO = (LAS float*)(lds + C2_YO), *Gm = (LAS float*)(lds + C2_G), *ABT = (LAS float*)(lds + C2_ABT), *GC = (LAS float*)(lds + C2_GC), *BON = (LAS float*)(lds + C2_BON);
    LAS bf16_t *UB = (LAS bf16_t*)(lds + C2_UB), *AKT = (LAS bf16_t*)(lds + C2_AKT), *NBT = (LAS bf16_t*)(lds + C2_NBT), *NKT = (LAS bf16_t*)(lds + C2_NKT);
    LAS bf16_t *KKS = (LAS bf16_t*)(lds + C2_KKS), *BS = (LAS bf16_t*)(lds + C2_BS), *KDS = (LAS bf16_t*)(lds + C2_KDS), *RS = (LAS bf16_t*)(lds + C2_RS);
    LAS bf16_t *BST = (LAS bf16_t*)(lds + C2_BST), *KDST = (LAS bf16_t*)(lds + C2_KDST), *VT = (LAS bf16_t*)(lds + C2_VT), *S0B = (LAS bf16_t*)(lds + C2_S0B);
    auto segcol = [&](int s) { return s < 3 ? s * RW + h * 64 : (s == 3 ? OFF_WD + d * DL : OFF_AD + d * AL); };
    for (int i = tid; i < 2 * RAWW; i += NT) { const int m = i / RAWW, c = i % RAWW; MU[i] = in.shift_mu[m * RC + segcol(c >> 6) + (c & 63)]; }
    for (int i = tid; i < 64 * 64; i += NT) { const int j = i >> 6, c = i & 63;
        WUP[c * 72 + j] = f2bf(in.rw_w_up[((size_t)d * DL + j) * RW + h * 64 + c]); AUP[c * 72 + j] = f2bf(in.rw_a_up[((size_t)d * AL + j) * RW + h * 64 + c]); }
    for (int i = tid; i < 64; i += NT) { CST[i] = in.rw_w0[d * RW + h * 64 + i]; CST[64 + i] = in.rw_a0[d * RW + h * 64 + i]; CST[128 + i] = in.rw_k_k[h * 64 + i]; CST[192 + i] = in.rw_k_a[h * 64 + i]; CST[256 + i] = in.rw_r_k[h * 64 + i]; }
    for (int i = tid; i < 64 * 72 / 2; i += NT) ((LAS unsigned*)S0B)[i] = 0u;
    constexpr int NQ = (CTX + SEQ) / TB, NQC = CTX / TB;
    auto blk_info = [&](int q, bool& isctx, int& t0, bool& hp, bool& hn, size_t& grow0) {
        isctx = q < NQC;
        if (isctx) { const int qq = d == 0 ? q : NQC - 1 - q; t0 = qq * TB; hp = t0 > 0; hn = t0 + TB < CTX; grow0 = (size_t)nlat + (size_t)bl * CTX + t0; }
        else { const int ql = q - NQC, qq = d == 0 ? ql : SEQ / TB - 1 - ql; t0 = qq * TB; hp = (t0 % GW) != 0; hn = ((t0 + TB) % GW) != 0; grow0 = (size_t)bl * SEQ + t0; }
    };
    u32x4 pre[RW_PPT]; int poff[RW_PPT], plds[RW_PPT], pkind[RW_PPT];
#pragma unroll
    for (int k = 0; k < RW_PPT; ++k) { const int i = tid + k * NT, rr = i / 40, sp = i % 40, seg = sp >> 3, part = sp & 7;
        poff[k] = (rr - 1) * Z1_N + segcol(seg) + part * 8; plds[k] = rr * RAWW + sp * 8; pkind[k] = i >= RW_NPIECE ? 3 : (rr == 0 ? 1 : (rr == TB + 1 ? 2 : 0)); }
    auto prefetch = [&](int q) {
        bool isctx, hp, hn; int t0; size_t grow0; blk_info(q, isctx, t0, hp, hn, grow0);
        const bf16_t* base = p.z1 + grow0 * Z1_N;
#pragma unroll
        for (int k = 0; k < RW_PPT; ++k) { u32x4 v = (u32x4){0u, 0u, 0u, 0u};
            const bool ok = pkind[k] == 0 || (pkind[k] == 1 && hp) || (pkind[k] == 2 && hn);
            if (ok) v = *(const u32x4*)(base + poff[k]);
            pre[k] = v; }
    };
    auto commit = [&]() {
#pragma unroll
        for (int k = 0; k < RW_PPT; ++k) if (pkind[k] != 3) *(LAS u32x4*)(RAW + plds[k]) = pre[k];
    };
    f32x4 Sreg[2];
    Sreg[0] = (f32x4){0.f, 0.f, 0.f, 0.f}; Sreg[1] = Sreg[0];
    const int rt = wid >> 1;
    prefetch(0);
    for (int q = 0; q < NQ; ++q) {
        bool isctx, hp, hn; int t0; size_t grow0; blk_info(q, isctx, t0, hp, hn, grow0);
        commit();
        __syncthreads();
        if (q + 1 < NQ) prefetch(q + 1);
        auto shift8 = [&](int t, int c0, float (&s)[8]) {
            const u32x4 xp = *(const LAS u32x4*)(RAW + t * RAWW + c0), xc = *(const LAS u32x4*)(RAW + (t + 1) * RAWW + c0), xn_ = *(const LAS u32x4*)(RAW + (t + 2) * RAWW + c0);
            const f32x4 m0a = *(const LAS f32x4*)(MU + c0), m0b = *(const LAS f32x4*)(MU + c0 + 4), m1a = *(const LAS f32x4*)(MU + RAWW + c0), m1b = *(const LAS f32x4*)(MU + RAWW + c0 + 4);
#pragma unroll
            for (int j = 0; j < 4; ++j) { const unsigned a = xp[j], b = xc[j], c = xn_[j];
                const float mu0l = j < 2 ? m0a[2 * j] : m0b[2 * j - 4], mu0h = j < 2 ? m0a[2 * j + 1] : m0b[2 * j - 3], mu1l = j < 2 ? m1a[2 * j] : m1b[2 * j - 4], mu1h = j < 2 ? m1a[2 * j + 1] : m1b[2 * j - 3];
                { const float x = bflo(b); s[2 * j] = x + mu0l * (bflo(a) - x) + mu1l * (bflo(c) - x); }
                { const float x = bfhi(b); s[2 * j + 1] = x + mu0h * (bfhi(a) - x) + mu1h * (bfhi(c) - x); } } };
        for (int it = tid; it < TB * 24; it += NT) {
            const int t = it / 24, g = it % 24, seg = g >> 3, cc = (g & 7) * 8, js = d == 0 ? t : TB - 1 - t; float s[8]; shift8(t, g * 8, s);
            LAS float* dst = (seg == 0 ? Rr : (seg == 1 ? KR : Vv)) + js * 64 + cc; *(LAS f32x4*)dst = (f32x4){s[0], s[1], s[2], s[3]}; *(LAS f32x4*)(dst + 4) = (f32x4){s[4], s[5], s[6], s[7]};
        }
        { const int t = tid >> 4, g = 24 + (tid & 15), cc = (g & 7) * 8, js = d == 0 ? t : TB - 1 - t; float s[8]; shift8(t, g * 8, s);
          const bool isw = (tid & 15) < 8;
#pragma unroll
          for (int j = 0; j < 8; ++j) { const float th = fast_tanh(s[j]); s[j] = isw ? th : s[j]; }
          LAS bf16_t* dst = (isw ? AWD : AAD) + js * 72 + cc;
          u32x4 w; w.x = cvt_pk_bf16(s[0], s[1]); w.y = cvt_pk_bf16(s[2], s[3]); w.z = cvt_pk_bf16(s[4], s[5]); w.w = cvt_pk_bf16(s[6], s[7]); *(LAS u32x4*)dst = w; }
        __syncthreads();
        if (MODE == 3) continue;
        {
            const int lora = wid >> 2, ct = wid & 3;
            const LAS bf16_t* Am = lora ? AAD : AWD; const LAS bf16_t* Bm = lora ? AUP : WUP;
            float carry = 0.f;
#pragma unroll
            for (int r2 = 0; r2 < 2; ++r2) {
                f32x4 acc = (f32x4){0.f, 0.f, 0.f, 0.f};
#pragma unroll
                for (int ks = 0; ks < 2; ++ks) acc = __builtin_amdgcn_mfma_f32_16x16x32_bf16(ldsb8(Am + (r2 * 16 + fr) * 72 + ks * 32 + fq * 8), ldsb8(Bm + (ct * 16 + fr) * 72 + ks * 32 + fq * 8), acc, 0, 0, 0);
                const int col = ct * 16 + fr;
                if (lora == 0) {
                    float c[4];
#pragma unroll
                    for (int i = 0; i < 4; ++i) { const float lw = acc[i] + CST[col]; const float e = __expf(-fast_softplus(-lw) - 0.5f); c[i] = i ? c[i - 1] + e : e; }
                    const float tot = c[3];
                    float s1 = tot; { const float y = __shfl_up(s1, 16); s1 += fq >= 1 ? y : 0.f; }
                    float s2 = s1;  { const float z = __shfl_up(s1, 32); s2 += fq >= 2 ? z : 0.f; }
                    const float base = carry + s2 - tot;
#pragma unroll
                    for (int i = 0; i < 4; ++i) CUM[(r2 * 16 + fq * 4 + i) * 64 + col] = base + c[i];
                    carry += __shfl(s2, 48 + fr);
                } else {
#pragma unroll
                    for (int i = 0; i < 4; ++i) LA_[(r2 * 16 + fq * 4 + i) * 64 + col] = fast_sigmoid(acc[i] + CST[64 + col]);
                }
            }
        }
        __syncthreads();
        if (MODE == 2) continue;
        {
            const int j = tid >> 4, c4 = (tid & 15) * 4;
            const f32x4 k = *(const LAS f32x4*)(KR + j * 64 + c4), a = *(const LAS f32x4*)(LA_ + j * 64 + c4), r = *(const LAS f32x4*)(Rr + j * 64 + c4), vv = *(const LAS f32x4*)(Vv + j * 64 + c4);
            const f32x4 cu = *(const LAS f32x4*)(CUM + j * 64 + c4); f32x4 cp = (f32x4){0.f, 0.f, 0.f, 0.f}; if (j > 0) cp = *(const LAS f32x4*)(CUM + (j - 1) * 64 + c4);
            float kkr[4], ss = 0.f, bn = 0.f;
#pragma unroll
            for (int x = 0; x < 4; ++x) { kkr[x] = k[x] * CST[128 + c4 + x]; ss += kkr[x] * kkr[x]; }
            ss = allreduce16(ss);
            const float inv = 1.f / fmaxf(sqrtf(ss), 1e-12f);
            float kks[4], bs[4], kds[4], rs[4];
#pragma unroll
            for (int x = 0; x < 4; ++x) { const float kk = kkr[x] * inv, kd = k[x] * (1.f + (a[x] - 1.f) * CST[192 + c4 + x]), bb = kk * a[x];
                const float g = __expf(-cu[x]), gp = __expf(-cp[x]), ig = __expf(cu[x]);
                kks[x] = kk * gp; bs[x] = bb * ig; kds[x] = kd * ig; rs[x] = r[x] * g; bn += r[x] * kd * CST[256 + c4 + x];
                if (j == TB - 1) GC[c4 + x] = g;
            }
#pragma unroll
            for (int x = 0; x < 4; x += 2) { const unsigned pb = cvt_pk_bf16(bs[x], bs[x + 1]), pk = cvt_pk_bf16(kds[x], kds[x + 1]), pv = cvt_pk_bf16(vv[x], vv[x + 1]);
                BST[(c4 + x) * 40 + j] = (bf16_t)pb; BST[(c4 + x + 1) * 40 + j] = (bf16_t)(pb >> 16); KDST[(c4 + x) * 40 + j] = (bf16_t)pk; KDST[(c4 + x + 1) * 40 + j] = (bf16_t)(pk >> 16);
                VT[(c4 + x) * 40 + j] = (bf16_t)pv; VT[(c4 + x + 1) * 40 + j] = (bf16_t)(pv >> 16); }
            bn = allreduce16(bn);
            u32x2 w; w.x = cvt_pk_bf16(kks[0], kks[1]); w.y = cvt_pk_bf16(kks[2], kks[3]); *(LAS u32x2*)(KKS + j * 72 + c4) = w;
            w.x = cvt_pk_bf16(bs[0], bs[1]); w.y = cvt_pk_bf16(bs[2], bs[3]); *(LAS u32x2*)(BS + j * 72 + c4) = w;
            w.x = cvt_pk_bf16(kds[0], kds[1]); w.y = cvt_pk_bf16(kds[2], kds[3]); *(LAS u32x2*)(KDS + j * 72 + c4) = w;
            w.x = cvt_pk_bf16(rs[0], rs[1]); w.y = cvt_pk_bf16(rs[2], rs[3]); *(LAS u32x2*)(RS + j * 72 + c4) = w;
            if ((tid & 15) == 0) BON[j] = bn;
        }
        __syncthreads();
        if (MODE == 1) continue;
        const int ctg = wid & 1;
        f32x4 accG = (f32x4){0.f, 0.f, 0.f, 0.f}, accY = accG;
        {
            const int pr = wid >> 1, rts = wid & 1;
            const LAS bf16_t* Xm = (pr & 1) ? KDS : BS; const LAS bf16_t* Ym = (pr < 2) ? KKS : RS;
            const bf16x8 a0 = ldsb8(Xm + (rts * 16 + fr) * 72 + fq * 8), a1 = ldsb8(Xm + (rts * 16 + fr) * 72 + 32 + fq * 8);
#pragma unroll
            for (int cts = 0; cts < 2; ++cts) {
                f32x4 acc = (f32x4){0.f, 0.f, 0.f, 0.f};
                acc = __builtin_amdgcn_mfma_f32_16x16x32_bf16(a0, ldsb8(Ym + (cts * 16 + fr) * 72 + fq * 8), acc, 0, 0, 0);
                acc = __builtin_amdgcn_mfma_f32_16x16x32_bf16(a1, ldsb8(Ym + (cts * 16 + fr) * 72 + 32 + fq * 8), acc, 0, 0, 0);
                const int t = cts * 16 + fr, s0 = rts * 16 + fq * 4;
#pragma unroll
                for (int i = 0; i < 4; ++i) { const bool keep = (pr < 2) ? (s0 + i < t) : (s0 + i <= t); acc[i] = keep ? acc[i] : 0.f; }
                if (pr == 0) *(LAS f32x4*)(ABT + t * 32 + s0) = acc;
                else { u32x2 w; w.x = cvt_pk_bf16(acc[0], acc[1]); w.y = cvt_pk_bf16(acc[2], acc[3]); *(LAS u32x2*)((pr == 1 ? AKT : (pr == 2 ? NBT : NKT)) + t * 40 + s0) = w; }
            }
#pragma unroll
            for (int ks = 0; ks < 2; ++ks) { const bf16x8 sa = ldsb8(S0B + (rt * 16 + fr) * 72 + ks * 32 + fq * 8);
                accG = __builtin_amdgcn_mfma_f32_16x16x32_bf16(sa, ldsb8(KKS + (ctg * 16 + fr) * 72 + ks * 32 + fq * 8), accG, 0, 0, 0);
                accY = __builtin_amdgcn_mfma_f32_16x16x32_bf16(sa, ldsb8(RS + (ctg * 16 + fr) * 72 + ks * 32 + fq * 8), accY, 0, 0, 0); }
        }
        __syncthreads();
        {
            const bf16x8 va = ldsb8(VT + (rt * 16 + fr) * 40 + fq * 8);
            accG = __builtin_amdgcn_mfma_f32_16x16x32_bf16(va, ldsb8(AKT + (ctg * 16 + fr) * 40 + fq * 8), accG, 0, 0, 0);
            accY = __builtin_amdgcn_mfma_f32_16x16x32_bf16(va, ldsb8(NKT + (ctg * 16 + fr) * 40 + fq * 8), accY, 0, 0, 0);
#pragma unroll
            for (int i = 0; i < 4; ++i) Gm[(rt * 16 + fq * 4 + i) * 36 + ctg * 16 + fr] = -accG[i];
        }
        __syncthreads();
        if (MODE == 4) continue;
        if (wid < 4) {
            const int v = wid * 16 + (lane >> 2), pq = lane & 3;
            const LAS float* grow = Gm + v * 36;
            f32x4 r0 = *(const LAS f32x4*)(grow + 4 * pq), r1 = *(const LAS f32x4*)(grow + 16 + 4 * pq);
            u32x2 ubo[TB / 4];
            const LAS float* abd = ABT; asm volatile("" : "+v"(abd));
            const LAS float* abq = ABT + 128 * pq; asm volatile("" : "+v"(abq));
            f32x4 dc[3], a0c[4], a1c[4];
            auto ldg = [&](int g, f32x4 (&dd)[3], f32x4 (&aa0)[4], f32x4 (&aa1)[4]) {
#pragma unroll
                for (int x = 0; x < 3; ++x) dd[x] = *(const LAS f32x4*)(abd + (4 * g + 1 + x) * 32 + 4 * g);
#pragma unroll
                for (int jj = 0; jj < 4; ++jj) { if (g < 3) aa0[jj] = *(const LAS f32x4*)(abq + jj * 32 + 4 * g); if (g < 7) aa1[jj] = *(const LAS f32x4*)(abq + (16 + jj) * 32 + 4 * g); } };
            ldg(0, dc, a0c, a1c);
#pragma unroll
            for (int g = 0; g < TB / 4; ++g) {
                f32x4 dn[3], a0n[4], a1n[4];
                if (g + 1 < TB / 4) ldg(g + 1, dn, a0n, a1n);
                __builtin_amdgcn_sched_barrier(0);
                const f32x4 rr = g < 4 ? r0 : r1;
                f32x4 u4;
                u4[0] = rr[0];
                u4[1] = rr[1] - u4[0] * dc[0][0];
                u4[2] = rr[2] - (u4[0] * dc[1][0] + u4[1] * dc[1][1]);
                u4[3] = rr[3] - (u4[0] * dc[2][0] + u4[1] * dc[2][1] + u4[2] * dc[2][2]);
#pragma unroll
                for (int x = 0; x < 4; ++x) { const int ui = __float_as_int(u4[x]); int bi;
                    if ((g & 3) == 0) bi = __builtin_amdgcn_update_dpp(0, ui, 0x00, 0xF, 0xF, true); else if ((g & 3) == 1) bi = __builtin_amdgcn_update_dpp(0, ui, 0x55, 0xF, 0xF, true);
                    else if ((g & 3) == 2) bi = __builtin_amdgcn_update_dpp(0, ui, 0xAA, 0xF, 0xF, true); else bi = __builtin_amdgcn_update_dpp(0, ui, 0xFF, 0xF, 0xF, true);
                    u4[x] = __int_as_float(bi); }
                ubo[g].x = cvt_pk_bf16(u4[0], u4[1]); ubo[g].y = cvt_pk_bf16(u4[2], u4[3]);
                if (g < 3) {
#pragma unroll
                    for (int jj = 0; jj < 4; ++jj) r0[jj] -= u4[0] * a0c[jj][0] + u4[1] * a0c[jj][1] + u4[2] * a0c[jj][2] + u4[3] * a0c[jj][3]; }
                if (g < 7) {
#pragma unroll
                    for (int jj = 0; jj < 4; ++jj) r1[jj] -= u4[0] * a1c[jj][0] + u4[1] * a1c[jj][1] + u4[2] * a1c[jj][2] + u4[3] * a1c[jj][3]; }
                if (g + 1 < TB / 4) {
#pragma unroll
                    for (int x = 0; x < 3; ++x) dc[x] = dn[x];
#pragma unroll
                    for (int jj = 0; jj < 4; ++jj) { a0c[jj] = a0n[jj]; a1c[jj] = a1n[jj]; } }
            }
            if (pq == 0) {
#pragma unroll
                for (int g = 0; g < TB / 4; g += 2) { u32x4 w; w.x = ubo[g].x; w.y = ubo[g].y; w.z = ubo[g + 1].x; w.w = ubo[g + 1].y; *(LAS u32x4*)(UB + v * 40 + 4 * g) = w; } }
        }
        __syncthreads();
        if (MODE == 5) continue;
        {
            const bf16x8 ua = ldsb8(UB + (rt * 16 + fr) * 40 + fq * 8), va = ldsb8(VT + (rt * 16 + fr) * 40 + fq * 8);
            accY = __builtin_amdgcn_mfma_f32_16x16x32_bf16(ua, ldsb8(NBT + (ctg * 16 + fr) * 40 + fq * 8), accY, 0, 0, 0);
            *(LAS f32x4*)(YO + (ctg * 16 + fr) * 64 + rt * 16 + fq * 4) = accY;
#pragma unroll
            for (int cc = 0; cc < 2; ++cc) { const int ct = 2 * (wid & 1) + cc, kcol = ct * 16 + fr;
                f32x4 acc = Sreg[cc];
                acc = __builtin_amdgcn_mfma_f32_16x16x32_bf16(ua, ldsb8(BST + kcol * 40 + fq * 8), acc, 0, 0, 0);
                acc = __builtin_amdgcn_mfma_f32_16x16x32_bf16(va, ldsb8(KDST + kcol * 40 + fq * 8), acc, 0, 0, 0);
                const float g = GC[kcol];
#pragma unroll
                for (int i = 0; i < 4; ++i) acc[i] *= g;
                { const unsigned p0 = cvt_pk_bf16(acc[0], acc[1]), p1 = cvt_pk_bf16(acc[2], acc[3]); LAS bf16_t* sp = S0B + (rt * 16 + fq * 4) * 72 + kcol;
                  sp[0] = (bf16_t)p0; sp[72] = (bf16_t)(p0 >> 16); sp[144] = (bf16_t)p1; sp[216] = (bf16_t)(p1 >> 16); }
                Sreg[cc] = acc; }
        }
        __syncthreads();
        if (!isctx) {
            const int j = tid >> 4, c4 = (tid & 15) * 4, t = d == 0 ? j : TB - 1 - j; const f32x4 y = *(const LAS f32x4*)(YO + j * 64 + c4);
            u32x2 w; w.x = cvt_pk_bf16(y[0], y[1]); w.y = cvt_pk_bf16(y[2], y[3]);
            bf16_t* yb_ = p.Y + ((size_t)d * nlat + grow0) * RW + h * 64;
            *(u32x2*)(yb_ + t * RW + c4) = w;
            if (tid < TB) { const int tt = d == 0 ? tid : TB - 1 - tid; float* bb_ = p.bon + ((size_t)d * nlat + grow0) * NH + h; bb_[tt * NH] = BON[tid]; }
        }
    }
}
template <int MODE = 0>
__device__ __forceinline__ void rwkv_phase2(LAS unsigned char* lds, const In& in, const RwkvP p, int bid, int nblk) {
    const int nchain = 2 * p.nb * NH;
    for (int c = bid; c < nchain; c += nblk) { rwkv_chain2<MODE>(lds, in, p, c); __syncthreads(); }
}
}

namespace mk {
namespace r3 {
constexpr int C2_RAW = 0;
constexpr int C2_MU = C2_RAW + (TB + 2) * RAWW * 2;
constexpr int C2_WUP = C2_MU + 3 * RAWW * 4;
constexpr int C2_AUP = C2_WUP + 64 * 72 * 2;
constexpr int C2_CST = C2_AUP + 64 * 72 * 2;
constexpr int C2_AWD = C2_CST + 5 * 64 * 4;
constexpr int C2_AAD = C2_AWD + TB * 72 * 2;
constexpr int C2_X = C2_AAD + TB * 72 * 2;
constexpr int C2_G = C2_X;
constexpr int C2_UB = C2_G + 64 * 36 * 4;
constexpr int C2_ABT = C2_UB + 64 * 40 * 2;
constexpr int C2_AKT = C2_ABT + 32 * 32 * 4;
constexpr int C2_NBT = C2_AKT + 32 * 40 * 2;
constexpr int C2_NKT = C2_NBT + 32 * 40 * 2;
constexpr int C2_YO = C2_NKT + 32 * 40 * 2;
constexpr int C2_X_END = C2_YO + TB * 64 * 4;
constexpr int C2_KKS = C2_X_END;
constexpr int C2_BS = C2_KKS + TB * 72 * 2, C2_KDS = C2_BS + TB * 72 * 2, C2_RS = C2_KDS + TB * 72 * 2;
constexpr int C2_BST = C2_RS + TB * 72 * 2;
constexpr int C2_KDST = C2_BST + 64 * 40 * 2;
constexpr int C2_VT = C2_KDST + 64 * 40 * 2;
constexpr int C2_S0B = C2_VT + 64 * 40 * 2;
constexpr int C2_GC = C2_S0B + 64 * 72 * 2;
constexpr int C2_BON = C2_GC + 64 * 4;
constexpr int C2_RB = C2_BON + TB * 4;
constexpr int C2_KRB = C2_RB + TB * 64 * 2, C2_VB = C2_KRB + TB * 64 * 2;
constexpr int C2_LA = C2_VB + TB * 64 * 2;
constexpr int C2_CUM = C2_LA + TB * 64 * 4;
constexpr int C2_BON2 = C2_CUM + (TB + 1) * 64 * 4;
constexpr int C2_END = C2_BON2 + TB * 4;
static_assert(C2_END <= LDS_BYTES - 16 && (C2_X % 16) == 0 && (C2_KKS % 16) == 0 && (C2_G % 16) == 0 && (C2_UB % 16) == 0 && (C2_ABT % 16) == 0 && (C2_AKT % 16) == 0 && (C2_S0B % 16) == 0, "rwkv2 LDS");

__device__ __forceinline__ bf16x8 ldsb8(const LAS bf16_t* p) { return *(const LAS bf16x8*)p; }

template <int MODE>
__device__ __forceinline__ void rwkv_chain3(LAS unsigned char* lds, const In& in, const RwkvP p, int chain) {
    const int tid = threadIdx.x, lane = tid & 63, wid = tid >> 6, fr = lane & 15, fq = lane >> 4;
    const int d = chain / (p.nb * NH), bl = (chain / NH) % p.nb, h = chain % NH;
    const int nlat = p.nb * SEQ;
    LAS bf16_t* RAW = (LAS bf16_t*)(lds + C2_RAW); LAS float* MU = (LAS float*)(lds + C2_MU);
    LAS bf16_t* WUP = (LAS bf16_t*)(lds + C2_WUP); LAS bf16_t* AUP = (LAS bf16_t*)(lds + C2_AUP); LAS float* CST = (LAS float*)(lds + C2_CST);
    LAS bf16_t* AWD = (LAS bf16_t*)(lds + C2_AWD); LAS bf16_t* AAD = (LAS bf16_t*)(lds + C2_AAD);
    LAS bf16_t *Rb = (LAS bf16_t*)(lds + C2_RB), *KRb = (LAS bf16_t*)(lds + C2_KRB), *Vb = (LAS bf16_t*)(lds + C2_VB); LAS float *LA_ = (LAS float*)(lds + C2_LA), *CUM = (LAS float*)(lds + C2_CUM);
    LAS float *YO = (LAS float*)(lds + C2_YO), *Gm = (LAS float*)(lds + C2_G), *ABT = (LAS float*)(lds + C2_ABT), *GC = (LAS float*)(lds + C2_GC), *BON = (LAS float*)(lds + C2_BON);
    LAS bf16_t *UB = (LAS bf16_t*)(lds + C2_UB), *AKT = (LAS bf16_t*)(lds + C2_AKT), *NBT = (LAS bf16_t*)(lds + C2_NBT), *NKT = (LAS bf16_t*)(lds + C2_NKT);
    LAS bf16_t *KKS = (LAS bf16_t*)(lds + C2_KKS), *BS = (LAS bf16_t*)(lds + C2_BS), *KDS = (LAS bf16_t*)(lds + C2_KDS), *RS = (LAS bf16_t*)(lds + C2_RS);
    LAS bf16_t *BST = (LAS bf16_t*)(lds + C2_BST), *KDST = (LAS bf16_t*)(lds + C2_KDST), *VT = (LAS bf16_t*)(lds + C2_VT), *S0B = (LAS bf16_t*)(lds + C2_S0B);
    auto segcol = [&](int s) __attribute__((always_inline)) { return s < 3 ? s * RW + h * 64 : (s == 3 ? OFF_WD + d * DL : OFF_AD + d * AL); };
    for (int i = tid; i < RAWW; i += NT) { const float m0 = in.shift_mu[segcol(i >> 6) + (i & 63)], m1 = in.shift_mu[RC + segcol(i >> 6) + (i & 63)]; MU[i] = m0; MU[RAWW + i] = m1; MU[2 * RAWW + i] = 1.f - m0 - m1; }
    for (int i = tid; i < 64 * 64; i += NT) { const int j = i >> 6, c = i & 63;
        WUP[c * 72 + j] = f2bf(in.rw_w_up[((size_t)d * DL + j) * RW + h * 64 + c]); AUP[c * 72 + j] = f2bf(in.rw_a_up[((size_t)d * AL + j) * RW + h * 64 + c]); }
    for (int i = tid; i < 64; i += NT) { CST[i] = in.rw_w0[d * RW + h * 64 + i]; CST[64 + i] = in.rw_a0[d * RW + h * 64 + i]; CST[128 + i] = in.rw_k_k[h * 64 + i]; CST[192 + i] = in.rw_k_a[h * 64 + i]; CST[256 + i] = in.rw_r_k[h * 64 + i]; }
    for (int i = tid; i < 64 * 72 / 2; i += NT) ((LAS unsigned*)S0B)[i] = 0u;
    constexpr int NQ = (CTX + SEQ) / TB, NQC = CTX / TB;
    auto blk_info = [&](int q, bool& isctx, int& t0, bool& hp, bool& hn, size_t& grow0) __attribute__((always_inline)) {
        isctx = q < NQC;
        if (isctx) { const int qq = d == 0 ? q : NQC - 1 - q; t0 = qq * TB; hp = t0 > 0; hn = t0 + TB < CTX; grow0 = (size_t)nlat + (size_t)bl * CTX + t0; }
        else { const int ql = q - NQC, qq = d == 0 ? ql : SEQ / TB - 1 - ql; t0 = qq * TB; hp = (t0 % GW) != 0; hn = ((t0 + TB) % GW) != 0; grow0 = (size_t)bl * SEQ + t0; }
    };
    u32x4 pre[RW_PPT]; int poff[RW_PPT], plds[RW_PPT];
#pragma unroll
    for (int k = 0; k < RW_PPT; ++k) { const int i = tid + k * NT, rr = i / 40, sp = i % 40, seg = sp >> 3, part = sp & 7;
        poff[k] = (rr - 1) * Z1_N + segcol(seg) + part * 8; plds[k] = (rr * RAWW + sp * 8) | (i >= RW_NPIECE ? 3 : (rr == 0 ? 1 : (rr == TB + 1 ? 2 : 0))); }
    auto prefetch = [&](int q) __attribute__((always_inline)) {
        bool isctx, hp, hn; int t0; size_t grow0; blk_info(q, isctx, t0, hp, hn, grow0);
        const bf16_t* base = p.z1 + grow0 * Z1_N;
#pragma unroll
        for (int k = 0; k < RW_PPT; ++k) { u32x4 v = (u32x4){0u, 0u, 0u, 0u};
            const int kind = plds[k] & 3; const bool ok = kind == 0 || (kind == 1 && hp) || (kind == 2 && hn);
            if (ok) v = *(const u32x4*)(base + poff[k]);
            pre[k] = v; }
    };
    auto commit = [&]() __attribute__((always_inline)) {
#pragma unroll
        for (int k = 0; k < RW_PPT; ++k) if ((plds[k] & 3) != 3) *(LAS u32x4*)(RAW + (plds[k] & ~3)) = pre[k];
    };
    f32x4 Sreg[2];
    Sreg[0] = (f32x4){0.f, 0.f, 0.f, 0.f}; Sreg[1] = Sreg[0];
    const int rt = wid >> 1;
    auto shift8 = [&](int t, int c0, f32x2 (&s)[4]) __attribute__((always_inline)) {
        const u32x4 xp = *(const LAS u32x4*)(RAW + t * RAWW + c0), xc = *(const LAS u32x4*)(RAW + (t + 1) * RAWW + c0), xn_ = *(const LAS u32x4*)(RAW + (t + 2) * RAWW + c0);
        const f32x4 m0a = *(const LAS f32x4*)(MU + c0), m0b = *(const LAS f32x4*)(MU + c0 + 4), m1a = *(const LAS f32x4*)(MU + RAWW + c0), m1b = *(const LAS f32x4*)(MU + RAWW + c0 + 4),
                    mca = *(const LAS f32x4*)(MU + 2 * RAWW + c0), mcb = *(const LAS f32x4*)(MU + 2 * RAWW + c0 + 4);
#define MK_SH2(J, XP, XC, XN, MC2, M02, M12) { f32x2 C, P, N; C.x = bflo(XC); C.y = bfhi(XC); P.x = bflo(XP); P.y = bfhi(XP); N.x = bflo(XN); N.y = bfhi(XN); f32x2 r_ = MC2 * C; r_ = M02 * P + r_; r_ = M12 * N + r_; s[J] = r_; }
        MK_SH2(0, xp.x, xc.x, xn_.x, mca.lo, m0a.lo, m1a.lo) MK_SH2(1, xp.y, xc.y, xn_.y, mca.hi, m0a.hi, m1a.hi)
        MK_SH2(2, xp.z, xc.z, xn_.z, mcb.lo, m0b.lo, m1b.lo) MK_SH2(3, xp.w, xc.w, xn_.w, mcb.hi, m0b.hi, m1b.hi)
#undef MK_SH2
    };
    auto pack4 = [&](const f32x2 (&s)[4]) __attribute__((always_inline)) { u32x4 w; w.x = cvt_pk_bf16(s[0].x, s[0].y); w.y = cvt_pk_bf16(s[1].x, s[1].y); w.z = cvt_pk_bf16(s[2].x, s[2].y); w.w = cvt_pk_bf16(s[3].x, s[3].y); return w; };
    int sh_t[3], sh_c[3], sh_d[3];
#pragma unroll
    for (int k = 0; k < 3; ++k) { const int it = (tid & (NT / 2 - 1)) + k * (NT / 2), t = it / 24, g = it % 24, seg = g >> 3, cc = (g & 7) * 8, js = d == 0 ? t : TB - 1 - t;
        sh_t[k] = t; sh_c[k] = g * 8; sh_d[k] = seg * (TB * 64) + js * 64 + cc; }
    auto do_shift = [&](int tl, int nth) __attribute__((always_inline)) {
#pragma unroll
        for (int k = 0; k < 3; ++k) { f32x2 s[4]; shift8(sh_t[k], sh_c[k], s); *(LAS u32x4*)(Rb + sh_d[k]) = pack4(s); }
#pragma unroll 1
        for (int it = tl; it < TB * 8; it += nth) { const int t = it >> 3, part = it & 7, js = d == 0 ? t : TB - 1 - t;
            { f32x2 s[4]; shift8(t, (24 + part) * 8, s);
#pragma unroll
              for (int j = 0; j < 4; ++j) { s[j].x = 1.f - 2.f * fast_rcp(1.f + __builtin_amdgcn_exp2f(2.885390081777927f * s[j].x)); s[j].y = 1.f - 2.f * fast_rcp(1.f + __builtin_amdgcn_exp2f(2.885390081777927f * s[j].y)); }
              *(LAS u32x4*)(AWD + js * 72 + part * 8) = pack4(s); }
            { f32x2 s[4]; shift8(t, (32 + part) * 8, s); *(LAS u32x4*)(AAD + js * 72 + part * 8) = pack4(s); }
        }
    };
    auto lora_stage = [&]() __attribute__((always_inline)) {
        {
            const int lora = wid >> 2, ct = wid & 3;
            const LAS bf16_t* Am = lora ? AAD : AWD; const LAS bf16_t* Bm = lora ? AUP : WUP;
            float carry = 0.f;
#pragma unroll
            for (int r2 = 0; r2 < 2; ++r2) {
                f32x4 acc = (f32x4){0.f, 0.f, 0.f, 0.f};
#pragma unroll
                for (int ks = 0; ks < 2; ++ks) acc = __builtin_amdgcn_mfma_f32_16x16x32_bf16(ldsb8(Am + (r2 * 16 + fr) * 72 + ks * 32 + fq * 8), ldsb8(Bm + (ct * 16 + fr) * 72 + ks * 32 + fq * 8), acc, 0, 0, 0);
                const int col = ct * 16 + fr;
                if (lora == 0) {
                    float c[4];
#pragma unroll
                    for (int i = 0; i < 4; ++i) { const float lw = acc[i] + CST[col]; const float e = fast_sigmoid(lw); c[i] = i ? c[i - 1] + e : e;   }
                    const float tot = c[3];
                    float s1 = tot; { const float y = __shfl_up(s1, 16); s1 += fq >= 1 ? y : 0.f; }
                    float s2 = s1;  { const float z = __shfl_up(s1, 32); s2 += fq >= 2 ? z : 0.f; }
                    const float base = carry + s2 - tot;
#pragma unroll
                    for (int i = 0; i < 4; ++i) CUM[(1 + r2 * 16 + fq * 4 + i) * 64 + col] = base + c[i];
                    carry += __shfl(s2, 48 + fr);
                } else {
#pragma unroll
                    for (int i = 0; i < 4; ++i) LA_[(r2 * 16 + fq * 4 + i) * 64 + col] = fast_sigmoid(acc[i] + CST[64 + col]);
                }
            }
        }
    };
    auto scale_stage = [&](LAS float* bonw) __attribute__((always_inline)) {
        {
            const int j = tid >> 4, c4 = (tid & 15) * 4;
            const u32x2 kp = *(const LAS u32x2*)(KRb + j * 64 + c4), rp = *(const LAS u32x2*)(Rb + j * 64 + c4), vp = *(const LAS u32x2*)(Vb + j * 64 + c4);
            const f32x4 k = (f32x4){bflo(kp.x), bfhi(kp.x), bflo(kp.y), bfhi(kp.y)}, r = (f32x4){bflo(rp.x), bfhi(rp.x), bflo(rp.y), bfhi(rp.y)};
            const f32x4 a = *(const LAS f32x4*)(LA_ + j * 64 + c4);
            const f32x4 cu = *(const LAS f32x4*)(CUM + (j + 1) * 64 + c4), cp = *(const LAS f32x4*)(CUM + j * 64 + c4);
            const f32x4 ckk = *(const LAS f32x4*)(CST + 128 + c4), cka = *(const LAS f32x4*)(CST + 192 + c4), crk = *(const LAS f32x4*)(CST + 256 + c4);
            float kkr[4], kd[4], ss = 0.f, bn = 0.f;
#pragma unroll
            for (int x = 0; x < 4; ++x) { kkr[x] = k[x] * ckk[x]; ss += kkr[x] * kkr[x]; kd[x] = k[x] * (1.f + (a[x] - 1.f) * cka[x]); bn += r[x] * kd[x] * crk[x]; }
            asm volatile("s_nop 1\n\t"
                "v_add_f32_dpp %0, %0, %0 quad_perm:[1,0,3,2] row_mask:0xf bank_mask:0xf\n\t" "v_add_f32_dpp %1, %1, %1 quad_perm:[1,0,3,2] row_mask:0xf bank_mask:0xf\n\ts_nop 0\n\t"
                "v_add_f32_dpp %0, %0, %0 quad_perm:[2,3,0,1] row_mask:0xf bank_mask:0xf\n\t" "v_add_f32_dpp %1, %1, %1 quad_perm:[2,3,0,1] row_mask:0xf bank_mask:0xf\n\ts_nop 0\n\t"
                "v_add_f32_dpp %0, %0, %0 row_half_mirror row_mask:0xf bank_mask:0xf\n\t" "v_add_f32_dpp %1, %1, %1 row_half_mirror row_mask:0xf bank_mask:0xf\n\ts_nop 0\n\t"
                "v_add_f32_dpp %0, %0, %0 row_mirror row_mask:0xf bank_mask:0xf\n\t" "v_add_f32_dpp %1, %1, %1 row_mirror row_mask:0xf bank_mask:0xf"
                : "+v"(ss), "+v"(bn));
            const float inv = __builtin_amdgcn_rsqf(fmaxf(ss, 1e-24f));
            float kks[4], bs[4], kds[4], rs[4]; f32x4 gv;
#pragma unroll
            for (int x = 0; x < 4; ++x) { const float kk = kkr[x] * inv, bb = kk * a[x];
                const float ig = __builtin_amdgcn_exp2f(0.87503877f * cu[x]), g = fast_rcp(ig), gp = __builtin_amdgcn_exp2f(-0.87503877f * cp[x]);
                kks[x] = kk * gp; bs[x] = bb * ig; kds[x] = kd[x] * ig; rs[x] = r[x] * g; gv[x] = g;
            }
            if (j == TB - 1) *(LAS f32x4*)(GC + c4) = gv;
#pragma unroll
            for (int x = 0; x < 4; x += 2) { const unsigned pb = cvt_pk_bf16(bs[x], bs[x + 1]), pk = cvt_pk_bf16(kds[x], kds[x + 1]), pv = x ? vp.y : vp.x;
                BST[(c4 + x) * 40 + j] = (bf16_t)pb; BST[(c4 + x + 1) * 40 + j] = (bf16_t)(pb >> 16); KDST[(c4 + x) * 40 + j] = (bf16_t)pk; KDST[(c4 + x + 1) * 40 + j] = (bf16_t)(pk >> 16);
                VT[(c4 + x) * 40 + j] = (bf16_t)pv; VT[(c4 + x + 1) * 40 + j] = (bf16_t)(pv >> 16); }
            u32x2 w; w.x = cvt_pk_bf16(kks[0], kks[1]); w.y = cvt_pk_bf16(kks[2], kks[3]); *(LAS u32x2*)(KKS + j * 72 + c4) = w;
            w.x = cvt_pk_bf16(bs[0], bs[1]); w.y = cvt_pk_bf16(bs[2], bs[3]); *(LAS u32x2*)(BS + j * 72 + c4) = w;
            w.x = cvt_pk_bf16(kds[0], kds[1]); w.y = cvt_pk_bf16(kds[2], kds[3]); *(LAS u32x2*)(KDS + j * 72 + c4) = w;
            w.x = cvt_pk_bf16(rs[0], rs[1]); w.y = cvt_pk_bf16(rs[2], rs[3]); *(LAS u32x2*)(RS + j * 72 + c4) = w;
            if ((tid & 15) == 0) bonw[j] = bn;
        }
    };
    if (tid < 16) *(LAS f32x4*)(CUM + tid * 4) = (f32x4){0.f, 0.f, 0.f, 0.f};
    prefetch(0);
    commit();
    __syncthreads();
    if (1 < NQ) prefetch(1);
    do_shift(tid & (NT / 2 - 1), NT / 2);
    __syncthreads();
    lora_stage();
    __syncthreads();
    scale_stage(BON);
    __syncthreads();
    for (int q = 0; q < NQ; ++q) {
        bool isctx, hp, hn; int t0; size_t grow0; blk_info(q, isctx, t0, hp, hn, grow0);
        LAS float* bonr = BON + (q & 1) * ((C2_BON2 - C2_BON) / 4); LAS float* bonn = BON + ((q + 1) & 1) * ((C2_BON2 - C2_BON) / 4);
        const int ctg = wid & 1;
        f32x4 accG = (f32x4){0.f, 0.f, 0.f, 0.f}, accY = accG;
        {
            const int pr = wid >> 1, rts = wid & 1;
            const LAS bf16_t* Xm = (pr & 1) ? KDS : BS; const LAS bf16_t* Ym = (pr < 2) ? KKS : RS;
            const bf16x8 a0 = ldsb8(Xm + (rts * 16 + fr) * 72 + fq * 8), a1 = ldsb8(Xm + (rts * 16 + fr) * 72 + 32 + fq * 8);
#pragma unroll
            for (int cts = 0; cts < 2; ++cts) {
                f32x4 acc = (f32x4){0.f, 0.f, 0.f, 0.f};
                acc = __builtin_amdgcn_mfma_f32_16x16x32_bf16(a0, ldsb8(Ym + (cts * 16 + fr) * 72 + fq * 8), acc, 0, 0, 0);
                acc = __builtin_amdgcn_mfma_f32_16x16x32_bf16(a1, ldsb8(Ym + (cts * 16 + fr) * 72 + 32 + fq * 8), acc, 0, 0, 0);
                const int t = cts * 16 + fr, s0 = rts * 16 + fq * 4;
#pragma unroll
                for (int i = 0; i < 4; ++i) { const bool keep = (pr < 2) ? (s0 + i < t) : (s0 + i <= t); acc[i] = keep ? acc[i] : 0.f; }
                if (pr == 0) { ABT[s0 * 32 + t] = acc[0]; ABT[(s0 + 1) * 32 + t] = acc[1]; ABT[(s0 + 2) * 32 + t] = acc[2]; ABT[(s0 + 3) * 32 + t] = acc[3]; }
                else { u32x2 w; w.x = cvt_pk_bf16(acc[0], acc[1]); w.y = cvt_pk_bf16(acc[2], acc[3]); *(LAS u32x2*)((pr == 1 ? AKT : (pr == 2 ? NBT : NKT)) + t * 40 + s0) = w; }
            }
#pragma unroll
            for (int ks = 0; ks < 2; ++ks) { const bf16x8 sa = ldsb8(S0B + (rt * 16 + fr) * 72 + ks * 32 + fq * 8);
                accG = __builtin_amdgcn_mfma_f32_16x16x32_bf16(sa, ldsb8(KKS + (ctg * 16 + fr) * 72 + ks * 32 + fq * 8), accG, 0, 0, 0);
                accY = __builtin_amdgcn_mfma_f32_16x16x32_bf16(sa, ldsb8(RS + (ctg * 16 + fr) * 72 + ks * 32 + fq * 8), accY, 0, 0, 0); }
        }
        __syncthreads();
        {
            const bf16x8 va = ldsb8(VT + (rt * 16 + fr) * 40 + fq * 8);
            accG = __builtin_amdgcn_mfma_f32_16x16x32_bf16(va, ldsb8(AKT + (ctg * 16 + fr) * 40 + fq * 8), accG, 0, 0, 0);
            accY = __builtin_amdgcn_mfma_f32_16x16x32_bf16(va, ldsb8(NKT + (ctg * 16 + fr) * 40 + fq * 8), accY, 0, 0, 0);
#pragma unroll
            for (int i = 0; i < 4; ++i) Gm[(rt * 16 + fq * 4 + i) * 36 + ctg * 16 + fr] = -accG[i];
            if (q + 1 < NQ) { commit(); if (q + 2 < NQ) prefetch(q + 2); }
        }
        __syncthreads();
        if (wid >= 4) { if (q + 1 < NQ) do_shift(tid & (NT / 2 - 1), NT / 2); }
        else {
            const int v = wid * 16 + (lane >> 2), pq = lane & 3;
            const LAS float* grow = Gm + v * 36;
            f32x4 r0 = *(const LAS f32x4*)(grow + 4 * pq), r1 = *(const LAS f32x4*)(grow + 16 + 4 * pq);
            u32x2 ubo[TB / 4];
            const LAS float* abq = ABT + 4 * pq; asm volatile("" : "+v"(abq));
            f32x4 a0c[4], a1c[4];
            auto ldg = [&](int g, f32x4 (&aa0)[4], f32x4 (&aa1)[4]) __attribute__((always_inline)) {
#pragma unroll
                for (int x = 0; x < 4; ++x) { if (g < 4) aa0[x] = *(const LAS f32x4*)(abq + (4 * g + x) * 32); aa1[x] = *(const LAS f32x4*)(abq + (4 * g + x) * 32 + 16); } };
            ldg(0, a0c, a1c);
#pragma unroll
            for (int g = 0; g < TB / 4; ++g) {
                f32x4 a0n[4], a1n[4];
                if (g + 1 < TB / 4) ldg(g + 1, a0n, a1n);
                __builtin_amdgcn_sched_barrier(0);
                const f32x4 rr = g < 4 ? r0 : r1;
                f32x4 dg[3];
#pragma unroll
                for (int x = 0; x < 3; ++x) dg[x] = g < 4 ? a0c[x] : a1c[x];
                f32x4 u4;
                u4[0] = rr[0];
                u4[1] = __builtin_fmaf(-u4[0], dg[0][1], rr[1]);
                u4[2] = __builtin_fmaf(-u4[1], dg[1][2], __builtin_fmaf(-u4[0], dg[0][2], rr[2]));
                u4[3] = __builtin_fmaf(-u4[2], dg[2][3], __builtin_fmaf(-u4[1], dg[1][3], __builtin_fmaf(-u4[0], dg[0][3], rr[3])));
#pragma unroll
                for (int x = 0; x < 4; ++x) { const int ui = __float_as_int(u4[x]); int bi;
                    if ((g & 3) == 0) bi = __builtin_amdgcn_update_dpp(0, ui, 0x00, 0xF, 0xF, true); else if ((g & 3) == 1) bi = __builtin_amdgcn_update_dpp(0, ui, 0x55, 0xF, 0xF, true);
                    else if ((g & 3) == 2) bi = __builtin_amdgcn_update_dpp(0, ui, 0xAA, 0xF, 0xF, true); else bi = __builtin_amdgcn_update_dpp(0, ui, 0xFF, 0xF, 0xF, true);
                    u4[x] = __int_as_float(bi); }
                ubo[g].x = cvt_pk_bf16(u4[0], u4[1]); ubo[g].y = cvt_pk_bf16(u4[2], u4[3]);
                if (g < 3) {
                    f32x2 lo = r0.lo, hi = r0.hi;
#pragma unroll
                    for (int x = 0; x < 4; ++x) { const f32x2 ux = (f32x2){u4[x], u4[x]}; lo = lo - ux * a0c[x].lo; hi = hi - ux * a0c[x].hi; }
                    r0.lo = lo; r0.hi = hi; }
                if (g < 7) {
                    f32x2 lo = r1.lo, hi = r1.hi;
#pragma unroll
                    for (int x = 0; x < 4; ++x) { const f32x2 ux = (f32x2){u4[x], u4[x]}; lo = lo - ux * a1c[x].lo; hi = hi - ux * a1c[x].hi; }
                    r1.lo = lo; r1.hi = hi; }
                if (g + 1 < TB / 4) {
#pragma unroll
                    for (int x = 0; x < 4; ++x) { a0c[x] = a0n[x]; a1c[x] = a1n[x]; } }
            }
            if (pq == 0) {
#pragma unroll
                for (int g = 0; g < TB / 4; g += 2) { u32x4 w; w.x = ubo[g].x; w.y = ubo[g].y; w.z = ubo[g + 1].x; w.w = ubo[g + 1].y; *(LAS u32x4*)(UB + v * 40 + 4 * g) = w; } }
        }
        __syncthreads();
        {
            const bf16x8 ua = ldsb8(UB + (rt * 16 + fr) * 40 + fq * 8), va = ldsb8(VT + (rt * 16 + fr) * 40 + fq * 8);
            accY = __builtin_amdgcn_mfma_f32_16x16x32_bf16(ua, ldsb8(NBT + (ctg * 16 + fr) * 40 + fq * 8), accY, 0, 0, 0);
            *(LAS f32x4*)(YO + (ctg * 16 + fr) * 64 + rt * 16 + fq * 4) = accY;
#pragma unroll
            for (int cc = 0; cc < 2; ++cc) { const int ct = 2 * (wid & 1) + cc, kcol = ct * 16 + fr;
                f32x4 acc = Sreg[cc];
                acc = __builtin_amdgcn_mfma_f32_16x16x32_bf16(ua, ldsb8(BST + kcol * 40 + fq * 8), acc, 0, 0, 0);
                acc = __builtin_amdgcn_mfma_f32_16x16x32_bf16(va, ldsb8(KDST + kcol * 40 + fq * 8), acc, 0, 0, 0);
                const float g = GC[kcol];
#pragma unroll
                for (int i = 0; i < 4; ++i) acc[i] *= g;
                { const unsigned p0 = cvt_pk_bf16(acc[0], acc[1]), p1 = cvt_pk_bf16(acc[2], acc[3]); LAS bf16_t* sp = S0B + (rt * 16 + fq * 4) * 72 + kcol;
                  sp[0] = (bf16_t)p0; sp[72] = (bf16_t)(p0 >> 16); sp[144] = (bf16_t)p1; sp[216] = (bf16_t)(p1 >> 16); }
                Sreg[cc] = acc; }
        }
        if (q + 1 < NQ) lora_stage();
        __syncthreads();
        if (!isctx) {
            const int j = tid >> 4, c4 = (tid & 15) * 4, t = d == 0 ? j : TB - 1 - j; const f32x4 y = *(const LAS f32x4*)(YO + j * 64 + c4);
            u32x2 w; w.x = cvt_pk_bf16(y[0], y[1]); w.y = cvt_pk_bf16(y[2], y[3]);
            bf16_t* yb_ = p.Y + ((size_t)d * nlat + grow0) * RW + h * 64;
            *(u32x2*)(yb_ + t * RW + c4) = w;
            if (tid < TB) { const int tt = d == 0 ? tid : TB - 1 - tid; float* bb_ = p.bon + ((size_t)d * nlat + grow0) * NH + h; bb_[tt * NH] = bonr[tid]; }
        }
        if (q + 1 < NQ) scale_stage(bonn);
        __syncthreads();
    }
}
template <int MODE = 0>
__device__ __forceinline__ void rwkv_phase3(LAS unsigned char* lds, const In& in, const RwkvP p, int bid, int nblk) {
    const int nchain = 2 * p.nb * NH;
    for (int c = bid; c < nchain; c += nblk) { rwkv_chain3<MODE>(lds, in, p, c); __syncthreads(); }
}
}
}

namespace mk {
constexpr int LR_XT = 0;
constexpr int LR_XC = LR_XT + 67 * 64 * 2 + 64;
constexpr int LR_XCB = LR_XC + 64 * 64 * 4;
constexpr int LR_GWT = LR_XCB + 64 * 72 * 2;
constexpr int LR_A = LR_GWT + 2 * 64 * 72 * 2;
constexpr int LR_BX = LR_A + 64 * 64 * 4;
constexpr int LR_HO = LR_BX + 64 * 64 * 4;
constexpr int LR_CST = LR_HO + 64 * 64 * 4;
constexpr int LR_SEGP = LR_CST + 8 * 64 * 4;
constexpr int LR_SEGH = LR_SEGP + 8 * 64 * 4;
constexpr int LR_HC = LR_SEGH + 8 * 64 * 4;
constexpr int LR_END = LR_HC + 64 * 4;
static_assert(LR_END <= LDS_BYTES && (LR_XC % 16) == 0, "lru LDS");

struct LruP { const bf16_t* z1; bf16_t* Hd; int b0, nb; };

__device__ __forceinline__ void lru_item(LAS unsigned char* lds, const In& in, const LruP p, int item) {
    const int tid = threadIdx.x, lane = tid & 63, wid = tid >> 6;
    const int d = item / (p.nb * LB), bl = (item / LB) % p.nb, n = item % LB;
    const int nlat = p.nb * SEQ;
    LAS bf16_t* XT = (LAS bf16_t*)(lds + LR_XT); LAS float* XC = (LAS float*)(lds + LR_XC); LAS bf16_t* XCB = (LAS bf16_t*)(lds + LR_XCB); LAS bf16_t* GWT = (LAS bf16_t*)(lds + LR_GWT);
    LAS float *A_ = (LAS float*)(lds + LR_A), *BX = (LAS float*)(lds + LR_BX), *HO = (LAS float*)(lds + LR_HO), *CST = (LAS float*)(lds + LR_CST), *SEGP = (LAS float*)(lds + LR_SEGP), *SEGH = (LAS float*)(lds + LR_SEGH), *HC = (LAS float*)(lds + LR_HC);
    for (int i = tid; i < 2 * 64 * 64; i += NT) { const int g = i >> 12, j = (i >> 6) & 63, k = i & 63;
        GWT[(g * 64 + k) * 72 + j] = f2bf(in.lru_gate_w[((((size_t)d * 2 + g) * LB + n) * LBS + j) * LBS + k]); }
    for (int i = tid; i < 64; i += NT) { const int c = n * 64 + i;
        CST[i] = in.lru_conv_w[c]; CST[64 + i] = in.lru_conv_w[LW + c]; CST[128 + i] = in.lru_conv_w[2 * LW + c]; CST[192 + i] = in.lru_conv_w[3 * LW + c]; CST[256 + i] = in.lru_conv_b[c];
        CST[320 + i] = in.lru_gate_b[((d * 2 + 0) * LB + n) * LBS + i]; CST[384 + i] = in.lru_gate_b[((d * 2 + 1) * LB + n) * LBS + i]; CST[448 + i] = softplusf_(-in.lru_l[d * LW + c]); }
    constexpr int NSEG = CTX / 64 + GW, NSC = CTX / 64;
    u32x4 pre[2];
    auto tok_row = [&](int sidx, int rr, bool& ok) -> size_t {
        if (sidx < NSC) { const int t = sidx * 64 + rr - 2; ok = t >= 0 && t < CTX; return (size_t)nlat + (size_t)bl * CTX + t; }
        const int col = sidx - NSC, row = rr - 2; ok = row >= 0 && row < ROWS; return (size_t)bl * SEQ + (size_t)row * GW + col;
    };
    auto seg_of = [&](int q) { if (q < NSC) return d == 0 ? q : NSC - 1 - q; const int ql = q - NSC; return NSC + (d == 0 ? ql : GW - 1 - ql); };
    auto prefetch = [&](int q) { const int sidx = seg_of(q);
#pragma unroll
        for (int k = 0; k < 2; ++k) { const int i = tid + k * NT; u32x4 v = (u32x4){0u, 0u, 0u, 0u};
            if (i < 67 * 8) { const int rr = i >> 3, part = i & 7; bool ok; const size_t gr = tok_row(sidx, rr, ok); if (ok) v = *(const u32x4*)(p.z1 + gr * Z1_N + Z1_LX + n * 64 + part * 8); }
            pre[k] = v; } };
    auto commit = [&]() {
#pragma unroll
        for (int k = 0; k < 2; ++k) { const int i = tid + k * NT; if (i < 67 * 8) *(LAS u32x4*)(XT + (i >> 3) * 64 + (i & 7) * 8) = pre[k]; } };
    if (tid < 64) HC[tid] = 0.f;
    auto conv = [&]() __attribute__((always_inline)) {
        const int t = tid >> 3, c0 = (tid & 7) * 8; f32x2 s[4];
        { const f32x4 b0 = *(const LAS f32x4*)(CST + 256 + c0), b1 = *(const LAS f32x4*)(CST + 256 + c0 + 4); s[0] = b0.lo; s[1] = b0.hi; s[2] = b1.lo; s[3] = b1.hi; }
#pragma unroll
        for (int tap = 0; tap < 4; ++tap) { const u32x4 x = *(const LAS u32x4*)(XT + (t + tap) * 64 + c0);
            const f32x4 w0 = *(const LAS f32x4*)(CST + tap * 64 + c0), w1 = *(const LAS f32x4*)(CST + tap * 64 + c0 + 4);
            f32x2 v; v.x = bflo(x[0]); v.y = bfhi(x[0]); s[0] = w0.lo * v + s[0]; v.x = bflo(x[1]); v.y = bfhi(x[1]); s[1] = w0.hi * v + s[1];
            v.x = bflo(x[2]); v.y = bfhi(x[2]); s[2] = w1.lo * v + s[2]; v.x = bflo(x[3]); v.y = bfhi(x[3]); s[3] = w1.hi * v + s[3]; }
        *(LAS f32x4*)(XC + t * 64 + c0) = (f32x4){s[0].x, s[0].y, s[1].x, s[1].y}; *(LAS f32x4*)(XC + t * 64 + c0 + 4) = (f32x4){s[2].x, s[2].y, s[3].x, s[3].y};
        u32x4 w; w.x = cvt_pk_bf16(s[0].x, s[0].y); w.y = cvt_pk_bf16(s[1].x, s[1].y); w.z = cvt_pk_bf16(s[2].x, s[2].y); w.w = cvt_pk_bf16(s[3].x, s[3].y); *(LAS u32x4*)(XCB + t * 72 + c0) = w; };
    auto output = [&](int sidx) __attribute__((always_inline)) {
        if (sidx >= NSC) { const int col = sidx - NSC, t = tid >> 3, c0 = (tid & 7) * 8;
            const f32x4 x = *(const LAS f32x4*)(HO + t * 64 + c0), y = *(const LAS f32x4*)(HO + t * 64 + c0 + 4);
            *(u32x4*)(p.Hd + ((size_t)d * nlat + (size_t)bl * SEQ + (size_t)t * GW + col) * LW + n * 64 + c0) = pack8(x, y); } };
    prefetch(0);
    commit();
    __syncthreads();
    if (1 < NSEG) prefetch(1);
    conv();
    __syncthreads();
    float hlast = 0.f;
    for (int q = 0; q < NSEG; ++q) {
        { const int rt = wid >> 1, fr = lane & 15, fq = lane >> 4;
          bf16x8 a[2];
#pragma unroll
          for (int ks = 0; ks < 2; ++ks) a[ks] = *(const LAS bf16x8*)(XCB + (rt * 16 + fr) * 72 + ks * 32 + fq * 8);
#pragma unroll
          for (int cc = 0; cc < 2; ++cc) { const int ct = 2 * (wid & 1) + cc, col = ct * 16 + fr;
              f32x4 acc0 = (f32x4){0.f, 0.f, 0.f, 0.f}, acc1 = acc0;
#pragma unroll
              for (int ks = 0; ks < 2; ++ks) {
                  const bf16x8 b0 = *(const LAS bf16x8*)(GWT + (0 * 64 + col) * 72 + ks * 32 + fq * 8), b1 = *(const LAS bf16x8*)(GWT + (1 * 64 + col) * 72 + ks * 32 + fq * 8);
                  acc0 = __builtin_amdgcn_mfma_f32_16x16x32_bf16(a[ks], b0, acc0, 0, 0, 0); acc1 = __builtin_amdgcn_mfma_f32_16x16x32_bf16(a[ks], b1, acc1, 0, 0, 0); }
              constexpr float L2E = 1.4426950408889634f;
              const float g0s = -L2E * CST[320 + col], g1s = -L2E * CST[384 + col], sp8l = -8.f * L2E * CST[448 + col];
#pragma unroll
              for (int i = 0; i < 4; ++i) { const int t = rt * 16 + fq * 4 + i;
                  const float rec = fast_rcp(1.f + __builtin_amdgcn_exp2f(__builtin_fmaf(acc0[i], -L2E, g0s))), ib = 1.f + __builtin_amdgcn_exp2f(__builtin_fmaf(acc1[i], -L2E, g1s));
                  const float av = __builtin_amdgcn_exp2f(sp8l * rec), om = __builtin_fmaf(-av, av, 1.f);
                  A_[t * 64 + col] = av; BX[t * 64 + col] = om * __builtin_amdgcn_rsqf(fmaxf(om * ib * ib, 1e-30f)) * XC[t * 64 + col]; } } }
        if (q + 1 < NSEG) commit();
        if (q > 0) { output(seg_of(q - 1)); if ((tid >> 6) == 7) HC[tid & 63] = hlast; }
        __syncthreads();
        const int ch = tid & 63, pc = tid >> 6; float av[8], bv[8];
        { float P = 1.f, H = 0.f;
#pragma unroll
          for (int x = 0; x < 8; ++x) { const int st = pc * 8 + x, t = d == 0 ? st : 63 - st; av[x] = A_[t * 64 + ch]; bv[x] = BX[t * 64 + ch]; H = av[x] * H + bv[x]; P *= av[x]; }
          SEGP[pc * 64 + ch] = P; SEGH[pc * 64 + ch] = H; }
        if (q + 1 < NSEG) { if (q + 2 < NSEG) prefetch(q + 2); conv(); }
        __syncthreads();
        { float h = HC[ch];
#pragma unroll
          for (int q2 = 0; q2 < 7; ++q2) if (q2 < pc) h = SEGP[q2 * 64 + ch] * h + SEGH[q2 * 64 + ch];
#pragma unroll
          for (int x = 0; x < 8; ++x) { const int st = pc * 8 + x, t = d == 0 ? st : 63 - st; h = av[x] * h + bv[x]; HO[t * 64 + ch] = h; }
          hlast = h; }
        __syncthreads();
    }
    output(seg_of(NSEG - 1));
}
__device__ __forceinline__ void lru_phase(LAS unsigned char* lds, const In& in, const LruP p, int bid, int nblk) {
    const int nitem = 2 * p.nb * LB;
    for (int it = bid; it < nitem; it += nblk) { lru_item(lds, in, p, it); __syncthreads(); }
}
}

namespace mk {
#define MK_DPPX(x, ctrl) __int_as_float(__builtin_amdgcn_update_dpp(__float_as_int(x), __float_as_int(x), ctrl, 0xF, 0xF, false))
__device__ __forceinline__ float allreduce4(float x) { x += MK_DPPX(x, 0xB1); x += MK_DPPX(x, 0x4E); return x; }
__device__ __forceinline__ void unpack8(const u32x4 w, float (&f)[8]) {
#pragma unroll
    for (int j = 0; j < 4; ++j) { f[2 * j] = bflo(w[j]); f[2 * j + 1] = bfhi(w[j]); } }
constexpr int AG_K = 256;
struct PostP { const bf16_t* z1; bf16_t* Y; const float* bon; bf16_t* Ag; int nlat; int pad_; };
__device__ __forceinline__ void rwkv_post_rows(LAS float* cst  , const In& in, const PostP p, int row_lo, int row_hi, bool dry = false) {
    const int lane = threadIdx.x & 63, wid = threadIdx.x >> 6, c0 = lane * 16, h = lane >> 2;
    float mg0[8], mg1[8];
    for (int i = threadIdx.x; i < RW; i += NT) { cst[i] = in.shift_mu[OFF_V + i]; cst[RW + i] = in.shift_mu[RC + OFF_V + i]; cst[2 * RW + i] = in.rw_lnx[i]; cst[3 * RW + i] = in.rw_lnx[RW + i]; }
    __syncthreads();
#pragma unroll
    for (int j = 0; j < 8; ++j) { const int c = OFF_GD + (lane < GL / 8 ? lane : 0) * 8 + j; mg0[j] = in.shift_mu[c]; mg1[j] = in.shift_mu[RC + c]; }
    struct Raw { u32x4 y00, y01, y10, y11, zx[2], zp[2], zn[2]; float b0, b1; };
    const u32x4 Z4 = (u32x4){0u, 0u, 0u, 0u};
    auto load_row = [&](int r, Raw& w) __attribute__((always_inline)) {
        const int cg = r % GW; const bool hp = cg > 0, hn = cg < GW - 1;
        const bf16_t* y0p = p.Y + (size_t)r * RW + c0; const bf16_t* y1p = p.Y + ((size_t)p.nlat + r) * RW + c0;
        w.y00 = *(const u32x4*)y0p; w.y01 = *(const u32x4*)(y0p + 8); w.y10 = *(const u32x4*)y1p; w.y11 = *(const u32x4*)(y1p + 8);
        w.b0 = p.bon[(size_t)r * NH + h]; w.b1 = p.bon[((size_t)p.nlat + r) * NH + h];
        const bf16_t* zr = p.z1 + (size_t)r * Z1_N;
#pragma unroll
        for (int half = 0; half < 2; ++half) { const int c = OFF_V + c0 + half * 8;
            w.zx[half] = *(const u32x4*)(zr + c); w.zp[half] = Z4; w.zn[half] = Z4;
            if (hp) w.zp[half] = *(const u32x4*)(zr - Z1_N + c);
            if (hn) w.zn[half] = *(const u32x4*)(zr + Z1_N + c); }
    };
    auto compute_row = [&](int r, const Raw& w) __attribute__((always_inline)) {
        bf16_t* y0p = p.Y + (size_t)r * RW + c0;
        float y[16], t8[8];
        unpack8(w.y00, t8);
#pragma unroll
        for (int j = 0; j < 8; ++j) y[j] = t8[j];
        unpack8(w.y01, t8);
#pragma unroll
        for (int j = 0; j < 8; ++j) y[8 + j] = t8[j];
        unpack8(w.y10, t8);
#pragma unroll
        for (int j = 0; j < 8; ++j) y[j] += t8[j];
        unpack8(w.y11, t8);
#pragma unroll
        for (int j = 0; j < 8; ++j) y[8 + j] += t8[j];
        float s = 0.f;
#pragma unroll
        for (int j = 0; j < 16; ++j) s += y[j];
        const float mu = allreduce4(s) * (1.f / 64.f); float q = 0.f;
#pragma unroll
        for (int j = 0; j < 16; ++j) { const float dlt = y[j] - mu; q += dlt * dlt; }
        const float rs = __builtin_amdgcn_rsqf(allreduce4(q) * (1.f / 64.f) + LNX_EPS);
        const float bonus = w.b0 + w.b1;
#pragma unroll
        for (int half = 0; half < 2; ++half) {
            float xv[8], pv[8], nv[8]; unpack8(w.zx[half], xv); unpack8(w.zp[half], pv); unpack8(w.zn[half], nv);
            float m0_[8], m1_[8], g0_[8], g1_[8];
            { const LAS float* cb = cst + c0 + half * 8; const f32x4 a0 = *(const LAS f32x4*)cb, a1 = *(const LAS f32x4*)(cb + 4), b0 = *(const LAS f32x4*)(cb + RW), b1 = *(const LAS f32x4*)(cb + RW + 4),
                  e0 = *(const LAS f32x4*)(cb + 2 * RW), e1 = *(const LAS f32x4*)(cb + 2 * RW + 4), f0 = *(const LAS f32x4*)(cb + 3 * RW), f1 = *(const LAS f32x4*)(cb + 3 * RW + 4);
#pragma unroll
              for (int j = 0; j < 4; ++j) { m0_[j] = a0[j]; m0_[4 + j] = a1[j]; m1_[j] = b0[j]; m1_[4 + j] = b1[j]; g0_[j] = e0[j]; g0_[4 + j] = e1[j]; g1_[j] = f0[j]; g1_[4 + j] = f1[j]; } }
            float o[8];
#pragma unroll
            for (int j = 0; j < 8; ++j) { const int cj = half * 8 + j; const float v = xv[j] + m0_[j] * (pv[j] - xv[j]) + m1_[j] * (nv[j] - xv[j]);
                o[j] = (y[cj] - mu) * rs * g0_[j] + g1_[j] + bonus * v; }
            u32x4 wv; wv.x = cvt_pk_bf16(o[0], o[1]); wv.y = cvt_pk_bf16(o[2], o[3]); wv.z = cvt_pk_bf16(o[4], o[5]); wv.w = cvt_pk_bf16(o[6], o[7]); if (!dry) *(u32x4*)(y0p + half * 8) = wv; else if (wv.x == 0x12345678u) *(u32x4*)(y0p + half * 8) = wv;
        }
        if (lane < 32) { u32x4 wv = Z4;
            if (lane < GL / 8) { const int cg = r % GW; const bool hp = cg > 0, hn = cg < GW - 1; const bf16_t* zr = p.z1 + (size_t)r * Z1_N; const int c = OFF_GD + lane * 8;
                u32x4 gx = *(const u32x4*)(zr + c), gp = Z4, gn = Z4; if (hp) gp = *(const u32x4*)(zr - Z1_N + c); if (hn) gn = *(const u32x4*)(zr + Z1_N + c);
                float xv[8], pv[8], nv[8]; unpack8(gx, xv); unpack8(gp, pv); unpack8(gn, nv);
                float o[8];
#pragma unroll
                for (int j = 0; j < 8; ++j) o[j] = fast_sigmoid(xv[j] + mg0[j] * (pv[j] - xv[j]) + mg1[j] * (nv[j] - xv[j]));
                wv.x = cvt_pk_bf16(o[0], o[1]); wv.y = cvt_pk_bf16(o[2], o[3]); wv.z = cvt_pk_bf16(o[4], o[5]); wv.w = cvt_pk_bf16(o[6], o[7]); }
            *(u32x4*)(p.Ag + (size_t)r * AG_K + lane * 8) = wv; }
    };
    constexpr int RS_ = NT / 64;
    Raw A, B;
    int r = row_lo + wid;
    if (r < row_hi) load_row(r, A);
    for (; r < row_hi; r += 2 * RS_) {
        if (r + RS_ < row_hi) load_row(r + RS_, B);
        compute_row(r, A);
        if (r + 2 * RS_ < row_hi) load_row(r + 2 * RS_, A);
        if (r + RS_ < row_hi) compute_row(r + RS_, B);
    }
}
#define MK_FR_ROW(f) ((((f) >> 3) * HALF) + wr * 64 + ((((f) >> 1) & 3) * 16) + fr)
#define MK_FR_COL(f) ((((f) & 1) * HALF) + wc * 32 + 8 * fq)
#define MK_FR_ACC(f, n) acc[(f) >> 3][(f) & 1][((f) >> 1) & 3][n]
#define MK_FENCE asm volatile("" ::: "memory")
struct EpiYa { static constexpr int NS = 16; const bf16_t* yn; bf16_t* ya;
    __device__ __forceinline__ bool operator()(f32x4 (&acc)[2][2][4][2], const Unit& u, int wr, int wc, int fr, int fq) const {
        const size_t base = (size_t)(u.pm * BM) * RW + u.pn * BM;
        u32x4 cur = *(const u32x4*)(yn + base + (size_t)MK_FR_ROW(0) * RW + MK_FR_COL(0));
#pragma unroll
        for (int f = 0; f < 16; ++f) { u32x4 nxt = cur; if (f + 1 < 16) nxt = *(const u32x4*)(yn + base + (size_t)MK_FR_ROW(f + 1) * RW + MK_FR_COL(f + 1));
            MK_FENCE; float v[8]; unpack8(cur, v); f32x4 a = MK_FR_ACC(f, 0), b = MK_FR_ACC(f, 1);
#pragma unroll
            for (int j = 0; j < 4; ++j) { a[j] *= v[j]; b[j] *= v[4 + j]; }
            *(u32x4*)(ya + base + (size_t)MK_FR_ROW(f) * RW + MK_FR_COL(f)) = pack8(a, b); MK_FENCE; cur = nxt; }
        return false; } };
struct EpiZc { static constexpr int NS = 16; const bf16_t* Hd; bf16_t* yb; bf16_t* gates; int nlat; int pad_;
    __device__ __forceinline__ bool operator()(f32x4 (&acc)[2][2][4][2], const Unit& u, int wr, int wc, int fr, int fq) const {
        if (u.pn < LW / BM) {
            MK_FRAG_LOOP(r, c) { const size_t o = (size_t)(u.pm * BM + r) * LW + u.pn * BM + c; float h0[8], h1[8]; unpack8(*(const u32x4*)(Hd + o), h0); unpack8(*(const u32x4*)(Hd + (size_t)nlat * LW + o), h1);
                f32x4 a = acc[ai][bj][m][0], b = acc[ai][bj][m][1];
#pragma unroll
                for (int j = 0; j < 4; ++j) { a[j] = fast_gelu_tanh(a[j]) * (h0[j] + h1[j]); b[j] = fast_gelu_tanh(b[j]) * (h0[4 + j] + h1[4 + j]); }
                *(u32x4*)(yb + o) = pack8(a, b); asm volatile("" ::: "memory"); }
        } else {
            MK_FRAG_LOOP(r, c) { const size_t o = (size_t)(u.pm * BM + r) * (2 * D) + (u.pn * BM - LW) + c;
                f32x4 a = acc[ai][bj][m][0], b = acc[ai][bj][m][1];
#pragma unroll
                for (int j = 0; j < 4; ++j) { a[j] = fast_sigmoid(a[j]); b[j] = fast_sigmoid(b[j]); }
                *(u32x4*)(gates + o) = pack8(a, b); }
        }
        return false; } };
struct PairOrder { StaticOrder S;
    __device__ bool next(int i, Unit& u) const { if (!S.next(i >> 1, u)) return false; u.e = i & 1; return true; } };
struct EpiBranch { const bf16_t* gates; bf16_t* mixed;
    __device__ __forceinline__ bool operator()(f32x4 (&acc)[2][2][4][2], const Unit& u, int wr, int wc, int fr, int fq) const {
        const size_t gbase = (size_t)(u.pm * BM) * (2 * D) + u.pn * BM, mbase = (size_t)(u.pm * BM) * D + u.pn * BM;
        u32x4 c1 = (u32x4){0u, 0u, 0u, 0u}, c2 = *(const u32x4*)(gates + gbase + (size_t)MK_FR_ROW(0) * (2 * D) + D + MK_FR_COL(0));
        if (u.e == 0) c1 = *(const u32x4*)(gates + gbase + (size_t)MK_FR_ROW(0) * (2 * D) + MK_FR_COL(0));
#pragma unroll
        for (int f = 0; f < 16; ++f) { u32x4 n1 = c1, n2 = c2;
            if (f + 1 < 16) { const size_t o = gbase + (size_t)MK_FR_ROW(f + 1) * (2 * D) + MK_FR_COL(f + 1); n2 = *(const u32x4*)(gates + o + D); if (u.e == 0) n1 = *(const u32x4*)(gates + o); }
            MK_FENCE; float g1[8], g2[8]; unpack8(c1, g1); unpack8(c2, g2);
            if (u.e == 0) {
#pragma unroll
                for (int j = 0; j < 4; ++j) { MK_FR_ACC(f, 0)[j] *= g1[j] / g2[j]; MK_FR_ACC(f, 1)[j] *= g1[4 + j] / g2[4 + j]; }
            } else { f32x4 a = MK_FR_ACC(f, 0), b = MK_FR_ACC(f, 1);
#pragma unroll
                for (int j = 0; j < 4; ++j) { a[j] *= g2[j]; b[j] *= g2[4 + j]; }
                *(u32x4*)(mixed + mbase + (size_t)MK_FR_ROW(f) * D + MK_FR_COL(f)) = pack8(a, b); }
            MK_FENCE; c1 = n1; c2 = n2; }
        __builtin_amdgcn_s_waitcnt(0x0F70);
        return u.e == 0; } };
struct EpiF32 { float* C; long ldc;
    __device__ __forceinline__ bool operator()(f32x4 (&acc)[2][2][4][2], const Unit& u, int wr, int wc, int fr, int fq) const {
        MK_FRAG_LOOP(r, c) { float* o = C + (size_t)(u.pm * BM + r) * ldc + u.pn * BM + c; *(f32x4*)o = acc[ai][bj][m][0]; *(f32x4*)(o + 4) = acc[ai][bj][m][1]; }
        return false; } };
}

namespace mk {
constexpr int NEX = NE + 1;
constexpr int SLOTS_PER_TOK = TOPK + 1;
constexpr int RP_MOD = 0;
constexpr int RP_UH = RP_MOD + 3 * D * 4;
constexpr int RP_UL = RP_UH + 16 * (D + 8) * 2;
constexpr int RP_PART = RP_UL + 16 * (D + 8) * 2;
constexpr int RP_LOG = RP_PART + 8 * 16 * 64 * 4;
constexpr int RP_HIST = RP_LOG + 16 * 64 * 4;
constexpr int RP_END = RP_HIST + 64 * 4;
static_assert(RP_END <= LDS_BYTES, "rowpass LDS");

constexpr float FP8_SR = 64.f;
constexpr float FP8_SA = 8.f, FP8_SWD = 256.f;
constexpr float FP8_SU = 16.f, FP8_SW = 256.f;
struct RowP { float* y2h1; bf16_t* u; unsigned char* u8; const float* modpart; const bf16_t* rwt;
              int* tope; float* gatev; int* lrank; int* blkcnt; int b0, nlat; };
__device__ __forceinline__ float wave_max(float x) { return wave_max64(x); }
__device__ __forceinline__ void row_pass(LAS unsigned char* lds, const In& in, const RowP p, int row_lo, int row_hi, bool dry = false) {
    const int tid = threadIdx.x, lane = tid & 63, wid = tid >> 6;
    LAS float* MOD = (LAS float*)(lds + RP_MOD); LAS bf16_t* UH = (LAS bf16_t*)(lds + RP_UH); LAS bf16_t* UL = (LAS bf16_t*)(lds + RP_UL);
    LAS float* PART = (LAS float*)(lds + RP_PART); LAS float* LOG = (LAS float*)(lds + RP_LOG); LAS int* HIST = (LAS int*)(lds + RP_HIST);
    const int mr = p.b0 + row_lo / SEQ;
    for (int j = tid; j < 3 * D; j += NT) MOD[j] = mod_value(in, p.modpart, mr, 2 * D + j);
    if (tid < 64) HIST[tid] = 0;
    __syncthreads();
    float gp1[16], gp2[16];
#pragma unroll
    for (int j = 0; j < 4; ++j)
#pragma unroll
        for (int q = 0; q < 4; ++q) { gp1[4 * j + q] = in.norm_g[D + j * 256 + lane * 4 + q]; gp2[4 * j + q] = in.norm_g[2 * D + j * 256 + lane * 4 + q]; }
    u32x2 py[2][4]; f32x4 px[2][4];
    auto fetch = [&](int r16) __attribute__((always_inline)) {
#pragma unroll
        for (int rr = 0; rr < 2; ++rr) { const int r = r16 + wid * 2 + rr;
#pragma unroll
            for (int j = 0; j < 4; ++j) { py[rr][j] = *(const u32x2*)(p.u + (size_t)r * D + j * 256 + lane * 4); px[rr][j] = *(const f32x4*)(in.x + ((size_t)p.b0 * SEQ + r) * D + j * 256 + lane * 4); } } };
    fetch(row_lo);
    for (int r16 = row_lo; r16 < row_hi; r16 += 16) {
#pragma unroll
        for (int rr = 0; rr < 2; ++rr) {
            const int lr = wid * 2 + rr, r = r16 + lr;
            float* yp = p.y2h1 + (size_t)r * D;
            f32x4 v[4]; float ss = 0.f;
#pragma unroll
            for (int j = 0; j < 4; ++j) { const u32x2 yw = py[rr][j];
                v[j] = (f32x4){bflo(yw.x), bfhi(yw.x), bflo(yw.y), bfhi(yw.y)}; ss += v[j][0] * v[j][0] + v[j][1] * v[j][1] + v[j][2] * v[j][2] + v[j][3] * v[j][3]; }
#pragma unroll
            for (int o_ = 0; o_ < 1; ++o_) ss = wave_sum64(ss);
            const float rinv = __builtin_amdgcn_rsqf(ss * (1.f / D) + NORM_EPS); float s2 = 0.f;
#pragma unroll
            for (int j = 0; j < 4; ++j) { const int c = j * 256 + lane * 4; const f32x4 xv = px[rr][j];
#pragma unroll
                for (int q = 0; q < 4; ++q) { const float hv = xv[q] + MOD[c + q] * (v[j][q] * rinv * gp1[4 * j + q]); v[j][q] = hv; s2 += hv * hv; }
                if (!dry) *(f32x4*)(yp + c) = v[j]; }
#pragma unroll
            for (int o_ = 0; o_ < 1; ++o_) s2 = wave_sum64(s2);
            const float r2 = __builtin_amdgcn_rsqf(s2 * (1.f / D) + NORM_EPS);
#pragma unroll
            for (int j = 0; j < 4; ++j) { const int c = j * 256 + lane * 4; float uu[4], lo[4]; unsigned hw[2];
#pragma unroll
                for (int q = 0; q < 4; ++q) uu[q] = (v[j][q] * r2 * gp2[4 * j + q]) * (1.f + MOD[2 * D + c + q]) + MOD[D + c + q];
                hw[0] = cvt_pk_bf16(uu[0], uu[1]); hw[1] = cvt_pk_bf16(uu[2], uu[3]);
                lo[0] = uu[0] - bflo(hw[0]); lo[1] = uu[1] - bfhi(hw[0]); lo[2] = uu[2] - bflo(hw[1]); lo[3] = uu[3] - bfhi(hw[1]);
                u32x2 w; w.x = hw[0]; w.y = hw[1]; *(unsigned*)(p.u8 + (size_t)r * D + c) = pack4_fp8(uu[0] * FP8_SU, uu[1] * FP8_SU, uu[2] * FP8_SU, uu[3] * FP8_SU); *(LAS u32x2*)(UH + lr * (D + 8) + c) = w;
                u32x2 wl; wl.x = cvt_pk_bf16(lo[0], lo[1]); wl.y = cvt_pk_bf16(lo[2], lo[3]); *(LAS u32x2*)(UL + lr * (D + 8) + c) = wl; }
        }
        __syncthreads();
        if (r16 + 16 < row_hi) fetch(r16 + 16);
        { const int fr = lane & 15, fq = lane >> 4;
          f32x4 acc[4];
#pragma unroll
          for (int ct = 0; ct < 4; ++ct) acc[ct] = (f32x4){0.f, 0.f, 0.f, 0.f};
#pragma unroll
          for (int ks = 0; ks < 4; ++ks) { const int k0 = wid * 128 + ks * 32 + fq * 8;
              const bf16x8 ah = *(const LAS bf16x8*)(UH + fr * (D + 8) + k0), al = *(const LAS bf16x8*)(UL + fr * (D + 8) + k0);
#pragma unroll
              for (int ct = 0; ct < 4; ++ct) { const bf16x8 bh = *(const bf16x8*)(p.rwt + (size_t)(ct * 16 + fr) * D + k0), bl = *(const bf16x8*)(p.rwt + (size_t)(NE + ct * 16 + fr) * D + k0);
                  acc[ct] = __builtin_amdgcn_mfma_f32_16x16x32_bf16(ah, bh, acc[ct], 0, 0, 0); acc[ct] = __builtin_amdgcn_mfma_f32_16x16x32_bf16(ah, bl, acc[ct], 0, 0, 0); acc[ct] = __builtin_amdgcn_mfma_f32_16x16x32_bf16(al, bh, acc[ct], 0, 0, 0); } }
#pragma unroll
          for (int ct = 0; ct < 4; ++ct)
#pragma unroll
              for (int i = 0; i < 4; ++i) PART[(wid * 16 + fq * 4 + i) * 64 + ct * 16 + fr] = acc[ct][i]; }
        __syncthreads();
        for (int i = tid; i < 16 * 64; i += NT) { float s = 0.f;
#pragma unroll
            for (int w = 0; w < 8; ++w) s += PART[w * 1024 + i];
            LOG[i] = s; }
        __syncthreads();
#pragma unroll 1
        for (int rr = 0; rr < 2; ++rr) {
            const int lr = wid * 2 + rr, r = r16 + lr;
            const float sc = sigmoidf_(LOG[lr * 64 + lane]), bi = sc + in.router_b[lane];
            float m1 = bi; m1 = fmaxf(m1, MK_DPPF(m1, 0xB1)); m1 = fmaxf(m1, MK_DPPF(m1, 0x4E)); m1 = fmaxf(m1, MK_DPPF(m1, 0x141));
            const unsigned long long eq = __ballot(bi == m1); const int first = __ffsll((long long)((eq >> (lane & ~7)) & 0xffull)) - 1 + (lane & ~7);
            float m2 = (lane == first) ? -1e30f : bi; m2 = fmaxf(m2, MK_DPPF(m2, 0xB1)); m2 = fmaxf(m2, MK_DPPF(m2, 0x4E)); m2 = fmaxf(m2, MK_DPPF(m2, 0x141));
            const float gs = m1 + m2; const int myg = lane >> 3; int rank = 0;
#pragma unroll
            for (int g = 0; g < NG; ++g) { const float og = __int_as_float(__builtin_amdgcn_readlane(__float_as_int(gs), g * 8)); rank += (og > gs || (og == gs && g < myg)) ? 1 : 0; }
            float cand = rank < TG ? bi : -1e30f; float tsum = 0.f; int myidx = 0; float mysc = 0.f;
#pragma unroll
            for (int it = 0; it < TOPK; ++it) { const float m = wave_max(cand); const unsigned long long bm = __ballot(cand == m); const int win = __builtin_amdgcn_readfirstlane(__ffsll((long long)bm) - 1);
                const float ws = __int_as_float(__builtin_amdgcn_readlane(__float_as_int(sc), win)); tsum += ws; if (lane == it) { myidx = win; mysc = ws; } if (lane == win) cand = -1e30f; }
            if (lane < TOPK) { const int rk = atomicAdd((int*)&HIST[myidx], 1);
                p.tope[(size_t)r * TOPK + lane] = myidx; p.gatev[(size_t)r * TOPK + lane] = mysc / tsum * 2.5f; p.lrank[(size_t)r * TOPK + lane] = rk; }
        }
        __syncthreads();
    }
    if (tid < 64) p.blkcnt[blockIdx.x * 64 + tid] = HIST[tid];
}

struct MoeP { const int* tope; const float* gatev; const int* lrank; const int* blkcnt;
              int* tilepre;
              int* list;
              int* sdst;
              float* sgate;
              int r0, nr, blk0, nbh, rpb, pad_; };
__device__ __forceinline__ void moe_assign(LAS unsigned char* lds, const MoeP p, int bid, int nblk) {
    LAS int* BASE = (LAS int*)lds; LAS int* CNT = BASE + 80; LAS int* BOFF = CNT + 80;
    const int tid = threadIdx.x;
    { LAS int* PC = BOFF + 80; const int e = tid & 63, part = tid >> 6, per = (p.nbh + 7) / 8; int c = 0, bo = 0;
#pragma unroll 4
      for (int b = part * per; b < (part + 1) * per && b < p.nbh; ++b) { const int v = p.blkcnt[(p.blk0 + b) * 64 + e]; if (p.blk0 + b < bid) bo += v; c += v; }
      PC[part * 64 + e] = c; PC[512 + part * 64 + e] = bo; }
    __syncthreads();
    if (tid < NE) { LAS int* PC = BOFF + 80; int c = 0, bo = 0;
#pragma unroll
        for (int q = 0; q < 8; ++q) { c += PC[q * 64 + tid]; bo += PC[512 + q * 64 + tid]; }
        CNT[tid] = c; BOFF[tid] = bo; }
    __syncthreads();
    if (tid == 0) { int s = 0; for (int e = 0; e < NE; ++e) { BASE[e] = s; s += (CNT[e] + BM - 1) / BM * BM; } BASE[NE] = s; CNT[NE] = p.nr; BASE[NE + 1] = s + p.nr;
        if (bid == 0) { for (int e = 0; e <= NEX; ++e) p.tilepre[e] = BASE[e] / BM; } }
    __syncthreads();
    if (bid >= p.blk0 && bid < p.blk0 + p.nbh) {
        const int rlo = p.r0 + (bid - p.blk0) * p.rpb;
        for (int i = tid; i < p.rpb * TOPK; i += NT) { const int r = rlo + i / TOPK, a = r * TOPK + i % TOPK, e = p.tope[a]; const int slot = BASE[e] + BOFF[e] + p.lrank[a];
            p.list[slot] = r; p.sdst[slot] = (r - p.r0) * SLOTS_PER_TOK + i % TOPK; p.sgate[slot] = p.gatev[a]; }
        for (int i = tid; i < p.rpb; i += NT) { const int r = rlo + i, slot = BASE[NE] + (r - p.r0); p.list[slot] = r; p.sdst[slot] = (r - p.r0) * SLOTS_PER_TOK + TOPK; p.sgate[slot] = 1.f; }
    }
    for (int e = bid; e < NE; e += nblk) { const int lo = BASE[e] + CNT[e], hi = BASE[e + 1]; for (int s = lo + tid; s < hi; s += NT) { p.list[s] = p.r0; p.sdst[s] = -1; p.sgate[s] = 0.f; } }
}
struct GroupOrder { int tpn, total, nN, G, c;
    __device__ void init(const int* tilepre, int nN_, int G_, int c_) { const int lane = threadIdx.x & 63;
        tpn = (int)__hip_atomic_load((const unsigned*)tilepre + lane + 1, __ATOMIC_RELAXED, __HIP_MEMORY_SCOPE_AGENT);
        total = (int)__hip_atomic_load((const unsigned*)tilepre + NEX, __ATOMIC_RELAXED, __HIP_MEMORY_SCOPE_AGENT); nN = nN_; G = G_; c = c_; }
    __device__ bool next(int i, Unit& u) const { const long L = (long)i * G + c; if (L >= (long)total * nN) return false;
        const int T = (int)(L / nN); const int e = __popcll(__ballot(tpn <= T));
        u.pm = T; u.pn = (int)(L % nN); u.e = __builtin_amdgcn_readfirstlane(e); return true; } };
struct EpiGU { static constexpr int NS = 16; bf16_t* act;
    __device__ __forceinline__ bool operator()(f32x4 (&acc)[2][2][4][2], const Unit& u, int wr, int wc, int fr, int fq) const {
        MK_FRAG_LOOP(r, c) { const f32x4 a = acc[ai][bj][m][0] * (1.f / (FP8_SU * FP8_SW)), b = acc[ai][bj][m][1] * (1.f / (FP8_SU * FP8_SW));
            *(unsigned*)((unsigned char*)act + (size_t)(u.pm * BM + r) * EF + ((u.pn * BM + c) >> 1)) =
                pack4_fp8(fast_silu(a[0]) * a[1] * FP8_SA, fast_silu(a[2]) * a[3] * FP8_SA, fast_silu(b[0]) * b[1] * FP8_SA, fast_silu(b[2]) * b[3] * FP8_SA); }
        return false; } };
struct EpiDown { const int* sdst; const float* sgate; bf16_t* rowsb; LAS unsigned char* lds;
    __device__ __forceinline__ void unit_begin(const Unit& u, LAS unsigned char* l) const {
        const int wid = __builtin_amdgcn_readfirstlane(threadIdx.x >> 6), lane = threadIdx.x & 63, w4 = wid & 3;
        const unsigned* src = (wid < 4 ? (const unsigned*)sdst : (const unsigned*)sgate) + (size_t)u.pm * BM + w4 * 64 + lane;
        __builtin_amdgcn_global_load_lds(src, (LAS unsigned*)(l + STAGE_BYTES + (wid < 4 ? 0 : 1024) + w4 * 256), 4, 0, 0); }
    __device__ __forceinline__ bool operator()(f32x4 (&acc)[2][2][4][2], const Unit& u, int wr, int wc, int fr, int fq) const {
        int dst[8]; float gt[8];
        const LAS int* LD = (const LAS int*)(lds + STAGE_BYTES); const LAS float* LG = (const LAS float*)(lds + STAGE_BYTES + 1024);
#pragma unroll
        for (int q = 0; q < 8; ++q) { const int sl = (q >> 2) * HALF + wr * 64 + (q & 3) * 16 + fr; dst[q] = LD[sl]; gt[q] = LG[sl]; }
#pragma unroll
        for (int ai = 0; ai < 2; ++ai)
#pragma unroll
            for (int m = 0; m < 4; ++m) { const int q = ai * 4 + m; const int dq = dst[q]; if (dq >= 0) {
#pragma unroll
                for (int bj = 0; bj < 2; ++bj) { f32x4 a = acc[ai][bj][m][0], b = acc[ai][bj][m][1];
#pragma unroll
                    for (int j = 0; j < 4; ++j) { a[j] *= gt[q] * (FP8_SR / (FP8_SA * FP8_SWD)); b[j] *= gt[q] * (FP8_SR / (FP8_SA * FP8_SWD)); }
                    u32x2 w8; w8.x = pack4_fp8(a[0], a[1], a[2], a[3]); w8.y = pack4_fp8(b[0], b[1], b[2], b[3]);
                    *(u32x2*)((unsigned char*)rowsb + (size_t)dq * D + u.pn * BM + bj * HALF + wc * 32 + 8 * fq) = w8; } } }
        return false; } };
__device__ __forceinline__ void final_rows(LAS float* sm  , const In& in, const float* modpart, const bf16_t* rowsb, float* h1out, int b0, int r0, int row_lo, int row_hi, bool dry = false) {
    const int tid = threadIdx.x, lane = tid & 63, wid = tid >> 6;
    const int mr = b0 + row_lo / SEQ;
    __syncthreads();
    for (int j = tid; j < D; j += NT) sm[j] = mod_value(in, modpart, mr, 5 * D + j);
    __syncthreads();
    float gq[16];
#pragma unroll
    for (int j = 0; j < 4; ++j)
#pragma unroll
        for (int q = 0; q < 4; ++q) gq[4 * j + q] = sm[j * 256 + lane * 4 + q] * in.norm_g[3 * D + j * 256 + lane * 4 + q];
    unsigned raw[SLOTS_PER_TOK][4]; f32x4 hraw[4];
    auto fetch = [&](int r) __attribute__((always_inline)) {
        const unsigned char* rb = (const unsigned char*)rowsb + (size_t)(r - r0) * SLOTS_PER_TOK * D; const float* hp = h1out + (size_t)r * D;
#pragma unroll
        for (int s = 0; s < SLOTS_PER_TOK; ++s)
#pragma unroll
            for (int j = 0; j < 4; ++j) raw[s][j] = *(const unsigned*)(rb + (size_t)s * D + j * 256 + lane * 4);
#pragma unroll
        for (int j = 0; j < 4; ++j) hraw[j] = *(const f32x4*)(hp + j * 256 + lane * 4); };
    if (row_lo + wid < row_hi) fetch(row_lo + wid);
    for (int r = row_lo + wid; r < row_hi; r += NT / 64) {
        float v[16];
#pragma unroll
        for (int j = 0; j < 16; ++j) v[j] = 0.f;
#pragma unroll
        for (int s = 0; s < SLOTS_PER_TOK; ++s)
#pragma unroll
            for (int j = 0; j < 4; ++j) { const int w = (int)raw[s][j]; const f32x2 lo = __builtin_amdgcn_cvt_pk_f32_fp8(w, false), hi = __builtin_amdgcn_cvt_pk_f32_fp8(w, true); v[4 * j] += lo.x; v[4 * j + 1] += lo.y; v[4 * j + 2] += hi.x; v[4 * j + 3] += hi.y; }
#pragma unroll
        for (int j = 0; j < 16; ++j) v[j] *= (1.f / FP8_SR);
        f32x4 hcur[4];
#pragma unroll
        for (int j = 0; j < 4; ++j) hcur[j] = hraw[j];
        if (r + NT / 64 < row_hi) fetch(r + NT / 64);
        float ss = 0.f;
#pragma unroll
        for (int j = 0; j < 16; ++j) ss += v[j] * v[j];
        ss = wave_sum64(ss);
        const float rinv = __builtin_amdgcn_rsqf(ss * (1.f / D) + NORM_EPS);
        float* hp = h1out + (size_t)r * D;
#pragma unroll
        for (int j = 0; j < 4; ++j) { const int c = j * 256 + lane * 4; f32x4 hv = hcur[j];
#pragma unroll
            for (int q = 0; q < 4; ++q) hv[q] += gq[4 * j + q] * (v[4 * j + q] * rinv);
            if (!dry) *(f32x4*)(hp + c) = hv; else if (hv[0] == 1.2345e30f) *(f32x4*)(hp + c) = hv; }
    }
}
__device__ __forceinline__ void rwt_prep(const In& in, bf16_t* rwt, int bid, int nblk) {
    for (int i = bid * NT + threadIdx.x; i < NE * D; i += nblk * NT) { const int e = i / D, k = i % D; const float w = in.router_w[(size_t)k * NE + e]; const bf16_t h = f2bf(w); rwt[i] = h; rwt[(size_t)NE * D + i] = f2bf(w - bf2f(h)); }
}
}

using namespace mk;
constexpr size_t MiB = (size_t)1 << 20;
constexpr int NLAT = NB * SEQ, NCTXR = NB * CTX, NALL = NLAT + NCTXR, NRH = NLAT / 2, MAXSLOTS = NRH * SLOTS_PER_TOK + NE * BM;
constexpr size_t O_W1A = 0, O_W1C = O_W1A + (size_t)Z1_N * D * 2, O_WG = O_W1C + (size_t)ZC_N * D * 2, O_WBR = O_WG + (size_t)RW * AG_K * 2, O_WOUT = O_WBR + (size_t)2 * D * RW * 2,
                 O_RWT = O_WOUT + (size_t)D * D * 2, O_MODP = O_RWT + (size_t)2 * NE * D * 2, O_S_END = O_MODP + (size_t)MOD_SL * (NB + 1) * 6 * D * 4;
static_assert(O_S_END <= 27 * MiB, "S region");
constexpr size_t O_BAR = 27 * MiB;
constexpr size_t O_Z1 = 28 * MiB, O_R2 = O_Z1 + (size_t)NALL * Z1_N * 2;
static_assert(O_R2 == 334 * MiB, "z1 size");
constexpr size_t O_HD = O_R2, O_BON = O_HD + (size_t)2 * NLAT * LW * 2, O_AG = O_BON + (size_t)2 * NLAT * NH * 4, O_R2_END = O_AG + (size_t)NLAT * AG_K * 2;
static_assert(O_R2_END <= 512 * MiB, "R2");
constexpr size_t O_XNL = O_Z1, O_YB = O_XNL + (size_t)NLAT * D * 2, O_GATES = O_YB + (size_t)NLAT * LW * 2, O_MIXED = O_HD;
static_assert(O_GATES + (size_t)NLAT * 2 * D * 2 <= O_R2, "late R1");
constexpr size_t O_U = O_Z1, O_WGU = O_U + (size_t)NLAT * D * 2, O_WDN = O_WGU + (size_t)NEX * 2 * EF * D * 2, O_ROUT = O_WDN + (size_t)NEX * D * EF * 2;
constexpr size_t O_TOPE = O_ROUT, O_LRANK = O_TOPE + (size_t)NLAT * TOPK * 4, O_GATEV = O_LRANK + (size_t)NLAT * TOPK * 4, O_BLKCNT = O_GATEV + (size_t)NLAT * TOPK * 4, O_TILEPRE = O_BLKCNT + 256 * 64 * 4,
                 O_LIST = O_TILEPRE + 2048, O_SDST = O_LIST + (size_t)2 * MAXSLOTS * 4, O_SGATE = O_SDST + (size_t)2 * MAXSLOTS * 4, O_ACT = ((O_SGATE + (size_t)2 * MAXSLOTS * 4 + 255) / 256) * 256,
                 O_ROWSB = ((O_ACT + (size_t)MAXSLOTS * EF * 2 + 255) / 256) * 256, O_END = O_ROWSB + ((size_t)NRH * SLOTS_PER_TOK + 1) * D * 2;
static_assert(O_END <= 512 * MiB, "workspace");
constexpr size_t O_U8 = O_WGU + (size_t)NEX * 2 * EF * D;
static_assert(O_U8 + (size_t)NLAT * D <= O_WDN, "u8");
static_assert(O_WGU >= O_YB && O_ROWSB >= O_GATES, "late layout");

struct MP { In in; float* out; unsigned char* ws; long ph_lo, ph_hi; };
constexpr int NPHASE = 16;

#if defined(__HIP_DEVICE_COMPILE__)
#define MK_KARGS auto Pq_ = Pk_; asm volatile("" : "+s"(Pq_)); const MP* Pg_ = (const MP*)Pq_; const In in = Pg_->in; unsigned char* ws = Pg_->ws; float* out_ = Pg_->out; (void)out_;
#else
#define MK_KARGS const In in = P.in; unsigned char* ws = P.ws; float* out_ = P.out; (void)out_; (void)Pk_;
#endif
#define MK_PHASE_PTRS \
    MK_KARGS \
    bf16_t *W1a = (bf16_t*)(ws + O_W1A), *W1c = (bf16_t*)(ws + O_W1C), *Wg = (bf16_t*)(ws + O_WG), *Wbr = (bf16_t*)(ws + O_WBR), *Wout = (bf16_t*)(ws + O_WOUT), *rwt = (bf16_t*)(ws + O_RWT); \
    float* modpart = (float*)(ws + O_MODP); \
    bf16_t *z1 = (bf16_t*)(ws + O_Z1), *Hd = (bf16_t*)(ws + O_HD), *Ag = (bf16_t*)(ws + O_AG); float* bon = (float*)(ws + O_BON); \
    bf16_t *xnl = (bf16_t*)(ws + O_XNL), *yb = (bf16_t*)(ws + O_YB), *gates = (bf16_t*)(ws + O_GATES), *mixed = (bf16_t*)(ws + O_MIXED); \
    unsigned char* u8 = ws + O_U8; \
    bf16_t *u = (bf16_t*)(ws + O_U), *Wgu = (bf16_t*)(ws + O_WGU), *Wdn = (bf16_t*)(ws + O_WDN), *act = (bf16_t*)(ws + O_ACT), *rowsb = (bf16_t*)(ws + O_ROWSB); \
    int *tope = (int*)(ws + O_TOPE), *lrank = (int*)(ws + O_LRANK), *blkcnt = (int*)(ws + O_BLKCNT), *tilepre = (int*)(ws + O_TILEPRE), *list = (int*)(ws + O_LIST), *sdst = (int*)(ws + O_SDST); \
    float *gatev = (float*)(ws + O_GATEV), *sgate = (float*)(ws + O_SGATE); \
    bf16_t* xn_all = (bf16_t*)out_; \
    bf16_t* Y = (bf16_t*)out_; \
    float* y2h1 = out_;
__device__ __forceinline__ void stagger_start(int bid, int ticks  ) {
    const int grp = (bid >> 3) & 3;
    if (grp) { const unsigned long long t0 = __builtin_amdgcn_s_memrealtime(); while (__builtin_amdgcn_s_memrealtime() - t0 < (unsigned long long)(grp * ticks)) __builtin_amdgcn_s_sleep(8); }
    __builtin_amdgcn_s_waitcnt(0xC07F);
}

__global__ void __launch_bounds__(512, 2) mega(MP P) {
    extern __shared__ __attribute__((aligned(16))) unsigned char shm[];
    LAS unsigned char* lds = (LAS unsigned char*)shm;
    typedef const __attribute__((address_space(4))) MP* KargP;
    const KargP Pk_ = (KargP)__builtin_amdgcn_kernarg_segment_ptr();
    const int bid = blockIdx.x, nblk = gridDim.x;
    const int gbid = (nblk & 7) ? bid : (bid & 7) * (nblk >> 3) + (bid >> 3);
    const int ph_lo = (int)P.ph_lo, ph_hi = (int)P.ph_hi;
    volatile LAS unsigned* xst = (volatile LAS unsigned*)(lds + LDS_BYTES - 16);
    if (threadIdx.x == 0) { xst[0] = 0u; xst[1] = 0u; }
    __syncthreads();
    const XcdBarrier xb = xcd_barrier_post((unsigned*)(P.ws + O_BAR), xst);
    if (0 >= ph_lo && 0 < ph_hi) { if (0 > ph_lo) xcd_barrier(xb); const int ph = 0; (void)ph; MK_PHASE_PTRS
        { LAS float* tile = (LAS float*)lds; int base = 0;
            convT_job<true>(tile, in.w_in, INC, D, W1a, D, Z1_N, CMapZ1{}, bid, nblk, base, 256.f);
            convT_job(tile, in.w_in, INC, D, W1c, D, ZC_N, CMapZC{}, bid, nblk, base);
            convT_job(tile, in.rw_g_up, RW, GL, Wg, AG_K, RW, CMapId{}, bid, nblk, base);
            convT_job(tile, in.w_branch_a, D, RW, Wbr, RW, D, CMapId{}, bid, nblk, base);
            convT_job(tile, in.w_branch_b, D, LW, Wbr + (size_t)D * RW, LW, D, CMapId{}, bid, nblk, base);
            convT_job(tile, in.w_out, D, D, Wout, D, D, CMapId{}, bid, nblk, base);
            rwt_prep(in, rwt, bid, nblk);
            mod_partials((LAS float*)lds, in, modpart, bid, nblk); }
    }
    if (1 >= ph_lo && 1 < ph_hi) { if (1 > ph_lo) xcd_barrier(xb); const int ph = 1; (void)ph; MK_PHASE_PTRS
        { const int L = NLAT / nblk, Lc = NCTXR / nblk;
            xn_rows<true>((LAS float*)lds, in, modpart, xn_all, 0, NB, bid * L, (bid + 1) * L);
            xn_rows<true>((LAS float*)lds, in, modpart, xn_all, 0, NB, NLAT + bid * Lc, NLAT + (bid + 1) * Lc); }
    }
    if (2 >= ph_lo && 2 < ph_hi) { if (2 > ph_lo) xcd_barrier(xb); const int ph = 2; (void)ph; MK_PHASE_PTRS
        { GemmP g{xn_all, xn_all, W1a, 0, nullptr, D / 2, 0}; StaticOrder S; S.init(NALL, Z1_N, nblk, bid); gemm_phase<false, true>(lds, g, S, EpiStoreBf16S{z1, Z1_N, 1.f / 4096.f, 0}); }
    }
    if (3 >= ph_lo && 3 < ph_hi) { if (3 > ph_lo) xcd_barrier(xb); const int ph = 3; (void)ph; MK_PHASE_PTRS
        { LruP lp{z1, Hd, 0, NB}; lru_phase(lds, in, lp, bid, nblk); __syncthreads();
                  RwkvP rp{z1, Y, bon, 0, NB}; r3::rwkv_phase3(lds, in, rp, bid, nblk); }
    }
    if (4 >= ph_lo && 4 < ph_hi) { if (4 > ph_lo) xcd_barrier(xb); const int ph = 4; (void)ph; MK_PHASE_PTRS
        { const int L = NLAT / nblk; PostP pp{z1, Y, bon, Ag, NLAT, 0}; rwkv_post_rows((LAS float*)lds, in, pp, bid * L, (bid + 1) * L); }
    }
    if (5 >= ph_lo && 5 < ph_hi) { if (5 > ph_lo) xcd_barrier(xb); const int ph = 5; (void)ph; MK_PHASE_PTRS
        { const int L = NLAT / nblk;
            if (bid & 1) { xn_rows((LAS float*)lds, in, modpart, xnl, 0, NB, bid * L, (bid + 1) * L); __syncthreads(); }
            { GemmP g{Ag, Ag, Wg, 0, nullptr, AG_K, 0}; StaticOrder S; S.init(NLAT, RW, nblk, bid); gemm_phase(lds, g, S, EpiYa{Y, Y + (size_t)NLAT * RW}); }
            if (!(bid & 1)) { __syncthreads(); xn_rows((LAS float*)lds, in, modpart, xnl, 0, NB, bid * L, (bid + 1) * L); } }
    }
    if (6 >= ph_lo && 6 < ph_hi) { if (6 > ph_lo) xcd_barrier(xb); const int ph = 6; (void)ph; MK_PHASE_PTRS
        { GemmP g{xnl, xnl, W1c, 0, nullptr, D, 0}; StaticOrder S; S.init(NLAT, ZC_N, nblk, bid); gemm_phase(lds, g, S, EpiZc{Hd, yb, gates, NLAT, 0}); }
    }
    if (7 >= ph_lo && 7 < ph_hi) { if (7 > ph_lo) xcd_barrier(xb); const int ph = 7; (void)ph; MK_PHASE_PTRS
        { GemmP g{Y + (size_t)NLAT * RW, yb, Wbr, (long)D * RW, nullptr, D, 0}; PairOrder S; S.S.init(NLAT, D, nblk, bid); gemm_phase(lds, g, S, EpiBranch{gates, mixed}); }
    }
    if (8 >= ph_lo && 8 < ph_hi) { if (8 > ph_lo) xcd_barrier(xb); const int ph = 8; (void)ph; MK_PHASE_PTRS
        { LAS float* tile = (LAS float*)lds;
            struct MGU { const float* ex; const float* sh; unsigned char* d; __device__ const float* src(int m) const { return m < NE ? ex + (size_t)m * D * 2 * EF : sh; } __device__ unsigned char* dst(int m) const { return d + (size_t)m * 2 * EF * D; } };
            struct MDN { const float* ex; const float* sh; unsigned char* d; __device__ const float* src(int m) const { return m < NE ? ex + (size_t)m * EF * D : sh; } __device__ unsigned char* dst(int m) const { return d + (size_t)m * D * EF; } };
            auto conv = [&]() __attribute__((always_inline)) {
                convT_multi<true>(tile, MGU{in.ex_w_gu, in.sh_w_gu, (unsigned char*)Wgu}, NEX, 2 * EF, D, D, 2 * EF, CMapGU{EF}, bid, nblk, FP8_SW);
                convT_multi<true>(tile, MDN{in.ex_w_down, in.sh_w_down, (unsigned char*)Wdn}, NEX, D, EF, EF, D, CMapId{}, bid, nblk, FP8_SWD); };
            if (bid & 1) { conv(); __syncthreads(); }
            { GemmP g{mixed, mixed, Wout, 0, nullptr, D, 0}; StaticOrder S; S.init(NLAT, D, nblk, bid); gemm_phase(lds, g, S, EpiStoreBf16{u, D}); }
            if (!(bid & 1)) { __syncthreads(); conv(); } }
    }
    if (9 >= ph_lo && 9 < ph_hi) { if (9 > ph_lo) xcd_barrier(xb); const int ph = 9; (void)ph; MK_PHASE_PTRS
        { const int L = NLAT / nblk; RowP rp{y2h1, u, u8, modpart, rwt, tope, gatev, lrank, blkcnt, 0, NLAT}; row_pass(lds, in, rp, bid * L, (bid + 1) * L); }
    }
    if (10 >= ph_lo && 10 < ph_hi) { if (10 > ph_lo) xcd_barrier(xb); const int ph = 10; (void)ph; MK_PHASE_PTRS
        { const int q = ph - 10, half = q >= 4 ? 1 : 0, st = q - 4 * half;
            const int rpb = NLAT / nblk;
            auto assign = [&](int hf) { MoeP mp{tope, gatev, lrank, blkcnt, tilepre + hf * 256, list + (size_t)hf * MAXSLOTS, sdst + (size_t)hf * MAXSLOTS, sgate + (size_t)hf * MAXSLOTS, hf * NRH, NRH, hf * (nblk / 2), nblk / 2, rpb, 0}; moe_assign(lds, mp, bid, nblk); };
            auto fin = [&](int hf) { const int L = NRH / nblk, r0 = hf * NRH; final_rows((LAS float*)lds, in, modpart, rowsb, y2h1, 0, r0, r0 + bid * L, r0 + (bid + 1) * L); };
            if (ph == 10) { assign(0); __syncthreads(); assign(1); }
            else if (ph == 11 || ph == 13) { const int hf = ph == 13 ? 1 : 0;
                if (ph == 13 && (bid & 1)) { fin(0); __syncthreads(); }
                { GemmP g{(const bf16_t*)u8, (const bf16_t*)u8, Wgu, (long)EF * D, list + (size_t)hf * MAXSLOTS, D / 2, 0}; GroupOrder S; S.init(tilepre + hf * 256, 2 * EF / BM, nblk, gbid); gemm_phase<true, true>(lds, g, S, EpiGU{act}); }
                if (ph == 13 && !(bid & 1)) { __syncthreads(); fin(0); } }
            else if (ph == 12 || ph == 14) { const int hf = ph == 14 ? 1 : 0;
                GemmP g{act, act, Wdn, (long)D * EF / 2, nullptr, EF / 2, 0}; GroupOrder S; S.init(tilepre + hf * 256, D / BM, nblk, gbid); gemm_phase<false, true>(lds, g, S, EpiDown{sdst + (size_t)hf * MAXSLOTS, sgate + (size_t)hf * MAXSLOTS, rowsb, lds}); }
            else if (ph == 15) fin(1);
            (void)half; (void)st; }
    }
    if (11 >= ph_lo && 11 < ph_hi) { if (11 > ph_lo) xcd_barrier(xb); const int ph = 11; (void)ph; MK_PHASE_PTRS
        { const int q = ph - 10, half = q >= 4 ? 1 : 0, st = q - 4 * half;
            const int rpb = NLAT / nblk;
            auto assign = [&](int hf) { MoeP mp{tope, gatev, lrank, blkcnt, tilepre + hf * 256, list + (size_t)hf * MAXSLOTS, sdst + (size_t)hf * MAXSLOTS, sgate + (size_t)hf * MAXSLOTS, hf * NRH, NRH, hf * (nblk / 2), nblk / 2, rpb, 0}; moe_assign(lds, mp, bid, nblk); };
            auto fin = [&](int hf) { const int L = NRH / nblk, r0 = hf * NRH; final_rows((LAS float*)lds, in, modpart, rowsb, y2h1, 0, r0, r0 + bid * L, r0 + (bid + 1) * L); };
            if (ph == 10) { assign(0); __syncthreads(); assign(1); }
            else if (ph == 11 || ph == 13) { const int hf = ph == 13 ? 1 : 0;
                if (ph == 13 && (bid & 1)) { fin(0); __syncthreads(); }
                { GemmP g{(const bf16_t*)u8, (const bf16_t*)u8, Wgu, (long)EF * D, list + (size_t)hf * MAXSLOTS, D / 2, 0}; GroupOrder S; S.init(tilepre + hf * 256, 2 * EF / BM, nblk, gbid); gemm_phase<true, true>(lds, g, S, EpiGU{act}); }
                if (ph == 13 && !(bid & 1)) { __syncthreads(); fin(0); } }
            else if (ph == 12 || ph == 14) { const int hf = ph == 14 ? 1 : 0;
                GemmP g{act, act, Wdn, (long)D * EF / 2, nullptr, EF / 2, 0}; GroupOrder S; S.init(tilepre + hf * 256, D / BM, nblk, gbid); gemm_phase<false, true>(lds, g, S, EpiDown{sdst + (size_t)hf * MAXSLOTS, sgate + (size_t)hf * MAXSLOTS, rowsb, lds}); }
            else if (ph == 15) fin(1);
            (void)half; (void)st; }
    }
    if (12 >= ph_lo && 12 < ph_hi) { if (12 > ph_lo) xcd_barrier(xb); const int ph = 12; (void)ph; MK_PHASE_PTRS
        { const int q = ph - 10, half = q >= 4 ? 1 : 0, st = q - 4 * half;
            const int rpb = NLAT / nblk;
            auto assign = [&](int hf) { MoeP mp{tope, gatev, lrank, blkcnt, tilepre + hf * 256, list + (size_t)hf * MAXSLOTS, sdst + (size_t)hf * MAXSLOTS, sgate + (size_t)hf * MAXSLOTS, hf * NRH, NRH, hf * (nblk / 2), nblk / 2, rpb, 0}; moe_assign(lds, mp, bid, nblk); };
            auto fin = [&](int hf) { const int L = NRH / nblk, r0 = hf * NRH; final_rows((LAS float*)lds, in, modpart, rowsb, y2h1, 0, r0, r0 + bid * L, r0 + (bid + 1) * L); };
            if (ph == 10) { assign(0); __syncthreads(); assign(1); }
            else if (ph == 11 || ph == 13) { const int hf = ph == 13 ? 1 : 0;
                if (ph == 13 && (bid & 1)) { fin(0); __syncthreads(); }
                { GemmP g{(const bf16_t*)u8, (const bf16_t*)u8, Wgu, (long)EF * D, list + (size_t)hf * MAXSLOTS, D / 2, 0}; GroupOrder S; S.init(tilepre + hf * 256, 2 * EF / BM, nblk, gbid); gemm_phase<true, true>(lds, g, S, EpiGU{act}); }
                if (ph == 13 && !(bid & 1)) { __syncthreads(); fin(0); } }
            else if (ph == 12 || ph == 14) { const int hf = ph == 14 ? 1 : 0;
                GemmP g{act, act, Wdn, (long)D * EF / 2, nullptr, EF / 2, 0}; GroupOrder S; S.init(tilepre + hf * 256, D / BM, nblk, gbid); gemm_phase<false, true>(lds, g, S, EpiDown{sdst + (size_t)hf * MAXSLOTS, sgate + (size_t)hf * MAXSLOTS, rowsb, lds}); }
            else if (ph == 15) fin(1);
            (void)half; (void)st; }
    }
    if (13 >= ph_lo && 13 < ph_hi) { if (13 > ph_lo) xcd_barrier(xb); const int ph = 13; (void)ph; MK_PHASE_PTRS
        { const int q = ph - 10, half = q >= 4 ? 1 : 0, st = q - 4 * half;
            const int rpb = NLAT / nblk;
            auto assign = [&](int hf) { MoeP mp{tope, gatev, lrank, blkcnt, tilepre + hf * 256, list + (size_t)hf * MAXSLOTS, sdst + (size_t)hf * MAXSLOTS, sgate + (size_t)hf * MAXSLOTS, hf * NRH, NRH, hf * (nblk / 2), nblk / 2, rpb, 0}; moe_assign(lds, mp, bid, nblk); };
            auto fin = [&](int hf) { const int L = NRH / nblk, r0 = hf * NRH; final_rows((LAS float*)lds, in, modpart, rowsb, y2h1, 0, r0, r0 + bid * L, r0 + (bid + 1) * L); };
            if (ph == 10) { assign(0); __syncthreads(); assign(1); }
            else if (ph == 11 || ph == 13) { const int hf = ph == 13 ? 1 : 0;
                if (ph == 13 && (bid & 1)) { fin(0); __syncthreads(); }
                { GemmP g{(const bf16_t*)u8, (const bf16_t*)u8, Wgu, (long)EF * D, list + (size_t)hf * MAXSLOTS, D / 2, 0}; GroupOrder S; S.init(tilepre + hf * 256, 2 * EF / BM, nblk, gbid); gemm_phase<true, true>(lds, g, S, EpiGU{act}); }
                if (ph == 13 && !(bid & 1)) { __syncthreads(); fin(0); } }
            else if (ph == 12 || ph == 14) { const int hf = ph == 14 ? 1 : 0;
                GemmP g{act, act, Wdn, (long)D * EF / 2, nullptr, EF / 2, 0}; GroupOrder S; S.init(tilepre + hf * 256, D / BM, nblk, gbid); gemm_phase<false, true>(lds, g, S, EpiDown{sdst + (size_t)hf * MAXSLOTS, sgate + (size_t)hf * MAXSLOTS, rowsb, lds}); }
            else if (ph == 15) fin(1);
            (void)half; (void)st; }
    }
    if (14 >= ph_lo && 14 < ph_hi) { if (14 > ph_lo) xcd_barrier(xb); const int ph = 14; (void)ph; MK_PHASE_PTRS
        { const int q = ph - 10, half = q >= 4 ? 1 : 0, st = q - 4 * half;
            const int rpb = NLAT / nblk;
            auto assign = [&](int hf) { MoeP mp{tope, gatev, lrank, blkcnt, tilepre + hf * 256, list + (size_t)hf * MAXSLOTS, sdst + (size_t)hf * MAXSLOTS, sgate + (size_t)hf * MAXSLOTS, hf * NRH, NRH, hf * (nblk / 2), nblk / 2, rpb, 0}; moe_assign(lds, mp, bid, nblk); };
            auto fin = [&](int hf) { const int L = NRH / nblk, r0 = hf * NRH; final_rows((LAS float*)lds, in, modpart, rowsb, y2h1, 0, r0, r0 + bid * L, r0 + (bid + 1) * L); };
            if (ph == 10) { assign(0); __syncthreads(); assign(1); }
            else if (ph == 11 || ph == 13) { const int hf = ph == 13 ? 1 : 0;
                if (ph == 13 && (bid & 1)) { fin(0); __syncthreads(); }
                { GemmP g{(const bf16_t*)u8, (const bf16_t*)u8, Wgu, (long)EF * D, list + (size_t)hf * MAXSLOTS, D / 2, 0}; GroupOrder S; S.init(tilepre + hf * 256, 2 * EF / BM, nblk, gbid); gemm_phase<true, true>(lds, g, S, EpiGU{act}); }
                if (ph == 13 && !(bid & 1)) { __syncthreads(); fin(0); } }
            else if (ph == 12 || ph == 14) { const int hf = ph == 14 ? 1 : 0;
                GemmP g{act, act, Wdn, (long)D * EF / 2, nullptr, EF / 2, 0}; GroupOrder S; S.init(tilepre + hf * 256, D / BM, nblk, gbid); gemm_phase<false, true>(lds, g, S, EpiDown{sdst + (size_t)hf * MAXSLOTS, sgate + (size_t)hf * MAXSLOTS, rowsb, lds}); }
            else if (ph == 15) fin(1);
            (void)half; (void)st; }
    }
    if (15 >= ph_lo && 15 < ph_hi) { if (15 > ph_lo) xcd_barrier(xb); const int ph = 15; (void)ph; MK_PHASE_PTRS
        { const int q = ph - 10, half = q >= 4 ? 1 : 0, st = q - 4 * half;
            const int rpb = NLAT / nblk;
            auto assign = [&](int hf) { MoeP mp{tope, gatev, lrank, blkcnt, tilepre + hf * 256, list + (size_t)hf * MAXSLOTS, sdst + (size_t)hf * MAXSLOTS, sgate + (size_t)hf * MAXSLOTS, hf * NRH, NRH, hf * (nblk / 2), nblk / 2, rpb, 0}; moe_assign(lds, mp, bid, nblk); };
            auto fin = [&](int hf) { const int L = NRH / nblk, r0 = hf * NRH; final_rows((LAS float*)lds, in, modpart, rowsb, y2h1, 0, r0, r0 + bid * L, r0 + (bid + 1) * L); };
            if (ph == 10) { assign(0); __syncthreads(); assign(1); }
            else if (ph == 11 || ph == 13) { const int hf = ph == 13 ? 1 : 0;
                if (ph == 13 && (bid & 1)) { fin(0); __syncthreads(); }
                { GemmP g{(const bf16_t*)u8, (const bf16_t*)u8, Wgu, (long)EF * D, list + (size_t)hf * MAXSLOTS, D / 2, 0}; GroupOrder S; S.init(tilepre + hf * 256, 2 * EF / BM, nblk, gbid); gemm_phase<true, true>(lds, g, S, EpiGU{act}); }
                if (ph == 13 && !(bid & 1)) { __syncthreads(); fin(0); } }
            else if (ph == 12 || ph == 14) { const int hf = ph == 14 ? 1 : 0;
                GemmP g{act, act, Wdn, (long)D * EF / 2, nullptr, EF / 2, 0}; GroupOrder S; S.init(tilepre + hf * 256, D / BM, nblk, gbid); gemm_phase<false, true>(lds, g, S, EpiDown{sdst + (size_t)hf * MAXSLOTS, sgate + (size_t)hf * MAXSLOTS, rowsb, lds}); }
            else if (ph == 15) fin(1);
            (void)half; (void)st; }
    }
}
extern "C" void kernel_launch(void* const* d_in, const int* in_sizes, int n_in, void* d_out, int out_size, void* d_ws, size_t ws_size, hipStream_t stream) {
    static int grid = 0;
    if (grid == 0) {
        int dev = 0, cus = 0; hipGetDevice(&dev); hipDeviceGetAttribute(&cus, hipDeviceAttributeMultiprocessorCount, dev);
        hipFuncSetAttribute((const void*)mega, hipFuncAttributeMaxDynamicSharedMemorySize, LDS_BYTES);
        grid = cus;
        if (ws_size < O_END || grid != 256) fprintf(stderr, "kernel_launch: unexpected ws_size %zu (need %zu) or CU count %d\n", ws_size, (size_t)O_END, grid);
    }
    hipMemsetAsync((char*)d_ws + O_BAR, 0, XCD_BAR_WORDS * 4, stream);
    MP P; memset(&P, 0, sizeof(P));
    const float** f = (const float**)&P.in; for (int i = 0; i < 32; ++i) f[i] = (const float*)d_in[i];
    P.out = (float*)d_out; P.ws = (unsigned char*)d_ws;
#ifdef MK_PER_PHASE
    for (int ph = 0; ph < NPHASE; ++ph) { P.ph_lo = ph; P.ph_hi = ph + 1; hipLaunchKernelGGL(mega, dim3(grid), dim3(NT), LDS_BYTES, stream, P); }
#else
    P.ph_lo = 0; P.ph_hi = NPHASE;
    void* args[] = {&P};
    hipError_t e = hipLaunchCooperativeKernel((void*)mega, dim3(grid), dim3(NT), args, LDS_BYTES, stream);
    if (e != hipSuccess) fprintf(stderr, "cooperative launch failed: %s (grid %d)\n", hipGetErrorString(e), grid);
#endif
}
```

```cpp
#include <hip/hip_runtime.h>
#include <cstdio>
#include <cstring>
#define HD __host__ __device__ __forceinline__
static hipStream_t g_stream;

#ifdef SMALL
constexpr int D = 128, NB = 2, SEQ = 64, GW = 8, CTX = 16, RW = 128, RH = 64, DL = 16, AL = 16, GL = 24, LW = 128, LB = 2, NE = 8, TOPK = 3, NG = 4, TG = 2, EF = 32, SF = 32;
#else
constexpr int D = 1024, NB = 8, SEQ = 4096, GW = 64, CTX = 256, RW = 1024, RH = 64, DL = 64, AL = 64, GL = 160, LW = 1024, LB = 16, NE = 64, TOPK = 6, NG = 8, TG = 4, EF = 256, SF = 256;
#endif
constexpr int NH = RW / RH, LBS = LW / LB, ROWS = SEQ / GW, TA = CTX + SEQ;
constexpr int OFF_R = 0, OFF_K = RW, OFF_V = 2 * RW, OFF_WD = 3 * RW, OFF_AD = OFF_WD + 2 * DL, OFF_GD = OFF_AD + 2 * AL, RC = OFF_GD + GL;
constexpr int OFF_LX = RC, OFF_LG = OFF_LX + LW, OFF_GATE = OFF_LG + LW, INC = OFF_GATE + 2 * D;
constexpr int EPG = NE / NG, NASG = SEQ * TOPK;
#define NORM_EPS 1e-6f
#define LNX_EPS 64e-5f

HD float sigmoidf_(float x) { return 1.f / (1.f + expf(-x)); }
HD float softplusf_(float x) { return x > 20.f ? x : log1pf(expf(x)); }
HD float siluf_(float x) { return x * sigmoidf_(x); }
HD float gelu_tanhf_(float x) { return 0.5f * x * (1.f + tanhf(0.7978845608028654f * (x + 0.044715f * x * x * x))); }

struct In {
    const float *x, *c, *ctx, *c_ctx, *w_mod, *b_mod, *norm_g, *w_in, *shift_mu, *rw_w0, *rw_w_up, *rw_a0, *rw_a_up, *rw_g_up, *rw_k_k, *rw_k_a, *rw_r_k, *rw_lnx,
        *lru_conv_w, *lru_conv_b, *lru_gate_w, *lru_gate_b, *lru_l, *w_branch_a, *w_branch_b, *w_out, *router_w, *router_b, *ex_w_gu, *ex_w_down, *sh_w_gu, *sh_w_down;
};


namespace mk {
#define LAS __attribute__((address_space(3)))
typedef unsigned short bf16_t;
typedef short bf16x8 __attribute__((ext_vector_type(8)));
typedef float f32x4 __attribute__((ext_vector_type(4)));
typedef float f32x2 __attribute__((ext_vector_type(2)));
typedef int i32x4 __attribute__((ext_vector_type(4)));
typedef int i32x8 __attribute__((ext_vector_type(8)));
typedef unsigned u32x4 __attribute__((ext_vector_type(4)));
typedef unsigned u32x2 __attribute__((ext_vector_type(2)));
constexpr int NT = 512;
constexpr int BM = 256, BK = 64, HALF = 128, HTB = HALF * BK * 2, STAGE_BYTES = 8 * HTB;
constexpr int LDS_BYTES = 160 * 1024 - 1024;

constexpr int Z1_LX = 3584, Z1_N = 4608;
constexpr int ZC_N = 3072;

__device__ __forceinline__ unsigned cvt_pk_bf16(float lo, float hi) { unsigned r; asm volatile("s_nop 0\n\tv_cvt_pk_bf16_f32 %0, %1, %2" : "=v"(r) : "v"(lo), "v"(hi)); return r; }
__device__ __forceinline__ bf16_t f2bf(float f) { unsigned u = __float_as_uint(f); u += 0x7FFFu + ((u >> 16) & 1u); return (bf16_t)(u >> 16); }
__device__ __forceinline__ float bf2f(bf16_t b) { return __uint_as_float(((unsigned)b) << 16); }
__device__ __forceinline__ float bflo(unsigned w) { return __uint_as_float(w << 16); }
__device__ __forceinline__ float bfhi(unsigned w) { return __uint_as_float(w & 0xffff0000u); }

#define MK_DPPF(x, ctrl) __int_as_float(__builtin_amdgcn_update_dpp(__float_as_int(x), __float_as_int(x), ctrl, 0xF, 0xF, false))
__device__ __forceinline__ float wave_sum64(float x) {
    x += MK_DPPF(x, 0xB1); x += MK_DPPF(x, 0x4E); x += MK_DPPF(x, 0x141); x += MK_DPPF(x, 0x140);
    const int xi = __float_as_int(x);
    return (__int_as_float(__builtin_amdgcn_readlane(xi, 0)) + __int_as_float(__builtin_amdgcn_readlane(xi, 16))) + (__int_as_float(__builtin_amdgcn_readlane(xi, 32)) + __int_as_float(__builtin_amdgcn_readlane(xi, 48)));
}
__device__ __forceinline__ float wave_max64(float x) {
    x = fmaxf(x, MK_DPPF(x, 0xB1)); x = fmaxf(x, MK_DPPF(x, 0x4E)); x = fmaxf(x, MK_DPPF(x, 0x141)); x = fmaxf(x, MK_DPPF(x, 0x140));
    const int xi = __float_as_int(x);
    return fmaxf(fmaxf(__int_as_float(__builtin_amdgcn_readlane(xi, 0)), __int_as_float(__builtin_amdgcn_readlane(xi, 16))), fmaxf(__int_as_float(__builtin_amdgcn_readlane(xi, 32)), __int_as_float(__builtin_amdgcn_readlane(xi, 48))));
}
__device__ __forceinline__ float fast_rcp(float x) { return __builtin_amdgcn_rcpf(x); }
__device__ __forceinline__ float fast_sigmoid(float x) { return fast_rcp(1.f + __expf(-x)); }
__device__ __forceinline__ float fast_tanh(float x) { return 1.f - 2.f * fast_rcp(1.f + __expf(2.f * x)); }
__device__ __forceinline__ float fast_softplus(float x) { return x > 15.f ? x : __logf(1.f + __expf(x)); }
__device__ __forceinline__ float fast_silu(float x) { return x * fast_sigmoid(x); }
__device__ __forceinline__ float fast_gelu_tanh(float x) { return x * fast_sigmoid(1.5957691216057308f * (x + 0.044715f * x * x * x)); }
__device__ __forceinline__ int lds_byte(int r, int c) { const int st = (r >> 4) * 2 + (c >> 5), rr = r & 15, cc = c & 31, ob = rr * 64 + cc * 2; return st * 1024 + (ob ^ (((ob >> 9) & 1) << 5)); }
__device__ __forceinline__ void stage_rc(int b, int& R, int& C) { const int st = b / 1024, sb = b % 1024, swz = sb ^ (((sb >> 9) & 1) << 5); R = (st >> 1) * 16 + swz / 64; C = (st & 1) * 32 + (swz % 64) / 2; }
__device__ __forceinline__ int perm32(int rho) { const int n = rho >> 4, i = rho & 15; return 8 * (i >> 2) + 4 * n + (i & 3); }

struct Unit { int pm, pn, e; };
struct GemmP { const bf16_t* A0; const bf16_t* A1; const bf16_t* Bt; long strideB; const int* gather; int K; int pad_; };

struct StaticOrder {
    int nM, nN, nwg, G, c;
    __device__ void init(int M, int N, int G_, int c_) { nM = M / BM; nN = N / BM; nwg = nM * nN; G = G_; c = c_; }
    __device__ bool next(int i, Unit& u) const {
        const long L = (long)i * G + c; if (L >= nwg) return false;
        int wgid = (int)L; { const int q = nwg / 8, r = nwg % 8, xcd = wgid % 8, off = wgid / 8; wgid = (xcd < r ? xcd * (q + 1) : r * (q + 1) + (xcd - r) * q) + off; }
        const int nig = 8 * nN, gid = wgid / nig, fm = gid * 8, gsz = (nM - fm) < 8 ? (nM - fm) : 8;
        u.pm = fm + ((wgid % nig) % gsz); u.pn = (wgid % nig) / gsz; u.e = 0; return true;
    }
};

#define MK_FRAG_LOOP(ROW, COL) \
    _Pragma("unroll") for (int ai = 0; ai < 2; ++ai) _Pragma("unroll") for (int m = 0; m < 4; ++m) _Pragma("unroll") for (int bj = 0; bj < 2; ++bj) \
        if (const int ROW = ai * HALF + wr * 64 + m * 16 + fr; true) if (const int COL = bj * HALF + wc * 32 + 8 * fq; true)

template <class E, class = void> struct epi_has_begin { static constexpr bool value = false; };
template <class E> struct epi_has_begin<E, decltype((void)&E::unit_begin)> { static constexpr bool value = true; };
template <bool B> struct BoolC { static constexpr bool value = B; };
template <class E, class = void> struct epi_ns { static constexpr int value = 0; };
template <class E> struct epi_ns<E, decltype((void)E::NS)> { static constexpr int value = 0 * E::NS; };
template <class E> __device__ __forceinline__ void epi_unit_begin(const E& e, const Unit& u, LAS unsigned char* lds) { if constexpr (epi_has_begin<E>::value) e.unit_begin(u, lds); }
template <bool GATHER = false, bool FP8 = false, class Epi, class Sched>
__device__ __forceinline__ void gemm_phase(LAS unsigned char* lds, const GemmP g, const Sched& S, const Epi& E) {
    const int tid = threadIdx.x, wid = __builtin_amdgcn_readfirstlane(tid >> 6), lane = tid & 63, wr = wid >> 2, wc = wid & 3, fr = lane & 15, fq = lane >> 4;
    int K = g.K; asm volatile("" : "+s"(K));
    const int nt = K / BK;
    int RA[2], CA[2]; unsigned voffB[2];
#pragma unroll
    for (int i = 0; i < 2; ++i) { int R, C; stage_rc(tid * 16 + i * 8192, R, C); RA[i] = R; CA[i] = C; const int Rb = (R & ~31) + perm32(R & 31); voffB[i] = (unsigned)(Rb * K + C) * 2u; }
    const size_t kstep = (size_t)(BK * 2), hstepB = (size_t)HALF * K * 2, tstepB = 2 * hstepB;
    const unsigned ldsw = (unsigned)wid * 1024u;
    const int aoff = lds_byte(wr * 64 + fr, fq * 8), boff = lds_byte(wc * 32 + fr, fq * 8);
#define MK_SA(b, h) (((b) * 2 + (h)) * HTB)
#define MK_SB(b, h) ((4 + (b) * 2 + (h)) * HTB)
#define MK_STAGE(bufoff, gbase, voff) do { _Pragma("unroll") for (int _i = 0; _i < 2; ++_i) \
        __builtin_amdgcn_global_load_lds((const unsigned*)((const char*)(gbase) + (voff)[_i]), (LAS unsigned*)(lds + (bufoff) + ldsw + _i * 8192), 16, 0, 0); } while (0)
#define MK_CAT8(x, y) __builtin_shufflevector(__builtin_bit_cast(i32x4, x), __builtin_bit_cast(i32x4, y), 0, 1, 2, 3, 4, 5, 6, 7)
#define MK_LDA(dst, b, h) do { _Pragma("unroll") for (int m = 0; m < 4; ++m) { if constexpr (FP8) dst##8[m] = MK_CAT8(*(const LAS bf16x8*)(lds + MK_SA(b, h) + aoff + m * 2048), *(const LAS bf16x8*)(lds + MK_SA(b, h) + aoff + m * 2048 + 1024)); \
        else { _Pragma("unroll") for (int k = 0; k < 2; ++k) dst[m][k] = *(const LAS bf16x8*)(lds + MK_SA(b, h) + aoff + m * 2048 + k * 1024); } } } while (0)
#define MK_LDB(dst, b, h) do { _Pragma("unroll") for (int n = 0; n < 2; ++n) { if constexpr (FP8) dst##8[n] = MK_CAT8(*(const LAS bf16x8*)(lds + MK_SB(b, h) + boff + n * 2048), *(const LAS bf16x8*)(lds + MK_SB(b, h) + boff + n * 2048 + 1024)); \
        else { _Pragma("unroll") for (int k = 0; k < 2; ++k) dst[n][k] = *(const LAS bf16x8*)(lds + MK_SB(b, h) + boff + n * 2048 + k * 1024); } } } while (0)
#define MK_MMA(ai, bj, At, Bt) do { __builtin_amdgcn_s_setprio(1); _Pragma("unroll") for (int m = 0; m < 4; ++m) _Pragma("unroll") for (int n = 0; n < 2; ++n) { \
        if constexpr (FP8) asm volatile("v_mfma_scale_f32_16x16x128_f8f6f4 %0, %1, %2, %0, %3, %3 op_sel_hi:[0,0,0]" : "+v"(acc[ai][bj][m][n]) : "v"(Bt##8[n]), "v"(At##8[m]), "v"(mx_one));   \
        else { _Pragma("unroll") for (int k = 0; k < 2; ++k) acc[ai][bj][m][n] = __builtin_amdgcn_mfma_f32_16x16x32_bf16(Bt[n][k], At[m][k], acc[ai][bj][m][n], 0, 0, 0); } } \
        __builtin_amdgcn_s_setprio(0); } while (0)
#define MK_WAIT_V(n) asm volatile("s_waitcnt vmcnt(" #n ")" ::: "memory")
#define MK_WAIT_L(n) asm volatile("s_waitcnt lgkmcnt(" #n ")" ::: "memory")
#define MK_BAR __builtin_amdgcn_s_barrier()
#define MK_SCHED __builtin_amdgcn_sched_barrier(0)
    Unit cur, nxt; int ui = 0;
    if (!S.next(0, cur)) return;
    f32x4 acc[2][2][4][2];
#pragma unroll
    for (int a = 0; a < 2; ++a)
#pragma unroll
        for (int b = 0; b < 2; ++b)
#pragma unroll
            for (int m = 0; m < 4; ++m)
#pragma unroll
                for (int n = 0; n < 2; ++n) acc[a][b][m][n] = (f32x4){0.f, 0.f, 0.f, 0.f};
    bf16x8 At[4][2], B0[2][2], B1[2][2];
    i32x8 At8[4], B08[2], B18[2];
    int mx_one = 0x7f7f7f7f; asm volatile("" : "+v"(mx_one));
    unsigned vA[2][2], vAn[2][2];
    const size_t hstepA = GATHER ? 0 : (size_t)HALF * K * 2, tstepA = 2 * (size_t)HALF * K * 2;
    auto a_voff = [&](const Unit& u, unsigned (&vo)[2][2]) {
#pragma unroll
        for (int h = 0; h < 2; ++h)
#pragma unroll
            for (int i = 0; i < 2; ++i) { if (GATHER) { const int row = u.pm * BM + h * HALF + RA[i]; vo[h][i] = (unsigned)((size_t)g.gather[row] * K + CA[i]) * 2u; } else vo[h][i] = (unsigned)(RA[i] * K + CA[i]) * 2u; }
    };
    a_voff(cur, vA);
    const LAS int* GLDS = (const LAS int*)(lds + STAGE_BYTES + 2048);
    auto a_voff_lds = [&](unsigned (&vo)[2][2]) {
#pragma unroll
        for (int h = 0; h < 2; ++h)
#pragma unroll
            for (int i = 0; i < 2; ++i) vo[h][i] = (unsigned)((size_t)GLDS[h * HALF + RA[i]] * K + CA[i]) * 2u;
    };
    auto a_base = [&](const Unit& u) { return (const char*)(u.e ? g.A1 : g.A0) + (GATHER ? (size_t)0 : (size_t)u.pm * tstepA); };
    const char* cA = a_base(cur);
    const char* cB = (const char*)g.Bt + ((size_t)cur.e * g.strideB) * 2 + (size_t)cur.pn * tstepB;
    MK_STAGE(MK_SB(0, 0), cB, voffB); MK_STAGE(MK_SA(0, 0), cA, vA[0]); MK_STAGE(MK_SB(0, 1), cB + hstepB, voffB); MK_STAGE(MK_SA(0, 1), cA + hstepA, vA[1]);
    if (wr == 1) MK_BAR;
    MK_WAIT_V(4); MK_BAR;
    MK_STAGE(MK_SB(1, 0), cB + kstep, voffB); MK_STAGE(MK_SA(1, 0), cA + kstep, vA[0]); MK_STAGE(MK_SB(1, 1), cB + hstepB + kstep, voffB);
    MK_WAIT_V(6); MK_BAR;
    for (;;) {
        epi_unit_begin(E, cur, lds);
        const bool has_next = S.next(ui + 1, nxt);
        if (GATHER && has_next && wid < 4) __builtin_amdgcn_global_load_lds((const unsigned*)g.gather + (size_t)nxt.pm * BM + wid * 64 + lane, (LAS unsigned*)(lds + STAGE_BYTES + 2048 + wid * 256), 4, 0, 0);
        const char* nA = has_next ? a_base(nxt) : cA;
        const char* nB = has_next ? (const char*)g.Bt + ((size_t)nxt.e * g.strideB) * 2 + (size_t)nxt.pn * tstepB : cB;
        for (int t = 0; t < nt; t += 2) {
            const bool last = (t == nt - 2);
            const int relax = (epi_ns<Epi>::value == 16 && t == 0) ? 1 : 0;
#define MK_WAIT_VR do { if constexpr (epi_ns<Epi>::value != 16) MK_WAIT_V(10); else asm volatile("v_cmp_ne_u32_e32 vcc, 0, %0\n\ts_nop 3\n\ts_cbranch_vccnz .Lwr%=\n\ts_waitcnt vmcnt(10)\n.Lwr%=:\n\ts_waitcnt vmcnt(26)" :: "v"(relax) : "vcc", "memory"); } while (0)
            if (GATHER && last) { if (has_next) a_voff_lds(vAn); else {
#pragma unroll
                for (int h = 0; h < 2; ++h)
#pragma unroll
                    for (int i = 0; i < 2; ++i) vAn[h][i] = vA[h][i]; } }
            const char* a1 = cA + (size_t)(t + 1) * kstep;
            const char* a2 = last ? nA : cA + (size_t)(t + 2) * kstep; const char* b2 = last ? nB : cB + (size_t)(t + 2) * kstep;
            const char* a3 = a2 + kstep; const char* b3 = b2 + kstep;
            unsigned v2[2][2];
#pragma unroll
            for (int h = 0; h < 2; ++h)
#pragma unroll
                for (int i = 0; i < 2; ++i) v2[h][i] = (GATHER && last) ? vAn[h][i] : vA[h][i];
            MK_LDB(B0, 0, 0); MK_SCHED; MK_LDA(At, 0, 0); MK_STAGE(MK_SA(1, 1), a1 + hstepA, vA[1]);
            MK_WAIT_VR; MK_WAIT_L(8); MK_BAR; MK_WAIT_L(0); MK_MMA(0, 0, At, B0); MK_BAR; MK_SCHED;
            MK_LDB(B1, 0, 1); MK_STAGE(MK_SB(0, 0), b2, voffB);
            MK_WAIT_VR; MK_BAR; MK_WAIT_L(0); MK_MMA(0, 1, At, B1); MK_BAR;
            MK_LDA(At, 0, 1); MK_STAGE(MK_SA(0, 0), a2, v2[0]);
            MK_BAR; MK_WAIT_L(0); MK_MMA(1, 0, At, B0); MK_BAR; MK_SCHED;
            MK_STAGE(MK_SB(0, 1), b2 + hstepB, voffB);
            MK_WAIT_VR; MK_BAR; MK_MMA(1, 1, At, B1); MK_BAR;
            MK_LDB(B0, 1, 0); MK_SCHED; MK_LDA(At, 1, 0); MK_STAGE(MK_SA(0, 1), a2 + hstepA, v2[1]);
            MK_WAIT_VR; MK_WAIT_L(8); MK_BAR; MK_WAIT_L(0); MK_MMA(0, 0, At, B0); MK_BAR; MK_SCHED;
            MK_LDB(B1, 1, 1); MK_STAGE(MK_SB(1, 0), b3, voffB);
            MK_WAIT_V(10); MK_BAR; MK_WAIT_L(0); MK_MMA(0, 1, At, B1); MK_BAR;
            MK_LDA(At, 1, 1); MK_STAGE(MK_SA(1, 0), a3, v2[0]);
            MK_BAR; MK_WAIT_L(0); MK_MMA(1, 0, At, B0); MK_BAR; MK_SCHED;
            MK_STAGE(MK_SB(1, 1), b3 + hstepB, voffB);
            MK_WAIT_V(10); MK_BAR; MK_MMA(1, 1, At, B1); MK_BAR;
        }
        if constexpr (FP8) asm volatile("s_nop 15\n\ts_nop 15" : "+v"(acc[1][1][0][0]), "+v"(acc[1][1][0][1]), "+v"(acc[1][1][1][0]), "+v"(acc[1][1][1][1]),
                                        "+v"(acc[1][1][2][0]), "+v"(acc[1][1][2][1]), "+v"(acc[1][1][3][0]), "+v"(acc[1][1][3][1]) :: "memory");
        int fr_ = fr, fq_ = fq; asm volatile("" : "+v"(fr_), "+v"(fq_));
        if (wr == 0) MK_BAR;
        const bool keep = E(acc, cur, wr, wc, fr_, fq_);
        if (wr == 1) MK_BAR;
        if (!has_next) break;
        if (!keep) {
#pragma unroll
            for (int a = 0; a < 2; ++a)
#pragma unroll
                for (int b = 0; b < 2; ++b)
#pragma unroll
                    for (int m = 0; m < 4; ++m)
#pragma unroll
                        for (int n = 0; n < 2; ++n) acc[a][b][m][n] = (f32x4){0.f, 0.f, 0.f, 0.f};
        }
        cur = nxt; cA = nA; cB = nB; ++ui;
        if (GATHER) {
#pragma unroll
            for (int h = 0; h < 2; ++h)
#pragma unroll
                for (int i = 0; i < 2; ++i) vA[h][i] = vAn[h][i]; }
    }
    MK_WAIT_V(0);
    if (wr == 0) MK_BAR;
    MK_BAR;
#undef MK_SA
#undef MK_SB
#undef MK_STAGE
#undef MK_LDA
#undef MK_LDB
#undef MK_MMA
#undef MK_CAT8
#undef MK_WAIT_V
#undef MK_WAIT_VR
#undef MK_WAIT_L
#undef MK_BAR
#undef MK_SCHED
}

__device__ __forceinline__ unsigned pack4_fp8(float a, float b, float c, float d) {
    a = fminf(fmaxf(a, -448.f), 448.f); b = fminf(fmaxf(b, -448.f), 448.f); c = fminf(fmaxf(c, -448.f), 448.f); d = fminf(fmaxf(d, -448.f), 448.f);
    int w = __builtin_amdgcn_cvt_pk_fp8_f32(a, b, 0, false); w = __builtin_amdgcn_cvt_pk_fp8_f32(c, d, w, true); return (unsigned)w; }
__device__ __forceinline__ u32x4 pack8(const f32x4 a, const f32x4 b) { u32x4 w; w.x = cvt_pk_bf16(a[0], a[1]); w.y = cvt_pk_bf16(a[2], a[3]); w.z = cvt_pk_bf16(b[0], b[1]); w.w = cvt_pk_bf16(b[2], b[3]); return w; }
struct EpiStoreBf16S {
    bf16_t* O; long ldc; float sc; int pad_;
    __device__ __forceinline__ bool operator()(const f32x4 (&acc)[2][2][4][2], const Unit& u, int wr, int wc, int fr, int fq) const {
        MK_FRAG_LOOP(r, c) { *(u32x4*)(O + (size_t)(u.pm * BM + r) * ldc + u.pn * BM + c) = pack8(acc[ai][bj][m][0] * sc, acc[ai][bj][m][1] * sc); }
        return false;
    }
};
struct EpiStoreBf16 {
    static constexpr int NS = 16;
    bf16_t* O; long ldc;
    __device__ __forceinline__ bool operator()(const f32x4 (&acc)[2][2][4][2], const Unit& u, int wr, int wc, int fr, int fq) const {
        MK_FRAG_LOOP(r, c) { *(u32x4*)(O + (size_t)(u.pm * BM + r) * ldc + u.pn * BM + c) = pack8(acc[ai][bj][m][0], acc[ai][bj][m][1]); }
        return false;
    }
};

struct EpiStorePred {
    bf16_t* O; long ldc;
    __device__ __forceinline__ bool operator()(const f32x4 (&acc)[2][2][4][2], const Unit& u, int wr, int wc, int fr, int fq) const {
        MK_FRAG_LOOP(r, c) { const u32x4 w = pack8(acc[ai][bj][m][0], acc[ai][bj][m][1]); if (w.x == 0x7fc17fc1u && w.w == 0x12345678u) *(u32x4*)(O + (size_t)(u.pm * BM + r) * ldc + u.pn * BM + c) = w; }
        return false;
    }
};
struct EpiStoreLine {
    bf16_t* O; long nunit;
    __device__ __forceinline__ bool operator()(const f32x4 (&acc)[2][2][4][2], const Unit& u, int wr, int wc, int fr, int fq) const {
        const size_t ub = (size_t)((u.pm * 18 + u.pn) % (int)nunit) * (BM * BM); const int wid = wr * 4 + wc, lane = fq * 16 + fr; int f = 0;
        MK_FRAG_LOOP(r, c) { *(u32x4*)(O + ub + ((size_t)(f * 8 + wid) * 64 + lane) * 8) = pack8(acc[ai][bj][m][0], acc[ai][bj][m][1]); ++f; }
        return false;
    }
};
struct EpiNull {
    __device__ __forceinline__ bool operator()(const f32x4 (&acc)[2][2][4][2], const Unit& u, int wr, int wc, int fr, int fq) const {
        MK_FRAG_LOOP(r, c) { asm volatile("" :: "v"(acc[ai][bj][m][0]), "v"(acc[ai][bj][m][1])); }
        return false;
    }
};

__device__ __forceinline__ void ld8_contig(const float* p, float (&o)[8]) { const f32x4 a = *(const f32x4*)p, b = *(const f32x4*)(p + 4); o[0] = a[0]; o[1] = a[1]; o[2] = a[2]; o[3] = a[3]; o[4] = b[0]; o[5] = b[1]; o[6] = b[2]; o[7] = b[3]; }
struct CMapZ1 { __device__ int operator()(int n) const { return n < RC ? n : (n < Z1_LX ? -1 : OFF_LX + (n - Z1_LX)); }
    __device__ __forceinline__ void load8(const float* rowp, int n, float (&o)[8]) const { const int sc = (*this)(n); if (sc >= 0) ld8_contig(rowp + sc, o); else {
#pragma unroll
        for (int j = 0; j < 8; ++j) o[j] = 0.f; } } };
struct CMapZC { __device__ int operator()(int n) const { return OFF_LG + n; }
    __device__ __forceinline__ void load8(const float* rowp, int n, float (&o)[8]) const { ld8_contig(rowp + OFF_LG + n, o); } };
struct CMapId { __device__ int operator()(int n) const { return n; }
    __device__ __forceinline__ void load8(const float* rowp, int n, float (&o)[8]) const { ld8_contig(rowp + n, o); } };
struct CMapGU { int F; __device__ int operator()(int n) const { return (n & 1) * F + (n >> 1); }
    __device__ __forceinline__ void load8(const float* rowp, int n, float (&o)[8]) const { const f32x4 g = *(const f32x4*)(rowp + (n >> 1)), u = *(const f32x4*)(rowp + F + (n >> 1));
        o[0] = g[0]; o[1] = u[0]; o[2] = g[1]; o[3] = u[1]; o[4] = g[2]; o[5] = u[2]; o[6] = g[3]; o[7] = u[3]; } };
constexpr int CT_B = 8;
template <bool OUT8 = false, class CM>
__device__ __forceinline__ void convT_job(LAS float* tile  , const float* src, int lds_, int Ks, bf16_t* dst, int Kd, int N, const CM& cm, int bid, int nblk, int& base, float oscale = 1.f) {
    const int tk = Kd / 64, nt = (N / 64) * tk, tid = threadIdx.x;
    const int first = (bid - base % nblk + nblk) % nblk;
    const int kk = tid >> 3, nn8 = (tid & 7) * 8, nn = tid >> 3, kk8 = (tid & 7) * 8;
    for (int t0 = first; t0 < nt; t0 += CT_B * nblk) {
        float v[CT_B][8];
#pragma unroll
        for (int b = 0; b < CT_B; ++b) { const int t = t0 + b * nblk; const int n0 = (t / tk) * 64, k0 = (t % tk) * 64, k = k0 + kk;
            if (t < nt && k < Ks) cm.load8(src + (size_t)k * lds_, n0 + nn8, v[b]); else {
#pragma unroll
                for (int j = 0; j < 8; ++j) v[b][j] = 0.f; } }
#pragma unroll
        for (int b = 0; b < CT_B; ++b)
#pragma unroll
            for (int j = 0; j < 8; ++j) tile[b * 64 * 65 + kk * 65 + nn8 + j] = v[b][j];
        __syncthreads();
#pragma unroll
        for (int b = 0; b < CT_B; ++b) { const int t = t0 + b * nblk; if (t < nt) { const int n0 = (t / tk) * 64, k0 = (t % tk) * 64; f32x4 a, c;
#pragma unroll
            for (int j = 0; j < 4; ++j) { a[j] = tile[b * 64 * 65 + (kk8 + j) * 65 + nn]; c[j] = tile[b * 64 * 65 + (kk8 + 4 + j) * 65 + nn]; }
            if constexpr (OUT8) { u32x2 w8; w8.x = pack4_fp8(a[0] * oscale, a[1] * oscale, a[2] * oscale, a[3] * oscale); w8.y = pack4_fp8(c[0] * oscale, c[1] * oscale, c[2] * oscale, c[3] * oscale);
                *(u32x2*)((unsigned char*)dst + (size_t)(n0 + nn) * Kd + k0 + kk8) = w8; }
            else *(u32x4*)(dst + (size_t)(n0 + nn) * Kd + k0 + kk8) = pack8(a, c); } }
        __syncthreads();
    }
    base += nt;
}

template <bool OUT8 = false, class CM, class MS>
__device__ __forceinline__ void convT_multi(LAS float* tile, const MS& ms, int nmat, int lds_, int Ks, int Kd, int N, const CM& cm, int bid, int nblk, float oscale = 1.f) {
    const int tk = Kd / 64, tpm = (N / 64) * tk, nt = nmat * tpm, tid = threadIdx.x;
    const int kk = tid >> 3, nn8 = (tid & 7) * 8, nn = tid >> 3, kk8 = (tid & 7) * 8;
    for (int t0 = bid; t0 < nt; t0 += CT_B * nblk) {
        float v[CT_B][8];
#pragma unroll
        for (int b = 0; b < CT_B; ++b) { const int T = t0 + b * nblk, m = T / tpm, t = T % tpm; const int n0 = (t / tk) * 64, k0 = (t % tk) * 64, k = k0 + kk;
            if (T < nt && k < Ks) cm.load8(ms.src(m) + (size_t)k * lds_, n0 + nn8, v[b]); else {
#pragma unroll
                for (int j = 0; j < 8; ++j) v[b][j] = 0.f; } }
#pragma unroll
        for (int b = 0; b < CT_B; ++b)
#pragma unroll
            for (int j = 0; j < 8; ++j) tile[b * 64 * 65 + kk * 65 + nn8 + j] = v[b][j];
        __syncthreads();
#pragma unroll
        for (int b = 0; b < CT_B; ++b) { const int T = t0 + b * nblk; if (T < nt) { const int m = T / tpm, t = T % tpm, n0 = (t / tk) * 64, k0 = (t % tk) * 64; f32x4 a, c;
#pragma unroll
            for (int j = 0; j < 4; ++j) { a[j] = tile[b * 64 * 65 + (kk8 + j) * 65 + nn]; c[j] = tile[b * 64 * 65 + (kk8 + 4 + j) * 65 + nn]; }
            if constexpr (OUT8) { u32x2 w8; w8.x = pack4_fp8(a[0] * oscale, a[1] * oscale, a[2] * oscale, a[3] * oscale); w8.y = pack4_fp8(c[0] * oscale, c[1] * oscale, c[2] * oscale, c[3] * oscale);
                *(u32x2*)((unsigned char*)ms.dst(m) + (size_t)(n0 + nn) * Kd + k0 + kk8) = w8; }
            else *(u32x4*)(ms.dst(m) + (size_t)(n0 + nn) * Kd + k0 + kk8) = pack8(a, c); } }
        __syncthreads();
    }
}

constexpr int MOD_SL = 16, MOD_KS = D / MOD_SL;
__device__ __forceinline__ void mod_partials(LAS float* sl  , const In& in, float* part  , int bid, int nblk) {
    const int ncc = 6 * D / NT, nitem = MOD_SL * ncc;
    for (int it = bid; it < nitem; it += nblk) {
        const int s = it / ncc, j = (it % ncc) * NT + threadIdx.x;
        for (int i = threadIdx.x; i < (NB + 1) * MOD_KS; i += NT) { const int r = i / MOD_KS, k = s * MOD_KS + i % MOD_KS; const float cv = r < NB ? in.c[r * D + k] : in.c_ctx[k]; sl[i] = siluf_(cv); }
        __syncthreads();
        float acc[NB + 1];
#pragma unroll
        for (int r = 0; r <= NB; ++r) acc[r] = 0.f;
        for (int k = 0; k < MOD_KS; ++k) { const float w = in.w_mod[(size_t)(s * MOD_KS + k) * 6 * D + j];
#pragma unroll
            for (int r = 0; r <= NB; ++r) acc[r] += sl[r * MOD_KS + k] * w; }
#pragma unroll
        for (int r = 0; r <= NB; ++r) part[((size_t)s * (NB + 1) + r) * 6 * D + j] = acc[r];
        __syncthreads();
    }
}
__device__ __forceinline__ float mod_value(const In& in, const float* part, int r, int j) {
    float s = in.b_mod[j];
#pragma unroll
    for (int q = 0; q < MOD_SL; ++q) s += part[((size_t)q * (NB + 1) + r) * 6 * D + j];
    return s;
}

template <bool OUT8 = false>
__device__ __forceinline__ void xn_rows(LAS float* sm  , const In& in, const float* part, bf16_t* xn, int b0, int nb, int row_lo, int row_hi) {
    const int nlat = nb * SEQ, wid = threadIdx.x >> 6, lane = threadIdx.x & 63;
    int cur_mr = -1;
    float gp[16];
#pragma unroll
    for (int j = 0; j < 4; ++j)
#pragma unroll
        for (int q = 0; q < 4; ++q) gp[4 * j + q] = in.norm_g[j * 256 + lane * 4 + q];
    auto src_of = [&](int r) __attribute__((always_inline)) { return r < nlat ? in.x + ((size_t)b0 * SEQ + r) * D : in.ctx + ((size_t)b0 * CTX + (r - nlat)) * D; };
    f32x4 nx[4];
    { const int r = row_lo + wid; if (r < row_hi) { const float* src = src_of(r);
#pragma unroll
        for (int j = 0; j < 4; ++j) nx[j] = *(const f32x4*)(src + j * 256 + lane * 4); } }
    for (int rbase = row_lo; rbase < row_hi; rbase += 8) {
        const int mr = rbase < nlat ? b0 + rbase / SEQ : NB;
        if (mr != cur_mr) { __syncthreads(); for (int j = threadIdx.x; j < 2 * D; j += NT) sm[j] = mod_value(in, part, mr, j); __syncthreads(); cur_mr = mr; }
        const int r = rbase + wid; if (r >= row_hi) continue;
        f32x4 v[4]; float ss = 0.f;
#pragma unroll
        for (int j = 0; j < 4; ++j) { v[j] = nx[j]; ss += v[j][0] * v[j][0] + v[j][1] * v[j][1] + v[j][2] * v[j][2] + v[j][3] * v[j][3]; }
        if (r + 8 < row_hi) { const float* src = src_of(r + 8);
#pragma unroll
            for (int j = 0; j < 4; ++j) nx[j] = *(const f32x4*)(src + j * 256 + lane * 4); }
        ss = wave_sum64(ss);
        const float rinv = __builtin_amdgcn_rsqf(ss * (1.f / D) + NORM_EPS);
#pragma unroll
        for (int j = 0; j < 4; ++j) { const int c = j * 256 + lane * 4; float o[4];
#pragma unroll
            for (int q = 0; q < 4; ++q) o[q] = (v[j][q] * rinv * gp[4 * j + q]) * (1.f + sm[D + c + q]) + sm[c + q];
            if constexpr (OUT8) *(unsigned*)((unsigned char*)xn + (size_t)r * D + c) = pack4_fp8(o[0] * 16.f, o[1] * 16.f, o[2] * 16.f, o[3] * 16.f);
            else { u32x2 w; w.x = cvt_pk_bf16(o[0], o[1]); w.y = cvt_pk_bf16(o[2], o[3]); *(u32x2*)(xn + (size_t)r * D + c) = w; } }
    }
}
}

namespace mk {
#define XB_TMO      128
#define XB_XCNT(j)  (256  + 64 * (j))
#define XB_XSUB(j)  (1280 + 64 * (j))
#define XB_XGEN(j)  (2304 + 64 * (j))
#define XB_TOP      3328
#define XB_TOPGEN   3392
#define XCD_BAR_WORDS 3456
#define XB_SPIN_CAP (1u << 18)
__device__ __forceinline__ unsigned xb_ld(unsigned* p)              { return __hip_atomic_load(p, __ATOMIC_RELAXED, __HIP_MEMORY_SCOPE_AGENT); }
__device__ __forceinline__ unsigned xb_add(unsigned* p, unsigned v) { return __hip_atomic_fetch_add(p, v, __ATOMIC_RELAXED, __HIP_MEMORY_SCOPE_AGENT); }
__device__ __forceinline__ unsigned xb_xcc_id() { return (unsigned)__builtin_amdgcn_s_getreg((3 << 11) | 20) & 0xFu; }
#define XB_SPIN(cond, bar) do { unsigned _sp = 0; while (cond) { __builtin_amdgcn_s_sleep(1); \
    if ((++_sp & 255u) == 0u) { if (xb_ld(&(bar)[XB_TMO])) break; if (_sp > XB_SPIN_CAP) { atomicAdd(&(bar)[XB_TMO], 1u); break; } } } } while (0)
struct XcdBarrier { unsigned* bar; unsigned x; volatile LAS unsigned* st; };
__device__ __forceinline__ XcdBarrier xcd_barrier_post(unsigned* bar, volatile LAS unsigned* st) {
    XcdBarrier b; b.bar = bar; b.x = xb_xcc_id(); b.st = st;
    if (threadIdx.x == 0) (void)xb_add(&bar[XB_XCNT(b.x)], 1u);
    return b;
}
__device__ __forceinline__ void xcd_barrier_complete(unsigned* bar, unsigned x, unsigned& nloc, unsigned& nx) {
    const unsigned G = gridDim.x * gridDim.y * gridDim.z;
    unsigned sum, cnt, mine, sp = 0u;
    for (;;) {
        sum = 0u; cnt = 0u; mine = 0u;
#pragma unroll
        for (unsigned j = 0; j < 16; ++j) { const unsigned c = xb_ld(&bar[XB_XCNT(j)]); sum += c; cnt += (c > 0u) ? 1u : 0u; mine = (j == x) ? c : mine; }
        if (sum == G) break;
        __builtin_amdgcn_s_sleep(1);
        if ((++sp & 255u) == 0u) { if (xb_ld(&bar[XB_TMO])) break; if (sp > XB_SPIN_CAP) { atomicAdd(&bar[XB_TMO], 1u); break; } }
    }
    nloc = mine > 0u ? mine : 1u; nx = cnt > 0u ? cnt : 1u;
}
__device__ __forceinline__ void xcd_barrier(const XcdBarrier& b) {
    asm volatile("s_waitcnt vmcnt(0)" ::: "memory");
    __syncthreads();
    if (threadIdx.x == 0) {
        unsigned* bar = b.bar;
        __builtin_amdgcn_s_waitcnt(0);
        unsigned nloc = b.st[0], nx = b.st[1];
        if (nloc == 0u) { xcd_barrier_complete(bar, b.x, nloc, nx); b.st[0] = nloc; b.st[1] = nx; }
        const unsigned old = xb_add(&bar[XB_XSUB(b.x)], 1u);
        const unsigned gen = old / nloc;
        if (old + 1u == (gen + 1u) * nloc) {
            __builtin_amdgcn_fence(__ATOMIC_RELEASE, "agent");
            asm volatile("s_waitcnt vmcnt(0)" ::: "memory");
            const unsigned og = xb_add(&bar[XB_TOP], 1u);
            const unsigned tg = og / nx;
            if (og + 1u == (tg + 1u) * nx) xb_add(&bar[XB_TOPGEN], 1u);
            else XB_SPIN(xb_ld(&bar[XB_TOPGEN]) == tg, bar);
            __builtin_amdgcn_fence(__ATOMIC_ACQUIRE, "agent");
            xb_add(&bar[XB_XGEN(b.x)], 1u);
            asm volatile("s_waitcnt vmcnt(0)" ::: "memory");
        } else {
            XB_SPIN(xb_ld(&bar[XB_XGEN(b.x)]) == gen, bar);
            __builtin_amdgcn_fence(__ATOMIC_ACQUIRE, "agent");
            asm volatile("s_waitcnt vmcnt(0)" ::: "memory");
        }
    }
    __syncthreads();
}
}

namespace mk {
constexpr int TB = 32;
constexpr int RAWW = 320;
constexpr int RW_RAW = 0;
constexpr int RW_MU = RW_RAW + (TB + 2) * RAWW * 2;
constexpr int RW_WUP = RW_MU + 2 * RAWW * 4;
constexpr int RW_AUP = RW_WUP + 64 * 72 * 2;
constexpr int RW_CST = RW_AUP + 64 * 72 * 2;
constexpr int RW_AWD = RW_CST + 5 * 64 * 4;
constexpr int RW_AAD = RW_AWD + TB * 72 * 2;
constexpr int RW_R = RW_AAD + TB * 72 * 2;
constexpr int RW_KR = RW_R + TB * 64 * 4;
constexpr int RW_LA = RW_KR + TB * 64 * 4;
constexpr int RW_KK = RW_LA + TB * 64 * 4;
constexpr int RW_W = RW_KK + TB * 64 * 4;
constexpr int RW_B = RW_W + TB * 64 * 4;
constexpr int RW_KD = RW_B + TB * 64 * 4;
constexpr int RW_WR = RW_KD + TB * 64 * 4;
constexpr int RW_V = RW_WR + TB * 64 * 4;
constexpr int RW_SC = RW_V + TB * 64 * 4;
constexpr int RW_YO = RW_SC + TB * 2 * 4;
constexpr int RW_BON = RW_YO + TB * 64 * 4;
constexpr int RW_END = RW_BON + TB * 4;
static_assert(RW_END <= LDS_BYTES, "rwkv LDS");

#define MK_DPP(x, ctrl) __int_as_float(__builtin_amdgcn_update_dpp(__float_as_int(x), __float_as_int(x), ctrl, 0xF, 0xF, false))
__device__ __forceinline__ float allreduce16(float x) {
    x += MK_DPP(x, 0xB1); x += MK_DPP(x, 0x4E); x += MK_DPP(x, 0x141); x += MK_DPP(x, 0x140); return x;
}

__device__ __forceinline__ void allreduce16x4(float& a, float& b, float& c, float& d) {
    asm volatile("s_nop 1\n\t"
        "v_add_f32_dpp %0, %0, %0 quad_perm:[1,0,3,2] row_mask:0xf bank_mask:0xf\n\t" "v_add_f32_dpp %1, %1, %1 quad_perm:[1,0,3,2] row_mask:0xf bank_mask:0xf\n\t"
        "v_add_f32_dpp %2, %2, %2 quad_perm:[1,0,3,2] row_mask:0xf bank_mask:0xf\n\t" "v_add_f32_dpp %3, %3, %3 quad_perm:[1,0,3,2] row_mask:0xf bank_mask:0xf\n\t"
        "v_add_f32_dpp %0, %0, %0 quad_perm:[2,3,0,1] row_mask:0xf bank_mask:0xf\n\t" "v_add_f32_dpp %1, %1, %1 quad_perm:[2,3,0,1] row_mask:0xf bank_mask:0xf\n\t"
        "v_add_f32_dpp %2, %2, %2 quad_perm:[2,3,0,1] row_mask:0xf bank_mask:0xf\n\t" "v_add_f32_dpp %3, %3, %3 quad_perm:[2,3,0,1] row_mask:0xf bank_mask:0xf\n\t"
        "v_add_f32_dpp %0, %0, %0 row_half_mirror row_mask:0xf bank_mask:0xf\n\t" "v_add_f32_dpp %1, %1, %1 row_half_mirror row_mask:0xf bank_mask:0xf\n\t"
        "v_add_f32_dpp %2, %2, %2 row_half_mirror row_mask:0xf bank_mask:0xf\n\t" "v_add_f32_dpp %3, %3, %3 row_half_mirror row_mask:0xf bank_mask:0xf\n\t"
        "v_add_f32_dpp %0, %0, %0 row_mirror row_mask:0xf bank_mask:0xf\n\t" "v_add_f32_dpp %1, %1, %1 row_mirror row_mask:0xf bank_mask:0xf\n\t"
        "v_add_f32_dpp %2, %2, %2 row_mirror row_mask:0xf bank_mask:0xf\n\t" "v_add_f32_dpp %3, %3, %3 row_mirror row_mask:0xf bank_mask:0xf"
        : "+v"(a), "+v"(b), "+v"(c), "+v"(d));
}
struct RwkvP { const bf16_t* z1; bf16_t* Y; float* bon; int b0, nb; };

constexpr int RW_NPIECE = (TB + 2) * 40, RW_PPT = (RW_NPIECE + NT - 1) / NT;

__device__ __forceinline__ void rwkv_chain(LAS unsigned char* lds, const In& in, const RwkvP p, int chain) {
    const int tid = threadIdx.x, lane = tid & 63, wid = tid >> 6;
    const int d = chain / (p.nb * NH), bl = (chain / NH) % p.nb, h = chain % NH;
    const int nlat = p.nb * SEQ;
    LAS bf16_t* RAW = (LAS bf16_t*)(lds + RW_RAW); LAS float* MU = (LAS float*)(lds + RW_MU);
    LAS bf16_t* WUP = (LAS bf16_t*)(lds + RW_WUP); LAS bf16_t* AUP = (LAS bf16_t*)(lds + RW_AUP); LAS float* CST = (LAS float*)(lds + RW_CST);
    LAS bf16_t* AWD = (LAS bf16_t*)(lds + RW_AWD); LAS bf16_t* AAD = (LAS bf16_t*)(lds + RW_AAD);
    LAS float *Rr = (LAS float*)(lds + RW_R), *KR = (LAS float*)(lds + RW_KR), *LA_ = (LAS float*)(lds + RW_LA);
    LAS float *KK = (LAS float*)(lds + RW_KK), *Wv = (LAS float*)(lds + RW_W), *Bv = (LAS float*)(lds + RW_B), *KD = (LAS float*)(lds + RW_KD), *WR = (LAS float*)(lds + RW_WR), *Vv = (LAS float*)(lds + RW_V);
    LAS float *SC = (LAS float*)(lds + RW_SC), *YO = (LAS float*)(lds + RW_YO), *BON = (LAS float*)(lds + RW_BON);
    auto segcol = [&](int s) { return s < 3 ? s * RW + h * 64 : (s == 3 ? OFF_WD + d * DL : OFF_AD + d * AL); };
    for (int i = tid; i < 2 * RAWW; i += NT) { const int m = i / RAWW, c = i % RAWW; MU[i] = in.shift_mu[m * RC + segcol(c >> 6) + (c & 63)]; }
    for (int i = tid; i < 64 * 64; i += NT) { const int j = i >> 6, c = i & 63;
        WUP[c * 72 + j] = f2bf(in.rw_w_up[((size_t)d * DL + j) * RW + h * 64 + c]); AUP[c * 72 + j] = f2bf(in.rw_a_up[((size_t)d * AL + j) * RW + h * 64 + c]); }
    for (int i = tid; i < 64; i += NT) { CST[i] = in.rw_w0[d * RW + h * 64 + i]; CST[64 + i] = in.rw_a0[d * RW + h * 64 + i]; CST[128 + i] = in.rw_k_k[h * 64 + i]; CST[192 + i] = in.rw_k_a[h * 64 + i]; CST[256 + i] = in.rw_r_k[h * 64 + i]; }
    constexpr int NQ = (CTX + SEQ) / TB, NQC = CTX / TB;
    auto blk_info = [&](int q, bool& isctx, int& t0, bool& hp, bool& hn, size_t& grow0) {
        isctx = q < NQC;
        if (isctx) { const int qq = d == 0 ? q : NQC - 1 - q; t0 = qq * TB; hp = t0 > 0; hn = t0 + TB < CTX; grow0 = (size_t)nlat + (size_t)bl * CTX + t0; }
        else { const int ql = q - NQC, qq = d == 0 ? ql : SEQ / TB - 1 - ql; t0 = qq * TB; hp = (t0 % GW) != 0; hn = ((t0 + TB) % GW) != 0; grow0 = (size_t)bl * SEQ + t0; }
    };
    u32x4 pre[RW_PPT];
    auto prefetch = [&](int q) {
        bool isctx, hp, hn; int t0; size_t grow0; blk_info(q, isctx, t0, hp, hn, grow0);
#pragma unroll
        for (int k = 0; k < RW_PPT; ++k) { const int i = tid + k * NT; u32x4 v = (u32x4){0u, 0u, 0u, 0u};
            if (i < RW_NPIECE) { const int rr = i / 40, sp = i % 40, seg = sp >> 3, part = sp & 7;
                const bool ok = (rr == 0) ? hp : ((rr == TB + 1) ? hn : true);
                if (ok) v = *(const u32x4*)(p.z1 + (grow0 + rr - 1) * Z1_N + segcol(seg) + part * 8); }
            pre[k] = v; }
    };
    auto commit = [&]() {
#pragma unroll
        for (int k = 0; k < RW_PPT; ++k) { const int i = tid + k * NT; if (i < RW_NPIECE) { const int rr = i / 40, sp = i % 40; *(LAS u32x4*)(RAW + rr * RAWW + sp * 8) = pre[k]; } }
    };
    float S[2][4];
#pragma unroll
    for (int i = 0; i < 2; ++i)
#pragma unroll
        for (int j = 0; j < 4; ++j) S[i][j] = 0.f;
    const int kg = lane & 15, rp = (lane >> 4) + 4 * wid;
    prefetch(0);
    for (int q = 0; q < NQ; ++q) {
        bool isctx, hp, hn; int t0; size_t grow0; blk_info(q, isctx, t0, hp, hn, grow0);
        commit();
        __syncthreads();
        if (q + 1 < NQ) prefetch(q + 1);
        auto shift8 = [&](int t, int c0, float (&s)[8]) {
            const u32x4 xp = *(const LAS u32x4*)(RAW + t * RAWW + c0), xc = *(const LAS u32x4*)(RAW + (t + 1) * RAWW + c0), xn_ = *(const LAS u32x4*)(RAW + (t + 2) * RAWW + c0);
            const f32x4 m0a = *(const LAS f32x4*)(MU + c0), m0b = *(const LAS f32x4*)(MU + c0 + 4), m1a = *(const LAS f32x4*)(MU + RAWW + c0), m1b = *(const LAS f32x4*)(MU + RAWW + c0 + 4);
#pragma unroll
            for (int j = 0; j < 4; ++j) { const unsigned a = xp[j], b = xc[j], c = xn_[j];
                const float mu0l = j < 2 ? m0a[2 * j] : m0b[2 * j - 4], mu0h = j < 2 ? m0a[2 * j + 1] : m0b[2 * j - 3], mu1l = j < 2 ? m1a[2 * j] : m1b[2 * j - 4], mu1h = j < 2 ? m1a[2 * j + 1] : m1b[2 * j - 3];
                { const float x = bflo(b); s[2 * j] = x + mu0l * (bflo(a) - x) + mu1l * (bflo(c) - x); }
                { const float x = bfhi(b); s[2 * j + 1] = x + mu0h * (bfhi(a) - x) + mu1h * (bfhi(c) - x); } } };
        for (int it = tid; it < TB * 24; it += NT) {
            const int t = it / 24, g = it % 24, seg = g >> 3, cc = (g & 7) * 8; float s[8]; shift8(t, g * 8, s);
            LAS float* dst = (seg == 0 ? Rr : (seg == 1 ? KR : Vv)) + t * 64 + cc; *(LAS f32x4*)dst = (f32x4){s[0], s[1], s[2], s[3]}; *(LAS f32x4*)(dst + 4) = (f32x4){s[4], s[5], s[6], s[7]};
        }
        { const int t = tid >> 4, g = 24 + (tid & 15), cc = (g & 7) * 8; float s[8]; shift8(t, g * 8, s);
          const bool isw = (tid & 15) < 8;
#pragma unroll
          for (int j = 0; j < 8; ++j) { const float th = fast_tanh(s[j]); s[j] = isw ? th : s[j]; }
          LAS bf16_t* dst = (isw ? AWD : AAD) + t * 72 + cc;
          u32x4 w; w.x = cvt_pk_bf16(s[0], s[1]); w.y = cvt_pk_bf16(s[2], s[3]); w.z = cvt_pk_bf16(s[4], s[5]); w.w = cvt_pk_bf16(s[6], s[7]); *(LAS u32x4*)dst = w; }
        __syncthreads();
        {
            const int lora = wid >> 2, ct = wid & 3, fr = lane & 15, fq = lane >> 4;
            const LAS bf16_t* Am = lora ? AAD : AWD; const LAS bf16_t* Bm = lora ? AUP : WUP;
#pragma unroll
            for (int rt = 0; rt < 2; ++rt) {
                f32x4 acc = (f32x4){0.f, 0.f, 0.f, 0.f};
#pragma unroll
                for (int ks = 0; ks < 2; ++ks) {
                    const bf16x8 a = *(const LAS bf16x8*)(Am + (rt * 16 + fr) * 72 + ks * 32 + fq * 8);
                    const bf16x8 b = *(const LAS bf16x8*)(Bm + (ct * 16 + fr) * 72 + ks * 32 + fq * 8);
                    acc = __builtin_amdgcn_mfma_f32_16x16x32_bf16(a, b, acc, 0, 0, 0);
                }
                const int col = ct * 16 + fr;
#pragma unroll
                for (int i = 0; i < 4; ++i) { const int t = rt * 16 + fq * 4 + i;
                    if (lora == 0) { const float lw = acc[i] + CST[col]; const float wl = -fast_softplus(-lw) - 0.5f; Wv[t * 64 + col] = __expf(-__expf(wl)); }
                    else { LA_[t * 64 + col] = fast_sigmoid(acc[i] + CST[64 + col]); } }
            }
        }
        __syncthreads();
        {
            const int t = tid >> 4, c4 = (tid & 15) * 4;
            const f32x4 k = *(const LAS f32x4*)(KR + t * 64 + c4), a = *(const LAS f32x4*)(LA_ + t * 64 + c4), w = *(const LAS f32x4*)(Wv + t * 64 + c4), r = *(const LAS f32x4*)(Rr + t * 64 + c4);
            f32x4 kkr, kd, bb, wr; float ss = 0.f, br = 0.f, kr = 0.f, bn = 0.f;
#pragma unroll
            for (int j = 0; j < 4; ++j) { kkr[j] = k[j] * CST[128 + c4 + j]; ss += kkr[j] * kkr[j]; }
            ss = allreduce16(ss);
            const float inv = 1.f / fmaxf(sqrtf(ss), 1e-12f);
#pragma unroll
            for (int j = 0; j < 4; ++j) { const float kk = kkr[j] * inv; kkr[j] = kk; kd[j] = k[j] * (1.f + (a[j] - 1.f) * CST[192 + c4 + j]); bb[j] = kk * a[j]; wr[j] = w[j] * r[j];
                br += bb[j] * r[j]; kr += kd[j] * r[j]; bn += r[j] * kd[j] * CST[256 + c4 + j]; }
            br = allreduce16(br); kr = allreduce16(kr); bn = allreduce16(bn);
            *(LAS f32x4*)(KK + t * 64 + c4) = kkr; *(LAS f32x4*)(KD + t * 64 + c4) = kd; *(LAS f32x4*)(Bv + t * 64 + c4) = bb; *(LAS f32x4*)(WR + t * 64 + c4) = wr;
            if ((tid & 15) == 0) { SC[t * 2] = br; SC[t * 2 + 1] = kr; BON[t] = bn; }
        }
        __syncthreads();
        {
            auto tof = [&](int st) { return d == 0 ? st : TB - 1 - st; };
            const LAS float* lb = KK + 4 * kg;
            const LAS float* vb = Vv + 2 * rp;
            constexpr int OW = (RW_W - RW_KK) / 4, OB = (RW_B - RW_KK) / 4, OKD = (RW_KD - RW_KK) / 4, OWR = (RW_WR - RW_KK) / 4;
            int t = tof(0);
            f32x4 kk4 = *(const LAS f32x4*)(lb + t * 64), w4 = *(const LAS f32x4*)(lb + t * 64 + OW), b4 = *(const LAS f32x4*)(lb + t * 64 + OB),
                  kd4 = *(const LAS f32x4*)(lb + t * 64 + OKD), wr4 = *(const LAS f32x4*)(lb + t * 64 + OWR);
            f32x2 vv = *(const LAS f32x2*)(vb + t * 64), sc = *(const LAS f32x2*)(SC + t * 2);
            f32x2 S2[4];
#pragma unroll
            for (int j = 0; j < 4; ++j) { S2[j][0] = S[0][j]; S2[j][1] = S[1][j]; }
#pragma unroll 2
            for (int st = 0; st < TB; ++st) {
                const int tn = tof(st + 1 < TB ? st + 1 : st);
                const f32x4 nkk4 = *(const LAS f32x4*)(lb + tn * 64), nw4 = *(const LAS f32x4*)(lb + tn * 64 + OW), nb4 = *(const LAS f32x4*)(lb + tn * 64 + OB),
                            nkd4 = *(const LAS f32x4*)(lb + tn * 64 + OKD), nwr4 = *(const LAS f32x4*)(lb + tn * 64 + OWR);
                const f32x2 nvv = *(const LAS f32x2*)(vb + tn * 64), nsc = *(const LAS f32x2*)(SC + tn * 2);
                f32x2 sa2 = S2[0] * kk4[0], yo2 = S2[0] * wr4[0];
#pragma unroll
                for (int j = 1; j < 4; ++j) { sa2 += S2[j] * kk4[j]; yo2 += S2[j] * wr4[j]; }
                float sa0 = sa2[0], sa1 = sa2[1], yo0 = yo2[0], yo1 = yo2[1];
                allreduce16x4(sa0, sa1, yo0, yo1);
                f32x2 sar; sar[0] = sa0; sar[1] = sa1;
#pragma unroll
                for (int j = 0; j < 4; ++j) S2[j] = S2[j] * w4[j] + (vv * kd4[j] - sar * b4[j]);
                if (kg == 0) { f32x2 yor; yor[0] = yo0; yor[1] = yo1; const f32x2 y = yor - sar * sc[0] + vv * sc[1]; *(LAS f32x2*)(YO + t * 64 + 2 * rp) = y; }
                kk4 = nkk4; w4 = nw4; b4 = nb4; kd4 = nkd4; wr4 = nwr4; vv = nvv; sc = nsc; t = tn;
            }
#pragma unroll
            for (int j = 0; j < 4; ++j) { S[0][j] = S2[j][0]; S[1][j] = S2[j][1]; }
        }
        __syncthreads();
        if (!isctx) {
            const int t = tid >> 4, c4 = (tid & 15) * 4; const f32x4 y = *(const LAS f32x4*)(YO + t * 64 + c4);
            u32x2 w; w.x = cvt_pk_bf16(y[0], y[1]); w.y = cvt_pk_bf16(y[2], y[3]);
            *(u32x2*)(p.Y + ((size_t)d * nlat + grow0 + t) * RW + h * 64 + c4) = w;
            if (tid < TB) p.bon[((size_t)d * nlat + grow0 + tid) * NH + h] = BON[tid];
        }
    }
}
__device__ __forceinline__ void rwkv_phase(LAS unsigned char* lds, const In& in, const RwkvP p, int bid, int nblk) {
    const int nchain = 2 * p.nb * NH;
    for (int c = bid; c < nchain; c += nblk) { rwkv_chain(lds, in, p, c); __syncthreads(); }
}
}

namespace mk {
constexpr int C2_RAW = 0;
constexpr int C2_MU = C2_RAW + (TB + 2) * RAWW * 2;
constexpr int C2_WUP = C2_MU + 2 * RAWW * 4;
constexpr int C2_AUP = C2_WUP + 64 * 72 * 2;
constexpr int C2_CST = C2_AUP + 64 * 72 * 2;
constexpr int C2_AWD = C2_CST + 5 * 64 * 4;
constexpr int C2_AAD = C2_AWD + TB * 72 * 2;
constexpr int C2_X = C2_AAD + TB * 72 * 2;
constexpr int C2_R = C2_X, C2_KR = C2_R + TB * 64 * 4, C2_V = C2_KR + TB * 64 * 4, C2_E = C2_V + TB * 64 * 4, C2_LA = C2_E + TB * 64 * 4, C2_CUM = C2_LA + TB * 64 * 4, C2_X_END = C2_CUM + TB * 64 * 4;
constexpr int C2_YO = C2_X;
constexpr int C2_G = C2_YO + TB * 64 * 4;
constexpr int C2_UB = C2_G + 64 * 36 * 4;
constexpr int C2_ABT = C2_UB + 64 * 40 * 2;
constexpr int C2_AKT = C2_ABT + 32 * 32 * 4;
constexpr int C2_NBT = C2_AKT + 32 * 40 * 2;
constexpr int C2_NKT = C2_NBT + 32 * 40 * 2;
static_assert(C2_NKT + 32 * 40 * 2 <= C2_X_END, "region X reuse");
constexpr int C2_KKS = C2_X_END;
constexpr int C2_BS = C2_KKS + TB * 72 * 2, C2_KDS = C2_BS + TB * 72 * 2, C2_RS = C2_KDS + TB * 72 * 2;
constexpr int C2_BST = C2_RS + TB * 72 * 2;
constexpr int C2_KDST = C2_BST + 64 * 40 * 2;
constexpr int C2_VT = C2_KDST + 64 * 40 * 2;
constexpr int C2_S0B = C2_VT + 64 * 40 * 2;
constexpr int C2_GC = C2_S0B + 64 * 72 * 2;
constexpr int C2_BON = C2_GC + 64 * 4;
constexpr int C2_END = C2_BON + TB * 4;
static_assert(C2_END <= LDS_BYTES - 16 && (C2_X % 16) == 0 && (C2_KKS % 16) == 0 && (C2_G % 16) == 0 && (C2_UB % 16) == 0 && (C2_ABT % 16) == 0 && (C2_AKT % 16) == 0 && (C2_S0B % 16) == 0, "rwkv2 LDS");

__device__ __forceinline__ bf16x8 ldsb8(const LAS bf16_t* p) { return *(const LAS bf16x8*)p; }

template <int MODE>
__device__ __forceinline__ void rwkv_chain2(LAS unsigned char* lds, const In& in, const RwkvP p, int chain) {
    const int tid = threadIdx.x, lane = tid & 63, wid = tid >> 6, fr = lane & 15, fq = lane >> 4;
    const int d = chain / (p.nb * NH), bl = (chain / NH) % p.nb, h = chain % NH;
    const int nlat = p.nb * SEQ;
    LAS bf16_t* RAW = (LAS bf16_t*)(lds + C2_RAW); LAS float* MU = (LAS float*)(lds + C2_MU);
    LAS bf16_t* WUP = (LAS bf16_t*)(lds + C2_WUP); LAS bf16_t* AUP = (LAS bf16_t*)(lds + C2_AUP); LAS float* CST = (LAS float*)(lds + C2_CST);
    LAS bf16_t* AWD = (LAS bf16_t*)(lds + C2_AWD); LAS bf16_t* AAD = (LAS bf16_t*)(lds + C2_AAD);
    LAS float *Rr = (LAS float*)(lds + C2_R), *KR = (LAS float*)(lds + C2_KR), *Vv = (LAS float*)(lds + C2_V), *Ee = (LAS float*)(lds + C2_E), *LA_ = (LAS float*)(lds + C2_LA), *CUM = (LAS float*)(lds + C2_CUM);
    LAS float *YO = (LAS float*)(lds + C2_YO), *Gm = (LAS float*)(lds + C2_G), *ABT = (LAS float*)(lds + C2_ABT), *GC = (LAS float*)(lds + C2_GC), *BON = (LAS float*)(lds + C2_BON);
    LAS bf16_t *UB = (LAS bf16_t*)(lds + C2_UB), *AKT = (LAS bf16_t*)(lds + C2_AKT), *NBT = (LAS bf16_t*)(lds + C2_NBT), *NKT = (LAS bf16_t*)(lds + C2_NKT);
    LAS bf16_t *KKS = (LAS bf16_t*)(lds + C2_KKS), *BS = (LAS bf16_t*)(lds + C2_BS), *KDS = (LAS bf16_t*)(lds + C2_KDS), *RS = (LAS bf16_t*)(lds + C2_RS);
    LAS bf16_t *BST = (LAS bf16_t*)(lds + C2_BST), *KDST = (LAS bf16_t*)(lds + C2_KDST), *VT = (LAS bf16_t*)(lds + C2_VT), *S0B = (LAS bf16_t*)(lds + C2_S0B);
    auto segcol = [&](int s) { return s < 3 ? s * RW + h * 64 : (s == 3 ? OFF_WD + d * DL : OFF_AD + d * AL); };
    for (int i = tid; i < 2 * RAWW; i += NT) { const int m = i / RAWW, c = i % RAWW; MU[i] = in.shift_mu[m * RC + segcol(c >> 6) + (c & 63)]; }
    for (int i = tid; i < 64 * 64; i += NT) { const int j = i >> 6, c = i & 63;
        WUP[c * 72 + j] = f2bf(in.rw_w_up[((size_t)d * DL + j) * RW + h * 64 + c]); AUP[c * 72 + j] = f2bf(in.rw_a_up[((size_t)d * AL + j) * RW + h * 64 + c]); }
    for (int i = tid; i < 64; i += NT) { CST[i] = in.rw_w0[d * RW + h * 64 + i]; CST[64 + i] = in.rw_a0[d * RW + h * 64 + i]; CST[128 + i] = in.rw_k_k[h * 64 + i]; CST[192 + i] = in.rw_k_a[h * 64 + i]; CST[256 + i] = in.rw_r_k[h * 64 + i]; }
    for (int i = tid; i < 64 * 72 / 2; i += NT) ((LAS unsigned*)S0B)[i] = 0u;
    constexpr int NQ = (CTX + SEQ) / TB, NQC = CTX / TB;
    auto blk_info = [&](int q, bool& isctx, int& t0, bool& hp, bool& hn, size_t& grow0) {
        isctx = q < NQC;
        if (isctx) { const int qq = d == 0 ? q : NQC - 1 - q; t0 = qq * TB; hp = t0 > 0; hn = t0 + TB < CTX; grow0 = (size_t)nlat + (size_t)bl * CTX + t0; }
        else { const int ql = q - NQC, qq = d == 0 ? ql : SEQ / TB - 1 - ql; t0 = qq * TB; hp = (t0 % GW) != 0; hn = ((t0 + TB) % GW) != 0; grow0 = (size_t)bl * SEQ + t0; }
    };
    u32x4 pre[RW_PPT]; int poff[RW_PPT], plds[RW_PPT], pkind[RW_PPT];
#pragma unroll
    for (int k = 0; k < RW_PPT; ++k) { const int i = tid + k * NT, rr = i / 40, sp = i % 40, seg = sp >> 3, part = sp & 7;
        poff[k] = (rr - 1) * Z1_N + segcol(seg) + part * 8; plds[k] = rr * RAWW + sp * 8; pkind[k] = i >= RW_NPIECE ? 3 : (rr == 0 ? 1 : (rr == TB + 1 ? 2 : 0)); }
    auto prefetch = [&](int q) {
        bool isctx, hp, hn; int t0; size_t grow0; blk_info(q, isctx, t0, hp, hn, grow0);
        const bf16_t* base = p.z1 + grow0 * Z1_N;
#pragma unroll
        for (int k = 0; k < RW_PPT; ++k) { u32x4 v = (u32x4){0u, 0u, 0u, 0u};
            const bool ok = pkind[k] == 0 || (pkind[k] == 1 && hp) || (pkind[k] == 2 && hn);
            if (ok) v = *(const u32x4*)(base + poff[k]);
            pre[k] = v; }
    };
    auto commit = [&]() {
#pragma unroll
        for (int k = 0; k < RW_PPT; ++k) if (pkind[k] != 3) *(LAS u32x4*)(RAW + plds[k]) = pre[k];
    };
    f32x4 Sreg[2];
    Sreg[0] = (f32x4){0.f, 0.f, 0.f, 0.f}; Sreg[1] = Sreg[0];
    const int rt = wid >> 1;
    prefetch(0);
    for (int q = 0; q < NQ; ++q) {
        bool isctx, hp, hn; int t0; size_t grow0; blk_info(q, isctx, t0, hp, hn, grow0);
        commit();
        __syncthreads();
        if (q + 1 < NQ) prefetch(q + 1);
        auto shift8 = [&](int t, int c0, float (&s)[8]) {
            const u32x4 xp = *(const LAS u32x4*)(RAW + t * RAWW + c0), xc = *(const LAS u32x4*)(RAW + (t + 1) * RAWW + c0), xn_ = *(const LAS u32x4*)(RAW + (t + 2) * RAWW + c0);
            const f32x4 m0a = *(const LAS f32x4*)(MU + c0), m0b = *(const LAS f32x4*)(MU + c0 + 4), m1a = *(const LAS f32x4*)(MU + RAWW + c0), m1b = *(const LAS f32x4*)(MU + RAWW + c0 + 4);
#pragma unroll
            for (int j = 0; j < 4; ++j) { const unsigned a = xp[j], b = xc[j], c = xn_[j];
                const float mu0l = j < 2 ? m0a[2 * j] : m0b[2 * j - 4], mu0h = j < 2 ? m0a[2 * j + 1] : m0b[2 * j - 3], mu1l = j < 2 ? m1a[2 * j] : m1b[2 * j - 4], mu1h = j < 2 ? m1a[2 * j + 1] : m1b[2 * j - 3];
                { const float x = bflo(b); s[2 * j] = x + mu0l * (bflo(a) - x) + mu1l * (bflo(c) - x); }
                { const float x = bfhi(b); s[2 * j + 1] = x + mu0h * (bfhi(a) - x) + mu1h * (bfhi(c) - x); } } };
        for (int it = tid; it < TB * 24; it += NT) {
            const int t = it / 24, g = it % 24, seg = g >> 3, cc = (g & 7) * 8, js = d == 0 ? t : TB - 1 - t; float s[8]; shift8(t, g * 8, s);
            LAS float* dst = (seg == 0 ? Rr : (seg == 1 ? KR : Vv)) + js * 64 + cc; *(LAS f32x4*)dst = (f32x4){s[0], s[1], s[2], s[3]}; *(LAS f32x4*)(dst + 4) = (f32x4){s[4], s[5], s[6], s[7]};
        }
        { const int t = tid >> 4, g = 24 + (tid & 15), cc = (g & 7) * 8, js = d == 0 ? t : TB - 1 - t; float s[8]; shift8(t, g * 8, s);
          const bool isw = (tid & 15) < 8;
#pragma unroll
          for (int j = 0; j < 8; ++j) { const float th = fast_tanh(s[j]); s[j] = isw ? th : s[j]; }
          LAS bf16_t* dst = (isw ? AWD : AAD) + js * 72 + cc;
          u32x4 w; w.x = cvt_pk_bf16(s[0], s[1]); w.y = cvt_pk_bf16(s[2], s[3]); w.z = cvt_pk_bf16(s[4], s[5]); w.w = cvt_pk_bf16(s[6], s[7]); *(LAS u32x4*)dst = w; }
        __syncthreads();
        if (MODE == 3) continue;
        {
            const int lora = wid >> 2, ct = wid & 3;
            const LAS bf16_t* Am = lora ? AAD : AWD; const LAS bf16_t* Bm = lora ? AUP : WUP;
            float carry = 0.f;
#pragma unroll
            for (int r2 = 0; r2 < 2; ++r2) {
                f32x4 acc = (f32x4){0.f, 0.f, 0.f, 0.f};
#pragma unroll
                for (int ks = 0; ks < 2; ++ks) acc = __builtin_amdgcn_mfma_f32_16x16x32_bf16(ldsb8(Am + (r2 * 16 + fr) * 72 + ks * 32 + fq * 8), ldsb8(Bm + (ct * 16 + fr) * 72 + ks * 32 + fq * 8), acc, 0, 0, 0);
                const int col = ct * 16 + fr;
                if (lora == 0) {
                    float c[4];
#pragma unroll
                    for (int i = 0; i < 4; ++i) { const float lw = acc[i] + CST[col]; const float e = __expf(-fast_softplus(-lw) - 0.5f); c[i] = i ? c[i - 1] + e : e; }
                    const float tot = c[3];
                    float s1 = tot; { const float y = __shfl_up(s1, 16); s1 += fq >= 1 ? y : 0.f; }
                    float s2 = s1;  { const float z = __shfl_up(s1, 32); s2 += fq >= 2 ? z : 0.f; }
                    const float base = carry + s2 - tot;
#pragma unroll
                    for (int i = 0; i < 4; ++i) CUM[(r2 * 16 + fq * 4 + i) * 64 + col] = base + c[i];
                    carry += __shfl(s2, 48 + fr);
                } else {
#pragma unroll
                    for (int i = 0; i < 4; ++i) LA_[(r2 * 16 + fq * 4 + i) * 64 + col] = fast_sigmoid(acc[i] + CST[64 + col]);
                }
            }
        }
        __syncthreads();
        if (MODE == 2) continue;
        {
            const int j = tid >> 4, c4 = (tid & 15) * 4;
            const f32x4 k = *(const LAS f32x4*)(KR + j * 64 + c4), a = *(const LAS f32x4*)(LA_ + j * 64 + c4), r = *(const LAS f32x4*)(Rr + j * 64 + c4), vv = *(const LAS f32x4*)(Vv + j * 64 + c4);
            const f32x4 cu = *(const LAS f32x4*)(CUM + j * 64 + c4); f32x4 cp = (f32x4){0.f, 0.f, 0.f, 0.f}; if (j > 0) cp = *(const LAS f32x4*)(CUM + (j - 1) * 64 + c4);
            float kkr[4], ss = 0.f, bn = 0.f;
#pragma unroll
            for (int x = 0; x < 4; ++x) { kkr[x] = k[x] * CST[128 + c4 + x]; ss += kkr[x] * kkr[x]; }
            ss = allreduce16(ss);
            const float inv = 1.f / fmaxf(sqrtf(ss), 1e-12f);
            float kks[4], bs[4], kds[4], rs[4];
#pragma unroll
            for (int x = 0; x < 4; ++x) { const float kk = kkr[x] * inv, kd = k[x] * (1.f + (a[x] - 1.f) * CST[192 + c4 + x]), bb = kk * a[x];
                const float g = __expf(-cu[x]), gp = __expf(-cp[x]), ig = __expf(cu[x]);
                kks[x] = kk * gp; bs[x] = bb * ig; kds[x] = kd * ig; rs[x] = r[x] * g; bn += r[x] * kd * CST[256 + c4 + x];
                if (j == TB - 1) GC[c4 + x] = g;
            }
#pragma unroll
            for (int x = 0; x < 4; x += 2) { const unsigned pb = cvt_pk_bf16(bs[x], bs[x + 1]), pk = cvt_pk_bf16(kds[x], kds[x + 1]), pv = cvt_pk_bf16(vv[x], vv[x + 1]);
                BST[(c4 + x) * 40 + j] = (bf16_t)pb; BST[(c4 + x + 1) * 40 + j] = (bf16_t)(pb >> 16); KDST[(c4 + x) * 40 + j] = (bf16_t)pk; KDST[(c4 + x + 1) * 40 + j] = (bf16_t)(pk >> 16);
                VT[(c4 + x) * 40 + j] = (bf16_t)pv; VT[(c4 + x + 1) * 40 + j] = (bf16_t)(pv >> 16); }
            bn = allreduce16(bn);
            u32x2 w; w.x = cvt_pk_bf16(kks[0], kks[1]); w.y = cvt_pk_bf16(kks[2], kks[3]); *(LAS u32x2*)(KKS + j * 72 + c4) = w;
            w.x = cvt_pk_bf16(bs[0], bs[1]); w.y = cvt_pk_bf16(bs[2], bs[3]); *(LAS u32x2*)(BS + j * 72 + c4) = w;
            w.x = cvt_pk_bf16(kds[0], kds[1]); w.y = cvt_pk_bf16(kds[2], kds[3]); *(LAS u32x2*)(KDS + j * 72 + c4) = w;
            w.x = cvt_pk_bf16(rs[0], rs[1]); w.y = cvt_pk_bf16(rs[2], rs[3]); *(LAS u32x2*)(RS + j * 72 + c4) = w;
            if ((tid & 15) == 0) BON[j] = bn;
        }
        __syncthreads();
        if (MODE == 1) continue;
        const int ctg = wid & 1;
        f32x4 accG = (f32x4){0.f, 0.f, 0.f, 0.f}, accY = accG;
        {
            const int pr = wid >> 1, rts = wid & 1;
            const LAS bf16_t* Xm = (pr & 1) ? KDS : BS; const LAS bf16_t* Ym = (pr < 2) ? KKS : RS;
            const bf16x8 a0 = ldsb8(Xm + (rts * 16 + fr) * 72 + fq * 8), a1 = ldsb8(Xm + (rts * 16 + fr) * 72 + 32 + fq * 8);
#pragma unroll
            for (int cts = 0; cts < 2; ++cts) {
                f32x4 acc = (f32x4){0.f, 0.f, 0.f, 0.f};
                acc = __builtin_amdgcn_mfma_f32_16x16x32_bf16(a0, ldsb8(Ym + (cts * 16 + fr) * 72 + fq * 8), acc, 0, 0, 0);
                acc = __builtin_amdgcn_mfma_f32_16x16x32_bf16(a1, ldsb8(Ym + (cts * 16 + fr) * 72 + 32 + fq * 8), acc, 0, 0, 0);
                const int t = cts * 16 + fr, s0 = rts * 16 + fq * 4;
#pragma unroll
                for (int i = 0; i < 4; ++i) { const bool keep = (pr < 2) ? (s0 + i < t) : (s0 + i <= t); acc[i] = keep ? acc[i] : 0.f; }
                if (pr == 0) *(LAS f32x4*)(ABT + t * 32 + s0) = acc;
                else { u32x2 w; w.x = cvt_pk_bf16(acc[0], acc[1]); w.y = cvt_pk_bf16(acc[2], acc[3]); *(LAS u32x2*)((pr == 1 ? AKT : (pr == 2 ? NBT : NKT)) + t * 40 + s0) = w; }
            }
#pragma unroll
            for (int ks = 0; ks < 2; ++ks) { const bf16x8 sa = ldsb8(S0B + (rt * 16 + fr) * 72 + ks * 32 + fq * 8);
                accG = __builtin_amdgcn_mfma_f32_16x16x32_bf16(sa, ldsb8(KKS + (ctg * 16 + fr) * 72 + ks * 32 + fq * 8), accG, 0, 0, 0);
                accY = __builtin_amdgcn_mfma_f32_16x16x32_bf16(sa, ldsb8(RS + (ctg * 16 + fr) * 72 + ks * 32 + fq * 8), accY, 0, 0, 0); }
        }
        __syncthreads();
        {
            const bf16x8 va = ldsb8(VT + (rt * 16 + fr) * 40 + fq * 8);
            accG = __builtin_amdgcn_mfma_f32_16x16x32_bf16(va, ldsb8(AKT + (ctg * 16 + fr) * 40 + fq * 8), accG, 0, 0, 0);
            accY = __builtin_amdgcn_mfma_f32_16x16x32_bf16(va, ldsb8(NKT + (ctg * 16 + fr) * 40 + fq * 8), accY, 0, 0, 0);
#pragma unroll
            for (int i = 0; i < 4; ++i) Gm[(rt * 16 + fq * 4 + i) * 36 + ctg * 16 + fr] = -accG[i];
        }
        __syncthreads();
        if (MODE == 4) continue;
        if (wid < 4) {
            const int v = wid * 16 + (lane >> 2), pq = lane & 3;
            const LAS float* grow = Gm + v * 36;
            f32x4 r0 = *(const LAS f32x4*)(grow + 4 * pq), r1 = *(const LAS f32x4*)(grow + 16 + 4 * pq);
            u32x2 ubo[TB / 4];
            const LAS float* abd = ABT; asm volatile("" : "+v"(abd));
            const LAS float* abq = ABT + 128 * pq; asm volatile("" : "+v"(abq));
            f32x4 dc[3], a0c[4], a1c[4];
            auto ldg = [&](int g, f32x4 (&dd)[3], f32x4 (&aa0)[4], f32x4 (&aa1)[4]) {
#pragma unroll
                for (int x = 0; x < 3; ++x) dd[x] = *(const LAS f32x4*)(abd + (4 * g + 1 + x) * 32 + 4 * g);
#pragma unroll
                for (int jj = 0; jj < 4; ++jj) { if (g < 3) aa0[jj] = *(const LAS f32x4*)(abq + jj * 32 + 4 * g); if (g < 7) aa1[jj] = *(const LAS f32x4*)(abq + (16 + jj) * 32 + 4 * g); } };
            ldg(0, dc, a0c, a1c);
#pragma unroll
            for (int g = 0; g < TB / 4; ++g) {
                f32x4 dn[3], a0n[4], a1n[4];
                if (g + 1 < TB / 4) ldg(g + 1, dn, a0n, a1n);
                __builtin_amdgcn_sched_barrier(0);
                const f32x4 rr = g < 4 ? r0 : r1;
                f32x4 u4;
                u4[0] = rr[0];
                u4[1] = rr[1] - u4[0] * dc[0][0];
                u4[2] = rr[2] - (u4[0] * dc[1][0] + u4[1] * dc[1][1]);
                u4[3] = rr[3] - (u4[0] * dc[2][0] + u4[1] * dc[2][1] + u4[2] * dc[2][2]);
#pragma unroll
                for (int x = 0; x < 4; ++x) { const int ui = __float_as_int(u4[x]); int bi;
                    if ((g & 3) == 0) bi = __builtin_amdgcn_update_dpp(0, ui, 0x00, 0xF, 0xF, true); else if ((g & 3) == 1) bi = __builtin_amdgcn_update_dpp(0, ui, 0x55, 0xF, 0xF, true);
                    else if ((g & 3) == 2) bi = __builtin_amdgcn_update_dpp(0, ui, 0xAA, 0xF, 0xF, true); else bi = __builtin_amdgcn_update_dpp(0, ui, 0xFF, 0xF, 0xF, true);
                    u4[x] = __int_as_float(bi); }
                ubo[g].x = cvt_pk_bf16(u4[0], u4[1]); ubo[g].y = cvt_pk_bf16(u4[2], u4[3]);
                if (g < 3) {
#pragma unroll
                    for (int jj = 0; jj < 4; ++jj) r0[jj] -= u4[0] * a0c[jj][0] + u4[1] * a0c[jj][1] + u4[2] * a0c[jj][2] + u4[3] * a0c[jj][3]; }
                if (g < 7) {
#pragma unroll
                    for (int jj = 0; jj < 4; ++jj) r1[jj] -= u4[0] * a1c[jj][0] + u4[1] * a1c[jj][1] + u4[2] * a1c[jj][2] + u4[3] * a1c[jj][3]; }
                if (g + 1 < TB / 4) {
#pragma unroll
                    for (int x = 0; x < 3; ++x) dc[x] = dn[x];
#pragma unroll
                    for (int jj = 0; jj < 4; ++jj) { a0c[jj] = a0n[jj]; a1c[jj] = a1n[jj]; } }
            }
            if (pq == 0) {
#pragma unroll
                for (int g = 0; g < TB / 4; g += 2) { u32x4 w; w.x = ubo[g].x; w.y = ubo[g].y; w.z = ubo[g + 1].x; w.w = ubo[g + 1].y; *(LAS u32x4*)(UB + v * 40 + 4 * g) = w; } }
        }
        __syncthreads();
        if (MODE == 5) continue;
        {
            const bf16x8 ua = ldsb8(UB + (rt * 16 + fr) * 40 + fq * 8), va = ldsb8(VT + (rt * 16 + fr) * 40 + fq * 8);
            accY = __builtin_amdgcn_mfma_f32_16x16x32_bf16(ua, ldsb8(NBT + (ctg * 16 + fr) * 40 + fq * 8), accY, 0, 0, 0);
            *(LAS f32x4*)(YO + (ctg * 16 + fr) * 64 + rt * 16 + fq * 4) = accY;
#pragma unroll
            for (int cc = 0; cc < 2; ++cc) { const int ct = 2 * (wid & 1) + cc, kcol = ct * 16 + fr;
                f32x4 acc = Sreg[cc];
                acc = __builtin_amdgcn_mfma_f32_16x16x32_bf16(ua, ldsb8(BST + kcol * 40 + fq * 8), acc, 0, 0, 0);
                acc = __builtin_amdgcn_mfma_f32_16x16x32_bf16(va, ldsb8(KDST + kcol * 40 + fq * 8), acc, 0, 0, 0);
                const float g = GC[kcol];
#pragma unroll
                for (int i = 0; i < 4; ++i) acc[i] *= g;
                { const unsigned p0 = cvt_pk_bf16(acc[0], acc[1]), p1 = cvt_pk_bf16(acc[2], acc[3]); LAS bf16_t* sp = S0B + (rt * 16 + fq * 4) * 72 + kcol;
                  sp[0] = (bf16_t)p0; sp[72] = (bf16_t)(p0 >> 16); sp[144] = (bf16_t)p1; sp[216] = (bf16_t)(p1 >> 16); }
                Sreg[cc] = acc; }
        }
        __syncthreads();
        if (!isctx) {
            const int j = tid >> 4, c4 = (tid & 15) * 4, t = d == 0 ? j : TB - 1 - j; const f32x4 y = *(const LAS f32x4*)(YO + j * 64 + c4);
            u32x2 w; w.x = cvt_pk_bf16(y[0], y[1]); w.y = cvt_pk_bf16(y[2], y[3]);
            bf16_t* yb_ = p.Y + ((size_t)d * nlat + grow0) * RW + h * 64;
            *(u32x2*)(yb_ + t * RW + c4) = w;
            if (tid < TB) { const int tt = d == 0 ? tid : TB - 1 - tid; float* bb_ = p.bon + ((size_t)d * nlat + grow0) * NH + h; bb_[tt * NH] = BON[tid]; }
        }
    }
}
template <int MODE = 0>
__device__ __forceinline__ void rwkv_phase2(LAS unsigned char* lds, const In& in, const RwkvP p, int bid, int nblk) {
    const int nchain = 2 * p.nb * NH;
    for (int c = bid; c < nchain; c += nblk) { rwkv_chain2<MODE>(lds, in, p, c); __syncthreads(); }
}
}

namespace mk {
namespace r3 {
constexpr int C2_RAW = 0;
constexpr int C2_MU = C2_RAW + (TB + 2) * RAWW * 2;
constexpr int C2_WUP = C2_MU + 3 * RAWW * 4;
constexpr int C2_AUP = C2_WUP + 64 * 72 * 2;
constexpr int C2_CST = C2_AUP + 64 * 72 * 2;
constexpr int C2_AWD = C2_CST + 5 * 64 * 4;
constexpr int C2_AAD = C2_AWD + TB * 72 * 2;
constexpr int C2_X = C2_AAD + TB * 72 * 2;
constexpr int C2_G = C2_X;
constexpr int C2_UB = C2_G + 64 * 36 * 4;
constexpr int C2_ABT = C2_UB + 64 * 40 * 2;
constexpr int C2_AKT = C2_ABT + 32 * 32 * 4;
constexpr int C2_NBT = C2_AKT + 32 * 40 * 2;
constexpr int C2_NKT = C2_NBT + 32 * 40 * 2;
constexpr int C2_YO = C2_NKT + 32 * 40 * 2;
constexpr int C2_X_END = C2_YO + TB * 64 * 4;
constexpr int C2_KKS = C2_X_END;
constexpr int C2_BS = C2_KKS + TB * 72 * 2, C2_KDS = C2_BS + TB * 72 * 2, C2_RS = C2_KDS + TB * 72 * 2;
constexpr int C2_BST = C2_RS + TB * 72 * 2;
constexpr int C2_KDST = C2_BST + 64 * 40 * 2;
constexpr int C2_VT = C2_KDST + 64 * 40 * 2;
constexpr int C2_S0B = C2_VT + 64 * 40 * 2;
constexpr int C2_GC = C2_S0B + 64 * 72 * 2;
constexpr int C2_BON = C2_GC + 64 * 4;
constexpr int C2_RB = C2_BON + TB * 4;
constexpr int C2_KRB = C2_RB + TB * 64 * 2, C2_VB = C2_KRB + TB * 64 * 2;
constexpr int C2_LA = C2_VB + TB * 64 * 2;
constexpr int C2_CUM = C2_LA + TB * 64 * 4;
constexpr int C2_BON2 = C2_CUM + (TB + 1) * 64 * 4;
constexpr int C2_END = C2_BON2 + TB * 4;
static_assert(C2_END <= LDS_BYTES - 16 && (C2_X % 16) == 0 && (C2_KKS % 16) == 0 && (C2_G % 16) == 0 && (C2_UB % 16) == 0 && (C2_ABT % 16) == 0 && (C2_AKT % 16) == 0 && (C2_S0B % 16) == 0, "rwkv2 LDS");

__device__ __forceinline__ bf16x8 ldsb8(const LAS bf16_t* p) { return *(const LAS bf16x8*)p; }

template <int MODE>
__device__ __forceinline__ void rwkv_chain3(LAS unsigned char* lds, const In& in, const RwkvP p, int chain) {
    const int tid = threadIdx.x, lane = tid & 63, wid = tid >> 6, fr = lane & 15, fq = lane >> 4;
    const int d = chain / (p.nb * NH), bl = (chain / NH) % p.nb, h = chain % NH;
    const int nlat = p.nb * SEQ;
    LAS bf16_t* RAW = (LAS bf16_t*)(lds + C2_RAW); LAS float* MU = (LAS float*)(lds + C2_MU);
    LAS bf16_t* WUP = (LAS bf16_t*)(lds + C2_WUP); LAS bf16_t* AUP = (LAS bf16_t*)(lds + C2_AUP); LAS float* CST = (LAS float*)(lds + C2_CST);
    LAS bf16_t* AWD = (LAS bf16_t*)(lds + C2_AWD); LAS bf16_t* AAD = (LAS bf16_t*)(lds + C2_AAD);
    LAS bf16_t *Rb = (LAS bf16_t*)(lds + C2_RB), *KRb = (LAS bf16_t*)(lds + C2_KRB), *Vb = (LAS bf16_t*)(lds + C2_VB); LAS float *LA_ = (LAS float*)(lds + C2_LA), *CUM = (LAS float*)(lds + C2_CUM);
    LAS float *YO = (LAS float*)(lds + C2_YO), *Gm = (LAS float*)(lds + C2_G), *ABT = (LAS float*)(lds + C2_ABT), *GC = (LAS float*)(lds + C2_GC), *BON = (LAS float*)(lds + C2_BON);
    LAS bf16_t *UB = (LAS bf16_t*)(lds + C2_UB), *AKT = (LAS bf16_t*)(lds + C2_AKT), *NBT = (LAS bf16_t*)(lds + C2_NBT), *NKT = (LAS bf16_t*)(lds + C2_NKT);
    LAS bf16_t *KKS = (LAS bf16_t*)(lds + C2_KKS), *BS = (LAS bf16_t*)(lds + C2_BS), *KDS = (LAS bf16_t*)(lds + C2_KDS), *RS = (LAS bf16_t*)(lds + C2_RS);
    LAS bf16_t *BST = (LAS bf16_t*)(lds + C2_BST), *KDST = (LAS bf16_t*)(lds + C2_KDST), *VT = (LAS bf16_t*)(lds + C2_VT), *S0B = (LAS bf16_t*)(lds + C2_S0B);
    auto segcol = [&](int s) __attribute__((always_inline)) { return s < 3 ? s * RW + h * 64 : (s == 3 ? OFF_WD + d * DL : OFF_AD + d * AL); };
    for (int i = tid; i < RAWW; i += NT) { const float m0 = in.shift_mu[segcol(i >> 6) + (i & 63)], m1 = in.shift_mu[RC + segcol(i >> 6) + (i & 63)]; MU[i] = m0; MU[RAWW + i] = m1; MU[2 * RAWW + i] = 1.f - m0 - m1; }
    for (int i = tid; i < 64 * 64; i += NT) { const int j = i >> 6, c = i & 63;
        WUP[c * 72 + j] = f2bf(in.rw_w_up[((size_t)d * DL + j) * RW + h * 64 + c]); AUP[c * 72 + j] = f2bf(in.rw_a_up[((size_t)d * AL + j) * RW + h * 64 + c]); }
    for (int i = tid; i < 64; i += NT) { CST[i] = in.rw_w0[d * RW + h * 64 + i]; CST[64 + i] = in.rw_a0[d * RW + h * 64 + i]; CST[128 + i] = in.rw_k_k[h * 64 + i]; CST[192 + i] = in.rw_k_a[h * 64 + i]; CST[256 + i] = in.rw_r_k[h * 64 + i]; }
    for (int i = tid; i < 64 * 72 / 2; i += NT) ((LAS unsigned*)S0B)[i] = 0u;
    constexpr int NQ = (CTX + SEQ) / TB, NQC = CTX / TB;
    auto blk_info = [&](int q, bool& isctx, int& t0, bool& hp, bool& hn, size_t& grow0) __attribute__((always_inline)) {
        isctx = q < NQC;
        if (isctx) { const int qq = d == 0 ? q : NQC - 1 - q; t0 = qq * TB; hp = t0 > 0; hn = t0 + TB < CTX; grow0 = (size_t)nlat + (size_t)bl * CTX + t0; }
        else { const int ql = q - NQC, qq = d == 0 ? ql : SEQ / TB - 1 - ql; t0 = qq * TB; hp = (t0 % GW) != 0; hn = ((t0 + TB) % GW) != 0; grow0 = (size_t)bl * SEQ + t0; }
    };
    u32x4 pre[RW_PPT]; int poff[RW_PPT], plds[RW_PPT];
#pragma unroll
    for (int k = 0; k < RW_PPT; ++k) { const int i = tid + k * NT, rr = i / 40, sp = i % 40, seg = sp >> 3, part = sp & 7;
        poff[k] = (rr - 1) * Z1_N + segcol(seg) + part * 8; plds[k] = (rr * RAWW + sp * 8) | (i >= RW_NPIECE ? 3 : (rr == 0 ? 1 : (rr == TB + 1 ? 2 : 0))); }
    auto prefetch = [&](int q) __attribute__((always_inline)) {
        bool isctx, hp, hn; int t0; size_t grow0; blk_info(q, isctx, t0, hp, hn, grow0);
        const bf16_t* base = p.z1 + grow0 * Z1_N;
#pragma unroll
        for (int k = 0; k < RW_PPT; ++k) { u32x4 v = (u32x4){0u, 0u, 0u, 0u};
            const int kind = plds[k] & 3; const bool ok = kind == 0 || (kind == 1 && hp) || (kind == 2 && hn);
            if (ok) v = *(const u32x4*)(base + poff[k]);
            pre[k] = v; }
    };
    auto commit = [&]() __attribute__((always_inline)) {
#pragma unroll
        for (int k = 0; k < RW_PPT; ++k) if ((plds[k] & 3) != 3) *(LAS u32x4*)(RAW + (plds[k] & ~3)) = pre[k];
    };
    f32x4 Sreg[2];
    Sreg[0] = (f32x4){0.f, 0.f, 0.f, 0.f}; Sreg[1] = Sreg[0];
    const int rt = wid >> 1;
    auto shift8 = [&](int t, int c0, f32x2 (&s)[4]) __attribute__((always_inline)) {
        const u32x4 xp = *(const LAS u32x4*)(RAW + t * RAWW + c0), xc = *(const LAS u32x4*)(RAW + (t + 1) * RAWW + c0), xn_ = *(const LAS u32x4*)(RAW + (t + 2) * RAWW + c0);
        const f32x4 m0a = *(const LAS f32x4*)(MU + c0), m0b = *(const LAS f32x4*)(MU + c0 + 4), m1a = *(const LAS f32x4*)(MU + RAWW + c0), m1b = *(const LAS f32x4*)(MU + RAWW + c0 + 4),
                    mca = *(const LAS f32x4*)(MU + 2 * RAWW + c0), mcb = *(const LAS f32x4*)(MU + 2 * RAWW + c0 + 4);
#define MK_SH2(J, XP, XC, XN, MC2, M02, M12) { f32x2 C, P, N; C.x = bflo(XC); C.y = bfhi(XC); P.x = bflo(XP); P.y = bfhi(XP); N.x = bflo(XN); N.y = bfhi(XN); f32x2 r_ = MC2 * C; r_ = M02 * P + r_; r_ = M12 * N + r_; s[J] = r_; }
        MK_SH2(0, xp.x, xc.x, xn_.x, mca.lo, m0a.lo, m1a.lo) MK_SH2(1, xp.y, xc.y, xn_.y, mca.hi, m0a.hi, m1a.hi)
        MK_SH2(2, xp.z, xc.z, xn_.z, mcb.lo, m0b.lo, m1b.lo) MK_SH2(3, xp.w, xc.w, xn_.w, mcb.hi, m0b.hi, m1b.hi)
#undef MK_SH2
    };
    auto pack4 = [&](const f32x2 (&s)[4]) __attribute__((always_inline)) { u32x4 w; w.x = cvt_pk_bf16(s[0].x, s[0].y); w.y = cvt_pk_bf16(s[1].x, s[1].y); w.z = cvt_pk_bf16(s[2].x, s[2].y); w.w = cvt_pk_bf16(s[3].x, s[3].y); return w; };
    int sh_t[3], sh_c[3], sh_d[3];
#pragma unroll
    for (int k = 0; k < 3; ++k) { const int it = (tid & (NT / 2 - 1)) + k * (NT / 2), t = it / 24, g = it % 24, seg = g >> 3, cc = (g & 7) * 8, js = d == 0 ? t : TB - 1 - t;
        sh_t[k] = t; sh_c[k] = g * 8; sh_d[k] = seg * (TB * 64) + js * 64 + cc; }
    auto do_shift = [&](int tl, int nth) __attribute__((always_inline)) {
#pragma unroll
        for (int k = 0; k < 3; ++k) { f32x2 s[4]; shift8(sh_t[k], sh_c[k], s); *(LAS u32x4*)(Rb + sh_d[k]) = pack4(s); }
#pragma unroll 1
        for (int it = tl; it < TB * 8; it += nth) { const int t = it >> 3, part = it & 7, js = d == 0 ? t : TB - 1 - t;
            { f32x2 s[4]; shift8(t, (24 + part) * 8, s);
#pragma unroll
              for (int j = 0; j < 4; ++j) { s[j].x = 1.f - 2.f * fast_rcp(1.f + __builtin_amdgcn_exp2f(2.885390081777927f * s[j].x)); s[j].y = 1.f - 2.f * fast_rcp(1.f + __builtin_amdgcn_exp2f(2.885390081777927f * s[j].y)); }
              *(LAS u32x4*)(AWD + js * 72 + part * 8) = pack4(s); }
            { f32x2 s[4]; shift8(t, (32 + part) * 8, s); *(LAS u32x4*)(AAD + js * 72 + part * 8) = pack4(s); }
        }
    };
    auto lora_stage = [&]() __attribute__((always_inline)) {
        {
            const int lora = wid >> 2, ct = wid & 3;
            const LAS bf16_t* Am = lora ? AAD : AWD; const LAS bf16_t* Bm = lora ? AUP : WUP;
            float carry = 0.f;
#pragma unroll
            for (int r2 = 0; r2 < 2; ++r2) {
                f32x4 acc = (f32x4){0.f, 0.f, 0.f, 0.f};
#pragma unroll
                for (int ks = 0; ks < 2; ++ks) acc = __builtin_amdgcn_mfma_f32_16x16x32_bf16(ldsb8(Am + (r2 * 16 + fr) * 72 + ks * 32 + fq * 8), ldsb8(Bm + (ct * 16 + fr) * 72 + ks * 32 + fq * 8), acc, 0, 0, 0);
                const int col = ct * 16 + fr;
                if (lora == 0) {
                    float c[4];
#pragma unroll
                    for (int i = 0; i < 4; ++i) { const float lw = acc[i] + CST[col]; const float e = fast_sigmoid(lw); c[i] = i ? c[i - 1] + e : e;   }
                    const float tot = c[3];
                    float s1 = tot; { const float y = __shfl_up(s1, 16); s1 += fq >= 1 ? y : 0.f; }
                    float s2 = s1;  { const float z = __shfl_up(s1, 32); s2 += fq >= 2 ? z : 0.f; }
                    const float base = carry + s2 - tot;
#pragma unroll
                    for (int i = 0; i < 4; ++i) CUM[(1 + r2 * 16 + fq * 4 + i) * 64 + col] = base + c[i];
                    carry += __shfl(s2, 48 + fr);
                } else {
#pragma unroll
                    for (int i = 0; i < 4; ++i) LA_[(r2 * 16 + fq * 4 + i) * 64 + col] = fast_sigmoid(acc[i] + CST[64 + col]);
                }
            }
        }
    };
    auto scale_stage = [&](LAS float* bonw) __attribute__((always_inline)) {
        {
            const int j = tid >> 4, c4 = (tid & 15) * 4;
            const u32x2 kp = *(const LAS u32x2*)(KRb + j * 64 + c4), rp = *(const LAS u32x2*)(Rb + j * 64 + c4), vp = *(const LAS u32x2*)(Vb + j * 64 + c4);
            const f32x4 k = (f32x4){bflo(kp.x), bfhi(kp.x), bflo(kp.y), bfhi(kp.y)}, r = (f32x4){bflo(rp.x), bfhi(rp.x), bflo(rp.y), bfhi(rp.y)};
            const f32x4 a = *(const LAS f32x4*)(LA_ + j * 64 + c4);
            const f32x4 cu = *(const LAS f32x4*)(CUM + (j + 1) * 64 + c4), cp = *(const LAS f32x4*)(CUM + j * 64 + c4);
            const f32x4 ckk = *(const LAS f32x4*)(CST + 128 + c4), cka = *(const LAS f32x4*)(CST + 192 + c4), crk = *(const LAS f32x4*)(CST + 256 + c4);
            float kkr[4], kd[4], ss = 0.f, bn = 0.f;
#pragma unroll
            for (int x = 0; x < 4; ++x) { kkr[x] = k[x] * ckk[x]; ss += kkr[x] * kkr[x]; kd[x] = k[x] * (1.f + (a[x] - 1.f) * cka[x]); bn += r[x] * kd[x] * crk[x]; }
            asm volatile("s_nop 1\n\t"
                "v_add_f32_dpp %0, %0, %0 quad_perm:[1,0,3,2] row_mask:0xf bank_mask:0xf\n\t" "v_add_f32_dpp %1, %1, %1 quad_perm:[1,0,3,2] row_mask:0xf bank_mask:0xf\n\ts_nop 0\n\t"
                "v_add_f32_dpp %0, %0, %0 quad_perm:[2,3,0,1] row_mask:0xf bank_mask:0xf\n\t" "v_add_f32_dpp %1, %1, %1 quad_perm:[2,3,0,1] row_mask:0xf bank_mask:0xf\n\ts_nop 0\n\t"
                "v_add_f32_dpp %0, %0, %0 row_half_mirror row_mask:0xf bank_mask:0xf\n\t" "v_add_f32_dpp %1, %1, %1 row_half_mirror row_mask:0xf bank_mask:0xf\n\ts_nop 0\n\t"
                "v_add_f32_dpp %0, %0, %0 row_mirror row_mask:0xf bank_mask:0xf\n\t" "v_add_f32_dpp %1, %1, %1 row_mirror row_mask:0xf bank_mask:0xf"
                : "+v"(ss), "+v"(bn));
            const float inv = __builtin_amdgcn_rsqf(fmaxf(ss, 1e-24f));
            float kks[4], bs[4], kds[4], rs[4]; f32x4 gv;
#pragma unroll
            for (int x = 0; x < 4; ++x) { const float kk = kkr[x] * inv, bb = kk * a[x];
                const float ig = __builtin_amdgcn_exp2f(0.87503877f * cu[x]), g = fast_rcp(ig), gp = __builtin_amdgcn_exp2f(-0.87503877f * cp[x]);
                kks[x] = kk * gp; bs[x] = bb * ig; kds[x] = kd[x] * ig; rs[x] = r[x] * g; gv[x] = g;
            }
            if (j == TB - 1) *(LAS f32x4*)(GC + c4) = gv;
#pragma unroll
            for (int x = 0; x < 4; x += 2) { const unsigned pb = cvt_pk_bf16(bs[x], bs[x + 1]), pk = cvt_pk_bf16(kds[x], kds[x + 1]), pv = x ? vp.y : vp.x;
                BST[(c4 + x) * 40 + j] = (bf16_t)pb; BST[(c4 + x + 1) * 40 + j] = (bf16_t)(pb >> 16); KDST[(c4 + x) * 40 + j] = (bf16_t)pk; KDST[(c4 + x + 1) * 40 + j] = (bf16_t)(pk >> 16);
                VT[(c4 + x) * 40 + j] = (bf16_t)pv; VT[(c4 + x + 1) * 40 + j] = (bf16_t)(pv >> 16); }
            u32x2 w; w.x = cvt_pk_bf16(kks[0], kks[1]); w.y = cvt_pk_bf16(kks[2], kks[3]); *(LAS u32x2*)(KKS + j * 72 + c4) = w;
            w.x = cvt_pk_bf16(bs[0], bs[1]); w.y = cvt_pk_bf16(bs[2], bs[3]); *(LAS u32x2*)(BS + j * 72 + c4) = w;
            w.x = cvt_pk_bf16(kds[0], kds[1]); w.y = cvt_pk_bf16(kds[2], kds[3]); *(LAS u32x2*)(KDS + j * 72 + c4) = w;
            w.x = cvt_pk_bf16(rs[0], rs[1]); w.y = cvt_pk_bf16(rs[2], rs[3]); *(LAS u32x2*)(RS + j * 72 + c4) = w;
            if ((tid & 15) == 0) bonw[j] = bn;
        }
    };
    if (tid < 16) *(LAS f32x4*)(CUM + tid * 4) = (f32x4){0.f, 0.f, 0.f, 0.f};
    prefetch(0);
    commit();
    __syncthreads();
    if (1 < NQ) prefetch(1);
    do_shift(tid & (NT / 2 - 1), NT / 2);
    __syncthreads();
    lora_stage();
    __syncthreads();
    scale_stage(BON);
    __syncthreads();
    for (int q = 0; q < NQ; ++q) {
        bool isctx, hp, hn; int t0; size_t grow0; blk_info(q, isctx, t0, hp, hn, grow0);
        LAS float* bonr = BON + (q & 1) * ((C2_BON2 - C2_BON) / 4); LAS float* bonn = BON + ((q + 1) & 1) * ((C2_BON2 - C2_BON) / 4);
        const int ctg = wid & 1;
        f32x4 accG = (f32x4){0.f, 0.f, 0.f, 0.f}, accY = accG;
        {
            const int pr = wid >> 1, rts = wid & 1;
            const LAS bf16_t* Xm = (pr & 1) ? KDS : BS; const LAS bf16_t* Ym = (pr < 2) ? KKS : RS;
            const bf16x8 a0 = ldsb8(Xm + (rts * 16 + fr) * 72 + fq * 8), a1 = ldsb8(Xm + (rts * 16 + fr) * 72 + 32 + fq * 8);
#pragma unroll
            for (int cts = 0; cts < 2; ++cts) {
                f32x4 acc = (f32x4){0.f, 0.f, 0.f, 0.f};
                acc = __builtin_amdgcn_mfma_f32_16x16x32_bf16(a0, ldsb8(Ym + (cts * 16 + fr) * 72 + fq * 8), acc, 0, 0, 0);
                acc = __builtin_amdgcn_mfma_f32_16x16x32_bf16(a1, ldsb8(Ym + (cts * 16 + fr) * 72 + 32 + fq * 8), acc, 0, 0, 0);
                const int t = cts * 16 + fr, s0 = rts * 16 + fq * 4;
#pragma unroll
                for (int i = 0; i < 4; ++i) { const bool keep = (pr < 2) ? (s0 + i < t) : (s0 + i <= t); acc[i] = keep ? acc[i] : 0.f; }
                if (pr == 0) { ABT[s0 * 32 + t] = acc[0]; ABT[(s0 + 1) * 32 + t] = acc[1]; ABT[(s0 + 2) * 32 + t] = acc[2]; ABT[(s0 + 3) * 32 + t] = acc[3]; }
                else { u32x2 w; w.x = cvt_pk_bf16(acc[0], acc[1]); w.y = cvt_pk_bf16(acc[2], acc[3]); *(LAS u32x2*)((pr == 1 ? AKT : (pr == 2 ? NBT : NKT)) + t * 40 + s0) = w; }
            }
#pragma unroll
            for (int ks = 0; ks < 2; ++ks) { const bf16x8 sa = ldsb8(S0B + (rt * 16 + fr) * 72 + ks * 32 + fq * 8);
                accG = __builtin_amdgcn_mfma_f32_16x16x32_bf16(sa, ldsb8(KKS + (ctg * 16 + fr) * 72 + ks * 32 + fq * 8), accG, 0, 0, 0);
                accY = __builtin_amdgcn_mfma_f32_16x16x32_bf16(sa, ldsb8(RS + (ctg * 16 + fr) * 72 + ks * 32 + fq * 8), accY, 0, 0, 0); }
        }
        __syncthreads();
        {
            const bf16x8 va = ldsb8(VT + (rt * 16 + fr) * 40 + fq * 8);
            accG = __builtin_amdgcn_mfma_f32_16x16x32_bf16(va, ldsb8(AKT + (ctg * 16 + fr) * 40 + fq * 8), accG, 0, 0, 0);
            accY = __builtin_amdgcn_mfma_f32_16x16x32_bf16(va, ldsb8(NKT + (ctg * 16 + fr) * 40 + fq * 8), accY, 0, 0, 0);
#pragma unroll
            for (int i = 0; i < 4; ++i) Gm[(rt * 16 + fq * 4 + i) * 36 + ctg * 16 + fr] = -accG[i];
            if (q + 1 < NQ) { commit(); if (q + 2 < NQ) prefetch(q + 2); }
        }
        __syncthreads();
        if (wid >= 4) { if (q + 1 < NQ) do_shift(tid & (NT / 2 - 1), NT / 2); }
        else {
            const int v = wid * 16 + (lane >> 2), pq = lane & 3;
            const LAS float* grow = Gm + v * 36;
            f32x4 r0 = *(const LAS f32x4*)(grow + 4 * pq), r1 = *(const LAS f32x4*)(grow + 16 + 4 * pq);
            u32x2 ubo[TB / 4];
            const LAS float* abq = ABT + 4 * pq; asm volatile("" : "+v"(abq));
            f32x4 a0c[4], a1c[4];
            auto ldg = [&](int g, f32x4 (&aa0)[4], f32x4 (&aa1)[4]) __attribute__((always_inline)) {
#pragma unroll
                for (int x = 0; x < 4; ++x) { if (g < 4) aa0[x] = *(const LAS f32x4*)(abq + (4 * g + x) * 32); aa1[x] = *(const LAS f32x4*)(abq + (4 * g + x) * 32 + 16); } };
            ldg(0, a0c, a1c);
#pragma unroll
            for (int g = 0; g < TB / 4; ++g) {
                f32x4 a0n[4], a1n[4];
                if (g + 1 < TB / 4) ldg(g + 1, a0n, a1n);
                __builtin_amdgcn_sched_barrier(0);
                const f32x4 rr = g < 4 ? r0 : r1;
                f32x4 dg[3];
#pragma unroll
                for (int x = 0; x < 3; ++x) dg[x] = g < 4 ? a0c[x] : a1c[x];
                f32x4 u4;
                u4[0] = rr[0];
                u4[1] = __builtin_fmaf(-u4[0], dg[0][1], rr[1]);
                u4[2] = __builtin_fmaf(-u4[1], dg[1][2], __builtin_fmaf(-u4[0], dg[0][2], rr[2]));
                u4[3] = __builtin_fmaf(-u4[2], dg[2][3], __builtin_fmaf(-u4[1], dg[1][3], __builtin_fmaf(-u4[0], dg[0][3], rr[3])));
#pragma unroll
                for (int x = 0; x < 4; ++x) { const int ui = __float_as_int(u4[x]); int bi;
                    if ((g & 3) == 0) bi = __builtin_amdgcn_update_dpp(0, ui, 0x00, 0xF, 0xF, true); else if ((g & 3) == 1) bi = __builtin_amdgcn_update_dpp(0, ui, 0x55, 0xF, 0xF, true);
                    else if ((g & 3) == 2) bi = __builtin_amdgcn_update_dpp(0, ui, 0xAA, 0xF, 0xF, true); else bi = __builtin_amdgcn_update_dpp(0, ui, 0xFF, 0xF, 0xF, true);
                    u4[x] = __int_as_float(bi); }
                ubo[g].x = cvt_pk_bf16(u4[0], u4[1]); ubo[g].y = cvt_pk_bf16(u4[2], u4[3]);
                if (g < 3) {
                    f32x2 lo = r0.lo, hi = r0.hi;
#pragma unroll
                    for (int x = 0; x < 4; ++x) { const f32x2 ux = (f32x2){u4[x], u4[x]}; lo = lo - ux * a0c[x].lo; hi = hi - ux * a0c[x].hi; }
                    r0.lo = lo; r0.hi = hi; }
                if (g < 7) {
                    f32x2 lo = r1.lo, hi = r1.hi;
#pragma unroll
                    for (int x = 0; x < 4; ++x) { const f32x2 ux = (f32x2){u4[x], u4[x]}; lo = lo - ux * a1c[x].lo; hi = hi - ux * a1c[x].hi; }
                    r1.lo = lo; r1.hi = hi; }
                if (g + 1 < TB / 4) {
#pragma unroll
                    for (int x = 0; x < 4; ++x) { a0c[x] = a0n[x]; a1c[x] = a1n[x]; } }
            }
            if (pq == 0) {
#pragma unroll
                for (int g = 0; g < TB / 4; g += 2) { u32x4 w; w.x = ubo[g].x; w.y = ubo[g].y; w.z = ubo[g + 1].x; w.w = ubo[g + 1].y; *(LAS u32x4*)(UB + v * 40 + 4 * g) = w; } }
        }
        __syncthreads();
        {
            const bf16x8 ua = ldsb8(UB + (rt * 16 + fr) * 40 + fq * 8), va = ldsb8(VT + (rt * 16 + fr) * 40 + fq * 8);
            accY = __builtin_amdgcn_mfma_f32_16x16x32_bf16(ua, ldsb8(NBT + (ctg * 16 + fr) * 40 + fq * 8), accY, 0, 0, 0);
            *(LAS f32x4*)(YO + (ctg * 16 + fr) * 64 + rt * 16 + fq * 4) = accY;
#pragma unroll
            for (int cc = 0; cc < 2; ++cc) { const int ct = 2 * (wid & 1) + cc, kcol = ct * 16 + fr;
                f32x4 acc = Sreg[cc];
                acc = __builtin_amdgcn_mfma_f32_16x16x32_bf16(ua, ldsb8(BST + kcol * 40 + fq * 8), acc, 0, 0, 0);
                acc = __builtin_amdgcn_mfma_f32_16x16x32_bf16(va, ldsb8(KDST + kcol * 40 + fq * 8), acc, 0, 0, 0);
                const float g = GC[kcol];
#pragma unroll
                for (int i = 0; i < 4; ++i) acc[i] *= g;
                { const unsigned p0 = cvt_pk_bf16(acc[0], acc[1]), p1 = cvt_pk_bf16(acc[2], acc[3]); LAS bf16_t* sp = S0B + (rt * 16 + fq * 4) * 72 + kcol;
                  sp[0] = (bf16_t)p0; sp[72] = (bf16_t)(p0 >> 16); sp[144] = (bf16_t)p1; sp[216] = (bf16_t)(p1 >> 16); }
                Sreg[cc] = acc; }
        }
        if (q + 1 < NQ) lora_stage();
        __syncthreads();
        if (!isctx) {
            const int j = tid >> 4, c4 = (tid & 15) * 4, t = d == 0 ? j : TB - 1 - j; const f32x4 y = *(const LAS f32x4*)(YO + j * 64 + c4);
            u32x2 w; w.x = cvt_pk_bf16(y[0], y[1]); w.y = cvt_pk_bf16(y[2], y[3]);
            bf16_t* yb_ = p.Y + ((size_t)d * nlat + grow0) * RW + h * 64;
            *(u32x2*)(yb_ + t * RW + c4) = w;
            if (tid < TB) { const int tt = d == 0 ? tid : TB - 1 - tid; float* bb_ = p.bon + ((size_t)d * nlat + grow0) * NH + h; bb_[tt * NH] = bonr[tid]; }
        }
        if (q + 1 < NQ) scale_stage(bonn);
        __syncthreads();
    }
}
template <int MODE = 0>
__device__ __forceinline__ void rwkv_phase3(LAS unsigned char* lds, const In& in, const RwkvP p, int bid, int nblk) {
    const int nchain = 2 * p.nb * NH;
    for (int c = bid; c < nchain; c += nblk) { rwkv_chain3<MODE>(lds, in, p, c); __syncthreads(); }
}
}
}

namespace mk {
constexpr int LR_XT = 0;
constexpr int LR_XC = LR_XT + 67 * 64 * 2 + 64;
constexpr int LR_XCB = LR_XC + 64 * 64 * 4;
constexpr int LR_GWT = LR_XCB + 64 * 72 * 2;
constexpr int LR_A = LR_GWT + 2 * 64 * 72 * 2;
constexpr int LR_BX = LR_A + 64 * 64 * 4;
constexpr int LR_HO = LR_BX + 64 * 64 * 4;
constexpr int LR_CST = LR_HO + 64 * 64 * 4;
constexpr int LR_SEGP = LR_CST + 8 * 64 * 4;
constexpr int LR_SEGH = LR_SEGP + 8 * 64 * 4;
constexpr int LR_HC = LR_SEGH + 8 * 64 * 4;
constexpr int LR_END = LR_HC + 64 * 4;
static_assert(LR_END <= LDS_BYTES && (LR_XC % 16) == 0, "lru LDS");

struct LruP { const bf16_t* z1; bf16_t* Hd; int b0, nb; };

__device__ __forceinline__ void lru_item(LAS unsigned char* lds, const In& in, const LruP p, int item) {
    const int tid = threadIdx.x, lane = tid & 63, wid = tid >> 6;
    const int d = item / (p.nb * LB), bl = (item / LB) % p.nb, n = item % LB;
    const int nlat = p.nb * SEQ;
    LAS bf16_t* XT = (LAS bf16_t*)(lds + LR_XT); LAS float* XC = (LAS float*)(lds + LR_XC); LAS bf16_t* XCB = (LAS bf16_t*)(lds + LR_XCB); LAS bf16_t* GWT = (LAS bf16_t*)(lds + LR_GWT);
    LAS float *A_ = (LAS float*)(lds + LR_A), *BX = (LAS float*)(lds + LR_BX), *HO = (LAS float*)(lds + LR_HO), *CST = (LAS float*)(lds + LR_CST), *SEGP = (LAS float*)(lds + LR_SEGP), *SEGH = (LAS float*)(lds + LR_SEGH), *HC = (LAS float*)(lds + LR_HC);
    for (int i = tid; i < 2 * 64 * 64; i += NT) { const int g = i >> 12, j = (i >> 6) & 63, k = i & 63;
        GWT[(g * 64 + k) * 72 + j] = f2bf(in.lru_gate_w[((((size_t)d * 2 + g) * LB + n) * LBS + j) * LBS + k]); }
    for (int i = tid; i < 64; i += NT) { const int c = n * 64 + i;
        CST[i] = in.lru_conv_w[c]; CST[64 + i] = in.lru_conv_w[LW + c]; CST[128 + i] = in.lru_conv_w[2 * LW + c]; CST[192 + i] = in.lru_conv_w[3 * LW + c]; CST[256 + i] = in.lru_conv_b[c];
        CST[320 + i] = in.lru_gate_b[((d * 2 + 0) * LB + n) * LBS + i]; CST[384 + i] = in.lru_gate_b[((d * 2 + 1) * LB + n) * LBS + i]; CST[448 + i] = softplusf_(-in.lru_l[d * LW + c]); }
    constexpr int NSEG = CTX / 64 + GW, NSC = CTX / 64;
    u32x4 pre[2];
    auto tok_row = [&](int sidx, int rr, bool& ok) -> size_t {
        if (sidx < NSC) { const int t = sidx * 64 + rr - 2; ok = t >= 0 && t < CTX; return (size_t)nlat + (size_t)bl * CTX + t; }
        const int col = sidx - NSC, row = rr - 2; ok = row >= 0 && row < ROWS; return (size_t)bl * SEQ + (size_t)row * GW + col;
    };
    auto seg_of = [&](int q) { if (q < NSC) return d == 0 ? q : NSC - 1 - q; const int ql = q - NSC; return NSC + (d == 0 ? ql : GW - 1 - ql); };
    auto prefetch = [&](int q) { const int sidx = seg_of(q);
#pragma unroll
        for (int k = 0; k < 2; ++k) { const int i = tid + k * NT; u32x4 v = (u32x4){0u, 0u, 0u, 0u};
            if (i < 67 * 8) { const int rr = i >> 3, part = i & 7; bool ok; const size_t gr = tok_row(sidx, rr, ok); if (ok) v = *(const u32x4*)(p.z1 + gr * Z1_N + Z1_LX + n * 64 + part * 8); }
            pre[k] = v; } };
    auto commit = [&]() {
#pragma unroll
        for (int k = 0; k < 2; ++k) { const int i = tid + k * NT; if (i < 67 * 8) *(LAS u32x4*)(XT + (i >> 3) * 64 + (i & 7) * 8) = pre[k]; } };
    if (tid < 64) HC[tid] = 0.f;
    auto conv = [&]() __attribute__((always_inline)) {
        const int t = tid >> 3, c0 = (tid & 7) * 8; f32x2 s[4];
        { const f32x4 b0 = *(const LAS f32x4*)(CST + 256 + c0), b1 = *(const LAS f32x4*)(CST + 256 + c0 + 4); s[0] = b0.lo; s[1] = b0.hi; s[2] = b1.lo; s[3] = b1.hi; }
#pragma unroll
        for (int tap = 0; tap < 4; ++tap) { const u32x4 x = *(const LAS u32x4*)(XT + (t + tap) * 64 + c0);
            const f32x4 w0 = *(const LAS f32x4*)(CST + tap * 64 + c0), w1 = *(const LAS f32x4*)(CST + tap * 64 + c0 + 4);
            f32x2 v; v.x = bflo(x[0]); v.y = bfhi(x[0]); s[0] = w0.lo * v + s[0]; v.x = bflo(x[1]); v.y = bfhi(x[1]); s[1] = w0.hi * v + s[1];
            v.x = bflo(x[2]); v.y = bfhi(x[2]); s[2] = w1.lo * v + s[2]; v.x = bflo(x[3]); v.y = bfhi(x[3]); s[3] = w1.hi * v + s[3]; }
        *(LAS f32x4*)(XC + t * 64 + c0) = (f32x4){s[0].x, s[0].y, s[1].x, s[1].y}; *(LAS f32x4*)(XC + t * 64 + c0 + 4) = (f32x4){s[2].x, s[2].y, s[3].x, s[3].y};
        u32x4 w; w.x = cvt_pk_bf16(s[0].x, s[0].y); w.y = cvt_pk_bf16(s[1].x, s[1].y); w.z = cvt_pk_bf16(s[2].x, s[2].y); w.w = cvt_pk_bf16(s[3].x, s[3].y); *(LAS u32x4*)(XCB + t * 72 + c0) = w; };
    auto output = [&](int sidx) __attribute__((always_inline)) {
        if (sidx >= NSC) { const int col = sidx - NSC, t = tid >> 3, c0 = (tid & 7) * 8;
            const f32x4 x = *(const LAS f32x4*)(HO + t * 64 + c0), y = *(const LAS f32x4*)(HO + t * 64 + c0 + 4);
            *(u32x4*)(p.Hd + ((size_t)d * nlat + (size_t)bl * SEQ + (size_t)t * GW + col) * LW + n * 64 + c0) = pack8(x, y); } };
    prefetch(0);
    commit();
    __syncthreads();
    if (1 < NSEG) prefetch(1);
    conv();
    __syncthreads();
    float hlast = 0.f;
    for (int q = 0; q < NSEG; ++q) {
        { const int rt = wid >> 1, fr = lane & 15, fq = lane >> 4;
          bf16x8 a[2];
#pragma unroll
          for (int ks = 0; ks < 2; ++ks) a[ks] = *(const LAS bf16x8*)(XCB + (rt * 16 + fr) * 72 + ks * 32 + fq * 8);
#pragma unroll
          for (int cc = 0; cc < 2; ++cc) { const int ct = 2 * (wid & 1) + cc, col = ct * 16 + fr;
              f32x4 acc0 = (f32x4){0.f, 0.f, 0.f, 0.f}, acc1 = acc0;
#pragma unroll
              for (int ks = 0; ks < 2; ++ks) {
                  const bf16x8 b0 = *(const LAS bf16x8*)(GWT + (0 * 64 + col) * 72 + ks * 32 + fq * 8), b1 = *(const LAS bf16x8*)(GWT + (1 * 64 + col) * 72 + ks * 32 + fq * 8);
                  acc0 = __builtin_amdgcn_mfma_f32_16x16x32_bf16(a[ks], b0, acc0, 0, 0, 0); acc1 = __builtin_amdgcn_mfma_f32_16x16x32_bf16(a[ks], b1, acc1, 0, 0, 0); }
              constexpr float L2E = 1.4426950408889634f;
              const float g0s = -L2E * CST[320 + col], g1s = -L2E * CST[384 + col], sp8l = -8.f * L2E * CST[448 + col];
#pragma unroll
              for (int i = 0; i < 4; ++i) { const int t = rt * 16 + fq * 4 + i;
                  const float rec = fast_rcp(1.f + __builtin_amdgcn_exp2f(__builtin_fmaf(acc0[i], -L2E, g0s))), ib = 1.f + __builtin_amdgcn_exp2f(__builtin_fmaf(acc1[i], -L2E, g1s));
                  const float av = __builtin_amdgcn_exp2f(sp8l * rec), om = __builtin_fmaf(-av, av, 1.f);
                  A_[t * 64 + col] = av; BX[t * 64 + col] = om * __builtin_amdgcn_rsqf(fmaxf(om * ib * ib, 1e-30f)) * XC[t * 64 + col]; } } }
        if (q + 1 < NSEG) commit();
        if (q > 0) { output(seg_of(q - 1)); if ((tid >> 6) == 7) HC[tid & 63] = hlast; }
        __syncthreads();
        const int ch = tid & 63, pc = tid >> 6; float av[8], bv[8];
        { float P = 1.f, H = 0.f;
#pragma unroll
          for (int x = 0; x < 8; ++x) { const int st = pc * 8 + x, t = d == 0 ? st : 63 - st; av[x] = A_[t * 64 + ch]; bv[x] = BX[t * 64 + ch]; H = av[x] * H + bv[x]; P *= av[x]; }
          SEGP[pc * 64 + ch] = P; SEGH[pc * 64 + ch] = H; }
        if (q + 1 < NSEG) { if (q + 2 < NSEG) prefetch(q + 2); conv(); }
        __syncthreads();
        { float h = HC[ch];
#pragma unroll
          for (int q2 = 0; q2 < 7; ++q2) if (q2 < pc) h = SEGP[q2 * 64 + ch] * h + SEGH[q2 * 64 + ch];
#pragma unroll
          for (int x = 0; x < 8; ++x) { const int st = pc * 8 + x, t = d == 0 ? st : 63 - st; h = av[x] * h + bv[x]; HO[t * 64 + ch] = h; }
          hlast = h; }
        __syncthreads();
    }
    output(seg_of(NSEG - 1));
}
__device__ __forceinline__ void lru_phase(LAS unsigned char* lds, const In& in, const LruP p, int bid, int nblk) {
    const int nitem = 2 * p.nb * LB;
    for (int it = bid; it < nitem; it += nblk) { lru_item(lds, in, p, it); __syncthreads(); }
}
}

namespace mk {
#define MK_DPPX(x, ctrl) __int_as_float(__builtin_amdgcn_update_dpp(__float_as_int(x), __float_as_int(x), ctrl, 0xF, 0xF, false))
__device__ __forceinline__ float allreduce4(float x) { x += MK_DPPX(x, 0xB1); x += MK_DPPX(x, 0x4E); return x; }
__device__ __forceinline__ void unpack8(const u32x4 w, float (&f)[8]) {
#pragma unroll
    for (int j = 0; j < 4; ++j) { f[2 * j] = bflo(w[j]); f[2 * j + 1] = bfhi(w[j]); } }
constexpr int AG_K = 256;
struct PostP { const bf16_t* z1; bf16_t* Y; const float* bon; bf16_t* Ag; int nlat; int pad_; };
__device__ __forceinline__ void rwkv_post_rows(LAS float* cst  , const In& in, const PostP p, int row_lo, int row_hi, bool dry = false) {
    const int lane = threadIdx.x & 63, wid = threadIdx.x >> 6, c0 = lane * 16, h = lane >> 2;
    float mg0[8], mg1[8];
    for (int i = threadIdx.x; i < RW; i += NT) { cst[i] = in.shift_mu[OFF_V + i]; cst[RW + i] = in.shift_mu[RC + OFF_V + i]; cst[2 * RW + i] = in.rw_lnx[i]; cst[3 * RW + i] = in.rw_lnx[RW + i]; }
    __syncthreads();
#pragma unroll
    for (int j = 0; j < 8; ++j) { const int c = OFF_GD + (lane < GL / 8 ? lane : 0) * 8 + j; mg0[j] = in.shift_mu[c]; mg1[j] = in.shift_mu[RC + c]; }
    struct Raw { u32x4 y00, y01, y10, y11, zx[2], zp[2], zn[2]; float b0, b1; };
    const u32x4 Z4 = (u32x4){0u, 0u, 0u, 0u};
    auto load_row = [&](int r, Raw& w) __attribute__((always_inline)) {
        const int cg = r % GW; const bool hp = cg > 0, hn = cg < GW - 1;
        const bf16_t* y0p = p.Y + (size_t)r * RW + c0; const bf16_t* y1p = p.Y + ((size_t)p.nlat + r) * RW + c0;
        w.y00 = *(const u32x4*)y0p; w.y01 = *(const u32x4*)(y0p + 8); w.y10 = *(const u32x4*)y1p; w.y11 = *(const u32x4*)(y1p + 8);
        w.b0 = p.bon[(size_t)r * NH + h]; w.b1 = p.bon[((size_t)p.nlat + r) * NH + h];
        const bf16_t* zr = p.z1 + (size_t)r * Z1_N;
#pragma unroll
        for (int half = 0; half < 2; ++half) { const int c = OFF_V + c0 + half * 8;
            w.zx[half] = *(const u32x4*)(zr + c); w.zp[half] = Z4; w.zn[half] = Z4;
            if (hp) w.zp[half] = *(const u32x4*)(zr - Z1_N + c);
            if (hn) w.zn[half] = *(const u32x4*)(zr + Z1_N + c); }
    };
    auto compute_row = [&](int r, const Raw& w) __attribute__((always_inline)) {
        bf16_t* y0p = p.Y + (size_t)r * RW + c0;
        float y[16], t8[8];
        unpack8(w.y00, t8);
#pragma unroll
        for (int j = 0; j < 8; ++j) y[j] = t8[j];
        unpack8(w.y01, t8);
#pragma unroll
        for (int j = 0; j < 8; ++j) y[8 + j] = t8[j];
        unpack8(w.y10, t8);
#pragma unroll
        for (int j = 0; j < 8; ++j) y[j] += t8[j];
        unpack8(w.y11, t8);
#pragma unroll
        for (int j = 0; j < 8; ++j) y[8 + j] += t8[j];
        float s = 0.f;
#pragma unroll
        for (int j = 0; j < 16; ++j) s += y[j];
        const float mu = allreduce4(s) * (1.f / 64.f); float q = 0.f;
#pragma unroll
        for (int j = 0; j < 16; ++j) { const float dlt = y[j] - mu; q += dlt * dlt; }
        const float rs = __builtin_amdgcn_rsqf(allreduce4(q) * (1.f / 64.f) + LNX_EPS);
        const float bonus = w.b0 + w.b1;
#pragma unroll
        for (int half = 0; half < 2; ++half) {
            float xv[8], pv[8], nv[8]; unpack8(w.zx[half], xv); unpack8(w.zp[half], pv); unpack8(w.zn[half], nv);
            float m0_[8], m1_[8], g0_[8], g1_[8];
            { const LAS float* cb = cst + c0 + half * 8; const f32x4 a0 = *(const LAS f32x4*)cb, a1 = *(const LAS f32x4*)(cb + 4), b0 = *(const LAS f32x4*)(cb + RW), b1 = *(const LAS f32x4*)(cb + RW + 4),
                  e0 = *(const LAS f32x4*)(cb + 2 * RW), e1 = *(const LAS f32x4*)(cb + 2 * RW + 4), f0 = *(const LAS f32x4*)(cb + 3 * RW), f1 = *(const LAS f32x4*)(cb + 3 * RW + 4);
#pragma unroll
              for (int j = 0; j < 4; ++j) { m0_[j] = a0[j]; m0_[4 + j] = a1[j]; m1_[j] = b0[j]; m1_[4 + j] = b1[j]; g0_[j] = e0[j]; g0_[4 + j] = e1[j]; g1_[j] = f0[j]; g1_[4 + j] = f1[j]; } }
            float o[8];
#pragma unroll
            for (int j = 0; j < 8; ++j) { const int cj = half * 8 + j; const float v = xv[j] + m0_[j] * (pv[j] - xv[j]) + m1_[j] * (nv[j] - xv[j]);
                o[j] = (y[cj] - mu) * rs * g0_[j] + g1_[j] + bonus * v; }
            u32x4 wv; wv.x = cvt_pk_bf16(o[0], o[1]); wv.y = cvt_pk_bf16(o[2], o[3]); wv.z = cvt_pk_bf16(o[4], o[5]); wv.w = cvt_pk_bf16(o[6], o[7]); if (!dry) *(u32x4*)(y0p + half * 8) = wv; else if (wv.x == 0x12345678u) *(u32x4*)(y0p + half * 8) = wv;
        }
        if (lane < 32) { u32x4 wv = Z4;
            if (lane < GL / 8) { const int cg = r % GW; const bool hp = cg > 0, hn = cg < GW - 1; const bf16_t* zr = p.z1 + (size_t)r * Z1_N; const int c = OFF_GD + lane * 8;
                u32x4 gx = *(const u32x4*)(zr + c), gp = Z4, gn = Z4; if (hp) gp = *(const u32x4*)(zr - Z1_N + c); if (hn) gn = *(const u32x4*)(zr + Z1_N + c);
                float xv[8], pv[8], nv[8]; unpack8(gx, xv); unpack8(gp, pv); unpack8(gn, nv);
                float o[8];
#pragma unroll
                for (int j = 0; j < 8; ++j) o[j] = fast_sigmoid(xv[j] + mg0[j] * (pv[j] - xv[j]) + mg1[j] * (nv[j] - xv[j]));
                wv.x = cvt_pk_bf16(o[0], o[1]); wv.y = cvt_pk_bf16(o[2], o[3]); wv.z = cvt_pk_bf16(o[4], o[5]); wv.w = cvt_pk_bf16(o[6], o[7]); }
            *(u32x4*)(p.Ag + (size_t)r * AG_K + lane * 8) = wv; }
    };
    constexpr int RS_ = NT / 64;
    Raw A, B;
    int r = row_lo + wid;
    if (r < row_hi) load_row(r, A);
    for (; r < row_hi; r += 2 * RS_) {
        if (r + RS_ < row_hi) load_row(r + RS_, B);
        compute_row(r, A);
        if (r + 2 * RS_ < row_hi) load_row(r + 2 * RS_, A);
        if (r + RS_ < row_hi) compute_row(r + RS_, B);
    }
}
#define MK_FR_ROW(f) ((((f) >> 3) * HALF) + wr * 64 + ((((f) >> 1) & 3) * 16) + fr)
#define MK_FR_COL(f) ((((f) & 1) * HALF) + wc * 32 + 8 * fq)
#define MK_FR_ACC(f, n) acc[(f) >> 3][(f) & 1][((f) >> 1) & 3][n]
#define MK_FENCE asm volatile("" ::: "memory")
struct EpiYa { static constexpr int NS = 16; const bf16_t* yn; bf16_t* ya;
    __device__ __forceinline__ bool operator()(f32x4 (&acc)[2][2][4][2], const Unit& u, int wr, int wc, int fr, int fq) const {
        const size_t base = (size_t)(u.pm * BM) * RW + u.pn * BM;
        u32x4 cur = *(const u32x4*)(yn + base + (size_t)MK_FR_ROW(0) * RW + MK_FR_COL(0));
#pragma unroll
        for (int f = 0; f < 16; ++f) { u32x4 nxt = cur; if (f + 1 < 16) nxt = *(const u32x4*)(yn + base + (size_t)MK_FR_ROW(f + 1) * RW + MK_FR_COL(f + 1));
            MK_FENCE; float v[8]; unpack8(cur, v); f32x4 a = MK_FR_ACC(f, 0), b = MK_FR_ACC(f, 1);
#pragma unroll
            for (int j = 0; j < 4; ++j) { a[j] *= v[j]; b[j] *= v[4 + j]; }
            *(u32x4*)(ya + base + (size_t)MK_FR_ROW(f) * RW + MK_FR_COL(f)) = pack8(a, b); MK_FENCE; cur = nxt; }
        return false; } };
struct EpiZc { static constexpr int NS = 16; const bf16_t* Hd; bf16_t* yb; bf16_t* gates; int nlat; float sc;
    __device__ __forceinline__ bool operator()(f32x4 (&acc)[2][2][4][2], const Unit& u, int wr, int wc, int fr, int fq) const {
        if (u.pn < LW / BM) {
            MK_FRAG_LOOP(r, c) { const size_t o = (size_t)(u.pm * BM + r) * LW + u.pn * BM + c; float h0[8], h1[8]; unpack8(*(const u32x4*)(Hd + o), h0); unpack8(*(const u32x4*)(Hd + (size_t)nlat * LW + o), h1);
                f32x4 a = acc[ai][bj][m][0] * sc, b = acc[ai][bj][m][1] * sc;
#pragma unroll
                for (int j = 0; j < 4; ++j) { a[j] = fast_gelu_tanh(a[j]) * (h0[j] + h1[j]); b[j] = fast_gelu_tanh(b[j]) * (h0[4 + j] + h1[4 + j]); }
                *(u32x4*)(yb + o) = pack8(a, b); asm volatile("" ::: "memory"); }
        } else {
            MK_FRAG_LOOP(r, c) { const size_t o = (size_t)(u.pm * BM + r) * (2 * D) + (u.pn * BM - LW) + c;
                f32x4 a = acc[ai][bj][m][0] * sc, b = acc[ai][bj][m][1] * sc;
#pragma unroll
                for (int j = 0; j < 4; ++j) { a[j] = fast_sigmoid(a[j]); b[j] = fast_sigmoid(b[j]); }
                *(u32x4*)(gates + o) = pack8(a, b); }
        }
        return false; } };
struct PairOrder { StaticOrder S;
    __device__ bool next(int i, Unit& u) const { if (!S.next(i >> 1, u)) return false; u.e = i & 1; return true; } };
struct EpiBranch { const bf16_t* gates; bf16_t* mixed;
    __device__ __forceinline__ bool operator()(f32x4 (&acc)[2][2][4][2], const Unit& u, int wr, int wc, int fr, int fq) const {
        const size_t gbase = (size_t)(u.pm * BM) * (2 * D) + u.pn * BM, mbase = (size_t)(u.pm * BM) * D + u.pn * BM;
        u32x4 c1 = (u32x4){0u, 0u, 0u, 0u}, c2 = *(const u32x4*)(gates + gbase + (size_t)MK_FR_ROW(0) * (2 * D) + D + MK_FR_COL(0));
        if (u.e == 0) c1 = *(const u32x4*)(gates + gbase + (size_t)MK_FR_ROW(0) * (2 * D) + MK_FR_COL(0));
#pragma unroll
        for (int f = 0; f < 16; ++f) { u32x4 n1 = c1, n2 = c2;
            if (f + 1 < 16) { const size_t o = gbase + (size_t)MK_FR_ROW(f + 1) * (2 * D) + MK_FR_COL(f + 1); n2 = *(const u32x4*)(gates + o + D); if (u.e == 0) n1 = *(const u32x4*)(gates + o); }
            MK_FENCE; float g1[8], g2[8]; unpack8(c1, g1); unpack8(c2, g2);
            if (u.e == 0) {
#pragma unroll
                for (int j = 0; j < 4; ++j) { MK_FR_ACC(f, 0)[j] *= g1[j] / g2[j]; MK_FR_ACC(f, 1)[j] *= g1[4 + j] / g2[4 + j]; }
            } else { f32x4 a = MK_FR_ACC(f, 0), b = MK_FR_ACC(f, 1);
#pragma unroll
                for (int j = 0; j < 4; ++j) { a[j] *= g2[j]; b[j] *= g2[4 + j]; }
                *(u32x4*)(mixed + mbase + (size_t)MK_FR_ROW(f) * D + MK_FR_COL(f)) = pack8(a, b); }
            MK_FENCE; c1 = n1; c2 = n2; }
        __builtin_amdgcn_s_waitcnt(0x0F70);
        return u.e == 0; } };
struct EpiF32 { float* C; long ldc;
    __device__ __forceinline__ bool operator()(f32x4 (&acc)[2][2][4][2], const Unit& u, int wr, int wc, int fr, int fq) const {
        MK_FRAG_LOOP(r, c) { float* o = C + (size_t)(u.pm * BM + r) * ldc + u.pn * BM + c; *(f32x4*)o = acc[ai][bj][m][0]; *(f32x4*)(o + 4) = acc[ai][bj][m][1]; }
        return false; } };
}

namespace mk {
constexpr int NEX = NE + 1;
constexpr int SLOTS_PER_TOK = TOPK + 1;
constexpr int RP_MOD = 0;
constexpr int RP_UH = RP_MOD + 3 * D * 4;
constexpr int RP_UL = RP_UH + 16 * (D + 8) * 2;
constexpr int RP_PART = RP_UL + 16 * (D + 8) * 2;
constexpr int RP_LOG = RP_PART + 8 * 16 * 64 * 4;
constexpr int RP_HIST = RP_LOG + 16 * 64 * 4;
constexpr int RP_END = RP_HIST + 64 * 4;
static_assert(RP_END <= LDS_BYTES, "rowpass LDS");

constexpr float FP8_SR = 64.f;
constexpr float FP8_SA = 8.f, FP8_SWD = 256.f;
constexpr float FP8_SU = 16.f, FP8_SW = 256.f;
struct RowP { float* y2h1; bf16_t* u; unsigned char* u8; const float* modpart; const bf16_t* rwt;
              int* tope; float* gatev; int* lrank; int* blkcnt; int b0, nlat; };
__device__ __forceinline__ float wave_max(float x) { return wave_max64(x); }
__device__ __forceinline__ void row_pass(LAS unsigned char* lds, const In& in, const RowP p, int row_lo, int row_hi, bool dry = false) {
    const int tid = threadIdx.x, lane = tid & 63, wid = tid >> 6;
    LAS float* MOD = (LAS float*)(lds + RP_MOD); LAS bf16_t* UH = (LAS bf16_t*)(lds + RP_UH); LAS bf16_t* UL = (LAS bf16_t*)(lds + RP_UL);
    LAS float* PART = (LAS float*)(lds + RP_PART); LAS float* LOG = (LAS float*)(lds + RP_LOG); LAS int* HIST = (LAS int*)(lds + RP_HIST);
    const int mr = p.b0 + row_lo / SEQ;
    for (int j = tid; j < 3 * D; j += NT) MOD[j] = mod_value(in, p.modpart, mr, 2 * D + j);
    if (tid < 64) HIST[tid] = 0;
    __syncthreads();
    float gp1[16], gp2[16];
#pragma unroll
    for (int j = 0; j < 4; ++j)
#pragma unroll
        for (int q = 0; q < 4; ++q) { gp1[4 * j + q] = in.norm_g[D + j * 256 + lane * 4 + q]; gp2[4 * j + q] = in.norm_g[2 * D + j * 256 + lane * 4 + q]; }
    u32x2 py[2][4]; f32x4 px[2][4];
    auto fetch = [&](int r16) __attribute__((always_inline)) {
#pragma unroll
        for (int rr = 0; rr < 2; ++rr) { const int r = r16 + wid * 2 + rr;
#pragma unroll
            for (int j = 0; j < 4; ++j) { py[rr][j] = *(const u32x2*)(p.u + (size_t)r * D + j * 256 + lane * 4); px[rr][j] = *(const f32x4*)(in.x + ((size_t)p.b0 * SEQ + r) * D + j * 256 + lane * 4); } } };
    fetch(row_lo);
    for (int r16 = row_lo; r16 < row_hi; r16 += 16) {
#pragma unroll
        for (int rr = 0; rr < 2; ++rr) {
            const int lr = wid * 2 + rr, r = r16 + lr;
            float* yp = p.y2h1 + (size_t)r * D;
            f32x4 v[4]; float ss = 0.f;
#pragma unroll
            for (int j = 0; j < 4; ++j) { const u32x2 yw = py[rr][j];
                v[j] = (f32x4){bflo(yw.x), bfhi(yw.x), bflo(yw.y), bfhi(yw.y)}; ss += v[j][0] * v[j][0] + v[j][1] * v[j][1] + v[j][2] * v[j][2] + v[j][3] * v[j][3]; }
#pragma unroll
            for (int o_ = 0; o_ < 1; ++o_) ss = wave_sum64(ss);
            const float rinv = __builtin_amdgcn_rsqf(ss * (1.f / D) + NORM_EPS); float s2 = 0.f;
#pragma unroll
            for (int j = 0; j < 4; ++j) { const int c = j * 256 + lane * 4; const f32x4 xv = px[rr][j];
#pragma unroll
                for (int q = 0; q < 4; ++q) { const float hv = xv[q] + MOD[c + q] * (v[j][q] * rinv * gp1[4 * j + q]); v[j][q] = hv; s2 += hv * hv; }
                if (!dry) *(f32x4*)(yp + c) = v[j]; }
#pragma unroll
            for (int o_ = 0; o_ < 1; ++o_) s2 = wave_sum64(s2);
            const float r2 = __builtin_amdgcn_rsqf(s2 * (1.f / D) + NORM_EPS);
#pragma unroll
            for (int j = 0; j < 4; ++j) { const int c = j * 256 + lane * 4; float uu[4], lo[4]; unsigned hw[2];
#pragma unroll
                for (int q = 0; q < 4; ++q) uu[q] = (v[j][q] * r2 * gp2[4 * j + q]) * (1.f + MOD[2 * D + c + q]) + MOD[D + c + q];
                hw[0] = cvt_pk_bf16(uu[0], uu[1]); hw[1] = cvt_pk_bf16(uu[2], uu[3]);
                lo[0] = uu[0] - bflo(hw[0]); lo[1] = uu[1] - bfhi(hw[0]); lo[2] = uu[2] - bflo(hw[1]); lo[3] = uu[3] - bfhi(hw[1]);
                u32x2 w; w.x = hw[0]; w.y = hw[1]; *(unsigned*)(p.u8 + (size_t)r * D + c) = pack4_fp8(uu[0] * FP8_SU, uu[1] * FP8_SU, uu[2] * FP8_SU, uu[3] * FP8_SU); *(LAS u32x2*)(UH + lr * (D + 8) + c) = w;
                u32x2 wl; wl.x = cvt_pk_bf16(lo[0], lo[1]); wl.y = cvt_pk_bf16(lo[2], lo[3]); *(LAS u32x2*)(UL + lr * (D + 8) + c) = wl; }
        }
        __syncthreads();
        if (r16 + 16 < row_hi) fetch(r16 + 16);
        { const int fr = lane & 15, fq = lane >> 4;
          f32x4 acc[4];
#pragma unroll
          for (int ct = 0; ct < 4; ++ct) acc[ct] = (f32x4){0.f, 0.f, 0.f, 0.f};
#pragma unroll
          for (int ks = 0; ks < 4; ++ks) { const int k0 = wid * 128 + ks * 32 + fq * 8;
              const bf16x8 ah = *(const LAS bf16x8*)(UH + fr * (D + 8) + k0), al = *(const LAS bf16x8*)(UL + fr * (D + 8) + k0);
#pragma unroll
              for (int ct = 0; ct < 4; ++ct) { const bf16x8 bh = *(const bf16x8*)(p.rwt + (size_t)(ct * 16 + fr) * D + k0), bl = *(const bf16x8*)(p.rwt + (size_t)(NE + ct * 16 + fr) * D + k0);
                  acc[ct] = __builtin_amdgcn_mfma_f32_16x16x32_bf16(ah, bh, acc[ct], 0, 0, 0); acc[ct] = __builtin_amdgcn_mfma_f32_16x16x32_bf16(ah, bl, acc[ct], 0, 0, 0); acc[ct] = __builtin_amdgcn_mfma_f32_16x16x32_bf16(al, bh, acc[ct], 0, 0, 0); } }
#pragma unroll
          for (int ct = 0; ct < 4; ++ct)
#pragma unroll
              for (int i = 0; i < 4; ++i) PART[(wid * 16 + fq * 4 + i) * 64 + ct * 16 + fr] = acc[ct][i]; }
        __syncthreads();
        for (int i = tid; i < 16 * 64; i += NT) { float s = 0.f;
#pragma unroll
            for (int w = 0; w < 8; ++w) s += PART[w * 1024 + i];
            LOG[i] = s; }
        __syncthreads();
#pragma unroll 1
        for (int rr = 0; rr < 2; ++rr) {
            const int lr = wid * 2 + rr, r = r16 + lr;
            const float sc = sigmoidf_(LOG[lr * 64 + lane]), bi = sc + in.router_b[lane];
            float m1 = bi; m1 = fmaxf(m1, MK_DPPF(m1, 0xB1)); m1 = fmaxf(m1, MK_DPPF(m1, 0x4E)); m1 = fmaxf(m1, MK_DPPF(m1, 0x141));
            const unsigned long long eq = __ballot(bi == m1); const int first = __ffsll((long long)((eq >> (lane & ~7)) & 0xffull)) - 1 + (lane & ~7);
            float m2 = (lane == first) ? -1e30f : bi; m2 = fmaxf(m2, MK_DPPF(m2, 0xB1)); m2 = fmaxf(m2, MK_DPPF(m2, 0x4E)); m2 = fmaxf(m2, MK_DPPF(m2, 0x141));
            const float gs = m1 + m2; const int myg = lane >> 3; int rank = 0;
#pragma unroll
            for (int g = 0; g < NG; ++g) { const float og = __int_as_float(__builtin_amdgcn_readlane(__float_as_int(gs), g * 8)); rank += (og > gs || (og == gs && g < myg)) ? 1 : 0; }
            float cand = rank < TG ? bi : -1e30f; float tsum = 0.f; int myidx = 0; float mysc = 0.f;
#pragma unroll
            for (int it = 0; it < TOPK; ++it) { const float m = wave_max(cand); const unsigned long long bm = __ballot(cand == m); const int win = __builtin_amdgcn_readfirstlane(__ffsll((long long)bm) - 1);
                const float ws = __int_as_float(__builtin_amdgcn_readlane(__float_as_int(sc), win)); tsum += ws; if (lane == it) { myidx = win; mysc = ws; } if (lane == win) cand = -1e30f; }
            if (lane < TOPK) { const int rk = atomicAdd((int*)&HIST[myidx], 1);
                p.tope[(size_t)r * TOPK + lane] = myidx; p.gatev[(size_t)r * TOPK + lane] = mysc / tsum * 2.5f; p.lrank[(size_t)r * TOPK + lane] = rk; }
        }
        __syncthreads();
    }
    if (tid < 64) p.blkcnt[blockIdx.x * 64 + tid] = HIST[tid];
}

struct MoeP { const int* tope; const float* gatev; const int* lrank; const int* blkcnt;
              int* tilepre;
              int* list;
              int* sdst;
              float* sgate;
              int r0, nr, blk0, nbh, rpb, pad_; };
__device__ __forceinline__ void moe_assign(LAS unsigned char* lds, const MoeP p, int bid, int nblk) {
    LAS int* BASE = (LAS int*)lds; LAS int* CNT = BASE + 80; LAS int* BOFF = CNT + 80;
    const int tid = threadIdx.x;
    { LAS int* PC = BOFF + 80; const int e = tid & 63, part = tid >> 6, per = (p.nbh + 7) / 8; int c = 0, bo = 0;
#pragma unroll 4
      for (int b = part * per; b < (part + 1) * per && b < p.nbh; ++b) { const int v = p.blkcnt[(p.blk0 + b) * 64 + e]; if (p.blk0 + b < bid) bo += v; c += v; }
      PC[part * 64 + e] = c; PC[512 + part * 64 + e] = bo; }
    __syncthreads();
    if (tid < NE) { LAS int* PC = BOFF + 80; int c = 0, bo = 0;
#pragma unroll
        for (int q = 0; q < 8; ++q) { c += PC[q * 64 + tid]; bo += PC[512 + q * 64 + tid]; }
        CNT[tid] = c; BOFF[tid] = bo; }
    __syncthreads();
    if (tid == 0) { int s = 0; for (int e = 0; e < NE; ++e) { BASE[e] = s; s += (CNT[e] + BM - 1) / BM * BM; } BASE[NE] = s; CNT[NE] = p.nr; BASE[NE + 1] = s + p.nr;
        if (bid == 0) { for (int e = 0; e <= NEX; ++e) p.tilepre[e] = BASE[e] / BM; } }
    __syncthreads();
    if (bid >= p.blk0 && bid < p.blk0 + p.nbh) {
        const int rlo = p.r0 + (bid - p.blk0) * p.rpb;
        for (int i = tid; i < p.rpb * TOPK; i += NT) { const int r = rlo + i / TOPK, a = r * TOPK + i % TOPK, e = p.tope[a]; const int slot = BASE[e] + BOFF[e] + p.lrank[a];
            p.list[slot] = r; p.sdst[slot] = (r - p.r0) * SLOTS_PER_TOK + i % TOPK; p.sgate[slot] = p.gatev[a]; }
        for (int i = tid; i < p.rpb; i += NT) { const int r = rlo + i, slot = BASE[NE] + (r - p.r0); p.list[slot] = r; p.sdst[slot] = (r - p.r0) * SLOTS_PER_TOK + TOPK; p.sgate[slot] = 1.f; }
    }
    for (int e = bid; e < NE; e += nblk) { const int lo = BASE[e] + CNT[e], hi = BASE[e + 1]; for (int s = lo + tid; s < hi; s += NT) { p.list[s] = p.r0; p.sdst[s] = -1; p.sgate[s] = 0.f; } }
}
struct GroupOrder { int tpn, total, nN, G, c;
    __device__ void init(const int* tilepre, int nN_, int G_, int c_) { const int lane = threadIdx.x & 63;
        tpn = (int)__hip_atomic_load((const unsigned*)tilepre + lane + 1, __ATOMIC_RELAXED, __HIP_MEMORY_SCOPE_AGENT);
        total = (int)__hip_atomic_load((const unsigned*)tilepre + NEX, __ATOMIC_RELAXED, __HIP_MEMORY_SCOPE_AGENT); nN = nN_; G = G_; c = c_; }
    __device__ bool next(int i, Unit& u) const { const long L = (long)i * G + c; if (L >= (long)total * nN) return false;
        const int T = (int)(L / nN); const int e = __popcll(__ballot(tpn <= T));
        u.pm = T; u.pn = (int)(L % nN); u.e = __builtin_amdgcn_readfirstlane(e); return true; } };
struct EpiGU { static constexpr int NS = 16; bf16_t* act;
    __device__ __forceinline__ bool operator()(f32x4 (&acc)[2][2][4][2], const Unit& u, int wr, int wc, int fr, int fq) const {
        MK_FRAG_LOOP(r, c) { const f32x4 a = acc[ai][bj][m][0] * (1.f / (FP8_SU * FP8_SW)), b = acc[ai][bj][m][1] * (1.f / (FP8_SU * FP8_SW));
            *(unsigned*)((unsigned char*)act + (size_t)(u.pm * BM + r) * EF + ((u.pn * BM + c) >> 1)) =
                pack4_fp8(fast_silu(a[0]) * a[1] * FP8_SA, fast_silu(a[2]) * a[3] * FP8_SA, fast_silu(b[0]) * b[1] * FP8_SA, fast_silu(b[2]) * b[3] * FP8_SA); }
        return false; } };
struct EpiDown { const int* sdst; const float* sgate; bf16_t* rowsb; LAS unsigned char* lds;
    __device__ __forceinline__ void unit_begin(const Unit& u, LAS unsigned char* l) const {
        const int wid = __builtin_amdgcn_readfirstlane(threadIdx.x >> 6), lane = threadIdx.x & 63, w4 = wid & 3;
        const unsigned* src = (wid < 4 ? (const unsigned*)sdst : (const unsigned*)sgate) + (size_t)u.pm * BM + w4 * 64 + lane;
        __builtin_amdgcn_global_load_lds(src, (LAS unsigned*)(l + STAGE_BYTES + (wid < 4 ? 0 : 1024) + w4 * 256), 4, 0, 0); }
    __device__ __forceinline__ bool operator()(f32x4 (&acc)[2][2][4][2], const Unit& u, int wr, int wc, int fr, int fq) const {
        int dst[8]; float gt[8];
        const LAS int* LD = (const LAS int*)(lds + STAGE_BYTES); const LAS float* LG = (const LAS float*)(lds + STAGE_BYTES + 1024);
#pragma unroll
        for (int q = 0; q < 8; ++q) { const int sl = (q >> 2) * HALF + wr * 64 + (q & 3) * 16 + fr; dst[q] = LD[sl]; gt[q] = LG[sl]; }
#pragma unroll
        for (int ai = 0; ai < 2; ++ai)
#pragma unroll
            for (int m = 0; m < 4; ++m) { const int q = ai * 4 + m; const int dq = dst[q]; if (dq >= 0) {
#pragma unroll
                for (int bj = 0; bj < 2; ++bj) { f32x4 a = acc[ai][bj][m][0], b = acc[ai][bj][m][1];
#pragma unroll
                    for (int j = 0; j < 4; ++j) { a[j] *= gt[q] * (FP8_SR / (FP8_SA * FP8_SWD)); b[j] *= gt[q] * (FP8_SR / (FP8_SA * FP8_SWD)); }
                    u32x2 w8; w8.x = pack4_fp8(a[0], a[1], a[2], a[3]); w8.y = pack4_fp8(b[0], b[1], b[2], b[3]);
                    *(u32x2*)((unsigned char*)rowsb + (size_t)dq * D + u.pn * BM + bj * HALF + wc * 32 + 8 * fq) = w8; } } }
        return false; } };
__device__ __forceinline__ void final_rows(LAS float* sm  , const In& in, const float* modpart, const bf16_t* rowsb, float* h1out, int b0, int r0, int row_lo, int row_hi, bool dry = false) {
    const int tid = threadIdx.x, lane = tid & 63, wid = tid >> 6;
    const int mr = b0 + row_lo / SEQ;
    __syncthreads();
    for (int j = tid; j < D; j += NT) sm[j] = mod_value(in, modpart, mr, 5 * D + j);
    __syncthreads();
    float gq[16];
#pragma unroll
    for (int j = 0; j < 4; ++j)
#pragma unroll
        for (int q = 0; q < 4; ++q) gq[4 * j + q] = sm[j * 256 + lane * 4 + q] * in.norm_g[3 * D + j * 256 + lane * 4 + q];
    unsigned raw[SLOTS_PER_TOK][4]; f32x4 hraw[4];
    auto fetch = [&](int r) __attribute__((always_inline)) {
        const unsigned char* rb = (const unsigned char*)rowsb + (size_t)(r - r0) * SLOTS_PER_TOK * D; const float* hp = h1out + (size_t)r * D;
#pragma unroll
        for (int s = 0; s < SLOTS_PER_TOK; ++s)
#pragma unroll
            for (int j = 0; j < 4; ++j) raw[s][j] = *(const unsigned*)(rb + (size_t)s * D + j * 256 + lane * 4);
#pragma unroll
        for (int j = 0; j < 4; ++j) hraw[j] = *(const f32x4*)(hp + j * 256 + lane * 4); };
    if (row_lo + wid < row_hi) fetch(row_lo + wid);
    for (int r = row_lo + wid; r < row_hi; r += NT / 64) {
        float v[16];
#pragma unroll
        for (int j = 0; j < 16; ++j) v[j] = 0.f;
#pragma unroll
        for (int s = 0; s < SLOTS_PER_TOK; ++s)
#pragma unroll
            for (int j = 0; j < 4; ++j) { const int w = (int)raw[s][j]; const f32x2 lo = __builtin_amdgcn_cvt_pk_f32_fp8(w, false), hi = __builtin_amdgcn_cvt_pk_f32_fp8(w, true); v[4 * j] += lo.x; v[4 * j + 1] += lo.y; v[4 * j + 2] += hi.x; v[4 * j + 3] += hi.y; }
#pragma unroll
        for (int j = 0; j < 16; ++j) v[j] *= (1.f / FP8_SR);
        f32x4 hcur[4];
#pragma unroll
        for (int j = 0; j < 4; ++j) hcur[j] = hraw[j];
        if (r + NT / 64 < row_hi) fetch(r + NT / 64);
        float ss = 0.f;
#pragma unroll
        for (int j = 0; j < 16; ++j) ss += v[j] * v[j];
        ss = wave_sum64(ss);
        const float rinv = __builtin_amdgcn_rsqf(ss * (1.f / D) + NORM_EPS);
        float* hp = h1out + (size_t)r * D;
#pragma unroll
        for (int j = 0; j < 4; ++j) { const int c = j * 256 + lane * 4; f32x4 hv = hcur[j];
#pragma unroll
            for (int q = 0; q < 4; ++q) hv[q] += gq[4 * j + q] * (v[4 * j + q] * rinv);
            if (!dry) *(f32x4*)(hp + c) = hv; else if (hv[0] == 1.2345e30f) *(f32x4*)(hp + c) = hv; }
    }
}
__device__ __forceinline__ void rwt_prep(const In& in, bf16_t* rwt, int bid, int nblk) {
    for (int i = bid * NT + threadIdx.x; i < NE * D; i += nblk * NT) { const int e = i / D, k = i % D; const float w = in.router_w[(size_t)k * NE + e]; const bf16_t h = f2bf(w); rwt[i] = h; rwt[(size_t)NE * D + i] = f2bf(w - bf2f(h)); }
}
}

using namespace mk;
constexpr size_t MiB = (size_t)1 << 20;
constexpr int NLAT = NB * SEQ, NCTXR = NB * CTX, NALL = NLAT + NCTXR, NRH = NLAT / 2, MAXSLOTS = NRH * SLOTS_PER_TOK + NE * BM;
constexpr size_t O_W1A = 0, O_W1C = O_W1A + (size_t)Z1_N * D * 2, O_WG = O_W1C + (size_t)ZC_N * D * 2, O_WBR = O_WG + (size_t)RW * AG_K * 2, O_WOUT = O_WBR + (size_t)2 * D * RW * 2,
                 O_RWT = O_WOUT + (size_t)D * D * 2, O_MODP = O_RWT + (size_t)2 * NE * D * 2, O_S_END = O_MODP + (size_t)MOD_SL * (NB + 1) * 6 * D * 4;
static_assert(O_S_END <= 27 * MiB, "S region");
constexpr size_t O_BAR = 27 * MiB;
constexpr size_t O_Z1 = 28 * MiB, O_R2 = O_Z1 + (size_t)NALL * Z1_N * 2;
static_assert(O_R2 == 334 * MiB, "z1 size");
constexpr size_t O_HD = O_R2, O_BON = O_HD + (size_t)2 * NLAT * LW * 2, O_AG = O_BON + (size_t)2 * NLAT * NH * 4, O_R2_END = O_AG + (size_t)NLAT * AG_K * 2;
static_assert(O_R2_END <= 512 * MiB, "R2");
constexpr size_t O_XNL = O_Z1, O_YB = O_XNL + (size_t)NLAT * D * 2, O_GATES = O_YB + (size_t)NLAT * LW * 2, O_MIXED = O_HD;
static_assert(O_GATES + (size_t)NLAT * 2 * D * 2 <= O_R2, "late R1");
constexpr size_t O_U = O_Z1, O_WGU = O_U + (size_t)NLAT * D * 2, O_WDN = O_WGU + (size_t)NEX * 2 * EF * D * 2, O_ROUT = O_WDN + (size_t)NEX * D * EF * 2;
constexpr size_t O_TOPE = O_ROUT, O_LRANK = O_TOPE + (size_t)NLAT * TOPK * 4, O_GATEV = O_LRANK + (size_t)NLAT * TOPK * 4, O_BLKCNT = O_GATEV + (size_t)NLAT * TOPK * 4, O_TILEPRE = O_BLKCNT + 256 * 64 * 4,
                 O_LIST = O_TILEPRE + 2048, O_SDST = O_LIST + (size_t)2 * MAXSLOTS * 4, O_SGATE = O_SDST + (size_t)2 * MAXSLOTS * 4, O_ACT = ((O_SGATE + (size_t)2 * MAXSLOTS * 4 + 255) / 256) * 256,
                 O_ROWSB = ((O_ACT + (size_t)MAXSLOTS * EF * 2 + 255) / 256) * 256, O_END = O_ROWSB + ((size_t)NRH * SLOTS_PER_TOK + 1) * D * 2;
static_assert(O_END <= 512 * MiB, "workspace");
constexpr size_t O_U8 = O_WGU + (size_t)NEX * 2 * EF * D;
static_assert(O_U8 + (size_t)NLAT * D <= O_WDN, "u8");
static_assert(O_WGU >= O_YB && O_ROWSB >= O_GATES, "late layout");

struct MP { In in; float* out; unsigned char* ws; long ph_lo, ph_hi; };
constexpr int NPHASE = 16;

#if defined(__HIP_DEVICE_COMPILE__)
#define MK_KARGS auto Pq_ = Pk_; asm volatile("" : "+s"(Pq_)); const MP* Pg_ = (const MP*)Pq_; const In in = Pg_->in; unsigned char* ws = Pg_->ws; float* out_ = Pg_->out; (void)out_;
#else
#define MK_KARGS const In in = P.in; unsigned char* ws = P.ws; float* out_ = P.out; (void)out_; (void)Pk_;
#endif
#define MK_PHASE_PTRS \
    MK_KARGS \
    bf16_t *W1a = (bf16_t*)(ws + O_W1A), *W1c = (bf16_t*)(ws + O_W1C), *Wg = (bf16_t*)(ws + O_WG), *Wbr = (bf16_t*)(ws + O_WBR), *Wout = (bf16_t*)(ws + O_WOUT), *rwt = (bf16_t*)(ws + O_RWT); \
    float* modpart = (float*)(ws + O_MODP); \
    bf16_t *z1 = (bf16_t*)(ws + O_Z1), *Hd = (bf16_t*)(ws + O_HD), *Ag = (bf16_t*)(ws + O_AG); float* bon = (float*)(ws + O_BON); \
    bf16_t *xnl = (bf16_t*)(ws + O_XNL), *yb = (bf16_t*)(ws + O_YB), *gates = (bf16_t*)(ws + O_GATES), *mixed = (bf16_t*)(ws + O_MIXED); \
    unsigned char* u8 = ws + O_U8; \
    bf16_t *u = (bf16_t*)(ws + O_U), *Wgu = (bf16_t*)(ws + O_WGU), *Wdn = (bf16_t*)(ws + O_WDN), *act = (bf16_t*)(ws + O_ACT), *rowsb = (bf16_t*)(ws + O_ROWSB); \
    int *tope = (int*)(ws + O_TOPE), *lrank = (int*)(ws + O_LRANK), *blkcnt = (int*)(ws + O_BLKCNT), *tilepre = (int*)(ws + O_TILEPRE), *list = (int*)(ws + O_LIST), *sdst = (int*)(ws + O_SDST); \
    float *gatev = (float*)(ws + O_GATEV), *sgate = (float*)(ws + O_SGATE); \
    bf16_t* xn_all = (bf16_t*)out_; \
    bf16_t* Y = (bf16_t*)out_; \
    float* y2h1 = out_;
__device__ __forceinline__ void stagger_start(int bid, int ticks  ) {
    const int grp = (bid >> 3) & 3;
    if (grp) { const unsigned long long t0 = __builtin_amdgcn_s_memrealtime(); while (__builtin_amdgcn_s_memrealtime() - t0 < (unsigned long long)(grp * ticks)) __builtin_amdgcn_s_sleep(8); }
    __builtin_amdgcn_s_waitcnt(0xC07F);
}

__global__ void __launch_bounds__(512, 2) mega(MP P) {
    extern __shared__ __attribute__((aligned(16))) unsigned char shm[];
    LAS unsigned char* lds = (LAS unsigned char*)shm;
    typedef const __attribute__((address_space(4))) MP* KargP;
    const KargP Pk_ = (KargP)__builtin_amdgcn_kernarg_segment_ptr();
    const int bid = blockIdx.x, nblk = gridDim.x;
    const int gbid = (nblk & 7) ? bid : (bid & 7) * (nblk >> 3) + (bid >> 3);
    const int ph_lo = (int)P.ph_lo, ph_hi = (int)P.ph_hi;
    volatile LAS unsigned* xst = (volatile LAS unsigned*)(lds + LDS_BYTES - 16);
    if (threadIdx.x == 0) { xst[0] = 0u; xst[1] = 0u; }
    __syncthreads();
    const XcdBarrier xb = xcd_barrier_post((unsigned*)(P.ws + O_BAR), xst);
    if (0 >= ph_lo && 0 < ph_hi) { if (0 > ph_lo) xcd_barrier(xb); const int ph = 0; (void)ph; MK_PHASE_PTRS
        { LAS float* tile = (LAS float*)lds; int base = 0;
            convT_job<true>(tile, in.w_in, INC, D, W1a, D, Z1_N, CMapZ1{}, bid, nblk, base, 256.f);
            convT_job<true>(tile, in.w_in, INC, D, W1c, D, ZC_N, CMapZC{}, bid, nblk, base, 256.f);
            convT_job(tile, in.rw_g_up, RW, GL, Wg, AG_K, RW, CMapId{}, bid, nblk, base);
            convT_job(tile, in.w_branch_a, D, RW, Wbr, RW, D, CMapId{}, bid, nblk, base);
            convT_job(tile, in.w_branch_b, D, LW, Wbr + (size_t)D * RW, LW, D, CMapId{}, bid, nblk, base);
            convT_job(tile, in.w_out, D, D, Wout, D, D, CMapId{}, bid, nblk, base);
            rwt_prep(in, rwt, bid, nblk);
            mod_partials((LAS float*)lds, in, modpart, bid, nblk); }
    }
    if (1 >= ph_lo && 1 < ph_hi) { if (1 > ph_lo) xcd_barrier(xb); const int ph = 1; (void)ph; MK_PHASE_PTRS
        { const int L = NLAT / nblk, Lc = NCTXR / nblk;
            xn_rows<true>((LAS float*)lds, in, modpart, xn_all, 0, NB, bid * L, (bid + 1) * L);
            xn_rows<true>((LAS float*)lds, in, modpart, xn_all, 0, NB, NLAT + bid * Lc, NLAT + (bid + 1) * Lc); }
    }
    if (2 >= ph_lo && 2 < ph_hi) { if (2 > ph_lo) xcd_barrier(xb); const int ph = 2; (void)ph; MK_PHASE_PTRS
        { GemmP g{xn_all, xn_all, W1a, 0, nullptr, D / 2, 0}; StaticOrder S; S.init(NALL, Z1_N, nblk, bid); gemm_phase<false, true>(lds, g, S, EpiStoreBf16S{z1, Z1_N, 1.f / 4096.f, 0}); }
    }
    if (3 >= ph_lo && 3 < ph_hi) { if (3 > ph_lo) xcd_barrier(xb); const int ph = 3; (void)ph; MK_PHASE_PTRS
        { LruP lp{z1, Hd, 0, NB}; lru_phase(lds, in, lp, bid, nblk); __syncthreads();
                  RwkvP rp{z1, Y, bon, 0, NB}; r3::rwkv_phase3(lds, in, rp, bid, nblk); }
    }
    if (4 >= ph_lo && 4 < ph_hi) { if (4 > ph_lo) xcd_barrier(xb); const int ph = 4; (void)ph; MK_PHASE_PTRS
        { const int L = NLAT / nblk; PostP pp{z1, Y, bon, Ag, NLAT, 0}; rwkv_post_rows((LAS float*)lds, in, pp, bid * L, (bid + 1) * L); }
    }
    if (5 >= ph_lo && 5 < ph_hi) { if (5 > ph_lo) xcd_barrier(xb); const int ph = 5; (void)ph; MK_PHASE_PTRS
        { const int L = NLAT / nblk;
            if (bid & 1) { xn_rows<true>((LAS float*)lds, in, modpart, xnl, 0, NB, bid * L, (bid + 1) * L); __syncthreads(); }
            { GemmP g{Ag, Ag, Wg, 0, nullptr, AG_K, 0}; StaticOrder S; S.init(NLAT, RW, nblk, bid); gemm_phase(lds, g, S, EpiYa{Y, Y + (size_t)NLAT * RW}); }
            if (!(bid & 1)) { __syncthreads(); xn_rows<true>((LAS float*)lds, in, modpart, xnl, 0, NB, bid * L, (bid + 1) * L); } }
    }
    if (6 >= ph_lo && 6 < ph_hi) { if (6 > ph_lo) xcd_barrier(xb); const int ph = 6; (void)ph; MK_PHASE_PTRS
        { GemmP g{xnl, xnl, W1c, 0, nullptr, D / 2, 0}; StaticOrder S; S.init(NLAT, ZC_N, nblk, bid); gemm_phase<false, true>(lds, g, S, EpiZc{Hd, yb, gates, NLAT, 1.f / 4096.f}); }
    }
    if (7 >= ph_lo && 7 < ph_hi) { if (7 > ph_lo) xcd_barrier(xb); const int ph = 7; (void)ph; MK_PHASE_PTRS
        { GemmP g{Y + (size_t)NLAT * RW, yb, Wbr, (long)D * RW, nullptr, D, 0}; PairOrder S; S.S.init(NLAT, D, nblk, bid); gemm_phase(lds, g, S, EpiBranch{gates, mixed}); }
    }
    if (8 >= ph_lo && 8 < ph_hi) { if (8 > ph_lo) xcd_barrier(xb); const int ph = 8; (void)ph; MK_PHASE_PTRS
        { LAS float* tile = (LAS float*)lds;
            struct MGU { const float* ex; const float* sh; unsigned char* d; __device__ const float* src(int m) const { return m < NE ? ex + (size_t)m * D * 2 * EF : sh; } __device__ unsigned char* dst(int m) const { return d + (size_t)m * 2 * EF * D; } };
            struct MDN { const float* ex; const float* sh; unsigned char* d; __device__ const float* src(int m) const { return m < NE ? ex + (size_t)m * EF * D : sh; } __device__ unsigned char* dst(int m) const { return d + (size_t)m * D * EF; } };
            auto conv = [&]() __attribute__((always_inline)) {
                convT_multi<true>(tile, MGU{in.ex_w_gu, in.sh_w_gu, (unsigned char*)Wgu}, NEX, 2 * EF, D, D, 2 * EF, CMapGU{EF}, bid, nblk, FP8_SW);
                convT_multi<true>(tile, MDN{in.ex_w_down, in.sh_w_down, (unsigned char*)Wdn}, NEX, D, EF, EF, D, CMapId{}, bid, nblk, FP8_SWD); };
            if (bid & 1) { conv(); __syncthreads(); }
            { GemmP g{mixed, mixed, Wout, 0, nullptr, D, 0}; StaticOrder S; S.init(NLAT, D, nblk, bid); gemm_phase(lds, g, S, EpiStoreBf16{u, D}); }
            if (!(bid & 1)) { __syncthreads(); conv(); } }
    }
    if (9 >= ph_lo && 9 < ph_hi) { if (9 > ph_lo) xcd_barrier(xb); const int ph = 9; (void)ph; MK_PHASE_PTRS
        { const int L = NLAT / nblk; RowP rp{y2h1, u, u8, modpart, rwt, tope, gatev, lrank, blkcnt, 0, NLAT}; row_pass(lds, in, rp, bid * L, (bid + 1) * L); }
    }
    if (10 >= ph_lo && 10 < ph_hi) { if (10 > ph_lo) xcd_barrier(xb); const int ph = 10; (void)ph; MK_PHASE_PTRS
        { const int q = ph - 10, half = q >= 4 ? 1 : 0, st = q - 4 * half;
            const int rpb = NLAT / nblk;
            auto assign = [&](int hf) { MoeP mp{tope, gatev, lrank, blkcnt, tilepre + hf * 256, list + (size_t)hf * MAXSLOTS, sdst + (size_t)hf * MAXSLOTS, sgate + (size_t)hf * MAXSLOTS, hf * NRH, NRH, hf * (nblk / 2), nblk / 2, rpb, 0}; moe_assign(lds, mp, bid, nblk); };
            auto fin = [&](int hf) { const int L = NRH / nblk, r0 = hf * NRH; final_rows((LAS float*)lds, in, modpart, rowsb, y2h1, 0, r0, r0 + bid * L, r0 + (bid + 1) * L); };
            if (ph == 10) { assign(0); __syncthreads(); assign(1); }
            else if (ph == 11 || ph == 13) { const int hf = ph == 13 ? 1 : 0;
                if (ph == 13 && (bid & 1)) { fin(0); __syncthreads(); }
                { GemmP g{(const bf16_t*)u8, (const bf16_t*)u8, Wgu, (long)EF * D, list + (size_t)hf * MAXSLOTS, D / 2, 0}; GroupOrder S; S.init(tilepre + hf * 256, 2 * EF / BM, nblk, gbid); gemm_phase<true, true>(lds, g, S, EpiGU{act}); }
                if (ph == 13 && !(bid & 1)) { __syncthreads(); fin(0); } }
            else if (ph == 12 || ph == 14) { const int hf = ph == 14 ? 1 : 0;
                GemmP g{act, act, Wdn, (long)D * EF / 2, nullptr, EF / 2, 0}; GroupOrder S; S.init(tilepre + hf * 256, D / BM, nblk, gbid); gemm_phase<false, true>(lds, g, S, EpiDown{sdst + (size_t)hf * MAXSLOTS, sgate + (size_t)hf * MAXSLOTS, rowsb, lds}); }
            else if (ph == 15) fin(1);
            (void)half; (void)st; }
    }
    if (11 >= ph_lo && 11 < ph_hi) { if (11 > ph_lo) xcd_barrier(xb); const int ph = 11; (void)ph; MK_PHASE_PTRS
        { const int q = ph - 10, half = q >= 4 ? 1 : 0, st = q - 4 * half;
            const int rpb = NLAT / nblk;
            auto assign = [&](int hf) { MoeP mp{tope, gatev, lrank, blkcnt, tilepre + hf * 256, list + (size_t)hf * MAXSLOTS, sdst + (size_t)hf * MAXSLOTS, sgate + (size_t)hf * MAXSLOTS, hf * NRH, NRH, hf * (nblk / 2), nblk / 2, rpb, 0}; moe_assign(lds, mp, bid, nblk); };
            auto fin = [&](int hf) { const int L = NRH / nblk, r0 = hf * NRH; final_rows((LAS float*)lds, in, modpart, rowsb, y2h1, 0, r0, r0 + bid * L, r0 + (bid + 1) * L); };
            if (ph == 10) { assign(0); __syncthreads(); assign(1); }
            else if (ph == 11 || ph == 13) { const int hf = ph == 13 ? 1 : 0;
                if (ph == 13 && (bid & 1)) { fin(0); __syncthreads(); }
                { GemmP g{(const bf16_t*)u8, (const bf16_t*)u8, Wgu, (long)EF * D, list + (size_t)hf * MAXSLOTS, D / 2, 0}; GroupOrder S; S.init(tilepre + hf * 256, 2 * EF / BM, nblk, gbid); gemm_phase<true, true>(lds, g, S, EpiGU{act}); }
                if (ph == 13 && !(bid & 1)) { __syncthreads(); fin(0); } }
            else if (ph == 12 || ph == 14) { const int hf = ph == 14 ? 1 : 0;
                GemmP g{act, act, Wdn, (long)D * EF / 2, nullptr, EF / 2, 0}; GroupOrder S; S.init(tilepre + hf * 256, D / BM, nblk, gbid); gemm_phase<false, true>(lds, g, S, EpiDown{sdst + (size_t)hf * MAXSLOTS, sgate + (size_t)hf * MAXSLOTS, rowsb, lds}); }
            else if (ph == 15) fin(1);
            (void)half; (void)st; }
    }
    if (12 >= ph_lo && 12 < ph_hi) { if (12 > ph_lo) xcd_barrier(xb); const int ph = 12; (void)ph; MK_PHASE_PTRS
        { const int q = ph - 10, half = q >= 4 ? 1 : 0, st = q - 4 * half;
            const int rpb = NLAT / nblk;
            auto assign = [&](int hf) { MoeP mp{tope, gatev, lrank, blkcnt, tilepre + hf * 256, list + (size_t)hf * MAXSLOTS, sdst + (size_t)hf * MAXSLOTS, sgate + (size_t)hf * MAXSLOTS, hf * NRH, NRH, hf * (nblk / 2), nblk / 2, rpb, 0}; moe_assign(lds, mp, bid, nblk); };
            auto fin = [&](int hf) { const int L = NRH / nblk, r0 = hf * NRH; final_rows((LAS float*)lds, in, modpart, rowsb, y2h1, 0, r0, r0 + bid * L, r0 + (bid + 1) * L); };
            if (ph == 10) { assign(0); __syncthreads(); assign(1); }
            else if (ph == 11 || ph == 13) { const int hf = ph == 13 ? 1 : 0;
                if (ph == 13 && (bid & 1)) { fin(0); __syncthreads(); }
                { GemmP g{(const bf16_t*)u8, (const bf16_t*)u8, Wgu, (long)EF * D, list + (size_t)hf * MAXSLOTS, D / 2, 0}; GroupOrder S; S.init(tilepre + hf * 256, 2 * EF / BM, nblk, gbid); gemm_phase<true, true>(lds, g, S, EpiGU{act}); }
                if (ph == 13 && !(bid & 1)) { __syncthreads(); fin(0); } }
            else if (ph == 12 || ph == 14) { const int hf = ph == 14 ? 1 : 0;
                GemmP g{act, act, Wdn, (long)D * EF / 2, nullptr, EF / 2, 0}; GroupOrder S; S.init(tilepre + hf * 256, D / BM, nblk, gbid); gemm_phase<false, true>(lds, g, S, EpiDown{sdst + (size_t)hf * MAXSLOTS, sgate + (size_t)hf * MAXSLOTS, rowsb, lds}); }
            else if (ph == 15) fin(1);
            (void)half; (void)st; }
    }
    if (13 >= ph_lo && 13 < ph_hi) { if (13 > ph_lo) xcd_barrier(xb); const int ph = 13; (void)ph; MK_PHASE_PTRS
        { const int q = ph - 10, half = q >= 4 ? 1 : 0, st = q - 4 * half;
            const int rpb = NLAT / nblk;
            auto assign = [&](int hf) { MoeP mp{tope, gatev, lrank, blkcnt, tilepre + hf * 256, list + (size_t)hf * MAXSLOTS, sdst + (size_t)hf * MAXSLOTS, sgate + (size_t)hf * MAXSLOTS, hf * NRH, NRH, hf * (nblk / 2), nblk / 2, rpb, 0}; moe_assign(lds, mp, bid, nblk); };
            auto fin = [&](int hf) { const int L = NRH / nblk, r0 = hf * NRH; final_rows((LAS float*)lds, in, modpart, rowsb, y2h1, 0, r0, r0 + bid * L, r0 + (bid + 1) * L); };
            if (ph == 10) { assign(0); __syncthreads(); assign(1); }
            else if (ph == 11 || ph == 13) { const int hf = ph == 13 ? 1 : 0;
                if (ph == 13 && (bid & 1)) { fin(0); __syncthreads(); }
                { GemmP g{(const bf16_t*)u8, (const bf16_t*)u8, Wgu, (long)EF * D, list + (size_t)hf * MAXSLOTS, D / 2, 0}; GroupOrder S; S.init(tilepre + hf * 256, 2 * EF / BM, nblk, gbid); gemm_phase<true, true>(lds, g, S, EpiGU{act}); }
                if (ph == 13 && !(bid & 1)) { __syncthreads(); fin(0); } }
            else if (ph == 12 || ph == 14) { const int hf = ph == 14 ? 1 : 0;
                GemmP g{act, act, Wdn, (long)D * EF / 2, nullptr, EF / 2, 0}; GroupOrder S; S.init(tilepre + hf * 256, D / BM, nblk, gbid); gemm_phase<false, true>(lds, g, S, EpiDown{sdst + (size_t)hf * MAXSLOTS, sgate + (size_t)hf * MAXSLOTS, rowsb, lds}); }
            else if (ph == 15) fin(1);
            (void)half; (void)st; }
    }
    if (14 >= ph_lo && 14 < ph_hi) { if (14 > ph_lo) xcd_barrier(xb); const int ph = 14; (void)ph; MK_PHASE_PTRS
        { const int q = ph - 10, half = q >= 4 ? 1 : 0, st = q - 4 * half;
            const int rpb = NLAT / nblk;
            auto assign = [&](int hf) { MoeP mp{tope, gatev, lrank, blkcnt, tilepre + hf * 256, list + (size_t)hf * MAXSLOTS, sdst + (size_t)hf * MAXSLOTS, sgate + (size_t)hf * MAXSLOTS, hf * NRH, NRH, hf * (nblk / 2), nblk / 2, rpb, 0}; moe_assign(lds, mp, bid, nblk); };
            auto fin = [&](int hf) { const int L = NRH / nblk, r0 = hf * NRH; final_rows((LAS float*)lds, in, modpart, rowsb, y2h1, 0, r0, r0 + bid * L, r0 + (bid + 1) * L); };
            if (ph == 10) { assign(0); __syncthreads(); assign(1); }
            else if (ph == 11 || ph == 13) { const int hf = ph == 13 ? 1 : 0;
                if (ph == 13 && (bid & 1)) { fin(0); __syncthreads(); }
                { GemmP g{(const bf16_t*)u8, (const bf16_t*)u8, Wgu, (long)EF * D, list + (size_t)hf * MAXSLOTS, D / 2, 0}; GroupOrder S; S.init(tilepre + hf * 256, 2 * EF / BM, nblk, gbid); gemm_phase<true, true>(lds, g, S, EpiGU{act}); }
                if (ph == 13 && !(bid & 1)) { __syncthreads(); fin(0); } }
            else if (ph == 12 || ph == 14) { const int hf = ph == 14 ? 1 : 0;
                GemmP g{act, act, Wdn, (long)D * EF / 2, nullptr, EF / 2, 0}; GroupOrder S; S.init(tilepre + hf * 256, D / BM, nblk, gbid); gemm_phase<false, true>(lds, g, S, EpiDown{sdst + (size_t)hf * MAXSLOTS, sgate + (size_t)hf * MAXSLOTS, rowsb, lds}); }
            else if (ph == 15) fin(1);
            (void)half; (void)st; }
    }
    if (15 >= ph_lo && 15 < ph_hi) { if (15 > ph_lo) xcd_barrier(xb); const int ph = 15; (void)ph; MK_PHASE_PTRS
        { const int q = ph - 10, half = q >= 4 ? 1 : 0, st = q - 4 * half;
            const int rpb = NLAT / nblk;
            auto assign = [&](int hf) { MoeP mp{tope, gatev, lrank, blkcnt, tilepre + hf * 256, list + (size_t)hf * MAXSLOTS, sdst + (size_t)hf * MAXSLOTS, sgate + (size_t)hf * MAXSLOTS, hf * NRH, NRH, hf * (nblk / 2), nblk / 2, rpb, 0}; moe_assign(lds, mp, bid, nblk); };
            auto fin = [&](int hf) { const int L = NRH / nblk, r0 = hf * NRH; final_rows((LAS float*)lds, in, modpart, rowsb, y2h1, 0, r0, r0 + bid * L, r0 + (bid + 1) * L); };
            if (ph == 10) { assign(0); __syncthreads(); assign(1); }
            else if (ph == 11 || ph == 13) { const int hf = ph == 13 ? 1 : 0;
                if (ph == 13 && (bid & 1)) { fin(0); __syncthreads(); }
                { GemmP g{(const bf16_t*)u8, (const bf16_t*)u8, Wgu, (long)EF * D, list + (size_t)hf * MAXSLOTS, D / 2, 0}; GroupOrder S; S.init(tilepre + hf * 256, 2 * EF / BM, nblk, gbid); gemm_phase<true, true>(lds, g, S, EpiGU{act}); }
                if (ph == 13 && !(bid & 1)) { __syncthreads(); fin(0); } }
            else if (ph == 12 || ph == 14) { const int hf = ph == 14 ? 1 : 0;
                GemmP g{act, act, Wdn, (long)D * EF / 2, nullptr, EF / 2, 0}; GroupOrder S; S.init(tilepre + hf * 256, D / BM, nblk, gbid); gemm_phase<false, true>(lds, g, S, EpiDown{sdst + (size_t)hf * MAXSLOTS, sgate + (size_t)hf * MAXSLOTS, rowsb, lds}); }
            else if (ph == 15) fin(1);
            (void)half; (void)st; }
    }
}
extern "C" void kernel_launch(void* const* d_in, const int* in_sizes, int n_in, void* d_out, int out_size, void* d_ws, size_t ws_size, hipStream_t stream) {
    static int grid = 0;
    if (grid == 0) {
        int dev = 0, cus = 0; hipGetDevice(&dev); hipDeviceGetAttribute(&cus, hipDeviceAttributeMultiprocessorCount, dev);
        hipFuncSetAttribute((const void*)mega, hipFuncAttributeMaxDynamicSharedMemorySize, LDS_BYTES);
        grid = cus;
        if (ws_size < O_END || grid != 256) fprintf(stderr, "kernel_launch: unexpected ws_size %zu (need %zu) or CU count %d\n", ws_size, (size_t)O_END, grid);
    }
    hipMemsetAsync((char*)d_ws + O_BAR, 0, XCD_BAR_WORDS * 4, stream);
    MP P; memset(&P, 0, sizeof(P));
    const float** f = (const float**)&P.in; for (int i = 0; i < 32; ++i) f[i] = (const float*)d_in[i];
    P.out = (float*)d_out; P.ws = (unsigned char*)d_ws;
#ifdef MK_PER_PHASE
    for (int ph = 0; ph < NPHASE; ++ph) { P.ph_lo = ph; P.ph_hi = ph + 1; hipLaunchKernelGGL(mega, dim3(grid), dim3(NT), LDS_BYTES, stream, P); }
#else
    P.ph_lo = 0; P.ph_hi = NPHASE;
    void* args[] = {&P};
    hipError_t e = hipLaunchCooperativeKernel((void*)mega, dim3(grid), dim3(NT), args, LDS_BYTES, stream);
    if (e != hipSuccess) fprintf(stderr, "cooperative launch failed: %s (grid %d)\n", hipGetErrorString(e), grid);
#endif
}
```

```cpp
#include <hip/hip_runtime.h>
#include <cstdio>
#include <cstring>
#define HD __host__ __device__ __forceinline__
static hipStream_t g_stream;

#ifdef SMALL
constexpr int D = 128, NB = 2, SEQ = 64, GW = 8, CTX = 16, RW = 128, RH = 64, DL = 16, AL = 16, GL = 24, LW = 128, LB = 2, NE = 8, TOPK = 3, NG = 4, TG = 2, EF = 32, SF = 32;
#else
constexpr int D = 1024, NB = 8, SEQ = 4096, GW = 64, CTX = 256, RW = 1024, RH = 64, DL = 64, AL = 64, GL = 160, LW = 1024, LB = 16, NE = 64, TOPK = 6, NG = 8, TG = 4, EF = 256, SF = 256;
#endif
constexpr int NH = RW / RH, LBS = LW / LB, ROWS = SEQ / GW, TA = CTX + SEQ;
constexpr int OFF_R = 0, OFF_K = RW, OFF_V = 2 * RW, OFF_WD = 3 * RW, OFF_AD = OFF_WD + 2 * DL, OFF_GD = OFF_AD + 2 * AL, RC = OFF_GD + GL;
constexpr int OFF_LX = RC, OFF_LG = OFF_LX + LW, OFF_GATE = OFF_LG + LW, INC = OFF_GATE + 2 * D;
constexpr int EPG = NE / NG, NASG = SEQ * TOPK;
#define NORM_EPS 1e-6f
#define LNX_EPS 64e-5f

HD float sigmoidf_(float x) { return 1.f / (1.f + expf(-x)); }
HD float softplusf_(float x) { return x > 20.f ? x : log1pf(expf(x)); }
HD float siluf_(float x) { return x * sigmoidf_(x); }
HD float gelu_tanhf_(float x) { return 0.5f * x * (1.f + tanhf(0.7978845608028654f * (x + 0.044715f * x * x * x))); }

struct In {
    const float *x, *c, *ctx, *c_ctx, *w_mod, *b_mod, *norm_g, *w_in, *shift_mu, *rw_w0, *rw_w_up, *rw_a0, *rw_a_up, *rw_g_up, *rw_k_k, *rw_k_a, *rw_r_k, *rw_lnx,
        *lru_conv_w, *lru_conv_b, *lru_gate_w, *lru_gate_b, *lru_l, *w_branch_a, *w_branch_b, *w_out, *router_w, *router_b, *ex_w_gu, *ex_w_down, *sh_w_gu, *sh_w_down;
};


namespace mk {
#define LAS __attribute__((address_space(3)))
typedef unsigned short bf16_t;
typedef short bf16x8 __attribute__((ext_vector_type(8)));
typedef float f32x4 __attribute__((ext_vector_type(4)));
typedef float f32x2 __attribute__((ext_vector_type(2)));
typedef int i32x4 __attribute__((ext_vector_type(4)));
typedef int i32x8 __attribute__((ext_vector_type(8)));
typedef unsigned u32x4 __attribute__((ext_vector_type(4)));
typedef unsigned u32x2 __attribute__((ext_vector_type(2)));
constexpr int NT = 512;
constexpr int BM = 256, BK = 64, HALF = 128, HTB = HALF * BK * 2, STAGE_BYTES = 8 * HTB;
constexpr int LDS_BYTES = 160 * 1024 - 1024;

constexpr int Z1_LX = 3584, Z1_N = 4608;
constexpr int ZC_N = 3072;

__device__ __forceinline__ unsigned cvt_pk_bf16(float lo, float hi) { unsigned r; asm volatile("s_nop 0\n\tv_cvt_pk_bf16_f32 %0, %1, %2" : "=v"(r) : "v"(lo), "v"(hi)); return r; }
__device__ __forceinline__ bf16_t f2bf(float f) { unsigned u = __float_as_uint(f); u += 0x7FFFu + ((u >> 16) & 1u); return (bf16_t)(u >> 16); }
__device__ __forceinline__ float bf2f(bf16_t b) { return __uint_as_float(((unsigned)b) << 16); }
__device__ __forceinline__ float bflo(unsigned w) { return __uint_as_float(w << 16); }
__device__ __forceinline__ float bfhi(unsigned w) { return __uint_as_float(w & 0xffff0000u); }

#define MK_DPPF(x, ctrl) __int_as_float(__builtin_amdgcn_update_dpp(__float_as_int(x), __float_as_int(x), ctrl, 0xF, 0xF, false))
__device__ __forceinline__ float wave_sum64(float x) {
    x += MK_DPPF(x, 0xB1); x += MK_DPPF(x, 0x4E); x += MK_DPPF(x, 0x141); x += MK_DPPF(x, 0x140);
    const int xi = __float_as_int(x);
    return (__int_as_float(__builtin_amdgcn_readlane(xi, 0)) + __int_as_float(__builtin_amdgcn_readlane(xi, 16))) + (__int_as_float(__builtin_amdgcn_readlane(xi, 32)) + __int_as_float(__builtin_amdgcn_readlane(xi, 48)));
}
__device__ __forceinline__ float wave_max64(float x) {
    x = fmaxf(x, MK_DPPF(x, 0xB1)); x = fmaxf(x, MK_DPPF(x, 0x4E)); x = fmaxf(x, MK_DPPF(x, 0x141)); x = fmaxf(x, MK_DPPF(x, 0x140));
    const int xi = __float_as_int(x);
    return fmaxf(fmaxf(__int_as_float(__builtin_amdgcn_readlane(xi, 0)), __int_as_float(__builtin_amdgcn_readlane(xi, 16))), fmaxf(__int_as_float(__builtin_amdgcn_readlane(xi, 32)), __int_as_float(__builtin_amdgcn_readlane(xi, 48))));
}
__device__ __forceinline__ float fast_rcp(float x) { return __builtin_amdgcn_rcpf(x); }
__device__ __forceinline__ float fast_sigmoid(float x) { return fast_rcp(1.f + __expf(-x)); }
__device__ __forceinline__ float fast_tanh(float x) { return 1.f - 2.f * fast_rcp(1.f + __expf(2.f * x)); }
__device__ __forceinline__ float fast_softplus(float x) { return x > 15.f ? x : __logf(1.f + __expf(x)); }
__device__ __forceinline__ float fast_silu(float x) { return x * fast_sigmoid(x); }
__device__ __forceinline__ float fast_gelu_tanh(float x) { return x * fast_sigmoid(1.5957691216057308f * (x + 0.044715f * x * x * x)); }
__device__ __forceinline__ int lds_byte(int r, int c) { const int st = (r >> 4) * 2 + (c >> 5), rr = r & 15, cc = c & 31, ob = rr * 64 + cc * 2; return st * 1024 + (ob ^ (((ob >> 9) & 1) << 5)); }
__device__ __forceinline__ void stage_rc(int b, int& R, int& C) { const int st = b / 1024, sb = b % 1024, swz = sb ^ (((sb >> 9) & 1) << 5); R = (st >> 1) * 16 + swz / 64; C = (st & 1) * 32 + (swz % 64) / 2; }
__device__ __forceinline__ int perm32(int rho) { const int n = rho >> 4, i = rho & 15; return 8 * (i >> 2) + 4 * n + (i & 3); }

struct Unit { int pm, pn, e; };
struct GemmP { const bf16_t* A0; const bf16_t* A1; const bf16_t* Bt; long strideB; const int* gather; int K; int pad_; };

struct StaticOrder {
    int nM, nN, nwg, G, c;
    __device__ void init(int M, int N, int G_, int c_) { nM = M / BM; nN = N / BM; nwg = nM * nN; G = G_; c = c_; }
    __device__ bool next(int i, Unit& u) const {
        const long L = (long)i * G + c; if (L >= nwg) return false;
        int wgid = (int)L; { const int q = nwg / 8, r = nwg % 8, xcd = wgid % 8, off = wgid / 8; wgid = (xcd < r ? xcd * (q + 1) : r * (q + 1) + (xcd - r) * q) + off; }
        const int nig = 8 * nN, gid = wgid / nig, fm = gid * 8, gsz = (nM - fm) < 8 ? (nM - fm) : 8;
        u.pm = fm + ((wgid % nig) % gsz); u.pn = (wgid % nig) / gsz; u.e = 0; return true;
    }
};

#define MK_FRAG_LOOP(ROW, COL) \
    _Pragma("unroll") for (int ai = 0; ai < 2; ++ai) _Pragma("unroll") for (int m = 0; m < 4; ++m) _Pragma("unroll") for (int bj = 0; bj < 2; ++bj) \
        if (const int ROW = ai * HALF + wr * 64 + m * 16 + fr; true) if (const int COL = bj * HALF + wc * 32 + 8 * fq; true)

template <class E, class = void> struct epi_has_begin { static constexpr bool value = false; };
template <class E> struct epi_has_begin<E, decltype((void)&E::unit_begin)> { static constexpr bool value = true; };
template <bool B> struct BoolC { static constexpr bool value = B; };
template <class E, class = void> struct epi_ns { static constexpr int value = 0; };
template <class E> struct epi_ns<E, decltype((void)E::NS)> { static constexpr int value = 0 * E::NS; };
template <class E> __device__ __forceinline__ void epi_unit_begin(const E& e, const Unit& u, LAS unsigned char* lds) { if constexpr (epi_has_begin<E>::value) e.unit_begin(u, lds); }
template <bool GATHER = false, bool FP8 = false, class Epi, class Sched>
__device__ __forceinline__ void gemm_phase(LAS unsigned char* lds, const GemmP g, const Sched& S, const Epi& E) {
    const int tid = threadIdx.x, wid = __builtin_amdgcn_readfirstlane(tid >> 6), lane = tid & 63, wr = wid >> 2, wc = wid & 3, fr = lane & 15, fq = lane >> 4;
    int K = g.K; asm volatile("" : "+s"(K));
    const int nt = K / BK;
    int RA[2], CA[2]; unsigned voffB[2];
#pragma unroll
    for (int i = 0; i < 2; ++i) { int R, C; stage_rc(tid * 16 + i * 8192, R, C); RA[i] = R; CA[i] = C; const int Rb = (R & ~31) + perm32(R & 31); voffB[i] = (unsigned)(Rb * K + C) * 2u; }
    const size_t kstep = (size_t)(BK * 2), hstepB = (size_t)HALF * K * 2, tstepB = 2 * hstepB;
    const unsigned ldsw = (unsigned)wid * 1024u;
    const int aoff = lds_byte(wr * 64 + fr, fq * 8), boff = lds_byte(wc * 32 + fr, fq * 8);
#define MK_SA(b, h) (((b) * 2 + (h)) * HTB)
#define MK_SB(b, h) ((4 + (b) * 2 + (h)) * HTB)
#define MK_STAGE(bufoff, gbase, voff) do { _Pragma("unroll") for (int _i = 0; _i < 2; ++_i) \
        __builtin_amdgcn_global_load_lds((const unsigned*)((const char*)(gbase) + (voff)[_i]), (LAS unsigned*)(lds + (bufoff) + ldsw + _i * 8192), 16, 0, 0); } while (0)
#define MK_CAT8(x, y) __builtin_shufflevector(__builtin_bit_cast(i32x4, x), __builtin_bit_cast(i32x4, y), 0, 1, 2, 3, 4, 5, 6, 7)
#define MK_LDA(dst, b, h) do { _Pragma("unroll") for (int m = 0; m < 4; ++m) { if constexpr (FP8) dst##8[m] = MK_CAT8(*(const LAS bf16x8*)(lds + MK_SA(b, h) + aoff + m * 2048), *(const LAS bf16x8*)(lds + MK_SA(b, h) + aoff + m * 2048 + 1024)); \
        else { _Pragma("unroll") for (int k = 0; k < 2; ++k) dst[m][k] = *(const LAS bf16x8*)(lds + MK_SA(b, h) + aoff + m * 2048 + k * 1024); } } } while (0)
#define MK_LDB(dst, b, h) do { _Pragma("unroll") for (int n = 0; n < 2; ++n) { if constexpr (FP8) dst##8[n] = MK_CAT8(*(const LAS bf16x8*)(lds + MK_SB(b, h) + boff + n * 2048), *(const LAS bf16x8*)(lds + MK_SB(b, h) + boff + n * 2048 + 1024)); \
        else { _Pragma("unroll") for (int k = 0; k < 2; ++k) dst[n][k] = *(const LAS bf16x8*)(lds + MK_SB(b, h) + boff + n * 2048 + k * 1024); } } } while (0)
#define MK_MMA(ai, bj, At, Bt) do { __builtin_amdgcn_s_setprio(1); _Pragma("unroll") for (int m = 0; m < 4; ++m) _Pragma("unroll") for (int n = 0; n < 2; ++n) { \
        if constexpr (FP8) asm volatile("v_mfma_scale_f32_16x16x128_f8f6f4 %0, %1, %2, %0, %3, %3 op_sel_hi:[0,0,0]" : "+v"(acc[ai][bj][m][n]) : "v"(Bt##8[n]), "v"(At##8[m]), "v"(mx_one));   \
        else { _Pragma("unroll") for (int k = 0; k < 2; ++k) acc[ai][bj][m][n] = __builtin_amdgcn_mfma_f32_16x16x32_bf16(Bt[n][k], At[m][k], acc[ai][bj][m][n], 0, 0, 0); } } \
        __builtin_amdgcn_s_setprio(0); } while (0)
#define MK_WAIT_V(n) asm volatile("s_waitcnt vmcnt(" #n ")" ::: "memory")
#define MK_WAIT_L(n) asm volatile("s_waitcnt lgkmcnt(" #n ")" ::: "memory")
#define MK_BAR __builtin_amdgcn_s_barrier()
#define MK_SCHED __builtin_amdgcn_sched_barrier(0)
    Unit cur, nxt; int ui = 0;
    if (!S.next(0, cur)) return;
    f32x4 acc[2][2][4][2];
#pragma unroll
    for (int a = 0; a < 2; ++a)
#pragma unroll
        for (int b = 0; b < 2; ++b)
#pragma unroll
            for (int m = 0; m < 4; ++m)
#pragma unroll
                for (int n = 0; n < 2; ++n) acc[a][b][m][n] = (f32x4){0.f, 0.f, 0.f, 0.f};
    bf16x8 At[4][2], B0[2][2], B1[2][2];
    i32x8 At8[4], B08[2], B18[2];
    int mx_one = 0x7f7f7f7f; asm volatile("" : "+v"(mx_one));
    unsigned vA[2][2], vAn[2][2];
    const size_t hstepA = GATHER ? 0 : (size_t)HALF * K * 2, tstepA = 2 * (size_t)HALF * K * 2;
    auto a_voff = [&](const Unit& u, unsigned (&vo)[2][2]) {
#pragma unroll
        for (int h = 0; h < 2; ++h)
#pragma unroll
            for (int i = 0; i < 2; ++i) { if (GATHER) { const int row = u.pm * BM + h * HALF + RA[i]; vo[h][i] = (unsigned)((size_t)g.gather[row] * K + CA[i]) * 2u; } else vo[h][i] = (unsigned)(RA[i] * K + CA[i]) * 2u; }
    };
    a_voff(cur, vA);
    const LAS int* GLDS = (const LAS int*)(lds + STAGE_BYTES + 2048);
    auto a_voff_lds = [&](unsigned (&vo)[2][2]) {
#pragma unroll
        for (int h = 0; h < 2; ++h)
#pragma unroll
            for (int i = 0; i < 2; ++i) vo[h][i] = (unsigned)((size_t)GLDS[h * HALF + RA[i]] * K + CA[i]) * 2u;
    };
    auto a_base = [&](const Unit& u) { return (const char*)(u.e ? g.A1 : g.A0) + (GATHER ? (size_t)0 : (size_t)u.pm * tstepA); };
    const char* cA = a_base(cur);
    const char* cB = (const char*)g.Bt + ((size_t)cur.e * g.strideB) * 2 + (size_t)cur.pn * tstepB;
    MK_STAGE(MK_SB(0, 0), cB, voffB); MK_STAGE(MK_SA(0, 0), cA, vA[0]); MK_STAGE(MK_SB(0, 1), cB + hstepB, voffB); MK_STAGE(MK_SA(0, 1), cA + hstepA, vA[1]);
    if (wr == 1) MK_BAR;
    MK_WAIT_V(4); MK_BAR;
    MK_STAGE(MK_SB(1, 0), cB + kstep, voffB); MK_STAGE(MK_SA(1, 0), cA + kstep, vA[0]); MK_STAGE(MK_SB(1, 1), cB + hstepB + kstep, voffB);
    MK_WAIT_V(6); MK_BAR;
    for (;;) {
        epi_unit_begin(E, cur, lds);
        const bool has_next = S.next(ui + 1, nxt);
        if (GATHER && has_next && wid < 4) __builtin_amdgcn_global_load_lds((const unsigned*)g.gather + (size_t)nxt.pm * BM + wid * 64 + lane, (LAS unsigned*)(lds + STAGE_BYTES + 2048 + wid * 256), 4, 0, 0);
        const char* nA = has_next ? a_base(nxt) : cA;
        const char* nB = has_next ? (const char*)g.Bt + ((size_t)nxt.e * g.strideB) * 2 + (size_t)nxt.pn * tstepB : cB;
        for (int t = 0; t < nt; t += 2) {
            const bool last = (t == nt - 2);
            const int relax = (epi_ns<Epi>::value == 16 && t == 0) ? 1 : 0;
#define MK_WAIT_VR do { if constexpr (epi_ns<Epi>::value != 16) MK_WAIT_V(10); else asm volatile("v_cmp_ne_u32_e32 vcc, 0, %0\n\ts_nop 3\n\ts_cbranch_vccnz .Lwr%=\n\ts_waitcnt vmcnt(10)\n.Lwr%=:\n\ts_waitcnt vmcnt(26)" :: "v"(relax) : "vcc", "memory"); } while (0)
            if (GATHER && last) { if (has_next) a_voff_lds(vAn); else {
#pragma unroll
                for (int h = 0; h < 2; ++h)
#pragma unroll
                    for (int i = 0; i < 2; ++i) vAn[h][i] = vA[h][i]; } }
            const char* a1 = cA + (size_t)(t + 1) * kstep;
            const char* a2 = last ? nA : cA + (size_t)(t + 2) * kstep; const char* b2 = last ? nB : cB + (size_t)(t + 2) * kstep;
            const char* a3 = a2 + kstep; const char* b3 = b2 + kstep;
            unsigned v2[2][2];
#pragma unroll
            for (int h = 0; h < 2; ++h)
#pragma unroll
                for (int i = 0; i < 2; ++i) v2[h][i] = (GATHER && last) ? vAn[h][i] : vA[h][i];
            MK_LDB(B0, 0, 0); MK_SCHED; MK_LDA(At, 0, 0); MK_STAGE(MK_SA(1, 1), a1 + hstepA, vA[1]);
            MK_WAIT_VR; MK_WAIT_L(8); MK_BAR; MK_WAIT_L(0); MK_MMA(0, 0, At, B0); MK_BAR; MK_SCHED;
            MK_LDB(B1, 0, 1); MK_STAGE(MK_SB(0, 0), b2, voffB);
            MK_WAIT_VR; MK_BAR; MK_WAIT_L(0); MK_MMA(0, 1, At, B1); MK_BAR;
            MK_LDA(At, 0, 1); MK_STAGE(MK_SA(0, 0), a2, v2[0]);
            MK_BAR; MK_WAIT_L(0); MK_MMA(1, 0, At, B0); MK_BAR; MK_SCHED;
            MK_STAGE(MK_SB(0, 1), b2 + hstepB, voffB);
            MK_WAIT_VR; MK_BAR; MK_MMA(1, 1, At, B1); MK_BAR;
            MK_LDB(B0, 1, 0); MK_SCHED; MK_LDA(At, 1, 0); MK_STAGE(MK_SA(0, 1), a2 + hstepA, v2[1]);
            MK_WAIT_VR; MK_WAIT_L(8); MK_BAR; MK_WAIT_L(0); MK_MMA(0, 0, At, B0); MK_BAR; MK_SCHED;
            MK_LDB(B1, 1, 1); MK_STAGE(MK_SB(1, 0), b3, voffB);
            MK_WAIT_V(10); MK_BAR; MK_WAIT_L(0); MK_MMA(0, 1, At, B1); MK_BAR;
            MK_LDA(At, 1, 1); MK_STAGE(MK_SA(1, 0), a3, v2[0]);
            MK_BAR; MK_WAIT_L(0); MK_MMA(1, 0, At, B0); MK_BAR; MK_SCHED;
            MK_STAGE(MK_SB(1, 1), b3 + hstepB, voffB);
            MK_WAIT_V(10); MK_BAR; MK_MMA(1, 1, At, B1); MK_BAR;
        }
        if constexpr (FP8) asm volatile("s_nop 15\n\ts_nop 15" : "+v"(acc[1][1][0][0]), "+v"(acc[1][1][0][1]), "+v"(acc[1][1][1][0]), "+v"(acc[1][1][1][1]),
                                        "+v"(acc[1][1][2][0]), "+v"(acc[1][1][2][1]), "+v"(acc[1][1][3][0]), "+v"(acc[1][1][3][1]) :: "memory");
        int fr_ = fr, fq_ = fq; asm volatile("" : "+v"(fr_), "+v"(fq_));
        if (wr == 0) MK_BAR;
        const bool keep = E(acc, cur, wr, wc, fr_, fq_);
        if (wr == 1) MK_BAR;
        if (!has_next) break;
        if (!keep) {
#pragma unroll
            for (int a = 0; a < 2; ++a)
#pragma unroll
                for (int b = 0; b < 2; ++b)
#pragma unroll
                    for (int m = 0; m < 4; ++m)
#pragma unroll
                        for (int n = 0; n < 2; ++n) acc[a][b][m][n] = (f32x4){0.f, 0.f, 0.f, 0.f};
        }
        cur = nxt; cA = nA; cB = nB; ++ui;
        if (GATHER) {
#pragma unroll
            for (int h = 0; h < 2; ++h)
#pragma unroll
                for (int i = 0; i < 2; ++i) vA[h][i] = vAn[h][i]; }
    }
    MK_WAIT_V(0);
    if (wr == 0) MK_BAR;
    MK_BAR;
#undef MK_SA
#undef MK_SB
#undef MK_STAGE
#undef MK_LDA
#undef MK_LDB
#undef MK_MMA
#undef MK_CAT8
#undef MK_WAIT_V
#undef MK_WAIT_VR
#undef MK_WAIT_L
#undef MK_BAR
#undef MK_SCHED
}

__device__ __forceinline__ unsigned pack4_fp8(float a, float b, float c, float d) {
    a = fminf(fmaxf(a, -448.f), 448.f); b = fminf(fmaxf(b, -448.f), 448.f); c = fminf(fmaxf(c, -448.f), 448.f); d = fminf(fmaxf(d, -448.f), 448.f);
    int w = __builtin_amdgcn_cvt_pk_fp8_f32(a, b, 0, false); w = __builtin_amdgcn_cvt_pk_fp8_f32(c, d, w, true); return (unsigned)w; }
__device__ __forceinline__ u32x4 pack8(const f32x4 a, const f32x4 b) { u32x4 w; w.x = cvt_pk_bf16(a[0], a[1]); w.y = cvt_pk_bf16(a[2], a[3]); w.z = cvt_pk_bf16(b[0], b[1]); w.w = cvt_pk_bf16(b[2], b[3]); return w; }
struct EpiStoreBf16S {
    bf16_t* O; long ldc; float sc; int pad_;
    __device__ __forceinline__ bool operator()(const f32x4 (&acc)[2][2][4][2], const Unit& u, int wr, int wc, int fr, int fq) const {
        MK_FRAG_LOOP(r, c) { *(u32x4*)(O + (size_t)(u.pm * BM + r) * ldc + u.pn * BM + c) = pack8(acc[ai][bj][m][0] * sc, acc[ai][bj][m][1] * sc); }
        return false;
    }
};
struct EpiStoreBf16 {
    static constexpr int NS = 16;
    bf16_t* O; long ldc;
    __device__ __forceinline__ bool operator()(const f32x4 (&acc)[2][2][4][2], const Unit& u, int wr, int wc, int fr, int fq) const {
        MK_FRAG_LOOP(r, c) { *(u32x4*)(O + (size_t)(u.pm * BM + r) * ldc + u.pn * BM + c) = pack8(acc[ai][bj][m][0], acc[ai][bj][m][1]); }
        return false;
    }
};

struct EpiStorePred {
    bf16_t* O; long ldc;
    __device__ __forceinline__ bool operator()(const f32x4 (&acc)[2][2][4][2], const Unit& u, int wr, int wc, int fr, int fq) const {
        MK_FRAG_LOOP(r, c) { const u32x4 w = pack8(acc[ai][bj][m][0], acc[ai][bj][m][1]); if (w.x == 0x7fc17fc1u && w.w == 0x12345678u) *(u32x4*)(O + (size_t)(u.pm * BM + r) * ldc + u.pn * BM + c) = w; }
        return false;
    }
};
struct EpiStoreLine {
    bf16_t* O; long nunit;
    __device__ __forceinline__ bool operator()(const f32x4 (&acc)[2][2][4][2], const Unit& u, int wr, int wc, int fr, int fq) const {
        const size_t ub = (size_t)((u.pm * 18 + u.pn) % (int)nunit) * (BM * BM); const int wid = wr * 4 + wc, lane = fq * 16 + fr; int f = 0;
        MK_FRAG_LOOP(r, c) { *(u32x4*)(O + ub + ((size_t)(f * 8 + wid) * 64 + lane) * 8) = pack8(acc[ai][bj][m][0], acc[ai][bj][m][1]); ++f; }
        return false;
    }
};
struct EpiNull {
    __device__ __forceinline__ bool operator()(const f32x4 (&acc)[2][2][4][2], const Unit& u, int wr, int wc, int fr, int fq) const {
        MK_FRAG_LOOP(r, c) { asm volatile("" :: "v"(acc[ai][bj][m][0]), "v"(acc[ai][bj][m][1])); }
        return false;
    }
};

__device__ __forceinline__ void ld8_contig(const float* p, float (&o)[8]) { const f32x4 a = *(const f32x4*)p, b = *(const f32x4*)(p + 4); o[0] = a[0]; o[1] = a[1]; o[2] = a[2]; o[3] = a[3]; o[4] = b[0]; o[5] = b[1]; o[6] = b[2]; o[7] = b[3]; }
struct CMapZ1 { __device__ int operator()(int n) const { return n < RC ? n : (n < Z1_LX ? -1 : OFF_LX + (n - Z1_LX)); }
    __device__ __forceinline__ void load8(const float* rowp, int n, float (&o)[8]) const { const int sc = (*this)(n); if (sc >= 0) ld8_contig(rowp + sc, o); else {
#pragma unroll
        for (int j = 0; j < 8; ++j) o[j] = 0.f; } } };
struct CMapZC { __device__ int operator()(int n) const { return OFF_LG + n; }
    __device__ __forceinline__ void load8(const float* rowp, int n, float (&o)[8]) const { ld8_contig(rowp + OFF_LG + n, o); } };
struct CMapId { __device__ int operator()(int n) const { return n; }
    __device__ __forceinline__ void load8(const float* rowp, int n, float (&o)[8]) const { ld8_contig(rowp + n, o); } };
struct CMapGU { int F; __device__ int operator()(int n) const { return (n & 1) * F + (n >> 1); }
    __device__ __forceinline__ void load8(const float* rowp, int n, float (&o)[8]) const { const f32x4 g = *(const f32x4*)(rowp + (n >> 1)), u = *(const f32x4*)(rowp + F + (n >> 1));
        o[0] = g[0]; o[1] = u[0]; o[2] = g[1]; o[3] = u[1]; o[4] = g[2]; o[5] = u[2]; o[6] = g[3]; o[7] = u[3]; } };
constexpr int CT_B = 8;
template <bool OUT8 = false, class CM>
__device__ __forceinline__ void convT_job(LAS float* tile  , const float* src, int lds_, int Ks, bf16_t* dst, int Kd, int N, const CM& cm, int bid, int nblk, int& base, float oscale = 1.f) {
    const int tk = Kd / 64, nt = (N / 64) * tk, tid = threadIdx.x;
    const int first = (bid - base % nblk + nblk) % nblk;
    const int kk = tid >> 3, nn8 = (tid & 7) * 8, nn = tid >> 3, kk8 = (tid & 7) * 8;
    for (int t0 = first; t0 < nt; t0 += CT_B * nblk) {
        float v[CT_B][8];
#pragma unroll
        for (int b = 0; b < CT_B; ++b) { const int t = t0 + b * nblk; const int n0 = (t / tk) * 64, k0 = (t % tk) * 64, k = k0 + kk;
            if (t < nt && k < Ks) cm.load8(src + (size_t)k * lds_, n0 + nn8, v[b]); else {
#pragma unroll
                for (int j = 0; j < 8; ++j) v[b][j] = 0.f; } }
#pragma unroll
        for (int b = 0; b < CT_B; ++b)
#pragma unroll
            for (int j = 0; j < 8; ++j) tile[b * 64 * 65 + kk * 65 + nn8 + j] = v[b][j];
        __syncthreads();
#pragma unroll
        for (int b = 0; b < CT_B; ++b) { const int t = t0 + b * nblk; if (t < nt) { const int n0 = (t / tk) * 64, k0 = (t % tk) * 64; f32x4 a, c;
#pragma unroll
            for (int j = 0; j < 4; ++j) { a[j] = tile[b * 64 * 65 + (kk8 + j) * 65 + nn]; c[j] = tile[b * 64 * 65 + (kk8 + 4 + j) * 65 + nn]; }
            if constexpr (OUT8) { u32x2 w8; w8.x = pack4_fp8(a[0] * oscale, a[1] * oscale, a[2] * oscale, a[3] * oscale); w8.y = pack4_fp8(c[0] * oscale, c[1] * oscale, c[2] * oscale, c[3] * oscale);
                *(u32x2*)((unsigned char*)dst + (size_t)(n0 + nn) * Kd + k0 + kk8) = w8; }
            else *(u32x4*)(dst + (size_t)(n0 + nn) * Kd + k0 + kk8) = pack8(a, c); } }
        __syncthreads();
    }
    base += nt;
}

template <bool OUT8 = false, class CM, class MS>
__device__ __forceinline__ void convT_multi(LAS float* tile, const MS& ms, int nmat, int lds_, int Ks, int Kd, int N, const CM& cm, int bid, int nblk, float oscale = 1.f) {
    const int tk = Kd / 64, tpm = (N / 64) * tk, nt = nmat * tpm, tid = threadIdx.x;
    const int kk = tid >> 3, nn8 = (tid & 7) * 8, nn = tid >> 3, kk8 = (tid & 7) * 8;
    for (int t0 = bid; t0 < nt; t0 += CT_B * nblk) {
        float v[CT_B][8];
#pragma unroll
        for (int b = 0; b < CT_B; ++b) { const int T = t0 + b * nblk, m = T / tpm, t = T % tpm; const int n0 = (t / tk) * 64, k0 = (t % tk) * 64, k = k0 + kk;
            if (T < nt && k < Ks) cm.load8(ms.src(m) + (size_t)k * lds_, n0 + nn8, v[b]); else {
#pragma unroll
                for (int j = 0; j < 8; ++j) v[b][j] = 0.f; } }
#pragma unroll
        for (int b = 0; b < CT_B; ++b)
#pragma unroll
            for (int j = 0; j < 8; ++j) tile[b * 64 * 65 + kk * 65 + nn8 + j] = v[b][j];
        __syncthreads();
#pragma unroll
        for (int b = 0; b < CT_B; ++b) { const int T = t0 + b * nblk; if (T < nt) { const int m = T / tpm, t = T % tpm, n0 = (t / tk) * 64, k0 = (t % tk) * 64; f32x4 a, c;
#pragma unroll
            for (int j = 0; j < 4; ++j) { a[j] = tile[b * 64 * 65 + (kk8 + j) * 65 + nn]; c[j] = tile[b * 64 * 65 + (kk8 + 4 + j) * 65 + nn]; }
            if constexpr (OUT8) { u32x2 w8; w8.x = pack4_fp8(a[0] * oscale, a[1] * oscale, a[2] * oscale, a[3] * oscale); w8.y = pack4_fp8(c[0] * oscale, c[1] * oscale, c[2] * oscale, c[3] * oscale);
                *(u32x2*)((unsigned char*)ms.dst(m) + (size_t)(n0 + nn) * Kd + k0 + kk8) = w8; }
            else *(u32x4*)(ms.dst(m) + (size_t)(n0 + nn) * Kd + k0 + kk8) = pack8(a, c); } }
        __syncthreads();
    }
}

constexpr int MOD_SL = 16, MOD_KS = D / MOD_SL;
__device__ __forceinline__ void mod_partials(LAS float* sl  , const In& in, float* part  , int bid, int nblk) {
    const int ncc = 6 * D / NT, nitem = MOD_SL * ncc;
    for (int it = bid; it < nitem; it += nblk) {
        const int s = it / ncc, j = (it % ncc) * NT + threadIdx.x;
        for (int i = threadIdx.x; i < (NB + 1) * MOD_KS; i += NT) { const int r = i / MOD_KS, k = s * MOD_KS + i % MOD_KS; const float cv = r < NB ? in.c[r * D + k] : in.c_ctx[k]; sl[i] = siluf_(cv); }
        __syncthreads();
        float acc[NB + 1];
#pragma unroll
        for (int r = 0; r <= NB; ++r) acc[r] = 0.f;
        for (int k = 0; k < MOD_KS; ++k) { const float w = in.w_mod[(size_t)(s * MOD_KS + k) * 6 * D + j];
#pragma unroll
            for (int r = 0; r <= NB; ++r) acc[r] += sl[r * MOD_KS + k] * w; }
#pragma unroll
        for (int r = 0; r <= NB; ++r) part[((size_t)s * (NB + 1) + r) * 6 * D + j] = acc[r];
        __syncthreads();
    }
}
__device__ __forceinline__ float mod_value(const In& in, const float* part, int r, int j) {
    float s = in.b_mod[j];
#pragma unroll
    for (int q = 0; q < MOD_SL; ++q) s += part[((size_t)q * (NB + 1) + r) * 6 * D + j];
    return s;
}

template <bool OUT8 = false>
__device__ __forceinline__ void xn_rows(LAS float* sm  , const In& in, const float* part, bf16_t* xn, int b0, int nb, int row_lo, int row_hi, unsigned char* xn2 = nullptr  ) {
    const int nlat = nb * SEQ, wid = threadIdx.x >> 6, lane = threadIdx.x & 63;
    int cur_mr = -1;
    float gp[16];
#pragma unroll
    for (int j = 0; j < 4; ++j)
#pragma unroll
        for (int q = 0; q < 4; ++q) gp[4 * j + q] = in.norm_g[j * 256 + lane * 4 + q];
    auto src_of = [&](int r) __attribute__((always_inline)) { return r < nlat ? in.x + ((size_t)b0 * SEQ + r) * D : in.ctx + ((size_t)b0 * CTX + (r - nlat)) * D; };
    f32x4 nx[4];
    { const int r = row_lo + wid; if (r < row_hi) { const float* src = src_of(r);
#pragma unroll
        for (int j = 0; j < 4; ++j) nx[j] = *(const f32x4*)(src + j * 256 + lane * 4); } }
    for (int rbase = row_lo; rbase < row_hi; rbase += 8) {
        const int mr = rbase < nlat ? b0 + rbase / SEQ : NB;
        if (mr != cur_mr) { __syncthreads(); for (int j = threadIdx.x; j < 2 * D; j += NT) sm[j] = mod_value(in, part, mr, j); __syncthreads(); cur_mr = mr; }
        const int r = rbase + wid; if (r >= row_hi) continue;
        f32x4 v[4]; float ss = 0.f;
#pragma unroll
        for (int j = 0; j < 4; ++j) { v[j] = nx[j]; ss += v[j][0] * v[j][0] + v[j][1] * v[j][1] + v[j][2] * v[j][2] + v[j][3] * v[j][3]; }
        if (r + 8 < row_hi) { const float* src = src_of(r + 8);
#pragma unroll
            for (int j = 0; j < 4; ++j) nx[j] = *(const f32x4*)(src + j * 256 + lane * 4); }
        ss = wave_sum64(ss);
        const float rinv = __builtin_amdgcn_rsqf(ss * (1.f / D) + NORM_EPS);
#pragma unroll
        for (int j = 0; j < 4; ++j) { const int c = j * 256 + lane * 4; float o[4];
#pragma unroll
            for (int q = 0; q < 4; ++q) o[q] = (v[j][q] * rinv * gp[4 * j + q]) * (1.f + sm[D + c + q]) + sm[c + q];
            if constexpr (OUT8) { const unsigned w8 = pack4_fp8(o[0] * 16.f, o[1] * 16.f, o[2] * 16.f, o[3] * 16.f); *(unsigned*)((unsigned char*)xn + (size_t)r * D + c) = w8; if (xn2) *(unsigned*)(xn2 + (size_t)r * D + c) = w8; }
            else { u32x2 w; w.x = cvt_pk_bf16(o[0], o[1]); w.y = cvt_pk_bf16(o[2], o[3]); *(u32x2*)(xn + (size_t)r * D + c) = w; } }
    }
}
}

namespace mk {
#define XB_TMO      128
#define XB_XCNT(j)  (256  + 64 * (j))
#define XB_XSUB(j)  (1280 + 64 * (j))
#define XB_XGEN(j)  (2304 + 64 * (j))
#define XB_TOP      3328
#define XB_TOPGEN   3392
#define XCD_BAR_WORDS 3456
#define XB_SPIN_CAP (1u << 18)
__device__ __forceinline__ unsigned xb_ld(unsigned* p)              { return __hip_atomic_load(p, __ATOMIC_RELAXED, __HIP_MEMORY_SCOPE_AGENT); }
__device__ __forceinline__ unsigned xb_add(unsigned* p, unsigned v) { return __hip_atomic_fetch_add(p, v, __ATOMIC_RELAXED, __HIP_MEMORY_SCOPE_AGENT); }
__device__ __forceinline__ unsigned xb_xcc_id() { return (unsigned)__builtin_amdgcn_s_getreg((3 << 11) | 20) & 0xFu; }
#define XB_SPIN(cond, bar) do { unsigned _sp = 0; while (cond) { __builtin_amdgcn_s_sleep(1); \
    if ((++_sp & 255u) == 0u) { if (xb_ld(&(bar)[XB_TMO])) break; if (_sp > XB_SPIN_CAP) { atomicAdd(&(bar)[XB_TMO], 1u); break; } } } } while (0)
struct XcdBarrier { unsigned* bar; unsigned x; volatile LAS unsigned* st; };
__device__ __forceinline__ XcdBarrier xcd_barrier_post(unsigned* bar, volatile LAS unsigned* st) {
    XcdBarrier b; b.bar = bar; b.x = xb_xcc_id(); b.st = st;
    if (threadIdx.x == 0) (void)xb_add(&bar[XB_XCNT(b.x)], 1u);
    return b;
}
__device__ __forceinline__ void xcd_barrier_complete(unsigned* bar, unsigned x, unsigned& nloc, unsigned& nx) {
    const unsigned G = gridDim.x * gridDim.y * gridDim.z;
    unsigned sum, cnt, mine, sp = 0u;
    for (;;) {
        sum = 0u; cnt = 0u; mine = 0u;
#pragma unroll
        for (unsigned j = 0; j < 16; ++j) { const unsigned c = xb_ld(&bar[XB_XCNT(j)]); sum += c; cnt += (c > 0u) ? 1u : 0u; mine = (j == x) ? c : mine; }
        if (sum == G) break;
        __builtin_amdgcn_s_sleep(1);
        if ((++sp & 255u) == 0u) { if (xb_ld(&bar[XB_TMO])) break; if (sp > XB_SPIN_CAP) { atomicAdd(&bar[XB_TMO], 1u); break; } }
    }
    nloc = mine > 0u ? mine : 1u; nx = cnt > 0u ? cnt : 1u;
}
__device__ __forceinline__ void xcd_barrier(const XcdBarrier& b) {
    asm volatile("s_waitcnt vmcnt(0)" ::: "memory");
    __syncthreads();
    if (threadIdx.x == 0) {
        unsigned* bar = b.bar;
        __builtin_amdgcn_s_waitcnt(0);
        unsigned nloc = b.st[0], nx = b.st[1];
        if (nloc == 0u) { xcd_barrier_complete(bar, b.x, nloc, nx); b.st[0] = nloc; b.st[1] = nx; }
        const unsigned old = xb_add(&bar[XB_XSUB(b.x)], 1u);
        const unsigned gen = old / nloc;
        if (old + 1u == (gen + 1u) * nloc) {
            __builtin_amdgcn_fence(__ATOMIC_RELEASE, "agent");
            asm volatile("s_waitcnt vmcnt(0)" ::: "memory");
            const unsigned og = xb_add(&bar[XB_TOP], 1u);
            const unsigned tg = og / nx;
            if (og + 1u == (tg + 1u) * nx) xb_add(&bar[XB_TOPGEN], 1u);
            else XB_SPIN(xb_ld(&bar[XB_TOPGEN]) == tg, bar);
            __builtin_amdgcn_fence(__ATOMIC_ACQUIRE, "agent");
            xb_add(&bar[XB_XGEN(b.x)], 1u);
            asm volatile("s_waitcnt vmcnt(0)" ::: "memory");
        } else {
            XB_SPIN(xb_ld(&bar[XB_XGEN(b.x)]) == gen, bar);
            __builtin_amdgcn_fence(__ATOMIC_ACQUIRE, "agent");
            asm volatile("s_waitcnt vmcnt(0)" ::: "memory");
        }
    }
    __syncthreads();
}
}

namespace mk {
constexpr int TB = 32;
constexpr int RAWW = 320;
constexpr int RW_RAW = 0;
constexpr int RW_MU = RW_RAW + (TB + 2) * RAWW * 2;
constexpr int RW_WUP = RW_MU + 2 * RAWW * 4;
constexpr int RW_AUP = RW_WUP + 64 * 72 * 2;
constexpr int RW_CST = RW_AUP + 64 * 72 * 2;
constexpr int RW_AWD = RW_CST + 5 * 64 * 4;
constexpr int RW_AAD = RW_AWD + TB * 72 * 2;
constexpr int RW_R = RW_AAD + TB * 72 * 2;
constexpr int RW_KR = RW_R + TB * 64 * 4;
constexpr int RW_LA = RW_KR + TB * 64 * 4;
constexpr int RW_KK = RW_LA + TB * 64 * 4;
constexpr int RW_W = RW_KK + TB * 64 * 4;
constexpr int RW_B = RW_W + TB * 64 * 4;
constexpr int RW_KD = RW_B + TB * 64 * 4;
constexpr int RW_WR = RW_KD + TB * 64 * 4;
constexpr int RW_V = RW_WR + TB * 64 * 4;
constexpr int RW_SC = RW_V + TB * 64 * 4;
constexpr int RW_YO = RW_SC + TB * 2 * 4;
constexpr int RW_BON = RW_YO + TB * 64 * 4;
constexpr int RW_END = RW_BON + TB * 4;
static_assert(RW_END <= LDS_BYTES, "rwkv LDS");

#define MK_DPP(x, ctrl) __int_as_float(__builtin_amdgcn_update_dpp(__float_as_int(x), __float_as_int(x), ctrl, 0xF, 0xF, false))
__device__ __forceinline__ float allreduce16(float x) {
    x += MK_DPP(x, 0xB1); x += MK_DPP(x, 0x4E); x += MK_DPP(x, 0x141); x += MK_DPP(x, 0x140); return x;
}

__device__ __forceinline__ void allreduce16x4(float& a, float& b, float& c, float& d) {
    asm volatile("s_nop 1\n\t"
        "v_add_f32_dpp %0, %0, %0 quad_perm:[1,0,3,2] row_mask:0xf bank_mask:0xf\n\t" "v_add_f32_dpp %1, %1, %1 quad_perm:[1,0,3,2] row_mask:0xf bank_mask:0xf\n\t"
        "v_add_f32_dpp %2, %2, %2 quad_perm:[1,0,3,2] row_mask:0xf bank_mask:0xf\n\t" "v_add_f32_dpp %3, %3, %3 quad_perm:[1,0,3,2] row_mask:0xf bank_mask:0xf\n\t"
        "v_add_f32_dpp %0, %0, %0 quad_perm:[2,3,0,1] row_mask:0xf bank_mask:0xf\n\t" "v_add_f32_dpp %1, %1, %1 quad_perm:[2,3,0,1] row_mask:0xf bank_mask:0xf\n\t"
        "v_add_f32_dpp %2, %2, %2 quad_perm:[2,3,0,1] row_mask:0xf bank_mask:0xf\n\t" "v_add_f32_dpp %3, %3, %3 quad_perm:[2,3,0,1] row_mask:0xf bank_mask:0xf\n\t"
        "v_add_f32_dpp %0, %0, %0 row_half_mirror row_mask:0xf bank_mask:0xf\n\t" "v_add_f32_dpp %1, %1, %1 row_half_mirror row_mask:0xf bank_mask:0xf\n\t"
        "v_add_f32_dpp %2, %2, %2 row_half_mirror row_mask:0xf bank_mask:0xf\n\t" "v_add_f32_dpp %3, %3, %3 row_half_mirror row_mask:0xf bank_mask:0xf\n\t"
        "v_add_f32_dpp %0, %0, %0 row_mirror row_mask:0xf bank_mask:0xf\n\t" "v_add_f32_dpp %1, %1, %1 row_mirror row_mask:0xf bank_mask:0xf\n\t"
        "v_add_f32_dpp %2, %2, %2 row_mirror row_mask:0xf bank_mask:0xf\n\t" "v_add_f32_dpp %3, %3, %3 row_mirror row_mask:0xf bank_mask:0xf"
        : "+v"(a), "+v"(b), "+v"(c), "+v"(d));
}
struct RwkvP { const bf16_t* z1; bf16_t* Y; float* bon; int b0, nb; };

constexpr int RW_NPIECE = (TB + 2) * 40, RW_PPT = (RW_NPIECE + NT - 1) / NT;

__device__ __forceinline__ void rwkv_chain(LAS unsigned char* lds, const In& in, const RwkvP p, int chain) {
    const int tid = threadIdx.x, lane = tid & 63, wid = tid >> 6;
    const int d = chain / (p.nb * NH), bl = (chain / NH) % p.nb, h = chain % NH;
    const int nlat = p.nb * SEQ;
    LAS bf16_t* RAW = (LAS bf16_t*)(lds + RW_RAW); LAS float* MU = (LAS float*)(lds + RW_MU);
    LAS bf16_t* WUP = (LAS bf16_t*)(lds + RW_WUP); LAS bf16_t* AUP = (LAS bf16_t*)(lds + RW_AUP); LAS float* CST = (LAS float*)(lds + RW_CST);
    LAS bf16_t* AWD = (LAS bf16_t*)(lds + RW_AWD); LAS bf16_t* AAD = (LAS bf16_t*)(lds + RW_AAD);
    LAS float *Rr = (LAS float*)(lds + RW_R), *KR = (LAS float*)(lds + RW_KR), *LA_ = (LAS float*)(lds + RW_LA);
    LAS float *KK = (LAS float*)(lds + RW_KK), *Wv = (LAS float*)(lds + RW_W), *Bv = (LAS float*)(lds + RW_B), *KD = (LAS float*)(lds + RW_KD), *WR = (LAS float*)(lds + RW_WR), *Vv = (LAS float*)(lds + RW_V);
    LAS float *SC = (LAS float*)(lds + RW_SC), *YO = (LAS float*)(lds + RW_YO), *BON = (LAS float*)(lds + RW_BON);
    auto segcol = [&](int s) { return s < 3 ? s * RW + h * 64 : (s == 3 ? OFF_WD + d * DL : OFF_AD + d * AL); };
    for (int i = tid; i < 2 * RAWW; i += NT) { const int m = i / RAWW, c = i % RAWW; MU[i] = in.shift_mu[m * RC + segcol(c >> 6) + (c & 63)]; }
    for (int i = tid; i < 64 * 64; i += NT) { const int j = i >> 6, c = i & 63;
        WUP[c * 72 + j] = f2bf(in.rw_w_up[((size_t)d * DL + j) * RW + h * 64 + c]); AUP[c * 72 + j] = f2bf(in.rw_a_up[((size_t)d * AL + j) * RW + h * 64 + c]); }
    for (int i = tid; i < 64; i += NT) { CST[i] = in.rw_w0[d * RW + h * 64 + i]; CST[64 + i] = in.rw_a0[d * RW + h * 64 + i]; CST[128 + i] = in.rw_k_k[h * 64 + i]; CST[192 + i] = in.rw_k_a[h * 64 + i]; CST[256 + i] = in.rw_r_k[h * 64 + i]; }
    constexpr int NQ = (CTX + SEQ) / TB, NQC = CTX / TB;
    auto blk_info = [&](int q, bool& isctx, int& t0, bool& hp, bool& hn, size_t& grow0) {
        isctx = q < NQC;
        if (isctx) { const int qq = d == 0 ? q : NQC - 1 - q; t0 = qq * TB; hp = t0 > 0; hn = t0 + TB < CTX; grow0 = (size_t)nlat + (size_t)bl * CTX + t0; }
        else { const int ql = q - NQC, qq = d == 0 ? ql : SEQ / TB - 1 - ql; t0 = qq * TB; hp = (t0 % GW) != 0; hn = ((t0 + TB) % GW) != 0; grow0 = (size_t)bl * SEQ + t0; }
    };
    u32x4 pre[RW_PPT];
    auto prefetch = [&](int q) {
        bool isctx, hp, hn; int t0; size_t grow0; blk_info(q, isctx, t0, hp, hn, grow0);
#pragma unroll
        for (int k = 0; k < RW_PPT; ++k) { const int i = tid + k * NT; u32x4 v = (u32x4){0u, 0u, 0u, 0u};
            if (i < RW_NPIECE) { const int rr = i / 40, sp = i % 40, seg = sp >> 3, part = sp & 7;
                const bool ok = (rr == 0) ? hp : ((rr == TB + 1) ? hn : true);
                if (ok) v = *(const u32x4*)(p.z1 + (grow0 + rr - 1) * Z1_N + segcol(seg) + part * 8); }
            pre[k] = v; }
    };
    auto commit = [&]() {
#pragma unroll
        for (int k = 0; k < RW_PPT; ++k) { const int i = tid + k * NT; if (i < RW_NPIECE) { const int rr = i / 40, sp = i % 40; *(LAS u32x4*)(RAW + rr * RAWW + sp * 8) = pre[k]; } }
    };
    float S[2][4];
#pragma unroll
    for (int i = 0; i < 2; ++i)
#pragma unroll
        for (int j = 0; j < 4; ++j) S[i][j] = 0.f;
    const int kg = lane & 15, rp = (lane >> 4) + 4 * wid;
    prefetch(0);
    for (int q = 0; q < NQ; ++q) {
        bool isctx, hp, hn; int t0; size_t grow0; blk_info(q, isctx, t0, hp, hn, grow0);
        commit();
        __syncthreads();
        if (q + 1 < NQ) prefetch(q + 1);
        auto shift8 = [&](int t, int c0, float (&s)[8]) {
            const u32x4 xp = *(const LAS u32x4*)(RAW + t * RAWW + c0), xc = *(const LAS u32x4*)(RAW + (t + 1) * RAWW + c0), xn_ = *(const LAS u32x4*)(RAW + (t + 2) * RAWW + c0);
            const f32x4 m0a = *(const LAS f32x4*)(MU + c0), m0b = *(const LAS f32x4*)(MU + c0 + 4), m1a = *(const LAS f32x4*)(MU + RAWW + c0), m1b = *(const LAS f32x4*)(MU + RAWW + c0 + 4);
#pragma unroll
            for (int j = 0; j < 4; ++j) { const unsigned a = xp[j], b = xc[j], c = xn_[j];
                const float mu0l = j < 2 ? m0a[2 * j] : m0b[2 * j - 4], mu0h = j < 2 ? m0a[2 * j + 1] : m0b[2 * j - 3], mu1l = j < 2 ? m1a[2 * j] : m1b[2 * j - 4], mu1h = j < 2 ? m1a[2 * j + 1] : m1b[2 * j - 3];
                { const float x = bflo(b); s[2 * j] = x + mu0l * (bflo(a) - x) + mu1l * (bflo(c) - x); }
                { const float x = bfhi(b); s[2 * j + 1] = x + mu0h * (bfhi(a) - x) + mu1h * (bfhi(c) - x); } } };
        for (int it = tid; it < TB * 24; it += NT) {
            const int t = it / 24, g = it % 24, seg = g >> 3, cc = (g & 7) * 8; float s[8]; shift8(t, g * 8, s);
            LAS float* dst = (seg == 0 ? Rr : (seg == 1 ? KR : Vv)) + t * 64 + cc; *(LAS f32x4*)dst = (f32x4){s[0], s[1], s[2], s[3]}; *(LAS f32x4*)(dst + 4) = (f32x4){s[4], s[5], s[6], s[7]};
        }
        { const int t = tid >> 4, g = 24 + (tid & 15), cc = (g & 7) * 8; float s[8]; shift8(t, g * 8, s);
          const bool isw = (tid & 15) < 8;
#pragma unroll
          for (int j = 0; j < 8; ++j) { const float th = fast_tanh(s[j]); s[j] = isw ? th : s[j]; }
          LAS bf16_t* dst = (isw ? AWD : AAD) + t * 72 + cc;
          u32x4 w; w.x = cvt_pk_bf16(s[0], s[1]); w.y = cvt_pk_bf16(s[2], s[3]); w.z = cvt_pk_bf16(s[4], s[5]); w.w = cvt_pk_bf16(s[6], s[7]); *(LAS u32x4*)dst = w; }
        __syncthreads();
        {
            const int lora = wid >> 2, ct = wid & 3, fr = lane & 15, fq = lane >> 4;
            const LAS bf16_t* Am = lora ? AAD : AWD; const LAS bf16_t* Bm = lora ? AUP : WUP;
#pragma unroll
            for (int rt = 0; rt < 2; ++rt) {
                f32x4 acc = (f32x4){0.f, 0.f, 0.f, 0.f};
#pragma unroll
                for (int ks = 0; ks < 2; ++ks) {
                    const bf16x8 a = *(const LAS bf16x8*)(Am + (rt * 16 + fr) * 72 + ks * 32 + fq * 8);
                    const bf16x8 b = *(const LAS bf16x8*)(Bm + (ct * 16 + fr) * 72 + ks * 32 + fq * 8);
                    acc = __builtin_amdgcn_mfma_f32_16x16x32_bf16(a, b, acc, 0, 0, 0);
                }
                const int col = ct * 16 + fr;
#pragma unroll
                for (int i = 0; i < 4; ++i) { const int t = rt * 16 + fq * 4 + i;
                    if (lora == 0) { const float lw = acc[i] + CST[col]; const float wl = -fast_softplus(-lw) - 0.5f; Wv[t * 64 + col] = __expf(-__expf(wl)); }
                    else { LA_[t * 64 + col] = fast_sigmoid(acc[i] + CST[64 + col]); } }
            }
        }
        __syncthreads();
        {
            const int t = tid >> 4, c4 = (tid & 15) * 4;
            const f32x4 k = *(const LAS f32x4*)(KR + t * 64 + c4), a = *(const LAS f32x4*)(LA_ + t * 64 + c4), w = *(const LAS f32x4*)(Wv + t * 64 + c4), r = *(const LAS f32x4*)(Rr + t * 64 + c4);
            f32x4 kkr, kd, bb, wr; float ss = 0.f, br = 0.f, kr = 0.f, bn = 0.f;
#pragma unroll
            for (int j = 0; j < 4; ++j) { kkr[j] = k[j] * CST[128 + c4 + j]; ss += kkr[j] * kkr[j]; }
            ss = allreduce16(ss);
            const float inv = 1.f / fmaxf(sqrtf(ss), 1e-12f);
#pragma unroll
            for (int j = 0; j < 4; ++j) { const float kk = kkr[j] * inv; kkr[j] = kk; kd[j] = k[j] * (1.f + (a[j] - 1.f) * CST[192 + c4 + j]); bb[j] = kk * a[j]; wr[j] = w[j] * r[j];
                br += bb[j] * r[j]; kr += kd[j] * r[j]; bn += r[j] * kd[j] * CST[256 + c4 + j]; }
            br = allreduce16(br); kr = allreduce16(kr); bn = allreduce16(bn);
            *(LAS f32x4*)(KK + t * 64 + c4) = kkr; *(LAS f32x4*)(KD + t * 64 + c4) = kd; *(LAS f32x4*)(Bv + t * 64 + c4) = bb; *(LAS f32x4*)(WR + t * 64 + c4) = wr;
            if ((tid & 15) == 0) { SC[t * 2] = br; SC[t * 2 + 1] = kr; BON[t] = bn; }
        }
        __syncthreads();
        {
            auto tof = [&](int st) { return d == 0 ? st : TB - 1 - st; };
            const LAS float* lb = KK + 4 * kg;
            const LAS float* vb = Vv + 2 * rp;
            constexpr int OW = (RW_W - RW_KK) / 4, OB = (RW_B - RW_KK) / 4, OKD = (RW_KD - RW_KK) / 4, OWR = (RW_WR - RW_KK) / 4;
            int t = tof(0);
            f32x4 kk4 = *(const LAS f32x4*)(lb + t * 64), w4 = *(const LAS f32x4*)(lb + t * 64 + OW), b4 = *(const LAS f32x4*)(lb + t * 64 + OB),
                  kd4 = *(const LAS f32x4*)(lb + t * 64 + OKD), wr4 = *(const LAS f32x4*)(lb + t * 64 + OWR);
            f32x2 vv = *(const LAS f32x2*)(vb + t * 64), sc = *(const LAS f32x2*)(SC + t * 2);
            f32x2 S2[4];
#pragma unroll
            for (int j = 0; j < 4; ++j) { S2[j][0] = S[0][j]; S2[j][1] = S[1][j]; }
#pragma unroll 2
            for (int st = 0; st < TB; ++st) {
                const int tn = tof(st + 1 < TB ? st + 1 : st);
                const f32x4 nkk4 = *(const LAS f32x4*)(lb + tn * 64), nw4 = *(const LAS f32x4*)(lb + tn * 64 + OW), nb4 = *(const LAS f32x4*)(lb + tn * 64 + OB),
                            nkd4 = *(const LAS f32x4*)(lb + tn * 64 + OKD), nwr4 = *(const LAS f32x4*)(lb + tn * 64 + OWR);
                const f32x2 nvv = *(const LAS f32x2*)(vb + tn * 64), nsc = *(const LAS f32x2*)(SC + tn * 2);
                f32x2 sa2 = S2[0] * kk4[0], yo2 = S2[0] * wr4[0];
#pragma unroll
                for (int j = 1; j < 4; ++j) { sa2 += S2[j] * kk4[j]; yo2 += S2[j] * wr4[j]; }
                float sa0 = sa2[0], sa1 = sa2[1], yo0 = yo2[0], yo1 = yo2[1];
                allreduce16x4(sa0, sa1, yo0, yo1);
                f32x2 sar; sar[0] = sa0; sar[1] = sa1;
#pragma unroll
                for (int j = 0; j < 4; ++j) S2[j] = S2[j] * w4[j] + (vv * kd4[j] - sar * b4[j]);
                if (kg == 0) { f32x2 yor; yor[0] = yo0; yor[1] = yo1; const f32x2 y = yor - sar * sc[0] + vv * sc[1]; *(LAS f32x2*)(YO + t * 64 + 2 * rp) = y; }
                kk4 = nkk4; w4 = nw4; b4 = nb4; kd4 = nkd4; wr4 = nwr4; vv = nvv; sc = nsc; t = tn;
            }
#pragma unroll
            for (int j = 0; j < 4; ++j) { S[0][j] = S2[j][0]; S[1][j] = S2[j][1]; }
        }
        __syncthreads();
        if (!isctx) {
            const int t = tid >> 4, c4 = (tid & 15) * 4; const f32x4 y = *(const LAS f32x4*)(YO + t * 64 + c4);
            u32x2 w; w.x = cvt_pk_bf16(y[0], y[1]); w.y = cvt_pk_bf16(y[2], y[3]);
            *(u32x2*)(p.Y + ((size_t)d * nlat + grow0 + t) * RW + h * 64 + c4) = w;
            if (tid < TB) p.bon[((size_t)d * nlat + grow0 + tid) * NH + h] = BON[tid];
        }
    }
}
__device__ __forceinline__ void rwkv_phase(LAS unsigned char* lds, const In& in, const RwkvP p, int bid, int nblk) {
    const int nchain = 2 * p.nb * NH;
    for (int c = bid; c < nchain; c += nblk) { rwkv_chain(lds, in, p, c); __syncthreads(); }
}
}

namespace mk {
constexpr int C2_RAW = 0;
constexpr int C2_MU = C2_RAW + (TB + 2) * RAWW * 2;
constexpr int C2_WUP = C2_MU + 2 * RAWW * 4;
constexpr int C2_AUP = C2_WUP + 64 * 72 * 2;
constexpr int C2_CST = C2_AUP + 64 * 72 * 2;
constexpr int C2_AWD = C2_CST + 5 * 64 * 4;
constexpr int C2_AAD = C2_AWD + TB * 72 * 2;
constexpr int C2_X = C2_AAD + TB * 72 * 2;
constexpr int C2_R = C2_X, C2_KR = C2_R + TB * 64 * 4, C2_V = C2_KR + TB * 64 * 4, C2_E = C2_V + TB * 64 * 4, C2_LA = C2_E + TB * 64 * 4, C2_CUM = C2_LA + TB * 64 * 4, C2_X_END = C2_CUM + TB * 64 * 4;
constexpr int C2_YO = C2_X;
constexpr int C2_G = C2_YO + TB * 64 * 4;
constexpr int C2_UB = C2_G + 64 * 36 * 4;
constexpr int C2_ABT = C2_UB + 64 * 40 * 2;
constexpr int C2_AKT = C2_ABT + 32 * 32 * 4;
constexpr int C2_NBT = C2_AKT + 32 * 40 * 2;
constexpr int C2_NKT = C2_NBT + 32 * 40 * 2;
static_assert(C2_NKT + 32 * 40 * 2 <= C2_X_END, "region X reuse");
constexpr int C2_KKS = C2_X_END;
constexpr int C2_BS = C2_KKS + TB * 72 * 2, C2_KDS = C2_BS + TB * 72 * 2, C2_RS = C2_KDS + TB * 72 * 2;
constexpr int C2_BST = C2_RS + TB * 72 * 2;
constexpr int C2_KDST = C2_BST + 64 * 40 * 2;
constexpr int C2_VT = C2_KDST + 64 * 40 * 2;
constexpr int C2_S0B = C2_VT + 64 * 40 * 2;
constexpr int C2_GC = C2_S0B + 64 * 72 * 2;
constexpr int C2_BON = C2_GC + 64 * 4;
constexpr int C2_END = C2_BON + TB * 4;
static_assert(C2_END <= LDS_BYTES - 16 && (C2_X % 16) == 0 && (C2_KKS % 16) == 0 && (C2_G % 16) == 0 && (C2_UB % 16) == 0 && (C2_ABT % 16) == 0 && (C2_AKT % 16) == 0 && (C2_S0B % 16) == 0, "rwkv2 LDS");

__device__ __forceinline__ bf16x8 ldsb8(const LAS bf16_t* p) { return *(const LAS bf16x8*)p; }

template <int MODE>
__device__ __forceinline__ void rwkv_chain2(LAS unsigned char* lds, const In& in, const RwkvP p, int chain) {
    const int tid = threadIdx.x, lane = tid & 63, wid = tid >> 6, fr = lane & 15, fq = lane >> 4;
    const int d = chain / (p.nb * NH), bl = (chain / NH) % p.nb, h = chain % NH;
    const int nlat = p.nb * SEQ;
    LAS bf16_t* RAW = (LAS bf16_t*)(lds + C2_RAW); LAS float* MU = (LAS float*)(lds + C2_MU);
    LAS bf16_t* WUP = (LAS bf16_t*)(lds + C2_WUP); LAS bf16_t* AUP = (LAS bf16_t*)(lds + C2_AUP); LAS float* CST = (LAS float*)(lds + C2_CST);
    LAS bf16_t* AWD = (LAS bf16_t*)(lds + C2_AWD); LAS bf16_t* AAD = (LAS bf16_t*)(lds + C2_AAD);
    LAS float *Rr = (LAS float*)(lds + C2_R), *KR = (LAS float*)(lds + C2_KR), *Vv = (LAS float*)(lds + C2_V), *Ee = (LAS float*)(lds + C2_E), *LA_ = (LAS float*)(lds + C2_LA), *CUM = (LAS float*)(lds + C2_CUM);
    LAS float *YO = (LAS float*)(lds + C2_YO), *Gm = (LAS float*)(lds + C2_G), *ABT = (LAS float*)(lds + C2_ABT), *GC = (LAS float*)(lds + C2_GC), *BON = (LAS float*)(lds + C2_BON);
    LAS bf16_t *UB = (LAS bf16_t*)(lds + C2_UB), *AKT = (LAS bf16_t*)(lds + C2_AKT), *NBT = (LAS bf16_t*)(lds + C2_NBT), *NKT = (LAS bf16_t*)(lds + C2_NKT);
    LAS bf16_t *KKS = (LAS bf16_t*)(lds + C2_KKS), *BS = (LAS bf16_t*)(lds + C2_BS), *KDS = (LAS bf16_t*)(lds + C2_KDS), *RS = (LAS bf16_t*)(lds + C2_RS);
    LAS bf16_t *BST = (LAS bf16_t*)(lds + C2_BST), *KDST = (LAS bf16_t*)(lds + C2_KDST), *VT = (LAS bf16_t*)(lds + C2_VT), *S0B = (LAS bf16_t*)(lds + C2_S0B);
    auto segcol = [&](int s) { return s < 3 ? s * RW + h * 64 : (s == 3 ? OFF_WD + d * DL : OFF_AD + d * AL); };
    for (int i = tid; i < 2 * RAWW; i += NT) { const int m = i / RAWW, c = i % RAWW; MU[i] = in.shift_mu[m * RC + segcol(c >> 6) + (c & 63)]; }
    for (int i = tid; i < 64 * 64; i += NT) { const int j = i >> 6, c = i & 63;
        WUP[c * 72 + j] = f2bf(in.rw_w_up[((size_t)d * DL + j) * RW + h * 64 + c]); AUP[c * 72 + j] = f2bf(in.rw_a_up[((size_t)d * AL + j) * RW + h * 64 + c]); }
    for (int i = tid; i < 64; i += NT) { CST[i] = in.rw_w0[d * RW + h * 64 + i]; CST[64 + i] = in.rw_a0[d * RW + h * 64 + i]; CST[128 + i] = in.rw_k_k[h * 64 + i]; CST[192 + i] = in.rw_k_a[h * 64 + i]; CST[256 + i] = in.rw_r_k[h * 64 + i]; }
    for (int i = tid; i < 64 * 72 / 2; i += NT) ((LAS unsigned*)S0B)[i] = 0u;
    constexpr int NQ = (CTX + SEQ) / TB, NQC = CTX / TB;
    auto blk_info = [&](int q, bool& isctx, int& t0, bool& hp, bool& hn, size_t& grow0) {
        isctx = q < NQC;
        if (isctx) { const int qq = d == 0 ? q : NQC - 1 - q; t0 = qq * TB; hp = t0 > 0; hn = t0 + TB < CTX; grow0 = (size_t)nlat + (size_t)bl * CTX + t0; }
        else { const int ql = q - NQC, qq = d == 0 ? ql : SEQ / TB - 1 - ql; t0 = qq * TB; hp = (t0 % GW) != 0; hn = ((t0 + TB) % GW) != 0; grow0 = (size_t)bl * SEQ + t0; }
    };
    u32x4 pre[RW_PPT]; int poff[RW_PPT], plds[RW_PPT], pkind[RW_PPT];
#pragma unroll
    for (int k = 0; k < RW_PPT; ++k) { const int i = tid + k * NT, rr = i / 40, sp = i % 40, seg = sp >> 3, part = sp & 7;
        poff[k] = (rr - 1) * Z1_N + segcol(seg) + part * 8; plds[k] = rr * RAWW + sp * 8; pkind[k] = i >= RW_NPIECE ? 3 : (rr == 0 ? 1 : (rr == TB + 1 ? 2 : 0)); }
    auto prefetch = [&](int q) {
        bool isctx, hp, hn; int t0; size_t grow0; blk_info(q, isctx, t0, hp, hn, grow0);
        const bf16_t* base = p.z1 + grow0 * Z1_N;
#pragma unroll
        for (int k = 0; k < RW_PPT; ++k) { u32x4 v = (u32x4){0u, 0u, 0u, 0u};
            const bool ok = pkind[k] == 0 || (pkind[k] == 1 && hp) || (pkind[k] == 2 && hn);
            if (ok) v = *(const u32x4*)(base + poff[k]);
            pre[k] = v; }
    };
    auto commit = [&]() {
#pragma unroll
        for (int k = 0; k < RW_PPT; ++k) if (pkind[k] != 3) *(LAS u32x4*)(RAW + plds[k]) = pre[k];
    };
    f32x4 Sreg[2];
    Sreg[0] = (f32x4){0.f, 0.f, 0.f, 0.f}; Sreg[1] = Sreg[0];
    const int rt = wid >> 1;
    prefetch(0);
    for (int q = 0; q < NQ; ++q) {
        bool isctx, hp, hn; int t0; size_t grow0; blk_info(q, isctx, t0, hp, hn, grow0);
        commit();
        __syncthreads();
        if (q + 1 < NQ) prefetch(q + 1);
        auto shift8 = [&](int t, int c0, float (&s)[8]) {
            const u32x4 xp = *(const LAS u32x4*)(RAW + t * RAWW + c0), xc = *(const LAS u32x4*)(RAW + (t + 1) * RAWW + c0), xn_ = *(const LAS u32x4*)(RAW + (t + 2) * RAWW + c0);
            const f32x4 m0a = *(const LAS f32x4*)(MU + c0), m0b = *(const LAS f32x4*)(MU + c0 + 4), m1a = *(const LAS f32x4*)(MU + RAWW + c0), m1b = *(const LAS f32x4*)(MU + RAWW + c0 + 4);
#pragma unroll
            for (int j = 0; j < 4; ++j) { const unsigned a = xp[j], b = xc[j], c = xn_[j];
                const float mu0l = j < 2 ? m0a[2 * j] : m0b[2 * j - 4], mu0h = j < 2 ? m0a[2 * j + 1] : m0b[2 * j - 3], mu1l = j < 2 ? m1a[2 * j] : m1b[2 * j - 4], mu1h = j < 2 ? m1a[2 * j + 1] : m1b[2 * j - 3];
                { const float x = bflo(b); s[2 * j] = x + mu0l * (bflo(a) - x) + mu1l * (bflo(c) - x); }
                { const float x = bfhi(b); s[2 * j + 1] = x + mu0h * (bfhi(a) - x) + mu1h * (bfhi(c) - x); } } };
        for (int it = tid; it < TB * 24; it += NT) {
            const int t = it / 24, g = it % 24, seg = g >> 3, cc = (g & 7) * 8, js = d == 0 ? t : TB - 1 - t; float s[8]; shift8(t, g * 8, s);
            LAS float* dst = (seg == 0 ? Rr : (seg == 1 ? KR : Vv)) + js * 64 + cc; *(LAS f32x4*)dst = (f32x4){s[0], s[1], s[2], s[3]}; *(LAS f32x4*)(dst + 4) = (f32x4){s[4], s[5], s[6], s[7]};
        }
        { const int t = tid >> 4, g = 24 + (tid & 15), cc = (g & 7) * 8, js = d == 0 ? t : TB - 1 - t; float s[8]; shift8(t, g * 8, s);
          const bool isw = (tid & 15) < 8;
#pragma unroll
          for (int j = 0; j < 8; ++j) { const float th = fast_tanh(s[j]); s[j] = isw ? th : s[j]; }
          LAS bf16_t* dst = (isw ? AWD : AAD) + js * 72 + cc;
          u32x4 w; w.x = cvt_pk_bf16(s[0], s[1]); w.y = cvt_pk_bf16(s[2], s[3]); w.z = cvt_pk_bf16(s[4], s[5]); w.w = cvt_pk_bf16(s[6], s[7]); *(LAS u32x4*)dst = w; }
        __syncthreads();
        if (MODE == 3) continue;
        {
            const int lora = wid >> 2, ct = wid & 3;
            const LAS bf16_t* Am = lora ? AAD : AWD; const LAS bf16_t* Bm = lora ? AUP : WUP;
            float carry = 0.f;
#pragma unroll
            for (int r2 = 0; r2 < 2; ++r2) {
                f32x4 acc = (f32x4){0.f, 0.f, 0.f, 0.f};
#pragma unroll
                for (int ks = 0; ks < 2; ++ks) acc = __builtin_amdgcn_mfma_f32_16x16x32_bf16(ldsb8(Am + (r2 * 16 + fr) * 72 + ks * 32 + fq * 8), ldsb8(Bm + (ct * 16 + fr) * 72 + ks * 32 + fq * 8), acc, 0, 0, 0);
                const int col = ct * 16 + fr;
                if (lora == 0) {
                    float c[4];
#pragma unroll
                    for (int i = 0; i < 4; ++i) { const float lw = acc[i] + CST[col]; const float e = __expf(-fast_softplus(-lw) - 0.5f); c[i] = i ? c[i - 1] + e : e; }
                    const float tot = c[3];
                    float s1 = tot; { const float y = __shfl_up(s1, 16); s1 += fq >= 1 ? y : 0.f; }
                    float s2 = s1;  { const float z = __shfl_up(s1, 32); s2 += fq >= 2 ? z : 0.f; }
                    const float base = carry + s2 - tot;
#pragma unroll
                    for (int i = 0; i < 4; ++i) CUM[(r2 * 16 + fq * 4 + i) * 64 + col] = base + c[i];
                    carry += __shfl(s2, 48 + fr);
                } else {
#pragma unroll
                    for (int i = 0; i < 4; ++i) LA_[(r2 * 16 + fq * 4 + i) * 64 + col] = fast_sigmoid(acc[i] + CST[64 + col]);
                }
            }
        }
        __syncthreads();
        if (MODE == 2) continue;
        {
            const int j = tid >> 4, c4 = (tid & 15) * 4;
            const f32x4 k = *(const LAS f32x4*)(KR + j * 64 + c4), a = *(const LAS f32x4*)(LA_ + j * 64 + c4), r = *(const LAS f32x4*)(Rr + j * 64 + c4), vv = *(const LAS f32x4*)(Vv + j * 64 + c4);
            const f32x4 cu = *(const LAS f32x4*)(CUM + j * 64 + c4); f32x4 cp = (f32x4){0.f, 0.f, 0.f, 0.f}; if (j > 0) cp = *(const LAS f32x4*)(CUM + (j - 1) * 64 + c4);
            float kkr[4], ss = 0.f, bn = 0.f;
#pragma unroll
            for (int x = 0; x < 4; ++x) { kkr[x] = k[x] * CST[128 + c4 + x]; ss += kkr[x] * kkr[x]; }
            ss = allreduce16(ss);
            const float inv = 1.f / fmaxf(sqrtf(ss), 1e-12f);
            float kks[4], bs[4], kds[4], rs[4];
#pragma unroll
            for (int x = 0; x < 4; ++x) { const float kk = kkr[x] * inv, kd = k[x] * (1.f + (a[x] - 1.f) * CST[192 + c4 + x]), bb = kk * a[x];
                const float g = __expf(-cu[x]), gp = __expf(-cp[x]), ig = __expf(cu[x]);
                kks[x] = kk * gp; bs[x] = bb * ig; kds[x] = kd * ig; rs[x] = r[x] * g; bn += r[x] * kd * CST[256 + c4 + x];
                if (j == TB - 1) GC[c4 + x] = g;
            }
#pragma unroll
            for (int x = 0; x < 4; x += 2) { const unsigned pb = cvt_pk_bf16(bs[x], bs[x + 1]), pk = cvt_pk_bf16(kds[x], kds[x + 1]), pv = cvt_pk_bf16(vv[x], vv[x + 1]);
                BST[(c4 + x) * 40 + j] = (bf16_t)pb; BST[(c4 + x + 1) * 40 + j] = (bf16_t)(pb >> 16); KDST[(c4 + x) * 40 + j] = (bf16_t)pk; KDST[(c4 + x + 1) * 40 + j] = (bf16_t)(pk >> 16);
                VT[(c4 + x) * 40 + j] = (bf16_t)pv; VT[(c4 + x + 1) * 40 + j] = (bf16_t)(pv >> 16); }
            bn = allreduce16(bn);
            u32x2 w; w.x = cvt_pk_bf16(kks[0], kks[1]); w.y = cvt_pk_bf16(kks[2], kks[3]); *(LAS u32x2*)(KKS + j * 72 + c4) = w;
            w.x = cvt_pk_bf16(bs[0], bs[1]); w.y = cvt_pk_bf16(bs[2], bs[3]); *(LAS u32x2*)(BS + j * 72 + c4) = w;
            w.x = cvt_pk_bf16(kds[0], kds[1]); w.y = cvt_pk_bf16(kds[2], kds[3]); *(LAS u32x2*)(KDS + j * 72 + c4) = w;
            w.x = cvt_pk_bf16(rs[0], rs[1]); w.y = cvt_pk_bf16(rs[2], rs[3]); *(LAS u32x2*)(RS + j * 72 + c4) = w;
            if ((tid & 15) == 0) BON[j] = bn;
        }
        __syncthreads();
        if (MODE == 1) continue;
        const int ctg = wid & 1;
        f32x4 accG = (f32x4){0.f, 0.f, 0.f, 0.f}, accY = accG;
        {
            const int pr = wid >> 1, rts = wid & 1;
            const LAS bf16_t* Xm = (pr & 1) ? KDS : BS; const LAS bf16_t* Ym = (pr < 2) ? KKS : RS;
            const bf16x8 a0 = ldsb8(Xm + (rts * 16 + fr) * 72 + fq * 8), a1 = ldsb8(Xm + (rts * 16 + fr) * 72 + 32 + fq * 8);
#pragma unroll
            for (int cts = 0; cts < 2; ++cts) {
                f32x4 acc = (f32x4){0.f, 0.f, 0.f, 0.f};
                acc = __builtin_amdgcn_mfma_f32_16x16x32_bf16(a0, ldsb8(Ym + (cts * 16 + fr) * 72 + fq * 8), acc, 0, 0, 0);
                acc = __builtin_amdgcn_mfma_f32_16x16x32_bf16(a1, ldsb8(Ym + (cts * 16 + fr) * 72 + 32 + fq * 8), acc, 0, 0, 0);
                const int t = cts * 16 + fr, s0 = rts * 16 + fq * 4;
#pragma unroll
                for (int i = 0; i < 4; ++i) { const bool keep = (pr < 2) ? (s0 + i < t) : (s0 + i <= t); acc[i] = keep ? acc[i] : 0.f; }
                if (pr == 0) *(LAS f32x4*)(ABT + t * 32 + s0) = acc;
                else { u32x2 w; w.x = cvt_pk_bf16(acc[0], acc[1]); w.y = cvt_pk_bf16(acc[2], acc[3]); *(LAS u32x2*)((pr == 1 ? AKT : (pr == 2 ? NBT : NKT)) + t * 40 + s0) = w; }
            }
#pragma unroll
            for (int ks = 0; ks < 2; ++ks) { const bf16x8 sa = ldsb8(S0B + (rt * 16 + fr) * 72 + ks * 32 + fq * 8);
                accG = __builtin_amdgcn_mfma_f32_16x16x32_bf16(sa, ldsb8(KKS + (ctg * 16 + fr) * 72 + ks * 32 + fq * 8), accG, 0, 0, 0);
                accY = __builtin_amdgcn_mfma_f32_16x16x32_bf16(sa, ldsb8(RS + (ctg * 16 + fr) * 72 + ks * 32 + fq * 8), accY, 0, 0, 0); }
        }
        __syncthreads();
        {
            const bf16x8 va = ldsb8(VT + (rt * 16 + fr) * 40 + fq * 8);
            accG = __builtin_amdgcn_mfma_f32_16x16x32_bf16(va, ldsb8(AKT + (ctg * 16 + fr) * 40 + fq * 8), accG, 0, 0, 0);
            accY = __builtin_amdgcn_mfma_f32_16x16x32_bf16(va, ldsb8(NKT + (ctg * 16 + fr) * 40 + fq * 8), accY, 0, 0, 0);
#pragma unroll
            for (int i = 0; i < 4; ++i) Gm[(rt * 16 + fq * 4 + i) * 36 + ctg * 16 + fr] = -accG[i];
        }
        __syncthreads();
        if (MODE == 4) continue;
        if (wid < 4) {
            const int v = wid * 16 + (lane >> 2), pq = lane & 3;
            const LAS float* grow = Gm + v * 36;
            f32x4 r0 = *(const LAS f32x4*)(grow + 4 * pq), r1 = *(const LAS f32x4*)(grow + 16 + 4 * pq);
            u32x2 ubo[TB / 4];
            const LAS float* abd = ABT; asm volatile("" : "+v"(abd));
            const LAS float* abq = ABT + 128 * pq; asm volatile("" : "+v"(abq));
            f32x4 dc[3], a0c[4], a1c[4];
            auto ldg = [&](int g, f32x4 (&dd)[3], f32x4 (&aa0)[4], f32x4 (&aa1)[4]) {
#pragma unroll
                for (int x = 0; x < 3; ++x) dd[x] = *(const LAS f32x4*)(abd + (4 * g + 1 + x) * 32 + 4 * g);
#pragma unroll
                for (int jj = 0; jj < 4; ++jj) { if (g < 3) aa0[jj] = *(const LAS f32x4*)(abq + jj * 32 + 4 * g); if (g < 7) aa1[jj] = *(const LAS f32x4*)(abq + (16 + jj) * 32 + 4 * g); } };
            ldg(0, dc, a0c, a1c);
#pragma unroll
            for (int g = 0; g < TB / 4; ++g) {
                f32x4 dn[3], a0n[4], a1n[4];
                if (g + 1 < TB / 4) ldg(g + 1, dn, a0n, a1n);
                __builtin_amdgcn_sched_barrier(0);
                const f32x4 rr = g < 4 ? r0 : r1;
                f32x4 u4;
                u4[0] = rr[0];
                u4[1] = rr[1] - u4[0] * dc[0][0];
                u4[2] = rr[2] - (u4[0] * dc[1][0] + u4[1] * dc[1][1]);
                u4[3] = rr[3] - (u4[0] * dc[2][0] + u4[1] * dc[2][1] + u4[2] * dc[2][2]);
#pragma unroll
                for (int x = 0; x < 4; ++x) { const int ui = __float_as_int(u4[x]); int bi;
                    if ((g & 3) == 0) bi = __builtin_amdgcn_update_dpp(0, ui, 0x00, 0xF, 0xF, true); else if ((g & 3) == 1) bi = __builtin_amdgcn_update_dpp(0, ui, 0x55, 0xF, 0xF, true);
                    else if ((g & 3) == 2) bi = __builtin_amdgcn_update_dpp(0, ui, 0xAA, 0xF, 0xF, true); else bi = __builtin_amdgcn_update_dpp(0, ui, 0xFF, 0xF, 0xF, true);
                    u4[x] = __int_as_float(bi); }
                ubo[g].x = cvt_pk_bf16(u4[0], u4[1]); ubo[g].y = cvt_pk_bf16(u4[2], u4[3]);
                if (g < 3) {
#pragma unroll
                    for (int jj = 0; jj < 4; ++jj) r0[jj] -= u4[0] * a0c[jj][0] + u4[1] * a0c[jj][1] + u4[2] * a0c[jj][2] + u4[3] * a0c[jj][3]; }
                if (g < 7) {
#pragma unroll
                    for (int jj = 0; jj < 4; ++jj) r1[jj] -= u4[0] * a1c[jj][0] + u4[1] * a1c[jj][1] + u4[2] * a1c[jj][2] + u4[3] * a1c[jj][3]; }
                if (g + 1 < TB / 4) {
#pragma unroll
                    for (int x = 0; x < 3; ++x) dc[x] = dn[x];
#pragma unroll
                    for (int jj = 0; jj < 4; ++jj) { a0c[jj] = a0n[jj]; a1c[jj] = a1n[jj]; } }
            }
            if (pq == 0) {
#pragma unroll
                for (int g = 0; g < TB / 4; g += 2) { u32x4 w; w.x = ubo[g].x; w.y = ubo[g].y; w.z = ubo[g + 1].x; w.w = ubo[g + 1].y; *(LAS u32x4*)(UB + v * 40 + 4 * g) = w; } }
        }
        __syncthreads();
        if (MODE == 5) continue;
        {
            const bf16x8 ua = ldsb8(UB + (rt * 16 + fr) * 40 + fq * 8), va = ldsb8(VT + (rt * 16 + fr) * 40 + fq * 8);
            accY = __builtin_amdgcn_mfma_f32_16x16x32_bf16(ua, ldsb8(NBT + (ctg * 16 + fr) * 40 + fq * 8), accY, 0, 0, 0);
            *(LAS f32x4*)(YO + (ctg * 16 + fr) * 64 + rt * 16 + fq * 4) = accY;
#pragma unroll
            for (int cc = 0; cc < 2; ++cc) { const int ct = 2 * (wid & 1) + cc, kcol = ct * 16 + fr;
                f32x4 acc = Sreg[cc];
                acc = __builtin_amdgcn_mfma_f32_16x16x32_bf16(ua, ldsb8(BST + kcol * 40 + fq * 8), acc, 0, 0, 0);
                acc = __builtin_amdgcn_mfma_f32_16x16x32_bf16(va, ldsb8(KDST + kcol * 40 + fq * 8), acc, 0, 0, 0);
                const float g = GC[kcol];
#pragma unroll
                for (int i = 0; i < 4; ++i) acc[i] *= g;
                { const unsigned p0 = cvt_pk_bf16(acc[0], acc[1]), p1 = cvt_pk_bf16(acc[2], acc[3]); LAS bf16_t* sp = S0B + (rt * 16 + fq * 4) * 72 + kcol;
                  sp[0] = (bf16_t)p0; sp[72] = (bf16_t)(p0 >> 16); sp[144] = (bf16_t)p1; sp[216] = (bf16_t)(p1 >> 16); }
                Sreg[cc] = acc; }
        }
        __syncthreads();
        if (!isctx) {
            const int j = tid >> 4, c4 = (tid & 15) * 4, t = d == 0 ? j : TB - 1 - j; const f32x4 y = *(const LAS f32x4*)(YO + j * 64 + c4);
            u32x2 w; w.x = cvt_pk_bf16(y[0], y[1]); w.y = cvt_pk_bf16(y[2], y[3]);
            bf16_t* yb_ = p.Y + ((size_t)d * nlat + grow0) * RW + h * 64;
            *(u32x2*)(yb_ + t * RW + c4) = w;
            if (tid < TB) { const int tt = d == 0 ? tid : TB - 1 - tid; float* bb_ = p.bon + ((size_t)d * nlat + grow0) * NH + h; bb_[tt * NH] = BON[tid]; }
        }
    }
}
template <int MODE = 0>
__device__ __forceinline__ void rwkv_phase2(LAS unsigned char* lds, const In& in, const RwkvP p, int bid, int nblk) {
    const int nchain = 2 * p.nb * NH;
    for (int c = bid; c < nchain; c += nblk) { rwkv_chain2<MODE>(lds, in, p, c); __syncthreads(); }
}
}

namespace mk {
namespace r3 {
constexpr int C2_RAW = 0;
constexpr int C2_MU = C2_RAW + (TB + 2) * RAWW * 2;
constexpr int C2_WUP = C2_MU + 3 * RAWW * 4;
constexpr int C2_AUP = C2_WUP + 64 * 72 * 2;
constexpr int C2_CST = C2_AUP + 64 * 72 * 2;
constexpr int C2_AWD = C2_CST + 5 * 64 * 4;
constexpr int C2_AAD = C2_AWD + TB * 72 * 2;
constexpr int C2_X = C2_AAD + TB * 72 * 2;
constexpr int C2_G = C2_X;
constexpr int C2_UB = C2_G + 64 * 36 * 4;
constexpr int C2_ABT = C2_UB + 64 * 40 * 2;
constexpr int C2_AKT = C2_ABT + 32 * 32 * 4;
constexpr int C2_NBT = C2_AKT + 32 * 40 * 2;
constexpr int C2_NKT = C2_NBT + 32 * 40 * 2;
constexpr int C2_YO = C2_NKT + 32 * 40 * 2;
constexpr int C2_X_END = C2_YO + TB * 64 * 4;
constexpr int C2_KKS = C2_X_END;
constexpr int C2_BS = C2_KKS + TB * 72 * 2, C2_KDS = C2_BS + TB * 72 * 2, C2_RS = C2_KDS + TB * 72 * 2;
constexpr int C2_BST = C2_RS + TB * 72 * 2;
constexpr int C2_KDST = C2_BST + 64 * 40 * 2;
constexpr int C2_VT = C2_KDST + 64 * 40 * 2;
constexpr int C2_S0B = C2_VT + 64 * 40 * 2;
constexpr int C2_GC = C2_S0B + 64 * 72 * 2;
constexpr int C2_BON = C2_GC + 64 * 4;
constexpr int C2_RB = C2_BON + TB * 4;
constexpr int C2_KRB = C2_RB + TB * 64 * 2, C2_VB = C2_KRB + TB * 64 * 2;
constexpr int C2_LA = C2_VB + TB * 64 * 2;
constexpr int C2_CUM = C2_LA + TB * 64 * 4;
constexpr int C2_BON2 = C2_CUM + (TB + 1) * 64 * 4;
constexpr int C2_END = C2_BON2 + TB * 4;
static_assert(C2_END <= LDS_BYTES - 16 && (C2_X % 16) == 0 && (C2_KKS % 16) == 0 && (C2_G % 16) == 0 && (C2_UB % 16) == 0 && (C2_ABT % 16) == 0 && (C2_AKT % 16) == 0 && (C2_S0B % 16) == 0, "rwkv2 LDS");

__device__ __forceinline__ bf16x8 ldsb8(const LAS bf16_t* p) { return *(const LAS bf16x8*)p; }

template <int MODE>
__device__ __forceinline__ void rwkv_chain3(LAS unsigned char* lds, const In& in, const RwkvP p, int chain) {
    const int tid = threadIdx.x, lane = tid & 63, wid = tid >> 6, fr = lane & 15, fq = lane >> 4;
    const int d = chain / (p.nb * NH), bl = (chain / NH) % p.nb, h = chain % NH;
    const int nlat = p.nb * SEQ;
    LAS bf16_t* RAW = (LAS bf16_t*)(lds + C2_RAW); LAS float* MU = (LAS float*)(lds + C2_MU);
    LAS bf16_t* WUP = (LAS bf16_t*)(lds + C2_WUP); LAS bf16_t* AUP = (LAS bf16_t*)(lds + C2_AUP); LAS float* CST = (LAS float*)(lds + C2_CST);
    LAS bf16_t* AWD = (LAS bf16_t*)(lds + C2_AWD); LAS bf16_t* AAD = (LAS bf16_t*)(lds + C2_AAD);
    LAS bf16_t *Rb = (LAS bf16_t*)(lds + C2_RB), *KRb = (LAS bf16_t*)(lds + C2_KRB), *Vb = (LAS bf16_t*)(lds + C2_VB); LAS float *LA_ = (LAS float*)(lds + C2_LA), *CUM = (LAS float*)(lds + C2_CUM);
    LAS float *YO = (LAS float*)(lds + C2_YO), *Gm = (LAS float*)(lds + C2_G), *ABT = (LAS float*)(lds + C2_ABT), *GC = (LAS float*)(lds + C2_GC), *BON = (LAS float*)(lds + C2_BON);
    LAS bf16_t *UB = (LAS bf16_t*)(lds + C2_UB), *AKT = (LAS bf16_t*)(lds + C2_AKT), *NBT = (LAS bf16_t*)(lds + C2_NBT), *NKT = (LAS bf16_t*)(lds + C2_NKT);
    LAS bf16_t *KKS = (LAS bf16_t*)(lds + C2_KKS), *BS = (LAS bf16_t*)(lds + C2_BS), *KDS = (LAS bf16_t*)(lds + C2_KDS), *RS = (LAS bf16_t*)(lds + C2_RS);
    LAS bf16_t *BST = (LAS bf16_t*)(lds + C2_BST), *KDST = (LAS bf16_t*)(lds + C2_KDST), *VT = (LAS bf16_t*)(lds + C2_VT), *S0B = (LAS bf16_t*)(lds + C2_S0B);
    auto segcol = [&](int s) __attribute__((always_inline)) { return s < 3 ? s * RW + h * 64 : (s == 3 ? OFF_WD + d * DL : OFF_AD + d * AL); };
    for (int i = tid; i < RAWW; i += NT) { const float m0 = in.shift_mu[segcol(i >> 6) + (i & 63)], m1 = in.shift_mu[RC + segcol(i >> 6) + (i & 63)]; MU[i] = m0; MU[RAWW + i] = m1; MU[2 * RAWW + i] = 1.f - m0 - m1; }
    for (int i = tid; i < 64 * 64; i += NT) { const int j = i >> 6, c = i & 63;
        WUP[c * 72 + j] = f2bf(in.rw_w_up[((size_t)d * DL + j) * RW + h * 64 + c]); AUP[c * 72 + j] = f2bf(in.rw_a_up[((size_t)d * AL + j) * RW + h * 64 + c]); }
    for (int i = tid; i < 64; i += NT) { CST[i] = in.rw_w0[d * RW + h * 64 + i]; CST[64 + i] = in.rw_a0[d * RW + h * 64 + i]; CST[128 + i] = in.rw_k_k[h * 64 + i]; CST[192 + i] = in.rw_k_a[h * 64 + i]; CST[256 + i] = in.rw_r_k[h * 64 + i]; }
    for (int i = tid; i < 64 * 72 / 2; i += NT) ((LAS unsigned*)S0B)[i] = 0u;
    constexpr int NQ = (CTX + SEQ) / TB, NQC = CTX / TB;
    auto blk_info = [&](int q, bool& isctx, int& t0, bool& hp, bool& hn, size_t& grow0) __attribute__((always_inline)) {
        isctx = q < NQC;
        if (isctx) { const int qq = d == 0 ? q : NQC - 1 - q; t0 = qq * TB; hp = t0 > 0; hn = t0 + TB < CTX; grow0 = (size_t)nlat + (size_t)bl * CTX + t0; }
        else { const int ql = q - NQC, qq = d == 0 ? ql : SEQ / TB - 1 - ql; t0 = qq * TB; hp = (t0 % GW) != 0; hn = ((t0 + TB) % GW) != 0; grow0 = (size_t)bl * SEQ + t0; }
    };
    u32x4 pre[RW_PPT]; int poff[RW_PPT], plds[RW_PPT];
#pragma unroll
    for (int k = 0; k < RW_PPT; ++k) { const int i = tid + k * NT, rr = i / 40, sp = i % 40, seg = sp >> 3, part = sp & 7;
        poff[k] = (rr - 1) * Z1_N + segcol(seg) + part * 8; plds[k] = (rr * RAWW + sp * 8) | (i >= RW_NPIECE ? 3 : (rr == 0 ? 1 : (rr == TB + 1 ? 2 : 0))); }
    auto prefetch = [&](int q) __attribute__((always_inline)) {
        bool isctx, hp, hn; int t0; size_t grow0; blk_info(q, isctx, t0, hp, hn, grow0);
        const bf16_t* base = p.z1 + grow0 * Z1_N;
#pragma unroll
        for (int k = 0; k < RW_PPT; ++k) { u32x4 v = (u32x4){0u, 0u, 0u, 0u};
            const int kind = plds[k] & 3; const bool ok = kind == 0 || (kind == 1 && hp) || (kind == 2 && hn);
            if (ok) v = *(const u32x4*)(base + poff[k]);
            pre[k] = v; }
    };
    auto commit = [&]() __attribute__((always_inline)) {
#pragma unroll
        for (int k = 0; k < RW_PPT; ++k) if ((plds[k] & 3) != 3) *(LAS u32x4*)(RAW + (plds[k] & ~3)) = pre[k];
    };
    f32x4 Sreg[2];
    Sreg[0] = (f32x4){0.f, 0.f, 0.f, 0.f}; Sreg[1] = Sreg[0];
    const int rt = wid >> 1;
    auto shift8 = [&](int t, int c0, f32x2 (&s)[4]) __attribute__((always_inline)) {
        const u32x4 xp = *(const LAS u32x4*)(RAW + t * RAWW + c0), xc = *(const LAS u32x4*)(RAW + (t + 1) * RAWW + c0), xn_ = *(const LAS u32x4*)(RAW + (t + 2) * RAWW + c0);
        const f32x4 m0a = *(const LAS f32x4*)(MU + c0), m0b = *(const LAS f32x4*)(MU + c0 + 4), m1a = *(const LAS f32x4*)(MU + RAWW + c0), m1b = *(const LAS f32x4*)(MU + RAWW + c0 + 4),
                    mca = *(const LAS f32x4*)(MU + 2 * RAWW + c0), mcb = *(const LAS f32x4*)(MU + 2 * RAWW + c0 + 4);
#define MK_SH2(J, XP, XC, XN, MC2, M02, M12) { f32x2 C, P, N; C.x = bflo(XC); C.y = bfhi(XC); P.x = bflo(XP); P.y = bfhi(XP); N.x = bflo(XN); N.y = bfhi(XN); f32x2 r_ = MC2 * C; r_ = M02 * P + r_; r_ = M12 * N + r_; s[J] = r_; }
        MK_SH2(0, xp.x, xc.x, xn_.x, mca.lo, m0a.lo, m1a.lo) MK_SH2(1, xp.y, xc.y, xn_.y, mca.hi, m0a.hi, m1a.hi)
        MK_SH2(2, xp.z, xc.z, xn_.z, mcb.lo, m0b.lo, m1b.lo) MK_SH2(3, xp.w, xc.w, xn_.w, mcb.hi, m0b.hi, m1b.hi)
#undef MK_SH2
    };
    auto pack4 = [&](const f32x2 (&s)[4]) __attribute__((always_inline)) { u32x4 w; w.x = cvt_pk_bf16(s[0].x, s[0].y); w.y = cvt_pk_bf16(s[1].x, s[1].y); w.z = cvt_pk_bf16(s[2].x, s[2].y); w.w = cvt_pk_bf16(s[3].x, s[3].y); return w; };
    int sh_t[3], sh_c[3], sh_d[3];
#pragma unroll
    for (int k = 0; k < 3; ++k) { const int it = (tid & (NT / 2 - 1)) + k * (NT / 2), t = it / 24, g = it % 24, seg = g >> 3, cc = (g & 7) * 8, js = d == 0 ? t : TB - 1 - t;
        sh_t[k] = t; sh_c[k] = g * 8; sh_d[k] = seg * (TB * 64) + js * 64 + cc; }
    auto do_shift = [&](int tl, int nth) __attribute__((always_inline)) {
#pragma unroll
        for (int k = 0; k < 3; ++k) { f32x2 s[4]; shift8(sh_t[k], sh_c[k], s); *(LAS u32x4*)(Rb + sh_d[k]) = pack4(s); }
#pragma unroll 1
        for (int it = tl; it < TB * 8; it += nth) { const int t = it >> 3, part = it & 7, js = d == 0 ? t : TB - 1 - t;
            { f32x2 s[4]; shift8(t, (24 + part) * 8, s);
#pragma unroll
              for (int j = 0; j < 4; ++j) { s[j].x = 1.f - 2.f * fast_rcp(1.f + __builtin_amdgcn_exp2f(2.885390081777927f * s[j].x)); s[j].y = 1.f - 2.f * fast_rcp(1.f + __builtin_amdgcn_exp2f(2.885390081777927f * s[j].y)); }
              *(LAS u32x4*)(AWD + js * 72 + part * 8) = pack4(s); }
            { f32x2 s[4]; shift8(t, (32 + part) * 8, s); *(LAS u32x4*)(AAD + js * 72 + part * 8) = pack4(s); }
        }
    };
    auto lora_stage = [&]() __attribute__((always_inline)) {
        {
            const int lora = wid >> 2, ct = wid & 3;
            const LAS bf16_t* Am = lora ? AAD : AWD; const LAS bf16_t* Bm = lora ? AUP : WUP;
            float carry = 0.f;
#pragma unroll
            for (int r2 = 0; r2 < 2; ++r2) {
                f32x4 acc = (f32x4){0.f, 0.f, 0.f, 0.f};
#pragma unroll
                for (int ks = 0; ks < 2; ++ks) acc = __builtin_amdgcn_mfma_f32_16x16x32_bf16(ldsb8(Am + (r2 * 16 + fr) * 72 + ks * 32 + fq * 8), ldsb8(Bm + (ct * 16 + fr) * 72 + ks * 32 + fq * 8), acc, 0, 0, 0);
                const int col = ct * 16 + fr;
                if (lora == 0) {
                    float c[4];
#pragma unroll
                    for (int i = 0; i < 4; ++i) { const float lw = acc[i] + CST[col]; const float e = fast_sigmoid(lw); c[i] = i ? c[i - 1] + e : e;   }
                    const float tot = c[3];
                    float s1 = tot; { const float y = __shfl_up(s1, 16); s1 += fq >= 1 ? y : 0.f; }
                    float s2 = s1;  { const float z = __shfl_up(s1, 32); s2 += fq >= 2 ? z : 0.f; }
                    const float base = carry + s2 - tot;
#pragma unroll
                    for (int i = 0; i < 4; ++i) CUM[(1 + r2 * 16 + fq * 4 + i) * 64 + col] = base + c[i];
                    carry += __shfl(s2, 48 + fr);
                } else {
#pragma unroll
                    for (int i = 0; i < 4; ++i) LA_[(r2 * 16 + fq * 4 + i) * 64 + col] = fast_sigmoid(acc[i] + CST[64 + col]);
                }
            }
        }
    };
    auto scale_stage = [&](LAS float* bonw) __attribute__((always_inline)) {
        {
            const int j = tid >> 4, c4 = (tid & 15) * 4;
            const u32x2 kp = *(const LAS u32x2*)(KRb + j * 64 + c4), rp = *(const LAS u32x2*)(Rb + j * 64 + c4), vp = *(const LAS u32x2*)(Vb + j * 64 + c4);
            const f32x4 k = (f32x4){bflo(kp.x), bfhi(kp.x), bflo(kp.y), bfhi(kp.y)}, r = (f32x4){bflo(rp.x), bfhi(rp.x), bflo(rp.y), bfhi(rp.y)};
            const f32x4 a = *(const LAS f32x4*)(LA_ + j * 64 + c4);
            const f32x4 cu = *(const LAS f32x4*)(CUM + (j + 1) * 64 + c4), cp = *(const LAS f32x4*)(CUM + j * 64 + c4);
            const f32x4 ckk = *(const LAS f32x4*)(CST + 128 + c4), cka = *(const LAS f32x4*)(CST + 192 + c4), crk = *(const LAS f32x4*)(CST + 256 + c4);
            float kkr[4], kd[4], ss = 0.f, bn = 0.f;
#pragma unroll
            for (int x = 0; x < 4; ++x) { kkr[x] = k[x] * ckk[x]; ss += kkr[x] * kkr[x]; kd[x] = k[x] * (1.f + (a[x] - 1.f) * cka[x]); bn += r[x] * kd[x] * crk[x]; }
            asm volatile("s_nop 1\n\t"
                "v_add_f32_dpp %0, %0, %0 quad_perm:[1,0,3,2] row_mask:0xf bank_mask:0xf\n\t" "v_add_f32_dpp %1, %1, %1 quad_perm:[1,0,3,2] row_mask:0xf bank_mask:0xf\n\ts_nop 0\n\t"
                "v_add_f32_dpp %0, %0, %0 quad_perm:[2,3,0,1] row_mask:0xf bank_mask:0xf\n\t" "v_add_f32_dpp %1, %1, %1 quad_perm:[2,3,0,1] row_mask:0xf bank_mask:0xf\n\ts_nop 0\n\t"
                "v_add_f32_dpp %0, %0, %0 row_half_mirror row_mask:0xf bank_mask:0xf\n\t" "v_add_f32_dpp %1, %1, %1 row_half_mirror row_mask:0xf bank_mask:0xf\n\ts_nop 0\n\t"
                "v_add_f32_dpp %0, %0, %0 row_mirror row_mask:0xf bank_mask:0xf\n\t" "v_add_f32_dpp %1, %1, %1 row_mirror row_mask:0xf bank_mask:0xf"
                : "+v"(ss), "+v"(bn));
            const float inv = __builtin_amdgcn_rsqf(fmaxf(ss, 1e-24f));
            float kks[4], bs[4], kds[4], rs[4]; f32x4 gv;
#pragma unroll
            for (int x = 0; x < 4; ++x) { const float kk = kkr[x] * inv, bb = kk * a[x];
                const float ig = __builtin_amdgcn_exp2f(0.87503877f * cu[x]), g = fast_rcp(ig), gp = __builtin_amdgcn_exp2f(-0.87503877f * cp[x]);
                kks[x] = kk * gp; bs[x] = bb * ig; kds[x] = kd[x] * ig; rs[x] = r[x] * g; gv[x] = g;
            }
            if (j == TB - 1) *(LAS f32x4*)(GC + c4) = gv;
#pragma unroll
            for (int x = 0; x < 4; x += 2) { const unsigned pb = cvt_pk_bf16(bs[x], bs[x + 1]), pk = cvt_pk_bf16(kds[x], kds[x + 1]), pv = x ? vp.y : vp.x;
                BST[(c4 + x) * 40 + j] = (bf16_t)pb; BST[(c4 + x + 1) * 40 + j] = (bf16_t)(pb >> 16); KDST[(c4 + x) * 40 + j] = (bf16_t)pk; KDST[(c4 + x + 1) * 40 + j] = (bf16_t)(pk >> 16);
                VT[(c4 + x) * 40 + j] = (bf16_t)pv; VT[(c4 + x + 1) * 40 + j] = (bf16_t)(pv >> 16); }
            u32x2 w; w.x = cvt_pk_bf16(kks[0], kks[1]); w.y = cvt_pk_bf16(kks[2], kks[3]); *(LAS u32x2*)(KKS + j * 72 + c4) = w;
            w.x = cvt_pk_bf16(bs[0], bs[1]); w.y = cvt_pk_bf16(bs[2], bs[3]); *(LAS u32x2*)(BS + j * 72 + c4) = w;
            w.x = cvt_pk_bf16(kds[0], kds[1]); w.y = cvt_pk_bf16(kds[2], kds[3]); *(LAS u32x2*)(KDS + j * 72 + c4) = w;
            w.x = cvt_pk_bf16(rs[0], rs[1]); w.y = cvt_pk_bf16(rs[2], rs[3]); *(LAS u32x2*)(RS + j * 72 + c4) = w;
            if ((tid & 15) == 0) bonw[j] = bn;
        }
    };
    if (tid < 16) *(LAS f32x4*)(CUM + tid * 4) = (f32x4){0.f, 0.f, 0.f, 0.f};
    prefetch(0);
    commit();
    __syncthreads();
    if (1 < NQ) prefetch(1);
    do_shift(tid & (NT / 2 - 1), NT / 2);
    __syncthreads();
    lora_stage();
    __syncthreads();
    scale_stage(BON);
    __syncthreads();
    for (int q = 0; q < NQ; ++q) {
        bool isctx, hp, hn; int t0; size_t grow0; blk_info(q, isctx, t0, hp, hn, grow0);
        LAS float* bonr = BON + (q & 1) * ((C2_BON2 - C2_BON) / 4); LAS float* bonn = BON + ((q + 1) & 1) * ((C2_BON2 - C2_BON) / 4);
        const int ctg = wid & 1;
        f32x4 accG = (f32x4){0.f, 0.f, 0.f, 0.f}, accY = accG;
        {
            const int pr = wid >> 1, rts = wid & 1;
            const LAS bf16_t* Xm = (pr & 1) ? KDS : BS; const LAS bf16_t* Ym = (pr < 2) ? KKS : RS;
            const bf16x8 a0 = ldsb8(Xm + (rts * 16 + fr) * 72 + fq * 8), a1 = ldsb8(Xm + (rts * 16 + fr) * 72 + 32 + fq * 8);
#pragma unroll
            for (int cts = 0; cts < 2; ++cts) {
                f32x4 acc = (f32x4){0.f, 0.f, 0.f, 0.f};
                acc = __builtin_amdgcn_mfma_f32_16x16x32_bf16(a0, ldsb8(Ym + (cts * 16 + fr) * 72 + fq * 8), acc, 0, 0, 0);
                acc = __builtin_amdgcn_mfma_f32_16x16x32_bf16(a1, ldsb8(Ym + (cts * 16 + fr) * 72 + 32 + fq * 8), acc, 0, 0, 0);
                const int t = cts * 16 + fr, s0 = rts * 16 + fq * 4;
#pragma unroll
                for (int i = 0; i < 4; ++i) { const bool keep = (pr < 2) ? (s0 + i < t) : (s0 + i <= t); acc[i] = keep ? acc[i] : 0.f; }
                if (pr == 0) { ABT[s0 * 32 + t] = acc[0]; ABT[(s0 + 1) * 32 + t] = acc[1]; ABT[(s0 + 2) * 32 + t] = acc[2]; ABT[(s0 + 3) * 32 + t] = acc[3]; }
                else { u32x2 w; w.x = cvt_pk_bf16(acc[0], acc[1]); w.y = cvt_pk_bf16(acc[2], acc[3]); *(LAS u32x2*)((pr == 1 ? AKT : (pr == 2 ? NBT : NKT)) + t * 40 + s0) = w; }
            }
#pragma unroll
            for (int ks = 0; ks < 2; ++ks) { const bf16x8 sa = ldsb8(S0B + (rt * 16 + fr) * 72 + ks * 32 + fq * 8);
                accG = __builtin_amdgcn_mfma_f32_16x16x32_bf16(sa, ldsb8(KKS + (ctg * 16 + fr) * 72 + ks * 32 + fq * 8), accG, 0, 0, 0);
                accY = __builtin_amdgcn_mfma_f32_16x16x32_bf16(sa, ldsb8(RS + (ctg * 16 + fr) * 72 + ks * 32 + fq * 8), accY, 0, 0, 0); }
        }
        __syncthreads();
        {
            const bf16x8 va = ldsb8(VT + (rt * 16 + fr) * 40 + fq * 8);
            accG = __builtin_amdgcn_mfma_f32_16x16x32_bf16(va, ldsb8(AKT + (ctg * 16 + fr) * 40 + fq * 8), accG, 0, 0, 0);
            accY = __builtin_amdgcn_mfma_f32_16x16x32_bf16(va, ldsb8(NKT + (ctg * 16 + fr) * 40 + fq * 8), accY, 0, 0, 0);
#pragma unroll
            for (int i = 0; i < 4; ++i) Gm[(rt * 16 + fq * 4 + i) * 36 + ctg * 16 + fr] = -accG[i];
            if (q + 1 < NQ) { commit(); if (q + 2 < NQ) prefetch(q + 2); }
        }
        __syncthreads();
        if (wid >= 4) { if (q + 1 < NQ) do_shift(tid & (NT / 2 - 1), NT / 2); }
        else {
            const int v = wid * 16 + (lane >> 2), pq = lane & 3;
            const LAS float* grow = Gm + v * 36;
            f32x4 r0 = *(const LAS f32x4*)(grow + 4 * pq), r1 = *(const LAS f32x4*)(grow + 16 + 4 * pq);
            u32x2 ubo[TB / 4];
            const LAS float* abq = ABT + 4 * pq; asm volatile("" : "+v"(abq));
            f32x4 a0c[4], a1c[4];
            auto ldg = [&](int g, f32x4 (&aa0)[4], f32x4 (&aa1)[4]) __attribute__((always_inline)) {
#pragma unroll
                for (int x = 0; x < 4; ++x) { if (g < 4) aa0[x] = *(const LAS f32x4*)(abq + (4 * g + x) * 32); aa1[x] = *(const LAS f32x4*)(abq + (4 * g + x) * 32 + 16); } };
            ldg(0, a0c, a1c);
#pragma unroll
            for (int g = 0; g < TB / 4; ++g) {
                f32x4 a0n[4], a1n[4];
                if (g + 1 < TB / 4) ldg(g + 1, a0n, a1n);
                __builtin_amdgcn_sched_barrier(0);
                const f32x4 rr = g < 4 ? r0 : r1;
                f32x4 dg[3];
#pragma unroll
                for (int x = 0; x < 3; ++x) dg[x] = g < 4 ? a0c[x] : a1c[x];
                f32x4 u4;
                u4[0] = rr[0];
                u4[1] = __builtin_fmaf(-u4[0], dg[0][1], rr[1]);
                u4[2] = __builtin_fmaf(-u4[1], dg[1][2], __builtin_fmaf(-u4[0], dg[0][2], rr[2]));
                u4[3] = __builtin_fmaf(-u4[2], dg[2][3], __builtin_fmaf(-u4[1], dg[1][3], __builtin_fmaf(-u4[0], dg[0][3], rr[3])));
#pragma unroll
                for (int x = 0; x < 4; ++x) { const int ui = __float_as_int(u4[x]); int bi;
                    if ((g & 3) == 0) bi = __builtin_amdgcn_update_dpp(0, ui, 0x00, 0xF, 0xF, true); else if ((g & 3) == 1) bi = __builtin_amdgcn_update_dpp(0, ui, 0x55, 0xF, 0xF, true);
                    else if ((g & 3) == 2) bi = __builtin_amdgcn_update_dpp(0, ui, 0xAA, 0xF, 0xF, true); else bi = __builtin_amdgcn_update_dpp(0, ui, 0xFF, 0xF, 0xF, true);
                    u4[x] = __int_as_float(bi); }
                ubo[g].x = cvt_pk_bf16(u4[0], u4[1]); ubo[g].y = cvt_pk_bf16(u4[2], u4[3]);
                if (g < 3) {
                    f32x2 lo = r0.lo, hi = r0.hi;
#pragma unroll
                    for (int x = 0; x < 4; ++x) { const f32x2 ux = (f32x2){u4[x], u4[x]}; lo = lo - ux * a0c[x].lo; hi = hi - ux * a0c[x].hi; }
                    r0.lo = lo; r0.hi = hi; }
                if (g < 7) {
                    f32x2 lo = r1.lo, hi = r1.hi;
#pragma unroll
                    for (int x = 0; x < 4; ++x) { const f32x2 ux = (f32x2){u4[x], u4[x]}; lo = lo - ux * a1c[x].lo; hi = hi - ux * a1c[x].hi; }
                    r1.lo = lo; r1.hi = hi; }
                if (g + 1 < TB / 4) {
#pragma unroll
                    for (int x = 0; x < 4; ++x) { a0c[x] = a0n[x]; a1c[x] = a1n[x]; } }
            }
            if (pq == 0) {
#pragma unroll
                for (int g = 0; g < TB / 4; g += 2) { u32x4 w; w.x = ubo[g].x; w.y = ubo[g].y; w.z = ubo[g + 1].x; w.w = ubo[g + 1].y; *(LAS u32x4*)(UB + v * 40 + 4 * g) = w; } }
        }
        __syncthreads();
        {
            const bf16x8 ua = ldsb8(UB + (rt * 16 + fr) * 40 + fq * 8), va = ldsb8(VT + (rt * 16 + fr) * 40 + fq * 8);
            accY = __builtin_amdgcn_mfma_f32_16x16x32_bf16(ua, ldsb8(NBT + (ctg * 16 + fr) * 40 + fq * 8), accY, 0, 0, 0);
            *(LAS f32x4*)(YO + (ctg * 16 + fr) * 64 + rt * 16 + fq * 4) = accY;
#pragma unroll
            for (int cc = 0; cc < 2; ++cc) { const int ct = 2 * (wid & 1) + cc, kcol = ct * 16 + fr;
                f32x4 acc = Sreg[cc];
                acc = __builtin_amdgcn_mfma_f32_16x16x32_bf16(ua, ldsb8(BST + kcol * 40 + fq * 8), acc, 0, 0, 0);
                acc = __builtin_amdgcn_mfma_f32_16x16x32_bf16(va, ldsb8(KDST + kcol * 40 + fq * 8), acc, 0, 0, 0);
                const float g = GC[kcol];
#pragma unroll
                for (int i = 0; i < 4; ++i) acc[i] *= g;
                { const unsigned p0 = cvt_pk_bf16(acc[0], acc[1]), p1 = cvt_pk_bf16(acc[2], acc[3]); LAS bf16_t* sp = S0B + (rt * 16 + fq * 4) * 72 + kcol;
                  sp[0] = (bf16_t)p0; sp[72] = (bf16_t)(p0 >> 16); sp[144] = (bf16_t)p1; sp[216] = (bf16_t)(p1 >> 16); }
                Sreg[cc] = acc; }
        }
        if (q + 1 < NQ) lora_stage();
        __syncthreads();
        if (!isctx) {
            const int j = tid >> 4, c4 = (tid & 15) * 4, t = d == 0 ? j : TB - 1 - j; const f32x4 y = *(const LAS f32x4*)(YO + j * 64 + c4);
            u32x2 w; w.x = cvt_pk_bf16(y[0], y[1]); w.y = cvt_pk_bf16(y[2], y[3]);
            bf16_t* yb_ = p.Y + ((size_t)d * nlat + grow0) * RW + h * 64;
            *(u32x2*)(yb_ + t * RW + c4) = w;
            if (tid < TB) { const int tt = d == 0 ? tid : TB - 1 - tid; float* bb_ = p.bon + ((size_t)d * nlat + grow0) * NH + h; bb_[tt * NH] = bonr[tid]; }
        }
        if (q + 1 < NQ) scale_stage(bonn);
        __syncthreads();
    }
}
template <int MODE = 0>
__device__ __forceinline__ void rwkv_phase3(LAS unsigned char* lds, const In& in, const RwkvP p, int bid, int nblk) {
    const int nchain = 2 * p.nb * NH;
    for (int c = bid; c < nchain; c += nblk) { rwkv_chain3<MODE>(lds, in, p, c); __syncthreads(); }
}
}
}

namespace mk {
constexpr int LR_XT = 0;
constexpr int LR_XC = LR_XT + 67 * 64 * 2 + 64;
constexpr int LR_XCB = LR_XC + 64 * 64 * 4;
constexpr int LR_GWT = LR_XCB + 64 * 72 * 2;
constexpr int LR_A = LR_GWT + 2 * 64 * 72 * 2;
constexpr int LR_BX = LR_A + 64 * 64 * 4;
constexpr int LR_HO = LR_BX + 64 * 64 * 4;
constexpr int LR_CST = LR_HO + 64 * 64 * 4;
constexpr int LR_SEGP = LR_CST + 8 * 64 * 4;
constexpr int LR_SEGH = LR_SEGP + 8 * 64 * 4;
constexpr int LR_HC = LR_SEGH + 8 * 64 * 4;
constexpr int LR_END = LR_HC + 64 * 4;
static_assert(LR_END <= LDS_BYTES && (LR_XC % 16) == 0, "lru LDS");

struct LruP { const bf16_t* z1; bf16_t* Hd; int b0, nb; };

__device__ __forceinline__ void lru_item(LAS unsigned char* lds, const In& in, const LruP p, int item) {
    const int tid = threadIdx.x, lane = tid & 63, wid = tid >> 6;
    const int d = item / (p.nb * LB), bl = (item / LB) % p.nb, n = item % LB;
    const int nlat = p.nb * SEQ;
    LAS bf16_t* XT = (LAS bf16_t*)(lds + LR_XT); LAS float* XC = (LAS float*)(lds + LR_XC); LAS bf16_t* XCB = (LAS bf16_t*)(lds + LR_XCB); LAS bf16_t* GWT = (LAS bf16_t*)(lds + LR_GWT);
    LAS float *A_ = (LAS float*)(lds + LR_A), *BX = (LAS float*)(lds + LR_BX), *HO = (LAS float*)(lds + LR_HO), *CST = (LAS float*)(lds + LR_CST), *SEGP = (LAS float*)(lds + LR_SEGP), *SEGH = (LAS float*)(lds + LR_SEGH), *HC = (LAS float*)(lds + LR_HC);
    for (int i = tid; i < 2 * 64 * 64; i += NT) { const int g = i >> 12, j = (i >> 6) & 63, k = i & 63;
        GWT[(g * 64 + k) * 72 + j] = f2bf(in.lru_gate_w[((((size_t)d * 2 + g) * LB + n) * LBS + j) * LBS + k]); }
    for (int i = tid; i < 64; i += NT) { const int c = n * 64 + i;
        CST[i] = in.lru_conv_w[c]; CST[64 + i] = in.lru_conv_w[LW + c]; CST[128 + i] = in.lru_conv_w[2 * LW + c]; CST[192 + i] = in.lru_conv_w[3 * LW + c]; CST[256 + i] = in.lru_conv_b[c];
        CST[320 + i] = in.lru_gate_b[((d * 2 + 0) * LB + n) * LBS + i]; CST[384 + i] = in.lru_gate_b[((d * 2 + 1) * LB + n) * LBS + i]; CST[448 + i] = softplusf_(-in.lru_l[d * LW + c]); }
    constexpr int NSEG = CTX / 64 + GW, NSC = CTX / 64;
    u32x4 pre[2];
    auto tok_row = [&](int sidx, int rr, bool& ok) -> size_t {
        if (sidx < NSC) { const int t = sidx * 64 + rr - 2; ok = t >= 0 && t < CTX; return (size_t)nlat + (size_t)bl * CTX + t; }
        const int col = sidx - NSC, row = rr - 2; ok = row >= 0 && row < ROWS; return (size_t)bl * SEQ + (size_t)row * GW + col;
    };
    auto seg_of = [&](int q) { if (q < NSC) return d == 0 ? q : NSC - 1 - q; const int ql = q - NSC; return NSC + (d == 0 ? ql : GW - 1 - ql); };
    auto prefetch = [&](int q) { const int sidx = seg_of(q);
#pragma unroll
        for (int k = 0; k < 2; ++k) { const int i = tid + k * NT; u32x4 v = (u32x4){0u, 0u, 0u, 0u};
            if (i < 67 * 8) { const int rr = i >> 3, part = i & 7; bool ok; const size_t gr = tok_row(sidx, rr, ok); if (ok) v = *(const u32x4*)(p.z1 + gr * Z1_N + Z1_LX + n * 64 + part * 8); }
            pre[k] = v; } };
    auto commit = [&]() {
#pragma unroll
        for (int k = 0; k < 2; ++k) { const int i = tid + k * NT; if (i < 67 * 8) *(LAS u32x4*)(XT + (i >> 3) * 64 + (i & 7) * 8) = pre[k]; } };
    if (tid < 64) HC[tid] = 0.f;
    auto conv = [&]() __attribute__((always_inline)) {
        const int t = tid >> 3, c0 = (tid & 7) * 8; f32x2 s[4];
        { const f32x4 b0 = *(const LAS f32x4*)(CST + 256 + c0), b1 = *(const LAS f32x4*)(CST + 256 + c0 + 4); s[0] = b0.lo; s[1] = b0.hi; s[2] = b1.lo; s[3] = b1.hi; }
#pragma unroll
        for (int tap = 0; tap < 4; ++tap) { const u32x4 x = *(const LAS u32x4*)(XT + (t + tap) * 64 + c0);
            const f32x4 w0 = *(const LAS f32x4*)(CST + tap * 64 + c0), w1 = *(const LAS f32x4*)(CST + tap * 64 + c0 + 4);
            f32x2 v; v.x = bflo(x[0]); v.y = bfhi(x[0]); s[0] = w0.lo * v + s[0]; v.x = bflo(x[1]); v.y = bfhi(x[1]); s[1] = w0.hi * v + s[1];
            v.x = bflo(x[2]); v.y = bfhi(x[2]); s[2] = w1.lo * v + s[2]; v.x = bflo(x[3]); v.y = bfhi(x[3]); s[3] = w1.hi * v + s[3]; }
        *(LAS f32x4*)(XC + t * 64 + c0) = (f32x4){s[0].x, s[0].y, s[1].x, s[1].y}; *(LAS f32x4*)(XC + t * 64 + c0 + 4) = (f32x4){s[2].x, s[2].y, s[3].x, s[3].y};
        u32x4 w; w.x = cvt_pk_bf16(s[0].x, s[0].y); w.y = cvt_pk_bf16(s[1].x, s[1].y); w.z = cvt_pk_bf16(s[2].x, s[2].y); w.w = cvt_pk_bf16(s[3].x, s[3].y); *(LAS u32x4*)(XCB + t * 72 + c0) = w; };
    auto output = [&](int sidx) __attribute__((always_inline)) {
        if (sidx >= NSC) { const int col = sidx - NSC, t = tid >> 3, c0 = (tid & 7) * 8;
            const f32x4 x = *(const LAS f32x4*)(HO + t * 64 + c0), y = *(const LAS f32x4*)(HO + t * 64 + c0 + 4);
            *(u32x4*)(p.Hd + ((size_t)d * nlat + (size_t)bl * SEQ + (size_t)t * GW + col) * LW + n * 64 + c0) = pack8(x, y); } };
    prefetch(0);
    commit();
    __syncthreads();
    if (1 < NSEG) prefetch(1);
    conv();
    __syncthreads();
    float hlast = 0.f;
    for (int q = 0; q < NSEG; ++q) {
        { const int rt = wid >> 1, fr = lane & 15, fq = lane >> 4;
          bf16x8 a[2];
#pragma unroll
          for (int ks = 0; ks < 2; ++ks) a[ks] = *(const LAS bf16x8*)(XCB + (rt * 16 + fr) * 72 + ks * 32 + fq * 8);
#pragma unroll
          for (int cc = 0; cc < 2; ++cc) { const int ct = 2 * (wid & 1) + cc, col = ct * 16 + fr;
              f32x4 acc0 = (f32x4){0.f, 0.f, 0.f, 0.f}, acc1 = acc0;
#pragma unroll
              for (int ks = 0; ks < 2; ++ks) {
                  const bf16x8 b0 = *(const LAS bf16x8*)(GWT + (0 * 64 + col) * 72 + ks * 32 + fq * 8), b1 = *(const LAS bf16x8*)(GWT + (1 * 64 + col) * 72 + ks * 32 + fq * 8);
                  acc0 = __builtin_amdgcn_mfma_f32_16x16x32_bf16(a[ks], b0, acc0, 0, 0, 0); acc1 = __builtin_amdgcn_mfma_f32_16x16x32_bf16(a[ks], b1, acc1, 0, 0, 0); }
              constexpr float L2E = 1.4426950408889634f;
              const float g0s = -L2E * CST[320 + col], g1s = -L2E * CST[384 + col], sp8l = -8.f * L2E * CST[448 + col];
#pragma unroll
              for (int i = 0; i < 4; ++i) { const int t = rt * 16 + fq * 4 + i;
                  const float rec = fast_rcp(1.f + __builtin_amdgcn_exp2f(__builtin_fmaf(acc0[i], -L2E, g0s))), ib = 1.f + __builtin_amdgcn_exp2f(__builtin_fmaf(acc1[i], -L2E, g1s));
                  const float av = __builtin_amdgcn_exp2f(sp8l * rec), om = __builtin_fmaf(-av, av, 1.f);
                  A_[t * 64 + col] = av; BX[t * 64 + col] = om * __builtin_amdgcn_rsqf(fmaxf(om * ib * ib, 1e-30f)) * XC[t * 64 + col]; } } }
        if (q + 1 < NSEG) commit();
        if (q > 0) { output(seg_of(q - 1)); if ((tid >> 6) == 7) HC[tid & 63] = hlast; }
        __syncthreads();
        const int ch = tid & 63, pc = tid >> 6; float av[8], bv[8];
        { float P = 1.f, H = 0.f;
#pragma unroll
          for (int x = 0; x < 8; ++x) { const int st = pc * 8 + x, t = d == 0 ? st : 63 - st; av[x] = A_[t * 64 + ch]; bv[x] = BX[t * 64 + ch]; H = av[x] * H + bv[x]; P *= av[x]; }
          SEGP[pc * 64 + ch] = P; SEGH[pc * 64 + ch] = H; }
        if (q + 1 < NSEG) { if (q + 2 < NSEG) prefetch(q + 2); conv(); }
        __syncthreads();
        { float h = HC[ch];
#pragma unroll
          for (int q2 = 0; q2 < 7; ++q2) if (q2 < pc) h = SEGP[q2 * 64 + ch] * h + SEGH[q2 * 64 + ch];
#pragma unroll
          for (int x = 0; x < 8; ++x) { const int st = pc * 8 + x, t = d == 0 ? st : 63 - st; h = av[x] * h + bv[x]; HO[t * 64 + ch] = h; }
          hlast = h; }
        __syncthreads();
    }
    output(seg_of(NSEG - 1));
}
__device__ __forceinline__ void lru_phase(LAS unsigned char* lds, const In& in, const LruP p, int bid, int nblk) {
    const int nitem = 2 * p.nb * LB;
    for (int it = bid; it < nitem; it += nblk) { lru_item(lds, in, p, it); __syncthreads(); }
}
}

namespace mk {
#define MK_DPPX(x, ctrl) __int_as_float(__builtin_amdgcn_update_dpp(__float_as_int(x), __float_as_int(x), ctrl, 0xF, 0xF, false))
__device__ __forceinline__ float allreduce4(float x) { x += MK_DPPX(x, 0xB1); x += MK_DPPX(x, 0x4E); return x; }
__device__ __forceinline__ void unpack8(const u32x4 w, float (&f)[8]) {
#pragma unroll
    for (int j = 0; j < 4; ++j) { f[2 * j] = bflo(w[j]); f[2 * j + 1] = bfhi(w[j]); } }
constexpr int AG_K = 256;
struct PostP { const bf16_t* z1; bf16_t* Y; const float* bon; bf16_t* Ag; int nlat; int pad_; };
__device__ __forceinline__ void rwkv_post_rows(LAS float* cst  , const In& in, const PostP p, int row_lo, int row_hi, bool dry = false) {
    const int lane = threadIdx.x & 63, wid = threadIdx.x >> 6, c0 = lane * 16, h = lane >> 2;
    float mg0[8], mg1[8];
    for (int i = threadIdx.x; i < RW; i += NT) { cst[i] = in.shift_mu[OFF_V + i]; cst[RW + i] = in.shift_mu[RC + OFF_V + i]; cst[2 * RW + i] = in.rw_lnx[i]; cst[3 * RW + i] = in.rw_lnx[RW + i]; }
    __syncthreads();
#pragma unroll
    for (int j = 0; j < 8; ++j) { const int c = OFF_GD + (lane < GL / 8 ? lane : 0) * 8 + j; mg0[j] = in.shift_mu[c]; mg1[j] = in.shift_mu[RC + c]; }
    struct Raw { u32x4 y00, y01, y10, y11, zx[2], zp[2], zn[2]; float b0, b1; };
    const u32x4 Z4 = (u32x4){0u, 0u, 0u, 0u};
    auto load_row = [&](int r, Raw& w) __attribute__((always_inline)) {
        const int cg = r % GW; const bool hp = cg > 0, hn = cg < GW - 1;
        const bf16_t* y0p = p.Y + (size_t)r * RW + c0; const bf16_t* y1p = p.Y + ((size_t)p.nlat + r) * RW + c0;
        w.y00 = *(const u32x4*)y0p; w.y01 = *(const u32x4*)(y0p + 8); w.y10 = *(const u32x4*)y1p; w.y11 = *(const u32x4*)(y1p + 8);
        w.b0 = p.bon[(size_t)r * NH + h]; w.b1 = p.bon[((size_t)p.nlat + r) * NH + h];
        const bf16_t* zr = p.z1 + (size_t)r * Z1_N;
#pragma unroll
        for (int half = 0; half < 2; ++half) { const int c = OFF_V + c0 + half * 8;
            w.zx[half] = *(const u32x4*)(zr + c); w.zp[half] = Z4; w.zn[half] = Z4;
            if (hp) w.zp[half] = *(const u32x4*)(zr - Z1_N + c);
            if (hn) w.zn[half] = *(const u32x4*)(zr + Z1_N + c); }
    };
    auto compute_row = [&](int r, const Raw& w) __attribute__((always_inline)) {
        bf16_t* y0p = p.Y + (size_t)r * RW + c0;
        float y[16], t8[8];
        unpack8(w.y00, t8);
#pragma unroll
        for (int j = 0; j < 8; ++j) y[j] = t8[j];
        unpack8(w.y01, t8);
#pragma unroll
        for (int j = 0; j < 8; ++j) y[8 + j] = t8[j];
        unpack8(w.y10, t8);
#pragma unroll
        for (int j = 0; j < 8; ++j) y[j] += t8[j];
        unpack8(w.y11, t8);
#pragma unroll
        for (int j = 0; j < 8; ++j) y[8 + j] += t8[j];
        float s = 0.f;
#pragma unroll
        for (int j = 0; j < 16; ++j) s += y[j];
        const float mu = allreduce4(s) * (1.f / 64.f); float q = 0.f;
#pragma unroll
        for (int j = 0; j < 16; ++j) { const float dlt = y[j] - mu; q += dlt * dlt; }
        const float rs = __builtin_amdgcn_rsqf(allreduce4(q) * (1.f / 64.f) + LNX_EPS);
        const float bonus = w.b0 + w.b1;
#pragma unroll
        for (int half = 0; half < 2; ++half) {
            float xv[8], pv[8], nv[8]; unpack8(w.zx[half], xv); unpack8(w.zp[half], pv); unpack8(w.zn[half], nv);
            float m0_[8], m1_[8], g0_[8], g1_[8];
            { const LAS float* cb = cst + c0 + half * 8; const f32x4 a0 = *(const LAS f32x4*)cb, a1 = *(const LAS f32x4*)(cb + 4), b0 = *(const LAS f32x4*)(cb + RW), b1 = *(const LAS f32x4*)(cb + RW + 4),
                  e0 = *(const LAS f32x4*)(cb + 2 * RW), e1 = *(const LAS f32x4*)(cb + 2 * RW + 4), f0 = *(const LAS f32x4*)(cb + 3 * RW), f1 = *(const LAS f32x4*)(cb + 3 * RW + 4);
#pragma unroll
              for (int j = 0; j < 4; ++j) { m0_[j] = a0[j]; m0_[4 + j] = a1[j]; m1_[j] = b0[j]; m1_[4 + j] = b1[j]; g0_[j] = e0[j]; g0_[4 + j] = e1[j]; g1_[j] = f0[j]; g1_[4 + j] = f1[j]; } }
            float o[8];
#pragma unroll
            for (int j = 0; j < 8; ++j) { const int cj = half * 8 + j; const float v = xv[j] + m0_[j] * (pv[j] - xv[j]) + m1_[j] * (nv[j] - xv[j]);
                o[j] = (y[cj] - mu) * rs * g0_[j] + g1_[j] + bonus * v; }
            u32x4 wv; wv.x = cvt_pk_bf16(o[0], o[1]); wv.y = cvt_pk_bf16(o[2], o[3]); wv.z = cvt_pk_bf16(o[4], o[5]); wv.w = cvt_pk_bf16(o[6], o[7]); if (!dry) *(u32x4*)(y0p + half * 8) = wv; else if (wv.x == 0x12345678u) *(u32x4*)(y0p + half * 8) = wv;
        }
        if (lane < 32) { u32x4 wv = Z4;
            if (lane < GL / 8) { const int cg = r % GW; const bool hp = cg > 0, hn = cg < GW - 1; const bf16_t* zr = p.z1 + (size_t)r * Z1_N; const int c = OFF_GD + lane * 8;
                u32x4 gx = *(const u32x4*)(zr + c), gp = Z4, gn = Z4; if (hp) gp = *(const u32x4*)(zr - Z1_N + c); if (hn) gn = *(const u32x4*)(zr + Z1_N + c);
                float xv[8], pv[8], nv[8]; unpack8(gx, xv); unpack8(gp, pv); unpack8(gn, nv);
                float o[8];
#pragma unroll
                for (int j = 0; j < 8; ++j) o[j] = fast_sigmoid(xv[j] + mg0[j] * (pv[j] - xv[j]) + mg1[j] * (nv[j] - xv[j]));
                wv.x = cvt_pk_bf16(o[0], o[1]); wv.y = cvt_pk_bf16(o[2], o[3]); wv.z = cvt_pk_bf16(o[4], o[5]); wv.w = cvt_pk_bf16(o[6], o[7]); }
            *(u32x4*)(p.Ag + (size_t)r * AG_K + lane * 8) = wv; }
    };
    constexpr int RS_ = NT / 64;
    Raw A, B;
    int r = row_lo + wid;
    if (r < row_hi) load_row(r, A);
    for (; r < row_hi; r += 2 * RS_) {
        if (r + RS_ < row_hi) load_row(r + RS_, B);
        compute_row(r, A);
        if (r + 2 * RS_ < row_hi) load_row(r + 2 * RS_, A);
        if (r + RS_ < row_hi) compute_row(r + RS_, B);
    }
}
#define MK_FR_ROW(f) ((((f) >> 3) * HALF) + wr * 64 + ((((f) >> 1) & 3) * 16) + fr)
#define MK_FR_COL(f) ((((f) & 1) * HALF) + wc * 32 + 8 * fq)
#define MK_FR_ACC(f, n) acc[(f) >> 3][(f) & 1][((f) >> 1) & 3][n]
#define MK_FENCE asm volatile("" ::: "memory")
struct EpiYa { static constexpr int NS = 16; const bf16_t* yn; bf16_t* ya;
    __device__ __forceinline__ bool operator()(f32x4 (&acc)[2][2][4][2], const Unit& u, int wr, int wc, int fr, int fq) const {
        const size_t base = (size_t)(u.pm * BM) * RW + u.pn * BM;
        u32x4 cur = *(const u32x4*)(yn + base + (size_t)MK_FR_ROW(0) * RW + MK_FR_COL(0));
#pragma unroll
        for (int f = 0; f < 16; ++f) { u32x4 nxt = cur; if (f + 1 < 16) nxt = *(const u32x4*)(yn + base + (size_t)MK_FR_ROW(f + 1) * RW + MK_FR_COL(f + 1));
            MK_FENCE; float v[8]; unpack8(cur, v); f32x4 a = MK_FR_ACC(f, 0), b = MK_FR_ACC(f, 1);
#pragma unroll
            for (int j = 0; j < 4; ++j) { a[j] *= v[j]; b[j] *= v[4 + j]; }
            *(u32x4*)(ya + base + (size_t)MK_FR_ROW(f) * RW + MK_FR_COL(f)) = pack8(a, b); MK_FENCE; cur = nxt; }
        return false; } };
struct EpiZc { static constexpr int NS = 16; const bf16_t* Hd; bf16_t* yb; bf16_t* gates; int nlat; float sc;
    __device__ __forceinline__ bool operator()(f32x4 (&acc)[2][2][4][2], const Unit& u, int wr, int wc, int fr, int fq) const {
        if (u.pn < LW / BM) {
            MK_FRAG_LOOP(r, c) { const size_t o = (size_t)(u.pm * BM + r) * LW + u.pn * BM + c; float h0[8], h1[8]; unpack8(*(const u32x4*)(Hd + o), h0); unpack8(*(const u32x4*)(Hd + (size_t)nlat * LW + o), h1);
                f32x4 a = acc[ai][bj][m][0] * sc, b = acc[ai][bj][m][1] * sc;
#pragma unroll
                for (int j = 0; j < 4; ++j) { a[j] = fast_gelu_tanh(a[j]) * (h0[j] + h1[j]); b[j] = fast_gelu_tanh(b[j]) * (h0[4 + j] + h1[4 + j]); }
                *(u32x4*)(yb + o) = pack8(a, b); asm volatile("" ::: "memory"); }
        } else {
            MK_FRAG_LOOP(r, c) { const size_t o = (size_t)(u.pm * BM + r) * (2 * D) + (u.pn * BM - LW) + c;
                f32x4 a = acc[ai][bj][m][0] * sc, b = acc[ai][bj][m][1] * sc;
#pragma unroll
                for (int j = 0; j < 4; ++j) { a[j] = fast_sigmoid(a[j]); b[j] = fast_sigmoid(b[j]); }
                *(u32x4*)(gates + o) = pack8(a, b); }
        }
        return false; } };
struct PairOrder { StaticOrder S;
    __device__ bool next(int i, Unit& u) const { if (!S.next(i >> 1, u)) return false; u.e = i & 1; return true; } };
struct EpiBranch { const bf16_t* gates; bf16_t* mixed;
    __device__ __forceinline__ bool operator()(f32x4 (&acc)[2][2][4][2], const Unit& u, int wr, int wc, int fr, int fq) const {
        const size_t gbase = (size_t)(u.pm * BM) * (2 * D) + u.pn * BM, mbase = (size_t)(u.pm * BM) * D + u.pn * BM;
        u32x4 c1 = (u32x4){0u, 0u, 0u, 0u}, c2 = *(const u32x4*)(gates + gbase + (size_t)MK_FR_ROW(0) * (2 * D) + D + MK_FR_COL(0));
        if (u.e == 0) c1 = *(const u32x4*)(gates + gbase + (size_t)MK_FR_ROW(0) * (2 * D) + MK_FR_COL(0));
#pragma unroll
        for (int f = 0; f < 16; ++f) { u32x4 n1 = c1, n2 = c2;
            if (f + 1 < 16) { const size_t o = gbase + (size_t)MK_FR_ROW(f + 1) * (2 * D) + MK_FR_COL(f + 1); n2 = *(const u32x4*)(gates + o + D); if (u.e == 0) n1 = *(const u32x4*)(gates + o); }
            MK_FENCE; float g1[8], g2[8]; unpack8(c1, g1); unpack8(c2, g2);
            if (u.e == 0) {
#pragma unroll
                for (int j = 0; j < 4; ++j) { MK_FR_ACC(f, 0)[j] *= g1[j] / g2[j]; MK_FR_ACC(f, 1)[j] *= g1[4 + j] / g2[4 + j]; }
            } else { f32x4 a = MK_FR_ACC(f, 0), b = MK_FR_ACC(f, 1);
#pragma unroll
                for (int j = 0; j < 4; ++j) { a[j] *= g2[j]; b[j] *= g2[4 + j]; }
                *(u32x4*)(mixed + mbase + (size_t)MK_FR_ROW(f) * D + MK_FR_COL(f)) = pack8(a, b); }
            MK_FENCE; c1 = n1; c2 = n2; }
        __builtin_amdgcn_s_waitcnt(0x0F70);
        return u.e == 0; } };
struct EpiF32 { float* C; long ldc;
    __device__ __forceinline__ bool operator()(f32x4 (&acc)[2][2][4][2], const Unit& u, int wr, int wc, int fr, int fq) const {
        MK_FRAG_LOOP(r, c) { float* o = C + (size_t)(u.pm * BM + r) * ldc + u.pn * BM + c; *(f32x4*)o = acc[ai][bj][m][0]; *(f32x4*)(o + 4) = acc[ai][bj][m][1]; }
        return false; } };
}

namespace mk {
constexpr int NEX = NE + 1;
constexpr int SLOTS_PER_TOK = TOPK + 1;
constexpr int RP_MOD = 0;
constexpr int RP_UH = RP_MOD + 3 * D * 4;
constexpr int RP_UL = RP_UH + 16 * (D + 8) * 2;
constexpr int RP_PART = RP_UL + 16 * (D + 8) * 2;
constexpr int RP_LOG = RP_PART + 8 * 16 * 64 * 4;
constexpr int RP_HIST = RP_LOG + 16 * 64 * 4;
constexpr int RP_END = RP_HIST + 64 * 4;
static_assert(RP_END <= LDS_BYTES, "rowpass LDS");

constexpr float FP8_SR = 64.f;
constexpr float FP8_SA = 8.f, FP8_SWD = 256.f;
constexpr float FP8_SU = 16.f, FP8_SW = 256.f;
struct RowP { float* y2h1; bf16_t* u; unsigned char* u8; const float* modpart; const bf16_t* rwt;
              int* tope; float* gatev; int* lrank; int* blkcnt; int b0, nlat; };
__device__ __forceinline__ float wave_max(float x) { return wave_max64(x); }
__device__ __forceinline__ void row_pass(LAS unsigned char* lds, const In& in, const RowP p, int row_lo, int row_hi, bool dry = false) {
    const int tid = threadIdx.x, lane = tid & 63, wid = tid >> 6;
    LAS float* MOD = (LAS float*)(lds + RP_MOD); LAS bf16_t* UH = (LAS bf16_t*)(lds + RP_UH); LAS bf16_t* UL = (LAS bf16_t*)(lds + RP_UL);
    LAS float* PART = (LAS float*)(lds + RP_PART); LAS float* LOG = (LAS float*)(lds + RP_LOG); LAS int* HIST = (LAS int*)(lds + RP_HIST);
    const int mr = p.b0 + row_lo / SEQ;
    for (int j = tid; j < 3 * D; j += NT) MOD[j] = mod_value(in, p.modpart, mr, 2 * D + j);
    if (tid < 64) HIST[tid] = 0;
    __syncthreads();
    float gp1[16], gp2[16];
#pragma unroll
    for (int j = 0; j < 4; ++j)
#pragma unroll
        for (int q = 0; q < 4; ++q) { gp1[4 * j + q] = in.norm_g[D + j * 256 + lane * 4 + q]; gp2[4 * j + q] = in.norm_g[2 * D + j * 256 + lane * 4 + q]; }
    u32x2 py[2][4]; f32x4 px[2][4];
    auto fetch = [&](int r16) __attribute__((always_inline)) {
#pragma unroll
        for (int rr = 0; rr < 2; ++rr) { const int r = r16 + wid * 2 + rr;
#pragma unroll
            for (int j = 0; j < 4; ++j) { py[rr][j] = *(const u32x2*)(p.u + (size_t)r * D + j * 256 + lane * 4); px[rr][j] = *(const f32x4*)(in.x + ((size_t)p.b0 * SEQ + r) * D + j * 256 + lane * 4); } } };
    fetch(row_lo);
    for (int r16 = row_lo; r16 < row_hi; r16 += 16) {
#pragma unroll
        for (int rr = 0; rr < 2; ++rr) {
            const int lr = wid * 2 + rr, r = r16 + lr;
            float* yp = p.y2h1 + (size_t)r * D;
            f32x4 v[4]; float ss = 0.f;
#pragma unroll
            for (int j = 0; j < 4; ++j) { const u32x2 yw = py[rr][j];
                v[j] = (f32x4){bflo(yw.x), bfhi(yw.x), bflo(yw.y), bfhi(yw.y)}; ss += v[j][0] * v[j][0] + v[j][1] * v[j][1] + v[j][2] * v[j][2] + v[j][3] * v[j][3]; }
#pragma unroll
            for (int o_ = 0; o_ < 1; ++o_) ss = wave_sum64(ss);
            const float rinv = __builtin_amdgcn_rsqf(ss * (1.f / D) + NORM_EPS); float s2 = 0.f;
#pragma unroll
            for (int j = 0; j < 4; ++j) { const int c = j * 256 + lane * 4; const f32x4 xv = px[rr][j];
#pragma unroll
                for (int q = 0; q < 4; ++q) { const float hv = xv[q] + MOD[c + q] * (v[j][q] * rinv * gp1[4 * j + q]); v[j][q] = hv; s2 += hv * hv; }
                if (!dry) *(f32x4*)(yp + c) = v[j]; }
#pragma unroll
            for (int o_ = 0; o_ < 1; ++o_) s2 = wave_sum64(s2);
            const float r2 = __builtin_amdgcn_rsqf(s2 * (1.f / D) + NORM_EPS);
#pragma unroll
            for (int j = 0; j < 4; ++j) { const int c = j * 256 + lane * 4; float uu[4], lo[4]; unsigned hw[2];
#pragma unroll
                for (int q = 0; q < 4; ++q) uu[q] = (v[j][q] * r2 * gp2[4 * j + q]) * (1.f + MOD[2 * D + c + q]) + MOD[D + c + q];
                hw[0] = cvt_pk_bf16(uu[0], uu[1]); hw[1] = cvt_pk_bf16(uu[2], uu[3]);
                lo[0] = uu[0] - bflo(hw[0]); lo[1] = uu[1] - bfhi(hw[0]); lo[2] = uu[2] - bflo(hw[1]); lo[3] = uu[3] - bfhi(hw[1]);
                u32x2 w; w.x = hw[0]; w.y = hw[1]; *(unsigned*)(p.u8 + (size_t)r * D + c) = pack4_fp8(uu[0] * FP8_SU, uu[1] * FP8_SU, uu[2] * FP8_SU, uu[3] * FP8_SU); *(LAS u32x2*)(UH + lr * (D + 8) + c) = w;
                u32x2 wl; wl.x = cvt_pk_bf16(lo[0], lo[1]); wl.y = cvt_pk_bf16(lo[2], lo[3]); *(LAS u32x2*)(UL + lr * (D + 8) + c) = wl; }
        }
        __syncthreads();
        if (r16 + 16 < row_hi) fetch(r16 + 16);
        { const int fr = lane & 15, fq = lane >> 4;
          f32x4 acc[4];
#pragma unroll
          for (int ct = 0; ct < 4; ++ct) acc[ct] = (f32x4){0.f, 0.f, 0.f, 0.f};
#pragma unroll
          for (int ks = 0; ks < 4; ++ks) { const int k0 = wid * 128 + ks * 32 + fq * 8;
              const bf16x8 ah = *(const LAS bf16x8*)(UH + fr * (D + 8) + k0), al = *(const LAS bf16x8*)(UL + fr * (D + 8) + k0);
#pragma unroll
              for (int ct = 0; ct < 4; ++ct) { const bf16x8 bh = *(const bf16x8*)(p.rwt + (size_t)(ct * 16 + fr) * D + k0), bl = *(const bf16x8*)(p.rwt + (size_t)(NE + ct * 16 + fr) * D + k0);
                  acc[ct] = __builtin_amdgcn_mfma_f32_16x16x32_bf16(ah, bh, acc[ct], 0, 0, 0); acc[ct] = __builtin_amdgcn_mfma_f32_16x16x32_bf16(ah, bl, acc[ct], 0, 0, 0); acc[ct] = __builtin_amdgcn_mfma_f32_16x16x32_bf16(al, bh, acc[ct], 0, 0, 0); } }
#pragma unroll
          for (int ct = 0; ct < 4; ++ct)
#pragma unroll
              for (int i = 0; i < 4; ++i) PART[(wid * 16 + fq * 4 + i) * 64 + ct * 16 + fr] = acc[ct][i]; }
        __syncthreads();
        for (int i = tid; i < 16 * 64; i += NT) { float s = 0.f;
#pragma unroll
            for (int w = 0; w < 8; ++w) s += PART[w * 1024 + i];
            LOG[i] = s; }
        __syncthreads();
#pragma unroll 1
        for (int rr = 0; rr < 2; ++rr) {
            const int lr = wid * 2 + rr, r = r16 + lr;
            const float sc = sigmoidf_(LOG[lr * 64 + lane]), bi = sc + in.router_b[lane];
            float m1 = bi; m1 = fmaxf(m1, MK_DPPF(m1, 0xB1)); m1 = fmaxf(m1, MK_DPPF(m1, 0x4E)); m1 = fmaxf(m1, MK_DPPF(m1, 0x141));
            const unsigned long long eq = __ballot(bi == m1); const int first = __ffsll((long long)((eq >> (lane & ~7)) & 0xffull)) - 1 + (lane & ~7);
            float m2 = (lane == first) ? -1e30f : bi; m2 = fmaxf(m2, MK_DPPF(m2, 0xB1)); m2 = fmaxf(m2, MK_DPPF(m2, 0x4E)); m2 = fmaxf(m2, MK_DPPF(m2, 0x141));
            const float gs = m1 + m2; const int myg = lane >> 3; int rank = 0;
#pragma unroll
            for (int g = 0; g < NG; ++g) { const float og = __int_as_float(__builtin_amdgcn_readlane(__float_as_int(gs), g * 8)); rank += (og > gs || (og == gs && g < myg)) ? 1 : 0; }
            float cand = rank < TG ? bi : -1e30f; float tsum = 0.f; int myidx = 0; float mysc = 0.f;
#pragma unroll
            for (int it = 0; it < TOPK; ++it) { const float m = wave_max(cand); const unsigned long long bm = __ballot(cand == m); const int win = __builtin_amdgcn_readfirstlane(__ffsll((long long)bm) - 1);
                const float ws = __int_as_float(__builtin_amdgcn_readlane(__float_as_int(sc), win)); tsum += ws; if (lane == it) { myidx = win; mysc = ws; } if (lane == win) cand = -1e30f; }
            if (lane < TOPK) { const int rk = atomicAdd((int*)&HIST[myidx], 1);
                p.tope[(size_t)r * TOPK + lane] = myidx; p.gatev[(size_t)r * TOPK + lane] = mysc / tsum * 2.5f; p.lrank[(size_t)r * TOPK + lane] = rk; }
        }
        __syncthreads();
    }
    if (tid < 64) p.blkcnt[blockIdx.x * 64 + tid] = HIST[tid];
}

struct MoeP { const int* tope; const float* gatev; const int* lrank; const int* blkcnt;
              int* tilepre;
              int* list;
              int* sdst;
              float* sgate;
              int r0, nr, blk0, nbh, rpb, pad_; };
__device__ __forceinline__ void moe_assign(LAS unsigned char* lds, const MoeP p, int bid, int nblk) {
    LAS int* BASE = (LAS int*)lds; LAS int* CNT = BASE + 80; LAS int* BOFF = CNT + 80;
    const int tid = threadIdx.x;
    { LAS int* PC = BOFF + 80; const int e = tid & 63, part = tid >> 6, per = (p.nbh + 7) / 8; int c = 0, bo = 0;
#pragma unroll 4
      for (int b = part * per; b < (part + 1) * per && b < p.nbh; ++b) { const int v = p.blkcnt[(p.blk0 + b) * 64 + e]; if (p.blk0 + b < bid) bo += v; c += v; }
      PC[part * 64 + e] = c; PC[512 + part * 64 + e] = bo; }
    __syncthreads();
    if (tid < NE) { LAS int* PC = BOFF + 80; int c = 0, bo = 0;
#pragma unroll
        for (int q = 0; q < 8; ++q) { c += PC[q * 64 + tid]; bo += PC[512 + q * 64 + tid]; }
        CNT[tid] = c; BOFF[tid] = bo; }
    __syncthreads();
    if (tid == 0) { int s = 0; for (int e = 0; e < NE; ++e) { BASE[e] = s; s += (CNT[e] + BM - 1) / BM * BM; } BASE[NE] = s; CNT[NE] = p.nr; BASE[NE + 1] = s + p.nr;
        if (bid == 0) { for (int e = 0; e <= NEX; ++e) p.tilepre[e] = BASE[e] / BM; } }
    __syncthreads();
    if (bid >= p.blk0 && bid < p.blk0 + p.nbh) {
        const int rlo = p.r0 + (bid - p.blk0) * p.rpb;
        for (int i = tid; i < p.rpb * TOPK; i += NT) { const int r = rlo + i / TOPK, a = r * TOPK + i % TOPK, e = p.tope[a]; const int slot = BASE[e] + BOFF[e] + p.lrank[a];
            p.list[slot] = r; p.sdst[slot] = (r - p.r0) * SLOTS_PER_TOK + i % TOPK; p.sgate[slot] = p.gatev[a]; }
        for (int i = tid; i < p.rpb; i += NT) { const int r = rlo + i, slot = BASE[NE] + (r - p.r0); p.list[slot] = r; p.sdst[slot] = (r - p.r0) * SLOTS_PER_TOK + TOPK; p.sgate[slot] = 1.f; }
    }
    for (int e = bid; e < NE; e += nblk) { const int lo = BASE[e] + CNT[e], hi = BASE[e + 1]; for (int s = lo + tid; s < hi; s += NT) { p.list[s] = p.r0; p.sdst[s] = -1; p.sgate[s] = 0.f; } }
}
struct GroupOrder { int tpn, total, nN, G, c;
    __device__ void init(const int* tilepre, int nN_, int G_, int c_) { const int lane = threadIdx.x & 63;
        tpn = (int)__hip_atomic_load((const unsigned*)tilepre + lane + 1, __ATOMIC_RELAXED, __HIP_MEMORY_SCOPE_AGENT);
        total = (int)__hip_atomic_load((const unsigned*)tilepre + NEX, __ATOMIC_RELAXED, __HIP_MEMORY_SCOPE_AGENT); nN = nN_; G = G_; c = c_; }
    __device__ bool next(int i, Unit& u) const { const long L = (long)i * G + c; if (L >= (long)total * nN) return false;
        const int T = (int)(L / nN); const int e = __popcll(__ballot(tpn <= T));
        u.pm = T; u.pn = (int)(L % nN); u.e = __builtin_amdgcn_readfirstlane(e); return true; } };
struct EpiGU { static constexpr int NS = 16; bf16_t* act;
    __device__ __forceinline__ bool operator()(f32x4 (&acc)[2][2][4][2], const Unit& u, int wr, int wc, int fr, int fq) const {
        MK_FRAG_LOOP(r, c) { const f32x4 a = acc[ai][bj][m][0] * (1.f / (FP8_SU * FP8_SW)), b = acc[ai][bj][m][1] * (1.f / (FP8_SU * FP8_SW));
            *(unsigned*)((unsigned char*)act + (size_t)(u.pm * BM + r) * EF + ((u.pn * BM + c) >> 1)) =
                pack4_fp8(fast_silu(a[0]) * a[1] * FP8_SA, fast_silu(a[2]) * a[3] * FP8_SA, fast_silu(b[0]) * b[1] * FP8_SA, fast_silu(b[2]) * b[3] * FP8_SA); }
        return false; } };
struct EpiDown { const int* sdst; const float* sgate; bf16_t* rowsb; LAS unsigned char* lds;
    __device__ __forceinline__ void unit_begin(const Unit& u, LAS unsigned char* l) const {
        const int wid = __builtin_amdgcn_readfirstlane(threadIdx.x >> 6), lane = threadIdx.x & 63, w4 = wid & 3;
        const unsigned* src = (wid < 4 ? (const unsigned*)sdst : (const unsigned*)sgate) + (size_t)u.pm * BM + w4 * 64 + lane;
        __builtin_amdgcn_global_load_lds(src, (LAS unsigned*)(l + STAGE_BYTES + (wid < 4 ? 0 : 1024) + w4 * 256), 4, 0, 0); }
    __device__ __forceinline__ bool operator()(f32x4 (&acc)[2][2][4][2], const Unit& u, int wr, int wc, int fr, int fq) const {
        int dst[8]; float gt[8];
        const LAS int* LD = (const LAS int*)(lds + STAGE_BYTES); const LAS float* LG = (const LAS float*)(lds + STAGE_BYTES + 1024);
#pragma unroll
        for (int q = 0; q < 8; ++q) { const int sl = (q >> 2) * HALF + wr * 64 + (q & 3) * 16 + fr; dst[q] = LD[sl]; gt[q] = LG[sl]; }
#pragma unroll
        for (int ai = 0; ai < 2; ++ai)
#pragma unroll
            for (int m = 0; m < 4; ++m) { const int q = ai * 4 + m; const int dq = dst[q]; if (dq >= 0) {
#pragma unroll
                for (int bj = 0; bj < 2; ++bj) { f32x4 a = acc[ai][bj][m][0], b = acc[ai][bj][m][1];
#pragma unroll
                    for (int j = 0; j < 4; ++j) { a[j] *= gt[q] * (FP8_SR / (FP8_SA * FP8_SWD)); b[j] *= gt[q] * (FP8_SR / (FP8_SA * FP8_SWD)); }
                    u32x2 w8; w8.x = pack4_fp8(a[0], a[1], a[2], a[3]); w8.y = pack4_fp8(b[0], b[1], b[2], b[3]);
                    *(u32x2*)((unsigned char*)rowsb + (size_t)dq * D + u.pn * BM + bj * HALF + wc * 32 + 8 * fq) = w8; } } }
        return false; } };
__device__ __forceinline__ void final_rows(LAS float* sm  , const In& in, const float* modpart, const bf16_t* rowsb, float* h1out, int b0, int r0, int row_lo, int row_hi, bool dry = false) {
    const int tid = threadIdx.x, lane = tid & 63, wid = tid >> 6;
    const int mr = b0 + row_lo / SEQ;
    __syncthreads();
    for (int j = tid; j < D; j += NT) sm[j] = mod_value(in, modpart, mr, 5 * D + j);
    __syncthreads();
    float gq[16];
#pragma unroll
    for (int j = 0; j < 4; ++j)
#pragma unroll
        for (int q = 0; q < 4; ++q) gq[4 * j + q] = sm[j * 256 + lane * 4 + q] * in.norm_g[3 * D + j * 256 + lane * 4 + q];
    unsigned raw[SLOTS_PER_TOK][4]; f32x4 hraw[4];
    auto fetch = [&](int r) __attribute__((always_inline)) {
        const unsigned char* rb = (const unsigned char*)rowsb + (size_t)(r - r0) * SLOTS_PER_TOK * D; const float* hp = h1out + (size_t)r * D;
#pragma unroll
        for (int s = 0; s < SLOTS_PER_TOK; ++s)
#pragma unroll
            for (int j = 0; j < 4; ++j) raw[s][j] = *(const unsigned*)(rb + (size_t)s * D + j * 256 + lane * 4);
#pragma unroll
        for (int j = 0; j < 4; ++j) hraw[j] = *(const f32x4*)(hp + j * 256 + lane * 4); };
    if (row_lo + wid < row_hi) fetch(row_lo + wid);
    for (int r = row_lo + wid; r < row_hi; r += NT / 64) {
        float v[16];
#pragma unroll
        for (int j = 0; j < 16; ++j) v[j] = 0.f;
#pragma unroll
        for (int s = 0; s < SLOTS_PER_TOK; ++s)
#pragma unroll
            for (int j = 0; j < 4; ++j) { const int w = (int)raw[s][j]; const f32x2 lo = __builtin_amdgcn_cvt_pk_f32_fp8(w, false), hi = __builtin_amdgcn_cvt_pk_f32_fp8(w, true); v[4 * j] += lo.x; v[4 * j + 1] += lo.y; v[4 * j + 2] += hi.x; v[4 * j + 3] += hi.y; }
#pragma unroll
        for (int j = 0; j < 16; ++j) v[j] *= (1.f / FP8_SR);
        f32x4 hcur[4];
#pragma unroll
        for (int j = 0; j < 4; ++j) hcur[j] = hraw[j];
        if (r + NT / 64 < row_hi) fetch(r + NT / 64);
        float ss = 0.f;
#pragma unroll
        for (int j = 0; j < 16; ++j) ss += v[j] * v[j];
        ss = wave_sum64(ss);
        const float rinv = __builtin_amdgcn_rsqf(ss * (1.f / D) + NORM_EPS);
        float* hp = h1out + (size_t)r * D;
#pragma unroll
        for (int j = 0; j < 4; ++j) { const int c = j * 256 + lane * 4; f32x4 hv = hcur[j];
#pragma unroll
            for (int q = 0; q < 4; ++q) hv[q] += gq[4 * j + q] * (v[4 * j + q] * rinv);
            if (!dry) *(f32x4*)(hp + c) = hv; else if (hv[0] == 1.2345e30f) *(f32x4*)(hp + c) = hv; }
    }
}
__device__ __forceinline__ void rwt_prep(const In& in, bf16_t* rwt, int bid, int nblk) {
    for (int i = bid * NT + threadIdx.x; i < NE * D; i += nblk * NT) { const int e = i / D, k = i % D; const float w = in.router_w[(size_t)k * NE + e]; const bf16_t h = f2bf(w); rwt[i] = h; rwt[(size_t)NE * D + i] = f2bf(w - bf2f(h)); }
}
}

using namespace mk;
constexpr size_t MiB = (size_t)1 << 20;
constexpr int NLAT = NB * SEQ, NCTXR = NB * CTX, NALL = NLAT + NCTXR, NRH = NLAT / 2, MAXSLOTS = NRH * SLOTS_PER_TOK + NE * BM;
constexpr size_t O_W1A = 0, O_W1C = O_W1A + (size_t)Z1_N * D * 2, O_WG = O_W1C + (size_t)ZC_N * D * 2, O_WBR = O_WG + (size_t)RW * AG_K * 2, O_WOUT = O_WBR + (size_t)2 * D * RW * 2,
                 O_RWT = O_WOUT + (size_t)D * D * 2, O_MODP = O_RWT + (size_t)2 * NE * D * 2, O_S_END = O_MODP + (size_t)MOD_SL * (NB + 1) * 6 * D * 4;
static_assert(O_S_END <= 27 * MiB, "S region");
constexpr size_t O_BAR = 27 * MiB;
constexpr size_t O_Z1 = 28 * MiB, O_R2 = O_Z1 + (size_t)NALL * Z1_N * 2;
static_assert(O_R2 == 334 * MiB, "z1 size");
constexpr size_t O_HD = O_R2, O_BON = O_W1A + (size_t)Z1_N * D  , O_AG = O_HD + (size_t)2 * NLAT * LW * 2,
                 O_XNL8 = O_AG + (size_t)NLAT * AG_K * 2  , O_R2_END = O_XNL8 + (size_t)NLAT * D;
static_assert(O_BON + (size_t)2 * NLAT * NH * 4 <= O_W1C, "bon");
static_assert(O_R2_END <= 512 * MiB, "R2");
constexpr size_t O_XNL = O_Z1, O_YB = O_XNL + (size_t)NLAT * D * 2, O_GATES = O_YB + (size_t)NLAT * LW * 2, O_MIXED = O_HD;
static_assert(O_GATES + (size_t)NLAT * 2 * D * 2 <= O_R2, "late R1");
constexpr size_t O_U = O_Z1, O_WGU = O_U + (size_t)NLAT * D * 2, O_WDN = O_WGU + (size_t)NEX * 2 * EF * D * 2, O_ROUT = O_WDN + (size_t)NEX * D * EF * 2;
constexpr size_t O_TOPE = O_ROUT, O_LRANK = O_TOPE + (size_t)NLAT * TOPK * 4, O_GATEV = O_LRANK + (size_t)NLAT * TOPK * 4, O_BLKCNT = O_GATEV + (size_t)NLAT * TOPK * 4, O_TILEPRE = O_BLKCNT + 256 * 64 * 4,
                 O_LIST = O_TILEPRE + 2048, O_SDST = O_LIST + (size_t)2 * MAXSLOTS * 4, O_SGATE = O_SDST + (size_t)2 * MAXSLOTS * 4, O_ACT = ((O_SGATE + (size_t)2 * MAXSLOTS * 4 + 255) / 256) * 256,
                 O_ROWSB = ((O_ACT + (size_t)MAXSLOTS * EF * 2 + 255) / 256) * 256, O_END = O_ROWSB + ((size_t)NRH * SLOTS_PER_TOK + 1) * D * 2;
static_assert(O_END <= 512 * MiB, "workspace");
constexpr size_t O_U8 = O_WGU + (size_t)NEX * 2 * EF * D;
static_assert(O_U8 + (size_t)NLAT * D <= O_WDN, "u8");
static_assert(O_WGU >= O_YB && O_ROWSB >= O_GATES, "late layout");

struct MP { In in; float* out; unsigned char* ws; long ph_lo, ph_hi; };
constexpr int NPHASE = 16;

#if defined(__HIP_DEVICE_COMPILE__)
#define MK_KARGS auto Pq_ = Pk_; asm volatile("" : "+s"(Pq_)); const MP* Pg_ = (const MP*)Pq_; const In in = Pg_->in; unsigned char* ws = Pg_->ws; float* out_ = Pg_->out; (void)out_;
#else
#define MK_KARGS const In in = P.in; unsigned char* ws = P.ws; float* out_ = P.out; (void)out_; (void)Pk_;
#endif
#define MK_PHASE_PTRS \
    MK_KARGS \
    bf16_t *W1a = (bf16_t*)(ws + O_W1A), *W1c = (bf16_t*)(ws + O_W1C), *Wg = (bf16_t*)(ws + O_WG), *Wbr = (bf16_t*)(ws + O_WBR), *Wout = (bf16_t*)(ws + O_WOUT), *rwt = (bf16_t*)(ws + O_RWT); \
    float* modpart = (float*)(ws + O_MODP); \
    bf16_t *z1 = (bf16_t*)(ws + O_Z1), *Hd = (bf16_t*)(ws + O_HD), *Ag = (bf16_t*)(ws + O_AG); float* bon = (float*)(ws + O_BON); \
    bf16_t *xnl = (bf16_t*)(ws + O_XNL8), *yb = (bf16_t*)(ws + O_YB), *gates = (bf16_t*)(ws + O_GATES), *mixed = (bf16_t*)(ws + O_MIXED); \
    unsigned char* u8 = ws + O_U8; \
    bf16_t *u = (bf16_t*)(ws + O_U), *Wgu = (bf16_t*)(ws + O_WGU), *Wdn = (bf16_t*)(ws + O_WDN), *act = (bf16_t*)(ws + O_ACT), *rowsb = (bf16_t*)(ws + O_ROWSB); \
    int *tope = (int*)(ws + O_TOPE), *lrank = (int*)(ws + O_LRANK), *blkcnt = (int*)(ws + O_BLKCNT), *tilepre = (int*)(ws + O_TILEPRE), *list = (int*)(ws + O_LIST), *sdst = (int*)(ws + O_SDST); \
    float *gatev = (float*)(ws + O_GATEV), *sgate = (float*)(ws + O_SGATE); \
    bf16_t* xn_all = (bf16_t*)out_; \
    bf16_t* Y = (bf16_t*)out_; \
    float* y2h1 = out_;
__device__ __forceinline__ void stagger_start(int bid, int ticks  ) {
    const int grp = (bid >> 3) & 3;
    if (grp) { const unsigned long long t0 = __builtin_amdgcn_s_memrealtime(); while (__builtin_amdgcn_s_memrealtime() - t0 < (unsigned long long)(grp * ticks)) __builtin_amdgcn_s_sleep(8); }
    __builtin_amdgcn_s_waitcnt(0xC07F);
}

__global__ void __launch_bounds__(512, 2) mega(MP P) {
    extern __shared__ __attribute__((aligned(16))) unsigned char shm[];
    LAS unsigned char* lds = (LAS unsigned char*)shm;
    typedef const __attribute__((address_space(4))) MP* KargP;
    const KargP Pk_ = (KargP)__builtin_amdgcn_kernarg_segment_ptr();
    const int bid = blockIdx.x, nblk = gridDim.x;
    const int gbid = (nblk & 7) ? bid : (bid & 7) * (nblk >> 3) + (bid >> 3);
    const int ph_lo = (int)P.ph_lo, ph_hi = (int)P.ph_hi;
    volatile LAS unsigned* xst = (volatile LAS unsigned*)(lds + LDS_BYTES - 16);
    if (threadIdx.x == 0) { xst[0] = 0u; xst[1] = 0u; }
    __syncthreads();
    const XcdBarrier xb = xcd_barrier_post((unsigned*)(P.ws + O_BAR), xst);
    if (0 >= ph_lo && 0 < ph_hi) { if (0 > ph_lo) xcd_barrier(xb); const int ph = 0; (void)ph; MK_PHASE_PTRS
        { LAS float* tile = (LAS float*)lds; int base = 0;
            convT_job<true>(tile, in.w_in, INC, D, W1a, D, Z1_N, CMapZ1{}, bid, nblk, base, 256.f);
            convT_job<true>(tile, in.w_in, INC, D, W1c, D, ZC_N, CMapZC{}, bid, nblk, base, 256.f);
            convT_job(tile, in.rw_g_up, RW, GL, Wg, AG_K, RW, CMapId{}, bid, nblk, base);
            convT_job(tile, in.w_branch_a, D, RW, Wbr, RW, D, CMapId{}, bid, nblk, base);
            convT_job(tile, in.w_branch_b, D, LW, Wbr + (size_t)D * RW, LW, D, CMapId{}, bid, nblk, base);
            convT_job(tile, in.w_out, D, D, Wout, D, D, CMapId{}, bid, nblk, base);
            rwt_prep(in, rwt, bid, nblk);
            mod_partials((LAS float*)lds, in, modpart, bid, nblk); }
    }
    if (1 >= ph_lo && 1 < ph_hi) { if (1 > ph_lo) xcd_barrier(xb); const int ph = 1; (void)ph; MK_PHASE_PTRS
        { const int L = NLAT / nblk, Lc = NCTXR / nblk;
            xn_rows<true>((LAS float*)lds, in, modpart, xn_all, 0, NB, bid * L, (bid + 1) * L, (unsigned char*)xnl);
            xn_rows<true>((LAS float*)lds, in, modpart, xn_all, 0, NB, NLAT + bid * Lc, NLAT + (bid + 1) * Lc); }
    }
    if (2 >= ph_lo && 2 < ph_hi) { if (2 > ph_lo) xcd_barrier(xb); const int ph = 2; (void)ph; MK_PHASE_PTRS
        { GemmP g{xn_all, xn_all, W1a, 0, nullptr, D / 2, 0}; StaticOrder S; S.init(NALL, Z1_N, nblk, bid); gemm_phase<false, true>(lds, g, S, EpiStoreBf16S{z1, Z1_N, 1.f / 4096.f, 0}); }
    }
    if (3 >= ph_lo && 3 < ph_hi) { if (3 > ph_lo) xcd_barrier(xb); const int ph = 3; (void)ph; MK_PHASE_PTRS
        { LruP lp{z1, Hd, 0, NB}; lru_phase(lds, in, lp, bid, nblk); __syncthreads();
                  RwkvP rp{z1, Y, bon, 0, NB}; r3::rwkv_phase3(lds, in, rp, bid, nblk); }
    }
    if (4 >= ph_lo && 4 < ph_hi) { if (4 > ph_lo) xcd_barrier(xb); const int ph = 4; (void)ph; MK_PHASE_PTRS
        { const int L = NLAT / nblk; PostP pp{z1, Y, bon, Ag, NLAT, 0}; rwkv_post_rows((LAS float*)lds, in, pp, bid * L, (bid + 1) * L); }
    }
    if (5 >= ph_lo && 5 < ph_hi) { if (5 > ph_lo) xcd_barrier(xb); const int ph = 5; (void)ph; MK_PHASE_PTRS
        { const int L = NLAT / nblk;
            (void)L;
            { GemmP g{Ag, Ag, Wg, 0, nullptr, AG_K, 0}; StaticOrder S; S.init(NLAT, RW, nblk, bid); gemm_phase(lds, g, S, EpiYa{Y, Y + (size_t)NLAT * RW}); }
            }
    }
    if (6 >= ph_lo && 6 < ph_hi) { if (6 > ph_lo) xcd_barrier(xb); const int ph = 6; (void)ph; MK_PHASE_PTRS
        { GemmP g{xnl, xnl, W1c, 0, nullptr, D / 2, 0}; StaticOrder S; S.init(NLAT, ZC_N, nblk, bid); gemm_phase<false, true>(lds, g, S, EpiZc{Hd, yb, gates, NLAT, 1.f / 4096.f}); }
    }
    if (7 >= ph_lo && 7 < ph_hi) { if (7 > ph_lo) xcd_barrier(xb); const int ph = 7; (void)ph; MK_PHASE_PTRS
        { GemmP g{Y + (size_t)NLAT * RW, yb, Wbr, (long)D * RW, nullptr, D, 0}; PairOrder S; S.S.init(NLAT, D, nblk, bid); gemm_phase(lds, g, S, EpiBranch{gates, mixed}); }
    }
    if (8 >= ph_lo && 8 < ph_hi) { if (8 > ph_lo) xcd_barrier(xb); const int ph = 8; (void)ph; MK_PHASE_PTRS
        { LAS float* tile = (LAS float*)lds;
            struct MGU { const float* ex; const float* sh; unsigned char* d; __device__ const float* src(int m) const { return m < NE ? ex + (size_t)m * D * 2 * EF : sh; } __device__ unsigned char* dst(int m) const { return d + (size_t)m * 2 * EF * D; } };
            struct MDN { const float* ex; const float* sh; unsigned char* d; __device__ const float* src(int m) const { return m < NE ? ex + (size_t)m * EF * D : sh; } __device__ unsigned char* dst(int m) const { return d + (size_t)m * D * EF; } };
            auto conv = [&]() __attribute__((always_inline)) {
                convT_multi<true>(tile, MGU{in.ex_w_gu, in.sh_w_gu, (unsigned char*)Wgu}, NEX, 2 * EF, D, D, 2 * EF, CMapGU{EF}, bid, nblk, FP8_SW);
                convT_multi<true>(tile, MDN{in.ex_w_down, in.sh_w_down, (unsigned char*)Wdn}, NEX, D, EF, EF, D, CMapId{}, bid, nblk, FP8_SWD); };
            if (bid & 1) { conv(); __syncthreads(); }
            { GemmP g{mixed, mixed, Wout, 0, nullptr, D, 0}; StaticOrder S; S.init(NLAT, D, nblk, bid); gemm_phase(lds, g, S, EpiStoreBf16{u, D}); }
            if (!(bid & 1)) { __syncthreads(); conv(); } }
    }
    if (9 >= ph_lo && 9 < ph_hi) { if (9 > ph_lo) xcd_barrier(xb); const int ph = 9; (void)ph; MK_PHASE_PTRS
        { const int L = NLAT / nblk; RowP rp{y2h1, u, u8, modpart, rwt, tope, gatev, lrank, blkcnt, 0, NLAT}; row_pass(lds, in, rp, bid * L, (bid + 1) * L); }
    }
    if (10 >= ph_lo && 10 < ph_hi) { if (10 > ph_lo) xcd_barrier(xb); const int ph = 10; (void)ph; MK_PHASE_PTRS
        { const int q = ph - 10, half = q >= 4 ? 1 : 0, st = q - 4 * half;
            const int rpb = NLAT / nblk;
            auto assign = [&](int hf) { MoeP mp{tope, gatev, lrank, blkcnt, tilepre + hf * 256, list + (size_t)hf * MAXSLOTS, sdst + (size_t)hf * MAXSLOTS, sgate + (size_t)hf * MAXSLOTS, hf * NRH, NRH, hf * (nblk / 2), nblk / 2, rpb, 0}; moe_assign(lds, mp, bid, nblk); };
            auto fin = [&](int hf) { const int L = NRH / nblk, r0 = hf * NRH; final_rows((LAS float*)lds, in, modpart, rowsb, y2h1, 0, r0, r0 + bid * L, r0 + (bid + 1) * L); };
            if (ph == 10) { assign(0); __syncthreads(); assign(1); }
            else if (ph == 11 || ph == 13) { const int hf = ph == 13 ? 1 : 0;
                if (ph == 13 && (bid & 1)) { fin(0); __syncthreads(); }
                { GemmP g{(const bf16_t*)u8, (const bf16_t*)u8, Wgu, (long)EF * D, list + (size_t)hf * MAXSLOTS, D / 2, 0}; GroupOrder S; S.init(tilepre + hf * 256, 2 * EF / BM, nblk, gbid); gemm_phase<true, true>(lds, g, S, EpiGU{act}); }
                if (ph == 13 && !(bid & 1)) { __syncthreads(); fin(0); } }
            else if (ph == 12 || ph == 14) { const int hf = ph == 14 ? 1 : 0;
                GemmP g{act, act, Wdn, (long)D * EF / 2, nullptr, EF / 2, 0}; GroupOrder S; S.init(tilepre + hf * 256, D / BM, nblk, gbid); gemm_phase<false, true>(lds, g, S, EpiDown{sdst + (size_t)hf * MAXSLOTS, sgate + (size_t)hf * MAXSLOTS, rowsb, lds}); }
            else if (ph == 15) fin(1);
            (void)half; (void)st; }
    }
    if (11 >= ph_lo && 11 < ph_hi) { if (11 > ph_lo) xcd_barrier(xb); const int ph = 11; (void)ph; MK_PHASE_PTRS
        { const int q = ph - 10, half = q >= 4 ? 1 : 0, st = q - 4 * half;
            const int rpb = NLAT / nblk;
            auto assign = [&](int hf) { MoeP mp{tope, gatev, lrank, blkcnt, tilepre + hf * 256, list + (size_t)hf * MAXSLOTS, sdst + (size_t)hf * MAXSLOTS, sgate + (size_t)hf * MAXSLOTS, hf * NRH, NRH, hf * (nblk / 2), nblk / 2, rpb, 0}; moe_assign(lds, mp, bid, nblk); };
            auto fin = [&](int hf) { const int L = NRH / nblk, r0 = hf * NRH; final_rows((LAS float*)lds, in, modpart, rowsb, y2h1, 0, r0, r0 + bid * L, r0 + (bid + 1) * L); };
            if (ph == 10) { assign(0); __syncthreads(); assign(1); }
            else if (ph == 11 || ph == 13) { const int hf = ph == 13 ? 1 : 0;
                if (ph == 13 && (bid & 1)) { fin(0); __syncthreads(); }
                { GemmP g{(const bf16_t*)u8, (const bf16_t*)u8, Wgu, (long)EF * D, list + (size_t)hf * MAXSLOTS, D / 2, 0}; GroupOrder S; S.init(tilepre + hf * 256, 2 * EF / BM, nblk, gbid); gemm_phase<true, true>(lds, g, S, EpiGU{act}); }
                if (ph == 13 && !(bid & 1)) { __syncthreads(); fin(0); } }
            else if (ph == 12 || ph == 14) { const int hf = ph == 14 ? 1 : 0;
                GemmP g{act, act, Wdn, (long)D * EF / 2, nullptr, EF / 2, 0}; GroupOrder S; S.init(tilepre + hf * 256, D / BM, nblk, gbid); gemm_phase<false, true>(lds, g, S, EpiDown{sdst + (size_t)hf * MAXSLOTS, sgate + (size_t)hf * MAXSLOTS, rowsb, lds}); }
            else if (ph == 15) fin(1);
            (void)half; (void)st; }
    }
    if (12 >= ph_lo && 12 < ph_hi) { if (12 > ph_lo) xcd_barrier(xb); const int ph = 12; (void)ph; MK_PHASE_PTRS
        { const int q = ph - 10, half = q >= 4 ? 1 : 0, st = q - 4 * half;
            const int rpb = NLAT / nblk;
            auto assign = [&](int hf) { MoeP mp{tope, gatev, lrank, blkcnt, tilepre + hf * 256, list + (size_t)hf * MAXSLOTS, sdst + (size_t)hf * MAXSLOTS, sgate + (size_t)hf * MAXSLOTS, hf * NRH, NRH, hf * (nblk / 2), nblk / 2, rpb, 0}; moe_assign(lds, mp, bid, nblk); };
            auto fin = [&](int hf) { const int L = NRH / nblk, r0 = hf * NRH; final_rows((LAS float*)lds, in, modpart, rowsb, y2h1, 0, r0, r0 + bid * L, r0 + (bid + 1) * L); };
            if (ph == 10) { assign(0); __syncthreads(); assign(1); }
            else if (ph == 11 || ph == 13) { const int hf = ph == 13 ? 1 : 0;
                if (ph == 13 && (bid & 1)) { fin(0); __syncthreads(); }
                { GemmP g{(const bf16_t*)u8, (const bf16_t*)u8, Wgu, (long)EF * D, list + (size_t)hf * MAXSLOTS, D / 2, 0}; GroupOrder S; S.init(tilepre + hf * 256, 2 * EF / BM, nblk, gbid); gemm_phase<true, true>(lds, g, S, EpiGU{act}); }
                if (ph == 13 && !(bid & 1)) { __syncthreads(); fin(0); } }
            else if (ph == 12 || ph == 14) { const int hf = ph == 14 ? 1 : 0;
                GemmP g{act, act, Wdn, (long)D * EF / 2, nullptr, EF / 2, 0}; GroupOrder S; S.init(tilepre + hf * 256, D / BM, nblk, gbid); gemm_phase<false, true>(lds, g, S, EpiDown{sdst + (size_t)hf * MAXSLOTS, sgate + (size_t)hf * MAXSLOTS, rowsb, lds}); }
            else if (ph == 15) fin(1);
            (void)half; (void)st; }
    }
    if (13 >= ph_lo && 13 < ph_hi) { if (13 > ph_lo) xcd_barrier(xb); const int ph = 13; (void)ph; MK_PHASE_PTRS
        { const int q = ph - 10, half = q >= 4 ? 1 : 0, st = q - 4 * half;
            const int rpb = NLAT / nblk;
            auto assign = [&](int hf) { MoeP mp{tope, gatev, lrank, blkcnt, tilepre + hf * 256, list + (size_t)hf * MAXSLOTS, sdst + (size_t)hf * MAXSLOTS, sgate + (size_t)hf * MAXSLOTS, hf * NRH, NRH, hf * (nblk / 2), nblk / 2, rpb, 0}; moe_assign(lds, mp, bid, nblk); };
            auto fin = [&](int hf) { const int L = NRH / nblk, r0 = hf * NRH; final_rows((LAS float*)lds, in, modpart, rowsb, y2h1, 0, r0, r0 + bid * L, r0 + (bid + 1) * L); };
            if (ph == 10) { assign(0); __syncthreads(); assign(1); }
            else if (ph == 11 || ph == 13) { const int hf = ph == 13 ? 1 : 0;
                if (ph == 13 && (bid & 1)) { fin(0); __syncthreads(); }
                { GemmP g{(const bf16_t*)u8, (const bf16_t*)u8, Wgu, (long)EF * D, list + (size_t)hf * MAXSLOTS, D / 2, 0}; GroupOrder S; S.init(tilepre + hf * 256, 2 * EF / BM, nblk, gbid); gemm_phase<true, true>(lds, g, S, EpiGU{act}); }
                if (ph == 13 && !(bid & 1)) { __syncthreads(); fin(0); } }
            else if (ph == 12 || ph == 14) { const int hf = ph == 14 ? 1 : 0;
                GemmP g{act, act, Wdn, (long)D * EF / 2, nullptr, EF / 2, 0}; GroupOrder S; S.init(tilepre + hf * 256, D / BM, nblk, gbid); gemm_phase<false, true>(lds, g, S, EpiDown{sdst + (size_t)hf * MAXSLOTS, sgate + (size_t)hf * MAXSLOTS, rowsb, lds}); }
            else if (ph == 15) fin(1);
            (void)half; (void)st; }
    }
    if (14 >= ph_lo && 14 < ph_hi) { if (14 > ph_lo) xcd_barrier(xb); const int ph = 14; (void)ph; MK_PHASE_PTRS
        { const int q = ph - 10, half = q >= 4 ? 1 : 0, st = q - 4 * half;
            const int rpb = NLAT / nblk;
            auto assign = [&](int hf) { MoeP mp{tope, gatev, lrank, blkcnt, tilepre + hf * 256, list + (size_t)hf * MAXSLOTS, sdst + (size_t)hf * MAXSLOTS, sgate + (size_t)hf * MAXSLOTS, hf * NRH, NRH, hf * (nblk / 2), nblk / 2, rpb, 0}; moe_assign(lds, mp, bid, nblk); };
            auto fin = [&](int hf) { const int L = NRH / nblk, r0 = hf * NRH; final_rows((LAS float*)lds, in, modpart, rowsb, y2h1, 0, r0, r0 + bid * L, r0 + (bid + 1) * L); };
            if (ph == 10) { assign(0); __syncthreads(); assign(1); }
            else if (ph == 11 || ph == 13) { const int hf = ph == 13 ? 1 : 0;
                if (ph == 13 && (bid & 1)) { fin(0); __syncthreads(); }
                { GemmP g{(const bf16_t*)u8, (const bf16_t*)u8, Wgu, (long)EF * D, list + (size_t)hf * MAXSLOTS, D / 2, 0}; GroupOrder S; S.init(tilepre + hf * 256, 2 * EF / BM, nblk, gbid); gemm_phase<true, true>(lds, g, S, EpiGU{act}); }
                if (ph == 13 && !(bid & 1)) { __syncthreads(); fin(0); } }
            else if (ph == 12 || ph == 14) { const int hf = ph == 14 ? 1 : 0;
                GemmP g{act, act, Wdn, (long)D * EF / 2, nullptr, EF / 2, 0}; GroupOrder S; S.init(tilepre + hf * 256, D / BM, nblk, gbid); gemm_phase<false, true>(lds, g, S, EpiDown{sdst + (size_t)hf * MAXSLOTS, sgate + (size_t)hf * MAXSLOTS, rowsb, lds}); }
            else if (ph == 15) fin(1);
            (void)half; (void)st; }
    }
    if (15 >= ph_lo && 15 < ph_hi) { if (15 > ph_lo) xcd_barrier(xb); const int ph = 15; (void)ph; MK_PHASE_PTRS
        { const int q = ph - 10, half = q >= 4 ? 1 : 0, st = q - 4 * half;
            const int rpb = NLAT / nblk;
            auto assign = [&](int hf) { MoeP mp{tope, gatev, lrank, blkcnt, tilepre + hf * 256, list + (size_t)hf * MAXSLOTS, sdst + (size_t)hf * MAXSLOTS, sgate + (size_t)hf * MAXSLOTS, hf * NRH, NRH, hf * (nblk / 2), nblk / 2, rpb, 0}; moe_assign(lds, mp, bid, nblk); };
            auto fin = [&](int hf) { const int L = NRH / nblk, r0 = hf * NRH; final_rows((LAS float*)lds, in, modpart, rowsb, y2h1, 0, r0, r0 + bid * L, r0 + (bid + 1) * L); };
            if (ph == 10) { assign(0); __syncthreads(); assign(1); }
            else if (ph == 11 || ph == 13) { const int hf = ph == 13 ? 1 : 0;
                if (ph == 13 && (bid & 1)) { fin(0); __syncthreads(); }
                { GemmP g{(const bf16_t*)u8, (const bf16_t*)u8, Wgu, (long)EF * D, list + (size_t)hf * MAXSLOTS, D / 2, 0}; GroupOrder S; S.init(tilepre + hf * 256, 2 * EF / BM, nblk, gbid); gemm_phase<true, true>(lds, g, S, EpiGU{act}); }
                if (ph == 13 && !(bid & 1)) { __syncthreads(); fin(0); } }
            else if (ph == 12 || ph == 14) { const int hf = ph == 14 ? 1 : 0;
                GemmP g{act, act, Wdn, (long)D * EF / 2, nullptr, EF / 2, 0}; GroupOrder S; S.init(tilepre + hf * 256, D / BM, nblk, gbid); gemm_phase<false, true>(lds, g, S, EpiDown{sdst + (size_t)hf * MAXSLOTS, sgate + (size_t)hf * MAXSLOTS, rowsb, lds}); }
            else if (ph == 15) fin(1);
            (void)half; (void)st; }
    }
}
extern "C" void kernel_launch(void* const* d_in, const int* in_sizes, int n_in, void* d_out, int out_size, void* d_ws, size_t ws_size, hipStream_t stream) {
    static int grid = 0;
    if (grid == 0) {
        int dev = 0, cus = 0; hipGetDevice(&dev); hipDeviceGetAttribute(&cus, hipDeviceAttributeMultiprocessorCount, dev);
        hipFuncSetAttribute((const void*)mega, hipFuncAttributeMaxDynamicSharedMemorySize, LDS_BYTES);
        grid = cus;
        if (ws_size < O_END || grid != 256) fprintf(stderr, "kernel_launch: unexpected ws_size %zu (need %zu) or CU count %d\n", ws_size, (size_t)O_END, grid);
    }
    hipMemsetAsync((char*)d_ws + O_BAR, 0, XCD_BAR_WORDS * 4, stream);
    MP P; memset(&P, 0, sizeof(P));
    const float** f = (const float**)&P.in; for (int i = 0; i < 32; ++i) f[i] = (const float*)d_in[i];
    P.out = (float*)d_out; P.ws = (unsigned char*)d_ws;
#ifdef MK_PER_PHASE
    for (int ph = 0; ph < NPHASE; ++ph) { P.ph_lo = ph; P.ph_hi = ph + 1; hipLaunchKernelGGL(mega, dim3(grid), dim3(NT), LDS_BYTES, stream, P); }
#else
    P.ph_lo = 0; P.ph_hi = NPHASE;
    void* args[] = {&P};
    hipError_t e = hipLaunchCooperativeKernel((void*)mega, dim3(grid), dim3(NT), args, LDS_BYTES, stream);
    if (e != hipSuccess) fprintf(stderr, "cooperative launch failed: %s (grid %d)\n", hipGetErrorString(e), grid);
#endif
}
```

```cpp
#include <hip/hip_runtime.h>
#include <cstdio>
#include <cstring>
#define HD __host__ __device__ __forceinline__
static hipStream_t g_stream;

#ifdef SMALL
constexpr int D = 128, NB = 2, SEQ = 64, GW = 8, CTX = 16, RW = 128, RH = 64, DL = 16, AL = 16, GL = 24, LW = 128, LB = 2, NE = 8, TOPK = 3, NG = 4, TG = 2, EF = 32, SF = 32;
#else
constexpr int D = 1024, NB = 8, SEQ = 4096, GW = 64, CTX = 256, RW = 1024, RH = 64, DL = 64, AL = 64, GL = 160, LW = 1024, LB = 16, NE = 64, TOPK = 6, NG = 8, TG = 4, EF = 256, SF = 256;
#endif
constexpr int NH = RW / RH, LBS = LW / LB, ROWS = SEQ / GW, TA = CTX + SEQ;
constexpr int OFF_R = 0, OFF_K = RW, OFF_V = 2 * RW, OFF_WD = 3 * RW, OFF_AD = OFF_WD + 2 * DL, OFF_GD = OFF_AD + 2 * AL, RC = OFF_GD + GL;
constexpr int OFF_LX = RC, OFF_LG = OFF_LX + LW, OFF_GATE = OFF_LG + LW, INC = OFF_GATE + 2 * D;
constexpr int EPG = NE / NG, NASG = SEQ * TOPK;
#define NORM_EPS 1e-6f
#define LNX_EPS 64e-5f

HD float sigmoidf_(float x) { return 1.f / (1.f + expf(-x)); }
HD float softplusf_(float x) { return x > 20.f ? x : log1pf(expf(x)); }
HD float siluf_(float x) { return x * sigmoidf_(x); }
HD float gelu_tanhf_(float x) { return 0.5f * x * (1.f + tanhf(0.7978845608028654f * (x + 0.044715f * x * x * x))); }

struct In {
    const float *x, *c, *ctx, *c_ctx, *w_mod, *b_mod, *norm_g, *w_in, *shift_mu, *rw_w0, *rw_w_up, *rw_a0, *rw_a_up, *rw_g_up, *rw_k_k, *rw_k_a, *rw_r_k, *rw_lnx,
        *lru_conv_w, *lru_conv_b, *lru_gate_w, *lru_gate_b, *lru_l, *w_branch_a, *w_branch_b, *w_out, *router_w, *router_b, *ex_w_gu, *ex_w_down, *sh_w_gu, *sh_w_down;
};


namespace mk {
#define LAS __attribute__((address_space(3)))
typedef unsigned short bf16_t;
typedef short bf16x8 __attribute__((ext_vector_type(8)));
typedef float f32x4 __attribute__((ext_vector_type(4)));
typedef float f32x2 __attribute__((ext_vector_type(2)));
typedef int i32x4 __attribute__((ext_vector_type(4)));
typedef int i32x8 __attribute__((ext_vector_type(8)));
typedef unsigned u32x4 __attribute__((ext_vector_type(4)));
typedef unsigned u32x2 __attribute__((ext_vector_type(2)));
constexpr int NT = 512;
constexpr int BM = 256, BK = 64, HALF = 128, HTB = HALF * BK * 2, STAGE_BYTES = 8 * HTB;
constexpr int LDS_BYTES = 160 * 1024 - 1024;

constexpr int Z1_LX = 3584, Z1_N = 4608;
constexpr int ZC_N = 3072;

__device__ __forceinline__ unsigned cvt_pk_bf16(float lo, float hi) { unsigned r; asm volatile("s_nop 0\n\tv_cvt_pk_bf16_f32 %0, %1, %2" : "=v"(r) : "v"(lo), "v"(hi)); return r; }
__device__ __forceinline__ bf16_t f2bf(float f) { unsigned u = __float_as_uint(f); u += 0x7FFFu + ((u >> 16) & 1u); return (bf16_t)(u >> 16); }
__device__ __forceinline__ float bf2f(bf16_t b) { return __uint_as_float(((unsigned)b) << 16); }
__device__ __forceinline__ float bflo(unsigned w) { return __uint_as_float(w << 16); }
__device__ __forceinline__ float bfhi(unsigned w) { return __uint_as_float(w & 0xffff0000u); }

#define MK_DPPF(x, ctrl) __int_as_float(__builtin_amdgcn_update_dpp(__float_as_int(x), __float_as_int(x), ctrl, 0xF, 0xF, false))
__device__ __forceinline__ float wave_sum64(float x) {
    x += MK_DPPF(x, 0xB1); x += MK_DPPF(x, 0x4E); x += MK_DPPF(x, 0x141); x += MK_DPPF(x, 0x140);
    const int xi = __float_as_int(x);
    return (__int_as_float(__builtin_amdgcn_readlane(xi, 0)) + __int_as_float(__builtin_amdgcn_readlane(xi, 16))) + (__int_as_float(__builtin_amdgcn_readlane(xi, 32)) + __int_as_float(__builtin_amdgcn_readlane(xi, 48)));
}
__device__ __forceinline__ float wave_max64(float x) {
    x = fmaxf(x, MK_DPPF(x, 0xB1)); x = fmaxf(x, MK_DPPF(x, 0x4E)); x = fmaxf(x, MK_DPPF(x, 0x141)); x = fmaxf(x, MK_DPPF(x, 0x140));
    const int xi = __float_as_int(x);
    return fmaxf(fmaxf(__int_as_float(__builtin_amdgcn_readlane(xi, 0)), __int_as_float(__builtin_amdgcn_readlane(xi, 16))), fmaxf(__int_as_float(__builtin_amdgcn_readlane(xi, 32)), __int_as_float(__builtin_amdgcn_readlane(xi, 48))));
}
__device__ __forceinline__ float fast_rcp(float x) { return __builtin_amdgcn_rcpf(x); }
__device__ __forceinline__ float fast_sigmoid(float x) { return fast_rcp(1.f + __expf(-x)); }
__device__ __forceinline__ float fast_tanh(float x) { return 1.f - 2.f * fast_rcp(1.f + __expf(2.f * x)); }
__device__ __forceinline__ float fast_softplus(float x) { return x > 15.f ? x : __logf(1.f + __expf(x)); }
__device__ __forceinline__ float fast_silu(float x) { return x * fast_sigmoid(x); }
__device__ __forceinline__ float fast_gelu_tanh(float x) { return x * fast_sigmoid(1.5957691216057308f * (x + 0.044715f * x * x * x)); }
__device__ __forceinline__ int lds_byte(int r, int c) { const int st = (r >> 4) * 2 + (c >> 5), rr = r & 15, cc = c & 31, ob = rr * 64 + cc * 2; return st * 1024 + (ob ^ (((ob >> 9) & 1) << 5)); }
__device__ __forceinline__ void stage_rc(int b, int& R, int& C) { const int st = b / 1024, sb = b % 1024, swz = sb ^ (((sb >> 9) & 1) << 5); R = (st >> 1) * 16 + swz / 64; C = (st & 1) * 32 + (swz % 64) / 2; }
__device__ __forceinline__ int perm32(int rho) { const int n = rho >> 4, i = rho & 15; return 8 * (i >> 2) + 4 * n + (i & 3); }

struct Unit { int pm, pn, e; };
struct GemmP { const bf16_t* A0; const bf16_t* A1; const bf16_t* Bt; long strideB; const int* gather; int K; int pad_; };

struct StaticOrder {
    int nM, nN, nwg, G, c;
    __device__ void init(int M, int N, int G_, int c_) { nM = M / BM; nN = N / BM; nwg = nM * nN; G = G_; c = c_; }
    __device__ bool next(int i, Unit& u) const {
        const long L = (long)i * G + c; if (L >= nwg) return false;
        int wgid = (int)L; { const int q = nwg / 8, r = nwg % 8, xcd = wgid % 8, off = wgid / 8; wgid = (xcd < r ? xcd * (q + 1) : r * (q + 1) + (xcd - r) * q) + off; }
        const int nig = 8 * nN, gid = wgid / nig, fm = gid * 8, gsz = (nM - fm) < 8 ? (nM - fm) : 8;
        u.pm = fm + ((wgid % nig) % gsz); u.pn = (wgid % nig) / gsz; u.e = 0; return true;
    }
};

#define MK_FRAG_LOOP(ROW, COL) \
    _Pragma("unroll") for (int ai = 0; ai < 2; ++ai) _Pragma("unroll") for (int m = 0; m < 4; ++m) _Pragma("unroll") for (int bj = 0; bj < 2; ++bj) \
        if (const int ROW = ai * HALF + wr * 64 + m * 16 + fr; true) if (const int COL = bj * HALF + wc * 32 + 8 * fq; true)

template <class E, class = void> struct epi_has_begin { static constexpr bool value = false; };
template <class E> struct epi_has_begin<E, decltype((void)&E::unit_begin)> { static constexpr bool value = true; };
template <bool B> struct BoolC { static constexpr bool value = B; };
template <class E, class = void> struct epi_ns { static constexpr int value = 0; };
template <class E> struct epi_ns<E, decltype((void)E::NS)> { static constexpr int value = 0 * E::NS; };
template <class E> __device__ __forceinline__ void epi_unit_begin(const E& e, const Unit& u, LAS unsigned char* lds) { if constexpr (epi_has_begin<E>::value) e.unit_begin(u, lds); }
template <bool GATHER = false, bool FP8 = false, class Epi, class Sched>
__device__ __forceinline__ void gemm_phase(LAS unsigned char* lds, const GemmP g, const Sched& S, const Epi& E) {
    const int tid = threadIdx.x, wid = __builtin_amdgcn_readfirstlane(tid >> 6), lane = tid & 63, wr = wid >> 2, wc = wid & 3, fr = lane & 15, fq = lane >> 4;
    int K = g.K; asm volatile("" : "+s"(K));
    const int nt = K / BK;
    int RA[2], CA[2]; unsigned voffB[2];
#pragma unroll
    for (int i = 0; i < 2; ++i) { int R, C; stage_rc(tid * 16 + i * 8192, R, C); RA[i] = R; CA[i] = C; const int Rb = (R & ~31) + perm32(R & 31); voffB[i] = (unsigned)(Rb * K + C) * 2u; }
    const size_t kstep = (size_t)(BK * 2), hstepB = (size_t)HALF * K * 2, tstepB = 2 * hstepB;
    const unsigned ldsw = (unsigned)wid * 1024u;
    const int aoff = lds_byte(wr * 64 + fr, fq * 8), boff = lds_byte(wc * 32 + fr, fq * 8);
#define MK_SA(b, h) (((b) * 2 + (h)) * HTB)
#define MK_SB(b, h) ((4 + (b) * 2 + (h)) * HTB)
#define MK_STAGE(bufoff, gbase, voff) do { _Pragma("unroll") for (int _i = 0; _i < 2; ++_i) \
        __builtin_amdgcn_global_load_lds((const unsigned*)((const char*)(gbase) + (voff)[_i]), (LAS unsigned*)(lds + (bufoff) + ldsw + _i * 8192), 16, 0, 0); } while (0)
#define MK_CAT8(x, y) __builtin_shufflevector(__builtin_bit_cast(i32x4, x), __builtin_bit_cast(i32x4, y), 0, 1, 2, 3, 4, 5, 6, 7)
#define MK_LDA(dst, b, h) do { _Pragma("unroll") for (int m = 0; m < 4; ++m) { if constexpr (FP8) dst##8[m] = MK_CAT8(*(const LAS bf16x8*)(lds + MK_SA(b, h) + aoff + m * 2048), *(const LAS bf16x8*)(lds + MK_SA(b, h) + aoff + m * 2048 + 1024)); \
        else { _Pragma("unroll") for (int k = 0; k < 2; ++k) dst[m][k] = *(const LAS bf16x8*)(lds + MK_SA(b, h) + aoff + m * 2048 + k * 1024); } } } while (0)
#define MK_LDB(dst, b, h) do { _Pragma("unroll") for (int n = 0; n < 2; ++n) { if constexpr (FP8) dst##8[n] = MK_CAT8(*(const LAS bf16x8*)(lds + MK_SB(b, h) + boff + n * 2048), *(const LAS bf16x8*)(lds + MK_SB(b, h) + boff + n * 2048 + 1024)); \
        else { _Pragma("unroll") for (int k = 0; k < 2; ++k) dst[n][k] = *(const LAS bf16x8*)(lds + MK_SB(b, h) + boff + n * 2048 + k * 1024); } } } while (0)
#define MK_MMA(ai, bj, At, Bt) do { __builtin_amdgcn_s_setprio(1); _Pragma("unroll") for (int m = 0; m < 4; ++m) _Pragma("unroll") for (int n = 0; n < 2; ++n) { \
        if constexpr (FP8) asm volatile("v_mfma_scale_f32_16x16x128_f8f6f4 %0, %1, %2, %0, %3, %3 op_sel_hi:[0,0,0]" : "+v"(acc[ai][bj][m][n]) : "v"(Bt##8[n]), "v"(At##8[m]), "v"(mx_one));   \
        else { _Pragma("unroll") for (int k = 0; k < 2; ++k) acc[ai][bj][m][n] = __builtin_amdgcn_mfma_f32_16x16x32_bf16(Bt[n][k], At[m][k], acc[ai][bj][m][n], 0, 0, 0); } } \
        __builtin_amdgcn_s_setprio(0); } while (0)
#define MK_WAIT_V(n) asm volatile("s_waitcnt vmcnt(" #n ")" ::: "memory")
#define MK_WAIT_L(n) asm volatile("s_waitcnt lgkmcnt(" #n ")" ::: "memory")
#define MK_BAR __builtin_amdgcn_s_barrier()
#define MK_SCHED __builtin_amdgcn_sched_barrier(0)
    Unit cur, nxt; int ui = 0;
    if (!S.next(0, cur)) return;
    f32x4 acc[2][2][4][2];
#pragma unroll
    for (int a = 0; a < 2; ++a)
#pragma unroll
        for (int b = 0; b < 2; ++b)
#pragma unroll
            for (int m = 0; m < 4; ++m)
#pragma unroll
                for (int n = 0; n < 2; ++n) acc[a][b][m][n] = (f32x4){0.f, 0.f, 0.f, 0.f};
    bf16x8 At[4][2], B0[2][2], B1[2][2];
    i32x8 At8[4], B08[2], B18[2];
    int mx_one = 0x7f7f7f7f; asm volatile("" : "+v"(mx_one));
    unsigned vA[2][2], vAn[2][2];
    const size_t hstepA = GATHER ? 0 : (size_t)HALF * K * 2, tstepA = 2 * (size_t)HALF * K * 2;
    auto a_voff = [&](const Unit& u, unsigned (&vo)[2][2]) {
#pragma unroll
        for (int h = 0; h < 2; ++h)
#pragma unroll
            for (int i = 0; i < 2; ++i) { if (GATHER) { const int row = u.pm * BM + h * HALF + RA[i]; vo[h][i] = (unsigned)((size_t)g.gather[row] * K + CA[i]) * 2u; } else vo[h][i] = (unsigned)(RA[i] * K + CA[i]) * 2u; }
    };
    a_voff(cur, vA);
    const LAS int* GLDS = (const LAS int*)(lds + STAGE_BYTES + 2048);
    auto a_voff_lds = [&](unsigned (&vo)[2][2]) {
#pragma unroll
        for (int h = 0; h < 2; ++h)
#pragma unroll
            for (int i = 0; i < 2; ++i) vo[h][i] = (unsigned)((size_t)GLDS[h * HALF + RA[i]] * K + CA[i]) * 2u;
    };
    auto a_base = [&](const Unit& u) { return (const char*)(u.e ? g.A1 : g.A0) + (GATHER ? (size_t)0 : (size_t)u.pm * tstepA); };
    const char* cA = a_base(cur);
    const char* cB = (const char*)g.Bt + ((size_t)cur.e * g.strideB) * 2 + (size_t)cur.pn * tstepB;
    MK_STAGE(MK_SB(0, 0), cB, voffB); MK_STAGE(MK_SA(0, 0), cA, vA[0]); MK_STAGE(MK_SB(0, 1), cB + hstepB, voffB); MK_STAGE(MK_SA(0, 1), cA + hstepA, vA[1]);
    if (wr == 1) MK_BAR;
    MK_WAIT_V(4); MK_BAR;
    MK_STAGE(MK_SB(1, 0), cB + kstep, voffB); MK_STAGE(MK_SA(1, 0), cA + kstep, vA[0]); MK_STAGE(MK_SB(1, 1), cB + hstepB + kstep, voffB);
    MK_WAIT_V(6); MK_BAR;
    for (;;) {
        epi_unit_begin(E, cur, lds);
        const bool has_next = S.next(ui + 1, nxt);
        if (GATHER && has_next && wid < 4) __builtin_amdgcn_global_load_lds((const unsigned*)g.gather + (size_t)nxt.pm * BM + wid * 64 + lane, (LAS unsigned*)(lds + STAGE_BYTES + 2048 + wid * 256), 4, 0, 0);
        const char* nA = has_next ? a_base(nxt) : cA;
        const char* nB = has_next ? (const char*)g.Bt + ((size_t)nxt.e * g.strideB) * 2 + (size_t)nxt.pn * tstepB : cB;
        for (int t = 0; t < nt; t += 2) {
            const bool last = (t == nt - 2);
            const int relax = (epi_ns<Epi>::value == 16 && t == 0) ? 1 : 0;
#define MK_WAIT_VR do { if constexpr (epi_ns<Epi>::value != 16) MK_WAIT_V(10); else asm volatile("v_cmp_ne_u32_e32 vcc, 0, %0\n\ts_nop 3\n\ts_cbranch_vccnz .Lwr%=\n\ts_waitcnt vmcnt(10)\n.Lwr%=:\n\ts_waitcnt vmcnt(26)" :: "v"(relax) : "vcc", "memory"); } while (0)
            if (GATHER && last) { if (has_next) a_voff_lds(vAn); else {
#pragma unroll
                for (int h = 0; h < 2; ++h)
#pragma unroll
                    for (int i = 0; i < 2; ++i) vAn[h][i] = vA[h][i]; } }
            const char* a1 = cA + (size_t)(t + 1) * kstep;
            const char* a2 = last ? nA : cA + (size_t)(t + 2) * kstep; const char* b2 = last ? nB : cB + (size_t)(t + 2) * kstep;
            const char* a3 = a2 + kstep; const char* b3 = b2 + kstep;
            unsigned v2[2][2];
#pragma unroll
            for (int h = 0; h < 2; ++h)
#pragma unroll
                for (int i = 0; i < 2; ++i) v2[h][i] = (GATHER && last) ? vAn[h][i] : vA[h][i];
            MK_LDB(B0, 0, 0); MK_SCHED; MK_LDA(At, 0, 0); MK_STAGE(MK_SA(1, 1), a1 + hstepA, vA[1]);
            MK_WAIT_VR; MK_WAIT_L(8); MK_BAR; MK_WAIT_L(0); MK_MMA(0, 0, At, B0); MK_BAR; MK_SCHED;
            MK_LDB(B1, 0, 1); MK_STAGE(MK_SB(0, 0), b2, voffB);
            MK_WAIT_VR; MK_BAR; MK_WAIT_L(0); MK_MMA(0, 1, At, B1); MK_BAR;
            MK_LDA(At, 0, 1); MK_STAGE(MK_SA(0, 0), a2, v2[0]);
            MK_BAR; MK_WAIT_L(0); MK_MMA(1, 0, At, B0); MK_BAR; MK_SCHED;
            MK_STAGE(MK_SB(0, 1), b2 + hstepB, voffB);
            MK_WAIT_VR; MK_BAR; MK_MMA(1, 1, At, B1); MK_BAR;
            MK_LDB(B0, 1, 0); MK_SCHED; MK_LDA(At, 1, 0); MK_STAGE(MK_SA(0, 1), a2 + hstepA, v2[1]);
            MK_WAIT_VR; MK_WAIT_L(8); MK_BAR; MK_WAIT_L(0); MK_MMA(0, 0, At, B0); MK_BAR; MK_SCHED;
            MK_LDB(B1, 1, 1); MK_STAGE(MK_SB(1, 0), b3, voffB);
            MK_WAIT_V(10); MK_BAR; MK_WAIT_L(0); MK_MMA(0, 1, At, B1); MK_BAR;
            MK_LDA(At, 1, 1); MK_STAGE(MK_SA(1, 0), a3, v2[0]);
            MK_BAR; MK_WAIT_L(0); MK_MMA(1, 0, At, B0); MK_BAR; MK_SCHED;
            MK_STAGE(MK_SB(1, 1), b3 + hstepB, voffB);
            MK_WAIT_V(10); MK_BAR; MK_MMA(1, 1, At, B1); MK_BAR;
        }
        if constexpr (FP8) asm volatile("s_nop 15\n\ts_nop 15" : "+v"(acc[1][1][0][0]), "+v"(acc[1][1][0][1]), "+v"(acc[1][1][1][0]), "+v"(acc[1][1][1][1]),
                                        "+v"(acc[1][1][2][0]), "+v"(acc[1][1][2][1]), "+v"(acc[1][1][3][0]), "+v"(acc[1][1][3][1]) :: "memory");
        int fr_ = fr, fq_ = fq; asm volatile("" : "+v"(fr_), "+v"(fq_));
        if (wr == 0) MK_BAR;
        const bool keep = E(acc, cur, wr, wc, fr_, fq_);
        if (wr == 1) MK_BAR;
        if (!has_next) break;
        if (!keep) {
#pragma unroll
            for (int a = 0; a < 2; ++a)
#pragma unroll
                for (int b = 0; b < 2; ++b)
#pragma unroll
                    for (int m = 0; m < 4; ++m)
#pragma unroll
                        for (int n = 0; n < 2; ++n) acc[a][b][m][n] = (f32x4){0.f, 0.f, 0.f, 0.f};
        }
        cur = nxt; cA = nA; cB = nB; ++ui;
        if (GATHER) {
#pragma unroll
            for (int h = 0; h < 2; ++h)
#pragma unroll
                for (int i = 0; i < 2; ++i) vA[h][i] = vAn[h][i]; }
    }
    MK_WAIT_V(0);
    if (wr == 0) MK_BAR;
    MK_BAR;
#undef MK_SA
#undef MK_SB
#undef MK_STAGE
#undef MK_LDA
#undef MK_LDB
#undef MK_MMA
#undef MK_CAT8
#undef MK_WAIT_V
#undef MK_WAIT_VR
#undef MK_WAIT_L
#undef MK_BAR
#undef MK_SCHED
}

__device__ __forceinline__ unsigned pack4_fp8(float a, float b, float c, float d) {
    a = fminf(fmaxf(a, -448.f), 448.f); b = fminf(fmaxf(b, -448.f), 448.f); c = fminf(fmaxf(c, -448.f), 448.f); d = fminf(fmaxf(d, -448.f), 448.f);
    int w = __builtin_amdgcn_cvt_pk_fp8_f32(a, b, 0, false); w = __builtin_amdgcn_cvt_pk_fp8_f32(c, d, w, true); return (unsigned)w; }
__device__ __forceinline__ u32x4 pack8(const f32x4 a, const f32x4 b) { u32x4 w; w.x = cvt_pk_bf16(a[0], a[1]); w.y = cvt_pk_bf16(a[2], a[3]); w.z = cvt_pk_bf16(b[0], b[1]); w.w = cvt_pk_bf16(b[2], b[3]); return w; }
struct EpiStoreBf16S {
    bf16_t* O; long ldc; float sc; int pad_;
    __device__ __forceinline__ bool operator()(const f32x4 (&acc)[2][2][4][2], const Unit& u, int wr, int wc, int fr, int fq) const {
        MK_FRAG_LOOP(r, c) { *(u32x4*)(O + (size_t)(u.pm * BM + r) * ldc + u.pn * BM + c) = pack8(acc[ai][bj][m][0] * sc, acc[ai][bj][m][1] * sc); }
        return false;
    }
};
struct EpiStoreBf16 {
    static constexpr int NS = 16;
    bf16_t* O; long ldc;
    __device__ __forceinline__ bool operator()(const f32x4 (&acc)[2][2][4][2], const Unit& u, int wr, int wc, int fr, int fq) const {
        MK_FRAG_LOOP(r, c) { *(u32x4*)(O + (size_t)(u.pm * BM + r) * ldc + u.pn * BM + c) = pack8(acc[ai][bj][m][0], acc[ai][bj][m][1]); }
        return false;
    }
};

struct EpiStorePred {
    bf16_t* O; long ldc;
    __device__ __forceinline__ bool operator()(const f32x4 (&acc)[2][2][4][2], const Unit& u, int wr, int wc, int fr, int fq) const {
        MK_FRAG_LOOP(r, c) { const u32x4 w = pack8(acc[ai][bj][m][0], acc[ai][bj][m][1]); if (w.x == 0x7fc17fc1u && w.w == 0x12345678u) *(u32x4*)(O + (size_t)(u.pm * BM + r) * ldc + u.pn * BM + c) = w; }
        return false;
    }
};
struct EpiStoreLine {
    bf16_t* O; long nunit;
    __device__ __forceinline__ bool operator()(const f32x4 (&acc)[2][2][4][2], const Unit& u, int wr, int wc, int fr, int fq) const {
        const size_t ub = (size_t)((u.pm * 18 + u.pn) % (int)nunit) * (BM * BM); const int wid = wr * 4 + wc, lane = fq * 16 + fr; int f = 0;
        MK_FRAG_LOOP(r, c) { *(u32x4*)(O + ub + ((size_t)(f * 8 + wid) * 64 + lane) * 8) = pack8(acc[ai][bj][m][0], acc[ai][bj][m][1]); ++f; }
        return false;
    }
};
struct EpiNull {
    __device__ __forceinline__ bool operator()(const f32x4 (&acc)[2][2][4][2], const Unit& u, int wr, int wc, int fr, int fq) const {
        MK_FRAG_LOOP(r, c) { asm volatile("" :: "v"(acc[ai][bj][m][0]), "v"(acc[ai][bj][m][1])); }
        return false;
    }
};

__device__ __forceinline__ void ld8_contig(const float* p, float (&o)[8]) { const f32x4 a = *(const f32x4*)p, b = *(const f32x4*)(p + 4); o[0] = a[0]; o[1] = a[1]; o[2] = a[2]; o[3] = a[3]; o[4] = b[0]; o[5] = b[1]; o[6] = b[2]; o[7] = b[3]; }
struct CMapZ1 { __device__ int operator()(int n) const { return n < RC ? n : (n < Z1_LX ? -1 : OFF_LX + (n - Z1_LX)); }
    __device__ __forceinline__ void load8(const float* rowp, int n, float (&o)[8]) const { const int sc = (*this)(n); if (sc >= 0) ld8_contig(rowp + sc, o); else {
#pragma unroll
        for (int j = 0; j < 8; ++j) o[j] = 0.f; } } };
struct CMapZC { __device__ int operator()(int n) const { return OFF_LG + n; }
    __device__ __forceinline__ void load8(const float* rowp, int n, float (&o)[8]) const { ld8_contig(rowp + OFF_LG + n, o); } };
struct CMapId { __device__ int operator()(int n) const { return n; }
    __device__ __forceinline__ void load8(const float* rowp, int n, float (&o)[8]) const { ld8_contig(rowp + n, o); } };
struct CMapGU { int F; __device__ int operator()(int n) const { return (n & 1) * F + (n >> 1); }
    __device__ __forceinline__ void load8(const float* rowp, int n, float (&o)[8]) const { const f32x4 g = *(const f32x4*)(rowp + (n >> 1)), u = *(const f32x4*)(rowp + F + (n >> 1));
        o[0] = g[0]; o[1] = u[0]; o[2] = g[1]; o[3] = u[1]; o[4] = g[2]; o[5] = u[2]; o[6] = g[3]; o[7] = u[3]; } };
constexpr int CT_B = 8;
template <bool OUT8 = false, class CM>
__device__ __forceinline__ void convT_job(LAS float* tile  , const float* src, int lds_, int Ks, bf16_t* dst, int Kd, int N, const CM& cm, int bid, int nblk, int& base, float oscale = 1.f) {
    const int tk = Kd / 64, nt = (N / 64) * tk, tid = threadIdx.x;
    const int first = (bid - base % nblk + nblk) % nblk;
    const int kk = tid >> 3, nn8 = (tid & 7) * 8, nn = tid >> 3, kk8 = (tid & 7) * 8;
    for (int t0 = first; t0 < nt; t0 += CT_B * nblk) {
        float v[CT_B][8];
#pragma unroll
        for (int b = 0; b < CT_B; ++b) { const int t = t0 + b * nblk; const int n0 = (t / tk) * 64, k0 = (t % tk) * 64, k = k0 + kk;
            if (t < nt && k < Ks) cm.load8(src + (size_t)k * lds_, n0 + nn8, v[b]); else {
#pragma unroll
                for (int j = 0; j < 8; ++j) v[b][j] = 0.f; } }
#pragma unroll
        for (int b = 0; b < CT_B; ++b)
#pragma unroll
            for (int j = 0; j < 8; ++j) tile[b * 64 * 65 + kk * 65 + nn8 + j] = v[b][j];
        __syncthreads();
#pragma unroll
        for (int b = 0; b < CT_B; ++b) { const int t = t0 + b * nblk; if (t < nt) { const int n0 = (t / tk) * 64, k0 = (t % tk) * 64; f32x4 a, c;
#pragma unroll
            for (int j = 0; j < 4; ++j) { a[j] = tile[b * 64 * 65 + (kk8 + j) * 65 + nn]; c[j] = tile[b * 64 * 65 + (kk8 + 4 + j) * 65 + nn]; }
            if constexpr (OUT8) { u32x2 w8; w8.x = pack4_fp8(a[0] * oscale, a[1] * oscale, a[2] * oscale, a[3] * oscale); w8.y = pack4_fp8(c[0] * oscale, c[1] * oscale, c[2] * oscale, c[3] * oscale);
                *(u32x2*)((unsigned char*)dst + (size_t)(n0 + nn) * Kd + k0 + kk8) = w8; }
            else *(u32x4*)(dst + (size_t)(n0 + nn) * Kd + k0 + kk8) = pack8(a, c); } }
        __syncthreads();
    }
    base += nt;
}

template <bool OUT8 = false, class CM, class MS>
__device__ __forceinline__ void convT_multi(LAS float* tile, const MS& ms, int nmat, int lds_, int Ks, int Kd, int N, const CM& cm, int bid, int nblk, float oscale = 1.f) {
    const int tk = Kd / 64, tpm = (N / 64) * tk, nt = nmat * tpm, tid = threadIdx.x;
    const int kk = tid >> 3, nn8 = (tid & 7) * 8, nn = tid >> 3, kk8 = (tid & 7) * 8;
    for (int t0 = bid; t0 < nt; t0 += CT_B * nblk) {
        float v[CT_B][8];
#pragma unroll
        for (int b = 0; b < CT_B; ++b) { const int T = t0 + b * nblk, m = T / tpm, t = T % tpm; const int n0 = (t / tk) * 64, k0 = (t % tk) * 64, k = k0 + kk;
            if (T < nt && k < Ks) cm.load8(ms.src(m) + (size_t)k * lds_, n0 + nn8, v[b]); else {
#pragma unroll
                for (int j = 0; j < 8; ++j) v[b][j] = 0.f; } }
#pragma unroll
        for (int b = 0; b < CT_B; ++b)
#pragma unroll
            for (int j = 0; j < 8; ++j) tile[b * 64 * 65 + kk * 65 + nn8 + j] = v[b][j];
        __syncthreads();
#pragma unroll
        for (int b = 0; b < CT_B; ++b) { const int T = t0 + b * nblk; if (T < nt) { const int m = T / tpm, t = T % tpm, n0 = (t / tk) * 64, k0 = (t % tk) * 64; f32x4 a, c;
#pragma unroll
            for (int j = 0; j < 4; ++j) { a[j] = tile[b * 64 * 65 + (kk8 + j) * 65 + nn]; c[j] = tile[b * 64 * 65 + (kk8 + 4 + j) * 65 + nn]; }
            if constexpr (OUT8) { u32x2 w8; w8.x = pack4_fp8(a[0] * oscale, a[1] * oscale, a[2] * oscale, a[3] * oscale); w8.y = pack4_fp8(c[0] * oscale, c[1] * oscale, c[2] * oscale, c[3] * oscale);
                *(u32x2*)((unsigned char*)ms.dst(m) + (size_t)(n0 + nn) * Kd + k0 + kk8) = w8; }
            else *(u32x4*)(ms.dst(m) + (size_t)(n0 + nn) * Kd + k0 + kk8) = pack8(a, c); } }
        __syncthreads();
    }
}

constexpr int MOD_SL = 16, MOD_KS = D / MOD_SL;
__device__ __forceinline__ void mod_partials(LAS float* sl  , const In& in, float* part  , int bid, int nblk) {
    const int ncc = 6 * D / NT, nitem = MOD_SL * ncc;
    for (int it = bid; it < nitem; it += nblk) {
        const int s = it / ncc, j = (it % ncc) * NT + threadIdx.x;
        for (int i = threadIdx.x; i < (NB + 1) * MOD_KS; i += NT) { const int r = i / MOD_KS, k = s * MOD_KS + i % MOD_KS; const float cv = r < NB ? in.c[r * D + k] : in.c_ctx[k]; sl[i] = siluf_(cv); }
        __syncthreads();
        float acc[NB + 1];
#pragma unroll
        for (int r = 0; r <= NB; ++r) acc[r] = 0.f;
        for (int k = 0; k < MOD_KS; ++k) { const float w = in.w_mod[(size_t)(s * MOD_KS + k) * 6 * D + j];
#pragma unroll
            for (int r = 0; r <= NB; ++r) acc[r] += sl[r * MOD_KS + k] * w; }
#pragma unroll
        for (int r = 0; r <= NB; ++r) part[((size_t)s * (NB + 1) + r) * 6 * D + j] = acc[r];
        __syncthreads();
    }
}
__device__ __forceinline__ float mod_value(const In& in, const float* part, int r, int j) {
    float s = in.b_mod[j];
#pragma unroll
    for (int q = 0; q < MOD_SL; ++q) s += part[((size_t)q * (NB + 1) + r) * 6 * D + j];
    return s;
}

template <bool OUT8 = false>
__device__ __forceinline__ void xn_rows(LAS float* sm  , const In& in, const float* part, bf16_t* xn, int b0, int nb, int row_lo, int row_hi, unsigned char* xn2 = nullptr  ) {
    const int nlat = nb * SEQ, wid = threadIdx.x >> 6, lane = threadIdx.x & 63;
    int cur_mr = -1;
    float gp[16];
#pragma unroll
    for (int j = 0; j < 4; ++j)
#pragma unroll
        for (int q = 0; q < 4; ++q) gp[4 * j + q] = in.norm_g[j * 256 + lane * 4 + q];
    auto src_of = [&](int r) __attribute__((always_inline)) { return r < nlat ? in.x + ((size_t)b0 * SEQ + r) * D : in.ctx + ((size_t)b0 * CTX + (r - nlat)) * D; };
    f32x4 nx[4];
    { const int r = row_lo + wid; if (r < row_hi) { const float* src = src_of(r);
#pragma unroll
        for (int j = 0; j < 4; ++j) nx[j] = *(const f32x4*)(src + j * 256 + lane * 4); } }
    for (int rbase = row_lo; rbase < row_hi; rbase += 8) {
        const int mr = rbase < nlat ? b0 + rbase / SEQ : NB;
        if (mr != cur_mr) { __syncthreads(); for (int j = threadIdx.x; j < 2 * D; j += NT) sm[j] = mod_value(in, part, mr, j); __syncthreads(); cur_mr = mr; }
        const int r = rbase + wid; if (r >= row_hi) continue;
        f32x4 v[4]; float ss = 0.f;
#pragma unroll
        for (int j = 0; j < 4; ++j) { v[j] = nx[j]; ss += v[j][0] * v[j][0] + v[j][1] * v[j][1] + v[j][2] * v[j][2] + v[j][3] * v[j][3]; }
        if (r + 8 < row_hi) { const float* src = src_of(r + 8);
#pragma unroll
            for (int j = 0; j < 4; ++j) nx[j] = *(const f32x4*)(src + j * 256 + lane * 4); }
        ss = wave_sum64(ss);
        const float rinv = __builtin_amdgcn_rsqf(ss * (1.f / D) + NORM_EPS);
#pragma unroll
        for (int j = 0; j < 4; ++j) { const int c = j * 256 + lane * 4; float o[4];
#pragma unroll
            for (int q = 0; q < 4; ++q) o[q] = (v[j][q] * rinv * gp[4 * j + q]) * (1.f + sm[D + c + q]) + sm[c + q];
            if constexpr (OUT8) { const unsigned w8 = pack4_fp8(o[0] * 16.f, o[1] * 16.f, o[2] * 16.f, o[3] * 16.f); *(unsigned*)((unsigned char*)xn + (size_t)r * D + c) = w8; if (xn2) *(unsigned*)(xn2 + (size_t)r * D + c) = w8; }
            else { u32x2 w; w.x = cvt_pk_bf16(o[0], o[1]); w.y = cvt_pk_bf16(o[2], o[3]); *(u32x2*)(xn + (size_t)r * D + c) = w; } }
    }
}
}

namespace mk {
#define XB_TMO      128
#define XB_XCNT(j)  (256  + 64 * (j))
#define XB_XSUB(j)  (1280 + 64 * (j))
#define XB_XGEN(j)  (2304 + 64 * (j))
#define XB_TOP      3328
#define XB_TOPGEN   3392
#define XCD_BAR_WORDS 3456
#define XB_SPIN_CAP (1u << 18)
__device__ __forceinline__ unsigned xb_ld(unsigned* p)              { return __hip_atomic_load(p, __ATOMIC_RELAXED, __HIP_MEMORY_SCOPE_AGENT); }
__device__ __forceinline__ unsigned xb_add(unsigned* p, unsigned v) { return __hip_atomic_fetch_add(p, v, __ATOMIC_RELAXED, __HIP_MEMORY_SCOPE_AGENT); }
__device__ __forceinline__ unsigned xb_xcc_id() { return (unsigned)__builtin_amdgcn_s_getreg((3 << 11) | 20) & 0xFu; }
#define XB_SPIN(cond, bar) do { unsigned _sp = 0; while (cond) { __builtin_amdgcn_s_sleep(1); \
    if ((++_sp & 255u) == 0u) { if (xb_ld(&(bar)[XB_TMO])) break; if (_sp > XB_SPIN_CAP) { atomicAdd(&(bar)[XB_TMO], 1u); break; } } } } while (0)
struct XcdBarrier { unsigned* bar; unsigned x; volatile LAS unsigned* st; };
__device__ __forceinline__ XcdBarrier xcd_barrier_post(unsigned* bar, volatile LAS unsigned* st) {
    XcdBarrier b; b.bar = bar; b.x = xb_xcc_id(); b.st = st;
    if (threadIdx.x == 0) (void)xb_add(&bar[XB_XCNT(b.x)], 1u);
    return b;
}
__device__ __forceinline__ void xcd_barrier_complete(unsigned* bar, unsigned x, unsigned& nloc, unsigned& nx) {
    const unsigned G = gridDim.x * gridDim.y * gridDim.z;
    unsigned sum, cnt, mine, sp = 0u;
    for (;;) {
        sum = 0u; cnt = 0u; mine = 0u;
#pragma unroll
        for (unsigned j = 0; j < 16; ++j) { const unsigned c = xb_ld(&bar[XB_XCNT(j)]); sum += c; cnt += (c > 0u) ? 1u : 0u; mine = (j == x) ? c : mine; }
        if (sum == G) break;
        __builtin_amdgcn_s_sleep(1);
        if ((++sp & 255u) == 0u) { if (xb_ld(&bar[XB_TMO])) break; if (sp > XB_SPIN_CAP) { atomicAdd(&bar[XB_TMO], 1u); break; } }
    }
    nloc = mine > 0u ? mine : 1u; nx = cnt > 0u ? cnt : 1u;
}
__device__ __forceinline__ void xcd_barrier(const XcdBarrier& b) {
    asm volatile("s_waitcnt vmcnt(0)" ::: "memory");
    __syncthreads();
    if (threadIdx.x == 0) {
        unsigned* bar = b.bar;
        __builtin_amdgcn_s_waitcnt(0);
        unsigned nloc = b.st[0], nx = b.st[1];
        if (nloc == 0u) { xcd_barrier_complete(bar, b.x, nloc, nx); b.st[0] = nloc; b.st[1] = nx; }
        const unsigned old = xb_add(&bar[XB_XSUB(b.x)], 1u);
        const unsigned gen = old / nloc;
        if (old + 1u == (gen + 1u) * nloc) {
            __builtin_amdgcn_fence(__ATOMIC_RELEASE, "agent");
            asm volatile("s_waitcnt vmcnt(0)" ::: "memory");
            const unsigned og = xb_add(&bar[XB_TOP], 1u);
            const unsigned tg = og / nx;
            if (og + 1u == (tg + 1u) * nx) xb_add(&bar[XB_TOPGEN], 1u);
            else XB_SPIN(xb_ld(&bar[XB_TOPGEN]) == tg, bar);
            __builtin_amdgcn_fence(__ATOMIC_ACQUIRE, "agent");
            xb_add(&bar[XB_XGEN(b.x)], 1u);
            asm volatile("s_waitcnt vmcnt(0)" ::: "memory");
        } else {
            XB_SPIN(xb_ld(&bar[XB_XGEN(b.x)]) == gen, bar);
            __builtin_amdgcn_fence(__ATOMIC_ACQUIRE, "agent");
            asm volatile("s_waitcnt vmcnt(0)" ::: "memory");
        }
    }
    __syncthreads();
}
}

namespace mk {
constexpr int TB = 32;
constexpr int RAWW = 320;
constexpr int RW_RAW = 0;
constexpr int RW_MU = RW_RAW + (TB + 2) * RAWW * 2;
constexpr int RW_WUP = RW_MU + 2 * RAWW * 4;
constexpr int RW_AUP = RW_WUP + 64 * 72 * 2;
constexpr int RW_CST = RW_AUP + 64 * 72 * 2;
constexpr int RW_AWD = RW_CST + 5 * 64 * 4;
constexpr int RW_AAD = RW_AWD + TB * 72 * 2;
constexpr int RW_R = RW_AAD + TB * 72 * 2;
constexpr int RW_KR = RW_R + TB * 64 * 4;
constexpr int RW_LA = RW_KR + TB * 64 * 4;
constexpr int RW_KK = RW_LA + TB * 64 * 4;
constexpr int RW_W = RW_KK + TB * 64 * 4;
constexpr int RW_B = RW_W + TB * 64 * 4;
constexpr int RW_KD = RW_B + TB * 64 * 4;
constexpr int RW_WR = RW_KD + TB * 64 * 4;
constexpr int RW_V = RW_WR + TB * 64 * 4;
constexpr int RW_SC = RW_V + TB * 64 * 4;
constexpr int RW_YO = RW_SC + TB * 2 * 4;
constexpr int RW_BON = RW_YO + TB * 64 * 4;
constexpr int RW_END = RW_BON + TB * 4;
static_assert(RW_END <= LDS_BYTES, "rwkv LDS");

#define MK_DPP(x, ctrl) __int_as_float(__builtin_amdgcn_update_dpp(__float_as_int(x), __float_as_int(x), ctrl, 0xF, 0xF, false))
__device__ __forceinline__ float allreduce16(float x) {
    x += MK_DPP(x, 0xB1); x += MK_DPP(x, 0x4E); x += MK_DPP(x, 0x141); x += MK_DPP(x, 0x140); return x;
}

__device__ __forceinline__ void allreduce16x4(float& a, float& b, float& c, float& d) {
    asm volatile("s_nop 1\n\t"
        "v_add_f32_dpp %0, %0, %0 quad_perm:[1,0,3,2] row_mask:0xf bank_mask:0xf\n\t" "v_add_f32_dpp %1, %1, %1 quad_perm:[1,0,3,2] row_mask:0xf bank_mask:0xf\n\t"
        "v_add_f32_dpp %2, %2, %2 quad_perm:[1,0,3,2] row_mask:0xf bank_mask:0xf\n\t" "v_add_f32_dpp %3, %3, %3 quad_perm:[1,0,3,2] row_mask:0xf bank_mask:0xf\n\t"
        "v_add_f32_dpp %0, %0, %0 quad_perm:[2,3,0,1] row_mask:0xf bank_mask:0xf\n\t" "v_add_f32_dpp %1, %1, %1 quad_perm:[2,3,0,1] row_mask:0xf bank_mask:0xf\n\t"
        "v_add_f32_dpp %2, %2, %2 quad_perm:[2,3,0,1] row_mask:0xf bank_mask:0xf\n\t" "v_add_f32_dpp %3, %3, %3 quad_perm:[2,3,0,1] row_mask:0xf bank_mask:0xf\n\t"
        "v_add_f32_dpp %0, %0, %0 row_half_mirror row_mask:0xf bank_mask:0xf\n\t" "v_add_f32_dpp %1, %1, %1 row_half_mirror row_mask:0xf bank_mask:0xf\n\t"
        "v_add_f32_dpp %2, %2, %2 row_half_mirror row_mask:0xf bank_mask:0xf\n\t" "v_add_f32_dpp %3, %3, %3 row_half_mirror row_mask:0xf bank_mask:0xf\n\t"
        "v_add_f32_dpp %0, %0, %0 row_mirror row_mask:0xf bank_mask:0xf\n\t" "v_add_f32_dpp %1, %1, %1 row_mirror row_mask:0xf bank_mask:0xf\n\t"
        "v_add_f32_dpp %2, %2, %2 row_mirror row_mask:0xf bank_mask:0xf\n\t" "v_add_f32_dpp %3, %3, %3 row_mirror row_mask:0xf bank_mask:0xf"
        : "+v"(a), "+v"(b), "+v"(c), "+v"(d));
}
struct RwkvP { const bf16_t* z1; bf16_t* Y; float* bon; int b0, nb; };

constexpr int RW_NPIECE = (TB + 2) * 40, RW_PPT = (RW_NPIECE + NT - 1) / NT;

__device__ __forceinline__ void rwkv_chain(LAS unsigned char* lds, const In& in, const RwkvP p, int chain) {
    const int tid = threadIdx.x, lane = tid & 63, wid = tid >> 6;
    const int d = chain / (p.nb * NH), bl = (chain / NH) % p.nb, h = chain % NH;
    const int nlat = p.nb * SEQ;
    LAS bf16_t* RAW = (LAS bf16_t*)(lds + RW_RAW); LAS float* MU = (LAS float*)(lds + RW_MU);
    LAS bf16_t* WUP = (LAS bf16_t*)(lds + RW_WUP); LAS bf16_t* AUP = (LAS bf16_t*)(lds + RW_AUP); LAS float* CST = (LAS float*)(lds + RW_CST);
    LAS bf16_t* AWD = (LAS bf16_t*)(lds + RW_AWD); LAS bf16_t* AAD = (LAS bf16_t*)(lds + RW_AAD);
    LAS float *Rr = (LAS float*)(lds + RW_R), *KR = (LAS float*)(lds + RW_KR), *LA_ = (LAS float*)(lds + RW_LA);
    LAS float *KK = (LAS float*)(lds + RW_KK), *Wv = (LAS float*)(lds + RW_W), *Bv = (LAS float*)(lds + RW_B), *KD = (LAS float*)(lds + RW_KD), *WR = (LAS float*)(lds + RW_WR), *Vv = (LAS float*)(lds + RW_V);
    LAS float *SC = (LAS float*)(lds + RW_SC), *YO = (LAS float*)(lds + RW_YO), *BON = (LAS float*)(lds + RW_BON);
    auto segcol = [&](int s) { return s < 3 ? s * RW + h * 64 : (s == 3 ? OFF_WD + d * DL : OFF_AD + d * AL); };
    for (int i = tid; i < 2 * RAWW; i += NT) { const int m = i / RAWW, c = i % RAWW; MU[i] = in.shift_mu[m * RC + segcol(c >> 6) + (c & 63)]; }
    for (int i = tid; i < 64 * 64; i += NT) { const int j = i >> 6, c = i & 63;
        WUP[c * 72 + j] = f2bf(in.rw_w_up[((size_t)d * DL + j) * RW + h * 64 + c]); AUP[c * 72 + j] = f2bf(in.rw_a_up[((size_t)d * AL + j) * RW + h * 64 + c]); }
    for (int i = tid; i < 64; i += NT) { CST[i] = in.rw_w0[d * RW + h * 64 + i]; CST[64 + i] = in.rw_a0[d * RW + h * 64 + i]; CST[128 + i] = in.rw_k_k[h * 64 + i]; CST[192 + i] = in.rw_k_a[h * 64 + i]; CST[256 + i] = in.rw_r_k[h * 64 + i]; }
    constexpr int NQ = (CTX + SEQ) / TB, NQC = CTX / TB;
    auto blk_info = [&](int q, bool& isctx, int& t0, bool& hp, bool& hn, size_t& grow0) {
        isctx = q < NQC;
        if (isctx) { const int qq = d == 0 ? q : NQC - 1 - q; t0 = qq * TB; hp = t0 > 0; hn = t0 + TB < CTX; grow0 = (size_t)nlat + (size_t)bl * CTX + t0; }
        else { const int ql = q - NQC, qq = d == 0 ? ql : SEQ / TB - 1 - ql; t0 = qq * TB; hp = (t0 % GW) != 0; hn = ((t0 + TB) % GW) != 0; grow0 = (size_t)bl * SEQ + t0; }
    };
    u32x4 pre[RW_PPT];
    auto prefetch = [&](int q) {
        bool isctx, hp, hn; int t0; size_t grow0; blk_info(q, isctx, t0, hp, hn, grow0);
#pragma unroll
        for (int k = 0; k < RW_PPT; ++k) { const int i = tid + k * NT; u32x4 v = (u32x4){0u, 0u, 0u, 0u};
            if (i < RW_NPIECE) { const int rr = i / 40, sp = i % 40, seg = sp >> 3, part = sp & 7;
                const bool ok = (rr == 0) ? hp : ((rr == TB + 1) ? hn : true);
                if (ok) v = *(const u32x4*)(p.z1 + (grow0 + rr - 1) * Z1_N + segcol(seg) + part * 8); }
            pre[k] = v; }
    };
    auto commit = [&]() {
#pragma unroll
        for (int k = 0; k < RW_PPT; ++k) { const int i = tid + k * NT; if (i < RW_NPIECE) { const int rr = i / 40, sp = i % 40; *(LAS u32x4*)(RAW + rr * RAWW + sp * 8) = pre[k]; } }
    };
    float S[2][4];
#pragma unroll
    for (int i = 0; i < 2; ++i)
#pragma unroll
        for (int j = 0; j < 4; ++j) S[i][j] = 0.f;
    const int kg = lane & 15, rp = (lane >> 4) + 4 * wid;
    prefetch(0);
    for (int q = 0; q < NQ; ++q) {
        bool isctx, hp, hn; int t0; size_t grow0; blk_info(q, isctx, t0, hp, hn, grow0);
        commit();
        __syncthreads();
        if (q + 1 < NQ) prefetch(q + 1);
        auto shift8 = [&](int t, int c0, float (&s)[8]) {
            const u32x4 xp = *(const LAS u32x4*)(RAW + t * RAWW + c0), xc = *(const LAS u32x4*)(RAW + (t + 1) * RAWW + c0), xn_ = *(const LAS u32x4*)(RAW + (t + 2) * RAWW + c0);
            const f32x4 m0a = *(const LAS f32x4*)(MU + c0), m0b = *(const LAS f32x4*)(MU + c0 + 4), m1a = *(const LAS f32x4*)(MU + RAWW + c0), m1b = *(const LAS f32x4*)(MU + RAWW + c0 + 4);
#pragma unroll
            for (int j = 0; j < 4; ++j) { const unsigned a = xp[j], b = xc[j], c = xn_[j];
                const float mu0l = j < 2 ? m0a[2 * j] : m0b[2 * j - 4], mu0h = j < 2 ? m0a[2 * j + 1] : m0b[2 * j - 3], mu1l = j < 2 ? m1a[2 * j] : m1b[2 * j - 4], mu1h = j < 2 ? m1a[2 * j + 1] : m1b[2 * j - 3];
                { const float x = bflo(b); s[2 * j] = x + mu0l * (bflo(a) - x) + mu1l * (bflo(c) - x); }
                { const float x = bfhi(b); s[2 * j + 1] = x + mu0h * (bfhi(a) - x) + mu1h * (bfhi(c) - x); } } };
        for (int it = tid; it < TB * 24; it += NT) {
            const int t = it / 24, g = it % 24, seg = g >> 3, cc = (g & 7) * 8; float s[8]; shift8(t, g * 8, s);
            LAS float* dst = (seg == 0 ? Rr : (seg == 1 ? KR : Vv)) + t * 64 + cc; *(LAS f32x4*)dst = (f32x4){s[0], s[1], s[2], s[3]}; *(LAS f32x4*)(dst + 4) = (f32x4){s[4], s[5], s[6], s[7]};
        }
        { const int t = tid >> 4, g = 24 + (tid & 15), cc = (g & 7) * 8; float s[8]; shift8(t, g * 8, s);
          const bool isw = (tid & 15) < 8;
#pragma unroll
          for (int j = 0; j < 8; ++j) { const float th = fast_tanh(s[j]); s[j] = isw ? th : s[j]; }
          LAS bf16_t* dst = (isw ? AWD : AAD) + t * 72 + cc;
          u32x4 w; w.x = cvt_pk_bf16(s[0], s[1]); w.y = cvt_pk_bf16(s[2], s[3]); w.z = cvt_pk_bf16(s[4], s[5]); w.w = cvt_pk_bf16(s[6], s[7]); *(LAS u32x4*)dst = w; }
        __syncthreads();
        {
            const int lora = wid >> 2, ct = wid & 3, fr = lane & 15, fq = lane >> 4;
            const LAS bf16_t* Am = lora ? AAD : AWD; const LAS bf16_t* Bm = lora ? AUP : WUP;
#pragma unroll
            for (int rt = 0; rt < 2; ++rt) {
                f32x4 acc = (f32x4){0.f, 0.f, 0.f, 0.f};
#pragma unroll
                for (int ks = 0; ks < 2; ++ks) {
                    const bf16x8 a = *(const LAS bf16x8*)(Am + (rt * 16 + fr) * 72 + ks * 32 + fq * 8);
                    const bf16x8 b = *(const LAS bf16x8*)(Bm + (ct * 16 + fr) * 72 + ks * 32 + fq * 8);
                    acc = __builtin_amdgcn_mfma_f32_16x16x32_bf16(a, b, acc, 0, 0, 0);
                }
                const int col = ct * 16 + fr;
#pragma unroll
                for (int i = 0; i < 4; ++i) { const int t = rt * 16 + fq * 4 + i;
                    if (lora == 0) { const float lw = acc[i] + CST[col]; const float wl = -fast_softplus(-lw) - 0.5f; Wv[t * 64 + col] = __expf(-__expf(wl)); }
                    else { LA_[t * 64 + col] = fast_sigmoid(acc[i] + CST[64 + col]); } }
            }
        }
        __syncthreads();
        {
            const int t = tid >> 4, c4 = (tid & 15) * 4;
            const f32x4 k = *(const LAS f32x4*)(KR + t * 64 + c4), a = *(const LAS f32x4*)(LA_ + t * 64 + c4), w = *(const LAS f32x4*)(Wv + t * 64 + c4), r = *(const LAS f32x4*)(Rr + t * 64 + c4);
            f32x4 kkr, kd, bb, wr; float ss = 0.f, br = 0.f, kr = 0.f, bn = 0.f;
#pragma unroll
            for (int j = 0; j < 4; ++j) { kkr[j] = k[j] * CST[128 + c4 + j]; ss += kkr[j] * kkr[j]; }
            ss = allreduce16(ss);
            const float inv = 1.f / fmaxf(sqrtf(ss), 1e-12f);
#pragma unroll
            for (int j = 0; j < 4; ++j) { const float kk = kkr[j] * inv; kkr[j] = kk; kd[j] = k[j] * (1.f + (a[j] - 1.f) * CST[192 + c4 + j]); bb[j] = kk * a[j]; wr[j] = w[j] * r[j];
                br += bb[j] * r[j]; kr += kd[j] * r[j]; bn += r[j] * kd[j] * CST[256 + c4 + j]; }
            br = allreduce16(br); kr = allreduce16(kr); bn = allreduce16(bn);
            *(LAS f32x4*)(KK + t * 64 + c4) = kkr; *(LAS f32x4*)(KD + t * 64 + c4) = kd; *(LAS f32x4*)(Bv + t * 64 + c4) = bb; *(LAS f32x4*)(WR + t * 64 + c4) = wr;
            if ((tid & 15) == 0) { SC[t * 2] = br; SC[t * 2 + 1] = kr; BON[t] = bn; }
        }
        __syncthreads();
        {
            auto tof = [&](int st) { return d == 0 ? st : TB - 1 - st; };
            const LAS float* lb = KK + 4 * kg;
            const LAS float* vb = Vv + 2 * rp;
            constexpr int OW = (RW_W - RW_KK) / 4, OB = (RW_B - RW_KK) / 4, OKD = (RW_KD - RW_KK) / 4, OWR = (RW_WR - RW_KK) / 4;
            int t = tof(0);
            f32x4 kk4 = *(const LAS f32x4*)(lb + t * 64), w4 = *(const LAS f32x4*)(lb + t * 64 + OW), b4 = *(const LAS f32x4*)(lb + t * 64 + OB),
                  kd4 = *(const LAS f32x4*)(lb + t * 64 + OKD), wr4 = *(const LAS f32x4*)(lb + t * 64 + OWR);
            f32x2 vv = *(const LAS f32x2*)(vb + t * 64), sc = *(const LAS f32x2*)(SC + t * 2);
            f32x2 S2[4];
#pragma unroll
            for (int j = 0; j < 4; ++j) { S2[j][0] = S[0][j]; S2[j][1] = S[1][j]; }
#pragma unroll 2
            for (int st = 0; st < TB; ++st) {
                const int tn = tof(st + 1 < TB ? st + 1 : st);
                const f32x4 nkk4 = *(const LAS f32x4*)(lb + tn * 64), nw4 = *(const LAS f32x4*)(lb + tn * 64 + OW), nb4 = *(const LAS f32x4*)(lb + tn * 64 + OB),
                            nkd4 = *(const LAS f32x4*)(lb + tn * 64 + OKD), nwr4 = *(const LAS f32x4*)(lb + tn * 64 + OWR);
                const f32x2 nvv = *(const LAS f32x2*)(vb + tn * 64), nsc = *(const LAS f32x2*)(SC + tn * 2);
                f32x2 sa2 = S2[0] * kk4[0], yo2 = S2[0] * wr4[0];
#pragma unroll
                for (int j = 1; j < 4; ++j) { sa2 += S2[j] * kk4[j]; yo2 += S2[j] * wr4[j]; }
                float sa0 = sa2[0], sa1 = sa2[1], yo0 = yo2[0], yo1 = yo2[1];
                allreduce16x4(sa0, sa1, yo0, yo1);
                f32x2 sar; sar[0] = sa0; sar[1] = sa1;
#pragma unroll
                for (int j = 0; j < 4; ++j) S2[j] = S2[j] * w4[j] + (vv * kd4[j] - sar * b4[j]);
                if (kg == 0) { f32x2 yor; yor[0] = yo0; yor[1] = yo1; const f32x2 y = yor - sar * sc[0] + vv * sc[1]; *(LAS f32x2*)(YO + t * 64 + 2 * rp) = y; }
                kk4 = nkk4; w4 = nw4; b4 = nb4; kd4 = nkd4; wr4 = nwr4; vv = nvv; sc = nsc; t = tn;
            }
#pragma unroll
            for (int j = 0; j < 4; ++j) { S[0][j] = S2[j][0]; S[1][j] = S2[j][1]; }
        }
        __syncthreads();
        if (!isctx) {
            const int t = tid >> 4, c4 = (tid & 15) * 4; const f32x4 y = *(const LAS f32x4*)(YO + t * 64 + c4);
            u32x2 w; w.x = cvt_pk_bf16(y[0], y[1]); w.y = cvt_pk_bf16(y[2], y[3]);
            *(u32x2*)(p.Y + ((size_t)d * nlat + grow0 + t) * RW + h * 64 + c4) = w;
            if (tid < TB) p.bon[((size_t)d * nlat + grow0 + tid) * NH + h] = BON[tid];
        }
    }
}
__device__ __forceinline__ void rwkv_phase(LAS unsigned char* lds, const In& in, const RwkvP p, int bid, int nblk) {
    const int nchain = 2 * p.nb * NH;
    for (int c = bid; c < nchain; c += nblk) { rwkv_chain(lds, in, p, c); __syncthreads(); }
}
}

namespace mk {
constexpr int C2_RAW = 0;
constexpr int C2_MU = C2_RAW + (TB + 2) * RAWW * 2;
constexpr int C2_WUP = C2_MU + 2 * RAWW * 4;
constexpr int C2_AUP = C2_WUP + 64 * 72 * 2;
constexpr int C2_CST = C2_AUP + 64 * 72 * 2;
constexpr int C2_AWD = C2_CST + 5 * 64 * 4;
constexpr int C2_AAD = C2_AWD + TB * 72 * 2;
constexpr int C2_X = C2_AAD + TB * 72 * 2;
constexpr int C2_R = C2_X, C2_KR = C2_R + TB * 64 * 4, C2_V = C2_KR + TB * 64 * 4, C2_E = C2_V + TB * 64 * 4, C2_LA = C2_E + TB * 64 * 4, C2_CUM = C2_LA + TB * 64 * 4, C2_X_END = C2_CUM + TB * 64 * 4;
constexpr int C2_YO = C2_X;
constexpr int C2_G = C2_YO + TB * 64 * 4;
constexpr int C2_UB = C2_G + 64 * 36 * 4;
constexpr int C2_ABT = C2_UB + 64 * 40 * 2;
constexpr int C2_AKT = C2_ABT + 32 * 32 * 4;
constexpr int C2_NBT = C2_AKT + 32 * 40 * 2;
constexpr int C2_NKT = C2_NBT + 32 * 40 * 2;
static_assert(C2_NKT + 32 * 40 * 2 <= C2_X_END, "region X reuse");
constexpr int C2_KKS = C2_X_END;
constexpr int C2_BS = C2_KKS + TB * 72 * 2, C2_KDS = C2_BS + TB * 72 * 2, C2_RS = C2_KDS + TB * 72 * 2;
constexpr int C2_BST = C2_RS + TB * 72 * 2;
constexpr int C2_KDST = C2_BST + 64 * 40 * 2;
constexpr int C2_VT = C2_KDST + 64 * 40 * 2;
constexpr int C2_S0B = C2_VT + 64 * 40 * 2;
constexpr int C2_GC = C2_S0B + 64 * 72 * 2;
constexpr int C2_BON = C2_GC + 64 * 4;
constexpr int C2_END = C2_BON + TB * 4;
static_assert(C2_END <= LDS_BYTES - 16 && (C2_X % 16) == 0 && (C2_KKS % 16) == 0 && (C2_G % 16) == 0 && (C2_UB % 16) == 0 && (C2_ABT % 16) == 0 && (C2_AKT % 16) == 0 && (C2_S0B % 16) == 0, "rwkv2 LDS");

__device__ __forceinline__ bf16x8 ldsb8(const LAS bf16_t* p) { return *(const LAS bf16x8*)p; }

template <int MODE>
__device__ __forceinline__ void rwkv_chain2(LAS unsigned char* lds, const In& in, const RwkvP p, int chain) {
    const int tid = threadIdx.x, lane = tid & 63, wid = tid >> 6, fr = lane & 15, fq = lane >> 4;
    const int d = chain / (p.nb * NH), bl = (chain / NH) % p.nb, h = chain % NH;
    const int nlat = p.nb * SEQ;
    LAS bf16_t* RAW = (LAS bf16_t*)(lds + C2_RAW); LAS float* MU = (LAS float*)(lds + C2_MU);
    LAS bf16_t* WUP = (LAS bf16_t*)(lds + C2_WUP); LAS bf16_t* AUP = (LAS bf16_t*)(lds + C2_AUP); LAS float* CST = (LAS float*)(lds + C2_CST);
    LAS bf16_t* AWD = (LAS bf16_t*)(lds + C2_AWD); LAS bf16_t* AAD = (LAS bf16_t*)(lds + C2_AAD);
    LAS float *Rr = (LAS float*)(lds + C2_R), *KR = (LAS float*)(lds + C2_KR), *Vv = (LAS float*)(lds + C2_V), *Ee = (LAS float*)(lds + C2_E), *LA_ = (LAS float*)(lds + C2_LA), *CUM = (LAS float*)(lds + C2_CUM);
    LAS float *YO = (LAS float*)(lds + C2_YO), *Gm = (LAS float*)(lds + C2_G), *ABT = (LAS float*)(lds + C2_ABT), *GC = (LAS float*)(lds + C2_GC), *BON = (LAS float*)(lds + C2_BON);
    LAS bf16_t *UB = (LAS bf16_t*)(lds + C2_UB), *AKT = (LAS bf16_t*)(lds + C2_AKT), *NBT = (LAS bf16_t*)(lds + C2_NBT), *NKT = (LAS bf16_t*)(lds + C2_NKT);
    LAS bf16_t *KKS = (LAS bf16_t*)(lds + C2_KKS), *BS = (LAS bf16_t*)(lds + C2_BS), *KDS = (LAS bf16_t*)(lds + C2_KDS), *RS = (LAS bf16_t*)(lds + C2_RS);
    LAS bf16_t *BST = (LAS bf16_t*)(lds + C2_BST), *KDST = (LAS bf16_t*)(lds + C2_KDST), *VT = (LAS bf16_t*)(lds + C2_VT), *S0B = (LAS bf16_t*)(lds + C2_S0B);
    auto segcol = [&](int s) { return s < 3 ? s * RW + h * 64 : (s == 3 ? OFF_WD + d * DL : OFF_AD + d * AL); };
    for (int i = tid; i < 2 * RAWW; i += NT) { const int m = i / RAWW, c = i % RAWW; MU[i] = in.shift_mu[m * RC + segcol(c >> 6) + (c & 63)]; }
    for (int i = tid; i < 64 * 64; i += NT) { const int j = i >> 6, c = i & 63;
        WUP[c * 72 + j] = f2bf(in.rw_w_up[((size_t)d * DL + j) * RW + h * 64 + c]); AUP[c * 72 + j] = f2bf(in.rw_a_up[((size_t)d * AL + j) * RW + h * 64 + c]); }
    for (int i = tid; i < 64; i += NT) { CST[i] = in.rw_w0[d * RW + h * 64 + i]; CST[64 + i] = in.rw_a0[d * RW + h * 64 + i]; CST[128 + i] = in.rw_k_k[h * 64 + i]; CST[192 + i] = in.rw_k_a[h * 64 + i]; CST[256 + i] = in.rw_r_k[h * 64 + i]; }
    for (int i = tid; i < 64 * 72 / 2; i += NT) ((LAS unsigned*)S0B)[i] = 0u;
    constexpr int NQ = (CTX + SEQ) / TB, NQC = CTX / TB;
    auto blk_info = [&](int q, bool& isctx, int& t0, bool& hp, bool& hn, size_t& grow0) {
        isctx = q < NQC;
        if (isctx) { const int qq = d == 0 ? q : NQC - 1 - q; t0 = qq * TB; hp = t0 > 0; hn = t0 + TB < CTX; grow0 = (size_t)nlat + (size_t)bl * CTX + t0; }
        else { const int ql = q - NQC, qq = d == 0 ? ql : SEQ / TB - 1 - ql; t0 = qq * TB; hp = (t0 % GW) != 0; hn = ((t0 + TB) % GW) != 0; grow0 = (size_t)bl * SEQ + t0; }
    };
    u32x4 pre[RW_PPT]; int poff[RW_PPT], plds[RW_PPT], pkind[RW_PPT];
#pragma unroll
    for (int k = 0; k < RW_PPT; ++k) { const int i = tid + k * NT, rr = i / 40, sp = i % 40, seg = sp >> 3, part = sp & 7;
        poff[k] = (rr - 1) * Z1_N + segcol(seg) + part * 8; plds[k] = rr * RAWW + sp * 8; pkind[k] = i >= RW_NPIECE ? 3 : (rr == 0 ? 1 : (rr == TB + 1 ? 2 : 0)); }
    auto prefetch = [&](int q) {
        bool isctx, hp, hn; int t0; size_t grow0; blk_info(q, isctx, t0, hp, hn, grow0);
        const bf16_t* base = p.z1 + grow0 * Z1_N;
#pragma unroll
        for (int k = 0; k < RW_PPT; ++k) { u32x4 v = (u32x4){0u, 0u, 0u, 0u};
            const bool ok = pkind[k] == 0 || (pkind[k] == 1 && hp) || (pkind[k] == 2 && hn);
            if (ok) v = *(const u32x4*)(base + poff[k]);
            pre[k] = v; }
    };
    auto commit = [&]() {
#pragma unroll
        for (int k = 0; k < RW_PPT; ++k) if (pkind[k] != 3) *(LAS u32x4*)(RAW + plds[k]) = pre[k];
    };
    f32x4 Sreg[2];
    Sreg[0] = (f32x4){0.f, 0.f, 0.f, 0.f}; Sreg[1] = Sreg[0];
    const int rt = wid >> 1;
    prefetch(0);
    for (int q = 0; q < NQ; ++q) {
        bool isctx, hp, hn; int t0; size_t grow0; blk_info(q, isctx, t0, hp, hn, grow0);
        commit();
        __syncthreads();
        if (q + 1 < NQ) prefetch(q + 1);
        auto shift8 = [&](int t, int c0, float (&s)[8]) {
            const u32x4 xp = *(const LAS u32x4*)(RAW + t * RAWW + c0), xc = *(const LAS u32x4*)(RAW + (t + 1) * RAWW + c0), xn_ = *(const LAS u32x4*)(RAW + (t + 2) * RAWW + c0);
            const f32x4 m0a = *(const LAS f32x4*)(MU + c0), m0b = *(const LAS f32x4*)(MU + c0 + 4), m1a = *(const LAS f32x4*)(MU + RAWW + c0), m1b = *(const LAS f32x4*)(MU + RAWW + c0 + 4);
#pragma unroll
            for (int j = 0; j < 4; ++j) { const unsigned a = xp[j], b = xc[j], c = xn_[j];
                const float mu0l = j < 2 ? m0a[2 * j] : m0b[2 * j - 4], mu0h = j < 2 ? m0a[2 * j + 1] : m0b[2 * j - 3], mu1l = j < 2 ? m1a[2 * j] : m1b[2 * j - 4], mu1h = j < 2 ? m1a[2 * j + 1] : m1b[2 * j - 3];
                { const float x = bflo(b); s[2 * j] = x + mu0l * (bflo(a) - x) + mu1l * (bflo(c) - x); }
                { const float x = bfhi(b); s[2 * j + 1] = x + mu0h * (bfhi(a) - x) + mu1h * (bfhi(c) - x); } } };
        for (int it = tid; it < TB * 24; it += NT) {
            const int t = it / 24, g = it % 24, seg = g >> 3, cc = (g & 7) * 8, js = d == 0 ? t : TB - 1 - t; float s[8]; shift8(t, g * 8, s);
            LAS float* dst = (seg == 0 ? Rr : (seg == 1 ? KR : Vv)) + js * 64 + cc; *(LAS f32x4*)dst = (f32x4){s[0], s[1], s[2], s[3]}; *(LAS f32x4*)(dst + 4) = (f32x4){s[4], s[5], s[6], s[7]};
        }
        { const int t = tid >> 4, g = 24 + (tid & 15), cc = (g & 7) * 8, js = d == 0 ? t : TB - 1 - t; float s[8]; shift8(t, g * 8, s);
          const bool isw = (tid & 15) < 8;
#pragma unroll
          for (int j = 0; j < 8; ++j) { const float th = fast_tanh(s[j]); s[j] = isw ? th : s[j]; }
          LAS bf16_t* dst = (isw ? AWD : AAD) + js * 72 + cc;
          u32x4 w; w.x = cvt_pk_bf16(s[0], s[1]); w.y = cvt_pk_bf16(s[2], s[3]); w.z = cvt_pk_bf16(s[4], s[5]); w.w = cvt_pk_bf16(s[6], s[7]); *(LAS u32x4*)dst = w; }
        __syncthreads();
        if (MODE == 3) continue;
        {
            const int lora = wid >> 2, ct = wid & 3;
            const LAS bf16_t* Am = lora ? AAD : AWD; const LAS bf16_t* Bm = lora ? AUP : WUP;
            float carry = 0.f;
#pragma unroll
            for (int r2 = 0; r2 < 2; ++r2) {
                f32x4 acc = (f32x4){0.f, 0.f, 0.f, 0.f};
#pragma unroll
                for (int ks = 0; ks < 2; ++ks) acc = __builtin_amdgcn_mfma_f32_16x16x32_bf16(ldsb8(Am + (r2 * 16 + fr) * 72 + ks * 32 + fq * 8), ldsb8(Bm + (ct * 16 + fr) * 72 + ks * 32 + fq * 8), acc, 0, 0, 0);
                const int col = ct * 16 + fr;
                if (lora == 0) {
                    float c[4];
#pragma unroll
                    for (int i = 0; i < 4; ++i) { const float lw = acc[i] + CST[col]; const float e = __expf(-fast_softplus(-lw) - 0.5f); c[i] = i ? c[i - 1] + e : e; }
                    const float tot = c[3];
                    float s1 = tot; { const float y = __shfl_up(s1, 16); s1 += fq >= 1 ? y : 0.f; }
                    float s2 = s1;  { const float z = __shfl_up(s1, 32); s2 += fq >= 2 ? z : 0.f; }
                    const float base = carry + s2 - tot;
#pragma unroll
                    for (int i = 0; i < 4; ++i) CUM[(r2 * 16 + fq * 4 + i) * 64 + col] = base + c[i];
                    carry += __shfl(s2, 48 + fr);
                } else {
#pragma unroll
                    for (int i = 0; i < 4; ++i) LA_[(r2 * 16 + fq * 4 + i) * 64 + col] = fast_sigmoid(acc[i] + CST[64 + col]);
                }
            }
        }
        __syncthreads();
        if (MODE == 2) continue;
        {
            const int j = tid >> 4, c4 = (tid & 15) * 4;
            const f32x4 k = *(const LAS f32x4*)(KR + j * 64 + c4), a = *(const LAS f32x4*)(LA_ + j * 64 + c4), r = *(const LAS f32x4*)(Rr + j * 64 + c4), vv = *(const LAS f32x4*)(Vv + j * 64 + c4);
            const f32x4 cu = *(const LAS f32x4*)(CUM + j * 64 + c4); f32x4 cp = (f32x4){0.f, 0.f, 0.f, 0.f}; if (j > 0) cp = *(const LAS f32x4*)(CUM + (j - 1) * 64 + c4);
            float kkr[4], ss = 0.f, bn = 0.f;
#pragma unroll
            for (int x = 0; x < 4; ++x) { kkr[x] = k[x] * CST[128 + c4 + x]; ss += kkr[x] * kkr[x]; }
            ss = allreduce16(ss);
            const float inv = 1.f / fmaxf(sqrtf(ss), 1e-12f);
            float kks[4], bs[4], kds[4], rs[4];
#pragma unroll
            for (int x = 0; x < 4; ++x) { const float kk = kkr[x] * inv, kd = k[x] * (1.f + (a[x] - 1.f) * CST[192 + c4 + x]), bb = kk * a[x];
                const float g = __expf(-cu[x]), gp = __expf(-cp[x]), ig = __expf(cu[x]);
                kks[x] = kk * gp; bs[x] = bb * ig; kds[x] = kd * ig; rs[x] = r[x] * g; bn += r[x] * kd * CST[256 + c4 + x];
                if (j == TB - 1) GC[c4 + x] = g;
            }
#pragma unroll
            for (int x = 0; x < 4; x += 2) { const unsigned pb = cvt_pk_bf16(bs[x], bs[x + 1]), pk = cvt_pk_bf16(kds[x], kds[x + 1]), pv = cvt_pk_bf16(vv[x], vv[x + 1]);
                BST[(c4 + x) * 40 + j] = (bf16_t)pb; BST[(c4 + x + 1) * 40 + j] = (bf16_t)(pb >> 16); KDST[(c4 + x) * 40 + j] = (bf16_t)pk; KDST[(c4 + x + 1) * 40 + j] = (bf16_t)(pk >> 16);
                VT[(c4 + x) * 40 + j] = (bf16_t)pv; VT[(c4 + x + 1) * 40 + j] = (bf16_t)(pv >> 16); }
            bn = allreduce16(bn);
            u32x2 w; w.x = cvt_pk_bf16(kks[0], kks[1]); w.y = cvt_pk_bf16(kks[2], kks[3]); *(LAS u32x2*)(KKS + j * 72 + c4) = w;
            w.x = cvt_pk_bf16(bs[0], bs[1]); w.y = cvt_pk_bf16(bs[2], bs[3]); *(LAS u32x2*)(BS + j * 72 + c4) = w;
            w.x = cvt_pk_bf16(kds[0], kds[1]); w.y = cvt_pk_bf16(kds[2], kds[3]); *(LAS u32x2*)(KDS + j * 72 + c4) = w;
            w.x = cvt_pk_bf16(rs[0], rs[1]); w.y = cvt_pk_bf16(rs[2], rs[3]); *(LAS u32x2*)(RS + j * 72 + c4) = w;
            if ((tid & 15) == 0) BON[j] = bn;
        }
        __syncthreads();
        if (MODE == 1) continue;
        const int ctg = wid & 1;
        f32x4 accG = (f32x4){0.f, 0.f, 0.f, 0.f}, accY = accG;
        {
            const int pr = wid >> 1, rts = wid & 1;
            const LAS bf16_t* Xm = (pr & 1) ? KDS : BS; const LAS bf16_t* Ym = (pr < 2) ? KKS : RS;
            const bf16x8 a0 = ldsb8(Xm + (rts * 16 + fr) * 72 + fq * 8), a1 = ldsb8(Xm + (rts * 16 + fr) * 72 + 32 + fq * 8);
#pragma unroll
            for (int cts = 0; cts < 2; ++cts) {
                f32x4 acc = (f32x4){0.f, 0.f, 0.f, 0.f};
                acc = __builtin_amdgcn_mfma_f32_16x16x32_bf16(a0, ldsb8(Ym + (cts * 16 + fr) * 72 + fq * 8), acc, 0, 0, 0);
                acc = __builtin_amdgcn_mfma_f32_16x16x32_bf16(a1, ldsb8(Ym + (cts * 16 + fr) * 72 + 32 + fq * 8), acc, 0, 0, 0);
                const int t = cts * 16 + fr, s0 = rts * 16 + fq * 4;
#pragma unroll
                for (int i = 0; i < 4; ++i) { const bool keep = (pr < 2) ? (s0 + i < t) : (s0 + i <= t); acc[i] = keep ? acc[i] : 0.f; }
                if (pr == 0) *(LAS f32x4*)(ABT + t * 32 + s0) = acc;
                else { u32x2 w; w.x = cvt_pk_bf16(acc[0], acc[1]); w.y = cvt_pk_bf16(acc[2], acc[3]); *(LAS u32x2*)((pr == 1 ? AKT : (pr == 2 ? NBT : NKT)) + t * 40 + s0) = w; }
            }
#pragma unroll
            for (int ks = 0; ks < 2; ++ks) { const bf16x8 sa = ldsb8(S0B + (rt * 16 + fr) * 72 + ks * 32 + fq * 8);
                accG = __builtin_amdgcn_mfma_f32_16x16x32_bf16(sa, ldsb8(KKS + (ctg * 16 + fr) * 72 + ks * 32 + fq * 8), accG, 0, 0, 0);
                accY = __builtin_amdgcn_mfma_f32_16x16x32_bf16(sa, ldsb8(RS + (ctg * 16 + fr) * 72 + ks * 32 + fq * 8), accY, 0, 0, 0); }
        }
        __syncthreads();
        {
            const bf16x8 va = ldsb8(VT + (rt * 16 + fr) * 40 + fq * 8);
            accG = __builtin_amdgcn_mfma_f32_16x16x32_bf16(va, ldsb8(AKT + (ctg * 16 + fr) * 40 + fq * 8), accG, 0, 0, 0);
            accY = __builtin_amdgcn_mfma_f32_16x16x32_bf16(va, ldsb8(NKT + (ctg * 16 + fr) * 40 + fq * 8), accY, 0, 0, 0);
#pragma unroll
            for (int i = 0; i < 4; ++i) Gm[(rt * 16 + fq * 4 + i) * 36 + ctg * 16 + fr] = -accG[i];
        }
        __syncthreads();
        if (MODE == 4) continue;
        if (wid < 4) {
            const int v = wid * 16 + (lane >> 2), pq = lane & 3;
            const LAS float* grow = Gm + v * 36;
            f32x4 r0 = *(const LAS f32x4*)(grow + 4 * pq), r1 = *(const LAS f32x4*)(grow + 16 + 4 * pq);
            u32x2 ubo[TB / 4];
            const LAS float* abd = ABT; asm volatile("" : "+v"(abd));
            const LAS float* abq = ABT + 128 * pq; asm volatile("" : "+v"(abq));
            f32x4 dc[3], a0c[4], a1c[4];
            auto ldg = [&](int g, f32x4 (&dd)[3], f32x4 (&aa0)[4], f32x4 (&aa1)[4]) {
#pragma unroll
                for (int x = 0; x < 3; ++x) dd[x] = *(const LAS f32x4*)(abd + (4 * g + 1 + x) * 32 + 4 * g);
#pragma unroll
                for (int jj = 0; jj < 4; ++jj) { if (g < 3) aa0[jj] = *(const LAS f32x4*)(abq + jj * 32 + 4 * g); if (g < 7) aa1[jj] = *(const LAS f32x4*)(abq + (16 + jj) * 32 + 4 * g); } };
            ldg(0, dc, a0c, a1c);
#pragma unroll
            for (int g = 0; g < TB / 4; ++g) {
                f32x4 dn[3], a0n[4], a1n[4];
                if (g + 1 < TB / 4) ldg(g + 1, dn, a0n, a1n);
                __builtin_amdgcn_sched_barrier(0);
                const f32x4 rr = g < 4 ? r0 : r1;
                f32x4 u4;
                u4[0] = rr[0];
                u4[1] = rr[1] - u4[0] * dc[0][0];
                u4[2] = rr[2] - (u4[0] * dc[1][0] + u4[1] * dc[1][1]);
                u4[3] = rr[3] - (u4[0] * dc[2][0] + u4[1] * dc[2][1] + u4[2] * dc[2][2]);
#pragma unroll
                for (int x = 0; x < 4; ++x) { const int ui = __float_as_int(u4[x]); int bi;
                    if ((g & 3) == 0) bi = __builtin_amdgcn_update_dpp(0, ui, 0x00, 0xF, 0xF, true); else if ((g & 3) == 1) bi = __builtin_amdgcn_update_dpp(0, ui, 0x55, 0xF, 0xF, true);
                    else if ((g & 3) == 2) bi = __builtin_amdgcn_update_dpp(0, ui, 0xAA, 0xF, 0xF, true); else bi = __builtin_amdgcn_update_dpp(0, ui, 0xFF, 0xF, 0xF, true);
                    u4[x] = __int_as_float(bi); }
                ubo[g].x = cvt_pk_bf16(u4[0], u4[1]); ubo[g].y = cvt_pk_bf16(u4[2], u4[3]);
                if (g < 3) {
#pragma unroll
                    for (int jj = 0; jj < 4; ++jj) r0[jj] -= u4[0] * a0c[jj][0] + u4[1] * a0c[jj][1] + u4[2] * a0c[jj][2] + u4[3] * a0c[jj][3]; }
                if (g < 7) {
#pragma unroll
                    for (int jj = 0; jj < 4; ++jj) r1[jj] -= u4[0] * a1c[jj][0] + u4[1] * a1c[jj][1] + u4[2] * a1c[jj][2] + u4[3] * a1c[jj][3]; }
                if (g + 1 < TB / 4) {
#pragma unroll
                    for (int x = 0; x < 3; ++x) dc[x] = dn[x];
#pragma unroll
                    for (int jj = 0; jj < 4; ++jj) { a0c[jj] = a0n[jj]; a1c[jj] = a1n[jj]; } }
            }
            if (pq == 0) {
#pragma unroll
                for (int g = 0; g < TB / 4; g += 2) { u32x4 w; w.x = ubo[g].x; w.y = ubo[g].y; w.z = ubo[g + 1].x; w.w = ubo[g + 1].y; *(LAS u32x4*)(UB + v * 40 + 4 * g) = w; } }
        }
        __syncthreads();
        if (MODE == 5) continue;
        {
            const bf16x8 ua = ldsb8(UB + (rt * 16 + fr) * 40 + fq * 8), va = ldsb8(VT + (rt * 16 + fr) * 40 + fq * 8);
            accY = __builtin_amdgcn_mfma_f32_16x16x32_bf16(ua, ldsb8(NBT + (ctg * 16 + fr) * 40 + fq * 8), accY, 0, 0, 0);
            *(LAS f32x4*)(YO + (ctg * 16 + fr) * 64 + rt * 16 + fq * 4) = accY;
#pragma unroll
            for (int cc = 0; cc < 2; ++cc) { const int ct = 2 * (wid & 1) + cc, kcol = ct * 16 + fr;
                f32x4 acc = Sreg[cc];
                acc = __builtin_amdgcn_mfma_f32_16x16x32_bf16(ua, ldsb8(BST + kcol * 40 + fq * 8), acc, 0, 0, 0);
                acc = __builtin_amdgcn_mfma_f32_16x16x32_bf16(va, ldsb8(KDST + kcol * 40 + fq * 8), acc, 0, 0, 0);
                const float g = GC[kcol];
#pragma unroll
                for (int i = 0; i < 4; ++i) acc[i] *= g;
                { const unsigned p0 = cvt_pk_bf16(acc[0], acc[1]), p1 = cvt_pk_bf16(acc[2], acc[3]); LAS bf16_t* sp = S0B + (rt * 16 + fq * 4) * 72 + kcol;
                  sp[0] = (bf16_t)p0; sp[72] = (bf16_t)(p0 >> 16); sp[144] = (bf16_t)p1; sp[216] = (bf16_t)(p1 >> 16); }
                Sreg[cc] = acc; }
        }
        __syncthreads();
        if (!isctx) {
            const int j = tid >> 4, c4 = (tid & 15) * 4, t = d == 0 ? j : TB - 1 - j; const f32x4 y = *(const LAS f32x4*)(YO + j * 64 + c4);
            u32x2 w; w.x = cvt_pk_bf16(y[0], y[1]); w.y = cvt_pk_bf16(y[2], y[3]);
            bf16_t* yb_ = p.Y + ((size_t)d * nlat + grow0) * RW + h * 64;
            *(u32x2*)(yb_ + t * RW + c4) = w;
            if (tid < TB) { const int tt = d == 0 ? tid : TB - 1 - tid; float* bb_ = p.bon + ((size_t)d * nlat + grow0) * NH + h; bb_[tt * NH] = BON[tid]; }
        }
    }
}
template <int MODE = 0>
__device__ __forceinline__ void rwkv_phase2(LAS unsigned char* lds, const In& in, const RwkvP p, int bid, int nblk) {
    const int nchain = 2 * p.nb * NH;
    for (int c = bid; c < nchain; c += nblk) { rwkv_chain2<MODE>(lds, in, p, c); __syncthreads(); }
}
}

namespace mk {
namespace r3 {
constexpr int C2_RAW = 0;
constexpr int C2_MU = C2_RAW + (TB + 2) * RAWW * 2;
constexpr int C2_WUP = C2_MU + 3 * RAWW * 4;
constexpr int C2_AUP = C2_WUP + 64 * 72 * 2;
constexpr int C2_CST = C2_AUP + 64 * 72 * 2;
constexpr int C2_AWD = C2_CST + 5 * 64 * 4;
constexpr int C2_AAD = C2_AWD + TB * 72 * 2;
constexpr int C2_X = C2_AAD + TB * 72 * 2;
constexpr int C2_G = C2_X;
constexpr int C2_UB = C2_G + 64 * 36 * 4;
constexpr int C2_ABT = C2_UB + 64 * 40 * 2;
constexpr int C2_AKT = C2_ABT + 32 * 32 * 4;
constexpr int C2_NBT = C2_AKT + 32 * 40 * 2;
constexpr int C2_NKT = C2_NBT + 32 * 40 * 2;
constexpr int C2_YO = C2_NKT + 32 * 40 * 2;
constexpr int C2_X_END = C2_YO + TB * 64 * 4;
constexpr int C2_KKS = C2_X_END;
constexpr int C2_BS = C2_KKS + TB * 72 * 2, C2_KDS = C2_BS + TB * 72 * 2, C2_RS = C2_KDS + TB * 72 * 2;
constexpr int C2_BST = C2_RS + TB * 72 * 2;
constexpr int C2_KDST = C2_BST + 64 * 40 * 2;
constexpr int C2_VT = C2_KDST + 64 * 40 * 2;
constexpr int C2_S0B = C2_VT + 64 * 40 * 2;
constexpr int C2_GC = C2_S0B + 64 * 72 * 2;
constexpr int C2_BON = C2_GC + 64 * 4;
constexpr int C2_RB = C2_BON + TB * 4;
constexpr int C2_KRB = C2_RB + TB * 64 * 2, C2_VB = C2_KRB + TB * 64 * 2;
constexpr int C2_LA = C2_VB + TB * 64 * 2;
constexpr int C2_CUM = C2_LA + TB * 64 * 4;
constexpr int C2_BON2 = C2_CUM + (TB + 1) * 64 * 4;
constexpr int C2_END = C2_BON2 + TB * 4;
static_assert(C2_END <= LDS_BYTES - 16 && (C2_X % 16) == 0 && (C2_KKS % 16) == 0 && (C2_G % 16) == 0 && (C2_UB % 16) == 0 && (C2_ABT % 16) == 0 && (C2_AKT % 16) == 0 && (C2_S0B % 16) == 0, "rwkv2 LDS");

__device__ __forceinline__ bf16x8 ldsb8(const LAS bf16_t* p) { return *(const LAS bf16x8*)p; }

template <int MODE>
__device__ __forceinline__ void rwkv_chain3(LAS unsigned char* lds, const In& in, const RwkvP p, int chain) {
    const int tid = threadIdx.x, lane = tid & 63, wid = tid >> 6, fr = lane & 15, fq = lane >> 4;
    const int d = chain / (p.nb * NH), bl = (chain / NH) % p.nb, h = chain % NH;
    const int nlat = p.nb * SEQ;
    LAS bf16_t* RAW = (LAS bf16_t*)(lds + C2_RAW); LAS float* MU = (LAS float*)(lds + C2_MU);
    LAS bf16_t* WUP = (LAS bf16_t*)(lds + C2_WUP); LAS bf16_t* AUP = (LAS bf16_t*)(lds + C2_AUP); LAS float* CST = (LAS float*)(lds + C2_CST);
    LAS bf16_t* AWD = (LAS bf16_t*)(lds + C2_AWD); LAS bf16_t* AAD = (LAS bf16_t*)(lds + C2_AAD);
    LAS bf16_t *Rb = (LAS bf16_t*)(lds + C2_RB), *KRb = (LAS bf16_t*)(lds + C2_KRB), *Vb = (LAS bf16_t*)(lds + C2_VB); LAS float *LA_ = (LAS float*)(lds + C2_LA), *CUM = (LAS float*)(lds + C2_CUM);
    LAS float *YO = (LAS float*)(lds + C2_YO), *Gm = (LAS float*)(lds + C2_G), *ABT = (LAS float*)(lds + C2_ABT), *GC = (LAS float*)(lds + C2_GC), *BON = (LAS float*)(lds + C2_BON);
    LAS bf16_t *UB = (LAS bf16_t*)(lds + C2_UB), *AKT = (LAS bf16_t*)(lds + C2_AKT), *NBT = (LAS bf16_t*)(lds + C2_NBT), *NKT = (LAS bf16_t*)(lds + C2_NKT);
    LAS bf16_t *KKS = (LAS bf16_t*)(lds + C2_KKS), *BS = (LAS bf16_t*)(lds + C2_BS), *KDS = (LAS bf16_t*)(lds + C2_KDS), *RS = (LAS bf16_t*)(lds + C2_RS);
    LAS bf16_t *BST = (LAS bf16_t*)(lds + C2_BST), *KDST = (LAS bf16_t*)(lds + C2_KDST), *VT = (LAS bf16_t*)(lds + C2_VT), *S0B = (LAS bf16_t*)(lds + C2_S0B);
    auto segcol = [&](int s) __attribute__((always_inline)) { return s < 3 ? s * RW + h * 64 : (s == 3 ? OFF_WD + d * DL : OFF_AD + d * AL); };
    for (int i = tid; i < RAWW; i += NT) { const float m0 = in.shift_mu[segcol(i >> 6) + (i & 63)], m1 = in.shift_mu[RC + segcol(i >> 6) + (i & 63)]; MU[i] = m0; MU[RAWW + i] = m1; MU[2 * RAWW + i] = 1.f - m0 - m1; }
    for (int i = tid; i < 64 * 64; i += NT) { const int j = i >> 6, c = i & 63;
        WUP[c * 72 + j] = f2bf(in.rw_w_up[((size_t)d * DL + j) * RW + h * 64 + c]); AUP[c * 72 + j] = f2bf(in.rw_a_up[((size_t)d * AL + j) * RW + h * 64 + c]); }
    for (int i = tid; i < 64; i += NT) { CST[i] = in.rw_w0[d * RW + h * 64 + i]; CST[64 + i] = in.rw_a0[d * RW + h * 64 + i]; CST[128 + i] = in.rw_k_k[h * 64 + i]; CST[192 + i] = in.rw_k_a[h * 64 + i]; CST[256 + i] = in.rw_r_k[h * 64 + i]; }
    for (int i = tid; i < 64 * 72 / 2; i += NT) ((LAS unsigned*)S0B)[i] = 0u;
    constexpr int NQ = (CTX + SEQ) / TB, NQC = CTX / TB;
    auto blk_info = [&](int q, bool& isctx, int& t0, bool& hp, bool& hn, size_t& grow0) __attribute__((always_inline)) {
        isctx = q < NQC;
        if (isctx) { const int qq = d == 0 ? q : NQC - 1 - q; t0 = qq * TB; hp = t0 > 0; hn = t0 + TB < CTX; grow0 = (size_t)nlat + (size_t)bl * CTX + t0; }
        else { const int ql = q - NQC, qq = d == 0 ? ql : SEQ / TB - 1 - ql; t0 = qq * TB; hp = (t0 % GW) != 0; hn = ((t0 + TB) % GW) != 0; grow0 = (size_t)bl * SEQ + t0; }
    };
    u32x4 pre[RW_PPT]; int poff[RW_PPT], plds[RW_PPT];
#pragma unroll
    for (int k = 0; k < RW_PPT; ++k) { const int i = tid + k * NT, rr = i / 40, sp = i % 40, seg = sp >> 3, part = sp & 7;
        poff[k] = (rr - 1) * Z1_N + segcol(seg) + part * 8; plds[k] = (rr * RAWW + sp * 8) | (i >= RW_NPIECE ? 3 : (rr == 0 ? 1 : (rr == TB + 1 ? 2 : 0))); }
    auto prefetch = [&](int q) __attribute__((always_inline)) {
        bool isctx, hp, hn; int t0; size_t grow0; blk_info(q, isctx, t0, hp, hn, grow0);
        const bf16_t* base = p.z1 + grow0 * Z1_N;
#pragma unroll
        for (int k = 0; k < RW_PPT; ++k) { u32x4 v = (u32x4){0u, 0u, 0u, 0u};
            const int kind = plds[k] & 3; const bool ok = kind == 0 || (kind == 1 && hp) || (kind == 2 && hn);
            if (ok) v = *(const u32x4*)(base + poff[k]);
            pre[k] = v; }
    };
    auto commit = [&]() __attribute__((always_inline)) {
#pragma unroll
        for (int k = 0; k < RW_PPT; ++k) if ((plds[k] & 3) != 3) *(LAS u32x4*)(RAW + (plds[k] & ~3)) = pre[k];
    };
    f32x4 Sreg[2];
    Sreg[0] = (f32x4){0.f, 0.f, 0.f, 0.f}; Sreg[1] = Sreg[0];
    const int rt = wid >> 1;
    auto shift8 = [&](int t, int c0, f32x2 (&s)[4]) __attribute__((always_inline)) {
        const u32x4 xp = *(const LAS u32x4*)(RAW + t * RAWW + c0), xc = *(const LAS u32x4*)(RAW + (t + 1) * RAWW + c0), xn_ = *(const LAS u32x4*)(RAW + (t + 2) * RAWW + c0);
        const f32x4 m0a = *(const LAS f32x4*)(MU + c0), m0b = *(const LAS f32x4*)(MU + c0 + 4), m1a = *(const LAS f32x4*)(MU + RAWW + c0), m1b = *(const LAS f32x4*)(MU + RAWW + c0 + 4),
                    mca = *(const LAS f32x4*)(MU + 2 * RAWW + c0), mcb = *(const LAS f32x4*)(MU + 2 * RAWW + c0 + 4);
#define MK_SH2(J, XP, XC, XN, MC2, M02, M12) { f32x2 C, P, N; C.x = bflo(XC); C.y = bfhi(XC); P.x = bflo(XP); P.y = bfhi(XP); N.x = bflo(XN); N.y = bfhi(XN); f32x2 r_ = MC2 * C; r_ = M02 * P + r_; r_ = M12 * N + r_; s[J] = r_; }
        MK_SH2(0, xp.x, xc.x, xn_.x, mca.lo, m0a.lo, m1a.lo) MK_SH2(1, xp.y, xc.y, xn_.y, mca.hi, m0a.hi, m1a.hi)
        MK_SH2(2, xp.z, xc.z, xn_.z, mcb.lo, m0b.lo, m1b.lo) MK_SH2(3, xp.w, xc.w, xn_.w, mcb.hi, m0b.hi, m1b.hi)
#undef MK_SH2
    };
    auto pack4 = [&](const f32x2 (&s)[4]) __attribute__((always_inline)) { u32x4 w; w.x = cvt_pk_bf16(s[0].x, s[0].y); w.y = cvt_pk_bf16(s[1].x, s[1].y); w.z = cvt_pk_bf16(s[2].x, s[2].y); w.w = cvt_pk_bf16(s[3].x, s[3].y); return w; };
    int sh_t[3], sh_c[3], sh_d[3];
#pragma unroll
    for (int k = 0; k < 3; ++k) { const int it = (tid & (NT / 2 - 1)) + k * (NT / 2), t = it / 24, g = it % 24, seg = g >> 3, cc = (g & 7) * 8, js = d == 0 ? t : TB - 1 - t;
        sh_t[k] = t; sh_c[k] = g * 8; sh_d[k] = seg * (TB * 64) + js * 64 + cc; }
    auto do_shift = [&](int tl, int nth) __attribute__((always_inline)) {
#pragma unroll
        for (int k = 0; k < 3; ++k) { f32x2 s[4]; shift8(sh_t[k], sh_c[k], s); *(LAS u32x4*)(Rb + sh_d[k]) = pack4(s); }
#pragma unroll 1
        for (int it = tl; it < TB * 8; it += nth) { const int t = it >> 3, part = it & 7, js = d == 0 ? t : TB - 1 - t;
            { f32x2 s[4]; shift8(t, (24 + part) * 8, s);
#pragma unroll
              for (int j = 0; j < 4; ++j) { s[j].x = 1.f - 2.f * fast_rcp(1.f + __builtin_amdgcn_exp2f(2.885390081777927f * s[j].x)); s[j].y = 1.f - 2.f * fast_rcp(1.f + __builtin_amdgcn_exp2f(2.885390081777927f * s[j].y)); }
              *(LAS u32x4*)(AWD + js * 72 + part * 8) = pack4(s); }
            { f32x2 s[4]; shift8(t, (32 + part) * 8, s); *(LAS u32x4*)(AAD + js * 72 + part * 8) = pack4(s); }
        }
    };
    auto lora_stage = [&]() __attribute__((always_inline)) {
        {
            const int lora = wid >> 2, ct = wid & 3;
            const LAS bf16_t* Am = lora ? AAD : AWD; const LAS bf16_t* Bm = lora ? AUP : WUP;
            float carry = 0.f;
#pragma unroll
            for (int r2 = 0; r2 < 2; ++r2) {
                f32x4 acc = (f32x4){0.f, 0.f, 0.f, 0.f};
#pragma unroll
                for (int ks = 0; ks < 2; ++ks) acc = __builtin_amdgcn_mfma_f32_16x16x32_bf16(ldsb8(Am + (r2 * 16 + fr) * 72 + ks * 32 + fq * 8), ldsb8(Bm + (ct * 16 + fr) * 72 + ks * 32 + fq * 8), acc, 0, 0, 0);
                const int col = ct * 16 + fr;
                if (lora == 0) {
                    float c[4];
#pragma unroll
                    for (int i = 0; i < 4; ++i) { const float lw = acc[i] + CST[col]; const float e = fast_sigmoid(lw); c[i] = i ? c[i - 1] + e : e;   }
                    const float tot = c[3];
                    float s1 = tot; { const float y = __shfl_up(s1, 16); s1 += fq >= 1 ? y : 0.f; }
                    float s2 = s1;  { const float z = __shfl_up(s1, 32); s2 += fq >= 2 ? z : 0.f; }
                    const float base = carry + s2 - tot;
#pragma unroll
                    for (int i = 0; i < 4; ++i) CUM[(1 + r2 * 16 + fq * 4 + i) * 64 + col] = base + c[i];
                    carry += __shfl(s2, 48 + fr);
                } else {
#pragma unroll
                    for (int i = 0; i < 4; ++i) LA_[(r2 * 16 + fq * 4 + i) * 64 + col] = fast_sigmoid(acc[i] + CST[64 + col]);
                }
            }
        }
    };
    auto scale_stage = [&](LAS float* bonw) __attribute__((always_inline)) {
        {
            const int j = tid >> 4, c4 = (tid & 15) * 4;
            const u32x2 kp = *(const LAS u32x2*)(KRb + j * 64 + c4), rp = *(const LAS u32x2*)(Rb + j * 64 + c4), vp = *(const LAS u32x2*)(Vb + j * 64 + c4);
            const f32x4 k = (f32x4){bflo(kp.x), bfhi(kp.x), bflo(kp.y), bfhi(kp.y)}, r = (f32x4){bflo(rp.x), bfhi(rp.x), bflo(rp.y), bfhi(rp.y)};
            const f32x4 a = *(const LAS f32x4*)(LA_ + j * 64 + c4);
            const f32x4 cu = *(const LAS f32x4*)(CUM + (j + 1) * 64 + c4), cp = *(const LAS f32x4*)(CUM + j * 64 + c4);
            const f32x4 ckk = *(const LAS f32x4*)(CST + 128 + c4), cka = *(const LAS f32x4*)(CST + 192 + c4), crk = *(const LAS f32x4*)(CST + 256 + c4);
            float kkr[4], kd[4], ss = 0.f, bn = 0.f;
#pragma unroll
            for (int x = 0; x < 4; ++x) { kkr[x] = k[x] * ckk[x]; ss += kkr[x] * kkr[x]; kd[x] = k[x] * (1.f + (a[x] - 1.f) * cka[x]); bn += r[x] * kd[x] * crk[x]; }
            asm volatile("s_nop 1\n\t"
                "v_add_f32_dpp %0, %0, %0 quad_perm:[1,0,3,2] row_mask:0xf bank_mask:0xf\n\t" "v_add_f32_dpp %1, %1, %1 quad_perm:[1,0,3,2] row_mask:0xf bank_mask:0xf\n\ts_nop 0\n\t"
                "v_add_f32_dpp %0, %0, %0 quad_perm:[2,3,0,1] row_mask:0xf bank_mask:0xf\n\t" "v_add_f32_dpp %1, %1, %1 quad_perm:[2,3,0,1] row_mask:0xf bank_mask:0xf\n\ts_nop 0\n\t"
                "v_add_f32_dpp %0, %0, %0 row_half_mirror row_mask:0xf bank_mask:0xf\n\t" "v_add_f32_dpp %1, %1, %1 row_half_mirror row_mask:0xf bank_mask:0xf\n\ts_nop 0\n\t"
                "v_add_f32_dpp %0, %0, %0 row_mirror row_mask:0xf bank_mask:0xf\n\t" "v_add_f32_dpp %1, %1, %1 row_mirror row_mask:0xf bank_mask:0xf"
                : "+v"(ss), "+v"(bn));
            const float inv = __builtin_amdgcn_rsqf(fmaxf(ss, 1e-24f));
            float kks[4], bs[4], kds[4], rs[4]; f32x4 gv;
#pragma unroll
            for (int x = 0; x < 4; ++x) { const float kk = kkr[x] * inv, bb = kk * a[x];
                const float ig = __builtin_amdgcn_exp2f(0.87503877f * cu[x]), g = fast_rcp(ig), gp = __builtin_amdgcn_exp2f(-0.87503877f * cp[x]);
                kks[x] = kk * gp; bs[x] = bb * ig; kds[x] = kd[x] * ig; rs[x] = r[x] * g; gv[x] = g;
            }
            if (j == TB - 1) *(LAS f32x4*)(GC + c4) = gv;
#pragma unroll
            for (int x = 0; x < 4; x += 2) { const unsigned pb = cvt_pk_bf16(bs[x], bs[x + 1]), pk = cvt_pk_bf16(kds[x], kds[x + 1]), pv = x ? vp.y : vp.x;
                BST[(c4 + x) * 40 + j] = (bf16_t)pb; BST[(c4 + x + 1) * 40 + j] = (bf16_t)(pb >> 16); KDST[(c4 + x) * 40 + j] = (bf16_t)pk; KDST[(c4 + x + 1) * 40 + j] = (bf16_t)(pk >> 16);
                VT[(c4 + x) * 40 + j] = (bf16_t)pv; VT[(c4 + x + 1) * 40 + j] = (bf16_t)(pv >> 16); }
            u32x2 w; w.x = cvt_pk_bf16(kks[0], kks[1]); w.y = cvt_pk_bf16(kks[2], kks[3]); *(LAS u32x2*)(KKS + j * 72 + c4) = w;
            w.x = cvt_pk_bf16(bs[0], bs[1]); w.y = cvt_pk_bf16(bs[2], bs[3]); *(LAS u32x2*)(BS + j * 72 + c4) = w;
            w.x = cvt_pk_bf16(kds[0], kds[1]); w.y = cvt_pk_bf16(kds[2], kds[3]); *(LAS u32x2*)(KDS + j * 72 + c4) = w;
            w.x = cvt_pk_bf16(rs[0], rs[1]); w.y = cvt_pk_bf16(rs[2], rs[3]); *(LAS u32x2*)(RS + j * 72 + c4) = w;
            if ((tid & 15) == 0) bonw[j] = bn;
        }
    };
    if (tid < 16) *(LAS f32x4*)(CUM + tid * 4) = (f32x4){0.f, 0.f, 0.f, 0.f};
    prefetch(0);
    commit();
    __syncthreads();
    if (1 < NQ) prefetch(1);
    do_shift(tid & (NT / 2 - 1), NT / 2);
    __syncthreads();
    lora_stage();
    __syncthreads();
    scale_stage(BON);
    __syncthreads();
    for (int q = 0; q < NQ; ++q) {
        bool isctx, hp, hn; int t0; size_t grow0; blk_info(q, isctx, t0, hp, hn, grow0);
        LAS float* bonr = BON + (q & 1) * ((C2_BON2 - C2_BON) / 4); LAS float* bonn = BON + ((q + 1) & 1) * ((C2_BON2 - C2_BON) / 4);
        const int ctg = wid & 1;
        f32x4 accG = (f32x4){0.f, 0.f, 0.f, 0.f}, accY = accG;
        {
            const int pr = wid >> 1, rts = wid & 1;
            const LAS bf16_t* Xm = (pr & 1) ? KDS : BS; const LAS bf16_t* Ym = (pr < 2) ? KKS : RS;
            const bf16x8 a0 = ldsb8(Xm + (rts * 16 + fr) * 72 + fq * 8), a1 = ldsb8(Xm + (rts * 16 + fr) * 72 + 32 + fq * 8);
#pragma unroll
            for (int cts = 0; cts < 2; ++cts) {
                f32x4 acc = (f32x4){0.f, 0.f, 0.f, 0.f};
                acc = __builtin_amdgcn_mfma_f32_16x16x32_bf16(a0, ldsb8(Ym + (cts * 16 + fr) * 72 + fq * 8), acc, 0, 0, 0);
                acc = __builtin_amdgcn_mfma_f32_16x16x32_bf16(a1, ldsb8(Ym + (cts * 16 + fr) * 72 + 32 + fq * 8), acc, 0, 0, 0);
                const int t = cts * 16 + fr, s0 = rts * 16 + fq * 4;
#pragma unroll
                for (int i = 0; i < 4; ++i) { const bool keep = (pr < 2) ? (s0 + i < t) : (s0 + i <= t); acc[i] = keep ? acc[i] : 0.f; }
                if (pr == 0) { ABT[s0 * 32 + t] = acc[0]; ABT[(s0 + 1) * 32 + t] = acc[1]; ABT[(s0 + 2) * 32 + t] = acc[2]; ABT[(s0 + 3) * 32 + t] = acc[3]; }
                else { u32x2 w; w.x = cvt_pk_bf16(acc[0], acc[1]); w.y = cvt_pk_bf16(acc[2], acc[3]); *(LAS u32x2*)((pr == 1 ? AKT : (pr == 2 ? NBT : NKT)) + t * 40 + s0) = w; }
            }
#pragma unroll
            for (int ks = 0; ks < 2; ++ks) { const bf16x8 sa = ldsb8(S0B + (rt * 16 + fr) * 72 + ks * 32 + fq * 8);
                accG = __builtin_amdgcn_mfma_f32_16x16x32_bf16(sa, ldsb8(KKS + (ctg * 16 + fr) * 72 + ks * 32 + fq * 8), accG, 0, 0, 0);
                accY = __builtin_amdgcn_mfma_f32_16x16x32_bf16(sa, ldsb8(RS + (ctg * 16 + fr) * 72 + ks * 32 + fq * 8), accY, 0, 0, 0); }
        }
        __syncthreads();
        {
            const bf16x8 va = ldsb8(VT + (rt * 16 + fr) * 40 + fq * 8);
            accG = __builtin_amdgcn_mfma_f32_16x16x32_bf16(va, ldsb8(AKT + (ctg * 16 + fr) * 40 + fq * 8), accG, 0, 0, 0);
            accY = __builtin_amdgcn_mfma_f32_16x16x32_bf16(va, ldsb8(NKT + (ctg * 16 + fr) * 40 + fq * 8), accY, 0, 0, 0);
#pragma unroll
            for (int i = 0; i < 4; ++i) Gm[(rt * 16 + fq * 4 + i) * 36 + ctg * 16 + fr] = -accG[i];
            if (q + 1 < NQ) { commit(); if (q + 2 < NQ) prefetch(q + 2); }
        }
        __syncthreads();
        if (wid >= 4) { if (q + 1 < NQ) do_shift(tid & (NT / 2 - 1), NT / 2); }
        else {
            const int v = wid * 16 + (lane >> 2), pq = lane & 3;
            const LAS float* grow = Gm + v * 36;
            f32x4 r0 = *(const LAS f32x4*)(grow + 4 * pq), r1 = *(const LAS f32x4*)(grow + 16 + 4 * pq);
            u32x2 ubo[TB / 4];
            const LAS float* abq = ABT + 4 * pq; asm volatile("" : "+v"(abq));
            f32x4 a0c[4], a1c[4];
            auto ldg = [&](int g, f32x4 (&aa0)[4], f32x4 (&aa1)[4]) __attribute__((always_inline)) {
#pragma unroll
                for (int x = 0; x < 4; ++x) { if (g < 4) aa0[x] = *(const LAS f32x4*)(abq + (4 * g + x) * 32); aa1[x] = *(const LAS f32x4*)(abq + (4 * g + x) * 32 + 16); } };
            ldg(0, a0c, a1c);
#pragma unroll
            for (int g = 0; g < TB / 4; ++g) {
                f32x4 a0n[4], a1n[4];
                if (g + 1 < TB / 4) ldg(g + 1, a0n, a1n);
                __builtin_amdgcn_sched_barrier(0);
                const f32x4 rr = g < 4 ? r0 : r1;
                f32x4 dg[3];
#pragma unroll
                for (int x = 0; x < 3; ++x) dg[x] = g < 4 ? a0c[x] : a1c[x];
                f32x4 u4;
                u4[0] = rr[0];
                u4[1] = __builtin_fmaf(-u4[0], dg[0][1], rr[1]);
                u4[2] = __builtin_fmaf(-u4[1], dg[1][2], __builtin_fmaf(-u4[0], dg[0][2], rr[2]));
                u4[3] = __builtin_fmaf(-u4[2], dg[2][3], __builtin_fmaf(-u4[1], dg[1][3], __builtin_fmaf(-u4[0], dg[0][3], rr[3])));
#pragma unroll
                for (int x = 0; x < 4; ++x) { const int ui = __float_as_int(u4[x]); int bi;
                    if ((g & 3) == 0) bi = __builtin_amdgcn_update_dpp(0, ui, 0x00, 0xF, 0xF, true); else if ((g & 3) == 1) bi = __builtin_amdgcn_update_dpp(0, ui, 0x55, 0xF, 0xF, true);
                    else if ((g & 3) == 2) bi = __builtin_amdgcn_update_dpp(0, ui, 0xAA, 0xF, 0xF, true); else bi = __builtin_amdgcn_update_dpp(0, ui, 0xFF, 0xF, 0xF, true);
                    u4[x] = __int_as_float(bi); }
                ubo[g].x = cvt_pk_bf16(u4[0], u4[1]); ubo[g].y = cvt_pk_bf16(u4[2], u4[3]);
                if (g < 3) {
                    f32x2 lo = r0.lo, hi = r0.hi;
#pragma unroll
                    for (int x = 0; x < 4; ++x) { const f32x2 ux = (f32x2){u4[x], u4[x]}; lo = lo - ux * a0c[x].lo; hi = hi - ux * a0c[x].hi; }
                    r0.lo = lo; r0.hi = hi; }
                if (g < 7) {
                    f32x2 lo = r1.lo, hi = r1.hi;
#pragma unroll
                    for (int x = 0; x < 4; ++x) { const f32x2 ux = (f32x2){u4[x], u4[x]}; lo = lo - ux * a1c[x].lo; hi = hi - ux * a1c[x].hi; }
                    r1.lo = lo; r1.hi = hi; }
                if (g + 1 < TB / 4) {
#pragma unroll
                    for (int x = 0; x < 4; ++x) { a0c[x] = a0n[x]; a1c[x] = a1n[x]; } }
            }
            if (pq == 0) {
#pragma unroll
                for (int g = 0; g < TB / 4; g += 2) { u32x4 w; w.x = ubo[g].x; w.y = ubo[g].y; w.z = ubo[g + 1].x; w.w = ubo[g + 1].y; *(LAS u32x4*)(UB + v * 40 + 4 * g) = w; } }
        }
        __syncthreads();
        {
            const bf16x8 ua = ldsb8(UB + (rt * 16 + fr) * 40 + fq * 8), va = ldsb8(VT + (rt * 16 + fr) * 40 + fq * 8);
            accY = __builtin_amdgcn_mfma_f32_16x16x32_bf16(ua, ldsb8(NBT + (ctg * 16 + fr) * 40 + fq * 8), accY, 0, 0, 0);
            *(LAS f32x4*)(YO + (ctg * 16 + fr) * 64 + rt * 16 + fq * 4) = accY;
#pragma unroll
            for (int cc = 0; cc < 2; ++cc) { const int ct = 2 * (wid & 1) + cc, kcol = ct * 16 + fr;
                f32x4 acc = Sreg[cc];
                acc = __builtin_amdgcn_mfma_f32_16x16x32_bf16(ua, ldsb8(BST + kcol * 40 + fq * 8), acc, 0, 0, 0);
                acc = __builtin_amdgcn_mfma_f32_16x16x32_bf16(va, ldsb8(KDST + kcol * 40 + fq * 8), acc, 0, 0, 0);
                const float g = GC[kcol];
#pragma unroll
                for (int i = 0; i < 4; ++i) acc[i] *= g;
                { const unsigned p0 = cvt_pk_bf16(acc[0], acc[1]), p1 = cvt_pk_bf16(acc[2], acc[3]); LAS bf16_t* sp = S0B + (rt * 16 + fq * 4) * 72 + kcol;
                  sp[0] = (bf16_t)p0; sp[72] = (bf16_t)(p0 >> 16); sp[144] = (bf16_t)p1; sp[216] = (bf16_t)(p1 >> 16); }
                Sreg[cc] = acc; }
        }
        if (q + 1 < NQ) lora_stage();
        __syncthreads();
        if (!isctx) {
            const int j = tid >> 4, c4 = (tid & 15) * 4, t = d == 0 ? j : TB - 1 - j; const f32x4 y = *(const LAS f32x4*)(YO + j * 64 + c4);
            u32x2 w; w.x = cvt_pk_bf16(y[0], y[1]); w.y = cvt_pk_bf16(y[2], y[3]);
            bf16_t* yb_ = p.Y + ((size_t)d * nlat + grow0) * RW + h * 64;
            *(u32x2*)(yb_ + t * RW + c4) = w;
            if (tid < TB) { const int tt = d == 0 ? tid : TB - 1 - tid; float* bb_ = p.bon + ((size_t)d * nlat + grow0) * NH + h; bb_[tt * NH] = bonr[tid]; }
        }
        if (q + 1 < NQ) scale_stage(bonn);
        __syncthreads();
    }
}
template <int MODE = 0>
__device__ __forceinline__ void rwkv_phase3(LAS unsigned char* lds, const In& in, const RwkvP p, int bid, int nblk) {
    const int nchain = 2 * p.nb * NH;
    for (int c = bid; c < nchain; c += nblk) { rwkv_chain3<MODE>(lds, in, p, c); __syncthreads(); }
}
}
}

namespace mk {
constexpr int LR_XT = 0;
constexpr int LR_XC = LR_XT + 67 * 64 * 2 + 64;
constexpr int LR_XCB = LR_XC + 64 * 64 * 4;
constexpr int LR_GWT = LR_XCB + 64 * 72 * 2;
constexpr int LR_A = LR_GWT + 2 * 64 * 72 * 2;
constexpr int LR_BX = LR_A + 64 * 64 * 4;
constexpr int LR_HO = LR_BX + 64 * 64 * 4;
constexpr int LR_CST = LR_HO + 64 * 64 * 4;
constexpr int LR_SEGP = LR_CST + 8 * 64 * 4;
constexpr int LR_SEGH = LR_SEGP + 8 * 64 * 4;
constexpr int LR_HC = LR_SEGH + 8 * 64 * 4;
constexpr int LR_END = LR_HC + 64 * 4;
static_assert(LR_END <= LDS_BYTES && (LR_XC % 16) == 0, "lru LDS");

struct LruP { const bf16_t* z1; bf16_t* Hd; int b0, nb; };

__device__ __forceinline__ void lru_item(LAS unsigned char* lds, const In& in, const LruP p, int item) {
    const int tid = threadIdx.x, lane = tid & 63, wid = tid >> 6;
    const int d = item / (p.nb * LB), bl = (item / LB) % p.nb, n = item % LB;
    const int nlat = p.nb * SEQ;
    LAS bf16_t* XT = (LAS bf16_t*)(lds + LR_XT); LAS float* XC = (LAS float*)(lds + LR_XC); LAS bf16_t* XCB = (LAS bf16_t*)(lds + LR_XCB); LAS bf16_t* GWT = (LAS bf16_t*)(lds + LR_GWT);
    LAS float *A_ = (LAS float*)(lds + LR_A), *BX = (LAS float*)(lds + LR_BX), *HO = (LAS float*)(lds + LR_HO), *CST = (LAS float*)(lds + LR_CST), *SEGP = (LAS float*)(lds + LR_SEGP), *SEGH = (LAS float*)(lds + LR_SEGH), *HC = (LAS float*)(lds + LR_HC);
    for (int i = tid; i < 2 * 64 * 64; i += NT) { const int g = i >> 12, j = (i >> 6) & 63, k = i & 63;
        GWT[(g * 64 + k) * 72 + j] = f2bf(in.lru_gate_w[((((size_t)d * 2 + g) * LB + n) * LBS + j) * LBS + k]); }
    for (int i = tid; i < 64; i += NT) { const int c = n * 64 + i;
        CST[i] = in.lru_conv_w[c]; CST[64 + i] = in.lru_conv_w[LW + c]; CST[128 + i] = in.lru_conv_w[2 * LW + c]; CST[192 + i] = in.lru_conv_w[3 * LW + c]; CST[256 + i] = in.lru_conv_b[c];
        CST[320 + i] = in.lru_gate_b[((d * 2 + 0) * LB + n) * LBS + i]; CST[384 + i] = in.lru_gate_b[((d * 2 + 1) * LB + n) * LBS + i]; CST[448 + i] = softplusf_(-in.lru_l[d * LW + c]); }
    constexpr int NSEG = CTX / 64 + GW, NSC = CTX / 64;
    u32x4 pre[2];
    auto tok_row = [&](int sidx, int rr, bool& ok) -> size_t {
        if (sidx < NSC) { const int t = sidx * 64 + rr - 2; ok = t >= 0 && t < CTX; return (size_t)nlat + (size_t)bl * CTX + t; }
        const int col = sidx - NSC, row = rr - 2; ok = row >= 0 && row < ROWS; return (size_t)bl * SEQ + (size_t)row * GW + col;
    };
    auto seg_of = [&](int q) { if (q < NSC) return d == 0 ? q : NSC - 1 - q; const int ql = q - NSC; return NSC + (d == 0 ? ql : GW - 1 - ql); };
    auto prefetch = [&](int q) { const int sidx = seg_of(q);
#pragma unroll
        for (int k = 0; k < 2; ++k) { const int i = tid + k * NT; u32x4 v = (u32x4){0u, 0u, 0u, 0u};
            if (i < 67 * 8) { const int rr = i >> 3, part = i & 7; bool ok; const size_t gr = tok_row(sidx, rr, ok); if (ok) v = *(const u32x4*)(p.z1 + gr * Z1_N + Z1_LX + n * 64 + part * 8); }
            pre[k] = v; } };
    auto commit = [&]() {
#pragma unroll
        for (int k = 0; k < 2; ++k) { const int i = tid + k * NT; if (i < 67 * 8) *(LAS u32x4*)(XT + (i >> 3) * 64 + (i & 7) * 8) = pre[k]; } };
    if (tid < 64) HC[tid] = 0.f;
    auto conv = [&]() __attribute__((always_inline)) {
        const int t = tid >> 3, c0 = (tid & 7) * 8; f32x2 s[4];
        { const f32x4 b0 = *(const LAS f32x4*)(CST + 256 + c0), b1 = *(const LAS f32x4*)(CST + 256 + c0 + 4); s[0] = b0.lo; s[1] = b0.hi; s[2] = b1.lo; s[3] = b1.hi; }
#pragma unroll
        for (int tap = 0; tap < 4; ++tap) { const u32x4 x = *(const LAS u32x4*)(XT + (t + tap) * 64 + c0);
            const f32x4 w0 = *(const LAS f32x4*)(CST + tap * 64 + c0), w1 = *(const LAS f32x4*)(CST + tap * 64 + c0 + 4);
            f32x2 v; v.x = bflo(x[0]); v.y = bfhi(x[0]); s[0] = w0.lo * v + s[0]; v.x = bflo(x[1]); v.y = bfhi(x[1]); s[1] = w0.hi * v + s[1];
            v.x = bflo(x[2]); v.y = bfhi(x[2]); s[2] = w1.lo * v + s[2]; v.x = bflo(x[3]); v.y = bfhi(x[3]); s[3] = w1.hi * v + s[3]; }
        *(LAS f32x4*)(XC + t * 64 + c0) = (f32x4){s[0].x, s[0].y, s[1].x, s[1].y}; *(LAS f32x4*)(XC + t * 64 + c0 + 4) = (f32x4){s[2].x, s[2].y, s[3].x, s[3].y};
        u32x4 w; w.x = cvt_pk_bf16(s[0].x, s[0].y); w.y = cvt_pk_bf16(s[1].x, s[1].y); w.z = cvt_pk_bf16(s[2].x, s[2].y); w.w = cvt_pk_bf16(s[3].x, s[3].y); *(LAS u32x4*)(XCB + t * 72 + c0) = w; };
    auto output = [&](int sidx) __attribute__((always_inline)) {
        if (sidx >= NSC) { const int col = sidx - NSC, t = tid >> 3, c0 = (tid & 7) * 8;
            const f32x4 x = *(const LAS f32x4*)(HO + t * 64 + c0), y = *(const LAS f32x4*)(HO + t * 64 + c0 + 4);
            *(u32x4*)(p.Hd + ((size_t)d * nlat + (size_t)bl * SEQ + (size_t)t * GW + col) * LW + n * 64 + c0) = pack8(x, y); } };
    prefetch(0);
    commit();
    __syncthreads();
    if (1 < NSEG) prefetch(1);
    conv();
    __syncthreads();
    float hlast = 0.f;
    for (int q = 0; q < NSEG; ++q) {
        { const int rt = wid >> 1, fr = lane & 15, fq = lane >> 4;
          bf16x8 a[2];
#pragma unroll
          for (int ks = 0; ks < 2; ++ks) a[ks] = *(const LAS bf16x8*)(XCB + (rt * 16 + fr) * 72 + ks * 32 + fq * 8);
#pragma unroll
          for (int cc = 0; cc < 2; ++cc) { const int ct = 2 * (wid & 1) + cc, col = ct * 16 + fr;
              f32x4 acc0 = (f32x4){0.f, 0.f, 0.f, 0.f}, acc1 = acc0;
#pragma unroll
              for (int ks = 0; ks < 2; ++ks) {
                  const bf16x8 b0 = *(const LAS bf16x8*)(GWT + (0 * 64 + col) * 72 + ks * 32 + fq * 8), b1 = *(const LAS bf16x8*)(GWT + (1 * 64 + col) * 72 + ks * 32 + fq * 8);
                  acc0 = __builtin_amdgcn_mfma_f32_16x16x32_bf16(a[ks], b0, acc0, 0, 0, 0); acc1 = __builtin_amdgcn_mfma_f32_16x16x32_bf16(a[ks], b1, acc1, 0, 0, 0); }
              constexpr float L2E = 1.4426950408889634f;
              const float g0s = -L2E * CST[320 + col], g1s = -L2E * CST[384 + col], sp8l = -8.f * L2E * CST[448 + col];
#pragma unroll
              for (int i = 0; i < 4; ++i) { const int t = rt * 16 + fq * 4 + i;
                  const float rec = fast_rcp(1.f + __builtin_amdgcn_exp2f(__builtin_fmaf(acc0[i], -L2E, g0s))), ib = 1.f + __builtin_amdgcn_exp2f(__builtin_fmaf(acc1[i], -L2E, g1s));
                  const float av = __builtin_amdgcn_exp2f(sp8l * rec), om = __builtin_fmaf(-av, av, 1.f);
                  A_[t * 64 + col] = av; BX[t * 64 + col] = om * __builtin_amdgcn_rsqf(fmaxf(om * ib * ib, 1e-30f)) * XC[t * 64 + col]; } } }
        if (q + 1 < NSEG) commit();
        if (q > 0) { output(seg_of(q - 1)); if ((tid >> 6) == 7) HC[tid & 63] = hlast; }
        __syncthreads();
        const int ch = tid & 63, pc = tid >> 6; float av[8], bv[8];
        { float P = 1.f, H = 0.f;
#pragma unroll
          for (int x = 0; x < 8; ++x) { const int st = pc * 8 + x, t = d == 0 ? st : 63 - st; av[x] = A_[t * 64 + ch]; bv[x] = BX[t * 64 + ch]; H = av[x] * H + bv[x]; P *= av[x]; }
          SEGP[pc * 64 + ch] = P; SEGH[pc * 64 + ch] = H; }
        if (q + 1 < NSEG) { if (q + 2 < NSEG) prefetch(q + 2); conv(); }
        __syncthreads();
        { float h = HC[ch];
#pragma unroll
          for (int q2 = 0; q2 < 7; ++q2) if (q2 < pc) h = SEGP[q2 * 64 + ch] * h + SEGH[q2 * 64 + ch];
#pragma unroll
          for (int x = 0; x < 8; ++x) { const int st = pc * 8 + x, t = d == 0 ? st : 63 - st; h = av[x] * h + bv[x]; HO[t * 64 + ch] = h; }
          hlast = h; }
        __syncthreads();
    }
    output(seg_of(NSEG - 1));
}
__device__ __forceinline__ void lru_phase(LAS unsigned char* lds, const In& in, const LruP p, int bid, int nblk) {
    const int nitem = 2 * p.nb * LB;
    for (int it = bid; it < nitem; it += nblk) { lru_item(lds, in, p, it); __syncthreads(); }
}
}

namespace mk {
#define MK_DPPX(x, ctrl) __int_as_float(__builtin_amdgcn_update_dpp(__float_as_int(x), __float_as_int(x), ctrl, 0xF, 0xF, false))
__device__ __forceinline__ float allreduce4(float x) { x += MK_DPPX(x, 0xB1); x += MK_DPPX(x, 0x4E); return x; }
__device__ __forceinline__ void unpack8(const u32x4 w, float (&f)[8]) {
#pragma unroll
    for (int j = 0; j < 4; ++j) { f[2 * j] = bflo(w[j]); f[2 * j + 1] = bfhi(w[j]); } }
constexpr int AG_K = 256;
struct PostP { const bf16_t* z1; bf16_t* Y; const float* bon; bf16_t* Ag; int nlat; int pad_; };
__device__ __forceinline__ void rwkv_post_rows(LAS float* cst  , const In& in, const PostP p, int row_lo, int row_hi, bool dry = false) {
    const int lane = threadIdx.x & 63, wid = threadIdx.x >> 6, c0 = lane * 16, h = lane >> 2;
    float mg0[8], mg1[8];
    for (int i = threadIdx.x; i < RW; i += NT) { cst[i] = in.shift_mu[OFF_V + i]; cst[RW + i] = in.shift_mu[RC + OFF_V + i]; cst[2 * RW + i] = in.rw_lnx[i]; cst[3 * RW + i] = in.rw_lnx[RW + i]; }
    __syncthreads();
#pragma unroll
    for (int j = 0; j < 8; ++j) { const int c = OFF_GD + (lane < GL / 8 ? lane : 0) * 8 + j; mg0[j] = in.shift_mu[c]; mg1[j] = in.shift_mu[RC + c]; }
    struct Raw { u32x4 y00, y01, y10, y11, zx[2], zp[2], zn[2]; float b0, b1; };
    const u32x4 Z4 = (u32x4){0u, 0u, 0u, 0u};
    auto load_row = [&](int r, Raw& w) __attribute__((always_inline)) {
        const int cg = r % GW; const bool hp = cg > 0, hn = cg < GW - 1;
        const bf16_t* y0p = p.Y + (size_t)r * RW + c0; const bf16_t* y1p = p.Y + ((size_t)p.nlat + r) * RW + c0;
        w.y00 = *(const u32x4*)y0p; w.y01 = *(const u32x4*)(y0p + 8); w.y10 = *(const u32x4*)y1p; w.y11 = *(const u32x4*)(y1p + 8);
        w.b0 = p.bon[(size_t)r * NH + h]; w.b1 = p.bon[((size_t)p.nlat + r) * NH + h];
        const bf16_t* zr = p.z1 + (size_t)r * Z1_N;
#pragma unroll
        for (int half = 0; half < 2; ++half) { const int c = OFF_V + c0 + half * 8;
            w.zx[half] = *(const u32x4*)(zr + c); w.zp[half] = Z4; w.zn[half] = Z4;
            if (hp) w.zp[half] = *(const u32x4*)(zr - Z1_N + c);
            if (hn) w.zn[half] = *(const u32x4*)(zr + Z1_N + c); }
    };
    auto compute_row = [&](int r, const Raw& w) __attribute__((always_inline)) {
        bf16_t* y0p = p.Y + (size_t)r * RW + c0;
        float y[16], t8[8];
        unpack8(w.y00, t8);
#pragma unroll
        for (int j = 0; j < 8; ++j) y[j] = t8[j];
        unpack8(w.y01, t8);
#pragma unroll
        for (int j = 0; j < 8; ++j) y[8 + j] = t8[j];
        unpack8(w.y10, t8);
#pragma unroll
        for (int j = 0; j < 8; ++j) y[j] += t8[j];
        unpack8(w.y11, t8);
#pragma unroll
        for (int j = 0; j < 8; ++j) y[8 + j] += t8[j];
        float s = 0.f;
#pragma unroll
        for (int j = 0; j < 16; ++j) s += y[j];
        const float mu = allreduce4(s) * (1.f / 64.f); float q = 0.f;
#pragma unroll
        for (int j = 0; j < 16; ++j) { const float dlt = y[j] - mu; q += dlt * dlt; }
        const float rs = __builtin_amdgcn_rsqf(allreduce4(q) * (1.f / 64.f) + LNX_EPS);
        const float bonus = w.b0 + w.b1;
#pragma unroll
        for (int half = 0; half < 2; ++half) {
            float xv[8], pv[8], nv[8]; unpack8(w.zx[half], xv); unpack8(w.zp[half], pv); unpack8(w.zn[half], nv);
            float m0_[8], m1_[8], g0_[8], g1_[8];
            { const LAS float* cb = cst + c0 + half * 8; const f32x4 a0 = *(const LAS f32x4*)cb, a1 = *(const LAS f32x4*)(cb + 4), b0 = *(const LAS f32x4*)(cb + RW), b1 = *(const LAS f32x4*)(cb + RW + 4),
                  e0 = *(const LAS f32x4*)(cb + 2 * RW), e1 = *(const LAS f32x4*)(cb + 2 * RW + 4), f0 = *(const LAS f32x4*)(cb + 3 * RW), f1 = *(const LAS f32x4*)(cb + 3 * RW + 4);
#pragma unroll
              for (int j = 0; j < 4; ++j) { m0_[j] = a0[j]; m0_[4 + j] = a1[j]; m1_[j] = b0[j]; m1_[4 + j] = b1[j]; g0_[j] = e0[j]; g0_[4 + j] = e1[j]; g1_[j] = f0[j]; g1_[4 + j] = f1[j]; } }
            float o[8];
#pragma unroll
            for (int j = 0; j < 8; ++j) { const int cj = half * 8 + j; const float v = xv[j] + m0_[j] * (pv[j] - xv[j]) + m1_[j] * (nv[j] - xv[j]);
                o[j] = (y[cj] - mu) * rs * g0_[j] + g1_[j] + bonus * v; }
            u32x4 wv; wv.x = cvt_pk_bf16(o[0], o[1]); wv.y = cvt_pk_bf16(o[2], o[3]); wv.z = cvt_pk_bf16(o[4], o[5]); wv.w = cvt_pk_bf16(o[6], o[7]); if (!dry) *(u32x4*)(y0p + half * 8) = wv; else if (wv.x == 0x12345678u) *(u32x4*)(y0p + half * 8) = wv;
        }
        if (lane < 32) { u32x4 wv = Z4;
            if (lane < GL / 8) { const int cg = r % GW; const bool hp = cg > 0, hn = cg < GW - 1; const bf16_t* zr = p.z1 + (size_t)r * Z1_N; const int c = OFF_GD + lane * 8;
                u32x4 gx = *(const u32x4*)(zr + c), gp = Z4, gn = Z4; if (hp) gp = *(const u32x4*)(zr - Z1_N + c); if (hn) gn = *(const u32x4*)(zr + Z1_N + c);
                float xv[8], pv[8], nv[8]; unpack8(gx, xv); unpack8(gp, pv); unpack8(gn, nv);
                float o[8];
#pragma unroll
                for (int j = 0; j < 8; ++j) o[j] = fast_sigmoid(xv[j] + mg0[j] * (pv[j] - xv[j]) + mg1[j] * (nv[j] - xv[j]));
                wv.x = cvt_pk_bf16(o[0], o[1]); wv.y = cvt_pk_bf16(o[2], o[3]); wv.z = cvt_pk_bf16(o[4], o[5]); wv.w = cvt_pk_bf16(o[6], o[7]); }
            *(u32x4*)(p.Ag + (size_t)r * AG_K + lane * 8) = wv; }
    };
    constexpr int RS_ = NT / 64;
    Raw A, B;
    int r = row_lo + wid;
    if (r < row_hi) load_row(r, A);
    for (; r < row_hi; r += 2 * RS_) {
        if (r + RS_ < row_hi) load_row(r + RS_, B);
        compute_row(r, A);
        if (r + 2 * RS_ < row_hi) load_row(r + 2 * RS_, A);
        if (r + RS_ < row_hi) compute_row(r + RS_, B);
    }
}
#define MK_FR_ROW(f) ((((f) >> 3) * HALF) + wr * 64 + ((((f) >> 1) & 3) * 16) + fr)
#define MK_FR_COL(f) ((((f) & 1) * HALF) + wc * 32 + 8 * fq)
#define MK_FR_ACC(f, n) acc[(f) >> 3][(f) & 1][((f) >> 1) & 3][n]
#define MK_FENCE asm volatile("" ::: "memory")
struct EpiYa { static constexpr int NS = 16; const bf16_t* yn; bf16_t* ya;
    __device__ __forceinline__ bool operator()(f32x4 (&acc)[2][2][4][2], const Unit& u, int wr, int wc, int fr, int fq) const {
        const size_t base = (size_t)(u.pm * BM) * RW + u.pn * BM;
        u32x4 cur = *(const u32x4*)(yn + base + (size_t)MK_FR_ROW(0) * RW + MK_FR_COL(0));
#pragma unroll
        for (int f = 0; f < 16; ++f) { u32x4 nxt = cur; if (f + 1 < 16) nxt = *(const u32x4*)(yn + base + (size_t)MK_FR_ROW(f + 1) * RW + MK_FR_COL(f + 1));
            MK_FENCE; float v[8]; unpack8(cur, v); f32x4 a = MK_FR_ACC(f, 0), b = MK_FR_ACC(f, 1);
#pragma unroll
            for (int j = 0; j < 4; ++j) { a[j] *= v[j]; b[j] *= v[4 + j]; }
            *(u32x4*)(ya + base + (size_t)MK_FR_ROW(f) * RW + MK_FR_COL(f)) = pack8(a, b); MK_FENCE; cur = nxt; }
        return false; } };
struct EpiZc { static constexpr int NS = 16; const bf16_t* Hd; bf16_t* yb; bf16_t* gates; int nlat; float sc;
    __device__ __forceinline__ bool operator()(f32x4 (&acc)[2][2][4][2], const Unit& u, int wr, int wc, int fr, int fq) const {
        if (u.pn < LW / BM) {
            MK_FRAG_LOOP(r, c) { const size_t o = (size_t)(u.pm * BM + r) * LW + u.pn * BM + c; float h0[8], h1[8]; unpack8(*(const u32x4*)(Hd + o), h0); unpack8(*(const u32x4*)(Hd + (size_t)nlat * LW + o), h1);
                f32x4 a = acc[ai][bj][m][0] * sc, b = acc[ai][bj][m][1] * sc;
#pragma unroll
                for (int j = 0; j < 4; ++j) { a[j] = fast_gelu_tanh(a[j]) * (h0[j] + h1[j]); b[j] = fast_gelu_tanh(b[j]) * (h0[4 + j] + h1[4 + j]); }
                *(u32x4*)(yb + o) = pack8(a, b); asm volatile("" ::: "memory"); }
        } else {
            MK_FRAG_LOOP(r, c) { const size_t o = (size_t)(u.pm * BM + r) * (2 * D) + (u.pn * BM - LW) + c;
                f32x4 a = acc[ai][bj][m][0] * sc, b = acc[ai][bj][m][1] * sc;
#pragma unroll
                for (int j = 0; j < 4; ++j) { a[j] = fast_sigmoid(a[j]); b[j] = fast_sigmoid(b[j]); }
                *(u32x4*)(gates + o) = pack8(a, b); }
        }
        return false; } };
struct PairOrder { StaticOrder S;
    __device__ bool next(int i, Unit& u) const { if (!S.next(i >> 1, u)) return false; u.e = i & 1; return true; } };
struct EpiBranch { const bf16_t* gates; bf16_t* mixed;
    __device__ __forceinline__ bool operator()(f32x4 (&acc)[2][2][4][2], const Unit& u, int wr, int wc, int fr, int fq) const {
        const size_t gbase = (size_t)(u.pm * BM) * (2 * D) + u.pn * BM, mbase = (size_t)(u.pm * BM) * D + u.pn * BM;
        u32x4 c1 = (u32x4){0u, 0u, 0u, 0u}, c2 = *(const u32x4*)(gates + gbase + (size_t)MK_FR_ROW(0) * (2 * D) + D + MK_FR_COL(0));
        if (u.e == 0) c1 = *(const u32x4*)(gates + gbase + (size_t)MK_FR_ROW(0) * (2 * D) + MK_FR_COL(0));
#pragma unroll
        for (int f = 0; f < 16; ++f) { u32x4 n1 = c1, n2 = c2;
            if (f + 1 < 16) { const size_t o = gbase + (size_t)MK_FR_ROW(f + 1) * (2 * D) + MK_FR_COL(f + 1); n2 = *(const u32x4*)(gates + o + D); if (u.e == 0) n1 = *(const u32x4*)(gates + o); }
            MK_FENCE; float g1[8], g2[8]; unpack8(c1, g1); unpack8(c2, g2);
            if (u.e == 0) {
#pragma unroll
                for (int j = 0; j < 4; ++j) { MK_FR_ACC(f, 0)[j] *= g1[j] / g2[j]; MK_FR_ACC(f, 1)[j] *= g1[4 + j] / g2[4 + j]; }
            } else { f32x4 a = MK_FR_ACC(f, 0), b = MK_FR_ACC(f, 1);
#pragma unroll
                for (int j = 0; j < 4; ++j) { a[j] *= g2[j]; b[j] *= g2[4 + j]; }
                *(u32x4*)(mixed + mbase + (size_t)MK_FR_ROW(f) * D + MK_FR_COL(f)) = pack8(a, b); }
            MK_FENCE; c1 = n1; c2 = n2; }
        __builtin_amdgcn_s_waitcnt(0x0F70);
        return u.e == 0; } };
struct EpiF32 { float* C; long ldc;
    __device__ __forceinline__ bool operator()(f32x4 (&acc)[2][2][4][2], const Unit& u, int wr, int wc, int fr, int fq) const {
        MK_FRAG_LOOP(r, c) { float* o = C + (size_t)(u.pm * BM + r) * ldc + u.pn * BM + c; *(f32x4*)o = acc[ai][bj][m][0]; *(f32x4*)(o + 4) = acc[ai][bj][m][1]; }
        return false; } };
}

namespace mk {
constexpr int NEX = NE + 1;
constexpr int SLOTS_PER_TOK = TOPK + 1;
constexpr int RP_MOD = 0;
constexpr int RP_UH = RP_MOD + 3 * D * 4;
constexpr int RP_UL = RP_UH + 16 * (D + 8) * 2;
constexpr int RP_PART = RP_UL + 16 * (D + 8) * 2;
constexpr int RP_LOG = RP_PART + 8 * 16 * 64 * 4;
constexpr int RP_HIST = RP_LOG + 16 * 64 * 4;
constexpr int RP_END = RP_HIST + 64 * 4;
static_assert(RP_END <= LDS_BYTES, "rowpass LDS");

constexpr float FP8_SR = 64.f;
constexpr float FP8_SA = 8.f, FP8_SWD = 256.f;
constexpr float FP8_SU = 16.f, FP8_SW = 256.f;
struct RowP { float* y2h1; bf16_t* u; unsigned char* u8; const float* modpart; const bf16_t* rwt;
              int* tope; float* gatev; int* lrank; int* blkcnt; int b0, nlat; };
__device__ __forceinline__ float wave_max(float x) { return wave_max64(x); }
__device__ __forceinline__ void row_pass(LAS unsigned char* lds, const In& in, const RowP p, int row_lo, int row_hi, bool dry = false) {
    const int tid = threadIdx.x, lane = tid & 63, wid = tid >> 6;
    LAS float* MOD = (LAS float*)(lds + RP_MOD); LAS bf16_t* UH = (LAS bf16_t*)(lds + RP_UH); LAS bf16_t* UL = (LAS bf16_t*)(lds + RP_UL);
    LAS float* PART = (LAS float*)(lds + RP_PART); LAS float* LOG = (LAS float*)(lds + RP_LOG); LAS int* HIST = (LAS int*)(lds + RP_HIST);
    const int mr = p.b0 + row_lo / SEQ;
    for (int j = tid; j < 3 * D; j += NT) MOD[j] = mod_value(in, p.modpart, mr, 2 * D + j);
    if (tid < 64) HIST[tid] = 0;
    __syncthreads();
    float gp1[16], gp2[16];
#pragma unroll
    for (int j = 0; j < 4; ++j)
#pragma unroll
        for (int q = 0; q < 4; ++q) { gp1[4 * j + q] = in.norm_g[D + j * 256 + lane * 4 + q]; gp2[4 * j + q] = in.norm_g[2 * D + j * 256 + lane * 4 + q]; }
    u32x2 py[2][4]; f32x4 px[2][4];
    auto fetch = [&](int r16) __attribute__((always_inline)) {
#pragma unroll
        for (int rr = 0; rr < 2; ++rr) { const int r = r16 + wid * 2 + rr;
#pragma unroll
            for (int j = 0; j < 4; ++j) { py[rr][j] = *(const u32x2*)(p.u + (size_t)r * D + j * 256 + lane * 4); px[rr][j] = *(const f32x4*)(in.x + ((size_t)p.b0 * SEQ + r) * D + j * 256 + lane * 4); } } };
    fetch(row_lo);
    for (int r16 = row_lo; r16 < row_hi; r16 += 16) {
#pragma unroll
        for (int rr = 0; rr < 2; ++rr) {
            const int lr = wid * 2 + rr, r = r16 + lr;
            float* yp = p.y2h1 + (size_t)r * D;
            f32x4 v[4]; float ss = 0.f;
#pragma unroll
            for (int j = 0; j < 4; ++j) { const u32x2 yw = py[rr][j];
                v[j] = (f32x4){bflo(yw.x), bfhi(yw.x), bflo(yw.y), bfhi(yw.y)}; ss += v[j][0] * v[j][0] + v[j][1] * v[j][1] + v[j][2] * v[j][2] + v[j][3] * v[j][3]; }
#pragma unroll
            for (int o_ = 0; o_ < 1; ++o_) ss = wave_sum64(ss);
            const float rinv = __builtin_amdgcn_rsqf(ss * (1.f / D) + NORM_EPS); float s2 = 0.f;
#pragma unroll
            for (int j = 0; j < 4; ++j) { const int c = j * 256 + lane * 4; const f32x4 xv = px[rr][j];
#pragma unroll
                for (int q = 0; q < 4; ++q) { const float hv = xv[q] + MOD[c + q] * (v[j][q] * rinv * gp1[4 * j + q]); v[j][q] = hv; s2 += hv * hv; }
                if (!dry) *(f32x4*)(yp + c) = v[j]; }
#pragma unroll
            for (int o_ = 0; o_ < 1; ++o_) s2 = wave_sum64(s2);
            const float r2 = __builtin_amdgcn_rsqf(s2 * (1.f / D) + NORM_EPS);
#pragma unroll
            for (int j = 0; j < 4; ++j) { const int c = j * 256 + lane * 4; float uu[4], lo[4]; unsigned hw[2];
#pragma unroll
                for (int q = 0; q < 4; ++q) uu[q] = (v[j][q] * r2 * gp2[4 * j + q]) * (1.f + MOD[2 * D + c + q]) + MOD[D + c + q];
                hw[0] = cvt_pk_bf16(uu[0], uu[1]); hw[1] = cvt_pk_bf16(uu[2], uu[3]);
                lo[0] = uu[0] - bflo(hw[0]); lo[1] = uu[1] - bfhi(hw[0]); lo[2] = uu[2] - bflo(hw[1]); lo[3] = uu[3] - bfhi(hw[1]);
                u32x2 w; w.x = hw[0]; w.y = hw[1]; *(unsigned*)(p.u8 + (size_t)r * D + c) = pack4_fp8(uu[0] * FP8_SU, uu[1] * FP8_SU, uu[2] * FP8_SU, uu[3] * FP8_SU); *(LAS u32x2*)(UH + lr * (D + 8) + c) = w;
                u32x2 wl; wl.x = cvt_pk_bf16(lo[0], lo[1]); wl.y = cvt_pk_bf16(lo[2], lo[3]); *(LAS u32x2*)(UL + lr * (D + 8) + c) = wl; }
        }
        __syncthreads();
        if (r16 + 16 < row_hi) fetch(r16 + 16);
        { const int fr = lane & 15, fq = lane >> 4;
          f32x4 acc[4];
#pragma unroll
          for (int ct = 0; ct < 4; ++ct) acc[ct] = (f32x4){0.f, 0.f, 0.f, 0.f};
#pragma unroll
          for (int ks = 0; ks < 4; ++ks) { const int k0 = wid * 128 + ks * 32 + fq * 8;
              const bf16x8 ah = *(const LAS bf16x8*)(UH + fr * (D + 8) + k0), al = *(const LAS bf16x8*)(UL + fr * (D + 8) + k0);
#pragma unroll
              for (int ct = 0; ct < 4; ++ct) { const bf16x8 bh = *(const bf16x8*)(p.rwt + (size_t)(ct * 16 + fr) * D + k0), bl = *(const bf16x8*)(p.rwt + (size_t)(NE + ct * 16 + fr) * D + k0);
                  acc[ct] = __builtin_amdgcn_mfma_f32_16x16x32_bf16(ah, bh, acc[ct], 0, 0, 0); acc[ct] = __builtin_amdgcn_mfma_f32_16x16x32_bf16(ah, bl, acc[ct], 0, 0, 0); acc[ct] = __builtin_amdgcn_mfma_f32_16x16x32_bf16(al, bh, acc[ct], 0, 0, 0); } }
#pragma unroll
          for (int ct = 0; ct < 4; ++ct)
#pragma unroll
              for (int i = 0; i < 4; ++i) PART[(wid * 16 + fq * 4 + i) * 64 + ct * 16 + fr] = acc[ct][i]; }
        __syncthreads();
        for (int i = tid; i < 16 * 64; i += NT) { float s = 0.f;
#pragma unroll
            for (int w = 0; w < 8; ++w) s += PART[w * 1024 + i];
            LOG[i] = s; }
        __syncthreads();
#pragma unroll 1
        for (int rr = 0; rr < 2; ++rr) {
            const int lr = wid * 2 + rr, r = r16 + lr;
            const float sc = sigmoidf_(LOG[lr * 64 + lane]), bi = sc + in.router_b[lane];
            float m1 = bi; m1 = fmaxf(m1, MK_DPPF(m1, 0xB1)); m1 = fmaxf(m1, MK_DPPF(m1, 0x4E)); m1 = fmaxf(m1, MK_DPPF(m1, 0x141));
            const unsigned long long eq = __ballot(bi == m1); const int first = __ffsll((long long)((eq >> (lane & ~7)) & 0xffull)) - 1 + (lane & ~7);
            float m2 = (lane == first) ? -1e30f : bi; m2 = fmaxf(m2, MK_DPPF(m2, 0xB1)); m2 = fmaxf(m2, MK_DPPF(m2, 0x4E)); m2 = fmaxf(m2, MK_DPPF(m2, 0x141));
            const float gs = m1 + m2; const int myg = lane >> 3; int rank = 0;
#pragma unroll
            for (int g = 0; g < NG; ++g) { const float og = __int_as_float(__builtin_amdgcn_readlane(__float_as_int(gs), g * 8)); rank += (og > gs || (og == gs && g < myg)) ? 1 : 0; }
            float cand = rank < TG ? bi : -1e30f; float tsum = 0.f; int myidx = 0; float mysc = 0.f;
#pragma unroll
            for (int it = 0; it < TOPK; ++it) { const float m = wave_max(cand); const unsigned long long bm = __ballot(cand == m); const int win = __builtin_amdgcn_readfirstlane(__ffsll((long long)bm) - 1);
                const float ws = __int_as_float(__builtin_amdgcn_readlane(__float_as_int(sc), win)); tsum += ws; if (lane == it) { myidx = win; mysc = ws; } if (lane == win) cand = -1e30f; }
            if (lane < TOPK) { const int rk = atomicAdd((int*)&HIST[myidx], 1);
                p.tope[(size_t)r * TOPK + lane] = myidx; p.gatev[(size_t)r * TOPK + lane] = mysc / tsum * 2.5f; p.lrank[(size_t)r * TOPK + lane] = rk; }
        }
        __syncthreads();
    }
    if (tid < 64) p.blkcnt[blockIdx.x * 64 + tid] = HIST[tid];
}

struct MoeP { const int* tope; const float* gatev; const int* lrank; const int* blkcnt;
              int* tilepre;
              int* list;
              int* sdst;
              float* sgate;
              int r0, nr, blk0, nbh, rpb, pad_; };
__device__ __forceinline__ void moe_assign(LAS unsigned char* lds, const MoeP p, int bid, int nblk) {
    LAS int* BASE = (LAS int*)lds; LAS int* CNT = BASE + 80; LAS int* BOFF = CNT + 80;
    const int tid = threadIdx.x;
    { LAS int* PC = BOFF + 80; const int e = tid & 63, part = tid >> 6, per = (p.nbh + 7) / 8; int c = 0, bo = 0;
#pragma unroll 4
      for (int b = part * per; b < (part + 1) * per && b < p.nbh; ++b) { const int v = p.blkcnt[(p.blk0 + b) * 64 + e]; if (p.blk0 + b < bid) bo += v; c += v; }
      PC[part * 64 + e] = c; PC[512 + part * 64 + e] = bo; }
    __syncthreads();
    if (tid < NE) { LAS int* PC = BOFF + 80; int c = 0, bo = 0;
#pragma unroll
        for (int q = 0; q < 8; ++q) { c += PC[q * 64 + tid]; bo += PC[512 + q * 64 + tid]; }
        CNT[tid] = c; BOFF[tid] = bo; }
    __syncthreads();
    if (tid == 0) { int s = 0; for (int e = 0; e < NE; ++e) { BASE[e] = s; s += (CNT[e] + BM - 1) / BM * BM; } BASE[NE] = s; CNT[NE] = p.nr; BASE[NE + 1] = s + p.nr;
        if (bid == 0) { for (int e = 0; e <= NEX; ++e) p.tilepre[e] = BASE[e] / BM; } }
    __syncthreads();
    if (bid >= p.blk0 && bid < p.blk0 + p.nbh) {
        const int rlo = p.r0 + (bid - p.blk0) * p.rpb;
        for (int i = tid; i < p.rpb * TOPK; i += NT) { const int r = rlo + i / TOPK, a = r * TOPK + i % TOPK, e = p.tope[a]; const int slot = BASE[e] + BOFF[e] + p.lrank[a];
            p.list[slot] = r; p.sdst[slot] = (r - p.r0) * SLOTS_PER_TOK + i % TOPK; p.sgate[slot] = p.gatev[a]; }
        for (int i = tid; i < p.rpb; i += NT) { const int r = rlo + i, slot = BASE[NE] + (r - p.r0); p.list[slot] = r; p.sdst[slot] = (r - p.r0) * SLOTS_PER_TOK + TOPK; p.sgate[slot] = 1.f; }
    }
    for (int e = bid; e < NE; e += nblk) { const int lo = BASE[e] + CNT[e], hi = BASE[e + 1]; for (int s = lo + tid; s < hi; s += NT) { p.list[s] = p.r0; p.sdst[s] = -1; p.sgate[s] = 0.f; } }
}
struct GroupOrder { int tpn, total, nN, G, c;
    __device__ void init(const int* tilepre, int nN_, int G_, int c_) { const int lane = threadIdx.x & 63;
        tpn = (int)__hip_atomic_load((const unsigned*)tilepre + lane + 1, __ATOMIC_RELAXED, __HIP_MEMORY_SCOPE_AGENT);
        total = (int)__hip_atomic_load((const unsigned*)tilepre + NEX, __ATOMIC_RELAXED, __HIP_MEMORY_SCOPE_AGENT); nN = nN_; G = G_; c = c_; }
    __device__ bool next(int i, Unit& u) const { const long L = (long)i * G + c; if (L >= (long)total * nN) return false;
        const int T = (int)(L / nN); const int e = __popcll(__ballot(tpn <= T));
        u.pm = T; u.pn = (int)(L % nN); u.e = __builtin_amdgcn_readfirstlane(e); return true; } };
struct EpiGU { static constexpr int NS = 16; bf16_t* act;
    __device__ __forceinline__ bool operator()(f32x4 (&acc)[2][2][4][2], const Unit& u, int wr, int wc, int fr, int fq) const {
        MK_FRAG_LOOP(r, c) { const f32x4 a = acc[ai][bj][m][0] * (1.f / (FP8_SU * FP8_SW)), b = acc[ai][bj][m][1] * (1.f / (FP8_SU * FP8_SW));
            *(unsigned*)((unsigned char*)act + (size_t)(u.pm * BM + r) * EF + ((u.pn * BM + c) >> 1)) =
                pack4_fp8(fast_silu(a[0]) * a[1] * FP8_SA, fast_silu(a[2]) * a[3] * FP8_SA, fast_silu(b[0]) * b[1] * FP8_SA, fast_silu(b[2]) * b[3] * FP8_SA); }
        return false; } };
struct EpiDown { const int* sdst; const float* sgate; bf16_t* rowsb; LAS unsigned char* lds;
    __device__ __forceinline__ void unit_begin(const Unit& u, LAS unsigned char* l) const {
        const int wid = __builtin_amdgcn_readfirstlane(threadIdx.x >> 6), lane = threadIdx.x & 63, w4 = wid & 3;
        const unsigned* src = (wid < 4 ? (const unsigned*)sdst : (const unsigned*)sgate) + (size_t)u.pm * BM + w4 * 64 + lane;
        __builtin_amdgcn_global_load_lds(src, (LAS unsigned*)(l + STAGE_BYTES + (wid < 4 ? 0 : 1024) + w4 * 256), 4, 0, 0); }
    __device__ __forceinline__ bool operator()(f32x4 (&acc)[2][2][4][2], const Unit& u, int wr, int wc, int fr, int fq) const {
        int dst[8]; float gt[8];
        const LAS int* LD = (const LAS int*)(lds + STAGE_BYTES); const LAS float* LG = (const LAS float*)(lds + STAGE_BYTES + 1024);
#pragma unroll
        for (int q = 0; q < 8; ++q) { const int sl = (q >> 2) * HALF + wr * 64 + (q & 3) * 16 + fr; dst[q] = LD[sl]; gt[q] = LG[sl]; }
#pragma unroll
        for (int ai = 0; ai < 2; ++ai)
#pragma unroll
            for (int m = 0; m < 4; ++m) { const int q = ai * 4 + m; const int dq = dst[q]; if (dq >= 0) {
#pragma unroll
                for (int bj = 0; bj < 2; ++bj) { f32x4 a = acc[ai][bj][m][0], b = acc[ai][bj][m][1];
#pragma unroll
                    for (int j = 0; j < 4; ++j) { a[j] *= gt[q] * (FP8_SR / (FP8_SA * FP8_SWD)); b[j] *= gt[q] * (FP8_SR / (FP8_SA * FP8_SWD)); }
                    u32x2 w8; w8.x = pack4_fp8(a[0], a[1], a[2], a[3]); w8.y = pack4_fp8(b[0], b[1], b[2], b[3]);
                    *(u32x2*)((unsigned char*)rowsb + (size_t)dq * D + u.pn * BM + bj * HALF + wc * 32 + 8 * fq) = w8; } } }
        return false; } };
__device__ __forceinline__ void final_rows(LAS float* sm  , const In& in, const float* modpart, const bf16_t* rowsb, float* h1out, int b0, int r0, int row_lo, int row_hi, bool dry = false) {
    const int tid = threadIdx.x, lane = tid & 63, wid = tid >> 6;
    const int mr = b0 + row_lo / SEQ;
    __syncthreads();
    for (int j = tid; j < D; j += NT) sm[j] = mod_value(in, modpart, mr, 5 * D + j);
    __syncthreads();
    float gq[16];
#pragma unroll
    for (int j = 0; j < 4; ++j)
#pragma unroll
        for (int q = 0; q < 4; ++q) gq[4 * j + q] = sm[j * 256 + lane * 4 + q] * in.norm_g[3 * D + j * 256 + lane * 4 + q];
    unsigned raw[SLOTS_PER_TOK][4]; f32x4 hraw[4];
    auto fetch = [&](int r) __attribute__((always_inline)) {
        const unsigned char* rb = (const unsigned char*)rowsb + (size_t)(r - r0) * SLOTS_PER_TOK * D; const float* hp = h1out + (size_t)r * D;
#pragma unroll
        for (int s = 0; s < SLOTS_PER_TOK; ++s)
#pragma unroll
            for (int j = 0; j < 4; ++j) raw[s][j] = *(const unsigned*)(rb + (size_t)s * D + j * 256 + lane * 4);
#pragma unroll
        for (int j = 0; j < 4; ++j) hraw[j] = *(const f32x4*)(hp + j * 256 + lane * 4); };
    if (row_lo + wid < row_hi) fetch(row_lo + wid);
    for (int r = row_lo + wid; r < row_hi; r += NT / 64) {
        float v[16];
#pragma unroll
        for (int j = 0; j < 16; ++j) v[j] = 0.f;
#pragma unroll
        for (int s = 0; s < SLOTS_PER_TOK; ++s)
#pragma unroll
            for (int j = 0; j < 4; ++j) { const int w = (int)raw[s][j]; const f32x2 lo = __builtin_amdgcn_cvt_pk_f32_fp8(w, false), hi = __builtin_amdgcn_cvt_pk_f32_fp8(w, true); v[4 * j] += lo.x; v[4 * j + 1] += lo.y; v[4 * j + 2] += hi.x; v[4 * j + 3] += hi.y; }
#pragma unroll
        for (int j = 0; j < 16; ++j) v[j] *= (1.f / FP8_SR);
        f32x4 hcur[4];
#pragma unroll
        for (int j = 0; j < 4; ++j) hcur[j] = hraw[j];
        if (r + NT / 64 < row_hi) fetch(r + NT / 64);
        float ss = 0.f;
#pragma unroll
        for (int j = 0; j < 16; ++j) ss += v[j] * v[j];
        ss = wave_sum64(ss);
        const float rinv = __builtin_amdgcn_rsqf(ss * (1.f / D) + NORM_EPS);
        float* hp = h1out + (size_t)r * D;
#pragma unroll
        for (int j = 0; j < 4; ++j) { const int c = j * 256 + lane * 4; f32x4 hv = hcur[j];
#pragma unroll
            for (int q = 0; q < 4; ++q) hv[q] += gq[4 * j + q] * (v[4 * j + q] * rinv);
            if (!dry) *(f32x4*)(hp + c) = hv; else if (hv[0] == 1.2345e30f) *(f32x4*)(hp + c) = hv; }
    }
}
__device__ __forceinline__ void rwt_prep(const In& in, bf16_t* rwt, int bid, int nblk) {
    for (int i = bid * NT + threadIdx.x; i < NE * D; i += nblk * NT) { const int e = i / D, k = i % D; const float w = in.router_w[(size_t)k * NE + e]; const bf16_t h = f2bf(w); rwt[i] = h; rwt[(size_t)NE * D + i] = f2bf(w - bf2f(h)); }
}
}

using namespace mk;
constexpr size_t MiB = (size_t)1 << 20;
constexpr int NLAT = NB * SEQ, NCTXR = NB * CTX, NALL = NLAT + NCTXR, NRH = NLAT / 2, MAXSLOTS = NRH * SLOTS_PER_TOK + NE * BM;
constexpr size_t O_W1A = 0, O_W1C = O_W1A + (size_t)Z1_N * D * 2, O_WG = O_W1C + (size_t)ZC_N * D * 2, O_WBR = O_WG + (size_t)RW * AG_K * 2, O_WOUT = O_WBR + (size_t)2 * D * RW * 2,
                 O_RWT = O_WOUT + (size_t)D * D * 2, O_MODP = O_RWT + (size_t)2 * NE * D * 2, O_S_END = O_MODP + (size_t)MOD_SL * (NB + 1) * 6 * D * 4;
static_assert(O_S_END <= 27 * MiB, "S region");
constexpr size_t O_BAR = 27 * MiB;
constexpr size_t O_Z1 = 28 * MiB, O_R2 = O_Z1 + (size_t)NALL * Z1_N * 2;
static_assert(O_R2 == 334 * MiB, "z1 size");
constexpr size_t O_HD = O_R2, O_BON = O_W1A + (size_t)Z1_N * D  , O_AG = O_HD + (size_t)2 * NLAT * LW * 2,
                 O_XNL8 = O_AG + (size_t)NLAT * AG_K * 2  , O_R2_END = O_XNL8 + (size_t)NLAT * D;
static_assert(O_BON + (size_t)2 * NLAT * NH * 4 <= O_W1C, "bon");
static_assert(O_R2_END <= 512 * MiB, "R2");
constexpr size_t O_XNL = O_Z1, O_YB = O_XNL + (size_t)NLAT * D * 2, O_GATES = O_YB + (size_t)NLAT * LW * 2, O_MIXED = O_HD;
static_assert(O_GATES + (size_t)NLAT * 2 * D * 2 <= O_R2, "late R1");
constexpr size_t O_U = O_Z1, O_WGU = O_U + (size_t)NLAT * D * 2, O_WDN = O_WGU + (size_t)NEX * 2 * EF * D * 2, O_ROUT = O_WDN + (size_t)NEX * D * EF * 2;
constexpr size_t O_TOPE = O_ROUT, O_LRANK = O_TOPE + (size_t)NLAT * TOPK * 4, O_GATEV = O_LRANK + (size_t)NLAT * TOPK * 4, O_BLKCNT = O_GATEV + (size_t)NLAT * TOPK * 4, O_TILEPRE = O_BLKCNT + 256 * 64 * 4,
                 O_LIST = O_TILEPRE + 2048, O_SDST = O_LIST + (size_t)2 * MAXSLOTS * 4, O_SGATE = O_SDST + (size_t)2 * MAXSLOTS * 4, O_ACT = ((O_SGATE + (size_t)2 * MAXSLOTS * 4 + 255) / 256) * 256,
                 O_ROWSB = ((O_ACT + (size_t)MAXSLOTS * EF * 2 + 255) / 256) * 256, O_END = O_ROWSB + ((size_t)NRH * SLOTS_PER_TOK + 1) * D * 2;
static_assert(O_END <= 512 * MiB, "workspace");
constexpr size_t O_U8 = O_WGU + (size_t)NEX * 2 * EF * D;
static_assert(O_U8 + (size_t)NLAT * D <= O_WDN, "u8");
static_assert(O_WGU >= O_YB && O_ROWSB >= O_GATES, "late layout");

struct MP { In in; float* out; unsigned char* ws; long ph_lo, ph_hi; };
constexpr int NPHASE = 16;

#if defined(__HIP_DEVICE_COMPILE__)
#define MK_KARGS auto Pq_ = Pk_; asm volatile("" : "+s"(Pq_)); const MP* Pg_ = (const MP*)Pq_; const In in = Pg_->in; unsigned char* ws = Pg_->ws; float* out_ = Pg_->out; (void)out_;
#else
#define MK_KARGS const In in = P.in; unsigned char* ws = P.ws; float* out_ = P.out; (void)out_; (void)Pk_;
#endif
#define MK_PHASE_PTRS \
    MK_KARGS \
    bf16_t *W1a = (bf16_t*)(ws + O_W1A), *W1c = (bf16_t*)(ws + O_W1C), *Wg = (bf16_t*)(ws + O_WG), *Wbr = (bf16_t*)(ws + O_WBR), *Wout = (bf16_t*)(ws + O_WOUT), *rwt = (bf16_t*)(ws + O_RWT); \
    float* modpart = (float*)(ws + O_MODP); \
    bf16_t *z1 = (bf16_t*)(ws + O_Z1), *Hd = (bf16_t*)(ws + O_HD), *Ag = (bf16_t*)(ws + O_AG); float* bon = (float*)(ws + O_BON); \
    bf16_t *xnl = (bf16_t*)(ws + O_XNL8), *yb = (bf16_t*)(ws + O_YB), *gates = (bf16_t*)(ws + O_GATES), *mixed = (bf16_t*)(ws + O_MIXED); \
    unsigned char* u8 = ws + O_U8; \
    bf16_t *u = (bf16_t*)(ws + O_U), *Wgu = (bf16_t*)(ws + O_WGU), *Wdn = (bf16_t*)(ws + O_WDN), *act = (bf16_t*)(ws + O_ACT), *rowsb = (bf16_t*)(ws + O_ROWSB); \
    int *tope = (int*)(ws + O_TOPE), *lrank = (int*)(ws + O_LRANK), *blkcnt = (int*)(ws + O_BLKCNT), *tilepre = (int*)(ws + O_TILEPRE), *list = (int*)(ws + O_LIST), *sdst = (int*)(ws + O_SDST); \
    float *gatev = (float*)(ws + O_GATEV), *sgate = (float*)(ws + O_SGATE); \
    bf16_t* xn_all = (bf16_t*)out_; \
    bf16_t* Y = (bf16_t*)out_; \
    float* y2h1 = out_;
__device__ __forceinline__ void stagger_start(int bid, int ticks  ) {
    const int grp = (bid >> 3) & 3;
    if (grp) { const unsigned long long t0 = __builtin_amdgcn_s_memrealtime(); while (__builtin_amdgcn_s_memrealtime() - t0 < (unsigned long long)(grp * ticks)) __builtin_amdgcn_s_sleep(8); }
    __builtin_amdgcn_s_waitcnt(0xC07F);
}

__global__ void __launch_bounds__(512, 2) mega(MP P) {
    extern __shared__ __attribute__((aligned(16))) unsigned char shm[];
    LAS unsigned char* lds = (LAS unsigned char*)shm;
    typedef const __attribute__((address_space(4))) MP* KargP;
    const KargP Pk_ = (KargP)__builtin_amdgcn_kernarg_segment_ptr();
    const int bid = blockIdx.x, nblk = gridDim.x;
    const int gbid = (nblk & 7) ? bid : (bid & 7) * (nblk >> 3) + (bid >> 3);
    const int ph_lo = (int)P.ph_lo, ph_hi = (int)P.ph_hi;
    volatile LAS unsigned* xst = (volatile LAS unsigned*)(lds + LDS_BYTES - 16);
    if (threadIdx.x == 0) { xst[0] = 0u; xst[1] = 0u; }
    __syncthreads();
    const XcdBarrier xb = xcd_barrier_post((unsigned*)(P.ws + O_BAR), xst);
    if (0 >= ph_lo && 0 < ph_hi) { if (0 > ph_lo) xcd_barrier(xb); const int ph = 0; (void)ph; MK_PHASE_PTRS
        { LAS float* tile = (LAS float*)lds; int base = 0;
            convT_job<true>(tile, in.w_in, INC, D, W1a, D, Z1_N, CMapZ1{}, bid, nblk, base, 256.f);
            convT_job<true>(tile, in.w_in, INC, D, W1c, D, ZC_N, CMapZC{}, bid, nblk, base, 256.f);
            convT_job(tile, in.rw_g_up, RW, GL, Wg, AG_K, RW, CMapId{}, bid, nblk, base);
            convT_job(tile, in.w_branch_a, D, RW, Wbr, RW, D, CMapId{}, bid, nblk, base);
            convT_job(tile, in.w_branch_b, D, LW, Wbr + (size_t)D * RW, LW, D, CMapId{}, bid, nblk, base);
            convT_job(tile, in.w_out, D, D, Wout, D, D, CMapId{}, bid, nblk, base);
            rwt_prep(in, rwt, bid, nblk);
            mod_partials((LAS float*)lds, in, modpart, bid, nblk); }
    }
    if (1 >= ph_lo && 1 < ph_hi) { if (1 > ph_lo) xcd_barrier(xb); const int ph = 1; (void)ph; MK_PHASE_PTRS
        { const int L = NLAT / nblk, Lc = NCTXR / nblk;
            xn_rows<true>((LAS float*)lds, in, modpart, xn_all, 0, NB, bid * L, (bid + 1) * L, (unsigned char*)xnl);
            xn_rows<true>((LAS float*)lds, in, modpart, xn_all, 0, NB, NLAT + bid * Lc, NLAT + (bid + 1) * Lc); }
    }
    if (2 >= ph_lo && 2 < ph_hi) { if (2 > ph_lo) xcd_barrier(xb); const int ph = 2; (void)ph; MK_PHASE_PTRS
        { GemmP g{xn_all, xn_all, W1a, 0, nullptr, D / 2, 0}; StaticOrder S; S.init(NALL, Z1_N, nblk, bid); gemm_phase<false, true>(lds, g, S, EpiStoreBf16S{z1, Z1_N, 1.f / 4096.f, 0}); }
    }
    if (3 >= ph_lo && 3 < ph_hi) { if (3 > ph_lo) xcd_barrier(xb); const int ph = 3; (void)ph; MK_PHASE_PTRS
        { LruP lp{z1, Hd, 0, NB}; lru_phase(lds, in, lp, bid, nblk); __syncthreads();
                  RwkvP rp{z1, Y, bon, 0, NB}; r3::rwkv_phase3(lds, in, rp, bid, nblk); }
    }
    if (4 >= ph_lo && 4 < ph_hi) { if (4 > ph_lo) xcd_barrier(xb); const int ph = 4; (void)ph; MK_PHASE_PTRS
        { const int L = NLAT / nblk; PostP pp{z1, Y, bon, Ag, NLAT, 0}; rwkv_post_rows((LAS float*)lds, in, pp, bid * L, (bid + 1) * L); }
    }
    if (6 >= ph_lo && 6 < ph_hi) { if (6 > ph_lo) xcd_barrier(xb); const int ph = 6; (void)ph; MK_PHASE_PTRS
        { { GemmP g{Ag, Ag, Wg, 0, nullptr, AG_K, 0}; StaticOrder S; S.init(NLAT, RW, nblk, bid); gemm_phase(lds, g, S, EpiYa{Y, Y + (size_t)NLAT * RW}); } __syncthreads(); }
        { GemmP g{xnl, xnl, W1c, 0, nullptr, D / 2, 0}; StaticOrder S; S.init(NLAT, ZC_N, nblk, bid); gemm_phase<false, true>(lds, g, S, EpiZc{Hd, yb, gates, NLAT, 1.f / 4096.f}); }
    }
    if (7 >= ph_lo && 7 < ph_hi) { if (7 > ph_lo) xcd_barrier(xb); const int ph = 7; (void)ph; MK_PHASE_PTRS
        { GemmP g{Y + (size_t)NLAT * RW, yb, Wbr, (long)D * RW, nullptr, D, 0}; PairOrder S; S.S.init(NLAT, D, nblk, bid); gemm_phase(lds, g, S, EpiBranch{gates, mixed}); }
    }
    if (8 >= ph_lo && 8 < ph_hi) { if (8 > ph_lo) xcd_barrier(xb); const int ph = 8; (void)ph; MK_PHASE_PTRS
        { LAS float* tile = (LAS float*)lds;
            struct MGU { const float* ex; const float* sh; unsigned char* d; __device__ const float* src(int m) const { return m < NE ? ex + (size_t)m * D * 2 * EF : sh; } __device__ unsigned char* dst(int m) const { return d + (size_t)m * 2 * EF * D; } };
            struct MDN { const float* ex; const float* sh; unsigned char* d; __device__ const float* src(int m) const { return m < NE ? ex + (size_t)m * EF * D : sh; } __device__ unsigned char* dst(int m) const { return d + (size_t)m * D * EF; } };
            auto conv = [&]() __attribute__((always_inline)) {
                convT_multi<true>(tile, MGU{in.ex_w_gu, in.sh_w_gu, (unsigned char*)Wgu}, NEX, 2 * EF, D, D, 2 * EF, CMapGU{EF}, bid, nblk, FP8_SW);
                convT_multi<true>(tile, MDN{in.ex_w_down, in.sh_w_down, (unsigned char*)Wdn}, NEX, D, EF, EF, D, CMapId{}, bid, nblk, FP8_SWD); };
            if (bid & 1) { conv(); __syncthreads(); }
            { GemmP g{mixed, mixed, Wout, 0, nullptr, D, 0}; StaticOrder S; S.init(NLAT, D, nblk, bid); gemm_phase(lds, g, S, EpiStoreBf16{u, D}); }
            if (!(bid & 1)) { __syncthreads(); conv(); } }
    }
    if (9 >= ph_lo && 9 < ph_hi) { if (9 > ph_lo) xcd_barrier(xb); const int ph = 9; (void)ph; MK_PHASE_PTRS
        { const int L = NLAT / nblk; RowP rp{y2h1, u, u8, modpart, rwt, tope, gatev, lrank, blkcnt, 0, NLAT}; row_pass(lds, in, rp, bid * L, (bid + 1) * L); }
    }
    if (10 >= ph_lo && 10 < ph_hi) { if (10 > ph_lo) xcd_barrier(xb); const int ph = 10; (void)ph; MK_PHASE_PTRS
        { const int q = ph - 10, half = q >= 4 ? 1 : 0, st = q - 4 * half;
            const int rpb = NLAT / nblk;
            auto assign = [&](int hf) { MoeP mp{tope, gatev, lrank, blkcnt, tilepre + hf * 256, list + (size_t)hf * MAXSLOTS, sdst + (size_t)hf * MAXSLOTS, sgate + (size_t)hf * MAXSLOTS, hf * NRH, NRH, hf * (nblk / 2), nblk / 2, rpb, 0}; moe_assign(lds, mp, bid, nblk); };
            auto fin = [&](int hf) { const int L = NRH / nblk, r0 = hf * NRH; final_rows((LAS float*)lds, in, modpart, rowsb, y2h1, 0, r0, r0 + bid * L, r0 + (bid + 1) * L); };
            if (ph == 10) { assign(0); __syncthreads(); assign(1); }
            else if (ph == 11 || ph == 13) { const int hf = ph == 13 ? 1 : 0;
                if (ph == 13 && (bid & 1)) { fin(0); __syncthreads(); }
                { GemmP g{(const bf16_t*)u8, (const bf16_t*)u8, Wgu, (long)EF * D, list + (size_t)hf * MAXSLOTS, D / 2, 0}; GroupOrder S; S.init(tilepre + hf * 256, 2 * EF / BM, nblk, gbid); gemm_phase<true, true>(lds, g, S, EpiGU{act}); }
                if (ph == 13 && !(bid & 1)) { __syncthreads(); fin(0); } }
            else if (ph == 12 || ph == 14) { const int hf = ph == 14 ? 1 : 0;
                GemmP g{act, act, Wdn, (long)D * EF / 2, nullptr, EF / 2, 0}; GroupOrder S; S.init(tilepre + hf * 256, D / BM, nblk, gbid); gemm_phase<false, true>(lds, g, S, EpiDown{sdst + (size_t)hf * MAXSLOTS, sgate + (size_t)hf * MAXSLOTS, rowsb, lds}); }
            else if (ph == 15) fin(1);
            (void)half; (void)st; }
    }
    if (11 >= ph_lo && 11 < ph_hi) { if (11 > ph_lo) xcd_barrier(xb); const int ph = 11; (void)ph; MK_PHASE_PTRS
        { const int q = ph - 10, half = q >= 4 ? 1 : 0, st = q - 4 * half;
            const int rpb = NLAT / nblk;
            auto assign = [&](int hf) { MoeP mp{tope, gatev, lrank, blkcnt, tilepre + hf * 256, list + (size_t)hf * MAXSLOTS, sdst + (size_t)hf * MAXSLOTS, sgate + (size_t)hf * MAXSLOTS, hf * NRH, NRH, hf * (nblk / 2), nblk / 2, rpb, 0}; moe_assign(lds, mp, bid, nblk); };
            auto fin = [&](int hf) { const int L = NRH / nblk, r0 = hf * NRH; final_rows((LAS float*)lds, in, modpart, rowsb, y2h1, 0, r0, r0 + bid * L, r0 + (bid + 1) * L); };
            if (ph == 10) { assign(0); __syncthreads(); assign(1); }
            else if (ph == 11 || ph == 13) { const int hf = ph == 13 ? 1 : 0;
                if (ph == 13 && (bid & 1)) { fin(0); __syncthreads(); }
                { GemmP g{(const bf16_t*)u8, (const bf16_t*)u8, Wgu, (long)EF * D, list + (size_t)hf * MAXSLOTS, D / 2, 0}; GroupOrder S; S.init(tilepre + hf * 256, 2 * EF / BM, nblk, gbid); gemm_phase<true, true>(lds, g, S, EpiGU{act}); }
                if (ph == 13 && !(bid & 1)) { __syncthreads(); fin(0); } }
            else if (ph == 12 || ph == 14) { const int hf = ph == 14 ? 1 : 0;
                GemmP g{act, act, Wdn, (long)D * EF / 2, nullptr, EF / 2, 0}; GroupOrder S; S.init(tilepre + hf * 256, D / BM, nblk, gbid); gemm_phase<false, true>(lds, g, S, EpiDown{sdst + (size_t)hf * MAXSLOTS, sgate + (size_t)hf * MAXSLOTS, rowsb, lds}); }
            else if (ph == 15) fin(1);
            (void)half; (void)st; }
    }
    if (12 >= ph_lo && 12 < ph_hi) { if (12 > ph_lo) xcd_barrier(xb); const int ph = 12; (void)ph; MK_PHASE_PTRS
        { const int q = ph - 10, half = q >= 4 ? 1 : 0, st = q - 4 * half;
            const int rpb = NLAT / nblk;
            auto assign = [&](int hf) { MoeP mp{tope, gatev, lrank, blkcnt, tilepre + hf * 256, list + (size_t)hf * MAXSLOTS, sdst + (size_t)hf * MAXSLOTS, sgate + (size_t)hf * MAXSLOTS, hf * NRH, NRH, hf * (nblk / 2), nblk / 2, rpb, 0}; moe_assign(lds, mp, bid, nblk); };
            auto fin = [&](int hf) { const int L = NRH / nblk, r0 = hf * NRH; final_rows((LAS float*)lds, in, modpart, rowsb, y2h1, 0, r0, r0 + bid * L, r0 + (bid + 1) * L); };
            if (ph == 10) { assign(0); __syncthreads(); assign(1); }
            else if (ph == 11 || ph == 13) { const int hf = ph == 13 ? 1 : 0;
                if (ph == 13 && (bid & 1)) { fin(0); __syncthreads(); }
                { GemmP g{(const bf16_t*)u8, (const bf16_t*)u8, Wgu, (long)EF * D, list + (size_t)hf * MAXSLOTS, D / 2, 0}; GroupOrder S; S.init(tilepre + hf * 256, 2 * EF / BM, nblk, gbid); gemm_phase<true, true>(lds, g, S, EpiGU{act}); }
                if (ph == 13 && !(bid & 1)) { __syncthreads(); fin(0); } }
            else if (ph == 12 || ph == 14) { const int hf = ph == 14 ? 1 : 0;
                GemmP g{act, act, Wdn, (long)D * EF / 2, nullptr, EF / 2, 0}; GroupOrder S; S.init(tilepre + hf * 256, D / BM, nblk, gbid); gemm_phase<false, true>(lds, g, S, EpiDown{sdst + (size_t)hf * MAXSLOTS, sgate + (size_t)hf * MAXSLOTS, rowsb, lds}); }
            else if (ph == 15) fin(1);
            (void)half; (void)st; }
    }
    if (13 >= ph_lo && 13 < ph_hi) { if (13 > ph_lo) xcd_barrier(xb); const int ph = 13; (void)ph; MK_PHASE_PTRS
        { const int q = ph - 10, half = q >= 4 ? 1 : 0, st = q - 4 * half;
            const int rpb = NLAT / nblk;
            auto assign = [&](int hf) { MoeP mp{tope, gatev, lrank, blkcnt, tilepre + hf * 256, list + (size_t)hf * MAXSLOTS, sdst + (size_t)hf * MAXSLOTS, sgate + (size_t)hf * MAXSLOTS, hf * NRH, NRH, hf * (nblk / 2), nblk / 2, rpb, 0}; moe_assign(lds, mp, bid, nblk); };
            auto fin = [&](int hf) { const int L = NRH / nblk, r0 = hf * NRH; final_rows((LAS float*)lds, in, modpart, rowsb, y2h1, 0, r0, r0 + bid * L, r0 + (bid + 1) * L); };
            if (ph == 10) { assign(0); __syncthreads(); assign(1); }
            else if (ph == 11 || ph == 13) { const int hf = ph == 13 ? 1 : 0;
                if (ph == 13 && (bid & 1)) { fin(0); __syncthreads(); }
                { GemmP g{(const bf16_t*)u8, (const bf16_t*)u8, Wgu, (long)EF * D, list + (size_t)hf * MAXSLOTS, D / 2, 0}; GroupOrder S; S.init(tilepre + hf * 256, 2 * EF / BM, nblk, gbid); gemm_phase<true, true>(lds, g, S, EpiGU{act}); }
                if (ph == 13 && !(bid & 1)) { __syncthreads(); fin(0); } }
            else if (ph == 12 || ph == 14) { const int hf = ph == 14 ? 1 : 0;
                GemmP g{act, act, Wdn, (long)D * EF / 2, nullptr, EF / 2, 0}; GroupOrder S; S.init(tilepre + hf * 256, D / BM, nblk, gbid); gemm_phase<false, true>(lds, g, S, EpiDown{sdst + (size_t)hf * MAXSLOTS, sgate + (size_t)hf * MAXSLOTS, rowsb, lds}); }
            else if (ph == 15) fin(1);
            (void)half; (void)st; }
    }
    if (14 >= ph_lo && 14 < ph_hi) { if (14 > ph_lo) xcd_barrier(xb); const int ph = 14; (void)ph; MK_PHASE_PTRS
        { const int q = ph - 10, half = q >= 4 ? 1 : 0, st = q - 4 * half;
            const int rpb = NLAT / nblk;
            auto assign = [&](int hf) { MoeP mp{tope, gatev, lrank, blkcnt, tilepre + hf * 256, list + (size_t)hf * MAXSLOTS, sdst + (size_t)hf * MAXSLOTS, sgate + (size_t)hf * MAXSLOTS, hf * NRH, NRH, hf * (nblk / 2), nblk / 2, rpb, 0}; moe_assign(lds, mp, bid, nblk); };
            auto fin = [&](int hf) { const int L = NRH / nblk, r0 = hf * NRH; final_rows((LAS float*)lds, in, modpart, rowsb, y2h1, 0, r0, r0 + bid * L, r0 + (bid + 1) * L); };
            if (ph == 10) { assign(0); __syncthreads(); assign(1); }
            else if (ph == 11 || ph == 13) { const int hf = ph == 13 ? 1 : 0;
                if (ph == 13 && (bid & 1)) { fin(0); __syncthreads(); }
                { GemmP g{(const bf16_t*)u8, (const bf16_t*)u8, Wgu, (long)EF * D, list + (size_t)hf * MAXSLOTS, D / 2, 0}; GroupOrder S; S.init(tilepre + hf * 256, 2 * EF / BM, nblk, gbid); gemm_phase<true, true>(lds, g, S, EpiGU{act}); }
                if (ph == 13 && !(bid & 1)) { __syncthreads(); fin(0); } }
            else if (ph == 12 || ph == 14) { const int hf = ph == 14 ? 1 : 0;
                GemmP g{act, act, Wdn, (long)D * EF / 2, nullptr, EF / 2, 0}; GroupOrder S; S.init(tilepre + hf * 256, D / BM, nblk, gbid); gemm_phase<false, true>(lds, g, S, EpiDown{sdst + (size_t)hf * MAXSLOTS, sgate + (size_t)hf * MAXSLOTS, rowsb, lds}); }
            else if (ph == 15) fin(1);
            (void)half; (void)st; }
    }
    if (15 >= ph_lo && 15 < ph_hi) { if (15 > ph_lo) xcd_barrier(xb); const int ph = 15; (void)ph; MK_PHASE_PTRS
        { const int q = ph - 10, half = q >= 4 ? 1 : 0, st = q - 4 * half;
            const int rpb = NLAT / nblk;
            auto assign = [&](int hf) { MoeP mp{tope, gatev, lrank, blkcnt, tilepre + hf * 256, list + (size_t)hf * MAXSLOTS, sdst + (size_t)hf * MAXSLOTS, sgate + (size_t)hf * MAXSLOTS, hf * NRH, NRH, hf * (nblk / 2), nblk / 2, rpb, 0}; moe_assign(lds, mp, bid, nblk); };
            auto fin = [&](int hf) { const int L = NRH / nblk, r0 = hf * NRH; final_rows((LAS float*)lds, in, modpart, rowsb, y2h1, 0, r0, r0 + bid * L, r0 + (bid + 1) * L); };
            if (ph == 10) { assign(0); __syncthreads(); assign(1); }
            else if (ph == 11 || ph == 13) { const int hf = ph == 13 ? 1 : 0;
                if (ph == 13 && (bid & 1)) { fin(0); __syncthreads(); }
                { GemmP g{(const bf16_t*)u8, (const bf16_t*)u8, Wgu, (long)EF * D, list + (size_t)hf * MAXSLOTS, D / 2, 0}; GroupOrder S; S.init(tilepre + hf * 256, 2 * EF / BM, nblk, gbid); gemm_phase<true, true>(lds, g, S, EpiGU{act}); }
                if (ph == 13 && !(bid & 1)) { __syncthreads(); fin(0); } }
            else if (ph == 12 || ph == 14) { const int hf = ph == 14 ? 1 : 0;
                GemmP g{act, act, Wdn, (long)D * EF / 2, nullptr, EF / 2, 0}; GroupOrder S; S.init(tilepre + hf * 256, D / BM, nblk, gbid); gemm_phase<false, true>(lds, g, S, EpiDown{sdst + (size_t)hf * MAXSLOTS, sgate + (size_t)hf * MAXSLOTS, rowsb, lds}); }
            else if (ph == 15) fin(1);
            (void)half; (void)st; }
    }
}
extern "C" void kernel_launch(void* const* d_in, const int* in_sizes, int n_in, void* d_out, int out_size, void* d_ws, size_t ws_size, hipStream_t stream) {
    static int grid = 0;
    if (grid == 0) {
        int dev = 0, cus = 0; hipGetDevice(&dev); hipDeviceGetAttribute(&cus, hipDeviceAttributeMultiprocessorCount, dev);
        hipFuncSetAttribute((const void*)mega, hipFuncAttributeMaxDynamicSharedMemorySize, LDS_BYTES);
        grid = cus;
        if (ws_size < O_END || grid != 256) fprintf(stderr, "kernel_launch: unexpected ws_size %zu (need %zu) or CU count %d\n", ws_size, (size_t)O_END, grid);
    }
    hipMemsetAsync((char*)d_ws + O_BAR, 0, XCD_BAR_WORDS * 4, stream);
    MP P; memset(&P, 0, sizeof(P));
    const float** f = (const float**)&P.in; for (int i = 0; i < 32; ++i) f[i] = (const float*)d_in[i];
    P.out = (float*)d_out; P.ws = (unsigned char*)d_ws;
#ifdef MK_PER_PHASE
    for (int ph = 0; ph < NPHASE; ++ph) { P.ph_lo = ph; P.ph_hi = ph + 1; hipLaunchKernelGGL(mega, dim3(grid), dim3(NT), LDS_BYTES, stream, P); }
#else
    P.ph_lo = 0; P.ph_hi = NPHASE;
    void* args[] = {&P};
    hipError_t e = hipLaunchCooperativeKernel((void*)mega, dim3(grid), dim3(NT), args, LDS_BYTES, stream);
    if (e != hipSuccess) fprintf(stderr, "cooperative launch failed: %s (grid %d)\n", hipGetErrorString(e), grid);
#endif
}
```

```cpp
#include <hip/hip_runtime.h>
#include <cstdio>
#include <cstring>
#define HD __host__ __device__ __forceinline__
static hipStream_t g_stream;

#ifdef SMALL
constexpr int D = 128, NB = 2, SEQ = 64, GW = 8, CTX = 16, RW = 128, RH = 64, DL = 16, AL = 16, GL = 24, LW = 128, LB = 2, NE = 8, TOPK = 3, NG = 4, TG = 2, EF = 32, SF = 32;
#else
constexpr int D = 1024, NB = 8, SEQ = 4096, GW = 64, CTX = 256, RW = 1024, RH = 64, DL = 64, AL = 64, GL = 160, LW = 1024, LB = 16, NE = 64, TOPK = 6, NG = 8, TG = 4, EF = 256, SF = 256;
#endif
constexpr int NH = RW / RH, LBS = LW / LB, ROWS = SEQ / GW, TA = CTX + SEQ;
constexpr int OFF_R = 0, OFF_K = RW, OFF_V = 2 * RW, OFF_WD = 3 * RW, OFF_AD = OFF_WD + 2 * DL, OFF_GD = OFF_AD + 2 * AL, RC = OFF_GD + GL;
constexpr int OFF_LX = RC, OFF_LG = OFF_LX + LW, OFF_GATE = OFF_LG + LW, INC = OFF_GATE + 2 * D;
constexpr int EPG = NE / NG, NASG = SEQ * TOPK;
#define NORM_EPS 1e-6f
#define LNX_EPS 64e-5f

HD float sigmoidf_(float x) { return 1.f / (1.f + expf(-x)); }
HD float softplusf_(float x) { return x > 20.f ? x : log1pf(expf(x)); }
HD float siluf_(float x) { return x * sigmoidf_(x); }
HD float gelu_tanhf_(float x) { return 0.5f * x * (1.f + tanhf(0.7978845608028654f * (x + 0.044715f * x * x * x))); }

struct In {
    const float *x, *c, *ctx, *c_ctx, *w_mod, *b_mod, *norm_g, *w_in, *shift_mu, *rw_w0, *rw_w_up, *rw_a0, *rw_a_up, *rw_g_up, *rw_k_k, *rw_k_a, *rw_r_k, *rw_lnx,
        *lru_conv_w, *lru_conv_b, *lru_gate_w, *lru_gate_b, *lru_l, *w_branch_a, *w_branch_b, *w_out, *router_w, *router_b, *ex_w_gu, *ex_w_down, *sh_w_gu, *sh_w_down;
};


namespace mk {
#define LAS __attribute__((address_space(3)))
typedef unsigned short bf16_t;
typedef short bf16x8 __attribute__((ext_vector_type(8)));
typedef float f32x4 __attribute__((ext_vector_type(4)));
typedef float f32x2 __attribute__((ext_vector_type(2)));
typedef int i32x4 __attribute__((ext_vector_type(4)));
typedef int i32x8 __attribute__((ext_vector_type(8)));
typedef unsigned u32x4 __attribute__((ext_vector_type(4)));
typedef unsigned u32x2 __attribute__((ext_vector_type(2)));
constexpr int NT = 512;
constexpr int BM = 256, BK = 64, HALF = 128, HTB = HALF * BK * 2, STAGE_BYTES = 8 * HTB;
constexpr int LDS_BYTES = 160 * 1024 - 1024;

constexpr int Z1_LX = 3584, Z1_N = 4608;
constexpr int ZC_N = 3072;

__device__ __forceinline__ unsigned cvt_pk_bf16(float lo, float hi) { unsigned r; asm volatile("s_nop 0\n\tv_cvt_pk_bf16_f32 %0, %1, %2" : "=v"(r) : "v"(lo), "v"(hi)); return r; }
__device__ __forceinline__ bf16_t f2bf(float f) { unsigned u = __float_as_uint(f); u += 0x7FFFu + ((u >> 16) & 1u); return (bf16_t)(u >> 16); }
__device__ __forceinline__ float bf2f(bf16_t b) { return __uint_as_float(((unsigned)b) << 16); }
__device__ __forceinline__ float bflo(unsigned w) { return __uint_as_float(w << 16); }
__device__ __forceinline__ float bfhi(unsigned w) { return __uint_as_float(w & 0xffff0000u); }

#define MK_DPPF(x, ctrl) __int_as_float(__builtin_amdgcn_update_dpp(__float_as_int(x), __float_as_int(x), ctrl, 0xF, 0xF, false))
__device__ __forceinline__ float wave_sum64(float x) {
    x += MK_DPPF(x, 0xB1); x += MK_DPPF(x, 0x4E); x += MK_DPPF(x, 0x141); x += MK_DPPF(x, 0x140);
    const int xi = __float_as_int(x);
    return (__int_as_float(__builtin_amdgcn_readlane(xi, 0)) + __int_as_float(__builtin_amdgcn_readlane(xi, 16))) + (__int_as_float(__builtin_amdgcn_readlane(xi, 32)) + __int_as_float(__builtin_amdgcn_readlane(xi, 48)));
}
__device__ __forceinline__ float wave_max64(float x) {
    x = fmaxf(x, MK_DPPF(x, 0xB1)); x = fmaxf(x, MK_DPPF(x, 0x4E)); x = fmaxf(x, MK_DPPF(x, 0x141)); x = fmaxf(x, MK_DPPF(x, 0x140));
    const int xi = __float_as_int(x);
    return fmaxf(fmaxf(__int_as_float(__builtin_amdgcn_readlane(xi, 0)), __int_as_float(__builtin_amdgcn_readlane(xi, 16))), fmaxf(__int_as_float(__builtin_amdgcn_readlane(xi, 32)), __int_as_float(__builtin_amdgcn_readlane(xi, 48))));
}
__device__ __forceinline__ float fast_rcp(float x) { return __builtin_amdgcn_rcpf(x); }
__device__ __forceinline__ float fast_sigmoid(float x) { return fast_rcp(1.f + __expf(-x)); }
__device__ __forceinline__ float fast_tanh(float x) { return 1.f - 2.f * fast_rcp(1.f + __expf(2.f * x)); }
__device__ __forceinline__ float fast_softplus(float x) { return x > 15.f ? x : __logf(1.f + __expf(x)); }
__device__ __forceinline__ float fast_silu(float x) { return x * fast_sigmoid(x); }
__device__ __forceinline__ float fast_gelu_tanh(float x) { return x * fast_sigmoid(1.5957691216057308f * (x + 0.044715f * x * x * x)); }
__device__ __forceinline__ int lds_byte(int r, int c) { const int st = (r >> 4) * 2 + (c >> 5), rr = r & 15, cc = c & 31, ob = rr * 64 + cc * 2; return st * 1024 + (ob ^ (((ob >> 9) & 1) << 5)); }
__device__ __forceinline__ void stage_rc(int b, int& R, int& C) { const int st = b / 1024, sb = b % 1024, swz = sb ^ (((sb >> 9) & 1) << 5); R = (st >> 1) * 16 + swz / 64; C = (st & 1) * 32 + (swz % 64) / 2; }
__device__ __forceinline__ int perm32(int rho) { const int n = rho >> 4, i = rho & 15; return 8 * (i >> 2) + 4 * n + (i & 3); }

struct Unit { int pm, pn, e; };
struct GemmP { const bf16_t* A0; const bf16_t* A1; const bf16_t* Bt; long strideB; const int* gather; int K; int pad_; };

struct StaticOrder {
    int nM, nN, nwg, G, c;
    __device__ void init(int M, int N, int G_, int c_) { nM = M / BM; nN = N / BM; nwg = nM * nN; G = G_; c = c_; }
    __device__ bool next(int i, Unit& u) const {
        const long L = (long)i * G + c; if (L >= nwg) return false;
        int wgid = (int)L; { const int q = nwg / 8, r = nwg % 8, xcd = wgid % 8, off = wgid / 8; wgid = (xcd < r ? xcd * (q + 1) : r * (q + 1) + (xcd - r) * q) + off; }
        const int nig = 8 * nN, gid = wgid / nig, fm = gid * 8, gsz = (nM - fm) < 8 ? (nM - fm) : 8;
        u.pm = fm + ((wgid % nig) % gsz); u.pn = (wgid % nig) / gsz; u.e = 0; return true;
    }
};

#define MK_FRAG_LOOP(ROW, COL) \
    _Pragma("unroll") for (int ai = 0; ai < 2; ++ai) _Pragma("unroll") for (int m = 0; m < 4; ++m) _Pragma("unroll") for (int bj = 0; bj < 2; ++bj) \
        if (const int ROW = ai * HALF + wr * 64 + m * 16 + fr; true) if (const int COL = bj * HALF + wc * 32 + 8 * fq; true)

template <class E, class = void> struct epi_has_begin { static constexpr bool value = false; };
template <class E> struct epi_has_begin<E, decltype((void)&E::unit_begin)> { static constexpr bool value = true; };
template <bool B> struct BoolC { static constexpr bool value = B; };
template <class E, class = void> struct epi_ns { static constexpr int value = 0; };
template <class E> struct epi_ns<E, decltype((void)E::NS)> { static constexpr int value = 0 * E::NS; };
template <class E> __device__ __forceinline__ void epi_unit_begin(const E& e, const Unit& u, LAS unsigned char* lds) { if constexpr (epi_has_begin<E>::value) e.unit_begin(u, lds); }
template <bool GATHER = false, bool FP8 = false, class Epi, class Sched>
__device__ __forceinline__ void gemm_phase(LAS unsigned char* lds, const GemmP g, const Sched& S, const Epi& E) {
    const int tid = threadIdx.x, wid = __builtin_amdgcn_readfirstlane(tid >> 6), lane = tid & 63, wr = wid >> 2, wc = wid & 3, fr = lane & 15, fq = lane >> 4;
    int K = g.K; asm volatile("" : "+s"(K));
    const int nt = K / BK;
    int RA[2], CA[2]; unsigned voffB[2];
#pragma unroll
    for (int i = 0; i < 2; ++i) { int R, C; stage_rc(tid * 16 + i * 8192, R, C); RA[i] = R; CA[i] = C; const int Rb = (R & ~31) + perm32(R & 31); voffB[i] = (unsigned)(Rb * K + C) * 2u; }
    const size_t kstep = (size_t)(BK * 2), hstepB = (size_t)HALF * K * 2, tstepB = 2 * hstepB;
    const unsigned ldsw = (unsigned)wid * 1024u;
    const int aoff = lds_byte(wr * 64 + fr, fq * 8), boff = lds_byte(wc * 32 + fr, fq * 8);
#define MK_SA(b, h) (((b) * 2 + (h)) * HTB)
#define MK_SB(b, h) ((4 + (b) * 2 + (h)) * HTB)
#define MK_STAGE(bufoff, gbase, voff) do { _Pragma("unroll") for (int _i = 0; _i < 2; ++_i) \
        __builtin_amdgcn_global_load_lds((const unsigned*)((const char*)(gbase) + (voff)[_i]), (LAS unsigned*)(lds + (bufoff) + ldsw + _i * 8192), 16, 0, 0); } while (0)
#define MK_CAT8(x, y) __builtin_shufflevector(__builtin_bit_cast(i32x4, x), __builtin_bit_cast(i32x4, y), 0, 1, 2, 3, 4, 5, 6, 7)
#define MK_LDA(dst, b, h) do { _Pragma("unroll") for (int m = 0; m < 4; ++m) { if constexpr (FP8) dst##8[m] = MK_CAT8(*(const LAS bf16x8*)(lds + MK_SA(b, h) + aoff + m * 2048), *(const LAS bf16x8*)(lds + MK_SA(b, h) + aoff + m * 2048 + 1024)); \
        else { _Pragma("unroll") for (int k = 0; k < 2; ++k) dst[m][k] = *(const LAS bf16x8*)(lds + MK_SA(b, h) + aoff + m * 2048 + k * 1024); } } } while (0)
#define MK_LDB(dst, b, h) do { _Pragma("unroll") for (int n = 0; n < 2; ++n) { if constexpr (FP8) dst##8[n] = MK_CAT8(*(const LAS bf16x8*)(lds + MK_SB(b, h) + boff + n * 2048), *(const LAS bf16x8*)(lds + MK_SB(b, h) + boff + n * 2048 + 1024)); \
        else { _Pragma("unroll") for (int k = 0; k < 2; ++k) dst[n][k] = *(const LAS bf16x8*)(lds + MK_SB(b, h) + boff + n * 2048 + k * 1024); } } } while (0)
#define MK_MMA(ai, bj, At, Bt) do { __builtin_amdgcn_s_setprio(1); _Pragma("unroll") for (int m = 0; m < 4; ++m) _Pragma("unroll") for (int n = 0; n < 2; ++n) { \
        if constexpr (FP8) asm volatile("v_mfma_scale_f32_16x16x128_f8f6f4 %0, %1, %2, %0, %3, %3 op_sel_hi:[0,0,0]" : "+v"(acc[ai][bj][m][n]) : "v"(Bt##8[n]), "v"(At##8[m]), "v"(mx_one));   \
        else { _Pragma("unroll") for (int k = 0; k < 2; ++k) acc[ai][bj][m][n] = __builtin_amdgcn_mfma_f32_16x16x32_bf16(Bt[n][k], At[m][k], acc[ai][bj][m][n], 0, 0, 0); } } \
        __builtin_amdgcn_s_setprio(0); } while (0)
#define MK_WAIT_V(n) asm volatile("s_waitcnt vmcnt(" #n ")" ::: "memory")
#define MK_WAIT_L(n) asm volatile("s_waitcnt lgkmcnt(" #n ")" ::: "memory")
#define MK_BAR __builtin_amdgcn_s_barrier()
#define MK_SCHED __builtin_amdgcn_sched_barrier(0)
    Unit cur, nxt; int ui = 0;
    if (!S.next(0, cur)) return;
    f32x4 acc[2][2][4][2];
#pragma unroll
    for (int a = 0; a < 2; ++a)
#pragma unroll
        for (int b = 0; b < 2; ++b)
#pragma unroll
            for (int m = 0; m < 4; ++m)
#pragma unroll
                for (int n = 0; n < 2; ++n) acc[a][b][m][n] = (f32x4){0.f, 0.f, 0.f, 0.f};
    bf16x8 At[4][2], B0[2][2], B1[2][2];
    i32x8 At8[4], B08[2], B18[2];
    int mx_one = 0x7f7f7f7f; asm volatile("" : "+v"(mx_one));
    unsigned vA[2][2], vAn[2][2];
    const size_t hstepA = GATHER ? 0 : (size_t)HALF * K * 2, tstepA = 2 * (size_t)HALF * K * 2;
    auto a_voff = [&](const Unit& u, unsigned (&vo)[2][2]) {
#pragma unroll
        for (int h = 0; h < 2; ++h)
#pragma unroll
            for (int i = 0; i < 2; ++i) { if (GATHER) { const int row = u.pm * BM + h * HALF + RA[i]; vo[h][i] = (unsigned)((size_t)g.gather[row] * K + CA[i]) * 2u; } else vo[h][i] = (unsigned)(RA[i] * K + CA[i]) * 2u; }
    };
    a_voff(cur, vA);
    const LAS int* GLDS = (const LAS int*)(lds + STAGE_BYTES + 2048);
    auto a_voff_lds = [&](unsigned (&vo)[2][2]) {
#pragma unroll
        for (int h = 0; h < 2; ++h)
#pragma unroll
            for (int i = 0; i < 2; ++i) vo[h][i] = (unsigned)((size_t)GLDS[h * HALF + RA[i]] * K + CA[i]) * 2u;
    };
    auto a_base = [&](const Unit& u) { return (const char*)(u.e ? g.A1 : g.A0) + (GATHER ? (size_t)0 : (size_t)u.pm * tstepA); };
    const char* cA = a_base(cur);
    const char* cB = (const char*)g.Bt + ((size_t)cur.e * g.strideB) * 2 + (size_t)cur.pn * tstepB;
    MK_STAGE(MK_SB(0, 0), cB, voffB); MK_STAGE(MK_SA(0, 0), cA, vA[0]); MK_STAGE(MK_SB(0, 1), cB + hstepB, voffB); MK_STAGE(MK_SA(0, 1), cA + hstepA, vA[1]);
    if (wr == 1) MK_BAR;
    MK_WAIT_V(4); MK_BAR;
    MK_STAGE(MK_SB(1, 0), cB + kstep, voffB); MK_STAGE(MK_SA(1, 0), cA + kstep, vA[0]); MK_STAGE(MK_SB(1, 1), cB + hstepB + kstep, voffB);
    MK_WAIT_V(6); MK_BAR;
    for (;;) {
        epi_unit_begin(E, cur, lds);
        const bool has_next = S.next(ui + 1, nxt);
        if (GATHER && has_next && wid < 4) __builtin_amdgcn_global_load_lds((const unsigned*)g.gather + (size_t)nxt.pm * BM + wid * 64 + lane, (LAS unsigned*)(lds + STAGE_BYTES + 2048 + wid * 256), 4, 0, 0);
        const char* nA = has_next ? a_base(nxt) : cA;
        const char* nB = has_next ? (const char*)g.Bt + ((size_t)nxt.e * g.strideB) * 2 + (size_t)nxt.pn * tstepB : cB;
        for (int t = 0; t < nt; t += 2) {
            const bool last = (t == nt - 2);
            const int relax = (epi_ns<Epi>::value == 16 && t == 0) ? 1 : 0;
#define MK_WAIT_VR do { if constexpr (epi_ns<Epi>::value != 16) MK_WAIT_V(10); else asm volatile("v_cmp_ne_u32_e32 vcc, 0, %0\n\ts_nop 3\n\ts_cbranch_vccnz .Lwr%=\n\ts_waitcnt vmcnt(10)\n.Lwr%=:\n\ts_waitcnt vmcnt(26)" :: "v"(relax) : "vcc", "memory"); } while (0)
            if (GATHER && last) { if (has_next) a_voff_lds(vAn); else {
#pragma unroll
                for (int h = 0; h < 2; ++h)
#pragma unroll
                    for (int i = 0; i < 2; ++i) vAn[h][i] = vA[h][i]; } }
            const char* a1 = cA + (size_t)(t + 1) * kstep;
            const char* a2 = last ? nA : cA + (size_t)(t + 2) * kstep; const char* b2 = last ? nB : cB + (size_t)(t + 2) * kstep;
            const char* a3 = a2 + kstep; const char* b3 = b2 + kstep;
            unsigned v2[2][2];
#pragma unroll
            for (int h = 0; h < 2; ++h)
#pragma unroll
                for (int i = 0; i < 2; ++i) v2[h][i] = (GATHER && last) ? vAn[h][i] : vA[h][i];
            MK_LDB(B0, 0, 0); MK_SCHED; MK_LDA(At, 0, 0); MK_STAGE(MK_SA(1, 1), a1 + hstepA, vA[1]);
            MK_WAIT_VR; MK_WAIT_L(8); MK_BAR; MK_WAIT_L(0); MK_MMA(0, 0, At, B0); MK_BAR; MK_SCHED;
            MK_LDB(B1, 0, 1); MK_STAGE(MK_SB(0, 0), b2, voffB);
            MK_WAIT_VR; MK_BAR; MK_WAIT_L(0); MK_MMA(0, 1, At, B1); MK_BAR;
            MK_LDA(At, 0, 1); MK_STAGE(MK_SA(0, 0), a2, v2[0]);
            MK_BAR; MK_WAIT_L(0); MK_MMA(1, 0, At, B0); MK_BAR; MK_SCHED;
            MK_STAGE(MK_SB(0, 1), b2 + hstepB, voffB);
            MK_WAIT_VR; MK_BAR; MK_MMA(1, 1, At, B1); MK_BAR;
            MK_LDB(B0, 1, 0); MK_SCHED; MK_LDA(At, 1, 0); MK_STAGE(MK_SA(0, 1), a2 + hstepA, v2[1]);
            MK_WAIT_VR; MK_WAIT_L(8); MK_BAR; MK_WAIT_L(0); MK_MMA(0, 0, At, B0); MK_BAR; MK_SCHED;
            MK_LDB(B1, 1, 1); MK_STAGE(MK_SB(1, 0), b3, voffB);
            MK_WAIT_V(10); MK_BAR; MK_WAIT_L(0); MK_MMA(0, 1, At, B1); MK_BAR;
            MK_LDA(At, 1, 1); MK_STAGE(MK_SA(1, 0), a3, v2[0]);
            MK_BAR; MK_WAIT_L(0); MK_MMA(1, 0, At, B0); MK_BAR; MK_SCHED;
            MK_STAGE(MK_SB(1, 1), b3 + hstepB, voffB);
            MK_WAIT_V(10); MK_BAR; MK_MMA(1, 1, At, B1); MK_BAR;
        }
        if constexpr (FP8) asm volatile("s_nop 15\n\ts_nop 15" : "+v"(acc[1][1][0][0]), "+v"(acc[1][1][0][1]), "+v"(acc[1][1][1][0]), "+v"(acc[1][1][1][1]),
                                        "+v"(acc[1][1][2][0]), "+v"(acc[1][1][2][1]), "+v"(acc[1][1][3][0]), "+v"(acc[1][1][3][1]) :: "memory");
        int fr_ = fr, fq_ = fq; asm volatile("" : "+v"(fr_), "+v"(fq_));
        if (wr == 0) MK_BAR;
        const bool keep = E(acc, cur, wr, wc, fr_, fq_);
        if (wr == 1) MK_BAR;
        if (!has_next) break;
        if (!keep) {
#pragma unroll
            for (int a = 0; a < 2; ++a)
#pragma unroll
                for (int b = 0; b < 2; ++b)
#pragma unroll
                    for (int m = 0; m < 4; ++m)
#pragma unroll
                        for (int n = 0; n < 2; ++n) acc[a][b][m][n] = (f32x4){0.f, 0.f, 0.f, 0.f};
        }
        cur = nxt; cA = nA; cB = nB; ++ui;
        if (GATHER) {
#pragma unroll
            for (int h = 0; h < 2; ++h)
#pragma unroll
                for (int i = 0; i < 2; ++i) vA[h][i] = vAn[h][i]; }
    }
    MK_WAIT_V(0);
    if (wr == 0) MK_BAR;
    MK_BAR;
#undef MK_SA
#undef MK_SB
#undef MK_STAGE
#undef MK_LDA
#undef MK_LDB
#undef MK_MMA
#undef MK_CAT8
#undef MK_WAIT_V
#undef MK_WAIT_VR
#undef MK_WAIT_L
#undef MK_BAR
#undef MK_SCHED
}

__device__ __forceinline__ unsigned pack4_fp8(float a, float b, float c, float d) {
    a = fminf(fmaxf(a, -448.f), 448.f); b = fminf(fmaxf(b, -448.f), 448.f); c = fminf(fmaxf(c, -448.f), 448.f); d = fminf(fmaxf(d, -448.f), 448.f);
    int w = __builtin_amdgcn_cvt_pk_fp8_f32(a, b, 0, false); w = __builtin_amdgcn_cvt_pk_fp8_f32(c, d, w, true); return (unsigned)w; }
__device__ __forceinline__ u32x4 pack8(const f32x4 a, const f32x4 b) { u32x4 w; w.x = cvt_pk_bf16(a[0], a[1]); w.y = cvt_pk_bf16(a[2], a[3]); w.z = cvt_pk_bf16(b[0], b[1]); w.w = cvt_pk_bf16(b[2], b[3]); return w; }
struct EpiStoreBf16S {
    bf16_t* O; long ldc; float sc; int pad_;
    __device__ __forceinline__ bool operator()(const f32x4 (&acc)[2][2][4][2], const Unit& u, int wr, int wc, int fr, int fq) const {
        MK_FRAG_LOOP(r, c) { *(u32x4*)(O + (size_t)(u.pm * BM + r) * ldc + u.pn * BM + c) = pack8(acc[ai][bj][m][0] * sc, acc[ai][bj][m][1] * sc); }
        return false;
    }
};
struct EpiStoreBf16 {
    static constexpr int NS = 16;
    bf16_t* O; long ldc;
    __device__ __forceinline__ bool operator()(const f32x4 (&acc)[2][2][4][2], const Unit& u, int wr, int wc, int fr, int fq) const {
        MK_FRAG_LOOP(r, c) { *(u32x4*)(O + (size_t)(u.pm * BM + r) * ldc + u.pn * BM + c) = pack8(acc[ai][bj][m][0], acc[ai][bj][m][1]); }
        return false;
    }
};

struct EpiStorePred {
    bf16_t* O; long ldc;
    __device__ __forceinline__ bool operator()(const f32x4 (&acc)[2][2][4][2], const Unit& u, int wr, int wc, int fr, int fq) const {
        MK_FRAG_LOOP(r, c) { const u32x4 w = pack8(acc[ai][bj][m][0], acc[ai][bj][m][1]); if (w.x == 0x7fc17fc1u && w.w == 0x12345678u) *(u32x4*)(O + (size_t)(u.pm * BM + r) * ldc + u.pn * BM + c) = w; }
        return false;
    }
};
struct EpiStoreLine {
    bf16_t* O; long nunit;
    __device__ __forceinline__ bool operator()(const f32x4 (&acc)[2][2][4][2], const Unit& u, int wr, int wc, int fr, int fq) const {
        const size_t ub = (size_t)((u.pm * 18 + u.pn) % (int)nunit) * (BM * BM); const int wid = wr * 4 + wc, lane = fq * 16 + fr; int f = 0;
        MK_FRAG_LOOP(r, c) { *(u32x4*)(O + ub + ((size_t)(f * 8 + wid) * 64 + lane) * 8) = pack8(acc[ai][bj][m][0], acc[ai][bj][m][1]); ++f; }
        return false;
    }
};
struct EpiNull {
    __device__ __forceinline__ bool operator()(const f32x4 (&acc)[2][2][4][2], const Unit& u, int wr, int wc, int fr, int fq) const {
        MK_FRAG_LOOP(r, c) { asm volatile("" :: "v"(acc[ai][bj][m][0]), "v"(acc[ai][bj][m][1])); }
        return false;
    }
};

__device__ __forceinline__ void ld8_contig(const float* p, float (&o)[8]) { const f32x4 a = *(const f32x4*)p, b = *(const f32x4*)(p + 4); o[0] = a[0]; o[1] = a[1]; o[2] = a[2]; o[3] = a[3]; o[4] = b[0]; o[5] = b[1]; o[6] = b[2]; o[7] = b[3]; }
struct CMapZ1 { __device__ int operator()(int n) const { return n < RC ? n : (n < Z1_LX ? -1 : OFF_LX + (n - Z1_LX)); }
    __device__ __forceinline__ void load8(const float* rowp, int n, float (&o)[8]) const { const int sc = (*this)(n); if (sc >= 0) ld8_contig(rowp + sc, o); else {
#pragma unroll
        for (int j = 0; j < 8; ++j) o[j] = 0.f; } } };
struct CMapZC { __device__ int operator()(int n) const { return OFF_LG + n; }
    __device__ __forceinline__ void load8(const float* rowp, int n, float (&o)[8]) const { ld8_contig(rowp + OFF_LG + n, o); } };
struct CMapId { __device__ int operator()(int n) const { return n; }
    __device__ __forceinline__ void load8(const float* rowp, int n, float (&o)[8]) const { ld8_contig(rowp + n, o); } };
struct CMapGU { int F; __device__ int operator()(int n) const { return (n & 1) * F + (n >> 1); }
    __device__ __forceinline__ void load8(const float* rowp, int n, float (&o)[8]) const { const f32x4 g = *(const f32x4*)(rowp + (n >> 1)), u = *(const f32x4*)(rowp + F + (n >> 1));
        o[0] = g[0]; o[1] = u[0]; o[2] = g[1]; o[3] = u[1]; o[4] = g[2]; o[5] = u[2]; o[6] = g[3]; o[7] = u[3]; } };
constexpr int CT_B = 8;
template <bool OUT8 = false, class CM>
__device__ __forceinline__ void convT_job(LAS float* tile  , const float* src, int lds_, int Ks, bf16_t* dst, int Kd, int N, const CM& cm, int bid, int nblk, int& base, float oscale = 1.f) {
    const int tk = Kd / 64, nt = (N / 64) * tk, tid = threadIdx.x;
    const int first = (bid - base % nblk + nblk) % nblk;
    const int kk = tid >> 3, nn8 = (tid & 7) * 8, nn = tid >> 3, kk8 = (tid & 7) * 8;
    for (int t0 = first; t0 < nt; t0 += CT_B * nblk) {
        float v[CT_B][8];
#pragma unroll
        for (int b = 0; b < CT_B; ++b) { const int t = t0 + b * nblk; const int n0 = (t / tk) * 64, k0 = (t % tk) * 64, k = k0 + kk;
            if (t < nt && k < Ks) cm.load8(src + (size_t)k * lds_, n0 + nn8, v[b]); else {
#pragma unroll
                for (int j = 0; j < 8; ++j) v[b][j] = 0.f; } }
#pragma unroll
        for (int b = 0; b < CT_B; ++b)
#pragma unroll
            for (int j = 0; j < 8; ++j) tile[b * 64 * 65 + kk * 65 + nn8 + j] = v[b][j];
        __syncthreads();
#pragma unroll
        for (int b = 0; b < CT_B; ++b) { const int t = t0 + b * nblk; if (t < nt) { const int n0 = (t / tk) * 64, k0 = (t % tk) * 64; f32x4 a, c;
#pragma unroll
            for (int j = 0; j < 4; ++j) { a[j] = tile[b * 64 * 65 + (kk8 + j) * 65 + nn]; c[j] = tile[b * 64 * 65 + (kk8 + 4 + j) * 65 + nn]; }
            if constexpr (OUT8) { u32x2 w8; w8.x = pack4_fp8(a[0] * oscale, a[1] * oscale, a[2] * oscale, a[3] * oscale); w8.y = pack4_fp8(c[0] * oscale, c[1] * oscale, c[2] * oscale, c[3] * oscale);
                *(u32x2*)((unsigned char*)dst + (size_t)(n0 + nn) * Kd + k0 + kk8) = w8; }
            else *(u32x4*)(dst + (size_t)(n0 + nn) * Kd + k0 + kk8) = pack8(a, c); } }
        __syncthreads();
    }
    base += nt;
}

template <bool OUT8 = false, class CM, class MS>
__device__ __forceinline__ void convT_multi(LAS float* tile, const MS& ms, int nmat, int lds_, int Ks, int Kd, int N, const CM& cm, int bid, int nblk, float oscale = 1.f) {
    const int tk = Kd / 64, tpm = (N / 64) * tk, nt = nmat * tpm, tid = threadIdx.x;
    const int kk = tid >> 3, nn8 = (tid & 7) * 8, nn = tid >> 3, kk8 = (tid & 7) * 8;
    for (int t0 = bid; t0 < nt; t0 += CT_B * nblk) {
        float v[CT_B][8];
#pragma unroll
        for (int b = 0; b < CT_B; ++b) { const int T = t0 + b * nblk, m = T / tpm, t = T % tpm; const int n0 = (t / tk) * 64, k0 = (t % tk) * 64, k = k0 + kk;
            if (T < nt && k < Ks) cm.load8(ms.src(m) + (size_t)k * lds_, n0 + nn8, v[b]); else {
#pragma unroll
                for (int j = 0; j < 8; ++j) v[b][j] = 0.f; } }
#pragma unroll
        for (int b = 0; b < CT_B; ++b)
#pragma unroll
            for (int j = 0; j < 8; ++j) tile[b * 64 * 65 + kk * 65 + nn8 + j] = v[b][j];
        __syncthreads();
#pragma unroll
        for (int b = 0; b < CT_B; ++b) { const int T = t0 + b * nblk; if (T < nt) { const int m = T / tpm, t = T % tpm, n0 = (t / tk) * 64, k0 = (t % tk) * 64; f32x4 a, c;
#pragma unroll
            for (int j = 0; j < 4; ++j) { a[j] = tile[b * 64 * 65 + (kk8 + j) * 65 + nn]; c[j] = tile[b * 64 * 65 + (kk8 + 4 + j) * 65 + nn]; }
            if constexpr (OUT8) { u32x2 w8; w8.x = pack4_fp8(a[0] * oscale, a[1] * oscale, a[2] * oscale, a[3] * oscale); w8.y = pack4_fp8(c[0] * oscale, c[1] * oscale, c[2] * oscale, c[3] * oscale);
                *(u32x2*)((unsigned char*)ms.dst(m) + (size_t)(n0 + nn) * Kd + k0 + kk8) = w8; }
            else *(u32x4*)(ms.dst(m) + (size_t)(n0 + nn) * Kd + k0 + kk8) = pack8(a, c); } }
        __syncthreads();
    }
}

constexpr int MOD_SL = 16, MOD_KS = D / MOD_SL;
__device__ __forceinline__ void mod_partials(LAS float* sl  , const In& in, float* part  , int bid, int nblk) {
    const int ncc = 6 * D / NT, nitem = MOD_SL * ncc;
    for (int it = bid; it < nitem; it += nblk) {
        const int s = it / ncc, j = (it % ncc) * NT + threadIdx.x;
        for (int i = threadIdx.x; i < (NB + 1) * MOD_KS; i += NT) { const int r = i / MOD_KS, k = s * MOD_KS + i % MOD_KS; const float cv = r < NB ? in.c[r * D + k] : in.c_ctx[k]; sl[i] = siluf_(cv); }
        __syncthreads();
        float acc[NB + 1];
#pragma unroll
        for (int r = 0; r <= NB; ++r) acc[r] = 0.f;
        for (int k = 0; k < MOD_KS; ++k) { const float w = in.w_mod[(size_t)(s * MOD_KS + k) * 6 * D + j];
#pragma unroll
            for (int r = 0; r <= NB; ++r) acc[r] += sl[r * MOD_KS + k] * w; }
#pragma unroll
        for (int r = 0; r <= NB; ++r) part[((size_t)s * (NB + 1) + r) * 6 * D + j] = acc[r];
        __syncthreads();
    }
}
__device__ __forceinline__ float mod_value(const In& in, const float* part, int r, int j) {
    float s = in.b_mod[j];
#pragma unroll
    for (int q = 0; q < MOD_SL; ++q) s += part[((size_t)q * (NB + 1) + r) * 6 * D + j];
    return s;
}

template <bool OUT8 = false>
__device__ __forceinline__ void xn_rows(LAS float* sm  , const In& in, const float* part, bf16_t* xn, int b0, int nb, int row_lo, int row_hi, unsigned char* xn2 = nullptr  ) {
    const int nlat = nb * SEQ, wid = threadIdx.x >> 6, lane = threadIdx.x & 63;
    int cur_mr = -1;
    float gp[16];
#pragma unroll
    for (int j = 0; j < 4; ++j)
#pragma unroll
        for (int q = 0; q < 4; ++q) gp[4 * j + q] = in.norm_g[j * 256 + lane * 4 + q];
    auto src_of = [&](int r) __attribute__((always_inline)) { return r < nlat ? in.x + ((size_t)b0 * SEQ + r) * D : in.ctx + ((size_t)b0 * CTX + (r - nlat)) * D; };
    f32x4 nx[4];
    { const int r = row_lo + wid; if (r < row_hi) { const float* src = src_of(r);
#pragma unroll
        for (int j = 0; j < 4; ++j) nx[j] = *(const f32x4*)(src + j * 256 + lane * 4); } }
    for (int rbase = row_lo; rbase < row_hi; rbase += 8) {
        const int mr = rbase < nlat ? b0 + rbase / SEQ : NB;
        if (mr != cur_mr) { __syncthreads(); for (int j = threadIdx.x; j < 2 * D; j += NT) sm[j] = mod_value(in, part, mr, j); __syncthreads(); cur_mr = mr; }
        const int r = rbase + wid; if (r >= row_hi) continue;
        f32x4 v[4]; float ss = 0.f;
#pragma unroll
        for (int j = 0; j < 4; ++j) { v[j] = nx[j]; ss += v[j][0] * v[j][0] + v[j][1] * v[j][1] + v[j][2] * v[j][2] + v[j][3] * v[j][3]; }
        if (r + 8 < row_hi) { const float* src = src_of(r + 8);
#pragma unroll
            for (int j = 0; j < 4; ++j) nx[j] = *(const f32x4*)(src + j * 256 + lane * 4); }
        ss = wave_sum64(ss);
        const float rinv = __builtin_amdgcn_rsqf(ss * (1.f / D) + NORM_EPS);
#pragma unroll
        for (int j = 0; j < 4; ++j) { const int c = j * 256 + lane * 4; float o[4];
#pragma unroll
            for (int q = 0; q < 4; ++q) o[q] = (v[j][q] * rinv * gp[4 * j + q]) * (1.f + sm[D + c + q]) + sm[c + q];
            if constexpr (OUT8) { const unsigned w8 = pack4_fp8(o[0] * 16.f, o[1] * 16.f, o[2] * 16.f, o[3] * 16.f); *(unsigned*)((unsigned char*)xn + (size_t)r * D + c) = w8; if (xn2) *(unsigned*)(xn2 + (size_t)r * D + c) = w8; }
            else { u32x2 w; w.x = cvt_pk_bf16(o[0], o[1]); w.y = cvt_pk_bf16(o[2], o[3]); *(u32x2*)(xn + (size_t)r * D + c) = w; } }
    }
}
}

namespace mk {
#define XB_TMO      128
#define XB_XCNT(j)  (256  + 64 * (j))
#define XB_XSUB(j)  (1280 + 64 * (j))
#define XB_XGEN(j)  (2304 + 64 * (j))
#define XB_TOP      3328
#define XB_TOPGEN   3392
#define XCD_BAR_WORDS 3456
#define XB_SPIN_CAP (1u << 18)
__device__ __forceinline__ unsigned xb_ld(unsigned* p)              { return __hip_atomic_load(p, __ATOMIC_RELAXED, __HIP_MEMORY_SCOPE_AGENT); }
__device__ __forceinline__ unsigned xb_add(unsigned* p, unsigned v) { return __hip_atomic_fetch_add(p, v, __ATOMIC_RELAXED, __HIP_MEMORY_SCOPE_AGENT); }
__device__ __forceinline__ unsigned xb_xcc_id() { return (unsigned)__builtin_amdgcn_s_getreg((3 << 11) | 20) & 0xFu; }
#define XB_SPIN(cond, bar) do { unsigned _sp = 0; while (cond) { __builtin_amdgcn_s_sleep(1); \
    if ((++_sp & 255u) == 0u) { if (xb_ld(&(bar)[XB_TMO])) break; if (_sp > XB_SPIN_CAP) { atomicAdd(&(bar)[XB_TMO], 1u); break; } } } } while (0)
struct XcdBarrier { unsigned* bar; unsigned x; volatile LAS unsigned* st; };
__device__ __forceinline__ XcdBarrier xcd_barrier_post(unsigned* bar, volatile LAS unsigned* st) {
    XcdBarrier b; b.bar = bar; b.x = xb_xcc_id(); b.st = st;
    if (threadIdx.x == 0) (void)xb_add(&bar[XB_XCNT(b.x)], 1u);
    return b;
}
__device__ __forceinline__ void xcd_barrier_complete(unsigned* bar, unsigned x, unsigned& nloc, unsigned& nx) {
    const unsigned G = gridDim.x * gridDim.y * gridDim.z;
    unsigned sum, cnt, mine, sp = 0u;
    for (;;) {
        sum = 0u; cnt = 0u; mine = 0u;
#pragma unroll
        for (unsigned j = 0; j < 16; ++j) { const unsigned c = xb_ld(&bar[XB_XCNT(j)]); sum += c; cnt += (c > 0u) ? 1u : 0u; mine = (j == x) ? c : mine; }
        if (sum == G) break;
        __builtin_amdgcn_s_sleep(1);
        if ((++sp & 255u) == 0u) { if (xb_ld(&bar[XB_TMO])) break; if (sp > XB_SPIN_CAP) { atomicAdd(&bar[XB_TMO], 1u); break; } }
    }
    nloc = mine > 0u ? mine : 1u; nx = cnt > 0u ? cnt : 1u;
}
__device__ __forceinline__ void xcd_barrier(const XcdBarrier& b) {
    asm volatile("s_waitcnt vmcnt(0)" ::: "memory");
    __syncthreads();
    if (threadIdx.x == 0) {
        unsigned* bar = b.bar;
        __builtin_amdgcn_s_waitcnt(0);
        unsigned nloc = b.st[0], nx = b.st[1];
        if (nloc == 0u) { xcd_barrier_complete(bar, b.x, nloc, nx); b.st[0] = nloc; b.st[1] = nx; }
        const unsigned old = xb_add(&bar[XB_XSUB(b.x)], 1u);
        const unsigned gen = old / nloc;
        if (old + 1u == (gen + 1u) * nloc) {
            __builtin_amdgcn_fence(__ATOMIC_RELEASE, "agent");
            asm volatile("s_waitcnt vmcnt(0)" ::: "memory");
            const unsigned og = xb_add(&bar[XB_TOP], 1u);
            const unsigned tg = og / nx;
            if (og + 1u == (tg + 1u) * nx) xb_add(&bar[XB_TOPGEN], 1u);
            else XB_SPIN(xb_ld(&bar[XB_TOPGEN]) == tg, bar);
            __builtin_amdgcn_fence(__ATOMIC_ACQUIRE, "agent");
            xb_add(&bar[XB_XGEN(b.x)], 1u);
            asm volatile("s_waitcnt vmcnt(0)" ::: "memory");
        } else {
            XB_SPIN(xb_ld(&bar[XB_XGEN(b.x)]) == gen, bar);
            __builtin_amdgcn_fence(__ATOMIC_ACQUIRE, "agent");
            asm volatile("s_waitcnt vmcnt(0)" ::: "memory");
        }
    }
    __syncthreads();
}
}

namespace mk {
constexpr int TB = 32;
constexpr int RAWW = 320;
constexpr int RW_RAW = 0;
constexpr int RW_MU = RW_RAW + (TB + 2) * RAWW * 2;
constexpr int RW_WUP = RW_MU + 2 * RAWW * 4;
constexpr int RW_AUP = RW_WUP + 64 * 72 * 2;
constexpr int RW_CST = RW_AUP + 64 * 72 * 2;
constexpr int RW_AWD = RW_CST + 5 * 64 * 4;
constexpr int RW_AAD = RW_AWD + TB * 72 * 2;
constexpr int RW_R = RW_AAD + TB * 72 * 2;
constexpr int RW_KR = RW_R + TB * 64 * 4;
constexpr int RW_LA = RW_KR + TB * 64 * 4;
constexpr int RW_KK = RW_LA + TB * 64 * 4;
constexpr int RW_W = RW_KK + TB * 64 * 4;
constexpr int RW_B = RW_W + TB * 64 * 4;
constexpr int RW_KD = RW_B + TB * 64 * 4;
constexpr int RW_WR = RW_KD + TB * 64 * 4;
constexpr int RW_V = RW_WR + TB * 64 * 4;
constexpr int RW_SC = RW_V + TB * 64 * 4;
constexpr int RW_YO = RW_SC + TB * 2 * 4;
constexpr int RW_BON = RW_YO + TB * 64 * 4;
constexpr int RW_END = RW_BON + TB * 4;
static_assert(RW_END <= LDS_BYTES, "rwkv LDS");

#define MK_DPP(x, ctrl) __int_as_float(__builtin_amdgcn_update_dpp(__float_as_int(x), __float_as_int(x), ctrl, 0xF, 0xF, false))
__device__ __forceinline__ float allreduce16(float x) {
    x += MK_DPP(x, 0xB1); x += MK_DPP(x, 0x4E); x += MK_DPP(x, 0x141); x += MK_DPP(x, 0x140); return x;
}

__device__ __forceinline__ void allreduce16x4(float& a, float& b, float& c, float& d) {
    asm volatile("s_nop 1\n\t"
        "v_add_f32_dpp %0, %0, %0 quad_perm:[1,0,3,2] row_mask:0xf bank_mask:0xf\n\t" "v_add_f32_dpp %1, %1, %1 quad_perm:[1,0,3,2] row_mask:0xf bank_mask:0xf\n\t"
        "v_add_f32_dpp %2, %2, %2 quad_perm:[1,0,3,2] row_mask:0xf bank_mask:0xf\n\t" "v_add_f32_dpp %3, %3, %3 quad_perm:[1,0,3,2] row_mask:0xf bank_mask:0xf\n\t"
        "v_add_f32_dpp %0, %0, %0 quad_perm:[2,3,0,1] row_mask:0xf bank_mask:0xf\n\t" "v_add_f32_dpp %1, %1, %1 quad_perm:[2,3,0,1] row_mask:0xf bank_mask:0xf\n\t"
        "v_add_f32_dpp %2, %2, %2 quad_perm:[2,3,0,1] row_mask:0xf bank_mask:0xf\n\t" "v_add_f32_dpp %3, %3, %3 quad_perm:[2,3,0,1] row_mask:0xf bank_mask:0xf\n\t"
        "v_add_f32_dpp %0, %0, %0 row_half_mirror row_mask:0xf bank_mask:0xf\n\t" "v_add_f32_dpp %1, %1, %1 row_half_mirror row_mask:0xf bank_mask:0xf\n\t"
        "v_add_f32_dpp %2, %2, %2 row_half_mirror row_mask:0xf bank_mask:0xf\n\t" "v_add_f32_dpp %3, %3, %3 row_half_mirror row_mask:0xf bank_mask:0xf\n\t"
        "v_add_f32_dpp %0, %0, %0 row_mirror row_mask:0xf bank_mask:0xf\n\t" "v_add_f32_dpp %1, %1, %1 row_mirror row_mask:0xf bank_mask:0xf\n\t"
        "v_add_f32_dpp %2, %2, %2 row_mirror row_mask:0xf bank_mask:0xf\n\t" "v_add_f32_dpp %3, %3, %3 row_mirror row_mask:0xf bank_mask:0xf"
        : "+v"(a), "+v"(b), "+v"(c), "+v"(d));
}
struct RwkvP { const bf16_t* z1; bf16_t* Y; float* bon; int b0, nb; };

constexpr int RW_NPIECE = (TB + 2) * 40, RW_PPT = (RW_NPIECE + NT - 1) / NT;

__device__ __forceinline__ void rwkv_chain(LAS unsigned char* lds, const In& in, const RwkvP p, int chain) {
    const int tid = threadIdx.x, lane = tid & 63, wid = tid >> 6;
    const int d = chain / (p.nb * NH), bl = (chain / NH) % p.nb, h = chain % NH;
    const int nlat = p.nb * SEQ;
    LAS bf16_t* RAW = (LAS bf16_t*)(lds + RW_RAW); LAS float* MU = (LAS float*)(lds + RW_MU);
    LAS bf16_t* WUP = (LAS bf16_t*)(lds + RW_WUP); LAS bf16_t* AUP = (LAS bf16_t*)(lds + RW_AUP); LAS float* CST = (LAS float*)(lds + RW_CST);
    LAS bf16_t* AWD = (LAS bf16_t*)(lds + RW_AWD); LAS bf16_t* AAD = (LAS bf16_t*)(lds + RW_AAD);
    LAS float *Rr = (LAS float*)(lds + RW_R), *KR = (LAS float*)(lds + RW_KR), *LA_ = (LAS float*)(lds + RW_LA);
    LAS float *KK = (LAS float*)(lds + RW_KK), *Wv = (LAS float*)(lds + RW_W), *Bv = (LAS float*)(lds + RW_B), *KD = (LAS float*)(lds + RW_KD), *WR = (LAS float*)(lds + RW_WR), *Vv = (LAS float*)(lds + RW_V);
    LAS float *SC = (LAS float*)(lds + RW_SC), *YO = (LAS float*)(lds + RW_YO), *BON = (LAS float*)(lds + RW_BON);
    auto segcol = [&](int s) { return s < 3 ? s * RW + h * 64 : (s == 3 ? OFF_WD + d * DL : OFF_AD + d * AL); };
    for (int i = tid; i < 2 * RAWW; i += NT) { const int m = i / RAWW, c = i % RAWW; MU[i] = in.shift_mu[m * RC + segcol(c >> 6) + (c & 63)]; }
    for (int i = tid; i < 64 * 64; i += NT) { const int j = i >> 6, c = i & 63;
        WUP[c * 72 + j] = f2bf(in.rw_w_up[((size_t)d * DL + j) * RW + h * 64 + c]); AUP[c * 72 + j] = f2bf(in.rw_a_up[((size_t)d * AL + j) * RW + h * 64 + c]); }
    for (int i = tid; i < 64; i += NT) { CST[i] = in.rw_w0[d * RW + h * 64 + i]; CST[64 + i] = in.rw_a0[d * RW + h * 64 + i]; CST[128 + i] = in.rw_k_k[h * 64 + i]; CST[192 + i] = in.rw_k_a[h * 64 + i]; CST[256 + i] = in.rw_r_k[h * 64 + i]; }
    constexpr int NQ = (CTX + SEQ) / TB, NQC = CTX / TB;
    auto blk_info = [&](int q, bool& isctx, int& t0, bool& hp, bool& hn, size_t& grow0) {
        isctx = q < NQC;
        if (isctx) { const int qq = d == 0 ? q : NQC - 1 - q; t0 = qq * TB; hp = t0 > 0; hn = t0 + TB < CTX; grow0 = (size_t)nlat + (size_t)bl * CTX + t0; }
        else { const int ql = q - NQC, qq = d == 0 ? ql : SEQ / TB - 1 - ql; t0 = qq * TB; hp = (t0 % GW) != 0; hn = ((t0 + TB) % GW) != 0; grow0 = (size_t)bl * SEQ + t0; }
    };
    u32x4 pre[RW_PPT];
    auto prefetch = [&](int q) {
        bool isctx, hp, hn; int t0; size_t grow0; blk_info(q, isctx, t0, hp, hn, grow0);
#pragma unroll
        for (int k = 0; k < RW_PPT; ++k) { const int i = tid + k * NT; u32x4 v = (u32x4){0u, 0u, 0u, 0u};
            if (i < RW_NPIECE) { const int rr = i / 40, sp = i % 40, seg = sp >> 3, part = sp & 7;
                const bool ok = (rr == 0) ? hp : ((rr == TB + 1) ? hn : true);
                if (ok) v = *(const u32x4*)(p.z1 + (grow0 + rr - 1) * Z1_N + segcol(seg) + part * 8); }
            pre[k] = v; }
    };
    auto commit = [&]() {
#pragma unroll
        for (int k = 0; k < RW_PPT; ++k) { const int i = tid + k * NT; if (i < RW_NPIECE) { const int rr = i / 40, sp = i % 40; *(LAS u32x4*)(RAW + rr * RAWW + sp * 8) = pre[k]; } }
    };
    float S[2][4];
#pragma unroll
    for (int i = 0; i < 2; ++i)
#pragma unroll
        for (int j = 0; j < 4; ++j) S[i][j] = 0.f;
    const int kg = lane & 15, rp = (lane >> 4) + 4 * wid;
    prefetch(0);
    for (int q = 0; q < NQ; ++q) {
        bool isctx, hp, hn; int t0; size_t grow0; blk_info(q, isctx, t0, hp, hn, grow0);
        commit();
        __syncthreads();
        if (q + 1 < NQ) prefetch(q + 1);
        auto shift8 = [&](int t, int c0, float (&s)[8]) {
            const u32x4 xp = *(const LAS u32x4*)(RAW + t * RAWW + c0), xc = *(const LAS u32x4*)(RAW + (t + 1) * RAWW + c0), xn_ = *(const LAS u32x4*)(RAW + (t + 2) * RAWW + c0);
            const f32x4 m0a = *(const LAS f32x4*)(MU + c0), m0b = *(const LAS f32x4*)(MU + c0 + 4), m1a = *(const LAS f32x4*)(MU + RAWW + c0), m1b = *(const LAS f32x4*)(MU + RAWW + c0 + 4);
#pragma unroll
            for (int j = 0; j < 4; ++j) { const unsigned a = xp[j], b = xc[j], c = xn_[j];
                const float mu0l = j < 2 ? m0a[2 * j] : m0b[2 * j - 4], mu0h = j < 2 ? m0a[2 * j + 1] : m0b[2 * j - 3], mu1l = j < 2 ? m1a[2 * j] : m1b[2 * j - 4], mu1h = j < 2 ? m1a[2 * j + 1] : m1b[2 * j - 3];
                { const float x = bflo(b); s[2 * j] = x + mu0l * (bflo(a) - x) + mu1l * (bflo(c) - x); }
                { const float x = bfhi(b); s[2 * j + 1] = x + mu0h * (bfhi(a) - x) + mu1h * (bfhi(c) - x); } } };
        for (int it = tid; it < TB * 24; it += NT) {
            const int t = it / 24, g = it % 24, seg = g >> 3, cc = (g & 7) * 8; float s[8]; shift8(t, g * 8, s);
            LAS float* dst = (seg == 0 ? Rr : (seg == 1 ? KR : Vv)) + t * 64 + cc; *(LAS f32x4*)dst = (f32x4){s[0], s[1], s[2], s[3]}; *(LAS f32x4*)(dst + 4) = (f32x4){s[4], s[5], s[6], s[7]};
        }
        { const int t = tid >> 4, g = 24 + (tid & 15), cc = (g & 7) * 8; float s[8]; shift8(t, g * 8, s);
          const bool isw = (tid & 15) < 8;
#pragma unroll
          for (int j = 0; j < 8; ++j) { const float th = fast_tanh(s[j]); s[j] = isw ? th : s[j]; }
          LAS bf16_t* dst = (isw ? AWD : AAD) + t * 72 + cc;
          u32x4 w; w.x = cvt_pk_bf16(s[0], s[1]); w.y = cvt_pk_bf16(s[2], s[3]); w.z = cvt_pk_bf16(s[4], s[5]); w.w = cvt_pk_bf16(s[6], s[7]); *(LAS u32x4*)dst = w; }
        __syncthreads();
        {
            const int lora = wid >> 2, ct = wid & 3, fr = lane & 15, fq = lane >> 4;
            const LAS bf16_t* Am = lora ? AAD : AWD; const LAS bf16_t* Bm = lora ? AUP : WUP;
#pragma unroll
            for (int rt = 0; rt < 2; ++rt) {
                f32x4 acc = (f32x4){0.f, 0.f, 0.f, 0.f};
#pragma unroll
                for (int ks = 0; ks < 2; ++ks) {
                    const bf16x8 a = *(const LAS bf16x8*)(Am + (rt * 16 + fr) * 72 + ks * 32 + fq * 8);
                    const bf16x8 b = *(const LAS bf16x8*)(Bm + (ct * 16 + fr) * 72 + ks * 32 + fq * 8);
                    acc = __builtin_amdgcn_mfma_f32_16x16x32_bf16(a, b, acc, 0, 0, 0);
                }
                const int col = ct * 16 + fr;
#pragma unroll
                for (int i = 0; i < 4; ++i) { const int t = rt * 16 + fq * 4 + i;
                    if (lora == 0) { const float lw = acc[i] + CST[col]; const float wl = -fast_softplus(-lw) - 0.5f; Wv[t * 64 + col] = __expf(-__expf(wl)); }
                    else { LA_[t * 64 + col] = fast_sigmoid(acc[i] + CST[64 + col]); } }
            }
        }
        __syncthreads();
        {
            const int t = tid >> 4, c4 = (tid & 15) * 4;
            const f32x4 k = *(const LAS f32x4*)(KR + t * 64 + c4), a = *(const LAS f32x4*)(LA_ + t * 64 + c4), w = *(const LAS f32x4*)(Wv + t * 64 + c4), r = *(const LAS f32x4*)(Rr + t * 64 + c4);
            f32x4 kkr, kd, bb, wr; float ss = 0.f, br = 0.f, kr = 0.f, bn = 0.f;
#pragma unroll
            for (int j = 0; j < 4; ++j) { kkr[j] = k[j] * CST[128 + c4 + j]; ss += kkr[j] * kkr[j]; }
            ss = allreduce16(ss);
            const float inv = 1.f / fmaxf(sqrtf(ss), 1e-12f);
#pragma unroll
            for (int j = 0; j < 4; ++j) { const float kk = kkr[j] * inv; kkr[j] = kk; kd[j] = k[j] * (1.f + (a[j] - 1.f) * CST[192 + c4 + j]); bb[j] = kk * a[j]; wr[j] = w[j] * r[j];
                br += bb[j] * r[j]; kr += kd[j] * r[j]; bn += r[j] * kd[j] * CST[256 + c4 + j]; }
            br = allreduce16(br); kr = allreduce16(kr); bn = allreduce16(bn);
            *(LAS f32x4*)(KK + t * 64 + c4) = kkr; *(LAS f32x4*)(KD + t * 64 + c4) = kd; *(LAS f32x4*)(Bv + t * 64 + c4) = bb; *(LAS f32x4*)(WR + t * 64 + c4) = wr;
            if ((tid & 15) == 0) { SC[t * 2] = br; SC[t * 2 + 1] = kr; BON[t] = bn; }
        }
        __syncthreads();
        {
            auto tof = [&](int st) { return d == 0 ? st : TB - 1 - st; };
            const LAS float* lb = KK + 4 * kg;
            const LAS float* vb = Vv + 2 * rp;
            constexpr int OW = (RW_W - RW_KK) / 4, OB = (RW_B - RW_KK) / 4, OKD = (RW_KD - RW_KK) / 4, OWR = (RW_WR - RW_KK) / 4;
            int t = tof(0);
            f32x4 kk4 = *(const LAS f32x4*)(lb + t * 64), w4 = *(const LAS f32x4*)(lb + t * 64 + OW), b4 = *(const LAS f32x4*)(lb + t * 64 + OB),
                  kd4 = *(const LAS f32x4*)(lb + t * 64 + OKD), wr4 = *(const LAS f32x4*)(lb + t * 64 + OWR);
            f32x2 vv = *(const LAS f32x2*)(vb + t * 64), sc = *(const LAS f32x2*)(SC + t * 2);
            f32x2 S2[4];
#pragma unroll
            for (int j = 0; j < 4; ++j) { S2[j][0] = S[0][j]; S2[j][1] = S[1][j]; }
#pragma unroll 2
            for (int st = 0; st < TB; ++st) {
                const int tn = tof(st + 1 < TB ? st + 1 : st);
                const f32x4 nkk4 = *(const LAS f32x4*)(lb + tn * 64), nw4 = *(const LAS f32x4*)(lb + tn * 64 + OW), nb4 = *(const LAS f32x4*)(lb + tn * 64 + OB),
                            nkd4 = *(const LAS f32x4*)(lb + tn * 64 + OKD), nwr4 = *(const LAS f32x4*)(lb + tn * 64 + OWR);
                const f32x2 nvv = *(const LAS f32x2*)(vb + tn * 64), nsc = *(const LAS f32x2*)(SC + tn * 2);
                f32x2 sa2 = S2[0] * kk4[0], yo2 = S2[0] * wr4[0];
#pragma unroll
                for (int j = 1; j < 4; ++j) { sa2 += S2[j] * kk4[j]; yo2 += S2[j] * wr4[j]; }
                float sa0 = sa2[0], sa1 = sa2[1], yo0 = yo2[0], yo1 = yo2[1];
                allreduce16x4(sa0, sa1, yo0, yo1);
                f32x2 sar; sar[0] = sa0; sar[1] = sa1;
#pragma unroll
                for (int j = 0; j < 4; ++j) S2[j] = S2[j] * w4[j] + (vv * kd4[j] - sar * b4[j]);
                if (kg == 0) { f32x2 yor; yor[0] = yo0; yor[1] = yo1; const f32x2 y = yor - sar * sc[0] + vv * sc[1]; *(LAS f32x2*)(YO + t * 64 + 2 * rp) = y; }
                kk4 = nkk4; w4 = nw4; b4 = nb4; kd4 = nkd4; wr4 = nwr4; vv = nvv; sc = nsc; t = tn;
            }
#pragma unroll
            for (int j = 0; j < 4; ++j) { S[0][j] = S2[j][0]; S[1][j] = S2[j][1]; }
        }
        __syncthreads();
        if (!isctx) {
            const int t = tid >> 4, c4 = (tid & 15) * 4; const f32x4 y = *(const LAS f32x4*)(YO + t * 64 + c4);
            u32x2 w; w.x = cvt_pk_bf16(y[0], y[1]); w.y = cvt_pk_bf16(y[2], y[3]);
            *(u32x2*)(p.Y + ((size_t)d * nlat + grow0 + t) * RW + h * 64 + c4) = w;
            if (tid < TB) p.bon[((size_t)d * nlat + grow0 + tid) * NH + h] = BON[tid];
        }
    }
}
__device__ __forceinline__ void rwkv_phase(LAS unsigned char* lds, const In& in, const RwkvP p, int bid, int nblk) {
    const int nchain = 2 * p.nb * NH;
    for (int c = bid; c < nchain; c += nblk) { rwkv_chain(lds, in, p, c); __syncthreads(); }
}
}

namespace mk {
constexpr int C2_RAW = 0;
constexpr int C2_MU = C2_RAW + (TB + 2) * RAWW * 2;
constexpr int C2_WUP = C2_MU + 2 * RAWW * 4;
constexpr int C2_AUP = C2_WUP + 64 * 72 * 2;
constexpr int C2_CST = C2_AUP + 64 * 72 * 2;
constexpr int C2_AWD = C2_CST + 5 * 64 * 4;
constexpr int C2_AAD = C2_AWD + TB * 72 * 2;
constexpr int C2_X = C2_AAD + TB * 72 * 2;
constexpr int C2_R = C2_X, C2_KR = C2_R + TB * 64 * 4, C2_V = C2_KR + TB * 64 * 4, C2_E = C2_V + TB * 64 * 4, C2_LA = C2_E + TB * 64 * 4, C2_CUM = C2_LA + TB * 64 * 4, C2_X_END = C2_CUM + TB * 64 * 4;
constexpr int C2_YO = C2_X;
constexpr int C2_G = C2_YO + TB * 64 * 4;
constexpr int C2_UB = C2_G + 64 * 36 * 4;
constexpr int C2_ABT = C2_UB + 64 * 40 * 2;
constexpr int C2_AKT = C2_ABT + 32 * 32 * 4;
constexpr int C2_NBT = C2_AKT + 32 * 40 * 2;
constexpr int C2_NKT = C2_NBT + 32 * 40 * 2;
static_assert(C2_NKT + 32 * 40 * 2 <= C2_X_END, "region X reuse");
constexpr int C2_KKS = C2_X_END;
constexpr int C2_BS = C2_KKS + TB * 72 * 2, C2_KDS = C2_BS + TB * 72 * 2, C2_RS = C2_KDS + TB * 72 * 2;
constexpr int C2_BST = C2_RS + TB * 72 * 2;
constexpr int C2_KDST = C2_BST + 64 * 40 * 2;
constexpr int C2_VT = C2_KDST + 64 * 40 * 2;
constexpr int C2_S0B = C2_VT + 64 * 40 * 2;
constexpr int C2_GC = C2_S0B + 64 * 72 * 2;
constexpr int C2_BON = C2_GC + 64 * 4;
constexpr int C2_END = C2_BON + TB * 4;
static_assert(C2_END <= LDS_BYTES - 16 && (C2_X % 16) == 0 && (C2_KKS % 16) == 0 && (C2_G % 16) == 0 && (C2_UB % 16) == 0 && (C2_ABT % 16) == 0 && (C2_AKT % 16) == 0 && (C2_S0B % 16) == 0, "rwkv2 LDS");

__device__ __forceinline__ bf16x8 ldsb8(const LAS bf16_t* p) { return *(const LAS bf16x8*)p; }

template <int MODE>
__device__ __forceinline__ void rwkv_chain2(LAS unsigned char* lds, const In& in, const RwkvP p, int chain) {
    const int tid = threadIdx.x, lane = tid & 63, wid = tid >> 6, fr = lane & 15, fq = lane >> 4;
    const int d = chain / (p.nb * NH), bl = (chain / NH) % p.nb, h = chain % NH;
    const int nlat = p.nb * SEQ;
    LAS bf16_t* RAW = (LAS bf16_t*)(lds + C2_RAW); LAS float* MU = (LAS float*)(lds + C2_MU);
    LAS bf16_t* WUP = (LAS bf16_t*)(lds + C2_WUP); LAS bf16_t* AUP = (LAS bf16_t*)(lds + C2_AUP); LAS float* CST = (LAS float*)(lds + C2_CST);
    LAS bf16_t* AWD = (LAS bf16_t*)(lds + C2_AWD); LAS bf16_t* AAD = (LAS bf16_t*)(lds + C2_AAD);
    LAS float *Rr = (LAS float*)(lds + C2_R), *KR = (LAS float*)(lds + C2_KR), *Vv = (LAS float*)(lds + C2_V), *Ee = (LAS float*)(lds + C2_E), *LA_ = (LAS float*)(lds + C2_LA), *CUM = (LAS float*)(lds + C2_CUM);
    LAS float *YO = (LAS float*)(lds + C2_YO), *Gm = (LAS float*)(lds + C2_G), *ABT = (LAS float*)(lds + C2_ABT), *GC = (LAS float*)(lds + C2_GC), *BON = (LAS float*)(lds + C2_BON);
    LAS bf16_t *UB = (LAS bf16_t*)(lds + C2_UB), *AKT = (LAS bf16_t*)(lds + C2_AKT), *NBT = (LAS bf16_t*)(lds + C2_NBT), *NKT = (LAS bf16_t*)(lds + C2_NKT);
    LAS bf16_t *KKS = (LAS bf16_t*)(lds + C2_KKS), *BS = (LAS bf16_t*)(lds + C2_BS), *KDS = (LAS bf16_t*)(lds + C2_KDS), *RS = (LAS bf16_t*)(lds + C2_RS);
    LAS bf16_t *BST = (LAS bf16_t*)(lds + C2_BST), *KDST = (LAS bf16_t*)(lds + C2_KDST), *VT = (LAS bf16_t*)(lds + C2_VT), *S0B = (LAS bf16_t*)(lds + C2_S0B);
    auto segcol = [&](int s) { return s < 3 ? s * RW + h * 64 : (s == 3 ? OFF_WD + d * DL : OFF_AD + d * AL); };
    for (int i = tid; i < 2 * RAWW; i += NT) { const int m = i / RAWW, c = i % RAWW; MU[i] = in.shift_mu[m * RC + segcol(c >> 6) + (c & 63)]; }
    for (int i = tid; i < 64 * 64; i += NT) { const int j = i >> 6, c = i & 63;
        WUP[c * 72 + j] = f2bf(in.rw_w_up[((size_t)d * DL + j) * RW + h * 64 + c]); AUP[c * 72 + j] = f2bf(in.rw_a_up[((size_t)d * AL + j) * RW + h * 64 + c]); }
    for (int i = tid; i < 64; i += NT) { CST[i] = in.rw_w0[d * RW + h * 64 + i]; CST[64 + i] = in.rw_a0[d * RW + h * 64 + i]; CST[128 + i] = in.rw_k_k[h * 64 + i]; CST[192 + i] = in.rw_k_a[h * 64 + i]; CST[256 + i] = in.rw_r_k[h * 64 + i]; }
    for (int i = tid; i < 64 * 72 / 2; i += NT) ((LAS unsigned*)S0B)[i] = 0u;
    constexpr int NQ = (CTX + SEQ) / TB, NQC = CTX / TB;
    auto blk_info = [&](int q, bool& isctx, int& t0, bool& hp, bool& hn, size_t& grow0) {
        isctx = q < NQC;
        if (isctx) { const int qq = d == 0 ? q : NQC - 1 - q; t0 = qq * TB; hp = t0 > 0; hn = t0 + TB < CTX; grow0 = (size_t)nlat + (size_t)bl * CTX + t0; }
        else { const int ql = q - NQC, qq = d == 0 ? ql : SEQ / TB - 1 - ql; t0 = qq * TB; hp = (t0 % GW) != 0; hn = ((t0 + TB) % GW) != 0; grow0 = (size_t)bl * SEQ + t0; }
    };
    u32x4 pre[RW_PPT]; int poff[RW_PPT], plds[RW_PPT], pkind[RW_PPT];
#pragma unroll
    for (int k = 0; k < RW_PPT; ++k) { const int i = tid + k * NT, rr = i / 40, sp = i % 40, seg = sp >> 3, part = sp & 7;
        poff[k] = (rr - 1) * Z1_N + segcol(seg) + part * 8; plds[k] = rr * RAWW + sp * 8; pkind[k] = i >= RW_NPIECE ? 3 : (rr == 0 ? 1 : (rr == TB + 1 ? 2 : 0)); }
    auto prefetch = [&](int q) {
        bool isctx, hp, hn; int t0; size_t grow0; blk_info(q, isctx, t0, hp, hn, grow0);
        const bf16_t* base = p.z1 + grow0 * Z1_N;
#pragma unroll
        for (int k = 0; k < RW_PPT; ++k) { u32x4 v = (u32x4){0u, 0u, 0u, 0u};
            const bool ok = pkind[k] == 0 || (pkind[k] == 1 && hp) || (pkind[k] == 2 && hn);
            if (ok) v = *(const u32x4*)(base + poff[k]);
            pre[k] = v; }
    };
    auto commit = [&]() {
#pragma unroll
        for (int k = 0; k < RW_PPT; ++k) if (pkind[k] != 3) *(LAS u32x4*)(RAW + plds[k]) = pre[k];
    };
    f32x4 Sreg[2];
    Sreg[0] = (f32x4){0.f, 0.f, 0.f, 0.f}; Sreg[1] = Sreg[0];
    const int rt = wid >> 1;
    prefetch(0);
    for (int q = 0; q < NQ; ++q) {
        bool isctx, hp, hn; int t0; size_t grow0; blk_info(q, isctx, t0, hp, hn, grow0);
        commit();
        __syncthreads();
        if (q + 1 < NQ) prefetch(q + 1);
        auto shift8 = [&](int t, int c0, float (&s)[8]) {
            const u32x4 xp = *(const LAS u32x4*)(RAW + t * RAWW + c0), xc = *(const LAS u32x4*)(RAW + (t + 1) * RAWW + c0), xn_ = *(const LAS u32x4*)(RAW + (t + 2) * RAWW + c0);
            const f32x4 m0a = *(const LAS f32x4*)(MU + c0), m0b = *(const LAS f32x4*)(MU + c0 + 4), m1a = *(const LAS f32x4*)(MU + RAWW + c0), m1b = *(const LAS f32x4*)(MU + RAWW + c0 + 4);
#pragma unroll
            for (int j = 0; j < 4; ++j) { const unsigned a = xp[j], b = xc[j], c = xn_[j];
                const float mu0l = j < 2 ? m0a[2 * j] : m0b[2 * j - 4], mu0h = j < 2 ? m0a[2 * j + 1] : m0b[2 * j - 3], mu1l = j < 2 ? m1a[2 * j] : m1b[2 * j - 4], mu1h = j < 2 ? m1a[2 * j + 1] : m1b[2 * j - 3];
                { const float x = bflo(b); s[2 * j] = x + mu0l * (bflo(a) - x) + mu1l * (bflo(c) - x); }
                { const float x = bfhi(b); s[2 * j + 1] = x + mu0h * (bfhi(a) - x) + mu1h * (bfhi(c) - x); } } };
        for (int it = tid; it < TB * 24; it += NT) {
            const int t = it / 24, g = it % 24, seg = g >> 3, cc = (g & 7) * 8, js = d == 0 ? t : TB - 1 - t; float s[8]; shift8(t, g * 8, s);
            LAS float* dst = (seg == 0 ? Rr : (seg == 1 ? KR : Vv)) + js * 64 + cc; *(LAS f32x4*)dst = (f32x4){s[0], s[1], s[2], s[3]}; *(LAS f32x4*)(dst + 4) = (f32x4){s[4], s[5], s[6], s[7]};
        }
        { const int t = tid >> 4, g = 24 + (tid & 15), cc = (g & 7) * 8, js = d == 0 ? t : TB - 1 - t; float s[8]; shift8(t, g * 8, s);
          const bool isw = (tid & 15) < 8;
#pragma unroll
          for (int j = 0; j < 8; ++j) { const float th = fast_tanh(s[j]); s[j] = isw ? th : s[j]; }
          LAS bf16_t* dst = (isw ? AWD : AAD) + js * 72 + cc;
          u32x4 w; w.x = cvt_pk_bf16(s[0], s[1]); w.y = cvt_pk_bf16(s[2], s[3]); w.z = cvt_pk_bf16(s[4], s[5]); w.w = cvt_pk_bf16(s[6], s[7]); *(LAS u32x4*)dst = w; }
        __syncthreads();
        if (MODE == 3) continue;
        {
            const int lora = wid >> 2, ct = wid & 3;
            const LAS bf16_t* Am = lora ? AAD : AWD; const LAS bf16_t* Bm = lora ? AUP : WUP;
            float carry = 0.f;
#pragma unroll
            for (int r2 = 0; r2 < 2; ++r2) {
                f32x4 acc = (f32x4){0.f, 0.f, 0.f, 0.f};
#pragma unroll
                for (int ks = 0; ks < 2; ++ks) acc = __builtin_amdgcn_mfma_f32_16x16x32_bf16(ldsb8(Am + (r2 * 16 + fr) * 72 + ks * 32 + fq * 8), ldsb8(Bm + (ct * 16 + fr) * 72 + ks * 32 + fq * 8), acc, 0, 0, 0);
                const int col = ct * 16 + fr;
                if (lora == 0) {
                    float c[4];
#pragma unroll
                    for (int i = 0; i < 4; ++i) { const float lw = acc[i] + CST[col]; const float e = __expf(-fast_softplus(-lw) - 0.5f); c[i] = i ? c[i - 1] + e : e; }
                    const float tot = c[3];
                    float s1 = tot; { const float y = __shfl_up(s1, 16); s1 += fq >= 1 ? y : 0.f; }
                    float s2 = s1;  { const float z = __shfl_up(s1, 32); s2 += fq >= 2 ? z : 0.f; }
                    const float base = carry + s2 - tot;
#pragma unroll
                    for (int i = 0; i < 4; ++i) CUM[(r2 * 16 + fq * 4 + i) * 64 + col] = base + c[i];
                    carry += __shfl(s2, 48 + fr);
                } else {
#pragma unroll
                    for (int i = 0; i < 4; ++i) LA_[(r2 * 16 + fq * 4 + i) * 64 + col] = fast_sigmoid(acc[i] + CST[64 + col]);
                }
            }
        }
        __syncthreads();
        if (MODE == 2) continue;
        {
            const int j = tid >> 4, c4 = (tid & 15) * 4;
            const f32x4 k = *(const LAS f32x4*)(KR + j * 64 + c4), a = *(const LAS f32x4*)(LA_ + j * 64 + c4), r = *(const LAS f32x4*)(Rr + j * 64 + c4), vv = *(const LAS f32x4*)(Vv + j * 64 + c4);
            const f32x4 cu = *(const LAS f32x4*)(CUM + j * 64 + c4); f32x4 cp = (f32x4){0.f, 0.f, 0.f, 0.f}; if (j > 0) cp = *(const LAS f32x4*)(CUM + (j - 1) * 64 + c4);
            float kkr[4], ss = 0.f, bn = 0.f;
#pragma unroll
            for (int x = 0; x < 4; ++x) { kkr[x] = k[x] * CST[128 + c4 + x]; ss += kkr[x] * kkr[x]; }
            ss = allreduce16(ss);
            const float inv = 1.f / fmaxf(sqrtf(ss), 1e-12f);
            float kks[4], bs[4], kds[4], rs[4];
#pragma unroll
            for (int x = 0; x < 4; ++x) { const float kk = kkr[x] * inv, kd = k[x] * (1.f + (a[x] - 1.f) * CST[192 + c4 + x]), bb = kk * a[x];
                const float g = __expf(-cu[x]), gp = __expf(-cp[x]), ig = __expf(cu[x]);
                kks[x] = kk * gp; bs[x] = bb * ig; kds[x] = kd * ig; rs[x] = r[x] * g; bn += r[x] * kd * CST[256 + c4 + x];
                if (j == TB - 1) GC[c4 + x] = g;
            }
#pragma unroll
            for (int x = 0; x < 4; x += 2) { const unsigned pb = cvt_pk_bf16(bs[x], bs[x + 1]), pk = cvt_pk_bf16(kds[x], kds[x + 1]), pv = cvt_pk_bf16(vv[x], vv[x + 1]);
                BST[(c4 + x) * 40 + j] = (bf16_t)pb; BST[(c4 + x + 1) * 40 + j] = (bf16_t)(pb >> 16); KDST[(c4 + x) * 40 + j] = (bf16_t)pk; KDST[(c4 + x + 1) * 40 + j] = (bf16_t)(pk >> 16);
                VT[(c4 + x) * 40 + j] = (bf16_t)pv; VT[(c4 + x + 1) * 40 + j] = (bf16_t)(pv >> 16); }
            bn = allreduce16(bn);
            u32x2 w; w.x = cvt_pk_bf16(kks[0], kks[1]); w.y = cvt_pk_bf16(kks[2], kks[3]); *(LAS u32x2*)(KKS + j * 72 + c4) = w;
            w.x = cvt_pk_bf16(bs[0], bs[1]); w.y = cvt_pk_bf16(bs[2], bs[3]); *(LAS u32x2*)(BS + j * 72 + c4) = w;
            w.x = cvt_pk_bf16(kds[0], kds[1]); w.y = cvt_pk_bf16(kds[2], kds[3]); *(LAS u32x2*)(KDS + j * 72 + c4) = w;
            w.x = cvt_pk_bf16(rs[0], rs[1]); w.y = cvt_pk_bf16(rs[2], rs[3]); *(LAS u32x2*)(RS + j * 72 + c4) = w;
            if ((tid & 15) == 0) BON[j] = bn;
        }
        __syncthreads();
        if (MODE == 1) continue;
        const int ctg = wid & 1;
        f32x4 accG = (f32x4){0.f, 0.f, 0.f, 0.f}, accY = accG;
        {
            const int pr = wid >> 1, rts = wid & 1;
            const LAS bf16_t* Xm = (pr & 1) ? KDS : BS; const LAS bf16_t* Ym = (pr < 2) ? KKS : RS;
            const bf16x8 a0 = ldsb8(Xm + (rts * 16 + fr) * 72 + fq * 8), a1 = ldsb8(Xm + (rts * 16 + fr) * 72 + 32 + fq * 8);
#pragma unroll
            for (int cts = 0; cts < 2; ++cts) {
                f32x4 acc = (f32x4){0.f, 0.f, 0.f, 0.f};
                acc = __builtin_amdgcn_mfma_f32_16x16x32_bf16(a0, ldsb8(Ym + (cts * 16 + fr) * 72 + fq * 8), acc, 0, 0, 0);
                acc = __builtin_amdgcn_mfma_f32_16x16x32_bf16(a1, ldsb8(Ym + (cts * 16 + fr) * 72 + 32 + fq * 8), acc, 0, 0, 0);
                const int t = cts * 16 + fr, s0 = rts * 16 + fq * 4;
#pragma unroll
                for (int i = 0; i < 4; ++i) { const bool keep = (pr < 2) ? (s0 + i < t) : (s0 + i <= t); acc[i] = keep ? acc[i] : 0.f; }
                if (pr == 0) *(LAS f32x4*)(ABT + t * 32 + s0) = acc;
                else { u32x2 w; w.x = cvt_pk_bf16(acc[0], acc[1]); w.y = cvt_pk_bf16(acc[2], acc[3]); *(LAS u32x2*)((pr == 1 ? AKT : (pr == 2 ? NBT : NKT)) + t * 40 + s0) = w; }
            }
#pragma unroll
            for (int ks = 0; ks < 2; ++ks) { const bf16x8 sa = ldsb8(S0B + (rt * 16 + fr) * 72 + ks * 32 + fq * 8);
                accG = __builtin_amdgcn_mfma_f32_16x16x32_bf16(sa, ldsb8(KKS + (ctg * 16 + fr) * 72 + ks * 32 + fq * 8), accG, 0, 0, 0);
                accY = __builtin_amdgcn_mfma_f32_16x16x32_bf16(sa, ldsb8(RS + (ctg * 16 + fr) * 72 + ks * 32 + fq * 8), accY, 0, 0, 0); }
        }
        __syncthreads();
        {
            const bf16x8 va = ldsb8(VT + (rt * 16 + fr) * 40 + fq * 8);
            accG = __builtin_amdgcn_mfma_f32_16x16x32_bf16(va, ldsb8(AKT + (ctg * 16 + fr) * 40 + fq * 8), accG, 0, 0, 0);
            accY = __builtin_amdgcn_mfma_f32_16x16x32_bf16(va, ldsb8(NKT + (ctg * 16 + fr) * 40 + fq * 8), accY, 0, 0, 0);
#pragma unroll
            for (int i = 0; i < 4; ++i) Gm[(rt * 16 + fq * 4 + i) * 36 + ctg * 16 + fr] = -accG[i];
        }
        __syncthreads();
        if (MODE == 4) continue;
        if (wid < 4) {
            const int v = wid * 16 + (lane >> 2), pq = lane & 3;
            const LAS float* grow = Gm + v * 36;
            f32x4 r0 = *(const LAS f32x4*)(grow + 4 * pq), r1 = *(const LAS f32x4*)(grow + 16 + 4 * pq);
            u32x2 ubo[TB / 4];
            const LAS float* abd = ABT; asm volatile("" : "+v"(abd));
            const LAS float* abq = ABT + 128 * pq; asm volatile("" : "+v"(abq));
            f32x4 dc[3], a0c[4], a1c[4];
            auto ldg = [&](int g, f32x4 (&dd)[3], f32x4 (&aa0)[4], f32x4 (&aa1)[4]) {
#pragma unroll
                for (int x = 0; x < 3; ++x) dd[x] = *(const LAS f32x4*)(abd + (4 * g + 1 + x) * 32 + 4 * g);
#pragma unroll
                for (int jj = 0; jj < 4; ++jj) { if (g < 3) aa0[jj] = *(const LAS f32x4*)(abq + jj * 32 + 4 * g); if (g < 7) aa1[jj] = *(const LAS f32x4*)(abq + (16 + jj) * 32 + 4 * g); } };
            ldg(0, dc, a0c, a1c);
#pragma unroll
            for (int g = 0; g < TB / 4; ++g) {
                f32x4 dn[3], a0n[4], a1n[4];
                if (g + 1 < TB / 4) ldg(g + 1, dn, a0n, a1n);
                __builtin_amdgcn_sched_barrier(0);
                const f32x4 rr = g < 4 ? r0 : r1;
                f32x4 u4;
                u4[0] = rr[0];
                u4[1] = rr[1] - u4[0] * dc[0][0];
                u4[2] = rr[2] - (u4[0] * dc[1][0] + u4[1] * dc[1][1]);
                u4[3] = rr[3] - (u4[0] * dc[2][0] + u4[1] * dc[2][1] + u4[2] * dc[2][2]);
#pragma unroll
                for (int x = 0; x < 4; ++x) { const int ui = __float_as_int(u4[x]); int bi;
                    if ((g & 3) == 0) bi = __builtin_amdgcn_update_dpp(0, ui, 0x00, 0xF, 0xF, true); else if ((g & 3) == 1) bi = __builtin_amdgcn_update_dpp(0, ui, 0x55, 0xF, 0xF, true);
                    else if ((g & 3) == 2) bi = __builtin_amdgcn_update_dpp(0, ui, 0xAA, 0xF, 0xF, true); else bi = __builtin_amdgcn_update_dpp(0, ui, 0xFF, 0xF, 0xF, true);
                    u4[x] = __int_as_float(bi); }
                ubo[g].x = cvt_pk_bf16(u4[0], u4[1]); ubo[g].y = cvt_pk_bf16(u4[2], u4[3]);
                if (g < 3) {
#pragma unroll
                    for (int jj = 0; jj < 4; ++jj) r0[jj] -= u4[0] * a0c[jj][0] + u4[1] * a0c[jj][1] + u4[2] * a0c[jj][2] + u4[3] * a0c[jj][3]; }
                if (g < 7) {
#pragma unroll
                    for (int jj = 0; jj < 4; ++jj) r1[jj] -= u4[0] * a1c[jj][0] + u4[1] * a1c[jj][1] + u4[2] * a1c[jj][2] + u4[3] * a1c[jj][3]; }
                if (g + 1 < TB / 4) {
#pragma unroll
                    for (int x = 0; x < 3; ++x) dc[x] = dn[x];
#pragma unroll
                    for (int jj = 0; jj < 4; ++jj) { a0c[jj] = a0n[jj]; a1c[jj] = a1n[jj]; } }
            }
            if (pq == 0) {
#pragma unroll
                for (int g = 0; g < TB / 4; g += 2) { u32x4 w; w.x = ubo[g].x; w.y = ubo[g].y; w.z = ubo[g + 1].x; w.w = ubo[g + 1].y; *(LAS u32x4*)(UB + v * 40 + 4 * g) = w; } }
        }
        __syncthreads();
        if (MODE == 5) continue;
        {
            const bf16x8 ua = ldsb8(UB + (rt * 16 + fr) * 40 + fq * 8), va = ldsb8(VT + (rt * 16 + fr) * 40 + fq * 8);
            accY = __builtin_amdgcn_mfma_f32_16x16x32_bf16(ua, ldsb8(NBT + (ctg * 16 + fr) * 40 + fq * 8), accY, 0, 0, 0);
            *(LAS f32x4*)(YO + (ctg * 16 + fr) * 64 + rt * 16 + fq * 4) = accY;
#pragma unroll
            for (int cc = 0; cc < 2; ++cc) { const int ct = 2 * (wid & 1) + cc, kcol = ct * 16 + fr;
                f32x4 acc = Sreg[cc];
                acc = __builtin_amdgcn_mfma_f32_16x16x32_bf16(ua, ldsb8(BST + kcol * 40 + fq * 8), acc, 0, 0, 0);
                acc = __builtin_amdgcn_mfma_f32_16x16x32_bf16(va, ldsb8(KDST + kcol * 40 + fq * 8), acc, 0, 0, 0);
                const float g = GC[kcol];
#pragma unroll
                for (int i = 0; i < 4; ++i) acc[i] *= g;
                { const unsigned p0 = cvt_pk_bf16(acc[0], acc[1]), p1 = cvt_pk_bf16(acc[2], acc[3]); LAS bf16_t* sp = S0B + (rt * 16 + fq * 4) * 72 + kcol;
                  sp[0] = (bf16_t)p0; sp[72] = (bf16_t)(p0 >> 16); sp[144] = (bf16_t)p1; sp[216] = (bf16_t)(p1 >> 16); }
                Sreg[cc] = acc; }
        }
        __syncthreads();
        if (!isctx) {
            const int j = tid >> 4, c4 = (tid & 15) * 4, t = d == 0 ? j : TB - 1 - j; const f32x4 y = *(const LAS f32x4*)(YO + j * 64 + c4);
            u32x2 w; w.x = cvt_pk_bf16(y[0], y[1]); w.y = cvt_pk_bf16(y[2], y[3]);
            bf16_t* yb_ = p.Y + ((size_t)d * nlat + grow0) * RW + h * 64;
            *(u32x2*)(yb_ + t * RW + c4) = w;
            if (tid < TB) { const int tt = d == 0 ? tid : TB - 1 - tid; float* bb_ = p.bon + ((size_t)d * nlat + grow0) * NH + h; bb_[tt * NH] = BON[tid]; }
        }
    }
}
template <int MODE = 0>
__device__ __forceinline__ void rwkv_phase2(LAS unsigned char* lds, const In& in, const RwkvP p, int bid, int nblk) {
    const int nchain = 2 * p.nb * NH;
    for (int c = bid; c < nchain; c += nblk) { rwkv_chain2<MODE>(lds, in, p, c); __syncthreads(); }
}
}

namespace mk {
namespace r3 {
constexpr int C2_RAW = 0;
constexpr int C2_MU = C2_RAW + (TB + 2) * RAWW * 2;
constexpr int C2_WUP = C2_MU + 3 * RAWW * 4;
constexpr int C2_AUP = C2_WUP + 64 * 72 * 2;
constexpr int C2_CST = C2_AUP + 64 * 72 * 2;
constexpr int C2_AWD = C2_CST + 5 * 64 * 4;
constexpr int C2_AAD = C2_AWD + TB * 72 * 2;
constexpr int C2_X = C2_AAD + TB * 72 * 2;
constexpr int C2_G = C2_X;
constexpr int C2_UB = C2_G + 64 * 36 * 4;
constexpr int C2_ABT = C2_UB + 64 * 40 * 2;
constexpr int C2_AKT = C2_ABT + 32 * 32 * 4;
constexpr int C2_NBT = C2_AKT + 32 * 40 * 2;
constexpr int C2_NKT = C2_NBT + 32 * 40 * 2;
constexpr int C2_YO = C2_NKT + 32 * 40 * 2;
constexpr int C2_X_END = C2_YO + TB * 64 * 4;
constexpr int C2_KKS = C2_X_END;
constexpr int C2_BS = C2_KKS + TB * 72 * 2, C2_KDS = C2_BS + TB * 72 * 2, C2_RS = C2_KDS + TB * 72 * 2;
constexpr int C2_BST = C2_RS + TB * 72 * 2;
constexpr int C2_KDST = C2_BST + 64 * 40 * 2;
constexpr int C2_VT = C2_KDST + 64 * 40 * 2;
constexpr int C2_S0B = C2_VT + 64 * 40 * 2;
constexpr int C2_GC = C2_S0B + 64 * 72 * 2;
constexpr int C2_BON = C2_GC + 64 * 4;
constexpr int C2_RB = C2_BON + TB * 4;
constexpr int C2_KRB = C2_RB + TB * 64 * 2, C2_VB = C2_KRB + TB * 64 * 2;
constexpr int C2_LA = C2_VB + TB * 64 * 2;
constexpr int C2_CUM = C2_LA + TB * 64 * 4;
constexpr int C2_BON2 = C2_CUM + (TB + 1) * 64 * 4;
constexpr int C2_END = C2_BON2 + TB * 4;
static_assert(C2_END <= LDS_BYTES - 16 && (C2_X % 16) == 0 && (C2_KKS % 16) == 0 && (C2_G % 16) == 0 && (C2_UB % 16) == 0 && (C2_ABT % 16) == 0 && (C2_AKT % 16) == 0 && (C2_S0B % 16) == 0, "rwkv2 LDS");

__device__ __forceinline__ bf16x8 ldsb8(const LAS bf16_t* p) { return *(const LAS bf16x8*)p; }

template <int MODE>
__device__ __forceinline__ void rwkv_chain3(LAS unsigned char* lds, const In& in, const RwkvP p, int chain) {
    const int tid = threadIdx.x, lane = tid & 63, wid = tid >> 6, fr = lane & 15, fq = lane >> 4;
    const int d = chain / (p.nb * NH), bl = (chain / NH) % p.nb, h = chain % NH;
    const int nlat = p.nb * SEQ;
    LAS bf16_t* RAW = (LAS bf16_t*)(lds + C2_RAW); LAS float* MU = (LAS float*)(lds + C2_MU);
    LAS bf16_t* WUP = (LAS bf16_t*)(lds + C2_WUP); LAS bf16_t* AUP = (LAS bf16_t*)(lds + C2_AUP); LAS float* CST = (LAS float*)(lds + C2_CST);
    LAS bf16_t* AWD = (LAS bf16_t*)(lds + C2_AWD); LAS bf16_t* AAD = (LAS bf16_t*)(lds + C2_AAD);
    LAS bf16_t *Rb = (LAS bf16_t*)(lds + C2_RB), *KRb = (LAS bf16_t*)(lds + C2_KRB), *Vb = (LAS bf16_t*)(lds + C2_VB); LAS float *LA_ = (LAS float*)(lds + C2_LA), *CUM = (LAS float*)(lds + C2_CUM);
    LAS float *YO = (LAS float*)(lds + C2_YO), *Gm = (LAS float*)(lds + C2_G), *ABT = (LAS float*)(lds + C2_ABT), *GC = (LAS float*)(lds + C2_GC), *BON = (LAS float*)(lds + C2_BON);
    LAS bf16_t *UB = (LAS bf16_t*)(lds + C2_UB), *AKT = (LAS bf16_t*)(lds + C2_AKT), *NBT = (LAS bf16_t*)(lds + C2_NBT), *NKT = (LAS bf16_t*)(lds + C2_NKT);
    LAS bf16_t *KKS = (LAS bf16_t*)(lds + C2_KKS), *BS = (LAS bf16_t*)(lds + C2_BS), *KDS = (LAS bf16_t*)(lds + C2_KDS), *RS = (LAS bf16_t*)(lds + C2_RS);
    LAS bf16_t *BST = (LAS bf16_t*)(lds + C2_BST), *KDST = (LAS bf16_t*)(lds + C2_KDST), *VT = (LAS bf16_t*)(lds + C2_VT), *S0B = (LAS bf16_t*)(lds + C2_S0B);
    auto segcol = [&](int s) __attribute__((always_inline)) { return s < 3 ? s * RW + h * 64 : (s == 3 ? OFF_WD + d * DL : OFF_AD + d * AL); };
    for (int i = tid; i < RAWW; i += NT) { const float m0 = in.shift_mu[segcol(i >> 6) + (i & 63)], m1 = in.shift_mu[RC + segcol(i >> 6) + (i & 63)]; MU[i] = m0; MU[RAWW + i] = m1; MU[2 * RAWW + i] = 1.f - m0 - m1; }
    for (int i = tid; i < 64 * 64; i += NT) { const int j = i >> 6, c = i & 63;
        WUP[c * 72 + j] = f2bf(in.rw_w_up[((size_t)d * DL + j) * RW + h * 64 + c]); AUP[c * 72 + j] = f2bf(in.rw_a_up[((size_t)d * AL + j) * RW + h * 64 + c]); }
    for (int i = tid; i < 64; i += NT) { CST[i] = in.rw_w0[d * RW + h * 64 + i]; CST[64 + i] = in.rw_a0[d * RW + h * 64 + i]; CST[128 + i] = in.rw_k_k[h * 64 + i]; CST[192 + i] = in.rw_k_a[h * 64 + i]; CST[256 + i] = in.rw_r_k[h * 64 + i]; }
    for (int i = tid; i < 64 * 72 / 2; i += NT) ((LAS unsigned*)S0B)[i] = 0u;
    constexpr int NQ = (CTX + SEQ) / TB, NQC = CTX / TB;
    auto blk_info = [&](int q, bool& isctx, int& t0, bool& hp, bool& hn, size_t& grow0) __attribute__((always_inline)) {
        isctx = q < NQC;
        if (isctx) { const int qq = d == 0 ? q : NQC - 1 - q; t0 = qq * TB; hp = t0 > 0; hn = t0 + TB < CTX; grow0 = (size_t)nlat + (size_t)bl * CTX + t0; }
        else { const int ql = q - NQC, qq = d == 0 ? ql : SEQ / TB - 1 - ql; t0 = qq * TB; hp = (t0 % GW) != 0; hn = ((t0 + TB) % GW) != 0; grow0 = (size_t)bl * SEQ + t0; }
    };
    u32x4 pre[RW_PPT]; int poff[RW_PPT], plds[RW_PPT];
#pragma unroll
    for (int k = 0; k < RW_PPT; ++k) { const int i = tid + k * NT, rr = i / 40, sp = i % 40, seg = sp >> 3, part = sp & 7;
        poff[k] = (rr - 1) * Z1_N + segcol(seg) + part * 8; plds[k] = (rr * RAWW + sp * 8) | (i >= RW_NPIECE ? 3 : (rr == 0 ? 1 : (rr == TB + 1 ? 2 : 0))); }
    auto prefetch = [&](int q) __attribute__((always_inline)) {
        bool isctx, hp, hn; int t0; size_t grow0; blk_info(q, isctx, t0, hp, hn, grow0);
        const bf16_t* base = p.z1 + grow0 * Z1_N;
#pragma unroll
        for (int k = 0; k < RW_PPT; ++k) { u32x4 v = (u32x4){0u, 0u, 0u, 0u};
            const int kind = plds[k] & 3; const bool ok = kind == 0 || (kind == 1 && hp) || (kind == 2 && hn);
            if (ok) v = *(const u32x4*)(base + poff[k]);
            pre[k] = v; }
    };
    auto commit = [&]() __attribute__((always_inline)) {
#pragma unroll
        for (int k = 0; k < RW_PPT; ++k) if ((plds[k] & 3) != 3) *(LAS u32x4*)(RAW + (plds[k] & ~3)) = pre[k];
    };
    f32x4 Sreg[2];
    Sreg[0] = (f32x4){0.f, 0.f, 0.f, 0.f}; Sreg[1] = Sreg[0];
    const int rt = wid >> 1;
    auto shift8 = [&](int t, int c0, f32x2 (&s)[4]) __attribute__((always_inline)) {
        const u32x4 xp = *(const LAS u32x4*)(RAW + t * RAWW + c0), xc = *(const LAS u32x4*)(RAW + (t + 1) * RAWW + c0), xn_ = *(const LAS u32x4*)(RAW + (t + 2) * RAWW + c0);
        const f32x4 m0a = *(const LAS f32x4*)(MU + c0), m0b = *(const LAS f32x4*)(MU + c0 + 4), m1a = *(const LAS f32x4*)(MU + RAWW + c0), m1b = *(const LAS f32x4*)(MU + RAWW + c0 + 4),
                    mca = *(const LAS f32x4*)(MU + 2 * RAWW + c0), mcb = *(const LAS f32x4*)(MU + 2 * RAWW + c0 + 4);
#define MK_SH2(J, XP, XC, XN, MC2, M02, M12) { f32x2 C, P, N; C.x = bflo(XC); C.y = bfhi(XC); P.x = bflo(XP); P.y = bfhi(XP); N.x = bflo(XN); N.y = bfhi(XN); f32x2 r_ = MC2 * C; r_ = M02 * P + r_; r_ = M12 * N + r_; s[J] = r_; }
        MK_SH2(0, xp.x, xc.x, xn_.x, mca.lo, m0a.lo, m1a.lo) MK_SH2(1, xp.y, xc.y, xn_.y, mca.hi, m0a.hi, m1a.hi)
        MK_SH2(2, xp.z, xc.z, xn_.z, mcb.lo, m0b.lo, m1b.lo) MK_SH2(3, xp.w, xc.w, xn_.w, mcb.hi, m0b.hi, m1b.hi)
#undef MK_SH2
    };
    auto pack4 = [&](const f32x2 (&s)[4]) __attribute__((always_inline)) { u32x4 w; w.x = cvt_pk_bf16(s[0].x, s[0].y); w.y = cvt_pk_bf16(s[1].x, s[1].y); w.z = cvt_pk_bf16(s[2].x, s[2].y); w.w = cvt_pk_bf16(s[3].x, s[3].y); return w; };
    int sh_t[3], sh_c[3], sh_d[3];
#pragma unroll
    for (int k = 0; k < 3; ++k) { const int it = (tid & (NT / 2 - 1)) + k * (NT / 2), t = it / 24, g = it % 24, seg = g >> 3, cc = (g & 7) * 8, js = d == 0 ? t : TB - 1 - t;
        sh_t[k] = t; sh_c[k] = g * 8; sh_d[k] = seg * (TB * 64) + js * 64 + cc; }
    auto do_shift = [&](int tl, int nth) __attribute__((always_inline)) {
#pragma unroll
        for (int k = 0; k < 3; ++k) { f32x2 s[4]; shift8(sh_t[k], sh_c[k], s); *(LAS u32x4*)(Rb + sh_d[k]) = pack4(s); }
#pragma unroll 1
        for (int it = tl; it < TB * 8; it += nth) { const int t = it >> 3, part = it & 7, js = d == 0 ? t : TB - 1 - t;
            { f32x2 s[4]; shift8(t, (24 + part) * 8, s);
#pragma unroll
              for (int j = 0; j < 4; ++j) { s[j].x = 1.f - 2.f * fast_rcp(1.f + __builtin_amdgcn_exp2f(2.885390081777927f * s[j].x)); s[j].y = 1.f - 2.f * fast_rcp(1.f + __builtin_amdgcn_exp2f(2.885390081777927f * s[j].y)); }
              *(LAS u32x4*)(AWD + js * 72 + part * 8) = pack4(s); }
            { f32x2 s[4]; shift8(t, (32 + part) * 8, s); *(LAS u32x4*)(AAD + js * 72 + part * 8) = pack4(s); }
        }
    };
    auto lora_stage = [&]() __attribute__((always_inline)) {
        {
            const int lora = wid >> 2, ct = wid & 3;
            const LAS bf16_t* Am = lora ? AAD : AWD; const LAS bf16_t* Bm = lora ? AUP : WUP;
            float carry = 0.f;
#pragma unroll
            for (int r2 = 0; r2 < 2; ++r2) {
                f32x4 acc = (f32x4){0.f, 0.f, 0.f, 0.f};
#pragma unroll
                for (int ks = 0; ks < 2; ++ks) acc = __builtin_amdgcn_mfma_f32_16x16x32_bf16(ldsb8(Am + (r2 * 16 + fr) * 72 + ks * 32 + fq * 8), ldsb8(Bm + (ct * 16 + fr) * 72 + ks * 32 + fq * 8), acc, 0, 0, 0);
                const int col = ct * 16 + fr;
                if (lora == 0) {
                    float c[4];
#pragma unroll
                    for (int i = 0; i < 4; ++i) { const float lw = acc[i] + CST[col]; const float e = fast_sigmoid(lw); c[i] = i ? c[i - 1] + e : e;   }
                    const float tot = c[3];
                    float s1 = tot; { const float y = __shfl_up(s1, 16); s1 += fq >= 1 ? y : 0.f; }
                    float s2 = s1;  { const float z = __shfl_up(s1, 32); s2 += fq >= 2 ? z : 0.f; }
                    const float base = carry + s2 - tot;
#pragma unroll
                    for (int i = 0; i < 4; ++i) CUM[(1 + r2 * 16 + fq * 4 + i) * 64 + col] = base + c[i];
                    carry += __shfl(s2, 48 + fr);
                } else {
#pragma unroll
                    for (int i = 0; i < 4; ++i) LA_[(r2 * 16 + fq * 4 + i) * 64 + col] = fast_sigmoid(acc[i] + CST[64 + col]);
                }
            }
        }
    };
    auto scale_stage = [&](LAS float* bonw) __attribute__((always_inline)) {
        {
            const int j = tid >> 4, c4 = (tid & 15) * 4;
            const u32x2 kp = *(const LAS u32x2*)(KRb + j * 64 + c4), rp = *(const LAS u32x2*)(Rb + j * 64 + c4), vp = *(const LAS u32x2*)(Vb + j * 64 + c4);
            const f32x4 k = (f32x4){bflo(kp.x), bfhi(kp.x), bflo(kp.y), bfhi(kp.y)}, r = (f32x4){bflo(rp.x), bfhi(rp.x), bflo(rp.y), bfhi(rp.y)};
            const f32x4 a = *(const LAS f32x4*)(LA_ + j * 64 + c4);
            const f32x4 cu = *(const LAS f32x4*)(CUM + (j + 1) * 64 + c4), cp = *(const LAS f32x4*)(CUM + j * 64 + c4);
            const f32x4 ckk = *(const LAS f32x4*)(CST + 128 + c4), cka = *(const LAS f32x4*)(CST + 192 + c4), crk = *(const LAS f32x4*)(CST + 256 + c4);
            float kkr[4], kd[4], ss = 0.f, bn = 0.f;
#pragma unroll
            for (int x = 0; x < 4; ++x) { kkr[x] = k[x] * ckk[x]; ss += kkr[x] * kkr[x]; kd[x] = k[x] * (1.f + (a[x] - 1.f) * cka[x]); bn += r[x] * kd[x] * crk[x]; }
            asm volatile("s_nop 1\n\t"
                "v_add_f32_dpp %0, %0, %0 quad_perm:[1,0,3,2] row_mask:0xf bank_mask:0xf\n\t" "v_add_f32_dpp %1, %1, %1 quad_perm:[1,0,3,2] row_mask:0xf bank_mask:0xf\n\ts_nop 0\n\t"
                "v_add_f32_dpp %0, %0, %0 quad_perm:[2,3,0,1] row_mask:0xf bank_mask:0xf\n\t" "v_add_f32_dpp %1, %1, %1 quad_perm:[2,3,0,1] row_mask:0xf bank_mask:0xf\n\ts_nop 0\n\t"
                "v_add_f32_dpp %0, %0, %0 row_half_mirror row_mask:0xf bank_mask:0xf\n\t" "v_add_f32_dpp %1, %1, %1 row_half_mirror row_mask:0xf bank_mask:0xf\n\ts_nop 0\n\t"
                "v_add_f32_dpp %0, %0, %0 row_mirror row_mask:0xf bank_mask:0xf\n\t" "v_add_f32_dpp %1, %1, %1 row_mirror row_mask:0xf bank_mask:0xf"
                : "+v"(ss), "+v"(bn));
            const float inv = __builtin_amdgcn_rsqf(fmaxf(ss, 1e-24f));
            float kks[4], bs[4], kds[4], rs[4]; f32x4 gv;
#pragma unroll
            for (int x = 0; x < 4; ++x) { const float kk = kkr[x] * inv, bb = kk * a[x];
                const float ig = __builtin_amdgcn_exp2f(0.87503877f * cu[x]), g = fast_rcp(ig), gp = __builtin_amdgcn_exp2f(-0.87503877f * cp[x]);
                kks[x] = kk * gp; bs[x] = bb * ig; kds[x] = kd[x] * ig; rs[x] = r[x] * g; gv[x] = g;
            }
            if (j == TB - 1) *(LAS f32x4*)(GC + c4) = gv;
#pragma unroll
            for (int x = 0; x < 4; x += 2) { const unsigned pb = cvt_pk_bf16(bs[x], bs[x + 1]), pk = cvt_pk_bf16(kds[x], kds[x + 1]), pv = x ? vp.y : vp.x;
                BST[(c4 + x) * 40 + j] = (bf16_t)pb; BST[(c4 + x + 1) * 40 + j] = (bf16_t)(pb >> 16); KDST[(c4 + x) * 40 + j] = (bf16_t)pk; KDST[(c4 + x + 1) * 40 + j] = (bf16_t)(pk >> 16);
                VT[(c4 + x) * 40 + j] = (bf16_t)pv; VT[(c4 + x + 1) * 40 + j] = (bf16_t)(pv >> 16); }
            u32x2 w; w.x = cvt_pk_bf16(kks[0], kks[1]); w.y = cvt_pk_bf16(kks[2], kks[3]); *(LAS u32x2*)(KKS + j * 72 + c4) = w;
            w.x = cvt_pk_bf16(bs[0], bs[1]); w.y = cvt_pk_bf16(bs[2], bs[3]); *(LAS u32x2*)(BS + j * 72 + c4) = w;
            w.x = cvt_pk_bf16(kds[0], kds[1]); w.y = cvt_pk_bf16(kds[2], kds[3]); *(LAS u32x2*)(KDS + j * 72 + c4) = w;
            w.x = cvt_pk_bf16(rs[0], rs[1]); w.y = cvt_pk_bf16(rs[2], rs[3]); *(LAS u32x2*)(RS + j * 72 + c4) = w;
            if ((tid & 15) == 0) bonw[j] = bn;
        }
    };
    if (tid < 16) *(LAS f32x4*)(CUM + tid * 4) = (f32x4){0.f, 0.f, 0.f, 0.f};
    prefetch(0);
    commit();
    __syncthreads();
    if (1 < NQ) prefetch(1);
    do_shift(tid & (NT / 2 - 1), NT / 2);
    __syncthreads();
    lora_stage();
    __syncthreads();
    scale_stage(BON);
    __syncthreads();
    for (int q = 0; q < NQ; ++q) {
        bool isctx, hp, hn; int t0; size_t grow0; blk_info(q, isctx, t0, hp, hn, grow0);
        LAS float* bonr = BON + (q & 1) * ((C2_BON2 - C2_BON) / 4); LAS float* bonn = BON + ((q + 1) & 1) * ((C2_BON2 - C2_BON) / 4);
        const int ctg = wid & 1;
        f32x4 accG = (f32x4){0.f, 0.f, 0.f, 0.f}, accY = accG;
        {
            const int pr = wid >> 1, rts = wid & 1;
            const LAS bf16_t* Xm = (pr & 1) ? KDS : BS; const LAS bf16_t* Ym = (pr < 2) ? KKS : RS;
            const bf16x8 a0 = ldsb8(Xm + (rts * 16 + fr) * 72 + fq * 8), a1 = ldsb8(Xm + (rts * 16 + fr) * 72 + 32 + fq * 8);
#pragma unroll
            for (int cts = 0; cts < 2; ++cts) {
                f32x4 acc = (f32x4){0.f, 0.f, 0.f, 0.f};
                acc = __builtin_amdgcn_mfma_f32_16x16x32_bf16(a0, ldsb8(Ym + (cts * 16 + fr) * 72 + fq * 8), acc, 0, 0, 0);
                acc = __builtin_amdgcn_mfma_f32_16x16x32_bf16(a1, ldsb8(Ym + (cts * 16 + fr) * 72 + 32 + fq * 8), acc, 0, 0, 0);
                const int t = cts * 16 + fr, s0 = rts * 16 + fq * 4;
#pragma unroll
                for (int i = 0; i < 4; ++i) { const bool keep = (pr < 2) ? (s0 + i < t) : (s0 + i <= t); acc[i] = keep ? acc[i] : 0.f; }
                if (pr == 0) { ABT[s0 * 32 + t] = acc[0]; ABT[(s0 + 1) * 32 + t] = acc[1]; ABT[(s0 + 2) * 32 + t] = acc[2]; ABT[(s0 + 3) * 32 + t] = acc[3]; }
                else { u32x2 w; w.x = cvt_pk_bf16(acc[0], acc[1]); w.y = cvt_pk_bf16(acc[2], acc[3]); *(LAS u32x2*)((pr == 1 ? AKT : (pr == 2 ? NBT : NKT)) + t * 40 + s0) = w; }
            }
#pragma unroll
            for (int ks = 0; ks < 2; ++ks) { const bf16x8 sa = ldsb8(S0B + (rt * 16 + fr) * 72 + ks * 32 + fq * 8);
                accG = __builtin_amdgcn_mfma_f32_16x16x32_bf16(sa, ldsb8(KKS + (ctg * 16 + fr) * 72 + ks * 32 + fq * 8), accG, 0, 0, 0);
                accY = __builtin_amdgcn_mfma_f32_16x16x32_bf16(sa, ldsb8(RS + (ctg * 16 + fr) * 72 + ks * 32 + fq * 8), accY, 0, 0, 0); }
        }
        __syncthreads();
        {
            const bf16x8 va = ldsb8(VT + (rt * 16 + fr) * 40 + fq * 8);
            accG = __builtin_amdgcn_mfma_f32_16x16x32_bf16(va, ldsb8(AKT + (ctg * 16 + fr) * 40 + fq * 8), accG, 0, 0, 0);
            accY = __builtin_amdgcn_mfma_f32_16x16x32_bf16(va, ldsb8(NKT + (ctg * 16 + fr) * 40 + fq * 8), accY, 0, 0, 0);
#pragma unroll
            for (int i = 0; i < 4; ++i) Gm[(rt * 16 + fq * 4 + i) * 36 + ctg * 16 + fr] = -accG[i];
            if (q + 1 < NQ) { commit(); if (q + 2 < NQ) prefetch(q + 2); }
        }
        __syncthreads();
        if (wid >= 4) { if (q + 1 < NQ) do_shift(tid & (NT / 2 - 1), NT / 2); }
        else {
            const int v = wid * 16 + (lane >> 2), pq = lane & 3;
            const LAS float* grow = Gm + v * 36;
            f32x4 r0 = *(const LAS f32x4*)(grow + 4 * pq), r1 = *(const LAS f32x4*)(grow + 16 + 4 * pq);
            u32x2 ubo[TB / 4];
            const LAS float* abq = ABT + 4 * pq; asm volatile("" : "+v"(abq));
            f32x4 a0c[4], a1c[4];
            auto ldg = [&](int g, f32x4 (&aa0)[4], f32x4 (&aa1)[4]) __attribute__((always_inline)) {
#pragma unroll
                for (int x = 0; x < 4; ++x) { if (g < 4) aa0[x] = *(const LAS f32x4*)(abq + (4 * g + x) * 32); aa1[x] = *(const LAS f32x4*)(abq + (4 * g + x) * 32 + 16); } };
            ldg(0, a0c, a1c);
#pragma unroll
            for (int g = 0; g < TB / 4; ++g) {
                f32x4 a0n[4], a1n[4];
                if (g + 1 < TB / 4) ldg(g + 1, a0n, a1n);
                __builtin_amdgcn_sched_barrier(0);
                const f32x4 rr = g < 4 ? r0 : r1;
                f32x4 dg[3];
#pragma unroll
                for (int x = 0; x < 3; ++x) dg[x] = g < 4 ? a0c[x] : a1c[x];
                f32x4 u4;
                u4[0] = rr[0];
                u4[1] = __builtin_fmaf(-u4[0], dg[0][1], rr[1]);
                u4[2] = __builtin_fmaf(-u4[1], dg[1][2], __builtin_fmaf(-u4[0], dg[0][2], rr[2]));
                u4[3] = __builtin_fmaf(-u4[2], dg[2][3], __builtin_fmaf(-u4[1], dg[1][3], __builtin_fmaf(-u4[0], dg[0][3], rr[3])));
#pragma unroll
                for (int x = 0; x < 4; ++x) { const int ui = __float_as_int(u4[x]); int bi;
                    if ((g & 3) == 0) bi = __builtin_amdgcn_update_dpp(0, ui, 0x00, 0xF, 0xF, true); else if ((g & 3) == 1) bi = __builtin_amdgcn_update_dpp(0, ui, 0x55, 0xF, 0xF, true);
                    else if ((g & 3) == 2) bi = __builtin_amdgcn_update_dpp(0, ui, 0xAA, 0xF, 0xF, true); else bi = __builtin_amdgcn_update_dpp(0, ui, 0xFF, 0xF, 0xF, true);
                    u4[x] = __int_as_float(bi); }
                ubo[g].x = cvt_pk_bf16(u4[0], u4[1]); ubo[g].y = cvt_pk_bf16(u4[2], u4[3]);
                if (g < 3) {
                    f32x2 lo = r0.lo, hi = r0.hi;
#pragma unroll
                    for (int x = 0; x < 4; ++x) { const f32x2 ux = (f32x2){u4[x], u4[x]}; lo = lo - ux * a0c[x].lo; hi = hi - ux * a0c[x].hi; }
                    r0.lo = lo; r0.hi = hi; }
                if (g < 7) {
                    f32x2 lo = r1.lo, hi = r1.hi;
#pragma unroll
                    for (int x = 0; x < 4; ++x) { const f32x2 ux = (f32x2){u4[x], u4[x]}; lo = lo - ux * a1c[x].lo; hi = hi - ux * a1c[x].hi; }
                    r1.lo = lo; r1.hi = hi; }
                if (g + 1 < TB / 4) {
#pragma unroll
                    for (int x = 0; x < 4; ++x) { a0c[x] = a0n[x]; a1c[x] = a1n[x]; } }
            }
            if (pq == 0) {
#pragma unroll
                for (int g = 0; g < TB / 4; g += 2) { u32x4 w; w.x = ubo[g].x; w.y = ubo[g].y; w.z = ubo[g + 1].x; w.w = ubo[g + 1].y; *(LAS u32x4*)(UB + v * 40 + 4 * g) = w; } }
        }
        __syncthreads();
        {
            const bf16x8 ua = ldsb8(UB + (rt * 16 + fr) * 40 + fq * 8), va = ldsb8(VT + (rt * 16 + fr) * 40 + fq * 8);
            accY = __builtin_amdgcn_mfma_f32_16x16x32_bf16(ua, ldsb8(NBT + (ctg * 16 + fr) * 40 + fq * 8), accY, 0, 0, 0);
            *(LAS f32x4*)(YO + (ctg * 16 + fr) * 64 + rt * 16 + fq * 4) = accY;
#pragma unroll
            for (int cc = 0; cc < 2; ++cc) { const int ct = 2 * (wid & 1) + cc, kcol = ct * 16 + fr;
                f32x4 acc = Sreg[cc];
                acc = __builtin_amdgcn_mfma_f32_16x16x32_bf16(ua, ldsb8(BST + kcol * 40 + fq * 8), acc, 0, 0, 0);
                acc = __builtin_amdgcn_mfma_f32_16x16x32_bf16(va, ldsb8(KDST + kcol * 40 + fq * 8), acc, 0, 0, 0);
                const float g = GC[kcol];
#pragma unroll
                for (int i = 0; i < 4; ++i) acc[i] *= g;
                { const unsigned p0 = cvt_pk_bf16(acc[0], acc[1]), p1 = cvt_pk_bf16(acc[2], acc[3]); LAS bf16_t* sp = S0B + (rt * 16 + fq * 4) * 72 + kcol;
                  sp[0] = (bf16_t)p0; sp[72] = (bf16_t)(p0 >> 16); sp[144] = (bf16_t)p1; sp[216] = (bf16_t)(p1 >> 16); }
                Sreg[cc] = acc; }
        }
        if (q + 1 < NQ) lora_stage();
        __syncthreads();
        if (!isctx) {
            const int j = tid >> 4, c4 = (tid & 15) * 4, t = d == 0 ? j : TB - 1 - j; const f32x4 y = *(const LAS f32x4*)(YO + j * 64 + c4);
            u32x2 w; w.x = cvt_pk_bf16(y[0], y[1]); w.y = cvt_pk_bf16(y[2], y[3]);
            bf16_t* yb_ = p.Y + ((size_t)d * nlat + grow0) * RW + h * 64;
            *(u32x2*)(yb_ + t * RW + c4) = w;
            if (tid < TB) { const int tt = d == 0 ? tid : TB - 1 - tid; float* bb_ = p.bon + ((size_t)d * nlat + grow0) * NH + h; bb_[tt * NH] = bonr[tid]; }
        }
        if (q + 1 < NQ) scale_stage(bonn);
        __syncthreads();
    }
}
template <int MODE = 0>
__device__ __forceinline__ void rwkv_phase3(LAS unsigned char* lds, const In& in, const RwkvP p, int bid, int nblk) {
    const int nchain = 2 * p.nb * NH;
    for (int c = bid; c < nchain; c += nblk) { rwkv_chain3<MODE>(lds, in, p, c); __syncthreads(); }
}
}
}

namespace mk {
constexpr int LR_XT = 0;
constexpr int LR_XC = LR_XT + 67 * 64 * 2 + 64;
constexpr int LR_XCB = LR_XC + 64 * 64 * 4;
constexpr int LR_GWT = LR_XCB + 64 * 72 * 2;
constexpr int LR_A = LR_GWT + 2 * 64 * 72 * 2;
constexpr int LR_BX = LR_A + 64 * 64 * 4;
constexpr int LR_HO = LR_BX + 64 * 64 * 4;
constexpr int LR_CST = LR_HO + 64 * 64 * 4;
constexpr int LR_SEGP = LR_CST + 8 * 64 * 4;
constexpr int LR_SEGH = LR_SEGP + 8 * 64 * 4;
constexpr int LR_HC = LR_SEGH + 8 * 64 * 4;
constexpr int LR_END = LR_HC + 64 * 4;
static_assert(LR_END <= LDS_BYTES && (LR_XC % 16) == 0, "lru LDS");

struct LruP { const bf16_t* z1; bf16_t* Hd; int b0, nb; };

__device__ __forceinline__ void lru_item(LAS unsigned char* lds, const In& in, const LruP p, int item) {
    const int tid = threadIdx.x, lane = tid & 63, wid = tid >> 6;
    const int d = item / (p.nb * LB), bl = (item / LB) % p.nb, n = item % LB;
    const int nlat = p.nb * SEQ;
    LAS bf16_t* XT = (LAS bf16_t*)(lds + LR_XT); LAS float* XC = (LAS float*)(lds + LR_XC); LAS bf16_t* XCB = (LAS bf16_t*)(lds + LR_XCB); LAS bf16_t* GWT = (LAS bf16_t*)(lds + LR_GWT);
    LAS float *A_ = (LAS float*)(lds + LR_A), *BX = (LAS float*)(lds + LR_BX), *HO = (LAS float*)(lds + LR_HO), *CST = (LAS float*)(lds + LR_CST), *SEGP = (LAS float*)(lds + LR_SEGP), *SEGH = (LAS float*)(lds + LR_SEGH), *HC = (LAS float*)(lds + LR_HC);
    for (int i = tid; i < 2 * 64 * 64; i += NT) { const int g = i >> 12, j = (i >> 6) & 63, k = i & 63;
        GWT[(g * 64 + k) * 72 + j] = f2bf(in.lru_gate_w[((((size_t)d * 2 + g) * LB + n) * LBS + j) * LBS + k]); }
    for (int i = tid; i < 64; i += NT) { const int c = n * 64 + i;
        CST[i] = in.lru_conv_w[c]; CST[64 + i] = in.lru_conv_w[LW + c]; CST[128 + i] = in.lru_conv_w[2 * LW + c]; CST[192 + i] = in.lru_conv_w[3 * LW + c]; CST[256 + i] = in.lru_conv_b[c];
        CST[320 + i] = in.lru_gate_b[((d * 2 + 0) * LB + n) * LBS + i]; CST[384 + i] = in.lru_gate_b[((d * 2 + 1) * LB + n) * LBS + i]; CST[448 + i] = softplusf_(-in.lru_l[d * LW + c]); }
    constexpr int NSEG = CTX / 64 + GW, NSC = CTX / 64;
    u32x4 pre[2];
    auto tok_row = [&](int sidx, int rr, bool& ok) -> size_t {
        if (sidx < NSC) { const int t = sidx * 64 + rr - 2; ok = t >= 0 && t < CTX; return (size_t)nlat + (size_t)bl * CTX + t; }
        const int col = sidx - NSC, row = rr - 2; ok = row >= 0 && row < ROWS; return (size_t)bl * SEQ + (size_t)row * GW + col;
    };
    auto seg_of = [&](int q) { if (q < NSC) return d == 0 ? q : NSC - 1 - q; const int ql = q - NSC; return NSC + (d == 0 ? ql : GW - 1 - ql); };
    auto prefetch = [&](int q) { const int sidx = seg_of(q);
#pragma unroll
        for (int k = 0; k < 2; ++k) { const int i = tid + k * NT; u32x4 v = (u32x4){0u, 0u, 0u, 0u};
            if (i < 67 * 8) { const int rr = i >> 3, part = i & 7; bool ok; const size_t gr = tok_row(sidx, rr, ok); if (ok) v = *(const u32x4*)(p.z1 + gr * Z1_N + Z1_LX + n * 64 + part * 8); }
            pre[k] = v; } };
    auto commit = [&]() {
#pragma unroll
        for (int k = 0; k < 2; ++k) { const int i = tid + k * NT; if (i < 67 * 8) *(LAS u32x4*)(XT + (i >> 3) * 64 + (i & 7) * 8) = pre[k]; } };
    if (tid < 64) HC[tid] = 0.f;
    auto conv = [&]() __attribute__((always_inline)) {
        const int t = tid >> 3, c0 = (tid & 7) * 8; f32x2 s[4];
        { const f32x4 b0 = *(const LAS f32x4*)(CST + 256 + c0), b1 = *(const LAS f32x4*)(CST + 256 + c0 + 4); s[0] = b0.lo; s[1] = b0.hi; s[2] = b1.lo; s[3] = b1.hi; }
#pragma unroll
        for (int tap = 0; tap < 4; ++tap) { const u32x4 x = *(const LAS u32x4*)(XT + (t + tap) * 64 + c0);
            const f32x4 w0 = *(const LAS f32x4*)(CST + tap * 64 + c0), w1 = *(const LAS f32x4*)(CST + tap * 64 + c0 + 4);
            f32x2 v; v.x = bflo(x[0]); v.y = bfhi(x[0]); s[0] = w0.lo * v + s[0]; v.x = bflo(x[1]); v.y = bfhi(x[1]); s[1] = w0.hi * v + s[1];
            v.x = bflo(x[2]); v.y = bfhi(x[2]); s[2] = w1.lo * v + s[2]; v.x = bflo(x[3]); v.y = bfhi(x[3]); s[3] = w1.hi * v + s[3]; }
        *(LAS f32x4*)(XC + t * 64 + c0) = (f32x4){s[0].x, s[0].y, s[1].x, s[1].y}; *(LAS f32x4*)(XC + t * 64 + c0 + 4) = (f32x4){s[2].x, s[2].y, s[3].x, s[3].y};
        u32x4 w; w.x = cvt_pk_bf16(s[0].x, s[0].y); w.y = cvt_pk_bf16(s[1].x, s[1].y); w.z = cvt_pk_bf16(s[2].x, s[2].y); w.w = cvt_pk_bf16(s[3].x, s[3].y); *(LAS u32x4*)(XCB + t * 72 + c0) = w; };
    auto output = [&](int sidx) __attribute__((always_inline)) {
        if (sidx >= NSC) { const int col = sidx - NSC, t = tid >> 3, c0 = (tid & 7) * 8;
            const f32x4 x = *(const LAS f32x4*)(HO + t * 64 + c0), y = *(const LAS f32x4*)(HO + t * 64 + c0 + 4);
            *(u32x4*)(p.Hd + ((size_t)d * nlat + (size_t)bl * SEQ + (size_t)t * GW + col) * LW + n * 64 + c0) = pack8(x, y); } };
    prefetch(0);
    commit();
    __syncthreads();
    if (1 < NSEG) prefetch(1);
    conv();
    __syncthreads();
    float hlast = 0.f;
    for (int q = 0; q < NSEG; ++q) {
        { const int rt = wid >> 1, fr = lane & 15, fq = lane >> 4;
          bf16x8 a[2];
#pragma unroll
          for (int ks = 0; ks < 2; ++ks) a[ks] = *(const LAS bf16x8*)(XCB + (rt * 16 + fr) * 72 + ks * 32 + fq * 8);
#pragma unroll
          for (int cc = 0; cc < 2; ++cc) { const int ct = 2 * (wid & 1) + cc, col = ct * 16 + fr;
              f32x4 acc0 = (f32x4){0.f, 0.f, 0.f, 0.f}, acc1 = acc0;
#pragma unroll
              for (int ks = 0; ks < 2; ++ks) {
                  const bf16x8 b0 = *(const LAS bf16x8*)(GWT + (0 * 64 + col) * 72 + ks * 32 + fq * 8), b1 = *(const LAS bf16x8*)(GWT + (1 * 64 + col) * 72 + ks * 32 + fq * 8);
                  acc0 = __builtin_amdgcn_mfma_f32_16x16x32_bf16(a[ks], b0, acc0, 0, 0, 0); acc1 = __builtin_amdgcn_mfma_f32_16x16x32_bf16(a[ks], b1, acc1, 0, 0, 0); }
              constexpr float L2E = 1.4426950408889634f;
              const float g0s = -L2E * CST[320 + col], g1s = -L2E * CST[384 + col], sp8l = -8.f * L2E * CST[448 + col];
#pragma unroll
              for (int i = 0; i < 4; ++i) { const int t = rt * 16 + fq * 4 + i;
                  const float rec = fast_rcp(1.f + __builtin_amdgcn_exp2f(__builtin_fmaf(acc0[i], -L2E, g0s))), ib = 1.f + __builtin_amdgcn_exp2f(__builtin_fmaf(acc1[i], -L2E, g1s));
                  const float av = __builtin_amdgcn_exp2f(sp8l * rec), om = __builtin_fmaf(-av, av, 1.f);
                  A_[t * 64 + col] = av; BX[t * 64 + col] = om * __builtin_amdgcn_rsqf(fmaxf(om * ib * ib, 1e-30f)) * XC[t * 64 + col]; } } }
        if (q + 1 < NSEG) commit();
        if (q > 0) { output(seg_of(q - 1)); if ((tid >> 6) == 7) HC[tid & 63] = hlast; }
        __syncthreads();
        const int ch = tid & 63, pc = tid >> 6; float av[8], bv[8];
        { float P = 1.f, H = 0.f;
#pragma unroll
          for (int x = 0; x < 8; ++x) { const int st = pc * 8 + x, t = d == 0 ? st : 63 - st; av[x] = A_[t * 64 + ch]; bv[x] = BX[t * 64 + ch]; H = av[x] * H + bv[x]; P *= av[x]; }
          SEGP[pc * 64 + ch] = P; SEGH[pc * 64 + ch] = H; }
        if (q + 1 < NSEG) { if (q + 2 < NSEG) prefetch(q + 2); conv(); }
        __syncthreads();
        { float h = HC[ch];
#pragma unroll
          for (int q2 = 0; q2 < 7; ++q2) if (q2 < pc) h = SEGP[q2 * 64 + ch] * h + SEGH[q2 * 64 + ch];
#pragma unroll
          for (int x = 0; x < 8; ++x) { const int st = pc * 8 + x, t = d == 0 ? st : 63 - st; h = av[x] * h + bv[x]; HO[t * 64 + ch] = h; }
          hlast = h; }
        __syncthreads();
    }
    output(seg_of(NSEG - 1));
}
__device__ __forceinline__ void lru_phase(LAS unsigned char* lds, const In& in, const LruP p, int bid, int nblk) {
    const int nitem = 2 * p.nb * LB;
    for (int it = bid; it < nitem; it += nblk) { lru_item(lds, in, p, it); __syncthreads(); }
}
}

namespace mk {
#define MK_DPPX(x, ctrl) __int_as_float(__builtin_amdgcn_update_dpp(__float_as_int(x), __float_as_int(x), ctrl, 0xF, 0xF, false))
__device__ __forceinline__ float allreduce4(float x) { x += MK_DPPX(x, 0xB1); x += MK_DPPX(x, 0x4E); return x; }
__device__ __forceinline__ void unpack8(const u32x4 w, float (&f)[8]) {
#pragma unroll
    for (int j = 0; j < 4; ++j) { f[2 * j] = bflo(w[j]); f[2 * j + 1] = bfhi(w[j]); } }
constexpr int AG_K = 256;
struct PostP { const bf16_t* z1; bf16_t* Y; const float* bon; bf16_t* Ag; int nlat; int pad_; };
__device__ __forceinline__ void rwkv_post_rows(LAS float* cst  , const In& in, const PostP p, int row_lo, int row_hi, bool dry = false) {
    const int lane = threadIdx.x & 63, wid = threadIdx.x >> 6, c0 = lane * 16, h = lane >> 2;
    float mg0[8], mg1[8];
    for (int i = threadIdx.x; i < RW; i += NT) { cst[i] = in.shift_mu[OFF_V + i]; cst[RW + i] = in.shift_mu[RC + OFF_V + i]; cst[2 * RW + i] = in.rw_lnx[i]; cst[3 * RW + i] = in.rw_lnx[RW + i]; }
    __syncthreads();
#pragma unroll
    for (int j = 0; j < 8; ++j) { const int c = OFF_GD + (lane < GL / 8 ? lane : 0) * 8 + j; mg0[j] = in.shift_mu[c]; mg1[j] = in.shift_mu[RC + c]; }
    struct Raw { u32x4 y00, y01, y10, y11, zx[2], zp[2], zn[2]; float b0, b1; };
    const u32x4 Z4 = (u32x4){0u, 0u, 0u, 0u};
    auto load_row = [&](int r, Raw& w) __attribute__((always_inline)) {
        const int cg = r % GW; const bool hp = cg > 0, hn = cg < GW - 1;
        const bf16_t* y0p = p.Y + (size_t)r * RW + c0; const bf16_t* y1p = p.Y + ((size_t)p.nlat + r) * RW + c0;
        w.y00 = *(const u32x4*)y0p; w.y01 = *(const u32x4*)(y0p + 8); w.y10 = *(const u32x4*)y1p; w.y11 = *(const u32x4*)(y1p + 8);
        w.b0 = p.bon[(size_t)r * NH + h]; w.b1 = p.bon[((size_t)p.nlat + r) * NH + h];
        const bf16_t* zr = p.z1 + (size_t)r * Z1_N;
#pragma unroll
        for (int half = 0; half < 2; ++half) { const int c = OFF_V + c0 + half * 8;
            w.zx[half] = *(const u32x4*)(zr + c); w.zp[half] = Z4; w.zn[half] = Z4;
            if (hp) w.zp[half] = *(const u32x4*)(zr - Z1_N + c);
            if (hn) w.zn[half] = *(const u32x4*)(zr + Z1_N + c); }
    };
    auto compute_row = [&](int r, const Raw& w) __attribute__((always_inline)) {
        bf16_t* y0p = p.Y + (size_t)r * RW + c0;
        float y[16], t8[8];
        unpack8(w.y00, t8);
#pragma unroll
        for (int j = 0; j < 8; ++j) y[j] = t8[j];
        unpack8(w.y01, t8);
#pragma unroll
        for (int j = 0; j < 8; ++j) y[8 + j] = t8[j];
        unpack8(w.y10, t8);
#pragma unroll
        for (int j = 0; j < 8; ++j) y[j] += t8[j];
        unpack8(w.y11, t8);
#pragma unroll
        for (int j = 0; j < 8; ++j) y[8 + j] += t8[j];
        float s = 0.f;
#pragma unroll
        for (int j = 0; j < 16; ++j) s += y[j];
        const float mu = allreduce4(s) * (1.f / 64.f); float q = 0.f;
#pragma unroll
        for (int j = 0; j < 16; ++j) { const float dlt = y[j] - mu; q += dlt * dlt; }
        const float rs = __builtin_amdgcn_rsqf(allreduce4(q) * (1.f / 64.f) + LNX_EPS);
        const float bonus = w.b0 + w.b1;
#pragma unroll
        for (int half = 0; half < 2; ++half) {
            float xv[8], pv[8], nv[8]; unpack8(w.zx[half], xv); unpack8(w.zp[half], pv); unpack8(w.zn[half], nv);
            float m0_[8], m1_[8], g0_[8], g1_[8];
            { const LAS float* cb = cst + c0 + half * 8; const f32x4 a0 = *(const LAS f32x4*)cb, a1 = *(const LAS f32x4*)(cb + 4), b0 = *(const LAS f32x4*)(cb + RW), b1 = *(const LAS f32x4*)(cb + RW + 4),
                  e0 = *(const LAS f32x4*)(cb + 2 * RW), e1 = *(const LAS f32x4*)(cb + 2 * RW + 4), f0 = *(const LAS f32x4*)(cb + 3 * RW), f1 = *(const LAS f32x4*)(cb + 3 * RW + 4);
#pragma unroll
              for (int j = 0; j < 4; ++j) { m0_[j] = a0[j]; m0_[4 + j] = a1[j]; m1_[j] = b0[j]; m1_[4 + j] = b1[j]; g0_[j] = e0[j]; g0_[4 + j] = e1[j]; g1_[j] = f0[j]; g1_[4 + j] = f1[j]; } }
            float o[8];
#pragma unroll
            for (int j = 0; j < 8; ++j) { const int cj = half * 8 + j; const float v = xv[j] + m0_[j] * (pv[j] - xv[j]) + m1_[j] * (nv[j] - xv[j]);
                o[j] = (y[cj] - mu) * rs * g0_[j] + g1_[j] + bonus * v; }
            u32x4 wv; wv.x = cvt_pk_bf16(o[0], o[1]); wv.y = cvt_pk_bf16(o[2], o[3]); wv.z = cvt_pk_bf16(o[4], o[5]); wv.w = cvt_pk_bf16(o[6], o[7]); if (!dry) *(u32x4*)(y0p + half * 8) = wv; else if (wv.x == 0x12345678u) *(u32x4*)(y0p + half * 8) = wv;
        }
        if (lane < 32) { u32x4 wv = Z4;
            if (lane < GL / 8) { const int cg = r % GW; const bool hp = cg > 0, hn = cg < GW - 1; const bf16_t* zr = p.z1 + (size_t)r * Z1_N; const int c = OFF_GD + lane * 8;
                u32x4 gx = *(const u32x4*)(zr + c), gp = Z4, gn = Z4; if (hp) gp = *(const u32x4*)(zr - Z1_N + c); if (hn) gn = *(const u32x4*)(zr + Z1_N + c);
                float xv[8], pv[8], nv[8]; unpack8(gx, xv); unpack8(gp, pv); unpack8(gn, nv);
                float o[8];
#pragma unroll
                for (int j = 0; j < 8; ++j) o[j] = fast_sigmoid(xv[j] + mg0[j] * (pv[j] - xv[j]) + mg1[j] * (nv[j] - xv[j]));
                wv.x = cvt_pk_bf16(o[0], o[1]); wv.y = cvt_pk_bf16(o[2], o[3]); wv.z = cvt_pk_bf16(o[4], o[5]); wv.w = cvt_pk_bf16(o[6], o[7]); }
            *(u32x4*)(p.Ag + (size_t)r * AG_K + lane * 8) = wv; }
    };
    constexpr int RS_ = NT / 64;
    Raw A, B;
    int r = row_lo + wid;
    if (r < row_hi) load_row(r, A);
    for (; r < row_hi; r += 2 * RS_) {
        if (r + RS_ < row_hi) load_row(r + RS_, B);
        compute_row(r, A);
        if (r + 2 * RS_ < row_hi) load_row(r + 2 * RS_, A);
        if (r + RS_ < row_hi) compute_row(r + RS_, B);
    }
}
#define MK_FR_ROW(f) ((((f) >> 3) * HALF) + wr * 64 + ((((f) >> 1) & 3) * 16) + fr)
#define MK_FR_COL(f) ((((f) & 1) * HALF) + wc * 32 + 8 * fq)
#define MK_FR_ACC(f, n) acc[(f) >> 3][(f) & 1][((f) >> 1) & 3][n]
#define MK_FENCE asm volatile("" ::: "memory")
struct EpiYa { static constexpr int NS = 16; const bf16_t* yn; bf16_t* ya;
    __device__ __forceinline__ bool operator()(f32x4 (&acc)[2][2][4][2], const Unit& u, int wr, int wc, int fr, int fq) const {
        const size_t base = (size_t)(u.pm * BM) * RW + u.pn * BM;
        u32x4 cur = *(const u32x4*)(yn + base + (size_t)MK_FR_ROW(0) * RW + MK_FR_COL(0));
#pragma unroll
        for (int f = 0; f < 16; ++f) { u32x4 nxt = cur; if (f + 1 < 16) nxt = *(const u32x4*)(yn + base + (size_t)MK_FR_ROW(f + 1) * RW + MK_FR_COL(f + 1));
            MK_FENCE; float v[8]; unpack8(cur, v); f32x4 a = MK_FR_ACC(f, 0), b = MK_FR_ACC(f, 1);
#pragma unroll
            for (int j = 0; j < 4; ++j) { a[j] *= v[j]; b[j] *= v[4 + j]; }
            *(u32x4*)(ya + base + (size_t)MK_FR_ROW(f) * RW + MK_FR_COL(f)) = pack8(a, b); MK_FENCE; cur = nxt; }
        return false; } };
struct EpiZc { static constexpr int NS = 16; const bf16_t* Hd; bf16_t* yb; bf16_t* gates; int nlat; float sc;
    __device__ __forceinline__ bool operator()(f32x4 (&acc)[2][2][4][2], const Unit& u, int wr, int wc, int fr, int fq) const {
        if (u.pn < LW / BM) {
            MK_FRAG_LOOP(r, c) { const size_t o = (size_t)(u.pm * BM + r) * LW + u.pn * BM + c; float h0[8], h1[8]; unpack8(*(const u32x4*)(Hd + o), h0); unpack8(*(const u32x4*)(Hd + (size_t)nlat * LW + o), h1);
                f32x4 a = acc[ai][bj][m][0] * sc, b = acc[ai][bj][m][1] * sc;
#pragma unroll
                for (int j = 0; j < 4; ++j) { a[j] = fast_gelu_tanh(a[j]) * (h0[j] + h1[j]); b[j] = fast_gelu_tanh(b[j]) * (h0[4 + j] + h1[4 + j]); }
                *(u32x4*)(yb + o) = pack8(a, b); asm volatile("" ::: "memory"); }
        } else {
            MK_FRAG_LOOP(r, c) { const size_t o = (size_t)(u.pm * BM + r) * (2 * D) + (u.pn * BM - LW) + c;
                f32x4 a = acc[ai][bj][m][0] * sc, b = acc[ai][bj][m][1] * sc;
#pragma unroll
                for (int j = 0; j < 4; ++j) { a[j] = fast_sigmoid(a[j]); b[j] = fast_sigmoid(b[j]); }
                *(u32x4*)(gates + o) = pack8(a, b); }
        }
        return false; } };
struct PairOrder { StaticOrder S;
    __device__ bool next(int i, Unit& u) const { if (!S.next(i >> 1, u)) return false; u.e = i & 1; return true; } };
struct EpiBranch { const bf16_t* gates; bf16_t* mixed;
    __device__ __forceinline__ bool operator()(f32x4 (&acc)[2][2][4][2], const Unit& u, int wr, int wc, int fr, int fq) const {
        const size_t gbase = (size_t)(u.pm * BM) * (2 * D) + u.pn * BM, mbase = (size_t)(u.pm * BM) * D + u.pn * BM;
        u32x4 c1 = (u32x4){0u, 0u, 0u, 0u}, c2 = *(const u32x4*)(gates + gbase + (size_t)MK_FR_ROW(0) * (2 * D) + D + MK_FR_COL(0));
        if (u.e == 0) c1 = *(const u32x4*)(gates + gbase + (size_t)MK_FR_ROW(0) * (2 * D) + MK_FR_COL(0));
#pragma unroll
        for (int f = 0; f < 16; ++f) { u32x4 n1 = c1, n2 = c2;
            if (f + 1 < 16) { const size_t o = gbase + (size_t)MK_FR_ROW(f + 1) * (2 * D) + MK_FR_COL(f + 1); n2 = *(const u32x4*)(gates + o + D); if (u.e == 0) n1 = *(const u32x4*)(gates + o); }
            MK_FENCE; float g1[8], g2[8]; unpack8(c1, g1); unpack8(c2, g2);
            if (u.e == 0) {
#pragma unroll
                for (int j = 0; j < 4; ++j) { MK_FR_ACC(f, 0)[j] *= g1[j] / g2[j]; MK_FR_ACC(f, 1)[j] *= g1[4 + j] / g2[4 + j]; }
            } else { f32x4 a = MK_FR_ACC(f, 0), b = MK_FR_ACC(f, 1);
#pragma unroll
                for (int j = 0; j < 4; ++j) { a[j] *= g2[j]; b[j] *= g2[4 + j]; }
                *(u32x4*)(mixed + mbase + (size_t)MK_FR_ROW(f) * D + MK_FR_COL(f)) = pack8(a, b); }
            MK_FENCE; c1 = n1; c2 = n2; }
        __builtin_amdgcn_s_waitcnt(0x0F70);
        return u.e == 0; } };
struct EpiF32 { float* C; long ldc;
    __device__ __forceinline__ bool operator()(f32x4 (&acc)[2][2][4][2], const Unit& u, int wr, int wc, int fr, int fq) const {
        MK_FRAG_LOOP(r, c) { float* o = C + (size_t)(u.pm * BM + r) * ldc + u.pn * BM + c; *(f32x4*)o = acc[ai][bj][m][0]; *(f32x4*)(o + 4) = acc[ai][bj][m][1]; }
        return false; } };
}

namespace mk {
constexpr int NEX = NE + 1;
constexpr int SLOTS_PER_TOK = TOPK + 1;
constexpr int RP_MOD = 0;
constexpr int RP_UH = RP_MOD + 3 * D * 4;
constexpr int RP_UL = RP_UH + 16 * (D + 8) * 2;
constexpr int RP_PART = RP_UL + 16 * (D + 8) * 2;
constexpr int RP_LOG = RP_PART + 8 * 16 * 64 * 4;
constexpr int RP_HIST = RP_LOG + 16 * 64 * 4;
constexpr int RP_END = RP_HIST + 64 * 4;
static_assert(RP_END <= LDS_BYTES, "rowpass LDS");

constexpr float FP8_SR = 64.f;
constexpr float FP8_SA = 8.f, FP8_SWD = 256.f;
constexpr float FP8_SU = 16.f, FP8_SW = 256.f;
struct RowP { float* y2h1; bf16_t* u; unsigned char* u8; const float* modpart; const bf16_t* rwt;
              int* tope; float* gatev; int* lrank; int* blkcnt; int b0, nlat; };
__device__ __forceinline__ float wave_max(float x) { return wave_max64(x); }
__device__ __forceinline__ void row_pass(LAS unsigned char* lds, const In& in, const RowP p, int row_lo, int row_hi, bool dry = false) {
    const int tid = threadIdx.x, lane = tid & 63, wid = tid >> 6;
    LAS float* MOD = (LAS float*)(lds + RP_MOD); LAS bf16_t* UH = (LAS bf16_t*)(lds + RP_UH); LAS bf16_t* UL = (LAS bf16_t*)(lds + RP_UL);
    LAS float* PART = (LAS float*)(lds + RP_PART); LAS float* LOG = (LAS float*)(lds + RP_LOG); LAS int* HIST = (LAS int*)(lds + RP_HIST);
    const int mr = p.b0 + row_lo / SEQ;
    for (int j = tid; j < 3 * D; j += NT) MOD[j] = mod_value(in, p.modpart, mr, 2 * D + j);
    if (tid < 64) HIST[tid] = 0;
    __syncthreads();
    float gp1[16], gp2[16];
#pragma unroll
    for (int j = 0; j < 4; ++j)
#pragma unroll
        for (int q = 0; q < 4; ++q) { gp1[4 * j + q] = in.norm_g[D + j * 256 + lane * 4 + q]; gp2[4 * j + q] = in.norm_g[2 * D + j * 256 + lane * 4 + q]; }
    u32x2 py[2][4]; f32x4 px[2][4];
    auto fetch = [&](int r16) __attribute__((always_inline)) {
#pragma unroll
        for (int rr = 0; rr < 2; ++rr) { const int r = r16 + wid * 2 + rr;
#pragma unroll
            for (int j = 0; j < 4; ++j) { py[rr][j] = *(const u32x2*)(p.u + (size_t)r * D + j * 256 + lane * 4); px[rr][j] = *(const f32x4*)(in.x + ((size_t)p.b0 * SEQ + r) * D + j * 256 + lane * 4); } } };
    fetch(row_lo);
    for (int r16 = row_lo; r16 < row_hi; r16 += 16) {
#pragma unroll
        for (int rr = 0; rr < 2; ++rr) {
            const int lr = wid * 2 + rr, r = r16 + lr;
            float* yp = p.y2h1 + (size_t)r * D;
            f32x4 v[4]; float ss = 0.f;
#pragma unroll
            for (int j = 0; j < 4; ++j) { const u32x2 yw = py[rr][j];
                v[j] = (f32x4){bflo(yw.x), bfhi(yw.x), bflo(yw.y), bfhi(yw.y)}; ss += v[j][0] * v[j][0] + v[j][1] * v[j][1] + v[j][2] * v[j][2] + v[j][3] * v[j][3]; }
#pragma unroll
            for (int o_ = 0; o_ < 1; ++o_) ss = wave_sum64(ss);
            const float rinv = __builtin_amdgcn_rsqf(ss * (1.f / D) + NORM_EPS); float s2 = 0.f;
#pragma unroll
            for (int j = 0; j < 4; ++j) { const int c = j * 256 + lane * 4; const f32x4 xv = px[rr][j];
#pragma unroll
                for (int q = 0; q < 4; ++q) { const float hv = xv[q] + MOD[c + q] * (v[j][q] * rinv * gp1[4 * j + q]); v[j][q] = hv; s2 += hv * hv; }
                if (!dry) *(f32x4*)(yp + c) = v[j]; }
#pragma unroll
            for (int o_ = 0; o_ < 1; ++o_) s2 = wave_sum64(s2);
            const float r2 = __builtin_amdgcn_rsqf(s2 * (1.f / D) + NORM_EPS);
#pragma unroll
            for (int j = 0; j < 4; ++j) { const int c = j * 256 + lane * 4; float uu[4], lo[4]; unsigned hw[2];
#pragma unroll
                for (int q = 0; q < 4; ++q) uu[q] = (v[j][q] * r2 * gp2[4 * j + q]) * (1.f + MOD[2 * D + c + q]) + MOD[D + c + q];
                hw[0] = cvt_pk_bf16(uu[0], uu[1]); hw[1] = cvt_pk_bf16(uu[2], uu[3]);
                lo[0] = uu[0] - bflo(hw[0]); lo[1] = uu[1] - bfhi(hw[0]); lo[2] = uu[2] - bflo(hw[1]); lo[3] = uu[3] - bfhi(hw[1]);
                u32x2 w; w.x = hw[0]; w.y = hw[1]; *(unsigned*)(p.u8 + (size_t)r * D + c) = pack4_fp8(uu[0] * FP8_SU, uu[1] * FP8_SU, uu[2] * FP8_SU, uu[3] * FP8_SU); *(LAS u32x2*)(UH + lr * (D + 8) + c) = w;
                u32x2 wl; wl.x = cvt_pk_bf16(lo[0], lo[1]); wl.y = cvt_pk_bf16(lo[2], lo[3]); *(LAS u32x2*)(UL + lr * (D + 8) + c) = wl; }
        }
        __syncthreads();
        if (r16 + 16 < row_hi) fetch(r16 + 16);
        { const int fr = lane & 15, fq = lane >> 4;
          f32x4 acc[4];
#pragma unroll
          for (int ct = 0; ct < 4; ++ct) acc[ct] = (f32x4){0.f, 0.f, 0.f, 0.f};
#pragma unroll
          for (int ks = 0; ks < 4; ++ks) { const int k0 = wid * 128 + ks * 32 + fq * 8;
              const bf16x8 ah = *(const LAS bf16x8*)(UH + fr * (D + 8) + k0), al = *(const LAS bf16x8*)(UL + fr * (D + 8) + k0);
#pragma unroll
              for (int ct = 0; ct < 4; ++ct) { const bf16x8 bh = *(const bf16x8*)(p.rwt + (size_t)(ct * 16 + fr) * D + k0), bl = *(const bf16x8*)(p.rwt + (size_t)(NE + ct * 16 + fr) * D + k0);
                  acc[ct] = __builtin_amdgcn_mfma_f32_16x16x32_bf16(ah, bh, acc[ct], 0, 0, 0); acc[ct] = __builtin_amdgcn_mfma_f32_16x16x32_bf16(ah, bl, acc[ct], 0, 0, 0); acc[ct] = __builtin_amdgcn_mfma_f32_16x16x32_bf16(al, bh, acc[ct], 0, 0, 0); } }
#pragma unroll
          for (int ct = 0; ct < 4; ++ct)
#pragma unroll
              for (int i = 0; i < 4; ++i) PART[(wid * 16 + fq * 4 + i) * 64 + ct * 16 + fr] = acc[ct][i]; }
        __syncthreads();
        for (int i = tid; i < 16 * 64; i += NT) { float s = 0.f;
#pragma unroll
            for (int w = 0; w < 8; ++w) s += PART[w * 1024 + i];
            LOG[i] = s; }
        __syncthreads();
#pragma unroll 1
        for (int rr = 0; rr < 2; ++rr) {
            const int lr = wid * 2 + rr, r = r16 + lr;
            const float sc = sigmoidf_(LOG[lr * 64 + lane]), bi = sc + in.router_b[lane];
            float m1 = bi; m1 = fmaxf(m1, MK_DPPF(m1, 0xB1)); m1 = fmaxf(m1, MK_DPPF(m1, 0x4E)); m1 = fmaxf(m1, MK_DPPF(m1, 0x141));
            const unsigned long long eq = __ballot(bi == m1); const int first = __ffsll((long long)((eq >> (lane & ~7)) & 0xffull)) - 1 + (lane & ~7);
            float m2 = (lane == first) ? -1e30f : bi; m2 = fmaxf(m2, MK_DPPF(m2, 0xB1)); m2 = fmaxf(m2, MK_DPPF(m2, 0x4E)); m2 = fmaxf(m2, MK_DPPF(m2, 0x141));
            const float gs = m1 + m2; const int myg = lane >> 3; int rank = 0;
#pragma unroll
            for (int g = 0; g < NG; ++g) { const float og = __int_as_float(__builtin_amdgcn_readlane(__float_as_int(gs), g * 8)); rank += (og > gs || (og == gs && g < myg)) ? 1 : 0; }
            float cand = rank < TG ? bi : -1e30f; float tsum = 0.f; int myidx = 0; float mysc = 0.f;
#pragma unroll
            for (int it = 0; it < TOPK; ++it) { const float m = wave_max(cand); const unsigned long long bm = __ballot(cand == m); const int win = __builtin_amdgcn_readfirstlane(__ffsll((long long)bm) - 1);
                const float ws = __int_as_float(__builtin_amdgcn_readlane(__float_as_int(sc), win)); tsum += ws; if (lane == it) { myidx = win; mysc = ws; } if (lane == win) cand = -1e30f; }
            if (lane < TOPK) { const int rk = atomicAdd((int*)&HIST[myidx], 1);
                p.tope[(size_t)r * TOPK + lane] = myidx; p.gatev[(size_t)r * TOPK + lane] = mysc / tsum * 2.5f; p.lrank[(size_t)r * TOPK + lane] = rk; }
        }
        __syncthreads();
    }
    if (tid < 64) p.blkcnt[blockIdx.x * 64 + tid] = HIST[tid];
}

struct MoeP { const int* tope; const float* gatev; const int* lrank; const int* blkcnt;
              int* tilepre;
              int* list;
              int* sdst;
              float* sgate;
              int r0, nr, blk0, nbh, rpb, pad_; };
__device__ __forceinline__ void moe_assign(LAS unsigned char* lds, const MoeP p, int bid, int nblk) {
    LAS int* BASE = (LAS int*)lds; LAS int* CNT = BASE + 80; LAS int* BOFF = CNT + 80;
    const int tid = threadIdx.x;
    { LAS int* PC = BOFF + 80; const int e = tid & 63, part = tid >> 6, per = (p.nbh + 7) / 8; int c = 0, bo = 0;
#pragma unroll 4
      for (int b = part * per; b < (part + 1) * per && b < p.nbh; ++b) { const int v = p.blkcnt[(p.blk0 + b) * 64 + e]; if (p.blk0 + b < bid) bo += v; c += v; }
      PC[part * 64 + e] = c; PC[512 + part * 64 + e] = bo; }
    __syncthreads();
    if (tid < NE) { LAS int* PC = BOFF + 80; int c = 0, bo = 0;
#pragma unroll
        for (int q = 0; q < 8; ++q) { c += PC[q * 64 + tid]; bo += PC[512 + q * 64 + tid]; }
        CNT[tid] = c; BOFF[tid] = bo; }
    __syncthreads();
    if (tid == 0) { int s = 0; for (int e = 0; e < NE; ++e) { BASE[e] = s; s += (CNT[e] + BM - 1) / BM * BM; } BASE[NE] = s; CNT[NE] = p.nr; BASE[NE + 1] = s + p.nr;
        if (bid == 0) { for (int e = 0; e <= NEX; ++e) p.tilepre[e] = BASE[e] / BM; } }
    __syncthreads();
    if (bid >= p.blk0 && bid < p.blk0 + p.nbh) {
        const int rlo = p.r0 + (bid - p.blk0) * p.rpb;
        for (int i = tid; i < p.rpb * TOPK; i += NT) { const int r = rlo + i / TOPK, a = r * TOPK + i % TOPK, e = p.tope[a]; const int slot = BASE[e] + BOFF[e] + p.lrank[a];
            p.list[slot] = r; p.sdst[slot] = (r - p.r0) * SLOTS_PER_TOK + i % TOPK; p.sgate[slot] = p.gatev[a]; }
        for (int i = tid; i < p.rpb; i += NT) { const int r = rlo + i, slot = BASE[NE] + (r - p.r0); p.list[slot] = r; p.sdst[slot] = (r - p.r0) * SLOTS_PER_TOK + TOPK; p.sgate[slot] = 1.f; }
    }
    for (int e = bid; e < NE; e += nblk) { const int lo = BASE[e] + CNT[e], hi = BASE[e + 1]; for (int s = lo + tid; s < hi; s += NT) { p.list[s] = p.r0; p.sdst[s] = -1; p.sgate[s] = 0.f; } }
}
struct GroupOrder { int tpn, total, nN, G, c;
    __device__ void init(const int* tilepre, int nN_, int G_, int c_) { const int lane = threadIdx.x & 63;
        tpn = (int)__hip_atomic_load((const unsigned*)tilepre + lane + 1, __ATOMIC_RELAXED, __HIP_MEMORY_SCOPE_AGENT);
        total = (int)__hip_atomic_load((const unsigned*)tilepre + NEX, __ATOMIC_RELAXED, __HIP_MEMORY_SCOPE_AGENT); nN = nN_; G = G_; c = c_; }
    __device__ bool next(int i, Unit& u) const { const long L = (long)i * G + c; if (L >= (long)total * nN) return false;
        const int T = (int)(L / nN); const int e = __popcll(__ballot(tpn <= T));
        u.pm = T; u.pn = (int)(L % nN); u.e = __builtin_amdgcn_readfirstlane(e); return true; } };
struct EpiGU { static constexpr int NS = 16; bf16_t* act;
    __device__ __forceinline__ bool operator()(f32x4 (&acc)[2][2][4][2], const Unit& u, int wr, int wc, int fr, int fq) const {
        MK_FRAG_LOOP(r, c) { const f32x4 a = acc[ai][bj][m][0] * (1.f / (FP8_SU * FP8_SW)), b = acc[ai][bj][m][1] * (1.f / (FP8_SU * FP8_SW));
            *(unsigned*)((unsigned char*)act + (size_t)(u.pm * BM + r) * EF + ((u.pn * BM + c) >> 1)) =
                pack4_fp8(fast_silu(a[0]) * a[1] * FP8_SA, fast_silu(a[2]) * a[3] * FP8_SA, fast_silu(b[0]) * b[1] * FP8_SA, fast_silu(b[2]) * b[3] * FP8_SA); }
        return false; } };
struct EpiDown { const int* sdst; const float* sgate; bf16_t* rowsb; LAS unsigned char* lds;
    __device__ __forceinline__ void unit_begin(const Unit& u, LAS unsigned char* l) const {
        const int wid = __builtin_amdgcn_readfirstlane(threadIdx.x >> 6), lane = threadIdx.x & 63, w4 = wid & 3;
        const unsigned* src = (wid < 4 ? (const unsigned*)sdst : (const unsigned*)sgate) + (size_t)u.pm * BM + w4 * 64 + lane;
        __builtin_amdgcn_global_load_lds(src, (LAS unsigned*)(l + STAGE_BYTES + (wid < 4 ? 0 : 1024) + w4 * 256), 4, 0, 0); }
    __device__ __forceinline__ bool operator()(f32x4 (&acc)[2][2][4][2], const Unit& u, int wr, int wc, int fr, int fq) const {
        int dst[8]; float gt[8];
        const LAS int* LD = (const LAS int*)(lds + STAGE_BYTES); const LAS float* LG = (const LAS float*)(lds + STAGE_BYTES + 1024);
#pragma unroll
        for (int q = 0; q < 8; ++q) { const int sl = (q >> 2) * HALF + wr * 64 + (q & 3) * 16 + fr; dst[q] = LD[sl]; gt[q] = LG[sl]; }
#pragma unroll
        for (int ai = 0; ai < 2; ++ai)
#pragma unroll
            for (int m = 0; m < 4; ++m) { const int q = ai * 4 + m; const int dq = dst[q]; if (dq >= 0) {
#pragma unroll
                for (int bj = 0; bj < 2; ++bj) { f32x4 a = acc[ai][bj][m][0], b = acc[ai][bj][m][1];
#pragma unroll
                    for (int j = 0; j < 4; ++j) { a[j] *= gt[q] * (FP8_SR / (FP8_SA * FP8_SWD)); b[j] *= gt[q] * (FP8_SR / (FP8_SA * FP8_SWD)); }
                    u32x2 w8; w8.x = pack4_fp8(a[0], a[1], a[2], a[3]); w8.y = pack4_fp8(b[0], b[1], b[2], b[3]);
                    *(u32x2*)((unsigned char*)rowsb + (size_t)dq * D + u.pn * BM + bj * HALF + wc * 32 + 8 * fq) = w8; } } }
        return false; } };
__device__ __forceinline__ void final_rows(LAS float* sm  , const In& in, const float* modpart, const bf16_t* rowsb, float* h1out, int b0, int r0, int row_lo, int row_hi, bool dry = false) {
    const int tid = threadIdx.x, lane = tid & 63, wid = tid >> 6;
    const int mr = b0 + row_lo / SEQ;
    __syncthreads();
    for (int j = tid; j < D; j += NT) sm[j] = mod_value(in, modpart, mr, 5 * D + j);
    __syncthreads();
    float gq[16];
#pragma unroll
    for (int j = 0; j < 4; ++j)
#pragma unroll
        for (int q = 0; q < 4; ++q) gq[4 * j + q] = sm[j * 256 + lane * 4 + q] * in.norm_g[3 * D + j * 256 + lane * 4 + q];
    unsigned raw[SLOTS_PER_TOK][4]; f32x4 hraw[4];
    auto fetch = [&](int r) __attribute__((always_inline)) {
        const unsigned char* rb = (const unsigned char*)rowsb + (size_t)(r - r0) * SLOTS_PER_TOK * D; const float* hp = h1out + (size_t)r * D;
#pragma unroll
        for (int s = 0; s < SLOTS_PER_TOK; ++s)
#pragma unroll
            for (int j = 0; j < 4; ++j) raw[s][j] = *(const unsigned*)(rb + (size_t)s * D + j * 256 + lane * 4);
#pragma unroll
        for (int j = 0; j < 4; ++j) hraw[j] = *(const f32x4*)(hp + j * 256 + lane * 4); };
    if (row_lo + wid < row_hi) fetch(row_lo + wid);
    for (int r = row_lo + wid; r < row_hi; r += NT / 64) {
        float v[16];
#pragma unroll
        for (int j = 0; j < 16; ++j) v[j] = 0.f;
#pragma unroll
        for (int s = 0; s < SLOTS_PER_TOK; ++s)
#pragma unroll
            for (int j = 0; j < 4; ++j) { const int w = (int)raw[s][j]; const f32x2 lo = __builtin_amdgcn_cvt_pk_f32_fp8(w, false), hi = __builtin_amdgcn_cvt_pk_f32_fp8(w, true); v[4 * j] += lo.x; v[4 * j + 1] += lo.y; v[4 * j + 2] += hi.x; v[4 * j + 3] += hi.y; }
#pragma unroll
        for (int j = 0; j < 16; ++j) v[j] *= (1.f / FP8_SR);
        f32x4 hcur[4];
#pragma unroll
        for (int j = 0; j < 4; ++j) hcur[j] = hraw[j];
        if (r + NT / 64 < row_hi) fetch(r + NT / 64);
        float ss = 0.f;
#pragma unroll
        for (int j = 0; j < 16; ++j) ss += v[j] * v[j];
        ss = wave_sum64(ss);
        const float rinv = __builtin_amdgcn_rsqf(ss * (1.f / D) + NORM_EPS);
        float* hp = h1out + (size_t)r * D;
#pragma unroll
        for (int j = 0; j < 4; ++j) { const int c = j * 256 + lane * 4; f32x4 hv = hcur[j];
#pragma unroll
            for (int q = 0; q < 4; ++q) hv[q] += gq[4 * j + q] * (v[4 * j + q] * rinv);
            if (!dry) *(f32x4*)(hp + c) = hv; else if (hv[0] == 1.2345e30f) *(f32x4*)(hp + c) = hv; }
    }
}
__device__ __forceinline__ void rwt_prep(const In& in, bf16_t* rwt, int bid, int nblk) {
    for (int i = bid * NT + threadIdx.x; i < NE * D; i += nblk * NT) { const int e = i / D, k = i % D; const float w = in.router_w[(size_t)k * NE + e]; const bf16_t h = f2bf(w); rwt[i] = h; rwt[(size_t)NE * D + i] = f2bf(w - bf2f(h)); }
}
}

using namespace mk;
constexpr size_t MiB = (size_t)1 << 20;
constexpr int NLAT = NB * SEQ, NCTXR = NB * CTX, NALL = NLAT + NCTXR, NRH = NLAT / 2, MAXSLOTS = NRH * SLOTS_PER_TOK + NE * BM;
constexpr size_t O_W1A = 0, O_W1C = O_W1A + (size_t)Z1_N * D * 2, O_WG = O_W1C + (size_t)ZC_N * D * 2, O_WBR = O_WG + (size_t)RW * AG_K * 2, O_WOUT = O_WBR + (size_t)2 * D * RW * 2,
                 O_RWT = O_WOUT + (size_t)D * D * 2, O_MODP = O_RWT + (size_t)2 * NE * D * 2, O_S_END = O_MODP + (size_t)MOD_SL * (NB + 1) * 6 * D * 4;
static_assert(O_S_END <= 27 * MiB, "S region");
constexpr size_t O_BAR = 27 * MiB;
constexpr size_t O_Z1 = 28 * MiB, O_R2 = O_Z1 + (size_t)NALL * Z1_N * 2;
static_assert(O_R2 == 334 * MiB, "z1 size");
constexpr size_t O_HD = O_R2, O_BON = O_W1A + (size_t)Z1_N * D  , O_AG = O_HD + (size_t)2 * NLAT * LW * 2,
                 O_XNL8 = O_AG + (size_t)NLAT * AG_K * 2  , O_R2_END = O_XNL8 + (size_t)NLAT * D;
static_assert(O_BON + (size_t)2 * NLAT * NH * 4 <= O_W1C, "bon");
static_assert(O_R2_END <= 512 * MiB, "R2");
constexpr size_t O_XNL = O_Z1, O_YB = O_XNL + (size_t)NLAT * D * 2, O_GATES = O_YB + (size_t)NLAT * LW * 2, O_MIXED = O_HD;
static_assert(O_GATES + (size_t)NLAT * 2 * D * 2 <= O_R2, "late R1");
constexpr size_t O_U = O_Z1, O_WGU = O_U + (size_t)NLAT * D * 2, O_WDN = O_WGU + (size_t)NEX * 2 * EF * D * 2, O_ROUT = O_WDN + (size_t)NEX * D * EF * 2;
constexpr size_t O_TOPE = O_ROUT, O_LRANK = O_TOPE + (size_t)NLAT * TOPK * 4, O_GATEV = O_LRANK + (size_t)NLAT * TOPK * 4, O_BLKCNT = O_GATEV + (size_t)NLAT * TOPK * 4, O_TILEPRE = O_BLKCNT + 256 * 64 * 4,
                 O_LIST = O_TILEPRE + 2048, O_SDST = O_LIST + (size_t)2 * MAXSLOTS * 4, O_SGATE = O_SDST + (size_t)2 * MAXSLOTS * 4, O_ACT = ((O_SGATE + (size_t)2 * MAXSLOTS * 4 + 255) / 256) * 256,
                 O_ROWSB = ((O_ACT + (size_t)MAXSLOTS * EF * 2 + 255) / 256) * 256, O_END = O_ROWSB + ((size_t)NRH * SLOTS_PER_TOK + 1) * D * 2;
static_assert(O_END <= 512 * MiB, "workspace");
constexpr size_t O_U8 = O_WGU + (size_t)NEX * 2 * EF * D;
static_assert(O_U8 + (size_t)NLAT * D <= O_WDN, "u8");
static_assert(O_WGU >= O_YB && O_ROWSB >= O_GATES, "late layout");

struct MP { In in; float* out; unsigned char* ws; long ph_lo, ph_hi; };
constexpr int NPHASE = 16;

#if defined(__HIP_DEVICE_COMPILE__)
#define MK_KARGS auto Pq_ = Pk_; asm volatile("" : "+s"(Pq_)); const MP* Pg_ = (const MP*)Pq_; const In in = Pg_->in; unsigned char* ws = Pg_->ws; float* out_ = Pg_->out; (void)out_;
#else
#define MK_KARGS const In in = P.in; unsigned char* ws = P.ws; float* out_ = P.out; (void)out_; (void)Pk_;
#endif
#define MK_PHASE_PTRS \
    MK_KARGS \
    bf16_t *W1a = (bf16_t*)(ws + O_W1A), *W1c = (bf16_t*)(ws + O_W1C), *Wg = (bf16_t*)(ws + O_WG), *Wbr = (bf16_t*)(ws + O_WBR), *Wout = (bf16_t*)(ws + O_WOUT), *rwt = (bf16_t*)(ws + O_RWT); \
    float* modpart = (float*)(ws + O_MODP); \
    bf16_t *z1 = (bf16_t*)(ws + O_Z1), *Hd = (bf16_t*)(ws + O_HD), *Ag = (bf16_t*)(ws + O_AG); float* bon = (float*)(ws + O_BON); \
    bf16_t *xnl = (bf16_t*)(ws + O_XNL8), *yb = (bf16_t*)(ws + O_YB), *gates = (bf16_t*)(ws + O_GATES), *mixed = (bf16_t*)(ws + O_MIXED); \
    unsigned char* u8 = ws + O_U8; \
    bf16_t *u = (bf16_t*)(ws + O_U), *Wgu = (bf16_t*)(ws + O_WGU), *Wdn = (bf16_t*)(ws + O_WDN), *act = (bf16_t*)(ws + O_ACT), *rowsb = (bf16_t*)(ws + O_ROWSB); \
    int *tope = (int*)(ws + O_TOPE), *lrank = (int*)(ws + O_LRANK), *blkcnt = (int*)(ws + O_BLKCNT), *tilepre = (int*)(ws + O_TILEPRE), *list = (int*)(ws + O_LIST), *sdst = (int*)(ws + O_SDST); \
    float *gatev = (float*)(ws + O_GATEV), *sgate = (float*)(ws + O_SGATE); \
    bf16_t* xn_all = (bf16_t*)out_; \
    bf16_t* Y = (bf16_t*)out_; \
    float* y2h1 = out_;
__device__ __forceinline__ void stagger_start(int bid, int ticks  ) {
    const int grp = (bid >> 3) & 3;
    if (grp) { const unsigned long long t0 = __builtin_amdgcn_s_memrealtime(); while (__builtin_amdgcn_s_memrealtime() - t0 < (unsigned long long)(grp * ticks)) __builtin_amdgcn_s_sleep(8); }
    __builtin_amdgcn_s_waitcnt(0xC07F);
}

__global__ void __launch_bounds__(512, 2) mega(MP P) {
    extern __shared__ __attribute__((aligned(16))) unsigned char shm[];
    LAS unsigned char* lds = (LAS unsigned char*)shm;
    typedef const __attribute__((address_space(4))) MP* KargP;
    const KargP Pk_ = (KargP)__builtin_amdgcn_kernarg_segment_ptr();
    const int bid = blockIdx.x, nblk = gridDim.x;
    const int gbid = (nblk & 7) ? bid : (bid & 7) * (nblk >> 3) + (bid >> 3);
    const int ph_lo = (int)P.ph_lo, ph_hi = (int)P.ph_hi;
    volatile LAS unsigned* xst = (volatile LAS unsigned*)(lds + LDS_BYTES - 16);
    if (threadIdx.x == 0) { xst[0] = 0u; xst[1] = 0u; }
    __syncthreads();
    const XcdBarrier xb = xcd_barrier_post((unsigned*)(P.ws + O_BAR), xst);
    if (0 >= ph_lo && 0 < ph_hi) { if (0 > ph_lo) xcd_barrier(xb); const int ph = 0; (void)ph; MK_PHASE_PTRS
        { LAS float* tile = (LAS float*)lds; int base = 0;
            convT_job<true>(tile, in.w_in, INC, D, W1a, D, Z1_N, CMapZ1{}, bid, nblk, base, 256.f);
            convT_job<true>(tile, in.w_in, INC, D, W1c, D, ZC_N, CMapZC{}, bid, nblk, base, 256.f);
            convT_job(tile, in.rw_g_up, RW, GL, Wg, AG_K, RW, CMapId{}, bid, nblk, base);
            convT_job(tile, in.w_branch_a, D, RW, Wbr, RW, D, CMapId{}, bid, nblk, base);
            convT_job(tile, in.w_branch_b, D, LW, Wbr + (size_t)D * RW, LW, D, CMapId{}, bid, nblk, base);
            convT_job(tile, in.w_out, D, D, Wout, D, D, CMapId{}, bid, nblk, base);
            rwt_prep(in, rwt, bid, nblk);
            mod_partials((LAS float*)lds, in, modpart, bid, nblk); }
    }
    if (1 >= ph_lo && 1 < ph_hi) { if (1 > ph_lo) xcd_barrier(xb); const int ph = 1; (void)ph; MK_PHASE_PTRS
        { const int L = NLAT / nblk, Lc = NCTXR / nblk;
            xn_rows<true>((LAS float*)lds, in, modpart, xn_all, 0, NB, bid * L, (bid + 1) * L, (unsigned char*)xnl);
            xn_rows<true>((LAS float*)lds, in, modpart, xn_all, 0, NB, NLAT + bid * Lc, NLAT + (bid + 1) * Lc); }
    }
    if (2 >= ph_lo && 2 < ph_hi) { if (2 > ph_lo) xcd_barrier(xb); const int ph = 2; (void)ph; MK_PHASE_PTRS
        { GemmP g{xn_all, xn_all, W1a, 0, nullptr, D / 2, 0}; StaticOrder S; S.init(NALL, Z1_N, nblk, bid); gemm_phase<false, true>(lds, g, S, EpiStoreBf16S{z1, Z1_N, 1.f / 4096.f, 0}); }
    }
    if (3 >= ph_lo && 3 < ph_hi) { if (3 > ph_lo) xcd_barrier(xb); const int ph = 3; (void)ph; MK_PHASE_PTRS
        { LruP lp{z1, Hd, 0, NB}; lru_phase(lds, in, lp, bid, nblk); __syncthreads();
                  RwkvP rp{z1, Y, bon, 0, NB}; r3::rwkv_phase3(lds, in, rp, bid, nblk); }
    }
    if (4 >= ph_lo && 4 < ph_hi) { if (4 > ph_lo) xcd_barrier(xb); const int ph = 4; (void)ph; MK_PHASE_PTRS
        { const int L = NLAT / nblk; PostP pp{z1, Y, bon, Ag, NLAT, 0}; rwkv_post_rows((LAS float*)lds, in, pp, bid * L, (bid + 1) * L); }
    }
    if (6 >= ph_lo && 6 < ph_hi) { if (6 > ph_lo) xcd_barrier(xb); const int ph = 6; (void)ph; MK_PHASE_PTRS
        { { GemmP g{Ag, Ag, Wg, 0, nullptr, AG_K, 0}; StaticOrder S; S.init(NLAT, RW, nblk, bid); gemm_phase(lds, g, S, EpiYa{Y, Y + (size_t)NLAT * RW}); } __syncthreads(); }
        { GemmP g{xnl, xnl, W1c, 0, nullptr, D / 2, 0}; StaticOrder S; S.init(NLAT, ZC_N, nblk, bid); gemm_phase<false, true>(lds, g, S, EpiZc{Hd, yb, gates, NLAT, 1.f / 4096.f}); }
    }
    if (7 >= ph_lo && 7 < ph_hi) { if (7 > ph_lo) xcd_barrier(xb); const int ph = 7; (void)ph; MK_PHASE_PTRS
        { GemmP g{Y + (size_t)NLAT * RW, yb, Wbr, (long)D * RW, nullptr, D, 0}; PairOrder S; S.S.init(NLAT, D, nblk, bid); gemm_phase(lds, g, S, EpiBranch{gates, mixed}); }
    }
    if (8 >= ph_lo && 8 < ph_hi) { if (8 > ph_lo) xcd_barrier(xb); const int ph = 8; (void)ph; MK_PHASE_PTRS
        { LAS float* tile = (LAS float*)lds;
            struct MGU { const float* ex; const float* sh; unsigned char* d; __device__ const float* src(int m) const { return m < NE ? ex + (size_t)m * D * 2 * EF : sh; } __device__ unsigned char* dst(int m) const { return d + (size_t)m * 2 * EF * D; } };
            struct MDN { const float* ex; const float* sh; unsigned char* d; __device__ const float* src(int m) const { return m < NE ? ex + (size_t)m * EF * D : sh; } __device__ unsigned char* dst(int m) const { return d + (size_t)m * D * EF; } };
            auto conv = [&]() __attribute__((always_inline)) {
                convT_multi<true>(tile, MGU{in.ex_w_gu, in.sh_w_gu, (unsigned char*)Wgu}, NEX, 2 * EF, D, D, 2 * EF, CMapGU{EF}, bid, nblk, FP8_SW);
                convT_multi<true>(tile, MDN{in.ex_w_down, in.sh_w_down, (unsigned char*)Wdn}, NEX, D, EF, EF, D, CMapId{}, bid, nblk, FP8_SWD); };
            (void)conv;
            { GemmP g{mixed, mixed, Wout, 0, nullptr, D, 0}; StaticOrder S; S.init(NLAT, D, nblk, bid); gemm_phase(lds, g, S, EpiStoreBf16{u, D}); } }
    }
    if (9 >= ph_lo && 9 < ph_hi) { if (9 > ph_lo) xcd_barrier(xb); const int ph = 9; (void)ph; MK_PHASE_PTRS
        { LAS float* tile = (LAS float*)lds;
            struct MGU { const float* ex; const float* sh; unsigned char* d; __device__ const float* src(int m) const { return m < NE ? ex + (size_t)m * D * 2 * EF : sh; } __device__ unsigned char* dst(int m) const { return d + (size_t)m * 2 * EF * D; } };
            struct MDN { const float* ex; const float* sh; unsigned char* d; __device__ const float* src(int m) const { return m < NE ? ex + (size_t)m * EF * D : sh; } __device__ unsigned char* dst(int m) const { return d + (size_t)m * D * EF; } };
            auto conv = [&]() __attribute__((always_inline)) {
                convT_multi<true>(tile, MGU{in.ex_w_gu, in.sh_w_gu, (unsigned char*)Wgu}, NEX, 2 * EF, D, D, 2 * EF, CMapGU{EF}, bid, nblk, FP8_SW);
                convT_multi<true>(tile, MDN{in.ex_w_down, in.sh_w_down, (unsigned char*)Wdn}, NEX, D, EF, EF, D, CMapId{}, bid, nblk, FP8_SWD); };
            if (bid & 1) { conv(); __syncthreads(); }
            { const int L = NLAT / nblk; RowP rp{y2h1, u, u8, modpart, rwt, tope, gatev, lrank, blkcnt, 0, NLAT}; row_pass(lds, in, rp, bid * L, (bid + 1) * L); }
            if (!(bid & 1)) { __syncthreads(); conv(); } }
    }
    if (10 >= ph_lo && 10 < ph_hi) { if (10 > ph_lo) xcd_barrier(xb); const int ph = 10; (void)ph; MK_PHASE_PTRS
        { const int q = ph - 10, half = q >= 4 ? 1 : 0, st = q - 4 * half;
            const int rpb = NLAT / nblk;
            auto assign = [&](int hf) { MoeP mp{tope, gatev, lrank, blkcnt, tilepre + hf * 256, list + (size_t)hf * MAXSLOTS, sdst + (size_t)hf * MAXSLOTS, sgate + (size_t)hf * MAXSLOTS, hf * NRH, NRH, hf * (nblk / 2), nblk / 2, rpb, 0}; moe_assign(lds, mp, bid, nblk); };
            auto fin = [&](int hf) { const int L = NRH / nblk, r0 = hf * NRH; final_rows((LAS float*)lds, in, modpart, rowsb, y2h1, 0, r0, r0 + bid * L, r0 + (bid + 1) * L); };
            if (ph == 10) { assign(0); __syncthreads(); assign(1); }
            else if (ph == 11 || ph == 13) { const int hf = ph == 13 ? 1 : 0;
                if (ph == 13 && (bid & 1)) { fin(0); __syncthreads(); }
                { GemmP g{(const bf16_t*)u8, (const bf16_t*)u8, Wgu, (long)EF * D, list + (size_t)hf * MAXSLOTS, D / 2, 0}; GroupOrder S; S.init(tilepre + hf * 256, 2 * EF / BM, nblk, gbid); gemm_phase<true, true>(lds, g, S, EpiGU{act}); }
                if (ph == 13 && !(bid & 1)) { __syncthreads(); fin(0); } }
            else if (ph == 12 || ph == 14) { const int hf = ph == 14 ? 1 : 0;
                GemmP g{act, act, Wdn, (long)D * EF / 2, nullptr, EF / 2, 0}; GroupOrder S; S.init(tilepre + hf * 256, D / BM, nblk, gbid); gemm_phase<false, true>(lds, g, S, EpiDown{sdst + (size_t)hf * MAXSLOTS, sgate + (size_t)hf * MAXSLOTS, rowsb, lds}); }
            else if (ph == 15) fin(1);
            (void)half; (void)st; }
    }
    if (11 >= ph_lo && 11 < ph_hi) { if (11 > ph_lo) xcd_barrier(xb); const int ph = 11; (void)ph; MK_PHASE_PTRS
        { const int q = ph - 10, half = q >= 4 ? 1 : 0, st = q - 4 * half;
            const int rpb = NLAT / nblk;
            auto assign = [&](int hf) { MoeP mp{tope, gatev, lrank, blkcnt, tilepre + hf * 256, list + (size_t)hf * MAXSLOTS, sdst + (size_t)hf * MAXSLOTS, sgate + (size_t)hf * MAXSLOTS, hf * NRH, NRH, hf * (nblk / 2), nblk / 2, rpb, 0}; moe_assign(lds, mp, bid, nblk); };
            auto fin = [&](int hf) { const int L = NRH / nblk, r0 = hf * NRH; final_rows((LAS float*)lds, in, modpart, rowsb, y2h1, 0, r0, r0 + bid * L, r0 + (bid + 1) * L); };
            if (ph == 10) { assign(0); __syncthreads(); assign(1); }
            else if (ph == 11 || ph == 13) { const int hf = ph == 13 ? 1 : 0;
                if (ph == 13 && (bid & 1)) { fin(0); __syncthreads(); }
                { GemmP g{(const bf16_t*)u8, (const bf16_t*)u8, Wgu, (long)EF * D, list + (size_t)hf * MAXSLOTS, D / 2, 0}; GroupOrder S; S.init(tilepre + hf * 256, 2 * EF / BM, nblk, gbid); gemm_phase<true, true>(lds, g, S, EpiGU{act}); }
                if (ph == 13 && !(bid & 1)) { __syncthreads(); fin(0); } }
            else if (ph == 12 || ph == 14) { const int hf = ph == 14 ? 1 : 0;
                GemmP g{act, act, Wdn, (long)D * EF / 2, nullptr, EF / 2, 0}; GroupOrder S; S.init(tilepre + hf * 256, D / BM, nblk, gbid); gemm_phase<false, true>(lds, g, S, EpiDown{sdst + (size_t)hf * MAXSLOTS, sgate + (size_t)hf * MAXSLOTS, rowsb, lds}); }
            else if (ph == 15) fin(1);
            (void)half; (void)st; }
    }
    if (12 >= ph_lo && 12 < ph_hi) { if (12 > ph_lo) xcd_barrier(xb); const int ph = 12; (void)ph; MK_PHASE_PTRS
        { const int q = ph - 10, half = q >= 4 ? 1 : 0, st = q - 4 * half;
            const int rpb = NLAT / nblk;
            auto assign = [&](int hf) { MoeP mp{tope, gatev, lrank, blkcnt, tilepre + hf * 256, list + (size_t)hf * MAXSLOTS, sdst + (size_t)hf * MAXSLOTS, sgate + (size_t)hf * MAXSLOTS, hf * NRH, NRH, hf * (nblk / 2), nblk / 2, rpb, 0}; moe_assign(lds, mp, bid, nblk); };
            auto fin = [&](int hf) { const int L = NRH / nblk, r0 = hf * NRH; final_rows((LAS float*)lds, in, modpart, rowsb, y2h1, 0, r0, r0 + bid * L, r0 + (bid + 1) * L); };
            if (ph == 10) { assign(0); __syncthreads(); assign(1); }
            else if (ph == 11 || ph == 13) { const int hf = ph == 13 ? 1 : 0;
                if (ph == 13 && (bid & 1)) { fin(0); __syncthreads(); }
                { GemmP g{(const bf16_t*)u8, (const bf16_t*)u8, Wgu, (long)EF * D, list + (size_t)hf * MAXSLOTS, D / 2, 0}; GroupOrder S; S.init(tilepre + hf * 256, 2 * EF / BM, nblk, gbid); gemm_phase<true, true>(lds, g, S, EpiGU{act}); }
                if (ph == 13 && !(bid & 1)) { __syncthreads(); fin(0); } }
            else if (ph == 12 || ph == 14) { const int hf = ph == 14 ? 1 : 0;
                GemmP g{act, act, Wdn, (long)D * EF / 2, nullptr, EF / 2, 0}; GroupOrder S; S.init(tilepre + hf * 256, D / BM, nblk, gbid); gemm_phase<false, true>(lds, g, S, EpiDown{sdst + (size_t)hf * MAXSLOTS, sgate + (size_t)hf * MAXSLOTS, rowsb, lds}); }
            else if (ph == 15) fin(1);
            (void)half; (void)st; }
    }
    if (13 >= ph_lo && 13 < ph_hi) { if (13 > ph_lo) xcd_barrier(xb); const int ph = 13; (void)ph; MK_PHASE_PTRS
        { const int q = ph - 10, half = q >= 4 ? 1 : 0, st = q - 4 * half;
            const int rpb = NLAT / nblk;
            auto assign = [&](int hf) { MoeP mp{tope, gatev, lrank, blkcnt, tilepre + hf * 256, list + (size_t)hf * MAXSLOTS, sdst + (size_t)hf * MAXSLOTS, sgate + (size_t)hf * MAXSLOTS, hf * NRH, NRH, hf * (nblk / 2), nblk / 2, rpb, 0}; moe_assign(lds, mp, bid, nblk); };
            auto fin = [&](int hf) { const int L = NRH / nblk, r0 = hf * NRH; final_rows((LAS float*)lds, in, modpart, rowsb, y2h1, 0, r0, r0 + bid * L, r0 + (bid + 1) * L); };
            if (ph == 10) { assign(0); __syncthreads(); assign(1); }
            else if (ph == 11 || ph == 13) { const int hf = ph == 13 ? 1 : 0;
                if (ph == 13 && (bid & 1)) { fin(0); __syncthreads(); }
                { GemmP g{(const bf16_t*)u8, (const bf16_t*)u8, Wgu, (long)EF * D, list + (size_t)hf * MAXSLOTS, D / 2, 0}; GroupOrder S; S.init(tilepre + hf * 256, 2 * EF / BM, nblk, gbid); gemm_phase<true, true>(lds, g, S, EpiGU{act}); }
                if (ph == 13 && !(bid & 1)) { __syncthreads(); fin(0); } }
            else if (ph == 12 || ph == 14) { const int hf = ph == 14 ? 1 : 0;
                GemmP g{act, act, Wdn, (long)D * EF / 2, nullptr, EF / 2, 0}; GroupOrder S; S.init(tilepre + hf * 256, D / BM, nblk, gbid); gemm_phase<false, true>(lds, g, S, EpiDown{sdst + (size_t)hf * MAXSLOTS, sgate + (size_t)hf * MAXSLOTS, rowsb, lds}); }
            else if (ph == 15) fin(1);
            (void)half; (void)st; }
    }
    if (14 >= ph_lo && 14 < ph_hi) { if (14 > ph_lo) xcd_barrier(xb); const int ph = 14; (void)ph; MK_PHASE_PTRS
        { const int q = ph - 10, half = q >= 4 ? 1 : 0, st = q - 4 * half;
            const int rpb = NLAT / nblk;
            auto assign = [&](int hf) { MoeP mp{tope, gatev, lrank, blkcnt, tilepre + hf * 256, list + (size_t)hf * MAXSLOTS, sdst + (size_t)hf * MAXSLOTS, sgate + (size_t)hf * MAXSLOTS, hf * NRH, NRH, hf * (nblk / 2), nblk / 2, rpb, 0}; moe_assign(lds, mp, bid, nblk); };
            auto fin = [&](int hf) { const int L = NRH / nblk, r0 = hf * NRH; final_rows((LAS float*)lds, in, modpart, rowsb, y2h1, 0, r0, r0 + bid * L, r0 + (bid + 1) * L); };
            if (ph == 10) { assign(0); __syncthreads(); assign(1); }
            else if (ph == 11 || ph == 13) { const int hf = ph == 13 ? 1 : 0;
                if (ph == 13 && (bid & 1)) { fin(0); __syncthreads(); }
                { GemmP g{(const bf16_t*)u8, (const bf16_t*)u8, Wgu, (long)EF * D, list + (size_t)hf * MAXSLOTS, D / 2, 0}; GroupOrder S; S.init(tilepre + hf * 256, 2 * EF / BM, nblk, gbid); gemm_phase<true, true>(lds, g, S, EpiGU{act}); }
                if (ph == 13 && !(bid & 1)) { __syncthreads(); fin(0); } }
            else if (ph == 12 || ph == 14) { const int hf = ph == 14 ? 1 : 0;
                GemmP g{act, act, Wdn, (long)D * EF / 2, nullptr, EF / 2, 0}; GroupOrder S; S.init(tilepre + hf * 256, D / BM, nblk, gbid); gemm_phase<false, true>(lds, g, S, EpiDown{sdst + (size_t)hf * MAXSLOTS, sgate + (size_t)hf * MAXSLOTS, rowsb, lds}); }
            else if (ph == 15) fin(1);
            (void)half; (void)st; }
    }
    if (15 >= ph_lo && 15 < ph_hi) { if (15 > ph_lo) xcd_barrier(xb); const int ph = 15; (void)ph; MK_PHASE_PTRS
        { const int q = ph - 10, half = q >= 4 ? 1 : 0, st = q - 4 * half;
            const int rpb = NLAT / nblk;
            auto assign = [&](int hf) { MoeP mp{tope, gatev, lrank, blkcnt, tilepre + hf * 256, list + (size_t)hf * MAXSLOTS, sdst + (size_t)hf * MAXSLOTS, sgate + (size_t)hf * MAXSLOTS, hf * NRH, NRH, hf * (nblk / 2), nblk / 2, rpb, 0}; moe_assign(lds, mp, bid, nblk); };
            auto fin = [&](int hf) { const int L = NRH / nblk, r0 = hf * NRH; final_rows((LAS float*)lds, in, modpart, rowsb, y2h1, 0, r0, r0 + bid * L, r0 + (bid + 1) * L); };
            if (ph == 10) { assign(0); __syncthreads(); assign(1); }
            else if (ph == 11 || ph == 13) { const int hf = ph == 13 ? 1 : 0;
                if (ph == 13 && (bid & 1)) { fin(0); __syncthreads(); }
                { GemmP g{(const bf16_t*)u8, (const bf16_t*)u8, Wgu, (long)EF * D, list + (size_t)hf * MAXSLOTS, D / 2, 0}; GroupOrder S; S.init(tilepre + hf * 256, 2 * EF / BM, nblk, gbid); gemm_phase<true, true>(lds, g, S, EpiGU{act}); }
                if (ph == 13 && !(bid & 1)) { __syncthreads(); fin(0); } }
            else if (ph == 12 || ph == 14) { const int hf = ph == 14 ? 1 : 0;
                GemmP g{act, act, Wdn, (long)D * EF / 2, nullptr, EF / 2, 0}; GroupOrder S; S.init(tilepre + hf * 256, D / BM, nblk, gbid); gemm_phase<false, true>(lds, g, S, EpiDown{sdst + (size_t)hf * MAXSLOTS, sgate + (size_t)hf * MAXSLOTS, rowsb, lds}); }
            else if (ph == 15) fin(1);
            (void)half; (void)st; }
    }
}
extern "C" void kernel_launch(void* const* d_in, const int* in_sizes, int n_in, void* d_out, int out_size, void* d_ws, size_t ws_size, hipStream_t stream) {
    static int grid = 0;
    if (grid == 0) {
        int dev = 0, cus = 0; hipGetDevice(&dev); hipDeviceGetAttribute(&cus, hipDeviceAttributeMultiprocessorCount, dev);
        hipFuncSetAttribute((const void*)mega, hipFuncAttributeMaxDynamicSharedMemorySize, LDS_BYTES);
        grid = cus;
        if (ws_size < O_END || grid != 256) fprintf(stderr, "kernel_launch: unexpected ws_size %zu (need %zu) or CU count %d\n", ws_size, (size_t)O_END, grid);
    }
    hipMemsetAsync((char*)d_ws + O_BAR, 0, XCD_BAR_WORDS * 4, stream);
    MP P; memset(&P, 0, sizeof(P));
    const float** f = (const float**)&P.in; for (int i = 0; i < 32; ++i) f[i] = (const float*)d_in[i];
    P.out = (float*)d_out; P.ws = (unsigned char*)d_ws;
#ifdef MK_PER_PHASE
    for (int ph = 0; ph < NPHASE; ++ph) { P.ph_lo = ph; P.ph_hi = ph + 1; hipLaunchKernelGGL(mega, dim3(grid), dim3(NT), LDS_BYTES, stream, P); }
#else
    P.ph_lo = 0; P.ph_hi = NPHASE;
    void* args[] = {&P};
    hipError_t e = hipLaunchCooperativeKernel((void*)mega, dim3(grid), dim3(NT), args, LDS_BYTES, stream);
    if (e != hipSuccess) fprintf(stderr, "cooperative launch failed: %s (grid %d)\n", hipGetErrorString(e), grid);
#endif
}
```
